# Optimizing an MI355X kernel written in HIP

```python
import jax, jax.numpy as jnp
from jax import lax
import numpy as np

D_MODEL = 1024
BATCH = 8
SEQ = 2048
DEPTH = 2
DEC_BATCH = 32
DEC_SEQ = 1
PAST_LEN = 8192
PAGE_SIZE = 128

N_EVEN = (DEPTH + 1) // 2
N_ODD = DEPTH // 2
D_A = D_MODEL // 2
CONV_W = 31
H_B = 8
HD_B = 64
D_B = H_B * HD_B
KV_H = 2
GRP = H_B // KV_H
L_CMP = 32
L_SEL = 64
K_SEL = 16
WINDOW = 512
Q_BLK_SEL = 64
Q_BLK_WIN = 128
FORCE = 1e4
HD_C = 64
H_C = D_MODEL // HD_C
D_C = H_C * HD_C
LORA_W = 64
LORA_A = 64
GN_EPS = 64e-5
ALPHA = (2 * DEPTH) ** 0.25
BETA = (8 * DEPTH) ** -0.25
LN_EPS = 1e-5
NEG = -1e30
D_IN_EVEN = 3 * D_A + D_B + 6 * KV_H * HD_B + 3 * H_B + D_B

kernel_name = 'hybrid_conformer_nsa_rwkv7_deepnorm_step'


def _layer_norm(x, g, b, eps=LN_EPS):
    xf = x.astype(jnp.float32)
    mu = xf.mean(-1, keepdims=True)
    var = jnp.square(xf - mu).mean(-1, keepdims=True)
    return ((xf - mu) * lax.rsqrt(var + eps) * g + b).astype(x.dtype)


def _masked_softmax(s, mask):
    p = jax.nn.softmax(jnp.where(mask, s, NEG), axis=-1)
    return jnp.where(mask, p, 0.0)


def _alibi_slopes():
    return jnp.exp2(-8.0 * (jnp.arange(H_B, dtype=jnp.float32) + 1.0) / H_B).reshape(KV_H, GRP)


def nsa_cmp_sel(qf, q_pos, kv_cmp, kv_sel, wk_cmp, wv_cmp, slopes):
    f32 = jnp.float32
    B, Tq = qf.shape[:2]
    Lk = kv_cmp.shape[1]
    n_cmp = Lk // L_CMP
    blk = kv_cmp[:, :n_cmp * L_CMP].reshape(B, n_cmp, L_CMP, 2, KV_H, HD_B).astype(f32)
    kc = jnp.einsum('bnlgd,lg->bngd', blk[:, :, :, 0], wk_cmp.astype(f32))
    vc = jnp.einsum('bnlgd,lg->bngd', blk[:, :, :, 1], wv_cmp.astype(f32))
    c_end = jnp.arange(n_cmp) * L_CMP + (L_CMP - 1)
    dist_c = q_pos[:, None] - c_end[None, :]
    s_c = (jnp.einsum('btgrd,bngd->btgrn', qf, kc)
           - slopes[None, None, :, :, None] * dist_c[None, :, None, None, :].astype(f32))
    p_c = _masked_softmax(s_c, (dist_c >= 0)[None, :, None, None, :])
    o_c = jnp.einsum('btgrn,bngd->btgrd', p_c, vc)
    n_sel = -(-Lk // L_SEL)
    ratio = L_SEL // L_CMP
    imp = jnp.pad(p_c.sum(axis=3), ((0, 0), (0, 0), (0, 0), (0, n_sel * ratio - n_cmp)))
    imp = imp.reshape(B, Tq, KV_H, n_sel, ratio).sum(-1)
    sb = jnp.arange(n_sel)[None, :]
    tb = (q_pos // L_SEL)[:, None]
    forced = (sb == 0) | (sb == tb) | (sb == tb - 1)
    imp = jnp.where(forced[None, :, None, :], FORCE, imp)
    imp = jnp.where((sb <= tb)[None, :, None, :], imp, -jnp.inf)
    k_top = min(K_SEL, n_sel)
    _, idx = lax.top_k(imp, k_top)
    pad = n_sel * L_SEL - Lk
    ks = jnp.pad(kv_sel, ((0, 0), (0, pad), (0, 0), (0, 0), (0, 0)))
    ks = ks.reshape(B, n_sel, L_SEL, 2, KV_H, HD_B).transpose(0, 4, 1, 3, 2, 5)
    bi = jnp.arange(B)[:, None, None, None]
    gi = jnp.arange(KV_H)[None, :, None, None]
    lpos = jnp.arange(L_SEL)

    def sel_block(args):
        qb, pb, ib = args
        it = ib.transpose(0, 2, 1, 3)
        kvg = ks[bi, gi, it].astype(f32)
        kpos = it[..., None] * L_SEL + lpos
        dist = pb[None, None, :, None, None] - kpos
        s = (jnp.einsum('bqgrd,bgqkld->bgqrkl', qb, kvg[:, :, :, :, 0])
             - slopes[None, :, None, :, None, None] * dist[:, :, :, None].astype(f32))
        sh = s.shape
        p = _masked_softmax(s.reshape(sh[:4] + (-1,)), (dist >= 0)[:, :, :, None].reshape(sh[:3] + (1, -1)))
        return jnp.einsum('bgqrkl,bgqkld->bqgrd', p.reshape(sh), kvg[:, :, :, :, 1])

    qbs = Q_BLK_SEL if Tq % Q_BLK_SEL == 0 else Tq
    nb = Tq // qbs
    o_s = lax.map(sel_block, (qf.reshape(B, nb, qbs, KV_H, GRP, HD_B).swapaxes(0, 1),
                              q_pos.reshape(nb, qbs),
                              idx.reshape(B, nb, qbs, KV_H, k_top).swapaxes(0, 1)))
    o_s = o_s.swapaxes(0, 1).reshape(B, Tq, KV_H, GRP, HD_B)
    return o_c, o_s


def window_banded(qf, kv_w, slopes):
    f32 = jnp.float32
    B, T = qf.shape[:2]
    qbs = min(Q_BLK_WIN, T)
    nb = T // qbs
    kvp = jnp.pad(kv_w, ((0, 0), (WINDOW, 0), (0, 0), (0, 0), (0, 0)))
    kidx = jnp.arange(nb)[:, None] * qbs + jnp.arange(qbs + WINDOW)[None, :]
    kvb = kvp[:, kidx].astype(f32)
    kpos = kidx - WINDOW
    qpos = jnp.arange(T).reshape(nb, qbs)
    dist = qpos[:, :, None] - kpos[:, None, :]
    mask = (dist >= 0) & (dist < WINDOW) & (kpos[:, None, :] >= 0)
    qb = qf.reshape(B, nb, qbs, KV_H, GRP, HD_B)
    s = (jnp.einsum('bnqgrd,bnkgd->bngrqk', qb, kvb[:, :, :, 0])
         - slopes[None, None, :, :, None, None] * dist[None, :, None, None].astype(f32))
    p = _masked_softmax(s, mask[None, :, None, None])
    o = jnp.einsum('bngrqk,bnkgd->bnqgrd', p, kvb[:, :, :, 1])
    return o.reshape(B, T, KV_H, GRP, HD_B)


def window_dense(qf, q_pos, kv_ctx, k_pos0, slopes):
    f32 = jnp.float32
    kvf = kv_ctx.astype(f32)
    kpos = k_pos0 + jnp.arange(kv_ctx.shape[1])
    dist = q_pos[:, None] - kpos[None, :]
    mask = (dist >= 0) & (dist < WINDOW)
    s = (jnp.einsum('btgrd,bkgd->bgrtk', qf, kvf[:, :, 0])
         - slopes[None, :, :, None, None] * dist[None, None, None].astype(f32))
    p = _masked_softmax(s, mask[None, None, None])
    return jnp.einsum('bgrtk,bkgd->btgrd', p, kvf[:, :, 1])


def even_mixer(x, q_pos, conv_prev, past_cmp, past_sel, win_prev, w_in, conv_w, conv_b, cln_g, cln_b,
               wk_cmp, wv_cmp, w_out, slopes, banded):
    f32 = jnp.float32
    B, T, _ = x.shape
    h = x @ w_in
    cuts = [int(c) for c in np.cumsum([D_A, D_A, D_A, D_B, 6 * KV_H * HD_B, 3 * H_B])]
    a_val, a_glu, z_a, q, kv6, g3, z_b = jnp.split(h, cuts, axis=-1)
    u = a_val * jax.nn.sigmoid(a_glu)
    ext = jnp.concatenate([conv_prev.astype(u.dtype), u], axis=1)
    c = lax.conv_general_dilated(ext, conv_w.astype(u.dtype), (1,), 'VALID',
                                 dimension_numbers=('NWC', 'WIO', 'NWC'), feature_group_count=D_A) + conv_b
    ya = jax.nn.silu(_layer_norm(c, cln_g, cln_b)) * jax.nn.silu(z_a)
    conv_new = ext[:, ext.shape[1] - (CONV_W - 1):]
    qf = q.reshape(B, T, KV_H, GRP, HD_B).astype(f32) * (HD_B ** -0.5)
    kv6 = kv6.reshape(B, T, 3, 2, KV_H, HD_B)
    cmp_new, sel_new, win_new = kv6[:, :, 0], kv6[:, :, 1], kv6[:, :, 2]
    kv_cmp = jnp.concatenate([past_cmp.astype(x.dtype), cmp_new], axis=1)
    kv_sel = jnp.concatenate([past_sel.astype(x.dtype), sel_new], axis=1)
    o_c, o_s = nsa_cmp_sel(qf, q_pos, kv_cmp, kv_sel, wk_cmp, wv_cmp, slopes)
    if banded:
        o_w = window_banded(qf, win_new, slopes)
        win_state = win_new[:, T - min(WINDOW, T):]
    else:
        ctx = jnp.concatenate([win_prev.astype(x.dtype), win_new], axis=1)
        o_w = window_dense(qf, q_pos, ctx, q_pos[0] - win_prev.shape[1], slopes)
        win_state = ctx[:, ctx.shape[1] - min(WINDOW, ctx.shape[1]):]
    g = jax.nn.sigmoid(g3.astype(f32)).reshape(B, T, KV_H, GRP, 3)
    o = g[..., 0:1] * o_c + g[..., 1:2] * o_s + g[..., 2:3] * o_w
    yb = o.reshape(B, T, D_B).astype(x.dtype) * jax.nn.silu(z_b)
    y = jnp.concatenate([ya, yb], axis=-1) @ w_out
    return y, cmp_new, sel_new, win_state, conv_new


def rwkv_mixer(x, shift_prev, S0, mu, w_rkvz, w0, w1, w2, a0, a1, a2, k_k, k_a, r_k, gn_g, gn_b, w_out):
    f32 = jnp.float32
    B, T, _ = x.shape
    x_prev = jnp.concatenate([shift_prev[:, None].astype(x.dtype), x[:, :-1]], axis=1)
    xsh = x[None] + (x_prev - x)[None] * mu[:, None, None, :]
    r, k, v, z = jnp.einsum('nbtd,nde->nbte', xsh[:4], w_rkvz)
    r, k, v = r.astype(f32), k.astype(f32), v.astype(f32)
    w_raw = -jax.nn.softplus(-(w0 + jnp.tanh(xsh[4] @ w1) @ w2).astype(f32)) - 0.5
    decay = jnp.exp(-jnp.exp(w_raw))
    a = jax.nn.sigmoid((a0 + (xsh[5] @ a1) @ a2).astype(f32))
    kk = (k * k_k).reshape(B, T, H_C, HD_C)
    kk = kk / jnp.maximum(jnp.sqrt(jnp.sum(kk * kk, axis=-1, keepdims=True)), 1e-12)
    k = k * (1.0 + (a - 1.0) * k_a)
    hs = lambda t: t.reshape(B, T, H_C, HD_C)
    r, decay, k, v, a = hs(r), hs(decay), hs(k), hs(v), hs(a)

    def step(S, inp):
        r_t, w_t, k_t, v_t, kk_t, a_t = inp
        sa = jnp.einsum('bhvk,bhk->bhv', S, kk_t)
        S = S * w_t[:, :, None, :] - sa[..., None] * (kk_t * a_t)[:, :, None, :] + v_t[..., None] * k_t[:, :, None, :]
        return S, jnp.einsum('bhvk,bhk->bhv', S, r_t)

    tm = lambda t: jnp.swapaxes(t, 0, 1)
    S_fin, y = lax.scan(step, S0.astype(f32), (tm(r), tm(decay), tm(k), tm(v), tm(kk), tm(a)))
    y = jnp.swapaxes(y, 0, 1)
    mu_y = y.mean(-1, keepdims=True)
    var_y = jnp.square(y - mu_y).mean(-1, keepdims=True)
    y = (y - mu_y) * lax.rsqrt(var_y + GN_EPS) * gn_g.reshape(H_C, HD_C) + gn_b.reshape(H_C, HD_C)
    y = y + jnp.sum(r * k * r_k, axis=-1, keepdims=True) * v
    out = (y.reshape(B, T, D_C).astype(x.dtype) * jax.nn.silu(z)) @ w_out
    return out, S_fin, x[:, -1]


def setup_inputs(seed: int = 0) -> dict:
    key = jax.random.key(seed)
    ks = iter(jax.random.split(key, 48))
    nrm = lambda shape, scale: scale * jax.random.normal(next(ks), shape, jnp.float32)
    n_pages = PAST_LEN // PAGE_SIZE
    used = DEC_BATCH * n_pages
    n_pool = used + max(1, used // 4)
    w_buf = min(WINDOW, PAST_LEN)
    return {
        'x_prompt': nrm((BATCH, SEQ, D_MODEL), 1.0),
        'x_sample': nrm((DEC_BATCH, DEC_SEQ, D_MODEL), 1.0),
        'cache_cmp_kv': nrm((N_EVEN, n_pool, PAGE_SIZE, 2, KV_H, HD_B), 1.0),
        'cache_sel_kv': nrm((N_EVEN, n_pool, PAGE_SIZE, 2, KV_H, HD_B), 1.0),
        'cache_win_kv': nrm((N_EVEN, DEC_BATCH, w_buf, 2, KV_H, HD_B), 1.0),
        'state_conv': nrm((N_EVEN, DEC_BATCH, CONV_W - 1, D_A), 0.5),
        'state_wkv': nrm((N_ODD, DEC_BATCH, H_C, HD_C, HD_C), 0.5),
        'state_shift': nrm((N_ODD, DEC_BATCH, D_MODEL), 1.0),
        'page_table': jax.random.permutation(next(ks), n_pool)[:used].reshape(DEC_BATCH, n_pages).astype(jnp.int32),
        'w_in_even': nrm((N_EVEN, D_MODEL, D_IN_EVEN), D_MODEL ** -0.5),
        'conv_w': nrm((N_EVEN, CONV_W, 1, D_A), CONV_W ** -0.5),
        'conv_b': nrm((N_EVEN, D_A), 0.02),
        'conv_ln_g': 1.0 + nrm((N_EVEN, D_A), 0.02),
        'conv_ln_b': nrm((N_EVEN, D_A), 0.02),
        'wk_cmp': (1.0 + nrm((N_EVEN, L_CMP, KV_H), 0.1)) / L_CMP,
        'wv_cmp': (1.0 + nrm((N_EVEN, L_CMP, KV_H), 0.1)) / L_CMP,
        'w_out_even': nrm((N_EVEN, D_A + D_B, D_MODEL), BETA * (D_A + D_B) ** -0.5),
        'mu_c': jax.random.uniform(next(ks), (N_ODD, 6, D_MODEL), jnp.float32),
        'w_rkvz': nrm((N_ODD, 4, D_MODEL, D_C), D_MODEL ** -0.5),
        'w0': -0.6 + nrm((N_ODD, D_C), 0.5),
        'w1': nrm((N_ODD, D_MODEL, LORA_W), D_MODEL ** -0.5),
        'w2': nrm((N_ODD, LORA_W, D_C), 0.5 * LORA_W ** -0.5),
        'a0': nrm((N_ODD, D_C), 0.3),
        'a1': nrm((N_ODD, D_MODEL, LORA_A), D_MODEL ** -0.5),
        'a2': nrm((N_ODD, LORA_A, D_C), 0.5 * LORA_A ** -0.5),
        'k_k': 0.85 + nrm((N_ODD, D_C), 0.05),
        'k_a': 1.0 + nrm((N_ODD, D_C), 0.05),
        'r_k': nrm((N_ODD, H_C, HD_C), 0.1),
        'gn_g': 1.0 + nrm((N_ODD, D_C), 0.02),
        'gn_b': nrm((N_ODD, D_C), 0.02),
        'w_out_odd': nrm((N_ODD, D_C, D_MODEL), BETA * D_C ** -0.5),
        'ln_g': 1.0 + nrm((DEPTH, D_MODEL), 0.02),
        'ln_b': nrm((DEPTH, D_MODEL), 0.02),
    }


def reference(x_prompt, x_sample, cache_cmp_kv, cache_sel_kv, cache_win_kv, state_conv, state_wkv, state_shift,
              page_table, w_in_even, conv_w, conv_b, conv_ln_g, conv_ln_b, wk_cmp, wv_cmp, w_out_even,
              mu_c, w_rkvz, w0, w1, w2, a0, a1, a2, k_k, k_a, r_k, gn_g, gn_b, w_out_odd, ln_g, ln_b):
    slopes = _alibi_slopes()
    Bp, Tp, _ = x_prompt.shape
    Bs, Ts, _ = x_sample.shape
    past_len = page_table.shape[1] * PAGE_SIZE
    pos_p = jnp.arange(Tp, dtype=jnp.int32)
    pos_s = past_len + jnp.arange(Ts, dtype=jnp.int32)
    xp, xq = x_prompt, x_sample
    cmp_p, cmp_s, sel_p, sel_s, win_p, win_s, conv_p, conv_s = [], [], [], [], [], [], [], []
    wkv_p, wkv_s, sh_p, sh_s = [], [], [], []
    for l in range(DEPTH):
        if l % 2 == 0:
            e = l // 2
            pe = (w_in_even[e], conv_w[e], conv_b[e], conv_ln_g[e], conv_ln_b[e], wk_cmp[e], wv_cmp[e], w_out_even[e], slopes)
            empty = jnp.zeros((Bp, 0, 2, KV_H, HD_B), xp.dtype)
            yp, c1, s1, w1_, v1 = even_mixer(xp, pos_p, jnp.zeros((Bp, CONV_W - 1, D_A), xp.dtype),
                                             empty, empty, empty, *pe, banded=True)
            past_c = cache_cmp_kv[e][page_table].reshape(Bs, past_len, 2, KV_H, HD_B)
            past_s = cache_sel_kv[e][page_table].reshape(Bs, past_len, 2, KV_H, HD_B)
            ys, c2, s2, w2_, v2 = even_mixer(xq, pos_s, state_conv[e], past_c, past_s, cache_win_kv[e],
                                             *pe, banded=False)
            cmp_p.append(c1); cmp_s.append(c2); sel_p.append(s1); sel_s.append(s2)
            win_p.append(w1_); win_s.append(w2_); conv_p.append(v1); conv_s.append(v2)
        else:
            o = l // 2
            po = (mu_c[o], w_rkvz[o], w0[o], w1[o], w2[o], a0[o], a1[o], a2[o], k_k[o], k_a[o], r_k[o],
                  gn_g[o], gn_b[o], w_out_odd[o])
            yp, S1, h1 = rwkv_mixer(xp, jnp.zeros((Bp, D_MODEL), xp.dtype),
                                    jnp.zeros((Bp, H_C, HD_C, HD_C), jnp.float32), *po)
            ys, S2, h2 = rwkv_mixer(xq, state_shift[o], state_wkv[o], *po)
            wkv_p.append(S1); wkv_s.append(S2); sh_p.append(h1); sh_s.append(h2)
        xp = _layer_norm(ALPHA * xp + yp, ln_g[l], ln_b[l])
        xq = _layer_norm(ALPHA * xq + ys, ln_g[l], ln_b[l])
    return (xp, xq,
            jnp.stack(cmp_p), jnp.stack(cmp_s), jnp.stack(sel_p), jnp.stack(sel_s),
            jnp.stack(win_p), jnp.stack(win_s), jnp.stack(conv_p), jnp.stack(conv_s),
            jnp.stack(wkv_p), jnp.stack(wkv_s), jnp.stack(sh_p), jnp.stack(sh_s))
```

```cpp
#include <hip/hip_runtime.h>
#include <hip/hip_cooperative_groups.h>
#include <cstdio>
namespace cg = cooperative_groups;

constexpr int D = 1024, BP = 8, TP = 2048, MP = BP * TP, BS = 32, MT = MP + BS;
constexpr int DIN = 3352;
constexpr int C_AVAL = 0, C_AGLU = 512, C_ZA = 1024, C_Q = 1536, C_KV = 2048, C_G3 = 2816, C_ZB = 2840;
constexpr int C_CMP = C_KV, C_SEL = C_KV + 256, C_WIN = C_KV + 512;
constexpr int PAST = 8192, NPAGE = 64, PAGE = 128;
constexpr float ALPHA = 1.4142135623730951f;
constexpr float LN_EPS = 1e-5f, GN_EPS = 64e-5f;

constexpr size_t O_Y = 0, O_YS = 16777216, O_CMPP = 16809984, O_CMPS = 21004288, O_SELP = 21012480, O_SELS = 25206784,
                 O_WINP = 25214976, O_WINS = 26263552, O_CONVP = 30457856, O_CONVS = 30580736, O_WKVP = 31072256,
                 O_WKVS = 31596544, O_SHP = 33693696, O_SHS = 33701888;

enum { I_XP = 0, I_XS, I_CCMP, I_CSEL, I_CWIN, I_SCONV, I_SWKV, I_SSHIFT, I_PT, I_WIN, I_CONVW, I_CONVB, I_CLNG, I_CLNB,
       I_WKC, I_WVC, I_WOUTE, I_MU, I_WRKVZ, I_W0, I_W1, I_W2, I_A0, I_A1, I_A2, I_KK, I_KA, I_RK, I_GNG, I_GNB, I_WOUTO,
       I_LNG, I_LNB, N_IN };

constexpr size_t SZ_ROWD = (size_t)MT * D;
constexpr size_t WS_H = 0;
constexpr size_t WS_CAT = WS_H + (size_t)MT * DIN;
constexpr size_t WS_OC = WS_CAT + SZ_ROWD;
constexpr size_t WS_XSH = 0;
constexpr size_t WS_Y = 0;
constexpr size_t WS_G4 = SZ_ROWD;
constexpr size_t WS_R0END = 6 * SZ_ROWD;
constexpr size_t WS_PRE = WS_R0END;
constexpr size_t WS_X1 = WS_PRE + SZ_ROWD;
constexpr size_t WS_R = WS_X1 + SZ_ROWD;
constexpr size_t WS_K = WS_R + SZ_ROWD;
constexpr size_t WS_V = WS_K + SZ_ROWD;
constexpr size_t WS_Z = WS_V + SZ_ROWD;
constexpr size_t WS_DEC = WS_Z + SZ_ROWD;
constexpr size_t WS_KKN = WS_DEC + SZ_ROWD;
constexpr size_t WS_KKA = WS_KKN + SZ_ROWD;
constexpr size_t WS_TW = WS_KKA + SZ_ROWD;
constexpr size_t WS_AW = WS_TW + (size_t)MT * 64;
constexpr size_t WS_RK = WS_AW + (size_t)MT * 64;
constexpr size_t WS_END = WS_RK + (size_t)MT * 16;
constexpr size_t WS_PCP = WS_R;
constexpr size_t WS_PCS = WS_R + (size_t)MP * 8 * 64;
constexpr size_t WS_IMP = WS_K;
constexpr size_t WS_SELIDX = WS_V;
constexpr size_t WS_KCP = WS_Z;
constexpr size_t WS_KCS = WS_Z + (size_t)8 * 64 * 256;
static_assert(WS_OC + (size_t)MT * 512 <= WS_R0END, "layer0 temporaries overflow region 0");

namespace pg8 {
#define PG8_LAS __attribute__((address_space(3)))
typedef unsigned short bf16_t;
typedef short bf16x8 __attribute__((ext_vector_type(8)));
typedef float f32x4 __attribute__((ext_vector_type(4)));
typedef unsigned u32x4 __attribute__((ext_vector_type(4)));
constexpr int BM = 256, BK = 64, HALF = 128, HTB = HALF * BK * 2  , STAGE_BYTES = 8 * HTB, NXCD = 8, WGM = 8;

__host__ __device__ __forceinline__ int lds_byte(int r, int c) { const int st = (r >> 4) * 2 + (c >> 5), rr = r & 15, cc = c & 31, ob = rr * 64 + cc * 2; return st * 1024 + (ob ^ (((ob >> 9) & 1) << 5)); }
__host__ __device__ __forceinline__ void stage_rc(int b, int& R, int& C) { const int st = b / 1024, sb = b % 1024, swz = sb ^ (((sb >> 9) & 1) << 5); R = (st >> 1) * 16 + swz / 64; C = (st & 1) * 32 + (swz % 64) / 2; }
__host__ __device__ __forceinline__ int perm32(int rho) { const int n = rho >> 4, i = rho & 15; return 8 * (i >> 2) + 4 * n + (i & 3); }

struct Unit { int pm, pn; };
struct Gemm { const bf16_t* A; const bf16_t* Bt; int M, N, K; };

struct StaticOrder {
    int nM, nN, nwg, G, c;
    __host__ __device__ void init(int M, int N, int G_, int c_) { nM = M / BM; nN = N / BM; nwg = nM * nN; G = G_; c = c_; }
    __host__ __device__ bool next(int i, Unit& u) const {
        const long L = (long)i * G + c; if (L >= nwg) return false;
        int wgid = (int)L; { const int q = nwg / NXCD, r = nwg % NXCD, xcd = wgid % NXCD, off = wgid / NXCD; wgid = (xcd < r ? xcd * (q + 1) : r * (q + 1) + (xcd - r) * q) + off; }
        const int nig = WGM * nN, gid = wgid / nig, fm = gid * WGM, gsz = (nM - fm) < WGM ? (nM - fm) : WGM;
        u.pm = fm + ((wgid % nig) % gsz); u.pn = (wgid % nig) / gsz; return true;
    }
    __device__ __forceinline__ void a_ready(const Unit&) const {}
    __device__ __forceinline__ void done(const Unit&) const {}
};
struct CountedOrder : StaticOrder {
    const unsigned* ready; unsigned need; unsigned* tmo;
    __device__ __forceinline__ void a_ready(const Unit& u) const {
        if (threadIdx.x < 64) {
            const unsigned long long t0 = __builtin_amdgcn_s_memrealtime(); unsigned polls = 0;
            while ((unsigned)__builtin_amdgcn_readfirstlane(__hip_atomic_load(ready + 64 * u.pm, __ATOMIC_RELAXED, __HIP_MEMORY_SCOPE_AGENT)) < need) {
                if ((++polls & 255u) == 0u && __builtin_amdgcn_readfirstlane(__hip_atomic_load(tmo, __ATOMIC_RELAXED, __HIP_MEMORY_SCOPE_AGENT)) != 0u) break;
                if (__builtin_amdgcn_s_memrealtime() - t0 > 2000000ull) {
                    if (threadIdx.x == 0) { unsigned expect = 0u; __hip_atomic_compare_exchange_strong(tmo + 1, &expect, 0x600u | (unsigned)(u.pm & 0xff), __ATOMIC_RELAXED, __ATOMIC_RELAXED, __HIP_MEMORY_SCOPE_AGENT); __hip_atomic_store(tmo, 1u, __ATOMIC_RELAXED, __HIP_MEMORY_SCOPE_AGENT); }
                    break; }
                __builtin_amdgcn_s_sleep(2); }
            __builtin_amdgcn_fence(__ATOMIC_ACQUIRE, "agent");
            asm volatile("s_waitcnt vmcnt(0)" ::: "memory");
        }
#if !defined(BROKEN_HOOK_NO_BARRIER)
        asm volatile("" ::: "memory"); __builtin_amdgcn_s_barrier(); asm volatile("" ::: "memory");
#endif
    }
};


template <class Epi, class Sched, bool STAMP = false>
__device__ __forceinline__ void gemm_phase(PG8_LAS unsigned char* lds, const Gemm g, const Sched& S, const Epi& E, unsigned long long* stamps) {
    int tid_ = threadIdx.x; asm volatile("" : "+v"(tid_));
    const int tid = tid_, wid = __builtin_amdgcn_readfirstlane(tid >> 6), lane = tid & 63, wr = wid >> 2, wc = wid & 3, fr = lane & 15, fq = lane >> 4;
    const int K = g.K, nt = K / BK;
    int ts_lo = 0, ts_hi = 0, nts = 0; const unsigned long long rt_entry = STAMP ? (unsigned long long)wall_clock64() : 0ull;
#define PG8_STAMP() do { if (STAMP && wid == 0 && nts < 64) { const unsigned long long _c = (unsigned long long)clock64(); \
        ts_lo = (lane == nts) ? (int)(unsigned)_c : ts_lo; ts_hi = (lane == nts) ? (int)(unsigned)(_c >> 32) : ts_hi; ++nts; } } while (0)
    PG8_STAMP();
    unsigned voffA[2], voffB[2];
#pragma unroll
    for (int i = 0; i < 2; ++i) { int R, C; stage_rc(tid * 16 + i * 8192, R, C); const int Rb = Epi::PERM ? ((R & ~31) + perm32(R & 31)) : R;
        voffA[i] = (unsigned)(R * K + C) * 2u; voffB[i] = (unsigned)(Rb * K + C) * 2u; }
    const size_t kstep = (size_t)(BK * 2);
    const size_t hstep = (size_t)HALF * K * 2;
    const size_t tstep = 2 * hstep;
    const unsigned ldsw = (unsigned)wid * 1024u;
    const int aoff = lds_byte(wr * 64 + fr, fq * 8), boff = lds_byte(wc * 32 + fr, fq * 8);
#define PG8_SA(b, h) (((b) * 2 + (h)) * HTB)
#define PG8_SB(b, h) ((4 + (b) * 2 + (h)) * HTB)
#define PG8_STAGE(bufoff, gbase, voff) do { _Pragma("unroll") for (int _i = 0; _i < 2; ++_i) \
        __builtin_amdgcn_global_load_lds((const unsigned*)((const char*)(gbase) + (voff)[_i]), (PG8_LAS unsigned*)(lds + (bufoff) + ldsw + _i * 8192), 16, 0, 0); } while (0)
#define PG8_LDA(dst, b, h) do { _Pragma("unroll") for (int m = 0; m < 4; ++m) _Pragma("unroll") for (int k = 0; k < 2; ++k) dst[m][k] = *(const PG8_LAS bf16x8*)(lds + PG8_SA(b, h) + aoff + m * 2048 + k * 1024); } while (0)
#define PG8_LDB(dst, b, h) do { _Pragma("unroll") for (int n = 0; n < 2; ++n) _Pragma("unroll") for (int k = 0; k < 2; ++k) dst[n][k] = *(const PG8_LAS bf16x8*)(lds + PG8_SB(b, h) + boff + n * 2048 + k * 1024); } while (0)
#define PG8_MMA(ai, bj, At, Bt) do { __builtin_amdgcn_s_setprio(1); _Pragma("unroll") for (int m = 0; m < 4; ++m) _Pragma("unroll") for (int n = 0; n < 2; ++n) _Pragma("unroll") for (int k = 0; k < 2; ++k) \
        acc[ai][bj][m][n] = __builtin_amdgcn_mfma_f32_16x16x32_bf16(Bt[n][k], At[m][k], acc[ai][bj][m][n], 0, 0, 0); __builtin_amdgcn_s_setprio(0); } while (0)
#define PG8_WAIT_V(n) asm volatile("s_waitcnt vmcnt(" #n ")" ::: "memory")
#define PG8_WAIT_L(n) asm volatile("s_waitcnt lgkmcnt(" #n ")" ::: "memory")
#define PG8_BAR __builtin_amdgcn_s_barrier()
#define PG8_SCHED __builtin_amdgcn_sched_barrier(0)
    Unit cur, nxt; int ui = 0;
    if (!S.next(0, cur)) return;
    f32x4 acc[2][2][4][2];
#pragma unroll
    for (int a = 0; a < 2; ++a)
#pragma unroll
        for (int b = 0; b < 2; ++b)
#pragma unroll
            for (int m = 0; m < 4; ++m)
#pragma unroll
                for (int n = 0; n < 2; ++n) acc[a][b][m][n] = (f32x4){0.f, 0.f, 0.f, 0.f};
    bf16x8 At[4][2], B0[2][2], B1[2][2];
    const char* cA = (const char*)g.A + (size_t)cur.pm * tstep; const char* cB = (const char*)g.Bt + (size_t)cur.pn * tstep;
    S.a_ready(cur);
    PG8_STAGE(PG8_SB(0, 0), cB, voffB); PG8_STAGE(PG8_SA(0, 0), cA, voffA); PG8_STAGE(PG8_SB(0, 1), cB + hstep, voffB); PG8_STAGE(PG8_SA(0, 1), cA + hstep, voffA);
    if (wr == 1) PG8_BAR;
    PG8_WAIT_V(4); PG8_BAR;
    PG8_STAGE(PG8_SB(1, 0), cB + kstep, voffB); PG8_STAGE(PG8_SA(1, 0), cA + kstep, voffA); PG8_STAGE(PG8_SB(1, 1), cB + hstep + kstep, voffB);
    PG8_WAIT_V(6); PG8_BAR;
    PG8_STAMP();
    for (;;) {
        const bool has_next = S.next(ui + 1, nxt);
        const char* nA = has_next ? (const char*)g.A + (size_t)nxt.pm * tstep : cA; const char* nB = has_next ? (const char*)g.Bt + (size_t)nxt.pn * tstep : cB;
        for (int t = 0; t < nt; t += 2) {
            const bool last = (t == nt - 2);
            const char* a1 = cA + (size_t)(t + 1) * kstep;
            const char* a2 = last ? nA : cA + (size_t)(t + 2) * kstep; const char* b2 = last ? nB : cB + (size_t)(t + 2) * kstep;
            const char* a3 = a2 + kstep; const char* b3 = b2 + kstep;
            if (last && has_next) S.a_ready(nxt);
            PG8_LDB(B0, 0, 0); PG8_SCHED; PG8_LDA(At, 0, 0); PG8_STAGE(PG8_SA(1, 1), a1 + hstep, voffA);
            PG8_WAIT_L(8); PG8_BAR; PG8_WAIT_L(0); PG8_MMA(0, 0, At, B0); PG8_BAR; PG8_SCHED;
            PG8_LDB(B1, 0, 1); PG8_STAGE(PG8_SB(0, 0), b2, voffB);
            PG8_BAR; PG8_WAIT_L(0); PG8_MMA(0, 1, At, B1); PG8_BAR;
            PG8_LDA(At, 0, 1); PG8_STAGE(PG8_SA(0, 0), a2, voffA);
            PG8_BAR; PG8_WAIT_L(0); PG8_MMA(1, 0, At, B0); PG8_BAR; PG8_SCHED;
            PG8_STAGE(PG8_SB(0, 1), b2 + hstep, voffB);
            PG8_WAIT_V(6); PG8_BAR; PG8_MMA(1, 1, At, B1); PG8_BAR;
            PG8_LDB(B0, 1, 0); PG8_SCHED; PG8_LDA(At, 1, 0); PG8_STAGE(PG8_SA(0, 1), a2 + hstep, voffA);
            PG8_WAIT_L(8); PG8_BAR; PG8_WAIT_L(0); PG8_MMA(0, 0, At, B0); PG8_BAR; PG8_SCHED;
            PG8_LDB(B1, 1, 1); PG8_STAGE(PG8_SB(1, 0), b3, voffB);
            PG8_BAR; PG8_WAIT_L(0); PG8_MMA(0, 1, At, B1); PG8_BAR;
            PG8_LDA(At, 1, 1); PG8_STAGE(PG8_SA(1, 0), a3, voffA);
            PG8_BAR; PG8_WAIT_L(0); PG8_MMA(1, 0, At, B0); PG8_BAR; PG8_SCHED;
            PG8_STAGE(PG8_SB(1, 1), b3 + hstep, voffB);
            PG8_WAIT_V(6); PG8_BAR; PG8_MMA(1, 1, At, B1); PG8_BAR;
        }
        PG8_STAMP();
        if constexpr (!Epi::AFTER_DRAIN) { E(acc, cur, wr, wc, fr, fq); S.done(cur); }
        PG8_STAMP();
        if (!has_next) break;
#pragma unroll
        for (int a = 0; a < 2; ++a)
#pragma unroll
            for (int b = 0; b < 2; ++b)
#pragma unroll
                for (int m = 0; m < 4; ++m)
#pragma unroll
                    for (int n = 0; n < 2; ++n) acc[a][b][m][n] = (f32x4){0.f, 0.f, 0.f, 0.f};
        cur = nxt; cA = nA; cB = nB; ++ui;
    }
    PG8_WAIT_V(0);
    if (wr == 0) PG8_BAR;
    PG8_BAR;
    if constexpr (Epi::AFTER_DRAIN) { E.fused(acc, cur, wr, wc, fr, fq, lds, wid, lane); S.done(cur); }
    PG8_STAMP();
    if (STAMP && wid == 0) { stamps[lane] = lane < nts ? (((unsigned long long)(unsigned)ts_hi << 32) | (unsigned)ts_lo) : 0ull;
        if (lane == 62) stamps[62] = rt_entry; if (lane == 63) stamps[63] = (unsigned long long)wall_clock64(); }
#undef PG8_STAMP
#undef PG8_SA
#undef PG8_SB
#undef PG8_STAGE
#undef PG8_LDA
#undef PG8_LDB
#undef PG8_MMA
#undef PG8_WAIT_V
#undef PG8_WAIT_L
#undef PG8_BAR
#undef PG8_SCHED
}
}

#define XB_TMO      128
#define XB_XCNT(j)  (256  + 64 * (j))
#define XB_XSUB(j)  (1280 + 64 * (j))
#define XB_XGEN(j)  (2304 + 64 * (j))
#define XB_TOP      3328
#define XB_TOPGEN   3392
#define XCD_BAR_WORDS 3456
#define XB_SPIN_CAP (1u << 18)
#define LAS __attribute__((address_space(3)))

__device__ __forceinline__ unsigned xb_ld(unsigned* p)              { return __hip_atomic_load(p, __ATOMIC_RELAXED, __HIP_MEMORY_SCOPE_AGENT); }
__device__ __forceinline__ unsigned xb_add(unsigned* p, unsigned v) { return __hip_atomic_fetch_add(p, v, __ATOMIC_RELAXED, __HIP_MEMORY_SCOPE_AGENT); }
__device__ __forceinline__ unsigned xb_xcc_id() { return (unsigned)__builtin_amdgcn_s_getreg((3 << 11) | 20) & 0xFu; }
#define XB_SPIN(cond, bar) do { unsigned _sp = 0; while (cond) { __builtin_amdgcn_s_sleep(1); \
    if ((++_sp & 255u) == 0u) { if (xb_ld(&(bar)[XB_TMO])) break; if (_sp > XB_SPIN_CAP) { atomicAdd(&(bar)[XB_TMO], 1u); break; } } } } while (0)

struct XcdBarrier {
    unsigned* bar; unsigned x;
    volatile LAS unsigned* st;
};

__device__ __forceinline__ XcdBarrier xcd_barrier_post(unsigned* bar, volatile LAS unsigned* st) {
    XcdBarrier b; b.bar = bar; b.x = xb_xcc_id(); b.st = st;
    if (threadIdx.x == 0) (void)xb_add(&bar[XB_XCNT(b.x)], 1u);
    return b;
}
__device__ __forceinline__ void xcd_barrier_complete(unsigned* bar, unsigned x, unsigned& nloc, unsigned& nx) {
    const unsigned G = gridDim.x * gridDim.y * gridDim.z;
    unsigned sum, cnt, mine, sp = 0u;
    for (;;) {
        sum = 0u; cnt = 0u; mine = 0u;
#pragma unroll
        for (unsigned j = 0; j < 16; ++j) { const unsigned c = xb_ld(&bar[XB_XCNT(j)]); sum += c; cnt += (c > 0u) ? 1u : 0u; mine = (j == x) ? c : mine; }
        if (sum == G) break;
        __builtin_amdgcn_s_sleep(1);
        if ((++sp & 255u) == 0u) { if (xb_ld(&bar[XB_TMO])) break; if (sp > XB_SPIN_CAP) { atomicAdd(&bar[XB_TMO], 1u); break; } }
    }
    nloc = mine > 0u ? mine : 1u; nx = cnt > 0u ? cnt : 1u;
}

__device__ __forceinline__ void xcd_barrier(const XcdBarrier& b) {
    asm volatile("s_waitcnt vmcnt(0)" ::: "memory");
    __syncthreads();
    if (threadIdx.x == 0) {
        unsigned* bar = b.bar;
        __builtin_amdgcn_s_waitcnt(0);
        unsigned nloc = b.st[0], nx = b.st[1];
        if (nloc == 0u) { xcd_barrier_complete(bar, b.x, nloc, nx); b.st[0] = nloc; b.st[1] = nx; }
        const unsigned old = xb_add(&bar[XB_XSUB(b.x)], 1u);
        const unsigned gen = old / nloc;
        if (old + 1u == (gen + 1u) * nloc) {
            __builtin_amdgcn_fence(__ATOMIC_RELEASE, "agent");
            asm volatile("s_waitcnt vmcnt(0)" ::: "memory");
            const unsigned og = xb_add(&bar[XB_TOP], 1u);
            const unsigned tg = og / nx;
            if (og + 1u == (tg + 1u) * nx) xb_add(&bar[XB_TOPGEN], 1u);
            else XB_SPIN(xb_ld(&bar[XB_TOPGEN]) == tg, bar);
            __builtin_amdgcn_fence(__ATOMIC_ACQUIRE, "agent");
            xb_add(&bar[XB_XGEN(b.x)], 1u);
            asm volatile("s_waitcnt vmcnt(0)" ::: "memory");
        } else {
            XB_SPIN(xb_ld(&bar[XB_XGEN(b.x)]) == gen, bar);
            __builtin_amdgcn_fence(__ATOMIC_ACQUIRE, "agent");
            asm volatile("s_waitcnt vmcnt(0)" ::: "memory");
        }
    }
    __syncthreads();
}

namespace nk {
using pg8::bf16_t; using pg8::bf16x8; using pg8::f32x4; using pg8::u32x4; using pg8::Unit;
constexpr int NTH = 512;
constexpr int LDS_STAGE = pg8::STAGE_BYTES;
constexpr int LDS_MISC = LDS_STAGE;
constexpr int LDS_BYTES = LDS_STAGE + 1024;

constexpr size_t NB0 = WS_END * 4;
constexpr size_t NB_BAR = NB0;
constexpr size_t NB_WT1 = NB_BAR + 32768;
constexpr size_t NB_WT2 = NB_WT1 + (size_t)3584 * 1024 * 2;
constexpr size_t NB_XB = NB_WT2 + (size_t)1024 * 1024 * 2;
constexpr size_t NB_XSB = NB_XB + (size_t)MP * 1024 * 2;
constexpr size_t NB_HB = NB_XSB + (size_t)BS * 1024 * 2;
constexpr size_t NB_KVB = NB_HB + (size_t)MT * 2560 * 2;
constexpr size_t NB_G3 = NB_KVB + (size_t)MT * 768 * 2;
constexpr size_t NB_CATB = NB_G3 + (size_t)MT * 32 * 4;
constexpr size_t NB_CBUF = NB_CATB + (size_t)MT * 1024 * 2;
constexpr size_t NB_KCB = NB_CBUF + (size_t)MP * 512 * 4;
constexpr size_t NB_WT3 = NB_KCB + (size_t)BP * 64 * 256 * 2;
constexpr size_t NB_WT4 = NB_WT3 + (size_t)4 * 1024 * 1024 * 2;
constexpr size_t NB_W1T = NB_WT4 + (size_t)1024 * 1024 * 2;
constexpr size_t NB_A1T = NB_W1T + (size_t)64 * 1024 * 2;
constexpr size_t NB_W2T = NB_A1T + (size_t)64 * 1024 * 2;
constexpr size_t NB_A2T = NB_W2T + (size_t)64 * 1024 * 2;
constexpr size_t NB_KCS = NB_A2T + (size_t)64 * 1024 * 2;
constexpr size_t NB_END = NB_KCS + (size_t)BS * 256 * 256 * 4;
constexpr size_t NB_XSH = 0;
constexpr size_t NB_RKVZ = NB_XSH + (size_t)6 * 16640 * 1024 * 2;
constexpr size_t NB_TWB = NB_RKVZ + (size_t)4 * 16640 * 1024 * 2;
constexpr size_t NB_AWB = NB_TWB + (size_t)MT * 64 * 2;
constexpr size_t NB_RKS = NB_AWB + (size_t)MT * 64 * 2;
static_assert(NB_RKS + (size_t)MT * 16 * 4 <= WS_PRE * 4, "layer-1 region A overflows into PRE");
constexpr size_t NB_DEC = (WS_X1 + SZ_ROWD) * 4;
constexpr size_t NB_KKN = NB_DEC + (size_t)MT * 1024 * 4;
constexpr size_t NB_KKA = NB_KKN + (size_t)MT * 1024 * 2;
constexpr size_t NB_KP = NB_KKA + (size_t)MT * 1024 * 2;
constexpr size_t NB_Y = NB_KP + (size_t)MT * 1024 * 2;
constexpr size_t NB_G4B = NB_Y + (size_t)MT * 1024 * 4;
static_assert(NB_G4B + (size_t)MT * 1024 * 2 <= NB0, "layer-1 region B overflows");
constexpr int N1PAD = 3584;
__host__ __device__ __forceinline__ int win_src_col(int n) { return n < 2048 ? n : (n < 2560 ? C_ZB + (n - 2048) : (n < 3328 ? C_KV + (n - 2560) : (n < 3352 ? C_G3 + (n - 3328) : -1))); }

__device__ __forceinline__ int opaque(int x) { asm volatile("" : "+s"(x)); return x; }
__device__ __forceinline__ int opaque_v(int x) { asm volatile("" : "+v"(x)); return x; }
struct Args { const float* in[N_IN]; float* out; unsigned char* ws; int ph_lo, ph_hi; };

__device__ __forceinline__ unsigned pk_bf16(float lo, float hi) { unsigned r; asm volatile("v_cvt_pk_bf16_f32 %0, %1, %2" : "=v"(r) : "v"(lo), "v"(hi)); return r; }

template <class MAP>
__device__ __forceinline__ void convert_wt(const float* __restrict__ W, int K, int ldw, bf16_t* __restrict__ Wt, int Npad, MAP map, int bid, int nb) {
    const int kg = K / 8;
    const size_t total = (size_t)Npad * kg;
    for (size_t i = (size_t)bid * NTH + threadIdx.x; i < total; i += (size_t)nb * NTH) {
        const int n = (int)(i % Npad), k0 = (int)(i / Npad) * 8;
        const int sc = map(n);
        u32x4 w = {0u, 0u, 0u, 0u};
        if (sc >= 0) {
            float v[8];
#pragma unroll
            for (int j = 0; j < 8; ++j) v[j] = W[(size_t)(k0 + j) * ldw + sc];
            w.x = pk_bf16(v[0], v[1]); w.y = pk_bf16(v[2], v[3]); w.z = pk_bf16(v[4], v[5]); w.w = pk_bf16(v[6], v[7]);
        }
        *(u32x4*)(Wt + (size_t)n * K + k0) = w;
    }
}
struct MapId { __device__ __forceinline__ int operator()(int n) const { return n; } };
struct MapWin { __device__ __forceinline__ int operator()(int n) const { return win_src_col(n); } };
__device__ __forceinline__ void convert_rows(const float* __restrict__ src, size_t n8, bf16_t* __restrict__ dst, int bid, int nb) {
    for (size_t i = (size_t)bid * NTH + threadIdx.x; i < n8; i += (size_t)nb * NTH) {
        const float4 a = *(const float4*)(src + i * 8), b = *(const float4*)(src + i * 8 + 4);
        u32x4 w; w.x = pk_bf16(a.x, a.y); w.y = pk_bf16(a.z, a.w); w.z = pk_bf16(b.x, b.y); w.w = pk_bf16(b.z, b.w);
        *(u32x4*)(dst + i * 8) = w;
    }
}

struct EpiPre {
    static constexpr bool PERM = false, AFTER_DRAIN = false;
    float* C; int ldc;
    __device__ __forceinline__ void operator()(const f32x4 (&acc)[2][2][4][2], const Unit& u, int wr, int wc, int fr, int fq) const {
        const int row0 = u.pm * 256 + wr * 64 + fr, col0 = u.pn * 256 + wc * 32 + 4 * fq;
#pragma unroll
        for (int ai = 0; ai < 2; ++ai)
#pragma unroll
            for (int m = 0; m < 4; ++m) { float* rowp = C + (size_t)(row0 + ai * 128 + m * 16) * ldc + col0;
#pragma unroll
                for (int bj = 0; bj < 2; ++bj)
#pragma unroll
                    for (int n = 0; n < 2; ++n) *(f32x4*)(rowp + bj * 128 + n * 16) = acc[ai][bj][m][n]; }
    }
};


struct Route1 {
    bf16_t* HB; bf16_t* KVB; float* G3; float* out;
    __device__ __forceinline__ void put8(int row, int n0, const f32x4& v0, const f32x4& v1) const {
        if (n0 < 2560) {
            const float sc = (n0 >= 1536 && n0 < 2048) ? 0.125f : 1.0f;
            u32x4 w; w.x = pk_bf16(v0[0] * sc, v0[1] * sc); w.y = pk_bf16(v0[2] * sc, v0[3] * sc); w.z = pk_bf16(v1[0] * sc, v1[1] * sc); w.w = pk_bf16(v1[2] * sc, v1[3] * sc);
            *(u32x4*)(HB + (size_t)row * 2560 + n0) = w;
        } else if (n0 < 3328) {
            const int c = n0 - 2560, i3 = c >> 8, cc = c & 255;
            u32x4 w; w.x = pk_bf16(v0[0], v0[1]); w.y = pk_bf16(v0[2], v0[3]); w.z = pk_bf16(v1[0], v1[1]); w.w = pk_bf16(v1[2], v1[3]);
            *(u32x4*)(KVB + (size_t)row * 768 + c) = w;
            float* dst = nullptr;
            if (row < MP) {
                if (i3 == 0) dst = out + O_CMPP + (size_t)row * 256 + cc;
                else if (i3 == 1) dst = out + O_SELP + (size_t)row * 256 + cc;
                else { const int b = row >> 11, t = row & 2047; if (t >= TP - 512) dst = out + O_WINP + (size_t)(b * 512 + t - (TP - 512)) * 256 + cc; }
            } else {
                const int sidx = row - MP;
                if (i3 == 0) dst = out + O_CMPS + (size_t)sidx * 256 + cc;
                else if (i3 == 1) dst = out + O_SELS + (size_t)sidx * 256 + cc;
                else dst = out + O_WINS + (size_t)(sidx * 512 + 511) * 256 + cc;
            }
            if (dst) { *(f32x4*)dst = v0; *(f32x4*)(dst + 4) = v1; }
        } else if (n0 < 3352) {
            float* dst = G3 + (size_t)row * 32 + (n0 - 3328);
            *(f32x4*)dst = v0; *(f32x4*)(dst + 4) = v1;
        }
    }
};
struct Epi1 {
    static constexpr bool PERM = true, AFTER_DRAIN = false;
    Route1 R;
    __device__ __forceinline__ void operator()(const f32x4 (&acc)[2][2][4][2], const Unit& u, int wr, int wc, int fr, int fq) const {
        const int row0 = u.pm * 256 + wr * 64 + fr, col0 = u.pn * 256 + wc * 32 + 8 * fq;
#pragma unroll
        for (int ai = 0; ai < 2; ++ai)
#pragma unroll
            for (int m = 0; m < 4; ++m)
#pragma unroll
                for (int bj = 0; bj < 2; ++bj) R.put8(row0 + ai * 128 + m * 16, col0 + bj * 128, acc[ai][bj][m][0], acc[ai][bj][m][1]);
    }
};

typedef float f32x16 __attribute__((ext_vector_type(16)));
template <class EMIT>
__device__ __forceinline__ void sample_gemm32(const bf16_t* __restrict__ A, const bf16_t* __restrict__ Bt, int K, int n0, int lane, EMIT emit) {
    const bf16_t* ap = A + (size_t)(lane & 31) * K + 8 * (lane >> 5);
    const bf16_t* bp = Bt + (size_t)(n0 + (lane & 31)) * K + 8 * (lane >> 5);
    f32x16 acc;
#pragma unroll
    for (int i = 0; i < 16; ++i) acc[i] = 0.f;
#pragma unroll 8
    for (int k = 0; k < K; k += 16) {
        const bf16x8 av = *(const bf16x8*)(ap + k), bv = *(const bf16x8*)(bp + k);
        acc = __builtin_amdgcn_mfma_f32_32x32x16_bf16(av, bv, acc, 0, 0, 0);
    }
#pragma unroll
    for (int r = 0; r < 16; ++r) emit((r & 3) + 8 * (r >> 2) + 4 * (lane >> 5), n0 + (lane & 31), acc[r]);
}

typedef float f32x16 __attribute__((ext_vector_type(16)));
__device__ __forceinline__ float bf2f(bf16_t v) { return __uint_as_float((unsigned)v << 16); }
__device__ __forceinline__ float sigm_f(float x) { return 1.f / (1.f + __expf(-x)); }
__device__ __forceinline__ float silu_f(float x) { return x / (1.f + __expf(-x)); }

__device__ __forceinline__ void conv_item(const Args& a, unsigned char* ws, PG8_LAS unsigned char* lds, int item) {
    const int tid = opaque_v(threadIdx.x);
    const int b = item >> 5, t0 = (item & 31) * 64;
    const bf16_t* HB = (const bf16_t*)(ws + NB_HB);
    float* CB = (float*)(ws + NB_CBUF);
    PG8_LAS float* U = (PG8_LAS float*)lds;
    const int chl = tid & 255, tp = tid >> 8;
    for (int half = 0; half < 2; ++half) {
        const int chb = half * 256;
        for (int idx = tid; idx < 94 * 256; idx += NTH) {
            const int r = idx >> 8, c = idx & 255, t = t0 - 30 + r;
            float u = 0.f;
            if (t >= 0) { const bf16_t* h = HB + (size_t)(b * TP + t) * 2560 + chb + c; u = bf2f(h[0]) * sigm_f(bf2f(h[512])); }
            U[idx] = u;
            if (t >= TP - 30) a.out[O_CONVP + (size_t)(b * 30 + t - (TP - 30)) * 512 + chb + c] = u;
        }
        __syncthreads();
        {
            const int ch = chb + chl;
            float w[31];
#pragma unroll
            for (int j = 0; j < 31; ++j) w[j] = a.in[I_CONVW][j * 512 + ch];
            const float bias = a.in[I_CONVB][ch];
#pragma unroll 4
            for (int k = 0; k < 32; ++k) {
                const int tt = tp * 32 + k;
                float acc = bias;
#pragma unroll
                for (int j = 0; j < 31; ++j) acc = fmaf(w[j], U[(tt + j) * 256 + chl], acc);
                CB[(size_t)(b * TP + t0 + tt) * 512 + ch] = acc;
            }
        }
        __syncthreads();
    }
    {
        const int lane = tid & 63, wv = tid >> 6;
        const float4 g0 = *(const float4*)(a.in[I_CLNG] + lane * 8), g1 = *(const float4*)(a.in[I_CLNG] + lane * 8 + 4);
        const float4 b0 = *(const float4*)(a.in[I_CLNB] + lane * 8), b1 = *(const float4*)(a.in[I_CLNB] + lane * 8 + 4);
        const float gg[8] = {g0.x, g0.y, g0.z, g0.w, g1.x, g1.y, g1.z, g1.w}, bb[8] = {b0.x, b0.y, b0.z, b0.w, b1.x, b1.y, b1.z, b1.w};
        for (int k = 0; k < 8; ++k) {
            const size_t row = (size_t)(b * TP + t0 + wv * 8 + k);
            const float4 c0 = *(const float4*)(CB + row * 512 + lane * 8), c1 = *(const float4*)(CB + row * 512 + lane * 8 + 4);
            float c[8] = {c0.x, c0.y, c0.z, c0.w, c1.x, c1.y, c1.z, c1.w};
            float sm = 0.f;
#pragma unroll
            for (int i = 0; i < 8; ++i) sm += c[i];
#pragma unroll
            for (int o = 32; o > 0; o >>= 1) sm += __shfl_xor(sm, o);
            const float mean = sm * (1.f / 512.f);
            float sq = 0.f;
#pragma unroll
            for (int i = 0; i < 8; ++i) { c[i] -= mean; sq += c[i] * c[i]; }
#pragma unroll
            for (int o = 32; o > 0; o >>= 1) sq += __shfl_xor(sq, o);
            const float rs = rsqrtf(sq * (1.f / 512.f) + LN_EPS);
            const u32x4 zv = *(const u32x4*)(HB + row * 2560 + 1024 + lane * 8);
            float y[8];
#pragma unroll
            for (int i = 0; i < 8; ++i) {
                const float z = __uint_as_float((i & 1) ? (zv[i >> 1] & 0xffff0000u) : (zv[i >> 1] << 16));
                y[i] = silu_f(c[i] * rs * gg[i] + bb[i]) * silu_f(z);
            }
            u32x4 o; o.x = pk_bf16(y[0], y[1]); o.y = pk_bf16(y[2], y[3]); o.z = pk_bf16(y[4], y[5]); o.w = pk_bf16(y[6], y[7]);
            *(u32x4*)((bf16_t*)(ws + NB_CATB) + row * 1024 + lane * 8) = o;
        }
    }
    __syncthreads();
}

__device__ __forceinline__ void pool_prompt(const Args& a, unsigned char* ws, int bid, int nb) {
    bf16_t* KCB = (bf16_t*)(ws + NB_KCB);
    for (int i = bid * NTH + threadIdx.x; i < BP * 64 * 256; i += nb * NTH) {
        const int c = i & 255, n = (i >> 8) & 63, b = i >> 14;
        const int kv = c >> 7, g = (c >> 6) & 1;
        const float* w = kv ? a.in[I_WVC] : a.in[I_WKC];
        const float* src = a.out + O_CMPP + (size_t)(b * TP + n * 32) * 256 + c;
        float acc = 0.f;
#pragma unroll 8
        for (int l = 0; l < 32; ++l) acc = fmaf(src[(size_t)l * 256], w[l * 2 + g], acc);
        KCB[i] = (bf16_t)(pk_bf16(acc, 0.f) & 0xffffu);
    }
}

constexpr int A_KT = 0;
constexpr int A_VT = 18432;
constexpr int A_IMPH = 35840;
constexpr int A_IMPS = 68608;
constexpr int A_MASK = 76800;
constexpr float LOG2E = 1.4426950408889634f;

struct KvSrc { const bf16_t* k; const bf16_t* v; int rstride; };

__device__ __forceinline__ void kv_issue(const KvSrc& s, int tid, u32x4& kr, u32x4& vr) {
    const int key = tid >> 3, c8 = tid & 7;
    kr = *(const u32x4*)(s.k + (size_t)key * s.rstride + c8 * 8);
    vr = *(const u32x4*)(s.v + (size_t)key * s.rstride + c8 * 8);
}
__device__ __forceinline__ void kv_write(PG8_LAS unsigned char* lds, int buf, int tid, const u32x4& kr, const u32x4& vr) {
    const int key = tid >> 3, c8 = tid & 7;
    *(PG8_LAS u32x4*)(lds + A_KT + buf * 9216 + key * 144 + c8 * 16) = kr;
    PG8_LAS bf16_t* vt = (PG8_LAS bf16_t*)(lds + A_VT + buf * 8704);
#pragma unroll
    for (int i = 0; i < 4; ++i) { vt[(c8 * 8 + 2 * i) * 68 + key] = (bf16_t)(vr[i] & 0xffffu); vt[(c8 * 8 + 2 * i + 1) * 68 + key] = (bf16_t)(vr[i] >> 16); }
}

__device__ __forceinline__ void attn_block(const int MODE, PG8_LAS unsigned char* lds, int buf, const bf16x8 (&qf)[4], int lane, float kslope, float base, int kmax, int kmin,
                                           float& m, float& l, f32x16 (&o)[2], f32x16 (&x)[2]) {
    const int lr = lane & 31, h = lane >> 5;
    const PG8_LAS unsigned char* kt_p = lds + A_KT + buf * 9216 + lr * 144 + h * 16;
#pragma unroll
    for (int kt = 0; kt < 2; ++kt) {
#pragma unroll
        for (int i = 0; i < 16; ++i) x[kt][i] = 0.f;
#pragma unroll
        for (int s = 0; s < 4; ++s) {
            const bf16x8 kf = *(const PG8_LAS bf16x8*)(kt_p + kt * 32 * 144 + s * 32);
            x[kt] = __builtin_amdgcn_mfma_f32_32x32x16_bf16(kf, qf[s], x[kt], 0, 0, 0);
        }
    }
    const float bh = base + kslope * (float)(4 * h);
    float mx = -INFINITY;
#pragma unroll
    for (int kt = 0; kt < 2; ++kt)
#pragma unroll
        for (int i = 0; i < 16; ++i) {
            const int kc = kt * 32 + (i & 3) + 8 * (i >> 2);
            x[kt][i] = fmaf(x[kt][i], LOG2E, fmaf(kslope, (float)kc, bh));
        }
    if (MODE) {
        const int hi = kmax - 4 * h, lo = kmin - 4 * h;
#pragma unroll
        for (int kt = 0; kt < 2; ++kt)
#pragma unroll
            for (int i = 0; i < 16; ++i) {
                const int kc = kt * 32 + (i & 3) + 8 * (i >> 2);
                x[kt][i] = (kc > hi || kc < lo) ? -INFINITY : x[kt][i];
            }
    }
#pragma unroll
    for (int kt = 0; kt < 2; ++kt)
#pragma unroll
        for (int i = 0; i < 16; ++i) mx = fmaxf(mx, x[kt][i]);
    mx = fmaxf(mx, __shfl_xor(mx, 32));
    const float mn = fmaxf(m, mx);
    const float corr = __builtin_amdgcn_exp2f(m - mn);
    m = mn;
    float ls = 0.f;
#pragma unroll
    for (int kt = 0; kt < 2; ++kt)
#pragma unroll
        for (int i = 0; i < 16; ++i) { const float pv = __builtin_amdgcn_exp2f(x[kt][i] - mn); x[kt][i] = pv; ls += pv; }
    l = fmaf(l, corr, ls);
#pragma unroll
    for (int dt = 0; dt < 2; ++dt)
#pragma unroll
        for (int i = 0; i < 16; ++i) o[dt][i] *= corr;
    const PG8_LAS unsigned char* vt_p = lds + A_VT + buf * 8704 + lr * 136 + h * 8;
#pragma unroll
    for (int kt = 0; kt < 2; ++kt)
#pragma unroll
        for (int s = 0; s < 2; ++s) {
            u32x4 pw; pw.x = pk_bf16(x[kt][8 * s + 0], x[kt][8 * s + 1]); pw.y = pk_bf16(x[kt][8 * s + 2], x[kt][8 * s + 3]);
            pw.z = pk_bf16(x[kt][8 * s + 4], x[kt][8 * s + 5]); pw.w = pk_bf16(x[kt][8 * s + 6], x[kt][8 * s + 7]);
            const bf16x8 pf = __builtin_bit_cast(bf16x8, pw);
#pragma unroll
            for (int dt = 0; dt < 2; ++dt) {
                const PG8_LAS unsigned char* vp = vt_p + dt * 32 * 136 + (kt * 32 + s * 16) * 2;
                typedef unsigned u32x2 __attribute__((ext_vector_type(2)));
                const u32x2 v0 = *(const PG8_LAS u32x2*)vp, v1 = *(const PG8_LAS u32x2*)(vp + 16);
                u32x4 vw; vw.x = v0.x; vw.y = v0.y; vw.z = v1.x; vw.w = v1.y;
                o[dt] = __builtin_amdgcn_mfma_f32_32x32x16_bf16(__builtin_bit_cast(bf16x8, vw), pf, o[dt], 0, 0, 0);
            }
        }
}

__device__ __forceinline__ void attn_item(const Args& a, unsigned char* ws, PG8_LAS unsigned char* lds, int b, int g, int qb) {
    const int tid = opaque_v(threadIdx.x), lane = tid & 63, wv = __builtin_amdgcn_readfirstlane(tid >> 6);
    const int lr = lane & 31, h = lane >> 5;
    const int r = wv >> 1, th = wv & 1, hh = g * 4 + r;
    const int t0 = qb * 64, tb = qb;
    const int qloc = th * 32 + lr;
    const int qpos = t0 + qloc;
    const size_t qrow = (size_t)b * TP + qpos;
    const bf16_t* HB = (const bf16_t*)(ws + NB_HB);
    const bf16_t* KVB = (const bf16_t*)(ws + NB_KVB);
    const float slope2 = __builtin_amdgcn_exp2f(-(float)(hh + 1)) * LOG2E;
    bf16x8 qf[4];
#pragma unroll
    for (int s = 0; s < 4; ++s) qf[s] = *(const bf16x8*)(HB + qrow * 2560 + 1536 + hh * 64 + s * 16 + h * 8);
    const float* g3p = (const float*)(ws + NB_G3) + qrow * 32 + hh * 3;
    const float gc = sigm_f(g3p[0]), gs = sigm_f(g3p[1]), gw = sigm_f(g3p[2]);
    f32x16 res[2], o[2], x[2];
#pragma unroll
    for (int dt = 0; dt < 2; ++dt)
#pragma unroll
        for (int i = 0; i < 16; ++i) { res[dt][i] = 0.f; o[dt][i] = 0.f; }
    float m = -1e30f, l = 0.f;
    u32x4 kr, vr;
    PG8_LAS float* IMPH = (PG8_LAS float*)(lds + A_IMPH);
    PG8_LAS float* IMPS = (PG8_LAS float*)(lds + A_IMPS);
    PG8_LAS unsigned* MASK = (PG8_LAS unsigned*)(lds + A_MASK);

    {
        const bf16_t* kc = (const bf16_t*)(ws + NB_KCB) + (size_t)b * 64 * 256 + g * 64;
        KvSrc s{kc, kc + 128, 256};
        kv_issue(s, tid, kr, vr); kv_write(lds, 0, tid, kr, vr);
        if (tid < 64) MASK[tid] = 0u;
        __syncthreads();
        const int nmax = (qpos >= 31) ? ((qpos - 31) >> 5) : -1;
        attn_block(1, lds, 0, qf, lane, slope2 * 32.f, slope2 * (float)(31 - qpos), nmax, 0, m, l, o, x);
        const float lt = l + __shfl_xor(l, 32);
        const float inv = (nmax >= 0) ? 1.f / lt : 0.f;
        const float sc = gc * inv;
#pragma unroll
        for (int dt = 0; dt < 2; ++dt)
#pragma unroll
            for (int i = 0; i < 16; ++i) { res[dt][i] = o[dt][i] * sc; o[dt][i] = 0.f; }
        if (tb >= 16) {
#pragma unroll
            for (int kt = 0; kt < 2; ++kt)
#pragma unroll
                for (int c = 0; c < 4; ++c)
#pragma unroll
                    for (int e = 0; e < 2; ++e)
                        IMPH[(r * 64 + qloc) * 32 + kt * 16 + 4 * c + 2 * h + e] = (nmax >= 0) ? (x[kt][4 * c + 2 * e] + x[kt][4 * c + 2 * e + 1]) * inv : 0.f;
        }
        m = -1e30f; l = 0.f;
        __syncthreads();
    }
    if (tb >= 16) {
        const int tq = opaque_v(tid);
        const int q = tq >> 3, jq = tq & 7;
        float v4[4];
#pragma unroll
        for (int e = 0; e < 4; ++e) {
            const int j = jq * 4 + e;
            float v = IMPH[(0 * 64 + q) * 32 + j] + IMPH[(1 * 64 + q) * 32 + j] + IMPH[(2 * 64 + q) * 32 + j] + IMPH[(3 * 64 + q) * 32 + j];
            if (j == 0 || j == tb || j == tb - 1) v = 1e4f;
            IMPS[q * 32 + j] = v; v4[e] = v;
        }
        __syncthreads();
        unsigned bits = 0u;
#pragma unroll
        for (int e = 0; e < 4; ++e) {
            const int j = jq * 4 + e;
            int rank = 0;
            for (int i = 0; i <= tb; ++i) { const float vi = IMPS[q * 32 + i]; rank += (vi > v4[e] || (vi == v4[e] && i < j)) ? 1 : 0; }
            if (j <= tb && rank < 16) bits |= 1u << j;
        }
        if (bits) atomicOr((unsigned*)&MASK[q], bits);
    } else {
        if (tid < 64) MASK[tid] = (2u << tb) - 1u;
    }
    __syncthreads();
    const unsigned selmask = MASK[qloc];

    {
        const bf16_t* kb = KVB + (size_t)b * TP * 768 + 256 + g * 64;
        { KvSrc s{kb, kb + 128, 768}; kv_issue(s, tid, kr, vr); kv_write(lds, 0, tid, kr, vr); }
        __syncthreads();
        for (int j = 0; j <= tb; ++j) {
            if (j < tb) { KvSrc s{kb + (size_t)(j + 1) * 64 * 768, kb + (size_t)(j + 1) * 64 * 768 + 128, 768}; kv_issue(s, tid, kr, vr); }
            const float base = ((selmask >> j) & 1u) ? slope2 * (float)(j * 64 - qpos) : -INFINITY;
            attn_block(j == tb, lds, j & 1, qf, lane, slope2, base, qloc, 0, m, l, o, x);
            if (j < tb) kv_write(lds, (j + 1) & 1, tid, kr, vr);
            __syncthreads();
        }
        const float lt = l + __shfl_xor(l, 32);
        const float sc = gs / lt;
#pragma unroll
        for (int dt = 0; dt < 2; ++dt)
#pragma unroll
            for (int i = 0; i < 16; ++i) { res[dt][i] = fmaf(o[dt][i], sc, res[dt][i]); o[dt][i] = 0.f; }
        m = -1e30f; l = 0.f;
    }
    {
        const int jlo = (tb >= 8) ? tb - 8 : 0;
        const bf16_t* kb = KVB + (size_t)b * TP * 768 + 512 + g * 64;
        { KvSrc s{kb + (size_t)jlo * 64 * 768, kb + (size_t)jlo * 64 * 768 + 128, 768}; kv_issue(s, tid, kr, vr); kv_write(lds, 0, tid, kr, vr); }
        __syncthreads();
        for (int j = jlo; j <= tb; ++j) {
            const int bi = (j - jlo) & 1;
            if (j < tb) { KvSrc s{kb + (size_t)(j + 1) * 64 * 768, kb + (size_t)(j + 1) * 64 * 768 + 128, 768}; kv_issue(s, tid, kr, vr); }
            const float base = slope2 * (float)(j * 64 - qpos);
            attn_block((j == tb) || (j == tb - 8), lds, bi, qf, lane, slope2, base, (j == tb) ? qloc : 64, (j == tb - 8) ? qpos - 511 - j * 64 : 0, m, l, o, x);
            if (j < tb) kv_write(lds, bi ^ 1, tid, kr, vr);
            __syncthreads();
        }
        const float lt = l + __shfl_xor(l, 32);
        const float sc = gw / lt;
#pragma unroll
        for (int dt = 0; dt < 2; ++dt)
#pragma unroll
            for (int i = 0; i < 16; ++i) res[dt][i] = fmaf(o[dt][i], sc, res[dt][i]);
    }
    {
        const size_t qrow2 = (size_t)b * TP + t0 + th * 32 + (opaque_v(lane) & 31);
        const bf16_t* zb = HB + qrow2 * 2560 + 2048 + hh * 64;
        bf16_t* dst = (bf16_t*)(ws + NB_CATB) + qrow2 * 1024 + 512 + hh * 64;
        typedef unsigned u32x2 __attribute__((ext_vector_type(2)));
#pragma unroll
        for (int dt = 0; dt < 2; ++dt)
#pragma unroll
            for (int c = 0; c < 4; ++c) {
                const int d = dt * 32 + 8 * c + 4 * h;
                const u32x2 zv = *(const u32x2*)(zb + d);
                const float z0 = __uint_as_float(zv.x << 16), z1 = __uint_as_float(zv.x & 0xffff0000u), z2 = __uint_as_float(zv.y << 16), z3 = __uint_as_float(zv.y & 0xffff0000u);
                u32x2 w; w.x = pk_bf16(res[dt][4 * c + 0] * silu_f(z0), res[dt][4 * c + 1] * silu_f(z1)); w.y = pk_bf16(res[dt][4 * c + 2] * silu_f(z2), res[dt][4 * c + 3] * silu_f(z3));
                *(u32x2*)(dst + d) = w;
            }
    }
}

constexpr int XSH_ROWS = 16640;
__device__ __forceinline__ float wave_sum(float v) {
#pragma unroll
    for (int o = 32; o > 0; o >>= 1) v += __shfl_xor(v, o);
    return v;
}
__device__ __forceinline__ void ln_row16(const float* __restrict__ src, const float* __restrict__ g, const float* __restrict__ bta, int lane, float (&x)[16]) {
#pragma unroll
    for (int q = 0; q < 4; ++q) { const float4 v = *(const float4*)(src + lane * 16 + q * 4); x[4 * q] = v.x; x[4 * q + 1] = v.y; x[4 * q + 2] = v.z; x[4 * q + 3] = v.w; }
    float sm = 0.f;
#pragma unroll
    for (int i = 0; i < 16; ++i) sm += x[i];
    const float mean = wave_sum(sm) * (1.f / 1024.f);
    float sq = 0.f;
#pragma unroll
    for (int i = 0; i < 16; ++i) { x[i] -= mean; sq += x[i] * x[i]; }
    const float rs = rsqrtf(wave_sum(sq) * (1.f / 1024.f) + LN_EPS);
#pragma unroll
    for (int q = 0; q < 4; ++q) {
        const float4 gv = *(const float4*)(g + lane * 16 + q * 4), bv = *(const float4*)(bta + lane * 16 + q * 4);
        x[4 * q] = x[4 * q] * rs * gv.x + bv.x; x[4 * q + 1] = x[4 * q + 1] * rs * gv.y + bv.y; x[4 * q + 2] = x[4 * q + 2] * rs * gv.z + bv.z; x[4 * q + 3] = x[4 * q + 3] * rs * gv.w + bv.w;
    }
}
__device__ __forceinline__ void store_x1_xsh(const Args& a, unsigned char* ws, size_t row, size_t xrow, int lane, const float (&cur)[16], const float (&prev)[16]) {
    float* X1 = (float*)ws + WS_X1 + row * 1024 + lane * 16;
#pragma unroll
    for (int q = 0; q < 4; ++q) *(float4*)(X1 + q * 4) = make_float4(cur[4 * q], cur[4 * q + 1], cur[4 * q + 2], cur[4 * q + 3]);
#pragma unroll 1
    for (int n = 0; n < 6; ++n) {
        const float* mu = a.in[I_MU] + n * 1024 + lane * 16;
        float y[16];
#pragma unroll
        for (int q = 0; q < 4; ++q) { const float4 m4 = *(const float4*)(mu + q * 4);
            y[4 * q] = fmaf(prev[4 * q] - cur[4 * q], m4.x, cur[4 * q]); y[4 * q + 1] = fmaf(prev[4 * q + 1] - cur[4 * q + 1], m4.y, cur[4 * q + 1]);
            y[4 * q + 2] = fmaf(prev[4 * q + 2] - cur[4 * q + 2], m4.z, cur[4 * q + 2]); y[4 * q + 3] = fmaf(prev[4 * q + 3] - cur[4 * q + 3], m4.w, cur[4 * q + 3]); }
        bf16_t* dst = (bf16_t*)(ws + NB_XSH) + ((size_t)n * XSH_ROWS + xrow) * 1024 + lane * 16;
        u32x4 w0, w1;
        w0.x = pk_bf16(y[0], y[1]); w0.y = pk_bf16(y[2], y[3]); w0.z = pk_bf16(y[4], y[5]); w0.w = pk_bf16(y[6], y[7]);
        w1.x = pk_bf16(y[8], y[9]); w1.y = pk_bf16(y[10], y[11]); w1.z = pk_bf16(y[12], y[13]); w1.w = pk_bf16(y[14], y[15]);
        *(u32x4*)dst = w0; *(u32x4*)(dst + 8) = w1;
    }
}
__device__ __forceinline__ void phase_lns(const Args& a, unsigned char* ws, int bid, int nb) {
    const int tid = opaque_v(threadIdx.x), lane = tid & 63, wv = tid >> 6;
    const float* PRE = (const float*)ws + WS_PRE;
    const float* g = a.in[I_LNG]; const float* bta = a.in[I_LNB];
    for (int blk = bid; blk < 256; blk += nb) {
        const int r0 = blk * 64 + wv * 8;
        float prev[16], cur[16];
        if ((r0 & (TP - 1)) == 0) {
#pragma unroll
            for (int i = 0; i < 16; ++i) prev[i] = 0.f;
        } else ln_row16(PRE + (size_t)(r0 - 1) * 1024, g, bta, lane, prev);
#pragma unroll 1
        for (int k = 0; k < 8; ++k) {
            const int row = r0 + k;
            ln_row16(PRE + (size_t)row * 1024, g, bta, lane, cur);
            store_x1_xsh(a, ws, row, row, lane, cur, prev);
            if ((row & (TP - 1)) == TP - 1) {
                float* so = a.out + O_SHP + (size_t)(row >> 11) * 1024 + lane * 16;
#pragma unroll
                for (int q = 0; q < 4; ++q) *(float4*)(so + q * 4) = make_float4(cur[4 * q], cur[4 * q + 1], cur[4 * q + 2], cur[4 * q + 3]);
            }
#pragma unroll
            for (int i = 0; i < 16; ++i) prev[i] = cur[i];
        }
    }
    for (int s = bid * 8 + wv; s < BS; s += nb * 8) {
        float prev[16], cur[16];
        const float* sp = a.in[I_SSHIFT] + (size_t)s * 1024 + lane * 16;
#pragma unroll
        for (int q = 0; q < 4; ++q) { const float4 v = *(const float4*)(sp + q * 4); prev[4 * q] = v.x; prev[4 * q + 1] = v.y; prev[4 * q + 2] = v.z; prev[4 * q + 3] = v.w; }
        ln_row16(PRE + (size_t)(MP + s) * 1024, g, bta, lane, cur);
        store_x1_xsh(a, ws, MP + s, MP + s, lane, cur, prev);
        float* so = a.out + O_SHS + (size_t)s * 1024 + lane * 16;
#pragma unroll
        for (int q = 0; q < 4; ++q) *(float4*)(so + q * 4) = make_float4(cur[4 * q], cur[4 * q + 1], cur[4 * q + 2], cur[4 * q + 3]);
    }
}

struct Order3 {
    pg8::StaticOrder so;
    __device__ void init(int G, int c) { so.init(MP, 4096, G, c); }
    __device__ bool next(int i, Unit& u) const { Unit v; if (!so.next(i, v)) return false; const int n = v.pn >> 2; u.pm = n * 65 + v.pm; u.pn = v.pn; return true; }
    __device__ __forceinline__ void a_ready(const Unit&) const {}
    __device__ __forceinline__ void done(const Unit&) const {}
};
struct Epi3 {
    static constexpr bool PERM = true, AFTER_DRAIN = false;
    bf16_t* O;
    __device__ __forceinline__ void operator()(const f32x4 (&acc)[2][2][4][2], const Unit& u, int wr, int wc, int fr, int fq) const {
        const int n = u.pn >> 2, pm = u.pm - n * 65, pn = u.pn & 3;
        const int row0 = pm * 256 + wr * 64 + fr, col0 = pn * 256 + wc * 32 + 8 * fq;
        bf16_t* base = O + (size_t)n * XSH_ROWS * 1024;
#pragma unroll
        for (int ai = 0; ai < 2; ++ai)
#pragma unroll
            for (int m = 0; m < 4; ++m) { bf16_t* rowp = base + (size_t)(row0 + ai * 128 + m * 16) * 1024 + col0;
#pragma unroll
                for (int bj = 0; bj < 2; ++bj) { const f32x4 v0 = acc[ai][bj][m][0], v1 = acc[ai][bj][m][1];
                    u32x4 w; w.x = pk_bf16(v0[0], v0[1]); w.y = pk_bf16(v0[2], v0[3]); w.z = pk_bf16(v1[0], v1[1]); w.w = pk_bf16(v1[2], v1[3]);
                    *(u32x4*)(rowp + bj * 128) = w; } }
    }
};
struct EpiPreRes {
    static constexpr bool PERM = false, AFTER_DRAIN = false;
    float* C; const float* X;
    __device__ __forceinline__ void operator()(const f32x4 (&acc)[2][2][4][2], const Unit& u, int wr, int wc, int fr, int fq) const {
        const int row0 = u.pm * 256 + wr * 64 + fr, col0 = u.pn * 256 + wc * 32 + 4 * fq;
#pragma unroll
        for (int ai = 0; ai < 2; ++ai)
#pragma unroll
            for (int m = 0; m < 4; ++m) { const size_t off = (size_t)(row0 + ai * 128 + m * 16) * 1024 + col0;
#pragma unroll
                for (int bj = 0; bj < 2; ++bj)
#pragma unroll
                    for (int n = 0; n < 2; ++n) { const f32x4 xv = *(const f32x4*)(X + off + bj * 128 + n * 16); *(f32x4*)(C + off + bj * 128 + n * 16) = acc[ai][bj][m][n] + xv * ALPHA; } }
    }
};

__device__ __forceinline__ void prep2_task(const Args& a, unsigned char* ws, int rt, int hd, int lane) {
    const int lr = lane & 31, h2 = lane >> 5;
    const size_t row = (size_t)rt * 32 + lr;
    const bf16_t* W2T = (const bf16_t*)(ws + NB_W2T); const bf16_t* A2T = (const bf16_t*)(ws + NB_A2T);
    const bf16_t* TWB = (const bf16_t*)(ws + NB_TWB); const bf16_t* AWB = (const bf16_t*)(ws + NB_AWB);
    f32x16 aw[2], aa[2];
#pragma unroll
    for (int ct = 0; ct < 2; ++ct)
#pragma unroll
        for (int i = 0; i < 16; ++i) { aw[ct][i] = 0.f; aa[ct][i] = 0.f; }
#pragma unroll
    for (int s = 0; s < 4; ++s) {
        const bf16x8 bt = *(const bf16x8*)(TWB + row * 64 + s * 16 + h2 * 8), ba = *(const bf16x8*)(AWB + row * 64 + s * 16 + h2 * 8);
#pragma unroll
        for (int ct = 0; ct < 2; ++ct) {
            const size_t e = (size_t)hd * 64 + ct * 32 + lr;
            const bf16x8 w2 = *(const bf16x8*)(W2T + e * 64 + s * 16 + h2 * 8), a2 = *(const bf16x8*)(A2T + e * 64 + s * 16 + h2 * 8);
            aw[ct] = __builtin_amdgcn_mfma_f32_32x32x16_bf16(w2, bt, aw[ct], 0, 0, 0);
            aa[ct] = __builtin_amdgcn_mfma_f32_32x32x16_bf16(a2, ba, aa[ct], 0, 0, 0);
        }
    }
    const bf16_t* KB = (const bf16_t*)(ws + NB_RKVZ) + ((size_t)1 * XSH_ROWS + row) * 1024;
    const bf16_t* RB = (const bf16_t*)(ws + NB_RKVZ) + ((size_t)0 * XSH_ROWS + row) * 1024;
    float* DEC = (float*)(ws + NB_DEC) + row * 1024;
    bf16_t* KKN = (bf16_t*)(ws + NB_KKN) + row * 1024; bf16_t* KKA = (bf16_t*)(ws + NB_KKA) + row * 1024; bf16_t* KP = (bf16_t*)(ws + NB_KP) + row * 1024;
    typedef unsigned u32x2 __attribute__((ext_vector_type(2)));
    float n2 = 0.f, rk = 0.f;
    float kkv[2][16], av[2][16];
#pragma unroll
    for (int ct = 0; ct < 2; ++ct)
#pragma unroll
        for (int c = 0; c < 4; ++c) {
            const int e = hd * 64 + ct * 32 + 8 * c + 4 * h2;
            const float4 w0v = *(const float4*)(a.in[I_W0] + e), a0v = *(const float4*)(a.in[I_A0] + e), kkp = *(const float4*)(a.in[I_KK] + e),
                         kap = *(const float4*)(a.in[I_KA] + e), rkp = *(const float4*)(a.in[I_RK] + e);
            const float w0a[4] = {w0v.x, w0v.y, w0v.z, w0v.w}, a0a[4] = {a0v.x, a0v.y, a0v.z, a0v.w}, kka[4] = {kkp.x, kkp.y, kkp.z, kkp.w},
                        kaa[4] = {kap.x, kap.y, kap.z, kap.w}, rka[4] = {rkp.x, rkp.y, rkp.z, rkp.w};
            const u32x2 kw = *(const u32x2*)(KB + e), rw = *(const u32x2*)(RB + e);
            const float kf[4] = {__uint_as_float(kw.x << 16), __uint_as_float(kw.x & 0xffff0000u), __uint_as_float(kw.y << 16), __uint_as_float(kw.y & 0xffff0000u)};
            const float rf[4] = {__uint_as_float(rw.x << 16), __uint_as_float(rw.x & 0xffff0000u), __uint_as_float(rw.y << 16), __uint_as_float(rw.y & 0xffff0000u)};
            float dec[4], kp[4];
#pragma unroll
            for (int i = 0; i < 4; ++i) {
                const float wl = w0a[i] + aw[ct][4 * c + i];
                const float sp = fmaxf(-wl, 0.f) + log1pf(__expf(-fabsf(wl)));
                dec[i] = __expf(-__expf(-sp - 0.5f));
                const float av_ = sigm_f(a0a[i] + aa[ct][4 * c + i]);
                const float kk = kf[i] * kka[i];
                kp[i] = kf[i] * (1.f + (av_ - 1.f) * kaa[i]);
                kkv[ct][4 * c + i] = kk; av[ct][4 * c + i] = av_;
                n2 = fmaf(kk, kk, n2);
                rk = fmaf(rf[i] * kp[i], rka[i], rk);
            }
            *(float4*)(DEC + e) = make_float4(dec[0], dec[1], dec[2], dec[3]);
            u32x2 kpw; kpw.x = pk_bf16(kp[0], kp[1]); kpw.y = pk_bf16(kp[2], kp[3]);
            *(u32x2*)(KP + e) = kpw;
        }
    n2 += __shfl_xor(n2, 32); rk += __shfl_xor(rk, 32);
    const float inv = 1.f / fmaxf(sqrtf(n2), 1e-12f);
#pragma unroll
    for (int ct = 0; ct < 2; ++ct)
#pragma unroll
        for (int c = 0; c < 4; ++c) {
            const int e = hd * 64 + ct * 32 + 8 * c + 4 * h2;
            float kn[4];
#pragma unroll
            for (int i = 0; i < 4; ++i) kn[i] = kkv[ct][4 * c + i] * inv;
            u32x2 w1, w2; w1.x = pk_bf16(kn[0], kn[1]); w1.y = pk_bf16(kn[2], kn[3]);
            w2.x = pk_bf16(kn[0] * av[ct][4 * c], kn[1] * av[ct][4 * c + 1]); w2.y = pk_bf16(kn[2] * av[ct][4 * c + 2], kn[3] * av[ct][4 * c + 3]);
            *(u32x2*)(KKN + e) = w1; *(u32x2*)(KKA + e) = w2;
        }
    if (h2 == 0) ((float*)(ws + NB_RKS))[row * 16 + hd] = rk;
}

constexpr int SC_BUF = 53248;
__device__ __forceinline__ float dpp_red16(float v) {
    v += __builtin_bit_cast(float, __builtin_amdgcn_update_dpp(0, __builtin_bit_cast(int, v), 0xB1, 0xF, 0xF, true));
    v += __builtin_bit_cast(float, __builtin_amdgcn_update_dpp(0, __builtin_bit_cast(int, v), 0x4E, 0xF, 0xF, true));
    v += __builtin_bit_cast(float, __builtin_amdgcn_update_dpp(0, __builtin_bit_cast(int, v), 0x141, 0xF, 0xF, true));
    v += __builtin_bit_cast(float, __builtin_amdgcn_update_dpp(0, __builtin_bit_cast(int, v), 0x140, 0xF, 0xF, true));
    return v;
}
struct ScanRegs { u32x4 d0, d1, kn, ka, kp, r, v; };
__device__ __forceinline__ void scan_issue(unsigned char* ws, int b, int hd, int vh, int chunk, int tid, ScanRegs& g) {
    const int tt = tid >> 3, part = tid & 7;
    const size_t row = (size_t)b * TP + chunk * 64 + tt;
    const size_t off = row * 1024 + hd * 64 + part * 8;
    const float* dp = (const float*)(ws + NB_DEC) + off;
    g.d0 = *(const u32x4*)dp; g.d1 = *(const u32x4*)(dp + 4);
    g.kn = *(const u32x4*)((const bf16_t*)(ws + NB_KKN) + off);
    g.ka = *(const u32x4*)((const bf16_t*)(ws + NB_KKA) + off);
    g.kp = *(const u32x4*)((const bf16_t*)(ws + NB_KP) + off);
    g.r = *(const u32x4*)((const bf16_t*)(ws + NB_RKVZ) + ((size_t)0 * XSH_ROWS + row) * 1024 + hd * 64 + part * 8);
    if (part < 4) g.v = *(const u32x4*)((const bf16_t*)(ws + NB_RKVZ) + ((size_t)2 * XSH_ROWS + row) * 1024 + hd * 64 + vh * 32 + part * 8);
}
__device__ __forceinline__ void scan_write(PG8_LAS unsigned char* buf, int tid, const ScanRegs& g) {
    const int tt = tid >> 3, part = tid & 7;
    *(PG8_LAS u32x4*)(buf + tt * 256 + part * 32) = g.d0; *(PG8_LAS u32x4*)(buf + tt * 256 + part * 32 + 16) = g.d1;
    *(PG8_LAS u32x4*)(buf + 16384 + tt * 128 + part * 16) = g.kn;
    *(PG8_LAS u32x4*)(buf + 24576 + tt * 128 + part * 16) = g.ka;
    *(PG8_LAS u32x4*)(buf + 32768 + tt * 128 + part * 16) = g.kp;
    *(PG8_LAS u32x4*)(buf + 40960 + tt * 128 + part * 16) = g.r;
    if (part < 4) *(PG8_LAS u32x4*)(buf + 49152 + tt * 64 + part * 16) = g.v;
}
__device__ __forceinline__ void scan_prompt(const Args& a, unsigned char* ws, PG8_LAS unsigned char* lds, int item) {
    const int tid = opaque_v(threadIdx.x);
    const int b = item >> 5, hd = (item >> 1) & 15, vh = item & 1;
    const int vl = tid >> 4, kq = tid & 15;
    typedef unsigned u32x2 __attribute__((ext_vector_type(2)));
    float S[4] = {0.f, 0.f, 0.f, 0.f};
    ScanRegs g;
    PG8_LAS float* YS = (PG8_LAS float*)(lds + 2 * SC_BUF);
    scan_issue(ws, b, hd, vh, 0, tid, g); scan_write(lds, tid, g);
    __syncthreads();
    for (int c = 0; c < TP / 64; ++c) {
        PG8_LAS unsigned char* buf = lds + (c & 1) * SC_BUF;
        if (c + 1 < TP / 64) scan_issue(ws, b, hd, vh, c + 1, tid, g);
#pragma unroll 4
        for (int tt = 0; tt < 64; ++tt) {
            const f32x4 w = *(const PG8_LAS f32x4*)(buf + tt * 256 + kq * 16);
            const u32x2 knw = *(const PG8_LAS u32x2*)(buf + 16384 + tt * 128 + kq * 8), kaw = *(const PG8_LAS u32x2*)(buf + 24576 + tt * 128 + kq * 8),
                        kpw = *(const PG8_LAS u32x2*)(buf + 32768 + tt * 128 + kq * 8), rw = *(const PG8_LAS u32x2*)(buf + 40960 + tt * 128 + kq * 8);
            const float vv = bf2f(*(const PG8_LAS bf16_t*)(buf + 49152 + tt * 64 + vl * 2));
            const float kn[4] = {__uint_as_float(knw.x << 16), __uint_as_float(knw.x & 0xffff0000u), __uint_as_float(knw.y << 16), __uint_as_float(knw.y & 0xffff0000u)};
            const float ka[4] = {__uint_as_float(kaw.x << 16), __uint_as_float(kaw.x & 0xffff0000u), __uint_as_float(kaw.y << 16), __uint_as_float(kaw.y & 0xffff0000u)};
            const float kp[4] = {__uint_as_float(kpw.x << 16), __uint_as_float(kpw.x & 0xffff0000u), __uint_as_float(kpw.y << 16), __uint_as_float(kpw.y & 0xffff0000u)};
            const float rr[4] = {__uint_as_float(rw.x << 16), __uint_as_float(rw.x & 0xffff0000u), __uint_as_float(rw.y << 16), __uint_as_float(rw.y & 0xffff0000u)};
            float sa = S[0] * kn[0];
            sa = fmaf(S[1], kn[1], sa); sa = fmaf(S[2], kn[2], sa); sa = fmaf(S[3], kn[3], sa);
            sa = dpp_red16(sa);
            float y = 0.f;
#pragma unroll
            for (int i = 0; i < 4; ++i) { S[i] = fmaf(S[i], w[i], fmaf(vv, kp[i], -sa * ka[i])); y = fmaf(S[i], rr[i], y); }
            y = dpp_red16(y);
            if (kq == 0) YS[tt * 32 + vl] = y;
        }
        if (c + 1 < TP / 64) scan_write(lds + ((c + 1) & 1) * SC_BUF, tid, g);
        __syncthreads();
        {
            float* Y = (float*)(ws + NB_Y);
            for (int i = tid; i < 64 * 32; i += NTH) { const int tt = i >> 5, v = i & 31; Y[((size_t)b * TP + c * 64 + tt) * 1024 + hd * 64 + vh * 32 + v] = YS[i]; }
        }
        __syncthreads();
    }
    float* so = a.out + O_WKVP + ((size_t)(b * 16 + hd) * 64 + vh * 32 + vl) * 64 + kq * 4;
    *(float4*)so = make_float4(S[0], S[1], S[2], S[3]);
}
__device__ __forceinline__ void scan_sample(const Args& a, unsigned char* ws, int s, int hd, int lane) {
    const size_t row = (size_t)MP + s;
    const float* s0 = a.in[I_SWKV] + ((size_t)(s * 16 + hd) * 64 + lane) * 64;
    float* sout = a.out + O_WKVS + ((size_t)(s * 16 + hd) * 64 + lane) * 64;
    const float* dec = (const float*)(ws + NB_DEC) + row * 1024 + hd * 64;
    const bf16_t* kn = (const bf16_t*)(ws + NB_KKN) + row * 1024 + hd * 64; const bf16_t* ka = (const bf16_t*)(ws + NB_KKA) + row * 1024 + hd * 64;
    const bf16_t* kp = (const bf16_t*)(ws + NB_KP) + row * 1024 + hd * 64;
    const bf16_t* rp = (const bf16_t*)(ws + NB_RKVZ) + ((size_t)0 * XSH_ROWS + row) * 1024 + hd * 64;
    const float vv = bf2f(((const bf16_t*)(ws + NB_RKVZ) + ((size_t)2 * XSH_ROWS + row) * 1024 + hd * 64)[lane]);
    float sa = 0.f;
#pragma unroll 8
    for (int k = 0; k < 64; ++k) sa = fmaf(s0[k], bf2f(kn[k]), sa);
    float y = 0.f;
#pragma unroll 8
    for (int k = 0; k < 64; ++k) { const float sn = fmaf(s0[k], dec[k], fmaf(vv, bf2f(kp[k]), -sa * bf2f(ka[k]))); sout[k] = sn; y = fmaf(sn, bf2f(rp[k]), y); }
    ((float*)(ws + NB_Y))[row * 1024 + hd * 64 + lane] = y;
}

__device__ __forceinline__ void phase_post(const Args& a, unsigned char* ws, int bid, int nb) {
    const int tid = opaque_v(threadIdx.x), lane = tid & 63, wv = tid >> 6;
    for (int row = bid * 8 + wv; row < MT; row += nb * 8) {
        const float* yp = (const float*)(ws + NB_Y) + (size_t)row * 1024 + lane * 16;
        float y[16];
#pragma unroll
        for (int q = 0; q < 4; ++q) { const float4 v = *(const float4*)(yp + q * 4); y[4 * q] = v.x; y[4 * q + 1] = v.y; y[4 * q + 2] = v.z; y[4 * q + 3] = v.w; }
        float sm = 0.f;
#pragma unroll
        for (int i = 0; i < 16; ++i) sm += y[i];
        sm += __shfl_xor(sm, 1); sm += __shfl_xor(sm, 2);
        const float mean = sm * (1.f / 64.f);
        float sq = 0.f;
#pragma unroll
        for (int i = 0; i < 16; ++i) { y[i] -= mean; sq += y[i] * y[i]; }
        sq += __shfl_xor(sq, 1); sq += __shfl_xor(sq, 2);
        const float rs = rsqrtf(sq * (1.f / 64.f) + GN_EPS);
        const float rk = ((const float*)(ws + NB_RKS))[(size_t)row * 16 + (lane >> 2)];
        const bf16_t* vp = (const bf16_t*)(ws + NB_RKVZ) + ((size_t)2 * XSH_ROWS + row) * 1024 + lane * 16;
        const bf16_t* zp = (const bf16_t*)(ws + NB_RKVZ) + ((size_t)3 * XSH_ROWS + row) * 1024 + lane * 16;
        const u32x4 v0 = *(const u32x4*)vp, v1 = *(const u32x4*)(vp + 8), z0 = *(const u32x4*)zp, z1 = *(const u32x4*)(zp + 8);
        float o[16];
#pragma unroll
        for (int i = 0; i < 16; ++i) {
            const unsigned vw = (i < 8) ? v0[i >> 1] : v1[(i - 8) >> 1], zw = (i < 8) ? z0[i >> 1] : z1[(i - 8) >> 1];
            const float vf = __uint_as_float((i & 1) ? (vw & 0xffff0000u) : (vw << 16)), zf = __uint_as_float((i & 1) ? (zw & 0xffff0000u) : (zw << 16));
            const int e = lane * 16 + i;
            const float yn = fmaf(rk, vf, y[i] * rs * a.in[I_GNG][e] + a.in[I_GNB][e]);
            o[i] = yn * silu_f(zf);
        }
        bf16_t* dst = (bf16_t*)(ws + NB_G4B) + (size_t)row * 1024 + lane * 16;
        u32x4 w0, w1;
        w0.x = pk_bf16(o[0], o[1]); w0.y = pk_bf16(o[2], o[3]); w0.z = pk_bf16(o[4], o[5]); w0.w = pk_bf16(o[6], o[7]);
        w1.x = pk_bf16(o[8], o[9]); w1.y = pk_bf16(o[10], o[11]); w1.z = pk_bf16(o[12], o[13]); w1.w = pk_bf16(o[14], o[15]);
        *(u32x4*)dst = w0; *(u32x4*)(dst + 8) = w1;
    }
}
__device__ __forceinline__ void phase_lnf(const Args& a, unsigned char* ws, int bid, int nb) {
    const int tid = opaque_v(threadIdx.x), lane = tid & 63, wv = tid >> 6;
    for (int row = bid * 8 + wv; row < MT; row += nb * 8) {
        float x[16];
        ln_row16((const float*)ws + WS_PRE + (size_t)row * 1024, a.in[I_LNG] + 1024, a.in[I_LNB] + 1024, lane, x);
        float* o = (row < MP ? a.out + O_Y + (size_t)row * 1024 : a.out + O_YS + (size_t)(row - MP) * 1024) + lane * 16;
#pragma unroll
        for (int q = 0; q < 4; ++q) *(float4*)(o + q * 4) = make_float4(x[4 * q], x[4 * q + 1], x[4 * q + 2], x[4 * q + 3]);
    }
}

__device__ __forceinline__ void sample_pool_copy(const Args& a, unsigned char* ws, int bid, int nb) {
    float* KCS = (float*)(ws + NB_KCS);
    const int* pt = (const int*)a.in[I_PT];
    const float* ccmp = a.in[I_CCMP];
    for (int i = bid * NTH + threadIdx.x; i < BS * 256 * 256; i += nb * NTH) {
        const int c = i & 255, n = (i >> 8) & 255, s = i >> 16;
        const int kv = c >> 7, g = (c >> 6) & 1;
        const float* w = kv ? a.in[I_WVC] : a.in[I_WKC];
        const int pos0 = n * 32;
        const float* src = ccmp + ((size_t)pt[s * NPAGE + (pos0 >> 7)] * PAGE + (pos0 & 127)) * 256 + c;
        float acc = 0.f;
#pragma unroll 8
        for (int l = 0; l < 32; ++l) acc = fmaf(src[(size_t)l * 256], w[l * 2 + g], acc);
        KCS[i] = acc;
    }
    const float4* cw = (const float4*)a.in[I_CWIN];
    float4* ow = (float4*)(a.out + O_WINS);
    for (int i = bid * NTH + threadIdx.x; i < BS * 511 * 64; i += nb * NTH) {
        const int s = i / (511 * 64), rem = i - s * (511 * 64);
        ow[(size_t)s * 512 * 64 + rem] = cw[(size_t)s * 512 * 64 + 64 + rem];
    }
}
__device__ __forceinline__ void sample_conv(const Args& a, unsigned char* ws, PG8_LAS unsigned char* lds, int s) {
    const int ch = opaque_v(threadIdx.x);
    const bf16_t* h = (const bf16_t*)(ws + NB_HB) + (size_t)(MP + s) * 2560;
    const float* sc = a.in[I_SCONV] + (size_t)s * 30 * 512 + ch;
    const float u = bf2f(h[ch]) * sigm_f(bf2f(h[512 + ch]));
    float acc = a.in[I_CONVB][ch];
#pragma unroll 6
    for (int j = 0; j < 30; ++j) acc = fmaf(a.in[I_CONVW][j * 512 + ch], sc[(size_t)j * 512], acc);
    acc = fmaf(a.in[I_CONVW][30 * 512 + ch], u, acc);
    float* oc = a.out + O_CONVS + (size_t)s * 30 * 512 + ch;
    for (int i = 0; i < 29; ++i) oc[(size_t)i * 512] = sc[(size_t)(i + 1) * 512];
    oc[(size_t)29 * 512] = u;
    PG8_LAS float* red = (PG8_LAS float*)lds;
    const int lane = ch & 63, wv = ch >> 6;
    float sm = wave_sum(acc);
    __syncthreads();
    if (lane == 0) red[wv] = sm;
    __syncthreads();
    float tot = 0.f;
#pragma unroll
    for (int i = 0; i < 8; ++i) tot += red[i];
    const float mean = tot * (1.f / 512.f);
    const float d = acc - mean;
    float sq = wave_sum(d * d);
    __syncthreads();
    if (lane == 0) red[wv] = sq;
    __syncthreads();
    tot = 0.f;
#pragma unroll
    for (int i = 0; i < 8; ++i) tot += red[i];
    const float rs = rsqrtf(tot * (1.f / 512.f) + LN_EPS);
    const float y = silu_f(d * rs * a.in[I_CLNG][ch] + a.in[I_CLNB][ch]) * silu_f(bf2f(h[1024 + ch]));
    ((bf16_t*)(ws + NB_CATB))[(size_t)(MP + s) * 1024 + ch] = (bf16_t)(pk_bf16(y, 0.f) & 0xffffu);
    __syncthreads();
}

__device__ __forceinline__ void sample_attn(const Args& a, unsigned char* ws, PG8_LAS unsigned char* lds, int s, int g) {
    const int tid = opaque_v(threadIdx.x), lane = tid & 63, wv = __builtin_amdgcn_readfirstlane(tid >> 6);
    PG8_LAS float* PC = (PG8_LAS float*)lds;
    PG8_LAS float* IMP = (PG8_LAS float*)(lds + 4096);
    PG8_LAS int* SEL = (PG8_LAS int*)(lds + 4096 + 1024);
    PG8_LAS int* FLG = (PG8_LAS int*)(lds + 4096 + 1024 + 128);
    PG8_LAS float* PS = (PG8_LAS float*)(lds + 8192) + (tid >> 6) * 64;
    const int hh = g * 4 + (wv & 3);
    const float slope = __builtin_amdgcn_exp2f(-(float)(hh + 1));
    const int* pt = (const int*)a.in[I_PT] + s * NPAGE;
    const bf16_t* hrow = (const bf16_t*)(ws + NB_HB) + (size_t)(MP + s) * 2560;
    float q[64];
    float res = 0.f;
    if (wv < 4) {
#pragma unroll
        for (int d8 = 0; d8 < 8; ++d8) { const u32x4 w = *(const u32x4*)(hrow + 1536 + hh * 64 + d8 * 8);
#pragma unroll
            for (int i = 0; i < 4; ++i) { q[d8 * 8 + 2 * i] = __uint_as_float(w[i] << 16); q[d8 * 8 + 2 * i + 1] = __uint_as_float(w[i] & 0xffff0000u); } }
    }
#define SAMP_DOT(KPTR, OUT) { const float4* k4_ = (const float4*)(KPTR); float s_ = 0.f; \
        _Pragma("unroll") for (int i_ = 0; i_ < 16; ++i_) { const float4 kk_ = k4_[i_]; s_ = fmaf(q[4 * i_], kk_.x, s_); s_ = fmaf(q[4 * i_ + 1], kk_.y, s_); s_ = fmaf(q[4 * i_ + 2], kk_.z, s_); s_ = fmaf(q[4 * i_ + 3], kk_.w, s_); } OUT = s_; }
    float gc = 0.f, gs = 0.f, gw = 0.f;
    if (wv < 4) {
        const float* g3p = (const float*)(ws + NB_G3) + (size_t)(MP + s) * 32 + hh * 3;
        gc = sigm_f(g3p[0]); gs = sigm_f(g3p[1]); gw = sigm_f(g3p[2]);
        const float* kc = (const float*)(ws + NB_KCS) + (size_t)s * 256 * 256 + g * 64;
        float sc[4];
        float mx = -INFINITY;
#pragma unroll
        for (int i = 0; i < 4; ++i) { const int n = lane + 64 * i; float d; SAMP_DOT(kc + (size_t)n * 256, d); sc[i] = d - slope * (float)(PAST - (32 * n + 31)); mx = fmaxf(mx, sc[i]); }
#pragma unroll
        for (int o = 32; o > 0; o >>= 1) mx = fmaxf(mx, __shfl_xor(mx, o));
        float ls = 0.f;
#pragma unroll
        for (int i = 0; i < 4; ++i) { sc[i] = __expf(sc[i] - mx); ls += sc[i]; }
        ls = wave_sum(ls);
        const float inv = 1.f / ls;
#pragma unroll
        for (int i = 0; i < 4; ++i) PC[(wv & 3) * 256 + lane + 64 * i] = sc[i] * inv;
    }
    __syncthreads();
    if (wv < 4) {
        const float* vc = (const float*)(ws + NB_KCS) + (size_t)s * 256 * 256 + 128 + g * 64 + lane;
        float oc = 0.f;
#pragma unroll 8
        for (int n = 0; n < 256; ++n) oc = fmaf(PC[(wv & 3) * 256 + n], vc[(size_t)n * 256], oc);
        res = gc * oc;
    }
    if (tid < 129) {
        float v = 0.f;
        if (tid < 128) { for (int r = 0; r < 4; ++r) v += PC[r * 256 + 2 * tid] + PC[r * 256 + 2 * tid + 1]; }
        if (tid == 0 || tid >= 127) v = 1e4f;
        IMP[tid] = v;
    }
    __syncthreads();
    if (tid < 129) {
        const float vj = IMP[tid];
        int rank = 0;
        for (int i = 0; i < 129; ++i) { const float vi = IMP[i]; rank += (vi > vj || (vi == vj && i < tid)) ? 1 : 0; }
        FLG[tid] = (rank < 16) ? 1 : 0;
    }
    __syncthreads();
    if (tid < 129 && FLG[tid]) { int slot = 0; for (int i = 0; i < tid; ++i) slot += FLG[i]; SEL[slot] = tid; }
    __syncthreads();
    if (wv < 4) {
        float m = -1e30f, l = 0.f, o = 0.f;
        const float* csel = a.in[I_CSEL];
        const float* newsel = a.out + O_SELS + (size_t)s * 256;
#pragma unroll 1
        for (int si = 0; si < 16; ++si) {
            const int blk = SEL[si];
            const int kpos = blk * 64 + lane;
            const bool valid = kpos <= PAST;
            const float* rowp = (blk < 128) ? csel + ((size_t)pt[kpos >> 7] * PAGE + (kpos & 127)) * 256 : newsel;
            float sc = -INFINITY;
            if (valid) { float d; SAMP_DOT(rowp + g * 64, d); sc = d - slope * (float)(PAST - kpos); }
            float mx = sc;
#pragma unroll
            for (int of = 32; of > 0; of >>= 1) mx = fmaxf(mx, __shfl_xor(mx, of));
            const float mn = fmaxf(m, mx), corr = __expf(m - mn), p = valid ? __expf(sc - mn) : 0.f;
            m = mn; l = fmaf(l, corr, wave_sum(p)); o *= corr;
            const float* vb = (blk < 128) ? csel + ((size_t)pt[(blk * 64) >> 7] * PAGE + ((blk * 64) & 127)) * 256 + 128 + g * 64 + lane : newsel + 128 + g * 64 + lane;
            const int nk = (blk < 128) ? 64 : 1;
            PS[lane] = p; __builtin_amdgcn_wave_barrier();
#pragma unroll 8
            for (int k = 0; k < 64; ++k) { if (k < nk) o = fmaf(PS[k], vb[(size_t)k * 256], o); }
            __builtin_amdgcn_wave_barrier();
        }
        res = fmaf(gs, o / l, res);
        m = -1e30f; l = 0.f; o = 0.f;
        const float* cwin = a.in[I_CWIN] + (size_t)s * 512 * 256;
        const float* newwin = a.out + O_WINS + (size_t)(s * 512 + 511) * 256;
#pragma unroll 1
        for (int wb = 0; wb < 8; ++wb) {
            const int i = 1 + wb * 64 + lane;
            const float* rowp = (i < 512) ? cwin + (size_t)i * 256 : newwin;
            float d; SAMP_DOT(rowp + g * 64, d);
            const float sc = d - slope * (float)(512 - i);
            float mx = sc;
#pragma unroll
            for (int of = 32; of > 0; of >>= 1) mx = fmaxf(mx, __shfl_xor(mx, of));
            const float mn = fmaxf(m, mx), corr = __expf(m - mn), p = __expf(sc - mn);
            m = mn; l = fmaf(l, corr, wave_sum(p)); o *= corr;
            PS[lane] = p; __builtin_amdgcn_wave_barrier();
#pragma unroll 8
            for (int k = 0; k < 64; ++k) {
                const int ik = 1 + wb * 64 + k;
                const float* vr = (ik < 512) ? cwin + (size_t)ik * 256 : newwin;
                o = fmaf(PS[k], vr[128 + g * 64 + lane], o);
            }
            __builtin_amdgcn_wave_barrier();
        }
        res = fmaf(gw, o / l, res);
        const float y = res * silu_f(bf2f(hrow[2048 + hh * 64 + lane]));
        ((bf16_t*)(ws + NB_CATB))[(size_t)(MP + s) * 1024 + 512 + hh * 64 + lane] = (bf16_t)(pk_bf16(y, 0.f) & 0xffffu);
    }
#undef SAMP_DOT
    __syncthreads();
}

enum { PH_PREP = 0, PH_GEMM1, PH_CONV, PH_ATTN, PH_GEMM2, PH_LNS, PH_GEMM3, PH_PREP2, PH_SCAN, PH_POST, PH_GEMM4, PH_LNF, NPHASE };

__global__ void __launch_bounds__(NTH, 2) mega(Args a) {
    extern __shared__ __attribute__((aligned(16))) unsigned char lds_raw[];
    PG8_LAS unsigned char* lds = (PG8_LAS unsigned char*)lds_raw;
    unsigned char* ws = a.ws;
    volatile LAS unsigned* misc = (volatile LAS unsigned*)(lds + LDS_MISC);
    if (threadIdx.x < 4) misc[threadIdx.x] = 0u;
    __syncthreads();
    XcdBarrier bar = xcd_barrier_post((unsigned*)(ws + NB_BAR), misc);
    const int lo = a.ph_lo, hi = a.ph_hi;
#ifndef SKIPMASK
#define SKIPMASK 0
#endif
#define IN(k) (lo <= (k) && (k) < hi && !((SKIPMASK >> (k)) & 1))
#define SEAM(k) do { if (IN(k) && IN((k) + 1)) { if ((k) == lo) cg::this_grid().sync(); else xcd_barrier(bar); } } while (0)
    if (IN(PH_PREP)) {
        const int bid = opaque(blockIdx.x), nb = gridDim.x;
        convert_wt(a.in[I_WIN], 1024, DIN, (bf16_t*)(ws + NB_WT1), N1PAD, MapWin{}, bid, nb);
        convert_wt(a.in[I_WOUTE], 1024, 1024, (bf16_t*)(ws + NB_WT2), 1024, MapId{}, bid, nb);
        for (int n = 0; n < 4; ++n) convert_wt(a.in[I_WRKVZ] + (size_t)n * 1024 * 1024, 1024, 1024, (bf16_t*)(ws + NB_WT3) + (size_t)n * 1024 * 1024, 1024, MapId{}, bid, nb);
        convert_wt(a.in[I_WOUTO], 1024, 1024, (bf16_t*)(ws + NB_WT4), 1024, MapId{}, bid, nb);
        convert_wt(a.in[I_W1], 1024, 64, (bf16_t*)(ws + NB_W1T), 64, MapId{}, bid, nb);
        convert_wt(a.in[I_A1], 1024, 64, (bf16_t*)(ws + NB_A1T), 64, MapId{}, bid, nb);
        convert_wt(a.in[I_W2], 64, 1024, (bf16_t*)(ws + NB_W2T), 1024, MapId{}, bid, nb);
        convert_wt(a.in[I_A2], 64, 1024, (bf16_t*)(ws + NB_A2T), 1024, MapId{}, bid, nb);
        convert_rows(a.in[I_XP], (size_t)MP * 1024 / 8, (bf16_t*)(ws + NB_XB), bid, nb);
        convert_rows(a.in[I_XS], (size_t)BS * 1024 / 8, (bf16_t*)(ws + NB_XSB), bid, nb);
        sample_pool_copy(a, ws, bid, nb);
    }
    SEAM(PH_PREP);
    if (IN(PH_GEMM1)) {
        const int bid = opaque(blockIdx.x), nb = gridDim.x;
        const Route1 R{(bf16_t*)(ws + NB_HB), (bf16_t*)(ws + NB_KVB), (float*)(ws + NB_G3), a.out};
        {
            pg8::Gemm g{(const bf16_t*)(ws + NB_XB), (const bf16_t*)(ws + NB_WT1), MP, N1PAD, 1024};
            pg8::StaticOrder S; S.init(MP, N1PAD, nb, bid);
            Epi1 E{R};
            pg8::gemm_phase<Epi1, pg8::StaticOrder, false>(lds, g, S, E, nullptr);
        }
        {
            const int lane = threadIdx.x & 63, wv = __builtin_amdgcn_readfirstlane(threadIdx.x >> 6);
            for (int task = bid * 8 + wv; task < 105; task += nb * 8) {
                sample_gemm32((const bf16_t*)(ws + NB_XSB), (const bf16_t*)(ws + NB_WT1), 1024, task * 32, lane,
                    [&](int r, int n, float v) {
                        const int row = MP + r;
                        if (n < 2560) { const float sc = (n >= 1536 && n < 2048) ? 0.125f : 1.0f; ((bf16_t*)(ws + NB_HB))[(size_t)row * 2560 + n] = (bf16_t)(pk_bf16(v * sc, 0.f) & 0xffffu); }
                        else if (n < 3328) { const int c = n - 2560, i3 = c >> 8, cc = c & 255; ((bf16_t*)(ws + NB_KVB))[(size_t)row * 768 + c] = (bf16_t)(pk_bf16(v, 0.f) & 0xffffu);
                            float* dst = (i3 == 0) ? a.out + O_CMPS + (size_t)r * 256 + cc : (i3 == 1) ? a.out + O_SELS + (size_t)r * 256 + cc : a.out + O_WINS + (size_t)(r * 512 + 511) * 256 + cc;
                            *dst = v; }
                        else if (n < 3352) ((float*)(ws + NB_G3))[(size_t)row * 32 + (n - 3328)] = v;
                    });
            }
        }
    }
    SEAM(PH_GEMM1);
    if (IN(PH_CONV)) {
        const int bid = opaque(blockIdx.x), nb = gridDim.x;
        for (int item = bid; item < 256; item += nb) conv_item(a, ws, lds, item);
        pool_prompt(a, ws, bid, nb);
        if (bid < 64) sample_attn(a, ws, lds, bid >> 1, bid & 1);
        else if (bid < 96) sample_conv(a, ws, lds, bid - 64);
    }
    SEAM(PH_CONV);
    if (IN(PH_ATTN)) {
        const int bid = opaque(blockIdx.x), nb = gridDim.x;
        for (int pr = bid; pr < 256; pr += nb) {
            const int b = pr >> 5, g = (pr >> 4) & 1, xq = pr & 15;
#pragma unroll 1
            for (int k = 0; k < 2; ++k) attn_item(a, ws, lds, b, g, k ? xq : 31 - xq);
        }
    }
    SEAM(PH_ATTN);
    if (IN(PH_GEMM2)) {
        const int bid = opaque(blockIdx.x), nb = gridDim.x;
        {
            pg8::Gemm g{(const bf16_t*)(ws + NB_CATB), (const bf16_t*)(ws + NB_WT2), MP, 1024, 1024};
            pg8::StaticOrder S; S.init(MP, 1024, nb, bid);
            EpiPreRes E{(float*)ws + WS_PRE, a.in[I_XP]};
            pg8::gemm_phase<EpiPreRes, pg8::StaticOrder, false>(lds, g, S, E, nullptr);
        }
        {
            const int lane = threadIdx.x & 63, wv = __builtin_amdgcn_readfirstlane(threadIdx.x >> 6);
            float* PREs = (float*)ws + WS_PRE + (size_t)MP * 1024;
            const float* xs = a.in[I_XS];
            for (int task = bid * 8 + wv; task < 32; task += nb * 8)
                sample_gemm32((const bf16_t*)(ws + NB_CATB) + (size_t)MP * 1024, (const bf16_t*)(ws + NB_WT2), 1024, task * 32, lane,
                              [&](int r, int n, float v) { PREs[(size_t)r * 1024 + n] = fmaf(ALPHA, xs[(size_t)r * 1024 + n], v); });
        }
    }
    SEAM(PH_GEMM2);
    if (IN(PH_LNS)) { const int bid = opaque(blockIdx.x), nb = gridDim.x; phase_lns(a, ws, bid, nb); }
    SEAM(PH_LNS);
    if (IN(PH_GEMM3)) {
        const int bid = opaque(blockIdx.x), nb = gridDim.x;
        {
            pg8::Gemm g{(const bf16_t*)(ws + NB_XSH), (const bf16_t*)(ws + NB_WT3), MP, 4096, 1024};
            Order3 S; S.init(nb, bid);
            Epi3 E{(bf16_t*)(ws + NB_RKVZ)};
            pg8::gemm_phase<Epi3, Order3, false>(lds, g, S, E, nullptr);
        }
        {
            const int lane = threadIdx.x & 63, wv = __builtin_amdgcn_readfirstlane(threadIdx.x >> 6);
            for (int task = bid * 8 + wv; task < 128; task += nb * 8) {
                const int n = task >> 5, n0 = (task & 31) * 32;
                bf16_t* dst = (bf16_t*)(ws + NB_RKVZ) + ((size_t)n * XSH_ROWS + MP) * 1024;
                sample_gemm32((const bf16_t*)(ws + NB_XSH) + ((size_t)n * XSH_ROWS + MP) * 1024, (const bf16_t*)(ws + NB_WT3) + (size_t)n * 1024 * 1024, 1024, n0, lane,
                              [&](int r, int c, float v) { dst[(size_t)r * 1024 + c] = (bf16_t)(pk_bf16(v, 0.f) & 0xffffu); });
            }
            for (int task = bid * 8 + wv; task < 513 * 4; task += nb * 8) {
                const int rt = task >> 2, which = (task >> 1) & 1, n0 = (task & 1) * 32;
                const bf16_t* A = (const bf16_t*)(ws + NB_XSH) + ((size_t)(4 + which) * XSH_ROWS + (size_t)rt * 32) * 1024;
                bf16_t* dst = (bf16_t*)(ws + (which ? NB_AWB : NB_TWB)) + (size_t)rt * 32 * 64;
                sample_gemm32(A, (const bf16_t*)(ws + (which ? NB_A1T : NB_W1T)), 1024, n0, lane,
                              [&](int r, int c, float v) { dst[(size_t)r * 64 + c] = (bf16_t)(pk_bf16(which ? v : tanhf(v), 0.f) & 0xffffu); });
            }
        }
    }
    SEAM(PH_GEMM3);
    if (IN(PH_PREP2)) {
        const int bid = opaque(blockIdx.x), nb = gridDim.x;
        const int lane = opaque_v(threadIdx.x) & 63, wv = __builtin_amdgcn_readfirstlane(threadIdx.x >> 6);
#pragma unroll 1
        for (int task = bid * 8 + wv; task < 513 * 16; task += nb * 8) prep2_task(a, ws, task >> 4, task & 15, lane);
    }
    SEAM(PH_PREP2);
    if (IN(PH_SCAN)) {
        const int bid = opaque(blockIdx.x), nb = gridDim.x;
        for (int item = bid; item < 256; item += nb) scan_prompt(a, ws, lds, item);
        const int lane = opaque_v(threadIdx.x) & 63, wv = __builtin_amdgcn_readfirstlane(threadIdx.x >> 6);
        for (int task = bid * 8 + wv; task < BS * 16; task += nb * 8) scan_sample(a, ws, task >> 4, task & 15, lane);
    }
    SEAM(PH_SCAN);
    if (IN(PH_POST)) { const int bid = opaque(blockIdx.x), nb = gridDim.x; phase_post(a, ws, bid, nb); }
    SEAM(PH_POST);
    if (IN(PH_GEMM4)) {
        const int bid = opaque(blockIdx.x), nb = gridDim.x;
        {
            pg8::Gemm g{(const bf16_t*)(ws + NB_G4B), (const bf16_t*)(ws + NB_WT4), MP, 1024, 1024};
            pg8::StaticOrder S; S.init(MP, 1024, nb, bid);
            EpiPreRes E{(float*)ws + WS_PRE, (const float*)ws + WS_X1};
            pg8::gemm_phase<EpiPreRes, pg8::StaticOrder, false>(lds, g, S, E, nullptr);
        }
        {
            const int lane = threadIdx.x & 63, wv = __builtin_amdgcn_readfirstlane(threadIdx.x >> 6);
            float* PREs = (float*)ws + WS_PRE + (size_t)MP * 1024;
            const float* xs = (const float*)ws + WS_X1 + (size_t)MP * 1024;
            for (int task = bid * 8 + wv; task < 32; task += nb * 8)
                sample_gemm32((const bf16_t*)(ws + NB_G4B) + (size_t)MP * 1024, (const bf16_t*)(ws + NB_WT4), 1024, task * 32, lane,
                              [&](int r, int n, float v) { PREs[(size_t)r * 1024 + n] = fmaf(ALPHA, xs[(size_t)r * 1024 + n], v); });
        }
    }
    SEAM(PH_GEMM4);
    if (IN(PH_LNF)) { const int bid = opaque(blockIdx.x), nb = gridDim.x; phase_lnf(a, ws, bid, nb); }
#undef IN
#undef SEAM
}
}

extern "C" void kernel_launch(void* const* d_in, const int* in_sizes, int n_in, void* d_out, int out_size, void* d_ws, size_t ws_size,
                              hipStream_t stream) {
    if (n_in != N_IN || ws_size < nk::NB_END) { fprintf(stderr, "kernel_launch: unexpected n_in %d or ws_size %zu (need %zu)\n", n_in, ws_size, (size_t)nk::NB_END); return; }
    static int grid = 0;
    if (!grid) {
        int dev = 0, cus = 0, per_cu = 0;
        hipGetDevice(&dev);
        hipDeviceGetAttribute(&cus, hipDeviceAttributeMultiprocessorCount, dev);
        hipFuncSetAttribute((const void*)nk::mega, hipFuncAttributeMaxDynamicSharedMemorySize, nk::LDS_BYTES);
        hipOccupancyMaxActiveBlocksPerMultiprocessor(&per_cu, (const void*)nk::mega, nk::NTH, nk::LDS_BYTES);
        if (per_cu < 1) fprintf(stderr, "kernel_launch: occupancy query says %d blocks per CU\n", per_cu);
        grid = cus;
    }
    hipMemsetAsync((unsigned char*)d_ws + nk::NB_BAR, 0, 32768, stream);
    nk::Args a{};
    for (int i = 0; i < N_IN; ++i) a.in[i] = (const float*)d_in[i];
    a.out = (float*)d_out; a.ws = (unsigned char*)d_ws; a.ph_lo = 0; a.ph_hi = nk::NPHASE;
    void* args[] = {&a};
    hipError_t e = hipLaunchCooperativeKernel((const void*)nk::mega, dim3(grid), dim3(nk::NTH), args, nk::LDS_BYTES, stream);
    if (e != hipSuccess) fprintf(stderr, "cooperative launch failed: %s (grid %d)\n", hipGetErrorString(e), grid);
}
```

```cpp
#include <hip/hip_runtime.h>
#include <hip/hip_cooperative_groups.h>
#include <cstdio>
namespace cg = cooperative_groups;

constexpr int D = 1024, BP = 8, TP = 2048, MP = BP * TP, BS = 32, MT = MP + BS;
constexpr int DIN = 3352;
constexpr int C_AVAL = 0, C_AGLU = 512, C_ZA = 1024, C_Q = 1536, C_KV = 2048, C_G3 = 2816, C_ZB = 2840;
constexpr int C_CMP = C_KV, C_SEL = C_KV + 256, C_WIN = C_KV + 512;
constexpr int PAST = 8192, NPAGE = 64, PAGE = 128;
constexpr float ALPHA = 1.4142135623730951f;
constexpr float LN_EPS = 1e-5f, GN_EPS = 64e-5f;

constexpr size_t O_Y = 0, O_YS = 16777216, O_CMPP = 16809984, O_CMPS = 21004288, O_SELP = 21012480, O_SELS = 25206784,
                 O_WINP = 25214976, O_WINS = 26263552, O_CONVP = 30457856, O_CONVS = 30580736, O_WKVP = 31072256,
                 O_WKVS = 31596544, O_SHP = 33693696, O_SHS = 33701888;

enum { I_XP = 0, I_XS, I_CCMP, I_CSEL, I_CWIN, I_SCONV, I_SWKV, I_SSHIFT, I_PT, I_WIN, I_CONVW, I_CONVB, I_CLNG, I_CLNB,
       I_WKC, I_WVC, I_WOUTE, I_MU, I_WRKVZ, I_W0, I_W1, I_W2, I_A0, I_A1, I_A2, I_KK, I_KA, I_RK, I_GNG, I_GNB, I_WOUTO,
       I_LNG, I_LNB, N_IN };

constexpr size_t SZ_ROWD = (size_t)MT * D;
constexpr size_t WS_H = 0;
constexpr size_t WS_CAT = WS_H + (size_t)MT * DIN;
constexpr size_t WS_OC = WS_CAT + SZ_ROWD;
constexpr size_t WS_XSH = 0;
constexpr size_t WS_Y = 0;
constexpr size_t WS_G4 = SZ_ROWD;
constexpr size_t WS_R0END = 6 * SZ_ROWD;
constexpr size_t WS_PRE = WS_R0END;
constexpr size_t WS_X1 = WS_PRE + SZ_ROWD;
constexpr size_t WS_R = WS_X1 + SZ_ROWD;
constexpr size_t WS_K = WS_R + SZ_ROWD;
constexpr size_t WS_V = WS_K + SZ_ROWD;
constexpr size_t WS_Z = WS_V + SZ_ROWD;
constexpr size_t WS_DEC = WS_Z + SZ_ROWD;
constexpr size_t WS_KKN = WS_DEC + SZ_ROWD;
constexpr size_t WS_KKA = WS_KKN + SZ_ROWD;
constexpr size_t WS_TW = WS_KKA + SZ_ROWD;
constexpr size_t WS_AW = WS_TW + (size_t)MT * 64;
constexpr size_t WS_RK = WS_AW + (size_t)MT * 64;
constexpr size_t WS_END = WS_RK + (size_t)MT * 16;
constexpr size_t WS_PCP = WS_R;
constexpr size_t WS_PCS = WS_R + (size_t)MP * 8 * 64;
constexpr size_t WS_IMP = WS_K;
constexpr size_t WS_SELIDX = WS_V;
constexpr size_t WS_KCP = WS_Z;
constexpr size_t WS_KCS = WS_Z + (size_t)8 * 64 * 256;
static_assert(WS_OC + (size_t)MT * 512 <= WS_R0END, "layer0 temporaries overflow region 0");

namespace pg8 {
#define PG8_LAS __attribute__((address_space(3)))
typedef unsigned short bf16_t;
typedef short bf16x8 __attribute__((ext_vector_type(8)));
typedef float f32x4 __attribute__((ext_vector_type(4)));
typedef unsigned u32x4 __attribute__((ext_vector_type(4)));
constexpr int BM = 256, BK = 64, HALF = 128, HTB = HALF * BK * 2  , STAGE_BYTES = 8 * HTB, NXCD = 8, WGM = 8;

__host__ __device__ __forceinline__ int lds_byte(int r, int c) { const int st = (r >> 4) * 2 + (c >> 5), rr = r & 15, cc = c & 31, ob = rr * 64 + cc * 2; return st * 1024 + (ob ^ (((ob >> 9) & 1) << 5)); }
__host__ __device__ __forceinline__ void stage_rc(int b, int& R, int& C) { const int st = b / 1024, sb = b % 1024, swz = sb ^ (((sb >> 9) & 1) << 5); R = (st >> 1) * 16 + swz / 64; C = (st & 1) * 32 + (swz % 64) / 2; }
__host__ __device__ __forceinline__ int perm32(int rho) { const int n = rho >> 4, i = rho & 15; return 8 * (i >> 2) + 4 * n + (i & 3); }

struct Unit { int pm, pn; };
struct Gemm { const bf16_t* A; const bf16_t* Bt; int M, N, K; };

struct StaticOrder {
    int nM, nN, nwg, G, c;
    __host__ __device__ void init(int M, int N, int G_, int c_) { nM = M / BM; nN = N / BM; nwg = nM * nN; G = G_; c = c_; }
    __host__ __device__ bool next(int i, Unit& u) const {
        const long L = (long)i * G + c; if (L >= nwg) return false;
        int wgid = (int)L; { const int q = nwg / NXCD, r = nwg % NXCD, xcd = wgid % NXCD, off = wgid / NXCD; wgid = (xcd < r ? xcd * (q + 1) : r * (q + 1) + (xcd - r) * q) + off; }
        const int nig = WGM * nN, gid = wgid / nig, fm = gid * WGM, gsz = (nM - fm) < WGM ? (nM - fm) : WGM;
        u.pm = fm + ((wgid % nig) % gsz); u.pn = (wgid % nig) / gsz; return true;
    }
    __device__ __forceinline__ void a_ready(const Unit&) const {}
    __device__ __forceinline__ void done(const Unit&) const {}
};
struct CountedOrder : StaticOrder {
    const unsigned* ready; unsigned need; unsigned* tmo;
    __device__ __forceinline__ void a_ready(const Unit& u) const {
        if (threadIdx.x < 64) {
            const unsigned long long t0 = __builtin_amdgcn_s_memrealtime(); unsigned polls = 0;
            while ((unsigned)__builtin_amdgcn_readfirstlane(__hip_atomic_load(ready + 64 * u.pm, __ATOMIC_RELAXED, __HIP_MEMORY_SCOPE_AGENT)) < need) {
                if ((++polls & 255u) == 0u && __builtin_amdgcn_readfirstlane(__hip_atomic_load(tmo, __ATOMIC_RELAXED, __HIP_MEMORY_SCOPE_AGENT)) != 0u) break;
                if (__builtin_amdgcn_s_memrealtime() - t0 > 2000000ull) {
                    if (threadIdx.x == 0) { unsigned expect = 0u; __hip_atomic_compare_exchange_strong(tmo + 1, &expect, 0x600u | (unsigned)(u.pm & 0xff), __ATOMIC_RELAXED, __ATOMIC_RELAXED, __HIP_MEMORY_SCOPE_AGENT); __hip_atomic_store(tmo, 1u, __ATOMIC_RELAXED, __HIP_MEMORY_SCOPE_AGENT); }
                    break; }
                __builtin_amdgcn_s_sleep(2); }
            __builtin_amdgcn_fence(__ATOMIC_ACQUIRE, "agent");
            asm volatile("s_waitcnt vmcnt(0)" ::: "memory");
        }
#if !defined(BROKEN_HOOK_NO_BARRIER)
        asm volatile("" ::: "memory"); __builtin_amdgcn_s_barrier(); asm volatile("" ::: "memory");
#endif
    }
};


template <class Epi, class Sched, bool STAMP = false>
__device__ __forceinline__ void gemm_phase(PG8_LAS unsigned char* lds, const Gemm g, const Sched& S, const Epi& E, unsigned long long* stamps) {
    int tid_ = threadIdx.x; asm volatile("" : "+v"(tid_));
    const int tid = tid_, wid = __builtin_amdgcn_readfirstlane(tid >> 6), lane = tid & 63, wr = wid >> 2, wc = wid & 3, fr = lane & 15, fq = lane >> 4;
    const int K = g.K, nt = K / BK;
    int ts_lo = 0, ts_hi = 0, nts = 0; const unsigned long long rt_entry = STAMP ? (unsigned long long)wall_clock64() : 0ull;
#define PG8_STAMP() do { if (STAMP && wid == 0 && nts < 64) { const unsigned long long _c = (unsigned long long)clock64(); \
        ts_lo = (lane == nts) ? (int)(unsigned)_c : ts_lo; ts_hi = (lane == nts) ? (int)(unsigned)(_c >> 32) : ts_hi; ++nts; } } while (0)
    PG8_STAMP();
    unsigned voffA[2], voffB[2];
#pragma unroll
    for (int i = 0; i < 2; ++i) { int R, C; stage_rc(tid * 16 + i * 8192, R, C); const int Rb = Epi::PERM ? ((R & ~31) + perm32(R & 31)) : R;
        voffA[i] = (unsigned)(R * K + C) * 2u; voffB[i] = (unsigned)(Rb * K + C) * 2u; }
    const size_t kstep = (size_t)(BK * 2);
    const size_t hstep = (size_t)HALF * K * 2;
    const size_t tstep = 2 * hstep;
    const unsigned ldsw = (unsigned)wid * 1024u;
    const int aoff = lds_byte(wr * 64 + fr, fq * 8), boff = lds_byte(wc * 32 + fr, fq * 8);
#define PG8_SA(b, h) (((b) * 2 + (h)) * HTB)
#define PG8_SB(b, h) ((4 + (b) * 2 + (h)) * HTB)
#define PG8_STAGE(bufoff, gbase, voff) do { _Pragma("unroll") for (int _i = 0; _i < 2; ++_i) \
        __builtin_amdgcn_global_load_lds((const unsigned*)((const char*)(gbase) + (voff)[_i]), (PG8_LAS unsigned*)(lds + (bufoff) + ldsw + _i * 8192), 16, 0, 0); } while (0)
#define PG8_LDA(dst, b, h) do { _Pragma("unroll") for (int m = 0; m < 4; ++m) _Pragma("unroll") for (int k = 0; k < 2; ++k) dst[m][k] = *(const PG8_LAS bf16x8*)(lds + PG8_SA(b, h) + aoff + m * 2048 + k * 1024); } while (0)
#define PG8_LDB(dst, b, h) do { _Pragma("unroll") for (int n = 0; n < 2; ++n) _Pragma("unroll") for (int k = 0; k < 2; ++k) dst[n][k] = *(const PG8_LAS bf16x8*)(lds + PG8_SB(b, h) + boff + n * 2048 + k * 1024); } while (0)
#define PG8_MMA(ai, bj, At, Bt) do { __builtin_amdgcn_s_setprio(1); _Pragma("unroll") for (int m = 0; m < 4; ++m) _Pragma("unroll") for (int n = 0; n < 2; ++n) _Pragma("unroll") for (int k = 0; k < 2; ++k) \
        acc[ai][bj][m][n] = __builtin_amdgcn_mfma_f32_16x16x32_bf16(Bt[n][k], At[m][k], acc[ai][bj][m][n], 0, 0, 0); __builtin_amdgcn_s_setprio(0); } while (0)
#define PG8_WAIT_V(n) asm volatile("s_waitcnt vmcnt(" #n ")" ::: "memory")
#define PG8_WAIT_L(n) asm volatile("s_waitcnt lgkmcnt(" #n ")" ::: "memory")
#define PG8_BAR __builtin_amdgcn_s_barrier()
#define PG8_SCHED __builtin_amdgcn_sched_barrier(0)
    Unit cur, nxt; int ui = 0;
    if (!S.next(0, cur)) return;
    f32x4 acc[2][2][4][2];
#pragma unroll
    for (int a = 0; a < 2; ++a)
#pragma unroll
        for (int b = 0; b < 2; ++b)
#pragma unroll
            for (int m = 0; m < 4; ++m)
#pragma unroll
                for (int n = 0; n < 2; ++n) acc[a][b][m][n] = (f32x4){0.f, 0.f, 0.f, 0.f};
    bf16x8 At[4][2], B0[2][2], B1[2][2];
    const char* cA = (const char*)g.A + (size_t)cur.pm * tstep; const char* cB = (const char*)g.Bt + (size_t)cur.pn * tstep;
    S.a_ready(cur);
    PG8_STAGE(PG8_SB(0, 0), cB, voffB); PG8_STAGE(PG8_SA(0, 0), cA, voffA); PG8_STAGE(PG8_SB(0, 1), cB + hstep, voffB); PG8_STAGE(PG8_SA(0, 1), cA + hstep, voffA);
    if (wr == 1) PG8_BAR;
    PG8_WAIT_V(4); PG8_BAR;
    PG8_STAGE(PG8_SB(1, 0), cB + kstep, voffB); PG8_STAGE(PG8_SA(1, 0), cA + kstep, voffA); PG8_STAGE(PG8_SB(1, 1), cB + hstep + kstep, voffB);
    PG8_WAIT_V(6); PG8_BAR;
    PG8_STAMP();
    for (;;) {
        const bool has_next = S.next(ui + 1, nxt);
        const char* nA = has_next ? (const char*)g.A + (size_t)nxt.pm * tstep : cA; const char* nB = has_next ? (const char*)g.Bt + (size_t)nxt.pn * tstep : cB;
        for (int t = 0; t < nt; t += 2) {
            const bool last = (t == nt - 2);
            const char* a1 = cA + (size_t)(t + 1) * kstep;
            const char* a2 = last ? nA : cA + (size_t)(t + 2) * kstep; const char* b2 = last ? nB : cB + (size_t)(t + 2) * kstep;
            const char* a3 = a2 + kstep; const char* b3 = b2 + kstep;
            if (last && has_next) S.a_ready(nxt);
            PG8_LDB(B0, 0, 0); PG8_SCHED; PG8_LDA(At, 0, 0); PG8_STAGE(PG8_SA(1, 1), a1 + hstep, voffA);
            PG8_WAIT_L(8); PG8_BAR; PG8_WAIT_L(0); PG8_MMA(0, 0, At, B0); PG8_BAR; PG8_SCHED;
            PG8_LDB(B1, 0, 1); PG8_STAGE(PG8_SB(0, 0), b2, voffB);
            PG8_BAR; PG8_WAIT_L(0); PG8_MMA(0, 1, At, B1); PG8_BAR;
            PG8_LDA(At, 0, 1); PG8_STAGE(PG8_SA(0, 0), a2, voffA);
            PG8_BAR; PG8_WAIT_L(0); PG8_MMA(1, 0, At, B0); PG8_BAR; PG8_SCHED;
            PG8_STAGE(PG8_SB(0, 1), b2 + hstep, voffB);
            PG8_WAIT_V(6); PG8_BAR; PG8_MMA(1, 1, At, B1); PG8_BAR;
            PG8_LDB(B0, 1, 0); PG8_SCHED; PG8_LDA(At, 1, 0); PG8_STAGE(PG8_SA(0, 1), a2 + hstep, voffA);
            PG8_WAIT_L(8); PG8_BAR; PG8_WAIT_L(0); PG8_MMA(0, 0, At, B0); PG8_BAR; PG8_SCHED;
            PG8_LDB(B1, 1, 1); PG8_STAGE(PG8_SB(1, 0), b3, voffB);
            PG8_BAR; PG8_WAIT_L(0); PG8_MMA(0, 1, At, B1); PG8_BAR;
            PG8_LDA(At, 1, 1); PG8_STAGE(PG8_SA(1, 0), a3, voffA);
            PG8_BAR; PG8_WAIT_L(0); PG8_MMA(1, 0, At, B0); PG8_BAR; PG8_SCHED;
            PG8_STAGE(PG8_SB(1, 1), b3 + hstep, voffB);
            PG8_WAIT_V(6); PG8_BAR; PG8_MMA(1, 1, At, B1); PG8_BAR;
        }
        PG8_STAMP();
        if constexpr (!Epi::AFTER_DRAIN) { E(acc, cur, wr, wc, fr, fq); S.done(cur); }
        PG8_STAMP();
        if (!has_next) break;
#pragma unroll
        for (int a = 0; a < 2; ++a)
#pragma unroll
            for (int b = 0; b < 2; ++b)
#pragma unroll
                for (int m = 0; m < 4; ++m)
#pragma unroll
                    for (int n = 0; n < 2; ++n) acc[a][b][m][n] = (f32x4){0.f, 0.f, 0.f, 0.f};
        cur = nxt; cA = nA; cB = nB; ++ui;
    }
    PG8_WAIT_V(0);
    if (wr == 0) PG8_BAR;
    PG8_BAR;
    if constexpr (Epi::AFTER_DRAIN) { E.fused(acc, cur, wr, wc, fr, fq, lds, wid, lane); S.done(cur); }
    PG8_STAMP();
    if (STAMP && wid == 0) { stamps[lane] = lane < nts ? (((unsigned long long)(unsigned)ts_hi << 32) | (unsigned)ts_lo) : 0ull;
        if (lane == 62) stamps[62] = rt_entry; if (lane == 63) stamps[63] = (unsigned long long)wall_clock64(); }
#undef PG8_STAMP
#undef PG8_SA
#undef PG8_SB
#undef PG8_STAGE
#undef PG8_LDA
#undef PG8_LDB
#undef PG8_MMA
#undef PG8_WAIT_V
#undef PG8_WAIT_L
#undef PG8_BAR
#undef PG8_SCHED
}
}

#define XB_TMO      128
#define XB_XCNT(j)  (256  + 64 * (j))
#define XB_XSUB(j)  (1280 + 64 * (j))
#define XB_XGEN(j)  (2304 + 64 * (j))
#define XB_TOP      3328
#define XB_TOPGEN   3392
#define XCD_BAR_WORDS 3456
#define XB_SPIN_CAP (1u << 18)
#define LAS __attribute__((address_space(3)))

__device__ __forceinline__ unsigned xb_ld(unsigned* p)              { return __hip_atomic_load(p, __ATOMIC_RELAXED, __HIP_MEMORY_SCOPE_AGENT); }
__device__ __forceinline__ unsigned xb_add(unsigned* p, unsigned v) { return __hip_atomic_fetch_add(p, v, __ATOMIC_RELAXED, __HIP_MEMORY_SCOPE_AGENT); }
__device__ __forceinline__ unsigned xb_xcc_id() { return (unsigned)__builtin_amdgcn_s_getreg((3 << 11) | 20) & 0xFu; }
#define XB_SPIN(cond, bar) do { unsigned _sp = 0; while (cond) { __builtin_amdgcn_s_sleep(1); \
    if ((++_sp & 255u) == 0u) { if (xb_ld(&(bar)[XB_TMO])) break; if (_sp > XB_SPIN_CAP) { atomicAdd(&(bar)[XB_TMO], 1u); break; } } } } while (0)

struct XcdBarrier {
    unsigned* bar; unsigned x;
    volatile LAS unsigned* st;
};

__device__ __forceinline__ XcdBarrier xcd_barrier_post(unsigned* bar, volatile LAS unsigned* st) {
    XcdBarrier b; b.bar = bar; b.x = xb_xcc_id(); b.st = st;
    if (threadIdx.x == 0) (void)xb_add(&bar[XB_XCNT(b.x)], 1u);
    return b;
}
__device__ __forceinline__ void xcd_barrier_complete(unsigned* bar, unsigned x, unsigned& nloc, unsigned& nx) {
    const unsigned G = gridDim.x * gridDim.y * gridDim.z;
    unsigned sum, cnt, mine, sp = 0u;
    for (;;) {
        sum = 0u; cnt = 0u; mine = 0u;
#pragma unroll
        for (unsigned j = 0; j < 16; ++j) { const unsigned c = xb_ld(&bar[XB_XCNT(j)]); sum += c; cnt += (c > 0u) ? 1u : 0u; mine = (j == x) ? c : mine; }
        if (sum == G) break;
        __builtin_amdgcn_s_sleep(1);
        if ((++sp & 255u) == 0u) { if (xb_ld(&bar[XB_TMO])) break; if (sp > XB_SPIN_CAP) { atomicAdd(&bar[XB_TMO], 1u); break; } }
    }
    nloc = mine > 0u ? mine : 1u; nx = cnt > 0u ? cnt : 1u;
}

__device__ __forceinline__ void xcd_barrier(const XcdBarrier& b) {
    asm volatile("s_waitcnt vmcnt(0)" ::: "memory");
    __syncthreads();
    if (threadIdx.x == 0) {
        unsigned* bar = b.bar;
        __builtin_amdgcn_s_waitcnt(0);
        unsigned nloc = b.st[0], nx = b.st[1];
        if (nloc == 0u) { xcd_barrier_complete(bar, b.x, nloc, nx); b.st[0] = nloc; b.st[1] = nx; }
        const unsigned old = xb_add(&bar[XB_XSUB(b.x)], 1u);
        const unsigned gen = old / nloc;
        if (old + 1u == (gen + 1u) * nloc) {
            __builtin_amdgcn_fence(__ATOMIC_RELEASE, "agent");
            asm volatile("s_waitcnt vmcnt(0)" ::: "memory");
            const unsigned og = xb_add(&bar[XB_TOP], 1u);
            const unsigned tg = og / nx;
            if (og + 1u == (tg + 1u) * nx) xb_add(&bar[XB_TOPGEN], 1u);
            else XB_SPIN(xb_ld(&bar[XB_TOPGEN]) == tg, bar);
            __builtin_amdgcn_fence(__ATOMIC_ACQUIRE, "agent");
            xb_add(&bar[XB_XGEN(b.x)], 1u);
            asm volatile("s_waitcnt vmcnt(0)" ::: "memory");
        } else {
            XB_SPIN(xb_ld(&bar[XB_XGEN(b.x)]) == gen, bar);
            __builtin_amdgcn_fence(__ATOMIC_ACQUIRE, "agent");
            asm volatile("s_waitcnt vmcnt(0)" ::: "memory");
        }
    }
    __syncthreads();
}

namespace nk {
using pg8::bf16_t; using pg8::bf16x8; using pg8::f32x4; using pg8::u32x4; using pg8::Unit;
constexpr int NTH = 512;
constexpr int LDS_STAGE = pg8::STAGE_BYTES;
constexpr int LDS_MISC = 158720;
constexpr int LDS_BYTES = LDS_MISC + 1024;

constexpr size_t NB0 = WS_END * 4;
constexpr size_t NB_BAR = NB0;
constexpr size_t NB_WT1 = NB_BAR + 32768;
constexpr size_t NB_WT2 = NB_WT1 + (size_t)3584 * 1024 * 2;
constexpr size_t NB_XB = NB_WT2 + (size_t)1024 * 1024 * 2;
constexpr size_t NB_XSB = NB_XB + (size_t)MP * 1024 * 2;
constexpr size_t NB_HB = NB_XSB + (size_t)BS * 1024 * 2;
constexpr size_t NB_KVB = NB_HB + (size_t)MT * 2560 * 2;
constexpr size_t NB_G3 = NB_KVB + (size_t)MT * 768 * 2;
constexpr size_t NB_CATB = NB_G3 + (size_t)MT * 32 * 4;
constexpr size_t NB_CBUF = NB_CATB + (size_t)MT * 1024 * 2;
constexpr size_t NB_KCB = NB_CBUF + (size_t)MP * 512 * 4;
constexpr size_t NB_WT3 = NB_KCB + (size_t)BP * 64 * 256 * 2;
constexpr size_t NB_WT4 = NB_WT3 + (size_t)4 * 1024 * 1024 * 2;
constexpr size_t NB_W1T = NB_WT4 + (size_t)1024 * 1024 * 2;
constexpr size_t NB_A1T = NB_W1T + (size_t)64 * 1024 * 2;
constexpr size_t NB_W2T = NB_A1T + (size_t)64 * 1024 * 2;
constexpr size_t NB_A2T = NB_W2T + (size_t)64 * 1024 * 2;
constexpr size_t NB_KCS = NB_A2T + (size_t)64 * 1024 * 2;
constexpr size_t NB_OCS = NB_KCS + (size_t)BS * 256 * 256 * 4;
constexpr size_t NB_PARTS = NB_OCS + (size_t)BS * 8 * 64 * 4;
constexpr size_t NB_END = NB_PARTS + (size_t)BS * 8 * 24 * 66 * 4;
constexpr size_t NB_XSH = 0;
constexpr size_t NB_RKVZ = NB_XSH + (size_t)6 * 16640 * 1024 * 2;
constexpr size_t NB_TWB = NB_RKVZ + (size_t)4 * 16640 * 1024 * 2;
constexpr size_t NB_AWB = NB_TWB + (size_t)MT * 64 * 2;
constexpr size_t NB_RKS = NB_AWB + (size_t)MT * 64 * 2;
static_assert(NB_RKS + (size_t)MT * 16 * 4 <= WS_PRE * 4, "layer-1 region A overflows into PRE");
constexpr size_t NB_DEC = (WS_X1 + SZ_ROWD) * 4;
constexpr size_t NB_KKN = NB_DEC + (size_t)MT * 1024 * 4;
constexpr size_t NB_KKA = NB_KKN + (size_t)MT * 1024 * 2;
constexpr size_t NB_KP = NB_KKA + (size_t)MT * 1024 * 2;
constexpr size_t NB_Y = NB_KP + (size_t)MT * 1024 * 2;
constexpr size_t NB_G4B = NB_Y + (size_t)MT * 1024 * 4;
constexpr size_t NB_CHK = NB_G4B + (size_t)MT * 1024 * 2;
static_assert(NB_CHK + (size_t)4096 * 49152 <= NB0, "layer-1 region B overflows");
constexpr int N1PAD = 3584;
__host__ __device__ __forceinline__ int win_src_col(int n) { return n < 2048 ? n : (n < 2560 ? C_ZB + (n - 2048) : (n < 3328 ? C_KV + (n - 2560) : (n < 3352 ? C_G3 + (n - 3328) : -1))); }

__device__ __forceinline__ int opaque(int x) { asm volatile("" : "+s"(x)); return x; }
__device__ __forceinline__ int opaque_v(int x) { asm volatile("" : "+v"(x)); return x; }
struct Args { const float* in[N_IN]; float* out; unsigned char* ws; int ph_lo, ph_hi; };

__device__ __forceinline__ unsigned pk_bf16(float lo, float hi) { unsigned r; asm volatile("v_cvt_pk_bf16_f32 %0, %1, %2" : "=v"(r) : "v"(lo), "v"(hi)); return r; }
typedef __bf16 bf16x2_t __attribute__((ext_vector_type(2)));
__device__ __forceinline__ unsigned pk_bf16c(float lo, float hi) { bf16x2_t v; v[0] = (__bf16)lo; v[1] = (__bf16)hi; return __builtin_bit_cast(unsigned, v); }

template <class MAP>
__device__ __forceinline__ void convert_wt(const float* __restrict__ W, int K, int ldw, bf16_t* __restrict__ Wt, int Npad, MAP map, int bid, int nb) {
    const int kg = K / 8;
    const size_t total = (size_t)Npad * kg;
    for (size_t i = (size_t)bid * NTH + threadIdx.x; i < total; i += (size_t)nb * NTH) {
        const int n = (int)(i % Npad), k0 = (int)(i / Npad) * 8;
        const int sc = map(n);
        u32x4 w = {0u, 0u, 0u, 0u};
        if (sc >= 0) {
            float v[8];
#pragma unroll
            for (int j = 0; j < 8; ++j) v[j] = W[(size_t)(k0 + j) * ldw + sc];
            w.x = pk_bf16(v[0], v[1]); w.y = pk_bf16(v[2], v[3]); w.z = pk_bf16(v[4], v[5]); w.w = pk_bf16(v[6], v[7]);
        }
        *(u32x4*)(Wt + (size_t)n * K + k0) = w;
    }
}
struct MapId { __device__ __forceinline__ int operator()(int n) const { return n; } };
struct MapWin { __device__ __forceinline__ int operator()(int n) const { return win_src_col(n); } };
__device__ __forceinline__ void convert_rows(const float* __restrict__ src, size_t n8, bf16_t* __restrict__ dst, int bid, int nb) {
#pragma unroll 4
    for (size_t i = (size_t)bid * NTH + threadIdx.x; i < n8; i += (size_t)nb * NTH) {
        const float4 a = *(const float4*)(src + i * 8), b = *(const float4*)(src + i * 8 + 4);
        u32x4 w; w.x = pk_bf16(a.x, a.y); w.y = pk_bf16(a.z, a.w); w.z = pk_bf16(b.x, b.y); w.w = pk_bf16(b.z, b.w);
        *(u32x4*)(dst + i * 8) = w;
    }
}

struct EpiPre {
    static constexpr bool PERM = false, AFTER_DRAIN = false;
    float* C; int ldc;
    __device__ __forceinline__ void operator()(const f32x4 (&acc)[2][2][4][2], const Unit& u, int wr, int wc, int fr, int fq) const {
        const int row0 = u.pm * 256 + wr * 64 + fr, col0 = u.pn * 256 + wc * 32 + 4 * fq;
#pragma unroll
        for (int ai = 0; ai < 2; ++ai)
#pragma unroll
            for (int m = 0; m < 4; ++m) { float* rowp = C + (size_t)(row0 + ai * 128 + m * 16) * ldc + col0;
#pragma unroll
                for (int bj = 0; bj < 2; ++bj)
#pragma unroll
                    for (int n = 0; n < 2; ++n) *(f32x4*)(rowp + bj * 128 + n * 16) = acc[ai][bj][m][n]; }
    }
};


struct Route1 {
    bf16_t* HB; bf16_t* KVB; float* G3; float* out;
    __device__ __forceinline__ void put8(int row, int n0, const f32x4& v0, const f32x4& v1) const {
        if (n0 < 2560) {
            const float sc = (n0 >= 1536 && n0 < 2048) ? 0.125f : 1.0f;
            u32x4 w; w.x = pk_bf16c(v0[0] * sc, v0[1] * sc); w.y = pk_bf16c(v0[2] * sc, v0[3] * sc); w.z = pk_bf16c(v1[0] * sc, v1[1] * sc); w.w = pk_bf16c(v1[2] * sc, v1[3] * sc);
            *(u32x4*)(HB + (size_t)row * 2560 + n0) = w;
        } else if (n0 < 3328) {
            const int c = n0 - 2560, i3 = c >> 8, cc = c & 255;
            u32x4 w; w.x = pk_bf16c(v0[0], v0[1]); w.y = pk_bf16c(v0[2], v0[3]); w.z = pk_bf16c(v1[0], v1[1]); w.w = pk_bf16c(v1[2], v1[3]);
            *(u32x4*)(KVB + (size_t)row * 768 + c) = w;
            float* dst = nullptr;
            if (row < MP) {
                if (i3 == 0) dst = out + O_CMPP + (size_t)row * 256 + cc;
                else if (i3 == 1) dst = out + O_SELP + (size_t)row * 256 + cc;
                else { const int b = row >> 11, t = row & 2047; if (t >= TP - 512) dst = out + O_WINP + (size_t)(b * 512 + t - (TP - 512)) * 256 + cc; }
            } else {
                const int sidx = row - MP;
                if (i3 == 0) dst = out + O_CMPS + (size_t)sidx * 256 + cc;
                else if (i3 == 1) dst = out + O_SELS + (size_t)sidx * 256 + cc;
                else dst = out + O_WINS + (size_t)(sidx * 512 + 511) * 256 + cc;
            }
            if (dst) { *(f32x4*)dst = v0; *(f32x4*)(dst + 4) = v1; }
        } else if (n0 < 3352) {
            float* dst = G3 + (size_t)row * 32 + (n0 - 3328);
            *(f32x4*)dst = v0; *(f32x4*)(dst + 4) = v1;
        }
    }
};
struct Epi1 {
    static constexpr bool PERM = true, AFTER_DRAIN = false;
    Route1 R;
    __device__ __forceinline__ void operator()(const f32x4 (&acc)[2][2][4][2], const Unit& u, int wr, int wc, int fr, int fq) const {
        const int row0 = u.pm * 256 + wr * 64 + fr, col0 = u.pn * 256 + wc * 32 + 8 * fq;
#pragma unroll
        for (int ai = 0; ai < 2; ++ai)
#pragma unroll
            for (int m = 0; m < 4; ++m)
#pragma unroll
                for (int bj = 0; bj < 2; ++bj) R.put8(row0 + ai * 128 + m * 16, col0 + bj * 128, acc[ai][bj][m][0], acc[ai][bj][m][1]);
    }
};

typedef float f32x16 __attribute__((ext_vector_type(16)));
template <class EMIT>
__device__ __forceinline__ void sample_gemm32(const bf16_t* __restrict__ A, const bf16_t* __restrict__ Bt, int K, int n0, int lane, EMIT emit) {
    const bf16_t* ap = A + (size_t)(lane & 31) * K + 8 * (lane >> 5);
    const bf16_t* bp = Bt + (size_t)(n0 + (lane & 31)) * K + 8 * (lane >> 5);
    f32x16 acc;
#pragma unroll
    for (int i = 0; i < 16; ++i) acc[i] = 0.f;
#pragma unroll 16
    for (int k = 0; k < K; k += 16) {
        const bf16x8 av = *(const bf16x8*)(ap + k), bv = *(const bf16x8*)(bp + k);
        acc = __builtin_amdgcn_mfma_f32_32x32x16_bf16(av, bv, acc, 0, 0, 0);
    }
#pragma unroll
    for (int r = 0; r < 16; ++r) emit((r & 3) + 8 * (r >> 2) + 4 * (lane >> 5), n0 + (lane & 31), acc[r]);
}

template <class EMIT>
__device__ __forceinline__ void sample_gemm32_wg(const bf16_t* __restrict__ A, const bf16_t* __restrict__ Bt, int K, int n0, PG8_LAS unsigned char* lds, EMIT emit) {
    const int tid = opaque_v(threadIdx.x), lane = tid & 63, wv = tid >> 6;
    const int kq = K / 8;
    const bf16_t* ap = A + (size_t)(lane & 31) * K + 8 * (lane >> 5) + wv * kq;
    const bf16_t* bp = Bt + (size_t)(n0 + (lane & 31)) * K + 8 * (lane >> 5) + wv * kq;
    f32x16 acc;
#pragma unroll
    for (int i = 0; i < 16; ++i) acc[i] = 0.f;
#pragma unroll 8
    for (int k = 0; k < kq; k += 16) {
        const bf16x8 av = *(const bf16x8*)(ap + k), bv = *(const bf16x8*)(bp + k);
        acc = __builtin_amdgcn_mfma_f32_32x32x16_bf16(av, bv, acc, 0, 0, 0);
    }
    PG8_LAS float* P = (PG8_LAS float*)lds;
#pragma unroll
    for (int q = 0; q < 4; ++q) *(PG8_LAS f32x4*)(P + (wv * 64 + lane) * 16 + q * 4) = (f32x4){acc[4 * q], acc[4 * q + 1], acc[4 * q + 2], acc[4 * q + 3]};
    __syncthreads();
    if (wv == 0) {
#pragma unroll
        for (int w = 1; w < 8; ++w)
#pragma unroll
            for (int q = 0; q < 4; ++q) { const f32x4 v = *(const PG8_LAS f32x4*)(P + (w * 64 + lane) * 16 + q * 4); acc[4 * q] += v[0]; acc[4 * q + 1] += v[1]; acc[4 * q + 2] += v[2]; acc[4 * q + 3] += v[3]; }
#pragma unroll
        for (int r = 0; r < 16; ++r) emit((r & 3) + 8 * (r >> 2) + 4 * (lane >> 5), n0 + (lane & 31), acc[r]);
    }
    __syncthreads();
}

typedef float f32x16 __attribute__((ext_vector_type(16)));
__device__ __forceinline__ float bf2f(bf16_t v) { return __uint_as_float((unsigned)v << 16); }
__device__ __forceinline__ float sigm_f(float x) { return 1.f / (1.f + __expf(-x)); }
__device__ __forceinline__ float silu_f(float x) { return x / (1.f + __expf(-x)); }

__device__ __forceinline__ void conv_item(const Args& a, unsigned char* ws, PG8_LAS unsigned char* lds, int item) {
    const int tid = opaque_v(threadIdx.x);
    const int b = item >> 5, t0 = (item & 31) * 64;
    const bf16_t* HB = (const bf16_t*)(ws + NB_HB);
    float* CB = (float*)(ws + NB_CBUF);
    PG8_LAS float* U = (PG8_LAS float*)lds;
    const int chl = tid & 255, tp = tid >> 8;
    for (int half = 0; half < 2; ++half) {
        const int chb = half * 256;
#pragma unroll
        for (int it = 0; it < 6; ++it) {
            const int vi = tid + it * NTH;
            if (vi < 94 * 32) {
                const int r = vi >> 5, c8 = (vi & 31) * 8, t = t0 - 30 + r;
                float u[8];
                if (t >= 0) {
                    const bf16_t* h = HB + (size_t)(b * TP + t) * 2560 + chb + c8;
                    const u32x4 av = *(const u32x4*)h, gv = *(const u32x4*)(h + 512);
#pragma unroll
                    for (int i = 0; i < 8; ++i) {
                        const float x = __uint_as_float((i & 1) ? (av[i >> 1] & 0xffff0000u) : (av[i >> 1] << 16));
                        const float g = __uint_as_float((i & 1) ? (gv[i >> 1] & 0xffff0000u) : (gv[i >> 1] << 16));
                        u[i] = x * sigm_f(g);
                    }
                } else {
#pragma unroll
                    for (int i = 0; i < 8; ++i) u[i] = 0.f;
                }
                *(PG8_LAS f32x4*)(U + r * 256 + c8) = (f32x4){u[0], u[1], u[2], u[3]};
                *(PG8_LAS f32x4*)(U + r * 256 + c8 + 4) = (f32x4){u[4], u[5], u[6], u[7]};
                if (t >= TP - 30) {
                    float* o = a.out + O_CONVP + (size_t)(b * 30 + t - (TP - 30)) * 512 + chb + c8;
                    *(float4*)o = make_float4(u[0], u[1], u[2], u[3]); *(float4*)(o + 4) = make_float4(u[4], u[5], u[6], u[7]);
                }
            }
        }
        __syncthreads();
        {
            const int ch = chb + chl;
            float w[31];
#pragma unroll
            for (int j = 0; j < 31; ++j) w[j] = a.in[I_CONVW][j * 512 + ch];
            const float bias = a.in[I_CONVB][ch];
#pragma unroll 4
            for (int k = 0; k < 32; ++k) {
                const int tt = tp * 32 + k;
                float acc = bias;
#pragma unroll
                for (int j = 0; j < 31; ++j) acc = fmaf(w[j], U[(tt + j) * 256 + chl], acc);
                CB[(size_t)(b * TP + t0 + tt) * 512 + ch] = acc;
            }
        }
        __syncthreads();
    }
    {
        const int lane = tid & 63, wv = tid >> 6;
        const float4 g0 = *(const float4*)(a.in[I_CLNG] + lane * 8), g1 = *(const float4*)(a.in[I_CLNG] + lane * 8 + 4);
        const float4 b0 = *(const float4*)(a.in[I_CLNB] + lane * 8), b1 = *(const float4*)(a.in[I_CLNB] + lane * 8 + 4);
        const float gg[8] = {g0.x, g0.y, g0.z, g0.w, g1.x, g1.y, g1.z, g1.w}, bb[8] = {b0.x, b0.y, b0.z, b0.w, b1.x, b1.y, b1.z, b1.w};
        for (int k = 0; k < 8; ++k) {
            const size_t row = (size_t)(b * TP + t0 + wv * 8 + k);
            const float4 c0 = *(const float4*)(CB + row * 512 + lane * 8), c1 = *(const float4*)(CB + row * 512 + lane * 8 + 4);
            float c[8] = {c0.x, c0.y, c0.z, c0.w, c1.x, c1.y, c1.z, c1.w};
            float sm = 0.f;
#pragma unroll
            for (int i = 0; i < 8; ++i) sm += c[i];
#pragma unroll
            for (int o = 32; o > 0; o >>= 1) sm += __shfl_xor(sm, o);
            const float mean = sm * (1.f / 512.f);
            float sq = 0.f;
#pragma unroll
            for (int i = 0; i < 8; ++i) { c[i] -= mean; sq += c[i] * c[i]; }
#pragma unroll
            for (int o = 32; o > 0; o >>= 1) sq += __shfl_xor(sq, o);
            const float rs = rsqrtf(sq * (1.f / 512.f) + LN_EPS);
            const u32x4 zv = *(const u32x4*)(HB + row * 2560 + 1024 + lane * 8);
            float y[8];
#pragma unroll
            for (int i = 0; i < 8; ++i) {
                const float z = __uint_as_float((i & 1) ? (zv[i >> 1] & 0xffff0000u) : (zv[i >> 1] << 16));
                y[i] = silu_f(c[i] * rs * gg[i] + bb[i]) * silu_f(z);
            }
            u32x4 o; o.x = pk_bf16(y[0], y[1]); o.y = pk_bf16(y[2], y[3]); o.z = pk_bf16(y[4], y[5]); o.w = pk_bf16(y[6], y[7]);
            *(u32x4*)((bf16_t*)(ws + NB_CATB) + row * 1024 + lane * 8) = o;
        }
    }
    __syncthreads();
}

__device__ __forceinline__ void pool_prompt(const Args& a, unsigned char* ws, int bid, int nb) {
    bf16_t* KCB = (bf16_t*)(ws + NB_KCB);
    for (int i = bid * NTH + threadIdx.x; i < BP * 64 * 256; i += nb * NTH) {
        const int c = i & 255, n = (i >> 8) & 63, b = i >> 14;
        const int kv = c >> 7, g = (c >> 6) & 1;
        const float* w = kv ? a.in[I_WVC] : a.in[I_WKC];
        const float* src = a.out + O_CMPP + (size_t)(b * TP + n * 32) * 256 + c;
        float acc = 0.f;
#pragma unroll 8
        for (int l = 0; l < 32; ++l) acc = fmaf(src[(size_t)l * 256], w[l * 2 + g], acc);
        KCB[i] = (bf16_t)(pk_bf16(acc, 0.f) & 0xffffu);
    }
}

constexpr int A_KT = 0;
constexpr int A_VT = 18432;
constexpr int A_IMPH = 35840;
constexpr int A_IMPS = 68608;
constexpr int A_MASK = 76800;
constexpr float LOG2E = 1.4426950408889634f;

struct KvSrc { const bf16_t* k; const bf16_t* v; int rstride; };

__device__ __forceinline__ void kv_issue(const KvSrc& s, int tid, u32x4& kr, u32x4& vr) {
    const int key = tid >> 3, c8 = tid & 7;
    kr = *(const u32x4*)(s.k + (size_t)key * s.rstride + c8 * 8);
    vr = *(const u32x4*)(s.v + (size_t)key * s.rstride + c8 * 8);
}
__device__ __forceinline__ void kv_write(PG8_LAS unsigned char* lds, int buf, int tid, const u32x4& kr, const u32x4& vr) {
    const int key = tid >> 3, c8 = tid & 7;
    *(PG8_LAS u32x4*)(lds + A_KT + buf * 9216 + key * 144 + c8 * 16) = kr;
    PG8_LAS bf16_t* vt = (PG8_LAS bf16_t*)(lds + A_VT + buf * 8704);
#pragma unroll
    for (int i = 0; i < 4; ++i) { vt[(c8 * 8 + 2 * i) * 68 + key] = (bf16_t)(vr[i] & 0xffffu); vt[(c8 * 8 + 2 * i + 1) * 68 + key] = (bf16_t)(vr[i] >> 16); }
}

__device__ __forceinline__ void attn_block(const int MODE, PG8_LAS unsigned char* lds, int buf, const bf16x8 (&qf)[4], int lane, float kslope, float base, int kmax, int kmin,
                                           float& m, float& l, f32x16 (&o)[2], f32x16 (&x)[2]) {
    const int lr = lane & 31, h = lane >> 5;
    const PG8_LAS unsigned char* kt_p = lds + A_KT + buf * 9216 + lr * 144 + h * 16;
#pragma unroll
    for (int kt = 0; kt < 2; ++kt) {
#pragma unroll
        for (int i = 0; i < 16; ++i) x[kt][i] = 0.f;
#pragma unroll
        for (int s = 0; s < 4; ++s) {
            const bf16x8 kf = *(const PG8_LAS bf16x8*)(kt_p + kt * 32 * 144 + s * 32);
            x[kt] = __builtin_amdgcn_mfma_f32_32x32x16_bf16(kf, qf[s], x[kt], 0, 0, 0);
        }
    }
    const float bh = base + kslope * (float)(4 * h);
    float mx = -INFINITY;
#pragma unroll
    for (int kt = 0; kt < 2; ++kt)
#pragma unroll
        for (int i = 0; i < 16; ++i) {
            const int kc = kt * 32 + (i & 3) + 8 * (i >> 2);
            x[kt][i] = fmaf(x[kt][i], LOG2E, fmaf(kslope, (float)kc, bh));
        }
    if (MODE) {
        const int hi = kmax - 4 * h, lo = kmin - 4 * h;
#pragma unroll
        for (int kt = 0; kt < 2; ++kt)
#pragma unroll
            for (int i = 0; i < 16; ++i) {
                const int kc = kt * 32 + (i & 3) + 8 * (i >> 2);
                x[kt][i] = (kc > hi || kc < lo) ? -INFINITY : x[kt][i];
            }
    }
#pragma unroll
    for (int kt = 0; kt < 2; ++kt)
#pragma unroll
        for (int i = 0; i < 16; ++i) mx = fmaxf(mx, x[kt][i]);
    mx = fmaxf(mx, __shfl_xor(mx, 32));
    const float mn = fmaxf(m, mx);
    const float corr = __builtin_amdgcn_exp2f(m - mn);
    m = mn;
    float ls = 0.f;
#pragma unroll
    for (int kt = 0; kt < 2; ++kt)
#pragma unroll
        for (int i = 0; i < 16; ++i) { const float pv = __builtin_amdgcn_exp2f(x[kt][i] - mn); x[kt][i] = pv; ls += pv; }
    l = fmaf(l, corr, ls);
#pragma unroll
    for (int dt = 0; dt < 2; ++dt)
#pragma unroll
        for (int i = 0; i < 16; ++i) o[dt][i] *= corr;
    const PG8_LAS unsigned char* vt_p = lds + A_VT + buf * 8704 + lr * 136 + h * 8;
#pragma unroll
    for (int kt = 0; kt < 2; ++kt)
#pragma unroll
        for (int s = 0; s < 2; ++s) {
            u32x4 pw; pw.x = pk_bf16(x[kt][8 * s + 0], x[kt][8 * s + 1]); pw.y = pk_bf16(x[kt][8 * s + 2], x[kt][8 * s + 3]);
            pw.z = pk_bf16(x[kt][8 * s + 4], x[kt][8 * s + 5]); pw.w = pk_bf16(x[kt][8 * s + 6], x[kt][8 * s + 7]);
            const bf16x8 pf = __builtin_bit_cast(bf16x8, pw);
#pragma unroll
            for (int dt = 0; dt < 2; ++dt) {
                const PG8_LAS unsigned char* vp = vt_p + dt * 32 * 136 + (kt * 32 + s * 16) * 2;
                typedef unsigned u32x2 __attribute__((ext_vector_type(2)));
                const u32x2 v0 = *(const PG8_LAS u32x2*)vp, v1 = *(const PG8_LAS u32x2*)(vp + 16);
                u32x4 vw; vw.x = v0.x; vw.y = v0.y; vw.z = v1.x; vw.w = v1.y;
                o[dt] = __builtin_amdgcn_mfma_f32_32x32x16_bf16(__builtin_bit_cast(bf16x8, vw), pf, o[dt], 0, 0, 0);
            }
        }
}

__device__ __forceinline__ void attn_item(const Args& a, unsigned char* ws, PG8_LAS unsigned char* lds, int b, int g, int qb) {
    const int tid = opaque_v(threadIdx.x), lane = tid & 63, wv = __builtin_amdgcn_readfirstlane(tid >> 6);
    const int lr = lane & 31, h = lane >> 5;
    const int r = wv >> 1, th = wv & 1, hh = g * 4 + r;
    const int t0 = qb * 64, tb = qb;
    const int qloc = th * 32 + lr;
    const int qpos = t0 + qloc;
    const size_t qrow = (size_t)b * TP + qpos;
    const bf16_t* HB = (const bf16_t*)(ws + NB_HB);
    const bf16_t* KVB = (const bf16_t*)(ws + NB_KVB);
    const float slope2 = __builtin_amdgcn_exp2f(-(float)(hh + 1)) * LOG2E;
    bf16x8 qf[4];
#pragma unroll
    for (int s = 0; s < 4; ++s) qf[s] = *(const bf16x8*)(HB + qrow * 2560 + 1536 + hh * 64 + s * 16 + h * 8);
    const float* g3p = (const float*)(ws + NB_G3) + qrow * 32 + hh * 3;
    const float gc = sigm_f(g3p[0]), gs = sigm_f(g3p[1]), gw = sigm_f(g3p[2]);
    f32x16 res[2], o[2], x[2];
#pragma unroll
    for (int dt = 0; dt < 2; ++dt)
#pragma unroll
        for (int i = 0; i < 16; ++i) { res[dt][i] = 0.f; o[dt][i] = 0.f; }
    float m = -1e30f, l = 0.f;
    u32x4 kr, vr;
    PG8_LAS float* IMPH = (PG8_LAS float*)(lds + A_IMPH);
    PG8_LAS float* IMPS = (PG8_LAS float*)(lds + A_IMPS);
    PG8_LAS unsigned* MASK = (PG8_LAS unsigned*)(lds + A_MASK);

    {
        const bf16_t* kc = (const bf16_t*)(ws + NB_KCB) + (size_t)b * 64 * 256 + g * 64;
        KvSrc s{kc, kc + 128, 256};
        kv_issue(s, tid, kr, vr); kv_write(lds, 0, tid, kr, vr);
        if (tid < 64) MASK[tid] = 0u;
        __syncthreads();
        const int nmax = (qpos >= 31) ? ((qpos - 31) >> 5) : -1;
        attn_block(1, lds, 0, qf, lane, slope2 * 32.f, slope2 * (float)(31 - qpos), nmax, 0, m, l, o, x);
        const float lt = l + __shfl_xor(l, 32);
        const float inv = (nmax >= 0) ? 1.f / lt : 0.f;
        const float sc = gc * inv;
#pragma unroll
        for (int dt = 0; dt < 2; ++dt)
#pragma unroll
            for (int i = 0; i < 16; ++i) { res[dt][i] = o[dt][i] * sc; o[dt][i] = 0.f; }
        if (tb >= 16) {
#pragma unroll
            for (int kt = 0; kt < 2; ++kt)
#pragma unroll
                for (int c = 0; c < 4; ++c)
#pragma unroll
                    for (int e = 0; e < 2; ++e)
                        IMPH[(r * 64 + qloc) * 32 + kt * 16 + 4 * c + 2 * h + e] = (nmax >= 0) ? (x[kt][4 * c + 2 * e] + x[kt][4 * c + 2 * e + 1]) * inv : 0.f;
        }
        m = -1e30f; l = 0.f;
        __syncthreads();
    }
    if (tb >= 16) {
        const int tq = opaque_v(tid);
        const int q = tq >> 3, jq = tq & 7;
        float v4[4];
#pragma unroll
        for (int e = 0; e < 4; ++e) {
            const int j = jq * 4 + e;
            float v = IMPH[(0 * 64 + q) * 32 + j] + IMPH[(1 * 64 + q) * 32 + j] + IMPH[(2 * 64 + q) * 32 + j] + IMPH[(3 * 64 + q) * 32 + j];
            if (j == 0 || j == tb || j == tb - 1) v = 1e4f;
            IMPS[q * 32 + j] = v; v4[e] = v;
        }
        __syncthreads();
        unsigned bits = 0u;
#pragma unroll
        for (int e = 0; e < 4; ++e) {
            const int j = jq * 4 + e;
            int rank = 0;
            for (int i = 0; i <= tb; ++i) { const float vi = IMPS[q * 32 + i]; rank += (vi > v4[e] || (vi == v4[e] && i < j)) ? 1 : 0; }
            if (j <= tb && rank < 16) bits |= 1u << j;
        }
        if (bits) atomicOr((unsigned*)&MASK[q], bits);
    } else {
        if (tid < 64) MASK[tid] = (2u << tb) - 1u;
    }
    __syncthreads();
    const unsigned selmask = MASK[qloc];

    {
        const bf16_t* kb = KVB + (size_t)b * TP * 768 + 256 + g * 64;
        { KvSrc s{kb, kb + 128, 768}; kv_issue(s, tid, kr, vr); kv_write(lds, 0, tid, kr, vr); }
        __syncthreads();
        for (int j = 0; j <= tb; ++j) {
            if (j < tb) { KvSrc s{kb + (size_t)(j + 1) * 64 * 768, kb + (size_t)(j + 1) * 64 * 768 + 128, 768}; kv_issue(s, tid, kr, vr); }
            const float base = ((selmask >> j) & 1u) ? slope2 * (float)(j * 64 - qpos) : -INFINITY;
            attn_block(j == tb, lds, j & 1, qf, lane, slope2, base, qloc, 0, m, l, o, x);
            if (j < tb) kv_write(lds, (j + 1) & 1, tid, kr, vr);
            __syncthreads();
        }
        const float lt = l + __shfl_xor(l, 32);
        const float sc = gs / lt;
#pragma unroll
        for (int dt = 0; dt < 2; ++dt)
#pragma unroll
            for (int i = 0; i < 16; ++i) { res[dt][i] = fmaf(o[dt][i], sc, res[dt][i]); o[dt][i] = 0.f; }
        m = -1e30f; l = 0.f;
    }
    {
        const int jlo = (tb >= 8) ? tb - 8 : 0;
        const bf16_t* kb = KVB + (size_t)b * TP * 768 + 512 + g * 64;
        { KvSrc s{kb + (size_t)jlo * 64 * 768, kb + (size_t)jlo * 64 * 768 + 128, 768}; kv_issue(s, tid, kr, vr); kv_write(lds, 0, tid, kr, vr); }
        __syncthreads();
        for (int j = jlo; j <= tb; ++j) {
            const int bi = (j - jlo) & 1;
            if (j < tb) { KvSrc s{kb + (size_t)(j + 1) * 64 * 768, kb + (size_t)(j + 1) * 64 * 768 + 128, 768}; kv_issue(s, tid, kr, vr); }
            const float base = slope2 * (float)(j * 64 - qpos);
            attn_block((j == tb) || (j == tb - 8), lds, bi, qf, lane, slope2, base, (j == tb) ? qloc : 64, (j == tb - 8) ? qpos - 511 - j * 64 : 0, m, l, o, x);
            if (j < tb) kv_write(lds, bi ^ 1, tid, kr, vr);
            __syncthreads();
        }
        const float lt = l + __shfl_xor(l, 32);
        const float sc = gw / lt;
#pragma unroll
        for (int dt = 0; dt < 2; ++dt)
#pragma unroll
            for (int i = 0; i < 16; ++i) res[dt][i] = fmaf(o[dt][i], sc, res[dt][i]);
    }
    {
        const size_t qrow2 = (size_t)b * TP + t0 + th * 32 + (opaque_v(lane) & 31);
        const bf16_t* zb = HB + qrow2 * 2560 + 2048 + hh * 64;
        bf16_t* dst = (bf16_t*)(ws + NB_CATB) + qrow2 * 1024 + 512 + hh * 64;
        typedef unsigned u32x2 __attribute__((ext_vector_type(2)));
#pragma unroll
        for (int dt = 0; dt < 2; ++dt)
#pragma unroll
            for (int c = 0; c < 4; ++c) {
                const int d = dt * 32 + 8 * c + 4 * h;
                const u32x2 zv = *(const u32x2*)(zb + d);
                const float z0 = __uint_as_float(zv.x << 16), z1 = __uint_as_float(zv.x & 0xffff0000u), z2 = __uint_as_float(zv.y << 16), z3 = __uint_as_float(zv.y & 0xffff0000u);
                u32x2 w; w.x = pk_bf16(res[dt][4 * c + 0] * silu_f(z0), res[dt][4 * c + 1] * silu_f(z1)); w.y = pk_bf16(res[dt][4 * c + 2] * silu_f(z2), res[dt][4 * c + 3] * silu_f(z3));
                *(u32x2*)(dst + d) = w;
            }
    }
}

constexpr int XSH_ROWS = 16640;
__device__ __forceinline__ float wave_sum(float v) {
#pragma unroll
    for (int o = 32; o > 0; o >>= 1) v += __shfl_xor(v, o);
    return v;
}
__device__ __forceinline__ void ld_row16(const float* __restrict__ src, int lane, float (&x)[16]) {
#pragma unroll
    for (int q = 0; q < 4; ++q) { const float4 v = *(const float4*)(src + lane * 16 + q * 4); x[4 * q] = v.x; x[4 * q + 1] = v.y; x[4 * q + 2] = v.z; x[4 * q + 3] = v.w; }
}
__device__ __forceinline__ void ln_calc16(const float* __restrict__ g, const float* __restrict__ bta, int lane, float (&x)[16]) {
    float sm = 0.f;
#pragma unroll
    for (int i = 0; i < 16; ++i) sm += x[i];
    const float mean = wave_sum(sm) * (1.f / 1024.f);
    float sq = 0.f;
#pragma unroll
    for (int i = 0; i < 16; ++i) { x[i] -= mean; sq += x[i] * x[i]; }
    const float rs = rsqrtf(wave_sum(sq) * (1.f / 1024.f) + LN_EPS);
#pragma unroll
    for (int q = 0; q < 4; ++q) {
        const float4 gv = *(const float4*)(g + lane * 16 + q * 4), bv = *(const float4*)(bta + lane * 16 + q * 4);
        x[4 * q] = x[4 * q] * rs * gv.x + bv.x; x[4 * q + 1] = x[4 * q + 1] * rs * gv.y + bv.y; x[4 * q + 2] = x[4 * q + 2] * rs * gv.z + bv.z; x[4 * q + 3] = x[4 * q + 3] * rs * gv.w + bv.w;
    }
}
__device__ __forceinline__ void ln_row16(const float* __restrict__ src, const float* __restrict__ g, const float* __restrict__ bta, int lane, float (&x)[16]) {
    ld_row16(src, lane, x); ln_calc16(g, bta, lane, x);
}
__device__ __forceinline__ void store_x1_xsh(const Args& a, unsigned char* ws, size_t row, size_t xrow, int lane, const float (&cur)[16], const float (&prev)[16]) {
#pragma unroll 1
    for (int n = 0; n < 6; ++n) {
        const float* mu = a.in[I_MU] + n * 1024 + lane * 16;
        float y[16];
#pragma unroll
        for (int q = 0; q < 4; ++q) { const float4 m4 = *(const float4*)(mu + q * 4);
            y[4 * q] = fmaf(prev[4 * q] - cur[4 * q], m4.x, cur[4 * q]); y[4 * q + 1] = fmaf(prev[4 * q + 1] - cur[4 * q + 1], m4.y, cur[4 * q + 1]);
            y[4 * q + 2] = fmaf(prev[4 * q + 2] - cur[4 * q + 2], m4.z, cur[4 * q + 2]); y[4 * q + 3] = fmaf(prev[4 * q + 3] - cur[4 * q + 3], m4.w, cur[4 * q + 3]); }
        bf16_t* dst = (bf16_t*)(ws + NB_XSH) + ((size_t)n * XSH_ROWS + xrow) * 1024 + lane * 16;
        u32x4 w0, w1;
        w0.x = pk_bf16(y[0], y[1]); w0.y = pk_bf16(y[2], y[3]); w0.z = pk_bf16(y[4], y[5]); w0.w = pk_bf16(y[6], y[7]);
        w1.x = pk_bf16(y[8], y[9]); w1.y = pk_bf16(y[10], y[11]); w1.z = pk_bf16(y[12], y[13]); w1.w = pk_bf16(y[14], y[15]);
        *(u32x4*)dst = w0; *(u32x4*)(dst + 8) = w1;
    }
}
__device__ __forceinline__ void phase_lns(const Args& a, unsigned char* ws, int bid, int nb) {
    const int tid = opaque_v(threadIdx.x), lane = tid & 63, wv = tid >> 6;
    const float* PRE = (const float*)ws + WS_PRE;
    const float* g = a.in[I_LNG]; const float* bta = a.in[I_LNB];
    for (int blk = bid; blk < 256; blk += nb) {
        const int r0 = blk * 64 + wv * 8;
        float prev[16], cur[16];
        if ((r0 & (TP - 1)) == 0) {
#pragma unroll
            for (int i = 0; i < 16; ++i) prev[i] = 0.f;
        } else ln_row16(PRE + (size_t)(r0 - 1) * 1024, g, bta, lane, prev);
        float nxt[16];
        ld_row16(PRE + (size_t)r0 * 1024, lane, nxt);
#pragma unroll 1
        for (int k = 0; k < 8; ++k) {
            const int row = r0 + k;
#pragma unroll
            for (int i = 0; i < 16; ++i) cur[i] = nxt[i];
            if (k + 1 < 8) ld_row16(PRE + (size_t)(row + 1) * 1024, lane, nxt);
            ln_calc16(g, bta, lane, cur);
            store_x1_xsh(a, ws, row, row, lane, cur, prev);
            if ((row & (TP - 1)) == TP - 1) {
                float* so = a.out + O_SHP + (size_t)(row >> 11) * 1024 + lane * 16;
#pragma unroll
                for (int q = 0; q < 4; ++q) *(float4*)(so + q * 4) = make_float4(cur[4 * q], cur[4 * q + 1], cur[4 * q + 2], cur[4 * q + 3]);
            }
#pragma unroll
            for (int i = 0; i < 16; ++i) prev[i] = cur[i];
        }
    }
    for (int s = bid * 8 + wv; s < BS; s += nb * 8) {
        float prev[16], cur[16];
        const float* sp = a.in[I_SSHIFT] + (size_t)s * 1024 + lane * 16;
#pragma unroll
        for (int q = 0; q < 4; ++q) { const float4 v = *(const float4*)(sp + q * 4); prev[4 * q] = v.x; prev[4 * q + 1] = v.y; prev[4 * q + 2] = v.z; prev[4 * q + 3] = v.w; }
        ln_row16(PRE + (size_t)(MP + s) * 1024, g, bta, lane, cur);
        store_x1_xsh(a, ws, MP + s, MP + s, lane, cur, prev);
        float* so = a.out + O_SHS + (size_t)s * 1024 + lane * 16;
#pragma unroll
        for (int q = 0; q < 4; ++q) *(float4*)(so + q * 4) = make_float4(cur[4 * q], cur[4 * q + 1], cur[4 * q + 2], cur[4 * q + 3]);
    }
}

struct Order3 {
    pg8::StaticOrder so;
    __device__ void init(int G, int c) { so.init(MP, 4096, G, c); }
    __device__ bool next(int i, Unit& u) const { Unit v; if (!so.next(i, v)) return false; const int n = v.pn >> 2; u.pm = n * 65 + v.pm; u.pn = v.pn; return true; }
    __device__ __forceinline__ void a_ready(const Unit&) const {}
    __device__ __forceinline__ void done(const Unit&) const {}
};
struct Epi3 {
    static constexpr bool PERM = true, AFTER_DRAIN = false;
    bf16_t* O;
    __device__ __forceinline__ void operator()(const f32x4 (&acc)[2][2][4][2], const Unit& u, int wr, int wc, int fr, int fq) const {
        const int n = u.pn >> 2, pm = u.pm - n * 65, pn = u.pn & 3;
        const int row0 = pm * 256 + wr * 64 + fr, col0 = pn * 256 + wc * 32 + 8 * fq;
        bf16_t* base = O + (size_t)n * XSH_ROWS * 1024;
#pragma unroll
        for (int ai = 0; ai < 2; ++ai)
#pragma unroll
            for (int m = 0; m < 4; ++m) { bf16_t* rowp = base + (size_t)(row0 + ai * 128 + m * 16) * 1024 + col0;
#pragma unroll
                for (int bj = 0; bj < 2; ++bj) { const f32x4 v0 = acc[ai][bj][m][0], v1 = acc[ai][bj][m][1];
                    u32x4 w; w.x = pk_bf16c(v0[0], v0[1]); w.y = pk_bf16c(v0[2], v0[3]); w.z = pk_bf16c(v1[0], v1[1]); w.w = pk_bf16c(v1[2], v1[3]);
                    *(u32x4*)(rowp + bj * 128) = w; } }
    }
};
struct EpiPreRes {
    static constexpr bool PERM = false, AFTER_DRAIN = false;
    float* C; const float* X;
    __device__ __forceinline__ void operator()(const f32x4 (&acc)[2][2][4][2], const Unit& u, int wr, int wc, int fr, int fq) const {
        const int row0 = u.pm * 256 + wr * 64 + fr, col0 = u.pn * 256 + wc * 32 + 4 * fq;
#pragma unroll
        for (int ai = 0; ai < 2; ++ai)
#pragma unroll
            for (int m = 0; m < 4; ++m) { const size_t off = (size_t)(row0 + ai * 128 + m * 16) * 1024 + col0;
#pragma unroll
                for (int bj = 0; bj < 2; ++bj)
#pragma unroll
                    for (int n = 0; n < 2; ++n) { const f32x4 xv = *(const f32x4*)(X + off + bj * 128 + n * 16); *(f32x4*)(C + off + bj * 128 + n * 16) = acc[ai][bj][m][n] + xv * ALPHA; } }
    }
};

__device__ __forceinline__ float dpp_red16f(float v) {
    v += __builtin_bit_cast(float, __builtin_amdgcn_update_dpp(0, __builtin_bit_cast(int, v), 0xB1, 0xF, 0xF, true));
    v += __builtin_bit_cast(float, __builtin_amdgcn_update_dpp(0, __builtin_bit_cast(int, v), 0x4E, 0xF, 0xF, true));
    v += __builtin_bit_cast(float, __builtin_amdgcn_update_dpp(0, __builtin_bit_cast(int, v), 0x141, 0xF, 0xF, true));
    v += __builtin_bit_cast(float, __builtin_amdgcn_update_dpp(0, __builtin_bit_cast(int, v), 0x140, 0xF, 0xF, true));
    return v;
}
__device__ __forceinline__ void prep2_task(const Args& a, unsigned char* ws, int rt, int hd, int lane) {
    const int lr = lane & 31, h2 = lane >> 5;
    const size_t row0 = (size_t)rt * 32;
    const bf16_t* W2T = (const bf16_t*)(ws + NB_W2T); const bf16_t* A2T = (const bf16_t*)(ws + NB_A2T);
    const bf16_t* TWB = (const bf16_t*)(ws + NB_TWB); const bf16_t* AWB = (const bf16_t*)(ws + NB_AWB);
    f32x16 aw[2], aa[2];
#pragma unroll
    for (int ct = 0; ct < 2; ++ct)
#pragma unroll
        for (int i = 0; i < 16; ++i) { aw[ct][i] = 0.f; aa[ct][i] = 0.f; }
#pragma unroll
    for (int s = 0; s < 4; ++s) {
        const bf16x8 at = *(const bf16x8*)(TWB + (row0 + lr) * 64 + s * 16 + h2 * 8), aa_ = *(const bf16x8*)(AWB + (row0 + lr) * 64 + s * 16 + h2 * 8);
#pragma unroll
        for (int ct = 0; ct < 2; ++ct) {
            const size_t e = (size_t)hd * 64 + ct * 32 + lr;
            const bf16x8 w2 = *(const bf16x8*)(W2T + e * 64 + s * 16 + h2 * 8), a2 = *(const bf16x8*)(A2T + e * 64 + s * 16 + h2 * 8);
            aw[ct] = __builtin_amdgcn_mfma_f32_32x32x16_bf16(at, w2, aw[ct], 0, 0, 0);
            aa[ct] = __builtin_amdgcn_mfma_f32_32x32x16_bf16(aa_, a2, aa[ct], 0, 0, 0);
        }
    }
    const bf16_t* KB = (const bf16_t*)(ws + NB_RKVZ) + (size_t)1 * XSH_ROWS * 1024;
    const bf16_t* RB = (const bf16_t*)(ws + NB_RKVZ);
    float* DEC = (float*)(ws + NB_DEC);
    bf16_t* KKN = (bf16_t*)(ws + NB_KKN); bf16_t* KKA = (bf16_t*)(ws + NB_KKA); bf16_t* KP = (bf16_t*)(ws + NB_KP);
    float w0v[2], a0v[2], kkp[2], kap[2], rkp[2];
#pragma unroll
    for (int ct = 0; ct < 2; ++ct) { const int e = hd * 64 + ct * 32 + lr; w0v[ct] = a.in[I_W0][e]; a0v[ct] = a.in[I_A0][e]; kkp[ct] = a.in[I_KK][e]; kap[ct] = a.in[I_KA][e]; rkp[ct] = a.in[I_RK][e]; }
    float n2[16], rk[16];
#pragma unroll
    for (int i = 0; i < 16; ++i) { n2[i] = 0.f; rk[i] = 0.f; }
#pragma unroll
    for (int ct = 0; ct < 2; ++ct)
#pragma unroll
        for (int i = 0; i < 16; ++i) {
            const size_t off = (row0 + (i & 3) + 8 * (i >> 2) + 4 * h2) * 1024 + hd * 64 + ct * 32 + lr;
            const float kf = bf2f(KB[off]), rf = bf2f(RB[off]);
            const float wl = w0v[ct] + aw[ct][i];
            const float sp = fmaxf(-wl, 0.f) + log1pf(__expf(-fabsf(wl)));
            DEC[off] = __expf(-__expf(-sp - 0.5f));
            const float av_ = sigm_f(a0v[ct] + aa[ct][i]);
            const float kk = kf * kkp[ct];
            const float kp = kf * (1.f + (av_ - 1.f) * kap[ct]);
            KP[off] = (bf16_t)(pk_bf16(kp, 0.f) & 0xffffu);
            aw[ct][i] = kk; aa[ct][i] = av_;
            n2[i] = fmaf(kk, kk, n2[i]);
            rk[i] = fmaf(rf * kp, rkp[ct], rk[i]);
        }
#pragma unroll
    for (int i = 0; i < 16; ++i) {
        float v = dpp_red16f(n2[i]); v += __shfl_xor(v, 16); n2[i] = 1.f / fmaxf(sqrtf(v), 1e-12f);
        float w = dpp_red16f(rk[i]); w += __shfl_xor(w, 16); rk[i] = w;
    }
#pragma unroll
    for (int ct = 0; ct < 2; ++ct)
#pragma unroll
        for (int i = 0; i < 16; ++i) {
            const size_t off = (row0 + (i & 3) + 8 * (i >> 2) + 4 * h2) * 1024 + hd * 64 + ct * 32 + lr;
            const float kn = aw[ct][i] * n2[i];
            KKN[off] = (bf16_t)(pk_bf16(kn, 0.f) & 0xffffu);
            KKA[off] = (bf16_t)(pk_bf16(kn * aa[ct][i], 0.f) & 0xffffu);
        }
    if (lr == 0) {
#pragma unroll
        for (int i = 0; i < 16; ++i) ((float*)(ws + NB_RKS))[(row0 + (i & 3) + 8 * (i >> 2) + 4 * h2) * 16 + hd] = rk[i];
    }
}

constexpr int SC_BUF = 53248;
__device__ __forceinline__ float dpp_red16(float v) {
    v += __builtin_bit_cast(float, __builtin_amdgcn_update_dpp(0, __builtin_bit_cast(int, v), 0xB1, 0xF, 0xF, true));
    v += __builtin_bit_cast(float, __builtin_amdgcn_update_dpp(0, __builtin_bit_cast(int, v), 0x4E, 0xF, 0xF, true));
    v += __builtin_bit_cast(float, __builtin_amdgcn_update_dpp(0, __builtin_bit_cast(int, v), 0x141, 0xF, 0xF, true));
    v += __builtin_bit_cast(float, __builtin_amdgcn_update_dpp(0, __builtin_bit_cast(int, v), 0x140, 0xF, 0xF, true));
    return v;
}
struct ScanRegs { u32x4 d0, d1, kn, ka, kp, r, v; };
__device__ __forceinline__ void scan_issue(unsigned char* ws, int b, int hd, int vh, int chunk, int tid, ScanRegs& g) {
    const int tt = tid >> 3, part = tid & 7;
    const size_t row = (size_t)b * TP + chunk * 64 + tt;
    const size_t off = row * 1024 + hd * 64 + part * 8;
    const float* dp = (const float*)(ws + NB_DEC) + off;
    g.d0 = *(const u32x4*)dp; g.d1 = *(const u32x4*)(dp + 4);
    g.kn = *(const u32x4*)((const bf16_t*)(ws + NB_KKN) + off);
    g.ka = *(const u32x4*)((const bf16_t*)(ws + NB_KKA) + off);
    g.kp = *(const u32x4*)((const bf16_t*)(ws + NB_KP) + off);
    g.r = *(const u32x4*)((const bf16_t*)(ws + NB_RKVZ) + ((size_t)0 * XSH_ROWS + row) * 1024 + hd * 64 + part * 8);
    if (part < 4) g.v = *(const u32x4*)((const bf16_t*)(ws + NB_RKVZ) + ((size_t)2 * XSH_ROWS + row) * 1024 + hd * 64 + vh * 32 + part * 8);
}
__device__ __forceinline__ void scan_write(PG8_LAS unsigned char* buf, int tid, const ScanRegs& g) {
    const int tt = tid >> 3, part = tid & 7;
    *(PG8_LAS u32x4*)(buf + tt * 256 + part * 32) = g.d0; *(PG8_LAS u32x4*)(buf + tt * 256 + part * 32 + 16) = g.d1;
    *(PG8_LAS u32x4*)(buf + 16384 + tt * 128 + part * 16) = g.kn;
    *(PG8_LAS u32x4*)(buf + 24576 + tt * 128 + part * 16) = g.ka;
    *(PG8_LAS u32x4*)(buf + 32768 + tt * 128 + part * 16) = g.kp;
    *(PG8_LAS u32x4*)(buf + 40960 + tt * 128 + part * 16) = g.r;
    if (part < 4) *(PG8_LAS u32x4*)(buf + 49152 + tt * 64 + part * 16) = g.v;
}
__device__ __forceinline__ void scan_prompt(const Args& a, unsigned char* ws, PG8_LAS unsigned char* lds, int item) {
    const int tid = opaque_v(threadIdx.x);
    const int b = item >> 5, hd = (item >> 1) & 15, vh = item & 1;
    const int vl = tid >> 4, kq = tid & 15;
    typedef unsigned u32x2 __attribute__((ext_vector_type(2)));
    float S[4] = {0.f, 0.f, 0.f, 0.f};
    ScanRegs g;
    PG8_LAS float* YS = (PG8_LAS float*)(lds + 2 * SC_BUF);
    scan_issue(ws, b, hd, vh, 0, tid, g); scan_write(lds, tid, g);
    __syncthreads();
    for (int c = 0; c < TP / 64; ++c) {
        PG8_LAS unsigned char* buf = lds + (c & 1) * SC_BUF;
        if (c + 1 < TP / 64) scan_issue(ws, b, hd, vh, c + 1, tid, g);
#pragma unroll 4
        for (int tt = 0; tt < 64; ++tt) {
            const f32x4 w = *(const PG8_LAS f32x4*)(buf + tt * 256 + kq * 16);
            const u32x2 knw = *(const PG8_LAS u32x2*)(buf + 16384 + tt * 128 + kq * 8), kaw = *(const PG8_LAS u32x2*)(buf + 24576 + tt * 128 + kq * 8),
                        kpw = *(const PG8_LAS u32x2*)(buf + 32768 + tt * 128 + kq * 8), rw = *(const PG8_LAS u32x2*)(buf + 40960 + tt * 128 + kq * 8);
            const float vv = bf2f(*(const PG8_LAS bf16_t*)(buf + 49152 + tt * 64 + vl * 2));
            const float kn[4] = {__uint_as_float(knw.x << 16), __uint_as_float(knw.x & 0xffff0000u), __uint_as_float(knw.y << 16), __uint_as_float(knw.y & 0xffff0000u)};
            const float ka[4] = {__uint_as_float(kaw.x << 16), __uint_as_float(kaw.x & 0xffff0000u), __uint_as_float(kaw.y << 16), __uint_as_float(kaw.y & 0xffff0000u)};
            const float kp[4] = {__uint_as_float(kpw.x << 16), __uint_as_float(kpw.x & 0xffff0000u), __uint_as_float(kpw.y << 16), __uint_as_float(kpw.y & 0xffff0000u)};
            const float rr[4] = {__uint_as_float(rw.x << 16), __uint_as_float(rw.x & 0xffff0000u), __uint_as_float(rw.y << 16), __uint_as_float(rw.y & 0xffff0000u)};
            float sa = S[0] * kn[0];
            sa = fmaf(S[1], kn[1], sa); sa = fmaf(S[2], kn[2], sa); sa = fmaf(S[3], kn[3], sa);
            sa = dpp_red16(sa);
            float y = 0.f;
#pragma unroll
            for (int i = 0; i < 4; ++i) { S[i] = fmaf(S[i], w[i], fmaf(vv, kp[i], -sa * ka[i])); y = fmaf(S[i], rr[i], y); }
            y = dpp_red16(y);
            if (kq == 0) YS[tt * 32 + vl] = y;
        }
        if (c + 1 < TP / 64) scan_write(lds + ((c + 1) & 1) * SC_BUF, tid, g);
        __syncthreads();
        {
            float* Y = (float*)(ws + NB_Y);
            for (int i = tid; i < 64 * 32; i += NTH) { const int tt = i >> 5, v = i & 31; Y[((size_t)b * TP + c * 64 + tt) * 1024 + hd * 64 + vh * 32 + v] = YS[i]; }
        }
        __syncthreads();
    }
    float* so = a.out + O_WKVP + ((size_t)(b * 16 + hd) * 64 + vh * 32 + vl) * 64 + kq * 4;
    *(float4*)so = make_float4(S[0], S[1], S[2], S[3]);
}
__device__ __forceinline__ void scan_sample(const Args& a, unsigned char* ws, int s, int hd, int lane) {
    const size_t row = (size_t)MP + s;
    const float* s0 = a.in[I_SWKV] + ((size_t)(s * 16 + hd) * 64 + lane) * 64;
    float* sout = a.out + O_WKVS + ((size_t)(s * 16 + hd) * 64 + lane) * 64;
    const float* dec = (const float*)(ws + NB_DEC) + row * 1024 + hd * 64;
    const bf16_t* kn = (const bf16_t*)(ws + NB_KKN) + row * 1024 + hd * 64; const bf16_t* ka = (const bf16_t*)(ws + NB_KKA) + row * 1024 + hd * 64;
    const bf16_t* kp = (const bf16_t*)(ws + NB_KP) + row * 1024 + hd * 64;
    const bf16_t* rp = (const bf16_t*)(ws + NB_RKVZ) + ((size_t)0 * XSH_ROWS + row) * 1024 + hd * 64;
    const float vv = bf2f(((const bf16_t*)(ws + NB_RKVZ) + ((size_t)2 * XSH_ROWS + row) * 1024 + hd * 64)[lane]);
    float sa = 0.f;
#pragma unroll 8
    for (int k = 0; k < 64; ++k) sa = fmaf(s0[k], bf2f(kn[k]), sa);
    float y = 0.f;
#pragma unroll 8
    for (int k = 0; k < 64; ++k) { const float sn = fmaf(s0[k], dec[k], fmaf(vv, bf2f(kp[k]), -sa * bf2f(ka[k]))); sout[k] = sn; y = fmaf(sn, bf2f(rp[k]), y); }
    {
        const float mean = wave_sum(y) * (1.f / 64.f);
        const float d = y - mean;
        const float rs = rsqrtf(wave_sum(d * d) * (1.f / 64.f) + GN_EPS);
        const int e = hd * 64 + lane;
        const float rkv = ((const float*)(ws + NB_RKS))[row * 16 + hd];
        const float zf = bf2f(((const bf16_t*)(ws + NB_RKVZ) + ((size_t)3 * XSH_ROWS + row) * 1024)[e]);
        const float o = fmaf(rkv, vv, d * rs * a.in[I_GNG][e] + a.in[I_GNB][e]) * silu_f(zf);
        ((bf16_t*)(ws + NB_G4B))[row * 1024 + e] = (bf16_t)(pk_bf16c(o, 0.f) & 0xffffu);
    }
}

constexpr int CS_LD = 72;
constexpr int CS_SLOT = 64 * CS_LD * 2;
constexpr int CS_F32A = 13 * CS_SLOT;
constexpr int CS_F32B = CS_F32A + 16384;
constexpr int CS_GS = CS_F32B + 16384;
constexpr int CS_END = CS_GS + 4096;
constexpr size_t CK_MCT = 0, CK_RY = 8192, CK_SADD = 16384, CK_Y0 = 32768, CK_BYTES = 49152;

__device__ __forceinline__ PG8_LAS bf16_t* cs_slot(PG8_LAS unsigned char* lds, int i) { return (PG8_LAS bf16_t*)(lds + i * CS_SLOT); }
__device__ __forceinline__ void cs_mm(f32x16& acc, const PG8_LAS bf16_t* X, const PG8_LAS bf16_t* Yt, int mt, int nt, int lane) {
    const int lr = lane & 31, h = lane >> 5;
#pragma unroll
    for (int s = 0; s < 4; ++s) {
        const bf16x8 av = *(const PG8_LAS bf16x8*)(X + (mt * 32 + lr) * CS_LD + s * 16 + h * 8);
        const bf16x8 bv = *(const PG8_LAS bf16x8*)(Yt + (nt * 32 + lr) * CS_LD + s * 16 + h * 8);
        acc = __builtin_amdgcn_mfma_f32_32x32x16_bf16(av, bv, acc, 0, 0, 0);
    }
}
__device__ __forceinline__ void cs_store_t(const f32x16& acc, PG8_LAS bf16_t* D, int mt, int nt, int lane) {
    typedef unsigned u32x2 __attribute__((ext_vector_type(2)));
    const int lr = lane & 31, h = lane >> 5;
#pragma unroll
    for (int c = 0; c < 4; ++c) { u32x2 w; w.x = pk_bf16c(acc[4 * c], acc[4 * c + 1]); w.y = pk_bf16c(acc[4 * c + 2], acc[4 * c + 3]);
        *(PG8_LAS u32x2*)(D + (nt * 32 + lr) * CS_LD + mt * 32 + 8 * c + 4 * h) = w; }
}
__device__ __forceinline__ void cs_store_n(const f32x16& acc, PG8_LAS bf16_t* D, int mt, int nt, int lane) {
    const int lr = lane & 31, h = lane >> 5;
#pragma unroll
    for (int i = 0; i < 16; ++i) D[(mt * 32 + (i & 3) + 8 * (i >> 2) + 4 * h) * CS_LD + nt * 32 + lr] = (bf16_t)(pk_bf16c(acc[i], 0.f) & 0xffffu);
}
__device__ __forceinline__ void cs_zero(f32x16& a) {
#pragma unroll
    for (int i = 0; i < 16; ++i) a[i] = 0.f;
}
__device__ __forceinline__ float dpp_red8(float v) {
    v += __builtin_bit_cast(float, __builtin_amdgcn_update_dpp(0, __builtin_bit_cast(int, v), 0xB1, 0xF, 0xF, true));
    v += __builtin_bit_cast(float, __builtin_amdgcn_update_dpp(0, __builtin_bit_cast(int, v), 0x4E, 0xF, 0xF, true));
    v += __builtin_bit_cast(float, __builtin_amdgcn_update_dpp(0, __builtin_bit_cast(int, v), 0x141, 0xF, 0xF, true));
    return v;
}

struct PreRegs { u32x4 kv, rv, vv; bf16x8 af[4]; };
__device__ __forceinline__ void scanpre_load(unsigned char* ws, int b, int hd, int c, int tid, PreRegs& r) {
    const int lane = tid & 63, wv = tid >> 6, lr = lane & 31, h = lane >> 5;
    const size_t row0 = (size_t)b * TP + c * 64;
    const int tok = tid >> 3, c8 = tid & 7;
    const size_t off = (row0 + tok) * 1024 + hd * 64 + c8 * 8;
    const bf16_t* RK = (const bf16_t*)(ws + NB_RKVZ);
    r.kv = *(const u32x4*)(RK + (size_t)1 * XSH_ROWS * 1024 + off); r.rv = *(const u32x4*)(RK + off); r.vv = *(const u32x4*)(RK + (size_t)2 * XSH_ROWS * 1024 + off);
    const int which = wv >> 2, mt = (wv >> 1) & 1;
    const bf16_t* A = (const bf16_t*)(ws + (which ? NB_AWB : NB_TWB)) + (row0 + mt * 32 + lr) * 64 + h * 8;
#pragma unroll
    for (int s = 0; s < 4; ++s) r.af[s] = *(const bf16x8*)(A + s * 16);
}
__device__ __forceinline__ void scanpre_chunk(const Args& a, unsigned char* ws, PG8_LAS unsigned char* lds, int b, int hd, int c, const PreRegs& pre, const bf16x8 (&btf)[4]) {
    const int tid = opaque_v(threadIdx.x), lane = tid & 63, wv = __builtin_amdgcn_readfirstlane(tid >> 6);
    const int lr = lane & 31, h = lane >> 5;
    const size_t row0 = (size_t)b * TP + c * 64;
    typedef unsigned u32x2 __attribute__((ext_vector_type(2)));
    PG8_LAS float* LCUM = (PG8_LAS float*)(lds + CS_F32A);
    PG8_LAS float* AV = (PG8_LAS float*)(lds + CS_F32B);
    PG8_LAS float* GS = (PG8_LAS float*)(lds + CS_GS);
    unsigned char* rec = ws + NB_CHK + ((size_t)(b * 16 + hd) * 32 + c) * CK_BYTES;
    {
        const int tok = tid >> 3, c8 = tid & 7;
        *(PG8_LAS u32x4*)(cs_slot(lds, 0) + tok * CS_LD + c8 * 8) = pre.kv;
        *(PG8_LAS u32x4*)(cs_slot(lds, 1) + tok * CS_LD + c8 * 8) = pre.rv;
        *(PG8_LAS u32x4*)(cs_slot(lds, 2) + tok * CS_LD + c8 * 8) = pre.vv;
    }
    {
        const int which = wv >> 2, mt = (wv >> 1) & 1, nt = wv & 1;
        f32x16 acc; cs_zero(acc);
#pragma unroll
        for (int s = 0; s < 4; ++s) acc = __builtin_amdgcn_mfma_f32_32x32x16_bf16(pre.af[s], btf[s], acc, 0, 0, 0);
        PG8_LAS float* D = which ? AV : LCUM;
        const float bias = a.in[which ? I_A0 : I_W0][hd * 64 + nt * 32 + lr];
#pragma unroll
        for (int i = 0; i < 16; ++i) {
            const float x = acc[i] + bias;
            float y;
            if (which) y = sigm_f(x);
            else { const float sp = fmaxf(-x, 0.f) + __logf(1.f + __expf(-fabsf(x))); y = -__expf(-sp - 0.5f); }
            D[(mt * 32 + (i & 3) + 8 * (i >> 2) + 4 * h) * 64 + nt * 32 + lr] = y;
        }
    }
    __syncthreads();
    {
        const int ch = tid & 63, tg = tid >> 6;
        float p[8]; float run = 0.f;
#pragma unroll
        for (int i = 0; i < 8; ++i) { run += LCUM[(tg * 8 + i) * 64 + ch]; p[i] = run; }
        GS[tg * 64 + ch] = run;
        __syncthreads();
        float offs = 0.f;
        for (int g = 0; g < tg; ++g) offs += GS[g * 64 + ch];
#pragma unroll
        for (int i = 0; i < 8; ++i) LCUM[(tg * 8 + i) * 64 + ch] = p[i] + offs;
    }
    __syncthreads();
    {
        const int tok = tid >> 3, c8 = tid & 7;
        const u32x4 kw = *(const PG8_LAS u32x4*)(cs_slot(lds, 0) + tok * CS_LD + c8 * 8), rw = *(const PG8_LAS u32x4*)(cs_slot(lds, 1) + tok * CS_LD + c8 * 8),
                    vw = *(const PG8_LAS u32x4*)(cs_slot(lds, 2) + tok * CS_LD + c8 * 8);
        float kf[8], rf[8], kk[8], kp[8], av[8];
        float n2 = 0.f, rk = 0.f;
#pragma unroll
        for (int i = 0; i < 8; ++i) {
            const int e = hd * 64 + c8 * 8 + i;
            kf[i] = __uint_as_float((i & 1) ? (kw[i >> 1] & 0xffff0000u) : (kw[i >> 1] << 16));
            rf[i] = __uint_as_float((i & 1) ? (rw[i >> 1] & 0xffff0000u) : (rw[i >> 1] << 16));
            av[i] = AV[tok * 64 + c8 * 8 + i];
            kk[i] = kf[i] * a.in[I_KK][e];
            kp[i] = kf[i] * (1.f + (av[i] - 1.f) * a.in[I_KA][e]);
            n2 = fmaf(kk[i], kk[i], n2);
            rk = fmaf(rf[i] * kp[i], a.in[I_RK][e], rk);
        }
        n2 = dpp_red8(n2); rk = dpp_red8(rk);
        const float inv = 1.f / fmaxf(sqrtf(n2), 1e-12f);
        if (c8 == 0) ((float*)(ws + NB_RKS))[(row0 + tok) * 16 + hd] = rk;
        if (tok == 63) {
#pragma unroll
            for (int i = 0; i < 8; ++i) GS[512 + c8 * 8 + i] = __expf(LCUM[63 * 64 + c8 * 8 + i]);
        }
        float qt[8], rt[8], kt[8], bt[8], kh[8], bh[8];
#pragma unroll
        for (int i = 0; i < 8; ++i) {
            const int ch = c8 * 8 + i;
            const float Lt = LCUM[tok * 64 + ch], Lp = tok ? LCUM[(tok - 1) * 64 + ch] : 0.f, Lc = LCUM[63 * 64 + ch];
            const float kn = kk[i] * inv, ka = kn * av[i];
            const float en = __expf(-Lt), ec = __expf(Lc - Lt);
            qt[i] = kn * __expf(Lp); rt[i] = rf[i] * __expf(Lt); kt[i] = kp[i] * en; bt[i] = ka * en; kh[i] = kp[i] * ec; bh[i] = ka * ec;
        }
#define CS_PUT_ROW(SLOT, ARR) { u32x4 w_; w_.x = pk_bf16c(ARR[0], ARR[1]); w_.y = pk_bf16c(ARR[2], ARR[3]); w_.z = pk_bf16c(ARR[4], ARR[5]); w_.w = pk_bf16c(ARR[6], ARR[7]); \
            *(PG8_LAS u32x4*)(cs_slot(lds, SLOT) + tok * CS_LD + c8 * 8) = w_; }
#define CS_PUT_COL(SLOT, ARR) { _Pragma("unroll") for (int i_ = 0; i_ < 8; ++i_) cs_slot(lds, SLOT)[(c8 * 8 + i_) * CS_LD + tok] = (bf16_t)(pk_bf16c(ARR[i_], 0.f) & 0xffffu); }
        CS_PUT_ROW(3, qt) CS_PUT_ROW(4, rt) CS_PUT_ROW(5, kt) CS_PUT_ROW(6, bt)
        CS_PUT_COL(7, qt) CS_PUT_COL(8, bh) CS_PUT_COL(9, kh)
#pragma unroll
        for (int i = 0; i < 8; ++i) cs_slot(lds, 10)[(c8 * 8 + i) * CS_LD + tok] = (bf16_t)((i & 1) ? (vw[i >> 1] >> 16) : (vw[i >> 1] & 0xffffu));
#undef CS_PUT_ROW
#undef CS_PUT_COL
    }
    __syncthreads();
    {
#pragma unroll 1
        for (int j = 0; j < 2; ++j) {
            const int job = wv * 2 + j, prod = job >> 2, mt = (job >> 1) & 1, nt = job & 1;
            const PG8_LAS bf16_t* X = cs_slot(lds, (prod & 1) ? 6 : 5);
            const PG8_LAS bf16_t* Y = cs_slot(lds, (prod & 2) ? 4 : 3);
            f32x16 acc; cs_zero(acc);
            cs_mm(acc, X, Y, mt, nt, lane);
            const int t = nt * 32 + lr, incl = (prod & 2) ? 1 : 0;
#pragma unroll
            for (int i = 0; i < 16; ++i) { const int sidx = mt * 32 + (i & 3) + 8 * (i >> 2) + 4 * h; acc[i] = (sidx < t + incl) ? acc[i] : 0.f; }
            const int dst = (prod == 0) ? 0 : (prod == 1) ? 11 : (prod == 2) ? 1 : 2;
            cs_store_t(acc, cs_slot(lds, dst), mt, nt, lane);
            if (prod == 1) cs_store_n(acc, cs_slot(lds, 12), mt, nt, lane);
        }
    }
    __syncthreads();
    {
        const int mt = (wv >> 1) & 1, nt = wv & 1;
        f32x16 pacc;
        if (wv < 4) {
#pragma unroll
            for (int i = 0; i < 16; ++i) { const int u = mt * 32 + (i & 3) + 8 * (i >> 2) + 4 * h, t = nt * 32 + lr;
                pacc[i] = ((u == t) ? 1.f : 0.f) - bf2f(cs_slot(lds, 12)[u * CS_LD + t]); }
            cs_store_t(pacc, cs_slot(lds, 3), mt, nt, lane);
        }
        __syncthreads();
        const int mcur = 11, mtcur = 12, mnxt = 5, mtnxt = 6;
        PG8_LAS bf16_t* XS0 = (PG8_LAS bf16_t*)(lds + CS_F32A);
        PG8_LAS bf16_t* XS1 = (PG8_LAS bf16_t*)(lds + CS_F32A + CS_SLOT);
        PG8_LAS bf16_t* XS2 = (PG8_LAS bf16_t*)(lds + CS_F32A + 2 * CS_SLOT);
        PG8_LAS bf16_t* Pc = cs_slot(lds, 3); PG8_LAS bf16_t* Pn = XS0;
        PG8_LAS bf16_t* Mc_ = cs_slot(lds, mcur); PG8_LAS bf16_t* MTc = cs_slot(lds, mtcur);
        PG8_LAS bf16_t* Mn = cs_slot(lds, mnxt); PG8_LAS bf16_t* MTn = cs_slot(lds, mtnxt);
#pragma unroll 1
        for (int it = 0; it < 5; ++it) {
            if (wv >= 4) {
                f32x16 acc; cs_zero(acc);
                cs_mm(acc, Mc_, MTc, mt, nt, lane);
                cs_store_n(acc, Mn, mt, nt, lane);
                cs_store_t(acc, MTn, mt, nt, lane);
                float mx = 0.f;
#pragma unroll
                for (int i = 0; i < 16; ++i) mx = fmaxf(mx, fabsf(acc[i]));
#pragma unroll
                for (int o = 32; o > 0; o >>= 1) mx = fmaxf(mx, __shfl_xor(mx, o));
                if (lane == 0) GS[640 + (wv & 3)] = mx;
            }
            __syncthreads();
            const float m2max = fmaxf(fmaxf(GS[640], GS[641]), fmaxf(GS[642], GS[643]));
            if (wv < 4) {
                cs_mm(pacc, MTn, Pc, mt, nt, lane);
                cs_store_t(pacc, Pn, mt, nt, lane);
            }
            __syncthreads();
            { PG8_LAS bf16_t* t0 = Mc_; Mc_ = Mn; Mn = t0; t0 = MTc; MTc = MTn; MTn = t0; t0 = Pc; Pc = Pn; Pn = t0; }
            if (m2max < 1e-7f) break;
        }
        {
            f32x16 acc; cs_zero(acc);
            if (wv < 4) { cs_mm(acc, cs_slot(lds, 0), cs_slot(lds, 10), mt, nt, lane); cs_store_t(acc, XS1, mt, nt, lane); }
            else { cs_mm(acc, Pc, cs_slot(lds, 7), mt, nt, lane); cs_store_t(acc, XS2, mt, nt, lane); }
        }
        __syncthreads();
        if (wv < 4) { f32x16 acc; cs_zero(acc); cs_mm(acc, Pc, XS1, mt, nt, lane); cs_store_t(acc, cs_slot(lds, 11), mt, nt, lane); }
        __syncthreads();
        if (wv < 4) {
            f32x16 acc; cs_zero(acc);
            cs_mm(acc, XS2, cs_slot(lds, 8), mt, nt, lane);
#pragma unroll
            for (int i = 0; i < 16; ++i) { const int k = mt * 32 + (i & 3) + 8 * (i >> 2) + 4 * h, kp_ = nt * 32 + lr; acc[i] = ((k == kp_) ? GS[512 + k] : 0.f) - acc[i]; }
            bf16_t* mct = (bf16_t*)(rec + CK_MCT);
#pragma unroll
            for (int cc = 0; cc < 4; ++cc) { u32x2 w; w.x = pk_bf16c(acc[4 * cc], acc[4 * cc + 1]); w.y = pk_bf16c(acc[4 * cc + 2], acc[4 * cc + 3]);
                *(u32x2*)(mct + (nt * 32 + lr) * 64 + mt * 32 + 8 * cc + 4 * h) = w; }
            f32x16 s1, s2; cs_zero(s1); cs_zero(s2);
            cs_mm(s1, cs_slot(lds, 9), cs_slot(lds, 10), mt, nt, lane);
            cs_mm(s2, cs_slot(lds, 8), cs_slot(lds, 11), mt, nt, lane);
            float* sd = (float*)(rec + CK_SADD) + ((size_t)(wv & 3) * 64 + lane) * 16;
#pragma unroll
            for (int q4 = 0; q4 < 4; ++q4) *(float4*)(sd + q4 * 4) = make_float4(s1[4 * q4] - s2[4 * q4], s1[4 * q4 + 1] - s2[4 * q4 + 1], s1[4 * q4 + 2] - s2[4 * q4 + 2], s1[4 * q4 + 3] - s2[4 * q4 + 3]);
        } else {
            f32x16 acc; cs_zero(acc);
            cs_mm(acc, XS2, cs_slot(lds, 2), mt, nt, lane);
            bf16_t* ry = (bf16_t*)(rec + CK_RY);
#pragma unroll
            for (int cc = 0; cc < 4; ++cc) {
                const u32x2 rv = *(const PG8_LAS u32x2*)(cs_slot(lds, 4) + (nt * 32 + lr) * CS_LD + mt * 32 + 8 * cc + 4 * h);
                const float r0 = __uint_as_float(rv.x << 16), r1 = __uint_as_float(rv.x & 0xffff0000u), r2 = __uint_as_float(rv.y << 16), r3 = __uint_as_float(rv.y & 0xffff0000u);
                u32x2 w; w.x = pk_bf16c(r0 - acc[4 * cc], r1 - acc[4 * cc + 1]); w.y = pk_bf16c(r2 - acc[4 * cc + 2], r3 - acc[4 * cc + 3]);
                *(u32x2*)(ry + (nt * 32 + lr) * 64 + mt * 32 + 8 * cc + 4 * h) = w;
            }
            f32x16 s1, s2; cs_zero(s1); cs_zero(s2);
            cs_mm(s1, cs_slot(lds, 1), cs_slot(lds, 10), mt, nt, lane);
            cs_mm(s2, cs_slot(lds, 2), cs_slot(lds, 11), mt, nt, lane);
            float* yd = (float*)(rec + CK_Y0) + ((size_t)(wv & 3) * 64 + lane) * 16;
#pragma unroll
            for (int q4 = 0; q4 < 4; ++q4) *(float4*)(yd + q4 * 4) = make_float4(s1[4 * q4] - s2[4 * q4], s1[4 * q4 + 1] - s2[4 * q4 + 1], s1[4 * q4 + 2] - s2[4 * q4 + 2], s1[4 * q4 + 3] - s2[4 * q4 + 3]);
        }
    }
    __syncthreads();
}

struct SeqRegs { bf16x8 a[4]; f32x4 c[4]; };
__device__ __forceinline__ void seq_load(const unsigned char* rec, bool isS, int wv, int mt, int lane, SeqRegs& r) {
    const int lr = lane & 31, h = lane >> 5;
    const bf16_t* ap = (const bf16_t*)(rec + (isS ? CK_MCT : CK_RY)) + (mt * 32 + lr) * 64 + h * 8;
    const float* cp = (const float*)(rec + (isS ? CK_SADD : CK_Y0)) + ((size_t)(wv & 3) * 64 + lane) * 16;
#pragma unroll
    for (int s = 0; s < 4; ++s) { r.a[s] = *(const bf16x8*)(ap + s * 16); r.c[s] = *(const f32x4*)(cp + s * 4); }
}
__device__ __forceinline__ void scanseq_head(const Args& a, unsigned char* ws, PG8_LAS unsigned char* lds, int b, int hd) {
    const int tid = opaque_v(threadIdx.x), lane = tid & 63, wv = __builtin_amdgcn_readfirstlane(tid >> 6);
    const int lr = lane & 31, h = lane >> 5;
    const int mt = (wv >> 1) & 1, nt = wv & 1;
    const bool isS = wv < 4;
    PG8_LAS bf16_t* SB0 = cs_slot(lds, 0); PG8_LAS bf16_t* SB1 = cs_slot(lds, 1);
    f32x16 st; cs_zero(st);
    for (int i = tid; i < 64 * CS_LD; i += NTH) { SB0[i] = 0; }
    const unsigned char* rec0 = ws + NB_CHK + (size_t)(b * 16 + hd) * 32 * CK_BYTES;
    SeqRegs cur, nxt;
    seq_load(rec0, isS, wv, mt, lane, nxt);
    PG8_LAS float* YT = (PG8_LAS float*)(lds + 2 * CS_SLOT);
    const int ptok = tid >> 3, pv8 = (tid & 7) * 8;
    float gg[8], gb[8];
#pragma unroll
    for (int q = 0; q < 2; ++q) { const float4 g4 = *(const float4*)(a.in[I_GNG] + hd * 64 + pv8 + q * 4), b4 = *(const float4*)(a.in[I_GNB] + hd * 64 + pv8 + q * 4);
        gg[4 * q] = g4.x; gg[4 * q + 1] = g4.y; gg[4 * q + 2] = g4.z; gg[4 * q + 3] = g4.w; gb[4 * q] = b4.x; gb[4 * q + 1] = b4.y; gb[4 * q + 2] = b4.z; gb[4 * q + 3] = b4.w; }
    __syncthreads();
#pragma unroll 1
    for (int c = 0; c < 32; ++c) {
        cur = nxt;
        if (c + 1 < 32) seq_load(rec0 + (size_t)(c + 1) * CK_BYTES, isS, wv, mt, lane, nxt);
        const size_t prow = (size_t)b * TP + c * 64 + ptok;
        const u32x4 vw = *(const u32x4*)((const bf16_t*)(ws + NB_RKVZ) + ((size_t)2 * XSH_ROWS + prow) * 1024 + hd * 64 + pv8);
        const u32x4 zw = *(const u32x4*)((const bf16_t*)(ws + NB_RKVZ) + ((size_t)3 * XSH_ROWS + prow) * 1024 + hd * 64 + pv8);
        const float rkv = ((const float*)(ws + NB_RKS))[prow * 16 + hd];
        const PG8_LAS bf16_t* S = (c & 1) ? SB1 : SB0;
        PG8_LAS bf16_t* Sn = (c & 1) ? SB0 : SB1;
        PG8_LAS float* Yb = YT + (c & 1) * (64 * 68);
        f32x16 acc;
#pragma unroll
        for (int q4 = 0; q4 < 4; ++q4) { acc[4 * q4] = cur.c[q4][0]; acc[4 * q4 + 1] = cur.c[q4][1]; acc[4 * q4 + 2] = cur.c[q4][2]; acc[4 * q4 + 3] = cur.c[q4][3]; }
#pragma unroll
        for (int s = 0; s < 4; ++s) {
            const bf16x8 bv = *(const PG8_LAS bf16x8*)(S + (nt * 32 + lr) * CS_LD + s * 16 + h * 8);
            acc = __builtin_amdgcn_mfma_f32_32x32x16_bf16(cur.a[s], bv, acc, 0, 0, 0);
        }
        if (isS) { st = acc; cs_store_t(st, Sn, mt, nt, lane); }
        else {
#pragma unroll
            for (int i = 0; i < 16; ++i) Yb[(mt * 32 + (i & 3) + 8 * (i >> 2) + 4 * h) * 68 + nt * 32 + lr] = acc[i];
        }
        __syncthreads();
        {
            float y[8];
            const f32x4 y0 = *(const PG8_LAS f32x4*)(Yb + ptok * 68 + pv8), y1 = *(const PG8_LAS f32x4*)(Yb + ptok * 68 + pv8 + 4);
            y[0] = y0[0]; y[1] = y0[1]; y[2] = y0[2]; y[3] = y0[3]; y[4] = y1[0]; y[5] = y1[1]; y[6] = y1[2]; y[7] = y1[3];
            float sm = 0.f;
#pragma unroll
            for (int i = 0; i < 8; ++i) sm += y[i];
            const float mean = dpp_red8(sm) * (1.f / 64.f);
            float sq = 0.f;
#pragma unroll
            for (int i = 0; i < 8; ++i) { y[i] -= mean; sq += y[i] * y[i]; }
            const float rs = rsqrtf(dpp_red8(sq) * (1.f / 64.f) + GN_EPS);
            float o[8];
#pragma unroll
            for (int i = 0; i < 8; ++i) {
                const float vf = __uint_as_float((i & 1) ? (vw[i >> 1] & 0xffff0000u) : (vw[i >> 1] << 16)), zf = __uint_as_float((i & 1) ? (zw[i >> 1] & 0xffff0000u) : (zw[i >> 1] << 16));
                o[i] = fmaf(rkv, vf, y[i] * rs * gg[i] + gb[i]) * silu_f(zf);
            }
            u32x4 w; w.x = pk_bf16c(o[0], o[1]); w.y = pk_bf16c(o[2], o[3]); w.z = pk_bf16c(o[4], o[5]); w.w = pk_bf16c(o[6], o[7]);
            *(u32x4*)((bf16_t*)(ws + NB_G4B) + prow * 1024 + hd * 64 + pv8) = w;
        }
    }
    if (isS) {
        float* so = a.out + O_WKVP + ((size_t)(b * 16 + hd) * 64 + nt * 32 + lr) * 64 + mt * 32 + 4 * h;
#pragma unroll
        for (int cc = 0; cc < 4; ++cc) *(float4*)(so + 8 * cc) = make_float4(st[4 * cc], st[4 * cc + 1], st[4 * cc + 2], st[4 * cc + 3]);
    }
    __syncthreads();
}

struct PostRegs { float y[16]; u32x4 v0, v1, z0, z1; float rk; };
__device__ __forceinline__ void post_load(unsigned char* ws, int row, int lane, PostRegs& r) {
    ld_row16((const float*)(ws + NB_Y) + (size_t)row * 1024, lane, r.y);
    const bf16_t* vp = (const bf16_t*)(ws + NB_RKVZ) + ((size_t)2 * XSH_ROWS + row) * 1024 + lane * 16;
    const bf16_t* zp = (const bf16_t*)(ws + NB_RKVZ) + ((size_t)3 * XSH_ROWS + row) * 1024 + lane * 16;
    r.v0 = *(const u32x4*)vp; r.v1 = *(const u32x4*)(vp + 8); r.z0 = *(const u32x4*)zp; r.z1 = *(const u32x4*)(zp + 8);
    r.rk = ((const float*)(ws + NB_RKS))[(size_t)row * 16 + (lane >> 2)];
}
__device__ __forceinline__ void phase_post(const Args& a, unsigned char* ws, int bid, int nb) {
    const int tid = opaque_v(threadIdx.x), lane = tid & 63, wv = tid >> 6;
    float gg[16], gb[16];
#pragma unroll
    for (int q = 0; q < 4; ++q) { const float4 g4 = *(const float4*)(a.in[I_GNG] + lane * 16 + q * 4), b4 = *(const float4*)(a.in[I_GNB] + lane * 16 + q * 4);
        gg[4 * q] = g4.x; gg[4 * q + 1] = g4.y; gg[4 * q + 2] = g4.z; gg[4 * q + 3] = g4.w; gb[4 * q] = b4.x; gb[4 * q + 1] = b4.y; gb[4 * q + 2] = b4.z; gb[4 * q + 3] = b4.w; }
    PostRegs cur, nxt;
    int row = bid * 8 + wv;
    if (row < MT) post_load(ws, row, lane, nxt);
#pragma unroll 1
    while (row < MT) {
        cur = nxt;
        const int nrow = row + nb * 8;
        if (nrow < MT) post_load(ws, nrow, lane, nxt);
        float* y = cur.y;
        float sm = 0.f;
#pragma unroll
        for (int i = 0; i < 16; ++i) sm += y[i];
        sm += __shfl_xor(sm, 1); sm += __shfl_xor(sm, 2);
        const float mean = sm * (1.f / 64.f);
        float sq = 0.f;
#pragma unroll
        for (int i = 0; i < 16; ++i) { y[i] -= mean; sq += y[i] * y[i]; }
        sq += __shfl_xor(sq, 1); sq += __shfl_xor(sq, 2);
        const float rs = rsqrtf(sq * (1.f / 64.f) + GN_EPS);
        float o[16];
#pragma unroll
        for (int i = 0; i < 16; ++i) {
            const unsigned vw = (i < 8) ? cur.v0[i >> 1] : cur.v1[(i - 8) >> 1], zw = (i < 8) ? cur.z0[i >> 1] : cur.z1[(i - 8) >> 1];
            const float vf = __uint_as_float((i & 1) ? (vw & 0xffff0000u) : (vw << 16)), zf = __uint_as_float((i & 1) ? (zw & 0xffff0000u) : (zw << 16));
            const float yn = fmaf(cur.rk, vf, y[i] * rs * gg[i] + gb[i]);
            o[i] = yn * silu_f(zf);
        }
        bf16_t* dst = (bf16_t*)(ws + NB_G4B) + (size_t)row * 1024 + lane * 16;
        u32x4 w0, w1;
        w0.x = pk_bf16(o[0], o[1]); w0.y = pk_bf16(o[2], o[3]); w0.z = pk_bf16(o[4], o[5]); w0.w = pk_bf16(o[6], o[7]);
        w1.x = pk_bf16(o[8], o[9]); w1.y = pk_bf16(o[10], o[11]); w1.z = pk_bf16(o[12], o[13]); w1.w = pk_bf16(o[14], o[15]);
        *(u32x4*)dst = w0; *(u32x4*)(dst + 8) = w1;
        row = nrow;
    }
}
__device__ __forceinline__ void phase_lnf(const Args& a, unsigned char* ws, int bid, int nb) {
    const int tid = opaque_v(threadIdx.x), lane = tid & 63, wv = tid >> 6;
    const float* PRE = (const float*)ws + WS_PRE;
    const float* P2 = (const float*)(ws + NB_Y);
    float x[16], nx[16], y[16], ny[16];
    int row = bid * 8 + wv;
    if (row < MT) { ld_row16(PRE + (size_t)row * 1024, lane, nx); ld_row16(P2 + (size_t)row * 1024, lane, ny); }
#pragma unroll 1
    while (row < MT) {
#pragma unroll
        for (int i = 0; i < 16; ++i) { x[i] = nx[i]; y[i] = ny[i]; }
        const int nrow = row + nb * 8;
        if (nrow < MT) { ld_row16(PRE + (size_t)nrow * 1024, lane, nx); ld_row16(P2 + (size_t)nrow * 1024, lane, ny); }
        ln_calc16(a.in[I_LNG], a.in[I_LNB], lane, x);
#pragma unroll
        for (int i = 0; i < 16; ++i) x[i] = fmaf(ALPHA, x[i], y[i]);
        ln_calc16(a.in[I_LNG] + 1024, a.in[I_LNB] + 1024, lane, x);
        float* o = (row < MP ? a.out + O_Y + (size_t)row * 1024 : a.out + O_YS + (size_t)(row - MP) * 1024) + lane * 16;
#pragma unroll
        for (int q = 0; q < 4; ++q) *(float4*)(o + q * 4) = make_float4(x[4 * q], x[4 * q + 1], x[4 * q + 2], x[4 * q + 3]);
        row = nrow;
    }
}
__device__ __forceinline__ void sample_pool_copy(const Args& a, unsigned char* ws, int bid, int nb) {
    float* KCS = (float*)(ws + NB_KCS);
    const int* pt = (const int*)a.in[I_PT];
    const float* ccmp = a.in[I_CCMP];
#pragma unroll 2
    for (int i = bid * NTH + threadIdx.x; i < BS * 256 * 256; i += nb * NTH) {
        const int c = i & 255, n = (i >> 8) & 255, s = i >> 16;
        const int kv = c >> 7, g = (c >> 6) & 1;
        const float* w = kv ? a.in[I_WVC] : a.in[I_WKC];
        const int pos0 = n * 32;
        const float* src = ccmp + ((size_t)pt[s * NPAGE + (pos0 >> 7)] * PAGE + (pos0 & 127)) * 256 + c;
        float acc = 0.f;
#pragma unroll
        for (int l = 0; l < 32; ++l) acc = fmaf(src[(size_t)l * 256], w[l * 2 + g], acc);
        KCS[i] = acc;
    }
    const float4* cw = (const float4*)a.in[I_CWIN];
    float4* ow = (float4*)(a.out + O_WINS);
#pragma unroll 4
    for (int i = bid * NTH + threadIdx.x; i < BS * 511 * 64; i += nb * NTH) {
        const int s = i / (511 * 64), rem = i - s * (511 * 64);
        ow[(size_t)s * 512 * 64 + rem] = cw[(size_t)s * 512 * 64 + 64 + rem];
    }
}
__device__ __forceinline__ void sample_conv(const Args& a, unsigned char* ws, PG8_LAS unsigned char* lds, int s) {
    const int ch = opaque_v(threadIdx.x);
    const bf16_t* h = (const bf16_t*)(ws + NB_HB) + (size_t)(MP + s) * 2560;
    const float* sc = a.in[I_SCONV] + (size_t)s * 30 * 512 + ch;
    const float u = bf2f(h[ch]) * sigm_f(bf2f(h[512 + ch]));
    float scv[30], wj[31];
    const float* __restrict__ cwp = a.in[I_CONVW] + ch;
#pragma unroll
    for (int j = 0; j < 30; ++j) { scv[j] = sc[(size_t)j * 512]; wj[j] = cwp[j * 512]; }
    wj[30] = cwp[30 * 512];
    float acc = a.in[I_CONVB][ch];
#pragma unroll
    for (int j = 0; j < 30; ++j) acc = fmaf(wj[j], scv[j], acc);
    acc = fmaf(wj[30], u, acc);
    float* __restrict__ oc = a.out + O_CONVS + (size_t)s * 30 * 512 + ch;
#pragma unroll
    for (int i = 0; i < 29; ++i) oc[(size_t)i * 512] = scv[i + 1];
    oc[(size_t)29 * 512] = u;
    PG8_LAS float* red = (PG8_LAS float*)lds;
    const int lane = ch & 63, wv = ch >> 6;
    float sm = wave_sum(acc);
    __syncthreads();
    if (lane == 0) red[wv] = sm;
    __syncthreads();
    float tot = 0.f;
#pragma unroll
    for (int i = 0; i < 8; ++i) tot += red[i];
    const float mean = tot * (1.f / 512.f);
    const float d = acc - mean;
    float sq = wave_sum(d * d);
    __syncthreads();
    if (lane == 0) red[wv] = sq;
    __syncthreads();
    tot = 0.f;
#pragma unroll
    for (int i = 0; i < 8; ++i) tot += red[i];
    const float rs = rsqrtf(tot * (1.f / 512.f) + LN_EPS);
    const float y = silu_f(d * rs * a.in[I_CLNG][ch] + a.in[I_CLNB][ch]) * silu_f(bf2f(h[1024 + ch]));
    ((bf16_t*)(ws + NB_CATB))[(size_t)(MP + s) * 1024 + ch] = (bf16_t)(pk_bf16(y, 0.f) & 0xffffu);
    __syncthreads();
}

constexpr int SP_STRIDE = 66;
__device__ __forceinline__ void sample_attn(const Args& a, unsigned char* ws, PG8_LAS unsigned char* lds, int s, int g, int part) {
    const int tid = opaque_v(threadIdx.x), lane = tid & 63, wv = __builtin_amdgcn_readfirstlane(tid >> 6);
    PG8_LAS float* PC = (PG8_LAS float*)lds;
    PG8_LAS float* IMP = (PG8_LAS float*)(lds + 4096);
    PG8_LAS int* SEL = (PG8_LAS int*)(lds + 4096 + 1024);
    PG8_LAS int* FLG = (PG8_LAS int*)(lds + 4096 + 1024 + 128);
    PG8_LAS float* PS = (PG8_LAS float*)(lds + 8192) + (tid >> 6) * 64;
    const int r = wv & 3, hh = g * 4 + r;
    const float slope = __builtin_amdgcn_exp2f(-(float)(hh + 1));
    const int* pt = (const int*)a.in[I_PT] + s * NPAGE;
    const bf16_t* hrow = (const bf16_t*)(ws + NB_HB) + (size_t)(MP + s) * 2560;
    float q[64];
#pragma unroll
    for (int d8 = 0; d8 < 8; ++d8) { const u32x4 w = *(const u32x4*)(hrow + 1536 + hh * 64 + d8 * 8);
#pragma unroll
        for (int i = 0; i < 4; ++i) { q[d8 * 8 + 2 * i] = __uint_as_float(w[i] << 16); q[d8 * 8 + 2 * i + 1] = __uint_as_float(w[i] & 0xffff0000u); } }
#define SAMP_DOT(KPTR, OUT) { const float4* k4_ = (const float4*)(KPTR); float4 kk_[16]; \
        _Pragma("unroll") for (int i_ = 0; i_ < 16; ++i_) kk_[i_] = k4_[i_]; float s_ = 0.f; \
        _Pragma("unroll") for (int i_ = 0; i_ < 16; ++i_) { s_ = fmaf(q[4 * i_], kk_[i_].x, s_); s_ = fmaf(q[4 * i_ + 1], kk_[i_].y, s_); s_ = fmaf(q[4 * i_ + 2], kk_[i_].z, s_); s_ = fmaf(q[4 * i_ + 3], kk_[i_].w, s_); } OUT = s_; }
    if (wv < 4) {
        const float* kc = (const float*)(ws + NB_KCS) + (size_t)s * 256 * 256 + g * 64;
        float sc[4];
        float mx = -INFINITY;
#pragma unroll
        for (int i = 0; i < 4; ++i) { const int n = lane + 64 * i; float d; SAMP_DOT(kc + (size_t)n * 256, d); sc[i] = d - slope * (float)(PAST - (32 * n + 31)); mx = fmaxf(mx, sc[i]); }
#pragma unroll
        for (int o = 32; o > 0; o >>= 1) mx = fmaxf(mx, __shfl_xor(mx, o));
        float ls = 0.f;
#pragma unroll
        for (int i = 0; i < 4; ++i) { sc[i] = __expf(sc[i] - mx); ls += sc[i]; }
        ls = wave_sum(ls);
        const float inv = 1.f / ls;
#pragma unroll
        for (int i = 0; i < 4; ++i) PC[r * 256 + lane + 64 * i] = sc[i] * inv;
    }
    __syncthreads();
    if (wv < 4 && part == 0) {
        const float* vc = (const float*)(ws + NB_KCS) + (size_t)s * 256 * 256 + 128 + g * 64 + lane;
        float oc0 = 0.f, oc1 = 0.f, oc2 = 0.f, oc3 = 0.f;
#pragma unroll 8
        for (int n = 0; n < 256; n += 4) {
            oc0 = fmaf(PC[r * 256 + n], vc[(size_t)n * 256], oc0); oc1 = fmaf(PC[r * 256 + n + 1], vc[(size_t)(n + 1) * 256], oc1);
            oc2 = fmaf(PC[r * 256 + n + 2], vc[(size_t)(n + 2) * 256], oc2); oc3 = fmaf(PC[r * 256 + n + 3], vc[(size_t)(n + 3) * 256], oc3);
        }
        ((float*)(ws + NB_OCS))[(size_t)(s * 8 + hh) * 64 + lane] = (oc0 + oc1) + (oc2 + oc3);
    }
    if (tid < 129) {
        float v = 0.f;
        if (tid < 128) { for (int rr = 0; rr < 4; ++rr) v += PC[rr * 256 + 2 * tid] + PC[rr * 256 + 2 * tid + 1]; }
        if (tid == 0 || tid >= 127) v = 1e4f;
        IMP[tid] = v;
    }
    __syncthreads();
    if (tid < 129) {
        const float vj = IMP[tid];
        int rank = 0;
        for (int i = 0; i < 129; ++i) { const float vi = IMP[i]; rank += (vi > vj || (vi == vj && i < tid)) ? 1 : 0; }
        FLG[tid] = (rank < 16) ? 1 : 0;
    }
    __syncthreads();
    if (tid < 129 && FLG[tid]) { int slot = 0; for (int i = 0; i < tid; ++i) slot += FLG[i]; SEL[slot] = tid; }
    __syncthreads();
    const float* csel = a.in[I_CSEL];
    const float* newsel = a.out + O_SELS + (size_t)s * 256;
    const float* cwin = a.in[I_CWIN] + (size_t)s * 512 * 256;
    const float* newwin = a.out + O_WINS + (size_t)(s * 512 + 511) * 256;
#pragma unroll 1
    for (int it = 0; it < 3; ++it) {
        const int lb = (wv >> 2) + 2 * it;
        const bool is_sel = lb < 4;
        const int slot = is_sel ? part * 4 + lb : part * 2 + (lb - 4);
        const float* rowp; const float* vb; int vstride_last; float dist; bool valid; int nk;
        if (is_sel) {
            const int blk = SEL[slot];
            const int kpos = blk * 64 + lane;
            valid = kpos <= PAST;
            rowp = (blk < 128) ? csel + ((size_t)pt[blk >> 1] * PAGE + (kpos & 127)) * 256 : newsel;
            vb = (blk < 128) ? csel + ((size_t)pt[blk >> 1] * PAGE + ((blk * 64) & 127)) * 256 + 128 + g * 64 + lane : newsel + 128 + g * 64 + lane;
            nk = (blk < 128) ? 64 : 1; dist = (float)(PAST - kpos); vstride_last = 0;
        } else {
            const int i0 = 1 + slot * 64;
            const int i = i0 + lane;
            valid = true; nk = 64;
            rowp = (i < 512) ? cwin + (size_t)i * 256 : newwin;
            vb = cwin + (size_t)i0 * 256 + 128 + g * 64 + lane;
            dist = (float)(512 - i); vstride_last = (slot == 7) ? 1 : 0;
        }
        float sc = -INFINITY;
        if (valid) { float d; SAMP_DOT(rowp + g * 64, d); sc = d - slope * dist; }
        float mx = sc;
#pragma unroll
        for (int of = 32; of > 0; of >>= 1) mx = fmaxf(mx, __shfl_xor(mx, of));
        const float p = valid ? __expf(sc - mx) : 0.f;
        const float l = wave_sum(p);
        PS[lane] = p; __builtin_amdgcn_wave_barrier();
        float o0 = 0.f, o1 = 0.f, o2 = 0.f, o3 = 0.f;
        if (nk == 64) {
            float vv[64];
#pragma unroll
            for (int k = 0; k < 63; ++k) vv[k] = vb[(size_t)k * 256];
            vv[63] = vstride_last ? newwin[128 + g * 64 + lane] : vb[(size_t)63 * 256];
#pragma unroll
            for (int k = 0; k < 64; k += 4) { o0 = fmaf(PS[k], vv[k], o0); o1 = fmaf(PS[k + 1], vv[k + 1], o1); o2 = fmaf(PS[k + 2], vv[k + 2], o2); o3 = fmaf(PS[k + 3], vv[k + 3], o3); }
        } else o0 = PS[0] * vb[0];
        __builtin_amdgcn_wave_barrier();
        float* pp = (float*)(ws + NB_PARTS) + ((size_t)((s * 8 + hh) * 24 + (is_sel ? slot : 16 + slot))) * SP_STRIDE;
        pp[2 + lane] = (o0 + o1) + (o2 + o3);
        if (lane == 0) { pp[0] = mx; pp[1] = l; }
    }
#undef SAMP_DOT
    __syncthreads();
}
__device__ __forceinline__ void sample_combine(const Args& a, unsigned char* ws, int s, int g) {
    const int tid = opaque_v(threadIdx.x), lane = tid & 63, wv = __builtin_amdgcn_readfirstlane(tid >> 6);
    if (wv >= 4) return;
    const int hh = g * 4 + wv;
    const float* pp = (const float*)(ws + NB_PARTS) + (size_t)(s * 8 + hh) * 24 * SP_STRIDE;
    const float* g3p = (const float*)(ws + NB_G3) + (size_t)(MP + s) * 32 + hh * 3;
    const float gc = sigm_f(g3p[0]), gs = sigm_f(g3p[1]), gw = sigm_f(g3p[2]);
    float res = gc * ((const float*)(ws + NB_OCS))[(size_t)(s * 8 + hh) * 64 + lane];
#pragma unroll
    for (int br = 0; br < 2; ++br) {
        const int n0 = br ? 16 : 0, cnt = br ? 8 : 16;
        float M = -INFINITY;
        for (int i = 0; i < cnt; ++i) M = fmaxf(M, pp[(size_t)(n0 + i) * SP_STRIDE]);
        float L = 0.f, O = 0.f;
        for (int i = 0; i < cnt; ++i) { const float* q = pp + (size_t)(n0 + i) * SP_STRIDE; const float w = __expf(q[0] - M); L = fmaf(q[1], w, L); O = fmaf(q[2 + lane], w, O); }
        res = fmaf(br ? gw : gs, O / L, res);
    }
    const bf16_t* hrow = (const bf16_t*)(ws + NB_HB) + (size_t)(MP + s) * 2560;
    const float y = res * silu_f(bf2f(hrow[2048 + hh * 64 + lane]));
    ((bf16_t*)(ws + NB_CATB))[(size_t)(MP + s) * 1024 + 512 + hh * 64 + lane] = (bf16_t)(pk_bf16(y, 0.f) & 0xffffu);
}

static_assert(CS_END <= LDS_MISC, "chunk-scan LDS map overlaps the barrier words");
enum { PH_PREP = 0, PH_GEMM1, PH_CONV, PH_ATTN, PH_GEMM2, PH_LNS, PH_GEMM3, PH_PREP2, PH_SCAN, PH_POST, PH_GEMM4, PH_LNF, NPHASE };

__global__ void __launch_bounds__(NTH, 2) mega(Args a) {
    extern __shared__ __attribute__((aligned(16))) unsigned char lds_raw[];
    PG8_LAS unsigned char* lds = (PG8_LAS unsigned char*)lds_raw;
    unsigned char* ws = a.ws;
    volatile LAS unsigned* misc = (volatile LAS unsigned*)(lds + LDS_MISC);
    if (threadIdx.x < 4) misc[threadIdx.x] = 0u;
    __syncthreads();
    XcdBarrier bar = xcd_barrier_post((unsigned*)(ws + NB_BAR), misc);
    const int lo = a.ph_lo, hi = a.ph_hi;
#ifndef DUP_SATTN
#define DUP_SATTN 0
#endif
#ifndef DUP_CONV
#define DUP_CONV 0
#endif
#ifndef DUP_GEMM1
#define DUP_GEMM1 0
#endif
#ifndef SKIPMASK
#define SKIPMASK 0
#endif
#define IN(k) (lo <= (k) && (k) < hi && !((SKIPMASK >> (k)) & 1))
#ifndef REPMASK
#define REPMASK 0
#endif
#define REPS(k) _Pragma("unroll 1") for (int rep_ = 0; rep_ < (((REPMASK >> (k)) & 1) ? 2 : 1); ++rep_)
#define SEAM(k) do { if (IN(k) && IN((k) + 1)) xcd_barrier(bar); } while (0)
    if (IN(PH_PREP)) REPS(PH_PREP) {
        const int bid = opaque(blockIdx.x), nb = gridDim.x;
        convert_wt(a.in[I_WIN], 1024, DIN, (bf16_t*)(ws + NB_WT1), N1PAD, MapWin{}, bid, nb);
        convert_wt(a.in[I_WOUTE], 1024, 1024, (bf16_t*)(ws + NB_WT2), 1024, MapId{}, bid, nb);
        for (int n = 0; n < 4; ++n) convert_wt(a.in[I_WRKVZ] + (size_t)n * 1024 * 1024, 1024, 1024, (bf16_t*)(ws + NB_WT3) + (size_t)n * 1024 * 1024, 1024, MapId{}, bid, nb);
        convert_wt(a.in[I_WOUTO], 1024, 1024, (bf16_t*)(ws + NB_WT4), 1024, MapId{}, bid, nb);
        convert_wt(a.in[I_W1], 1024, 64, (bf16_t*)(ws + NB_W1T), 64, MapId{}, bid, nb);
        convert_wt(a.in[I_A1], 1024, 64, (bf16_t*)(ws + NB_A1T), 64, MapId{}, bid, nb);
        convert_wt(a.in[I_W2], 64, 1024, (bf16_t*)(ws + NB_W2T), 1024, MapId{}, bid, nb);
        convert_wt(a.in[I_A2], 64, 1024, (bf16_t*)(ws + NB_A2T), 1024, MapId{}, bid, nb);
        convert_rows(a.in[I_XP], (size_t)MP * 1024 / 8, (bf16_t*)(ws + NB_XB), bid, nb);
        convert_rows(a.in[I_XS], (size_t)BS * 1024 / 8, (bf16_t*)(ws + NB_XSB), bid, nb);
        sample_pool_copy(a, ws, bid, nb);
    }
    SEAM(PH_PREP);
    if (IN(PH_GEMM1)) REPS(PH_GEMM1) {
        const int bid = opaque(blockIdx.x), nb = gridDim.x;
        const Route1 R{(bf16_t*)(ws + NB_HB), (bf16_t*)(ws + NB_KVB), (float*)(ws + NB_G3), a.out};
        {
            pg8::Gemm g{(const bf16_t*)(ws + NB_XB), (const bf16_t*)(ws + NB_WT1), MP, N1PAD, 1024};
            pg8::StaticOrder S; S.init(MP, N1PAD, nb, bid);
            Epi1 E{R};
            pg8::gemm_phase<Epi1, pg8::StaticOrder, false>(lds, g, S, E, nullptr);
#if DUP_GEMM1
            __syncthreads();
            pg8::gemm_phase<Epi1, pg8::StaticOrder, false>(lds, g, S, E, nullptr);
#endif
        }
        {
            for (int task = bid; task < 105; task += nb) {
                sample_gemm32_wg((const bf16_t*)(ws + NB_XSB), (const bf16_t*)(ws + NB_WT1), 1024, task * 32, lds,
                    [&](int r, int n, float v) {
                        const int row = MP + r;
                        if (n < 2560) { const float sc = (n >= 1536 && n < 2048) ? 0.125f : 1.0f; ((bf16_t*)(ws + NB_HB))[(size_t)row * 2560 + n] = (bf16_t)(pk_bf16c(v * sc, 0.f) & 0xffffu); }
                        else if (n < 3328) { const int c = n - 2560, i3 = c >> 8, cc = c & 255; ((bf16_t*)(ws + NB_KVB))[(size_t)row * 768 + c] = (bf16_t)(pk_bf16c(v, 0.f) & 0xffffu);
                            float* dst = (i3 == 0) ? a.out + O_CMPS + (size_t)r * 256 + cc : (i3 == 1) ? a.out + O_SELS + (size_t)r * 256 + cc : a.out + O_WINS + (size_t)(r * 512 + 511) * 256 + cc;
                            *dst = v; }
                        else if (n < 3352) ((float*)(ws + NB_G3))[(size_t)row * 32 + (n - 3328)] = v;
                    });
            }
        }
    }
    SEAM(PH_GEMM1);
    if (IN(PH_CONV)) REPS(PH_CONV) {
        const int bid = opaque(blockIdx.x), nb = gridDim.x;
        for (int item = bid; item < 256; item += nb) conv_item(a, ws, lds, item);
#if DUP_CONV
        for (int item = bid; item < 256; item += nb) conv_item(a, ws, lds, item);
#endif
        pool_prompt(a, ws, bid, nb);
        sample_attn(a, ws, lds, bid >> 3, (bid >> 2) & 1, bid & 3);
#if DUP_SATTN
        __syncthreads();
        sample_attn(a, ws, lds, bid >> 3, (bid >> 2) & 1, bid & 3);
#endif
        if (bid >= 96 && bid < 128) sample_conv(a, ws, lds, bid - 96);
    }
    SEAM(PH_CONV);
    if (IN(PH_ATTN)) REPS(PH_ATTN) {
        const int bid = opaque(blockIdx.x), nb = gridDim.x;
        if (bid < 64) sample_combine(a, ws, bid >> 1, bid & 1);
        for (int pr = bid; pr < 256; pr += nb) {
            const int b = pr >> 5, g = (pr >> 4) & 1, xq = pr & 15;
#pragma unroll 1
            for (int k = 0; k < 2; ++k) attn_item(a, ws, lds, b, g, k ? xq : 31 - xq);
        }
    }
    SEAM(PH_ATTN);
    if (IN(PH_GEMM2)) REPS(PH_GEMM2) {
        const int bid = opaque(blockIdx.x), nb = gridDim.x;
        {
            pg8::Gemm g{(const bf16_t*)(ws + NB_CATB), (const bf16_t*)(ws + NB_WT2), MP, 1024, 1024};
            pg8::StaticOrder S; S.init(MP, 1024, nb, bid);
            EpiPreRes E{(float*)ws + WS_PRE, a.in[I_XP]};
            pg8::gemm_phase<EpiPreRes, pg8::StaticOrder, false>(lds, g, S, E, nullptr);
        }
        {
            const int lane = threadIdx.x & 63, wv = __builtin_amdgcn_readfirstlane(threadIdx.x >> 6);
            float* PREs = (float*)ws + WS_PRE + (size_t)MP * 1024;
            const float* xs = a.in[I_XS];
            for (int task = bid; task < 32; task += nb)
                sample_gemm32_wg((const bf16_t*)(ws + NB_CATB) + (size_t)MP * 1024, (const bf16_t*)(ws + NB_WT2), 1024, task * 32, lds,
                              [&](int r, int n, float v) { PREs[(size_t)r * 1024 + n] = fmaf(ALPHA, xs[(size_t)r * 1024 + n], v); });
        }
    }
    SEAM(PH_GEMM2);
    if (IN(PH_LNS)) REPS(PH_LNS) { const int bid = opaque(blockIdx.x), nb = gridDim.x; phase_lns(a, ws, bid, nb); }
    SEAM(PH_LNS);
    if (IN(PH_GEMM3)) REPS(PH_GEMM3) {
        const int bid = opaque(blockIdx.x), nb = gridDim.x;
        {
            pg8::Gemm g{(const bf16_t*)(ws + NB_XSH), (const bf16_t*)(ws + NB_WT3), MP, 4096, 1024};
            Order3 S; S.init(nb, bid);
            Epi3 E{(bf16_t*)(ws + NB_RKVZ)};
            pg8::gemm_phase<Epi3, Order3, false>(lds, g, S, E, nullptr);
        }
        {
            const int lane = threadIdx.x & 63, wv = __builtin_amdgcn_readfirstlane(threadIdx.x >> 6);
            for (int task = bid; task < 128; task += nb) {
                const int n = task >> 5, n0 = (task & 31) * 32;
                bf16_t* dst = (bf16_t*)(ws + NB_RKVZ) + ((size_t)n * XSH_ROWS + MP) * 1024;
                sample_gemm32_wg((const bf16_t*)(ws + NB_XSH) + ((size_t)n * XSH_ROWS + MP) * 1024, (const bf16_t*)(ws + NB_WT3) + (size_t)n * 1024 * 1024, 1024, n0, lds,
                              [&](int r, int c, float v) { dst[(size_t)r * 1024 + c] = (bf16_t)(pk_bf16c(v, 0.f) & 0xffffu); });
            }
            for (int task = bid * 8 + wv; task < 513 * 4; task += nb * 8) {
                const int rt = task >> 2, which = (task >> 1) & 1, n0 = (task & 1) * 32;
                const bf16_t* A = (const bf16_t*)(ws + NB_XSH) + ((size_t)(4 + which) * XSH_ROWS + (size_t)rt * 32) * 1024;
                bf16_t* dst = (bf16_t*)(ws + (which ? NB_AWB : NB_TWB)) + (size_t)rt * 32 * 64;
                sample_gemm32(A, (const bf16_t*)(ws + (which ? NB_A1T : NB_W1T)), 1024, n0, lane,
                              [&](int r, int c, float v) { dst[(size_t)r * 64 + c] = (bf16_t)(pk_bf16c(which ? v : tanhf(v), 0.f) & 0xffffu); });
            }
        }
    }
    SEAM(PH_GEMM3);
    if (IN(PH_PREP2)) REPS(PH_PREP2) {
        const int bid = opaque(blockIdx.x), nb = gridDim.x;
        for (int pr = bid; pr < 256; pr += nb) {
            const int bh = pr >> 1, b = bh >> 4, hd = bh & 15, c0 = (pr & 1) * 16;
            const int tidp = opaque_v(threadIdx.x), lanep = tidp & 63, wvp = tidp >> 6;
            bf16x8 btf[4];
            { const int which = wvp >> 2, nt = wvp & 1;
              const bf16_t* Bt = (const bf16_t*)(ws + (which ? NB_A2T : NB_W2T)) + (size_t)(hd * 64 + nt * 32 + (lanep & 31)) * 64 + (lanep >> 5) * 8;
#pragma unroll
              for (int s4 = 0; s4 < 4; ++s4) btf[s4] = *(const bf16x8*)(Bt + s4 * 16); }
            PreRegs pcur, pnxt;
            scanpre_load(ws, b, hd, c0, tidp, pnxt);
#pragma unroll 1
            for (int cc = 0; cc < 16; ++cc) {
                pcur = pnxt;
                if (cc + 1 < 16) scanpre_load(ws, b, hd, c0 + cc + 1, tidp, pnxt);
                scanpre_chunk(a, ws, lds, b, hd, c0 + cc, pcur, btf);
            }
        }
        const int lane = opaque_v(threadIdx.x) & 63, wv = __builtin_amdgcn_readfirstlane(threadIdx.x >> 6);
        for (int task = bid * 8 + wv; task < 16; task += nb * 8) prep2_task(a, ws, 512, task, lane);
    }
    SEAM(PH_PREP2);
    if (IN(PH_SCAN)) REPS(PH_SCAN) {
        const int bid = opaque(blockIdx.x), nb = gridDim.x;
#pragma unroll 1
        for (int item = bid; item < 128; item += nb) scanseq_head(a, ws, lds, item >> 4, item & 15);
        const int lane = opaque_v(threadIdx.x) & 63, wv = __builtin_amdgcn_readfirstlane(threadIdx.x >> 6);
        for (int task = (nb - 1 - bid) * 8 + wv; task < BS * 16; task += nb * 8) scan_sample(a, ws, task >> 4, task & 15, lane);
    }
    if (IN(PH_SCAN) && IN(PH_GEMM4)) xcd_barrier(bar);
    if (IN(PH_GEMM4)) REPS(PH_GEMM4) {
        const int bid = opaque(blockIdx.x), nb = gridDim.x;
        {
            pg8::Gemm g{(const bf16_t*)(ws + NB_G4B), (const bf16_t*)(ws + NB_WT4), MP, 1024, 1024};
            pg8::StaticOrder S; S.init(MP, 1024, nb, bid);
            EpiPre E{(float*)(ws + NB_Y), 1024};
            pg8::gemm_phase<EpiPre, pg8::StaticOrder, false>(lds, g, S, E, nullptr);
        }
        {
            float* PREs = (float*)(ws + NB_Y) + (size_t)MP * 1024;
            for (int task = bid; task < 32; task += nb)
                sample_gemm32_wg((const bf16_t*)(ws + NB_G4B) + (size_t)MP * 1024, (const bf16_t*)(ws + NB_WT4), 1024, task * 32, lds,
                              [&](int r, int n, float v) { PREs[(size_t)r * 1024 + n] = v; });
        }
    }
    SEAM(PH_GEMM4);
    if (IN(PH_LNF)) REPS(PH_LNF) { const int bid = opaque(blockIdx.x), nb = gridDim.x; phase_lnf(a, ws, bid, nb); }
#undef IN
#undef SEAM
}
}

extern "C" void kernel_launch(void* const* d_in, const int* in_sizes, int n_in, void* d_out, int out_size, void* d_ws, size_t ws_size,
                              hipStream_t stream) {
    if (n_in != N_IN || ws_size < nk::NB_END) { fprintf(stderr, "kernel_launch: unexpected n_in %d or ws_size %zu (need %zu)\n", n_in, ws_size, (size_t)nk::NB_END); return; }
    static int grid = 0;
    if (!grid) {
        int dev = 0, cus = 0, per_cu = 0;
        hipGetDevice(&dev);
        hipDeviceGetAttribute(&cus, hipDeviceAttributeMultiprocessorCount, dev);
        hipFuncSetAttribute((const void*)nk::mega, hipFuncAttributeMaxDynamicSharedMemorySize, nk::LDS_BYTES);
        hipOccupancyMaxActiveBlocksPerMultiprocessor(&per_cu, (const void*)nk::mega, nk::NTH, nk::LDS_BYTES);
        if (per_cu < 1) fprintf(stderr, "kernel_launch: occupancy query says %d blocks per CU\n", per_cu);
        grid = cus;
    }
    hipMemsetAsync((unsigned char*)d_ws + nk::NB_BAR, 0, 32768, stream);
    nk::Args a{};
    for (int i = 0; i < N_IN; ++i) a.in[i] = (const float*)d_in[i];
    a.out = (float*)d_out; a.ws = (unsigned char*)d_ws; a.ph_lo = 0; a.ph_hi = nk::NPHASE;
    void* args[] = {&a};
    hipError_t e = hipLaunchCooperativeKernel((const void*)nk::mega, dim3(grid), dim3(nk::NTH), args, nk::LDS_BYTES, stream);
    if (e != hipSuccess) fprintf(stderr, "cooperative launch failed: %s (grid %d)\n", hipGetErrorString(e), grid);
}
```

```cpp
#include <hip/hip_runtime.h>
#include <hip/hip_cooperative_groups.h>
#include <cstdio>
namespace cg = cooperative_groups;

constexpr int D = 1024, BP = 8, TP = 2048, MP = BP * TP, BS = 32, MT = MP + BS;
constexpr int DIN = 3352;
constexpr int C_AVAL = 0, C_AGLU = 512, C_ZA = 1024, C_Q = 1536, C_KV = 2048, C_G3 = 2816, C_ZB = 2840;
constexpr int C_CMP = C_KV, C_SEL = C_KV + 256, C_WIN = C_KV + 512;
constexpr int PAST = 8192, NPAGE = 64, PAGE = 128;
constexpr float ALPHA = 1.4142135623730951f;
constexpr float LN_EPS = 1e-5f, GN_EPS = 64e-5f;

constexpr size_t O_Y = 0, O_YS = 16777216, O_CMPP = 16809984, O_CMPS = 21004288, O_SELP = 21012480, O_SELS = 25206784,
                 O_WINP = 25214976, O_WINS = 26263552, O_CONVP = 30457856, O_CONVS = 30580736, O_WKVP = 31072256,
                 O_WKVS = 31596544, O_SHP = 33693696, O_SHS = 33701888;

enum { I_XP = 0, I_XS, I_CCMP, I_CSEL, I_CWIN, I_SCONV, I_SWKV, I_SSHIFT, I_PT, I_WIN, I_CONVW, I_CONVB, I_CLNG, I_CLNB,
       I_WKC, I_WVC, I_WOUTE, I_MU, I_WRKVZ, I_W0, I_W1, I_W2, I_A0, I_A1, I_A2, I_KK, I_KA, I_RK, I_GNG, I_GNB, I_WOUTO,
       I_LNG, I_LNB, N_IN };

constexpr size_t SZ_ROWD = (size_t)MT * D;
constexpr size_t WS_H = 0;
constexpr size_t WS_CAT = WS_H + (size_t)MT * DIN;
constexpr size_t WS_OC = WS_CAT + SZ_ROWD;
constexpr size_t WS_XSH = 0;
constexpr size_t WS_Y = 0;
constexpr size_t WS_G4 = SZ_ROWD;
constexpr size_t WS_R0END = 6 * SZ_ROWD;
constexpr size_t WS_PRE = WS_R0END;
constexpr size_t WS_X1 = WS_PRE + SZ_ROWD;
constexpr size_t WS_R = WS_X1 + SZ_ROWD;
constexpr size_t WS_K = WS_R + SZ_ROWD;
constexpr size_t WS_V = WS_K + SZ_ROWD;
constexpr size_t WS_Z = WS_V + SZ_ROWD;
constexpr size_t WS_DEC = WS_Z + SZ_ROWD;
constexpr size_t WS_KKN = WS_DEC + SZ_ROWD;
constexpr size_t WS_KKA = WS_KKN + SZ_ROWD;
constexpr size_t WS_TW = WS_KKA + SZ_ROWD;
constexpr size_t WS_AW = WS_TW + (size_t)MT * 64;
constexpr size_t WS_RK = WS_AW + (size_t)MT * 64;
constexpr size_t WS_END = WS_RK + (size_t)MT * 16;
constexpr size_t WS_PCP = WS_R;
constexpr size_t WS_PCS = WS_R + (size_t)MP * 8 * 64;
constexpr size_t WS_IMP = WS_K;
constexpr size_t WS_SELIDX = WS_V;
constexpr size_t WS_KCP = WS_Z;
constexpr size_t WS_KCS = WS_Z + (size_t)8 * 64 * 256;
static_assert(WS_OC + (size_t)MT * 512 <= WS_R0END, "layer0 temporaries overflow region 0");

namespace pg8 {
#define PG8_LAS __attribute__((address_space(3)))
typedef unsigned short bf16_t;
typedef short bf16x8 __attribute__((ext_vector_type(8)));
typedef float f32x4 __attribute__((ext_vector_type(4)));
typedef unsigned u32x4 __attribute__((ext_vector_type(4)));
constexpr int BM = 256, BK = 64, HALF = 128, HTB = HALF * BK * 2  , STAGE_BYTES = 8 * HTB, NXCD = 8, WGM = 8;

__host__ __device__ __forceinline__ int lds_byte(int r, int c) { const int st = (r >> 4) * 2 + (c >> 5), rr = r & 15, cc = c & 31, ob = rr * 64 + cc * 2; return st * 1024 + (ob ^ (((ob >> 9) & 1) << 5)); }
__host__ __device__ __forceinline__ void stage_rc(int b, int& R, int& C) { const int st = b / 1024, sb = b % 1024, swz = sb ^ (((sb >> 9) & 1) << 5); R = (st >> 1) * 16 + swz / 64; C = (st & 1) * 32 + (swz % 64) / 2; }
__host__ __device__ __forceinline__ int perm32(int rho) { const int n = rho >> 4, i = rho & 15; return 8 * (i >> 2) + 4 * n + (i & 3); }

struct Unit { int pm, pn; };
struct Gemm { const bf16_t* A; const bf16_t* Bt; int M, N, K; };

struct StaticOrder {
    int nM, nN, nwg, G, c;
    __host__ __device__ void init(int M, int N, int G_, int c_) { nM = M / BM; nN = N / BM; nwg = nM * nN; G = G_; c = c_; }
    __host__ __device__ bool next(int i, Unit& u) const {
        const long L = (long)i * G + c; if (L >= nwg) return false;
        int wgid = (int)L; { const int q = nwg / NXCD, r = nwg % NXCD, xcd = wgid % NXCD, off = wgid / NXCD; wgid = (xcd < r ? xcd * (q + 1) : r * (q + 1) + (xcd - r) * q) + off; }
        const int nig = WGM * nN, gid = wgid / nig, fm = gid * WGM, gsz = (nM - fm) < WGM ? (nM - fm) : WGM;
        u.pm = fm + ((wgid % nig) % gsz); u.pn = (wgid % nig) / gsz; return true;
    }
    __device__ __forceinline__ void a_ready(const Unit&) const {}
    __device__ __forceinline__ void done(const Unit&) const {}
};
struct CountedOrder : StaticOrder {
    const unsigned* ready; unsigned need; unsigned* tmo;
    __device__ __forceinline__ void a_ready(const Unit& u) const {
        if (threadIdx.x < 64) {
            const unsigned long long t0 = __builtin_amdgcn_s_memrealtime(); unsigned polls = 0;
            while ((unsigned)__builtin_amdgcn_readfirstlane(__hip_atomic_load(ready + 64 * u.pm, __ATOMIC_RELAXED, __HIP_MEMORY_SCOPE_AGENT)) < need) {
                if ((++polls & 255u) == 0u && __builtin_amdgcn_readfirstlane(__hip_atomic_load(tmo, __ATOMIC_RELAXED, __HIP_MEMORY_SCOPE_AGENT)) != 0u) break;
                if (__builtin_amdgcn_s_memrealtime() - t0 > 2000000ull) {
                    if (threadIdx.x == 0) { unsigned expect = 0u; __hip_atomic_compare_exchange_strong(tmo + 1, &expect, 0x600u | (unsigned)(u.pm & 0xff), __ATOMIC_RELAXED, __ATOMIC_RELAXED, __HIP_MEMORY_SCOPE_AGENT); __hip_atomic_store(tmo, 1u, __ATOMIC_RELAXED, __HIP_MEMORY_SCOPE_AGENT); }
                    break; }
                __builtin_amdgcn_s_sleep(2); }
            __builtin_amdgcn_fence(__ATOMIC_ACQUIRE, "agent");
            asm volatile("s_waitcnt vmcnt(0)" ::: "memory");
        }
#if !defined(BROKEN_HOOK_NO_BARRIER)
        asm volatile("" ::: "memory"); __builtin_amdgcn_s_barrier(); asm volatile("" ::: "memory");
#endif
    }
};


template <class Epi, class Sched, bool STAMP = false>
__device__ __forceinline__ void gemm_phase(PG8_LAS unsigned char* lds, const Gemm g, const Sched& S, const Epi& E, unsigned long long* stamps) {
    int tid_ = threadIdx.x; asm volatile("" : "+v"(tid_));
    const int tid = tid_, wid = __builtin_amdgcn_readfirstlane(tid >> 6), lane = tid & 63, wr = wid >> 2, wc = wid & 3, fr = lane & 15, fq = lane >> 4;
    const int K = g.K, nt = K / BK;
    int ts_lo = 0, ts_hi = 0, nts = 0; const unsigned long long rt_entry = STAMP ? (unsigned long long)wall_clock64() : 0ull;
#define PG8_STAMP() do { if (STAMP && wid == 0 && nts < 64) { const unsigned long long _c = (unsigned long long)clock64(); \
        ts_lo = (lane == nts) ? (int)(unsigned)_c : ts_lo; ts_hi = (lane == nts) ? (int)(unsigned)(_c >> 32) : ts_hi; ++nts; } } while (0)
    PG8_STAMP();
    unsigned voffA[2], voffB[2];
#pragma unroll
    for (int i = 0; i < 2; ++i) { int R, C; stage_rc(tid * 16 + i * 8192, R, C); const int Rb = Epi::PERM ? ((R & ~31) + perm32(R & 31)) : R;
        voffA[i] = (unsigned)(R * K + C) * 2u; voffB[i] = (unsigned)(Rb * K + C) * 2u; }
    const size_t kstep = (size_t)(BK * 2);
    const size_t hstep = (size_t)HALF * K * 2;
    const size_t tstep = 2 * hstep;
    const unsigned ldsw = (unsigned)wid * 1024u;
    const int aoff = lds_byte(wr * 64 + fr, fq * 8), boff = lds_byte(wc * 32 + fr, fq * 8);
#define PG8_SA(b, h) (((b) * 2 + (h)) * HTB)
#define PG8_SB(b, h) ((4 + (b) * 2 + (h)) * HTB)
#define PG8_STAGE(bufoff, gbase, voff) do { _Pragma("unroll") for (int _i = 0; _i < 2; ++_i) \
        __builtin_amdgcn_global_load_lds((const unsigned*)((const char*)(gbase) + (voff)[_i]), (PG8_LAS unsigned*)(lds + (bufoff) + ldsw + _i * 8192), 16, 0, 0); } while (0)
#define PG8_LDA(dst, b, h) do { _Pragma("unroll") for (int m = 0; m < 4; ++m) _Pragma("unroll") for (int k = 0; k < 2; ++k) dst[m][k] = *(const PG8_LAS bf16x8*)(lds + PG8_SA(b, h) + aoff + m * 2048 + k * 1024); } while (0)
#define PG8_LDB(dst, b, h) do { _Pragma("unroll") for (int n = 0; n < 2; ++n) _Pragma("unroll") for (int k = 0; k < 2; ++k) dst[n][k] = *(const PG8_LAS bf16x8*)(lds + PG8_SB(b, h) + boff + n * 2048 + k * 1024); } while (0)
#define PG8_MMA(ai, bj, At, Bt) do { __builtin_amdgcn_s_setprio(1); _Pragma("unroll") for (int m = 0; m < 4; ++m) _Pragma("unroll") for (int n = 0; n < 2; ++n) _Pragma("unroll") for (int k = 0; k < 2; ++k) \
        acc[ai][bj][m][n] = __builtin_amdgcn_mfma_f32_16x16x32_bf16(Bt[n][k], At[m][k], acc[ai][bj][m][n], 0, 0, 0); __builtin_amdgcn_s_setprio(0); } while (0)
#define PG8_WAIT_V(n) asm volatile("s_waitcnt vmcnt(" #n ")" ::: "memory")
#define PG8_WAIT_L(n) asm volatile("s_waitcnt lgkmcnt(" #n ")" ::: "memory")
#define PG8_BAR __builtin_amdgcn_s_barrier()
#define PG8_SCHED __builtin_amdgcn_sched_barrier(0)
    Unit cur, nxt; int ui = 0;
    if (!S.next(0, cur)) return;
    f32x4 acc[2][2][4][2];
#pragma unroll
    for (int a = 0; a < 2; ++a)
#pragma unroll
        for (int b = 0; b < 2; ++b)
#pragma unroll
            for (int m = 0; m < 4; ++m)
#pragma unroll
                for (int n = 0; n < 2; ++n) acc[a][b][m][n] = (f32x4){0.f, 0.f, 0.f, 0.f};
    bf16x8 At[4][2], B0[2][2], B1[2][2];
    const char* cA = (const char*)g.A + (size_t)cur.pm * tstep; const char* cB = (const char*)g.Bt + (size_t)cur.pn * tstep;
    S.a_ready(cur);
    PG8_STAGE(PG8_SB(0, 0), cB, voffB); PG8_STAGE(PG8_SA(0, 0), cA, voffA); PG8_STAGE(PG8_SB(0, 1), cB + hstep, voffB); PG8_STAGE(PG8_SA(0, 1), cA + hstep, voffA);
    if (wr == 1) PG8_BAR;
    PG8_WAIT_V(4); PG8_BAR;
    PG8_STAGE(PG8_SB(1, 0), cB + kstep, voffB); PG8_STAGE(PG8_SA(1, 0), cA + kstep, voffA); PG8_STAGE(PG8_SB(1, 1), cB + hstep + kstep, voffB);
    PG8_WAIT_V(6); PG8_BAR;
    PG8_STAMP();
    for (;;) {
        const bool has_next = S.next(ui + 1, nxt);
        const char* nA = has_next ? (const char*)g.A + (size_t)nxt.pm * tstep : cA; const char* nB = has_next ? (const char*)g.Bt + (size_t)nxt.pn * tstep : cB;
        for (int t = 0; t < nt; t += 2) {
            const bool last = (t == nt - 2);
            const char* a1 = cA + (size_t)(t + 1) * kstep;
            const char* a2 = last ? nA : cA + (size_t)(t + 2) * kstep; const char* b2 = last ? nB : cB + (size_t)(t + 2) * kstep;
            const char* a3 = a2 + kstep; const char* b3 = b2 + kstep;
            if (last && has_next) S.a_ready(nxt);
            PG8_LDB(B0, 0, 0); PG8_SCHED; PG8_LDA(At, 0, 0); PG8_STAGE(PG8_SA(1, 1), a1 + hstep, voffA);
            PG8_WAIT_L(8); PG8_BAR; PG8_WAIT_L(0); PG8_MMA(0, 0, At, B0); PG8_BAR; PG8_SCHED;
            PG8_LDB(B1, 0, 1); PG8_STAGE(PG8_SB(0, 0), b2, voffB);
            PG8_BAR; PG8_WAIT_L(0); PG8_MMA(0, 1, At, B1); PG8_BAR;
            PG8_LDA(At, 0, 1); PG8_STAGE(PG8_SA(0, 0), a2, voffA);
            PG8_BAR; PG8_WAIT_L(0); PG8_MMA(1, 0, At, B0); PG8_BAR; PG8_SCHED;
            PG8_STAGE(PG8_SB(0, 1), b2 + hstep, voffB);
            PG8_WAIT_V(6); PG8_BAR; PG8_MMA(1, 1, At, B1); PG8_BAR;
            PG8_LDB(B0, 1, 0); PG8_SCHED; PG8_LDA(At, 1, 0); PG8_STAGE(PG8_SA(0, 1), a2 + hstep, voffA);
            PG8_WAIT_L(8); PG8_BAR; PG8_WAIT_L(0); PG8_MMA(0, 0, At, B0); PG8_BAR; PG8_SCHED;
            PG8_LDB(B1, 1, 1); PG8_STAGE(PG8_SB(1, 0), b3, voffB);
            PG8_BAR; PG8_WAIT_L(0); PG8_MMA(0, 1, At, B1); PG8_BAR;
            PG8_LDA(At, 1, 1); PG8_STAGE(PG8_SA(1, 0), a3, voffA);
            PG8_BAR; PG8_WAIT_L(0); PG8_MMA(1, 0, At, B0); PG8_BAR; PG8_SCHED;
            PG8_STAGE(PG8_SB(1, 1), b3 + hstep, voffB);
            PG8_WAIT_V(6); PG8_BAR; PG8_MMA(1, 1, At, B1); PG8_BAR;
        }
        PG8_STAMP();
        if constexpr (!Epi::AFTER_DRAIN) { E(acc, cur, wr, wc, fr, fq); S.done(cur); }
        PG8_STAMP();
        if (!has_next) break;
#pragma unroll
        for (int a = 0; a < 2; ++a)
#pragma unroll
            for (int b = 0; b < 2; ++b)
#pragma unroll
                for (int m = 0; m < 4; ++m)
#pragma unroll
                    for (int n = 0; n < 2; ++n) acc[a][b][m][n] = (f32x4){0.f, 0.f, 0.f, 0.f};
        cur = nxt; cA = nA; cB = nB; ++ui;
    }
    PG8_WAIT_V(0);
    if (wr == 0) PG8_BAR;
    PG8_BAR;
    if constexpr (Epi::AFTER_DRAIN) { E.fused(acc, cur, wr, wc, fr, fq, lds, wid, lane); S.done(cur); }
    PG8_STAMP();
    if (STAMP && wid == 0) { stamps[lane] = lane < nts ? (((unsigned long long)(unsigned)ts_hi << 32) | (unsigned)ts_lo) : 0ull;
        if (lane == 62) stamps[62] = rt_entry; if (lane == 63) stamps[63] = (unsigned long long)wall_clock64(); }
#undef PG8_STAMP
#undef PG8_SA
#undef PG8_SB
#undef PG8_STAGE
#undef PG8_LDA
#undef PG8_LDB
#undef PG8_MMA
#undef PG8_WAIT_V
#undef PG8_WAIT_L
#undef PG8_BAR
#undef PG8_SCHED
}
}

#define XB_TMO      128
#define XB_XCNT(j)  (256  + 64 * (j))
#define XB_XSUB(j)  (1280 + 64 * (j))
#define XB_XGEN(j)  (2304 + 64 * (j))
#define XB_TOP      3328
#define XB_TOPGEN   3392
#define XCD_BAR_WORDS 3456
#define XB_SPIN_CAP (1u << 18)
#define LAS __attribute__((address_space(3)))

__device__ __forceinline__ unsigned xb_ld(unsigned* p)              { return __hip_atomic_load(p, __ATOMIC_RELAXED, __HIP_MEMORY_SCOPE_AGENT); }
__device__ __forceinline__ unsigned xb_add(unsigned* p, unsigned v) { return __hip_atomic_fetch_add(p, v, __ATOMIC_RELAXED, __HIP_MEMORY_SCOPE_AGENT); }
__device__ __forceinline__ unsigned xb_xcc_id() { return (unsigned)__builtin_amdgcn_s_getreg((3 << 11) | 20) & 0xFu; }
#define XB_SPIN(cond, bar) do { unsigned _sp = 0; while (cond) { __builtin_amdgcn_s_sleep(1); \
    if ((++_sp & 255u) == 0u) { if (xb_ld(&(bar)[XB_TMO])) break; if (_sp > XB_SPIN_CAP) { atomicAdd(&(bar)[XB_TMO], 1u); break; } } } } while (0)

struct XcdBarrier {
    unsigned* bar; unsigned x;
    volatile LAS unsigned* st;
};

__device__ __forceinline__ XcdBarrier xcd_barrier_post(unsigned* bar, volatile LAS unsigned* st) {
    XcdBarrier b; b.bar = bar; b.x = xb_xcc_id(); b.st = st;
    if (threadIdx.x == 0) (void)xb_add(&bar[XB_XCNT(b.x)], 1u);
    return b;
}
__device__ __forceinline__ void xcd_barrier_complete(unsigned* bar, unsigned x, unsigned& nloc, unsigned& nx) {
    const unsigned G = gridDim.x * gridDim.y * gridDim.z;
    unsigned sum, cnt, mine, sp = 0u;
    for (;;) {
        sum = 0u; cnt = 0u; mine = 0u;
#pragma unroll
        for (unsigned j = 0; j < 16; ++j) { const unsigned c = xb_ld(&bar[XB_XCNT(j)]); sum += c; cnt += (c > 0u) ? 1u : 0u; mine = (j == x) ? c : mine; }
        if (sum == G) break;
        __builtin_amdgcn_s_sleep(1);
        if ((++sp & 255u) == 0u) { if (xb_ld(&bar[XB_TMO])) break; if (sp > XB_SPIN_CAP) { atomicAdd(&bar[XB_TMO], 1u); break; } }
    }
    nloc = mine > 0u ? mine : 1u; nx = cnt > 0u ? cnt : 1u;
}

__device__ __forceinline__ void xcd_barrier(const XcdBarrier& b) {
    asm volatile("s_waitcnt vmcnt(0)" ::: "memory");
    __syncthreads();
    if (threadIdx.x == 0) {
        unsigned* bar = b.bar;
        __builtin_amdgcn_s_waitcnt(0);
        unsigned nloc = b.st[0], nx = b.st[1];
        if (nloc == 0u) { xcd_barrier_complete(bar, b.x, nloc, nx); b.st[0] = nloc; b.st[1] = nx; }
        const unsigned old = xb_add(&bar[XB_XSUB(b.x)], 1u);
        const unsigned gen = old / nloc;
        if (old + 1u == (gen + 1u) * nloc) {
            __builtin_amdgcn_fence(__ATOMIC_RELEASE, "agent");
            asm volatile("s_waitcnt vmcnt(0)" ::: "memory");
            const unsigned og = xb_add(&bar[XB_TOP], 1u);
            const unsigned tg = og / nx;
            if (og + 1u == (tg + 1u) * nx) xb_add(&bar[XB_TOPGEN], 1u);
            else XB_SPIN(xb_ld(&bar[XB_TOPGEN]) == tg, bar);
            __builtin_amdgcn_fence(__ATOMIC_ACQUIRE, "agent");
            xb_add(&bar[XB_XGEN(b.x)], 1u);
            asm volatile("s_waitcnt vmcnt(0)" ::: "memory");
        } else {
            XB_SPIN(xb_ld(&bar[XB_XGEN(b.x)]) == gen, bar);
            __builtin_amdgcn_fence(__ATOMIC_ACQUIRE, "agent");
            asm volatile("s_waitcnt vmcnt(0)" ::: "memory");
        }
    }
    __syncthreads();
}

namespace nk {
using pg8::bf16_t; using pg8::bf16x8; using pg8::f32x4; using pg8::u32x4; using pg8::Unit;
constexpr int NTH = 512;
constexpr int LDS_STAGE = pg8::STAGE_BYTES;
constexpr int LDS_MISC = 158720;
constexpr int LDS_BYTES = LDS_MISC + 1024;

constexpr size_t NB0 = WS_END * 4;
constexpr size_t NB_BAR = NB0;
constexpr size_t NB_WT1 = NB_BAR + 32768;
constexpr size_t NB_WT2 = NB_WT1 + (size_t)3584 * 1024 * 2;
constexpr size_t NB_XB = NB_WT2 + (size_t)1024 * 1024 * 2;
constexpr size_t NB_XSB = NB_XB + (size_t)MP * 1024 * 2;
constexpr size_t NB_HB = NB_XSB + (size_t)BS * 1024 * 2;
constexpr size_t NB_KVB = NB_HB + (size_t)MT * 2560 * 2;
constexpr size_t NB_G3 = NB_KVB + (size_t)MT * 768 * 2;
constexpr size_t NB_CATB = NB_G3 + (size_t)MT * 32 * 4;
constexpr size_t NB_CBUF = NB_CATB + (size_t)MT * 1024 * 2;
constexpr size_t NB_KCB = NB_CBUF + (size_t)MP * 512 * 4;
constexpr size_t NB_WT3 = NB_KCB + (size_t)BP * 64 * 256 * 2;
constexpr size_t NB_WT4 = NB_WT3 + (size_t)4 * 1024 * 1024 * 2;
constexpr size_t NB_W1T = NB_WT4 + (size_t)1024 * 1024 * 2;
constexpr size_t NB_A1T = NB_W1T + (size_t)64 * 1024 * 2;
constexpr size_t NB_W2T = NB_A1T + (size_t)64 * 1024 * 2;
constexpr size_t NB_A2T = NB_W2T + (size_t)64 * 1024 * 2;
constexpr size_t NB_KCS = NB_A2T + (size_t)64 * 1024 * 2;
constexpr size_t NB_OCS = NB_KCS + (size_t)BS * 256 * 256 * 4;
constexpr size_t NB_PARTS = NB_OCS + (size_t)BS * 8 * 64 * 4;
constexpr size_t NB_END = NB_PARTS + (size_t)BS * 8 * 24 * 66 * 4;
constexpr size_t NB_XSH = 0;
constexpr size_t NB_RKVZ = NB_XSH + (size_t)6 * 16640 * 1024 * 2;
constexpr size_t NB_TWB = NB_RKVZ + (size_t)4 * 16640 * 1024 * 2;
constexpr size_t NB_AWB = NB_TWB + (size_t)MT * 64 * 2;
constexpr size_t NB_RKS = NB_AWB + (size_t)MT * 64 * 2;
static_assert(NB_RKS + (size_t)MT * 16 * 4 <= WS_PRE * 4, "layer-1 region A overflows into PRE");
constexpr size_t NB_DEC = (WS_X1 + SZ_ROWD) * 4;
constexpr size_t NB_KKN = NB_DEC + (size_t)MT * 1024 * 4;
constexpr size_t NB_KKA = NB_KKN + (size_t)MT * 1024 * 2;
constexpr size_t NB_KP = NB_KKA + (size_t)MT * 1024 * 2;
constexpr size_t NB_Y = NB_KP + (size_t)MT * 1024 * 2;
constexpr size_t NB_G4B = NB_Y + (size_t)MT * 1024 * 4;
constexpr size_t NB_CHK = NB_G4B + (size_t)MT * 1024 * 2;
static_assert(NB_CHK + (size_t)4096 * 49152 <= NB0, "layer-1 region B overflows");
constexpr int N1PAD = 3584;
__host__ __device__ __forceinline__ int win_src_col(int n) { return n < 2048 ? n : (n < 2560 ? C_ZB + (n - 2048) : (n < 3328 ? C_KV + (n - 2560) : (n < 3352 ? C_G3 + (n - 3328) : -1))); }

__device__ __forceinline__ int opaque(int x) { asm volatile("" : "+s"(x)); return x; }
__device__ __forceinline__ int opaque_v(int x) { asm volatile("" : "+v"(x)); return x; }
struct Args { const float* in[N_IN]; float* out; unsigned char* ws; int ph_lo, ph_hi; };

__device__ __forceinline__ unsigned pk_bf16(float lo, float hi) { unsigned r; asm volatile("v_cvt_pk_bf16_f32 %0, %1, %2" : "=v"(r) : "v"(lo), "v"(hi)); return r; }
typedef __bf16 bf16x2_t __attribute__((ext_vector_type(2)));
__device__ __forceinline__ unsigned pk_bf16c(float lo, float hi) { bf16x2_t v; v[0] = (__bf16)lo; v[1] = (__bf16)hi; return __builtin_bit_cast(unsigned, v); }

template <class MAP>
__device__ __forceinline__ void convert_wt(const float* __restrict__ W, int K, int ldw, bf16_t* __restrict__ Wt, int Npad, MAP map, int bid, int nb) {
    const int kg = K / 8;
    const size_t total = (size_t)Npad * kg;
    for (size_t i = (size_t)bid * NTH + threadIdx.x; i < total; i += (size_t)nb * NTH) {
        const int n = (int)(i % Npad), k0 = (int)(i / Npad) * 8;
        const int sc = map(n);
        u32x4 w = {0u, 0u, 0u, 0u};
        if (sc >= 0) {
            float v[8];
#pragma unroll
            for (int j = 0; j < 8; ++j) v[j] = W[(size_t)(k0 + j) * ldw + sc];
            w.x = pk_bf16(v[0], v[1]); w.y = pk_bf16(v[2], v[3]); w.z = pk_bf16(v[4], v[5]); w.w = pk_bf16(v[6], v[7]);
        }
        *(u32x4*)(Wt + (size_t)n * K + k0) = w;
    }
}
struct MapId { __device__ __forceinline__ int operator()(int n) const { return n; } };
struct MapWin { __device__ __forceinline__ int operator()(int n) const { return win_src_col(n); } };
__device__ __forceinline__ void convert_rows(const float* __restrict__ src, size_t n8, bf16_t* __restrict__ dst, int bid, int nb) {
#pragma unroll 4
    for (size_t i = (size_t)bid * NTH + threadIdx.x; i < n8; i += (size_t)nb * NTH) {
        const float4 a = *(const float4*)(src + i * 8), b = *(const float4*)(src + i * 8 + 4);
        u32x4 w; w.x = pk_bf16(a.x, a.y); w.y = pk_bf16(a.z, a.w); w.z = pk_bf16(b.x, b.y); w.w = pk_bf16(b.z, b.w);
        *(u32x4*)(dst + i * 8) = w;
    }
}

struct EpiPre {
    static constexpr bool PERM = false, AFTER_DRAIN = false;
    float* C; int ldc;
    __device__ __forceinline__ void operator()(const f32x4 (&acc)[2][2][4][2], const Unit& u, int wr, int wc, int fr, int fq) const {
        const int row0 = u.pm * 256 + wr * 64 + fr, col0 = u.pn * 256 + wc * 32 + 4 * fq;
#pragma unroll
        for (int ai = 0; ai < 2; ++ai)
#pragma unroll
            for (int m = 0; m < 4; ++m) { float* rowp = C + (size_t)(row0 + ai * 128 + m * 16) * ldc + col0;
#pragma unroll
                for (int bj = 0; bj < 2; ++bj)
#pragma unroll
                    for (int n = 0; n < 2; ++n) *(f32x4*)(rowp + bj * 128 + n * 16) = acc[ai][bj][m][n]; }
    }
};


struct Route1 {
    bf16_t* HB; bf16_t* KVB; float* G3; float* out;
    __device__ __forceinline__ void put8(int row, int n0, const f32x4& v0, const f32x4& v1) const {
        if (n0 < 2560) {
            const float sc = (n0 >= 1536 && n0 < 2048) ? 0.125f : 1.0f;
            u32x4 w; w.x = pk_bf16c(v0[0] * sc, v0[1] * sc); w.y = pk_bf16c(v0[2] * sc, v0[3] * sc); w.z = pk_bf16c(v1[0] * sc, v1[1] * sc); w.w = pk_bf16c(v1[2] * sc, v1[3] * sc);
            *(u32x4*)(HB + (size_t)row * 2560 + n0) = w;
        } else if (n0 < 3328) {
            const int c = n0 - 2560, i3 = c >> 8, cc = c & 255;
            u32x4 w; w.x = pk_bf16c(v0[0], v0[1]); w.y = pk_bf16c(v0[2], v0[3]); w.z = pk_bf16c(v1[0], v1[1]); w.w = pk_bf16c(v1[2], v1[3]);
            *(u32x4*)(KVB + (size_t)row * 768 + c) = w;
            float* dst = nullptr;
            if (row < MP) {
                if (i3 == 0) dst = out + O_CMPP + (size_t)row * 256 + cc;
                else if (i3 == 1) dst = out + O_SELP + (size_t)row * 256 + cc;
                else { const int b = row >> 11, t = row & 2047; if (t >= TP - 512) dst = out + O_WINP + (size_t)(b * 512 + t - (TP - 512)) * 256 + cc; }
            } else {
                const int sidx = row - MP;
                if (i3 == 0) dst = out + O_CMPS + (size_t)sidx * 256 + cc;
                else if (i3 == 1) dst = out + O_SELS + (size_t)sidx * 256 + cc;
                else dst = out + O_WINS + (size_t)(sidx * 512 + 511) * 256 + cc;
            }
            if (dst) { *(f32x4*)dst = v0; *(f32x4*)(dst + 4) = v1; }
        } else if (n0 < 3352) {
            float* dst = G3 + (size_t)row * 32 + (n0 - 3328);
            *(f32x4*)dst = v0; *(f32x4*)(dst + 4) = v1;
        }
    }
};
struct Epi1 {
    static constexpr bool PERM = true, AFTER_DRAIN = false;
    Route1 R;
    __device__ __forceinline__ void operator()(const f32x4 (&acc)[2][2][4][2], const Unit& u, int wr, int wc, int fr, int fq) const {
        const int row0 = u.pm * 256 + wr * 64 + fr, col0 = u.pn * 256 + wc * 32 + 8 * fq;
#pragma unroll
        for (int ai = 0; ai < 2; ++ai)
#pragma unroll
            for (int m = 0; m < 4; ++m)
#pragma unroll
                for (int bj = 0; bj < 2; ++bj) R.put8(row0 + ai * 128 + m * 16, col0 + bj * 128, acc[ai][bj][m][0], acc[ai][bj][m][1]);
    }
};

typedef float f32x16 __attribute__((ext_vector_type(16)));
template <class EMIT>
__device__ __forceinline__ void sample_gemm32(const bf16_t* __restrict__ A, const bf16_t* __restrict__ Bt, int K, int n0, int lane, EMIT emit) {
    const bf16_t* ap = A + (size_t)(lane & 31) * K + 8 * (lane >> 5);
    const bf16_t* bp = Bt + (size_t)(n0 + (lane & 31)) * K + 8 * (lane >> 5);
    f32x16 acc;
#pragma unroll
    for (int i = 0; i < 16; ++i) acc[i] = 0.f;
#pragma unroll 16
    for (int k = 0; k < K; k += 16) {
        const bf16x8 av = *(const bf16x8*)(ap + k), bv = *(const bf16x8*)(bp + k);
        acc = __builtin_amdgcn_mfma_f32_32x32x16_bf16(av, bv, acc, 0, 0, 0);
    }
#pragma unroll
    for (int r = 0; r < 16; ++r) emit((r & 3) + 8 * (r >> 2) + 4 * (lane >> 5), n0 + (lane & 31), acc[r]);
}

template <class EMIT>
__device__ __forceinline__ void sample_gemm32_wg(const bf16_t* __restrict__ A, const bf16_t* __restrict__ Bt, int K, int n0, PG8_LAS unsigned char* lds, EMIT emit) {
    const int tid = opaque_v(threadIdx.x), lane = tid & 63, wv = tid >> 6;
    const int kq = K / 8;
    const bf16_t* ap = A + (size_t)(lane & 31) * K + 8 * (lane >> 5) + wv * kq;
    const bf16_t* bp = Bt + (size_t)(n0 + (lane & 31)) * K + 8 * (lane >> 5) + wv * kq;
    f32x16 acc;
#pragma unroll
    for (int i = 0; i < 16; ++i) acc[i] = 0.f;
#pragma unroll 8
    for (int k = 0; k < kq; k += 16) {
        const bf16x8 av = *(const bf16x8*)(ap + k), bv = *(const bf16x8*)(bp + k);
        acc = __builtin_amdgcn_mfma_f32_32x32x16_bf16(av, bv, acc, 0, 0, 0);
    }
    PG8_LAS float* P = (PG8_LAS float*)lds;
#pragma unroll
    for (int q = 0; q < 4; ++q) *(PG8_LAS f32x4*)(P + (wv * 64 + lane) * 16 + q * 4) = (f32x4){acc[4 * q], acc[4 * q + 1], acc[4 * q + 2], acc[4 * q + 3]};
    __syncthreads();
    if (wv == 0) {
#pragma unroll
        for (int w = 1; w < 8; ++w)
#pragma unroll
            for (int q = 0; q < 4; ++q) { const f32x4 v = *(const PG8_LAS f32x4*)(P + (w * 64 + lane) * 16 + q * 4); acc[4 * q] += v[0]; acc[4 * q + 1] += v[1]; acc[4 * q + 2] += v[2]; acc[4 * q + 3] += v[3]; }
#pragma unroll
        for (int r = 0; r < 16; ++r) emit((r & 3) + 8 * (r >> 2) + 4 * (lane >> 5), n0 + (lane & 31), acc[r]);
    }
    __syncthreads();
}

typedef float f32x16 __attribute__((ext_vector_type(16)));
__device__ __forceinline__ float bf2f(bf16_t v) { return __uint_as_float((unsigned)v << 16); }
__device__ __forceinline__ float sigm_f(float x) { return 1.f / (1.f + __expf(-x)); }
__device__ __forceinline__ float silu_f(float x) { return x / (1.f + __expf(-x)); }

__device__ __forceinline__ void conv_item(const Args& a, unsigned char* ws, PG8_LAS unsigned char* lds, int item) {
    const int tid = opaque_v(threadIdx.x);
    const int b = item >> 5, t0 = (item & 31) * 64;
    const bf16_t* HB = (const bf16_t*)(ws + NB_HB);
    float* CB = (float*)(ws + NB_CBUF);
    PG8_LAS float* U = (PG8_LAS float*)lds;
    const int chl = tid & 255, tp = tid >> 8;
    for (int half = 0; half < 2; ++half) {
        const int chb = half * 256;
#pragma unroll
        for (int it = 0; it < 6; ++it) {
            const int vi = tid + it * NTH;
            if (vi < 94 * 32) {
                const int r = vi >> 5, c8 = (vi & 31) * 8, t = t0 - 30 + r;
                float u[8];
                if (t >= 0) {
                    const bf16_t* h = HB + (size_t)(b * TP + t) * 2560 + chb + c8;
                    const u32x4 av = *(const u32x4*)h, gv = *(const u32x4*)(h + 512);
#pragma unroll
                    for (int i = 0; i < 8; ++i) {
                        const float x = __uint_as_float((i & 1) ? (av[i >> 1] & 0xffff0000u) : (av[i >> 1] << 16));
                        const float g = __uint_as_float((i & 1) ? (gv[i >> 1] & 0xffff0000u) : (gv[i >> 1] << 16));
                        u[i] = x * sigm_f(g);
                    }
                } else {
#pragma unroll
                    for (int i = 0; i < 8; ++i) u[i] = 0.f;
                }
                *(PG8_LAS f32x4*)(U + r * 256 + c8) = (f32x4){u[0], u[1], u[2], u[3]};
                *(PG8_LAS f32x4*)(U + r * 256 + c8 + 4) = (f32x4){u[4], u[5], u[6], u[7]};
                if (t >= TP - 30) {
                    float* o = a.out + O_CONVP + (size_t)(b * 30 + t - (TP - 30)) * 512 + chb + c8;
                    *(float4*)o = make_float4(u[0], u[1], u[2], u[3]); *(float4*)(o + 4) = make_float4(u[4], u[5], u[6], u[7]);
                }
            }
        }
        __syncthreads();
        {
            const int ch = chb + chl;
            float w[31];
#pragma unroll
            for (int j = 0; j < 31; ++j) w[j] = a.in[I_CONVW][j * 512 + ch];
            const float bias = a.in[I_CONVB][ch];
#pragma unroll 4
            for (int k = 0; k < 32; ++k) {
                const int tt = tp * 32 + k;
                float acc = bias;
#pragma unroll
                for (int j = 0; j < 31; ++j) acc = fmaf(w[j], U[(tt + j) * 256 + chl], acc);
                CB[(size_t)(b * TP + t0 + tt) * 512 + ch] = acc;
            }
        }
        __syncthreads();
    }
    {
        const int lane = tid & 63, wv = tid >> 6;
        const float4 g0 = *(const float4*)(a.in[I_CLNG] + lane * 8), g1 = *(const float4*)(a.in[I_CLNG] + lane * 8 + 4);
        const float4 b0 = *(const float4*)(a.in[I_CLNB] + lane * 8), b1 = *(const float4*)(a.in[I_CLNB] + lane * 8 + 4);
        const float gg[8] = {g0.x, g0.y, g0.z, g0.w, g1.x, g1.y, g1.z, g1.w}, bb[8] = {b0.x, b0.y, b0.z, b0.w, b1.x, b1.y, b1.z, b1.w};
        for (int k = 0; k < 8; ++k) {
            const size_t row = (size_t)(b * TP + t0 + wv * 8 + k);
            const float4 c0 = *(const float4*)(CB + row * 512 + lane * 8), c1 = *(const float4*)(CB + row * 512 + lane * 8 + 4);
            float c[8] = {c0.x, c0.y, c0.z, c0.w, c1.x, c1.y, c1.z, c1.w};
            float sm = 0.f;
#pragma unroll
            for (int i = 0; i < 8; ++i) sm += c[i];
#pragma unroll
            for (int o = 32; o > 0; o >>= 1) sm += __shfl_xor(sm, o);
            const float mean = sm * (1.f / 512.f);
            float sq = 0.f;
#pragma unroll
            for (int i = 0; i < 8; ++i) { c[i] -= mean; sq += c[i] * c[i]; }
#pragma unroll
            for (int o = 32; o > 0; o >>= 1) sq += __shfl_xor(sq, o);
            const float rs = rsqrtf(sq * (1.f / 512.f) + LN_EPS);
            const u32x4 zv = *(const u32x4*)(HB + row * 2560 + 1024 + lane * 8);
            float y[8];
#pragma unroll
            for (int i = 0; i < 8; ++i) {
                const float z = __uint_as_float((i & 1) ? (zv[i >> 1] & 0xffff0000u) : (zv[i >> 1] << 16));
                y[i] = silu_f(c[i] * rs * gg[i] + bb[i]) * silu_f(z);
            }
            u32x4 o; o.x = pk_bf16(y[0], y[1]); o.y = pk_bf16(y[2], y[3]); o.z = pk_bf16(y[4], y[5]); o.w = pk_bf16(y[6], y[7]);
            *(u32x4*)((bf16_t*)(ws + NB_CATB) + row * 1024 + lane * 8) = o;
        }
    }
    __syncthreads();
}

__device__ __forceinline__ void pool_prompt(const Args& a, unsigned char* ws, int bid, int nb) {
    bf16_t* KCB = (bf16_t*)(ws + NB_KCB);
    for (int i = bid * NTH + threadIdx.x; i < BP * 64 * 256; i += nb * NTH) {
        const int c = i & 255, n = (i >> 8) & 63, b = i >> 14;
        const int kv = c >> 7, g = (c >> 6) & 1;
        const float* w = kv ? a.in[I_WVC] : a.in[I_WKC];
        const float* src = a.out + O_CMPP + (size_t)(b * TP + n * 32) * 256 + c;
        float acc = 0.f;
#pragma unroll 8
        for (int l = 0; l < 32; ++l) acc = fmaf(src[(size_t)l * 256], w[l * 2 + g], acc);
        KCB[i] = (bf16_t)(pk_bf16(acc, 0.f) & 0xffffu);
    }
}

constexpr int A_KT = 0;
constexpr int A_VT = 18432;
constexpr int A_IMPH = 35840;
constexpr int A_IMPS = 68608;
constexpr int A_MASK = 76800;
constexpr float LOG2E = 1.4426950408889634f;

struct KvSrc { const bf16_t* k; const bf16_t* v; int rstride; };

__device__ __forceinline__ void kv_issue(const KvSrc& s, int tid, u32x4& kr, u32x4& vr) {
    const int key = tid >> 3, c8 = tid & 7;
    kr = *(const u32x4*)(s.k + (size_t)key * s.rstride + c8 * 8);
    vr = *(const u32x4*)(s.v + (size_t)key * s.rstride + c8 * 8);
}
__device__ __forceinline__ void kv_write(PG8_LAS unsigned char* lds, int buf, int tid, const u32x4& kr, const u32x4& vr) {
    const int key = tid >> 3, c8 = tid & 7;
    *(PG8_LAS u32x4*)(lds + A_KT + buf * 9216 + key * 144 + c8 * 16) = kr;
    PG8_LAS bf16_t* vt = (PG8_LAS bf16_t*)(lds + A_VT + buf * 8704);
#pragma unroll
    for (int i = 0; i < 4; ++i) { vt[(c8 * 8 + 2 * i) * 68 + key] = (bf16_t)(vr[i] & 0xffffu); vt[(c8 * 8 + 2 * i + 1) * 68 + key] = (bf16_t)(vr[i] >> 16); }
}

__device__ __forceinline__ void attn_block(const int MODE, PG8_LAS unsigned char* lds, int buf, const bf16x8 (&qf)[4], int lane, float kslope, float base, int kmax, int kmin,
                                           float& m, float& l, f32x16 (&o)[2], f32x16 (&x)[2]) {
    const int lr = lane & 31, h = lane >> 5;
    const PG8_LAS unsigned char* kt_p = lds + A_KT + buf * 9216 + lr * 144 + h * 16;
#pragma unroll
    for (int kt = 0; kt < 2; ++kt) {
#pragma unroll
        for (int i = 0; i < 16; ++i) x[kt][i] = 0.f;
#pragma unroll
        for (int s = 0; s < 4; ++s) {
            const bf16x8 kf = *(const PG8_LAS bf16x8*)(kt_p + kt * 32 * 144 + s * 32);
            x[kt] = __builtin_amdgcn_mfma_f32_32x32x16_bf16(kf, qf[s], x[kt], 0, 0, 0);
        }
    }
    const float bh = base + kslope * (float)(4 * h);
    float mx = -INFINITY;
#pragma unroll
    for (int kt = 0; kt < 2; ++kt)
#pragma unroll
        for (int i = 0; i < 16; ++i) {
            const int kc = kt * 32 + (i & 3) + 8 * (i >> 2);
            x[kt][i] = fmaf(x[kt][i], LOG2E, fmaf(kslope, (float)kc, bh));
        }
    if (MODE) {
        const int hi = kmax - 4 * h, lo = kmin - 4 * h;
#pragma unroll
        for (int kt = 0; kt < 2; ++kt)
#pragma unroll
            for (int i = 0; i < 16; ++i) {
                const int kc = kt * 32 + (i & 3) + 8 * (i >> 2);
                x[kt][i] = (kc > hi || kc < lo) ? -INFINITY : x[kt][i];
            }
    }
#pragma unroll
    for (int kt = 0; kt < 2; ++kt)
#pragma unroll
        for (int i = 0; i < 16; ++i) mx = fmaxf(mx, x[kt][i]);
    mx = fmaxf(mx, __shfl_xor(mx, 32));
    const float mn = fmaxf(m, mx);
    const float corr = __builtin_amdgcn_exp2f(m - mn);
    const bool grew = __any(mn > m);
    m = mn;
    float ls = 0.f;
#pragma unroll
    for (int kt = 0; kt < 2; ++kt)
#pragma unroll
        for (int i = 0; i < 16; ++i) { const float pv = __builtin_amdgcn_exp2f(x[kt][i] - mn); x[kt][i] = pv; ls += pv; }
    l = fmaf(l, corr, ls);
    if (grew) {
#pragma unroll
        for (int dt = 0; dt < 2; ++dt)
#pragma unroll
            for (int i = 0; i < 16; ++i) o[dt][i] *= corr;
    }
    const PG8_LAS unsigned char* vt_p = lds + A_VT + buf * 8704 + lr * 136 + h * 8;
#pragma unroll
    for (int kt = 0; kt < 2; ++kt)
#pragma unroll
        for (int s = 0; s < 2; ++s) {
            u32x4 pw; pw.x = pk_bf16(x[kt][8 * s + 0], x[kt][8 * s + 1]); pw.y = pk_bf16(x[kt][8 * s + 2], x[kt][8 * s + 3]);
            pw.z = pk_bf16(x[kt][8 * s + 4], x[kt][8 * s + 5]); pw.w = pk_bf16(x[kt][8 * s + 6], x[kt][8 * s + 7]);
            const bf16x8 pf = __builtin_bit_cast(bf16x8, pw);
#pragma unroll
            for (int dt = 0; dt < 2; ++dt) {
                const PG8_LAS unsigned char* vp = vt_p + dt * 32 * 136 + (kt * 32 + s * 16) * 2;
                typedef unsigned u32x2 __attribute__((ext_vector_type(2)));
                const u32x2 v0 = *(const PG8_LAS u32x2*)vp, v1 = *(const PG8_LAS u32x2*)(vp + 16);
                u32x4 vw; vw.x = v0.x; vw.y = v0.y; vw.z = v1.x; vw.w = v1.y;
                o[dt] = __builtin_amdgcn_mfma_f32_32x32x16_bf16(__builtin_bit_cast(bf16x8, vw), pf, o[dt], 0, 0, 0);
            }
        }
}

__device__ __forceinline__ void attn_item(const Args& a, unsigned char* ws, PG8_LAS unsigned char* lds, int b, int g, int qb) {
    const int tid = opaque_v(threadIdx.x), lane = tid & 63, wv = __builtin_amdgcn_readfirstlane(tid >> 6);
    const int lr = lane & 31, h = lane >> 5;
    const int r = wv >> 1, th = wv & 1, hh = g * 4 + r;
    const int t0 = qb * 64, tb = qb;
    const int qloc = th * 32 + lr;
    const int qpos = t0 + qloc;
    const size_t qrow = (size_t)b * TP + qpos;
    const bf16_t* HB = (const bf16_t*)(ws + NB_HB);
    const bf16_t* KVB = (const bf16_t*)(ws + NB_KVB);
    const float slope2 = __builtin_amdgcn_exp2f(-(float)(hh + 1)) * LOG2E;
    bf16x8 qf[4];
#pragma unroll
    for (int s = 0; s < 4; ++s) qf[s] = *(const bf16x8*)(HB + qrow * 2560 + 1536 + hh * 64 + s * 16 + h * 8);
    const float* g3p = (const float*)(ws + NB_G3) + qrow * 32 + hh * 3;
    const float gc = sigm_f(g3p[0]), gs = sigm_f(g3p[1]), gw = sigm_f(g3p[2]);
    f32x16 res[2], o[2], x[2];
#pragma unroll
    for (int dt = 0; dt < 2; ++dt)
#pragma unroll
        for (int i = 0; i < 16; ++i) { res[dt][i] = 0.f; o[dt][i] = 0.f; }
    float m = -1e30f, l = 0.f;
    u32x4 kr, vr;
    PG8_LAS float* IMPH = (PG8_LAS float*)(lds + A_IMPH);
    PG8_LAS float* IMPS = (PG8_LAS float*)(lds + A_IMPS);
    PG8_LAS unsigned* MASK = (PG8_LAS unsigned*)(lds + A_MASK);

    {
        const bf16_t* kc = (const bf16_t*)(ws + NB_KCB) + (size_t)b * 64 * 256 + g * 64;
        KvSrc s{kc, kc + 128, 256};
        kv_issue(s, tid, kr, vr); kv_write(lds, 0, tid, kr, vr);
        if (tid < 64) MASK[tid] = 0u;
        __syncthreads();
        const int nmax = (qpos >= 31) ? ((qpos - 31) >> 5) : -1;
        attn_block(1, lds, 0, qf, lane, slope2 * 32.f, slope2 * (float)(31 - qpos), nmax, 0, m, l, o, x);
        const float lt = l + __shfl_xor(l, 32);
        const float inv = (nmax >= 0) ? 1.f / lt : 0.f;
        const float sc = gc * inv;
#pragma unroll
        for (int dt = 0; dt < 2; ++dt)
#pragma unroll
            for (int i = 0; i < 16; ++i) { res[dt][i] = o[dt][i] * sc; o[dt][i] = 0.f; }
        if (tb >= 16) {
#pragma unroll
            for (int kt = 0; kt < 2; ++kt)
#pragma unroll
                for (int c = 0; c < 4; ++c)
#pragma unroll
                    for (int e = 0; e < 2; ++e)
                        IMPH[(r * 64 + qloc) * 32 + kt * 16 + 4 * c + 2 * h + e] = (nmax >= 0) ? (x[kt][4 * c + 2 * e] + x[kt][4 * c + 2 * e + 1]) * inv : 0.f;
        }
        m = -1e30f; l = 0.f;
        __syncthreads();
    }
    if (tb >= 16) {
        const int tq = opaque_v(tid);
        const int q = tq >> 3, jq = tq & 7;
        float v4[4];
#pragma unroll
        for (int e = 0; e < 4; ++e) {
            const int j = jq * 4 + e;
            float v = IMPH[(0 * 64 + q) * 32 + j] + IMPH[(1 * 64 + q) * 32 + j] + IMPH[(2 * 64 + q) * 32 + j] + IMPH[(3 * 64 + q) * 32 + j];
            if (j == 0 || j == tb || j == tb - 1) v = 1e4f;
            IMPS[q * 32 + j] = v; v4[e] = v;
        }
        __syncthreads();
        unsigned bits = 0u;
#pragma unroll
        for (int e = 0; e < 4; ++e) {
            const int j = jq * 4 + e;
            int rank = 0;
            for (int i = 0; i <= tb; ++i) { const float vi = IMPS[q * 32 + i]; rank += (vi > v4[e] || (vi == v4[e] && i < j)) ? 1 : 0; }
            if (j <= tb && rank < 16) bits |= 1u << j;
        }
        if (bits) atomicOr((unsigned*)&MASK[q], bits);
    } else {
        if (tid < 64) MASK[tid] = (2u << tb) - 1u;
    }
    __syncthreads();
    const unsigned selmask = MASK[qloc];

    {
        const bf16_t* kb = KVB + (size_t)b * TP * 768 + 256 + g * 64;
        { KvSrc s{kb, kb + 128, 768}; kv_issue(s, tid, kr, vr); kv_write(lds, 0, tid, kr, vr); }
        __syncthreads();
        for (int j = 0; j <= tb; ++j) {
            if (j < tb) { KvSrc s{kb + (size_t)(j + 1) * 64 * 768, kb + (size_t)(j + 1) * 64 * 768 + 128, 768}; kv_issue(s, tid, kr, vr); }
            const float base = ((selmask >> j) & 1u) ? slope2 * (float)(j * 64 - qpos) : -INFINITY;
            attn_block(j == tb, lds, j & 1, qf, lane, slope2, base, qloc, 0, m, l, o, x);
            if (j < tb) kv_write(lds, (j + 1) & 1, tid, kr, vr);
            __syncthreads();
        }
        const float lt = l + __shfl_xor(l, 32);
        const float sc = gs / lt;
#pragma unroll
        for (int dt = 0; dt < 2; ++dt)
#pragma unroll
            for (int i = 0; i < 16; ++i) { res[dt][i] = fmaf(o[dt][i], sc, res[dt][i]); o[dt][i] = 0.f; }
        m = -1e30f; l = 0.f;
    }
    {
        const int jlo = (tb >= 8) ? tb - 8 : 0;
        const bf16_t* kb = KVB + (size_t)b * TP * 768 + 512 + g * 64;
        { KvSrc s{kb + (size_t)jlo * 64 * 768, kb + (size_t)jlo * 64 * 768 + 128, 768}; kv_issue(s, tid, kr, vr); kv_write(lds, 0, tid, kr, vr); }
        __syncthreads();
        for (int j = jlo; j <= tb; ++j) {
            const int bi = (j - jlo) & 1;
            if (j < tb) { KvSrc s{kb + (size_t)(j + 1) * 64 * 768, kb + (size_t)(j + 1) * 64 * 768 + 128, 768}; kv_issue(s, tid, kr, vr); }
            const float base = slope2 * (float)(j * 64 - qpos);
            attn_block((j == tb) || (j == tb - 8), lds, bi, qf, lane, slope2, base, (j == tb) ? qloc : 64, (j == tb - 8) ? qpos - 511 - j * 64 : 0, m, l, o, x);
            if (j < tb) kv_write(lds, bi ^ 1, tid, kr, vr);
            __syncthreads();
        }
        const float lt = l + __shfl_xor(l, 32);
        const float sc = gw / lt;
#pragma unroll
        for (int dt = 0; dt < 2; ++dt)
#pragma unroll
            for (int i = 0; i < 16; ++i) res[dt][i] = fmaf(o[dt][i], sc, res[dt][i]);
    }
    {
        const size_t qrow2 = (size_t)b * TP + t0 + th * 32 + (opaque_v(lane) & 31);
        const bf16_t* zb = HB + qrow2 * 2560 + 2048 + hh * 64;
        bf16_t* dst = (bf16_t*)(ws + NB_CATB) + qrow2 * 1024 + 512 + hh * 64;
        typedef unsigned u32x2 __attribute__((ext_vector_type(2)));
#pragma unroll
        for (int dt = 0; dt < 2; ++dt)
#pragma unroll
            for (int c = 0; c < 4; ++c) {
                const int d = dt * 32 + 8 * c + 4 * h;
                const u32x2 zv = *(const u32x2*)(zb + d);
                const float z0 = __uint_as_float(zv.x << 16), z1 = __uint_as_float(zv.x & 0xffff0000u), z2 = __uint_as_float(zv.y << 16), z3 = __uint_as_float(zv.y & 0xffff0000u);
                u32x2 w; w.x = pk_bf16(res[dt][4 * c + 0] * silu_f(z0), res[dt][4 * c + 1] * silu_f(z1)); w.y = pk_bf16(res[dt][4 * c + 2] * silu_f(z2), res[dt][4 * c + 3] * silu_f(z3));
                *(u32x2*)(dst + d) = w;
            }
    }
}

constexpr int XSH_ROWS = 16640;
__device__ __forceinline__ float wave_sum(float v) {
#pragma unroll
    for (int o = 32; o > 0; o >>= 1) v += __shfl_xor(v, o);
    return v;
}
__device__ __forceinline__ void ld_row16(const float* __restrict__ src, int lane, float (&x)[16]) {
#pragma unroll
    for (int q = 0; q < 4; ++q) { const float4 v = *(const float4*)(src + lane * 16 + q * 4); x[4 * q] = v.x; x[4 * q + 1] = v.y; x[4 * q + 2] = v.z; x[4 * q + 3] = v.w; }
}
__device__ __forceinline__ void ln_calc16(const float* __restrict__ g, const float* __restrict__ bta, int lane, float (&x)[16]) {
    float sm = 0.f;
#pragma unroll
    for (int i = 0; i < 16; ++i) sm += x[i];
    const float mean = wave_sum(sm) * (1.f / 1024.f);
    float sq = 0.f;
#pragma unroll
    for (int i = 0; i < 16; ++i) { x[i] -= mean; sq += x[i] * x[i]; }
    const float rs = rsqrtf(wave_sum(sq) * (1.f / 1024.f) + LN_EPS);
#pragma unroll
    for (int q = 0; q < 4; ++q) {
        const float4 gv = *(const float4*)(g + lane * 16 + q * 4), bv = *(const float4*)(bta + lane * 16 + q * 4);
        x[4 * q] = x[4 * q] * rs * gv.x + bv.x; x[4 * q + 1] = x[4 * q + 1] * rs * gv.y + bv.y; x[4 * q + 2] = x[4 * q + 2] * rs * gv.z + bv.z; x[4 * q + 3] = x[4 * q + 3] * rs * gv.w + bv.w;
    }
}
__device__ __forceinline__ void ln_row16(const float* __restrict__ src, const float* __restrict__ g, const float* __restrict__ bta, int lane, float (&x)[16]) {
    ld_row16(src, lane, x); ln_calc16(g, bta, lane, x);
}
__device__ __forceinline__ void store_x1_xsh(const Args& a, unsigned char* ws, size_t row, size_t xrow, int lane, const float (&cur)[16], const float (&prev)[16]) {
#pragma unroll 1
    for (int n = 0; n < 6; ++n) {
        const float* mu = a.in[I_MU] + n * 1024 + lane * 16;
        float y[16];
#pragma unroll
        for (int q = 0; q < 4; ++q) { const float4 m4 = *(const float4*)(mu + q * 4);
            y[4 * q] = fmaf(prev[4 * q] - cur[4 * q], m4.x, cur[4 * q]); y[4 * q + 1] = fmaf(prev[4 * q + 1] - cur[4 * q + 1], m4.y, cur[4 * q + 1]);
            y[4 * q + 2] = fmaf(prev[4 * q + 2] - cur[4 * q + 2], m4.z, cur[4 * q + 2]); y[4 * q + 3] = fmaf(prev[4 * q + 3] - cur[4 * q + 3], m4.w, cur[4 * q + 3]); }
        bf16_t* dst = (bf16_t*)(ws + NB_XSH) + ((size_t)n * XSH_ROWS + xrow) * 1024 + lane * 16;
        u32x4 w0, w1;
        w0.x = pk_bf16(y[0], y[1]); w0.y = pk_bf16(y[2], y[3]); w0.z = pk_bf16(y[4], y[5]); w0.w = pk_bf16(y[6], y[7]);
        w1.x = pk_bf16(y[8], y[9]); w1.y = pk_bf16(y[10], y[11]); w1.z = pk_bf16(y[12], y[13]); w1.w = pk_bf16(y[14], y[15]);
        *(u32x4*)dst = w0; *(u32x4*)(dst + 8) = w1;
    }
}
__device__ __forceinline__ void phase_lns(const Args& a, unsigned char* ws, int bid, int nb) {
    const int tid = opaque_v(threadIdx.x), lane = tid & 63, wv = tid >> 6;
    const float* PRE = (const float*)ws + WS_PRE;
    const float* g = a.in[I_LNG]; const float* bta = a.in[I_LNB];
    for (int blk = bid; blk < 256; blk += nb) {
        const int r0 = blk * 64 + wv * 8;
        float prev[16], cur[16];
        if ((r0 & (TP - 1)) == 0) {
#pragma unroll
            for (int i = 0; i < 16; ++i) prev[i] = 0.f;
        } else ln_row16(PRE + (size_t)(r0 - 1) * 1024, g, bta, lane, prev);
        float nxt[16];
        ld_row16(PRE + (size_t)r0 * 1024, lane, nxt);
#pragma unroll 1
        for (int k = 0; k < 8; ++k) {
            const int row = r0 + k;
#pragma unroll
            for (int i = 0; i < 16; ++i) cur[i] = nxt[i];
            if (k + 1 < 8) ld_row16(PRE + (size_t)(row + 1) * 1024, lane, nxt);
            ln_calc16(g, bta, lane, cur);
            store_x1_xsh(a, ws, row, row, lane, cur, prev);
            if ((row & (TP - 1)) == TP - 1) {
                float* so = a.out + O_SHP + (size_t)(row >> 11) * 1024 + lane * 16;
#pragma unroll
                for (int q = 0; q < 4; ++q) *(float4*)(so + q * 4) = make_float4(cur[4 * q], cur[4 * q + 1], cur[4 * q + 2], cur[4 * q + 3]);
            }
#pragma unroll
            for (int i = 0; i < 16; ++i) prev[i] = cur[i];
        }
    }
    for (int s = bid * 8 + wv; s < BS; s += nb * 8) {
        float prev[16], cur[16];
        const float* sp = a.in[I_SSHIFT] + (size_t)s * 1024 + lane * 16;
#pragma unroll
        for (int q = 0; q < 4; ++q) { const float4 v = *(const float4*)(sp + q * 4); prev[4 * q] = v.x; prev[4 * q + 1] = v.y; prev[4 * q + 2] = v.z; prev[4 * q + 3] = v.w; }
        ln_row16(PRE + (size_t)(MP + s) * 1024, g, bta, lane, cur);
        store_x1_xsh(a, ws, MP + s, MP + s, lane, cur, prev);
        float* so = a.out + O_SHS + (size_t)s * 1024 + lane * 16;
#pragma unroll
        for (int q = 0; q < 4; ++q) *(float4*)(so + q * 4) = make_float4(cur[4 * q], cur[4 * q + 1], cur[4 * q + 2], cur[4 * q + 3]);
    }
}

struct Order3 {
    pg8::StaticOrder so;
    __device__ void init(int G, int c) { so.init(MP, 4096, G, c); }
    __device__ bool next(int i, Unit& u) const { Unit v; if (!so.next(i, v)) return false; const int n = v.pn >> 2; u.pm = n * 65 + v.pm; u.pn = v.pn; return true; }
    __device__ __forceinline__ void a_ready(const Unit&) const {}
    __device__ __forceinline__ void done(const Unit&) const {}
};
struct Epi3 {
    static constexpr bool PERM = true, AFTER_DRAIN = false;
    bf16_t* O;
    __device__ __forceinline__ void operator()(const f32x4 (&acc)[2][2][4][2], const Unit& u, int wr, int wc, int fr, int fq) const {
        const int n = u.pn >> 2, pm = u.pm - n * 65, pn = u.pn & 3;
        const int row0 = pm * 256 + wr * 64 + fr, col0 = pn * 256 + wc * 32 + 8 * fq;
        bf16_t* base = O + (size_t)n * XSH_ROWS * 1024;
#pragma unroll
        for (int ai = 0; ai < 2; ++ai)
#pragma unroll
            for (int m = 0; m < 4; ++m) { bf16_t* rowp = base + (size_t)(row0 + ai * 128 + m * 16) * 1024 + col0;
#pragma unroll
                for (int bj = 0; bj < 2; ++bj) { const f32x4 v0 = acc[ai][bj][m][0], v1 = acc[ai][bj][m][1];
                    u32x4 w; w.x = pk_bf16c(v0[0], v0[1]); w.y = pk_bf16c(v0[2], v0[3]); w.z = pk_bf16c(v1[0], v1[1]); w.w = pk_bf16c(v1[2], v1[3]);
                    *(u32x4*)(rowp + bj * 128) = w; } }
    }
};
struct EpiPreRes {
    static constexpr bool PERM = false, AFTER_DRAIN = false;
    float* C; const float* X;
    __device__ __forceinline__ void operator()(const f32x4 (&acc)[2][2][4][2], const Unit& u, int wr, int wc, int fr, int fq) const {
        const int row0 = u.pm * 256 + wr * 64 + fr, col0 = u.pn * 256 + wc * 32 + 4 * fq;
#pragma unroll
        for (int ai = 0; ai < 2; ++ai)
#pragma unroll
            for (int m = 0; m < 4; ++m) { const size_t off = (size_t)(row0 + ai * 128 + m * 16) * 1024 + col0;
#pragma unroll
                for (int bj = 0; bj < 2; ++bj)
#pragma unroll
                    for (int n = 0; n < 2; ++n) { const f32x4 xv = *(const f32x4*)(X + off + bj * 128 + n * 16); *(f32x4*)(C + off + bj * 128 + n * 16) = acc[ai][bj][m][n] + xv * ALPHA; } }
    }
};

__device__ __forceinline__ float dpp_red16f(float v) {
    v += __builtin_bit_cast(float, __builtin_amdgcn_update_dpp(0, __builtin_bit_cast(int, v), 0xB1, 0xF, 0xF, true));
    v += __builtin_bit_cast(float, __builtin_amdgcn_update_dpp(0, __builtin_bit_cast(int, v), 0x4E, 0xF, 0xF, true));
    v += __builtin_bit_cast(float, __builtin_amdgcn_update_dpp(0, __builtin_bit_cast(int, v), 0x141, 0xF, 0xF, true));
    v += __builtin_bit_cast(float, __builtin_amdgcn_update_dpp(0, __builtin_bit_cast(int, v), 0x140, 0xF, 0xF, true));
    return v;
}
__device__ __forceinline__ void prep2_task(const Args& a, unsigned char* ws, int rt, int hd, int lane) {
    const int lr = lane & 31, h2 = lane >> 5;
    const size_t row0 = (size_t)rt * 32;
    const bf16_t* W2T = (const bf16_t*)(ws + NB_W2T); const bf16_t* A2T = (const bf16_t*)(ws + NB_A2T);
    const bf16_t* TWB = (const bf16_t*)(ws + NB_TWB); const bf16_t* AWB = (const bf16_t*)(ws + NB_AWB);
    f32x16 aw[2], aa[2];
#pragma unroll
    for (int ct = 0; ct < 2; ++ct)
#pragma unroll
        for (int i = 0; i < 16; ++i) { aw[ct][i] = 0.f; aa[ct][i] = 0.f; }
#pragma unroll
    for (int s = 0; s < 4; ++s) {
        const bf16x8 at = *(const bf16x8*)(TWB + (row0 + lr) * 64 + s * 16 + h2 * 8), aa_ = *(const bf16x8*)(AWB + (row0 + lr) * 64 + s * 16 + h2 * 8);
#pragma unroll
        for (int ct = 0; ct < 2; ++ct) {
            const size_t e = (size_t)hd * 64 + ct * 32 + lr;
            const bf16x8 w2 = *(const bf16x8*)(W2T + e * 64 + s * 16 + h2 * 8), a2 = *(const bf16x8*)(A2T + e * 64 + s * 16 + h2 * 8);
            aw[ct] = __builtin_amdgcn_mfma_f32_32x32x16_bf16(at, w2, aw[ct], 0, 0, 0);
            aa[ct] = __builtin_amdgcn_mfma_f32_32x32x16_bf16(aa_, a2, aa[ct], 0, 0, 0);
        }
    }
    const bf16_t* KB = (const bf16_t*)(ws + NB_RKVZ) + (size_t)1 * XSH_ROWS * 1024;
    const bf16_t* RB = (const bf16_t*)(ws + NB_RKVZ);
    float* DEC = (float*)(ws + NB_DEC);
    bf16_t* KKN = (bf16_t*)(ws + NB_KKN); bf16_t* KKA = (bf16_t*)(ws + NB_KKA); bf16_t* KP = (bf16_t*)(ws + NB_KP);
    float w0v[2], a0v[2], kkp[2], kap[2], rkp[2];
#pragma unroll
    for (int ct = 0; ct < 2; ++ct) { const int e = hd * 64 + ct * 32 + lr; w0v[ct] = a.in[I_W0][e]; a0v[ct] = a.in[I_A0][e]; kkp[ct] = a.in[I_KK][e]; kap[ct] = a.in[I_KA][e]; rkp[ct] = a.in[I_RK][e]; }
    float n2[16], rk[16];
#pragma unroll
    for (int i = 0; i < 16; ++i) { n2[i] = 0.f; rk[i] = 0.f; }
#pragma unroll
    for (int ct = 0; ct < 2; ++ct)
#pragma unroll
        for (int i = 0; i < 16; ++i) {
            const size_t off = (row0 + (i & 3) + 8 * (i >> 2) + 4 * h2) * 1024 + hd * 64 + ct * 32 + lr;
            const float kf = bf2f(KB[off]), rf = bf2f(RB[off]);
            const float wl = w0v[ct] + aw[ct][i];
            const float sp = fmaxf(-wl, 0.f) + log1pf(__expf(-fabsf(wl)));
            DEC[off] = __expf(-__expf(-sp - 0.5f));
            const float av_ = sigm_f(a0v[ct] + aa[ct][i]);
            const float kk = kf * kkp[ct];
            const float kp = kf * (1.f + (av_ - 1.f) * kap[ct]);
            KP[off] = (bf16_t)(pk_bf16(kp, 0.f) & 0xffffu);
            aw[ct][i] = kk; aa[ct][i] = av_;
            n2[i] = fmaf(kk, kk, n2[i]);
            rk[i] = fmaf(rf * kp, rkp[ct], rk[i]);
        }
#pragma unroll
    for (int i = 0; i < 16; ++i) {
        float v = dpp_red16f(n2[i]); v += __shfl_xor(v, 16); n2[i] = 1.f / fmaxf(sqrtf(v), 1e-12f);
        float w = dpp_red16f(rk[i]); w += __shfl_xor(w, 16); rk[i] = w;
    }
#pragma unroll
    for (int ct = 0; ct < 2; ++ct)
#pragma unroll
        for (int i = 0; i < 16; ++i) {
            const size_t off = (row0 + (i & 3) + 8 * (i >> 2) + 4 * h2) * 1024 + hd * 64 + ct * 32 + lr;
            const float kn = aw[ct][i] * n2[i];
            KKN[off] = (bf16_t)(pk_bf16(kn, 0.f) & 0xffffu);
            KKA[off] = (bf16_t)(pk_bf16(kn * aa[ct][i], 0.f) & 0xffffu);
        }
    if (lr == 0) {
#pragma unroll
        for (int i = 0; i < 16; ++i) ((float*)(ws + NB_RKS))[(row0 + (i & 3) + 8 * (i >> 2) + 4 * h2) * 16 + hd] = rk[i];
    }
}

constexpr int SC_BUF = 53248;
__device__ __forceinline__ float dpp_red16(float v) {
    v += __builtin_bit_cast(float, __builtin_amdgcn_update_dpp(0, __builtin_bit_cast(int, v), 0xB1, 0xF, 0xF, true));
    v += __builtin_bit_cast(float, __builtin_amdgcn_update_dpp(0, __builtin_bit_cast(int, v), 0x4E, 0xF, 0xF, true));
    v += __builtin_bit_cast(float, __builtin_amdgcn_update_dpp(0, __builtin_bit_cast(int, v), 0x141, 0xF, 0xF, true));
    v += __builtin_bit_cast(float, __builtin_amdgcn_update_dpp(0, __builtin_bit_cast(int, v), 0x140, 0xF, 0xF, true));
    return v;
}
struct ScanRegs { u32x4 d0, d1, kn, ka, kp, r, v; };
__device__ __forceinline__ void scan_issue(unsigned char* ws, int b, int hd, int vh, int chunk, int tid, ScanRegs& g) {
    const int tt = tid >> 3, part = tid & 7;
    const size_t row = (size_t)b * TP + chunk * 64 + tt;
    const size_t off = row * 1024 + hd * 64 + part * 8;
    const float* dp = (const float*)(ws + NB_DEC) + off;
    g.d0 = *(const u32x4*)dp; g.d1 = *(const u32x4*)(dp + 4);
    g.kn = *(const u32x4*)((const bf16_t*)(ws + NB_KKN) + off);
    g.ka = *(const u32x4*)((const bf16_t*)(ws + NB_KKA) + off);
    g.kp = *(const u32x4*)((const bf16_t*)(ws + NB_KP) + off);
    g.r = *(const u32x4*)((const bf16_t*)(ws + NB_RKVZ) + ((size_t)0 * XSH_ROWS + row) * 1024 + hd * 64 + part * 8);
    if (part < 4) g.v = *(const u32x4*)((const bf16_t*)(ws + NB_RKVZ) + ((size_t)2 * XSH_ROWS + row) * 1024 + hd * 64 + vh * 32 + part * 8);
}
__device__ __forceinline__ void scan_write(PG8_LAS unsigned char* buf, int tid, const ScanRegs& g) {
    const int tt = tid >> 3, part = tid & 7;
    *(PG8_LAS u32x4*)(buf + tt * 256 + part * 32) = g.d0; *(PG8_LAS u32x4*)(buf + tt * 256 + part * 32 + 16) = g.d1;
    *(PG8_LAS u32x4*)(buf + 16384 + tt * 128 + part * 16) = g.kn;
    *(PG8_LAS u32x4*)(buf + 24576 + tt * 128 + part * 16) = g.ka;
    *(PG8_LAS u32x4*)(buf + 32768 + tt * 128 + part * 16) = g.kp;
    *(PG8_LAS u32x4*)(buf + 40960 + tt * 128 + part * 16) = g.r;
    if (part < 4) *(PG8_LAS u32x4*)(buf + 49152 + tt * 64 + part * 16) = g.v;
}
__device__ __forceinline__ void scan_prompt(const Args& a, unsigned char* ws, PG8_LAS unsigned char* lds, int item) {
    const int tid = opaque_v(threadIdx.x);
    const int b = item >> 5, hd = (item >> 1) & 15, vh = item & 1;
    const int vl = tid >> 4, kq = tid & 15;
    typedef unsigned u32x2 __attribute__((ext_vector_type(2)));
    float S[4] = {0.f, 0.f, 0.f, 0.f};
    ScanRegs g;
    PG8_LAS float* YS = (PG8_LAS float*)(lds + 2 * SC_BUF);
    scan_issue(ws, b, hd, vh, 0, tid, g); scan_write(lds, tid, g);
    __syncthreads();
    for (int c = 0; c < TP / 64; ++c) {
        PG8_LAS unsigned char* buf = lds + (c & 1) * SC_BUF;
        if (c + 1 < TP / 64) scan_issue(ws, b, hd, vh, c + 1, tid, g);
#pragma unroll 4
        for (int tt = 0; tt < 64; ++tt) {
            const f32x4 w = *(const PG8_LAS f32x4*)(buf + tt * 256 + kq * 16);
            const u32x2 knw = *(const PG8_LAS u32x2*)(buf + 16384 + tt * 128 + kq * 8), kaw = *(const PG8_LAS u32x2*)(buf + 24576 + tt * 128 + kq * 8),
                        kpw = *(const PG8_LAS u32x2*)(buf + 32768 + tt * 128 + kq * 8), rw = *(const PG8_LAS u32x2*)(buf + 40960 + tt * 128 + kq * 8);
            const float vv = bf2f(*(const PG8_LAS bf16_t*)(buf + 49152 + tt * 64 + vl * 2));
            const float kn[4] = {__uint_as_float(knw.x << 16), __uint_as_float(knw.x & 0xffff0000u), __uint_as_float(knw.y << 16), __uint_as_float(knw.y & 0xffff0000u)};
            const float ka[4] = {__uint_as_float(kaw.x << 16), __uint_as_float(kaw.x & 0xffff0000u), __uint_as_float(kaw.y << 16), __uint_as_float(kaw.y & 0xffff0000u)};
            const float kp[4] = {__uint_as_float(kpw.x << 16), __uint_as_float(kpw.x & 0xffff0000u), __uint_as_float(kpw.y << 16), __uint_as_float(kpw.y & 0xffff0000u)};
            const float rr[4] = {__uint_as_float(rw.x << 16), __uint_as_float(rw.x & 0xffff0000u), __uint_as_float(rw.y << 16), __uint_as_float(rw.y & 0xffff0000u)};
            float sa = S[0] * kn[0];
            sa = fmaf(S[1], kn[1], sa); sa = fmaf(S[2], kn[2], sa); sa = fmaf(S[3], kn[3], sa);
            sa = dpp_red16(sa);
            float y = 0.f;
#pragma unroll
            for (int i = 0; i < 4; ++i) { S[i] = fmaf(S[i], w[i], fmaf(vv, kp[i], -sa * ka[i])); y = fmaf(S[i], rr[i], y); }
            y = dpp_red16(y);
            if (kq == 0) YS[tt * 32 + vl] = y;
        }
        if (c + 1 < TP / 64) scan_write(lds + ((c + 1) & 1) * SC_BUF, tid, g);
        __syncthreads();
        {
            float* Y = (float*)(ws + NB_Y);
            for (int i = tid; i < 64 * 32; i += NTH) { const int tt = i >> 5, v = i & 31; Y[((size_t)b * TP + c * 64 + tt) * 1024 + hd * 64 + vh * 32 + v] = YS[i]; }
        }
        __syncthreads();
    }
    float* so = a.out + O_WKVP + ((size_t)(b * 16 + hd) * 64 + vh * 32 + vl) * 64 + kq * 4;
    *(float4*)so = make_float4(S[0], S[1], S[2], S[3]);
}
__device__ __forceinline__ void scan_sample(const Args& a, unsigned char* ws, int s, int hd, int lane) {
    const size_t row = (size_t)MP + s;
    const float* s0 = a.in[I_SWKV] + ((size_t)(s * 16 + hd) * 64 + lane) * 64;
    float* sout = a.out + O_WKVS + ((size_t)(s * 16 + hd) * 64 + lane) * 64;
    const float* dec = (const float*)(ws + NB_DEC) + row * 1024 + hd * 64;
    const bf16_t* kn = (const bf16_t*)(ws + NB_KKN) + row * 1024 + hd * 64; const bf16_t* ka = (const bf16_t*)(ws + NB_KKA) + row * 1024 + hd * 64;
    const bf16_t* kp = (const bf16_t*)(ws + NB_KP) + row * 1024 + hd * 64;
    const bf16_t* rp = (const bf16_t*)(ws + NB_RKVZ) + ((size_t)0 * XSH_ROWS + row) * 1024 + hd * 64;
    const float vv = bf2f(((const bf16_t*)(ws + NB_RKVZ) + ((size_t)2 * XSH_ROWS + row) * 1024 + hd * 64)[lane]);
    float sa = 0.f;
#pragma unroll 8
    for (int k = 0; k < 64; ++k) sa = fmaf(s0[k], bf2f(kn[k]), sa);
    float y = 0.f;
#pragma unroll 8
    for (int k = 0; k < 64; ++k) { const float sn = fmaf(s0[k], dec[k], fmaf(vv, bf2f(kp[k]), -sa * bf2f(ka[k]))); sout[k] = sn; y = fmaf(sn, bf2f(rp[k]), y); }
    {
        const float mean = wave_sum(y) * (1.f / 64.f);
        const float d = y - mean;
        const float rs = rsqrtf(wave_sum(d * d) * (1.f / 64.f) + GN_EPS);
        const int e = hd * 64 + lane;
        const float rkv = ((const float*)(ws + NB_RKS))[row * 16 + hd];
        const float zf = bf2f(((const bf16_t*)(ws + NB_RKVZ) + ((size_t)3 * XSH_ROWS + row) * 1024)[e]);
        const float o = fmaf(rkv, vv, d * rs * a.in[I_GNG][e] + a.in[I_GNB][e]) * silu_f(zf);
        ((bf16_t*)(ws + NB_G4B))[row * 1024 + e] = (bf16_t)(pk_bf16c(o, 0.f) & 0xffffu);
    }
}

constexpr int CS_LD = 72;
constexpr int CS_SLOT = 64 * CS_LD * 2;
constexpr int CS_F32A = 13 * CS_SLOT;
constexpr int CS_F32B = CS_F32A + 16384;
constexpr int CS_GS = CS_F32B + 16384;
constexpr int CS_END = CS_GS + 4096;
constexpr size_t CK_MCT = 0, CK_RY = 8192, CK_SADD = 16384, CK_Y0 = 32768, CK_BYTES = 49152;

__device__ __forceinline__ PG8_LAS bf16_t* cs_slot(PG8_LAS unsigned char* lds, int i) { return (PG8_LAS bf16_t*)(lds + i * CS_SLOT); }
__device__ __forceinline__ void cs_mm(f32x16& acc, const PG8_LAS bf16_t* X, const PG8_LAS bf16_t* Yt, int mt, int nt, int lane) {
    const int lr = lane & 31, h = lane >> 5;
#pragma unroll
    for (int s = 0; s < 4; ++s) {
        const bf16x8 av = *(const PG8_LAS bf16x8*)(X + (mt * 32 + lr) * CS_LD + s * 16 + h * 8);
        const bf16x8 bv = *(const PG8_LAS bf16x8*)(Yt + (nt * 32 + lr) * CS_LD + s * 16 + h * 8);
        acc = __builtin_amdgcn_mfma_f32_32x32x16_bf16(av, bv, acc, 0, 0, 0);
    }
}
__device__ __forceinline__ void cs_store_t(const f32x16& acc, PG8_LAS bf16_t* D, int mt, int nt, int lane) {
    typedef unsigned u32x2 __attribute__((ext_vector_type(2)));
    const int lr = lane & 31, h = lane >> 5;
#pragma unroll
    for (int c = 0; c < 4; ++c) { u32x2 w; w.x = pk_bf16c(acc[4 * c], acc[4 * c + 1]); w.y = pk_bf16c(acc[4 * c + 2], acc[4 * c + 3]);
        *(PG8_LAS u32x2*)(D + (nt * 32 + lr) * CS_LD + mt * 32 + 8 * c + 4 * h) = w; }
}
__device__ __forceinline__ void cs_store_n(const f32x16& acc, PG8_LAS bf16_t* D, int mt, int nt, int lane) {
    const int lr = lane & 31, h = lane >> 5;
#pragma unroll
    for (int i = 0; i < 16; ++i) D[(mt * 32 + (i & 3) + 8 * (i >> 2) + 4 * h) * CS_LD + nt * 32 + lr] = (bf16_t)(pk_bf16c(acc[i], 0.f) & 0xffffu);
}
__device__ __forceinline__ void cs_zero(f32x16& a) {
#pragma unroll
    for (int i = 0; i < 16; ++i) a[i] = 0.f;
}
__device__ __forceinline__ float dpp_red8(float v) {
    v += __builtin_bit_cast(float, __builtin_amdgcn_update_dpp(0, __builtin_bit_cast(int, v), 0xB1, 0xF, 0xF, true));
    v += __builtin_bit_cast(float, __builtin_amdgcn_update_dpp(0, __builtin_bit_cast(int, v), 0x4E, 0xF, 0xF, true));
    v += __builtin_bit_cast(float, __builtin_amdgcn_update_dpp(0, __builtin_bit_cast(int, v), 0x141, 0xF, 0xF, true));
    return v;
}

struct PreRegs { u32x4 kv, rv, vv; bf16x8 af[4]; };
__device__ __forceinline__ void scanpre_load(unsigned char* ws, int b, int hd, int c, int tid, PreRegs& r) {
    const int lane = tid & 63, wv = tid >> 6, lr = lane & 31, h = lane >> 5;
    const size_t row0 = (size_t)b * TP + c * 64;
    const int tok = tid >> 3, c8 = tid & 7;
    const size_t off = (row0 + tok) * 1024 + hd * 64 + c8 * 8;
    const bf16_t* RK = (const bf16_t*)(ws + NB_RKVZ);
    r.kv = *(const u32x4*)(RK + (size_t)1 * XSH_ROWS * 1024 + off); r.rv = *(const u32x4*)(RK + off); r.vv = *(const u32x4*)(RK + (size_t)2 * XSH_ROWS * 1024 + off);
    const int which = wv >> 2, mt = (wv >> 1) & 1;
    const bf16_t* A = (const bf16_t*)(ws + (which ? NB_AWB : NB_TWB)) + (row0 + mt * 32 + lr) * 64 + h * 8;
#pragma unroll
    for (int s = 0; s < 4; ++s) r.af[s] = *(const bf16x8*)(A + s * 16);
}
__device__ __forceinline__ void scanpre_chunk(const Args& a, unsigned char* ws, PG8_LAS unsigned char* lds, int b, int hd, int c, const PreRegs& pre, const bf16x8 (&btf)[4]) {
    const int tid = opaque_v(threadIdx.x), lane = tid & 63, wv = __builtin_amdgcn_readfirstlane(tid >> 6);
    const int lr = lane & 31, h = lane >> 5;
    const size_t row0 = (size_t)b * TP + c * 64;
    typedef unsigned u32x2 __attribute__((ext_vector_type(2)));
    PG8_LAS float* LCUM = (PG8_LAS float*)(lds + CS_F32A);
    PG8_LAS float* AV = (PG8_LAS float*)(lds + CS_F32B);
    PG8_LAS float* GS = (PG8_LAS float*)(lds + CS_GS);
    unsigned char* rec = ws + NB_CHK + ((size_t)(b * 16 + hd) * 32 + c) * CK_BYTES;
    {
        const int tok = tid >> 3, c8 = tid & 7;
        *(PG8_LAS u32x4*)(cs_slot(lds, 0) + tok * CS_LD + c8 * 8) = pre.kv;
        *(PG8_LAS u32x4*)(cs_slot(lds, 1) + tok * CS_LD + c8 * 8) = pre.rv;
        *(PG8_LAS u32x4*)(cs_slot(lds, 2) + tok * CS_LD + c8 * 8) = pre.vv;
    }
    {
        const int which = wv >> 2, mt = (wv >> 1) & 1, nt = wv & 1;
        f32x16 acc; cs_zero(acc);
#pragma unroll
        for (int s = 0; s < 4; ++s) acc = __builtin_amdgcn_mfma_f32_32x32x16_bf16(pre.af[s], btf[s], acc, 0, 0, 0);
        PG8_LAS float* D = which ? AV : LCUM;
        const float bias = a.in[which ? I_A0 : I_W0][hd * 64 + nt * 32 + lr];
#pragma unroll
        for (int i = 0; i < 16; ++i) {
            const float x = acc[i] + bias;
            float y;
            if (which) y = sigm_f(x);
            else { const float sp = fmaxf(-x, 0.f) + __logf(1.f + __expf(-fabsf(x))); y = -__expf(-sp - 0.5f); }
            D[(mt * 32 + (i & 3) + 8 * (i >> 2) + 4 * h) * 64 + nt * 32 + lr] = y;
        }
    }
    __syncthreads();
    {
        const int ch = tid & 63, tg = tid >> 6;
        float p[8]; float run = 0.f;
#pragma unroll
        for (int i = 0; i < 8; ++i) { run += LCUM[(tg * 8 + i) * 64 + ch]; p[i] = run; }
        GS[tg * 64 + ch] = run;
        __syncthreads();
        float offs = 0.f;
        for (int g = 0; g < tg; ++g) offs += GS[g * 64 + ch];
#pragma unroll
        for (int i = 0; i < 8; ++i) LCUM[(tg * 8 + i) * 64 + ch] = p[i] + offs;
    }
    __syncthreads();
    {
        const int tok = tid >> 3, c8 = tid & 7;
        const u32x4 kw = *(const PG8_LAS u32x4*)(cs_slot(lds, 0) + tok * CS_LD + c8 * 8), rw = *(const PG8_LAS u32x4*)(cs_slot(lds, 1) + tok * CS_LD + c8 * 8),
                    vw = *(const PG8_LAS u32x4*)(cs_slot(lds, 2) + tok * CS_LD + c8 * 8);
        float kf[8], rf[8], kk[8], kp[8], av[8];
        float n2 = 0.f, rk = 0.f;
#pragma unroll
        for (int i = 0; i < 8; ++i) {
            const int e = hd * 64 + c8 * 8 + i;
            kf[i] = __uint_as_float((i & 1) ? (kw[i >> 1] & 0xffff0000u) : (kw[i >> 1] << 16));
            rf[i] = __uint_as_float((i & 1) ? (rw[i >> 1] & 0xffff0000u) : (rw[i >> 1] << 16));
            av[i] = AV[tok * 64 + c8 * 8 + i];
            kk[i] = kf[i] * a.in[I_KK][e];
            kp[i] = kf[i] * (1.f + (av[i] - 1.f) * a.in[I_KA][e]);
            n2 = fmaf(kk[i], kk[i], n2);
            rk = fmaf(rf[i] * kp[i], a.in[I_RK][e], rk);
        }
        n2 = dpp_red8(n2); rk = dpp_red8(rk);
        const float inv = 1.f / fmaxf(sqrtf(n2), 1e-12f);
        if (c8 == 0) ((float*)(ws + NB_RKS))[(row0 + tok) * 16 + hd] = rk;
        if (tok == 63) {
#pragma unroll
            for (int i = 0; i < 8; ++i) GS[512 + c8 * 8 + i] = __expf(LCUM[63 * 64 + c8 * 8 + i]);
        }
        float qt[8], rt[8], kt[8], bt[8], kh[8], bh[8];
#pragma unroll
        for (int i = 0; i < 8; ++i) {
            const int ch = c8 * 8 + i;
            const float Lt = LCUM[tok * 64 + ch], Lp = tok ? LCUM[(tok - 1) * 64 + ch] : 0.f, Lc = LCUM[63 * 64 + ch];
            const float kn = kk[i] * inv, ka = kn * av[i];
            const float en = __expf(-Lt), ec = __expf(Lc - Lt);
            qt[i] = kn * __expf(Lp); rt[i] = rf[i] * __expf(Lt); kt[i] = kp[i] * en; bt[i] = ka * en; kh[i] = kp[i] * ec; bh[i] = ka * ec;
        }
#define CS_PUT_ROW(SLOT, ARR) { u32x4 w_; w_.x = pk_bf16c(ARR[0], ARR[1]); w_.y = pk_bf16c(ARR[2], ARR[3]); w_.z = pk_bf16c(ARR[4], ARR[5]); w_.w = pk_bf16c(ARR[6], ARR[7]); \
            *(PG8_LAS u32x4*)(cs_slot(lds, SLOT) + tok * CS_LD + c8 * 8) = w_; }
#define CS_PUT_COL(SLOT, ARR) { _Pragma("unroll") for (int i_ = 0; i_ < 8; ++i_) cs_slot(lds, SLOT)[(c8 * 8 + i_) * CS_LD + tok] = (bf16_t)(pk_bf16c(ARR[i_], 0.f) & 0xffffu); }
        CS_PUT_ROW(3, qt) CS_PUT_ROW(4, rt) CS_PUT_ROW(5, kt) CS_PUT_ROW(6, bt)
        CS_PUT_COL(7, qt) CS_PUT_COL(8, bh) CS_PUT_COL(9, kh)
#pragma unroll
        for (int i = 0; i < 8; ++i) cs_slot(lds, 10)[(c8 * 8 + i) * CS_LD + tok] = (bf16_t)((i & 1) ? (vw[i >> 1] >> 16) : (vw[i >> 1] & 0xffffu));
#undef CS_PUT_ROW
#undef CS_PUT_COL
    }
    __syncthreads();
    {
#pragma unroll 1
        for (int j = 0; j < 2; ++j) {
            const int job = wv * 2 + j, prod = job >> 2, mt = (job >> 1) & 1, nt = job & 1;
            const PG8_LAS bf16_t* X = cs_slot(lds, (prod & 1) ? 6 : 5);
            const PG8_LAS bf16_t* Y = cs_slot(lds, (prod & 2) ? 4 : 3);
            f32x16 acc; cs_zero(acc);
            cs_mm(acc, X, Y, mt, nt, lane);
            const int t = nt * 32 + lr, incl = (prod & 2) ? 1 : 0;
#pragma unroll
            for (int i = 0; i < 16; ++i) { const int sidx = mt * 32 + (i & 3) + 8 * (i >> 2) + 4 * h; acc[i] = (sidx < t + incl) ? acc[i] : 0.f; }
            const int dst = (prod == 0) ? 0 : (prod == 1) ? 11 : (prod == 2) ? 1 : 2;
            cs_store_t(acc, cs_slot(lds, dst), mt, nt, lane);
            if (prod == 1) cs_store_n(acc, cs_slot(lds, 12), mt, nt, lane);
        }
    }
    __syncthreads();
    {
        const int mt = (wv >> 1) & 1, nt = wv & 1;
        f32x16 pacc;
        if (wv < 4) {
#pragma unroll
            for (int i = 0; i < 16; ++i) { const int u = mt * 32 + (i & 3) + 8 * (i >> 2) + 4 * h, t = nt * 32 + lr;
                pacc[i] = ((u == t) ? 1.f : 0.f) - bf2f(cs_slot(lds, 12)[u * CS_LD + t]); }
            cs_store_t(pacc, cs_slot(lds, 3), mt, nt, lane);
        }
        __syncthreads();
        const int mcur = 11, mtcur = 12, mnxt = 5, mtnxt = 6;
        PG8_LAS bf16_t* XS0 = (PG8_LAS bf16_t*)(lds + CS_F32A);
        PG8_LAS bf16_t* XS1 = (PG8_LAS bf16_t*)(lds + CS_F32A + CS_SLOT);
        PG8_LAS bf16_t* XS2 = (PG8_LAS bf16_t*)(lds + CS_F32A + 2 * CS_SLOT);
        PG8_LAS bf16_t* Pc = cs_slot(lds, 3); PG8_LAS bf16_t* Pn = XS0;
        PG8_LAS bf16_t* Mc_ = cs_slot(lds, mcur); PG8_LAS bf16_t* MTc = cs_slot(lds, mtcur);
        PG8_LAS bf16_t* Mn = cs_slot(lds, mnxt); PG8_LAS bf16_t* MTn = cs_slot(lds, mtnxt);
#pragma unroll 1
        for (int it = 0; it < 5; ++it) {
            if (wv >= 4) {
                f32x16 acc; cs_zero(acc);
                cs_mm(acc, Mc_, MTc, mt, nt, lane);
                cs_store_n(acc, Mn, mt, nt, lane);
                cs_store_t(acc, MTn, mt, nt, lane);
                float mx = 0.f;
#pragma unroll
                for (int i = 0; i < 16; ++i) mx = fmaxf(mx, fabsf(acc[i]));
#pragma unroll
                for (int o = 32; o > 0; o >>= 1) mx = fmaxf(mx, __shfl_xor(mx, o));
                if (lane == 0) GS[640 + (wv & 3)] = mx;
            }
            __syncthreads();
            const float m2max = fmaxf(fmaxf(GS[640], GS[641]), fmaxf(GS[642], GS[643]));
            if (wv < 4) {
                cs_mm(pacc, MTn, Pc, mt, nt, lane);
                cs_store_t(pacc, Pn, mt, nt, lane);
            }
            __syncthreads();
            { PG8_LAS bf16_t* t0 = Mc_; Mc_ = Mn; Mn = t0; t0 = MTc; MTc = MTn; MTn = t0; t0 = Pc; Pc = Pn; Pn = t0; }
            if (m2max < 1e-7f) break;
        }
        {
            f32x16 acc; cs_zero(acc);
            if (wv < 4) { cs_mm(acc, cs_slot(lds, 0), cs_slot(lds, 10), mt, nt, lane); cs_store_t(acc, XS1, mt, nt, lane); }
            else { cs_mm(acc, Pc, cs_slot(lds, 7), mt, nt, lane); cs_store_t(acc, XS2, mt, nt, lane); }
        }
        __syncthreads();
        if (wv < 4) { f32x16 acc; cs_zero(acc); cs_mm(acc, Pc, XS1, mt, nt, lane); cs_store_t(acc, cs_slot(lds, 11), mt, nt, lane); }
        __syncthreads();
        if (wv < 4) {
            f32x16 acc; cs_zero(acc);
            cs_mm(acc, XS2, cs_slot(lds, 8), mt, nt, lane);
#pragma unroll
            for (int i = 0; i < 16; ++i) { const int k = mt * 32 + (i & 3) + 8 * (i >> 2) + 4 * h, kp_ = nt * 32 + lr; acc[i] = ((k == kp_) ? GS[512 + k] : 0.f) - acc[i]; }
            bf16_t* mct = (bf16_t*)(rec + CK_MCT);
#pragma unroll
            for (int cc = 0; cc < 4; ++cc) { u32x2 w; w.x = pk_bf16c(acc[4 * cc], acc[4 * cc + 1]); w.y = pk_bf16c(acc[4 * cc + 2], acc[4 * cc + 3]);
                *(u32x2*)(mct + (nt * 32 + lr) * 64 + mt * 32 + 8 * cc + 4 * h) = w; }
            f32x16 s1, s2; cs_zero(s1); cs_zero(s2);
            cs_mm(s1, cs_slot(lds, 9), cs_slot(lds, 10), mt, nt, lane);
            cs_mm(s2, cs_slot(lds, 8), cs_slot(lds, 11), mt, nt, lane);
            float* sd = (float*)(rec + CK_SADD) + ((size_t)(wv & 3) * 64 + lane) * 16;
#pragma unroll
            for (int q4 = 0; q4 < 4; ++q4) *(float4*)(sd + q4 * 4) = make_float4(s1[4 * q4] - s2[4 * q4], s1[4 * q4 + 1] - s2[4 * q4 + 1], s1[4 * q4 + 2] - s2[4 * q4 + 2], s1[4 * q4 + 3] - s2[4 * q4 + 3]);
        } else {
            f32x16 acc; cs_zero(acc);
            cs_mm(acc, XS2, cs_slot(lds, 2), mt, nt, lane);
            bf16_t* ry = (bf16_t*)(rec + CK_RY);
#pragma unroll
            for (int cc = 0; cc < 4; ++cc) {
                const u32x2 rv = *(const PG8_LAS u32x2*)(cs_slot(lds, 4) + (nt * 32 + lr) * CS_LD + mt * 32 + 8 * cc + 4 * h);
                const float r0 = __uint_as_float(rv.x << 16), r1 = __uint_as_float(rv.x & 0xffff0000u), r2 = __uint_as_float(rv.y << 16), r3 = __uint_as_float(rv.y & 0xffff0000u);
                u32x2 w; w.x = pk_bf16c(r0 - acc[4 * cc], r1 - acc[4 * cc + 1]); w.y = pk_bf16c(r2 - acc[4 * cc + 2], r3 - acc[4 * cc + 3]);
                *(u32x2*)(ry + (nt * 32 + lr) * 64 + mt * 32 + 8 * cc + 4 * h) = w;
            }
            f32x16 s1, s2; cs_zero(s1); cs_zero(s2);
            cs_mm(s1, cs_slot(lds, 1), cs_slot(lds, 10), mt, nt, lane);
            cs_mm(s2, cs_slot(lds, 2), cs_slot(lds, 11), mt, nt, lane);
            float* yd = (float*)(rec + CK_Y0) + ((size_t)(wv & 3) * 64 + lane) * 16;
#pragma unroll
            for (int q4 = 0; q4 < 4; ++q4) *(float4*)(yd + q4 * 4) = make_float4(s1[4 * q4] - s2[4 * q4], s1[4 * q4 + 1] - s2[4 * q4 + 1], s1[4 * q4 + 2] - s2[4 * q4 + 2], s1[4 * q4 + 3] - s2[4 * q4 + 3]);
        }
    }
    __syncthreads();
}

struct SeqRegs { bf16x8 a[4]; f32x4 c[4]; };
__device__ __forceinline__ void seq_load(const unsigned char* rec, bool isS, int wv, int mt, int lane, SeqRegs& r) {
    const int lr = lane & 31, h = lane >> 5;
    const bf16_t* ap = (const bf16_t*)(rec + (isS ? CK_MCT : CK_RY)) + (mt * 32 + lr) * 64 + h * 8;
    const float* cp = (const float*)(rec + (isS ? CK_SADD : CK_Y0)) + ((size_t)(wv & 3) * 64 + lane) * 16;
#pragma unroll
    for (int s = 0; s < 4; ++s) { r.a[s] = *(const bf16x8*)(ap + s * 16); r.c[s] = *(const f32x4*)(cp + s * 4); }
}
__device__ __forceinline__ void scanseq_head(const Args& a, unsigned char* ws, PG8_LAS unsigned char* lds, int b, int hd) {
    const int tid = opaque_v(threadIdx.x), lane = tid & 63, wv = __builtin_amdgcn_readfirstlane(tid >> 6);
    const int lr = lane & 31, h = lane >> 5;
    const int mt = (wv >> 1) & 1, nt = wv & 1;
    const bool isS = wv < 4;
    PG8_LAS bf16_t* SB0 = cs_slot(lds, 0); PG8_LAS bf16_t* SB1 = cs_slot(lds, 1);
    f32x16 st; cs_zero(st);
    for (int i = tid; i < 64 * CS_LD; i += NTH) { SB0[i] = 0; }
    const unsigned char* rec0 = ws + NB_CHK + (size_t)(b * 16 + hd) * 32 * CK_BYTES;
    SeqRegs cur, nxt;
    seq_load(rec0, isS, wv, mt, lane, nxt);
    PG8_LAS float* YT = (PG8_LAS float*)(lds + 2 * CS_SLOT);
    const int ptok = tid >> 3, pv8 = (tid & 7) * 8;
    float gg[8], gb[8];
#pragma unroll
    for (int q = 0; q < 2; ++q) { const float4 g4 = *(const float4*)(a.in[I_GNG] + hd * 64 + pv8 + q * 4), b4 = *(const float4*)(a.in[I_GNB] + hd * 64 + pv8 + q * 4);
        gg[4 * q] = g4.x; gg[4 * q + 1] = g4.y; gg[4 * q + 2] = g4.z; gg[4 * q + 3] = g4.w; gb[4 * q] = b4.x; gb[4 * q + 1] = b4.y; gb[4 * q + 2] = b4.z; gb[4 * q + 3] = b4.w; }
    __syncthreads();
#pragma unroll 1
    for (int c = 0; c < 32; ++c) {
        cur = nxt;
        if (c + 1 < 32) seq_load(rec0 + (size_t)(c + 1) * CK_BYTES, isS, wv, mt, lane, nxt);
        const size_t prow = (size_t)b * TP + c * 64 + ptok;
        const u32x4 vw = *(const u32x4*)((const bf16_t*)(ws + NB_RKVZ) + ((size_t)2 * XSH_ROWS + prow) * 1024 + hd * 64 + pv8);
        const u32x4 zw = *(const u32x4*)((const bf16_t*)(ws + NB_RKVZ) + ((size_t)3 * XSH_ROWS + prow) * 1024 + hd * 64 + pv8);
        const float rkv = ((const float*)(ws + NB_RKS))[prow * 16 + hd];
        const PG8_LAS bf16_t* S = (c & 1) ? SB1 : SB0;
        PG8_LAS bf16_t* Sn = (c & 1) ? SB0 : SB1;
        PG8_LAS float* Yb = YT + (c & 1) * (64 * 68);
        f32x16 acc;
#pragma unroll
        for (int q4 = 0; q4 < 4; ++q4) { acc[4 * q4] = cur.c[q4][0]; acc[4 * q4 + 1] = cur.c[q4][1]; acc[4 * q4 + 2] = cur.c[q4][2]; acc[4 * q4 + 3] = cur.c[q4][3]; }
#pragma unroll
        for (int s = 0; s < 4; ++s) {
            const bf16x8 bv = *(const PG8_LAS bf16x8*)(S + (nt * 32 + lr) * CS_LD + s * 16 + h * 8);
            acc = __builtin_amdgcn_mfma_f32_32x32x16_bf16(cur.a[s], bv, acc, 0, 0, 0);
        }
        if (isS) { st = acc; cs_store_t(st, Sn, mt, nt, lane); }
        else {
#pragma unroll
            for (int i = 0; i < 16; ++i) Yb[(mt * 32 + (i & 3) + 8 * (i >> 2) + 4 * h) * 68 + nt * 32 + lr] = acc[i];
        }
        __syncthreads();
        {
            float y[8];
            const f32x4 y0 = *(const PG8_LAS f32x4*)(Yb + ptok * 68 + pv8), y1 = *(const PG8_LAS f32x4*)(Yb + ptok * 68 + pv8 + 4);
            y[0] = y0[0]; y[1] = y0[1]; y[2] = y0[2]; y[3] = y0[3]; y[4] = y1[0]; y[5] = y1[1]; y[6] = y1[2]; y[7] = y1[3];
            float sm = 0.f;
#pragma unroll
            for (int i = 0; i < 8; ++i) sm += y[i];
            const float mean = dpp_red8(sm) * (1.f / 64.f);
            float sq = 0.f;
#pragma unroll
            for (int i = 0; i < 8; ++i) { y[i] -= mean; sq += y[i] * y[i]; }
            const float rs = rsqrtf(dpp_red8(sq) * (1.f / 64.f) + GN_EPS);
            float o[8];
#pragma unroll
            for (int i = 0; i < 8; ++i) {
                const float vf = __uint_as_float((i & 1) ? (vw[i >> 1] & 0xffff0000u) : (vw[i >> 1] << 16)), zf = __uint_as_float((i & 1) ? (zw[i >> 1] & 0xffff0000u) : (zw[i >> 1] << 16));
                o[i] = fmaf(rkv, vf, y[i] * rs * gg[i] + gb[i]) * silu_f(zf);
            }
            u32x4 w; w.x = pk_bf16c(o[0], o[1]); w.y = pk_bf16c(o[2], o[3]); w.z = pk_bf16c(o[4], o[5]); w.w = pk_bf16c(o[6], o[7]);
            *(u32x4*)((bf16_t*)(ws + NB_G4B) + prow * 1024 + hd * 64 + pv8) = w;
        }
    }
    if (isS) {
        float* so = a.out + O_WKVP + ((size_t)(b * 16 + hd) * 64 + nt * 32 + lr) * 64 + mt * 32 + 4 * h;
#pragma unroll
        for (int cc = 0; cc < 4; ++cc) *(float4*)(so + 8 * cc) = make_float4(st[4 * cc], st[4 * cc + 1], st[4 * cc + 2], st[4 * cc + 3]);
    }
    __syncthreads();
}

struct PostRegs { float y[16]; u32x4 v0, v1, z0, z1; float rk; };
__device__ __forceinline__ void post_load(unsigned char* ws, int row, int lane, PostRegs& r) {
    ld_row16((const float*)(ws + NB_Y) + (size_t)row * 1024, lane, r.y);
    const bf16_t* vp = (const bf16_t*)(ws + NB_RKVZ) + ((size_t)2 * XSH_ROWS + row) * 1024 + lane * 16;
    const bf16_t* zp = (const bf16_t*)(ws + NB_RKVZ) + ((size_t)3 * XSH_ROWS + row) * 1024 + lane * 16;
    r.v0 = *(const u32x4*)vp; r.v1 = *(const u32x4*)(vp + 8); r.z0 = *(const u32x4*)zp; r.z1 = *(const u32x4*)(zp + 8);
    r.rk = ((const float*)(ws + NB_RKS))[(size_t)row * 16 + (lane >> 2)];
}
__device__ __forceinline__ void phase_post(const Args& a, unsigned char* ws, int bid, int nb) {
    const int tid = opaque_v(threadIdx.x), lane = tid & 63, wv = tid >> 6;
    float gg[16], gb[16];
#pragma unroll
    for (int q = 0; q < 4; ++q) { const float4 g4 = *(const float4*)(a.in[I_GNG] + lane * 16 + q * 4), b4 = *(const float4*)(a.in[I_GNB] + lane * 16 + q * 4);
        gg[4 * q] = g4.x; gg[4 * q + 1] = g4.y; gg[4 * q + 2] = g4.z; gg[4 * q + 3] = g4.w; gb[4 * q] = b4.x; gb[4 * q + 1] = b4.y; gb[4 * q + 2] = b4.z; gb[4 * q + 3] = b4.w; }
    PostRegs cur, nxt;
    int row = bid * 8 + wv;
    if (row < MT) post_load(ws, row, lane, nxt);
#pragma unroll 1
    while (row < MT) {
        cur = nxt;
        const int nrow = row + nb * 8;
        if (nrow < MT) post_load(ws, nrow, lane, nxt);
        float* y = cur.y;
        float sm = 0.f;
#pragma unroll
        for (int i = 0; i < 16; ++i) sm += y[i];
        sm += __shfl_xor(sm, 1); sm += __shfl_xor(sm, 2);
        const float mean = sm * (1.f / 64.f);
        float sq = 0.f;
#pragma unroll
        for (int i = 0; i < 16; ++i) { y[i] -= mean; sq += y[i] * y[i]; }
        sq += __shfl_xor(sq, 1); sq += __shfl_xor(sq, 2);
        const float rs = rsqrtf(sq * (1.f / 64.f) + GN_EPS);
        float o[16];
#pragma unroll
        for (int i = 0; i < 16; ++i) {
            const unsigned vw = (i < 8) ? cur.v0[i >> 1] : cur.v1[(i - 8) >> 1], zw = (i < 8) ? cur.z0[i >> 1] : cur.z1[(i - 8) >> 1];
            const float vf = __uint_as_float((i & 1) ? (vw & 0xffff0000u) : (vw << 16)), zf = __uint_as_float((i & 1) ? (zw & 0xffff0000u) : (zw << 16));
            const float yn = fmaf(cur.rk, vf, y[i] * rs * gg[i] + gb[i]);
            o[i] = yn * silu_f(zf);
        }
        bf16_t* dst = (bf16_t*)(ws + NB_G4B) + (size_t)row * 1024 + lane * 16;
        u32x4 w0, w1;
        w0.x = pk_bf16(o[0], o[1]); w0.y = pk_bf16(o[2], o[3]); w0.z = pk_bf16(o[4], o[5]); w0.w = pk_bf16(o[6], o[7]);
        w1.x = pk_bf16(o[8], o[9]); w1.y = pk_bf16(o[10], o[11]); w1.z = pk_bf16(o[12], o[13]); w1.w = pk_bf16(o[14], o[15]);
        *(u32x4*)dst = w0; *(u32x4*)(dst + 8) = w1;
        row = nrow;
    }
}
__device__ __forceinline__ void phase_lnf(const Args& a, unsigned char* ws, int bid, int nb) {
    const int tid = opaque_v(threadIdx.x), lane = tid & 63, wv = tid >> 6;
    const float* PRE = (const float*)ws + WS_PRE;
    const float* P2 = (const float*)(ws + NB_Y);
    float x[16], nx[16], y[16], ny[16];
    int row = bid * 8 + wv;
    if (row < MT) { ld_row16(PRE + (size_t)row * 1024, lane, nx); ld_row16(P2 + (size_t)row * 1024, lane, ny); }
#pragma unroll 1
    while (row < MT) {
#pragma unroll
        for (int i = 0; i < 16; ++i) { x[i] = nx[i]; y[i] = ny[i]; }
        const int nrow = row + nb * 8;
        if (nrow < MT) { ld_row16(PRE + (size_t)nrow * 1024, lane, nx); ld_row16(P2 + (size_t)nrow * 1024, lane, ny); }
        ln_calc16(a.in[I_LNG], a.in[I_LNB], lane, x);
#pragma unroll
        for (int i = 0; i < 16; ++i) x[i] = fmaf(ALPHA, x[i], y[i]);
        ln_calc16(a.in[I_LNG] + 1024, a.in[I_LNB] + 1024, lane, x);
        float* o = (row < MP ? a.out + O_Y + (size_t)row * 1024 : a.out + O_YS + (size_t)(row - MP) * 1024) + lane * 16;
#pragma unroll
        for (int q = 0; q < 4; ++q) *(float4*)(o + q * 4) = make_float4(x[4 * q], x[4 * q + 1], x[4 * q + 2], x[4 * q + 3]);
        row = nrow;
    }
}
__device__ __forceinline__ void sample_pool_copy(const Args& a, unsigned char* ws, int bid, int nb) {
    float* KCS = (float*)(ws + NB_KCS);
    const int* pt = (const int*)a.in[I_PT];
    const float* ccmp = a.in[I_CCMP];
#pragma unroll 2
    for (int i = bid * NTH + threadIdx.x; i < BS * 256 * 256; i += nb * NTH) {
        const int c = i & 255, n = (i >> 8) & 255, s = i >> 16;
        const int kv = c >> 7, g = (c >> 6) & 1;
        const float* w = kv ? a.in[I_WVC] : a.in[I_WKC];
        const int pos0 = n * 32;
        const float* src = ccmp + ((size_t)pt[s * NPAGE + (pos0 >> 7)] * PAGE + (pos0 & 127)) * 256 + c;
        float acc = 0.f;
#pragma unroll
        for (int l = 0; l < 32; ++l) acc = fmaf(src[(size_t)l * 256], w[l * 2 + g], acc);
        KCS[i] = acc;
    }
    const float4* cw = (const float4*)a.in[I_CWIN];
    float4* ow = (float4*)(a.out + O_WINS);
#pragma unroll 4
    for (int i = bid * NTH + threadIdx.x; i < BS * 511 * 64; i += nb * NTH) {
        const int s = i / (511 * 64), rem = i - s * (511 * 64);
        ow[(size_t)s * 512 * 64 + rem] = cw[(size_t)s * 512 * 64 + 64 + rem];
    }
}
__device__ __forceinline__ void sample_conv(const Args& a, unsigned char* ws, PG8_LAS unsigned char* lds, int s) {
    const int ch = opaque_v(threadIdx.x);
    const bf16_t* h = (const bf16_t*)(ws + NB_HB) + (size_t)(MP + s) * 2560;
    const float* sc = a.in[I_SCONV] + (size_t)s * 30 * 512 + ch;
    const float u = bf2f(h[ch]) * sigm_f(bf2f(h[512 + ch]));
    float scv[30], wj[31];
    const float* __restrict__ cwp = a.in[I_CONVW] + ch;
#pragma unroll
    for (int j = 0; j < 30; ++j) { scv[j] = sc[(size_t)j * 512]; wj[j] = cwp[j * 512]; }
    wj[30] = cwp[30 * 512];
    float acc = a.in[I_CONVB][ch];
#pragma unroll
    for (int j = 0; j < 30; ++j) acc = fmaf(wj[j], scv[j], acc);
    acc = fmaf(wj[30], u, acc);
    float* __restrict__ oc = a.out + O_CONVS + (size_t)s * 30 * 512 + ch;
#pragma unroll
    for (int i = 0; i < 29; ++i) oc[(size_t)i * 512] = scv[i + 1];
    oc[(size_t)29 * 512] = u;
    PG8_LAS float* red = (PG8_LAS float*)lds;
    const int lane = ch & 63, wv = ch >> 6;
    float sm = wave_sum(acc);
    __syncthreads();
    if (lane == 0) red[wv] = sm;
    __syncthreads();
    float tot = 0.f;
#pragma unroll
    for (int i = 0; i < 8; ++i) tot += red[i];
    const float mean = tot * (1.f / 512.f);
    const float d = acc - mean;
    float sq = wave_sum(d * d);
    __syncthreads();
    if (lane == 0) red[wv] = sq;
    __syncthreads();
    tot = 0.f;
#pragma unroll
    for (int i = 0; i < 8; ++i) tot += red[i];
    const float rs = rsqrtf(tot * (1.f / 512.f) + LN_EPS);
    const float y = silu_f(d * rs * a.in[I_CLNG][ch] + a.in[I_CLNB][ch]) * silu_f(bf2f(h[1024 + ch]));
    ((bf16_t*)(ws + NB_CATB))[(size_t)(MP + s) * 1024 + ch] = (bf16_t)(pk_bf16(y, 0.f) & 0xffffu);
    __syncthreads();
}

constexpr int SP_STRIDE = 66;
__device__ __forceinline__ void sample_attn(const Args& a, unsigned char* ws, PG8_LAS unsigned char* lds, int s, int g, int part) {
    const int tid = opaque_v(threadIdx.x), lane = tid & 63, wv = __builtin_amdgcn_readfirstlane(tid >> 6);
    PG8_LAS float* PC = (PG8_LAS float*)lds;
    PG8_LAS float* IMP = (PG8_LAS float*)(lds + 4096);
    PG8_LAS int* SEL = (PG8_LAS int*)(lds + 4096 + 1024);
    PG8_LAS int* FLG = (PG8_LAS int*)(lds + 4096 + 1024 + 128);
    PG8_LAS float* PS = (PG8_LAS float*)(lds + 8192) + (tid >> 6) * 64;
    const int r = wv & 3, hh = g * 4 + r;
    const float slope = __builtin_amdgcn_exp2f(-(float)(hh + 1));
    const int* pt = (const int*)a.in[I_PT] + s * NPAGE;
    const bf16_t* hrow = (const bf16_t*)(ws + NB_HB) + (size_t)(MP + s) * 2560;
    float q[64];
#pragma unroll
    for (int d8 = 0; d8 < 8; ++d8) { const u32x4 w = *(const u32x4*)(hrow + 1536 + hh * 64 + d8 * 8);
#pragma unroll
        for (int i = 0; i < 4; ++i) { q[d8 * 8 + 2 * i] = __uint_as_float(w[i] << 16); q[d8 * 8 + 2 * i + 1] = __uint_as_float(w[i] & 0xffff0000u); } }
#define SAMP_DOT(KPTR, OUT) { const float4* k4_ = (const float4*)(KPTR); float4 kk_[16]; \
        _Pragma("unroll") for (int i_ = 0; i_ < 16; ++i_) kk_[i_] = k4_[i_]; float s_ = 0.f; \
        _Pragma("unroll") for (int i_ = 0; i_ < 16; ++i_) { s_ = fmaf(q[4 * i_], kk_[i_].x, s_); s_ = fmaf(q[4 * i_ + 1], kk_[i_].y, s_); s_ = fmaf(q[4 * i_ + 2], kk_[i_].z, s_); s_ = fmaf(q[4 * i_ + 3], kk_[i_].w, s_); } OUT = s_; }
    if (wv < 4) {
        const float* kc = (const float*)(ws + NB_KCS) + (size_t)s * 256 * 256 + g * 64;
        float sc[4];
        float mx = -INFINITY;
#pragma unroll
        for (int i = 0; i < 4; ++i) { const int n = lane + 64 * i; float d; SAMP_DOT(kc + (size_t)n * 256, d); sc[i] = d - slope * (float)(PAST - (32 * n + 31)); mx = fmaxf(mx, sc[i]); }
#pragma unroll
        for (int o = 32; o > 0; o >>= 1) mx = fmaxf(mx, __shfl_xor(mx, o));
        float ls = 0.f;
#pragma unroll
        for (int i = 0; i < 4; ++i) { sc[i] = __expf(sc[i] - mx); ls += sc[i]; }
        ls = wave_sum(ls);
        const float inv = 1.f / ls;
#pragma unroll
        for (int i = 0; i < 4; ++i) PC[r * 256 + lane + 64 * i] = sc[i] * inv;
    }
    __syncthreads();
    if (wv < 4 && part == 0) {
        const float* vc = (const float*)(ws + NB_KCS) + (size_t)s * 256 * 256 + 128 + g * 64 + lane;
        float oc0 = 0.f, oc1 = 0.f, oc2 = 0.f, oc3 = 0.f;
#pragma unroll 8
        for (int n = 0; n < 256; n += 4) {
            oc0 = fmaf(PC[r * 256 + n], vc[(size_t)n * 256], oc0); oc1 = fmaf(PC[r * 256 + n + 1], vc[(size_t)(n + 1) * 256], oc1);
            oc2 = fmaf(PC[r * 256 + n + 2], vc[(size_t)(n + 2) * 256], oc2); oc3 = fmaf(PC[r * 256 + n + 3], vc[(size_t)(n + 3) * 256], oc3);
        }
        ((float*)(ws + NB_OCS))[(size_t)(s * 8 + hh) * 64 + lane] = (oc0 + oc1) + (oc2 + oc3);
    }
    if (tid < 129) {
        float v = 0.f;
        if (tid < 128) { for (int rr = 0; rr < 4; ++rr) v += PC[rr * 256 + 2 * tid] + PC[rr * 256 + 2 * tid + 1]; }
        if (tid == 0 || tid >= 127) v = 1e4f;
        IMP[tid] = v;
    }
    __syncthreads();
    if (tid < 129) {
        const float vj = IMP[tid];
        int rank = 0;
        for (int i = 0; i < 129; ++i) { const float vi = IMP[i]; rank += (vi > vj || (vi == vj && i < tid)) ? 1 : 0; }
        FLG[tid] = (rank < 16) ? 1 : 0;
    }
    __syncthreads();
    if (tid < 129 && FLG[tid]) { int slot = 0; for (int i = 0; i < tid; ++i) slot += FLG[i]; SEL[slot] = tid; }
    __syncthreads();
    const float* csel = a.in[I_CSEL];
    const float* newsel = a.out + O_SELS + (size_t)s * 256;
    const float* cwin = a.in[I_CWIN] + (size_t)s * 512 * 256;
    const float* newwin = a.out + O_WINS + (size_t)(s * 512 + 511) * 256;
#pragma unroll 1
    for (int it = 0; it < 3; ++it) {
        const int lb = (wv >> 2) + 2 * it;
        const bool is_sel = lb < 4;
        const int slot = is_sel ? part * 4 + lb : part * 2 + (lb - 4);
        const float* rowp; const float* vb; int vstride_last; float dist; bool valid; int nk;
        if (is_sel) {
            const int blk = SEL[slot];
            const int kpos = blk * 64 + lane;
            valid = kpos <= PAST;
            rowp = (blk < 128) ? csel + ((size_t)pt[blk >> 1] * PAGE + (kpos & 127)) * 256 : newsel;
            vb = (blk < 128) ? csel + ((size_t)pt[blk >> 1] * PAGE + ((blk * 64) & 127)) * 256 + 128 + g * 64 + lane : newsel + 128 + g * 64 + lane;
            nk = (blk < 128) ? 64 : 1; dist = (float)(PAST - kpos); vstride_last = 0;
        } else {
            const int i0 = 1 + slot * 64;
            const int i = i0 + lane;
            valid = true; nk = 64;
            rowp = (i < 512) ? cwin + (size_t)i * 256 : newwin;
            vb = cwin + (size_t)i0 * 256 + 128 + g * 64 + lane;
            dist = (float)(512 - i); vstride_last = (slot == 7) ? 1 : 0;
        }
        float sc = -INFINITY;
        if (valid) { float d; SAMP_DOT(rowp + g * 64, d); sc = d - slope * dist; }
        float mx = sc;
#pragma unroll
        for (int of = 32; of > 0; of >>= 1) mx = fmaxf(mx, __shfl_xor(mx, of));
        const float p = valid ? __expf(sc - mx) : 0.f;
        const float l = wave_sum(p);
        PS[lane] = p; __builtin_amdgcn_wave_barrier();
        float o0 = 0.f, o1 = 0.f, o2 = 0.f, o3 = 0.f;
        if (nk == 64) {
            float vv[64];
#pragma unroll
            for (int k = 0; k < 63; ++k) vv[k] = vb[(size_t)k * 256];
            vv[63] = vstride_last ? newwin[128 + g * 64 + lane] : vb[(size_t)63 * 256];
#pragma unroll
            for (int k = 0; k < 64; k += 4) { o0 = fmaf(PS[k], vv[k], o0); o1 = fmaf(PS[k + 1], vv[k + 1], o1); o2 = fmaf(PS[k + 2], vv[k + 2], o2); o3 = fmaf(PS[k + 3], vv[k + 3], o3); }
        } else o0 = PS[0] * vb[0];
        __builtin_amdgcn_wave_barrier();
        float* pp = (float*)(ws + NB_PARTS) + ((size_t)((s * 8 + hh) * 24 + (is_sel ? slot : 16 + slot))) * SP_STRIDE;
        pp[2 + lane] = (o0 + o1) + (o2 + o3);
        if (lane == 0) { pp[0] = mx; pp[1] = l; }
    }
#undef SAMP_DOT
    __syncthreads();
}
__device__ __forceinline__ void sample_combine(const Args& a, unsigned char* ws, int s, int g) {
    const int tid = opaque_v(threadIdx.x), lane = tid & 63, wv = __builtin_amdgcn_readfirstlane(tid >> 6);
    if (wv >= 4) return;
    const int hh = g * 4 + wv;
    const float* pp = (const float*)(ws + NB_PARTS) + (size_t)(s * 8 + hh) * 24 * SP_STRIDE;
    const float* g3p = (const float*)(ws + NB_G3) + (size_t)(MP + s) * 32 + hh * 3;
    const float gc = sigm_f(g3p[0]), gs = sigm_f(g3p[1]), gw = sigm_f(g3p[2]);
    float res = gc * ((const float*)(ws + NB_OCS))[(size_t)(s * 8 + hh) * 64 + lane];
#pragma unroll
    for (int br = 0; br < 2; ++br) {
        const int n0 = br ? 16 : 0, cnt = br ? 8 : 16;
        float M = -INFINITY;
        for (int i = 0; i < cnt; ++i) M = fmaxf(M, pp[(size_t)(n0 + i) * SP_STRIDE]);
        float L = 0.f, O = 0.f;
        for (int i = 0; i < cnt; ++i) { const float* q = pp + (size_t)(n0 + i) * SP_STRIDE; const float w = __expf(q[0] - M); L = fmaf(q[1], w, L); O = fmaf(q[2 + lane], w, O); }
        res = fmaf(br ? gw : gs, O / L, res);
    }
    const bf16_t* hrow = (const bf16_t*)(ws + NB_HB) + (size_t)(MP + s) * 2560;
    const float y = res * silu_f(bf2f(hrow[2048 + hh * 64 + lane]));
    ((bf16_t*)(ws + NB_CATB))[(size_t)(MP + s) * 1024 + 512 + hh * 64 + lane] = (bf16_t)(pk_bf16(y, 0.f) & 0xffffu);
}

static_assert(CS_END <= LDS_MISC, "chunk-scan LDS map overlaps the barrier words");
enum { PH_PREP = 0, PH_GEMM1, PH_CONV, PH_ATTN, PH_GEMM2, PH_LNS, PH_GEMM3, PH_PREP2, PH_SCAN, PH_POST, PH_GEMM4, PH_LNF, NPHASE };

__global__ void __launch_bounds__(NTH, 2) mega(Args a) {
    extern __shared__ __attribute__((aligned(16))) unsigned char lds_raw[];
    PG8_LAS unsigned char* lds = (PG8_LAS unsigned char*)lds_raw;
    unsigned char* ws = a.ws;
    volatile LAS unsigned* misc = (volatile LAS unsigned*)(lds + LDS_MISC);
    if (threadIdx.x < 4) misc[threadIdx.x] = 0u;
    __syncthreads();
    XcdBarrier bar = xcd_barrier_post((unsigned*)(ws + NB_BAR), misc);
    const int lo = a.ph_lo, hi = a.ph_hi;
#ifndef DUP_SATTN
#define DUP_SATTN 0
#endif
#ifndef DUP_CONV
#define DUP_CONV 0
#endif
#ifndef DUP_GEMM1
#define DUP_GEMM1 0
#endif
#ifndef SKIPMASK
#define SKIPMASK 0
#endif
#define IN(k) (lo <= (k) && (k) < hi && !((SKIPMASK >> (k)) & 1))
#ifndef REPMASK
#define REPMASK 0
#endif
#define REPS(k) _Pragma("unroll 1") for (int rep_ = 0; rep_ < (((REPMASK >> (k)) & 1) ? 2 : 1); ++rep_)
#define SEAM(k) do { if (IN(k) && IN((k) + 1)) xcd_barrier(bar); } while (0)
    if (IN(PH_PREP)) REPS(PH_PREP) {
        const int bid = opaque(blockIdx.x), nb = gridDim.x;
        convert_wt(a.in[I_WIN], 1024, DIN, (bf16_t*)(ws + NB_WT1), N1PAD, MapWin{}, bid, nb);
        convert_wt(a.in[I_WOUTE], 1024, 1024, (bf16_t*)(ws + NB_WT2), 1024, MapId{}, bid, nb);
        for (int n = 0; n < 4; ++n) convert_wt(a.in[I_WRKVZ] + (size_t)n * 1024 * 1024, 1024, 1024, (bf16_t*)(ws + NB_WT3) + (size_t)n * 1024 * 1024, 1024, MapId{}, bid, nb);
        convert_wt(a.in[I_WOUTO], 1024, 1024, (bf16_t*)(ws + NB_WT4), 1024, MapId{}, bid, nb);
        convert_wt(a.in[I_W1], 1024, 64, (bf16_t*)(ws + NB_W1T), 64, MapId{}, bid, nb);
        convert_wt(a.in[I_A1], 1024, 64, (bf16_t*)(ws + NB_A1T), 64, MapId{}, bid, nb);
        convert_wt(a.in[I_W2], 64, 1024, (bf16_t*)(ws + NB_W2T), 1024, MapId{}, bid, nb);
        convert_wt(a.in[I_A2], 64, 1024, (bf16_t*)(ws + NB_A2T), 1024, MapId{}, bid, nb);
        convert_rows(a.in[I_XP], (size_t)MP * 1024 / 8, (bf16_t*)(ws + NB_XB), bid, nb);
        convert_rows(a.in[I_XS], (size_t)BS * 1024 / 8, (bf16_t*)(ws + NB_XSB), bid, nb);
        sample_pool_copy(a, ws, bid, nb);
    }
    SEAM(PH_PREP);
    if (IN(PH_GEMM1)) REPS(PH_GEMM1) {
        const int bid = opaque(blockIdx.x), nb = gridDim.x;
        const Route1 R{(bf16_t*)(ws + NB_HB), (bf16_t*)(ws + NB_KVB), (float*)(ws + NB_G3), a.out};
        {
            pg8::Gemm g{(const bf16_t*)(ws + NB_XB), (const bf16_t*)(ws + NB_WT1), MP, N1PAD, 1024};
            pg8::StaticOrder S; S.init(MP, N1PAD, nb, bid);
            Epi1 E{R};
            pg8::gemm_phase<Epi1, pg8::StaticOrder, false>(lds, g, S, E, nullptr);
#if DUP_GEMM1
            __syncthreads();
            pg8::gemm_phase<Epi1, pg8::StaticOrder, false>(lds, g, S, E, nullptr);
#endif
        }
        {
            for (int task = bid; task < 105; task += nb) {
                sample_gemm32_wg((const bf16_t*)(ws + NB_XSB), (const bf16_t*)(ws + NB_WT1), 1024, task * 32, lds,
                    [&](int r, int n, float v) {
                        const int row = MP + r;
                        if (n < 2560) { const float sc = (n >= 1536 && n < 2048) ? 0.125f : 1.0f; ((bf16_t*)(ws + NB_HB))[(size_t)row * 2560 + n] = (bf16_t)(pk_bf16c(v * sc, 0.f) & 0xffffu); }
                        else if (n < 3328) { const int c = n - 2560, i3 = c >> 8, cc = c & 255; ((bf16_t*)(ws + NB_KVB))[(size_t)row * 768 + c] = (bf16_t)(pk_bf16c(v, 0.f) & 0xffffu);
                            float* dst = (i3 == 0) ? a.out + O_CMPS + (size_t)r * 256 + cc : (i3 == 1) ? a.out + O_SELS + (size_t)r * 256 + cc : a.out + O_WINS + (size_t)(r * 512 + 511) * 256 + cc;
                            *dst = v; }
                        else if (n < 3352) ((float*)(ws + NB_G3))[(size_t)row * 32 + (n - 3328)] = v;
                    });
            }
        }
    }
    SEAM(PH_GEMM1);
    if (IN(PH_CONV)) REPS(PH_CONV) {
        const int bid = opaque(blockIdx.x), nb = gridDim.x;
        for (int item = bid; item < 256; item += nb) conv_item(a, ws, lds, item);
#if DUP_CONV
        for (int item = bid; item < 256; item += nb) conv_item(a, ws, lds, item);
#endif
        pool_prompt(a, ws, bid, nb);
        sample_attn(a, ws, lds, bid >> 3, (bid >> 2) & 1, bid & 3);
#if DUP_SATTN
        __syncthreads();
        sample_attn(a, ws, lds, bid >> 3, (bid >> 2) & 1, bid & 3);
#endif
        if (bid >= 96 && bid < 128) sample_conv(a, ws, lds, bid - 96);
    }
    SEAM(PH_CONV);
    if (IN(PH_ATTN)) REPS(PH_ATTN) {
        const int bid = opaque(blockIdx.x), nb = gridDim.x;
        if (bid < 64) sample_combine(a, ws, bid >> 1, bid & 1);
        for (int pr = bid; pr < 256; pr += nb) {
            const int b = pr >> 5, g = (pr >> 4) & 1, xq = pr & 15;
#pragma unroll 1
            for (int k = 0; k < 2; ++k) attn_item(a, ws, lds, b, g, k ? xq : 31 - xq);
        }
    }
    SEAM(PH_ATTN);
    if (IN(PH_GEMM2)) REPS(PH_GEMM2) {
        const int bid = opaque(blockIdx.x), nb = gridDim.x;
        {
            pg8::Gemm g{(const bf16_t*)(ws + NB_CATB), (const bf16_t*)(ws + NB_WT2), MP, 1024, 1024};
            pg8::StaticOrder S; S.init(MP, 1024, nb, bid);
            EpiPreRes E{(float*)ws + WS_PRE, a.in[I_XP]};
            pg8::gemm_phase<EpiPreRes, pg8::StaticOrder, false>(lds, g, S, E, nullptr);
        }
        {
            const int lane = threadIdx.x & 63, wv = __builtin_amdgcn_readfirstlane(threadIdx.x >> 6);
            float* PREs = (float*)ws + WS_PRE + (size_t)MP * 1024;
            const float* xs = a.in[I_XS];
            for (int task = bid; task < 32; task += nb)
                sample_gemm32_wg((const bf16_t*)(ws + NB_CATB) + (size_t)MP * 1024, (const bf16_t*)(ws + NB_WT2), 1024, task * 32, lds,
                              [&](int r, int n, float v) { PREs[(size_t)r * 1024 + n] = fmaf(ALPHA, xs[(size_t)r * 1024 + n], v); });
        }
    }
    SEAM(PH_GEMM2);
    if (IN(PH_LNS)) REPS(PH_LNS) { const int bid = opaque(blockIdx.x), nb = gridDim.x; phase_lns(a, ws, bid, nb); }
    SEAM(PH_LNS);
    if (IN(PH_GEMM3)) REPS(PH_GEMM3) {
        const int bid = opaque(blockIdx.x), nb = gridDim.x;
        {
            pg8::Gemm g{(const bf16_t*)(ws + NB_XSH), (const bf16_t*)(ws + NB_WT3), MP, 4096, 1024};
            Order3 S; S.init(nb, bid);
            Epi3 E{(bf16_t*)(ws + NB_RKVZ)};
            pg8::gemm_phase<Epi3, Order3, false>(lds, g, S, E, nullptr);
        }
        {
            const int lane = threadIdx.x & 63, wv = __builtin_amdgcn_readfirstlane(threadIdx.x >> 6);
            for (int task = bid; task < 128; task += nb) {
                const int n = task >> 5, n0 = (task & 31) * 32;
                bf16_t* dst = (bf16_t*)(ws + NB_RKVZ) + ((size_t)n * XSH_ROWS + MP) * 1024;
                sample_gemm32_wg((const bf16_t*)(ws + NB_XSH) + ((size_t)n * XSH_ROWS + MP) * 1024, (const bf16_t*)(ws + NB_WT3) + (size_t)n * 1024 * 1024, 1024, n0, lds,
                              [&](int r, int c, float v) { dst[(size_t)r * 1024 + c] = (bf16_t)(pk_bf16c(v, 0.f) & 0xffffu); });
            }
            for (int task = bid * 8 + wv; task < 513 * 4; task += nb * 8) {
                const int rt = task >> 2, which = (task >> 1) & 1, n0 = (task & 1) * 32;
                const bf16_t* A = (const bf16_t*)(ws + NB_XSH) + ((size_t)(4 + which) * XSH_ROWS + (size_t)rt * 32) * 1024;
                bf16_t* dst = (bf16_t*)(ws + (which ? NB_AWB : NB_TWB)) + (size_t)rt * 32 * 64;
                sample_gemm32(A, (const bf16_t*)(ws + (which ? NB_A1T : NB_W1T)), 1024, n0, lane,
                              [&](int r, int c, float v) { dst[(size_t)r * 64 + c] = (bf16_t)(pk_bf16c(which ? v : tanhf(v), 0.f) & 0xffffu); });
            }
        }
    }
    SEAM(PH_GEMM3);
    if (IN(PH_PREP2)) REPS(PH_PREP2) {
        const int bid = opaque(blockIdx.x), nb = gridDim.x;
        for (int pr = bid; pr < 256; pr += nb) {
            const int bh = pr >> 1, b = bh >> 4, hd = bh & 15, c0 = (pr & 1) * 16;
            const int tidp = opaque_v(threadIdx.x), lanep = tidp & 63, wvp = tidp >> 6;
            bf16x8 btf[4];
            { const int which = wvp >> 2, nt = wvp & 1;
              const bf16_t* Bt = (const bf16_t*)(ws + (which ? NB_A2T : NB_W2T)) + (size_t)(hd * 64 + nt * 32 + (lanep & 31)) * 64 + (lanep >> 5) * 8;
#pragma unroll
              for (int s4 = 0; s4 < 4; ++s4) btf[s4] = *(const bf16x8*)(Bt + s4 * 16); }
            PreRegs pcur, pnxt;
            scanpre_load(ws, b, hd, c0, tidp, pnxt);
#pragma unroll 1
            for (int cc = 0; cc < 16; ++cc) {
                pcur = pnxt;
                if (cc + 1 < 16) scanpre_load(ws, b, hd, c0 + cc + 1, tidp, pnxt);
                scanpre_chunk(a, ws, lds, b, hd, c0 + cc, pcur, btf);
            }
        }
        const int lane = opaque_v(threadIdx.x) & 63, wv = __builtin_amdgcn_readfirstlane(threadIdx.x >> 6);
        for (int task = bid * 8 + wv; task < 16; task += nb * 8) prep2_task(a, ws, 512, task, lane);
    }
    SEAM(PH_PREP2);
    if (IN(PH_SCAN)) REPS(PH_SCAN) {
        const int bid = opaque(blockIdx.x), nb = gridDim.x;
#pragma unroll 1
        for (int item = bid; item < 128; item += nb) scanseq_head(a, ws, lds, item >> 4, item & 15);
        const int lane = opaque_v(threadIdx.x) & 63, wv = __builtin_amdgcn_readfirstlane(threadIdx.x >> 6);
        for (int task = (nb - 1 - bid) * 8 + wv; task < BS * 16; task += nb * 8) scan_sample(a, ws, task >> 4, task & 15, lane);
    }
    if (IN(PH_SCAN) && IN(PH_GEMM4)) xcd_barrier(bar);
    if (IN(PH_GEMM4)) REPS(PH_GEMM4) {
        const int bid = opaque(blockIdx.x), nb = gridDim.x;
        {
            pg8::Gemm g{(const bf16_t*)(ws + NB_G4B), (const bf16_t*)(ws + NB_WT4), MP, 1024, 1024};
            pg8::StaticOrder S; S.init(MP, 1024, nb, bid);
            EpiPre E{(float*)(ws + NB_Y), 1024};
            pg8::gemm_phase<EpiPre, pg8::StaticOrder, false>(lds, g, S, E, nullptr);
        }
        {
            float* PREs = (float*)(ws + NB_Y) + (size_t)MP * 1024;
            for (int task = bid; task < 32; task += nb)
                sample_gemm32_wg((const bf16_t*)(ws + NB_G4B) + (size_t)MP * 1024, (const bf16_t*)(ws + NB_WT4), 1024, task * 32, lds,
                              [&](int r, int n, float v) { PREs[(size_t)r * 1024 + n] = v; });
        }
    }
    SEAM(PH_GEMM4);
    if (IN(PH_LNF)) REPS(PH_LNF) { const int bid = opaque(blockIdx.x), nb = gridDim.x; phase_lnf(a, ws, bid, nb); }
#undef IN
#undef SEAM
}
}

extern "C" void kernel_launch(void* const* d_in, const int* in_sizes, int n_in, void* d_out, int out_size, void* d_ws, size_t ws_size,
                              hipStream_t stream) {
    if (n_in != N_IN || ws_size < nk::NB_END) { fprintf(stderr, "kernel_launch: unexpected n_in %d or ws_size %zu (need %zu)\n", n_in, ws_size, (size_t)nk::NB_END); return; }
    static int grid = 0;
    if (!grid) {
        int dev = 0, cus = 0, per_cu = 0;
        hipGetDevice(&dev);
        hipDeviceGetAttribute(&cus, hipDeviceAttributeMultiprocessorCount, dev);
        hipFuncSetAttribute((const void*)nk::mega, hipFuncAttributeMaxDynamicSharedMemorySize, nk::LDS_BYTES);
        hipOccupancyMaxActiveBlocksPerMultiprocessor(&per_cu, (const void*)nk::mega, nk::NTH, nk::LDS_BYTES);
        if (per_cu < 1) fprintf(stderr, "kernel_launch: occupancy query says %d blocks per CU\n", per_cu);
        grid = cus;
    }
    hipMemsetAsync((unsigned char*)d_ws + nk::NB_BAR, 0, 32768, stream);
    nk::Args a{};
    for (int i = 0; i < N_IN; ++i) a.in[i] = (const float*)d_in[i];
    a.out = (float*)d_out; a.ws = (unsigned char*)d_ws; a.ph_lo = 0; a.ph_hi = nk::NPHASE;
    void* args[] = {&a};
    hipError_t e = hipLaunchCooperativeKernel((const void*)nk::mega, dim3(grid), dim3(nk::NTH), args, nk::LDS_BYTES, stream);
    if (e != hipSuccess) fprintf(stderr, "cooperative launch failed: %s (grid %d)\n", hipGetErrorString(e), grid);
}
```

```cpp
#include <hip/hip_runtime.h>
#include <hip/hip_cooperative_groups.h>
#include <cstdio>
namespace cg = cooperative_groups;
#ifndef PROBE_TIME
#define PROBE_TIME -1
#endif
#ifndef PROBE_K
#define PROBE_K 1e-4f
#endif

constexpr int D = 1024, BP = 8, TP = 2048, MP = BP * TP, BS = 32, MT = MP + BS;
constexpr int DIN = 3352;
constexpr int C_AVAL = 0, C_AGLU = 512, C_ZA = 1024, C_Q = 1536, C_KV = 2048, C_G3 = 2816, C_ZB = 2840;
constexpr int C_CMP = C_KV, C_SEL = C_KV + 256, C_WIN = C_KV + 512;
constexpr int PAST = 8192, NPAGE = 64, PAGE = 128;
constexpr float ALPHA = 1.4142135623730951f;
constexpr float LN_EPS = 1e-5f, GN_EPS = 64e-5f;

constexpr size_t O_Y = 0, O_YS = 16777216, O_CMPP = 16809984, O_CMPS = 21004288, O_SELP = 21012480, O_SELS = 25206784,
                 O_WINP = 25214976, O_WINS = 26263552, O_CONVP = 30457856, O_CONVS = 30580736, O_WKVP = 31072256,
                 O_WKVS = 31596544, O_SHP = 33693696, O_SHS = 33701888;

enum { I_XP = 0, I_XS, I_CCMP, I_CSEL, I_CWIN, I_SCONV, I_SWKV, I_SSHIFT, I_PT, I_WIN, I_CONVW, I_CONVB, I_CLNG, I_CLNB,
       I_WKC, I_WVC, I_WOUTE, I_MU, I_WRKVZ, I_W0, I_W1, I_W2, I_A0, I_A1, I_A2, I_KK, I_KA, I_RK, I_GNG, I_GNB, I_WOUTO,
       I_LNG, I_LNB, N_IN };

constexpr size_t SZ_ROWD = (size_t)MT * D;
constexpr size_t WS_H = 0;
constexpr size_t WS_CAT = WS_H + (size_t)MT * DIN;
constexpr size_t WS_OC = WS_CAT + SZ_ROWD;
constexpr size_t WS_XSH = 0;
constexpr size_t WS_Y = 0;
constexpr size_t WS_G4 = SZ_ROWD;
constexpr size_t WS_R0END = 6 * SZ_ROWD;
constexpr size_t WS_PRE = WS_R0END;
constexpr size_t WS_X1 = WS_PRE + SZ_ROWD;
constexpr size_t WS_R = WS_X1 + SZ_ROWD;
constexpr size_t WS_K = WS_R + SZ_ROWD;
constexpr size_t WS_V = WS_K + SZ_ROWD;
constexpr size_t WS_Z = WS_V + SZ_ROWD;
constexpr size_t WS_DEC = WS_Z + SZ_ROWD;
constexpr size_t WS_KKN = WS_DEC + SZ_ROWD;
constexpr size_t WS_KKA = WS_KKN + SZ_ROWD;
constexpr size_t WS_TW = WS_KKA + SZ_ROWD;
constexpr size_t WS_AW = WS_TW + (size_t)MT * 64;
constexpr size_t WS_RK = WS_AW + (size_t)MT * 64;
constexpr size_t WS_END = WS_RK + (size_t)MT * 16;
constexpr size_t WS_PCP = WS_R;
constexpr size_t WS_PCS = WS_R + (size_t)MP * 8 * 64;
constexpr size_t WS_IMP = WS_K;
constexpr size_t WS_SELIDX = WS_V;
constexpr size_t WS_KCP = WS_Z;
constexpr size_t WS_KCS = WS_Z + (size_t)8 * 64 * 256;
static_assert(WS_OC + (size_t)MT * 512 <= WS_R0END, "layer0 temporaries overflow region 0");

namespace pg8 {
#define PG8_LAS __attribute__((address_space(3)))
typedef unsigned short bf16_t;
typedef short bf16x8 __attribute__((ext_vector_type(8)));
typedef float f32x4 __attribute__((ext_vector_type(4)));
typedef unsigned u32x4 __attribute__((ext_vector_type(4)));
constexpr int BM = 256, BK = 64, HALF = 128, HTB = HALF * BK * 2  , STAGE_BYTES = 8 * HTB, NXCD = 8, WGM = 8;

__host__ __device__ __forceinline__ int lds_byte(int r, int c) { const int st = (r >> 4) * 2 + (c >> 5), rr = r & 15, cc = c & 31, ob = rr * 64 + cc * 2; return st * 1024 + (ob ^ (((ob >> 9) & 1) << 5)); }
__host__ __device__ __forceinline__ void stage_rc(int b, int& R, int& C) { const int st = b / 1024, sb = b % 1024, swz = sb ^ (((sb >> 9) & 1) << 5); R = (st >> 1) * 16 + swz / 64; C = (st & 1) * 32 + (swz % 64) / 2; }
__host__ __device__ __forceinline__ int perm32(int rho) { const int n = rho >> 4, i = rho & 15; return 8 * (i >> 2) + 4 * n + (i & 3); }

struct Unit { int pm, pn; };
struct Gemm { const bf16_t* A; const bf16_t* Bt; int M, N, K; };

struct StaticOrder {
    int nM, nN, nwg, G, c;
    __host__ __device__ void init(int M, int N, int G_, int c_) { nM = M / BM; nN = N / BM; nwg = nM * nN; G = G_; c = c_; }
    __host__ __device__ bool next(int i, Unit& u) const {
        const long L = (long)i * G + c; if (L >= nwg) return false;
        int wgid = (int)L; { const int q = nwg / NXCD, r = nwg % NXCD, xcd = wgid % NXCD, off = wgid / NXCD; wgid = (xcd < r ? xcd * (q + 1) : r * (q + 1) + (xcd - r) * q) + off; }
        const int nig = WGM * nN, gid = wgid / nig, fm = gid * WGM, gsz = (nM - fm) < WGM ? (nM - fm) : WGM;
        u.pm = fm + ((wgid % nig) % gsz); u.pn = (wgid % nig) / gsz; return true;
    }
    __device__ __forceinline__ void a_ready(const Unit&) const {}
    __device__ __forceinline__ void done(const Unit&) const {}
};
struct CountedOrder : StaticOrder {
    const unsigned* ready; unsigned need; unsigned* tmo;
    __device__ __forceinline__ void a_ready(const Unit& u) const {
        if (threadIdx.x < 64) {
            const unsigned long long t0 = __builtin_amdgcn_s_memrealtime(); unsigned polls = 0;
            while ((unsigned)__builtin_amdgcn_readfirstlane(__hip_atomic_load(ready + 64 * u.pm, __ATOMIC_RELAXED, __HIP_MEMORY_SCOPE_AGENT)) < need) {
                if ((++polls & 255u) == 0u && __builtin_amdgcn_readfirstlane(__hip_atomic_load(tmo, __ATOMIC_RELAXED, __HIP_MEMORY_SCOPE_AGENT)) != 0u) break;
                if (__builtin_amdgcn_s_memrealtime() - t0 > 2000000ull) {
                    if (threadIdx.x == 0) { unsigned expect = 0u; __hip_atomic_compare_exchange_strong(tmo + 1, &expect, 0x600u | (unsigned)(u.pm & 0xff), __ATOMIC_RELAXED, __ATOMIC_RELAXED, __HIP_MEMORY_SCOPE_AGENT); __hip_atomic_store(tmo, 1u, __ATOMIC_RELAXED, __HIP_MEMORY_SCOPE_AGENT); }
                    break; }
                __builtin_amdgcn_s_sleep(2); }
            __builtin_amdgcn_fence(__ATOMIC_ACQUIRE, "agent");
            asm volatile("s_waitcnt vmcnt(0)" ::: "memory");
        }
#if !defined(BROKEN_HOOK_NO_BARRIER)
        asm volatile("" ::: "memory"); __builtin_amdgcn_s_barrier(); asm volatile("" ::: "memory");
#endif
    }
};


template <class Epi, class Sched, bool STAMP = false>
__device__ __forceinline__ void gemm_phase(PG8_LAS unsigned char* lds, const Gemm g, const Sched& S, const Epi& E, unsigned long long* stamps) {
    int tid_ = threadIdx.x; asm volatile("" : "+v"(tid_));
    const int tid = tid_, wid = __builtin_amdgcn_readfirstlane(tid >> 6), lane = tid & 63, wr = wid >> 2, wc = wid & 3, fr = lane & 15, fq = lane >> 4;
    const int K = g.K, nt = K / BK;
    int ts_lo = 0, ts_hi = 0, nts = 0; const unsigned long long rt_entry = STAMP ? (unsigned long long)wall_clock64() : 0ull;
#define PG8_STAMP() do { if (STAMP && wid == 0 && nts < 64) { const unsigned long long _c = (unsigned long long)clock64(); \
        ts_lo = (lane == nts) ? (int)(unsigned)_c : ts_lo; ts_hi = (lane == nts) ? (int)(unsigned)(_c >> 32) : ts_hi; ++nts; } } while (0)
    PG8_STAMP();
    unsigned voffA[2], voffB[2];
#pragma unroll
    for (int i = 0; i < 2; ++i) { int R, C; stage_rc(tid * 16 + i * 8192, R, C); const int Rb = Epi::PERM ? ((R & ~31) + perm32(R & 31)) : R;
        voffA[i] = (unsigned)(R * K + C) * 2u; voffB[i] = (unsigned)(Rb * K + C) * 2u; }
    const size_t kstep = (size_t)(BK * 2);
    const size_t hstep = (size_t)HALF * K * 2;
    const size_t tstep = 2 * hstep;
    const unsigned ldsw = (unsigned)wid * 1024u;
    const int aoff = lds_byte(wr * 64 + fr, fq * 8), boff = lds_byte(wc * 32 + fr, fq * 8);
#define PG8_SA(b, h) (((b) * 2 + (h)) * HTB)
#define PG8_SB(b, h) ((4 + (b) * 2 + (h)) * HTB)
#define PG8_STAGE(bufoff, gbase, voff) do { _Pragma("unroll") for (int _i = 0; _i < 2; ++_i) \
        __builtin_amdgcn_global_load_lds((const unsigned*)((const char*)(gbase) + (voff)[_i]), (PG8_LAS unsigned*)(lds + (bufoff) + ldsw + _i * 8192), 16, 0, 0); } while (0)
#define PG8_LDA(dst, b, h) do { _Pragma("unroll") for (int m = 0; m < 4; ++m) _Pragma("unroll") for (int k = 0; k < 2; ++k) dst[m][k] = *(const PG8_LAS bf16x8*)(lds + PG8_SA(b, h) + aoff + m * 2048 + k * 1024); } while (0)
#define PG8_LDB(dst, b, h) do { _Pragma("unroll") for (int n = 0; n < 2; ++n) _Pragma("unroll") for (int k = 0; k < 2; ++k) dst[n][k] = *(const PG8_LAS bf16x8*)(lds + PG8_SB(b, h) + boff + n * 2048 + k * 1024); } while (0)
#define PG8_MMA(ai, bj, At, Bt) do { __builtin_amdgcn_s_setprio(1); _Pragma("unroll") for (int m = 0; m < 4; ++m) _Pragma("unroll") for (int n = 0; n < 2; ++n) _Pragma("unroll") for (int k = 0; k < 2; ++k) \
        acc[ai][bj][m][n] = __builtin_amdgcn_mfma_f32_16x16x32_bf16(Bt[n][k], At[m][k], acc[ai][bj][m][n], 0, 0, 0); __builtin_amdgcn_s_setprio(0); } while (0)
#define PG8_WAIT_V(n) asm volatile("s_waitcnt vmcnt(" #n ")" ::: "memory")
#define PG8_WAIT_L(n) asm volatile("s_waitcnt lgkmcnt(" #n ")" ::: "memory")
#define PG8_BAR __builtin_amdgcn_s_barrier()
#define PG8_SCHED __builtin_amdgcn_sched_barrier(0)
    Unit cur, nxt; int ui = 0;
    if (!S.next(0, cur)) return;
    f32x4 acc[2][2][4][2];
#pragma unroll
    for (int a = 0; a < 2; ++a)
#pragma unroll
        for (int b = 0; b < 2; ++b)
#pragma unroll
            for (int m = 0; m < 4; ++m)
#pragma unroll
                for (int n = 0; n < 2; ++n) acc[a][b][m][n] = (f32x4){0.f, 0.f, 0.f, 0.f};
    bf16x8 At[4][2], B0[2][2], B1[2][2];
    const char* cA = (const char*)g.A + (size_t)cur.pm * tstep; const char* cB = (const char*)g.Bt + (size_t)cur.pn * tstep;
    S.a_ready(cur);
    PG8_STAGE(PG8_SB(0, 0), cB, voffB); PG8_STAGE(PG8_SA(0, 0), cA, voffA); PG8_STAGE(PG8_SB(0, 1), cB + hstep, voffB); PG8_STAGE(PG8_SA(0, 1), cA + hstep, voffA);
    if (wr == 1) PG8_BAR;
    PG8_WAIT_V(4); PG8_BAR;
    PG8_STAGE(PG8_SB(1, 0), cB + kstep, voffB); PG8_STAGE(PG8_SA(1, 0), cA + kstep, voffA); PG8_STAGE(PG8_SB(1, 1), cB + hstep + kstep, voffB);
    PG8_WAIT_V(6); PG8_BAR;
    PG8_STAMP();
    for (;;) {
        const bool has_next = S.next(ui + 1, nxt);
        const char* nA = has_next ? (const char*)g.A + (size_t)nxt.pm * tstep : cA; const char* nB = has_next ? (const char*)g.Bt + (size_t)nxt.pn * tstep : cB;
        for (int t = 0; t < nt; t += 2) {
            const bool last = (t == nt - 2);
            const char* a1 = cA + (size_t)(t + 1) * kstep;
            const char* a2 = last ? nA : cA + (size_t)(t + 2) * kstep; const char* b2 = last ? nB : cB + (size_t)(t + 2) * kstep;
            const char* a3 = a2 + kstep; const char* b3 = b2 + kstep;
            if (last && has_next) S.a_ready(nxt);
            PG8_LDB(B0, 0, 0); PG8_SCHED; PG8_LDA(At, 0, 0); PG8_STAGE(PG8_SA(1, 1), a1 + hstep, voffA);
            PG8_WAIT_L(8); PG8_BAR; PG8_WAIT_L(0); PG8_MMA(0, 0, At, B0); PG8_BAR; PG8_SCHED;
            PG8_LDB(B1, 0, 1); PG8_STAGE(PG8_SB(0, 0), b2, voffB);
            PG8_BAR; PG8_WAIT_L(0); PG8_MMA(0, 1, At, B1); PG8_BAR;
            PG8_LDA(At, 0, 1); PG8_STAGE(PG8_SA(0, 0), a2, voffA);
            PG8_BAR; PG8_WAIT_L(0); PG8_MMA(1, 0, At, B0); PG8_BAR; PG8_SCHED;
            PG8_STAGE(PG8_SB(0, 1), b2 + hstep, voffB);
            PG8_WAIT_V(6); PG8_BAR; PG8_MMA(1, 1, At, B1); PG8_BAR;
            PG8_LDB(B0, 1, 0); PG8_SCHED; PG8_LDA(At, 1, 0); PG8_STAGE(PG8_SA(0, 1), a2 + hstep, voffA);
            PG8_WAIT_L(8); PG8_BAR; PG8_WAIT_L(0); PG8_MMA(0, 0, At, B0); PG8_BAR; PG8_SCHED;
            PG8_LDB(B1, 1, 1); PG8_STAGE(PG8_SB(1, 0), b3, voffB);
            PG8_BAR; PG8_WAIT_L(0); PG8_MMA(0, 1, At, B1); PG8_BAR;
            PG8_LDA(At, 1, 1); PG8_STAGE(PG8_SA(1, 0), a3, voffA);
            PG8_BAR; PG8_WAIT_L(0); PG8_MMA(1, 0, At, B0); PG8_BAR; PG8_SCHED;
            PG8_STAGE(PG8_SB(1, 1), b3 + hstep, voffB);
            PG8_WAIT_V(6); PG8_BAR; PG8_MMA(1, 1, At, B1); PG8_BAR;
        }
        PG8_STAMP();
        if constexpr (!Epi::AFTER_DRAIN) { E(acc, cur, wr, wc, fr, fq); S.done(cur); }
        PG8_STAMP();
        if (!has_next) break;
#pragma unroll
        for (int a = 0; a < 2; ++a)
#pragma unroll
            for (int b = 0; b < 2; ++b)
#pragma unroll
                for (int m = 0; m < 4; ++m)
#pragma unroll
                    for (int n = 0; n < 2; ++n) acc[a][b][m][n] = (f32x4){0.f, 0.f, 0.f, 0.f};
        cur = nxt; cA = nA; cB = nB; ++ui;
    }
    PG8_WAIT_V(0);
    if (wr == 0) PG8_BAR;
    PG8_BAR;
    if constexpr (Epi::AFTER_DRAIN) { E.fused(acc, cur, wr, wc, fr, fq, lds, wid, lane); S.done(cur); }
    PG8_STAMP();
    if (STAMP && wid == 0) { stamps[lane] = lane < nts ? (((unsigned long long)(unsigned)ts_hi << 32) | (unsigned)ts_lo) : 0ull;
        if (lane == 62) stamps[62] = rt_entry; if (lane == 63) stamps[63] = (unsigned long long)wall_clock64(); }
#undef PG8_STAMP
#undef PG8_SA
#undef PG8_SB
#undef PG8_STAGE
#undef PG8_LDA
#undef PG8_LDB
#undef PG8_MMA
#undef PG8_WAIT_V
#undef PG8_WAIT_L
#undef PG8_BAR
#undef PG8_SCHED
}
}

#define XB_TMO      128
#define XB_XCNT(j)  (256  + 64 * (j))
#define XB_XSUB(j)  (1280 + 64 * (j))
#define XB_XGEN(j)  (2304 + 64 * (j))
#define XB_TOP      3328
#define XB_TOPGEN   3392
#define XCD_BAR_WORDS 3456
#define XB_SPIN_CAP (1u << 18)
#define LAS __attribute__((address_space(3)))

__device__ __forceinline__ unsigned xb_ld(unsigned* p)              { return __hip_atomic_load(p, __ATOMIC_RELAXED, __HIP_MEMORY_SCOPE_AGENT); }
__device__ __forceinline__ unsigned xb_add(unsigned* p, unsigned v) { return __hip_atomic_fetch_add(p, v, __ATOMIC_RELAXED, __HIP_MEMORY_SCOPE_AGENT); }
__device__ __forceinline__ unsigned xb_xcc_id() { return (unsigned)__builtin_amdgcn_s_getreg((3 << 11) | 20) & 0xFu; }
#define XB_SPIN(cond, bar) do { unsigned _sp = 0; while (cond) { __builtin_amdgcn_s_sleep(1); \
    if ((++_sp & 255u) == 0u) { if (xb_ld(&(bar)[XB_TMO])) break; if (_sp > XB_SPIN_CAP) { atomicAdd(&(bar)[XB_TMO], 1u); break; } } } } while (0)

struct XcdBarrier {
    unsigned* bar; unsigned x;
    volatile LAS unsigned* st;
};

__device__ __forceinline__ XcdBarrier xcd_barrier_post(unsigned* bar, volatile LAS unsigned* st) {
    XcdBarrier b; b.bar = bar; b.x = xb_xcc_id(); b.st = st;
    if (threadIdx.x == 0) (void)xb_add(&bar[XB_XCNT(b.x)], 1u);
    return b;
}
__device__ __forceinline__ void xcd_barrier_complete(unsigned* bar, unsigned x, unsigned& nloc, unsigned& nx) {
    const unsigned G = gridDim.x * gridDim.y * gridDim.z;
    unsigned sum, cnt, mine, sp = 0u;
    for (;;) {
        sum = 0u; cnt = 0u; mine = 0u;
#pragma unroll
        for (unsigned j = 0; j < 16; ++j) { const unsigned c = xb_ld(&bar[XB_XCNT(j)]); sum += c; cnt += (c > 0u) ? 1u : 0u; mine = (j == x) ? c : mine; }
        if (sum == G) break;
        __builtin_amdgcn_s_sleep(1);
        if ((++sp & 255u) == 0u) { if (xb_ld(&bar[XB_TMO])) break; if (sp > XB_SPIN_CAP) { atomicAdd(&bar[XB_TMO], 1u); break; } }
    }
    nloc = mine > 0u ? mine : 1u; nx = cnt > 0u ? cnt : 1u;
}

__device__ __forceinline__ void xcd_barrier(const XcdBarrier& b) {
    asm volatile("s_waitcnt vmcnt(0)" ::: "memory");
    __syncthreads();
    if (threadIdx.x == 0) {
        unsigned* bar = b.bar;
        __builtin_amdgcn_s_waitcnt(0);
        unsigned nloc = b.st[0], nx = b.st[1];
        if (nloc == 0u) { xcd_barrier_complete(bar, b.x, nloc, nx); b.st[0] = nloc; b.st[1] = nx; }
        const unsigned old = xb_add(&bar[XB_XSUB(b.x)], 1u);
        const unsigned gen = old / nloc;
        if (old + 1u == (gen + 1u) * nloc) {
            __builtin_amdgcn_fence(__ATOMIC_RELEASE, "agent");
            asm volatile("s_waitcnt vmcnt(0)" ::: "memory");
            const unsigned og = xb_add(&bar[XB_TOP], 1u);
            const unsigned tg = og / nx;
            if (og + 1u == (tg + 1u) * nx) xb_add(&bar[XB_TOPGEN], 1u);
            else XB_SPIN(xb_ld(&bar[XB_TOPGEN]) == tg, bar);
            __builtin_amdgcn_fence(__ATOMIC_ACQUIRE, "agent");
            xb_add(&bar[XB_XGEN(b.x)], 1u);
            asm volatile("s_waitcnt vmcnt(0)" ::: "memory");
        } else {
            XB_SPIN(xb_ld(&bar[XB_XGEN(b.x)]) == gen, bar);
            __builtin_amdgcn_fence(__ATOMIC_ACQUIRE, "agent");
            asm volatile("s_waitcnt vmcnt(0)" ::: "memory");
        }
    }
    __syncthreads();
}

namespace nk {
using pg8::bf16_t; using pg8::bf16x8; using pg8::f32x4; using pg8::u32x4; using pg8::Unit;
constexpr int NTH = 512;
constexpr int LDS_STAGE = pg8::STAGE_BYTES;
constexpr int LDS_MISC = 158720;
constexpr int LDS_BYTES = LDS_MISC + 1024;

constexpr size_t NB0 = WS_END * 4;
constexpr size_t NB_BAR = NB0;
constexpr size_t NB_WT1 = NB_BAR + 32768;
constexpr size_t NB_WT2 = NB_WT1 + (size_t)3584 * 1024 * 2;
constexpr size_t NB_XB = NB_WT2 + (size_t)1024 * 1024 * 2;
constexpr size_t NB_XSB = NB_XB + (size_t)MP * 1024 * 2;
constexpr size_t NB_HB = NB_XSB + (size_t)BS * 1024 * 2;
constexpr size_t NB_KVB = NB_HB + (size_t)MT * 2560 * 2;
constexpr size_t NB_G3 = NB_KVB + (size_t)MT * 768 * 2;
constexpr size_t NB_CATB = NB_G3 + (size_t)MT * 32 * 4;
constexpr size_t NB_CBUF = NB_CATB + (size_t)MT * 1024 * 2;
constexpr size_t NB_KCB = NB_CBUF + (size_t)MP * 512 * 4;
constexpr size_t NB_WT3 = NB_KCB + (size_t)BP * 64 * 256 * 2;
constexpr size_t NB_WT4 = NB_WT3 + (size_t)4 * 1024 * 1024 * 2;
constexpr size_t NB_W1T = NB_WT4 + (size_t)1024 * 1024 * 2;
constexpr size_t NB_A1T = NB_W1T + (size_t)64 * 1024 * 2;
constexpr size_t NB_W2T = NB_A1T + (size_t)64 * 1024 * 2;
constexpr size_t NB_A2T = NB_W2T + (size_t)64 * 1024 * 2;
constexpr size_t NB_KCS = NB_A2T + (size_t)64 * 1024 * 2;
constexpr size_t NB_OCS = NB_KCS + (size_t)BS * 256 * 256 * 4;
constexpr size_t NB_PARTS = NB_OCS + (size_t)BS * 8 * 64 * 4;
constexpr size_t NB_END = NB_PARTS + (size_t)BS * 8 * 24 * 66 * 4;
constexpr size_t NB_XSH = 0;
constexpr size_t NB_RKVZ = NB_XSH + (size_t)6 * 16640 * 1024 * 2;
constexpr size_t NB_TWB = NB_RKVZ + (size_t)4 * 16640 * 1024 * 2;
constexpr size_t NB_AWB = NB_TWB + (size_t)MT * 64 * 2;
constexpr size_t NB_RKS = NB_AWB + (size_t)MT * 64 * 2;
static_assert(NB_RKS + (size_t)MT * 16 * 4 <= WS_PRE * 4, "layer-1 region A overflows into PRE");
constexpr size_t NB_DEC = (WS_X1 + SZ_ROWD) * 4;
constexpr size_t NB_KKN = NB_DEC + (size_t)MT * 1024 * 4;
constexpr size_t NB_KKA = NB_KKN + (size_t)MT * 1024 * 2;
constexpr size_t NB_KP = NB_KKA + (size_t)MT * 1024 * 2;
constexpr size_t NB_Y = NB_KP + (size_t)MT * 1024 * 2;
constexpr size_t NB_G4B = NB_Y + (size_t)MT * 1024 * 4;
constexpr size_t NB_CHK = NB_G4B + (size_t)MT * 1024 * 2;
static_assert(NB_CHK + (size_t)4096 * 32768 <= NB0, "layer-1 region B overflows");
constexpr int N1PAD = 3584;
__host__ __device__ __forceinline__ int win_src_col(int n) { return n < 2048 ? n : (n < 2560 ? C_ZB + (n - 2048) : (n < 3328 ? C_KV + (n - 2560) : (n < 3352 ? C_G3 + (n - 3328) : -1))); }

__device__ __forceinline__ int opaque(int x) { asm volatile("" : "+s"(x)); return x; }
__device__ __forceinline__ void lds_barrier() { asm volatile("s_waitcnt lgkmcnt(0)" ::: "memory"); __builtin_amdgcn_s_barrier(); asm volatile("" ::: "memory"); }
__device__ __forceinline__ int opaque_v(int x) { asm volatile("" : "+v"(x)); return x; }
struct Args { const float* in[N_IN]; float* out; unsigned char* ws; int ph_lo, ph_hi; };

__device__ __forceinline__ unsigned pk_bf16(float lo, float hi) { unsigned r; asm volatile("v_cvt_pk_bf16_f32 %0, %1, %2" : "=v"(r) : "v"(lo), "v"(hi)); return r; }
typedef __bf16 bf16x2_t __attribute__((ext_vector_type(2)));
__device__ __forceinline__ unsigned pk_bf16c(float lo, float hi) { bf16x2_t v; v[0] = (__bf16)lo; v[1] = (__bf16)hi; return __builtin_bit_cast(unsigned, v); }

template <class MAP>
__device__ __forceinline__ void convert_wt(const float* __restrict__ W, int K, int ldw, bf16_t* __restrict__ Wt, int Npad, MAP map, int bid, int nb) {
    const int kg = K / 8;
    const size_t total = (size_t)Npad * kg;
    for (size_t i = (size_t)bid * NTH + threadIdx.x; i < total; i += (size_t)nb * NTH) {
        const int n = (int)(i % Npad), k0 = (int)(i / Npad) * 8;
        const int sc = map(n);
        u32x4 w = {0u, 0u, 0u, 0u};
        if (sc >= 0) {
            float v[8];
#pragma unroll
            for (int j = 0; j < 8; ++j) v[j] = W[(size_t)(k0 + j) * ldw + sc];
            w.x = pk_bf16(v[0], v[1]); w.y = pk_bf16(v[2], v[3]); w.z = pk_bf16(v[4], v[5]); w.w = pk_bf16(v[6], v[7]);
        }
        *(u32x4*)(Wt + (size_t)n * K + k0) = w;
    }
}
struct MapId { __device__ __forceinline__ int operator()(int n) const { return n; } };
struct MapWin { __device__ __forceinline__ int operator()(int n) const { return win_src_col(n); } };
__device__ __forceinline__ void convert_rows(const float* __restrict__ src, size_t n8, bf16_t* __restrict__ dst, int bid, int nb) {
#pragma unroll 4
    for (size_t i = (size_t)bid * NTH + threadIdx.x; i < n8; i += (size_t)nb * NTH) {
        const float4 a = *(const float4*)(src + i * 8), b = *(const float4*)(src + i * 8 + 4);
        u32x4 w; w.x = pk_bf16(a.x, a.y); w.y = pk_bf16(a.z, a.w); w.z = pk_bf16(b.x, b.y); w.w = pk_bf16(b.z, b.w);
        *(u32x4*)(dst + i * 8) = w;
    }
}

struct EpiPre {
    static constexpr bool PERM = false, AFTER_DRAIN = false;
    float* C; int ldc;
    __device__ __forceinline__ void operator()(const f32x4 (&acc)[2][2][4][2], const Unit& u, int wr, int wc, int fr, int fq) const {
        const int row0 = u.pm * 256 + wr * 64 + fr, col0 = u.pn * 256 + wc * 32 + 4 * fq;
#pragma unroll
        for (int ai = 0; ai < 2; ++ai)
#pragma unroll
            for (int m = 0; m < 4; ++m) { float* rowp = C + (size_t)(row0 + ai * 128 + m * 16) * ldc + col0;
#pragma unroll
                for (int bj = 0; bj < 2; ++bj)
#pragma unroll
                    for (int n = 0; n < 2; ++n) *(f32x4*)(rowp + bj * 128 + n * 16) = acc[ai][bj][m][n]; }
    }
};


struct Route1 {
    bf16_t* HB; bf16_t* KVB; float* G3; float* out;
    __device__ __forceinline__ void put8(int row, int n0, const f32x4& v0, const f32x4& v1) const {
        if (n0 < 2560) {
            const float sc = (n0 >= 1536 && n0 < 2048) ? 0.125f : 1.0f;
            u32x4 w; w.x = pk_bf16c(v0[0] * sc, v0[1] * sc); w.y = pk_bf16c(v0[2] * sc, v0[3] * sc); w.z = pk_bf16c(v1[0] * sc, v1[1] * sc); w.w = pk_bf16c(v1[2] * sc, v1[3] * sc);
            *(u32x4*)(HB + (size_t)row * 2560 + n0) = w;
        } else if (n0 < 3328) {
            const int c = n0 - 2560, i3 = c >> 8, cc = c & 255;
            u32x4 w; w.x = pk_bf16c(v0[0], v0[1]); w.y = pk_bf16c(v0[2], v0[3]); w.z = pk_bf16c(v1[0], v1[1]); w.w = pk_bf16c(v1[2], v1[3]);
            *(u32x4*)(KVB + (size_t)row * 768 + c) = w;
            float* dst = nullptr;
            if (row < MP) {
                if (i3 == 0) dst = out + O_CMPP + (size_t)row * 256 + cc;
                else if (i3 == 1) dst = out + O_SELP + (size_t)row * 256 + cc;
                else { const int b = row >> 11, t = row & 2047; if (t >= TP - 512) dst = out + O_WINP + (size_t)(b * 512 + t - (TP - 512)) * 256 + cc; }
            } else {
                const int sidx = row - MP;
                if (i3 == 0) dst = out + O_CMPS + (size_t)sidx * 256 + cc;
                else if (i3 == 1) dst = out + O_SELS + (size_t)sidx * 256 + cc;
                else dst = out + O_WINS + (size_t)(sidx * 512 + 511) * 256 + cc;
            }
            if (dst) { *(f32x4*)dst = v0; *(f32x4*)(dst + 4) = v1; }
        } else if (n0 < 3352) {
            float* dst = G3 + (size_t)row * 32 + (n0 - 3328);
            *(f32x4*)dst = v0; *(f32x4*)(dst + 4) = v1;
        }
    }
};
struct Epi1 {
    static constexpr bool PERM = true, AFTER_DRAIN = false;
    Route1 R;
    __device__ __forceinline__ void operator()(const f32x4 (&acc)[2][2][4][2], const Unit& u, int wr, int wc, int fr, int fq) const {
        const int row0 = u.pm * 256 + wr * 64 + fr, col0 = u.pn * 256 + wc * 32 + 8 * fq;
#pragma unroll
        for (int ai = 0; ai < 2; ++ai)
#pragma unroll
            for (int m = 0; m < 4; ++m)
#pragma unroll
                for (int bj = 0; bj < 2; ++bj) R.put8(row0 + ai * 128 + m * 16, col0 + bj * 128, acc[ai][bj][m][0], acc[ai][bj][m][1]);
    }
};

typedef float f32x16 __attribute__((ext_vector_type(16)));
template <class EMIT>
__device__ __forceinline__ void sample_gemm32(const bf16_t* __restrict__ A, const bf16_t* __restrict__ Bt, int K, int n0, int lane, EMIT emit) {
    const bf16_t* ap = A + (size_t)(lane & 31) * K + 8 * (lane >> 5);
    const bf16_t* bp = Bt + (size_t)(n0 + (lane & 31)) * K + 8 * (lane >> 5);
    f32x16 acc;
#pragma unroll
    for (int i = 0; i < 16; ++i) acc[i] = 0.f;
#pragma unroll 16
    for (int k = 0; k < K; k += 16) {
        const bf16x8 av = *(const bf16x8*)(ap + k), bv = *(const bf16x8*)(bp + k);
        acc = __builtin_amdgcn_mfma_f32_32x32x16_bf16(av, bv, acc, 0, 0, 0);
    }
#pragma unroll
    for (int r = 0; r < 16; ++r) emit((r & 3) + 8 * (r >> 2) + 4 * (lane >> 5), n0 + (lane & 31), acc[r]);
}

template <class EMIT>
__device__ __forceinline__ void sample_gemm32_wg(const bf16_t* __restrict__ A, const bf16_t* __restrict__ Bt, int K, int n0, PG8_LAS unsigned char* lds, EMIT emit) {
    const int tid = opaque_v(threadIdx.x), lane = tid & 63, wv = tid >> 6;
    const int kq = K / 8;
    const bf16_t* ap = A + (size_t)(lane & 31) * K + 8 * (lane >> 5) + wv * kq;
    const bf16_t* bp = Bt + (size_t)(n0 + (lane & 31)) * K + 8 * (lane >> 5) + wv * kq;
    f32x16 acc;
#pragma unroll
    for (int i = 0; i < 16; ++i) acc[i] = 0.f;
#pragma unroll 8
    for (int k = 0; k < kq; k += 16) {
        const bf16x8 av = *(const bf16x8*)(ap + k), bv = *(const bf16x8*)(bp + k);
        acc = __builtin_amdgcn_mfma_f32_32x32x16_bf16(av, bv, acc, 0, 0, 0);
    }
    PG8_LAS float* P = (PG8_LAS float*)lds;
#pragma unroll
    for (int q = 0; q < 4; ++q) *(PG8_LAS f32x4*)(P + (wv * 64 + lane) * 16 + q * 4) = (f32x4){acc[4 * q], acc[4 * q + 1], acc[4 * q + 2], acc[4 * q + 3]};
    __syncthreads();
    if (wv == 0) {
#pragma unroll
        for (int w = 1; w < 8; ++w)
#pragma unroll
            for (int q = 0; q < 4; ++q) { const f32x4 v = *(const PG8_LAS f32x4*)(P + (w * 64 + lane) * 16 + q * 4); acc[4 * q] += v[0]; acc[4 * q + 1] += v[1]; acc[4 * q + 2] += v[2]; acc[4 * q + 3] += v[3]; }
#pragma unroll
        for (int r = 0; r < 16; ++r) emit((r & 3) + 8 * (r >> 2) + 4 * (lane >> 5), n0 + (lane & 31), acc[r]);
    }
    __syncthreads();
}

typedef float f32x16 __attribute__((ext_vector_type(16)));
__device__ __forceinline__ float bf2f(bf16_t v) { return __uint_as_float((unsigned)v << 16); }
__device__ __forceinline__ float sigm_f(float x) { return 1.f / (1.f + __expf(-x)); }
__device__ __forceinline__ float silu_f(float x) { return x / (1.f + __expf(-x)); }

__device__ __forceinline__ float wsum64(float v) {
    v += __builtin_bit_cast(float, __builtin_amdgcn_update_dpp(0, __builtin_bit_cast(int, v), 0xB1, 0xF, 0xF, true));
    v += __builtin_bit_cast(float, __builtin_amdgcn_update_dpp(0, __builtin_bit_cast(int, v), 0x4E, 0xF, 0xF, true));
    v += __builtin_bit_cast(float, __builtin_amdgcn_update_dpp(0, __builtin_bit_cast(int, v), 0x141, 0xF, 0xF, true));
    v += __builtin_bit_cast(float, __builtin_amdgcn_update_dpp(0, __builtin_bit_cast(int, v), 0x140, 0xF, 0xF, true));
    v += __shfl_xor(v, 16); v += __shfl_xor(v, 32);
    return v;
}
constexpr int CV_U = 0;
constexpr int CV_C = 65536;
__device__ __forceinline__ void conv_item(const Args& a, unsigned char* ws, PG8_LAS unsigned char* lds, int item) {
    const int tid = opaque_v(threadIdx.x);
    const int b = item >> 6, t0 = (item & 63) * 32;
    const bf16_t* HB = (const bf16_t*)(ws + NB_HB);
    PG8_LAS float* U = (PG8_LAS float*)(lds + CV_U);
    PG8_LAS float* C = (PG8_LAS float*)(lds + CV_C);
    const int chl = tid & 255, tp = tid >> 8;
    const int lane = tid & 63, wv = tid >> 6;
    u32x4 zv[4];
#pragma unroll
    for (int k = 0; k < 4; ++k) zv[k] = *(const u32x4*)(HB + (size_t)(b * TP + t0 + wv * 4 + k) * 2560 + 1024 + lane * 8);
#pragma unroll 1
    for (int half = 0; half < 2; ++half) {
        const int chb = half * 256;
#pragma unroll
        for (int it = 0; it < 4; ++it) {
            const int vi = tid + it * NTH;
            if (vi < 62 * 32) {
                const int r = vi >> 5, c8 = (vi & 31) * 8, t = t0 - 30 + r;
                float u[8];
                if (t >= 0) {
                    const bf16_t* h = HB + (size_t)(b * TP + t) * 2560 + chb + c8;
                    const u32x4 av = *(const u32x4*)h, gv = *(const u32x4*)(h + 512);
#pragma unroll
                    for (int i = 0; i < 8; ++i) {
                        const float x = __uint_as_float((i & 1) ? (av[i >> 1] & 0xffff0000u) : (av[i >> 1] << 16));
                        const float g = __uint_as_float((i & 1) ? (gv[i >> 1] & 0xffff0000u) : (gv[i >> 1] << 16));
                        u[i] = x * sigm_f(g);
                    }
                } else {
#pragma unroll
                    for (int i = 0; i < 8; ++i) u[i] = 0.f;
                }
                *(PG8_LAS f32x4*)(U + r * 256 + c8) = (f32x4){u[0], u[1], u[2], u[3]};
                *(PG8_LAS f32x4*)(U + r * 256 + c8 + 4) = (f32x4){u[4], u[5], u[6], u[7]};
                if (t >= TP - 30 && r >= 30) {
                    float* o = a.out + O_CONVP + (size_t)(b * 30 + t - (TP - 30)) * 512 + chb + c8;
                    *(float4*)o = make_float4(u[0], u[1], u[2], u[3]); *(float4*)(o + 4) = make_float4(u[4], u[5], u[6], u[7]);
                }
            }
        }
        __syncthreads();
        {
            const int ch = chb + chl;
            float w[31], uw[46], acc[16];
#pragma unroll
            for (int j = 0; j < 31; ++j) w[j] = a.in[I_CONVW][j * 512 + ch];
            const float bias = a.in[I_CONVB][ch];
#pragma unroll
            for (int r = 0; r < 46; ++r) uw[r] = U[(tp * 16 + r) * 256 + chl];
#pragma unroll
            for (int k = 0; k < 16; ++k) {
                float s_ = bias;
#pragma unroll
                for (int j = 0; j < 31; ++j) s_ = fmaf(w[j], uw[k + j], s_);
                acc[k] = s_;
            }
#pragma unroll
            for (int k = 0; k < 16; ++k) C[(tp * 16 + k) * 516 + ch] = acc[k];
        }
        __syncthreads();
    }
    {
        const float4 g0 = *(const float4*)(a.in[I_CLNG] + lane * 8), g1 = *(const float4*)(a.in[I_CLNG] + lane * 8 + 4);
        const float4 b0 = *(const float4*)(a.in[I_CLNB] + lane * 8), b1 = *(const float4*)(a.in[I_CLNB] + lane * 8 + 4);
        const float gg[8] = {g0.x, g0.y, g0.z, g0.w, g1.x, g1.y, g1.z, g1.w}, bb[8] = {b0.x, b0.y, b0.z, b0.w, b1.x, b1.y, b1.z, b1.w};
#pragma unroll
        for (int k = 0; k < 4; ++k) {
            const int tl = wv * 4 + k;
            const size_t row = (size_t)(b * TP + t0 + tl);
            const f32x4 c0 = *(const PG8_LAS f32x4*)(C + tl * 516 + lane * 8), c1 = *(const PG8_LAS f32x4*)(C + tl * 516 + lane * 8 + 4);
            float c[8] = {c0[0], c0[1], c0[2], c0[3], c1[0], c1[1], c1[2], c1[3]};
            float sm = 0.f;
#pragma unroll
            for (int i = 0; i < 8; ++i) sm += c[i];
            const float mean = wsum64(sm) * (1.f / 512.f);
            float sq = 0.f;
#pragma unroll
            for (int i = 0; i < 8; ++i) { c[i] -= mean; sq += c[i] * c[i]; }
            const float rs = rsqrtf(wsum64(sq) * (1.f / 512.f) + LN_EPS);
            float y[8];
#pragma unroll
            for (int i = 0; i < 8; ++i) {
                const float z = __uint_as_float((i & 1) ? (zv[k][i >> 1] & 0xffff0000u) : (zv[k][i >> 1] << 16));
                y[i] = silu_f(c[i] * rs * gg[i] + bb[i]) * silu_f(z);
            }
            u32x4 o; o.x = pk_bf16(y[0], y[1]); o.y = pk_bf16(y[2], y[3]); o.z = pk_bf16(y[4], y[5]); o.w = pk_bf16(y[6], y[7]);
            *(u32x4*)((bf16_t*)(ws + NB_CATB) + row * 1024 + lane * 8) = o;
        }
    }
    __syncthreads();
}

__device__ __forceinline__ void pool_prompt(const Args& a, unsigned char* ws, int bid, int nb) {
    bf16_t* KCB = (bf16_t*)(ws + NB_KCB);
    for (int i = bid * NTH + threadIdx.x; i < BP * 64 * 256; i += nb * NTH) {
        const int c = i & 255, n = (i >> 8) & 63, b = i >> 14;
        const int kv = c >> 7, g = (c >> 6) & 1;
        const float* w = kv ? a.in[I_WVC] : a.in[I_WKC];
        const float* src = a.out + O_CMPP + (size_t)(b * TP + n * 32) * 256 + c;
        float acc = 0.f;
#pragma unroll 8
        for (int l = 0; l < 32; ++l) acc = fmaf(src[(size_t)l * 256], w[l * 2 + g], acc);
        KCB[i] = (bf16_t)(pk_bf16(acc, 0.f) & 0xffffu);
    }
}

constexpr int A_KT = 0;
constexpr int A_VT = 18432;
constexpr int A_IMPH = 35840;
constexpr int A_IMPS = 68608;
constexpr int A_MASK = 76800;
constexpr float LOG2E = 1.4426950408889634f;

struct KvSrc { const bf16_t* k; const bf16_t* v; int rstride; };

__device__ __forceinline__ void kv_issue(const KvSrc& s, int tid, u32x4& kr, u32x4& vr) {
    const int key = tid >> 3, c8 = tid & 7;
    kr = *(const u32x4*)(s.k + (size_t)key * s.rstride + c8 * 8);
    vr = *(const u32x4*)(s.v + (size_t)key * s.rstride + c8 * 8);
}
__device__ __forceinline__ void kv_write(PG8_LAS unsigned char* lds, int buf, int tid, const u32x4& kr, const u32x4& vr) {
    const int key = tid >> 3, c8 = tid & 7;
    *(PG8_LAS u32x4*)(lds + A_KT + buf * 9216 + key * 144 + c8 * 16) = kr;
    PG8_LAS bf16_t* vt = (PG8_LAS bf16_t*)(lds + A_VT + buf * 8704);
#pragma unroll
    for (int i = 0; i < 4; ++i) { vt[(c8 * 8 + 2 * i) * 68 + key] = (bf16_t)(vr[i] & 0xffffu); vt[(c8 * 8 + 2 * i + 1) * 68 + key] = (bf16_t)(vr[i] >> 16); }
}

__device__ __forceinline__ void attn_block(const int MODE, PG8_LAS unsigned char* lds, int buf, const bf16x8 (&qf)[4], int lane, float kslope, float base, int kmax, int kmin,
                                           float& m, float& l, f32x16 (&o)[2], f32x16 (&x)[2]) {
    const int lr = lane & 31, h = lane >> 5;
    const PG8_LAS unsigned char* kt_p = lds + A_KT + buf * 9216 + lr * 144 + h * 16;
#pragma unroll
    for (int kt = 0; kt < 2; ++kt) {
#pragma unroll
        for (int i = 0; i < 16; ++i) x[kt][i] = 0.f;
#pragma unroll
        for (int s = 0; s < 4; ++s) {
            const bf16x8 kf = *(const PG8_LAS bf16x8*)(kt_p + kt * 32 * 144 + s * 32);
            x[kt] = __builtin_amdgcn_mfma_f32_32x32x16_bf16(kf, qf[s], x[kt], 0, 0, 0);
        }
    }
    const float bh = base + kslope * (float)(4 * h);
    float mx = -INFINITY;
#pragma unroll
    for (int kt = 0; kt < 2; ++kt)
#pragma unroll
        for (int i = 0; i < 16; ++i) {
            const int kc = kt * 32 + (i & 3) + 8 * (i >> 2);
            x[kt][i] = fmaf(x[kt][i], LOG2E, fmaf(kslope, (float)kc, bh));
        }
    if (MODE) {
        const int hi = kmax - 4 * h, lo = kmin - 4 * h;
#pragma unroll
        for (int kt = 0; kt < 2; ++kt)
#pragma unroll
            for (int i = 0; i < 16; ++i) {
                const int kc = kt * 32 + (i & 3) + 8 * (i >> 2);
                x[kt][i] = (kc > hi || kc < lo) ? -INFINITY : x[kt][i];
            }
    }
#pragma unroll
    for (int kt = 0; kt < 2; ++kt)
#pragma unroll
        for (int i = 0; i < 16; ++i) mx = fmaxf(mx, x[kt][i]);
    mx = fmaxf(mx, __shfl_xor(mx, 32));
    const float mn = fmaxf(m, mx);
    const float corr = __builtin_amdgcn_exp2f(m - mn);
    const bool grew = __any(mn > m);
    m = mn;
    float ls = 0.f;
#pragma unroll
    for (int kt = 0; kt < 2; ++kt)
#pragma unroll
        for (int i = 0; i < 16; ++i) { const float pv = __builtin_amdgcn_exp2f(x[kt][i] - mn); x[kt][i] = pv; ls += pv; }
    l = fmaf(l, corr, ls);
    if (grew) {
#pragma unroll
        for (int dt = 0; dt < 2; ++dt)
#pragma unroll
            for (int i = 0; i < 16; ++i) o[dt][i] *= corr;
    }
    const PG8_LAS unsigned char* vt_p = lds + A_VT + buf * 8704 + lr * 136 + h * 8;
#pragma unroll
    for (int kt = 0; kt < 2; ++kt)
#pragma unroll
        for (int s = 0; s < 2; ++s) {
            u32x4 pw; pw.x = pk_bf16(x[kt][8 * s + 0], x[kt][8 * s + 1]); pw.y = pk_bf16(x[kt][8 * s + 2], x[kt][8 * s + 3]);
            pw.z = pk_bf16(x[kt][8 * s + 4], x[kt][8 * s + 5]); pw.w = pk_bf16(x[kt][8 * s + 6], x[kt][8 * s + 7]);
            const bf16x8 pf = __builtin_bit_cast(bf16x8, pw);
#pragma unroll
            for (int dt = 0; dt < 2; ++dt) {
                const PG8_LAS unsigned char* vp = vt_p + dt * 32 * 136 + (kt * 32 + s * 16) * 2;
                typedef unsigned u32x2 __attribute__((ext_vector_type(2)));
                const u32x2 v0 = *(const PG8_LAS u32x2*)vp, v1 = *(const PG8_LAS u32x2*)(vp + 16);
                u32x4 vw; vw.x = v0.x; vw.y = v0.y; vw.z = v1.x; vw.w = v1.y;
                o[dt] = __builtin_amdgcn_mfma_f32_32x32x16_bf16(__builtin_bit_cast(bf16x8, vw), pf, o[dt], 0, 0, 0);
            }
        }
}

__device__ __forceinline__ void attn_item(const Args& a, unsigned char* ws, PG8_LAS unsigned char* lds, int b, int g, int qb) {
    const int tid = opaque_v(threadIdx.x), lane = tid & 63, wv = __builtin_amdgcn_readfirstlane(tid >> 6);
    const int lr = lane & 31, h = lane >> 5;
    const int r = wv >> 1, th = wv & 1, hh = g * 4 + r;
    const int t0 = qb * 64, tb = qb;
    const int qloc = th * 32 + lr;
    const int qpos = t0 + qloc;
    const size_t qrow = (size_t)b * TP + qpos;
    const bf16_t* HB = (const bf16_t*)(ws + NB_HB);
    const bf16_t* KVB = (const bf16_t*)(ws + NB_KVB);
    const float slope2 = __builtin_amdgcn_exp2f(-(float)(hh + 1)) * LOG2E;
    bf16x8 qf[4];
#pragma unroll
    for (int s = 0; s < 4; ++s) qf[s] = *(const bf16x8*)(HB + qrow * 2560 + 1536 + hh * 64 + s * 16 + h * 8);
    const float* g3p = (const float*)(ws + NB_G3) + qrow * 32 + hh * 3;
    const float gc = sigm_f(g3p[0]), gs = sigm_f(g3p[1]), gw = sigm_f(g3p[2]);
    f32x16 res[2], o[2], x[2];
#pragma unroll
    for (int dt = 0; dt < 2; ++dt)
#pragma unroll
        for (int i = 0; i < 16; ++i) { res[dt][i] = 0.f; o[dt][i] = 0.f; }
    float m = -1e30f, l = 0.f;
    u32x4 kr, vr;
    PG8_LAS float* IMPH = (PG8_LAS float*)(lds + A_IMPH);
    PG8_LAS float* IMPS = (PG8_LAS float*)(lds + A_IMPS);
    PG8_LAS unsigned* MASK = (PG8_LAS unsigned*)(lds + A_MASK);

    {
        const bf16_t* kc = (const bf16_t*)(ws + NB_KCB) + (size_t)b * 64 * 256 + g * 64;
        KvSrc s{kc, kc + 128, 256};
        kv_issue(s, tid, kr, vr); kv_write(lds, 0, tid, kr, vr);
        if (tid < 64) MASK[tid] = 0u;
        __syncthreads();
        const int nmax = (qpos >= 31) ? ((qpos - 31) >> 5) : -1;
        attn_block(1, lds, 0, qf, lane, slope2 * 32.f, slope2 * (float)(31 - qpos), nmax, 0, m, l, o, x);
        const float lt = l + __shfl_xor(l, 32);
        const float inv = (nmax >= 0) ? 1.f / lt : 0.f;
        const float sc = gc * inv;
#pragma unroll
        for (int dt = 0; dt < 2; ++dt)
#pragma unroll
            for (int i = 0; i < 16; ++i) { res[dt][i] = o[dt][i] * sc; o[dt][i] = 0.f; }
        if (tb >= 16) {
#pragma unroll
            for (int kt = 0; kt < 2; ++kt)
#pragma unroll
                for (int c = 0; c < 4; ++c)
#pragma unroll
                    for (int e = 0; e < 2; ++e)
                        IMPH[(r * 64 + qloc) * 32 + kt * 16 + 4 * c + 2 * h + e] = (nmax >= 0) ? (x[kt][4 * c + 2 * e] + x[kt][4 * c + 2 * e + 1]) * inv : 0.f;
        }
        m = -1e30f; l = 0.f;
        __syncthreads();
    }
    if (tb >= 16) {
        const int tq = opaque_v(tid);
        const int q = tq >> 3, jq = tq & 7;
        float v4[4];
#pragma unroll
        for (int e = 0; e < 4; ++e) {
            const int j = jq * 4 + e;
            float v = IMPH[(0 * 64 + q) * 32 + j] + IMPH[(1 * 64 + q) * 32 + j] + IMPH[(2 * 64 + q) * 32 + j] + IMPH[(3 * 64 + q) * 32 + j];
            if (j == 0 || j == tb || j == tb - 1) v = 1e4f;
            IMPS[q * 32 + j] = v; v4[e] = v;
        }
        __syncthreads();
        unsigned bits = 0u;
#pragma unroll
        for (int e = 0; e < 4; ++e) {
            const int j = jq * 4 + e;
            int rank = 0;
            for (int i = 0; i <= tb; ++i) { const float vi = IMPS[q * 32 + i]; rank += (vi > v4[e] || (vi == v4[e] && i < j)) ? 1 : 0; }
            if (j <= tb && rank < 16) bits |= 1u << j;
        }
        if (bits) atomicOr((unsigned*)&MASK[q], bits);
    } else {
        if (tid < 64) MASK[tid] = (2u << tb) - 1u;
    }
    __syncthreads();
    const unsigned selmask = MASK[qloc];

    {
        const bf16_t* kb = KVB + (size_t)b * TP * 768 + 256 + g * 64;
        { KvSrc s{kb, kb + 128, 768}; kv_issue(s, tid, kr, vr); kv_write(lds, 0, tid, kr, vr); }
        __syncthreads();
        for (int j = 0; j <= tb; ++j) {
            if (j < tb) { KvSrc s{kb + (size_t)(j + 1) * 64 * 768, kb + (size_t)(j + 1) * 64 * 768 + 128, 768}; kv_issue(s, tid, kr, vr); }
            const float base = ((selmask >> j) & 1u) ? slope2 * (float)(j * 64 - qpos) : -INFINITY;
            attn_block(j == tb, lds, j & 1, qf, lane, slope2, base, qloc, 0, m, l, o, x);
            if (j < tb) kv_write(lds, (j + 1) & 1, tid, kr, vr);
            __syncthreads();
        }
        const float lt = l + __shfl_xor(l, 32);
        const float sc = gs / lt;
#pragma unroll
        for (int dt = 0; dt < 2; ++dt)
#pragma unroll
            for (int i = 0; i < 16; ++i) { res[dt][i] = fmaf(o[dt][i], sc, res[dt][i]); o[dt][i] = 0.f; }
        m = -1e30f; l = 0.f;
    }
    {
        const int jlo = (tb >= 8) ? tb - 8 : 0;
        const bf16_t* kb = KVB + (size_t)b * TP * 768 + 512 + g * 64;
        { KvSrc s{kb + (size_t)jlo * 64 * 768, kb + (size_t)jlo * 64 * 768 + 128, 768}; kv_issue(s, tid, kr, vr); kv_write(lds, 0, tid, kr, vr); }
        __syncthreads();
        for (int j = jlo; j <= tb; ++j) {
            const int bi = (j - jlo) & 1;
            if (j < tb) { KvSrc s{kb + (size_t)(j + 1) * 64 * 768, kb + (size_t)(j + 1) * 64 * 768 + 128, 768}; kv_issue(s, tid, kr, vr); }
            const float base = slope2 * (float)(j * 64 - qpos);
            attn_block((j == tb) || (j == tb - 8), lds, bi, qf, lane, slope2, base, (j == tb) ? qloc : 64, (j == tb - 8) ? qpos - 511 - j * 64 : 0, m, l, o, x);
            if (j < tb) kv_write(lds, bi ^ 1, tid, kr, vr);
            __syncthreads();
        }
        const float lt = l + __shfl_xor(l, 32);
        const float sc = gw / lt;
#pragma unroll
        for (int dt = 0; dt < 2; ++dt)
#pragma unroll
            for (int i = 0; i < 16; ++i) res[dt][i] = fmaf(o[dt][i], sc, res[dt][i]);
    }
    {
        const size_t qrow2 = (size_t)b * TP + t0 + th * 32 + (opaque_v(lane) & 31);
        const bf16_t* zb = HB + qrow2 * 2560 + 2048 + hh * 64;
        bf16_t* dst = (bf16_t*)(ws + NB_CATB) + qrow2 * 1024 + 512 + hh * 64;
        typedef unsigned u32x2 __attribute__((ext_vector_type(2)));
#pragma unroll
        for (int dt = 0; dt < 2; ++dt)
#pragma unroll
            for (int c = 0; c < 4; ++c) {
                const int d = dt * 32 + 8 * c + 4 * h;
                const u32x2 zv = *(const u32x2*)(zb + d);
                const float z0 = __uint_as_float(zv.x << 16), z1 = __uint_as_float(zv.x & 0xffff0000u), z2 = __uint_as_float(zv.y << 16), z3 = __uint_as_float(zv.y & 0xffff0000u);
                u32x2 w; w.x = pk_bf16(res[dt][4 * c + 0] * silu_f(z0), res[dt][4 * c + 1] * silu_f(z1)); w.y = pk_bf16(res[dt][4 * c + 2] * silu_f(z2), res[dt][4 * c + 3] * silu_f(z3));
                *(u32x2*)(dst + d) = w;
            }
    }
}

constexpr int XSH_ROWS = 16640;
__device__ __forceinline__ float wave_sum(float v) {
#pragma unroll
    for (int o = 32; o > 0; o >>= 1) v += __shfl_xor(v, o);
    return v;
}
__device__ __forceinline__ void ld_row16(const float* __restrict__ src, int lane, float (&x)[16]) {
#pragma unroll
    for (int q = 0; q < 4; ++q) { const float4 v = *(const float4*)(src + q * 256 + lane * 4); x[4 * q] = v.x; x[4 * q + 1] = v.y; x[4 * q + 2] = v.z; x[4 * q + 3] = v.w; }
}
__device__ __forceinline__ void ln_calc16(const float* __restrict__ g, const float* __restrict__ bta, int lane, float (&x)[16]) {
    float sm = 0.f;
#pragma unroll
    for (int i = 0; i < 16; ++i) sm += x[i];
    const float mean = wave_sum(sm) * (1.f / 1024.f);
    float sq = 0.f;
#pragma unroll
    for (int i = 0; i < 16; ++i) { x[i] -= mean; sq += x[i] * x[i]; }
    const float rs = rsqrtf(wave_sum(sq) * (1.f / 1024.f) + LN_EPS);
#pragma unroll
    for (int q = 0; q < 4; ++q) {
        const float4 gv = *(const float4*)(g + q * 256 + lane * 4), bv = *(const float4*)(bta + q * 256 + lane * 4);
        x[4 * q] = x[4 * q] * rs * gv.x + bv.x; x[4 * q + 1] = x[4 * q + 1] * rs * gv.y + bv.y; x[4 * q + 2] = x[4 * q + 2] * rs * gv.z + bv.z; x[4 * q + 3] = x[4 * q + 3] * rs * gv.w + bv.w;
    }
}
__device__ __forceinline__ void ln_row16(const float* __restrict__ src, const float* __restrict__ g, const float* __restrict__ bta, int lane, float (&x)[16]) {
    ld_row16(src, lane, x); ln_calc16(g, bta, lane, x);
}
__device__ __forceinline__ void store_x1_xsh(const Args& a, unsigned char* ws, size_t row, size_t xrow, int lane, const float (&cur)[16], const float (&prev)[16]) {
#pragma unroll 1
    for (int n = 0; n < 6; ++n) {
        const float* mu = a.in[I_MU] + n * 1024 + lane * 4;
        bf16_t* dst = (bf16_t*)(ws + NB_XSH) + ((size_t)n * XSH_ROWS + xrow) * 1024 + lane * 4;
        typedef unsigned u32x2 __attribute__((ext_vector_type(2)));
#pragma unroll
        for (int q = 0; q < 4; ++q) { const float4 m4 = *(const float4*)(mu + q * 256);
            u32x2 w; w.x = pk_bf16(fmaf(prev[4 * q] - cur[4 * q], m4.x, cur[4 * q]), fmaf(prev[4 * q + 1] - cur[4 * q + 1], m4.y, cur[4 * q + 1]));
            w.y = pk_bf16(fmaf(prev[4 * q + 2] - cur[4 * q + 2], m4.z, cur[4 * q + 2]), fmaf(prev[4 * q + 3] - cur[4 * q + 3], m4.w, cur[4 * q + 3]));
            *(u32x2*)(dst + q * 256) = w; }
    }
}
__device__ __forceinline__ void phase_lns(const Args& a, unsigned char* ws, int bid, int nb) {
    const int tid = opaque_v(threadIdx.x), lane = tid & 63, wv = tid >> 6;
    const float* PRE = (const float*)ws + WS_PRE;
    const float* g = a.in[I_LNG]; const float* bta = a.in[I_LNB];
    for (int blk = bid; blk < 256; blk += nb) {
        const int r0 = blk * 64 + wv * 8;
        float prev[16], cur[16];
        if ((r0 & (TP - 1)) == 0) {
#pragma unroll
            for (int i = 0; i < 16; ++i) prev[i] = 0.f;
        } else ln_row16(PRE + (size_t)(r0 - 1) * 1024, g, bta, lane, prev);
        float nxt[16];
        ld_row16(PRE + (size_t)r0 * 1024, lane, nxt);
#pragma unroll 1
        for (int k = 0; k < 8; ++k) {
            const int row = r0 + k;
#pragma unroll
            for (int i = 0; i < 16; ++i) cur[i] = nxt[i];
            if (k + 1 < 8) ld_row16(PRE + (size_t)(row + 1) * 1024, lane, nxt);
            ln_calc16(g, bta, lane, cur);
            store_x1_xsh(a, ws, row, row, lane, cur, prev);
            if ((row & (TP - 1)) == TP - 1) {
                float* so = a.out + O_SHP + (size_t)(row >> 11) * 1024 + lane * 4;
#pragma unroll
                for (int q = 0; q < 4; ++q) *(float4*)(so + q * 256) = make_float4(cur[4 * q], cur[4 * q + 1], cur[4 * q + 2], cur[4 * q + 3]);
            }
#pragma unroll
            for (int i = 0; i < 16; ++i) prev[i] = cur[i];
        }
    }
    for (int s = bid * 8 + wv; s < BS; s += nb * 8) {
        float prev[16], cur[16];
        const float* sp = a.in[I_SSHIFT] + (size_t)s * 1024 + lane * 4;
#pragma unroll
        for (int q = 0; q < 4; ++q) { const float4 v = *(const float4*)(sp + q * 256); prev[4 * q] = v.x; prev[4 * q + 1] = v.y; prev[4 * q + 2] = v.z; prev[4 * q + 3] = v.w; }
        ln_row16(PRE + (size_t)(MP + s) * 1024, g, bta, lane, cur);
        store_x1_xsh(a, ws, MP + s, MP + s, lane, cur, prev);
        float* so = a.out + O_SHS + (size_t)s * 1024 + lane * 4;
#pragma unroll
        for (int q = 0; q < 4; ++q) *(float4*)(so + q * 256) = make_float4(cur[4 * q], cur[4 * q + 1], cur[4 * q + 2], cur[4 * q + 3]);
    }
}

struct Order3 {
    pg8::StaticOrder so;
    __device__ void init(int G, int c) { so.init(MP, 4096, G, c); }
    __device__ bool next(int i, Unit& u) const { Unit v; if (!so.next(i, v)) return false; const int n = v.pn >> 2; u.pm = n * 65 + v.pm; u.pn = v.pn; return true; }
    __device__ __forceinline__ void a_ready(const Unit&) const {}
    __device__ __forceinline__ void done(const Unit&) const {}
};
struct Epi3 {
    static constexpr bool PERM = true, AFTER_DRAIN = false;
    bf16_t* O;
    __device__ __forceinline__ void operator()(const f32x4 (&acc)[2][2][4][2], const Unit& u, int wr, int wc, int fr, int fq) const {
        const int n = u.pn >> 2, pm = u.pm - n * 65, pn = u.pn & 3;
        const int row0 = pm * 256 + wr * 64 + fr, col0 = pn * 256 + wc * 32 + 8 * fq;
        bf16_t* base = O + (size_t)n * XSH_ROWS * 1024;
#pragma unroll
        for (int ai = 0; ai < 2; ++ai)
#pragma unroll
            for (int m = 0; m < 4; ++m) { bf16_t* rowp = base + (size_t)(row0 + ai * 128 + m * 16) * 1024 + col0;
#pragma unroll
                for (int bj = 0; bj < 2; ++bj) { const f32x4 v0 = acc[ai][bj][m][0], v1 = acc[ai][bj][m][1];
                    u32x4 w; w.x = pk_bf16c(v0[0], v0[1]); w.y = pk_bf16c(v0[2], v0[3]); w.z = pk_bf16c(v1[0], v1[1]); w.w = pk_bf16c(v1[2], v1[3]);
                    *(u32x4*)(rowp + bj * 128) = w; } }
    }
};
struct EpiPreRes {
    static constexpr bool PERM = false, AFTER_DRAIN = false;
    float* C; const float* X;
    __device__ __forceinline__ void operator()(const f32x4 (&acc)[2][2][4][2], const Unit& u, int wr, int wc, int fr, int fq) const {
        const int row0 = u.pm * 256 + wr * 64 + fr, col0 = u.pn * 256 + wc * 32 + 4 * fq;
#pragma unroll
        for (int ai = 0; ai < 2; ++ai)
#pragma unroll
            for (int m = 0; m < 4; ++m) { const size_t off = (size_t)(row0 + ai * 128 + m * 16) * 1024 + col0;
#pragma unroll
                for (int bj = 0; bj < 2; ++bj)
#pragma unroll
                    for (int n = 0; n < 2; ++n) { const f32x4 xv = *(const f32x4*)(X + off + bj * 128 + n * 16); *(f32x4*)(C + off + bj * 128 + n * 16) = acc[ai][bj][m][n] + xv * ALPHA; } }
    }
};

constexpr int LR_A = 0;
constexpr int LR_P = 67584;
struct LoraRegs { u32x4 v[8]; };
__device__ __forceinline__ void lora_load(unsigned char* ws, int task, int tid, LoraRegs& r) {
    const int rt = task >> 1, which = task & 1;
    const bf16_t* A = (const bf16_t*)(ws + NB_XSH) + ((size_t)(4 + which) * XSH_ROWS + (size_t)rt * 32) * 1024;
#pragma unroll
    for (int i = 0; i < 8; ++i) { const int idx = tid + i * NTH; r.v[i] = *(const u32x4*)(A + (size_t)(idx >> 7) * 1024 + (idx & 127) * 8); }
}
__device__ __forceinline__ void lora_tile(unsigned char* ws, PG8_LAS unsigned char* lds, int task, int tid, const LoraRegs& r) {
    const int rt = task >> 1, which = task & 1;
    const int lane = tid & 63, wv = tid >> 6, lr = lane & 31, h = lane >> 5;
    PG8_LAS bf16_t* AT = (PG8_LAS bf16_t*)(lds + LR_A);
    PG8_LAS float* P = (PG8_LAS float*)(lds + LR_P);
#pragma unroll
    for (int i = 0; i < 8; ++i) { const int idx = tid + i * NTH; *(PG8_LAS u32x4*)(AT + (idx >> 7) * 1032 + (idx & 127) * 8) = r.v[i]; }
    __syncthreads();
    const bf16_t* Bt = (const bf16_t*)(ws + (which ? NB_A1T : NB_W1T));
    f32x16 acc0, acc1;
#pragma unroll
    for (int i = 0; i < 16; ++i) { acc0[i] = 0.f; acc1[i] = 0.f; }
#pragma unroll
    for (int s = 0; s < 8; ++s) {
        const int k = wv * 128 + s * 16 + h * 8;
        const bf16x8 av = *(const PG8_LAS bf16x8*)(AT + lr * 1032 + k);
        const bf16x8 b0 = *(const bf16x8*)(Bt + (size_t)lr * 1024 + k), b1 = *(const bf16x8*)(Bt + (size_t)(32 + lr) * 1024 + k);
        acc0 = __builtin_amdgcn_mfma_f32_32x32x16_bf16(av, b0, acc0, 0, 0, 0);
        acc1 = __builtin_amdgcn_mfma_f32_32x32x16_bf16(av, b1, acc1, 0, 0, 0);
    }
#pragma unroll
    for (int q = 0; q < 4; ++q) {
        *(PG8_LAS f32x4*)(P + (wv * 64 + lane) * 32 + q * 4) = (f32x4){acc0[4 * q], acc0[4 * q + 1], acc0[4 * q + 2], acc0[4 * q + 3]};
        *(PG8_LAS f32x4*)(P + (wv * 64 + lane) * 32 + 16 + q * 4) = (f32x4){acc1[4 * q], acc1[4 * q + 1], acc1[4 * q + 2], acc1[4 * q + 3]};
    }
    __syncthreads();
    if (wv < 2) {
        float sum[16];
#pragma unroll
        for (int i = 0; i < 16; ++i) sum[i] = 0.f;
#pragma unroll
        for (int w = 0; w < 8; ++w)
#pragma unroll
            for (int q = 0; q < 4; ++q) { const f32x4 v = *(const PG8_LAS f32x4*)(P + (w * 64 + lane) * 32 + wv * 16 + q * 4); sum[4 * q] += v[0]; sum[4 * q + 1] += v[1]; sum[4 * q + 2] += v[2]; sum[4 * q + 3] += v[3]; }
        bf16_t* dst = (bf16_t*)(ws + (which ? NB_AWB : NB_TWB)) + (size_t)rt * 32 * 64 + wv * 32 + lr;
#pragma unroll
        for (int i = 0; i < 16; ++i) { const int row = (i & 3) + 8 * (i >> 2) + 4 * h; const float v = which ? sum[i] : tanhf(sum[i]); dst[(size_t)row * 64] = (bf16_t)(pk_bf16c(v, 0.f) & 0xffffu); }
    }
    __syncthreads();
}

__device__ __forceinline__ float dpp_red16f(float v) {
    v += __builtin_bit_cast(float, __builtin_amdgcn_update_dpp(0, __builtin_bit_cast(int, v), 0xB1, 0xF, 0xF, true));
    v += __builtin_bit_cast(float, __builtin_amdgcn_update_dpp(0, __builtin_bit_cast(int, v), 0x4E, 0xF, 0xF, true));
    v += __builtin_bit_cast(float, __builtin_amdgcn_update_dpp(0, __builtin_bit_cast(int, v), 0x141, 0xF, 0xF, true));
    v += __builtin_bit_cast(float, __builtin_amdgcn_update_dpp(0, __builtin_bit_cast(int, v), 0x140, 0xF, 0xF, true));
    return v;
}
__device__ __forceinline__ void prep2_task(const Args& a, unsigned char* ws, int rt, int hd, int lane) {
    const int lr = lane & 31, h2 = lane >> 5;
    const size_t row0 = (size_t)rt * 32;
    const bf16_t* W2T = (const bf16_t*)(ws + NB_W2T); const bf16_t* A2T = (const bf16_t*)(ws + NB_A2T);
    const bf16_t* TWB = (const bf16_t*)(ws + NB_TWB); const bf16_t* AWB = (const bf16_t*)(ws + NB_AWB);
    f32x16 aw[2], aa[2];
#pragma unroll
    for (int ct = 0; ct < 2; ++ct)
#pragma unroll
        for (int i = 0; i < 16; ++i) { aw[ct][i] = 0.f; aa[ct][i] = 0.f; }
#pragma unroll
    for (int s = 0; s < 4; ++s) {
        const bf16x8 at = *(const bf16x8*)(TWB + (row0 + lr) * 64 + s * 16 + h2 * 8), aa_ = *(const bf16x8*)(AWB + (row0 + lr) * 64 + s * 16 + h2 * 8);
#pragma unroll
        for (int ct = 0; ct < 2; ++ct) {
            const size_t e = (size_t)hd * 64 + ct * 32 + lr;
            const bf16x8 w2 = *(const bf16x8*)(W2T + e * 64 + s * 16 + h2 * 8), a2 = *(const bf16x8*)(A2T + e * 64 + s * 16 + h2 * 8);
            aw[ct] = __builtin_amdgcn_mfma_f32_32x32x16_bf16(at, w2, aw[ct], 0, 0, 0);
            aa[ct] = __builtin_amdgcn_mfma_f32_32x32x16_bf16(aa_, a2, aa[ct], 0, 0, 0);
        }
    }
    const bf16_t* KB = (const bf16_t*)(ws + NB_RKVZ) + (size_t)1 * XSH_ROWS * 1024;
    const bf16_t* RB = (const bf16_t*)(ws + NB_RKVZ);
    float* DEC = (float*)(ws + NB_DEC);
    bf16_t* KKN = (bf16_t*)(ws + NB_KKN); bf16_t* KKA = (bf16_t*)(ws + NB_KKA); bf16_t* KP = (bf16_t*)(ws + NB_KP);
    float w0v[2], a0v[2], kkp[2], kap[2], rkp[2];
#pragma unroll
    for (int ct = 0; ct < 2; ++ct) { const int e = hd * 64 + ct * 32 + lr; w0v[ct] = a.in[I_W0][e]; a0v[ct] = a.in[I_A0][e]; kkp[ct] = a.in[I_KK][e]; kap[ct] = a.in[I_KA][e]; rkp[ct] = a.in[I_RK][e]; }
    float n2[16], rk[16];
#pragma unroll
    for (int i = 0; i < 16; ++i) { n2[i] = 0.f; rk[i] = 0.f; }
#pragma unroll
    for (int ct = 0; ct < 2; ++ct)
#pragma unroll
        for (int i = 0; i < 16; ++i) {
            const size_t off = (row0 + (i & 3) + 8 * (i >> 2) + 4 * h2) * 1024 + hd * 64 + ct * 32 + lr;
            const float kf = bf2f(KB[off]), rf = bf2f(RB[off]);
            const float wl = w0v[ct] + aw[ct][i];
            const float sp = fmaxf(-wl, 0.f) + log1pf(__expf(-fabsf(wl)));
            DEC[off] = __expf(-__expf(-sp - 0.5f));
            const float av_ = sigm_f(a0v[ct] + aa[ct][i]);
            const float kk = kf * kkp[ct];
            const float kp = kf * (1.f + (av_ - 1.f) * kap[ct]);
            KP[off] = (bf16_t)(pk_bf16(kp, 0.f) & 0xffffu);
            aw[ct][i] = kk; aa[ct][i] = av_;
            n2[i] = fmaf(kk, kk, n2[i]);
            rk[i] = fmaf(rf * kp, rkp[ct], rk[i]);
        }
#pragma unroll
    for (int i = 0; i < 16; ++i) {
        float v = dpp_red16f(n2[i]); v += __shfl_xor(v, 16); n2[i] = 1.f / fmaxf(sqrtf(v), 1e-12f);
        float w = dpp_red16f(rk[i]); w += __shfl_xor(w, 16); rk[i] = w;
    }
#pragma unroll
    for (int ct = 0; ct < 2; ++ct)
#pragma unroll
        for (int i = 0; i < 16; ++i) {
            const size_t off = (row0 + (i & 3) + 8 * (i >> 2) + 4 * h2) * 1024 + hd * 64 + ct * 32 + lr;
            const float kn = aw[ct][i] * n2[i];
            KKN[off] = (bf16_t)(pk_bf16(kn, 0.f) & 0xffffu);
            KKA[off] = (bf16_t)(pk_bf16(kn * aa[ct][i], 0.f) & 0xffffu);
        }
    if (lr == 0) {
#pragma unroll
        for (int i = 0; i < 16; ++i) ((float*)(ws + NB_RKS))[(row0 + (i & 3) + 8 * (i >> 2) + 4 * h2) * 16 + hd] = rk[i];
    }
}

constexpr int SC_BUF = 53248;
__device__ __forceinline__ float dpp_red16(float v) {
    v += __builtin_bit_cast(float, __builtin_amdgcn_update_dpp(0, __builtin_bit_cast(int, v), 0xB1, 0xF, 0xF, true));
    v += __builtin_bit_cast(float, __builtin_amdgcn_update_dpp(0, __builtin_bit_cast(int, v), 0x4E, 0xF, 0xF, true));
    v += __builtin_bit_cast(float, __builtin_amdgcn_update_dpp(0, __builtin_bit_cast(int, v), 0x141, 0xF, 0xF, true));
    v += __builtin_bit_cast(float, __builtin_amdgcn_update_dpp(0, __builtin_bit_cast(int, v), 0x140, 0xF, 0xF, true));
    return v;
}
struct ScanRegs { u32x4 d0, d1, kn, ka, kp, r, v; };
__device__ __forceinline__ void scan_issue(unsigned char* ws, int b, int hd, int vh, int chunk, int tid, ScanRegs& g) {
    const int tt = tid >> 3, part = tid & 7;
    const size_t row = (size_t)b * TP + chunk * 64 + tt;
    const size_t off = row * 1024 + hd * 64 + part * 8;
    const float* dp = (const float*)(ws + NB_DEC) + off;
    g.d0 = *(const u32x4*)dp; g.d1 = *(const u32x4*)(dp + 4);
    g.kn = *(const u32x4*)((const bf16_t*)(ws + NB_KKN) + off);
    g.ka = *(const u32x4*)((const bf16_t*)(ws + NB_KKA) + off);
    g.kp = *(const u32x4*)((const bf16_t*)(ws + NB_KP) + off);
    g.r = *(const u32x4*)((const bf16_t*)(ws + NB_RKVZ) + ((size_t)0 * XSH_ROWS + row) * 1024 + hd * 64 + part * 8);
    if (part < 4) g.v = *(const u32x4*)((const bf16_t*)(ws + NB_RKVZ) + ((size_t)2 * XSH_ROWS + row) * 1024 + hd * 64 + vh * 32 + part * 8);
}
__device__ __forceinline__ void scan_write(PG8_LAS unsigned char* buf, int tid, const ScanRegs& g) {
    const int tt = tid >> 3, part = tid & 7;
    *(PG8_LAS u32x4*)(buf + tt * 256 + part * 32) = g.d0; *(PG8_LAS u32x4*)(buf + tt * 256 + part * 32 + 16) = g.d1;
    *(PG8_LAS u32x4*)(buf + 16384 + tt * 128 + part * 16) = g.kn;
    *(PG8_LAS u32x4*)(buf + 24576 + tt * 128 + part * 16) = g.ka;
    *(PG8_LAS u32x4*)(buf + 32768 + tt * 128 + part * 16) = g.kp;
    *(PG8_LAS u32x4*)(buf + 40960 + tt * 128 + part * 16) = g.r;
    if (part < 4) *(PG8_LAS u32x4*)(buf + 49152 + tt * 64 + part * 16) = g.v;
}
__device__ __forceinline__ void scan_prompt(const Args& a, unsigned char* ws, PG8_LAS unsigned char* lds, int item) {
    const int tid = opaque_v(threadIdx.x);
    const int b = item >> 5, hd = (item >> 1) & 15, vh = item & 1;
    const int vl = tid >> 4, kq = tid & 15;
    typedef unsigned u32x2 __attribute__((ext_vector_type(2)));
    float S[4] = {0.f, 0.f, 0.f, 0.f};
    ScanRegs g;
    PG8_LAS float* YS = (PG8_LAS float*)(lds + 2 * SC_BUF);
    scan_issue(ws, b, hd, vh, 0, tid, g); scan_write(lds, tid, g);
    __syncthreads();
    for (int c = 0; c < TP / 64; ++c) {
        PG8_LAS unsigned char* buf = lds + (c & 1) * SC_BUF;
        if (c + 1 < TP / 64) scan_issue(ws, b, hd, vh, c + 1, tid, g);
#pragma unroll 4
        for (int tt = 0; tt < 64; ++tt) {
            const f32x4 w = *(const PG8_LAS f32x4*)(buf + tt * 256 + kq * 16);
            const u32x2 knw = *(const PG8_LAS u32x2*)(buf + 16384 + tt * 128 + kq * 8), kaw = *(const PG8_LAS u32x2*)(buf + 24576 + tt * 128 + kq * 8),
                        kpw = *(const PG8_LAS u32x2*)(buf + 32768 + tt * 128 + kq * 8), rw = *(const PG8_LAS u32x2*)(buf + 40960 + tt * 128 + kq * 8);
            const float vv = bf2f(*(const PG8_LAS bf16_t*)(buf + 49152 + tt * 64 + vl * 2));
            const float kn[4] = {__uint_as_float(knw.x << 16), __uint_as_float(knw.x & 0xffff0000u), __uint_as_float(knw.y << 16), __uint_as_float(knw.y & 0xffff0000u)};
            const float ka[4] = {__uint_as_float(kaw.x << 16), __uint_as_float(kaw.x & 0xffff0000u), __uint_as_float(kaw.y << 16), __uint_as_float(kaw.y & 0xffff0000u)};
            const float kp[4] = {__uint_as_float(kpw.x << 16), __uint_as_float(kpw.x & 0xffff0000u), __uint_as_float(kpw.y << 16), __uint_as_float(kpw.y & 0xffff0000u)};
            const float rr[4] = {__uint_as_float(rw.x << 16), __uint_as_float(rw.x & 0xffff0000u), __uint_as_float(rw.y << 16), __uint_as_float(rw.y & 0xffff0000u)};
            float sa = S[0] * kn[0];
            sa = fmaf(S[1], kn[1], sa); sa = fmaf(S[2], kn[2], sa); sa = fmaf(S[3], kn[3], sa);
            sa = dpp_red16(sa);
            float y = 0.f;
#pragma unroll
            for (int i = 0; i < 4; ++i) { S[i] = fmaf(S[i], w[i], fmaf(vv, kp[i], -sa * ka[i])); y = fmaf(S[i], rr[i], y); }
            y = dpp_red16(y);
            if (kq == 0) YS[tt * 32 + vl] = y;
        }
        if (c + 1 < TP / 64) scan_write(lds + ((c + 1) & 1) * SC_BUF, tid, g);
        __syncthreads();
        {
            float* Y = (float*)(ws + NB_Y);
            for (int i = tid; i < 64 * 32; i += NTH) { const int tt = i >> 5, v = i & 31; Y[((size_t)b * TP + c * 64 + tt) * 1024 + hd * 64 + vh * 32 + v] = YS[i]; }
        }
        __syncthreads();
    }
    float* so = a.out + O_WKVP + ((size_t)(b * 16 + hd) * 64 + vh * 32 + vl) * 64 + kq * 4;
    *(float4*)so = make_float4(S[0], S[1], S[2], S[3]);
}
__device__ __forceinline__ void scan_sample(const Args& a, unsigned char* ws, int s, int hd, int lane) {
    const size_t row = (size_t)MP + s;
    const float* s0 = a.in[I_SWKV] + ((size_t)(s * 16 + hd) * 64 + lane) * 64;
    float* sout = a.out + O_WKVS + ((size_t)(s * 16 + hd) * 64 + lane) * 64;
    const float* dec = (const float*)(ws + NB_DEC) + row * 1024 + hd * 64;
    const bf16_t* kn = (const bf16_t*)(ws + NB_KKN) + row * 1024 + hd * 64; const bf16_t* ka = (const bf16_t*)(ws + NB_KKA) + row * 1024 + hd * 64;
    const bf16_t* kp = (const bf16_t*)(ws + NB_KP) + row * 1024 + hd * 64;
    const bf16_t* rp = (const bf16_t*)(ws + NB_RKVZ) + ((size_t)0 * XSH_ROWS + row) * 1024 + hd * 64;
    const float vv = bf2f(((const bf16_t*)(ws + NB_RKVZ) + ((size_t)2 * XSH_ROWS + row) * 1024 + hd * 64)[lane]);
    float sa = 0.f;
#pragma unroll 8
    for (int k = 0; k < 64; ++k) sa = fmaf(s0[k], bf2f(kn[k]), sa);
    float y = 0.f;
#pragma unroll 8
    for (int k = 0; k < 64; ++k) { const float sn = fmaf(s0[k], dec[k], fmaf(vv, bf2f(kp[k]), -sa * bf2f(ka[k]))); sout[k] = sn; y = fmaf(sn, bf2f(rp[k]), y); }
    {
        const float mean = wave_sum(y) * (1.f / 64.f);
        const float d = y - mean;
        const float rs = rsqrtf(wave_sum(d * d) * (1.f / 64.f) + GN_EPS);
        const int e = hd * 64 + lane;
        const float rkv = ((const float*)(ws + NB_RKS))[row * 16 + hd];
        const float zf = bf2f(((const bf16_t*)(ws + NB_RKVZ) + ((size_t)3 * XSH_ROWS + row) * 1024)[e]);
        const float o = fmaf(rkv, vv, d * rs * a.in[I_GNG][e] + a.in[I_GNB][e]) * silu_f(zf);
        ((bf16_t*)(ws + NB_G4B))[row * 1024 + e] = (bf16_t)(pk_bf16c(o, 0.f) & 0xffffu);
    }
}

constexpr int CS_LD = 72;
constexpr int CS_SLOT = 64 * CS_LD * 2;
constexpr int CS_F32A = 13 * CS_SLOT;
constexpr int CS_F32B = CS_F32A + 16384;
constexpr int CS_GS = CS_F32B + 16384;
constexpr int CS_END = CS_GS + 4096;
constexpr size_t CK_MCT = 0, CK_RY = 8192, CK_SADD = 16384, CK_Y0 = 24576, CK_BYTES = 32768;

__device__ __forceinline__ PG8_LAS bf16_t* cs_slot(PG8_LAS unsigned char* lds, int i) { return (PG8_LAS bf16_t*)(lds + i * CS_SLOT); }
__device__ __forceinline__ void cs_mm(f32x16& acc, const PG8_LAS bf16_t* X, const PG8_LAS bf16_t* Yt, int mt, int nt, int lane) {
    const int lr = lane & 31, h = lane >> 5;
#pragma unroll
    for (int s = 0; s < 4; ++s) {
        const bf16x8 av = *(const PG8_LAS bf16x8*)(X + (mt * 32 + lr) * CS_LD + s * 16 + h * 8);
        const bf16x8 bv = *(const PG8_LAS bf16x8*)(Yt + (nt * 32 + lr) * CS_LD + s * 16 + h * 8);
        acc = __builtin_amdgcn_mfma_f32_32x32x16_bf16(av, bv, acc, 0, 0, 0);
    }
}
__device__ __forceinline__ void cs_store_t(const f32x16& acc, PG8_LAS bf16_t* D, int mt, int nt, int lane) {
    typedef unsigned u32x2 __attribute__((ext_vector_type(2)));
    const int lr = lane & 31, h = lane >> 5;
#pragma unroll
    for (int c = 0; c < 4; ++c) { u32x2 w; w.x = pk_bf16c(acc[4 * c], acc[4 * c + 1]); w.y = pk_bf16c(acc[4 * c + 2], acc[4 * c + 3]);
        *(PG8_LAS u32x2*)(D + (nt * 32 + lr) * CS_LD + mt * 32 + 8 * c + 4 * h) = w; }
}
__device__ __forceinline__ void cs_store_n(const f32x16& acc, PG8_LAS bf16_t* D, int mt, int nt, int lane) {
    const int lr = lane & 31, h = lane >> 5;
#pragma unroll
    for (int i = 0; i < 16; ++i) D[(mt * 32 + (i & 3) + 8 * (i >> 2) + 4 * h) * CS_LD + nt * 32 + lr] = (bf16_t)(pk_bf16c(acc[i], 0.f) & 0xffffu);
}
__device__ __forceinline__ void cs_zero(f32x16& a) {
#pragma unroll
    for (int i = 0; i < 16; ++i) a[i] = 0.f;
}
__device__ __forceinline__ float dpp_red8(float v) {
    v += __builtin_bit_cast(float, __builtin_amdgcn_update_dpp(0, __builtin_bit_cast(int, v), 0xB1, 0xF, 0xF, true));
    v += __builtin_bit_cast(float, __builtin_amdgcn_update_dpp(0, __builtin_bit_cast(int, v), 0x4E, 0xF, 0xF, true));
    v += __builtin_bit_cast(float, __builtin_amdgcn_update_dpp(0, __builtin_bit_cast(int, v), 0x141, 0xF, 0xF, true));
    return v;
}

struct PreRegs { u32x4 kv, rv, vv; bf16x8 af[4]; };
__device__ __forceinline__ void scanpre_load(unsigned char* ws, int b, int hd, int c, int tid, PreRegs& r) {
    const int lane = tid & 63, wv = tid >> 6, lr = lane & 31, h = lane >> 5;
    const size_t row0 = (size_t)b * TP + c * 64;
    const int tok = tid >> 3, c8 = tid & 7;
    const size_t off = (row0 + tok) * 1024 + hd * 64 + c8 * 8;
    const bf16_t* RK = (const bf16_t*)(ws + NB_RKVZ);
    r.kv = *(const u32x4*)(RK + (size_t)1 * XSH_ROWS * 1024 + off); r.rv = *(const u32x4*)(RK + off); r.vv = *(const u32x4*)(RK + (size_t)2 * XSH_ROWS * 1024 + off);
    const int which = wv >> 2, mt = (wv >> 1) & 1;
    const bf16_t* A = (const bf16_t*)(ws + (which ? NB_AWB : NB_TWB)) + (row0 + mt * 32 + lr) * 64 + h * 8;
#pragma unroll
    for (int s = 0; s < 4; ++s) r.af[s] = *(const bf16x8*)(A + s * 16);
}
__device__ __forceinline__ void scanpre_chunk(const Args& a, unsigned char* ws, PG8_LAS unsigned char* lds, int b, int hd, int c, const PreRegs& pre, const bf16x8 (&btf)[4]) {
    const int tid = opaque_v(threadIdx.x), lane = tid & 63, wv = __builtin_amdgcn_readfirstlane(tid >> 6);
    const int lr = lane & 31, h = lane >> 5;
    const size_t row0 = (size_t)b * TP + c * 64;
    typedef unsigned u32x2 __attribute__((ext_vector_type(2)));
    PG8_LAS float* LCUM = (PG8_LAS float*)(lds + CS_F32A);
    PG8_LAS float* AV = (PG8_LAS float*)(lds + CS_F32B);
    PG8_LAS float* GS = (PG8_LAS float*)(lds + CS_GS);
    unsigned char* rec = ws + NB_CHK + ((size_t)(b * 16 + hd) * 32 + c) * CK_BYTES;
    {
        const int tok = tid >> 3, c8 = tid & 7;
        *(PG8_LAS u32x4*)(cs_slot(lds, 0) + tok * CS_LD + c8 * 8) = pre.kv;
        *(PG8_LAS u32x4*)(cs_slot(lds, 1) + tok * CS_LD + c8 * 8) = pre.rv;
        *(PG8_LAS u32x4*)(cs_slot(lds, 2) + tok * CS_LD + c8 * 8) = pre.vv;
    }
    {
        const int which = wv >> 2, mt = (wv >> 1) & 1, nt = wv & 1;
        f32x16 acc; cs_zero(acc);
#pragma unroll
        for (int s = 0; s < 4; ++s) acc = __builtin_amdgcn_mfma_f32_32x32x16_bf16(pre.af[s], btf[s], acc, 0, 0, 0);
        PG8_LAS float* D = which ? AV : LCUM;
        const float bias = a.in[which ? I_A0 : I_W0][hd * 64 + nt * 32 + lr];
#pragma unroll
        for (int i = 0; i < 16; ++i) {
            const float x = acc[i] + bias;
            float y;
            if (which) y = sigm_f(x);
            else { const float sp = fmaxf(-x, 0.f) + __logf(1.f + __expf(-fabsf(x))); y = -__expf(-sp - 0.5f); }
            D[(mt * 32 + (i & 3) + 8 * (i >> 2) + 4 * h) * 64 + nt * 32 + lr] = y;
        }
    }
    lds_barrier();
    {
        const int ch = tid & 63, tg = tid >> 6;
        float p[8]; float run = 0.f;
#pragma unroll
        for (int i = 0; i < 8; ++i) { run += LCUM[(tg * 8 + i) * 64 + ch]; p[i] = run; }
        GS[tg * 64 + ch] = run;
        lds_barrier();
        float offs = 0.f;
        for (int g = 0; g < tg; ++g) offs += GS[g * 64 + ch];
#pragma unroll
        for (int i = 0; i < 8; ++i) LCUM[(tg * 8 + i) * 64 + ch] = p[i] + offs;
    }
    lds_barrier();
    {
        const int tok = tid >> 3, c8 = tid & 7;
        const u32x4 kw = *(const PG8_LAS u32x4*)(cs_slot(lds, 0) + tok * CS_LD + c8 * 8), rw = *(const PG8_LAS u32x4*)(cs_slot(lds, 1) + tok * CS_LD + c8 * 8),
                    vw = *(const PG8_LAS u32x4*)(cs_slot(lds, 2) + tok * CS_LD + c8 * 8);
        float kf[8], rf[8], kk[8], kp[8], av[8];
        float n2 = 0.f, rk = 0.f;
#pragma unroll
        for (int i = 0; i < 8; ++i) {
            const int e = hd * 64 + c8 * 8 + i;
            kf[i] = __uint_as_float((i & 1) ? (kw[i >> 1] & 0xffff0000u) : (kw[i >> 1] << 16));
            rf[i] = __uint_as_float((i & 1) ? (rw[i >> 1] & 0xffff0000u) : (rw[i >> 1] << 16));
            av[i] = AV[tok * 64 + c8 * 8 + i];
            kk[i] = kf[i] * a.in[I_KK][e];
            kp[i] = kf[i] * (1.f + (av[i] - 1.f) * a.in[I_KA][e]);
            n2 = fmaf(kk[i], kk[i], n2);
            rk = fmaf(rf[i] * kp[i], a.in[I_RK][e], rk);
        }
        n2 = dpp_red8(n2); rk = dpp_red8(rk);
        const float inv = 1.f / fmaxf(sqrtf(n2), 1e-12f);
        if (c8 == 0) ((float*)(ws + NB_RKS))[(row0 + tok) * 16 + hd] = rk;
        if (tok == 63) {
#pragma unroll
            for (int i = 0; i < 8; ++i) GS[512 + c8 * 8 + i] = __expf(LCUM[63 * 64 + c8 * 8 + i]);
        }
        float qt[8], rt[8], kt[8], bt[8], kh[8], bh[8];
#pragma unroll
        for (int i = 0; i < 8; ++i) {
            const int ch = c8 * 8 + i;
            const float Lt = LCUM[tok * 64 + ch], Lp = tok ? LCUM[(tok - 1) * 64 + ch] : 0.f, Lc = LCUM[63 * 64 + ch];
            const float kn = kk[i] * inv, ka = kn * av[i];
            const float en = __expf(-Lt), ec = __expf(Lc - Lt);
            qt[i] = kn * __expf(Lp); rt[i] = rf[i] * __expf(Lt); kt[i] = kp[i] * en; bt[i] = ka * en; kh[i] = kp[i] * ec; bh[i] = ka * ec;
        }
#define CS_PUT_ROW(SLOT, ARR) { u32x4 w_; w_.x = pk_bf16c(ARR[0], ARR[1]); w_.y = pk_bf16c(ARR[2], ARR[3]); w_.z = pk_bf16c(ARR[4], ARR[5]); w_.w = pk_bf16c(ARR[6], ARR[7]); \
            *(PG8_LAS u32x4*)(cs_slot(lds, SLOT) + tok * CS_LD + c8 * 8) = w_; }
#define CS_PUT_COL(SLOT, ARR) { _Pragma("unroll") for (int i_ = 0; i_ < 8; ++i_) cs_slot(lds, SLOT)[(c8 * 8 + i_) * CS_LD + tok] = (bf16_t)(pk_bf16c(ARR[i_], 0.f) & 0xffffu); }
        CS_PUT_ROW(3, qt) CS_PUT_ROW(4, rt) CS_PUT_ROW(5, kt) CS_PUT_ROW(6, bt)
        CS_PUT_COL(7, qt) CS_PUT_COL(8, bh) CS_PUT_COL(9, kh)
#pragma unroll
        for (int i = 0; i < 8; ++i) cs_slot(lds, 10)[(c8 * 8 + i) * CS_LD + tok] = (bf16_t)((i & 1) ? (vw[i >> 1] >> 16) : (vw[i >> 1] & 0xffffu));
#undef CS_PUT_ROW
#undef CS_PUT_COL
    }
    lds_barrier();
    {
#pragma unroll 1
        for (int j = 0; j < 2; ++j) {
            const int job = wv * 2 + j, prod = job >> 2, mt = (job >> 1) & 1, nt = job & 1;
            const PG8_LAS bf16_t* X = cs_slot(lds, (prod & 1) ? 6 : 5);
            const PG8_LAS bf16_t* Y = cs_slot(lds, (prod & 2) ? 4 : 3);
            f32x16 acc; cs_zero(acc);
            cs_mm(acc, X, Y, mt, nt, lane);
            const int t = nt * 32 + lr, incl = (prod & 2) ? 1 : 0;
#pragma unroll
            for (int i = 0; i < 16; ++i) { const int sidx = mt * 32 + (i & 3) + 8 * (i >> 2) + 4 * h; acc[i] = (sidx < t + incl) ? acc[i] : 0.f; }
            const int dst = (prod == 0) ? 0 : (prod == 1) ? 11 : (prod == 2) ? 1 : 2;
            cs_store_t(acc, cs_slot(lds, dst), mt, nt, lane);
            if (prod == 1) cs_store_n(acc, cs_slot(lds, 12), mt, nt, lane);
        }
    }
    lds_barrier();
    {
        const int mt = (wv >> 1) & 1, nt = wv & 1;
        f32x16 pacc;
        if (wv < 4) {
#pragma unroll
            for (int i = 0; i < 16; ++i) { const int u = mt * 32 + (i & 3) + 8 * (i >> 2) + 4 * h, t = nt * 32 + lr;
                pacc[i] = ((u == t) ? 1.f : 0.f) - bf2f(cs_slot(lds, 12)[u * CS_LD + t]); }
            cs_store_t(pacc, cs_slot(lds, 3), mt, nt, lane);
        }
        lds_barrier();
        const int mcur = 11, mtcur = 12, mnxt = 5, mtnxt = 6;
        PG8_LAS bf16_t* XS0 = (PG8_LAS bf16_t*)(lds + CS_F32A);
        PG8_LAS bf16_t* XS1 = (PG8_LAS bf16_t*)(lds + CS_F32A + CS_SLOT);
        PG8_LAS bf16_t* XS2 = (PG8_LAS bf16_t*)(lds + CS_F32A + 2 * CS_SLOT);
        PG8_LAS bf16_t* Pc = cs_slot(lds, 3); PG8_LAS bf16_t* Pn = XS0;
        PG8_LAS bf16_t* Mc_ = cs_slot(lds, mcur); PG8_LAS bf16_t* MTc = cs_slot(lds, mtcur);
        PG8_LAS bf16_t* Mn = cs_slot(lds, mnxt); PG8_LAS bf16_t* MTn = cs_slot(lds, mtnxt);
#pragma unroll 1
        for (int it = 0; it < 5; ++it) {
            if (wv >= 4) {
                f32x16 acc; cs_zero(acc);
                cs_mm(acc, Mc_, MTc, mt, nt, lane);
                cs_store_n(acc, Mn, mt, nt, lane);
                cs_store_t(acc, MTn, mt, nt, lane);
                float mx = 0.f;
#pragma unroll
                for (int i = 0; i < 16; ++i) mx = fmaxf(mx, fabsf(acc[i]));
#pragma unroll
                for (int o = 32; o > 0; o >>= 1) mx = fmaxf(mx, __shfl_xor(mx, o));
                if (lane == 0) GS[640 + (wv & 3)] = mx;
            }
            lds_barrier();
            const float m2max = fmaxf(fmaxf(GS[640], GS[641]), fmaxf(GS[642], GS[643]));
            if (wv < 4) {
                cs_mm(pacc, MTn, Pc, mt, nt, lane);
                cs_store_t(pacc, Pn, mt, nt, lane);
            }
            lds_barrier();
            { PG8_LAS bf16_t* t0 = Mc_; Mc_ = Mn; Mn = t0; t0 = MTc; MTc = MTn; MTn = t0; t0 = Pc; Pc = Pn; Pn = t0; }
            if (m2max < 1e-7f) break;
        }
        {
            f32x16 acc; cs_zero(acc);
            if (wv < 4) { cs_mm(acc, cs_slot(lds, 0), cs_slot(lds, 10), mt, nt, lane); cs_store_t(acc, XS1, mt, nt, lane); }
            else { cs_mm(acc, Pc, cs_slot(lds, 7), mt, nt, lane); cs_store_t(acc, XS2, mt, nt, lane); }
        }
        lds_barrier();
        if (wv < 4) { f32x16 acc; cs_zero(acc); cs_mm(acc, Pc, XS1, mt, nt, lane); cs_store_t(acc, cs_slot(lds, 11), mt, nt, lane); }
        lds_barrier();
        if (wv < 4) {
            f32x16 acc; cs_zero(acc);
            cs_mm(acc, XS2, cs_slot(lds, 8), mt, nt, lane);
#pragma unroll
            for (int i = 0; i < 16; ++i) { const int k = mt * 32 + (i & 3) + 8 * (i >> 2) + 4 * h, kp_ = nt * 32 + lr; acc[i] = ((k == kp_) ? GS[512 + k] : 0.f) - acc[i]; }
            bf16_t* mct = (bf16_t*)(rec + CK_MCT);
#pragma unroll
            for (int cc = 0; cc < 4; ++cc) { u32x2 w; w.x = pk_bf16c(acc[4 * cc], acc[4 * cc + 1]); w.y = pk_bf16c(acc[4 * cc + 2], acc[4 * cc + 3]);
                *(u32x2*)(mct + (nt * 32 + lr) * 64 + mt * 32 + 8 * cc + 4 * h) = w; }
            f32x16 s1, s2; cs_zero(s1); cs_zero(s2);
            cs_mm(s1, cs_slot(lds, 9), cs_slot(lds, 10), mt, nt, lane);
            cs_mm(s2, cs_slot(lds, 8), cs_slot(lds, 11), mt, nt, lane);
            bf16_t* sd = (bf16_t*)(rec + CK_SADD) + ((size_t)(wv & 3) * 64 + lane) * 16;
#pragma unroll
            for (int q8 = 0; q8 < 2; ++q8) { u32x4 w;
                w.x = pk_bf16c(s1[8 * q8] - s2[8 * q8], s1[8 * q8 + 1] - s2[8 * q8 + 1]); w.y = pk_bf16c(s1[8 * q8 + 2] - s2[8 * q8 + 2], s1[8 * q8 + 3] - s2[8 * q8 + 3]);
                w.z = pk_bf16c(s1[8 * q8 + 4] - s2[8 * q8 + 4], s1[8 * q8 + 5] - s2[8 * q8 + 5]); w.w = pk_bf16c(s1[8 * q8 + 6] - s2[8 * q8 + 6], s1[8 * q8 + 7] - s2[8 * q8 + 7]);
                *(u32x4*)(sd + q8 * 8) = w; }
        } else {
            f32x16 acc; cs_zero(acc);
            cs_mm(acc, XS2, cs_slot(lds, 2), mt, nt, lane);
            bf16_t* ry = (bf16_t*)(rec + CK_RY);
#pragma unroll
            for (int cc = 0; cc < 4; ++cc) {
                const u32x2 rv = *(const PG8_LAS u32x2*)(cs_slot(lds, 4) + (nt * 32 + lr) * CS_LD + mt * 32 + 8 * cc + 4 * h);
                const float r0 = __uint_as_float(rv.x << 16), r1 = __uint_as_float(rv.x & 0xffff0000u), r2 = __uint_as_float(rv.y << 16), r3 = __uint_as_float(rv.y & 0xffff0000u);
                u32x2 w; w.x = pk_bf16c(r0 - acc[4 * cc], r1 - acc[4 * cc + 1]); w.y = pk_bf16c(r2 - acc[4 * cc + 2], r3 - acc[4 * cc + 3]);
                *(u32x2*)(ry + (nt * 32 + lr) * 64 + mt * 32 + 8 * cc + 4 * h) = w;
            }
            f32x16 s1, s2; cs_zero(s1); cs_zero(s2);
            cs_mm(s1, cs_slot(lds, 1), cs_slot(lds, 10), mt, nt, lane);
            cs_mm(s2, cs_slot(lds, 2), cs_slot(lds, 11), mt, nt, lane);
            bf16_t* yd = (bf16_t*)(rec + CK_Y0) + ((size_t)(wv & 3) * 64 + lane) * 16;
#pragma unroll
            for (int q8 = 0; q8 < 2; ++q8) { u32x4 w;
                w.x = pk_bf16c(s1[8 * q8] - s2[8 * q8], s1[8 * q8 + 1] - s2[8 * q8 + 1]); w.y = pk_bf16c(s1[8 * q8 + 2] - s2[8 * q8 + 2], s1[8 * q8 + 3] - s2[8 * q8 + 3]);
                w.z = pk_bf16c(s1[8 * q8 + 4] - s2[8 * q8 + 4], s1[8 * q8 + 5] - s2[8 * q8 + 5]); w.w = pk_bf16c(s1[8 * q8 + 6] - s2[8 * q8 + 6], s1[8 * q8 + 7] - s2[8 * q8 + 7]);
                *(u32x4*)(yd + q8 * 8) = w; }
        }
    }
    lds_barrier();
}

struct SeqRegs { bf16x8 a[4]; u32x4 c[2]; };
__device__ __forceinline__ void seq_load(const unsigned char* rec, bool isS, int wv, int mt, int lane, SeqRegs& r) {
    const int lr = lane & 31, h = lane >> 5;
    const bf16_t* ap = (const bf16_t*)(rec + (isS ? CK_MCT : CK_RY)) + (mt * 32 + lr) * 64 + h * 8;
    const bf16_t* cp = (const bf16_t*)(rec + (isS ? CK_SADD : CK_Y0)) + ((size_t)(wv & 3) * 64 + lane) * 16;
#pragma unroll
    for (int s = 0; s < 4; ++s) r.a[s] = *(const bf16x8*)(ap + s * 16);
    r.c[0] = *(const u32x4*)cp; r.c[1] = *(const u32x4*)(cp + 8);
}
__device__ __forceinline__ void scanseq_head(const Args& a, unsigned char* ws, PG8_LAS unsigned char* lds, int b, int hd) {
    const int tid = opaque_v(threadIdx.x), lane = tid & 63, wv = __builtin_amdgcn_readfirstlane(tid >> 6);
    const int lr = lane & 31, h = lane >> 5;
    const int mt = (wv >> 1) & 1, nt = wv & 1;
    const bool isS = wv < 4;
    PG8_LAS bf16_t* SB0 = cs_slot(lds, 0); PG8_LAS bf16_t* SB1 = cs_slot(lds, 1);
    f32x16 st; cs_zero(st);
    for (int i = tid; i < 64 * CS_LD; i += NTH) { SB0[i] = 0; }
    const unsigned char* rec0 = ws + NB_CHK + (size_t)(b * 16 + hd) * 32 * CK_BYTES;
    SeqRegs cur, nxt;
    seq_load(rec0, isS, wv, mt, lane, nxt);
    PG8_LAS float* YT = (PG8_LAS float*)(lds + 2 * CS_SLOT);
    const int ptok = tid >> 3, pv8 = (tid & 7) * 8;
    float gg[8], gb[8];
#pragma unroll
    for (int q = 0; q < 2; ++q) { const float4 g4 = *(const float4*)(a.in[I_GNG] + hd * 64 + pv8 + q * 4), b4 = *(const float4*)(a.in[I_GNB] + hd * 64 + pv8 + q * 4);
        gg[4 * q] = g4.x; gg[4 * q + 1] = g4.y; gg[4 * q + 2] = g4.z; gg[4 * q + 3] = g4.w; gb[4 * q] = b4.x; gb[4 * q + 1] = b4.y; gb[4 * q + 2] = b4.z; gb[4 * q + 3] = b4.w; }
    lds_barrier();
#pragma unroll 1
    for (int c = 0; c < 32; ++c) {
        cur = nxt;
        if (c + 1 < 32) seq_load(rec0 + (size_t)(c + 1) * CK_BYTES, isS, wv, mt, lane, nxt);
        const size_t prow = (size_t)b * TP + c * 64 + ptok;
        const u32x4 vw = *(const u32x4*)((const bf16_t*)(ws + NB_RKVZ) + ((size_t)2 * XSH_ROWS + prow) * 1024 + hd * 64 + pv8);
        const u32x4 zw = *(const u32x4*)((const bf16_t*)(ws + NB_RKVZ) + ((size_t)3 * XSH_ROWS + prow) * 1024 + hd * 64 + pv8);
        const float rkv = ((const float*)(ws + NB_RKS))[prow * 16 + hd];
        const PG8_LAS bf16_t* S = (c & 1) ? SB1 : SB0;
        PG8_LAS bf16_t* Sn = (c & 1) ? SB0 : SB1;
        PG8_LAS float* Yb = YT + (c & 1) * (64 * 68);
        f32x16 acc;
#pragma unroll
        for (int i = 0; i < 16; ++i) { const unsigned w = cur.c[i >> 3][(i & 7) >> 1]; acc[i] = __uint_as_float((i & 1) ? (w & 0xffff0000u) : (w << 16)); }
#pragma unroll
        for (int s = 0; s < 4; ++s) {
            const bf16x8 bv = *(const PG8_LAS bf16x8*)(S + (nt * 32 + lr) * CS_LD + s * 16 + h * 8);
            acc = __builtin_amdgcn_mfma_f32_32x32x16_bf16(cur.a[s], bv, acc, 0, 0, 0);
        }
        if (isS) { st = acc; cs_store_t(st, Sn, mt, nt, lane); }
        else {
#pragma unroll
            for (int i = 0; i < 16; ++i) Yb[(mt * 32 + (i & 3) + 8 * (i >> 2) + 4 * h) * 68 + nt * 32 + lr] = acc[i];
        }
        lds_barrier();
        {
            float y[8];
            const f32x4 y0 = *(const PG8_LAS f32x4*)(Yb + ptok * 68 + pv8), y1 = *(const PG8_LAS f32x4*)(Yb + ptok * 68 + pv8 + 4);
            y[0] = y0[0]; y[1] = y0[1]; y[2] = y0[2]; y[3] = y0[3]; y[4] = y1[0]; y[5] = y1[1]; y[6] = y1[2]; y[7] = y1[3];
            float sm = 0.f;
#pragma unroll
            for (int i = 0; i < 8; ++i) sm += y[i];
            const float mean = dpp_red8(sm) * (1.f / 64.f);
            float sq = 0.f;
#pragma unroll
            for (int i = 0; i < 8; ++i) { y[i] -= mean; sq += y[i] * y[i]; }
            const float rs = rsqrtf(dpp_red8(sq) * (1.f / 64.f) + GN_EPS);
            float o[8];
#pragma unroll
            for (int i = 0; i < 8; ++i) {
                const float vf = __uint_as_float((i & 1) ? (vw[i >> 1] & 0xffff0000u) : (vw[i >> 1] << 16)), zf = __uint_as_float((i & 1) ? (zw[i >> 1] & 0xffff0000u) : (zw[i >> 1] << 16));
                o[i] = fmaf(rkv, vf, y[i] * rs * gg[i] + gb[i]) * silu_f(zf);
            }
            u32x4 w; w.x = pk_bf16c(o[0], o[1]); w.y = pk_bf16c(o[2], o[3]); w.z = pk_bf16c(o[4], o[5]); w.w = pk_bf16c(o[6], o[7]);
            *(u32x4*)((bf16_t*)(ws + NB_G4B) + prow * 1024 + hd * 64 + pv8) = w;
        }
    }
    if (isS) {
        float* so = a.out + O_WKVP + ((size_t)(b * 16 + hd) * 64 + nt * 32 + lr) * 64 + mt * 32 + 4 * h;
#pragma unroll
        for (int cc = 0; cc < 4; ++cc) *(float4*)(so + 8 * cc) = make_float4(st[4 * cc], st[4 * cc + 1], st[4 * cc + 2], st[4 * cc + 3]);
    }
    lds_barrier();
}

__device__ __forceinline__ void phase_lnf(const Args& a, unsigned char* ws, int bid, int nb) {
    const int tid = opaque_v(threadIdx.x), lane = tid & 63, wv = tid >> 6;
    const float* PRE = (const float*)ws + WS_PRE;
    const float* P2 = (const float*)(ws + NB_Y);
    float x[16], nx[16], y[16], ny[16];
    int row = bid * 8 + wv;
    if (row < MT) { ld_row16(PRE + (size_t)row * 1024, lane, nx); ld_row16(P2 + (size_t)row * 1024, lane, ny); }
#pragma unroll 1
    while (row < MT) {
#pragma unroll
        for (int i = 0; i < 16; ++i) { x[i] = nx[i]; y[i] = ny[i]; }
        const int nrow = row + nb * 8;
        if (nrow < MT) { ld_row16(PRE + (size_t)nrow * 1024, lane, nx); ld_row16(P2 + (size_t)nrow * 1024, lane, ny); }
        ln_calc16(a.in[I_LNG], a.in[I_LNB], lane, x);
#pragma unroll
        for (int i = 0; i < 16; ++i) x[i] = fmaf(ALPHA, x[i], y[i]);
        ln_calc16(a.in[I_LNG] + 1024, a.in[I_LNB] + 1024, lane, x);
#if PROBE_TIME >= 0
        if (row >= MP) {
            const unsigned long long* tsp = (const unsigned long long*)(ws + NB_BAR + 16384);
            const float dt_us = (float)(__hip_atomic_load(tsp + PROBE_TIME + 1, __ATOMIC_RELAXED, __HIP_MEMORY_SCOPE_AGENT) - __hip_atomic_load(tsp + PROBE_TIME, __ATOMIC_RELAXED, __HIP_MEMORY_SCOPE_AGENT)) * 0.01f;
            const float f = 1.f + PROBE_K * dt_us;
#pragma unroll
            for (int i = 0; i < 16; ++i) x[i] *= f;
        }
#endif
        float* o = (row < MP ? a.out + O_Y + (size_t)row * 1024 : a.out + O_YS + (size_t)(row - MP) * 1024) + lane * 4;
#pragma unroll
        for (int q = 0; q < 4; ++q) *(float4*)(o + q * 256) = make_float4(x[4 * q], x[4 * q + 1], x[4 * q + 2], x[4 * q + 3]);
        row = nrow;
    }
}
__device__ __forceinline__ void sample_pool_copy(const Args& a, unsigned char* ws, int bid, int nb) {
    float* KCS = (float*)(ws + NB_KCS);
    const int* pt = (const int*)a.in[I_PT];
    const float* ccmp = a.in[I_CCMP];
#pragma unroll 2
    for (int i = bid * NTH + threadIdx.x; i < BS * 256 * 256; i += nb * NTH) {
        const int c = i & 255, n = (i >> 8) & 255, s = i >> 16;
        const int kv = c >> 7, g = (c >> 6) & 1;
        const float* w = kv ? a.in[I_WVC] : a.in[I_WKC];
        const int pos0 = n * 32;
        const float* src = ccmp + ((size_t)pt[s * NPAGE + (pos0 >> 7)] * PAGE + (pos0 & 127)) * 256 + c;
        float acc = 0.f;
#pragma unroll
        for (int l = 0; l < 32; ++l) acc = fmaf(src[(size_t)l * 256], w[l * 2 + g], acc);
        KCS[i] = acc;
    }
    const float4* cw = (const float4*)a.in[I_CWIN];
    float4* ow = (float4*)(a.out + O_WINS);
#pragma unroll 4
    for (int i = bid * NTH + threadIdx.x; i < BS * 511 * 64; i += nb * NTH) {
        const int s = i / (511 * 64), rem = i - s * (511 * 64);
        ow[(size_t)s * 512 * 64 + rem] = cw[(size_t)s * 512 * 64 + 64 + rem];
    }
}
__device__ __forceinline__ void sample_conv(const Args& a, unsigned char* ws, PG8_LAS unsigned char* lds, int s) {
    const int ch = opaque_v(threadIdx.x);
    const bf16_t* h = (const bf16_t*)(ws + NB_HB) + (size_t)(MP + s) * 2560;
    const float* sc = a.in[I_SCONV] + (size_t)s * 30 * 512 + ch;
    const float u = bf2f(h[ch]) * sigm_f(bf2f(h[512 + ch]));
    float scv[30], wj[31];
    const float* __restrict__ cwp = a.in[I_CONVW] + ch;
#pragma unroll
    for (int j = 0; j < 30; ++j) { scv[j] = sc[(size_t)j * 512]; wj[j] = cwp[j * 512]; }
    wj[30] = cwp[30 * 512];
    float acc = a.in[I_CONVB][ch];
#pragma unroll
    for (int j = 0; j < 30; ++j) acc = fmaf(wj[j], scv[j], acc);
    acc = fmaf(wj[30], u, acc);
    float* __restrict__ oc = a.out + O_CONVS + (size_t)s * 30 * 512 + ch;
#pragma unroll
    for (int i = 0; i < 29; ++i) oc[(size_t)i * 512] = scv[i + 1];
    oc[(size_t)29 * 512] = u;
    PG8_LAS float* red = (PG8_LAS float*)lds;
    const int lane = ch & 63, wv = ch >> 6;
    float sm = wave_sum(acc);
    __syncthreads();
    if (lane == 0) red[wv] = sm;
    __syncthreads();
    float tot = 0.f;
#pragma unroll
    for (int i = 0; i < 8; ++i) tot += red[i];
    const float mean = tot * (1.f / 512.f);
    const float d = acc - mean;
    float sq = wave_sum(d * d);
    __syncthreads();
    if (lane == 0) red[wv] = sq;
    __syncthreads();
    tot = 0.f;
#pragma unroll
    for (int i = 0; i < 8; ++i) tot += red[i];
    const float rs = rsqrtf(tot * (1.f / 512.f) + LN_EPS);
    const float y = silu_f(d * rs * a.in[I_CLNG][ch] + a.in[I_CLNB][ch]) * silu_f(bf2f(h[1024 + ch]));
    ((bf16_t*)(ws + NB_CATB))[(size_t)(MP + s) * 1024 + ch] = (bf16_t)(pk_bf16(y, 0.f) & 0xffffu);
    __syncthreads();
}

constexpr int SP_STRIDE = 66;
__device__ __forceinline__ void sample_attn(const Args& a, unsigned char* ws, PG8_LAS unsigned char* lds, int s, int g, int part) {
    const int tid = opaque_v(threadIdx.x), lane = tid & 63, wv = __builtin_amdgcn_readfirstlane(tid >> 6);
    PG8_LAS float* PC = (PG8_LAS float*)lds;
    PG8_LAS float* IMP = (PG8_LAS float*)(lds + 4096);
    PG8_LAS int* SEL = (PG8_LAS int*)(lds + 4096 + 1024);
    PG8_LAS int* FLG = (PG8_LAS int*)(lds + 4096 + 1024 + 128);
    PG8_LAS float* PS = (PG8_LAS float*)(lds + 8192) + (tid >> 6) * 64;
    const int r = wv & 3, hh = g * 4 + r;
    const float slope = __builtin_amdgcn_exp2f(-(float)(hh + 1));
    const int* pt = (const int*)a.in[I_PT] + s * NPAGE;
    const bf16_t* hrow = (const bf16_t*)(ws + NB_HB) + (size_t)(MP + s) * 2560;
    float q[64];
#pragma unroll
    for (int d8 = 0; d8 < 8; ++d8) { const u32x4 w = *(const u32x4*)(hrow + 1536 + hh * 64 + d8 * 8);
#pragma unroll
        for (int i = 0; i < 4; ++i) { q[d8 * 8 + 2 * i] = __uint_as_float(w[i] << 16); q[d8 * 8 + 2 * i + 1] = __uint_as_float(w[i] & 0xffff0000u); } }
#define SAMP_DOT(KPTR, OUT) { const float4* k4_ = (const float4*)(KPTR); float4 kk_[16]; \
        _Pragma("unroll") for (int i_ = 0; i_ < 16; ++i_) kk_[i_] = k4_[i_]; float s_ = 0.f; \
        _Pragma("unroll") for (int i_ = 0; i_ < 16; ++i_) { s_ = fmaf(q[4 * i_], kk_[i_].x, s_); s_ = fmaf(q[4 * i_ + 1], kk_[i_].y, s_); s_ = fmaf(q[4 * i_ + 2], kk_[i_].z, s_); s_ = fmaf(q[4 * i_ + 3], kk_[i_].w, s_); } OUT = s_; }
    if (wv < 4) {
        const float* kc = (const float*)(ws + NB_KCS) + (size_t)s * 256 * 256 + g * 64;
        float sc[4];
        float mx = -INFINITY;
#pragma unroll
        for (int i = 0; i < 4; ++i) { const int n = lane + 64 * i; float d; SAMP_DOT(kc + (size_t)n * 256, d); sc[i] = d - slope * (float)(PAST - (32 * n + 31)); mx = fmaxf(mx, sc[i]); }
#pragma unroll
        for (int o = 32; o > 0; o >>= 1) mx = fmaxf(mx, __shfl_xor(mx, o));
        float ls = 0.f;
#pragma unroll
        for (int i = 0; i < 4; ++i) { sc[i] = __expf(sc[i] - mx); ls += sc[i]; }
        ls = wave_sum(ls);
        const float inv = 1.f / ls;
#pragma unroll
        for (int i = 0; i < 4; ++i) PC[r * 256 + lane + 64 * i] = sc[i] * inv;
    }
    __syncthreads();
    if (wv < 4 && part == 0) {
        const float* vc = (const float*)(ws + NB_KCS) + (size_t)s * 256 * 256 + 128 + g * 64 + lane;
        float oc0 = 0.f, oc1 = 0.f, oc2 = 0.f, oc3 = 0.f;
#pragma unroll 8
        for (int n = 0; n < 256; n += 4) {
            oc0 = fmaf(PC[r * 256 + n], vc[(size_t)n * 256], oc0); oc1 = fmaf(PC[r * 256 + n + 1], vc[(size_t)(n + 1) * 256], oc1);
            oc2 = fmaf(PC[r * 256 + n + 2], vc[(size_t)(n + 2) * 256], oc2); oc3 = fmaf(PC[r * 256 + n + 3], vc[(size_t)(n + 3) * 256], oc3);
        }
        ((float*)(ws + NB_OCS))[(size_t)(s * 8 + hh) * 64 + lane] = (oc0 + oc1) + (oc2 + oc3);
    }
    if (tid < 129) {
        float v = 0.f;
        if (tid < 128) { for (int rr = 0; rr < 4; ++rr) v += PC[rr * 256 + 2 * tid] + PC[rr * 256 + 2 * tid + 1]; }
        if (tid == 0 || tid >= 127) v = 1e4f;
        IMP[tid] = v;
    }
    __syncthreads();
    if (tid < 129) {
        const float vj = IMP[tid];
        int rank = 0;
        for (int i = 0; i < 129; ++i) { const float vi = IMP[i]; rank += (vi > vj || (vi == vj && i < tid)) ? 1 : 0; }
        FLG[tid] = (rank < 16) ? 1 : 0;
    }
    __syncthreads();
    if (tid < 129 && FLG[tid]) { int slot = 0; for (int i = 0; i < tid; ++i) slot += FLG[i]; SEL[slot] = tid; }
    __syncthreads();
    const float* csel = a.in[I_CSEL];
    const float* newsel = a.out + O_SELS + (size_t)s * 256;
    const float* cwin = a.in[I_CWIN] + (size_t)s * 512 * 256;
    const float* newwin = a.out + O_WINS + (size_t)(s * 512 + 511) * 256;
#pragma unroll 1
    for (int it = 0; it < 3; ++it) {
        const int lb = (wv >> 2) + 2 * it;
        const bool is_sel = lb < 4;
        const int slot = is_sel ? part * 4 + lb : part * 2 + (lb - 4);
        const float* rowp; const float* vb; int vstride_last; float dist; bool valid; int nk;
        if (is_sel) {
            const int blk = SEL[slot];
            const int kpos = blk * 64 + lane;
            valid = kpos <= PAST;
            rowp = (blk < 128) ? csel + ((size_t)pt[blk >> 1] * PAGE + (kpos & 127)) * 256 : newsel;
            vb = (blk < 128) ? csel + ((size_t)pt[blk >> 1] * PAGE + ((blk * 64) & 127)) * 256 + 128 + g * 64 + lane : newsel + 128 + g * 64 + lane;
            nk = (blk < 128) ? 64 : 1; dist = (float)(PAST - kpos); vstride_last = 0;
        } else {
            const int i0 = 1 + slot * 64;
            const int i = i0 + lane;
            valid = true; nk = 64;
            rowp = (i < 512) ? cwin + (size_t)i * 256 : newwin;
            vb = cwin + (size_t)i0 * 256 + 128 + g * 64 + lane;
            dist = (float)(512 - i); vstride_last = (slot == 7) ? 1 : 0;
        }
        float sc = -INFINITY;
        if (valid) { float d; SAMP_DOT(rowp + g * 64, d); sc = d - slope * dist; }
        float mx = sc;
#pragma unroll
        for (int of = 32; of > 0; of >>= 1) mx = fmaxf(mx, __shfl_xor(mx, of));
        const float p = valid ? __expf(sc - mx) : 0.f;
        const float l = wave_sum(p);
        PS[lane] = p; __builtin_amdgcn_wave_barrier();
        float o0 = 0.f, o1 = 0.f, o2 = 0.f, o3 = 0.f;
        if (nk == 64) {
            float vv[64];
#pragma unroll
            for (int k = 0; k < 63; ++k) vv[k] = vb[(size_t)k * 256];
            vv[63] = vstride_last ? newwin[128 + g * 64 + lane] : vb[(size_t)63 * 256];
#pragma unroll
            for (int k = 0; k < 64; k += 4) { o0 = fmaf(PS[k], vv[k], o0); o1 = fmaf(PS[k + 1], vv[k + 1], o1); o2 = fmaf(PS[k + 2], vv[k + 2], o2); o3 = fmaf(PS[k + 3], vv[k + 3], o3); }
        } else o0 = PS[0] * vb[0];
        __builtin_amdgcn_wave_barrier();
        float* pp = (float*)(ws + NB_PARTS) + ((size_t)((s * 8 + hh) * 24 + (is_sel ? slot : 16 + slot))) * SP_STRIDE;
        pp[2 + lane] = (o0 + o1) + (o2 + o3);
        if (lane == 0) { pp[0] = mx; pp[1] = l; }
    }
#undef SAMP_DOT
    __syncthreads();
}
__device__ __forceinline__ void sample_combine(const Args& a, unsigned char* ws, int s, int g) {
    const int tid = opaque_v(threadIdx.x), lane = tid & 63, wv = __builtin_amdgcn_readfirstlane(tid >> 6);
    if (wv >= 4) return;
    const int hh = g * 4 + wv;
    const float* pp = (const float*)(ws + NB_PARTS) + (size_t)(s * 8 + hh) * 24 * SP_STRIDE;
    const float* g3p = (const float*)(ws + NB_G3) + (size_t)(MP + s) * 32 + hh * 3;
    const float gc = sigm_f(g3p[0]), gs = sigm_f(g3p[1]), gw = sigm_f(g3p[2]);
    float res = gc * ((const float*)(ws + NB_OCS))[(size_t)(s * 8 + hh) * 64 + lane];
#pragma unroll
    for (int br = 0; br < 2; ++br) {
        const int n0 = br ? 16 : 0, cnt = br ? 8 : 16;
        float M = -INFINITY;
        for (int i = 0; i < cnt; ++i) M = fmaxf(M, pp[(size_t)(n0 + i) * SP_STRIDE]);
        float L = 0.f, O = 0.f;
        for (int i = 0; i < cnt; ++i) { const float* q = pp + (size_t)(n0 + i) * SP_STRIDE; const float w = __expf(q[0] - M); L = fmaf(q[1], w, L); O = fmaf(q[2 + lane], w, O); }
        res = fmaf(br ? gw : gs, O / L, res);
    }
    const bf16_t* hrow = (const bf16_t*)(ws + NB_HB) + (size_t)(MP + s) * 2560;
    const float y = res * silu_f(bf2f(hrow[2048 + hh * 64 + lane]));
    ((bf16_t*)(ws + NB_CATB))[(size_t)(MP + s) * 1024 + 512 + hh * 64 + lane] = (bf16_t)(pk_bf16(y, 0.f) & 0xffffu);
}

static_assert(CS_END <= LDS_MISC, "chunk-scan LDS map overlaps the barrier words");
enum { PH_PREP = 0, PH_GEMM1, PH_CONV, PH_ATTN, PH_GEMM2, PH_LNS, PH_GEMM3, PH_PREP2, PH_SCAN, PH_POST, PH_GEMM4, PH_LNF, NPHASE };

__global__ void __launch_bounds__(NTH, 2) mega(Args a) {
    extern __shared__ __attribute__((aligned(16))) unsigned char lds_raw[];
    PG8_LAS unsigned char* lds = (PG8_LAS unsigned char*)lds_raw;
    unsigned char* ws = a.ws;
    volatile LAS unsigned* misc = (volatile LAS unsigned*)(lds + LDS_MISC);
    if (threadIdx.x < 4) misc[threadIdx.x] = 0u;
    __syncthreads();
    XcdBarrier bar = xcd_barrier_post((unsigned*)(ws + NB_BAR), misc);
    const int lo = a.ph_lo, hi = a.ph_hi;
#ifndef DUP_SATTN
#define DUP_SATTN 0
#endif
#ifndef DUP_CONV
#define DUP_CONV 0
#endif
#ifndef DUP_GEMM1
#define DUP_GEMM1 0
#endif
#ifndef SKIPMASK
#define SKIPMASK 0
#endif
#define IN(k) (lo <= (k) && (k) < hi && !((SKIPMASK >> (k)) & 1))
#ifndef REPMASK
#define REPMASK 0
#endif
#define REPS(k) _Pragma("unroll 1") for (int rep_ = 0; rep_ < (((REPMASK >> (k)) & 1) ? 2 : 1); ++rep_)
#if PROBE_TIME >= 0
    unsigned long long* const tstamp = (unsigned long long*)(ws + NB_BAR + 16384);
#define STAMP(i) do { if (blockIdx.x == 0 && threadIdx.x == 0) __hip_atomic_store(tstamp + (i), (unsigned long long)__builtin_amdgcn_s_memrealtime(), __ATOMIC_RELAXED, __HIP_MEMORY_SCOPE_AGENT); } while (0)
#else
#define STAMP(i) do { } while (0)
#endif
#define SEAM(k) do { if (IN(k) && IN((k) + 1)) xcd_barrier(bar); STAMP((k) + 1); } while (0)
    STAMP(0);
    if (IN(PH_PREP)) REPS(PH_PREP) {
        const int bid = opaque(blockIdx.x), nb = gridDim.x;
        convert_wt(a.in[I_WIN], 1024, DIN, (bf16_t*)(ws + NB_WT1), N1PAD, MapWin{}, bid, nb);
        convert_wt(a.in[I_WOUTE], 1024, 1024, (bf16_t*)(ws + NB_WT2), 1024, MapId{}, bid, nb);
        for (int n = 0; n < 4; ++n) convert_wt(a.in[I_WRKVZ] + (size_t)n * 1024 * 1024, 1024, 1024, (bf16_t*)(ws + NB_WT3) + (size_t)n * 1024 * 1024, 1024, MapId{}, bid, nb);
        convert_wt(a.in[I_WOUTO], 1024, 1024, (bf16_t*)(ws + NB_WT4), 1024, MapId{}, bid, nb);
        convert_wt(a.in[I_W1], 1024, 64, (bf16_t*)(ws + NB_W1T), 64, MapId{}, bid, nb);
        convert_wt(a.in[I_A1], 1024, 64, (bf16_t*)(ws + NB_A1T), 64, MapId{}, bid, nb);
        convert_wt(a.in[I_W2], 64, 1024, (bf16_t*)(ws + NB_W2T), 1024, MapId{}, bid, nb);
        convert_wt(a.in[I_A2], 64, 1024, (bf16_t*)(ws + NB_A2T), 1024, MapId{}, bid, nb);
        convert_rows(a.in[I_XP], (size_t)MP * 1024 / 8, (bf16_t*)(ws + NB_XB), bid, nb);
        convert_rows(a.in[I_XS], (size_t)BS * 1024 / 8, (bf16_t*)(ws + NB_XSB), bid, nb);
        sample_pool_copy(a, ws, bid, nb);
    }
    SEAM(PH_PREP);
    if (IN(PH_GEMM1)) REPS(PH_GEMM1) {
        const int bid = opaque(blockIdx.x), nb = gridDim.x;
        const Route1 R{(bf16_t*)(ws + NB_HB), (bf16_t*)(ws + NB_KVB), (float*)(ws + NB_G3), a.out};
        {
            pg8::Gemm g{(const bf16_t*)(ws + NB_XB), (const bf16_t*)(ws + NB_WT1), MP, N1PAD, 1024};
            pg8::StaticOrder S; S.init(MP, N1PAD, nb, bid);
            Epi1 E{R};
            pg8::gemm_phase<Epi1, pg8::StaticOrder, false>(lds, g, S, E, nullptr);
#if DUP_GEMM1
            __syncthreads();
            pg8::gemm_phase<Epi1, pg8::StaticOrder, false>(lds, g, S, E, nullptr);
#endif
        }
        {
            for (int task = bid; task < 105; task += nb) {
                sample_gemm32_wg((const bf16_t*)(ws + NB_XSB), (const bf16_t*)(ws + NB_WT1), 1024, task * 32, lds,
                    [&](int r, int n, float v) {
                        const int row = MP + r;
                        if (n < 2560) { const float sc = (n >= 1536 && n < 2048) ? 0.125f : 1.0f; ((bf16_t*)(ws + NB_HB))[(size_t)row * 2560 + n] = (bf16_t)(pk_bf16c(v * sc, 0.f) & 0xffffu); }
                        else if (n < 3328) { const int c = n - 2560, i3 = c >> 8, cc = c & 255; ((bf16_t*)(ws + NB_KVB))[(size_t)row * 768 + c] = (bf16_t)(pk_bf16c(v, 0.f) & 0xffffu);
                            float* dst = (i3 == 0) ? a.out + O_CMPS + (size_t)r * 256 + cc : (i3 == 1) ? a.out + O_SELS + (size_t)r * 256 + cc : a.out + O_WINS + (size_t)(r * 512 + 511) * 256 + cc;
                            *dst = v; }
                        else if (n < 3352) ((float*)(ws + NB_G3))[(size_t)row * 32 + (n - 3328)] = v;
                    });
            }
        }
    }
    SEAM(PH_GEMM1);
    if (IN(PH_CONV)) REPS(PH_CONV) {
        const int bid = opaque(blockIdx.x), nb = gridDim.x;
#pragma unroll 1
        for (int item = bid; item < 512; item += nb) conv_item(a, ws, lds, item);
        pool_prompt(a, ws, bid, nb);
        sample_attn(a, ws, lds, bid >> 3, (bid >> 2) & 1, bid & 3);
#if DUP_SATTN
        __syncthreads();
        sample_attn(a, ws, lds, bid >> 3, (bid >> 2) & 1, bid & 3);
#endif
        if (bid >= 96 && bid < 128) sample_conv(a, ws, lds, bid - 96);
    }
    SEAM(PH_CONV);
    if (IN(PH_ATTN)) REPS(PH_ATTN) {
        const int bid = opaque(blockIdx.x), nb = gridDim.x;
        if (bid < 64) sample_combine(a, ws, bid >> 1, bid & 1);
        for (int pr = bid; pr < 256; pr += nb) {
            const int b = pr >> 5, g = (pr >> 4) & 1, xq = pr & 15;
#pragma unroll 1
            for (int k = 0; k < 2; ++k) attn_item(a, ws, lds, b, g, k ? xq : 31 - xq);
        }
    }
    SEAM(PH_ATTN);
    if (IN(PH_GEMM2)) REPS(PH_GEMM2) {
        const int bid = opaque(blockIdx.x), nb = gridDim.x;
        {
            pg8::Gemm g{(const bf16_t*)(ws + NB_CATB), (const bf16_t*)(ws + NB_WT2), MP, 1024, 1024};
            pg8::StaticOrder S; S.init(MP, 1024, nb, bid);
            EpiPreRes E{(float*)ws + WS_PRE, a.in[I_XP]};
            pg8::gemm_phase<EpiPreRes, pg8::StaticOrder, false>(lds, g, S, E, nullptr);
        }
        {
            const int lane = threadIdx.x & 63, wv = __builtin_amdgcn_readfirstlane(threadIdx.x >> 6);
            float* PREs = (float*)ws + WS_PRE + (size_t)MP * 1024;
            const float* xs = a.in[I_XS];
            for (int task = bid; task < 32; task += nb)
                sample_gemm32_wg((const bf16_t*)(ws + NB_CATB) + (size_t)MP * 1024, (const bf16_t*)(ws + NB_WT2), 1024, task * 32, lds,
                              [&](int r, int n, float v) { PREs[(size_t)r * 1024 + n] = fmaf(ALPHA, xs[(size_t)r * 1024 + n], v); });
        }
    }
    SEAM(PH_GEMM2);
    if (IN(PH_LNS)) REPS(PH_LNS) { const int bid = opaque(blockIdx.x), nb = gridDim.x; phase_lns(a, ws, bid, nb); }
    SEAM(PH_LNS);
    if (IN(PH_GEMM3)) REPS(PH_GEMM3) {
        const int bid = opaque(blockIdx.x), nb = gridDim.x;
        {
            pg8::Gemm g{(const bf16_t*)(ws + NB_XSH), (const bf16_t*)(ws + NB_WT3), MP, 4096, 1024};
            Order3 S; S.init(nb, bid);
            Epi3 E{(bf16_t*)(ws + NB_RKVZ)};
            pg8::gemm_phase<Epi3, Order3, false>(lds, g, S, E, nullptr);
        }
        {
            const int lane = threadIdx.x & 63, wv = __builtin_amdgcn_readfirstlane(threadIdx.x >> 6);
            for (int task = bid; task < 128; task += nb) {
                const int n = task >> 5, n0 = (task & 31) * 32;
                bf16_t* dst = (bf16_t*)(ws + NB_RKVZ) + ((size_t)n * XSH_ROWS + MP) * 1024;
                sample_gemm32_wg((const bf16_t*)(ws + NB_XSH) + ((size_t)n * XSH_ROWS + MP) * 1024, (const bf16_t*)(ws + NB_WT3) + (size_t)n * 1024 * 1024, 1024, n0, lds,
                              [&](int r, int c, float v) { dst[(size_t)r * 1024 + c] = (bf16_t)(pk_bf16c(v, 0.f) & 0xffffu); });
            }
            {
                const int tidl = opaque_v(threadIdx.x);
                LoraRegs lcur, lnxt;
                int task = bid;
                if (task < 1026) lora_load(ws, task, tidl, lnxt);
#pragma unroll 1
                while (task < 1026) {
                    lcur = lnxt;
                    const int ntask = task + nb;
                    if (ntask < 1026) lora_load(ws, ntask, tidl, lnxt);
                    lora_tile(ws, lds, task, tidl, lcur);
                    task = ntask;
                }
            }
        }
    }
    SEAM(PH_GEMM3);
    if (IN(PH_PREP2)) REPS(PH_PREP2) {
        const int bid = opaque(blockIdx.x), nb = gridDim.x;
        for (int pr = bid; pr < 256; pr += nb) {
            const int bh = pr >> 1, b = bh >> 4, hd = bh & 15, c0 = (pr & 1) * 16;
            const int tidp = opaque_v(threadIdx.x), lanep = tidp & 63, wvp = tidp >> 6;
            bf16x8 btf[4];
            { const int which = wvp >> 2, nt = wvp & 1;
              const bf16_t* Bt = (const bf16_t*)(ws + (which ? NB_A2T : NB_W2T)) + (size_t)(hd * 64 + nt * 32 + (lanep & 31)) * 64 + (lanep >> 5) * 8;
#pragma unroll
              for (int s4 = 0; s4 < 4; ++s4) btf[s4] = *(const bf16x8*)(Bt + s4 * 16); }
            PreRegs pcur, pnxt;
            scanpre_load(ws, b, hd, c0, tidp, pnxt);
#pragma unroll 1
            for (int cc = 0; cc < 16; ++cc) {
                pcur = pnxt;
                if (cc + 1 < 16) scanpre_load(ws, b, hd, c0 + cc + 1, tidp, pnxt);
                scanpre_chunk(a, ws, lds, b, hd, c0 + cc, pcur, btf);
            }
        }
        const int lane = opaque_v(threadIdx.x) & 63, wv = __builtin_amdgcn_readfirstlane(threadIdx.x >> 6);
        for (int task = bid * 8 + wv; task < 16; task += nb * 8) prep2_task(a, ws, 512, task, lane);
    }
    SEAM(PH_PREP2);
    if (IN(PH_SCAN)) REPS(PH_SCAN) {
        const int bid = opaque(blockIdx.x), nb = gridDim.x;
#pragma unroll 1
        for (int item = bid; item < 128; item += nb) scanseq_head(a, ws, lds, item >> 4, item & 15);
        const int lane = opaque_v(threadIdx.x) & 63, wv = __builtin_amdgcn_readfirstlane(threadIdx.x >> 6);
        for (int task = (nb - 1 - bid) * 8 + wv; task < BS * 16; task += nb * 8) scan_sample(a, ws, task >> 4, task & 15, lane);
    }
    if (IN(PH_SCAN) && IN(PH_GEMM4)) xcd_barrier(bar);
    STAMP(PH_SCAN + 1); STAMP(PH_POST + 1);
    if (IN(PH_GEMM4)) REPS(PH_GEMM4) {
        const int bid = opaque(blockIdx.x), nb = gridDim.x;
        {
            pg8::Gemm g{(const bf16_t*)(ws + NB_G4B), (const bf16_t*)(ws + NB_WT4), MP, 1024, 1024};
            pg8::StaticOrder S; S.init(MP, 1024, nb, bid);
            EpiPre E{(float*)(ws + NB_Y), 1024};
            pg8::gemm_phase<EpiPre, pg8::StaticOrder, false>(lds, g, S, E, nullptr);
        }
        {
            float* PREs = (float*)(ws + NB_Y) + (size_t)MP * 1024;
            for (int task = bid; task < 32; task += nb)
                sample_gemm32_wg((const bf16_t*)(ws + NB_G4B) + (size_t)MP * 1024, (const bf16_t*)(ws + NB_WT4), 1024, task * 32, lds,
                              [&](int r, int n, float v) { PREs[(size_t)r * 1024 + n] = v; });
        }
    }
    SEAM(PH_GEMM4);
    if (IN(PH_LNF)) REPS(PH_LNF) { const int bid = opaque(blockIdx.x), nb = gridDim.x; phase_lnf(a, ws, bid, nb); }
#undef IN
#undef SEAM
}
}

extern "C" void kernel_launch(void* const* d_in, const int* in_sizes, int n_in, void* d_out, int out_size, void* d_ws, size_t ws_size,
                              hipStream_t stream) {
    if (n_in != N_IN || ws_size < nk::NB_END) { fprintf(stderr, "kernel_launch: unexpected n_in %d or ws_size %zu (need %zu)\n", n_in, ws_size, (size_t)nk::NB_END); return; }
    static int grid = 0;
    if (!grid) {
        int dev = 0, cus = 0, per_cu = 0;
        hipGetDevice(&dev);
        hipDeviceGetAttribute(&cus, hipDeviceAttributeMultiprocessorCount, dev);
        hipFuncSetAttribute((const void*)nk::mega, hipFuncAttributeMaxDynamicSharedMemorySize, nk::LDS_BYTES);
        hipOccupancyMaxActiveBlocksPerMultiprocessor(&per_cu, (const void*)nk::mega, nk::NTH, nk::LDS_BYTES);
        if (per_cu < 1) fprintf(stderr, "kernel_launch: occupancy query says %d blocks per CU\n", per_cu);
        grid = cus;
    }
    hipMemsetAsync((unsigned char*)d_ws + nk::NB_BAR, 0, 32768, stream);
    nk::Args a{};
    for (int i = 0; i < N_IN; ++i) a.in[i] = (const float*)d_in[i];
    a.out = (float*)d_out; a.ws = (unsigned char*)d_ws; a.ph_lo = 0; a.ph_hi = nk::NPHASE;
    void* args[] = {&a};
    hipError_t e = hipLaunchCooperativeKernel((const void*)nk::mega, dim3(grid), dim3(nk::NTH), args, nk::LDS_BYTES, stream);
    if (e != hipSuccess) fprintf(stderr, "cooperative launch failed: %s (grid %d)\n", hipGetErrorString(e), grid);
}
```

```cpp
#include <hip/hip_runtime.h>
#include <hip/hip_cooperative_groups.h>
#include <cstdio>
namespace cg = cooperative_groups;
#ifndef PROBE_TIME
#define PROBE_TIME -1
#endif
#ifndef PROBE_K
#define PROBE_K 1e-4f
#endif

constexpr int D = 1024, BP = 8, TP = 2048, MP = BP * TP, BS = 32, MT = MP + BS;
constexpr int DIN = 3352;
constexpr int C_AVAL = 0, C_AGLU = 512, C_ZA = 1024, C_Q = 1536, C_KV = 2048, C_G3 = 2816, C_ZB = 2840;
constexpr int C_CMP = C_KV, C_SEL = C_KV + 256, C_WIN = C_KV + 512;
constexpr int PAST = 8192, NPAGE = 64, PAGE = 128;
constexpr float ALPHA = 1.4142135623730951f;
constexpr float LN_EPS = 1e-5f, GN_EPS = 64e-5f;

constexpr size_t O_Y = 0, O_YS = 16777216, O_CMPP = 16809984, O_CMPS = 21004288, O_SELP = 21012480, O_SELS = 25206784,
                 O_WINP = 25214976, O_WINS = 26263552, O_CONVP = 30457856, O_CONVS = 30580736, O_WKVP = 31072256,
                 O_WKVS = 31596544, O_SHP = 33693696, O_SHS = 33701888;

enum { I_XP = 0, I_XS, I_CCMP, I_CSEL, I_CWIN, I_SCONV, I_SWKV, I_SSHIFT, I_PT, I_WIN, I_CONVW, I_CONVB, I_CLNG, I_CLNB,
       I_WKC, I_WVC, I_WOUTE, I_MU, I_WRKVZ, I_W0, I_W1, I_W2, I_A0, I_A1, I_A2, I_KK, I_KA, I_RK, I_GNG, I_GNB, I_WOUTO,
       I_LNG, I_LNB, N_IN };

constexpr size_t SZ_ROWD = (size_t)MT * D;
constexpr size_t WS_H = 0;
constexpr size_t WS_CAT = WS_H + (size_t)MT * DIN;
constexpr size_t WS_OC = WS_CAT + SZ_ROWD;
constexpr size_t WS_XSH = 0;
constexpr size_t WS_Y = 0;
constexpr size_t WS_G4 = SZ_ROWD;
constexpr size_t WS_R0END = 6 * SZ_ROWD;
constexpr size_t WS_PRE = WS_R0END;
constexpr size_t WS_X1 = WS_PRE + SZ_ROWD;
constexpr size_t WS_R = WS_X1 + SZ_ROWD;
constexpr size_t WS_K = WS_R + SZ_ROWD;
constexpr size_t WS_V = WS_K + SZ_ROWD;
constexpr size_t WS_Z = WS_V + SZ_ROWD;
constexpr size_t WS_DEC = WS_Z + SZ_ROWD;
constexpr size_t WS_KKN = WS_DEC + SZ_ROWD;
constexpr size_t WS_KKA = WS_KKN + SZ_ROWD;
constexpr size_t WS_TW = WS_KKA + SZ_ROWD;
constexpr size_t WS_AW = WS_TW + (size_t)MT * 64;
constexpr size_t WS_RK = WS_AW + (size_t)MT * 64;
constexpr size_t WS_END = WS_RK + (size_t)MT * 16;
constexpr size_t WS_PCP = WS_R;
constexpr size_t WS_PCS = WS_R + (size_t)MP * 8 * 64;
constexpr size_t WS_IMP = WS_K;
constexpr size_t WS_SELIDX = WS_V;
constexpr size_t WS_KCP = WS_Z;
constexpr size_t WS_KCS = WS_Z + (size_t)8 * 64 * 256;
static_assert(WS_OC + (size_t)MT * 512 <= WS_R0END, "layer0 temporaries overflow region 0");

namespace pg8 {
#define PG8_LAS __attribute__((address_space(3)))
typedef unsigned short bf16_t;
typedef short bf16x8 __attribute__((ext_vector_type(8)));
typedef float f32x4 __attribute__((ext_vector_type(4)));
typedef unsigned u32x4 __attribute__((ext_vector_type(4)));
constexpr int BM = 256, BK = 64, HALF = 128, HTB = HALF * BK * 2  , STAGE_BYTES = 8 * HTB, NXCD = 8, WGM = 8;

__host__ __device__ __forceinline__ int lds_byte(int r, int c) { const int st = (r >> 4) * 2 + (c >> 5), rr = r & 15, cc = c & 31, ob = rr * 64 + cc * 2; return st * 1024 + (ob ^ (((ob >> 9) & 1) << 5)); }
__host__ __device__ __forceinline__ void stage_rc(int b, int& R, int& C) { const int st = b / 1024, sb = b % 1024, swz = sb ^ (((sb >> 9) & 1) << 5); R = (st >> 1) * 16 + swz / 64; C = (st & 1) * 32 + (swz % 64) / 2; }
__host__ __device__ __forceinline__ int perm32(int rho) { const int n = rho >> 4, i = rho & 15; return 8 * (i >> 2) + 4 * n + (i & 3); }

struct Unit { int pm, pn; };
struct Gemm { const bf16_t* A; const bf16_t* Bt; int M, N, K; };

struct StaticOrder {
    int nM, nN, nwg, G, c;
    __host__ __device__ void init(int M, int N, int G_, int c_) { nM = M / BM; nN = N / BM; nwg = nM * nN; G = G_; c = c_; }
    __host__ __device__ bool next(int i, Unit& u) const {
        const long L = (long)i * G + c; if (L >= nwg) return false;
        int wgid = (int)L; { const int q = nwg / NXCD, r = nwg % NXCD, xcd = wgid % NXCD, off = wgid / NXCD; wgid = (xcd < r ? xcd * (q + 1) : r * (q + 1) + (xcd - r) * q) + off; }
        const int nig = WGM * nN, gid = wgid / nig, fm = gid * WGM, gsz = (nM - fm) < WGM ? (nM - fm) : WGM;
        u.pm = fm + ((wgid % nig) % gsz); u.pn = (wgid % nig) / gsz; return true;
    }
    __device__ __forceinline__ void a_ready(const Unit&) const {}
    __device__ __forceinline__ void done(const Unit&) const {}
};
struct CountedOrder : StaticOrder {
    const unsigned* ready; unsigned need; unsigned* tmo;
    __device__ __forceinline__ void a_ready(const Unit& u) const {
        if (threadIdx.x < 64) {
            const unsigned long long t0 = __builtin_amdgcn_s_memrealtime(); unsigned polls = 0;
            while ((unsigned)__builtin_amdgcn_readfirstlane(__hip_atomic_load(ready + 64 * u.pm, __ATOMIC_RELAXED, __HIP_MEMORY_SCOPE_AGENT)) < need) {
                if ((++polls & 255u) == 0u && __builtin_amdgcn_readfirstlane(__hip_atomic_load(tmo, __ATOMIC_RELAXED, __HIP_MEMORY_SCOPE_AGENT)) != 0u) break;
                if (__builtin_amdgcn_s_memrealtime() - t0 > 2000000ull) {
                    if (threadIdx.x == 0) { unsigned expect = 0u; __hip_atomic_compare_exchange_strong(tmo + 1, &expect, 0x600u | (unsigned)(u.pm & 0xff), __ATOMIC_RELAXED, __ATOMIC_RELAXED, __HIP_MEMORY_SCOPE_AGENT); __hip_atomic_store(tmo, 1u, __ATOMIC_RELAXED, __HIP_MEMORY_SCOPE_AGENT); }
                    break; }
                __builtin_amdgcn_s_sleep(2); }
            __builtin_amdgcn_fence(__ATOMIC_ACQUIRE, "agent");
            asm volatile("s_waitcnt vmcnt(0)" ::: "memory");
        }
#if !defined(BROKEN_HOOK_NO_BARRIER)
        asm volatile("" ::: "memory"); __builtin_amdgcn_s_barrier(); asm volatile("" ::: "memory");
#endif
    }
};


template <class Epi, class Sched, bool STAMP = false>
__device__ __forceinline__ void gemm_phase(PG8_LAS unsigned char* lds, const Gemm g, const Sched& S, const Epi& E, unsigned long long* stamps) {
    int tid_ = threadIdx.x; asm volatile("" : "+v"(tid_));
    const int tid = tid_, wid = __builtin_amdgcn_readfirstlane(tid >> 6), lane = tid & 63, wr = wid >> 2, wc = wid & 3, fr = lane & 15, fq = lane >> 4;
    const int K = g.K, nt = K / BK;
    int ts_lo = 0, ts_hi = 0, nts = 0; const unsigned long long rt_entry = STAMP ? (unsigned long long)wall_clock64() : 0ull;
#define PG8_STAMP() do { if (STAMP && wid == 0 && nts < 64) { const unsigned long long _c = (unsigned long long)clock64(); \
        ts_lo = (lane == nts) ? (int)(unsigned)_c : ts_lo; ts_hi = (lane == nts) ? (int)(unsigned)(_c >> 32) : ts_hi; ++nts; } } while (0)
    PG8_STAMP();
    unsigned voffA[2], voffB[2];
#pragma unroll
    for (int i = 0; i < 2; ++i) { int R, C; stage_rc(tid * 16 + i * 8192, R, C); const int Rb = Epi::PERM ? ((R & ~31) + perm32(R & 31)) : R;
        voffA[i] = (unsigned)(R * K + C) * 2u; voffB[i] = (unsigned)(Rb * K + C) * 2u; }
    const size_t kstep = (size_t)(BK * 2);
    const size_t hstep = (size_t)HALF * K * 2;
    const size_t tstep = 2 * hstep;
    const unsigned ldsw = (unsigned)wid * 1024u;
    const int aoff = lds_byte(wr * 64 + fr, fq * 8), boff = lds_byte(wc * 32 + fr, fq * 8);
#define PG8_SA(b, h) (((b) * 2 + (h)) * HTB)
#define PG8_SB(b, h) ((4 + (b) * 2 + (h)) * HTB)
#define PG8_STAGE(bufoff, gbase, voff) do { _Pragma("unroll") for (int _i = 0; _i < 2; ++_i) \
        __builtin_amdgcn_global_load_lds((const unsigned*)((const char*)(gbase) + (voff)[_i]), (PG8_LAS unsigned*)(lds + (bufoff) + ldsw + _i * 8192), 16, 0, 0); } while (0)
#define PG8_LDA(dst, b, h) do { _Pragma("unroll") for (int m = 0; m < 4; ++m) _Pragma("unroll") for (int k = 0; k < 2; ++k) dst[m][k] = *(const PG8_LAS bf16x8*)(lds + PG8_SA(b, h) + aoff + m * 2048 + k * 1024); } while (0)
#define PG8_LDB(dst, b, h) do { _Pragma("unroll") for (int n = 0; n < 2; ++n) _Pragma("unroll") for (int k = 0; k < 2; ++k) dst[n][k] = *(const PG8_LAS bf16x8*)(lds + PG8_SB(b, h) + boff + n * 2048 + k * 1024); } while (0)
#define PG8_MMA(ai, bj, At, Bt) do { __builtin_amdgcn_s_setprio(1); _Pragma("unroll") for (int m = 0; m < 4; ++m) _Pragma("unroll") for (int n = 0; n < 2; ++n) _Pragma("unroll") for (int k = 0; k < 2; ++k) \
        acc[ai][bj][m][n] = __builtin_amdgcn_mfma_f32_16x16x32_bf16(Bt[n][k], At[m][k], acc[ai][bj][m][n], 0, 0, 0); __builtin_amdgcn_s_setprio(0); } while (0)
#define PG8_WAIT_V(n) asm volatile("s_waitcnt vmcnt(" #n ")" ::: "memory")
#define PG8_WAIT_L(n) asm volatile("s_waitcnt lgkmcnt(" #n ")" ::: "memory")
#define PG8_BAR __builtin_amdgcn_s_barrier()
#define PG8_SCHED __builtin_amdgcn_sched_barrier(0)
    Unit cur, nxt; int ui = 0;
    if (!S.next(0, cur)) return;
    f32x4 acc[2][2][4][2];
#pragma unroll
    for (int a = 0; a < 2; ++a)
#pragma unroll
        for (int b = 0; b < 2; ++b)
#pragma unroll
            for (int m = 0; m < 4; ++m)
#pragma unroll
                for (int n = 0; n < 2; ++n) acc[a][b][m][n] = (f32x4){0.f, 0.f, 0.f, 0.f};
    bf16x8 At[4][2], B0[2][2], B1[2][2];
    const char* cA = (const char*)g.A + (size_t)cur.pm * tstep; const char* cB = (const char*)g.Bt + (size_t)cur.pn * tstep;
    S.a_ready(cur);
    PG8_STAGE(PG8_SB(0, 0), cB, voffB); PG8_STAGE(PG8_SA(0, 0), cA, voffA); PG8_STAGE(PG8_SB(0, 1), cB + hstep, voffB); PG8_STAGE(PG8_SA(0, 1), cA + hstep, voffA);
    if (wr == 1) PG8_BAR;
    PG8_WAIT_V(4); PG8_BAR;
    PG8_STAGE(PG8_SB(1, 0), cB + kstep, voffB); PG8_STAGE(PG8_SA(1, 0), cA + kstep, voffA); PG8_STAGE(PG8_SB(1, 1), cB + hstep + kstep, voffB);
    PG8_WAIT_V(6); PG8_BAR;
    PG8_STAMP();
    for (;;) {
        const bool has_next = S.next(ui + 1, nxt);
        const char* nA = has_next ? (const char*)g.A + (size_t)nxt.pm * tstep : cA; const char* nB = has_next ? (const char*)g.Bt + (size_t)nxt.pn * tstep : cB;
        for (int t = 0; t < nt; t += 2) {
            const bool last = (t == nt - 2);
            const char* a1 = cA + (size_t)(t + 1) * kstep;
            const char* a2 = last ? nA : cA + (size_t)(t + 2) * kstep; const char* b2 = last ? nB : cB + (size_t)(t + 2) * kstep;
            const char* a3 = a2 + kstep; const char* b3 = b2 + kstep;
            if (last && has_next) S.a_ready(nxt);
            PG8_LDB(B0, 0, 0); PG8_SCHED; PG8_LDA(At, 0, 0); PG8_STAGE(PG8_SA(1, 1), a1 + hstep, voffA);
            PG8_WAIT_L(8); PG8_BAR; PG8_WAIT_L(0); PG8_MMA(0, 0, At, B0); PG8_BAR; PG8_SCHED;
            PG8_LDB(B1, 0, 1); PG8_STAGE(PG8_SB(0, 0), b2, voffB);
            PG8_BAR; PG8_WAIT_L(0); PG8_MMA(0, 1, At, B1); PG8_BAR;
            PG8_LDA(At, 0, 1); PG8_STAGE(PG8_SA(0, 0), a2, voffA);
            PG8_BAR; PG8_WAIT_L(0); PG8_MMA(1, 0, At, B0); PG8_BAR; PG8_SCHED;
            PG8_STAGE(PG8_SB(0, 1), b2 + hstep, voffB);
            PG8_WAIT_V(6); PG8_BAR; PG8_MMA(1, 1, At, B1); PG8_BAR;
            PG8_LDB(B0, 1, 0); PG8_SCHED; PG8_LDA(At, 1, 0); PG8_STAGE(PG8_SA(0, 1), a2 + hstep, voffA);
            PG8_WAIT_L(8); PG8_BAR; PG8_WAIT_L(0); PG8_MMA(0, 0, At, B0); PG8_BAR; PG8_SCHED;
            PG8_LDB(B1, 1, 1); PG8_STAGE(PG8_SB(1, 0), b3, voffB);
            PG8_BAR; PG8_WAIT_L(0); PG8_MMA(0, 1, At, B1); PG8_BAR;
            PG8_LDA(At, 1, 1); PG8_STAGE(PG8_SA(1, 0), a3, voffA);
            PG8_BAR; PG8_WAIT_L(0); PG8_MMA(1, 0, At, B0); PG8_BAR; PG8_SCHED;
            PG8_STAGE(PG8_SB(1, 1), b3 + hstep, voffB);
            PG8_WAIT_V(6); PG8_BAR; PG8_MMA(1, 1, At, B1); PG8_BAR;
        }
        PG8_STAMP();
        if constexpr (!Epi::AFTER_DRAIN) { E(acc, cur, wr, wc, fr, fq); S.done(cur); }
        PG8_STAMP();
        if (!has_next) break;
#pragma unroll
        for (int a = 0; a < 2; ++a)
#pragma unroll
            for (int b = 0; b < 2; ++b)
#pragma unroll
                for (int m = 0; m < 4; ++m)
#pragma unroll
                    for (int n = 0; n < 2; ++n) acc[a][b][m][n] = (f32x4){0.f, 0.f, 0.f, 0.f};
        cur = nxt; cA = nA; cB = nB; ++ui;
    }
    PG8_WAIT_V(0);
    if (wr == 0) PG8_BAR;
    PG8_BAR;
    if constexpr (Epi::AFTER_DRAIN) { E.fused(acc, cur, wr, wc, fr, fq, lds, wid, lane); S.done(cur); }
    PG8_STAMP();
    if (STAMP && wid == 0) { stamps[lane] = lane < nts ? (((unsigned long long)(unsigned)ts_hi << 32) | (unsigned)ts_lo) : 0ull;
        if (lane == 62) stamps[62] = rt_entry; if (lane == 63) stamps[63] = (unsigned long long)wall_clock64(); }
#undef PG8_STAMP
#undef PG8_SA
#undef PG8_SB
#undef PG8_STAGE
#undef PG8_LDA
#undef PG8_LDB
#undef PG8_MMA
#undef PG8_WAIT_V
#undef PG8_WAIT_L
#undef PG8_BAR
#undef PG8_SCHED
}
}

#define XB_TMO      128
#define XB_XCNT(j)  (256  + 64 * (j))
#define XB_XSUB(j)  (1280 + 64 * (j))
#define XB_XGEN(j)  (2304 + 64 * (j))
#define XB_TOP      3328
#define XB_TOPGEN   3392
#define XCD_BAR_WORDS 3456
#define XB_SPIN_CAP (1u << 18)
#define LAS __attribute__((address_space(3)))

__device__ __forceinline__ unsigned xb_ld(unsigned* p)              { return __hip_atomic_load(p, __ATOMIC_RELAXED, __HIP_MEMORY_SCOPE_AGENT); }
__device__ __forceinline__ unsigned xb_add(unsigned* p, unsigned v) { return __hip_atomic_fetch_add(p, v, __ATOMIC_RELAXED, __HIP_MEMORY_SCOPE_AGENT); }
__device__ __forceinline__ unsigned xb_xcc_id() { return (unsigned)__builtin_amdgcn_s_getreg((3 << 11) | 20) & 0xFu; }
#define XB_SPIN(cond, bar) do { unsigned _sp = 0; while (cond) { __builtin_amdgcn_s_sleep(1); \
    if ((++_sp & 255u) == 0u) { if (xb_ld(&(bar)[XB_TMO])) break; if (_sp > XB_SPIN_CAP) { atomicAdd(&(bar)[XB_TMO], 1u); break; } } } } while (0)

struct XcdBarrier {
    unsigned* bar; unsigned x;
    volatile LAS unsigned* st;
};

__device__ __forceinline__ XcdBarrier xcd_barrier_post(unsigned* bar, volatile LAS unsigned* st) {
    XcdBarrier b; b.bar = bar; b.x = xb_xcc_id(); b.st = st;
    if (threadIdx.x == 0) (void)xb_add(&bar[XB_XCNT(b.x)], 1u);
    return b;
}
__device__ __forceinline__ void xcd_barrier_complete(unsigned* bar, unsigned x, unsigned& nloc, unsigned& nx) {
    const unsigned G = gridDim.x * gridDim.y * gridDim.z;
    unsigned sum, cnt, mine, sp = 0u;
    for (;;) {
        sum = 0u; cnt = 0u; mine = 0u;
#pragma unroll
        for (unsigned j = 0; j < 16; ++j) { const unsigned c = xb_ld(&bar[XB_XCNT(j)]); sum += c; cnt += (c > 0u) ? 1u : 0u; mine = (j == x) ? c : mine; }
        if (sum == G) break;
        __builtin_amdgcn_s_sleep(1);
        if ((++sp & 255u) == 0u) { if (xb_ld(&bar[XB_TMO])) break; if (sp > XB_SPIN_CAP) { atomicAdd(&bar[XB_TMO], 1u); break; } }
    }
    nloc = mine > 0u ? mine : 1u; nx = cnt > 0u ? cnt : 1u;
}

__device__ __forceinline__ void xcd_barrier(const XcdBarrier& b) {
    asm volatile("s_waitcnt vmcnt(0)" ::: "memory");
    __syncthreads();
    if (threadIdx.x == 0) {
        unsigned* bar = b.bar;
        __builtin_amdgcn_s_waitcnt(0);
        unsigned nloc = b.st[0], nx = b.st[1];
        if (nloc == 0u) { xcd_barrier_complete(bar, b.x, nloc, nx); b.st[0] = nloc; b.st[1] = nx; }
        const unsigned old = xb_add(&bar[XB_XSUB(b.x)], 1u);
        const unsigned gen = old / nloc;
        if (old + 1u == (gen + 1u) * nloc) {
            __builtin_amdgcn_fence(__ATOMIC_RELEASE, "agent");
            asm volatile("s_waitcnt vmcnt(0)" ::: "memory");
            const unsigned og = xb_add(&bar[XB_TOP], 1u);
            const unsigned tg = og / nx;
            if (og + 1u == (tg + 1u) * nx) xb_add(&bar[XB_TOPGEN], 1u);
            else XB_SPIN(xb_ld(&bar[XB_TOPGEN]) == tg, bar);
            __builtin_amdgcn_fence(__ATOMIC_ACQUIRE, "agent");
            xb_add(&bar[XB_XGEN(b.x)], 1u);
            asm volatile("s_waitcnt vmcnt(0)" ::: "memory");
        } else {
            XB_SPIN(xb_ld(&bar[XB_XGEN(b.x)]) == gen, bar);
            __builtin_amdgcn_fence(__ATOMIC_ACQUIRE, "agent");
            asm volatile("s_waitcnt vmcnt(0)" ::: "memory");
        }
    }
    __syncthreads();
}

namespace nk {
using pg8::bf16_t; using pg8::bf16x8; using pg8::f32x4; using pg8::u32x4; using pg8::Unit;
constexpr int NTH = 512;
constexpr int LDS_STAGE = pg8::STAGE_BYTES;
constexpr int LDS_MISC = 158720;
constexpr int LDS_BYTES = LDS_MISC + 1024;

constexpr size_t NB0 = WS_END * 4;
constexpr size_t NB_BAR = NB0;
constexpr size_t NB_WT1 = NB_BAR + 32768;
constexpr size_t NB_WT2 = NB_WT1 + (size_t)3584 * 1024 * 2;
constexpr size_t NB_XB = NB_WT2 + (size_t)1024 * 1024 * 2;
constexpr size_t NB_XSB = NB_XB + (size_t)MP * 1024 * 2;
constexpr size_t NB_HB = NB_XSB + (size_t)BS * 1024 * 2;
constexpr size_t NB_KVB = NB_HB + (size_t)MT * 2560 * 2;
constexpr size_t NB_G3 = NB_KVB + (size_t)MT * 768 * 2;
constexpr size_t NB_CATB = NB_G3 + (size_t)MT * 32 * 4;
constexpr size_t NB_CBUF = NB_CATB + (size_t)MT * 1024 * 2;
constexpr size_t NB_KCB = NB_CBUF + (size_t)MP * 512 * 4;
constexpr size_t NB_WT3 = NB_KCB + (size_t)BP * 64 * 256 * 2;
constexpr size_t NB_WT4 = NB_WT3 + (size_t)4 * 1024 * 1024 * 2;
constexpr size_t NB_W1T = NB_WT4 + (size_t)1024 * 1024 * 2;
constexpr size_t NB_A1T = NB_W1T + (size_t)64 * 1024 * 2;
constexpr size_t NB_W2T = NB_A1T + (size_t)64 * 1024 * 2;
constexpr size_t NB_A2T = NB_W2T + (size_t)64 * 1024 * 2;
constexpr size_t NB_KCS = NB_A2T + (size_t)64 * 1024 * 2;
constexpr size_t NB_OCS = NB_KCS + (size_t)BS * 256 * 256 * 4;
constexpr size_t NB_PARTS = NB_OCS + (size_t)BS * 8 * 64 * 4;
constexpr size_t NB_END = NB_PARTS + (size_t)BS * 8 * 24 * 66 * 4;
constexpr size_t NB_XSH = 0;
constexpr size_t NB_RKVZ = NB_XSH + (size_t)6 * 16640 * 1024 * 2;
constexpr size_t NB_TWB = NB_RKVZ + (size_t)4 * 16640 * 1024 * 2;
constexpr size_t NB_AWB = NB_TWB + (size_t)MT * 64 * 2;
constexpr size_t NB_RKS = NB_AWB + (size_t)MT * 64 * 2;
static_assert(NB_RKS + (size_t)MT * 16 * 4 <= WS_PRE * 4, "layer-1 region A overflows into PRE");
constexpr size_t NB_DEC = (WS_X1 + SZ_ROWD) * 4;
constexpr size_t NB_KKN = NB_DEC + (size_t)MT * 1024 * 4;
constexpr size_t NB_KKA = NB_KKN + (size_t)MT * 1024 * 2;
constexpr size_t NB_KP = NB_KKA + (size_t)MT * 1024 * 2;
constexpr size_t NB_Y = NB_KP + (size_t)MT * 1024 * 2;
constexpr size_t NB_G4B = NB_Y + (size_t)MT * 1024 * 4;
constexpr size_t NB_CHK = NB_G4B + (size_t)MT * 1024 * 2;
constexpr size_t NB_SREC = NB_CHK + (size_t)4096 * 32768;
static_assert(NB_SREC + (size_t)4096 * 8192 <= NB0, "layer-1 region B overflows");
constexpr int N1PAD = 3584;
__host__ __device__ __forceinline__ int win_src_col(int n) { return n < 2048 ? n : (n < 2560 ? C_ZB + (n - 2048) : (n < 3328 ? C_KV + (n - 2560) : (n < 3352 ? C_G3 + (n - 3328) : -1))); }

__device__ __forceinline__ int opaque(int x) { asm volatile("" : "+s"(x)); return x; }
__device__ __forceinline__ void lds_barrier() { asm volatile("s_waitcnt lgkmcnt(0)" ::: "memory"); __builtin_amdgcn_s_barrier(); asm volatile("" ::: "memory"); }
__device__ __forceinline__ int opaque_v(int x) { asm volatile("" : "+v"(x)); return x; }
struct Args { const float* in[N_IN]; float* out; unsigned char* ws; int ph_lo, ph_hi; };

__device__ __forceinline__ unsigned pk_bf16(float lo, float hi) { unsigned r; asm volatile("v_cvt_pk_bf16_f32 %0, %1, %2" : "=v"(r) : "v"(lo), "v"(hi)); return r; }
typedef __bf16 bf16x2_t __attribute__((ext_vector_type(2)));
__device__ __forceinline__ unsigned pk_bf16c(float lo, float hi) { bf16x2_t v; v[0] = (__bf16)lo; v[1] = (__bf16)hi; return __builtin_bit_cast(unsigned, v); }

template <class MAP>
__device__ __forceinline__ void convert_wt(const float* __restrict__ W, int K, int ldw, bf16_t* __restrict__ Wt, int Npad, MAP map, int bid, int nb) {
    const int kg = K / 8;
    const size_t total = (size_t)Npad * kg;
    for (size_t i = (size_t)bid * NTH + threadIdx.x; i < total; i += (size_t)nb * NTH) {
        const int n = (int)(i % Npad), k0 = (int)(i / Npad) * 8;
        const int sc = map(n);
        u32x4 w = {0u, 0u, 0u, 0u};
        if (sc >= 0) {
            float v[8];
#pragma unroll
            for (int j = 0; j < 8; ++j) v[j] = W[(size_t)(k0 + j) * ldw + sc];
            w.x = pk_bf16(v[0], v[1]); w.y = pk_bf16(v[2], v[3]); w.z = pk_bf16(v[4], v[5]); w.w = pk_bf16(v[6], v[7]);
        }
        *(u32x4*)(Wt + (size_t)n * K + k0) = w;
    }
}
struct MapId { __device__ __forceinline__ int operator()(int n) const { return n; } };
struct MapWin { __device__ __forceinline__ int operator()(int n) const { return win_src_col(n); } };
__device__ __forceinline__ void convert_rows(const float* __restrict__ src, size_t n8, bf16_t* __restrict__ dst, int bid, int nb) {
#pragma unroll 4
    for (size_t i = (size_t)bid * NTH + threadIdx.x; i < n8; i += (size_t)nb * NTH) {
        const float4 a = *(const float4*)(src + i * 8), b = *(const float4*)(src + i * 8 + 4);
        u32x4 w; w.x = pk_bf16(a.x, a.y); w.y = pk_bf16(a.z, a.w); w.z = pk_bf16(b.x, b.y); w.w = pk_bf16(b.z, b.w);
        *(u32x4*)(dst + i * 8) = w;
    }
}

struct EpiPre {
    static constexpr bool PERM = false, AFTER_DRAIN = false;
    float* C; int ldc;
    __device__ __forceinline__ void operator()(const f32x4 (&acc)[2][2][4][2], const Unit& u, int wr, int wc, int fr, int fq) const {
        const int row0 = u.pm * 256 + wr * 64 + fr, col0 = u.pn * 256 + wc * 32 + 4 * fq;
#pragma unroll
        for (int ai = 0; ai < 2; ++ai)
#pragma unroll
            for (int m = 0; m < 4; ++m) { float* rowp = C + (size_t)(row0 + ai * 128 + m * 16) * ldc + col0;
#pragma unroll
                for (int bj = 0; bj < 2; ++bj)
#pragma unroll
                    for (int n = 0; n < 2; ++n) *(f32x4*)(rowp + bj * 128 + n * 16) = acc[ai][bj][m][n]; }
    }
};


struct Route1 {
    bf16_t* HB; bf16_t* KVB; float* G3; float* out;
    __device__ __forceinline__ void put8(int row, int n0, const f32x4& v0, const f32x4& v1) const {
        if (n0 < 2560) {
            const float sc = (n0 >= 1536 && n0 < 2048) ? 0.125f : 1.0f;
            u32x4 w; w.x = pk_bf16c(v0[0] * sc, v0[1] * sc); w.y = pk_bf16c(v0[2] * sc, v0[3] * sc); w.z = pk_bf16c(v1[0] * sc, v1[1] * sc); w.w = pk_bf16c(v1[2] * sc, v1[3] * sc);
            *(u32x4*)(HB + (size_t)row * 2560 + n0) = w;
        } else if (n0 < 3328) {
            const int c = n0 - 2560, i3 = c >> 8, cc = c & 255;
            u32x4 w; w.x = pk_bf16c(v0[0], v0[1]); w.y = pk_bf16c(v0[2], v0[3]); w.z = pk_bf16c(v1[0], v1[1]); w.w = pk_bf16c(v1[2], v1[3]);
            *(u32x4*)(KVB + (size_t)row * 768 + c) = w;
            float* dst = nullptr;
            if (row < MP) {
                if (i3 == 0) dst = out + O_CMPP + (size_t)row * 256 + cc;
                else if (i3 == 1) dst = out + O_SELP + (size_t)row * 256 + cc;
                else { const int b = row >> 11, t = row & 2047; if (t >= TP - 512) dst = out + O_WINP + (size_t)(b * 512 + t - (TP - 512)) * 256 + cc; }
            } else {
                const int sidx = row - MP;
                if (i3 == 0) dst = out + O_CMPS + (size_t)sidx * 256 + cc;
                else if (i3 == 1) dst = out + O_SELS + (size_t)sidx * 256 + cc;
                else dst = out + O_WINS + (size_t)(sidx * 512 + 511) * 256 + cc;
            }
            if (dst) { *(f32x4*)dst = v0; *(f32x4*)(dst + 4) = v1; }
        } else if (n0 < 3352) {
            float* dst = G3 + (size_t)row * 32 + (n0 - 3328);
            *(f32x4*)dst = v0; *(f32x4*)(dst + 4) = v1;
        }
    }
};
struct Epi1 {
    static constexpr bool PERM = true, AFTER_DRAIN = false;
    Route1 R;
    __device__ __forceinline__ void operator()(const f32x4 (&acc)[2][2][4][2], const Unit& u, int wr, int wc, int fr, int fq) const {
        const int row0 = u.pm * 256 + wr * 64 + fr, col0 = u.pn * 256 + wc * 32 + 8 * fq;
#pragma unroll
        for (int ai = 0; ai < 2; ++ai)
#pragma unroll
            for (int m = 0; m < 4; ++m)
#pragma unroll
                for (int bj = 0; bj < 2; ++bj) R.put8(row0 + ai * 128 + m * 16, col0 + bj * 128, acc[ai][bj][m][0], acc[ai][bj][m][1]);
    }
};

typedef float f32x16 __attribute__((ext_vector_type(16)));
template <class EMIT>
__device__ __forceinline__ void sample_gemm32(const bf16_t* __restrict__ A, const bf16_t* __restrict__ Bt, int K, int n0, int lane, EMIT emit) {
    const bf16_t* ap = A + (size_t)(lane & 31) * K + 8 * (lane >> 5);
    const bf16_t* bp = Bt + (size_t)(n0 + (lane & 31)) * K + 8 * (lane >> 5);
    f32x16 acc;
#pragma unroll
    for (int i = 0; i < 16; ++i) acc[i] = 0.f;
#pragma unroll 16
    for (int k = 0; k < K; k += 16) {
        const bf16x8 av = *(const bf16x8*)(ap + k), bv = *(const bf16x8*)(bp + k);
        acc = __builtin_amdgcn_mfma_f32_32x32x16_bf16(av, bv, acc, 0, 0, 0);
    }
#pragma unroll
    for (int r = 0; r < 16; ++r) emit((r & 3) + 8 * (r >> 2) + 4 * (lane >> 5), n0 + (lane & 31), acc[r]);
}

template <class EMIT>
__device__ __forceinline__ void sample_gemm32_wg(const bf16_t* __restrict__ A, const bf16_t* __restrict__ Bt, int K, int n0, PG8_LAS unsigned char* lds, EMIT emit) {
    const int tid = opaque_v(threadIdx.x), lane = tid & 63, wv = tid >> 6;
    const int kq = K / 8;
    const bf16_t* ap = A + (size_t)(lane & 31) * K + 8 * (lane >> 5) + wv * kq;
    const bf16_t* bp = Bt + (size_t)(n0 + (lane & 31)) * K + 8 * (lane >> 5) + wv * kq;
    f32x16 acc;
#pragma unroll
    for (int i = 0; i < 16; ++i) acc[i] = 0.f;
#pragma unroll 8
    for (int k = 0; k < kq; k += 16) {
        const bf16x8 av = *(const bf16x8*)(ap + k), bv = *(const bf16x8*)(bp + k);
        acc = __builtin_amdgcn_mfma_f32_32x32x16_bf16(av, bv, acc, 0, 0, 0);
    }
    PG8_LAS float* P = (PG8_LAS float*)lds;
#pragma unroll
    for (int q = 0; q < 4; ++q) *(PG8_LAS f32x4*)(P + (wv * 64 + lane) * 16 + q * 4) = (f32x4){acc[4 * q], acc[4 * q + 1], acc[4 * q + 2], acc[4 * q + 3]};
    __syncthreads();
    if (wv == 0) {
#pragma unroll
        for (int w = 1; w < 8; ++w)
#pragma unroll
            for (int q = 0; q < 4; ++q) { const f32x4 v = *(const PG8_LAS f32x4*)(P + (w * 64 + lane) * 16 + q * 4); acc[4 * q] += v[0]; acc[4 * q + 1] += v[1]; acc[4 * q + 2] += v[2]; acc[4 * q + 3] += v[3]; }
#pragma unroll
        for (int r = 0; r < 16; ++r) emit((r & 3) + 8 * (r >> 2) + 4 * (lane >> 5), n0 + (lane & 31), acc[r]);
    }
    __syncthreads();
}

typedef float f32x16 __attribute__((ext_vector_type(16)));
__device__ __forceinline__ float bf2f(bf16_t v) { return __uint_as_float((unsigned)v << 16); }
__device__ __forceinline__ float sigm_f(float x) { return 1.f / (1.f + __expf(-x)); }
__device__ __forceinline__ float silu_f(float x) { return x / (1.f + __expf(-x)); }

__device__ __forceinline__ float wsum64(float v) {
    v += __builtin_bit_cast(float, __builtin_amdgcn_update_dpp(0, __builtin_bit_cast(int, v), 0xB1, 0xF, 0xF, true));
    v += __builtin_bit_cast(float, __builtin_amdgcn_update_dpp(0, __builtin_bit_cast(int, v), 0x4E, 0xF, 0xF, true));
    v += __builtin_bit_cast(float, __builtin_amdgcn_update_dpp(0, __builtin_bit_cast(int, v), 0x141, 0xF, 0xF, true));
    v += __builtin_bit_cast(float, __builtin_amdgcn_update_dpp(0, __builtin_bit_cast(int, v), 0x140, 0xF, 0xF, true));
    v += __shfl_xor(v, 16); v += __shfl_xor(v, 32);
    return v;
}
constexpr int CV_U = 0;
constexpr int CV_C = 65536;
__device__ __forceinline__ void conv_item(const Args& a, unsigned char* ws, PG8_LAS unsigned char* lds, int item) {
    const int tid = opaque_v(threadIdx.x);
    const int b = item >> 6, t0 = (item & 63) * 32;
    const bf16_t* HB = (const bf16_t*)(ws + NB_HB);
    PG8_LAS float* U = (PG8_LAS float*)(lds + CV_U);
    PG8_LAS float* C = (PG8_LAS float*)(lds + CV_C);
    const int chl = tid & 255, tp = tid >> 8;
    const int lane = tid & 63, wv = tid >> 6;
    u32x4 zv[4];
#pragma unroll
    for (int k = 0; k < 4; ++k) zv[k] = *(const u32x4*)(HB + (size_t)(b * TP + t0 + wv * 4 + k) * 2560 + 1024 + lane * 8);
#pragma unroll 1
    for (int half = 0; half < 2; ++half) {
        const int chb = half * 256;
#pragma unroll
        for (int it = 0; it < 4; ++it) {
            const int vi = tid + it * NTH;
            if (vi < 62 * 32) {
                const int r = vi >> 5, c8 = (vi & 31) * 8, t = t0 - 30 + r;
                float u[8];
                if (t >= 0) {
                    const bf16_t* h = HB + (size_t)(b * TP + t) * 2560 + chb + c8;
                    const u32x4 av = *(const u32x4*)h, gv = *(const u32x4*)(h + 512);
#pragma unroll
                    for (int i = 0; i < 8; ++i) {
                        const float x = __uint_as_float((i & 1) ? (av[i >> 1] & 0xffff0000u) : (av[i >> 1] << 16));
                        const float g = __uint_as_float((i & 1) ? (gv[i >> 1] & 0xffff0000u) : (gv[i >> 1] << 16));
                        u[i] = x * sigm_f(g);
                    }
                } else {
#pragma unroll
                    for (int i = 0; i < 8; ++i) u[i] = 0.f;
                }
                *(PG8_LAS f32x4*)(U + r * 256 + c8) = (f32x4){u[0], u[1], u[2], u[3]};
                *(PG8_LAS f32x4*)(U + r * 256 + c8 + 4) = (f32x4){u[4], u[5], u[6], u[7]};
                if (t >= TP - 30 && r >= 30) {
                    float* o = a.out + O_CONVP + (size_t)(b * 30 + t - (TP - 30)) * 512 + chb + c8;
                    *(float4*)o = make_float4(u[0], u[1], u[2], u[3]); *(float4*)(o + 4) = make_float4(u[4], u[5], u[6], u[7]);
                }
            }
        }
        __syncthreads();
        {
            const int ch = chb + chl;
            float w[31], uw[46], acc[16];
#pragma unroll
            for (int j = 0; j < 31; ++j) w[j] = a.in[I_CONVW][j * 512 + ch];
            const float bias = a.in[I_CONVB][ch];
#pragma unroll
            for (int r = 0; r < 46; ++r) uw[r] = U[(tp * 16 + r) * 256 + chl];
#pragma unroll
            for (int k = 0; k < 16; ++k) {
                float s_ = bias;
#pragma unroll
                for (int j = 0; j < 31; ++j) s_ = fmaf(w[j], uw[k + j], s_);
                acc[k] = s_;
            }
#pragma unroll
            for (int k = 0; k < 16; ++k) C[(tp * 16 + k) * 516 + ch] = acc[k];
        }
        __syncthreads();
    }
    {
        const float4 g0 = *(const float4*)(a.in[I_CLNG] + lane * 8), g1 = *(const float4*)(a.in[I_CLNG] + lane * 8 + 4);
        const float4 b0 = *(const float4*)(a.in[I_CLNB] + lane * 8), b1 = *(const float4*)(a.in[I_CLNB] + lane * 8 + 4);
        const float gg[8] = {g0.x, g0.y, g0.z, g0.w, g1.x, g1.y, g1.z, g1.w}, bb[8] = {b0.x, b0.y, b0.z, b0.w, b1.x, b1.y, b1.z, b1.w};
#pragma unroll
        for (int k = 0; k < 4; ++k) {
            const int tl = wv * 4 + k;
            const size_t row = (size_t)(b * TP + t0 + tl);
            const f32x4 c0 = *(const PG8_LAS f32x4*)(C + tl * 516 + lane * 8), c1 = *(const PG8_LAS f32x4*)(C + tl * 516 + lane * 8 + 4);
            float c[8] = {c0[0], c0[1], c0[2], c0[3], c1[0], c1[1], c1[2], c1[3]};
            float sm = 0.f;
#pragma unroll
            for (int i = 0; i < 8; ++i) sm += c[i];
            const float mean = wsum64(sm) * (1.f / 512.f);
            float sq = 0.f;
#pragma unroll
            for (int i = 0; i < 8; ++i) { c[i] -= mean; sq += c[i] * c[i]; }
            const float rs = rsqrtf(wsum64(sq) * (1.f / 512.f) + LN_EPS);
            float y[8];
#pragma unroll
            for (int i = 0; i < 8; ++i) {
                const float z = __uint_as_float((i & 1) ? (zv[k][i >> 1] & 0xffff0000u) : (zv[k][i >> 1] << 16));
                y[i] = silu_f(c[i] * rs * gg[i] + bb[i]) * silu_f(z);
            }
            u32x4 o; o.x = pk_bf16(y[0], y[1]); o.y = pk_bf16(y[2], y[3]); o.z = pk_bf16(y[4], y[5]); o.w = pk_bf16(y[6], y[7]);
            *(u32x4*)((bf16_t*)(ws + NB_CATB) + row * 1024 + lane * 8) = o;
        }
    }
    __syncthreads();
}

__device__ __forceinline__ void pool_prompt(const Args& a, unsigned char* ws, int bid, int nb) {
    bf16_t* KCB = (bf16_t*)(ws + NB_KCB);
    for (int i = bid * NTH + threadIdx.x; i < BP * 64 * 256; i += nb * NTH) {
        const int c = i & 255, n = (i >> 8) & 63, b = i >> 14;
        const int kv = c >> 7, g = (c >> 6) & 1;
        const float* w = kv ? a.in[I_WVC] : a.in[I_WKC];
        const float* src = a.out + O_CMPP + (size_t)(b * TP + n * 32) * 256 + c;
        float acc = 0.f;
#pragma unroll 8
        for (int l = 0; l < 32; ++l) acc = fmaf(src[(size_t)l * 256], w[l * 2 + g], acc);
        KCB[i] = (bf16_t)(pk_bf16(acc, 0.f) & 0xffffu);
    }
}

constexpr int A_KT = 0;
constexpr int A_VT = 18432;
constexpr int A_IMPH = 35840;
constexpr int A_IMPS = 68608;
constexpr int A_MASK = 76800;
constexpr float LOG2E = 1.4426950408889634f;

struct KvSrc { const bf16_t* k; const bf16_t* v; int rstride; };

__device__ __forceinline__ void kv_issue(const KvSrc& s, int tid, u32x4& kr, u32x4& vr) {
    const int key = tid >> 3, c8 = tid & 7;
    kr = *(const u32x4*)(s.k + (size_t)key * s.rstride + c8 * 8);
    vr = *(const u32x4*)(s.v + (size_t)key * s.rstride + c8 * 8);
}
__device__ __forceinline__ void kv_write(PG8_LAS unsigned char* lds, int buf, int tid, const u32x4& kr, const u32x4& vr) {
    const int key = tid >> 3, c8 = tid & 7;
    *(PG8_LAS u32x4*)(lds + A_KT + buf * 9216 + key * 144 + c8 * 16) = kr;
    PG8_LAS bf16_t* vt = (PG8_LAS bf16_t*)(lds + A_VT + buf * 8704);
#pragma unroll
    for (int i = 0; i < 4; ++i) { vt[(c8 * 8 + 2 * i) * 68 + key] = (bf16_t)(vr[i] & 0xffffu); vt[(c8 * 8 + 2 * i + 1) * 68 + key] = (bf16_t)(vr[i] >> 16); }
}

__device__ __forceinline__ void attn_block(const int MODE, PG8_LAS unsigned char* lds, int buf, const bf16x8 (&qf)[4], int lane, float kslope, float base, int kmax, int kmin,
                                           float& m, float& l, f32x16 (&o)[2], f32x16 (&x)[2]) {
    const int lr = lane & 31, h = lane >> 5;
    const PG8_LAS unsigned char* kt_p = lds + A_KT + buf * 9216 + lr * 144 + h * 16;
#pragma unroll
    for (int kt = 0; kt < 2; ++kt) {
#pragma unroll
        for (int i = 0; i < 16; ++i) x[kt][i] = 0.f;
#pragma unroll
        for (int s = 0; s < 4; ++s) {
            const bf16x8 kf = *(const PG8_LAS bf16x8*)(kt_p + kt * 32 * 144 + s * 32);
            x[kt] = __builtin_amdgcn_mfma_f32_32x32x16_bf16(kf, qf[s], x[kt], 0, 0, 0);
        }
    }
    const float bh = base + kslope * (float)(4 * h);
    float mx = -INFINITY;
#pragma unroll
    for (int kt = 0; kt < 2; ++kt)
#pragma unroll
        for (int i = 0; i < 16; ++i) {
            const int kc = kt * 32 + (i & 3) + 8 * (i >> 2);
            x[kt][i] = fmaf(x[kt][i], LOG2E, fmaf(kslope, (float)kc, bh));
        }
    if (MODE) {
        const int hi = kmax - 4 * h, lo = kmin - 4 * h;
#pragma unroll
        for (int kt = 0; kt < 2; ++kt)
#pragma unroll
            for (int i = 0; i < 16; ++i) {
                const int kc = kt * 32 + (i & 3) + 8 * (i >> 2);
                x[kt][i] = (kc > hi || kc < lo) ? -INFINITY : x[kt][i];
            }
    }
#pragma unroll
    for (int kt = 0; kt < 2; ++kt)
#pragma unroll
        for (int i = 0; i < 16; ++i) mx = fmaxf(mx, x[kt][i]);
    mx = fmaxf(mx, __shfl_xor(mx, 32));
    const float mn = fmaxf(m, mx);
    const float corr = __builtin_amdgcn_exp2f(m - mn);
    const bool grew = __any(mn > m);
    m = mn;
    float ls = 0.f;
#pragma unroll
    for (int kt = 0; kt < 2; ++kt)
#pragma unroll
        for (int i = 0; i < 16; ++i) { const float pv = __builtin_amdgcn_exp2f(x[kt][i] - mn); x[kt][i] = pv; ls += pv; }
    l = fmaf(l, corr, ls);
    if (grew) {
#pragma unroll
        for (int dt = 0; dt < 2; ++dt)
#pragma unroll
            for (int i = 0; i < 16; ++i) o[dt][i] *= corr;
    }
    const PG8_LAS unsigned char* vt_p = lds + A_VT + buf * 8704 + lr * 136 + h * 8;
#pragma unroll
    for (int kt = 0; kt < 2; ++kt)
#pragma unroll
        for (int s = 0; s < 2; ++s) {
            u32x4 pw; pw.x = pk_bf16(x[kt][8 * s + 0], x[kt][8 * s + 1]); pw.y = pk_bf16(x[kt][8 * s + 2], x[kt][8 * s + 3]);
            pw.z = pk_bf16(x[kt][8 * s + 4], x[kt][8 * s + 5]); pw.w = pk_bf16(x[kt][8 * s + 6], x[kt][8 * s + 7]);
            const bf16x8 pf = __builtin_bit_cast(bf16x8, pw);
#pragma unroll
            for (int dt = 0; dt < 2; ++dt) {
                const PG8_LAS unsigned char* vp = vt_p + dt * 32 * 136 + (kt * 32 + s * 16) * 2;
                typedef unsigned u32x2 __attribute__((ext_vector_type(2)));
                const u32x2 v0 = *(const PG8_LAS u32x2*)vp, v1 = *(const PG8_LAS u32x2*)(vp + 16);
                u32x4 vw; vw.x = v0.x; vw.y = v0.y; vw.z = v1.x; vw.w = v1.y;
                o[dt] = __builtin_amdgcn_mfma_f32_32x32x16_bf16(__builtin_bit_cast(bf16x8, vw), pf, o[dt], 0, 0, 0);
            }
        }
}

__device__ __forceinline__ void attn_item(const Args& a, unsigned char* ws, PG8_LAS unsigned char* lds, int b, int g, int qb) {
    const int tid = opaque_v(threadIdx.x), lane = tid & 63, wv = __builtin_amdgcn_readfirstlane(tid >> 6);
    const int lr = lane & 31, h = lane >> 5;
    const int r = wv >> 1, th = wv & 1, hh = g * 4 + r;
    const int t0 = qb * 64, tb = qb;
    const int qloc = th * 32 + lr;
    const int qpos = t0 + qloc;
    const size_t qrow = (size_t)b * TP + qpos;
    const bf16_t* HB = (const bf16_t*)(ws + NB_HB);
    const bf16_t* KVB = (const bf16_t*)(ws + NB_KVB);
    const float slope2 = __builtin_amdgcn_exp2f(-(float)(hh + 1)) * LOG2E;
    bf16x8 qf[4];
#pragma unroll
    for (int s = 0; s < 4; ++s) qf[s] = *(const bf16x8*)(HB + qrow * 2560 + 1536 + hh * 64 + s * 16 + h * 8);
    const float* g3p = (const float*)(ws + NB_G3) + qrow * 32 + hh * 3;
    const float gc = sigm_f(g3p[0]), gs = sigm_f(g3p[1]), gw = sigm_f(g3p[2]);
    f32x16 res[2], o[2], x[2];
#pragma unroll
    for (int dt = 0; dt < 2; ++dt)
#pragma unroll
        for (int i = 0; i < 16; ++i) { res[dt][i] = 0.f; o[dt][i] = 0.f; }
    float m = -1e30f, l = 0.f;
    u32x4 kr, vr;
    PG8_LAS float* IMPH = (PG8_LAS float*)(lds + A_IMPH);
    PG8_LAS float* IMPS = (PG8_LAS float*)(lds + A_IMPS);
    PG8_LAS unsigned* MASK = (PG8_LAS unsigned*)(lds + A_MASK);

    {
        const bf16_t* kc = (const bf16_t*)(ws + NB_KCB) + (size_t)b * 64 * 256 + g * 64;
        KvSrc s{kc, kc + 128, 256};
        kv_issue(s, tid, kr, vr); kv_write(lds, 0, tid, kr, vr);
        if (tid < 64) MASK[tid] = 0u;
        __syncthreads();
        const int nmax = (qpos >= 31) ? ((qpos - 31) >> 5) : -1;
        attn_block(1, lds, 0, qf, lane, slope2 * 32.f, slope2 * (float)(31 - qpos), nmax, 0, m, l, o, x);
        const float lt = l + __shfl_xor(l, 32);
        const float inv = (nmax >= 0) ? 1.f / lt : 0.f;
        const float sc = gc * inv;
#pragma unroll
        for (int dt = 0; dt < 2; ++dt)
#pragma unroll
            for (int i = 0; i < 16; ++i) { res[dt][i] = o[dt][i] * sc; o[dt][i] = 0.f; }
        if (tb >= 16) {
#pragma unroll
            for (int kt = 0; kt < 2; ++kt)
#pragma unroll
                for (int c = 0; c < 4; ++c)
#pragma unroll
                    for (int e = 0; e < 2; ++e)
                        IMPH[(r * 64 + qloc) * 32 + kt * 16 + 4 * c + 2 * h + e] = (nmax >= 0) ? (x[kt][4 * c + 2 * e] + x[kt][4 * c + 2 * e + 1]) * inv : 0.f;
        }
        m = -1e30f; l = 0.f;
        __syncthreads();
    }
    if (tb >= 16) {
        const int tq = opaque_v(tid);
        const int q = tq >> 3, jq = tq & 7;
        float v4[4];
#pragma unroll
        for (int e = 0; e < 4; ++e) {
            const int j = jq * 4 + e;
            float v = IMPH[(0 * 64 + q) * 32 + j] + IMPH[(1 * 64 + q) * 32 + j] + IMPH[(2 * 64 + q) * 32 + j] + IMPH[(3 * 64 + q) * 32 + j];
            if (j == 0 || j == tb || j == tb - 1) v = 1e4f;
            IMPS[q * 32 + j] = v; v4[e] = v;
        }
        __syncthreads();
        unsigned bits = 0u;
#pragma unroll
        for (int e = 0; e < 4; ++e) {
            const int j = jq * 4 + e;
            int rank = 0;
            for (int i = 0; i <= tb; ++i) { const float vi = IMPS[q * 32 + i]; rank += (vi > v4[e] || (vi == v4[e] && i < j)) ? 1 : 0; }
            if (j <= tb && rank < 16) bits |= 1u << j;
        }
        if (bits) atomicOr((unsigned*)&MASK[q], bits);
    } else {
        if (tid < 64) MASK[tid] = (2u << tb) - 1u;
    }
    __syncthreads();
    const unsigned selmask = MASK[qloc];

    {
        const bf16_t* kb = KVB + (size_t)b * TP * 768 + 256 + g * 64;
        { KvSrc s{kb, kb + 128, 768}; kv_issue(s, tid, kr, vr); kv_write(lds, 0, tid, kr, vr); }
        __syncthreads();
        for (int j = 0; j <= tb; ++j) {
            if (j < tb) { KvSrc s{kb + (size_t)(j + 1) * 64 * 768, kb + (size_t)(j + 1) * 64 * 768 + 128, 768}; kv_issue(s, tid, kr, vr); }
            const float base = ((selmask >> j) & 1u) ? slope2 * (float)(j * 64 - qpos) : -INFINITY;
            attn_block(j == tb, lds, j & 1, qf, lane, slope2, base, qloc, 0, m, l, o, x);
            if (j < tb) kv_write(lds, (j + 1) & 1, tid, kr, vr);
            __syncthreads();
        }
        const float lt = l + __shfl_xor(l, 32);
        const float sc = gs / lt;
#pragma unroll
        for (int dt = 0; dt < 2; ++dt)
#pragma unroll
            for (int i = 0; i < 16; ++i) { res[dt][i] = fmaf(o[dt][i], sc, res[dt][i]); o[dt][i] = 0.f; }
        m = -1e30f; l = 0.f;
    }
    {
        const int jlo = (tb >= 8) ? tb - 8 : 0;
        const bf16_t* kb = KVB + (size_t)b * TP * 768 + 512 + g * 64;
        { KvSrc s{kb + (size_t)jlo * 64 * 768, kb + (size_t)jlo * 64 * 768 + 128, 768}; kv_issue(s, tid, kr, vr); kv_write(lds, 0, tid, kr, vr); }
        __syncthreads();
        for (int j = jlo; j <= tb; ++j) {
            const int bi = (j - jlo) & 1;
            if (j < tb) { KvSrc s{kb + (size_t)(j + 1) * 64 * 768, kb + (size_t)(j + 1) * 64 * 768 + 128, 768}; kv_issue(s, tid, kr, vr); }
            const float base = slope2 * (float)(j * 64 - qpos);
            attn_block((j == tb) || (j == tb - 8), lds, bi, qf, lane, slope2, base, (j == tb) ? qloc : 64, (j == tb - 8) ? qpos - 511 - j * 64 : 0, m, l, o, x);
            if (j < tb) kv_write(lds, bi ^ 1, tid, kr, vr);
            __syncthreads();
        }
        const float lt = l + __shfl_xor(l, 32);
        const float sc = gw / lt;
#pragma unroll
        for (int dt = 0; dt < 2; ++dt)
#pragma unroll
            for (int i = 0; i < 16; ++i) res[dt][i] = fmaf(o[dt][i], sc, res[dt][i]);
    }
    {
        const size_t qrow2 = (size_t)b * TP + t0 + th * 32 + (opaque_v(lane) & 31);
        const bf16_t* zb = HB + qrow2 * 2560 + 2048 + hh * 64;
        bf16_t* dst = (bf16_t*)(ws + NB_CATB) + qrow2 * 1024 + 512 + hh * 64;
        typedef unsigned u32x2 __attribute__((ext_vector_type(2)));
#pragma unroll
        for (int dt = 0; dt < 2; ++dt)
#pragma unroll
            for (int c = 0; c < 4; ++c) {
                const int d = dt * 32 + 8 * c + 4 * h;
                const u32x2 zv = *(const u32x2*)(zb + d);
                const float z0 = __uint_as_float(zv.x << 16), z1 = __uint_as_float(zv.x & 0xffff0000u), z2 = __uint_as_float(zv.y << 16), z3 = __uint_as_float(zv.y & 0xffff0000u);
                u32x2 w; w.x = pk_bf16(res[dt][4 * c + 0] * silu_f(z0), res[dt][4 * c + 1] * silu_f(z1)); w.y = pk_bf16(res[dt][4 * c + 2] * silu_f(z2), res[dt][4 * c + 3] * silu_f(z3));
                *(u32x2*)(dst + d) = w;
            }
    }
}

constexpr int XSH_ROWS = 16640;
__device__ __forceinline__ float wave_sum(float v) {
#pragma unroll
    for (int o = 32; o > 0; o >>= 1) v += __shfl_xor(v, o);
    return v;
}
__device__ __forceinline__ void ld_row16(const float* __restrict__ src, int lane, float (&x)[16]) {
#pragma unroll
    for (int q = 0; q < 4; ++q) { const float4 v = *(const float4*)(src + q * 256 + lane * 4); x[4 * q] = v.x; x[4 * q + 1] = v.y; x[4 * q + 2] = v.z; x[4 * q + 3] = v.w; }
}
__device__ __forceinline__ void ln_calc16(const float* __restrict__ g, const float* __restrict__ bta, int lane, float (&x)[16]) {
    float sm = 0.f;
#pragma unroll
    for (int i = 0; i < 16; ++i) sm += x[i];
    const float mean = wave_sum(sm) * (1.f / 1024.f);
    float sq = 0.f;
#pragma unroll
    for (int i = 0; i < 16; ++i) { x[i] -= mean; sq += x[i] * x[i]; }
    const float rs = rsqrtf(wave_sum(sq) * (1.f / 1024.f) + LN_EPS);
#pragma unroll
    for (int q = 0; q < 4; ++q) {
        const float4 gv = *(const float4*)(g + q * 256 + lane * 4), bv = *(const float4*)(bta + q * 256 + lane * 4);
        x[4 * q] = x[4 * q] * rs * gv.x + bv.x; x[4 * q + 1] = x[4 * q + 1] * rs * gv.y + bv.y; x[4 * q + 2] = x[4 * q + 2] * rs * gv.z + bv.z; x[4 * q + 3] = x[4 * q + 3] * rs * gv.w + bv.w;
    }
}
__device__ __forceinline__ void ln_row16(const float* __restrict__ src, const float* __restrict__ g, const float* __restrict__ bta, int lane, float (&x)[16]) {
    ld_row16(src, lane, x); ln_calc16(g, bta, lane, x);
}
__device__ __forceinline__ void store_x1_xsh(const Args& a, unsigned char* ws, size_t row, size_t xrow, int lane, const float (&cur)[16], const float (&prev)[16]) {
#pragma unroll 1
    for (int n = 0; n < 6; ++n) {
        const float* mu = a.in[I_MU] + n * 1024 + lane * 4;
        bf16_t* dst = (bf16_t*)(ws + NB_XSH) + ((size_t)n * XSH_ROWS + xrow) * 1024 + lane * 4;
        typedef unsigned u32x2 __attribute__((ext_vector_type(2)));
#pragma unroll
        for (int q = 0; q < 4; ++q) { const float4 m4 = *(const float4*)(mu + q * 256);
            u32x2 w; w.x = pk_bf16(fmaf(prev[4 * q] - cur[4 * q], m4.x, cur[4 * q]), fmaf(prev[4 * q + 1] - cur[4 * q + 1], m4.y, cur[4 * q + 1]));
            w.y = pk_bf16(fmaf(prev[4 * q + 2] - cur[4 * q + 2], m4.z, cur[4 * q + 2]), fmaf(prev[4 * q + 3] - cur[4 * q + 3], m4.w, cur[4 * q + 3]));
            *(u32x2*)(dst + q * 256) = w; }
    }
}
__device__ __forceinline__ void phase_lns(const Args& a, unsigned char* ws, int bid, int nb) {
    const int tid = opaque_v(threadIdx.x), lane = tid & 63, wv = tid >> 6;
    const float* PRE = (const float*)ws + WS_PRE;
    const float* g = a.in[I_LNG]; const float* bta = a.in[I_LNB];
    for (int blk = bid; blk < 256; blk += nb) {
        const int r0 = blk * 64 + wv * 8;
        float prev[16], cur[16];
        if ((r0 & (TP - 1)) == 0) {
#pragma unroll
            for (int i = 0; i < 16; ++i) prev[i] = 0.f;
        } else ln_row16(PRE + (size_t)(r0 - 1) * 1024, g, bta, lane, prev);
        float nxt[16];
        ld_row16(PRE + (size_t)r0 * 1024, lane, nxt);
#pragma unroll 1
        for (int k = 0; k < 8; ++k) {
            const int row = r0 + k;
#pragma unroll
            for (int i = 0; i < 16; ++i) cur[i] = nxt[i];
            if (k + 1 < 8) ld_row16(PRE + (size_t)(row + 1) * 1024, lane, nxt);
            ln_calc16(g, bta, lane, cur);
            store_x1_xsh(a, ws, row, row, lane, cur, prev);
            if ((row & (TP - 1)) == TP - 1) {
                float* so = a.out + O_SHP + (size_t)(row >> 11) * 1024 + lane * 4;
#pragma unroll
                for (int q = 0; q < 4; ++q) *(float4*)(so + q * 256) = make_float4(cur[4 * q], cur[4 * q + 1], cur[4 * q + 2], cur[4 * q + 3]);
            }
#pragma unroll
            for (int i = 0; i < 16; ++i) prev[i] = cur[i];
        }
    }
    for (int s = bid * 8 + wv; s < BS; s += nb * 8) {
        float prev[16], cur[16];
        const float* sp = a.in[I_SSHIFT] + (size_t)s * 1024 + lane * 4;
#pragma unroll
        for (int q = 0; q < 4; ++q) { const float4 v = *(const float4*)(sp + q * 256); prev[4 * q] = v.x; prev[4 * q + 1] = v.y; prev[4 * q + 2] = v.z; prev[4 * q + 3] = v.w; }
        ln_row16(PRE + (size_t)(MP + s) * 1024, g, bta, lane, cur);
        store_x1_xsh(a, ws, MP + s, MP + s, lane, cur, prev);
        float* so = a.out + O_SHS + (size_t)s * 1024 + lane * 4;
#pragma unroll
        for (int q = 0; q < 4; ++q) *(float4*)(so + q * 256) = make_float4(cur[4 * q], cur[4 * q + 1], cur[4 * q + 2], cur[4 * q + 3]);
    }
}

struct Order3 {
    pg8::StaticOrder so;
    __device__ void init(int G, int c) { so.init(MP, 4096, G, c); }
    __device__ bool next(int i, Unit& u) const { Unit v; if (!so.next(i, v)) return false; const int n = v.pn >> 2; u.pm = n * 65 + v.pm; u.pn = v.pn; return true; }
    __device__ __forceinline__ void a_ready(const Unit&) const {}
    __device__ __forceinline__ void done(const Unit&) const {}
};
struct Epi3 {
    static constexpr bool PERM = true, AFTER_DRAIN = false;
    bf16_t* O;
    __device__ __forceinline__ void operator()(const f32x4 (&acc)[2][2][4][2], const Unit& u, int wr, int wc, int fr, int fq) const {
        const int n = u.pn >> 2, pm = u.pm - n * 65, pn = u.pn & 3;
        const int row0 = pm * 256 + wr * 64 + fr, col0 = pn * 256 + wc * 32 + 8 * fq;
        bf16_t* base = O + (size_t)n * XSH_ROWS * 1024;
#pragma unroll
        for (int ai = 0; ai < 2; ++ai)
#pragma unroll
            for (int m = 0; m < 4; ++m) { bf16_t* rowp = base + (size_t)(row0 + ai * 128 + m * 16) * 1024 + col0;
#pragma unroll
                for (int bj = 0; bj < 2; ++bj) { const f32x4 v0 = acc[ai][bj][m][0], v1 = acc[ai][bj][m][1];
                    u32x4 w; w.x = pk_bf16c(v0[0], v0[1]); w.y = pk_bf16c(v0[2], v0[3]); w.z = pk_bf16c(v1[0], v1[1]); w.w = pk_bf16c(v1[2], v1[3]);
                    *(u32x4*)(rowp + bj * 128) = w; } }
    }
};
struct EpiPreRes {
    static constexpr bool PERM = false, AFTER_DRAIN = false;
    float* C; const float* X;
    __device__ __forceinline__ void operator()(const f32x4 (&acc)[2][2][4][2], const Unit& u, int wr, int wc, int fr, int fq) const {
        const int row0 = u.pm * 256 + wr * 64 + fr, col0 = u.pn * 256 + wc * 32 + 4 * fq;
#pragma unroll
        for (int ai = 0; ai < 2; ++ai)
#pragma unroll
            for (int m = 0; m < 4; ++m) { const size_t off = (size_t)(row0 + ai * 128 + m * 16) * 1024 + col0;
#pragma unroll
                for (int bj = 0; bj < 2; ++bj)
#pragma unroll
                    for (int n = 0; n < 2; ++n) { const f32x4 xv = *(const f32x4*)(X + off + bj * 128 + n * 16); *(f32x4*)(C + off + bj * 128 + n * 16) = acc[ai][bj][m][n] + xv * ALPHA; } }
    }
};

constexpr int LR_A = 0;
constexpr int LR_P = 67584;
struct LoraRegs { u32x4 v[8]; };
__device__ __forceinline__ void lora_load(unsigned char* ws, int task, int tid, LoraRegs& r) {
    const int rt = task >> 1, which = task & 1;
    const bf16_t* A = (const bf16_t*)(ws + NB_XSH) + ((size_t)(4 + which) * XSH_ROWS + (size_t)rt * 32) * 1024;
#pragma unroll
    for (int i = 0; i < 8; ++i) { const int idx = tid + i * NTH; r.v[i] = *(const u32x4*)(A + (size_t)(idx >> 7) * 1024 + (idx & 127) * 8); }
}
__device__ __forceinline__ void lora_tile(unsigned char* ws, PG8_LAS unsigned char* lds, int task, int tid, const LoraRegs& r) {
    const int rt = task >> 1, which = task & 1;
    const int lane = tid & 63, wv = tid >> 6, lr = lane & 31, h = lane >> 5;
    PG8_LAS bf16_t* AT = (PG8_LAS bf16_t*)(lds + LR_A);
    PG8_LAS float* P = (PG8_LAS float*)(lds + LR_P);
#pragma unroll
    for (int i = 0; i < 8; ++i) { const int idx = tid + i * NTH; *(PG8_LAS u32x4*)(AT + (idx >> 7) * 1032 + (idx & 127) * 8) = r.v[i]; }
    __syncthreads();
    const bf16_t* Bt = (const bf16_t*)(ws + (which ? NB_A1T : NB_W1T));
    f32x16 acc0, acc1;
#pragma unroll
    for (int i = 0; i < 16; ++i) { acc0[i] = 0.f; acc1[i] = 0.f; }
#pragma unroll
    for (int s = 0; s < 8; ++s) {
        const int k = wv * 128 + s * 16 + h * 8;
        const bf16x8 av = *(const PG8_LAS bf16x8*)(AT + lr * 1032 + k);
        const bf16x8 b0 = *(const bf16x8*)(Bt + (size_t)lr * 1024 + k), b1 = *(const bf16x8*)(Bt + (size_t)(32 + lr) * 1024 + k);
        acc0 = __builtin_amdgcn_mfma_f32_32x32x16_bf16(av, b0, acc0, 0, 0, 0);
        acc1 = __builtin_amdgcn_mfma_f32_32x32x16_bf16(av, b1, acc1, 0, 0, 0);
    }
#pragma unroll
    for (int q = 0; q < 4; ++q) {
        *(PG8_LAS f32x4*)(P + (wv * 64 + lane) * 32 + q * 4) = (f32x4){acc0[4 * q], acc0[4 * q + 1], acc0[4 * q + 2], acc0[4 * q + 3]};
        *(PG8_LAS f32x4*)(P + (wv * 64 + lane) * 32 + 16 + q * 4) = (f32x4){acc1[4 * q], acc1[4 * q + 1], acc1[4 * q + 2], acc1[4 * q + 3]};
    }
    __syncthreads();
    if (wv < 2) {
        float sum[16];
#pragma unroll
        for (int i = 0; i < 16; ++i) sum[i] = 0.f;
#pragma unroll
        for (int w = 0; w < 8; ++w)
#pragma unroll
            for (int q = 0; q < 4; ++q) { const f32x4 v = *(const PG8_LAS f32x4*)(P + (w * 64 + lane) * 32 + wv * 16 + q * 4); sum[4 * q] += v[0]; sum[4 * q + 1] += v[1]; sum[4 * q + 2] += v[2]; sum[4 * q + 3] += v[3]; }
        bf16_t* dst = (bf16_t*)(ws + (which ? NB_AWB : NB_TWB)) + (size_t)rt * 32 * 64 + wv * 32 + lr;
#pragma unroll
        for (int i = 0; i < 16; ++i) { const int row = (i & 3) + 8 * (i >> 2) + 4 * h; const float v = which ? sum[i] : tanhf(sum[i]); dst[(size_t)row * 64] = (bf16_t)(pk_bf16c(v, 0.f) & 0xffffu); }
    }
    __syncthreads();
}

__device__ __forceinline__ float dpp_red16f(float v) {
    v += __builtin_bit_cast(float, __builtin_amdgcn_update_dpp(0, __builtin_bit_cast(int, v), 0xB1, 0xF, 0xF, true));
    v += __builtin_bit_cast(float, __builtin_amdgcn_update_dpp(0, __builtin_bit_cast(int, v), 0x4E, 0xF, 0xF, true));
    v += __builtin_bit_cast(float, __builtin_amdgcn_update_dpp(0, __builtin_bit_cast(int, v), 0x141, 0xF, 0xF, true));
    v += __builtin_bit_cast(float, __builtin_amdgcn_update_dpp(0, __builtin_bit_cast(int, v), 0x140, 0xF, 0xF, true));
    return v;
}
__device__ __forceinline__ void prep2_task(const Args& a, unsigned char* ws, int rt, int hd, int lane) {
    const int lr = lane & 31, h2 = lane >> 5;
    const size_t row0 = (size_t)rt * 32;
    const bf16_t* W2T = (const bf16_t*)(ws + NB_W2T); const bf16_t* A2T = (const bf16_t*)(ws + NB_A2T);
    const bf16_t* TWB = (const bf16_t*)(ws + NB_TWB); const bf16_t* AWB = (const bf16_t*)(ws + NB_AWB);
    f32x16 aw[2], aa[2];
#pragma unroll
    for (int ct = 0; ct < 2; ++ct)
#pragma unroll
        for (int i = 0; i < 16; ++i) { aw[ct][i] = 0.f; aa[ct][i] = 0.f; }
#pragma unroll
    for (int s = 0; s < 4; ++s) {
        const bf16x8 at = *(const bf16x8*)(TWB + (row0 + lr) * 64 + s * 16 + h2 * 8), aa_ = *(const bf16x8*)(AWB + (row0 + lr) * 64 + s * 16 + h2 * 8);
#pragma unroll
        for (int ct = 0; ct < 2; ++ct) {
            const size_t e = (size_t)hd * 64 + ct * 32 + lr;
            const bf16x8 w2 = *(const bf16x8*)(W2T + e * 64 + s * 16 + h2 * 8), a2 = *(const bf16x8*)(A2T + e * 64 + s * 16 + h2 * 8);
            aw[ct] = __builtin_amdgcn_mfma_f32_32x32x16_bf16(at, w2, aw[ct], 0, 0, 0);
            aa[ct] = __builtin_amdgcn_mfma_f32_32x32x16_bf16(aa_, a2, aa[ct], 0, 0, 0);
        }
    }
    const bf16_t* KB = (const bf16_t*)(ws + NB_RKVZ) + (size_t)1 * XSH_ROWS * 1024;
    const bf16_t* RB = (const bf16_t*)(ws + NB_RKVZ);
    float* DEC = (float*)(ws + NB_DEC);
    bf16_t* KKN = (bf16_t*)(ws + NB_KKN); bf16_t* KKA = (bf16_t*)(ws + NB_KKA); bf16_t* KP = (bf16_t*)(ws + NB_KP);
    float w0v[2], a0v[2], kkp[2], kap[2], rkp[2];
#pragma unroll
    for (int ct = 0; ct < 2; ++ct) { const int e = hd * 64 + ct * 32 + lr; w0v[ct] = a.in[I_W0][e]; a0v[ct] = a.in[I_A0][e]; kkp[ct] = a.in[I_KK][e]; kap[ct] = a.in[I_KA][e]; rkp[ct] = a.in[I_RK][e]; }
    float n2[16], rk[16];
#pragma unroll
    for (int i = 0; i < 16; ++i) { n2[i] = 0.f; rk[i] = 0.f; }
#pragma unroll
    for (int ct = 0; ct < 2; ++ct)
#pragma unroll
        for (int i = 0; i < 16; ++i) {
            const size_t off = (row0 + (i & 3) + 8 * (i >> 2) + 4 * h2) * 1024 + hd * 64 + ct * 32 + lr;
            const float kf = bf2f(KB[off]), rf = bf2f(RB[off]);
            const float wl = w0v[ct] + aw[ct][i];
            const float sp = fmaxf(-wl, 0.f) + log1pf(__expf(-fabsf(wl)));
            DEC[off] = __expf(-__expf(-sp - 0.5f));
            const float av_ = sigm_f(a0v[ct] + aa[ct][i]);
            const float kk = kf * kkp[ct];
            const float kp = kf * (1.f + (av_ - 1.f) * kap[ct]);
            KP[off] = (bf16_t)(pk_bf16(kp, 0.f) & 0xffffu);
            aw[ct][i] = kk; aa[ct][i] = av_;
            n2[i] = fmaf(kk, kk, n2[i]);
            rk[i] = fmaf(rf * kp, rkp[ct], rk[i]);
        }
#pragma unroll
    for (int i = 0; i < 16; ++i) {
        float v = dpp_red16f(n2[i]); v += __shfl_xor(v, 16); n2[i] = 1.f / fmaxf(sqrtf(v), 1e-12f);
        float w = dpp_red16f(rk[i]); w += __shfl_xor(w, 16); rk[i] = w;
    }
#pragma unroll
    for (int ct = 0; ct < 2; ++ct)
#pragma unroll
        for (int i = 0; i < 16; ++i) {
            const size_t off = (row0 + (i & 3) + 8 * (i >> 2) + 4 * h2) * 1024 + hd * 64 + ct * 32 + lr;
            const float kn = aw[ct][i] * n2[i];
            KKN[off] = (bf16_t)(pk_bf16(kn, 0.f) & 0xffffu);
            KKA[off] = (bf16_t)(pk_bf16(kn * aa[ct][i], 0.f) & 0xffffu);
        }
    if (lr == 0) {
#pragma unroll
        for (int i = 0; i < 16; ++i) ((float*)(ws + NB_RKS))[(row0 + (i & 3) + 8 * (i >> 2) + 4 * h2) * 16 + hd] = rk[i];
    }
}

constexpr int SC_BUF = 53248;
__device__ __forceinline__ float dpp_red16(float v) {
    v += __builtin_bit_cast(float, __builtin_amdgcn_update_dpp(0, __builtin_bit_cast(int, v), 0xB1, 0xF, 0xF, true));
    v += __builtin_bit_cast(float, __builtin_amdgcn_update_dpp(0, __builtin_bit_cast(int, v), 0x4E, 0xF, 0xF, true));
    v += __builtin_bit_cast(float, __builtin_amdgcn_update_dpp(0, __builtin_bit_cast(int, v), 0x141, 0xF, 0xF, true));
    v += __builtin_bit_cast(float, __builtin_amdgcn_update_dpp(0, __builtin_bit_cast(int, v), 0x140, 0xF, 0xF, true));
    return v;
}
struct ScanRegs { u32x4 d0, d1, kn, ka, kp, r, v; };
__device__ __forceinline__ void scan_issue(unsigned char* ws, int b, int hd, int vh, int chunk, int tid, ScanRegs& g) {
    const int tt = tid >> 3, part = tid & 7;
    const size_t row = (size_t)b * TP + chunk * 64 + tt;
    const size_t off = row * 1024 + hd * 64 + part * 8;
    const float* dp = (const float*)(ws + NB_DEC) + off;
    g.d0 = *(const u32x4*)dp; g.d1 = *(const u32x4*)(dp + 4);
    g.kn = *(const u32x4*)((const bf16_t*)(ws + NB_KKN) + off);
    g.ka = *(const u32x4*)((const bf16_t*)(ws + NB_KKA) + off);
    g.kp = *(const u32x4*)((const bf16_t*)(ws + NB_KP) + off);
    g.r = *(const u32x4*)((const bf16_t*)(ws + NB_RKVZ) + ((size_t)0 * XSH_ROWS + row) * 1024 + hd * 64 + part * 8);
    if (part < 4) g.v = *(const u32x4*)((const bf16_t*)(ws + NB_RKVZ) + ((size_t)2 * XSH_ROWS + row) * 1024 + hd * 64 + vh * 32 + part * 8);
}
__device__ __forceinline__ void scan_write(PG8_LAS unsigned char* buf, int tid, const ScanRegs& g) {
    const int tt = tid >> 3, part = tid & 7;
    *(PG8_LAS u32x4*)(buf + tt * 256 + part * 32) = g.d0; *(PG8_LAS u32x4*)(buf + tt * 256 + part * 32 + 16) = g.d1;
    *(PG8_LAS u32x4*)(buf + 16384 + tt * 128 + part * 16) = g.kn;
    *(PG8_LAS u32x4*)(buf + 24576 + tt * 128 + part * 16) = g.ka;
    *(PG8_LAS u32x4*)(buf + 32768 + tt * 128 + part * 16) = g.kp;
    *(PG8_LAS u32x4*)(buf + 40960 + tt * 128 + part * 16) = g.r;
    if (part < 4) *(PG8_LAS u32x4*)(buf + 49152 + tt * 64 + part * 16) = g.v;
}
__device__ __forceinline__ void scan_prompt(const Args& a, unsigned char* ws, PG8_LAS unsigned char* lds, int item) {
    const int tid = opaque_v(threadIdx.x);
    const int b = item >> 5, hd = (item >> 1) & 15, vh = item & 1;
    const int vl = tid >> 4, kq = tid & 15;
    typedef unsigned u32x2 __attribute__((ext_vector_type(2)));
    float S[4] = {0.f, 0.f, 0.f, 0.f};
    ScanRegs g;
    PG8_LAS float* YS = (PG8_LAS float*)(lds + 2 * SC_BUF);
    scan_issue(ws, b, hd, vh, 0, tid, g); scan_write(lds, tid, g);
    __syncthreads();
    for (int c = 0; c < TP / 64; ++c) {
        PG8_LAS unsigned char* buf = lds + (c & 1) * SC_BUF;
        if (c + 1 < TP / 64) scan_issue(ws, b, hd, vh, c + 1, tid, g);
#pragma unroll 4
        for (int tt = 0; tt < 64; ++tt) {
            const f32x4 w = *(const PG8_LAS f32x4*)(buf + tt * 256 + kq * 16);
            const u32x2 knw = *(const PG8_LAS u32x2*)(buf + 16384 + tt * 128 + kq * 8), kaw = *(const PG8_LAS u32x2*)(buf + 24576 + tt * 128 + kq * 8),
                        kpw = *(const PG8_LAS u32x2*)(buf + 32768 + tt * 128 + kq * 8), rw = *(const PG8_LAS u32x2*)(buf + 40960 + tt * 128 + kq * 8);
            const float vv = bf2f(*(const PG8_LAS bf16_t*)(buf + 49152 + tt * 64 + vl * 2));
            const float kn[4] = {__uint_as_float(knw.x << 16), __uint_as_float(knw.x & 0xffff0000u), __uint_as_float(knw.y << 16), __uint_as_float(knw.y & 0xffff0000u)};
            const float ka[4] = {__uint_as_float(kaw.x << 16), __uint_as_float(kaw.x & 0xffff0000u), __uint_as_float(kaw.y << 16), __uint_as_float(kaw.y & 0xffff0000u)};
            const float kp[4] = {__uint_as_float(kpw.x << 16), __uint_as_float(kpw.x & 0xffff0000u), __uint_as_float(kpw.y << 16), __uint_as_float(kpw.y & 0xffff0000u)};
            const float rr[4] = {__uint_as_float(rw.x << 16), __uint_as_float(rw.x & 0xffff0000u), __uint_as_float(rw.y << 16), __uint_as_float(rw.y & 0xffff0000u)};
            float sa = S[0] * kn[0];
            sa = fmaf(S[1], kn[1], sa); sa = fmaf(S[2], kn[2], sa); sa = fmaf(S[3], kn[3], sa);
            sa = dpp_red16(sa);
            float y = 0.f;
#pragma unroll
            for (int i = 0; i < 4; ++i) { S[i] = fmaf(S[i], w[i], fmaf(vv, kp[i], -sa * ka[i])); y = fmaf(S[i], rr[i], y); }
            y = dpp_red16(y);
            if (kq == 0) YS[tt * 32 + vl] = y;
        }
        if (c + 1 < TP / 64) scan_write(lds + ((c + 1) & 1) * SC_BUF, tid, g);
        __syncthreads();
        {
            float* Y = (float*)(ws + NB_Y);
            for (int i = tid; i < 64 * 32; i += NTH) { const int tt = i >> 5, v = i & 31; Y[((size_t)b * TP + c * 64 + tt) * 1024 + hd * 64 + vh * 32 + v] = YS[i]; }
        }
        __syncthreads();
    }
    float* so = a.out + O_WKVP + ((size_t)(b * 16 + hd) * 64 + vh * 32 + vl) * 64 + kq * 4;
    *(float4*)so = make_float4(S[0], S[1], S[2], S[3]);
}
__device__ __forceinline__ void scan_sample(const Args& a, unsigned char* ws, int s, int hd, int lane) {
    const size_t row = (size_t)MP + s;
    const float* s0 = a.in[I_SWKV] + ((size_t)(s * 16 + hd) * 64 + lane) * 64;
    float* sout = a.out + O_WKVS + ((size_t)(s * 16 + hd) * 64 + lane) * 64;
    const float decl = ((const float*)(ws + NB_DEC) + row * 1024 + hd * 64)[lane];
    const float knl = bf2f(((const bf16_t*)(ws + NB_KKN) + row * 1024 + hd * 64)[lane]);
    const float kal = bf2f(((const bf16_t*)(ws + NB_KKA) + row * 1024 + hd * 64)[lane]);
    const float kpl = bf2f(((const bf16_t*)(ws + NB_KP) + row * 1024 + hd * 64)[lane]);
    const float rl = bf2f(((const bf16_t*)(ws + NB_RKVZ) + ((size_t)0 * XSH_ROWS + row) * 1024 + hd * 64)[lane]);
    const float vv = bf2f(((const bf16_t*)(ws + NB_RKVZ) + ((size_t)2 * XSH_ROWS + row) * 1024 + hd * 64)[lane]);
    float S[64];
#pragma unroll
    for (int q = 0; q < 16; ++q) { const float4 v4 = *(const float4*)(s0 + q * 4); S[4 * q] = v4.x; S[4 * q + 1] = v4.y; S[4 * q + 2] = v4.z; S[4 * q + 3] = v4.w; }
#define RL(X, K) __builtin_bit_cast(float, __builtin_amdgcn_readlane(__builtin_bit_cast(int, X), K))
    float sa = 0.f;
#pragma unroll
    for (int k = 0; k < 64; ++k) sa = fmaf(S[k], RL(knl, k), sa);
    float y = 0.f;
#pragma unroll
    for (int k = 0; k < 64; ++k) { S[k] = fmaf(S[k], RL(decl, k), fmaf(vv, RL(kpl, k), -sa * RL(kal, k))); y = fmaf(S[k], RL(rl, k), y); }
#undef RL
#pragma unroll
    for (int q = 0; q < 16; ++q) *(float4*)(sout + q * 4) = make_float4(S[4 * q], S[4 * q + 1], S[4 * q + 2], S[4 * q + 3]);
    {
        const float mean = wave_sum(y) * (1.f / 64.f);
        const float d = y - mean;
        const float rs = rsqrtf(wave_sum(d * d) * (1.f / 64.f) + GN_EPS);
        const int e = hd * 64 + lane;
        const float rkv = ((const float*)(ws + NB_RKS))[row * 16 + hd];
        const float zf = bf2f(((const bf16_t*)(ws + NB_RKVZ) + ((size_t)3 * XSH_ROWS + row) * 1024)[e]);
        const float o = fmaf(rkv, vv, d * rs * a.in[I_GNG][e] + a.in[I_GNB][e]) * silu_f(zf);
        ((bf16_t*)(ws + NB_G4B))[row * 1024 + e] = (bf16_t)(pk_bf16c(o, 0.f) & 0xffffu);
    }
}

constexpr int CS_LD = 72;
constexpr int CS_SLOT = 64 * CS_LD * 2;
constexpr int CS_F32A = 13 * CS_SLOT;
constexpr int CS_F32B = CS_F32A + 16384;
constexpr int CS_GS = CS_F32B + 16384;
constexpr int CS_END = CS_GS + 4096;
constexpr size_t CK_MCT = 0, CK_RY = 8192, CK_SADD = 16384, CK_Y0 = 24576, CK_BYTES = 32768;

__device__ __forceinline__ PG8_LAS bf16_t* cs_slot(PG8_LAS unsigned char* lds, int i) { return (PG8_LAS bf16_t*)(lds + i * CS_SLOT); }
template <bool SWX = false, bool SWY = false>
__device__ __forceinline__ void cs_mm(f32x16& acc, const PG8_LAS bf16_t* X, const PG8_LAS bf16_t* Yt, int mt, int nt, int lane) {
    const int lr = lane & 31, h = lane >> 5;
    const int rx = mt * 32 + lr, ry = nt * 32 + lr;
    const int sx = SWX ? ((rx >> 3) & 7) : 0, sy = SWY ? ((ry >> 3) & 7) : 0;
#pragma unroll
    for (int s = 0; s < 4; ++s) {
        const bf16x8 av = *(const PG8_LAS bf16x8*)(X + rx * CS_LD + (((2 * s + h) ^ sx) << 3));
        const bf16x8 bv = *(const PG8_LAS bf16x8*)(Yt + ry * CS_LD + (((2 * s + h) ^ sy) << 3));
        acc = __builtin_amdgcn_mfma_f32_32x32x16_bf16(av, bv, acc, 0, 0, 0);
    }
}
__device__ __forceinline__ void cs_store_t(const f32x16& acc, PG8_LAS bf16_t* D, int mt, int nt, int lane) {
    typedef unsigned u32x2 __attribute__((ext_vector_type(2)));
    const int lr = lane & 31, h = lane >> 5;
#pragma unroll
    for (int c = 0; c < 4; ++c) { u32x2 w; w.x = pk_bf16c(acc[4 * c], acc[4 * c + 1]); w.y = pk_bf16c(acc[4 * c + 2], acc[4 * c + 3]);
        *(PG8_LAS u32x2*)(D + (nt * 32 + lr) * CS_LD + mt * 32 + 8 * c + 4 * h) = w; }
}
__device__ __forceinline__ void cs_store_n(const f32x16& acc, PG8_LAS bf16_t* D, int mt, int nt, int lane) {
    const int lr = lane & 31, h = lane >> 5;
#pragma unroll
    for (int i = 0; i < 16; ++i) D[(mt * 32 + (i & 3) + 8 * (i >> 2) + 4 * h) * CS_LD + nt * 32 + lr] = (bf16_t)(pk_bf16c(acc[i], 0.f) & 0xffffu);
}
__device__ __forceinline__ void cs_zero(f32x16& a) {
#pragma unroll
    for (int i = 0; i < 16; ++i) a[i] = 0.f;
}
__device__ __forceinline__ float dpp_red8(float v) {
    v += __builtin_bit_cast(float, __builtin_amdgcn_update_dpp(0, __builtin_bit_cast(int, v), 0xB1, 0xF, 0xF, true));
    v += __builtin_bit_cast(float, __builtin_amdgcn_update_dpp(0, __builtin_bit_cast(int, v), 0x4E, 0xF, 0xF, true));
    v += __builtin_bit_cast(float, __builtin_amdgcn_update_dpp(0, __builtin_bit_cast(int, v), 0x141, 0xF, 0xF, true));
    return v;
}

struct PreRegs { u32x4 kv, rv, vv; bf16x8 af[4]; };
__device__ __forceinline__ void scanpre_load(unsigned char* ws, int b, int hd, int c, int tid, PreRegs& r) {
    const int lane = tid & 63, wv = tid >> 6, lr = lane & 31, h = lane >> 5;
    const size_t row0 = (size_t)b * TP + c * 64;
    const int tok = tid >> 3, c8 = tid & 7;
    const size_t off = (row0 + tok) * 1024 + hd * 64 + c8 * 8;
    const bf16_t* RK = (const bf16_t*)(ws + NB_RKVZ);
    r.kv = *(const u32x4*)(RK + (size_t)1 * XSH_ROWS * 1024 + off); r.rv = *(const u32x4*)(RK + off); r.vv = *(const u32x4*)(RK + (size_t)2 * XSH_ROWS * 1024 + off);
    const int which = wv >> 2, mt = (wv >> 1) & 1;
    const bf16_t* A = (const bf16_t*)(ws + (which ? NB_AWB : NB_TWB)) + (row0 + mt * 32 + lr) * 64 + h * 8;
#pragma unroll
    for (int s = 0; s < 4; ++s) r.af[s] = *(const bf16x8*)(A + s * 16);
}
__device__ __forceinline__ void scanpre_chunk(const Args& a, unsigned char* ws, PG8_LAS unsigned char* lds, int b, int hd, int c, const PreRegs& pre, const bf16x8 (&btf)[4]) {
    const int tid = opaque_v(threadIdx.x), lane = tid & 63, wv = __builtin_amdgcn_readfirstlane(tid >> 6);
    const int lr = lane & 31, h = lane >> 5;
    const size_t row0 = (size_t)b * TP + c * 64;
    typedef unsigned u32x2 __attribute__((ext_vector_type(2)));
    PG8_LAS float* LCUM = (PG8_LAS float*)(lds + CS_F32A);
    PG8_LAS float* AV = (PG8_LAS float*)(lds + CS_F32B);
    PG8_LAS float* GS = (PG8_LAS float*)(lds + CS_GS);
    unsigned char* rec = ws + NB_CHK + ((size_t)(b * 16 + hd) * 32 + c) * CK_BYTES;
    {
        const int tok = tid >> 3, c8 = tid & 7;
        *(PG8_LAS u32x4*)(cs_slot(lds, 0) + tok * CS_LD + c8 * 8) = pre.kv;
        *(PG8_LAS u32x4*)(cs_slot(lds, 1) + tok * CS_LD + c8 * 8) = pre.rv;
        *(PG8_LAS u32x4*)(cs_slot(lds, 2) + tok * CS_LD + c8 * 8) = pre.vv;
    }
    {
        const int which = wv >> 2, mt = (wv >> 1) & 1, nt = wv & 1;
        f32x16 acc; cs_zero(acc);
#pragma unroll
        for (int s = 0; s < 4; ++s) acc = __builtin_amdgcn_mfma_f32_32x32x16_bf16(pre.af[s], btf[s], acc, 0, 0, 0);
        PG8_LAS float* D = which ? AV : LCUM;
        const float bias = a.in[which ? I_A0 : I_W0][hd * 64 + nt * 32 + lr];
#pragma unroll
        for (int i = 0; i < 16; ++i) {
            const float x = acc[i] + bias;
            float y;
            if (which) y = sigm_f(x);
            else y = -0.87503504f * sigm_f(x);
            D[(mt * 32 + (i & 3) + 8 * (i >> 2) + 4 * h) * 64 + nt * 32 + lr] = y;
        }
    }
    lds_barrier();
    {
        const int ch = tid & 63, tg = tid >> 6;
        float p[8]; float run = 0.f;
#pragma unroll
        for (int i = 0; i < 8; ++i) { run += LCUM[(tg * 8 + i) * 64 + ch]; p[i] = run; }
        GS[tg * 64 + ch] = run;
        lds_barrier();
        float offs = 0.f;
        for (int g = 0; g < tg; ++g) offs += GS[g * 64 + ch];
#pragma unroll
        for (int i = 0; i < 8; ++i) LCUM[(tg * 8 + i) * 64 + ch] = p[i] + offs;
    }
    lds_barrier();
    {
        const int tok = tid >> 3, c8 = tid & 7;
        const u32x4 kw = *(const PG8_LAS u32x4*)(cs_slot(lds, 0) + tok * CS_LD + c8 * 8), rw = *(const PG8_LAS u32x4*)(cs_slot(lds, 1) + tok * CS_LD + c8 * 8),
                    vw = *(const PG8_LAS u32x4*)(cs_slot(lds, 2) + tok * CS_LD + c8 * 8);
        float kf[8], rf[8], kk[8], kp[8], av[8];
        float n2 = 0.f, rk = 0.f;
#pragma unroll
        for (int i = 0; i < 8; ++i) {
            const int e = hd * 64 + c8 * 8 + i;
            kf[i] = __uint_as_float((i & 1) ? (kw[i >> 1] & 0xffff0000u) : (kw[i >> 1] << 16));
            rf[i] = __uint_as_float((i & 1) ? (rw[i >> 1] & 0xffff0000u) : (rw[i >> 1] << 16));
            av[i] = AV[tok * 64 + c8 * 8 + i];
            kk[i] = kf[i] * a.in[I_KK][e];
            kp[i] = kf[i] * (1.f + (av[i] - 1.f) * a.in[I_KA][e]);
            n2 = fmaf(kk[i], kk[i], n2);
            rk = fmaf(rf[i] * kp[i], a.in[I_RK][e], rk);
        }
        n2 = dpp_red8(n2); rk = dpp_red8(rk);
        const float inv = 1.f / fmaxf(sqrtf(n2), 1e-12f);
        if (c8 == 0) ((float*)(ws + NB_RKS))[(row0 + tok) * 16 + hd] = rk;
        if (tok == 63) {
#pragma unroll
            for (int i = 0; i < 8; ++i) GS[512 + c8 * 8 + i] = __builtin_amdgcn_exp2f(LCUM[63 * 64 + c8 * 8 + i]);
        }
        float qt[8], rt[8], kt[8], bt[8], kh[8], bh[8];
#pragma unroll
        for (int i = 0; i < 8; ++i) {
            const int ch = c8 * 8 + i;
            const float Lt = LCUM[tok * 64 + ch], Lp = tok ? LCUM[(tok - 1) * 64 + ch] : 0.f, Lc = LCUM[63 * 64 + ch];
            const float kn = kk[i] * inv, ka = kn * av[i];
            const float en = __builtin_amdgcn_exp2f(-Lt), ec = __builtin_amdgcn_exp2f(Lc - Lt);
            qt[i] = kn * __builtin_amdgcn_exp2f(Lp); rt[i] = rf[i] * __builtin_amdgcn_exp2f(Lt); kt[i] = kp[i] * en; bt[i] = ka * en; kh[i] = kp[i] * ec; bh[i] = ka * ec;
        }
#define CS_PUT_ROW(SLOT, ARR) { u32x4 w_; w_.x = pk_bf16c(ARR[0], ARR[1]); w_.y = pk_bf16c(ARR[2], ARR[3]); w_.z = pk_bf16c(ARR[4], ARR[5]); w_.w = pk_bf16c(ARR[6], ARR[7]); \
            *(PG8_LAS u32x4*)(cs_slot(lds, SLOT) + tok * CS_LD + c8 * 8) = w_; }
#define CS_PUT_COL(SLOT, ARR) { _Pragma("unroll") for (int i_ = 0; i_ < 8; ++i_) cs_slot(lds, SLOT)[(c8 * 8 + i_) * CS_LD + tsw] = (bf16_t)(pk_bf16c(ARR[i_], 0.f) & 0xffffu); }
        const int tsw = ((((tok >> 3) ^ c8) & 7) << 3) | (tok & 7);
        CS_PUT_ROW(3, qt) CS_PUT_ROW(4, rt) CS_PUT_ROW(5, kt) CS_PUT_ROW(6, bt)
        CS_PUT_COL(7, qt) CS_PUT_COL(8, bh) CS_PUT_COL(9, kh)
#pragma unroll
        for (int i = 0; i < 8; ++i) cs_slot(lds, 10)[(c8 * 8 + i) * CS_LD + tsw] = (bf16_t)((i & 1) ? (vw[i >> 1] >> 16) : (vw[i >> 1] & 0xffffu));
#undef CS_PUT_ROW
#undef CS_PUT_COL
    }
    lds_barrier();
    {
#pragma unroll 1
        for (int j = 0; j < 2; ++j) {
            const int job = wv * 2 + j, prod = job >> 2, mt = (job >> 1) & 1, nt = job & 1;
            const PG8_LAS bf16_t* X = cs_slot(lds, (prod & 1) ? 6 : 5);
            const PG8_LAS bf16_t* Y = cs_slot(lds, (prod & 2) ? 4 : 3);
            f32x16 acc; cs_zero(acc);
            cs_mm(acc, X, Y, mt, nt, lane);
            const int t = nt * 32 + lr, incl = (prod & 2) ? 1 : 0;
#pragma unroll
            for (int i = 0; i < 16; ++i) { const int sidx = mt * 32 + (i & 3) + 8 * (i >> 2) + 4 * h; acc[i] = (sidx < t + incl) ? acc[i] : 0.f; }
            const int dst = (prod == 0) ? 0 : (prod == 1) ? 11 : (prod == 2) ? 1 : 2;
            cs_store_t(acc, cs_slot(lds, dst), mt, nt, lane);
            if (prod == 1) cs_store_n(acc, cs_slot(lds, 12), mt, nt, lane);
        }
    }
    lds_barrier();
    {
        const int mt = (wv >> 1) & 1, nt = wv & 1;
        f32x16 pacc;
        if (wv < 4) {
#pragma unroll
            for (int i = 0; i < 16; ++i) { const int u = mt * 32 + (i & 3) + 8 * (i >> 2) + 4 * h, t = nt * 32 + lr;
                pacc[i] = ((u == t) ? 1.f : 0.f) - bf2f(cs_slot(lds, 12)[u * CS_LD + t]); }
            cs_store_t(pacc, cs_slot(lds, 3), mt, nt, lane);
        }
        lds_barrier();
        const int mcur = 11, mtcur = 12, mnxt = 5, mtnxt = 6;
        PG8_LAS bf16_t* XS0 = (PG8_LAS bf16_t*)(lds + CS_F32A);
        PG8_LAS bf16_t* XS1 = (PG8_LAS bf16_t*)(lds + CS_F32A + CS_SLOT);
        PG8_LAS bf16_t* XS2 = (PG8_LAS bf16_t*)(lds + CS_F32A + 2 * CS_SLOT);
        PG8_LAS bf16_t* Pc = cs_slot(lds, 3); PG8_LAS bf16_t* Pn = XS0;
        PG8_LAS bf16_t* Mc_ = cs_slot(lds, mcur); PG8_LAS bf16_t* MTc = cs_slot(lds, mtcur);
        PG8_LAS bf16_t* Mn = cs_slot(lds, mnxt); PG8_LAS bf16_t* MTn = cs_slot(lds, mtnxt);
#pragma unroll 1
        for (int it = 0; it < 5; ++it) {
            if (wv >= 4) {
                f32x16 acc; cs_zero(acc);
                cs_mm(acc, Mc_, MTc, mt, nt, lane);
                cs_store_n(acc, Mn, mt, nt, lane);
                cs_store_t(acc, MTn, mt, nt, lane);
                float mx = 0.f;
#pragma unroll
                for (int i = 0; i < 16; ++i) mx = fmaxf(mx, fabsf(acc[i]));
#pragma unroll
                for (int o = 32; o > 0; o >>= 1) mx = fmaxf(mx, __shfl_xor(mx, o));
                if (lane == 0) GS[640 + (wv & 3)] = mx;
            }
            lds_barrier();
            const float m2max = fmaxf(fmaxf(GS[640], GS[641]), fmaxf(GS[642], GS[643]));
            if (wv < 4) {
                cs_mm(pacc, MTn, Pc, mt, nt, lane);
                cs_store_t(pacc, Pn, mt, nt, lane);
            }
            lds_barrier();
            { PG8_LAS bf16_t* t0 = Mc_; Mc_ = Mn; Mn = t0; t0 = MTc; MTc = MTn; MTn = t0; t0 = Pc; Pc = Pn; Pn = t0; }
            if (m2max < 1e-7f) break;
        }
        {
            f32x16 acc; cs_zero(acc);
            if (wv < 4) { cs_mm<false, true>(acc, cs_slot(lds, 0), cs_slot(lds, 10), mt, nt, lane); cs_store_t(acc, XS1, mt, nt, lane); }
            else { cs_mm<false, true>(acc, Pc, cs_slot(lds, 7), mt, nt, lane); cs_store_t(acc, XS2, mt, nt, lane); }
        }
        lds_barrier();
        if (wv < 4) { f32x16 acc; cs_zero(acc); cs_mm(acc, Pc, XS1, mt, nt, lane); cs_store_t(acc, cs_slot(lds, 11), mt, nt, lane); }
        lds_barrier();
        if (wv < 4) {
            f32x16 acc; cs_zero(acc);
            cs_mm<false, true>(acc, XS2, cs_slot(lds, 8), mt, nt, lane);
#pragma unroll
            for (int i = 0; i < 16; ++i) { const int k = mt * 32 + (i & 3) + 8 * (i >> 2) + 4 * h, kp_ = nt * 32 + lr; acc[i] = ((k == kp_) ? GS[512 + k] : 0.f) - acc[i]; }
            bf16_t* mct = (bf16_t*)(rec + CK_MCT);
#pragma unroll
            for (int cc = 0; cc < 4; ++cc) { u32x2 w; w.x = pk_bf16c(acc[4 * cc], acc[4 * cc + 1]); w.y = pk_bf16c(acc[4 * cc + 2], acc[4 * cc + 3]);
                *(u32x2*)(mct + ((nt * 4 + 2 * mt + (cc >> 1)) * 64 + lr + 32 * (cc & 1)) * 8 + 4 * h) = w; }
            f32x16 s1, s2; cs_zero(s1); cs_zero(s2);
            cs_mm<true, true>(s1, cs_slot(lds, 9), cs_slot(lds, 10), mt, nt, lane);
            cs_mm<true, false>(s2, cs_slot(lds, 8), cs_slot(lds, 11), mt, nt, lane);
            bf16_t* sd = (bf16_t*)(rec + CK_SADD) + ((size_t)(wv & 3) * 64 + lane) * 16;
#pragma unroll
            for (int q8 = 0; q8 < 2; ++q8) { u32x4 w;
                w.x = pk_bf16c(s1[8 * q8] - s2[8 * q8], s1[8 * q8 + 1] - s2[8 * q8 + 1]); w.y = pk_bf16c(s1[8 * q8 + 2] - s2[8 * q8 + 2], s1[8 * q8 + 3] - s2[8 * q8 + 3]);
                w.z = pk_bf16c(s1[8 * q8 + 4] - s2[8 * q8 + 4], s1[8 * q8 + 5] - s2[8 * q8 + 5]); w.w = pk_bf16c(s1[8 * q8 + 6] - s2[8 * q8 + 6], s1[8 * q8 + 7] - s2[8 * q8 + 7]);
                *(u32x4*)(sd + q8 * 8) = w; }
        } else {
            f32x16 acc; cs_zero(acc);
            cs_mm(acc, XS2, cs_slot(lds, 2), mt, nt, lane);
            bf16_t* ry = (bf16_t*)(rec + CK_RY);
#pragma unroll
            for (int cc = 0; cc < 4; ++cc) {
                const u32x2 rv = *(const PG8_LAS u32x2*)(cs_slot(lds, 4) + (nt * 32 + lr) * CS_LD + mt * 32 + 8 * cc + 4 * h);
                const float r0 = __uint_as_float(rv.x << 16), r1 = __uint_as_float(rv.x & 0xffff0000u), r2 = __uint_as_float(rv.y << 16), r3 = __uint_as_float(rv.y & 0xffff0000u);
                u32x2 w; w.x = pk_bf16c(r0 - acc[4 * cc], r1 - acc[4 * cc + 1]); w.y = pk_bf16c(r2 - acc[4 * cc + 2], r3 - acc[4 * cc + 3]);
                *(u32x2*)(ry + ((nt * 4 + 2 * mt + (cc >> 1)) * 64 + lr + 32 * (cc & 1)) * 8 + 4 * h) = w;
            }
            f32x16 s1, s2; cs_zero(s1); cs_zero(s2);
            cs_mm<false, true>(s1, cs_slot(lds, 1), cs_slot(lds, 10), mt, nt, lane);
            cs_mm(s2, cs_slot(lds, 2), cs_slot(lds, 11), mt, nt, lane);
            bf16_t* yd = (bf16_t*)(rec + CK_Y0) + ((size_t)(wv & 3) * 64 + lane) * 16;
#pragma unroll
            for (int q8 = 0; q8 < 2; ++q8) { u32x4 w;
                w.x = pk_bf16c(s1[8 * q8] - s2[8 * q8], s1[8 * q8 + 1] - s2[8 * q8 + 1]); w.y = pk_bf16c(s1[8 * q8 + 2] - s2[8 * q8 + 2], s1[8 * q8 + 3] - s2[8 * q8 + 3]);
                w.z = pk_bf16c(s1[8 * q8 + 4] - s2[8 * q8 + 4], s1[8 * q8 + 5] - s2[8 * q8 + 5]); w.w = pk_bf16c(s1[8 * q8 + 6] - s2[8 * q8 + 6], s1[8 * q8 + 7] - s2[8 * q8 + 7]);
                *(u32x4*)(yd + q8 * 8) = w; }
        }
    }
    lds_barrier();
}

struct SeqRegs { bf16x8 a[4]; u32x4 c[2]; };
__device__ __forceinline__ void seq_load(const unsigned char* rec, int wv, int mt, int lane, SeqRegs& r) {
    const bf16_t* ap = (const bf16_t*)(rec + CK_MCT) + ((size_t)mt * 4 * 64 + lane) * 8;
    const bf16_t* cp = (const bf16_t*)(rec + CK_SADD) + ((size_t)(wv & 3) * 64 + lane) * 16;
#pragma unroll
    for (int s = 0; s < 4; ++s) r.a[s] = *(const bf16x8*)(ap + s * 64 * 8);
    r.c[0] = *(const u32x4*)cp; r.c[1] = *(const u32x4*)(cp + 8);
}
__device__ __forceinline__ void scanseq_head(const Args& a, unsigned char* ws, PG8_LAS unsigned char* lds, int b, int hd) {
    const int tid = opaque_v(threadIdx.x), lane = tid & 63, wv = __builtin_amdgcn_readfirstlane(tid >> 6);
    const int lr = lane & 31, h = lane >> 5;
    const int mt = (wv >> 1) & 1, nt = wv & 1;
    const bool isS = wv < 4;
    PG8_LAS bf16_t* SB0 = cs_slot(lds, 0); PG8_LAS bf16_t* SB1 = cs_slot(lds, 1);
    f32x16 st; cs_zero(st);
    for (int i = tid; i < 64 * CS_LD; i += NTH) { SB0[i] = 0; }
    const unsigned char* rec0 = ws + NB_CHK + (size_t)(b * 16 + hd) * 32 * CK_BYTES;
    bf16_t* srec0 = (bf16_t*)(ws + NB_SREC) + (size_t)(b * 16 + hd) * 32 * 4096;
    const int cr = (tid & 255) >> 2, cc8 = (tid & 3) * 16;
    lds_barrier();
    if (isS) {
        SeqRegs r[4];
#pragma unroll
        for (int c = 0; c < 4; ++c) seq_load(rec0 + (size_t)c * CK_BYTES, wv, mt, lane, r[c]);
#pragma unroll
        for (int c = 0; c < 32; ++c) {
            const PG8_LAS bf16_t* S = (c & 1) ? SB1 : SB0;
            PG8_LAS bf16_t* Sn = (c & 1) ? SB0 : SB1;
            f32x16 acc;
#pragma unroll
            for (int i = 0; i < 16; ++i) { const unsigned w = r[c & 3].c[i >> 3][(i & 7) >> 1]; acc[i] = __uint_as_float((i & 1) ? (w & 0xffff0000u) : (w << 16)); }
#pragma unroll
            for (int s = 0; s < 4; ++s) {
                const bf16x8 bv = *(const PG8_LAS bf16x8*)(S + (nt * 32 + lr) * CS_LD + s * 16 + h * 8);
                acc = __builtin_amdgcn_mfma_f32_32x32x16_bf16(r[c & 3].a[s], bv, acc, 0, 0, 0);
            }
            st = acc; cs_store_t(st, Sn, mt, nt, lane);
            if (c + 4 < 32) seq_load(rec0 + (size_t)(c + 4) * CK_BYTES, wv, mt, lane, r[c & 3]);
            lds_barrier();
        }
    } else {
#pragma unroll 1
        for (int c = 0; c < 32; ++c) {
            const PG8_LAS bf16_t* S = (c & 1) ? SB1 : SB0;
            const u32x4 v0 = *(const PG8_LAS u32x4*)(S + cr * CS_LD + cc8), v1 = *(const PG8_LAS u32x4*)(S + cr * CS_LD + cc8 + 8);
            bf16_t* d = srec0 + (size_t)c * 4096 + cr * 64 + cc8;
            *(u32x4*)d = v0; *(u32x4*)(d + 8) = v1;
            lds_barrier();
        }
    }
    if (isS) {
        float* so = a.out + O_WKVP + ((size_t)(b * 16 + hd) * 64 + nt * 32 + lr) * 64 + mt * 32 + 4 * h;
#pragma unroll
        for (int cc = 0; cc < 4; ++cc) *(float4*)(so + 8 * cc) = make_float4(st[4 * cc], st[4 * cc + 1], st[4 * cc + 2], st[4 * cc + 3]);
    }
    lds_barrier();
}
struct YgRegs { bf16x8 a[4]; u32x4 c[2]; u32x4 s0, s1; u32x4 vw[2], zw[2]; float rk; };
__device__ __forceinline__ void yg_load(unsigned char* ws, int ci, int tid, YgRegs& r) {
    const int lane = tid & 63, wv = tid >> 6, t4 = tid & 255;
    const int mt = (wv >> 1) & 1;
    const unsigned char* rec = ws + NB_CHK + (size_t)ci * CK_BYTES;
    const bf16_t* ap = (const bf16_t*)(rec + CK_RY) + ((size_t)mt * 4 * 64 + lane) * 8;
    const bf16_t* cp = (const bf16_t*)(rec + CK_Y0) + ((size_t)(wv & 3) * 64 + lane) * 16;
#pragma unroll
    for (int s = 0; s < 4; ++s) r.a[s] = *(const bf16x8*)(ap + s * 64 * 8);
    r.c[0] = *(const u32x4*)cp; r.c[1] = *(const u32x4*)(cp + 8);
    const bf16_t* sp = (const bf16_t*)(ws + NB_SREC) + (size_t)ci * 4096 + (t4 >> 2) * 64 + (t4 & 3) * 16;
    r.s0 = *(const u32x4*)sp; r.s1 = *(const u32x4*)(sp + 8);
    const int bh = ci >> 5, c = ci & 31, b = bh >> 4, hd = bh & 15;
    const size_t prow = (size_t)b * TP + c * 64 + (t4 >> 2);
    const int pv = (t4 & 3) * 16;
    const bf16_t* vp = (const bf16_t*)(ws + NB_RKVZ) + ((size_t)2 * XSH_ROWS + prow) * 1024 + hd * 64 + pv;
    const bf16_t* zp = (const bf16_t*)(ws + NB_RKVZ) + ((size_t)3 * XSH_ROWS + prow) * 1024 + hd * 64 + pv;
    r.vw[0] = *(const u32x4*)vp; r.vw[1] = *(const u32x4*)(vp + 8); r.zw[0] = *(const u32x4*)zp; r.zw[1] = *(const u32x4*)(zp + 8);
    r.rk = ((const float*)(ws + NB_RKS))[prow * 16 + hd];
}
__device__ __forceinline__ void yg_step(const Args& a, unsigned char* ws, PG8_LAS unsigned char* lds, int ci, int tid, const YgRegs& r) {
    const int lane = tid & 63, wv = tid >> 6, t4 = tid & 255, grp = wv >> 2;
    const int lr = lane & 31, h = lane >> 5, mt = (wv >> 1) & 1, nt = wv & 1;
    PG8_LAS bf16_t* SL = cs_slot(lds, grp);
    PG8_LAS float* YT = (PG8_LAS float*)(lds + 2 * CS_SLOT) + grp * (64 * 68);
    *(PG8_LAS u32x4*)(SL + (t4 >> 2) * CS_LD + (t4 & 3) * 16) = r.s0; *(PG8_LAS u32x4*)(SL + (t4 >> 2) * CS_LD + (t4 & 3) * 16 + 8) = r.s1;
    lds_barrier();
    {
        f32x16 acc;
#pragma unroll
        for (int i = 0; i < 16; ++i) { const unsigned w = r.c[i >> 3][(i & 7) >> 1]; acc[i] = __uint_as_float((i & 1) ? (w & 0xffff0000u) : (w << 16)); }
#pragma unroll
        for (int s = 0; s < 4; ++s) {
            const bf16x8 bv = *(const PG8_LAS bf16x8*)(SL + (nt * 32 + lr) * CS_LD + s * 16 + h * 8);
            acc = __builtin_amdgcn_mfma_f32_32x32x16_bf16(r.a[s], bv, acc, 0, 0, 0);
        }
#pragma unroll
        for (int i = 0; i < 16; ++i) YT[(mt * 32 + (i & 3) + 8 * (i >> 2) + 4 * h) * 68 + nt * 32 + lr] = acc[i];
    }
    lds_barrier();
    {
        const int ptok = t4 >> 2, pv = (t4 & 3) * 16;
        const int bh = ci >> 5, c = ci & 31, b = bh >> 4, hd = bh & 15;
        float y[16];
#pragma unroll
        for (int q = 0; q < 4; ++q) { const f32x4 v = *(const PG8_LAS f32x4*)(YT + ptok * 68 + pv + q * 4); y[4 * q] = v[0]; y[4 * q + 1] = v[1]; y[4 * q + 2] = v[2]; y[4 * q + 3] = v[3]; }
        float sm = 0.f;
#pragma unroll
        for (int i = 0; i < 16; ++i) sm += y[i];
        sm += __builtin_bit_cast(float, __builtin_amdgcn_update_dpp(0, __builtin_bit_cast(int, sm), 0xB1, 0xF, 0xF, true));
        sm += __builtin_bit_cast(float, __builtin_amdgcn_update_dpp(0, __builtin_bit_cast(int, sm), 0x4E, 0xF, 0xF, true));
        const float mean = sm * (1.f / 64.f);
        float sq = 0.f;
#pragma unroll
        for (int i = 0; i < 16; ++i) { y[i] -= mean; sq += y[i] * y[i]; }
        sq += __builtin_bit_cast(float, __builtin_amdgcn_update_dpp(0, __builtin_bit_cast(int, sq), 0xB1, 0xF, 0xF, true));
        sq += __builtin_bit_cast(float, __builtin_amdgcn_update_dpp(0, __builtin_bit_cast(int, sq), 0x4E, 0xF, 0xF, true));
        const float rs = rsqrtf(sq * (1.f / 64.f) + GN_EPS);
        const float* gg = a.in[I_GNG] + hd * 64 + pv; const float* gb = a.in[I_GNB] + hd * 64 + pv;
        float o[16];
#pragma unroll
        for (int i = 0; i < 16; ++i) {
            const unsigned vw = r.vw[i >> 3][(i & 7) >> 1], zw = r.zw[i >> 3][(i & 7) >> 1];
            const float vf = __uint_as_float((i & 1) ? (vw & 0xffff0000u) : (vw << 16)), zf = __uint_as_float((i & 1) ? (zw & 0xffff0000u) : (zw << 16));
            o[i] = fmaf(r.rk, vf, y[i] * rs * gg[i] + gb[i]) * silu_f(zf);
        }
        bf16_t* dst = (bf16_t*)(ws + NB_G4B) + ((size_t)b * TP + c * 64 + ptok) * 1024 + hd * 64 + pv;
        u32x4 w0, w1;
        w0.x = pk_bf16c(o[0], o[1]); w0.y = pk_bf16c(o[2], o[3]); w0.z = pk_bf16c(o[4], o[5]); w0.w = pk_bf16c(o[6], o[7]);
        w1.x = pk_bf16c(o[8], o[9]); w1.y = pk_bf16c(o[10], o[11]); w1.z = pk_bf16c(o[12], o[13]); w1.w = pk_bf16c(o[14], o[15]);
        *(u32x4*)dst = w0; *(u32x4*)(dst + 8) = w1;
    }
}
__device__ __forceinline__ void phase_ygate(const Args& a, unsigned char* ws, PG8_LAS unsigned char* lds, int bid, int nb) {
    const int tid = opaque_v(threadIdx.x), grp = tid >> 8;
    YgRegs cur, nxt;
    int pair = bid;
    if (pair < 2048) yg_load(ws, 2 * pair + grp, tid, nxt);
#pragma unroll 1
    while (pair < 2048) {
        cur = nxt;
        const int npair = pair + nb;
        if (npair < 2048) yg_load(ws, 2 * npair + grp, tid, nxt);
        yg_step(a, ws, lds, 2 * pair + grp, tid, cur);
        pair = npair;
    }
    lds_barrier();
}

__device__ __forceinline__ void phase_lnf(const Args& a, unsigned char* ws, int bid, int nb) {
    const int tid = opaque_v(threadIdx.x), lane = tid & 63, wv = tid >> 6;
    const float* PRE = (const float*)ws + WS_PRE;
    const float* P2 = (const float*)(ws + NB_Y);
    float x[16], nx[16], y[16], ny[16];
    int row = bid * 8 + wv;
    if (row < MT) { ld_row16(PRE + (size_t)row * 1024, lane, nx); ld_row16(P2 + (size_t)row * 1024, lane, ny); }
#pragma unroll 1
    while (row < MT) {
#pragma unroll
        for (int i = 0; i < 16; ++i) { x[i] = nx[i]; y[i] = ny[i]; }
        const int nrow = row + nb * 8;
        if (nrow < MT) { ld_row16(PRE + (size_t)nrow * 1024, lane, nx); ld_row16(P2 + (size_t)nrow * 1024, lane, ny); }
        ln_calc16(a.in[I_LNG], a.in[I_LNB], lane, x);
#pragma unroll
        for (int i = 0; i < 16; ++i) x[i] = fmaf(ALPHA, x[i], y[i]);
        ln_calc16(a.in[I_LNG] + 1024, a.in[I_LNB] + 1024, lane, x);
#if PROBE_TIME >= 0
        if (row >= MP) {
            const unsigned long long* tsp = (const unsigned long long*)(ws + NB_BAR + 16384);
            const float dt_us = (float)(__hip_atomic_load(tsp + PROBE_TIME + 1, __ATOMIC_RELAXED, __HIP_MEMORY_SCOPE_AGENT) - __hip_atomic_load(tsp + PROBE_TIME, __ATOMIC_RELAXED, __HIP_MEMORY_SCOPE_AGENT)) * 0.01f;
            const float f = 1.f + PROBE_K * dt_us;
#pragma unroll
            for (int i = 0; i < 16; ++i) x[i] *= f;
        }
#endif
        float* o = (row < MP ? a.out + O_Y + (size_t)row * 1024 : a.out + O_YS + (size_t)(row - MP) * 1024) + lane * 4;
#pragma unroll
        for (int q = 0; q < 4; ++q) *(float4*)(o + q * 256) = make_float4(x[4 * q], x[4 * q + 1], x[4 * q + 2], x[4 * q + 3]);
        row = nrow;
    }
}
__device__ __forceinline__ void sample_pool_copy(const Args& a, unsigned char* ws, int bid, int nb) {
    float* KCS = (float*)(ws + NB_KCS);
    const int* pt = (const int*)a.in[I_PT];
    const float* ccmp = a.in[I_CCMP];
#pragma unroll 2
    for (int i = bid * NTH + threadIdx.x; i < BS * 256 * 256; i += nb * NTH) {
        const int c = i & 255, n = (i >> 8) & 255, s = i >> 16;
        const int kv = c >> 7, g = (c >> 6) & 1;
        const float* w = kv ? a.in[I_WVC] : a.in[I_WKC];
        const int pos0 = n * 32;
        const float* src = ccmp + ((size_t)pt[s * NPAGE + (pos0 >> 7)] * PAGE + (pos0 & 127)) * 256 + c;
        float acc = 0.f;
#pragma unroll
        for (int l = 0; l < 32; ++l) acc = fmaf(src[(size_t)l * 256], w[l * 2 + g], acc);
        KCS[i] = acc;
    }
    const float4* cw = (const float4*)a.in[I_CWIN];
    float4* ow = (float4*)(a.out + O_WINS);
#pragma unroll 4
    for (int i = bid * NTH + threadIdx.x; i < BS * 511 * 64; i += nb * NTH) {
        const int s = i / (511 * 64), rem = i - s * (511 * 64);
        ow[(size_t)s * 512 * 64 + rem] = cw[(size_t)s * 512 * 64 + 64 + rem];
    }
}
__device__ __forceinline__ void sample_conv(const Args& a, unsigned char* ws, PG8_LAS unsigned char* lds, int s) {
    const int ch = opaque_v(threadIdx.x);
    const bf16_t* h = (const bf16_t*)(ws + NB_HB) + (size_t)(MP + s) * 2560;
    const float* sc = a.in[I_SCONV] + (size_t)s * 30 * 512 + ch;
    const float u = bf2f(h[ch]) * sigm_f(bf2f(h[512 + ch]));
    float scv[30], wj[31];
    const float* __restrict__ cwp = a.in[I_CONVW] + ch;
#pragma unroll
    for (int j = 0; j < 30; ++j) { scv[j] = sc[(size_t)j * 512]; wj[j] = cwp[j * 512]; }
    wj[30] = cwp[30 * 512];
    float acc = a.in[I_CONVB][ch];
#pragma unroll
    for (int j = 0; j < 30; ++j) acc = fmaf(wj[j], scv[j], acc);
    acc = fmaf(wj[30], u, acc);
    float* __restrict__ oc = a.out + O_CONVS + (size_t)s * 30 * 512 + ch;
#pragma unroll
    for (int i = 0; i < 29; ++i) oc[(size_t)i * 512] = scv[i + 1];
    oc[(size_t)29 * 512] = u;
    PG8_LAS float* red = (PG8_LAS float*)lds;
    const int lane = ch & 63, wv = ch >> 6;
    float sm = wave_sum(acc);
    __syncthreads();
    if (lane == 0) red[wv] = sm;
    __syncthreads();
    float tot = 0.f;
#pragma unroll
    for (int i = 0; i < 8; ++i) tot += red[i];
    const float mean = tot * (1.f / 512.f);
    const float d = acc - mean;
    float sq = wave_sum(d * d);
    __syncthreads();
    if (lane == 0) red[wv] = sq;
    __syncthreads();
    tot = 0.f;
#pragma unroll
    for (int i = 0; i < 8; ++i) tot += red[i];
    const float rs = rsqrtf(tot * (1.f / 512.f) + LN_EPS);
    const float y = silu_f(d * rs * a.in[I_CLNG][ch] + a.in[I_CLNB][ch]) * silu_f(bf2f(h[1024 + ch]));
    ((bf16_t*)(ws + NB_CATB))[(size_t)(MP + s) * 1024 + ch] = (bf16_t)(pk_bf16(y, 0.f) & 0xffffu);
    __syncthreads();
}

constexpr int SP_STRIDE = 66;
__device__ __forceinline__ void sample_attn(const Args& a, unsigned char* ws, PG8_LAS unsigned char* lds, int s, int g, int part) {
    const int tid = opaque_v(threadIdx.x), lane = tid & 63, wv = __builtin_amdgcn_readfirstlane(tid >> 6);
    PG8_LAS float* PC = (PG8_LAS float*)lds;
    PG8_LAS float* IMP = (PG8_LAS float*)(lds + 4096);
    PG8_LAS int* SEL = (PG8_LAS int*)(lds + 4096 + 1024);
    PG8_LAS int* FLG = (PG8_LAS int*)(lds + 4096 + 1024 + 128);
    PG8_LAS float* PS = (PG8_LAS float*)(lds + 8192) + (tid >> 6) * 64;
    const int r = wv & 3, hh = g * 4 + r;
    const float slope = __builtin_amdgcn_exp2f(-(float)(hh + 1));
    const int* pt = (const int*)a.in[I_PT] + s * NPAGE;
    const bf16_t* hrow = (const bf16_t*)(ws + NB_HB) + (size_t)(MP + s) * 2560;
    float q[64];
#pragma unroll
    for (int d8 = 0; d8 < 8; ++d8) { const u32x4 w = *(const u32x4*)(hrow + 1536 + hh * 64 + d8 * 8);
#pragma unroll
        for (int i = 0; i < 4; ++i) { q[d8 * 8 + 2 * i] = __uint_as_float(w[i] << 16); q[d8 * 8 + 2 * i + 1] = __uint_as_float(w[i] & 0xffff0000u); } }
#define SAMP_DOT(KPTR, OUT) { const float4* k4_ = (const float4*)(KPTR); float4 kk_[16]; \
        _Pragma("unroll") for (int i_ = 0; i_ < 16; ++i_) kk_[i_] = k4_[i_]; float s_ = 0.f; \
        _Pragma("unroll") for (int i_ = 0; i_ < 16; ++i_) { s_ = fmaf(q[4 * i_], kk_[i_].x, s_); s_ = fmaf(q[4 * i_ + 1], kk_[i_].y, s_); s_ = fmaf(q[4 * i_ + 2], kk_[i_].z, s_); s_ = fmaf(q[4 * i_ + 3], kk_[i_].w, s_); } OUT = s_; }
    if (wv < 4) {
        const float* kc = (const float*)(ws + NB_KCS) + (size_t)s * 256 * 256 + g * 64;
        float sc[4];
        float mx = -INFINITY;
#pragma unroll
        for (int i = 0; i < 4; ++i) { const int n = lane + 64 * i; float d; SAMP_DOT(kc + (size_t)n * 256, d); sc[i] = d - slope * (float)(PAST - (32 * n + 31)); mx = fmaxf(mx, sc[i]); }
#pragma unroll
        for (int o = 32; o > 0; o >>= 1) mx = fmaxf(mx, __shfl_xor(mx, o));
        float ls = 0.f;
#pragma unroll
        for (int i = 0; i < 4; ++i) { sc[i] = __expf(sc[i] - mx); ls += sc[i]; }
        ls = wave_sum(ls);
        const float inv = 1.f / ls;
#pragma unroll
        for (int i = 0; i < 4; ++i) PC[r * 256 + lane + 64 * i] = sc[i] * inv;
    }
    __syncthreads();
    if (wv < 4 && part == 0) {
        const float* vc = (const float*)(ws + NB_KCS) + (size_t)s * 256 * 256 + 128 + g * 64 + lane;
        float oc0 = 0.f, oc1 = 0.f, oc2 = 0.f, oc3 = 0.f;
#pragma unroll 8
        for (int n = 0; n < 256; n += 4) {
            oc0 = fmaf(PC[r * 256 + n], vc[(size_t)n * 256], oc0); oc1 = fmaf(PC[r * 256 + n + 1], vc[(size_t)(n + 1) * 256], oc1);
            oc2 = fmaf(PC[r * 256 + n + 2], vc[(size_t)(n + 2) * 256], oc2); oc3 = fmaf(PC[r * 256 + n + 3], vc[(size_t)(n + 3) * 256], oc3);
        }
        ((float*)(ws + NB_OCS))[(size_t)(s * 8 + hh) * 64 + lane] = (oc0 + oc1) + (oc2 + oc3);
    }
    if (tid < 129) {
        float v = 0.f;
        if (tid < 128) { for (int rr = 0; rr < 4; ++rr) v += PC[rr * 256 + 2 * tid] + PC[rr * 256 + 2 * tid + 1]; }
        if (tid == 0 || tid >= 127) v = 1e4f;
        IMP[tid] = v;
    }
    __syncthreads();
    if (tid < 129) {
        const float vj = IMP[tid];
        int rank = 0;
        for (int i = 0; i < 129; ++i) { const float vi = IMP[i]; rank += (vi > vj || (vi == vj && i < tid)) ? 1 : 0; }
        FLG[tid] = (rank < 16) ? 1 : 0;
    }
    __syncthreads();
    if (tid < 129 && FLG[tid]) { int slot = 0; for (int i = 0; i < tid; ++i) slot += FLG[i]; SEL[slot] = tid; }
    __syncthreads();
    const float* csel = a.in[I_CSEL];
    const float* newsel = a.out + O_SELS + (size_t)s * 256;
    const float* cwin = a.in[I_CWIN] + (size_t)s * 512 * 256;
    const float* newwin = a.out + O_WINS + (size_t)(s * 512 + 511) * 256;
#pragma unroll 1
    for (int it = 0; it < 3; ++it) {
        const int lb = (wv >> 2) + 2 * it;
        const bool is_sel = lb < 4;
        const int slot = is_sel ? part * 4 + lb : part * 2 + (lb - 4);
        const float* rowp; const float* vb; int vstride_last; float dist; bool valid; int nk;
        if (is_sel) {
            const int blk = SEL[slot];
            const int kpos = blk * 64 + lane;
            valid = kpos <= PAST;
            rowp = (blk < 128) ? csel + ((size_t)pt[blk >> 1] * PAGE + (kpos & 127)) * 256 : newsel;
            vb = (blk < 128) ? csel + ((size_t)pt[blk >> 1] * PAGE + ((blk * 64) & 127)) * 256 + 128 + g * 64 + lane : newsel + 128 + g * 64 + lane;
            nk = (blk < 128) ? 64 : 1; dist = (float)(PAST - kpos); vstride_last = 0;
        } else {
            const int i0 = 1 + slot * 64;
            const int i = i0 + lane;
            valid = true; nk = 64;
            rowp = (i < 512) ? cwin + (size_t)i * 256 : newwin;
            vb = cwin + (size_t)i0 * 256 + 128 + g * 64 + lane;
            dist = (float)(512 - i); vstride_last = (slot == 7) ? 1 : 0;
        }
        float sc = -INFINITY;
        if (valid) { float d; SAMP_DOT(rowp + g * 64, d); sc = d - slope * dist; }
        float mx = sc;
#pragma unroll
        for (int of = 32; of > 0; of >>= 1) mx = fmaxf(mx, __shfl_xor(mx, of));
        const float p = valid ? __expf(sc - mx) : 0.f;
        const float l = wave_sum(p);
        PS[lane] = p; __builtin_amdgcn_wave_barrier();
        float o0 = 0.f, o1 = 0.f, o2 = 0.f, o3 = 0.f;
        if (nk == 64) {
            float vv[64];
#pragma unroll
            for (int k = 0; k < 63; ++k) vv[k] = vb[(size_t)k * 256];
            vv[63] = vstride_last ? newwin[128 + g * 64 + lane] : vb[(size_t)63 * 256];
#pragma unroll
            for (int k = 0; k < 64; k += 4) { o0 = fmaf(PS[k], vv[k], o0); o1 = fmaf(PS[k + 1], vv[k + 1], o1); o2 = fmaf(PS[k + 2], vv[k + 2], o2); o3 = fmaf(PS[k + 3], vv[k + 3], o3); }
        } else o0 = PS[0] * vb[0];
        __builtin_amdgcn_wave_barrier();
        float* pp = (float*)(ws + NB_PARTS) + ((size_t)((s * 8 + hh) * 24 + (is_sel ? slot : 16 + slot))) * SP_STRIDE;
        pp[2 + lane] = (o0 + o1) + (o2 + o3);
        if (lane == 0) { pp[0] = mx; pp[1] = l; }
    }
#undef SAMP_DOT
    __syncthreads();
}
__device__ __forceinline__ void sample_combine(const Args& a, unsigned char* ws, int s, int g) {
    const int tid = opaque_v(threadIdx.x), lane = tid & 63, wv = __builtin_amdgcn_readfirstlane(tid >> 6);
    if (wv >= 4) return;
    const int hh = g * 4 + wv;
    const float* pp = (const float*)(ws + NB_PARTS) + (size_t)(s * 8 + hh) * 24 * SP_STRIDE;
    const float* g3p = (const float*)(ws + NB_G3) + (size_t)(MP + s) * 32 + hh * 3;
    const float gc = sigm_f(g3p[0]), gs = sigm_f(g3p[1]), gw = sigm_f(g3p[2]);
    float res = gc * ((const float*)(ws + NB_OCS))[(size_t)(s * 8 + hh) * 64 + lane];
#pragma unroll
    for (int br = 0; br < 2; ++br) {
        const int n0 = br ? 16 : 0, cnt = br ? 8 : 16;
        float M = -INFINITY;
        for (int i = 0; i < cnt; ++i) M = fmaxf(M, pp[(size_t)(n0 + i) * SP_STRIDE]);
        float L = 0.f, O = 0.f;
        for (int i = 0; i < cnt; ++i) { const float* q = pp + (size_t)(n0 + i) * SP_STRIDE; const float w = __expf(q[0] - M); L = fmaf(q[1], w, L); O = fmaf(q[2 + lane], w, O); }
        res = fmaf(br ? gw : gs, O / L, res);
    }
    const bf16_t* hrow = (const bf16_t*)(ws + NB_HB) + (size_t)(MP + s) * 2560;
    const float y = res * silu_f(bf2f(hrow[2048 + hh * 64 + lane]));
    ((bf16_t*)(ws + NB_CATB))[(size_t)(MP + s) * 1024 + 512 + hh * 64 + lane] = (bf16_t)(pk_bf16(y, 0.f) & 0xffffu);
}

static_assert(CS_END <= LDS_MISC, "chunk-scan LDS map overlaps the barrier words");
enum { PH_PREP = 0, PH_GEMM1, PH_CONV, PH_ATTN, PH_GEMM2, PH_LNS, PH_GEMM3, PH_PREP2, PH_SCAN, PH_POST, PH_GEMM4, PH_LNF, NPHASE };

__global__ void __launch_bounds__(NTH, 2) mega(Args a) {
    extern __shared__ __attribute__((aligned(16))) unsigned char lds_raw[];
    PG8_LAS unsigned char* lds = (PG8_LAS unsigned char*)lds_raw;
    unsigned char* ws = a.ws;
    volatile LAS unsigned* misc = (volatile LAS unsigned*)(lds + LDS_MISC);
    if (threadIdx.x < 4) misc[threadIdx.x] = 0u;
    __syncthreads();
    XcdBarrier bar = xcd_barrier_post((unsigned*)(ws + NB_BAR), misc);
    const int lo = a.ph_lo, hi = a.ph_hi;
#ifndef DUP_SATTN
#define DUP_SATTN 0
#endif
#ifndef DUP_CONV
#define DUP_CONV 0
#endif
#ifndef DUP_GEMM1
#define DUP_GEMM1 0
#endif
#ifndef SKIPMASK
#define SKIPMASK 0
#endif
#define IN(k) (lo <= (k) && (k) < hi && !((SKIPMASK >> (k)) & 1))
#ifndef REPMASK
#define REPMASK 0
#endif
#define REPS(k) _Pragma("unroll 1") for (int rep_ = 0; rep_ < (((REPMASK >> (k)) & 1) ? 2 : 1); ++rep_)
#if PROBE_TIME >= 0
    unsigned long long* const tstamp = (unsigned long long*)(ws + NB_BAR + 16384);
#define STAMP(i) do { if (blockIdx.x == 0 && threadIdx.x == 0) __hip_atomic_store(tstamp + (i), (unsigned long long)__builtin_amdgcn_s_memrealtime(), __ATOMIC_RELAXED, __HIP_MEMORY_SCOPE_AGENT); } while (0)
#else
#define STAMP(i) do { } while (0)
#endif
#define SEAM(k) do { if (IN(k) && IN((k) + 1)) xcd_barrier(bar); STAMP((k) + 1); } while (0)
    STAMP(0);
    if (IN(PH_PREP)) REPS(PH_PREP) {
        const int bid = opaque(blockIdx.x), nb = gridDim.x;
        convert_wt(a.in[I_WIN], 1024, DIN, (bf16_t*)(ws + NB_WT1), N1PAD, MapWin{}, bid, nb);
        convert_wt(a.in[I_WOUTE], 1024, 1024, (bf16_t*)(ws + NB_WT2), 1024, MapId{}, bid, nb);
        for (int n = 0; n < 4; ++n) convert_wt(a.in[I_WRKVZ] + (size_t)n * 1024 * 1024, 1024, 1024, (bf16_t*)(ws + NB_WT3) + (size_t)n * 1024 * 1024, 1024, MapId{}, bid, nb);
        convert_wt(a.in[I_WOUTO], 1024, 1024, (bf16_t*)(ws + NB_WT4), 1024, MapId{}, bid, nb);
        convert_wt(a.in[I_W1], 1024, 64, (bf16_t*)(ws + NB_W1T), 64, MapId{}, bid, nb);
        convert_wt(a.in[I_A1], 1024, 64, (bf16_t*)(ws + NB_A1T), 64, MapId{}, bid, nb);
        convert_wt(a.in[I_W2], 64, 1024, (bf16_t*)(ws + NB_W2T), 1024, MapId{}, bid, nb);
        convert_wt(a.in[I_A2], 64, 1024, (bf16_t*)(ws + NB_A2T), 1024, MapId{}, bid, nb);
        convert_rows(a.in[I_XP], (size_t)MP * 1024 / 8, (bf16_t*)(ws + NB_XB), bid, nb);
        convert_rows(a.in[I_XS], (size_t)BS * 1024 / 8, (bf16_t*)(ws + NB_XSB), bid, nb);
        sample_pool_copy(a, ws, bid, nb);
    }
    SEAM(PH_PREP);
    if (IN(PH_GEMM1)) REPS(PH_GEMM1) {
        const int bid = opaque(blockIdx.x), nb = gridDim.x;
        const Route1 R{(bf16_t*)(ws + NB_HB), (bf16_t*)(ws + NB_KVB), (float*)(ws + NB_G3), a.out};
        {
            pg8::Gemm g{(const bf16_t*)(ws + NB_XB), (const bf16_t*)(ws + NB_WT1), MP, N1PAD, 1024};
            pg8::StaticOrder S; S.init(MP, N1PAD, nb, bid);
            Epi1 E{R};
            pg8::gemm_phase<Epi1, pg8::StaticOrder, false>(lds, g, S, E, nullptr);
#if DUP_GEMM1
            __syncthreads();
            pg8::gemm_phase<Epi1, pg8::StaticOrder, false>(lds, g, S, E, nullptr);
#endif
        }
        {
            for (int task = bid; task < 105; task += nb) {
                sample_gemm32_wg((const bf16_t*)(ws + NB_XSB), (const bf16_t*)(ws + NB_WT1), 1024, task * 32, lds,
                    [&](int r, int n, float v) {
                        const int row = MP + r;
                        if (n < 2560) { const float sc = (n >= 1536 && n < 2048) ? 0.125f : 1.0f; ((bf16_t*)(ws + NB_HB))[(size_t)row * 2560 + n] = (bf16_t)(pk_bf16c(v * sc, 0.f) & 0xffffu); }
                        else if (n < 3328) { const int c = n - 2560, i3 = c >> 8, cc = c & 255; ((bf16_t*)(ws + NB_KVB))[(size_t)row * 768 + c] = (bf16_t)(pk_bf16c(v, 0.f) & 0xffffu);
                            float* dst = (i3 == 0) ? a.out + O_CMPS + (size_t)r * 256 + cc : (i3 == 1) ? a.out + O_SELS + (size_t)r * 256 + cc : a.out + O_WINS + (size_t)(r * 512 + 511) * 256 + cc;
                            *dst = v; }
                        else if (n < 3352) ((float*)(ws + NB_G3))[(size_t)row * 32 + (n - 3328)] = v;
                    });
            }
        }
    }
    SEAM(PH_GEMM1);
    if (IN(PH_CONV)) REPS(PH_CONV) {
        const int bid = opaque(blockIdx.x), nb = gridDim.x;
#pragma unroll 1
        for (int item = bid; item < 512; item += nb) conv_item(a, ws, lds, item);
        pool_prompt(a, ws, bid, nb);
        sample_attn(a, ws, lds, bid >> 3, (bid >> 2) & 1, bid & 3);
#if DUP_SATTN
        __syncthreads();
        sample_attn(a, ws, lds, bid >> 3, (bid >> 2) & 1, bid & 3);
#endif
        if (bid >= 96 && bid < 128) sample_conv(a, ws, lds, bid - 96);
    }
    SEAM(PH_CONV);
    if (IN(PH_ATTN)) REPS(PH_ATTN) {
        const int bid = opaque(blockIdx.x), nb = gridDim.x;
        if (bid < 64) sample_combine(a, ws, bid >> 1, bid & 1);
        for (int pr = bid; pr < 256; pr += nb) {
            const int b = pr >> 5, g = (pr >> 4) & 1, xq = pr & 15;
#pragma unroll 1
            for (int k = 0; k < 2; ++k) attn_item(a, ws, lds, b, g, k ? xq : 31 - xq);
        }
    }
    SEAM(PH_ATTN);
    if (IN(PH_GEMM2)) REPS(PH_GEMM2) {
        const int bid = opaque(blockIdx.x), nb = gridDim.x;
        {
            pg8::Gemm g{(const bf16_t*)(ws + NB_CATB), (const bf16_t*)(ws + NB_WT2), MP, 1024, 1024};
            pg8::StaticOrder S; S.init(MP, 1024, nb, bid);
            EpiPreRes E{(float*)ws + WS_PRE, a.in[I_XP]};
            pg8::gemm_phase<EpiPreRes, pg8::StaticOrder, false>(lds, g, S, E, nullptr);
        }
        {
            const int lane = threadIdx.x & 63, wv = __builtin_amdgcn_readfirstlane(threadIdx.x >> 6);
            float* PREs = (float*)ws + WS_PRE + (size_t)MP * 1024;
            const float* xs = a.in[I_XS];
            for (int task = bid; task < 32; task += nb)
                sample_gemm32_wg((const bf16_t*)(ws + NB_CATB) + (size_t)MP * 1024, (const bf16_t*)(ws + NB_WT2), 1024, task * 32, lds,
                              [&](int r, int n, float v) { PREs[(size_t)r * 1024 + n] = fmaf(ALPHA, xs[(size_t)r * 1024 + n], v); });
        }
    }
    SEAM(PH_GEMM2);
    if (IN(PH_LNS)) REPS(PH_LNS) { const int bid = opaque(blockIdx.x), nb = gridDim.x; phase_lns(a, ws, bid, nb); }
    SEAM(PH_LNS);
    if (IN(PH_GEMM3)) REPS(PH_GEMM3) {
        const int bid = opaque(blockIdx.x), nb = gridDim.x;
        {
            pg8::Gemm g{(const bf16_t*)(ws + NB_XSH), (const bf16_t*)(ws + NB_WT3), MP, 4096, 1024};
            Order3 S; S.init(nb, bid);
            Epi3 E{(bf16_t*)(ws + NB_RKVZ)};
            pg8::gemm_phase<Epi3, Order3, false>(lds, g, S, E, nullptr);
        }
        {
            const int lane = threadIdx.x & 63, wv = __builtin_amdgcn_readfirstlane(threadIdx.x >> 6);
            for (int task = bid; task < 128; task += nb) {
                const int n = task >> 5, n0 = (task & 31) * 32;
                bf16_t* dst = (bf16_t*)(ws + NB_RKVZ) + ((size_t)n * XSH_ROWS + MP) * 1024;
                sample_gemm32_wg((const bf16_t*)(ws + NB_XSH) + ((size_t)n * XSH_ROWS + MP) * 1024, (const bf16_t*)(ws + NB_WT3) + (size_t)n * 1024 * 1024, 1024, n0, lds,
                              [&](int r, int c, float v) { dst[(size_t)r * 1024 + c] = (bf16_t)(pk_bf16c(v, 0.f) & 0xffffu); });
            }
            {
                const int tidl = opaque_v(threadIdx.x);
                LoraRegs lcur, lnxt;
                int task = bid;
                if (task < 1026) lora_load(ws, task, tidl, lnxt);
#pragma unroll 1
                while (task < 1026) {
                    lcur = lnxt;
                    const int ntask = task + nb;
                    if (ntask < 1026) lora_load(ws, ntask, tidl, lnxt);
                    lora_tile(ws, lds, task, tidl, lcur);
                    task = ntask;
                }
            }
        }
    }
    SEAM(PH_GEMM3);
    if (IN(PH_PREP2)) REPS(PH_PREP2) {
        const int bid = opaque(blockIdx.x), nb = gridDim.x;
        for (int pr = bid; pr < 256; pr += nb) {
            const int bh = pr >> 1, b = bh >> 4, hd = bh & 15, c0 = (pr & 1) * 16;
            const int tidp = opaque_v(threadIdx.x), lanep = tidp & 63, wvp = tidp >> 6;
            bf16x8 btf[4];
            { const int which = wvp >> 2, nt = wvp & 1;
              const bf16_t* Bt = (const bf16_t*)(ws + (which ? NB_A2T : NB_W2T)) + (size_t)(hd * 64 + nt * 32 + (lanep & 31)) * 64 + (lanep >> 5) * 8;
#pragma unroll
              for (int s4 = 0; s4 < 4; ++s4) btf[s4] = *(const bf16x8*)(Bt + s4 * 16); }
            PreRegs pcur, pnxt;
            scanpre_load(ws, b, hd, c0, tidp, pnxt);
#pragma unroll 1
            for (int cc = 0; cc < 16; ++cc) {
                pcur = pnxt;
                if (cc + 1 < 16) scanpre_load(ws, b, hd, c0 + cc + 1, tidp, pnxt);
                scanpre_chunk(a, ws, lds, b, hd, c0 + cc, pcur, btf);
            }
        }
        const int lane = opaque_v(threadIdx.x) & 63, wv = __builtin_amdgcn_readfirstlane(threadIdx.x >> 6);
        for (int task = bid * 8 + wv; task < 16; task += nb * 8) prep2_task(a, ws, 512, task, lane);
    }
    SEAM(PH_PREP2);
    if (IN(PH_SCAN)) REPS(PH_SCAN) {
        const int bid = opaque(blockIdx.x), nb = gridDim.x;
#pragma unroll 1
        for (int item = bid; item < 128; item += nb) scanseq_head(a, ws, lds, item >> 4, item & 15);
        const int lane = opaque_v(threadIdx.x) & 63, wv = __builtin_amdgcn_readfirstlane(threadIdx.x >> 6);
        for (int task = (nb - 1 - bid) * 8 + wv; task < BS * 16; task += nb * 8) scan_sample(a, ws, task >> 4, task & 15, lane);
    }
    SEAM(PH_SCAN);
    if (IN(PH_POST)) REPS(PH_POST) { const int bid = opaque(blockIdx.x), nb = gridDim.x; phase_ygate(a, ws, lds, bid, nb); }
    SEAM(PH_POST);
    if (IN(PH_GEMM4)) REPS(PH_GEMM4) {
        const int bid = opaque(blockIdx.x), nb = gridDim.x;
        {
            pg8::Gemm g{(const bf16_t*)(ws + NB_G4B), (const bf16_t*)(ws + NB_WT4), MP, 1024, 1024};
            pg8::StaticOrder S; S.init(MP, 1024, nb, bid);
            EpiPre E{(float*)(ws + NB_Y), 1024};
            pg8::gemm_phase<EpiPre, pg8::StaticOrder, false>(lds, g, S, E, nullptr);
        }
        {
            float* PREs = (float*)(ws + NB_Y) + (size_t)MP * 1024;
            for (int task = bid; task < 32; task += nb)
                sample_gemm32_wg((const bf16_t*)(ws + NB_G4B) + (size_t)MP * 1024, (const bf16_t*)(ws + NB_WT4), 1024, task * 32, lds,
                              [&](int r, int n, float v) { PREs[(size_t)r * 1024 + n] = v; });
        }
    }
    SEAM(PH_GEMM4);
    if (IN(PH_LNF)) REPS(PH_LNF) { const int bid = opaque(blockIdx.x), nb = gridDim.x; phase_lnf(a, ws, bid, nb); }
#undef IN
#undef SEAM
}
}

extern "C" void kernel_launch(void* const* d_in, const int* in_sizes, int n_in, void* d_out, int out_size, void* d_ws, size_t ws_size,
                              hipStream_t stream) {
    if (n_in != N_IN || ws_size < nk::NB_END) { fprintf(stderr, "kernel_launch: unexpected n_in %d or ws_size %zu (need %zu)\n", n_in, ws_size, (size_t)nk::NB_END); return; }
    static int grid = 0;
    if (!grid) {
        int dev = 0, cus = 0, per_cu = 0;
        hipGetDevice(&dev);
        hipDeviceGetAttribute(&cus, hipDeviceAttributeMultiprocessorCount, dev);
        hipFuncSetAttribute((const void*)nk::mega, hipFuncAttributeMaxDynamicSharedMemorySize, nk::LDS_BYTES);
        hipOccupancyMaxActiveBlocksPerMultiprocessor(&per_cu, (const void*)nk::mega, nk::NTH, nk::LDS_BYTES);
        if (per_cu < 1) fprintf(stderr, "kernel_launch: occupancy query says %d blocks per CU\n", per_cu);
        grid = cus;
    }
    hipMemsetAsync((unsigned char*)d_ws + nk::NB_BAR, 0, 32768, stream);
    nk::Args a{};
    for (int i = 0; i < N_IN; ++i) a.in[i] = (const float*)d_in[i];
    a.out = (float*)d_out; a.ws = (unsigned char*)d_ws; a.ph_lo = 0; a.ph_hi = nk::NPHASE;
    void* args[] = {&a};
    hipError_t e = hipLaunchCooperativeKernel((const void*)nk::mega, dim3(grid), dim3(nk::NTH), args, nk::LDS_BYTES, stream);
    if (e != hipSuccess) fprintf(stderr, "cooperative launch failed: %s (grid %d)\n", hipGetErrorString(e), grid);
}
```

```cpp
#include <hip/hip_runtime.h>
#include <hip/hip_cooperative_groups.h>
#include <cstdio>
namespace cg = cooperative_groups;
#ifndef PROBE_TIME
#define PROBE_TIME -1
#endif
#ifndef PROBE_K
#define PROBE_K 1e-4f
#endif

constexpr int D = 1024, BP = 8, TP = 2048, MP = BP * TP, BS = 32, MT = MP + BS;
constexpr int DIN = 3352;
constexpr int C_AVAL = 0, C_AGLU = 512, C_ZA = 1024, C_Q = 1536, C_KV = 2048, C_G3 = 2816, C_ZB = 2840;
constexpr int C_CMP = C_KV, C_SEL = C_KV + 256, C_WIN = C_KV + 512;
constexpr int PAST = 8192, NPAGE = 64, PAGE = 128;
constexpr float ALPHA = 1.4142135623730951f;
constexpr float LN_EPS = 1e-5f, GN_EPS = 64e-5f;

constexpr size_t O_Y = 0, O_YS = 16777216, O_CMPP = 16809984, O_CMPS = 21004288, O_SELP = 21012480, O_SELS = 25206784,
                 O_WINP = 25214976, O_WINS = 26263552, O_CONVP = 30457856, O_CONVS = 30580736, O_WKVP = 31072256,
                 O_WKVS = 31596544, O_SHP = 33693696, O_SHS = 33701888;

enum { I_XP = 0, I_XS, I_CCMP, I_CSEL, I_CWIN, I_SCONV, I_SWKV, I_SSHIFT, I_PT, I_WIN, I_CONVW, I_CONVB, I_CLNG, I_CLNB,
       I_WKC, I_WVC, I_WOUTE, I_MU, I_WRKVZ, I_W0, I_W1, I_W2, I_A0, I_A1, I_A2, I_KK, I_KA, I_RK, I_GNG, I_GNB, I_WOUTO,
       I_LNG, I_LNB, N_IN };

constexpr size_t SZ_ROWD = (size_t)MT * D;
constexpr size_t WS_H = 0;
constexpr size_t WS_CAT = WS_H + (size_t)MT * DIN;
constexpr size_t WS_OC = WS_CAT + SZ_ROWD;
constexpr size_t WS_XSH = 0;
constexpr size_t WS_Y = 0;
constexpr size_t WS_G4 = SZ_ROWD;
constexpr size_t WS_R0END = 6 * SZ_ROWD;
constexpr size_t WS_PRE = WS_R0END;
constexpr size_t WS_X1 = WS_PRE + SZ_ROWD;
constexpr size_t WS_R = WS_X1 + SZ_ROWD;
constexpr size_t WS_K = WS_R + SZ_ROWD;
constexpr size_t WS_V = WS_K + SZ_ROWD;
constexpr size_t WS_Z = WS_V + SZ_ROWD;
constexpr size_t WS_DEC = WS_Z + SZ_ROWD;
constexpr size_t WS_KKN = WS_DEC + SZ_ROWD;
constexpr size_t WS_KKA = WS_KKN + SZ_ROWD;
constexpr size_t WS_TW = WS_KKA + SZ_ROWD;
constexpr size_t WS_AW = WS_TW + (size_t)MT * 64;
constexpr size_t WS_RK = WS_AW + (size_t)MT * 64;
constexpr size_t WS_END = WS_RK + (size_t)MT * 16;
constexpr size_t WS_PCP = WS_R;
constexpr size_t WS_PCS = WS_R + (size_t)MP * 8 * 64;
constexpr size_t WS_IMP = WS_K;
constexpr size_t WS_SELIDX = WS_V;
constexpr size_t WS_KCP = WS_Z;
constexpr size_t WS_KCS = WS_Z + (size_t)8 * 64 * 256;
static_assert(WS_OC + (size_t)MT * 512 <= WS_R0END, "layer0 temporaries overflow region 0");

namespace pg8 {
#define PG8_LAS __attribute__((address_space(3)))
typedef unsigned short bf16_t;
typedef short bf16x8 __attribute__((ext_vector_type(8)));
typedef float f32x4 __attribute__((ext_vector_type(4)));
typedef unsigned u32x4 __attribute__((ext_vector_type(4)));
constexpr int BM = 256, BK = 64, HALF = 128, HTB = HALF * BK * 2  , STAGE_BYTES = 8 * HTB, NXCD = 8, WGM = 8;

__host__ __device__ __forceinline__ int lds_byte(int r, int c) { const int st = (r >> 4) * 2 + (c >> 5), rr = r & 15, cc = c & 31, ob = rr * 64 + cc * 2; return st * 1024 + (ob ^ (((ob >> 9) & 1) << 5)); }
__host__ __device__ __forceinline__ void stage_rc(int b, int& R, int& C) { const int st = b / 1024, sb = b % 1024, swz = sb ^ (((sb >> 9) & 1) << 5); R = (st >> 1) * 16 + swz / 64; C = (st & 1) * 32 + (swz % 64) / 2; }
__host__ __device__ __forceinline__ int perm32(int rho) { const int n = rho >> 4, i = rho & 15; return 8 * (i >> 2) + 4 * n + (i & 3); }

struct Unit { int pm, pn; };
struct Gemm { const bf16_t* A; const bf16_t* Bt; int M, N, K; };

struct StaticOrder {
    int nM, nN, nwg, G, c;
    __host__ __device__ void init(int M, int N, int G_, int c_) { nM = M / BM; nN = N / BM; nwg = nM * nN; G = G_; c = c_; }
    __host__ __device__ bool next(int i, Unit& u) const {
        const long L = (long)i * G + c; if (L >= nwg) return false;
        int wgid = (int)L; { const int q = nwg / NXCD, r = nwg % NXCD, xcd = wgid % NXCD, off = wgid / NXCD; wgid = (xcd < r ? xcd * (q + 1) : r * (q + 1) + (xcd - r) * q) + off; }
        const int nig = WGM * nN, gid = wgid / nig, fm = gid * WGM, gsz = (nM - fm) < WGM ? (nM - fm) : WGM;
        u.pm = fm + ((wgid % nig) % gsz); u.pn = (wgid % nig) / gsz; return true;
    }
    __device__ __forceinline__ void a_ready(const Unit&) const {}
    __device__ __forceinline__ void done(const Unit&) const {}
};
struct CountedOrder : StaticOrder {
    const unsigned* ready; unsigned need; unsigned* tmo;
    __device__ __forceinline__ void a_ready(const Unit& u) const {
        if (threadIdx.x < 64) {
            const unsigned long long t0 = __builtin_amdgcn_s_memrealtime(); unsigned polls = 0;
            while ((unsigned)__builtin_amdgcn_readfirstlane(__hip_atomic_load(ready + 64 * u.pm, __ATOMIC_RELAXED, __HIP_MEMORY_SCOPE_AGENT)) < need) {
                if ((++polls & 255u) == 0u && __builtin_amdgcn_readfirstlane(__hip_atomic_load(tmo, __ATOMIC_RELAXED, __HIP_MEMORY_SCOPE_AGENT)) != 0u) break;
                if (__builtin_amdgcn_s_memrealtime() - t0 > 2000000ull) {
                    if (threadIdx.x == 0) { unsigned expect = 0u; __hip_atomic_compare_exchange_strong(tmo + 1, &expect, 0x600u | (unsigned)(u.pm & 0xff), __ATOMIC_RELAXED, __ATOMIC_RELAXED, __HIP_MEMORY_SCOPE_AGENT); __hip_atomic_store(tmo, 1u, __ATOMIC_RELAXED, __HIP_MEMORY_SCOPE_AGENT); }
                    break; }
                __builtin_amdgcn_s_sleep(2); }
            __builtin_amdgcn_fence(__ATOMIC_ACQUIRE, "agent");
            asm volatile("s_waitcnt vmcnt(0)" ::: "memory");
        }
#if !defined(BROKEN_HOOK_NO_BARRIER)
        asm volatile("" ::: "memory"); __builtin_amdgcn_s_barrier(); asm volatile("" ::: "memory");
#endif
    }
};


template <class Epi, class Sched, bool STAMP = false>
__device__ __forceinline__ void gemm_phase(PG8_LAS unsigned char* lds, const Gemm g, const Sched& S, const Epi& E, unsigned long long* stamps) {
    int tid_ = threadIdx.x; asm volatile("" : "+v"(tid_));
    const int tid = tid_, wid = __builtin_amdgcn_readfirstlane(tid >> 6), lane = tid & 63, wr = wid >> 2, wc = wid & 3, fr = lane & 15, fq = lane >> 4;
    const int K = g.K, nt = K / BK;
    int ts_lo = 0, ts_hi = 0, nts = 0; const unsigned long long rt_entry = STAMP ? (unsigned long long)wall_clock64() : 0ull;
#define PG8_STAMP() do { if (STAMP && wid == 0 && nts < 64) { const unsigned long long _c = (unsigned long long)clock64(); \
        ts_lo = (lane == nts) ? (int)(unsigned)_c : ts_lo; ts_hi = (lane == nts) ? (int)(unsigned)(_c >> 32) : ts_hi; ++nts; } } while (0)
    PG8_STAMP();
    unsigned voffA[2], voffB[2];
#pragma unroll
    for (int i = 0; i < 2; ++i) { int R, C; stage_rc(tid * 16 + i * 8192, R, C); const int Rb = Epi::PERM ? ((R & ~31) + perm32(R & 31)) : R;
        voffA[i] = (unsigned)(R * K + C) * 2u; voffB[i] = (unsigned)(Rb * K + C) * 2u; }
    const size_t kstep = (size_t)(BK * 2);
    const size_t hstep = (size_t)HALF * K * 2;
    const size_t tstep = 2 * hstep;
    const unsigned ldsw = (unsigned)wid * 1024u;
    const int aoff = lds_byte(wr * 64 + fr, fq * 8), boff = lds_byte(wc * 32 + fr, fq * 8);
#define PG8_SA(b, h) (((b) * 2 + (h)) * HTB)
#define PG8_SB(b, h) ((4 + (b) * 2 + (h)) * HTB)
#define PG8_STAGE(bufoff, gbase, voff) do { _Pragma("unroll") for (int _i = 0; _i < 2; ++_i) \
        __builtin_amdgcn_global_load_lds((const unsigned*)((const char*)(gbase) + (voff)[_i]), (PG8_LAS unsigned*)(lds + (bufoff) + ldsw + _i * 8192), 16, 0, 0); } while (0)
#define PG8_LDA(dst, b, h) do { _Pragma("unroll") for (int m = 0; m < 4; ++m) _Pragma("unroll") for (int k = 0; k < 2; ++k) dst[m][k] = *(const PG8_LAS bf16x8*)(lds + PG8_SA(b, h) + aoff + m * 2048 + k * 1024); } while (0)
#define PG8_LDB(dst, b, h) do { _Pragma("unroll") for (int n = 0; n < 2; ++n) _Pragma("unroll") for (int k = 0; k < 2; ++k) dst[n][k] = *(const PG8_LAS bf16x8*)(lds + PG8_SB(b, h) + boff + n * 2048 + k * 1024); } while (0)
#define PG8_MMA(ai, bj, At, Bt) do { __builtin_amdgcn_s_setprio(1); _Pragma("unroll") for (int m = 0; m < 4; ++m) _Pragma("unroll") for (int n = 0; n < 2; ++n) _Pragma("unroll") for (int k = 0; k < 2; ++k) \
        acc[ai][bj][m][n] = __builtin_amdgcn_mfma_f32_16x16x32_bf16(Bt[n][k], At[m][k], acc[ai][bj][m][n], 0, 0, 0); __builtin_amdgcn_s_setprio(0); } while (0)
#define PG8_WAIT_V(n) asm volatile("s_waitcnt vmcnt(" #n ")" ::: "memory")
#define PG8_WAIT_L(n) asm volatile("s_waitcnt lgkmcnt(" #n ")" ::: "memory")
#define PG8_BAR __builtin_amdgcn_s_barrier()
#define PG8_SCHED __builtin_amdgcn_sched_barrier(0)
    Unit cur, nxt; int ui = 0;
    if (!S.next(0, cur)) return;
    f32x4 acc[2][2][4][2];
#pragma unroll
    for (int a = 0; a < 2; ++a)
#pragma unroll
        for (int b = 0; b < 2; ++b)
#pragma unroll
            for (int m = 0; m < 4; ++m)
#pragma unroll
                for (int n = 0; n < 2; ++n) acc[a][b][m][n] = (f32x4){0.f, 0.f, 0.f, 0.f};
    bf16x8 At[4][2], B0[2][2], B1[2][2];
    const char* cA = (const char*)g.A + (size_t)cur.pm * tstep; const char* cB = (const char*)g.Bt + (size_t)cur.pn * tstep;
    S.a_ready(cur);
    PG8_STAGE(PG8_SB(0, 0), cB, voffB); PG8_STAGE(PG8_SA(0, 0), cA, voffA); PG8_STAGE(PG8_SB(0, 1), cB + hstep, voffB); PG8_STAGE(PG8_SA(0, 1), cA + hstep, voffA);
    if (wr == 1) PG8_BAR;
    PG8_WAIT_V(4); PG8_BAR;
    PG8_STAGE(PG8_SB(1, 0), cB + kstep, voffB); PG8_STAGE(PG8_SA(1, 0), cA + kstep, voffA); PG8_STAGE(PG8_SB(1, 1), cB + hstep + kstep, voffB);
    PG8_WAIT_V(6); PG8_BAR;
    PG8_STAMP();
    for (;;) {
        const bool has_next = S.next(ui + 1, nxt);
        const char* nA = has_next ? (const char*)g.A + (size_t)nxt.pm * tstep : cA; const char* nB = has_next ? (const char*)g.Bt + (size_t)nxt.pn * tstep : cB;
        for (int t = 0; t < nt; t += 2) {
            const bool last = (t == nt - 2);
            const char* a1 = cA + (size_t)(t + 1) * kstep;
            const char* a2 = last ? nA : cA + (size_t)(t + 2) * kstep; const char* b2 = last ? nB : cB + (size_t)(t + 2) * kstep;
            const char* a3 = a2 + kstep; const char* b3 = b2 + kstep;
            if (last && has_next) S.a_ready(nxt);
            PG8_LDB(B0, 0, 0); PG8_SCHED; PG8_LDA(At, 0, 0); PG8_STAGE(PG8_SA(1, 1), a1 + hstep, voffA);
            PG8_WAIT_L(8); PG8_BAR; PG8_WAIT_L(0); PG8_MMA(0, 0, At, B0); PG8_BAR; PG8_SCHED;
            PG8_LDB(B1, 0, 1); PG8_STAGE(PG8_SB(0, 0), b2, voffB);
            PG8_BAR; PG8_WAIT_L(0); PG8_MMA(0, 1, At, B1); PG8_BAR;
            PG8_LDA(At, 0, 1); PG8_STAGE(PG8_SA(0, 0), a2, voffA);
            PG8_BAR; PG8_WAIT_L(0); PG8_MMA(1, 0, At, B0); PG8_BAR; PG8_SCHED;
            PG8_STAGE(PG8_SB(0, 1), b2 + hstep, voffB);
            PG8_WAIT_V(6); PG8_BAR; PG8_MMA(1, 1, At, B1); PG8_BAR;
            PG8_LDB(B0, 1, 0); PG8_SCHED; PG8_LDA(At, 1, 0); PG8_STAGE(PG8_SA(0, 1), a2 + hstep, voffA);
            PG8_WAIT_L(8); PG8_BAR; PG8_WAIT_L(0); PG8_MMA(0, 0, At, B0); PG8_BAR; PG8_SCHED;
            PG8_LDB(B1, 1, 1); PG8_STAGE(PG8_SB(1, 0), b3, voffB);
            PG8_BAR; PG8_WAIT_L(0); PG8_MMA(0, 1, At, B1); PG8_BAR;
            PG8_LDA(At, 1, 1); PG8_STAGE(PG8_SA(1, 0), a3, voffA);
            PG8_BAR; PG8_WAIT_L(0); PG8_MMA(1, 0, At, B0); PG8_BAR; PG8_SCHED;
            PG8_STAGE(PG8_SB(1, 1), b3 + hstep, voffB);
            PG8_WAIT_V(6); PG8_BAR; PG8_MMA(1, 1, At, B1); PG8_BAR;
        }
        PG8_STAMP();
        if constexpr (!Epi::AFTER_DRAIN) { E(acc, cur, wr, wc, fr, fq); S.done(cur); }
        PG8_STAMP();
        if (!has_next) break;
#pragma unroll
        for (int a = 0; a < 2; ++a)
#pragma unroll
            for (int b = 0; b < 2; ++b)
#pragma unroll
                for (int m = 0; m < 4; ++m)
#pragma unroll
                    for (int n = 0; n < 2; ++n) acc[a][b][m][n] = (f32x4){0.f, 0.f, 0.f, 0.f};
        cur = nxt; cA = nA; cB = nB; ++ui;
    }
    PG8_WAIT_V(0);
    if (wr == 0) PG8_BAR;
    PG8_BAR;
    if constexpr (Epi::AFTER_DRAIN) { E.fused(acc, cur, wr, wc, fr, fq, lds, wid, lane); S.done(cur); }
    PG8_STAMP();
    if (STAMP && wid == 0) { stamps[lane] = lane < nts ? (((unsigned long long)(unsigned)ts_hi << 32) | (unsigned)ts_lo) : 0ull;
        if (lane == 62) stamps[62] = rt_entry; if (lane == 63) stamps[63] = (unsigned long long)wall_clock64(); }
#undef PG8_STAMP
#undef PG8_SA
#undef PG8_SB
#undef PG8_STAGE
#undef PG8_LDA
#undef PG8_LDB
#undef PG8_MMA
#undef PG8_WAIT_V
#undef PG8_WAIT_L
#undef PG8_BAR
#undef PG8_SCHED
}
}

#define XB_TMO      128
#define XB_XCNT(j)  (256  + 64 * (j))
#define XB_XSUB(j)  (1280 + 64 * (j))
#define XB_XGEN(j)  (2304 + 64 * (j))
#define XB_TOP      3328
#define XB_TOPGEN   3392
#define XCD_BAR_WORDS 3456
#define XB_SPIN_CAP (1u << 18)
#define LAS __attribute__((address_space(3)))

__device__ __forceinline__ unsigned xb_ld(unsigned* p)              { return __hip_atomic_load(p, __ATOMIC_RELAXED, __HIP_MEMORY_SCOPE_AGENT); }
__device__ __forceinline__ unsigned xb_add(unsigned* p, unsigned v) { return __hip_atomic_fetch_add(p, v, __ATOMIC_RELAXED, __HIP_MEMORY_SCOPE_AGENT); }
__device__ __forceinline__ unsigned xb_xcc_id() { return (unsigned)__builtin_amdgcn_s_getreg((3 << 11) | 20) & 0xFu; }
#define XB_SPIN(cond, bar) do { unsigned _sp = 0; while (cond) { __builtin_amdgcn_s_sleep(1); \
    if ((++_sp & 255u) == 0u) { if (xb_ld(&(bar)[XB_TMO])) break; if (_sp > XB_SPIN_CAP) { atomicAdd(&(bar)[XB_TMO], 1u); break; } } } } while (0)

struct XcdBarrier {
    unsigned* bar; unsigned x;
    volatile LAS unsigned* st;
};

__device__ __forceinline__ XcdBarrier xcd_barrier_post(unsigned* bar, volatile LAS unsigned* st) {
    XcdBarrier b; b.bar = bar; b.x = xb_xcc_id(); b.st = st;
    if (threadIdx.x == 0) (void)xb_add(&bar[XB_XCNT(b.x)], 1u);
    return b;
}
__device__ __forceinline__ void xcd_barrier_complete(unsigned* bar, unsigned x, unsigned& nloc, unsigned& nx) {
    const unsigned G = gridDim.x * gridDim.y * gridDim.z;
    unsigned sum, cnt, mine, sp = 0u;
    for (;;) {
        sum = 0u; cnt = 0u; mine = 0u;
#pragma unroll
        for (unsigned j = 0; j < 16; ++j) { const unsigned c = xb_ld(&bar[XB_XCNT(j)]); sum += c; cnt += (c > 0u) ? 1u : 0u; mine = (j == x) ? c : mine; }
        if (sum == G) break;
        __builtin_amdgcn_s_sleep(1);
        if ((++sp & 255u) == 0u) { if (xb_ld(&bar[XB_TMO])) break; if (sp > XB_SPIN_CAP) { atomicAdd(&bar[XB_TMO], 1u); break; } }
    }
    nloc = mine > 0u ? mine : 1u; nx = cnt > 0u ? cnt : 1u;
}

__device__ __forceinline__ void xcd_barrier(const XcdBarrier& b) {
    asm volatile("s_waitcnt vmcnt(0)" ::: "memory");
    __syncthreads();
    if (threadIdx.x == 0) {
        unsigned* bar = b.bar;
        __builtin_amdgcn_s_waitcnt(0);
        unsigned nloc = b.st[0], nx = b.st[1];
        if (nloc == 0u) { xcd_barrier_complete(bar, b.x, nloc, nx); b.st[0] = nloc; b.st[1] = nx; }
        const unsigned old = xb_add(&bar[XB_XSUB(b.x)], 1u);
        const unsigned gen = old / nloc;
        if (old + 1u == (gen + 1u) * nloc) {
            __builtin_amdgcn_fence(__ATOMIC_RELEASE, "agent");
            asm volatile("s_waitcnt vmcnt(0)" ::: "memory");
            const unsigned og = xb_add(&bar[XB_TOP], 1u);
            const unsigned tg = og / nx;
            if (og + 1u == (tg + 1u) * nx) xb_add(&bar[XB_TOPGEN], 1u);
            else XB_SPIN(xb_ld(&bar[XB_TOPGEN]) == tg, bar);
            __builtin_amdgcn_fence(__ATOMIC_ACQUIRE, "agent");
            xb_add(&bar[XB_XGEN(b.x)], 1u);
            asm volatile("s_waitcnt vmcnt(0)" ::: "memory");
        } else {
            XB_SPIN(xb_ld(&bar[XB_XGEN(b.x)]) == gen, bar);
            __builtin_amdgcn_fence(__ATOMIC_ACQUIRE, "agent");
            asm volatile("s_waitcnt vmcnt(0)" ::: "memory");
        }
    }
    __syncthreads();
}

namespace nk {
using pg8::bf16_t; using pg8::bf16x8; using pg8::f32x4; using pg8::u32x4; using pg8::Unit;
constexpr int NTH = 512;
constexpr int LDS_STAGE = pg8::STAGE_BYTES;
constexpr int LDS_MISC = 158720;
constexpr int LDS_BYTES = LDS_MISC + 1024;

constexpr size_t NB0 = WS_END * 4;
constexpr size_t NB_BAR = NB0;
constexpr size_t NB_WT1 = NB_BAR + 32768;
constexpr size_t NB_WT2 = NB_WT1 + (size_t)3584 * 1024 * 2;
constexpr size_t NB_XB = NB_WT2 + (size_t)1024 * 1024 * 2;
constexpr size_t NB_XSB = NB_XB + (size_t)MP * 1024 * 2;
constexpr size_t NB_HB = NB_XSB + (size_t)BS * 1024 * 2;
constexpr size_t NB_KVB = NB_HB + (size_t)MT * 2560 * 2;
constexpr size_t NB_G3 = NB_KVB + (size_t)MT * 768 * 2;
constexpr size_t NB_CATB = NB_G3 + (size_t)MT * 32 * 4;
constexpr size_t NB_CBUF = NB_CATB + (size_t)MT * 1024 * 2;
constexpr size_t NB_KCB = NB_CBUF + (size_t)MP * 512 * 4;
constexpr size_t NB_WT3 = NB_KCB + (size_t)BP * 64 * 256 * 2;
constexpr size_t NB_WT4 = NB_WT3 + (size_t)4 * 1024 * 1024 * 2;
constexpr size_t NB_W1T = NB_WT4 + (size_t)1024 * 1024 * 2;
constexpr size_t NB_A1T = NB_W1T + (size_t)64 * 1024 * 2;
constexpr size_t NB_W2T = NB_A1T + (size_t)64 * 1024 * 2;
constexpr size_t NB_A2T = NB_W2T + (size_t)64 * 1024 * 2;
constexpr size_t NB_KCS = NB_A2T + (size_t)64 * 1024 * 2;
constexpr size_t NB_OCS = NB_KCS + (size_t)BS * 256 * 256 * 4;
constexpr size_t NB_PARTS = NB_OCS + (size_t)BS * 8 * 64 * 4;
constexpr size_t NB_END = NB_PARTS + (size_t)BS * 8 * 24 * 66 * 4;
constexpr size_t NB_XSH = 0;
constexpr size_t NB_RKVZ = NB_XSH + (size_t)6 * 16640 * 1024 * 2;
constexpr size_t NB_TWB = NB_RKVZ + (size_t)4 * 16640 * 1024 * 2;
constexpr size_t NB_AWB = NB_TWB + (size_t)MT * 64 * 2;
constexpr size_t NB_RKS = NB_AWB + (size_t)MT * 64 * 2;
static_assert(NB_RKS + (size_t)MT * 16 * 4 <= WS_PRE * 4, "layer-1 region A overflows into PRE");
constexpr size_t NB_DEC = (WS_X1 + SZ_ROWD) * 4;
constexpr size_t NB_KKN = NB_DEC + (size_t)MT * 1024 * 4;
constexpr size_t NB_KKA = NB_KKN + (size_t)MT * 1024 * 2;
constexpr size_t NB_KP = NB_KKA + (size_t)MT * 1024 * 2;
constexpr size_t NB_Y = NB_KP + (size_t)MT * 1024 * 2;
constexpr size_t NB_G4B = NB_Y + (size_t)MT * 1024 * 4;
constexpr size_t NB_CHK = NB_G4B + (size_t)MT * 1024 * 2;
constexpr size_t NB_SREC = NB_CHK + (size_t)4096 * 32768;
static_assert(NB_SREC + (size_t)4096 * 8192 <= NB0, "layer-1 region B overflows");
constexpr int N1PAD = 3584;
__host__ __device__ __forceinline__ int win_src_col(int n) { return n < 2048 ? n : (n < 2560 ? C_ZB + (n - 2048) : (n < 3328 ? C_KV + (n - 2560) : (n < 3352 ? C_G3 + (n - 3328) : -1))); }

__device__ __forceinline__ int opaque(int x) { asm volatile("" : "+s"(x)); return x; }
__device__ __forceinline__ void lds_barrier() { asm volatile("s_waitcnt lgkmcnt(0)" ::: "memory"); __builtin_amdgcn_s_barrier(); asm volatile("" ::: "memory"); }
__device__ __forceinline__ int opaque_v(int x) { asm volatile("" : "+v"(x)); return x; }
struct Args { const float* in[N_IN]; float* out; unsigned char* ws; int ph_lo, ph_hi; };

__device__ __forceinline__ unsigned pk_bf16(float lo, float hi) { unsigned r; asm volatile("v_cvt_pk_bf16_f32 %0, %1, %2" : "=v"(r) : "v"(lo), "v"(hi)); return r; }
typedef __bf16 bf16x2_t __attribute__((ext_vector_type(2)));
__device__ __forceinline__ unsigned pk_bf16c(float lo, float hi) { bf16x2_t v; v[0] = (__bf16)lo; v[1] = (__bf16)hi; return __builtin_bit_cast(unsigned, v); }

template <class MAP>
__device__ __forceinline__ void convert_wt(const float* __restrict__ W, int K, int ldw, bf16_t* __restrict__ Wt, int Npad, MAP map, int bid, int nb) {
    const int kg = K / 8;
    const size_t total = (size_t)Npad * kg;
    for (size_t i = (size_t)bid * NTH + threadIdx.x; i < total; i += (size_t)nb * NTH) {
        const int n = (int)(i % Npad), k0 = (int)(i / Npad) * 8;
        const int sc = map(n);
        u32x4 w = {0u, 0u, 0u, 0u};
        if (sc >= 0) {
            float v[8];
#pragma unroll
            for (int j = 0; j < 8; ++j) v[j] = W[(size_t)(k0 + j) * ldw + sc];
            w.x = pk_bf16(v[0], v[1]); w.y = pk_bf16(v[2], v[3]); w.z = pk_bf16(v[4], v[5]); w.w = pk_bf16(v[6], v[7]);
        }
        *(u32x4*)(Wt + (size_t)n * K + k0) = w;
    }
}
struct MapId { __device__ __forceinline__ int operator()(int n) const { return n; } };
struct MapWin { __device__ __forceinline__ int operator()(int n) const { return win_src_col(n); } };
__device__ __forceinline__ void convert_rows(const float* __restrict__ src, size_t n8, bf16_t* __restrict__ dst, int bid, int nb) {
#pragma unroll 4
    for (size_t i = (size_t)bid * NTH + threadIdx.x; i < n8; i += (size_t)nb * NTH) {
        const float4 a = *(const float4*)(src + i * 8), b = *(const float4*)(src + i * 8 + 4);
        u32x4 w; w.x = pk_bf16(a.x, a.y); w.y = pk_bf16(a.z, a.w); w.z = pk_bf16(b.x, b.y); w.w = pk_bf16(b.z, b.w);
        *(u32x4*)(dst + i * 8) = w;
    }
}

struct EpiPre {
    static constexpr bool PERM = false, AFTER_DRAIN = false;
    float* C; int ldc;
    __device__ __forceinline__ void operator()(const f32x4 (&acc)[2][2][4][2], const Unit& u, int wr, int wc, int fr, int fq) const {
        const int row0 = u.pm * 256 + wr * 64 + fr, col0 = u.pn * 256 + wc * 32 + 4 * fq;
#pragma unroll
        for (int ai = 0; ai < 2; ++ai)
#pragma unroll
            for (int m = 0; m < 4; ++m) { float* rowp = C + (size_t)(row0 + ai * 128 + m * 16) * ldc + col0;
#pragma unroll
                for (int bj = 0; bj < 2; ++bj)
#pragma unroll
                    for (int n = 0; n < 2; ++n) *(f32x4*)(rowp + bj * 128 + n * 16) = acc[ai][bj][m][n]; }
    }
};


struct Route1 {
    bf16_t* HB; bf16_t* KVB; float* G3; float* out;
    __device__ __forceinline__ void put8(int row, int n0, const f32x4& v0, const f32x4& v1) const {
        if (n0 < 2560) {
            const float sc = (n0 >= 1536 && n0 < 2048) ? 0.125f : 1.0f;
            u32x4 w; w.x = pk_bf16c(v0[0] * sc, v0[1] * sc); w.y = pk_bf16c(v0[2] * sc, v0[3] * sc); w.z = pk_bf16c(v1[0] * sc, v1[1] * sc); w.w = pk_bf16c(v1[2] * sc, v1[3] * sc);
            *(u32x4*)(HB + (size_t)row * 2560 + n0) = w;
        } else if (n0 < 3328) {
            const int c = n0 - 2560, i3 = c >> 8, cc = c & 255;
            u32x4 w; w.x = pk_bf16c(v0[0], v0[1]); w.y = pk_bf16c(v0[2], v0[3]); w.z = pk_bf16c(v1[0], v1[1]); w.w = pk_bf16c(v1[2], v1[3]);
            *(u32x4*)(KVB + (size_t)row * 768 + c) = w;
            float* dst = nullptr;
            if (row < MP) {
                if (i3 == 0) dst = out + O_CMPP + (size_t)row * 256 + cc;
                else if (i3 == 1) dst = out + O_SELP + (size_t)row * 256 + cc;
                else { const int b = row >> 11, t = row & 2047; if (t >= TP - 512) dst = out + O_WINP + (size_t)(b * 512 + t - (TP - 512)) * 256 + cc; }
            } else {
                const int sidx = row - MP;
                if (i3 == 0) dst = out + O_CMPS + (size_t)sidx * 256 + cc;
                else if (i3 == 1) dst = out + O_SELS + (size_t)sidx * 256 + cc;
                else dst = out + O_WINS + (size_t)(sidx * 512 + 511) * 256 + cc;
            }
            if (dst) { *(f32x4*)dst = v0; *(f32x4*)(dst + 4) = v1; }
        } else if (n0 < 3352) {
            float* dst = G3 + (size_t)row * 32 + (n0 - 3328);
            *(f32x4*)dst = v0; *(f32x4*)(dst + 4) = v1;
        }
    }
};
struct Epi1 {
    static constexpr bool PERM = true, AFTER_DRAIN = false;
    Route1 R;
    __device__ __forceinline__ void operator()(const f32x4 (&acc)[2][2][4][2], const Unit& u, int wr, int wc, int fr, int fq) const {
        const int row0 = u.pm * 256 + wr * 64 + fr, col0 = u.pn * 256 + wc * 32 + 8 * fq;
#pragma unroll
        for (int ai = 0; ai < 2; ++ai)
#pragma unroll
            for (int m = 0; m < 4; ++m)
#pragma unroll
                for (int bj = 0; bj < 2; ++bj) R.put8(row0 + ai * 128 + m * 16, col0 + bj * 128, acc[ai][bj][m][0], acc[ai][bj][m][1]);
    }
};

typedef float f32x16 __attribute__((ext_vector_type(16)));
template <class EMIT>
__device__ __forceinline__ void sample_gemm32(const bf16_t* __restrict__ A, const bf16_t* __restrict__ Bt, int K, int n0, int lane, EMIT emit) {
    const bf16_t* ap = A + (size_t)(lane & 31) * K + 8 * (lane >> 5);
    const bf16_t* bp = Bt + (size_t)(n0 + (lane & 31)) * K + 8 * (lane >> 5);
    f32x16 acc;
#pragma unroll
    for (int i = 0; i < 16; ++i) acc[i] = 0.f;
#pragma unroll 16
    for (int k = 0; k < K; k += 16) {
        const bf16x8 av = *(const bf16x8*)(ap + k), bv = *(const bf16x8*)(bp + k);
        acc = __builtin_amdgcn_mfma_f32_32x32x16_bf16(av, bv, acc, 0, 0, 0);
    }
#pragma unroll
    for (int r = 0; r < 16; ++r) emit((r & 3) + 8 * (r >> 2) + 4 * (lane >> 5), n0 + (lane & 31), acc[r]);
}

template <class EMIT>
__device__ __forceinline__ void sample_gemm32_wg(const bf16_t* __restrict__ A, const bf16_t* __restrict__ Bt, int K, int n0, PG8_LAS unsigned char* lds, EMIT emit) {
    const int tid = opaque_v(threadIdx.x), lane = tid & 63, wv = tid >> 6;
    const int kq = K / 8;
    const bf16_t* ap = A + (size_t)(lane & 31) * K + 8 * (lane >> 5) + wv * kq;
    const bf16_t* bp = Bt + (size_t)(n0 + (lane & 31)) * K + 8 * (lane >> 5) + wv * kq;
    f32x16 acc;
#pragma unroll
    for (int i = 0; i < 16; ++i) acc[i] = 0.f;
#pragma unroll 8
    for (int k = 0; k < kq; k += 16) {
        const bf16x8 av = *(const bf16x8*)(ap + k), bv = *(const bf16x8*)(bp + k);
        acc = __builtin_amdgcn_mfma_f32_32x32x16_bf16(av, bv, acc, 0, 0, 0);
    }
    PG8_LAS float* P = (PG8_LAS float*)lds;
#pragma unroll
    for (int q = 0; q < 4; ++q) *(PG8_LAS f32x4*)(P + (wv * 64 + lane) * 16 + q * 4) = (f32x4){acc[4 * q], acc[4 * q + 1], acc[4 * q + 2], acc[4 * q + 3]};
    __syncthreads();
    if (wv == 0) {
#pragma unroll
        for (int w = 1; w < 8; ++w)
#pragma unroll
            for (int q = 0; q < 4; ++q) { const f32x4 v = *(const PG8_LAS f32x4*)(P + (w * 64 + lane) * 16 + q * 4); acc[4 * q] += v[0]; acc[4 * q + 1] += v[1]; acc[4 * q + 2] += v[2]; acc[4 * q + 3] += v[3]; }
#pragma unroll
        for (int r = 0; r < 16; ++r) emit((r & 3) + 8 * (r >> 2) + 4 * (lane >> 5), n0 + (lane & 31), acc[r]);
    }
    __syncthreads();
}

typedef float f32x16 __attribute__((ext_vector_type(16)));
__device__ __forceinline__ float bf2f(bf16_t v) { return __uint_as_float((unsigned)v << 16); }
__device__ __forceinline__ float sigm_f(float x) { return 1.f / (1.f + __expf(-x)); }
__device__ __forceinline__ float silu_f(float x) { return x / (1.f + __expf(-x)); }

__device__ __forceinline__ float wsum64(float v) {
    v += __builtin_bit_cast(float, __builtin_amdgcn_update_dpp(0, __builtin_bit_cast(int, v), 0xB1, 0xF, 0xF, true));
    v += __builtin_bit_cast(float, __builtin_amdgcn_update_dpp(0, __builtin_bit_cast(int, v), 0x4E, 0xF, 0xF, true));
    v += __builtin_bit_cast(float, __builtin_amdgcn_update_dpp(0, __builtin_bit_cast(int, v), 0x141, 0xF, 0xF, true));
    v += __builtin_bit_cast(float, __builtin_amdgcn_update_dpp(0, __builtin_bit_cast(int, v), 0x140, 0xF, 0xF, true));
    v += __shfl_xor(v, 16); v += __shfl_xor(v, 32);
    return v;
}
constexpr int CV_U = 0;
constexpr int CV_C = 65536;
__device__ __forceinline__ void conv_item(const Args& a, unsigned char* ws, PG8_LAS unsigned char* lds, int item) {
    const int tid = opaque_v(threadIdx.x);
    const int b = item >> 6, t0 = (item & 63) * 32;
    const bf16_t* HB = (const bf16_t*)(ws + NB_HB);
    PG8_LAS float* U = (PG8_LAS float*)(lds + CV_U);
    PG8_LAS float* C = (PG8_LAS float*)(lds + CV_C);
    const int chl = tid & 255, tp = tid >> 8;
    const int lane = tid & 63, wv = tid >> 6;
    u32x4 zv[4];
#pragma unroll
    for (int k = 0; k < 4; ++k) zv[k] = *(const u32x4*)(HB + (size_t)(b * TP + t0 + wv * 4 + k) * 2560 + 1024 + lane * 8);
#pragma unroll 1
    for (int half = 0; half < 2; ++half) {
        const int chb = half * 256;
#pragma unroll
        for (int it = 0; it < 4; ++it) {
            const int vi = tid + it * NTH;
            if (vi < 62 * 32) {
                const int r = vi >> 5, c8 = (vi & 31) * 8, t = t0 - 30 + r;
                float u[8];
                if (t >= 0) {
                    const bf16_t* h = HB + (size_t)(b * TP + t) * 2560 + chb + c8;
                    const u32x4 av = *(const u32x4*)h, gv = *(const u32x4*)(h + 512);
#pragma unroll
                    for (int i = 0; i < 8; ++i) {
                        const float x = __uint_as_float((i & 1) ? (av[i >> 1] & 0xffff0000u) : (av[i >> 1] << 16));
                        const float g = __uint_as_float((i & 1) ? (gv[i >> 1] & 0xffff0000u) : (gv[i >> 1] << 16));
                        u[i] = x * sigm_f(g);
                    }
                } else {
#pragma unroll
                    for (int i = 0; i < 8; ++i) u[i] = 0.f;
                }
                *(PG8_LAS f32x4*)(U + r * 256 + c8) = (f32x4){u[0], u[1], u[2], u[3]};
                *(PG8_LAS f32x4*)(U + r * 256 + c8 + 4) = (f32x4){u[4], u[5], u[6], u[7]};
                if (t >= TP - 30 && r >= 30) {
                    float* o = a.out + O_CONVP + (size_t)(b * 30 + t - (TP - 30)) * 512 + chb + c8;
                    *(float4*)o = make_float4(u[0], u[1], u[2], u[3]); *(float4*)(o + 4) = make_float4(u[4], u[5], u[6], u[7]);
                }
            }
        }
        __syncthreads();
        {
            const int ch = chb + chl;
            float w[31], uw[46], acc[16];
#pragma unroll
            for (int j = 0; j < 31; ++j) w[j] = a.in[I_CONVW][j * 512 + ch];
            const float bias = a.in[I_CONVB][ch];
#pragma unroll
            for (int r = 0; r < 46; ++r) uw[r] = U[(tp * 16 + r) * 256 + chl];
#pragma unroll
            for (int k = 0; k < 16; ++k) {
                float s_ = bias;
#pragma unroll
                for (int j = 0; j < 31; ++j) s_ = fmaf(w[j], uw[k + j], s_);
                acc[k] = s_;
            }
#pragma unroll
            for (int k = 0; k < 16; ++k) C[(tp * 16 + k) * 516 + ch] = acc[k];
        }
        __syncthreads();
    }
    {
        const float4 g0 = *(const float4*)(a.in[I_CLNG] + lane * 8), g1 = *(const float4*)(a.in[I_CLNG] + lane * 8 + 4);
        const float4 b0 = *(const float4*)(a.in[I_CLNB] + lane * 8), b1 = *(const float4*)(a.in[I_CLNB] + lane * 8 + 4);
        const float gg[8] = {g0.x, g0.y, g0.z, g0.w, g1.x, g1.y, g1.z, g1.w}, bb[8] = {b0.x, b0.y, b0.z, b0.w, b1.x, b1.y, b1.z, b1.w};
#pragma unroll
        for (int k = 0; k < 4; ++k) {
            const int tl = wv * 4 + k;
            const size_t row = (size_t)(b * TP + t0 + tl);
            const f32x4 c0 = *(const PG8_LAS f32x4*)(C + tl * 516 + lane * 8), c1 = *(const PG8_LAS f32x4*)(C + tl * 516 + lane * 8 + 4);
            float c[8] = {c0[0], c0[1], c0[2], c0[3], c1[0], c1[1], c1[2], c1[3]};
            float sm = 0.f;
#pragma unroll
            for (int i = 0; i < 8; ++i) sm += c[i];
            const float mean = wsum64(sm) * (1.f / 512.f);
            float sq = 0.f;
#pragma unroll
            for (int i = 0; i < 8; ++i) { c[i] -= mean; sq += c[i] * c[i]; }
            const float rs = rsqrtf(wsum64(sq) * (1.f / 512.f) + LN_EPS);
            float y[8];
#pragma unroll
            for (int i = 0; i < 8; ++i) {
                const float z = __uint_as_float((i & 1) ? (zv[k][i >> 1] & 0xffff0000u) : (zv[k][i >> 1] << 16));
                y[i] = silu_f(c[i] * rs * gg[i] + bb[i]) * silu_f(z);
            }
            u32x4 o; o.x = pk_bf16(y[0], y[1]); o.y = pk_bf16(y[2], y[3]); o.z = pk_bf16(y[4], y[5]); o.w = pk_bf16(y[6], y[7]);
            *(u32x4*)((bf16_t*)(ws + NB_CATB) + row * 1024 + lane * 8) = o;
        }
    }
    __syncthreads();
}

__device__ __forceinline__ void pool_prompt(const Args& a, unsigned char* ws, int bid, int nb) {
    bf16_t* KCB = (bf16_t*)(ws + NB_KCB);
    for (int i = bid * NTH + threadIdx.x; i < BP * 64 * 256; i += nb * NTH) {
        const int c = i & 255, n = (i >> 8) & 63, b = i >> 14;
        const int kv = c >> 7, g = (c >> 6) & 1;
        const float* w = kv ? a.in[I_WVC] : a.in[I_WKC];
        const float* src = a.out + O_CMPP + (size_t)(b * TP + n * 32) * 256 + c;
        float acc = 0.f;
#pragma unroll 8
        for (int l = 0; l < 32; ++l) acc = fmaf(src[(size_t)l * 256], w[l * 2 + g], acc);
        KCB[i] = (bf16_t)(pk_bf16(acc, 0.f) & 0xffffu);
    }
}

constexpr int A_KT = 0;
constexpr int A_VT = 18432;
constexpr int A_IMPH = 35840;
constexpr int A_IMPS = 68608;
constexpr int A_MASK = 76800;
constexpr float LOG2E = 1.4426950408889634f;

struct KvSrc { const bf16_t* k; const bf16_t* v; int rstride; };

__device__ __forceinline__ void kv_issue(const KvSrc& s, int tid, u32x4& kr, u32x4& vr) {
    const int key = tid >> 3, c8 = tid & 7;
    kr = *(const u32x4*)(s.k + (size_t)key * s.rstride + c8 * 8);
    vr = *(const u32x4*)(s.v + (size_t)key * s.rstride + c8 * 8);
}
__device__ __forceinline__ void kv_write(PG8_LAS unsigned char* lds, int buf, int tid, const u32x4& kr, const u32x4& vr) {
    const int key = tid >> 3, c8 = tid & 7;
    *(PG8_LAS u32x4*)(lds + A_KT + buf * 9216 + key * 144 + c8 * 16) = kr;
    PG8_LAS bf16_t* vt = (PG8_LAS bf16_t*)(lds + A_VT + buf * 8704);
#pragma unroll
    for (int i = 0; i < 4; ++i) { vt[(c8 * 8 + 2 * i) * 68 + key] = (bf16_t)(vr[i] & 0xffffu); vt[(c8 * 8 + 2 * i + 1) * 68 + key] = (bf16_t)(vr[i] >> 16); }
}

__device__ __forceinline__ void attn_block(const int MODE, PG8_LAS unsigned char* lds, int buf, const bf16x8 (&qf)[4], int lane, float kslope, float base, int kmax, int kmin,
                                           float& m, float& l, f32x16 (&o)[2], f32x16 (&x)[2]) {
    const int lr = lane & 31, h = lane >> 5;
    const PG8_LAS unsigned char* kt_p = lds + A_KT + buf * 9216 + lr * 144 + h * 16;
#pragma unroll
    for (int kt = 0; kt < 2; ++kt) {
#pragma unroll
        for (int i = 0; i < 16; ++i) x[kt][i] = 0.f;
#pragma unroll
        for (int s = 0; s < 4; ++s) {
            const bf16x8 kf = *(const PG8_LAS bf16x8*)(kt_p + kt * 32 * 144 + s * 32);
            x[kt] = __builtin_amdgcn_mfma_f32_32x32x16_bf16(kf, qf[s], x[kt], 0, 0, 0);
        }
    }
    const float bh = base + kslope * (float)(4 * h);
    float mx = -INFINITY;
#pragma unroll
    for (int kt = 0; kt < 2; ++kt)
#pragma unroll
        for (int i = 0; i < 16; ++i) {
            const int kc = kt * 32 + (i & 3) + 8 * (i >> 2);
            x[kt][i] = fmaf(x[kt][i], LOG2E, fmaf(kslope, (float)kc, bh));
        }
    if (MODE) {
        const int hi = kmax - 4 * h, lo = kmin - 4 * h;
#pragma unroll
        for (int kt = 0; kt < 2; ++kt)
#pragma unroll
            for (int i = 0; i < 16; ++i) {
                const int kc = kt * 32 + (i & 3) + 8 * (i >> 2);
                x[kt][i] = (kc > hi || kc < lo) ? -INFINITY : x[kt][i];
            }
    }
#pragma unroll
    for (int kt = 0; kt < 2; ++kt)
#pragma unroll
        for (int i = 0; i < 16; ++i) mx = fmaxf(mx, x[kt][i]);
    mx = fmaxf(mx, __shfl_xor(mx, 32));
    const float mn = fmaxf(m, mx);
    const float corr = __builtin_amdgcn_exp2f(m - mn);
    const bool grew = __any(mn > m);
    m = mn;
    float ls = 0.f;
#pragma unroll
    for (int kt = 0; kt < 2; ++kt)
#pragma unroll
        for (int i = 0; i < 16; ++i) { const float pv = __builtin_amdgcn_exp2f(x[kt][i] - mn); x[kt][i] = pv; ls += pv; }
    l = fmaf(l, corr, ls);
    if (grew) {
#pragma unroll
        for (int dt = 0; dt < 2; ++dt)
#pragma unroll
            for (int i = 0; i < 16; ++i) o[dt][i] *= corr;
    }
    const PG8_LAS unsigned char* vt_p = lds + A_VT + buf * 8704 + lr * 136 + h * 8;
#pragma unroll
    for (int kt = 0; kt < 2; ++kt)
#pragma unroll
        for (int s = 0; s < 2; ++s) {
            u32x4 pw; pw.x = pk_bf16(x[kt][8 * s + 0], x[kt][8 * s + 1]); pw.y = pk_bf16(x[kt][8 * s + 2], x[kt][8 * s + 3]);
            pw.z = pk_bf16(x[kt][8 * s + 4], x[kt][8 * s + 5]); pw.w = pk_bf16(x[kt][8 * s + 6], x[kt][8 * s + 7]);
            const bf16x8 pf = __builtin_bit_cast(bf16x8, pw);
#pragma unroll
            for (int dt = 0; dt < 2; ++dt) {
                const PG8_LAS unsigned char* vp = vt_p + dt * 32 * 136 + (kt * 32 + s * 16) * 2;
                typedef unsigned u32x2 __attribute__((ext_vector_type(2)));
                const u32x2 v0 = *(const PG8_LAS u32x2*)vp, v1 = *(const PG8_LAS u32x2*)(vp + 16);
                u32x4 vw; vw.x = v0.x; vw.y = v0.y; vw.z = v1.x; vw.w = v1.y;
                o[dt] = __builtin_amdgcn_mfma_f32_32x32x16_bf16(__builtin_bit_cast(bf16x8, vw), pf, o[dt], 0, 0, 0);
            }
        }
}

__device__ __forceinline__ void attn_item(const Args& a, unsigned char* ws, PG8_LAS unsigned char* lds, int b, int g, int qb) {
    const int tid = opaque_v(threadIdx.x), lane = tid & 63, wv = __builtin_amdgcn_readfirstlane(tid >> 6);
    const int lr = lane & 31, h = lane >> 5;
    const int r = wv >> 1, th = wv & 1, hh = g * 4 + r;
    const int t0 = qb * 64, tb = qb;
    const int qloc = th * 32 + lr;
    const int qpos = t0 + qloc;
    const size_t qrow = (size_t)b * TP + qpos;
    const bf16_t* HB = (const bf16_t*)(ws + NB_HB);
    const bf16_t* KVB = (const bf16_t*)(ws + NB_KVB);
    const float slope2 = __builtin_amdgcn_exp2f(-(float)(hh + 1)) * LOG2E;
    bf16x8 qf[4];
#pragma unroll
    for (int s = 0; s < 4; ++s) qf[s] = *(const bf16x8*)(HB + qrow * 2560 + 1536 + hh * 64 + s * 16 + h * 8);
    const float* g3p = (const float*)(ws + NB_G3) + qrow * 32 + hh * 3;
    const float gc = sigm_f(g3p[0]), gs = sigm_f(g3p[1]), gw = sigm_f(g3p[2]);
    f32x16 res[2], o[2], x[2];
#pragma unroll
    for (int dt = 0; dt < 2; ++dt)
#pragma unroll
        for (int i = 0; i < 16; ++i) { res[dt][i] = 0.f; o[dt][i] = 0.f; }
    float m = -1e30f, l = 0.f;
    u32x4 kr, vr;
    PG8_LAS float* IMPH = (PG8_LAS float*)(lds + A_IMPH);
    PG8_LAS float* IMPS = (PG8_LAS float*)(lds + A_IMPS);
    PG8_LAS unsigned* MASK = (PG8_LAS unsigned*)(lds + A_MASK);

    {
        const bf16_t* kc = (const bf16_t*)(ws + NB_KCB) + (size_t)b * 64 * 256 + g * 64;
        KvSrc s{kc, kc + 128, 256};
        kv_issue(s, tid, kr, vr); kv_write(lds, 0, tid, kr, vr);
        if (tid < 64) MASK[tid] = 0u;
        __syncthreads();
        const int nmax = (qpos >= 31) ? ((qpos - 31) >> 5) : -1;
        attn_block(1, lds, 0, qf, lane, slope2 * 32.f, slope2 * (float)(31 - qpos), nmax, 0, m, l, o, x);
        const float lt = l + __shfl_xor(l, 32);
        const float inv = (nmax >= 0) ? 1.f / lt : 0.f;
        const float sc = gc * inv;
#pragma unroll
        for (int dt = 0; dt < 2; ++dt)
#pragma unroll
            for (int i = 0; i < 16; ++i) { res[dt][i] = o[dt][i] * sc; o[dt][i] = 0.f; }
        if (tb >= 16) {
#pragma unroll
            for (int kt = 0; kt < 2; ++kt)
#pragma unroll
                for (int c = 0; c < 4; ++c)
#pragma unroll
                    for (int e = 0; e < 2; ++e)
                        IMPH[(r * 64 + qloc) * 32 + kt * 16 + 4 * c + 2 * h + e] = (nmax >= 0) ? (x[kt][4 * c + 2 * e] + x[kt][4 * c + 2 * e + 1]) * inv : 0.f;
        }
        m = -1e30f; l = 0.f;
        __syncthreads();
    }
    if (tb >= 16) {
        const int tq = opaque_v(tid);
        const int q = tq >> 3, jq = tq & 7;
        float v4[4];
#pragma unroll
        for (int e = 0; e < 4; ++e) {
            const int j = jq * 4 + e;
            float v = IMPH[(0 * 64 + q) * 32 + j] + IMPH[(1 * 64 + q) * 32 + j] + IMPH[(2 * 64 + q) * 32 + j] + IMPH[(3 * 64 + q) * 32 + j];
            if (j == 0 || j == tb || j == tb - 1) v = 1e4f;
            IMPS[q * 32 + j] = v; v4[e] = v;
        }
        __syncthreads();
        unsigned bits = 0u;
#pragma unroll
        for (int e = 0; e < 4; ++e) {
            const int j = jq * 4 + e;
            int rank = 0;
            for (int i = 0; i <= tb; ++i) { const float vi = IMPS[q * 32 + i]; rank += (vi > v4[e] || (vi == v4[e] && i < j)) ? 1 : 0; }
            if (j <= tb && rank < 16) bits |= 1u << j;
        }
        if (bits) atomicOr((unsigned*)&MASK[q], bits);
    } else {
        if (tid < 64) MASK[tid] = (2u << tb) - 1u;
    }
    __syncthreads();
    const unsigned selmask = MASK[qloc];

    {
        const bf16_t* kb = KVB + (size_t)b * TP * 768 + 256 + g * 64;
        { KvSrc s{kb, kb + 128, 768}; kv_issue(s, tid, kr, vr); kv_write(lds, 0, tid, kr, vr); }
        __syncthreads();
        for (int j = 0; j <= tb; ++j) {
            if (j < tb) { KvSrc s{kb + (size_t)(j + 1) * 64 * 768, kb + (size_t)(j + 1) * 64 * 768 + 128, 768}; kv_issue(s, tid, kr, vr); }
            const float base = ((selmask >> j) & 1u) ? slope2 * (float)(j * 64 - qpos) : -INFINITY;
            attn_block(j == tb, lds, j & 1, qf, lane, slope2, base, qloc, 0, m, l, o, x);
            if (j < tb) kv_write(lds, (j + 1) & 1, tid, kr, vr);
            __syncthreads();
        }
        const float lt = l + __shfl_xor(l, 32);
        const float sc = gs / lt;
#pragma unroll
        for (int dt = 0; dt < 2; ++dt)
#pragma unroll
            for (int i = 0; i < 16; ++i) { res[dt][i] = fmaf(o[dt][i], sc, res[dt][i]); o[dt][i] = 0.f; }
        m = -1e30f; l = 0.f;
    }
    {
        const int jlo = (tb >= 8) ? tb - 8 : 0;
        const bf16_t* kb = KVB + (size_t)b * TP * 768 + 512 + g * 64;
        { KvSrc s{kb + (size_t)jlo * 64 * 768, kb + (size_t)jlo * 64 * 768 + 128, 768}; kv_issue(s, tid, kr, vr); kv_write(lds, 0, tid, kr, vr); }
        __syncthreads();
        for (int j = jlo; j <= tb; ++j) {
            const int bi = (j - jlo) & 1;
            if (j < tb) { KvSrc s{kb + (size_t)(j + 1) * 64 * 768, kb + (size_t)(j + 1) * 64 * 768 + 128, 768}; kv_issue(s, tid, kr, vr); }
            const float base = slope2 * (float)(j * 64 - qpos);
            attn_block((j == tb) || (j == tb - 8), lds, bi, qf, lane, slope2, base, (j == tb) ? qloc : 64, (j == tb - 8) ? qpos - 511 - j * 64 : 0, m, l, o, x);
            if (j < tb) kv_write(lds, bi ^ 1, tid, kr, vr);
            __syncthreads();
        }
        const float lt = l + __shfl_xor(l, 32);
        const float sc = gw / lt;
#pragma unroll
        for (int dt = 0; dt < 2; ++dt)
#pragma unroll
            for (int i = 0; i < 16; ++i) res[dt][i] = fmaf(o[dt][i], sc, res[dt][i]);
    }
    {
        const size_t qrow2 = (size_t)b * TP + t0 + th * 32 + (opaque_v(lane) & 31);
        const bf16_t* zb = HB + qrow2 * 2560 + 2048 + hh * 64;
        bf16_t* dst = (bf16_t*)(ws + NB_CATB) + qrow2 * 1024 + 512 + hh * 64;
        typedef unsigned u32x2 __attribute__((ext_vector_type(2)));
#pragma unroll
        for (int dt = 0; dt < 2; ++dt)
#pragma unroll
            for (int c = 0; c < 4; ++c) {
                const int d = dt * 32 + 8 * c + 4 * h;
                const u32x2 zv = *(const u32x2*)(zb + d);
                const float z0 = __uint_as_float(zv.x << 16), z1 = __uint_as_float(zv.x & 0xffff0000u), z2 = __uint_as_float(zv.y << 16), z3 = __uint_as_float(zv.y & 0xffff0000u);
                u32x2 w; w.x = pk_bf16(res[dt][4 * c + 0] * silu_f(z0), res[dt][4 * c + 1] * silu_f(z1)); w.y = pk_bf16(res[dt][4 * c + 2] * silu_f(z2), res[dt][4 * c + 3] * silu_f(z3));
                *(u32x2*)(dst + d) = w;
            }
    }
}

constexpr int XSH_ROWS = 16640;
__device__ __forceinline__ float wave_sum(float v) {
#pragma unroll
    for (int o = 32; o > 0; o >>= 1) v += __shfl_xor(v, o);
    return v;
}
__device__ __forceinline__ void ld_row16(const float* __restrict__ src, int lane, float (&x)[16]) {
#pragma unroll
    for (int q = 0; q < 4; ++q) { const float4 v = *(const float4*)(src + q * 256 + lane * 4); x[4 * q] = v.x; x[4 * q + 1] = v.y; x[4 * q + 2] = v.z; x[4 * q + 3] = v.w; }
}
__device__ __forceinline__ void ln_calc16(const float* __restrict__ g, const float* __restrict__ bta, int lane, float (&x)[16]) {
    float sm = 0.f;
#pragma unroll
    for (int i = 0; i < 16; ++i) sm += x[i];
    const float mean = wave_sum(sm) * (1.f / 1024.f);
    float sq = 0.f;
#pragma unroll
    for (int i = 0; i < 16; ++i) { x[i] -= mean; sq += x[i] * x[i]; }
    const float rs = rsqrtf(wave_sum(sq) * (1.f / 1024.f) + LN_EPS);
#pragma unroll
    for (int q = 0; q < 4; ++q) {
        const float4 gv = *(const float4*)(g + q * 256 + lane * 4), bv = *(const float4*)(bta + q * 256 + lane * 4);
        x[4 * q] = x[4 * q] * rs * gv.x + bv.x; x[4 * q + 1] = x[4 * q + 1] * rs * gv.y + bv.y; x[4 * q + 2] = x[4 * q + 2] * rs * gv.z + bv.z; x[4 * q + 3] = x[4 * q + 3] * rs * gv.w + bv.w;
    }
}
__device__ __forceinline__ void ln_row16(const float* __restrict__ src, const float* __restrict__ g, const float* __restrict__ bta, int lane, float (&x)[16]) {
    ld_row16(src, lane, x); ln_calc16(g, bta, lane, x);
}
__device__ __forceinline__ void store_x1_xsh(const Args& a, unsigned char* ws, size_t row, size_t xrow, int lane, const float (&cur)[16], const float (&prev)[16]) {
#pragma unroll 1
    for (int n = 0; n < 6; ++n) {
        const float* mu = a.in[I_MU] + n * 1024 + lane * 4;
        bf16_t* dst = (bf16_t*)(ws + NB_XSH) + ((size_t)n * XSH_ROWS + xrow) * 1024 + lane * 4;
        typedef unsigned u32x2 __attribute__((ext_vector_type(2)));
#pragma unroll
        for (int q = 0; q < 4; ++q) { const float4 m4 = *(const float4*)(mu + q * 256);
            u32x2 w; w.x = pk_bf16(fmaf(prev[4 * q] - cur[4 * q], m4.x, cur[4 * q]), fmaf(prev[4 * q + 1] - cur[4 * q + 1], m4.y, cur[4 * q + 1]));
            w.y = pk_bf16(fmaf(prev[4 * q + 2] - cur[4 * q + 2], m4.z, cur[4 * q + 2]), fmaf(prev[4 * q + 3] - cur[4 * q + 3], m4.w, cur[4 * q + 3]));
            *(u32x2*)(dst + q * 256) = w; }
    }
}
__device__ __forceinline__ void phase_lns(const Args& a, unsigned char* ws, int bid, int nb) {
    const int tid = opaque_v(threadIdx.x), lane = tid & 63, wv = tid >> 6;
    const float* PRE = (const float*)ws + WS_PRE;
    const float* g = a.in[I_LNG]; const float* bta = a.in[I_LNB];
    for (int blk = bid; blk < 256; blk += nb) {
        const int r0 = blk * 64 + wv * 8;
        float prev[16], cur[16];
        if ((r0 & (TP - 1)) == 0) {
#pragma unroll
            for (int i = 0; i < 16; ++i) prev[i] = 0.f;
        } else ln_row16(PRE + (size_t)(r0 - 1) * 1024, g, bta, lane, prev);
        float nxt[16];
        ld_row16(PRE + (size_t)r0 * 1024, lane, nxt);
#pragma unroll 1
        for (int k = 0; k < 8; ++k) {
            const int row = r0 + k;
#pragma unroll
            for (int i = 0; i < 16; ++i) cur[i] = nxt[i];
            if (k + 1 < 8) ld_row16(PRE + (size_t)(row + 1) * 1024, lane, nxt);
            ln_calc16(g, bta, lane, cur);
            store_x1_xsh(a, ws, row, row, lane, cur, prev);
            if ((row & (TP - 1)) == TP - 1) {
                float* so = a.out + O_SHP + (size_t)(row >> 11) * 1024 + lane * 4;
#pragma unroll
                for (int q = 0; q < 4; ++q) *(float4*)(so + q * 256) = make_float4(cur[4 * q], cur[4 * q + 1], cur[4 * q + 2], cur[4 * q + 3]);
            }
#pragma unroll
            for (int i = 0; i < 16; ++i) prev[i] = cur[i];
        }
    }
    for (int s = bid * 8 + wv; s < BS; s += nb * 8) {
        float prev[16], cur[16];
        const float* sp = a.in[I_SSHIFT] + (size_t)s * 1024 + lane * 4;
#pragma unroll
        for (int q = 0; q < 4; ++q) { const float4 v = *(const float4*)(sp + q * 256); prev[4 * q] = v.x; prev[4 * q + 1] = v.y; prev[4 * q + 2] = v.z; prev[4 * q + 3] = v.w; }
        ln_row16(PRE + (size_t)(MP + s) * 1024, g, bta, lane, cur);
        store_x1_xsh(a, ws, MP + s, MP + s, lane, cur, prev);
        float* so = a.out + O_SHS + (size_t)s * 1024 + lane * 4;
#pragma unroll
        for (int q = 0; q < 4; ++q) *(float4*)(so + q * 256) = make_float4(cur[4 * q], cur[4 * q + 1], cur[4 * q + 2], cur[4 * q + 3]);
    }
}

struct Order3 {
    pg8::StaticOrder so;
    __device__ void init(int G, int c) { so.init(MP, 4096, G, c); }
    __device__ bool next(int i, Unit& u) const { Unit v; if (!so.next(i, v)) return false; const int n = v.pn >> 2; u.pm = n * 65 + v.pm; u.pn = v.pn; return true; }
    __device__ __forceinline__ void a_ready(const Unit&) const {}
    __device__ __forceinline__ void done(const Unit&) const {}
};
struct Epi3 {
    static constexpr bool PERM = true, AFTER_DRAIN = false;
    bf16_t* O;
    __device__ __forceinline__ void operator()(const f32x4 (&acc)[2][2][4][2], const Unit& u, int wr, int wc, int fr, int fq) const {
        const int n = u.pn >> 2, pm = u.pm - n * 65, pn = u.pn & 3;
        const int row0 = pm * 256 + wr * 64 + fr, col0 = pn * 256 + wc * 32 + 8 * fq;
        bf16_t* base = O + (size_t)n * XSH_ROWS * 1024;
#pragma unroll
        for (int ai = 0; ai < 2; ++ai)
#pragma unroll
            for (int m = 0; m < 4; ++m) { bf16_t* rowp = base + (size_t)(row0 + ai * 128 + m * 16) * 1024 + col0;
#pragma unroll
                for (int bj = 0; bj < 2; ++bj) { const f32x4 v0 = acc[ai][bj][m][0], v1 = acc[ai][bj][m][1];
                    u32x4 w; w.x = pk_bf16c(v0[0], v0[1]); w.y = pk_bf16c(v0[2], v0[3]); w.z = pk_bf16c(v1[0], v1[1]); w.w = pk_bf16c(v1[2], v1[3]);
                    *(u32x4*)(rowp + bj * 128) = w; } }
    }
};
struct EpiPreRes {
    static constexpr bool PERM = false, AFTER_DRAIN = false;
    float* C; const float* X;
    __device__ __forceinline__ void operator()(const f32x4 (&acc)[2][2][4][2], const Unit& u, int wr, int wc, int fr, int fq) const {
        const int row0 = u.pm * 256 + wr * 64 + fr, col0 = u.pn * 256 + wc * 32 + 4 * fq;
#pragma unroll
        for (int ai = 0; ai < 2; ++ai)
#pragma unroll
            for (int m = 0; m < 4; ++m) { const size_t off = (size_t)(row0 + ai * 128 + m * 16) * 1024 + col0;
#pragma unroll
                for (int bj = 0; bj < 2; ++bj)
#pragma unroll
                    for (int n = 0; n < 2; ++n) { const f32x4 xv = *(const f32x4*)(X + off + bj * 128 + n * 16); *(f32x4*)(C + off + bj * 128 + n * 16) = acc[ai][bj][m][n] + xv * ALPHA; } }
    }
};

constexpr int LR_A = 0;
constexpr int LR_P = 67584;
struct LoraRegs { u32x4 v[8]; };
__device__ __forceinline__ void lora_load(unsigned char* ws, int task, int tid, LoraRegs& r) {
    const int rt = task >> 1, which = task & 1;
    const bf16_t* A = (const bf16_t*)(ws + NB_XSH) + ((size_t)(4 + which) * XSH_ROWS + (size_t)rt * 32) * 1024;
#pragma unroll
    for (int i = 0; i < 8; ++i) { const int idx = tid + i * NTH; r.v[i] = *(const u32x4*)(A + (size_t)(idx >> 7) * 1024 + (idx & 127) * 8); }
}
__device__ __forceinline__ void lora_tile(unsigned char* ws, PG8_LAS unsigned char* lds, int task, int tid, const LoraRegs& r) {
    const int rt = task >> 1, which = task & 1;
    const int lane = tid & 63, wv = tid >> 6, lr = lane & 31, h = lane >> 5;
    PG8_LAS bf16_t* AT = (PG8_LAS bf16_t*)(lds + LR_A);
    PG8_LAS float* P = (PG8_LAS float*)(lds + LR_P);
#pragma unroll
    for (int i = 0; i < 8; ++i) { const int idx = tid + i * NTH; *(PG8_LAS u32x4*)(AT + (idx >> 7) * 1032 + (idx & 127) * 8) = r.v[i]; }
    __syncthreads();
    const bf16_t* Bt = (const bf16_t*)(ws + (which ? NB_A1T : NB_W1T));
    f32x16 acc0, acc1;
#pragma unroll
    for (int i = 0; i < 16; ++i) { acc0[i] = 0.f; acc1[i] = 0.f; }
#pragma unroll
    for (int s = 0; s < 8; ++s) {
        const int k = wv * 128 + s * 16 + h * 8;
        const bf16x8 av = *(const PG8_LAS bf16x8*)(AT + lr * 1032 + k);
        const bf16x8 b0 = *(const bf16x8*)(Bt + (size_t)lr * 1024 + k), b1 = *(const bf16x8*)(Bt + (size_t)(32 + lr) * 1024 + k);
        acc0 = __builtin_amdgcn_mfma_f32_32x32x16_bf16(av, b0, acc0, 0, 0, 0);
        acc1 = __builtin_amdgcn_mfma_f32_32x32x16_bf16(av, b1, acc1, 0, 0, 0);
    }
#pragma unroll
    for (int q = 0; q < 4; ++q) {
        *(PG8_LAS f32x4*)(P + (wv * 64 + lane) * 32 + q * 4) = (f32x4){acc0[4 * q], acc0[4 * q + 1], acc0[4 * q + 2], acc0[4 * q + 3]};
        *(PG8_LAS f32x4*)(P + (wv * 64 + lane) * 32 + 16 + q * 4) = (f32x4){acc1[4 * q], acc1[4 * q + 1], acc1[4 * q + 2], acc1[4 * q + 3]};
    }
    __syncthreads();
    if (wv < 2) {
        float sum[16];
#pragma unroll
        for (int i = 0; i < 16; ++i) sum[i] = 0.f;
#pragma unroll
        for (int w = 0; w < 8; ++w)
#pragma unroll
            for (int q = 0; q < 4; ++q) { const f32x4 v = *(const PG8_LAS f32x4*)(P + (w * 64 + lane) * 32 + wv * 16 + q * 4); sum[4 * q] += v[0]; sum[4 * q + 1] += v[1]; sum[4 * q + 2] += v[2]; sum[4 * q + 3] += v[3]; }
        bf16_t* dst = (bf16_t*)(ws + (which ? NB_AWB : NB_TWB)) + (size_t)rt * 32 * 64 + wv * 32 + lr;
#pragma unroll
        for (int i = 0; i < 16; ++i) { const int row = (i & 3) + 8 * (i >> 2) + 4 * h; const float v = which ? sum[i] : tanhf(sum[i]); dst[(size_t)row * 64] = (bf16_t)(pk_bf16c(v, 0.f) & 0xffffu); }
    }
    __syncthreads();
}

__device__ __forceinline__ float dpp_red16f(float v) {
    v += __builtin_bit_cast(float, __builtin_amdgcn_update_dpp(0, __builtin_bit_cast(int, v), 0xB1, 0xF, 0xF, true));
    v += __builtin_bit_cast(float, __builtin_amdgcn_update_dpp(0, __builtin_bit_cast(int, v), 0x4E, 0xF, 0xF, true));
    v += __builtin_bit_cast(float, __builtin_amdgcn_update_dpp(0, __builtin_bit_cast(int, v), 0x141, 0xF, 0xF, true));
    v += __builtin_bit_cast(float, __builtin_amdgcn_update_dpp(0, __builtin_bit_cast(int, v), 0x140, 0xF, 0xF, true));
    return v;
}
__device__ __forceinline__ void prep2_task(const Args& a, unsigned char* ws, int rt, int hd, int lane) {
    const int lr = lane & 31, h2 = lane >> 5;
    const size_t row0 = (size_t)rt * 32;
    const bf16_t* W2T = (const bf16_t*)(ws + NB_W2T); const bf16_t* A2T = (const bf16_t*)(ws + NB_A2T);
    const bf16_t* TWB = (const bf16_t*)(ws + NB_TWB); const bf16_t* AWB = (const bf16_t*)(ws + NB_AWB);
    f32x16 aw[2], aa[2];
#pragma unroll
    for (int ct = 0; ct < 2; ++ct)
#pragma unroll
        for (int i = 0; i < 16; ++i) { aw[ct][i] = 0.f; aa[ct][i] = 0.f; }
#pragma unroll
    for (int s = 0; s < 4; ++s) {
        const bf16x8 at = *(const bf16x8*)(TWB + (row0 + lr) * 64 + s * 16 + h2 * 8), aa_ = *(const bf16x8*)(AWB + (row0 + lr) * 64 + s * 16 + h2 * 8);
#pragma unroll
        for (int ct = 0; ct < 2; ++ct) {
            const size_t e = (size_t)hd * 64 + ct * 32 + lr;
            const bf16x8 w2 = *(const bf16x8*)(W2T + e * 64 + s * 16 + h2 * 8), a2 = *(const bf16x8*)(A2T + e * 64 + s * 16 + h2 * 8);
            aw[ct] = __builtin_amdgcn_mfma_f32_32x32x16_bf16(at, w2, aw[ct], 0, 0, 0);
            aa[ct] = __builtin_amdgcn_mfma_f32_32x32x16_bf16(aa_, a2, aa[ct], 0, 0, 0);
        }
    }
    const bf16_t* KB = (const bf16_t*)(ws + NB_RKVZ) + (size_t)1 * XSH_ROWS * 1024;
    const bf16_t* RB = (const bf16_t*)(ws + NB_RKVZ);
    float* DEC = (float*)(ws + NB_DEC);
    bf16_t* KKN = (bf16_t*)(ws + NB_KKN); bf16_t* KKA = (bf16_t*)(ws + NB_KKA); bf16_t* KP = (bf16_t*)(ws + NB_KP);
    float w0v[2], a0v[2], kkp[2], kap[2], rkp[2];
#pragma unroll
    for (int ct = 0; ct < 2; ++ct) { const int e = hd * 64 + ct * 32 + lr; w0v[ct] = a.in[I_W0][e]; a0v[ct] = a.in[I_A0][e]; kkp[ct] = a.in[I_KK][e]; kap[ct] = a.in[I_KA][e]; rkp[ct] = a.in[I_RK][e]; }
    float n2[16], rk[16];
#pragma unroll
    for (int i = 0; i < 16; ++i) { n2[i] = 0.f; rk[i] = 0.f; }
#pragma unroll
    for (int ct = 0; ct < 2; ++ct)
#pragma unroll
        for (int i = 0; i < 16; ++i) {
            const size_t off = (row0 + (i & 3) + 8 * (i >> 2) + 4 * h2) * 1024 + hd * 64 + ct * 32 + lr;
            const float kf = bf2f(KB[off]), rf = bf2f(RB[off]);
            const float wl = w0v[ct] + aw[ct][i];
            const float sp = fmaxf(-wl, 0.f) + log1pf(__expf(-fabsf(wl)));
            DEC[off] = __expf(-__expf(-sp - 0.5f));
            const float av_ = sigm_f(a0v[ct] + aa[ct][i]);
            const float kk = kf * kkp[ct];
            const float kp = kf * (1.f + (av_ - 1.f) * kap[ct]);
            KP[off] = (bf16_t)(pk_bf16(kp, 0.f) & 0xffffu);
            aw[ct][i] = kk; aa[ct][i] = av_;
            n2[i] = fmaf(kk, kk, n2[i]);
            rk[i] = fmaf(rf * kp, rkp[ct], rk[i]);
        }
#pragma unroll
    for (int i = 0; i < 16; ++i) {
        float v = dpp_red16f(n2[i]); v += __shfl_xor(v, 16); n2[i] = 1.f / fmaxf(sqrtf(v), 1e-12f);
        float w = dpp_red16f(rk[i]); w += __shfl_xor(w, 16); rk[i] = w;
    }
#pragma unroll
    for (int ct = 0; ct < 2; ++ct)
#pragma unroll
        for (int i = 0; i < 16; ++i) {
            const size_t off = (row0 + (i & 3) + 8 * (i >> 2) + 4 * h2) * 1024 + hd * 64 + ct * 32 + lr;
            const float kn = aw[ct][i] * n2[i];
            KKN[off] = (bf16_t)(pk_bf16(kn, 0.f) & 0xffffu);
            KKA[off] = (bf16_t)(pk_bf16(kn * aa[ct][i], 0.f) & 0xffffu);
        }
    if (lr == 0) {
#pragma unroll
        for (int i = 0; i < 16; ++i) ((float*)(ws + NB_RKS))[(row0 + (i & 3) + 8 * (i >> 2) + 4 * h2) * 16 + hd] = rk[i];
    }
}

constexpr int SC_BUF = 53248;
__device__ __forceinline__ float dpp_red16(float v) {
    v += __builtin_bit_cast(float, __builtin_amdgcn_update_dpp(0, __builtin_bit_cast(int, v), 0xB1, 0xF, 0xF, true));
    v += __builtin_bit_cast(float, __builtin_amdgcn_update_dpp(0, __builtin_bit_cast(int, v), 0x4E, 0xF, 0xF, true));
    v += __builtin_bit_cast(float, __builtin_amdgcn_update_dpp(0, __builtin_bit_cast(int, v), 0x141, 0xF, 0xF, true));
    v += __builtin_bit_cast(float, __builtin_amdgcn_update_dpp(0, __builtin_bit_cast(int, v), 0x140, 0xF, 0xF, true));
    return v;
}
struct ScanRegs { u32x4 d0, d1, kn, ka, kp, r, v; };
__device__ __forceinline__ void scan_issue(unsigned char* ws, int b, int hd, int vh, int chunk, int tid, ScanRegs& g) {
    const int tt = tid >> 3, part = tid & 7;
    const size_t row = (size_t)b * TP + chunk * 64 + tt;
    const size_t off = row * 1024 + hd * 64 + part * 8;
    const float* dp = (const float*)(ws + NB_DEC) + off;
    g.d0 = *(const u32x4*)dp; g.d1 = *(const u32x4*)(dp + 4);
    g.kn = *(const u32x4*)((const bf16_t*)(ws + NB_KKN) + off);
    g.ka = *(const u32x4*)((const bf16_t*)(ws + NB_KKA) + off);
    g.kp = *(const u32x4*)((const bf16_t*)(ws + NB_KP) + off);
    g.r = *(const u32x4*)((const bf16_t*)(ws + NB_RKVZ) + ((size_t)0 * XSH_ROWS + row) * 1024 + hd * 64 + part * 8);
    if (part < 4) g.v = *(const u32x4*)((const bf16_t*)(ws + NB_RKVZ) + ((size_t)2 * XSH_ROWS + row) * 1024 + hd * 64 + vh * 32 + part * 8);
}
__device__ __forceinline__ void scan_write(PG8_LAS unsigned char* buf, int tid, const ScanRegs& g) {
    const int tt = tid >> 3, part = tid & 7;
    *(PG8_LAS u32x4*)(buf + tt * 256 + part * 32) = g.d0; *(PG8_LAS u32x4*)(buf + tt * 256 + part * 32 + 16) = g.d1;
    *(PG8_LAS u32x4*)(buf + 16384 + tt * 128 + part * 16) = g.kn;
    *(PG8_LAS u32x4*)(buf + 24576 + tt * 128 + part * 16) = g.ka;
    *(PG8_LAS u32x4*)(buf + 32768 + tt * 128 + part * 16) = g.kp;
    *(PG8_LAS u32x4*)(buf + 40960 + tt * 128 + part * 16) = g.r;
    if (part < 4) *(PG8_LAS u32x4*)(buf + 49152 + tt * 64 + part * 16) = g.v;
}
__device__ __forceinline__ void scan_prompt(const Args& a, unsigned char* ws, PG8_LAS unsigned char* lds, int item) {
    const int tid = opaque_v(threadIdx.x);
    const int b = item >> 5, hd = (item >> 1) & 15, vh = item & 1;
    const int vl = tid >> 4, kq = tid & 15;
    typedef unsigned u32x2 __attribute__((ext_vector_type(2)));
    float S[4] = {0.f, 0.f, 0.f, 0.f};
    ScanRegs g;
    PG8_LAS float* YS = (PG8_LAS float*)(lds + 2 * SC_BUF);
    scan_issue(ws, b, hd, vh, 0, tid, g); scan_write(lds, tid, g);
    __syncthreads();
    for (int c = 0; c < TP / 64; ++c) {
        PG8_LAS unsigned char* buf = lds + (c & 1) * SC_BUF;
        if (c + 1 < TP / 64) scan_issue(ws, b, hd, vh, c + 1, tid, g);
#pragma unroll 4
        for (int tt = 0; tt < 64; ++tt) {
            const f32x4 w = *(const PG8_LAS f32x4*)(buf + tt * 256 + kq * 16);
            const u32x2 knw = *(const PG8_LAS u32x2*)(buf + 16384 + tt * 128 + kq * 8), kaw = *(const PG8_LAS u32x2*)(buf + 24576 + tt * 128 + kq * 8),
                        kpw = *(const PG8_LAS u32x2*)(buf + 32768 + tt * 128 + kq * 8), rw = *(const PG8_LAS u32x2*)(buf + 40960 + tt * 128 + kq * 8);
            const float vv = bf2f(*(const PG8_LAS bf16_t*)(buf + 49152 + tt * 64 + vl * 2));
            const float kn[4] = {__uint_as_float(knw.x << 16), __uint_as_float(knw.x & 0xffff0000u), __uint_as_float(knw.y << 16), __uint_as_float(knw.y & 0xffff0000u)};
            const float ka[4] = {__uint_as_float(kaw.x << 16), __uint_as_float(kaw.x & 0xffff0000u), __uint_as_float(kaw.y << 16), __uint_as_float(kaw.y & 0xffff0000u)};
            const float kp[4] = {__uint_as_float(kpw.x << 16), __uint_as_float(kpw.x & 0xffff0000u), __uint_as_float(kpw.y << 16), __uint_as_float(kpw.y & 0xffff0000u)};
            const float rr[4] = {__uint_as_float(rw.x << 16), __uint_as_float(rw.x & 0xffff0000u), __uint_as_float(rw.y << 16), __uint_as_float(rw.y & 0xffff0000u)};
            float sa = S[0] * kn[0];
            sa = fmaf(S[1], kn[1], sa); sa = fmaf(S[2], kn[2], sa); sa = fmaf(S[3], kn[3], sa);
            sa = dpp_red16(sa);
            float y = 0.f;
#pragma unroll
            for (int i = 0; i < 4; ++i) { S[i] = fmaf(S[i], w[i], fmaf(vv, kp[i], -sa * ka[i])); y = fmaf(S[i], rr[i], y); }
            y = dpp_red16(y);
            if (kq == 0) YS[tt * 32 + vl] = y;
        }
        if (c + 1 < TP / 64) scan_write(lds + ((c + 1) & 1) * SC_BUF, tid, g);
        __syncthreads();
        {
            float* Y = (float*)(ws + NB_Y);
            for (int i = tid; i < 64 * 32; i += NTH) { const int tt = i >> 5, v = i & 31; Y[((size_t)b * TP + c * 64 + tt) * 1024 + hd * 64 + vh * 32 + v] = YS[i]; }
        }
        __syncthreads();
    }
    float* so = a.out + O_WKVP + ((size_t)(b * 16 + hd) * 64 + vh * 32 + vl) * 64 + kq * 4;
    *(float4*)so = make_float4(S[0], S[1], S[2], S[3]);
}
__device__ __forceinline__ void scan_sample(const Args& a, unsigned char* ws, int s, int hd, int lane) {
    const size_t row = (size_t)MP + s;
    const float* s0 = a.in[I_SWKV] + ((size_t)(s * 16 + hd) * 64 + lane) * 64;
    float* sout = a.out + O_WKVS + ((size_t)(s * 16 + hd) * 64 + lane) * 64;
    const int e = hd * 64 + lane;
    const float twl = bf2f(((const bf16_t*)(ws + NB_TWB) + row * 64)[lane]), awl = bf2f(((const bf16_t*)(ws + NB_AWB) + row * 64)[lane]);
    const bf16_t* w2r = (const bf16_t*)(ws + NB_W2T) + (size_t)e * 64; const bf16_t* a2r = (const bf16_t*)(ws + NB_A2T) + (size_t)e * 64;
    float wl = a.in[I_W0][e], al = a.in[I_A0][e];
#define RL(X, K) __builtin_bit_cast(float, __builtin_amdgcn_readlane(__builtin_bit_cast(int, X), K))
#pragma unroll
    for (int j8 = 0; j8 < 8; ++j8) {
        const u32x4 wq = *(const u32x4*)(w2r + j8 * 8), aq = *(const u32x4*)(a2r + j8 * 8);
#pragma unroll
        for (int i = 0; i < 8; ++i) {
            const float wv_ = __uint_as_float((i & 1) ? (wq[i >> 1] & 0xffff0000u) : (wq[i >> 1] << 16)), av_ = __uint_as_float((i & 1) ? (aq[i >> 1] & 0xffff0000u) : (aq[i >> 1] << 16));
            wl = fmaf(RL(twl, j8 * 8 + i), wv_, wl); al = fmaf(RL(awl, j8 * 8 + i), av_, al);
        }
    }
    const float decl = __expf(-0.60653066f * sigm_f(wl));
    const float aa_ = sigm_f(al);
    const float kf = bf2f(((const bf16_t*)(ws + NB_RKVZ) + ((size_t)1 * XSH_ROWS + row) * 1024)[e]);
    const float rl = bf2f(((const bf16_t*)(ws + NB_RKVZ) + ((size_t)0 * XSH_ROWS + row) * 1024)[e]);
    const float vv = bf2f(((const bf16_t*)(ws + NB_RKVZ) + ((size_t)2 * XSH_ROWS + row) * 1024)[e]);
    const float kkr = kf * a.in[I_KK][e];
    const float kpl = kf * (1.f + (aa_ - 1.f) * a.in[I_KA][e]);
    const float knl = kkr / fmaxf(sqrtf(wave_sum(kkr * kkr)), 1e-12f);
    const float kal = knl * aa_;
    const float rkv = wave_sum(rl * kpl * a.in[I_RK][e]);
    float S[64];
#pragma unroll
    for (int q = 0; q < 16; ++q) { const float4 v4 = *(const float4*)(s0 + q * 4); S[4 * q] = v4.x; S[4 * q + 1] = v4.y; S[4 * q + 2] = v4.z; S[4 * q + 3] = v4.w; }
    float sa = 0.f;
#pragma unroll
    for (int k = 0; k < 64; ++k) sa = fmaf(S[k], RL(knl, k), sa);
    float y = 0.f;
#pragma unroll
    for (int k = 0; k < 64; ++k) { S[k] = fmaf(S[k], RL(decl, k), fmaf(vv, RL(kpl, k), -sa * RL(kal, k))); y = fmaf(S[k], RL(rl, k), y); }
#undef RL
#pragma unroll
    for (int q = 0; q < 16; ++q) *(float4*)(sout + q * 4) = make_float4(S[4 * q], S[4 * q + 1], S[4 * q + 2], S[4 * q + 3]);
    {
        const float mean = wave_sum(y) * (1.f / 64.f);
        const float d = y - mean;
        const float rs = rsqrtf(wave_sum(d * d) * (1.f / 64.f) + GN_EPS);
        const float zf = bf2f(((const bf16_t*)(ws + NB_RKVZ) + ((size_t)3 * XSH_ROWS + row) * 1024)[e]);
        const float o = fmaf(rkv, vv, d * rs * a.in[I_GNG][e] + a.in[I_GNB][e]) * silu_f(zf);
        ((bf16_t*)(ws + NB_G4B))[row * 1024 + e] = (bf16_t)(pk_bf16c(o, 0.f) & 0xffffu);
    }
}

constexpr int CS_LD = 72;
constexpr int CS_SLOT = 64 * CS_LD * 2;
constexpr int CS_F32A = 13 * CS_SLOT;
constexpr int CS_F32B = CS_F32A + 16384;
constexpr int CS_GS = CS_F32B + 16384;
constexpr int CS_END = CS_GS + 4096;
constexpr size_t CK_MCT = 0, CK_RY = 8192, CK_SADD = 16384, CK_Y0 = 24576, CK_BYTES = 32768;

__device__ __forceinline__ PG8_LAS bf16_t* cs_slot(PG8_LAS unsigned char* lds, int i) { return (PG8_LAS bf16_t*)(lds + i * CS_SLOT); }
template <bool SWX = false, bool SWY = false>
__device__ __forceinline__ void cs_mm(f32x16& acc, const PG8_LAS bf16_t* X, const PG8_LAS bf16_t* Yt, int mt, int nt, int lane) {
    const int lr = lane & 31, h = lane >> 5;
    const int rx = mt * 32 + lr, ry = nt * 32 + lr;
    const int sx = SWX ? ((rx >> 3) & 7) : 0, sy = SWY ? ((ry >> 3) & 7) : 0;
#pragma unroll
    for (int s = 0; s < 4; ++s) {
        const bf16x8 av = *(const PG8_LAS bf16x8*)(X + rx * CS_LD + (((2 * s + h) ^ sx) << 3));
        const bf16x8 bv = *(const PG8_LAS bf16x8*)(Yt + ry * CS_LD + (((2 * s + h) ^ sy) << 3));
        acc = __builtin_amdgcn_mfma_f32_32x32x16_bf16(av, bv, acc, 0, 0, 0);
    }
}
__device__ __forceinline__ void cs_store_t(const f32x16& acc, PG8_LAS bf16_t* D, int mt, int nt, int lane) {
    typedef unsigned u32x2 __attribute__((ext_vector_type(2)));
    const int lr = lane & 31, h = lane >> 5;
#pragma unroll
    for (int c = 0; c < 4; ++c) { u32x2 w; w.x = pk_bf16c(acc[4 * c], acc[4 * c + 1]); w.y = pk_bf16c(acc[4 * c + 2], acc[4 * c + 3]);
        *(PG8_LAS u32x2*)(D + (nt * 32 + lr) * CS_LD + mt * 32 + 8 * c + 4 * h) = w; }
}
__device__ __forceinline__ void cs_store_n(const f32x16& acc, PG8_LAS bf16_t* D, int mt, int nt, int lane) {
    const int lr = lane & 31, h = lane >> 5;
#pragma unroll
    for (int i = 0; i < 16; ++i) D[(mt * 32 + (i & 3) + 8 * (i >> 2) + 4 * h) * CS_LD + nt * 32 + lr] = (bf16_t)(pk_bf16c(acc[i], 0.f) & 0xffffu);
}
__device__ __forceinline__ void cs_zero(f32x16& a) {
#pragma unroll
    for (int i = 0; i < 16; ++i) a[i] = 0.f;
}
__device__ __forceinline__ float dpp_red8(float v) {
    v += __builtin_bit_cast(float, __builtin_amdgcn_update_dpp(0, __builtin_bit_cast(int, v), 0xB1, 0xF, 0xF, true));
    v += __builtin_bit_cast(float, __builtin_amdgcn_update_dpp(0, __builtin_bit_cast(int, v), 0x4E, 0xF, 0xF, true));
    v += __builtin_bit_cast(float, __builtin_amdgcn_update_dpp(0, __builtin_bit_cast(int, v), 0x141, 0xF, 0xF, true));
    return v;
}

struct PreRegs { u32x4 kv, rv, vv; bf16x8 af[4]; };
__device__ __forceinline__ void scanpre_load(unsigned char* ws, int b, int hd, int c, int tid, PreRegs& r) {
    const int lane = tid & 63, wv = tid >> 6, lr = lane & 31, h = lane >> 5;
    const size_t row0 = (size_t)b * TP + c * 64;
    const int tok = tid >> 3, c8 = tid & 7;
    const size_t off = (row0 + tok) * 1024 + hd * 64 + c8 * 8;
    const bf16_t* RK = (const bf16_t*)(ws + NB_RKVZ);
    r.kv = *(const u32x4*)(RK + (size_t)1 * XSH_ROWS * 1024 + off); r.rv = *(const u32x4*)(RK + off); r.vv = *(const u32x4*)(RK + (size_t)2 * XSH_ROWS * 1024 + off);
    const int which = wv >> 2, mt = (wv >> 1) & 1;
    const bf16_t* A = (const bf16_t*)(ws + (which ? NB_AWB : NB_TWB)) + (row0 + mt * 32 + lr) * 64 + h * 8;
#pragma unroll
    for (int s = 0; s < 4; ++s) r.af[s] = *(const bf16x8*)(A + s * 16);
}
__device__ __forceinline__ void scanpre_chunk(const Args& a, unsigned char* ws, PG8_LAS unsigned char* lds, int b, int hd, int c, const PreRegs& pre, const bf16x8 (&btf)[4]) {
    const int tid = opaque_v(threadIdx.x), lane = tid & 63, wv = __builtin_amdgcn_readfirstlane(tid >> 6);
    const int lr = lane & 31, h = lane >> 5;
    const size_t row0 = (size_t)b * TP + c * 64;
    typedef unsigned u32x2 __attribute__((ext_vector_type(2)));
    PG8_LAS float* LCUM = (PG8_LAS float*)(lds + CS_F32A);
    PG8_LAS float* AV = (PG8_LAS float*)(lds + CS_F32B);
    PG8_LAS float* GS = (PG8_LAS float*)(lds + CS_GS);
    unsigned char* rec = ws + NB_CHK + ((size_t)(b * 16 + hd) * 32 + c) * CK_BYTES;
    {
        const int tok = tid >> 3, c8 = tid & 7;
        *(PG8_LAS u32x4*)(cs_slot(lds, 0) + tok * CS_LD + c8 * 8) = pre.kv;
        *(PG8_LAS u32x4*)(cs_slot(lds, 1) + tok * CS_LD + c8 * 8) = pre.rv;
        *(PG8_LAS u32x4*)(cs_slot(lds, 2) + tok * CS_LD + c8 * 8) = pre.vv;
    }
    {
        const int which = wv >> 2, mt = (wv >> 1) & 1, nt = wv & 1;
        f32x16 acc; cs_zero(acc);
#pragma unroll
        for (int s = 0; s < 4; ++s) acc = __builtin_amdgcn_mfma_f32_32x32x16_bf16(pre.af[s], btf[s], acc, 0, 0, 0);
        PG8_LAS float* D = which ? AV : LCUM;
        const float bias = a.in[which ? I_A0 : I_W0][hd * 64 + nt * 32 + lr];
#pragma unroll
        for (int i = 0; i < 16; ++i) {
            const float x = acc[i] + bias;
            float y;
            if (which) y = sigm_f(x);
            else y = -0.87503504f * sigm_f(x);
            D[(mt * 32 + (i & 3) + 8 * (i >> 2) + 4 * h) * 64 + nt * 32 + lr] = y;
        }
    }
    lds_barrier();
    {
        const int ch = tid & 63, tg = tid >> 6;
        float p[8]; float run = 0.f;
#pragma unroll
        for (int i = 0; i < 8; ++i) { run += LCUM[(tg * 8 + i) * 64 + ch]; p[i] = run; }
        GS[tg * 64 + ch] = run;
        lds_barrier();
        float offs = 0.f;
        for (int g = 0; g < tg; ++g) offs += GS[g * 64 + ch];
#pragma unroll
        for (int i = 0; i < 8; ++i) LCUM[(tg * 8 + i) * 64 + ch] = p[i] + offs;
    }
    lds_barrier();
    {
        const int tok = tid >> 3, c8 = tid & 7;
        const u32x4 kw = *(const PG8_LAS u32x4*)(cs_slot(lds, 0) + tok * CS_LD + c8 * 8), rw = *(const PG8_LAS u32x4*)(cs_slot(lds, 1) + tok * CS_LD + c8 * 8),
                    vw = *(const PG8_LAS u32x4*)(cs_slot(lds, 2) + tok * CS_LD + c8 * 8);
        float kf[8], rf[8], kk[8], kp[8], av[8];
        float n2 = 0.f, rk = 0.f;
#pragma unroll
        for (int i = 0; i < 8; ++i) {
            const int e = hd * 64 + c8 * 8 + i;
            kf[i] = __uint_as_float((i & 1) ? (kw[i >> 1] & 0xffff0000u) : (kw[i >> 1] << 16));
            rf[i] = __uint_as_float((i & 1) ? (rw[i >> 1] & 0xffff0000u) : (rw[i >> 1] << 16));
            av[i] = AV[tok * 64 + c8 * 8 + i];
            kk[i] = kf[i] * a.in[I_KK][e];
            kp[i] = kf[i] * (1.f + (av[i] - 1.f) * a.in[I_KA][e]);
            n2 = fmaf(kk[i], kk[i], n2);
            rk = fmaf(rf[i] * kp[i], a.in[I_RK][e], rk);
        }
        n2 = dpp_red8(n2); rk = dpp_red8(rk);
        const float inv = 1.f / fmaxf(sqrtf(n2), 1e-12f);
        if (c8 == 0) ((float*)(ws + NB_RKS))[(row0 + tok) * 16 + hd] = rk;
        if (tok == 63) {
#pragma unroll
            for (int i = 0; i < 8; ++i) GS[512 + c8 * 8 + i] = __builtin_amdgcn_exp2f(LCUM[63 * 64 + c8 * 8 + i]);
        }
        float qt[8], rt[8], kt[8], bt[8], kh[8], bh[8];
#pragma unroll
        for (int i = 0; i < 8; ++i) {
            const int ch = c8 * 8 + i;
            const float Lt = LCUM[tok * 64 + ch], Lp = tok ? LCUM[(tok - 1) * 64 + ch] : 0.f, Lc = LCUM[63 * 64 + ch];
            const float kn = kk[i] * inv, ka = kn * av[i];
            const float en = __builtin_amdgcn_exp2f(-Lt), ec = __builtin_amdgcn_exp2f(Lc - Lt);
            qt[i] = kn * __builtin_amdgcn_exp2f(Lp); rt[i] = rf[i] * __builtin_amdgcn_exp2f(Lt); kt[i] = kp[i] * en; bt[i] = ka * en; kh[i] = kp[i] * ec; bh[i] = ka * ec;
        }
#define CS_PUT_ROW(SLOT, ARR) { u32x4 w_; w_.x = pk_bf16c(ARR[0], ARR[1]); w_.y = pk_bf16c(ARR[2], ARR[3]); w_.z = pk_bf16c(ARR[4], ARR[5]); w_.w = pk_bf16c(ARR[6], ARR[7]); \
            *(PG8_LAS u32x4*)(cs_slot(lds, SLOT) + tok * CS_LD + c8 * 8) = w_; }
#define CS_PUT_COL(SLOT, ARR) { _Pragma("unroll") for (int i_ = 0; i_ < 8; ++i_) cs_slot(lds, SLOT)[(c8 * 8 + i_) * CS_LD + tsw] = (bf16_t)(pk_bf16c(ARR[i_], 0.f) & 0xffffu); }
        const int tsw = ((((tok >> 3) ^ c8) & 7) << 3) | (tok & 7);
        CS_PUT_ROW(3, qt) CS_PUT_ROW(4, rt) CS_PUT_ROW(5, kt) CS_PUT_ROW(6, bt)
        CS_PUT_COL(7, qt) CS_PUT_COL(8, bh) CS_PUT_COL(9, kh)
#pragma unroll
        for (int i = 0; i < 8; ++i) cs_slot(lds, 10)[(c8 * 8 + i) * CS_LD + tsw] = (bf16_t)((i & 1) ? (vw[i >> 1] >> 16) : (vw[i >> 1] & 0xffffu));
#undef CS_PUT_ROW
#undef CS_PUT_COL
    }
    lds_barrier();
    {
#pragma unroll 1
        for (int j = 0; j < 2; ++j) {
            const int job = wv * 2 + j, prod = job >> 2, mt = (job >> 1) & 1, nt = job & 1;
            const PG8_LAS bf16_t* X = cs_slot(lds, (prod & 1) ? 6 : 5);
            const PG8_LAS bf16_t* Y = cs_slot(lds, (prod & 2) ? 4 : 3);
            f32x16 acc; cs_zero(acc);
            cs_mm(acc, X, Y, mt, nt, lane);
            const int t = nt * 32 + lr, incl = (prod & 2) ? 1 : 0;
#pragma unroll
            for (int i = 0; i < 16; ++i) { const int sidx = mt * 32 + (i & 3) + 8 * (i >> 2) + 4 * h; acc[i] = (sidx < t + incl) ? acc[i] : 0.f; }
            const int dst = (prod == 0) ? 0 : (prod == 1) ? 11 : (prod == 2) ? 1 : 2;
            cs_store_t(acc, cs_slot(lds, dst), mt, nt, lane);
            if (prod == 1) cs_store_n(acc, cs_slot(lds, 12), mt, nt, lane);
        }
    }
    lds_barrier();
    {
        const int mt = (wv >> 1) & 1, nt = wv & 1;
        f32x16 pacc;
        if (wv < 4) {
#pragma unroll
            for (int i = 0; i < 16; ++i) { const int u = mt * 32 + (i & 3) + 8 * (i >> 2) + 4 * h, t = nt * 32 + lr;
                pacc[i] = ((u == t) ? 1.f : 0.f) - bf2f(cs_slot(lds, 12)[u * CS_LD + t]); }
            cs_store_t(pacc, cs_slot(lds, 3), mt, nt, lane);
        }
        lds_barrier();
        const int mcur = 11, mtcur = 12, mnxt = 5, mtnxt = 6;
        PG8_LAS bf16_t* XS0 = (PG8_LAS bf16_t*)(lds + CS_F32A);
        PG8_LAS bf16_t* XS1 = (PG8_LAS bf16_t*)(lds + CS_F32A + CS_SLOT);
        PG8_LAS bf16_t* XS2 = (PG8_LAS bf16_t*)(lds + CS_F32A + 2 * CS_SLOT);
        PG8_LAS bf16_t* Pc = cs_slot(lds, 3); PG8_LAS bf16_t* Pn = XS0;
        PG8_LAS bf16_t* Mc_ = cs_slot(lds, mcur); PG8_LAS bf16_t* MTc = cs_slot(lds, mtcur);
        PG8_LAS bf16_t* Mn = cs_slot(lds, mnxt); PG8_LAS bf16_t* MTn = cs_slot(lds, mtnxt);
#pragma unroll 1
        for (int it = 0; it < 5; ++it) {
            if (wv >= 4) {
                f32x16 acc; cs_zero(acc);
                cs_mm(acc, Mc_, MTc, mt, nt, lane);
                cs_store_n(acc, Mn, mt, nt, lane);
                cs_store_t(acc, MTn, mt, nt, lane);
                float mx = 0.f;
#pragma unroll
                for (int i = 0; i < 16; ++i) mx = fmaxf(mx, fabsf(acc[i]));
#pragma unroll
                for (int o = 32; o > 0; o >>= 1) mx = fmaxf(mx, __shfl_xor(mx, o));
                if (lane == 0) GS[640 + (wv & 3)] = mx;
            }
            lds_barrier();
            const float m2max = fmaxf(fmaxf(GS[640], GS[641]), fmaxf(GS[642], GS[643]));
            if (wv < 4) {
                cs_mm(pacc, MTn, Pc, mt, nt, lane);
                cs_store_t(pacc, Pn, mt, nt, lane);
            }
            lds_barrier();
            { PG8_LAS bf16_t* t0 = Mc_; Mc_ = Mn; Mn = t0; t0 = MTc; MTc = MTn; MTn = t0; t0 = Pc; Pc = Pn; Pn = t0; }
            if (m2max < 1e-7f) break;
        }
        {
            f32x16 acc; cs_zero(acc);
            if (wv < 4) { cs_mm<false, true>(acc, cs_slot(lds, 0), cs_slot(lds, 10), mt, nt, lane); cs_store_t(acc, XS1, mt, nt, lane); }
            else { cs_mm<false, true>(acc, Pc, cs_slot(lds, 7), mt, nt, lane); cs_store_t(acc, XS2, mt, nt, lane); }
        }
        lds_barrier();
        if (wv < 4) { f32x16 acc; cs_zero(acc); cs_mm(acc, Pc, XS1, mt, nt, lane); cs_store_t(acc, cs_slot(lds, 11), mt, nt, lane); }
        lds_barrier();
        if (wv < 4) {
            f32x16 acc; cs_zero(acc);
            cs_mm<false, true>(acc, XS2, cs_slot(lds, 8), mt, nt, lane);
#pragma unroll
            for (int i = 0; i < 16; ++i) { const int k = mt * 32 + (i & 3) + 8 * (i >> 2) + 4 * h, kp_ = nt * 32 + lr; acc[i] = ((k == kp_) ? GS[512 + k] : 0.f) - acc[i]; }
            bf16_t* mct = (bf16_t*)(rec + CK_MCT);
#pragma unroll
            for (int cc = 0; cc < 4; ++cc) { u32x2 w; w.x = pk_bf16c(acc[4 * cc], acc[4 * cc + 1]); w.y = pk_bf16c(acc[4 * cc + 2], acc[4 * cc + 3]);
                *(u32x2*)(mct + ((nt * 4 + 2 * mt + (cc >> 1)) * 64 + lr + 32 * (cc & 1)) * 8 + 4 * h) = w; }
            f32x16 s1, s2; cs_zero(s1); cs_zero(s2);
            cs_mm<true, true>(s1, cs_slot(lds, 9), cs_slot(lds, 10), mt, nt, lane);
            cs_mm<true, false>(s2, cs_slot(lds, 8), cs_slot(lds, 11), mt, nt, lane);
            bf16_t* sd = (bf16_t*)(rec + CK_SADD) + ((size_t)(wv & 3) * 64 + lane) * 16;
#pragma unroll
            for (int q8 = 0; q8 < 2; ++q8) { u32x4 w;
                w.x = pk_bf16c(s1[8 * q8] - s2[8 * q8], s1[8 * q8 + 1] - s2[8 * q8 + 1]); w.y = pk_bf16c(s1[8 * q8 + 2] - s2[8 * q8 + 2], s1[8 * q8 + 3] - s2[8 * q8 + 3]);
                w.z = pk_bf16c(s1[8 * q8 + 4] - s2[8 * q8 + 4], s1[8 * q8 + 5] - s2[8 * q8 + 5]); w.w = pk_bf16c(s1[8 * q8 + 6] - s2[8 * q8 + 6], s1[8 * q8 + 7] - s2[8 * q8 + 7]);
                *(u32x4*)(sd + q8 * 8) = w; }
        } else {
            f32x16 acc; cs_zero(acc);
            cs_mm(acc, XS2, cs_slot(lds, 2), mt, nt, lane);
            bf16_t* ry = (bf16_t*)(rec + CK_RY);
#pragma unroll
            for (int cc = 0; cc < 4; ++cc) {
                const u32x2 rv = *(const PG8_LAS u32x2*)(cs_slot(lds, 4) + (nt * 32 + lr) * CS_LD + mt * 32 + 8 * cc + 4 * h);
                const float r0 = __uint_as_float(rv.x << 16), r1 = __uint_as_float(rv.x & 0xffff0000u), r2 = __uint_as_float(rv.y << 16), r3 = __uint_as_float(rv.y & 0xffff0000u);
                u32x2 w; w.x = pk_bf16c(r0 - acc[4 * cc], r1 - acc[4 * cc + 1]); w.y = pk_bf16c(r2 - acc[4 * cc + 2], r3 - acc[4 * cc + 3]);
                *(u32x2*)(ry + ((nt * 4 + 2 * mt + (cc >> 1)) * 64 + lr + 32 * (cc & 1)) * 8 + 4 * h) = w;
            }
            f32x16 s1, s2; cs_zero(s1); cs_zero(s2);
            cs_mm<false, true>(s1, cs_slot(lds, 1), cs_slot(lds, 10), mt, nt, lane);
            cs_mm(s2, cs_slot(lds, 2), cs_slot(lds, 11), mt, nt, lane);
            bf16_t* yd = (bf16_t*)(rec + CK_Y0) + ((size_t)(wv & 3) * 64 + lane) * 16;
#pragma unroll
            for (int q8 = 0; q8 < 2; ++q8) { u32x4 w;
                w.x = pk_bf16c(s1[8 * q8] - s2[8 * q8], s1[8 * q8 + 1] - s2[8 * q8 + 1]); w.y = pk_bf16c(s1[8 * q8 + 2] - s2[8 * q8 + 2], s1[8 * q8 + 3] - s2[8 * q8 + 3]);
                w.z = pk_bf16c(s1[8 * q8 + 4] - s2[8 * q8 + 4], s1[8 * q8 + 5] - s2[8 * q8 + 5]); w.w = pk_bf16c(s1[8 * q8 + 6] - s2[8 * q8 + 6], s1[8 * q8 + 7] - s2[8 * q8 + 7]);
                *(u32x4*)(yd + q8 * 8) = w; }
        }
    }
    lds_barrier();
}

struct SeqRegs { bf16x8 a[4]; u32x4 c[2]; };
__device__ __forceinline__ void seq_load(const unsigned char* rec, int wv, int mt, int lane, SeqRegs& r) {
    const bf16_t* ap = (const bf16_t*)(rec + CK_MCT) + ((size_t)mt * 4 * 64 + lane) * 8;
    const bf16_t* cp = (const bf16_t*)(rec + CK_SADD) + ((size_t)(wv & 3) * 64 + lane) * 16;
#pragma unroll
    for (int s = 0; s < 4; ++s) r.a[s] = *(const bf16x8*)(ap + s * 64 * 8);
    r.c[0] = *(const u32x4*)cp; r.c[1] = *(const u32x4*)(cp + 8);
}
__device__ __forceinline__ void scanseq_head(const Args& a, unsigned char* ws, PG8_LAS unsigned char* lds, int b, int hd) {
    const int tid = opaque_v(threadIdx.x), lane = tid & 63, wv = __builtin_amdgcn_readfirstlane(tid >> 6);
    const int lr = lane & 31, h = lane >> 5;
    const int mt = (wv >> 1) & 1, nt = wv & 1;
    const bool isS = wv < 4;
    PG8_LAS bf16_t* SB0 = cs_slot(lds, 0); PG8_LAS bf16_t* SB1 = cs_slot(lds, 1);
    f32x16 st; cs_zero(st);
    for (int i = tid; i < 64 * CS_LD; i += NTH) { SB0[i] = 0; }
    const unsigned char* rec0 = ws + NB_CHK + (size_t)(b * 16 + hd) * 32 * CK_BYTES;
    bf16_t* srec0 = (bf16_t*)(ws + NB_SREC) + (size_t)(b * 16 + hd) * 32 * 4096;
    const int cr = (tid & 255) >> 2, cc8 = (tid & 3) * 16;
    lds_barrier();
    if (isS) {
        SeqRegs r[4];
#pragma unroll
        for (int c = 0; c < 4; ++c) seq_load(rec0 + (size_t)c * CK_BYTES, wv, mt, lane, r[c]);
#pragma unroll
        for (int c = 0; c < 32; ++c) {
            const PG8_LAS bf16_t* S = (c & 1) ? SB1 : SB0;
            PG8_LAS bf16_t* Sn = (c & 1) ? SB0 : SB1;
            f32x16 acc;
#pragma unroll
            for (int i = 0; i < 16; ++i) { const unsigned w = r[c & 3].c[i >> 3][(i & 7) >> 1]; acc[i] = __uint_as_float((i & 1) ? (w & 0xffff0000u) : (w << 16)); }
#pragma unroll
            for (int s = 0; s < 4; ++s) {
                const bf16x8 bv = *(const PG8_LAS bf16x8*)(S + (nt * 32 + lr) * CS_LD + s * 16 + h * 8);
                acc = __builtin_amdgcn_mfma_f32_32x32x16_bf16(r[c & 3].a[s], bv, acc, 0, 0, 0);
            }
            st = acc; cs_store_t(st, Sn, mt, nt, lane);
            if (c + 4 < 32) seq_load(rec0 + (size_t)(c + 4) * CK_BYTES, wv, mt, lane, r[c & 3]);
            lds_barrier();
        }
    } else {
#pragma unroll 1
        for (int c = 0; c < 32; ++c) {
            const PG8_LAS bf16_t* S = (c & 1) ? SB1 : SB0;
            const u32x4 v0 = *(const PG8_LAS u32x4*)(S + cr * CS_LD + cc8), v1 = *(const PG8_LAS u32x4*)(S + cr * CS_LD + cc8 + 8);
            bf16_t* d = srec0 + (size_t)c * 4096 + cr * 64 + cc8;
            *(u32x4*)d = v0; *(u32x4*)(d + 8) = v1;
            lds_barrier();
        }
    }
    if (isS) {
        float* so = a.out + O_WKVP + ((size_t)(b * 16 + hd) * 64 + nt * 32 + lr) * 64 + mt * 32 + 4 * h;
#pragma unroll
        for (int cc = 0; cc < 4; ++cc) *(float4*)(so + 8 * cc) = make_float4(st[4 * cc], st[4 * cc + 1], st[4 * cc + 2], st[4 * cc + 3]);
    }
    lds_barrier();
}
struct YgRegs { bf16x8 a[4]; u32x4 c[2]; u32x4 s0, s1; u32x4 vw[2], zw[2]; float rk; };
__device__ __forceinline__ void yg_load(unsigned char* ws, int ci, int tid, YgRegs& r) {
    const int lane = tid & 63, wv = tid >> 6, t4 = tid & 255;
    const int mt = (wv >> 1) & 1;
    const unsigned char* rec = ws + NB_CHK + (size_t)ci * CK_BYTES;
    const bf16_t* ap = (const bf16_t*)(rec + CK_RY) + ((size_t)mt * 4 * 64 + lane) * 8;
    const bf16_t* cp = (const bf16_t*)(rec + CK_Y0) + ((size_t)(wv & 3) * 64 + lane) * 16;
#pragma unroll
    for (int s = 0; s < 4; ++s) r.a[s] = *(const bf16x8*)(ap + s * 64 * 8);
    r.c[0] = *(const u32x4*)cp; r.c[1] = *(const u32x4*)(cp + 8);
    const bf16_t* sp = (const bf16_t*)(ws + NB_SREC) + (size_t)ci * 4096 + (t4 >> 2) * 64 + (t4 & 3) * 16;
    r.s0 = *(const u32x4*)sp; r.s1 = *(const u32x4*)(sp + 8);
    const int bh = ci >> 5, c = ci & 31, b = bh >> 4, hd = bh & 15;
    const size_t prow = (size_t)b * TP + c * 64 + (t4 >> 2);
    const int pv = (t4 & 3) * 16;
    const bf16_t* vp = (const bf16_t*)(ws + NB_RKVZ) + ((size_t)2 * XSH_ROWS + prow) * 1024 + hd * 64 + pv;
    const bf16_t* zp = (const bf16_t*)(ws + NB_RKVZ) + ((size_t)3 * XSH_ROWS + prow) * 1024 + hd * 64 + pv;
    r.vw[0] = *(const u32x4*)vp; r.vw[1] = *(const u32x4*)(vp + 8); r.zw[0] = *(const u32x4*)zp; r.zw[1] = *(const u32x4*)(zp + 8);
    r.rk = ((const float*)(ws + NB_RKS))[prow * 16 + hd];
}
__device__ __forceinline__ void yg_step(const Args& a, unsigned char* ws, PG8_LAS unsigned char* lds, int ci, int tid, const YgRegs& r) {
    const int lane = tid & 63, wv = tid >> 6, t4 = tid & 255, grp = wv >> 2;
    const int lr = lane & 31, h = lane >> 5, mt = (wv >> 1) & 1, nt = wv & 1;
    PG8_LAS bf16_t* SL = cs_slot(lds, grp);
    PG8_LAS float* YT = (PG8_LAS float*)(lds + 2 * CS_SLOT) + grp * (64 * 68);
    *(PG8_LAS u32x4*)(SL + (t4 >> 2) * CS_LD + (t4 & 3) * 16) = r.s0; *(PG8_LAS u32x4*)(SL + (t4 >> 2) * CS_LD + (t4 & 3) * 16 + 8) = r.s1;
    lds_barrier();
    {
        f32x16 acc;
#pragma unroll
        for (int i = 0; i < 16; ++i) { const unsigned w = r.c[i >> 3][(i & 7) >> 1]; acc[i] = __uint_as_float((i & 1) ? (w & 0xffff0000u) : (w << 16)); }
#pragma unroll
        for (int s = 0; s < 4; ++s) {
            const bf16x8 bv = *(const PG8_LAS bf16x8*)(SL + (nt * 32 + lr) * CS_LD + s * 16 + h * 8);
            acc = __builtin_amdgcn_mfma_f32_32x32x16_bf16(r.a[s], bv, acc, 0, 0, 0);
        }
#pragma unroll
        for (int i = 0; i < 16; ++i) YT[(mt * 32 + (i & 3) + 8 * (i >> 2) + 4 * h) * 68 + nt * 32 + lr] = acc[i];
    }
    lds_barrier();
    {
        const int ptok = t4 >> 2, pv = (t4 & 3) * 16;
        const int bh = ci >> 5, c = ci & 31, b = bh >> 4, hd = bh & 15;
        float y[16];
#pragma unroll
        for (int q = 0; q < 4; ++q) { const f32x4 v = *(const PG8_LAS f32x4*)(YT + ptok * 68 + pv + q * 4); y[4 * q] = v[0]; y[4 * q + 1] = v[1]; y[4 * q + 2] = v[2]; y[4 * q + 3] = v[3]; }
        float sm = 0.f;
#pragma unroll
        for (int i = 0; i < 16; ++i) sm += y[i];
        sm += __builtin_bit_cast(float, __builtin_amdgcn_update_dpp(0, __builtin_bit_cast(int, sm), 0xB1, 0xF, 0xF, true));
        sm += __builtin_bit_cast(float, __builtin_amdgcn_update_dpp(0, __builtin_bit_cast(int, sm), 0x4E, 0xF, 0xF, true));
        const float mean = sm * (1.f / 64.f);
        float sq = 0.f;
#pragma unroll
        for (int i = 0; i < 16; ++i) { y[i] -= mean; sq += y[i] * y[i]; }
        sq += __builtin_bit_cast(float, __builtin_amdgcn_update_dpp(0, __builtin_bit_cast(int, sq), 0xB1, 0xF, 0xF, true));
        sq += __builtin_bit_cast(float, __builtin_amdgcn_update_dpp(0, __builtin_bit_cast(int, sq), 0x4E, 0xF, 0xF, true));
        const float rs = rsqrtf(sq * (1.f / 64.f) + GN_EPS);
        const float* gg = a.in[I_GNG] + hd * 64 + pv; const float* gb = a.in[I_GNB] + hd * 64 + pv;
        float o[16];
#pragma unroll
        for (int i = 0; i < 16; ++i) {
            const unsigned vw = r.vw[i >> 3][(i & 7) >> 1], zw = r.zw[i >> 3][(i & 7) >> 1];
            const float vf = __uint_as_float((i & 1) ? (vw & 0xffff0000u) : (vw << 16)), zf = __uint_as_float((i & 1) ? (zw & 0xffff0000u) : (zw << 16));
            o[i] = fmaf(r.rk, vf, y[i] * rs * gg[i] + gb[i]) * silu_f(zf);
        }
        bf16_t* dst = (bf16_t*)(ws + NB_G4B) + ((size_t)b * TP + c * 64 + ptok) * 1024 + hd * 64 + pv;
        u32x4 w0, w1;
        w0.x = pk_bf16c(o[0], o[1]); w0.y = pk_bf16c(o[2], o[3]); w0.z = pk_bf16c(o[4], o[5]); w0.w = pk_bf16c(o[6], o[7]);
        w1.x = pk_bf16c(o[8], o[9]); w1.y = pk_bf16c(o[10], o[11]); w1.z = pk_bf16c(o[12], o[13]); w1.w = pk_bf16c(o[14], o[15]);
        *(u32x4*)dst = w0; *(u32x4*)(dst + 8) = w1;
    }
}
__device__ __forceinline__ void phase_ygate(const Args& a, unsigned char* ws, PG8_LAS unsigned char* lds, int bid, int nb) {
    const int tid = opaque_v(threadIdx.x), grp = tid >> 8;
    YgRegs cur, nxt;
    int pair = bid;
    if (pair < 2048) yg_load(ws, 2 * pair + grp, tid, nxt);
#pragma unroll 1
    while (pair < 2048) {
        cur = nxt;
        const int npair = pair + nb;
        if (npair < 2048) yg_load(ws, 2 * npair + grp, tid, nxt);
        yg_step(a, ws, lds, 2 * pair + grp, tid, cur);
        pair = npair;
    }
    lds_barrier();
}

__device__ __forceinline__ void phase_lnf(const Args& a, unsigned char* ws, int bid, int nb) {
    const int tid = opaque_v(threadIdx.x), lane = tid & 63, wv = tid >> 6;
    const float* PRE = (const float*)ws + WS_PRE;
    const float* P2 = (const float*)(ws + NB_Y);
    float x[16], nx[16], y[16], ny[16];
    int row = bid * 8 + wv;
    if (row < MT) { ld_row16(PRE + (size_t)row * 1024, lane, nx); ld_row16(P2 + (size_t)row * 1024, lane, ny); }
#pragma unroll 1
    while (row < MT) {
#pragma unroll
        for (int i = 0; i < 16; ++i) { x[i] = nx[i]; y[i] = ny[i]; }
        const int nrow = row + nb * 8;
        if (nrow < MT) { ld_row16(PRE + (size_t)nrow * 1024, lane, nx); ld_row16(P2 + (size_t)nrow * 1024, lane, ny); }
        ln_calc16(a.in[I_LNG], a.in[I_LNB], lane, x);
#pragma unroll
        for (int i = 0; i < 16; ++i) x[i] = fmaf(ALPHA, x[i], y[i]);
        ln_calc16(a.in[I_LNG] + 1024, a.in[I_LNB] + 1024, lane, x);
#if PROBE_TIME >= 0
        if (row >= MP) {
            const unsigned long long* tsp = (const unsigned long long*)(ws + NB_BAR + 16384);
            const float dt_us = (float)(__hip_atomic_load(tsp + PROBE_TIME + 1, __ATOMIC_RELAXED, __HIP_MEMORY_SCOPE_AGENT) - __hip_atomic_load(tsp + PROBE_TIME, __ATOMIC_RELAXED, __HIP_MEMORY_SCOPE_AGENT)) * 0.01f;
            const float f = 1.f + PROBE_K * dt_us;
#pragma unroll
            for (int i = 0; i < 16; ++i) x[i] *= f;
        }
#endif
        float* o = (row < MP ? a.out + O_Y + (size_t)row * 1024 : a.out + O_YS + (size_t)(row - MP) * 1024) + lane * 4;
#pragma unroll
        for (int q = 0; q < 4; ++q) *(float4*)(o + q * 256) = make_float4(x[4 * q], x[4 * q + 1], x[4 * q + 2], x[4 * q + 3]);
        row = nrow;
    }
}
__device__ __forceinline__ void sample_pool_copy(const Args& a, unsigned char* ws, int bid, int nb) {
    float* KCS = (float*)(ws + NB_KCS);
    const int* pt = (const int*)a.in[I_PT];
    const float* ccmp = a.in[I_CCMP];
#pragma unroll 2
    for (int i = bid * NTH + threadIdx.x; i < BS * 256 * 256; i += nb * NTH) {
        const int c = i & 255, n = (i >> 8) & 255, s = i >> 16;
        const int kv = c >> 7, g = (c >> 6) & 1;
        const float* w = kv ? a.in[I_WVC] : a.in[I_WKC];
        const int pos0 = n * 32;
        const float* src = ccmp + ((size_t)pt[s * NPAGE + (pos0 >> 7)] * PAGE + (pos0 & 127)) * 256 + c;
        float acc = 0.f;
#pragma unroll
        for (int l = 0; l < 32; ++l) acc = fmaf(src[(size_t)l * 256], w[l * 2 + g], acc);
        KCS[i] = acc;
    }
    const float4* cw = (const float4*)a.in[I_CWIN];
    float4* ow = (float4*)(a.out + O_WINS);
#pragma unroll 4
    for (int i = bid * NTH + threadIdx.x; i < BS * 511 * 64; i += nb * NTH) {
        const int s = i / (511 * 64), rem = i - s * (511 * 64);
        ow[(size_t)s * 512 * 64 + rem] = cw[(size_t)s * 512 * 64 + 64 + rem];
    }
}
__device__ __forceinline__ void sample_conv(const Args& a, unsigned char* ws, PG8_LAS unsigned char* lds, int s) {
    const int ch = opaque_v(threadIdx.x);
    const bf16_t* h = (const bf16_t*)(ws + NB_HB) + (size_t)(MP + s) * 2560;
    const float* sc = a.in[I_SCONV] + (size_t)s * 30 * 512 + ch;
    const float u = bf2f(h[ch]) * sigm_f(bf2f(h[512 + ch]));
    float scv[30], wj[31];
    const float* __restrict__ cwp = a.in[I_CONVW] + ch;
#pragma unroll
    for (int j = 0; j < 30; ++j) { scv[j] = sc[(size_t)j * 512]; wj[j] = cwp[j * 512]; }
    wj[30] = cwp[30 * 512];
    float acc = a.in[I_CONVB][ch];
#pragma unroll
    for (int j = 0; j < 30; ++j) acc = fmaf(wj[j], scv[j], acc);
    acc = fmaf(wj[30], u, acc);
    float* __restrict__ oc = a.out + O_CONVS + (size_t)s * 30 * 512 + ch;
#pragma unroll
    for (int i = 0; i < 29; ++i) oc[(size_t)i * 512] = scv[i + 1];
    oc[(size_t)29 * 512] = u;
    PG8_LAS float* red = (PG8_LAS float*)lds;
    const int lane = ch & 63, wv = ch >> 6;
    float sm = wave_sum(acc);
    __syncthreads();
    if (lane == 0) red[wv] = sm;
    __syncthreads();
    float tot = 0.f;
#pragma unroll
    for (int i = 0; i < 8; ++i) tot += red[i];
    const float mean = tot * (1.f / 512.f);
    const float d = acc - mean;
    float sq = wave_sum(d * d);
    __syncthreads();
    if (lane == 0) red[wv] = sq;
    __syncthreads();
    tot = 0.f;
#pragma unroll
    for (int i = 0; i < 8; ++i) tot += red[i];
    const float rs = rsqrtf(tot * (1.f / 512.f) + LN_EPS);
    const float y = silu_f(d * rs * a.in[I_CLNG][ch] + a.in[I_CLNB][ch]) * silu_f(bf2f(h[1024 + ch]));
    ((bf16_t*)(ws + NB_CATB))[(size_t)(MP + s) * 1024 + ch] = (bf16_t)(pk_bf16(y, 0.f) & 0xffffu);
    __syncthreads();
}

constexpr int SP_STRIDE = 66;
__device__ __forceinline__ void sample_attn(const Args& a, unsigned char* ws, PG8_LAS unsigned char* lds, int s, int g, int part) {
    const int tid = opaque_v(threadIdx.x), lane = tid & 63, wv = __builtin_amdgcn_readfirstlane(tid >> 6);
    PG8_LAS float* PC = (PG8_LAS float*)lds;
    PG8_LAS float* IMP = (PG8_LAS float*)(lds + 4096);
    PG8_LAS int* SEL = (PG8_LAS int*)(lds + 4096 + 1024);
    PG8_LAS int* FLG = (PG8_LAS int*)(lds + 4096 + 1024 + 128);
    PG8_LAS float* PS = (PG8_LAS float*)(lds + 8192) + (tid >> 6) * 64;
    const int r = wv & 3, hh = g * 4 + r;
    const float slope = __builtin_amdgcn_exp2f(-(float)(hh + 1));
    const int* pt = (const int*)a.in[I_PT] + s * NPAGE;
    const bf16_t* hrow = (const bf16_t*)(ws + NB_HB) + (size_t)(MP + s) * 2560;
    float q[64];
#pragma unroll
    for (int d8 = 0; d8 < 8; ++d8) { const u32x4 w = *(const u32x4*)(hrow + 1536 + hh * 64 + d8 * 8);
#pragma unroll
        for (int i = 0; i < 4; ++i) { q[d8 * 8 + 2 * i] = __uint_as_float(w[i] << 16); q[d8 * 8 + 2 * i + 1] = __uint_as_float(w[i] & 0xffff0000u); } }
#define SAMP_DOT(KPTR, OUT) { const float4* k4_ = (const float4*)(KPTR); float4 kk_[16]; \
        _Pragma("unroll") for (int i_ = 0; i_ < 16; ++i_) kk_[i_] = k4_[i_]; float s_ = 0.f; \
        _Pragma("unroll") for (int i_ = 0; i_ < 16; ++i_) { s_ = fmaf(q[4 * i_], kk_[i_].x, s_); s_ = fmaf(q[4 * i_ + 1], kk_[i_].y, s_); s_ = fmaf(q[4 * i_ + 2], kk_[i_].z, s_); s_ = fmaf(q[4 * i_ + 3], kk_[i_].w, s_); } OUT = s_; }
    if (wv < 4) {
        const float* kc = (const float*)(ws + NB_KCS) + (size_t)s * 256 * 256 + g * 64;
        float sc[4];
        float mx = -INFINITY;
#pragma unroll
        for (int i = 0; i < 4; ++i) { const int n = lane + 64 * i; float d; SAMP_DOT(kc + (size_t)n * 256, d); sc[i] = d - slope * (float)(PAST - (32 * n + 31)); mx = fmaxf(mx, sc[i]); }
#pragma unroll
        for (int o = 32; o > 0; o >>= 1) mx = fmaxf(mx, __shfl_xor(mx, o));
        float ls = 0.f;
#pragma unroll
        for (int i = 0; i < 4; ++i) { sc[i] = __expf(sc[i] - mx); ls += sc[i]; }
        ls = wave_sum(ls);
        const float inv = 1.f / ls;
#pragma unroll
        for (int i = 0; i < 4; ++i) PC[r * 256 + lane + 64 * i] = sc[i] * inv;
    }
    __syncthreads();
    if (wv < 4 && part == 0) {
        const float* vc = (const float*)(ws + NB_KCS) + (size_t)s * 256 * 256 + 128 + g * 64 + lane;
        float oc0 = 0.f, oc1 = 0.f, oc2 = 0.f, oc3 = 0.f;
#pragma unroll 8
        for (int n = 0; n < 256; n += 4) {
            oc0 = fmaf(PC[r * 256 + n], vc[(size_t)n * 256], oc0); oc1 = fmaf(PC[r * 256 + n + 1], vc[(size_t)(n + 1) * 256], oc1);
            oc2 = fmaf(PC[r * 256 + n + 2], vc[(size_t)(n + 2) * 256], oc2); oc3 = fmaf(PC[r * 256 + n + 3], vc[(size_t)(n + 3) * 256], oc3);
        }
        ((float*)(ws + NB_OCS))[(size_t)(s * 8 + hh) * 64 + lane] = (oc0 + oc1) + (oc2 + oc3);
    }
    if (tid < 129) {
        float v = 0.f;
        if (tid < 128) { for (int rr = 0; rr < 4; ++rr) v += PC[rr * 256 + 2 * tid] + PC[rr * 256 + 2 * tid + 1]; }
        if (tid == 0 || tid >= 127) v = 1e4f;
        IMP[tid] = v;
    }
    __syncthreads();
    if (tid < 129) {
        const float vj = IMP[tid];
        int rank = 0;
        for (int i = 0; i < 129; ++i) { const float vi = IMP[i]; rank += (vi > vj || (vi == vj && i < tid)) ? 1 : 0; }
        FLG[tid] = (rank < 16) ? 1 : 0;
    }
    __syncthreads();
    if (tid < 129 && FLG[tid]) { int slot = 0; for (int i = 0; i < tid; ++i) slot += FLG[i]; SEL[slot] = tid; }
    __syncthreads();
    const float* csel = a.in[I_CSEL];
    const float* newsel = a.out + O_SELS + (size_t)s * 256;
    const float* cwin = a.in[I_CWIN] + (size_t)s * 512 * 256;
    const float* newwin = a.out + O_WINS + (size_t)(s * 512 + 511) * 256;
#pragma unroll 1
    for (int it = 0; it < 3; ++it) {
        const int lb = (wv >> 2) + 2 * it;
        const bool is_sel = lb < 4;
        const int slot = is_sel ? part * 4 + lb : part * 2 + (lb - 4);
        const float* rowp; const float* vb; int vstride_last; float dist; bool valid; int nk;
        if (is_sel) {
            const int blk = SEL[slot];
            const int kpos = blk * 64 + lane;
            valid = kpos <= PAST;
            rowp = (blk < 128) ? csel + ((size_t)pt[blk >> 1] * PAGE + (kpos & 127)) * 256 : newsel;
            vb = (blk < 128) ? csel + ((size_t)pt[blk >> 1] * PAGE + ((blk * 64) & 127)) * 256 + 128 + g * 64 + lane : newsel + 128 + g * 64 + lane;
            nk = (blk < 128) ? 64 : 1; dist = (float)(PAST - kpos); vstride_last = 0;
        } else {
            const int i0 = 1 + slot * 64;
            const int i = i0 + lane;
            valid = true; nk = 64;
            rowp = (i < 512) ? cwin + (size_t)i * 256 : newwin;
            vb = cwin + (size_t)i0 * 256 + 128 + g * 64 + lane;
            dist = (float)(512 - i); vstride_last = (slot == 7) ? 1 : 0;
        }
        float sc = -INFINITY;
        if (valid) { float d; SAMP_DOT(rowp + g * 64, d); sc = d - slope * dist; }
        float mx = sc;
#pragma unroll
        for (int of = 32; of > 0; of >>= 1) mx = fmaxf(mx, __shfl_xor(mx, of));
        const float p = valid ? __expf(sc - mx) : 0.f;
        const float l = wave_sum(p);
        PS[lane] = p; __builtin_amdgcn_wave_barrier();
        float o0 = 0.f, o1 = 0.f, o2 = 0.f, o3 = 0.f;
        if (nk == 64) {
            float vv[64];
#pragma unroll
            for (int k = 0; k < 63; ++k) vv[k] = vb[(size_t)k * 256];
            vv[63] = vstride_last ? newwin[128 + g * 64 + lane] : vb[(size_t)63 * 256];
#pragma unroll
            for (int k = 0; k < 64; k += 4) { o0 = fmaf(PS[k], vv[k], o0); o1 = fmaf(PS[k + 1], vv[k + 1], o1); o2 = fmaf(PS[k + 2], vv[k + 2], o2); o3 = fmaf(PS[k + 3], vv[k + 3], o3); }
        } else o0 = PS[0] * vb[0];
        __builtin_amdgcn_wave_barrier();
        float* pp = (float*)(ws + NB_PARTS) + ((size_t)((s * 8 + hh) * 24 + (is_sel ? slot : 16 + slot))) * SP_STRIDE;
        pp[2 + lane] = (o0 + o1) + (o2 + o3);
        if (lane == 0) { pp[0] = mx; pp[1] = l; }
    }
#undef SAMP_DOT
    __syncthreads();
}
__device__ __forceinline__ void sample_combine(const Args& a, unsigned char* ws, int s, int g) {
    const int tid = opaque_v(threadIdx.x), lane = tid & 63, wv = __builtin_amdgcn_readfirstlane(tid >> 6);
    if (wv >= 4) return;
    const int hh = g * 4 + wv;
    const float* pp = (const float*)(ws + NB_PARTS) + (size_t)(s * 8 + hh) * 24 * SP_STRIDE;
    const float* g3p = (const float*)(ws + NB_G3) + (size_t)(MP + s) * 32 + hh * 3;
    const float gc = sigm_f(g3p[0]), gs = sigm_f(g3p[1]), gw = sigm_f(g3p[2]);
    float res = gc * ((const float*)(ws + NB_OCS))[(size_t)(s * 8 + hh) * 64 + lane];
#pragma unroll
    for (int br = 0; br < 2; ++br) {
        const int n0 = br ? 16 : 0, cnt = br ? 8 : 16;
        float M = -INFINITY;
        for (int i = 0; i < cnt; ++i) M = fmaxf(M, pp[(size_t)(n0 + i) * SP_STRIDE]);
        float L = 0.f, O = 0.f;
        for (int i = 0; i < cnt; ++i) { const float* q = pp + (size_t)(n0 + i) * SP_STRIDE; const float w = __expf(q[0] - M); L = fmaf(q[1], w, L); O = fmaf(q[2 + lane], w, O); }
        res = fmaf(br ? gw : gs, O / L, res);
    }
    const bf16_t* hrow = (const bf16_t*)(ws + NB_HB) + (size_t)(MP + s) * 2560;
    const float y = res * silu_f(bf2f(hrow[2048 + hh * 64 + lane]));
    ((bf16_t*)(ws + NB_CATB))[(size_t)(MP + s) * 1024 + 512 + hh * 64 + lane] = (bf16_t)(pk_bf16(y, 0.f) & 0xffffu);
}

static_assert(CS_END <= LDS_MISC, "chunk-scan LDS map overlaps the barrier words");
enum { PH_PREP = 0, PH_GEMM1, PH_CONV, PH_ATTN, PH_GEMM2, PH_LNS, PH_GEMM3, PH_PREP2, PH_SCAN, PH_POST, PH_GEMM4, PH_LNF, NPHASE };

__global__ void __launch_bounds__(NTH, 2) mega(Args a) {
    extern __shared__ __attribute__((aligned(16))) unsigned char lds_raw[];
    PG8_LAS unsigned char* lds = (PG8_LAS unsigned char*)lds_raw;
    unsigned char* ws = a.ws;
    volatile LAS unsigned* misc = (volatile LAS unsigned*)(lds + LDS_MISC);
    if (threadIdx.x < 4) misc[threadIdx.x] = 0u;
    __syncthreads();
    XcdBarrier bar = xcd_barrier_post((unsigned*)(ws + NB_BAR), misc);
    const int lo = a.ph_lo, hi = a.ph_hi;
#ifndef DUP_SATTN
#define DUP_SATTN 0
#endif
#ifndef DUP_CONV
#define DUP_CONV 0
#endif
#ifndef DUP_GEMM1
#define DUP_GEMM1 0
#endif
#ifndef SKIPMASK
#define SKIPMASK 0
#endif
#define IN(k) (lo <= (k) && (k) < hi && !((SKIPMASK >> (k)) & 1))
#ifndef REPMASK
#define REPMASK 0
#endif
#define REPS(k) _Pragma("unroll 1") for (int rep_ = 0; rep_ < (((REPMASK >> (k)) & 1) ? 2 : 1); ++rep_)
#if PROBE_TIME >= 0
    unsigned long long* const tstamp = (unsigned long long*)(ws + NB_BAR + 16384);
#define STAMP(i) do { if (blockIdx.x == 0 && threadIdx.x == 0) __hip_atomic_store(tstamp + (i), (unsigned long long)__builtin_amdgcn_s_memrealtime(), __ATOMIC_RELAXED, __HIP_MEMORY_SCOPE_AGENT); } while (0)
#else
#define STAMP(i) do { } while (0)
#endif
#define SEAM(k) do { if (IN(k) && IN((k) + 1)) xcd_barrier(bar); STAMP((k) + 1); } while (0)
    STAMP(0);
    if (IN(PH_PREP)) REPS(PH_PREP) {
        const int bid = opaque(blockIdx.x), nb = gridDim.x;
        convert_wt(a.in[I_WIN], 1024, DIN, (bf16_t*)(ws + NB_WT1), N1PAD, MapWin{}, bid, nb);
        convert_wt(a.in[I_WOUTE], 1024, 1024, (bf16_t*)(ws + NB_WT2), 1024, MapId{}, bid, nb);
        for (int n = 0; n < 4; ++n) convert_wt(a.in[I_WRKVZ] + (size_t)n * 1024 * 1024, 1024, 1024, (bf16_t*)(ws + NB_WT3) + (size_t)n * 1024 * 1024, 1024, MapId{}, bid, nb);
        convert_wt(a.in[I_WOUTO], 1024, 1024, (bf16_t*)(ws + NB_WT4), 1024, MapId{}, bid, nb);
        convert_wt(a.in[I_W1], 1024, 64, (bf16_t*)(ws + NB_W1T), 64, MapId{}, bid, nb);
        convert_wt(a.in[I_A1], 1024, 64, (bf16_t*)(ws + NB_A1T), 64, MapId{}, bid, nb);
        convert_wt(a.in[I_W2], 64, 1024, (bf16_t*)(ws + NB_W2T), 1024, MapId{}, bid, nb);
        convert_wt(a.in[I_A2], 64, 1024, (bf16_t*)(ws + NB_A2T), 1024, MapId{}, bid, nb);
        convert_rows(a.in[I_XP], (size_t)MP * 1024 / 8, (bf16_t*)(ws + NB_XB), bid, nb);
        convert_rows(a.in[I_XS], (size_t)BS * 1024 / 8, (bf16_t*)(ws + NB_XSB), bid, nb);
        sample_pool_copy(a, ws, bid, nb);
    }
    SEAM(PH_PREP);
    if (IN(PH_GEMM1)) REPS(PH_GEMM1) {
        const int bid = opaque(blockIdx.x), nb = gridDim.x;
        const Route1 R{(bf16_t*)(ws + NB_HB), (bf16_t*)(ws + NB_KVB), (float*)(ws + NB_G3), a.out};
        {
            pg8::Gemm g{(const bf16_t*)(ws + NB_XB), (const bf16_t*)(ws + NB_WT1), MP, N1PAD, 1024};
            pg8::StaticOrder S; S.init(MP, N1PAD, nb, bid);
            Epi1 E{R};
            pg8::gemm_phase<Epi1, pg8::StaticOrder, false>(lds, g, S, E, nullptr);
#if DUP_GEMM1
            __syncthreads();
            pg8::gemm_phase<Epi1, pg8::StaticOrder, false>(lds, g, S, E, nullptr);
#endif
        }
        {
            for (int task = bid; task < 105; task += nb) {
                sample_gemm32_wg((const bf16_t*)(ws + NB_XSB), (const bf16_t*)(ws + NB_WT1), 1024, task * 32, lds,
                    [&](int r, int n, float v) {
                        const int row = MP + r;
                        if (n < 2560) { const float sc = (n >= 1536 && n < 2048) ? 0.125f : 1.0f; ((bf16_t*)(ws + NB_HB))[(size_t)row * 2560 + n] = (bf16_t)(pk_bf16c(v * sc, 0.f) & 0xffffu); }
                        else if (n < 3328) { const int c = n - 2560, i3 = c >> 8, cc = c & 255; ((bf16_t*)(ws + NB_KVB))[(size_t)row * 768 + c] = (bf16_t)(pk_bf16c(v, 0.f) & 0xffffu);
                            float* dst = (i3 == 0) ? a.out + O_CMPS + (size_t)r * 256 + cc : (i3 == 1) ? a.out + O_SELS + (size_t)r * 256 + cc : a.out + O_WINS + (size_t)(r * 512 + 511) * 256 + cc;
                            *dst = v; }
                        else if (n < 3352) ((float*)(ws + NB_G3))[(size_t)row * 32 + (n - 3328)] = v;
                    });
            }
        }
    }
    SEAM(PH_GEMM1);
    if (IN(PH_CONV)) REPS(PH_CONV) {
        const int bid = opaque(blockIdx.x), nb = gridDim.x;
#pragma unroll 1
        for (int item = bid; item < 512; item += nb) conv_item(a, ws, lds, item);
        pool_prompt(a, ws, bid, nb);
        sample_attn(a, ws, lds, bid >> 3, (bid >> 2) & 1, bid & 3);
#if DUP_SATTN
        __syncthreads();
        sample_attn(a, ws, lds, bid >> 3, (bid >> 2) & 1, bid & 3);
#endif
        if (bid >= 96 && bid < 128) sample_conv(a, ws, lds, bid - 96);
    }
    SEAM(PH_CONV);
    if (IN(PH_ATTN)) REPS(PH_ATTN) {
        const int bid = opaque(blockIdx.x), nb = gridDim.x;
        if (bid < 64) sample_combine(a, ws, bid >> 1, bid & 1);
        for (int pr = bid; pr < 256; pr += nb) {
            const int b = pr >> 5, g = (pr >> 4) & 1, xq = pr & 15;
#pragma unroll 1
            for (int k = 0; k < 2; ++k) attn_item(a, ws, lds, b, g, k ? xq : 31 - xq);
        }
    }
    SEAM(PH_ATTN);
    if (IN(PH_GEMM2)) REPS(PH_GEMM2) {
        const int bid = opaque(blockIdx.x), nb = gridDim.x;
        {
            pg8::Gemm g{(const bf16_t*)(ws + NB_CATB), (const bf16_t*)(ws + NB_WT2), MP, 1024, 1024};
            pg8::StaticOrder S; S.init(MP, 1024, nb, bid);
            EpiPreRes E{(float*)ws + WS_PRE, a.in[I_XP]};
            pg8::gemm_phase<EpiPreRes, pg8::StaticOrder, false>(lds, g, S, E, nullptr);
        }
        {
            const int lane = threadIdx.x & 63, wv = __builtin_amdgcn_readfirstlane(threadIdx.x >> 6);
            float* PREs = (float*)ws + WS_PRE + (size_t)MP * 1024;
            const float* xs = a.in[I_XS];
            for (int task = bid; task < 32; task += nb)
                sample_gemm32_wg((const bf16_t*)(ws + NB_CATB) + (size_t)MP * 1024, (const bf16_t*)(ws + NB_WT2), 1024, task * 32, lds,
                              [&](int r, int n, float v) { PREs[(size_t)r * 1024 + n] = fmaf(ALPHA, xs[(size_t)r * 1024 + n], v); });
        }
    }
    SEAM(PH_GEMM2);
    if (IN(PH_LNS)) REPS(PH_LNS) { const int bid = opaque(blockIdx.x), nb = gridDim.x; phase_lns(a, ws, bid, nb); }
    SEAM(PH_LNS);
    if (IN(PH_GEMM3)) REPS(PH_GEMM3) {
        const int bid = opaque(blockIdx.x), nb = gridDim.x;
        {
            pg8::Gemm g{(const bf16_t*)(ws + NB_XSH), (const bf16_t*)(ws + NB_WT3), MP, 4096, 1024};
            Order3 S; S.init(nb, bid);
            Epi3 E{(bf16_t*)(ws + NB_RKVZ)};
            pg8::gemm_phase<Epi3, Order3, false>(lds, g, S, E, nullptr);
        }
        {
            const int lane = threadIdx.x & 63, wv = __builtin_amdgcn_readfirstlane(threadIdx.x >> 6);
            for (int task = bid; task < 128; task += nb) {
                const int n = task >> 5, n0 = (task & 31) * 32;
                bf16_t* dst = (bf16_t*)(ws + NB_RKVZ) + ((size_t)n * XSH_ROWS + MP) * 1024;
                sample_gemm32_wg((const bf16_t*)(ws + NB_XSH) + ((size_t)n * XSH_ROWS + MP) * 1024, (const bf16_t*)(ws + NB_WT3) + (size_t)n * 1024 * 1024, 1024, n0, lds,
                              [&](int r, int c, float v) { dst[(size_t)r * 1024 + c] = (bf16_t)(pk_bf16c(v, 0.f) & 0xffffu); });
            }
            {
                const int tidl = opaque_v(threadIdx.x);
                LoraRegs lcur, lnxt;
                int task = bid;
                if (task < 1026) lora_load(ws, task, tidl, lnxt);
#pragma unroll 1
                while (task < 1026) {
                    lcur = lnxt;
                    const int ntask = task + nb;
                    if (ntask < 1026) lora_load(ws, ntask, tidl, lnxt);
                    lora_tile(ws, lds, task, tidl, lcur);
                    task = ntask;
                }
            }
        }
    }
    SEAM(PH_GEMM3);
    if (IN(PH_PREP2)) REPS(PH_PREP2) {
        const int bid = opaque(blockIdx.x), nb = gridDim.x;
        for (int pr = bid; pr < 256; pr += nb) {
            const int bh = pr >> 1, b = bh >> 4, hd = bh & 15, c0 = (pr & 1) * 16;
            const int tidp = opaque_v(threadIdx.x), lanep = tidp & 63, wvp = tidp >> 6;
            bf16x8 btf[4];
            { const int which = wvp >> 2, nt = wvp & 1;
              const bf16_t* Bt = (const bf16_t*)(ws + (which ? NB_A2T : NB_W2T)) + (size_t)(hd * 64 + nt * 32 + (lanep & 31)) * 64 + (lanep >> 5) * 8;
#pragma unroll
              for (int s4 = 0; s4 < 4; ++s4) btf[s4] = *(const bf16x8*)(Bt + s4 * 16); }
            PreRegs pcur, pnxt;
            scanpre_load(ws, b, hd, c0, tidp, pnxt);
#pragma unroll 1
            for (int cc = 0; cc < 16; ++cc) {
                pcur = pnxt;
                if (cc + 1 < 16) scanpre_load(ws, b, hd, c0 + cc + 1, tidp, pnxt);
                scanpre_chunk(a, ws, lds, b, hd, c0 + cc, pcur, btf);
            }
        }
    }
    SEAM(PH_PREP2);
    if (IN(PH_SCAN)) REPS(PH_SCAN) {
        const int bid = opaque(blockIdx.x), nb = gridDim.x;
#pragma unroll 1
        for (int item = bid; item < 128; item += nb) scanseq_head(a, ws, lds, item >> 4, item & 15);
        const int lane = opaque_v(threadIdx.x) & 63, wv = __builtin_amdgcn_readfirstlane(threadIdx.x >> 6);
        for (int task = (nb - 1 - bid) * 8 + wv; task < BS * 16; task += nb * 8) scan_sample(a, ws, task >> 4, task & 15, lane);
    }
    SEAM(PH_SCAN);
    if (IN(PH_POST)) REPS(PH_POST) { const int bid = opaque(blockIdx.x), nb = gridDim.x; phase_ygate(a, ws, lds, bid, nb); }
    SEAM(PH_POST);
    if (IN(PH_GEMM4)) REPS(PH_GEMM4) {
        const int bid = opaque(blockIdx.x), nb = gridDim.x;
        {
            pg8::Gemm g{(const bf16_t*)(ws + NB_G4B), (const bf16_t*)(ws + NB_WT4), MP, 1024, 1024};
            pg8::StaticOrder S; S.init(MP, 1024, nb, bid);
            EpiPre E{(float*)(ws + NB_Y), 1024};
            pg8::gemm_phase<EpiPre, pg8::StaticOrder, false>(lds, g, S, E, nullptr);
        }
        {
            float* PREs = (float*)(ws + NB_Y) + (size_t)MP * 1024;
            for (int task = bid; task < 32; task += nb)
                sample_gemm32_wg((const bf16_t*)(ws + NB_G4B) + (size_t)MP * 1024, (const bf16_t*)(ws + NB_WT4), 1024, task * 32, lds,
                              [&](int r, int n, float v) { PREs[(size_t)r * 1024 + n] = v; });
        }
    }
    SEAM(PH_GEMM4);
    if (IN(PH_LNF)) REPS(PH_LNF) { const int bid = opaque(blockIdx.x), nb = gridDim.x; phase_lnf(a, ws, bid, nb); }
#undef IN
#undef SEAM
}
}

extern "C" void kernel_launch(void* const* d_in, const int* in_sizes, int n_in, void* d_out, int out_size, void* d_ws, size_t ws_size,
                              hipStream_t stream) {
    if (n_in != N_IN || ws_size < nk::NB_END) { fprintf(stderr, "kernel_launch: unexpected n_in %d or ws_size %zu (need %zu)\n", n_in, ws_size, (size_t)nk::NB_END); return; }
    static int grid = 0;
    if (!grid) {
        int dev = 0, cus = 0, per_cu = 0;
        hipGetDevice(&dev);
        hipDeviceGetAttribute(&cus, hipDeviceAttributeMultiprocessorCount, dev);
        hipFuncSetAttribute((const void*)nk::mega, hipFuncAttributeMaxDynamicSharedMemorySize, nk::LDS_BYTES);
        hipOccupancyMaxActiveBlocksPerMultiprocessor(&per_cu, (const void*)nk::mega, nk::NTH, nk::LDS_BYTES);
        if (per_cu < 1) fprintf(stderr, "kernel_launch: occupancy query says %d blocks per CU\n", per_cu);
        grid = cus;
    }
    hipMemsetAsync((unsigned char*)d_ws + nk::NB_BAR, 0, 32768, stream);
    nk::Args a{};
    for (int i = 0; i < N_IN; ++i) a.in[i] = (const float*)d_in[i];
    a.out = (float*)d_out; a.ws = (unsigned char*)d_ws; a.ph_lo = 0; a.ph_hi = nk::NPHASE;
    void* args[] = {&a};
    hipError_t e = hipLaunchCooperativeKernel((const void*)nk::mega, dim3(grid), dim3(nk::NTH), args, nk::LDS_BYTES, stream);
    if (e != hipSuccess) fprintf(stderr, "cooperative launch failed: %s (grid %d)\n", hipGetErrorString(e), grid);
}
```

```cpp
#include <hip/hip_runtime.h>
#include <hip/hip_cooperative_groups.h>
#include <cstdio>
namespace cg = cooperative_groups;
#ifndef PROBE_TIME
#define PROBE_TIME -1
#endif
#ifndef PROBE_K
#define PROBE_K 1e-4f
#endif

constexpr int D = 1024, BP = 8, TP = 2048, MP = BP * TP, BS = 32, MT = MP + BS;
constexpr int DIN = 3352;
constexpr int C_AVAL = 0, C_AGLU = 512, C_ZA = 1024, C_Q = 1536, C_KV = 2048, C_G3 = 2816, C_ZB = 2840;
constexpr int C_CMP = C_KV, C_SEL = C_KV + 256, C_WIN = C_KV + 512;
constexpr int PAST = 8192, NPAGE = 64, PAGE = 128;
constexpr float ALPHA = 1.4142135623730951f;
constexpr float LN_EPS = 1e-5f, GN_EPS = 64e-5f;

constexpr size_t O_Y = 0, O_YS = 16777216, O_CMPP = 16809984, O_CMPS = 21004288, O_SELP = 21012480, O_SELS = 25206784,
                 O_WINP = 25214976, O_WINS = 26263552, O_CONVP = 30457856, O_CONVS = 30580736, O_WKVP = 31072256,
                 O_WKVS = 31596544, O_SHP = 33693696, O_SHS = 33701888;

enum { I_XP = 0, I_XS, I_CCMP, I_CSEL, I_CWIN, I_SCONV, I_SWKV, I_SSHIFT, I_PT, I_WIN, I_CONVW, I_CONVB, I_CLNG, I_CLNB,
       I_WKC, I_WVC, I_WOUTE, I_MU, I_WRKVZ, I_W0, I_W1, I_W2, I_A0, I_A1, I_A2, I_KK, I_KA, I_RK, I_GNG, I_GNB, I_WOUTO,
       I_LNG, I_LNB, N_IN };

constexpr size_t SZ_ROWD = (size_t)MT * D;
constexpr size_t WS_H = 0;
constexpr size_t WS_CAT = WS_H + (size_t)MT * DIN;
constexpr size_t WS_OC = WS_CAT + SZ_ROWD;
constexpr size_t WS_XSH = 0;
constexpr size_t WS_Y = 0;
constexpr size_t WS_G4 = SZ_ROWD;
constexpr size_t WS_R0END = 6 * SZ_ROWD;
constexpr size_t WS_PRE = WS_R0END;
constexpr size_t WS_X1 = WS_PRE + SZ_ROWD;
constexpr size_t WS_R = WS_X1 + SZ_ROWD;
constexpr size_t WS_K = WS_R + SZ_ROWD;
constexpr size_t WS_V = WS_K + SZ_ROWD;
constexpr size_t WS_Z = WS_V + SZ_ROWD;
constexpr size_t WS_DEC = WS_Z + SZ_ROWD;
constexpr size_t WS_KKN = WS_DEC + SZ_ROWD;
constexpr size_t WS_KKA = WS_KKN + SZ_ROWD;
constexpr size_t WS_TW = WS_KKA + SZ_ROWD;
constexpr size_t WS_AW = WS_TW + (size_t)MT * 64;
constexpr size_t WS_RK = WS_AW + (size_t)MT * 64;
constexpr size_t WS_END = WS_RK + (size_t)MT * 16;
constexpr size_t WS_PCP = WS_R;
constexpr size_t WS_PCS = WS_R + (size_t)MP * 8 * 64;
constexpr size_t WS_IMP = WS_K;
constexpr size_t WS_SELIDX = WS_V;
constexpr size_t WS_KCP = WS_Z;
constexpr size_t WS_KCS = WS_Z + (size_t)8 * 64 * 256;
static_assert(WS_OC + (size_t)MT * 512 <= WS_R0END, "layer0 temporaries overflow region 0");

namespace pg8 {
#define PG8_LAS __attribute__((address_space(3)))
typedef unsigned short bf16_t;
typedef short bf16x8 __attribute__((ext_vector_type(8)));
typedef float f32x4 __attribute__((ext_vector_type(4)));
typedef unsigned u32x4 __attribute__((ext_vector_type(4)));
constexpr int BM = 256, BK = 64, HALF = 128, HTB = HALF * BK * 2  , STAGE_BYTES = 8 * HTB, NXCD = 8, WGM = 8;

__host__ __device__ __forceinline__ int lds_byte(int r, int c) { const int st = (r >> 4) * 2 + (c >> 5), rr = r & 15, cc = c & 31, ob = rr * 64 + cc * 2; return st * 1024 + (ob ^ (((ob >> 9) & 1) << 5)); }
__host__ __device__ __forceinline__ void stage_rc(int b, int& R, int& C) { const int st = b / 1024, sb = b % 1024, swz = sb ^ (((sb >> 9) & 1) << 5); R = (st >> 1) * 16 + swz / 64; C = (st & 1) * 32 + (swz % 64) / 2; }
__host__ __device__ __forceinline__ int perm32(int rho) { const int n = rho >> 4, i = rho & 15; return 8 * (i >> 2) + 4 * n + (i & 3); }

struct Unit { int pm, pn; };
struct Gemm { const bf16_t* A; const bf16_t* Bt; int M, N, K; };

struct StaticOrder {
    int nM, nN, nwg, G, c;
    __host__ __device__ void init(int M, int N, int G_, int c_) { nM = M / BM; nN = N / BM; nwg = nM * nN; G = G_; c = c_; }
    __host__ __device__ bool next(int i, Unit& u) const {
        const long L = (long)i * G + c; if (L >= nwg) return false;
        int wgid = (int)L; { const int q = nwg / NXCD, r = nwg % NXCD, xcd = wgid % NXCD, off = wgid / NXCD; wgid = (xcd < r ? xcd * (q + 1) : r * (q + 1) + (xcd - r) * q) + off; }
        const int nig = WGM * nN, gid = wgid / nig, fm = gid * WGM, gsz = (nM - fm) < WGM ? (nM - fm) : WGM;
        u.pm = fm + ((wgid % nig) % gsz); u.pn = (wgid % nig) / gsz; return true;
    }
    __device__ __forceinline__ void a_ready(const Unit&) const {}
    __device__ __forceinline__ void done(const Unit&) const {}
};
struct CountedOrder : StaticOrder {
    const unsigned* ready; unsigned need; unsigned* tmo;
    __device__ __forceinline__ void a_ready(const Unit& u) const {
        if (threadIdx.x < 64) {
            const unsigned long long t0 = __builtin_amdgcn_s_memrealtime(); unsigned polls = 0;
            while ((unsigned)__builtin_amdgcn_readfirstlane(__hip_atomic_load(ready + 64 * u.pm, __ATOMIC_RELAXED, __HIP_MEMORY_SCOPE_AGENT)) < need) {
                if ((++polls & 255u) == 0u && __builtin_amdgcn_readfirstlane(__hip_atomic_load(tmo, __ATOMIC_RELAXED, __HIP_MEMORY_SCOPE_AGENT)) != 0u) break;
                if (__builtin_amdgcn_s_memrealtime() - t0 > 2000000ull) {
                    if (threadIdx.x == 0) { unsigned expect = 0u; __hip_atomic_compare_exchange_strong(tmo + 1, &expect, 0x600u | (unsigned)(u.pm & 0xff), __ATOMIC_RELAXED, __ATOMIC_RELAXED, __HIP_MEMORY_SCOPE_AGENT); __hip_atomic_store(tmo, 1u, __ATOMIC_RELAXED, __HIP_MEMORY_SCOPE_AGENT); }
                    break; }
                __builtin_amdgcn_s_sleep(2); }
            __builtin_amdgcn_fence(__ATOMIC_ACQUIRE, "agent");
            asm volatile("s_waitcnt vmcnt(0)" ::: "memory");
        }
#if !defined(BROKEN_HOOK_NO_BARRIER)
        asm volatile("" ::: "memory"); __builtin_amdgcn_s_barrier(); asm volatile("" ::: "memory");
#endif
    }
};


template <class Epi, class Sched, bool STAMP = false>
__device__ __forceinline__ void gemm_phase(PG8_LAS unsigned char* lds, const Gemm g, const Sched& S, const Epi& E, unsigned long long* stamps) {
    int tid_ = threadIdx.x; asm volatile("" : "+v"(tid_));
    const int tid = tid_, wid = __builtin_amdgcn_readfirstlane(tid >> 6), lane = tid & 63, wr = wid >> 2, wc = wid & 3, fr = lane & 15, fq = lane >> 4;
    const int K = g.K, nt = K / BK;
    int ts_lo = 0, ts_hi = 0, nts = 0; const unsigned long long rt_entry = STAMP ? (unsigned long long)wall_clock64() : 0ull;
#define PG8_STAMP() do { if (STAMP && wid == 0 && nts < 64) { const unsigned long long _c = (unsigned long long)clock64(); \
        ts_lo = (lane == nts) ? (int)(unsigned)_c : ts_lo; ts_hi = (lane == nts) ? (int)(unsigned)(_c >> 32) : ts_hi; ++nts; } } while (0)
    PG8_STAMP();
    unsigned voffA[2], voffB[2];
#pragma unroll
    for (int i = 0; i < 2; ++i) { int R, C; stage_rc(tid * 16 + i * 8192, R, C); const int Rb = Epi::PERM ? ((R & ~31) + perm32(R & 31)) : R;
        voffA[i] = (unsigned)(R * K + C) * 2u; voffB[i] = (unsigned)(Rb * K + C) * 2u; }
    const size_t kstep = (size_t)(BK * 2);
    const size_t hstep = (size_t)HALF * K * 2;
    const size_t tstep = 2 * hstep;
    const unsigned ldsw = (unsigned)wid * 1024u;
    const int aoff = lds_byte(wr * 64 + fr, fq * 8), boff = lds_byte(wc * 32 + fr, fq * 8);
#define PG8_SA(b, h) (((b) * 2 + (h)) * HTB)
#define PG8_SB(b, h) ((4 + (b) * 2 + (h)) * HTB)
#define PG8_STAGE(bufoff, gbase, voff) do { _Pragma("unroll") for (int _i = 0; _i < 2; ++_i) \
        __builtin_amdgcn_global_load_lds((const unsigned*)((const char*)(gbase) + (voff)[_i]), (PG8_LAS unsigned*)(lds + (bufoff) + ldsw + _i * 8192), 16, 0, 0); } while (0)
#define PG8_LDA(dst, b, h) do { _Pragma("unroll") for (int m = 0; m < 4; ++m) _Pragma("unroll") for (int k = 0; k < 2; ++k) dst[m][k] = *(const PG8_LAS bf16x8*)(lds + PG8_SA(b, h) + aoff + m * 2048 + k * 1024); } while (0)
#define PG8_LDB(dst, b, h) do { _Pragma("unroll") for (int n = 0; n < 2; ++n) _Pragma("unroll") for (int k = 0; k < 2; ++k) dst[n][k] = *(const PG8_LAS bf16x8*)(lds + PG8_SB(b, h) + boff + n * 2048 + k * 1024); } while (0)
#define PG8_MMA(ai, bj, At, Bt) do { __builtin_amdgcn_s_setprio(1); _Pragma("unroll") for (int m = 0; m < 4; ++m) _Pragma("unroll") for (int n = 0; n < 2; ++n) _Pragma("unroll") for (int k = 0; k < 2; ++k) \
        acc[ai][bj][m][n] = __builtin_amdgcn_mfma_f32_16x16x32_bf16(Bt[n][k], At[m][k], acc[ai][bj][m][n], 0, 0, 0); __builtin_amdgcn_s_setprio(0); } while (0)
#define PG8_WAIT_V(n) asm volatile("s_waitcnt vmcnt(" #n ")" ::: "memory")
#define PG8_WAIT_L(n) asm volatile("s_waitcnt lgkmcnt(" #n ")" ::: "memory")
#define PG8_BAR __builtin_amdgcn_s_barrier()
#define PG8_SCHED __builtin_amdgcn_sched_barrier(0)
    Unit cur, nxt; int ui = 0;
    if (!S.next(0, cur)) return;
    f32x4 acc[2][2][4][2];
#pragma unroll
    for (int a = 0; a < 2; ++a)
#pragma unroll
        for (int b = 0; b < 2; ++b)
#pragma unroll
            for (int m = 0; m < 4; ++m)
#pragma unroll
                for (int n = 0; n < 2; ++n) acc[a][b][m][n] = (f32x4){0.f, 0.f, 0.f, 0.f};
    bf16x8 At[4][2], B0[2][2], B1[2][2];
    const char* cA = (const char*)g.A + (size_t)cur.pm * tstep; const char* cB = (const char*)g.Bt + (size_t)cur.pn * tstep;
    S.a_ready(cur);
    PG8_STAGE(PG8_SB(0, 0), cB, voffB); PG8_STAGE(PG8_SA(0, 0), cA, voffA); PG8_STAGE(PG8_SB(0, 1), cB + hstep, voffB); PG8_STAGE(PG8_SA(0, 1), cA + hstep, voffA);
    if (wr == 1) PG8_BAR;
    PG8_WAIT_V(4); PG8_BAR;
    PG8_STAGE(PG8_SB(1, 0), cB + kstep, voffB); PG8_STAGE(PG8_SA(1, 0), cA + kstep, voffA); PG8_STAGE(PG8_SB(1, 1), cB + hstep + kstep, voffB);
    PG8_WAIT_V(6); PG8_BAR;
    PG8_STAMP();
    for (;;) {
        const bool has_next = S.next(ui + 1, nxt);
        const char* nA = has_next ? (const char*)g.A + (size_t)nxt.pm * tstep : cA; const char* nB = has_next ? (const char*)g.Bt + (size_t)nxt.pn * tstep : cB;
        for (int t = 0; t < nt; t += 2) {
            const bool last = (t == nt - 2);
            const char* a1 = cA + (size_t)(t + 1) * kstep;
            const char* a2 = last ? nA : cA + (size_t)(t + 2) * kstep; const char* b2 = last ? nB : cB + (size_t)(t + 2) * kstep;
            const char* a3 = a2 + kstep; const char* b3 = b2 + kstep;
            if (last && has_next) S.a_ready(nxt);
            PG8_LDB(B0, 0, 0); PG8_SCHED; PG8_LDA(At, 0, 0); PG8_STAGE(PG8_SA(1, 1), a1 + hstep, voffA);
            PG8_WAIT_L(8); PG8_BAR; PG8_WAIT_L(0); PG8_MMA(0, 0, At, B0); PG8_BAR; PG8_SCHED;
            PG8_LDB(B1, 0, 1); PG8_STAGE(PG8_SB(0, 0), b2, voffB);
            PG8_BAR; PG8_WAIT_L(0); PG8_MMA(0, 1, At, B1); PG8_BAR;
            PG8_LDA(At, 0, 1); PG8_STAGE(PG8_SA(0, 0), a2, voffA);
            PG8_BAR; PG8_WAIT_L(0); PG8_MMA(1, 0, At, B0); PG8_BAR; PG8_SCHED;
            PG8_STAGE(PG8_SB(0, 1), b2 + hstep, voffB);
            PG8_WAIT_V(6); PG8_BAR; PG8_MMA(1, 1, At, B1); PG8_BAR;
            PG8_LDB(B0, 1, 0); PG8_SCHED; PG8_LDA(At, 1, 0); PG8_STAGE(PG8_SA(0, 1), a2 + hstep, voffA);
            PG8_WAIT_L(8); PG8_BAR; PG8_WAIT_L(0); PG8_MMA(0, 0, At, B0); PG8_BAR; PG8_SCHED;
            PG8_LDB(B1, 1, 1); PG8_STAGE(PG8_SB(1, 0), b3, voffB);
            PG8_BAR; PG8_WAIT_L(0); PG8_MMA(0, 1, At, B1); PG8_BAR;
            PG8_LDA(At, 1, 1); PG8_STAGE(PG8_SA(1, 0), a3, voffA);
            PG8_BAR; PG8_WAIT_L(0); PG8_MMA(1, 0, At, B0); PG8_BAR; PG8_SCHED;
            PG8_STAGE(PG8_SB(1, 1), b3 + hstep, voffB);
            PG8_WAIT_V(6); PG8_BAR; PG8_MMA(1, 1, At, B1); PG8_BAR;
        }
        PG8_STAMP();
        if constexpr (!Epi::AFTER_DRAIN) { E(acc, cur, wr, wc, fr, fq); S.done(cur); }
        PG8_STAMP();
        if (!has_next) break;
#pragma unroll
        for (int a = 0; a < 2; ++a)
#pragma unroll
            for (int b = 0; b < 2; ++b)
#pragma unroll
                for (int m = 0; m < 4; ++m)
#pragma unroll
                    for (int n = 0; n < 2; ++n) acc[a][b][m][n] = (f32x4){0.f, 0.f, 0.f, 0.f};
        cur = nxt; cA = nA; cB = nB; ++ui;
    }
    PG8_WAIT_V(0);
    if (wr == 0) PG8_BAR;
    PG8_BAR;
    if constexpr (Epi::AFTER_DRAIN) { E.fused(acc, cur, wr, wc, fr, fq, lds, wid, lane); S.done(cur); }
    PG8_STAMP();
    if (STAMP && wid == 0) { stamps[lane] = lane < nts ? (((unsigned long long)(unsigned)ts_hi << 32) | (unsigned)ts_lo) : 0ull;
        if (lane == 62) stamps[62] = rt_entry; if (lane == 63) stamps[63] = (unsigned long long)wall_clock64(); }
#undef PG8_STAMP
#undef PG8_SA
#undef PG8_SB
#undef PG8_STAGE
#undef PG8_LDA
#undef PG8_LDB
#undef PG8_MMA
#undef PG8_WAIT_V
#undef PG8_WAIT_L
#undef PG8_BAR
#undef PG8_SCHED
}
}

#define XB_TMO      128
#define XB_XCNT(j)  (256  + 64 * (j))
#define XB_XSUB(j)  (1280 + 64 * (j))
#define XB_XGEN(j)  (2304 + 64 * (j))
#define XB_TOP      3328
#define XB_TOPGEN   3392
#define XCD_BAR_WORDS 3456
#define XB_SPIN_CAP (1u << 18)
#define LAS __attribute__((address_space(3)))

__device__ __forceinline__ unsigned xb_ld(unsigned* p)              { return __hip_atomic_load(p, __ATOMIC_RELAXED, __HIP_MEMORY_SCOPE_AGENT); }
__device__ __forceinline__ unsigned xb_add(unsigned* p, unsigned v) { return __hip_atomic_fetch_add(p, v, __ATOMIC_RELAXED, __HIP_MEMORY_SCOPE_AGENT); }
__device__ __forceinline__ unsigned xb_xcc_id() { return (unsigned)__builtin_amdgcn_s_getreg((3 << 11) | 20) & 0xFu; }
#define XB_SPIN(cond, bar) do { unsigned _sp = 0; while (cond) { __builtin_amdgcn_s_sleep(1); \
    if ((++_sp & 255u) == 0u) { if (xb_ld(&(bar)[XB_TMO])) break; if (_sp > XB_SPIN_CAP) { atomicAdd(&(bar)[XB_TMO], 1u); break; } } } } while (0)

struct XcdBarrier {
    unsigned* bar; unsigned x;
    volatile LAS unsigned* st;
};

__device__ __forceinline__ XcdBarrier xcd_barrier_post(unsigned* bar, volatile LAS unsigned* st) {
    XcdBarrier b; b.bar = bar; b.x = xb_xcc_id(); b.st = st;
    if (threadIdx.x == 0) (void)xb_add(&bar[XB_XCNT(b.x)], 1u);
    return b;
}
__device__ __forceinline__ void xcd_barrier_complete(unsigned* bar, unsigned x, unsigned& nloc, unsigned& nx) {
    const unsigned G = gridDim.x * gridDim.y * gridDim.z;
    unsigned sum, cnt, mine, sp = 0u;
    for (;;) {
        sum = 0u; cnt = 0u; mine = 0u;
#pragma unroll
        for (unsigned j = 0; j < 16; ++j) { const unsigned c = xb_ld(&bar[XB_XCNT(j)]); sum += c; cnt += (c > 0u) ? 1u : 0u; mine = (j == x) ? c : mine; }
        if (sum == G) break;
        __builtin_amdgcn_s_sleep(1);
        if ((++sp & 255u) == 0u) { if (xb_ld(&bar[XB_TMO])) break; if (sp > XB_SPIN_CAP) { atomicAdd(&bar[XB_TMO], 1u); break; } }
    }
    nloc = mine > 0u ? mine : 1u; nx = cnt > 0u ? cnt : 1u;
}

__device__ __forceinline__ void xcd_barrier(const XcdBarrier& b) {
    asm volatile("s_waitcnt vmcnt(0)" ::: "memory");
    __syncthreads();
    if (threadIdx.x == 0) {
        unsigned* bar = b.bar;
        __builtin_amdgcn_s_waitcnt(0);
        unsigned nloc = b.st[0], nx = b.st[1];
        if (nloc == 0u) { xcd_barrier_complete(bar, b.x, nloc, nx); b.st[0] = nloc; b.st[1] = nx; }
        const unsigned old = xb_add(&bar[XB_XSUB(b.x)], 1u);
        const unsigned gen = old / nloc;
        if (old + 1u == (gen + 1u) * nloc) {
            __builtin_amdgcn_fence(__ATOMIC_RELEASE, "agent");
            asm volatile("s_waitcnt vmcnt(0)" ::: "memory");
            const unsigned og = xb_add(&bar[XB_TOP], 1u);
            const unsigned tg = og / nx;
            if (og + 1u == (tg + 1u) * nx) xb_add(&bar[XB_TOPGEN], 1u);
            else XB_SPIN(xb_ld(&bar[XB_TOPGEN]) == tg, bar);
            __builtin_amdgcn_fence(__ATOMIC_ACQUIRE, "agent");
            xb_add(&bar[XB_XGEN(b.x)], 1u);
            asm volatile("s_waitcnt vmcnt(0)" ::: "memory");
        } else {
            XB_SPIN(xb_ld(&bar[XB_XGEN(b.x)]) == gen, bar);
            __builtin_amdgcn_fence(__ATOMIC_ACQUIRE, "agent");
            asm volatile("s_waitcnt vmcnt(0)" ::: "memory");
        }
    }
    __syncthreads();
}

namespace nk {
using pg8::bf16_t; using pg8::bf16x8; using pg8::f32x4; using pg8::u32x4; using pg8::Unit;
constexpr int NTH = 512;
constexpr int LDS_STAGE = pg8::STAGE_BYTES;
constexpr int LDS_MISC = 158720;
constexpr int LDS_BYTES = LDS_MISC + 1024;

constexpr size_t NB0 = WS_END * 4;
constexpr size_t NB_BAR = NB0;
constexpr size_t NB_WT1 = NB_BAR + 32768;
constexpr size_t NB_WT2 = NB_WT1 + (size_t)3584 * 1024 * 2;
constexpr size_t NB_XB = NB_WT2 + (size_t)1024 * 1024 * 2;
constexpr size_t NB_XSB = NB_XB + (size_t)MP * 1024 * 2;
constexpr size_t NB_HB = NB_XSB + (size_t)BS * 1024 * 2;
constexpr size_t NB_KVB = NB_HB + (size_t)MT * 2560 * 2;
constexpr size_t NB_G3 = NB_KVB + (size_t)MT * 768 * 2;
constexpr size_t NB_CATB = NB_G3 + (size_t)MT * 32 * 4;
constexpr size_t NB_CBUF = NB_CATB + (size_t)MT * 1024 * 2;
constexpr size_t NB_KCB = NB_CBUF + (size_t)MP * 512 * 4;
constexpr size_t NB_WT3 = NB_KCB + (size_t)BP * 64 * 256 * 2;
constexpr size_t NB_WT4 = NB_WT3 + (size_t)4 * 1024 * 1024 * 2;
constexpr size_t NB_W1T = NB_WT4 + (size_t)1024 * 1024 * 2;
constexpr size_t NB_A1T = NB_W1T + (size_t)64 * 1024 * 2;
constexpr size_t NB_W2T = NB_A1T + (size_t)64 * 1024 * 2;
constexpr size_t NB_A2T = NB_W2T + (size_t)64 * 1024 * 2;
constexpr size_t NB_KCS = NB_A2T + (size_t)64 * 1024 * 2;
constexpr size_t NB_OCS = NB_KCS + (size_t)BS * 256 * 256 * 4;
constexpr size_t NB_PARTS = NB_OCS + (size_t)BS * 8 * 64 * 4;
constexpr size_t NB_END = NB_PARTS + (size_t)BS * 8 * 24 * 66 * 4;
constexpr size_t NB_XSH = 0;
constexpr size_t NB_RKVZ = NB_XSH + (size_t)6 * 16640 * 1024 * 2;
constexpr size_t NB_TWB = NB_RKVZ + (size_t)4 * 16640 * 1024 * 2;
constexpr size_t NB_AWB = NB_TWB + (size_t)MT * 64 * 2;
constexpr size_t NB_RKS = NB_AWB + (size_t)MT * 64 * 2;
static_assert(NB_RKS + (size_t)MT * 16 * 4 <= WS_PRE * 4, "layer-1 region A overflows into PRE");
constexpr size_t NB_DEC = (WS_X1 + SZ_ROWD) * 4;
constexpr size_t NB_KKN = NB_DEC + (size_t)MT * 1024 * 4;
constexpr size_t NB_KKA = NB_KKN + (size_t)MT * 1024 * 2;
constexpr size_t NB_KP = NB_KKA + (size_t)MT * 1024 * 2;
constexpr size_t NB_Y = NB_KP + (size_t)MT * 1024 * 2;
constexpr size_t NB_G4B = NB_Y + (size_t)MT * 1024 * 4;
constexpr size_t NB_CHK = NB_G4B + (size_t)MT * 1024 * 2;
constexpr size_t NB_SREC = NB_CHK + (size_t)4096 * 32768;
static_assert(NB_SREC + (size_t)4096 * 8192 <= NB0, "layer-1 region B overflows");
constexpr int N1PAD = 3584;
__host__ __device__ __forceinline__ int win_src_col(int n) { return n < 2048 ? n : (n < 2560 ? C_ZB + (n - 2048) : (n < 3328 ? C_KV + (n - 2560) : (n < 3352 ? C_G3 + (n - 3328) : -1))); }

__device__ __forceinline__ int opaque(int x) { asm volatile("" : "+s"(x)); return x; }
__device__ __forceinline__ void lds_barrier() { asm volatile("s_waitcnt lgkmcnt(0)" ::: "memory"); __builtin_amdgcn_s_barrier(); asm volatile("" ::: "memory"); }
__device__ __forceinline__ int opaque_v(int x) { asm volatile("" : "+v"(x)); return x; }
struct Args { const float* in[N_IN]; float* out; unsigned char* ws; int ph_lo, ph_hi; };

__device__ __forceinline__ unsigned pk_bf16(float lo, float hi) { unsigned r; asm volatile("v_cvt_pk_bf16_f32 %0, %1, %2" : "=v"(r) : "v"(lo), "v"(hi)); return r; }
typedef __bf16 bf16x2_t __attribute__((ext_vector_type(2)));
__device__ __forceinline__ unsigned pk_bf16c(float lo, float hi) { bf16x2_t v; v[0] = (__bf16)lo; v[1] = (__bf16)hi; return __builtin_bit_cast(unsigned, v); }

template <class MAP>
__device__ __forceinline__ void convert_wt(const float* __restrict__ W, int K, int ldw, bf16_t* __restrict__ Wt, int Npad, MAP map, int bid, int nb) {
    const int kg = K / 8;
    const size_t total = (size_t)Npad * kg;
    for (size_t i = (size_t)bid * NTH + threadIdx.x; i < total; i += (size_t)nb * NTH) {
        const int n = (int)(i % Npad), k0 = (int)(i / Npad) * 8;
        const int sc = map(n);
        u32x4 w = {0u, 0u, 0u, 0u};
        if (sc >= 0) {
            float v[8];
#pragma unroll
            for (int j = 0; j < 8; ++j) v[j] = W[(size_t)(k0 + j) * ldw + sc];
            w.x = pk_bf16(v[0], v[1]); w.y = pk_bf16(v[2], v[3]); w.z = pk_bf16(v[4], v[5]); w.w = pk_bf16(v[6], v[7]);
        }
        *(u32x4*)(Wt + (size_t)n * K + k0) = w;
    }
}
struct MapId { __device__ __forceinline__ int operator()(int n) const { return n; } };
struct MapWin { __device__ __forceinline__ int operator()(int n) const { return win_src_col(n); } };
__device__ __forceinline__ void convert_rows(const float* __restrict__ src, size_t n8, bf16_t* __restrict__ dst, int bid, int nb) {
#pragma unroll 4
    for (size_t i = (size_t)bid * NTH + threadIdx.x; i < n8; i += (size_t)nb * NTH) {
        const float4 a = *(const float4*)(src + i * 8), b = *(const float4*)(src + i * 8 + 4);
        u32x4 w; w.x = pk_bf16(a.x, a.y); w.y = pk_bf16(a.z, a.w); w.z = pk_bf16(b.x, b.y); w.w = pk_bf16(b.z, b.w);
        *(u32x4*)(dst + i * 8) = w;
    }
}

struct EpiPre {
    static constexpr bool PERM = false, AFTER_DRAIN = false;
    float* C; int ldc;
    __device__ __forceinline__ void operator()(const f32x4 (&acc)[2][2][4][2], const Unit& u, int wr, int wc, int fr, int fq) const {
        const int row0 = u.pm * 256 + wr * 64 + fr, col0 = u.pn * 256 + wc * 32 + 4 * fq;
#pragma unroll
        for (int ai = 0; ai < 2; ++ai)
#pragma unroll
            for (int m = 0; m < 4; ++m) { float* rowp = C + (size_t)(row0 + ai * 128 + m * 16) * ldc + col0;
#pragma unroll
                for (int bj = 0; bj < 2; ++bj)
#pragma unroll
                    for (int n = 0; n < 2; ++n) *(f32x4*)(rowp + bj * 128 + n * 16) = acc[ai][bj][m][n]; }
    }
};


struct EpiPreB {
    static constexpr bool PERM = true, AFTER_DRAIN = false;
    bf16_t* O;
    __device__ __forceinline__ void operator()(const f32x4 (&acc)[2][2][4][2], const Unit& u, int wr, int wc, int fr, int fq) const {
        const int row0 = u.pm * 256 + wr * 64 + fr, col0 = u.pn * 256 + wc * 32 + 8 * fq;
#pragma unroll
        for (int ai = 0; ai < 2; ++ai)
#pragma unroll
            for (int m = 0; m < 4; ++m) { bf16_t* rowp = O + (size_t)(row0 + ai * 128 + m * 16) * 1024 + col0;
#pragma unroll
                for (int bj = 0; bj < 2; ++bj) { const f32x4 v0 = acc[ai][bj][m][0], v1 = acc[ai][bj][m][1];
                    u32x4 w; w.x = pk_bf16c(v0[0], v0[1]); w.y = pk_bf16c(v0[2], v0[3]); w.z = pk_bf16c(v1[0], v1[1]); w.w = pk_bf16c(v1[2], v1[3]);
                    *(u32x4*)(rowp + bj * 128) = w; } }
    }
};


struct Route1 {
    bf16_t* HB; bf16_t* KVB; float* G3; float* out;
    __device__ __forceinline__ void put8(int row, int n0, const f32x4& v0, const f32x4& v1) const {
        if (n0 < 2560) {
            const float sc = (n0 >= 1536 && n0 < 2048) ? 0.125f : 1.0f;
            u32x4 w; w.x = pk_bf16c(v0[0] * sc, v0[1] * sc); w.y = pk_bf16c(v0[2] * sc, v0[3] * sc); w.z = pk_bf16c(v1[0] * sc, v1[1] * sc); w.w = pk_bf16c(v1[2] * sc, v1[3] * sc);
            *(u32x4*)(HB + (size_t)row * 2560 + n0) = w;
        } else if (n0 < 3328) {
            const int c = n0 - 2560, i3 = c >> 8, cc = c & 255;
            u32x4 w; w.x = pk_bf16c(v0[0], v0[1]); w.y = pk_bf16c(v0[2], v0[3]); w.z = pk_bf16c(v1[0], v1[1]); w.w = pk_bf16c(v1[2], v1[3]);
            *(u32x4*)(KVB + (size_t)row * 768 + c) = w;
            float* dst = nullptr;
            if (row < MP) {
                if (i3 == 0) dst = out + O_CMPP + (size_t)row * 256 + cc;
                else if (i3 == 1) dst = out + O_SELP + (size_t)row * 256 + cc;
                else { const int b = row >> 11, t = row & 2047; if (t >= TP - 512) dst = out + O_WINP + (size_t)(b * 512 + t - (TP - 512)) * 256 + cc; }
            } else {
                const int sidx = row - MP;
                if (i3 == 0) dst = out + O_CMPS + (size_t)sidx * 256 + cc;
                else if (i3 == 1) dst = out + O_SELS + (size_t)sidx * 256 + cc;
                else dst = out + O_WINS + (size_t)(sidx * 512 + 511) * 256 + cc;
            }
            if (dst) { *(f32x4*)dst = v0; *(f32x4*)(dst + 4) = v1; }
        } else if (n0 < 3352) {
            float* dst = G3 + (size_t)row * 32 + (n0 - 3328);
            *(f32x4*)dst = v0; *(f32x4*)(dst + 4) = v1;
        }
    }
};
struct Epi1 {
    static constexpr bool PERM = true, AFTER_DRAIN = false;
    Route1 R;
    __device__ __forceinline__ void operator()(const f32x4 (&acc)[2][2][4][2], const Unit& u, int wr, int wc, int fr, int fq) const {
        const int row0 = u.pm * 256 + wr * 64 + fr, col0 = u.pn * 256 + wc * 32 + 8 * fq;
#pragma unroll
        for (int ai = 0; ai < 2; ++ai)
#pragma unroll
            for (int m = 0; m < 4; ++m)
#pragma unroll
                for (int bj = 0; bj < 2; ++bj) R.put8(row0 + ai * 128 + m * 16, col0 + bj * 128, acc[ai][bj][m][0], acc[ai][bj][m][1]);
    }
};

typedef float f32x16 __attribute__((ext_vector_type(16)));
template <class EMIT>
__device__ __forceinline__ void sample_gemm32(const bf16_t* __restrict__ A, const bf16_t* __restrict__ Bt, int K, int n0, int lane, EMIT emit) {
    const bf16_t* ap = A + (size_t)(lane & 31) * K + 8 * (lane >> 5);
    const bf16_t* bp = Bt + (size_t)(n0 + (lane & 31)) * K + 8 * (lane >> 5);
    f32x16 acc;
#pragma unroll
    for (int i = 0; i < 16; ++i) acc[i] = 0.f;
#pragma unroll 16
    for (int k = 0; k < K; k += 16) {
        const bf16x8 av = *(const bf16x8*)(ap + k), bv = *(const bf16x8*)(bp + k);
        acc = __builtin_amdgcn_mfma_f32_32x32x16_bf16(av, bv, acc, 0, 0, 0);
    }
#pragma unroll
    for (int r = 0; r < 16; ++r) emit((r & 3) + 8 * (r >> 2) + 4 * (lane >> 5), n0 + (lane & 31), acc[r]);
}

template <class EMIT>
__device__ __forceinline__ void sample_gemm32_wg(const bf16_t* __restrict__ A, const bf16_t* __restrict__ Bt, int K, int n0, PG8_LAS unsigned char* lds, EMIT emit) {
    const int tid = opaque_v(threadIdx.x), lane = tid & 63, wv = tid >> 6;
    const int kq = K / 8;
    const bf16_t* ap = A + (size_t)(lane & 31) * K + 8 * (lane >> 5) + wv * kq;
    const bf16_t* bp = Bt + (size_t)(n0 + (lane & 31)) * K + 8 * (lane >> 5) + wv * kq;
    f32x16 acc;
#pragma unroll
    for (int i = 0; i < 16; ++i) acc[i] = 0.f;
#pragma unroll 8
    for (int k = 0; k < kq; k += 16) {
        const bf16x8 av = *(const bf16x8*)(ap + k), bv = *(const bf16x8*)(bp + k);
        acc = __builtin_amdgcn_mfma_f32_32x32x16_bf16(av, bv, acc, 0, 0, 0);
    }
    PG8_LAS float* P = (PG8_LAS float*)lds;
#pragma unroll
    for (int q = 0; q < 4; ++q) *(PG8_LAS f32x4*)(P + (wv * 64 + lane) * 16 + q * 4) = (f32x4){acc[4 * q], acc[4 * q + 1], acc[4 * q + 2], acc[4 * q + 3]};
    __syncthreads();
    if (wv == 0) {
#pragma unroll
        for (int w = 1; w < 8; ++w)
#pragma unroll
            for (int q = 0; q < 4; ++q) { const f32x4 v = *(const PG8_LAS f32x4*)(P + (w * 64 + lane) * 16 + q * 4); acc[4 * q] += v[0]; acc[4 * q + 1] += v[1]; acc[4 * q + 2] += v[2]; acc[4 * q + 3] += v[3]; }
#pragma unroll
        for (int r = 0; r < 16; ++r) emit((r & 3) + 8 * (r >> 2) + 4 * (lane >> 5), n0 + (lane & 31), acc[r]);
    }
    __syncthreads();
}

typedef float f32x16 __attribute__((ext_vector_type(16)));
__device__ __forceinline__ float bf2f(bf16_t v) { return __uint_as_float((unsigned)v << 16); }
__device__ __forceinline__ float sigm_f(float x) { return 1.f / (1.f + __expf(-x)); }
__device__ __forceinline__ float silu_f(float x) { return x / (1.f + __expf(-x)); }

__device__ __forceinline__ float wsum64(float v) {
    v += __builtin_bit_cast(float, __builtin_amdgcn_update_dpp(0, __builtin_bit_cast(int, v), 0xB1, 0xF, 0xF, true));
    v += __builtin_bit_cast(float, __builtin_amdgcn_update_dpp(0, __builtin_bit_cast(int, v), 0x4E, 0xF, 0xF, true));
    v += __builtin_bit_cast(float, __builtin_amdgcn_update_dpp(0, __builtin_bit_cast(int, v), 0x141, 0xF, 0xF, true));
    v += __builtin_bit_cast(float, __builtin_amdgcn_update_dpp(0, __builtin_bit_cast(int, v), 0x140, 0xF, 0xF, true));
    v += __shfl_xor(v, 16); v += __shfl_xor(v, 32);
    return v;
}
constexpr int CV_U = 0;
constexpr int CV_C = 65536;
__device__ __forceinline__ void conv_item(const Args& a, unsigned char* ws, PG8_LAS unsigned char* lds, int item) {
    const int tid = opaque_v(threadIdx.x);
    const int b = item >> 6, t0 = (item & 63) * 32;
    const bf16_t* HB = (const bf16_t*)(ws + NB_HB);
    PG8_LAS float* U = (PG8_LAS float*)(lds + CV_U);
    PG8_LAS float* C = (PG8_LAS float*)(lds + CV_C);
    const int chl = tid & 255, tp = tid >> 8;
    const int lane = tid & 63, wv = tid >> 6;
    u32x4 zv[4];
#pragma unroll
    for (int k = 0; k < 4; ++k) zv[k] = *(const u32x4*)(HB + (size_t)(b * TP + t0 + wv * 4 + k) * 2560 + 1024 + lane * 8);
#pragma unroll 1
    for (int half = 0; half < 2; ++half) {
        const int chb = half * 256;
#pragma unroll
        for (int it = 0; it < 4; ++it) {
            const int vi = tid + it * NTH;
            if (vi < 62 * 32) {
                const int r = vi >> 5, c8 = (vi & 31) * 8, t = t0 - 30 + r;
                float u[8];
                if (t >= 0) {
                    const bf16_t* h = HB + (size_t)(b * TP + t) * 2560 + chb + c8;
                    const u32x4 av = *(const u32x4*)h, gv = *(const u32x4*)(h + 512);
#pragma unroll
                    for (int i = 0; i < 8; ++i) {
                        const float x = __uint_as_float((i & 1) ? (av[i >> 1] & 0xffff0000u) : (av[i >> 1] << 16));
                        const float g = __uint_as_float((i & 1) ? (gv[i >> 1] & 0xffff0000u) : (gv[i >> 1] << 16));
                        u[i] = x * sigm_f(g);
                    }
                } else {
#pragma unroll
                    for (int i = 0; i < 8; ++i) u[i] = 0.f;
                }
                *(PG8_LAS f32x4*)(U + r * 256 + c8) = (f32x4){u[0], u[1], u[2], u[3]};
                *(PG8_LAS f32x4*)(U + r * 256 + c8 + 4) = (f32x4){u[4], u[5], u[6], u[7]};
                if (t >= TP - 30 && r >= 30) {
                    float* o = a.out + O_CONVP + (size_t)(b * 30 + t - (TP - 30)) * 512 + chb + c8;
                    *(float4*)o = make_float4(u[0], u[1], u[2], u[3]); *(float4*)(o + 4) = make_float4(u[4], u[5], u[6], u[7]);
                }
            }
        }
        __syncthreads();
        {
            const int ch = chb + chl;
            float w[31], uw[46], acc[16];
#pragma unroll
            for (int j = 0; j < 31; ++j) w[j] = a.in[I_CONVW][j * 512 + ch];
            const float bias = a.in[I_CONVB][ch];
#pragma unroll
            for (int r = 0; r < 46; ++r) uw[r] = U[(tp * 16 + r) * 256 + chl];
#pragma unroll
            for (int k = 0; k < 16; ++k) {
                float s_ = bias;
#pragma unroll
                for (int j = 0; j < 31; ++j) s_ = fmaf(w[j], uw[k + j], s_);
                acc[k] = s_;
            }
#pragma unroll
            for (int k = 0; k < 16; ++k) C[(tp * 16 + k) * 516 + ch] = acc[k];
        }
        __syncthreads();
    }
    {
        const float4 g0 = *(const float4*)(a.in[I_CLNG] + lane * 8), g1 = *(const float4*)(a.in[I_CLNG] + lane * 8 + 4);
        const float4 b0 = *(const float4*)(a.in[I_CLNB] + lane * 8), b1 = *(const float4*)(a.in[I_CLNB] + lane * 8 + 4);
        const float gg[8] = {g0.x, g0.y, g0.z, g0.w, g1.x, g1.y, g1.z, g1.w}, bb[8] = {b0.x, b0.y, b0.z, b0.w, b1.x, b1.y, b1.z, b1.w};
#pragma unroll
        for (int k = 0; k < 4; ++k) {
            const int tl = wv * 4 + k;
            const size_t row = (size_t)(b * TP + t0 + tl);
            const f32x4 c0 = *(const PG8_LAS f32x4*)(C + tl * 516 + lane * 8), c1 = *(const PG8_LAS f32x4*)(C + tl * 516 + lane * 8 + 4);
            float c[8] = {c0[0], c0[1], c0[2], c0[3], c1[0], c1[1], c1[2], c1[3]};
            float sm = 0.f;
#pragma unroll
            for (int i = 0; i < 8; ++i) sm += c[i];
            const float mean = wsum64(sm) * (1.f / 512.f);
            float sq = 0.f;
#pragma unroll
            for (int i = 0; i < 8; ++i) { c[i] -= mean; sq += c[i] * c[i]; }
            const float rs = rsqrtf(wsum64(sq) * (1.f / 512.f) + LN_EPS);
            float y[8];
#pragma unroll
            for (int i = 0; i < 8; ++i) {
                const float z = __uint_as_float((i & 1) ? (zv[k][i >> 1] & 0xffff0000u) : (zv[k][i >> 1] << 16));
                y[i] = silu_f(c[i] * rs * gg[i] + bb[i]) * silu_f(z);
            }
            u32x4 o; o.x = pk_bf16(y[0], y[1]); o.y = pk_bf16(y[2], y[3]); o.z = pk_bf16(y[4], y[5]); o.w = pk_bf16(y[6], y[7]);
            *(u32x4*)((bf16_t*)(ws + NB_CATB) + row * 1024 + lane * 8) = o;
        }
    }
    __syncthreads();
}

__device__ __forceinline__ void pool_prompt(const Args& a, unsigned char* ws, int bid, int nb) {
    bf16_t* KCB = (bf16_t*)(ws + NB_KCB);
    for (int i = bid * NTH + threadIdx.x; i < BP * 64 * 256; i += nb * NTH) {
        const int c = i & 255, n = (i >> 8) & 63, b = i >> 14;
        const int kv = c >> 7, g = (c >> 6) & 1;
        const float* w = kv ? a.in[I_WVC] : a.in[I_WKC];
        const float* src = a.out + O_CMPP + (size_t)(b * TP + n * 32) * 256 + c;
        float acc = 0.f;
#pragma unroll 8
        for (int l = 0; l < 32; ++l) acc = fmaf(src[(size_t)l * 256], w[l * 2 + g], acc);
        KCB[i] = (bf16_t)(pk_bf16(acc, 0.f) & 0xffffu);
    }
}

constexpr int A_KT = 0;
constexpr int A_VT = 18432;
constexpr int A_IMPH = 35840;
constexpr int A_IMPS = 68608;
constexpr int A_MASK = 76800;
constexpr float LOG2E = 1.4426950408889634f;

struct KvSrc { const bf16_t* k; const bf16_t* v; int rstride; };

__device__ __forceinline__ void kv_issue(const KvSrc& s, int tid, u32x4& kr, u32x4& vr) {
    const int key = tid >> 3, c8 = tid & 7;
    kr = *(const u32x4*)(s.k + (size_t)key * s.rstride + c8 * 8);
    vr = *(const u32x4*)(s.v + (size_t)key * s.rstride + c8 * 8);
}
__device__ __forceinline__ void kv_write(PG8_LAS unsigned char* lds, int buf, int tid, const u32x4& kr, const u32x4& vr) {
    const int key = tid >> 3, c8 = tid & 7;
    *(PG8_LAS u32x4*)(lds + A_KT + buf * 9216 + key * 144 + c8 * 16) = kr;
    PG8_LAS bf16_t* vt = (PG8_LAS bf16_t*)(lds + A_VT + buf * 8704);
#pragma unroll
    for (int i = 0; i < 4; ++i) { vt[(c8 * 8 + 2 * i) * 68 + key] = (bf16_t)(vr[i] & 0xffffu); vt[(c8 * 8 + 2 * i + 1) * 68 + key] = (bf16_t)(vr[i] >> 16); }
}

__device__ __forceinline__ void attn_block(const int MODE, PG8_LAS unsigned char* lds, int buf, const bf16x8 (&qf)[4], int lane, float kslope, float base, int kmax, int kmin,
                                           float& m, float& l, f32x16 (&o)[2], f32x16 (&x)[2]) {
    const int lr = lane & 31, h = lane >> 5;
    const PG8_LAS unsigned char* kt_p = lds + A_KT + buf * 9216 + lr * 144 + h * 16;
#pragma unroll
    for (int kt = 0; kt < 2; ++kt) {
#pragma unroll
        for (int i = 0; i < 16; ++i) x[kt][i] = 0.f;
#pragma unroll
        for (int s = 0; s < 4; ++s) {
            const bf16x8 kf = *(const PG8_LAS bf16x8*)(kt_p + kt * 32 * 144 + s * 32);
            x[kt] = __builtin_amdgcn_mfma_f32_32x32x16_bf16(kf, qf[s], x[kt], 0, 0, 0);
        }
    }
    const float bh = base + kslope * (float)(4 * h);
    float mx = -INFINITY;
#pragma unroll
    for (int kt = 0; kt < 2; ++kt)
#pragma unroll
        for (int i = 0; i < 16; ++i) {
            const int kc = kt * 32 + (i & 3) + 8 * (i >> 2);
            x[kt][i] = fmaf(x[kt][i], LOG2E, fmaf(kslope, (float)kc, bh));
        }
    if (MODE) {
        const int hi = kmax - 4 * h, lo = kmin - 4 * h;
#pragma unroll
        for (int kt = 0; kt < 2; ++kt)
#pragma unroll
            for (int i = 0; i < 16; ++i) {
                const int kc = kt * 32 + (i & 3) + 8 * (i >> 2);
                x[kt][i] = (kc > hi || kc < lo) ? -INFINITY : x[kt][i];
            }
    }
#pragma unroll
    for (int kt = 0; kt < 2; ++kt)
#pragma unroll
        for (int i = 0; i < 16; ++i) mx = fmaxf(mx, x[kt][i]);
    mx = fmaxf(mx, __shfl_xor(mx, 32));
    const float mn = fmaxf(m, mx);
    const float corr = __builtin_amdgcn_exp2f(m - mn);
    const bool grew = __any(mn > m);
    m = mn;
    float ls = 0.f;
#pragma unroll
    for (int kt = 0; kt < 2; ++kt)
#pragma unroll
        for (int i = 0; i < 16; ++i) { const float pv = __builtin_amdgcn_exp2f(x[kt][i] - mn); x[kt][i] = pv; ls += pv; }
    l = fmaf(l, corr, ls);
    if (grew) {
#pragma unroll
        for (int dt = 0; dt < 2; ++dt)
#pragma unroll
            for (int i = 0; i < 16; ++i) o[dt][i] *= corr;
    }
    const PG8_LAS unsigned char* vt_p = lds + A_VT + buf * 8704 + lr * 136 + h * 8;
#pragma unroll
    for (int kt = 0; kt < 2; ++kt)
#pragma unroll
        for (int s = 0; s < 2; ++s) {
            u32x4 pw; pw.x = pk_bf16(x[kt][8 * s + 0], x[kt][8 * s + 1]); pw.y = pk_bf16(x[kt][8 * s + 2], x[kt][8 * s + 3]);
            pw.z = pk_bf16(x[kt][8 * s + 4], x[kt][8 * s + 5]); pw.w = pk_bf16(x[kt][8 * s + 6], x[kt][8 * s + 7]);
            const bf16x8 pf = __builtin_bit_cast(bf16x8, pw);
#pragma unroll
            for (int dt = 0; dt < 2; ++dt) {
                const PG8_LAS unsigned char* vp = vt_p + dt * 32 * 136 + (kt * 32 + s * 16) * 2;
                typedef unsigned u32x2 __attribute__((ext_vector_type(2)));
                const u32x2 v0 = *(const PG8_LAS u32x2*)vp, v1 = *(const PG8_LAS u32x2*)(vp + 16);
                u32x4 vw; vw.x = v0.x; vw.y = v0.y; vw.z = v1.x; vw.w = v1.y;
                o[dt] = __builtin_amdgcn_mfma_f32_32x32x16_bf16(__builtin_bit_cast(bf16x8, vw), pf, o[dt], 0, 0, 0);
            }
        }
}

__device__ __forceinline__ void attn_item(const Args& a, unsigned char* ws, PG8_LAS unsigned char* lds, int b, int g, int qb) {
    const int tid = opaque_v(threadIdx.x), lane = tid & 63, wv = __builtin_amdgcn_readfirstlane(tid >> 6);
    const int lr = lane & 31, h = lane >> 5;
    const int r = wv >> 1, th = wv & 1, hh = g * 4 + r;
    const int t0 = qb * 64, tb = qb;
    const int qloc = th * 32 + lr;
    const int qpos = t0 + qloc;
    const size_t qrow = (size_t)b * TP + qpos;
    const bf16_t* HB = (const bf16_t*)(ws + NB_HB);
    const bf16_t* KVB = (const bf16_t*)(ws + NB_KVB);
    const float slope2 = __builtin_amdgcn_exp2f(-(float)(hh + 1)) * LOG2E;
    bf16x8 qf[4];
#pragma unroll
    for (int s = 0; s < 4; ++s) qf[s] = *(const bf16x8*)(HB + qrow * 2560 + 1536 + hh * 64 + s * 16 + h * 8);
    const float* g3p = (const float*)(ws + NB_G3) + qrow * 32 + hh * 3;
    const float gc = sigm_f(g3p[0]), gs = sigm_f(g3p[1]), gw = sigm_f(g3p[2]);
    f32x16 res[2], o[2], x[2];
#pragma unroll
    for (int dt = 0; dt < 2; ++dt)
#pragma unroll
        for (int i = 0; i < 16; ++i) { res[dt][i] = 0.f; o[dt][i] = 0.f; }
    float m = -1e30f, l = 0.f;
    u32x4 kr, vr;
    PG8_LAS float* IMPH = (PG8_LAS float*)(lds + A_IMPH);
    PG8_LAS float* IMPS = (PG8_LAS float*)(lds + A_IMPS);
    PG8_LAS unsigned* MASK = (PG8_LAS unsigned*)(lds + A_MASK);

    {
        const bf16_t* kc = (const bf16_t*)(ws + NB_KCB) + (size_t)b * 64 * 256 + g * 64;
        KvSrc s{kc, kc + 128, 256};
        kv_issue(s, tid, kr, vr); kv_write(lds, 0, tid, kr, vr);
        if (tid < 64) MASK[tid] = 0u;
        __syncthreads();
        const int nmax = (qpos >= 31) ? ((qpos - 31) >> 5) : -1;
        attn_block(1, lds, 0, qf, lane, slope2 * 32.f, slope2 * (float)(31 - qpos), nmax, 0, m, l, o, x);
        const float lt = l + __shfl_xor(l, 32);
        const float inv = (nmax >= 0) ? 1.f / lt : 0.f;
        const float sc = gc * inv;
#pragma unroll
        for (int dt = 0; dt < 2; ++dt)
#pragma unroll
            for (int i = 0; i < 16; ++i) { res[dt][i] = o[dt][i] * sc; o[dt][i] = 0.f; }
        if (tb >= 16) {
#pragma unroll
            for (int kt = 0; kt < 2; ++kt)
#pragma unroll
                for (int c = 0; c < 4; ++c)
#pragma unroll
                    for (int e = 0; e < 2; ++e)
                        IMPH[(r * 64 + qloc) * 32 + kt * 16 + 4 * c + 2 * h + e] = (nmax >= 0) ? (x[kt][4 * c + 2 * e] + x[kt][4 * c + 2 * e + 1]) * inv : 0.f;
        }
        m = -1e30f; l = 0.f;
        __syncthreads();
    }
    if (tb >= 16) {
        const int tq = opaque_v(tid);
        const int q = tq >> 3, jq = tq & 7;
        float v4[4];
#pragma unroll
        for (int e = 0; e < 4; ++e) {
            const int j = jq * 4 + e;
            float v = IMPH[(0 * 64 + q) * 32 + j] + IMPH[(1 * 64 + q) * 32 + j] + IMPH[(2 * 64 + q) * 32 + j] + IMPH[(3 * 64 + q) * 32 + j];
            if (j == 0 || j == tb || j == tb - 1) v = 1e4f;
            IMPS[q * 32 + j] = v; v4[e] = v;
        }
        __syncthreads();
        unsigned bits = 0u;
#pragma unroll
        for (int e = 0; e < 4; ++e) {
            const int j = jq * 4 + e;
            int rank = 0;
            for (int i = 0; i <= tb; ++i) { const float vi = IMPS[q * 32 + i]; rank += (vi > v4[e] || (vi == v4[e] && i < j)) ? 1 : 0; }
            if (j <= tb && rank < 16) bits |= 1u << j;
        }
        if (bits) atomicOr((unsigned*)&MASK[q], bits);
    } else {
        if (tid < 64) MASK[tid] = (2u << tb) - 1u;
    }
    __syncthreads();
    const unsigned selmask = MASK[qloc];

    {
        const bf16_t* kb = KVB + (size_t)b * TP * 768 + 256 + g * 64;
        { KvSrc s{kb, kb + 128, 768}; kv_issue(s, tid, kr, vr); kv_write(lds, 0, tid, kr, vr); }
        __syncthreads();
        for (int j = 0; j <= tb; ++j) {
            if (j < tb) { KvSrc s{kb + (size_t)(j + 1) * 64 * 768, kb + (size_t)(j + 1) * 64 * 768 + 128, 768}; kv_issue(s, tid, kr, vr); }
            const float base = ((selmask >> j) & 1u) ? slope2 * (float)(j * 64 - qpos) : -INFINITY;
            attn_block(j == tb, lds, j & 1, qf, lane, slope2, base, qloc, 0, m, l, o, x);
            if (j < tb) kv_write(lds, (j + 1) & 1, tid, kr, vr);
            __syncthreads();
        }
        const float lt = l + __shfl_xor(l, 32);
        const float sc = gs / lt;
#pragma unroll
        for (int dt = 0; dt < 2; ++dt)
#pragma unroll
            for (int i = 0; i < 16; ++i) { res[dt][i] = fmaf(o[dt][i], sc, res[dt][i]); o[dt][i] = 0.f; }
        m = -1e30f; l = 0.f;
    }
    {
        const int jlo = (tb >= 8) ? tb - 8 : 0;
        const bf16_t* kb = KVB + (size_t)b * TP * 768 + 512 + g * 64;
        { KvSrc s{kb + (size_t)jlo * 64 * 768, kb + (size_t)jlo * 64 * 768 + 128, 768}; kv_issue(s, tid, kr, vr); kv_write(lds, 0, tid, kr, vr); }
        __syncthreads();
        for (int j = jlo; j <= tb; ++j) {
            const int bi = (j - jlo) & 1;
            if (j < tb) { KvSrc s{kb + (size_t)(j + 1) * 64 * 768, kb + (size_t)(j + 1) * 64 * 768 + 128, 768}; kv_issue(s, tid, kr, vr); }
            const float base = slope2 * (float)(j * 64 - qpos);
            attn_block((j == tb) || (j == tb - 8), lds, bi, qf, lane, slope2, base, (j == tb) ? qloc : 64, (j == tb - 8) ? qpos - 511 - j * 64 : 0, m, l, o, x);
            if (j < tb) kv_write(lds, bi ^ 1, tid, kr, vr);
            __syncthreads();
        }
        const float lt = l + __shfl_xor(l, 32);
        const float sc = gw / lt;
#pragma unroll
        for (int dt = 0; dt < 2; ++dt)
#pragma unroll
            for (int i = 0; i < 16; ++i) res[dt][i] = fmaf(o[dt][i], sc, res[dt][i]);
    }
    {
        const size_t qrow2 = (size_t)b * TP + t0 + th * 32 + (opaque_v(lane) & 31);
        const bf16_t* zb = HB + qrow2 * 2560 + 2048 + hh * 64;
        bf16_t* dst = (bf16_t*)(ws + NB_CATB) + qrow2 * 1024 + 512 + hh * 64;
        typedef unsigned u32x2 __attribute__((ext_vector_type(2)));
#pragma unroll
        for (int dt = 0; dt < 2; ++dt)
#pragma unroll
            for (int c = 0; c < 4; ++c) {
                const int d = dt * 32 + 8 * c + 4 * h;
                const u32x2 zv = *(const u32x2*)(zb + d);
                const float z0 = __uint_as_float(zv.x << 16), z1 = __uint_as_float(zv.x & 0xffff0000u), z2 = __uint_as_float(zv.y << 16), z3 = __uint_as_float(zv.y & 0xffff0000u);
                u32x2 w; w.x = pk_bf16(res[dt][4 * c + 0] * silu_f(z0), res[dt][4 * c + 1] * silu_f(z1)); w.y = pk_bf16(res[dt][4 * c + 2] * silu_f(z2), res[dt][4 * c + 3] * silu_f(z3));
                *(u32x2*)(dst + d) = w;
            }
    }
}

constexpr int XSH_ROWS = 16640;
__device__ __forceinline__ float wave_sum(float v) {
#pragma unroll
    for (int o = 32; o > 0; o >>= 1) v += __shfl_xor(v, o);
    return v;
}
__device__ __forceinline__ void ld_row16(const float* __restrict__ src, int lane, float (&x)[16]) {
#pragma unroll
    for (int q = 0; q < 4; ++q) { const float4 v = *(const float4*)(src + q * 256 + lane * 4); x[4 * q] = v.x; x[4 * q + 1] = v.y; x[4 * q + 2] = v.z; x[4 * q + 3] = v.w; }
}
__device__ __forceinline__ void ln_calc16(const float* __restrict__ g, const float* __restrict__ bta, int lane, float (&x)[16]) {
    float sm = 0.f;
#pragma unroll
    for (int i = 0; i < 16; ++i) sm += x[i];
    const float mean = wave_sum(sm) * (1.f / 1024.f);
    float sq = 0.f;
#pragma unroll
    for (int i = 0; i < 16; ++i) { x[i] -= mean; sq += x[i] * x[i]; }
    const float rs = rsqrtf(wave_sum(sq) * (1.f / 1024.f) + LN_EPS);
#pragma unroll
    for (int q = 0; q < 4; ++q) {
        const float4 gv = *(const float4*)(g + q * 256 + lane * 4), bv = *(const float4*)(bta + q * 256 + lane * 4);
        x[4 * q] = x[4 * q] * rs * gv.x + bv.x; x[4 * q + 1] = x[4 * q + 1] * rs * gv.y + bv.y; x[4 * q + 2] = x[4 * q + 2] * rs * gv.z + bv.z; x[4 * q + 3] = x[4 * q + 3] * rs * gv.w + bv.w;
    }
}
__device__ __forceinline__ void ln_row16(const float* __restrict__ src, const float* __restrict__ g, const float* __restrict__ bta, int lane, float (&x)[16]) {
    ld_row16(src, lane, x); ln_calc16(g, bta, lane, x);
}
__device__ __forceinline__ void store_x1_xsh(const Args& a, unsigned char* ws, size_t row, size_t xrow, int lane, const float (&cur)[16], const float (&prev)[16]) {
#pragma unroll 1
    for (int n = 0; n < 6; ++n) {
        const float* mu = a.in[I_MU] + n * 1024 + lane * 4;
        bf16_t* dst = (bf16_t*)(ws + NB_XSH) + ((size_t)n * XSH_ROWS + xrow) * 1024 + lane * 4;
        typedef unsigned u32x2 __attribute__((ext_vector_type(2)));
#pragma unroll
        for (int q = 0; q < 4; ++q) { const float4 m4 = *(const float4*)(mu + q * 256);
            u32x2 w; w.x = pk_bf16(fmaf(prev[4 * q] - cur[4 * q], m4.x, cur[4 * q]), fmaf(prev[4 * q + 1] - cur[4 * q + 1], m4.y, cur[4 * q + 1]));
            w.y = pk_bf16(fmaf(prev[4 * q + 2] - cur[4 * q + 2], m4.z, cur[4 * q + 2]), fmaf(prev[4 * q + 3] - cur[4 * q + 3], m4.w, cur[4 * q + 3]));
            *(u32x2*)(dst + q * 256) = w; }
    }
}
__device__ __forceinline__ void phase_lns(const Args& a, unsigned char* ws, int bid, int nb) {
    const int tid = opaque_v(threadIdx.x), lane = tid & 63, wv = tid >> 6;
    const float* PRE = (const float*)ws + WS_PRE;
    const float* g = a.in[I_LNG]; const float* bta = a.in[I_LNB];
    for (int blk = bid; blk < 256; blk += nb) {
        const int r0 = blk * 64 + wv * 8;
        float prev[16], cur[16];
        if ((r0 & (TP - 1)) == 0) {
#pragma unroll
            for (int i = 0; i < 16; ++i) prev[i] = 0.f;
        } else ln_row16(PRE + (size_t)(r0 - 1) * 1024, g, bta, lane, prev);
        float nxt[16];
        ld_row16(PRE + (size_t)r0 * 1024, lane, nxt);
#pragma unroll 1
        for (int k = 0; k < 8; ++k) {
            const int row = r0 + k;
#pragma unroll
            for (int i = 0; i < 16; ++i) cur[i] = nxt[i];
            if (k + 1 < 8) ld_row16(PRE + (size_t)(row + 1) * 1024, lane, nxt);
            ln_calc16(g, bta, lane, cur);
            store_x1_xsh(a, ws, row, row, lane, cur, prev);
            if ((row & (TP - 1)) == TP - 1) {
                float* so = a.out + O_SHP + (size_t)(row >> 11) * 1024 + lane * 4;
#pragma unroll
                for (int q = 0; q < 4; ++q) *(float4*)(so + q * 256) = make_float4(cur[4 * q], cur[4 * q + 1], cur[4 * q + 2], cur[4 * q + 3]);
            }
#pragma unroll
            for (int i = 0; i < 16; ++i) prev[i] = cur[i];
        }
    }
    for (int s = bid * 8 + wv; s < BS; s += nb * 8) {
        float prev[16], cur[16];
        const float* sp = a.in[I_SSHIFT] + (size_t)s * 1024 + lane * 4;
#pragma unroll
        for (int q = 0; q < 4; ++q) { const float4 v = *(const float4*)(sp + q * 256); prev[4 * q] = v.x; prev[4 * q + 1] = v.y; prev[4 * q + 2] = v.z; prev[4 * q + 3] = v.w; }
        ln_row16(PRE + (size_t)(MP + s) * 1024, g, bta, lane, cur);
        store_x1_xsh(a, ws, MP + s, MP + s, lane, cur, prev);
        float* so = a.out + O_SHS + (size_t)s * 1024 + lane * 4;
#pragma unroll
        for (int q = 0; q < 4; ++q) *(float4*)(so + q * 256) = make_float4(cur[4 * q], cur[4 * q + 1], cur[4 * q + 2], cur[4 * q + 3]);
    }
}

struct Order3 {
    pg8::StaticOrder so;
    __device__ void init(int G, int c) { so.init(MP, 4096, G, c); }
    __device__ bool next(int i, Unit& u) const { Unit v; if (!so.next(i, v)) return false; const int n = v.pn >> 2; u.pm = n * 65 + v.pm; u.pn = v.pn; return true; }
    __device__ __forceinline__ void a_ready(const Unit&) const {}
    __device__ __forceinline__ void done(const Unit&) const {}
};
struct Epi3 {
    static constexpr bool PERM = true, AFTER_DRAIN = false;
    bf16_t* O;
    __device__ __forceinline__ void operator()(const f32x4 (&acc)[2][2][4][2], const Unit& u, int wr, int wc, int fr, int fq) const {
        const int n = u.pn >> 2, pm = u.pm - n * 65, pn = u.pn & 3;
        const int row0 = pm * 256 + wr * 64 + fr, col0 = pn * 256 + wc * 32 + 8 * fq;
        bf16_t* base = O + (size_t)n * XSH_ROWS * 1024;
#pragma unroll
        for (int ai = 0; ai < 2; ++ai)
#pragma unroll
            for (int m = 0; m < 4; ++m) { bf16_t* rowp = base + (size_t)(row0 + ai * 128 + m * 16) * 1024 + col0;
#pragma unroll
                for (int bj = 0; bj < 2; ++bj) { const f32x4 v0 = acc[ai][bj][m][0], v1 = acc[ai][bj][m][1];
                    u32x4 w; w.x = pk_bf16c(v0[0], v0[1]); w.y = pk_bf16c(v0[2], v0[3]); w.z = pk_bf16c(v1[0], v1[1]); w.w = pk_bf16c(v1[2], v1[3]);
                    *(u32x4*)(rowp + bj * 128) = w; } }
    }
};
struct EpiPreRes {
    static constexpr bool PERM = false, AFTER_DRAIN = false;
    float* C; const float* X;
    __device__ __forceinline__ void operator()(const f32x4 (&acc)[2][2][4][2], const Unit& u, int wr, int wc, int fr, int fq) const {
        const int row0 = u.pm * 256 + wr * 64 + fr, col0 = u.pn * 256 + wc * 32 + 4 * fq;
#pragma unroll
        for (int ai = 0; ai < 2; ++ai)
#pragma unroll
            for (int m = 0; m < 4; ++m) { const size_t off = (size_t)(row0 + ai * 128 + m * 16) * 1024 + col0;
#pragma unroll
                for (int bj = 0; bj < 2; ++bj)
#pragma unroll
                    for (int n = 0; n < 2; ++n) { const f32x4 xv = *(const f32x4*)(X + off + bj * 128 + n * 16); *(f32x4*)(C + off + bj * 128 + n * 16) = acc[ai][bj][m][n] + xv * ALPHA; } }
    }
};

constexpr int LR_A = 0;
constexpr int LR_P = 67584;
struct LoraRegs { u32x4 v[8]; };
__device__ __forceinline__ void lora_load(unsigned char* ws, int task, int tid, LoraRegs& r) {
    const int rt = task >> 1, which = task & 1;
    const bf16_t* A = (const bf16_t*)(ws + NB_XSH) + ((size_t)(4 + which) * XSH_ROWS + (size_t)rt * 32) * 1024;
#pragma unroll
    for (int i = 0; i < 8; ++i) { const int idx = tid + i * NTH; r.v[i] = *(const u32x4*)(A + (size_t)(idx >> 7) * 1024 + (idx & 127) * 8); }
}
__device__ __forceinline__ void lora_tile(unsigned char* ws, PG8_LAS unsigned char* lds, int task, int tid, const LoraRegs& r) {
    const int rt = task >> 1, which = task & 1;
    const int lane = tid & 63, wv = tid >> 6, lr = lane & 31, h = lane >> 5;
    PG8_LAS bf16_t* AT = (PG8_LAS bf16_t*)(lds + LR_A);
    PG8_LAS float* P = (PG8_LAS float*)(lds + LR_P);
#pragma unroll
    for (int i = 0; i < 8; ++i) { const int idx = tid + i * NTH; *(PG8_LAS u32x4*)(AT + (idx >> 7) * 1032 + (idx & 127) * 8) = r.v[i]; }
    __syncthreads();
    const bf16_t* Bt = (const bf16_t*)(ws + (which ? NB_A1T : NB_W1T));
    f32x16 acc0, acc1;
#pragma unroll
    for (int i = 0; i < 16; ++i) { acc0[i] = 0.f; acc1[i] = 0.f; }
#pragma unroll
    for (int s = 0; s < 8; ++s) {
        const int k = wv * 128 + s * 16 + h * 8;
        const bf16x8 av = *(const PG8_LAS bf16x8*)(AT + lr * 1032 + k);
        const bf16x8 b0 = *(const bf16x8*)(Bt + (size_t)lr * 1024 + k), b1 = *(const bf16x8*)(Bt + (size_t)(32 + lr) * 1024 + k);
        acc0 = __builtin_amdgcn_mfma_f32_32x32x16_bf16(av, b0, acc0, 0, 0, 0);
        acc1 = __builtin_amdgcn_mfma_f32_32x32x16_bf16(av, b1, acc1, 0, 0, 0);
    }
#pragma unroll
    for (int q = 0; q < 4; ++q) {
        *(PG8_LAS f32x4*)(P + (wv * 64 + lane) * 32 + q * 4) = (f32x4){acc0[4 * q], acc0[4 * q + 1], acc0[4 * q + 2], acc0[4 * q + 3]};
        *(PG8_LAS f32x4*)(P + (wv * 64 + lane) * 32 + 16 + q * 4) = (f32x4){acc1[4 * q], acc1[4 * q + 1], acc1[4 * q + 2], acc1[4 * q + 3]};
    }
    __syncthreads();
    if (wv < 2) {
        float sum[16];
#pragma unroll
        for (int i = 0; i < 16; ++i) sum[i] = 0.f;
#pragma unroll
        for (int w = 0; w < 8; ++w)
#pragma unroll
            for (int q = 0; q < 4; ++q) { const f32x4 v = *(const PG8_LAS f32x4*)(P + (w * 64 + lane) * 32 + wv * 16 + q * 4); sum[4 * q] += v[0]; sum[4 * q + 1] += v[1]; sum[4 * q + 2] += v[2]; sum[4 * q + 3] += v[3]; }
        bf16_t* dst = (bf16_t*)(ws + (which ? NB_AWB : NB_TWB)) + (size_t)rt * 32 * 64 + wv * 32 + lr;
#pragma unroll
        for (int i = 0; i < 16; ++i) { const int row = (i & 3) + 8 * (i >> 2) + 4 * h; const float v = which ? sum[i] : tanhf(sum[i]); dst[(size_t)row * 64] = (bf16_t)(pk_bf16c(v, 0.f) & 0xffffu); }
    }
    __syncthreads();
}

__device__ __forceinline__ float dpp_red16f(float v) {
    v += __builtin_bit_cast(float, __builtin_amdgcn_update_dpp(0, __builtin_bit_cast(int, v), 0xB1, 0xF, 0xF, true));
    v += __builtin_bit_cast(float, __builtin_amdgcn_update_dpp(0, __builtin_bit_cast(int, v), 0x4E, 0xF, 0xF, true));
    v += __builtin_bit_cast(float, __builtin_amdgcn_update_dpp(0, __builtin_bit_cast(int, v), 0x141, 0xF, 0xF, true));
    v += __builtin_bit_cast(float, __builtin_amdgcn_update_dpp(0, __builtin_bit_cast(int, v), 0x140, 0xF, 0xF, true));
    return v;
}
__device__ __forceinline__ void prep2_task(const Args& a, unsigned char* ws, int rt, int hd, int lane) {
    const int lr = lane & 31, h2 = lane >> 5;
    const size_t row0 = (size_t)rt * 32;
    const bf16_t* W2T = (const bf16_t*)(ws + NB_W2T); const bf16_t* A2T = (const bf16_t*)(ws + NB_A2T);
    const bf16_t* TWB = (const bf16_t*)(ws + NB_TWB); const bf16_t* AWB = (const bf16_t*)(ws + NB_AWB);
    f32x16 aw[2], aa[2];
#pragma unroll
    for (int ct = 0; ct < 2; ++ct)
#pragma unroll
        for (int i = 0; i < 16; ++i) { aw[ct][i] = 0.f; aa[ct][i] = 0.f; }
#pragma unroll
    for (int s = 0; s < 4; ++s) {
        const bf16x8 at = *(const bf16x8*)(TWB + (row0 + lr) * 64 + s * 16 + h2 * 8), aa_ = *(const bf16x8*)(AWB + (row0 + lr) * 64 + s * 16 + h2 * 8);
#pragma unroll
        for (int ct = 0; ct < 2; ++ct) {
            const size_t e = (size_t)hd * 64 + ct * 32 + lr;
            const bf16x8 w2 = *(const bf16x8*)(W2T + e * 64 + s * 16 + h2 * 8), a2 = *(const bf16x8*)(A2T + e * 64 + s * 16 + h2 * 8);
            aw[ct] = __builtin_amdgcn_mfma_f32_32x32x16_bf16(at, w2, aw[ct], 0, 0, 0);
            aa[ct] = __builtin_amdgcn_mfma_f32_32x32x16_bf16(aa_, a2, aa[ct], 0, 0, 0);
        }
    }
    const bf16_t* KB = (const bf16_t*)(ws + NB_RKVZ) + (size_t)1 * XSH_ROWS * 1024;
    const bf16_t* RB = (const bf16_t*)(ws + NB_RKVZ);
    float* DEC = (float*)(ws + NB_DEC);
    bf16_t* KKN = (bf16_t*)(ws + NB_KKN); bf16_t* KKA = (bf16_t*)(ws + NB_KKA); bf16_t* KP = (bf16_t*)(ws + NB_KP);
    float w0v[2], a0v[2], kkp[2], kap[2], rkp[2];
#pragma unroll
    for (int ct = 0; ct < 2; ++ct) { const int e = hd * 64 + ct * 32 + lr; w0v[ct] = a.in[I_W0][e]; a0v[ct] = a.in[I_A0][e]; kkp[ct] = a.in[I_KK][e]; kap[ct] = a.in[I_KA][e]; rkp[ct] = a.in[I_RK][e]; }
    float n2[16], rk[16];
#pragma unroll
    for (int i = 0; i < 16; ++i) { n2[i] = 0.f; rk[i] = 0.f; }
#pragma unroll
    for (int ct = 0; ct < 2; ++ct)
#pragma unroll
        for (int i = 0; i < 16; ++i) {
            const size_t off = (row0 + (i & 3) + 8 * (i >> 2) + 4 * h2) * 1024 + hd * 64 + ct * 32 + lr;
            const float kf = bf2f(KB[off]), rf = bf2f(RB[off]);
            const float wl = w0v[ct] + aw[ct][i];
            const float sp = fmaxf(-wl, 0.f) + log1pf(__expf(-fabsf(wl)));
            DEC[off] = __expf(-__expf(-sp - 0.5f));
            const float av_ = sigm_f(a0v[ct] + aa[ct][i]);
            const float kk = kf * kkp[ct];
            const float kp = kf * (1.f + (av_ - 1.f) * kap[ct]);
            KP[off] = (bf16_t)(pk_bf16(kp, 0.f) & 0xffffu);
            aw[ct][i] = kk; aa[ct][i] = av_;
            n2[i] = fmaf(kk, kk, n2[i]);
            rk[i] = fmaf(rf * kp, rkp[ct], rk[i]);
        }
#pragma unroll
    for (int i = 0; i < 16; ++i) {
        float v = dpp_red16f(n2[i]); v += __shfl_xor(v, 16); n2[i] = 1.f / fmaxf(sqrtf(v), 1e-12f);
        float w = dpp_red16f(rk[i]); w += __shfl_xor(w, 16); rk[i] = w;
    }
#pragma unroll
    for (int ct = 0; ct < 2; ++ct)
#pragma unroll
        for (int i = 0; i < 16; ++i) {
            const size_t off = (row0 + (i & 3) + 8 * (i >> 2) + 4 * h2) * 1024 + hd * 64 + ct * 32 + lr;
            const float kn = aw[ct][i] * n2[i];
            KKN[off] = (bf16_t)(pk_bf16(kn, 0.f) & 0xffffu);
            KKA[off] = (bf16_t)(pk_bf16(kn * aa[ct][i], 0.f) & 0xffffu);
        }
    if (lr == 0) {
#pragma unroll
        for (int i = 0; i < 16; ++i) ((float*)(ws + NB_RKS))[(row0 + (i & 3) + 8 * (i >> 2) + 4 * h2) * 16 + hd] = rk[i];
    }
}

constexpr int SC_BUF = 53248;
__device__ __forceinline__ float dpp_red16(float v) {
    v += __builtin_bit_cast(float, __builtin_amdgcn_update_dpp(0, __builtin_bit_cast(int, v), 0xB1, 0xF, 0xF, true));
    v += __builtin_bit_cast(float, __builtin_amdgcn_update_dpp(0, __builtin_bit_cast(int, v), 0x4E, 0xF, 0xF, true));
    v += __builtin_bit_cast(float, __builtin_amdgcn_update_dpp(0, __builtin_bit_cast(int, v), 0x141, 0xF, 0xF, true));
    v += __builtin_bit_cast(float, __builtin_amdgcn_update_dpp(0, __builtin_bit_cast(int, v), 0x140, 0xF, 0xF, true));
    return v;
}
struct ScanRegs { u32x4 d0, d1, kn, ka, kp, r, v; };
__device__ __forceinline__ void scan_issue(unsigned char* ws, int b, int hd, int vh, int chunk, int tid, ScanRegs& g) {
    const int tt = tid >> 3, part = tid & 7;
    const size_t row = (size_t)b * TP + chunk * 64 + tt;
    const size_t off = row * 1024 + hd * 64 + part * 8;
    const float* dp = (const float*)(ws + NB_DEC) + off;
    g.d0 = *(const u32x4*)dp; g.d1 = *(const u32x4*)(dp + 4);
    g.kn = *(const u32x4*)((const bf16_t*)(ws + NB_KKN) + off);
    g.ka = *(const u32x4*)((const bf16_t*)(ws + NB_KKA) + off);
    g.kp = *(const u32x4*)((const bf16_t*)(ws + NB_KP) + off);
    g.r = *(const u32x4*)((const bf16_t*)(ws + NB_RKVZ) + ((size_t)0 * XSH_ROWS + row) * 1024 + hd * 64 + part * 8);
    if (part < 4) g.v = *(const u32x4*)((const bf16_t*)(ws + NB_RKVZ) + ((size_t)2 * XSH_ROWS + row) * 1024 + hd * 64 + vh * 32 + part * 8);
}
__device__ __forceinline__ void scan_write(PG8_LAS unsigned char* buf, int tid, const ScanRegs& g) {
    const int tt = tid >> 3, part = tid & 7;
    *(PG8_LAS u32x4*)(buf + tt * 256 + part * 32) = g.d0; *(PG8_LAS u32x4*)(buf + tt * 256 + part * 32 + 16) = g.d1;
    *(PG8_LAS u32x4*)(buf + 16384 + tt * 128 + part * 16) = g.kn;
    *(PG8_LAS u32x4*)(buf + 24576 + tt * 128 + part * 16) = g.ka;
    *(PG8_LAS u32x4*)(buf + 32768 + tt * 128 + part * 16) = g.kp;
    *(PG8_LAS u32x4*)(buf + 40960 + tt * 128 + part * 16) = g.r;
    if (part < 4) *(PG8_LAS u32x4*)(buf + 49152 + tt * 64 + part * 16) = g.v;
}
__device__ __forceinline__ void scan_prompt(const Args& a, unsigned char* ws, PG8_LAS unsigned char* lds, int item) {
    const int tid = opaque_v(threadIdx.x);
    const int b = item >> 5, hd = (item >> 1) & 15, vh = item & 1;
    const int vl = tid >> 4, kq = tid & 15;
    typedef unsigned u32x2 __attribute__((ext_vector_type(2)));
    float S[4] = {0.f, 0.f, 0.f, 0.f};
    ScanRegs g;
    PG8_LAS float* YS = (PG8_LAS float*)(lds + 2 * SC_BUF);
    scan_issue(ws, b, hd, vh, 0, tid, g); scan_write(lds, tid, g);
    __syncthreads();
    for (int c = 0; c < TP / 64; ++c) {
        PG8_LAS unsigned char* buf = lds + (c & 1) * SC_BUF;
        if (c + 1 < TP / 64) scan_issue(ws, b, hd, vh, c + 1, tid, g);
#pragma unroll 4
        for (int tt = 0; tt < 64; ++tt) {
            const f32x4 w = *(const PG8_LAS f32x4*)(buf + tt * 256 + kq * 16);
            const u32x2 knw = *(const PG8_LAS u32x2*)(buf + 16384 + tt * 128 + kq * 8), kaw = *(const PG8_LAS u32x2*)(buf + 24576 + tt * 128 + kq * 8),
                        kpw = *(const PG8_LAS u32x2*)(buf + 32768 + tt * 128 + kq * 8), rw = *(const PG8_LAS u32x2*)(buf + 40960 + tt * 128 + kq * 8);
            const float vv = bf2f(*(const PG8_LAS bf16_t*)(buf + 49152 + tt * 64 + vl * 2));
            const float kn[4] = {__uint_as_float(knw.x << 16), __uint_as_float(knw.x & 0xffff0000u), __uint_as_float(knw.y << 16), __uint_as_float(knw.y & 0xffff0000u)};
            const float ka[4] = {__uint_as_float(kaw.x << 16), __uint_as_float(kaw.x & 0xffff0000u), __uint_as_float(kaw.y << 16), __uint_as_float(kaw.y & 0xffff0000u)};
            const float kp[4] = {__uint_as_float(kpw.x << 16), __uint_as_float(kpw.x & 0xffff0000u), __uint_as_float(kpw.y << 16), __uint_as_float(kpw.y & 0xffff0000u)};
            const float rr[4] = {__uint_as_float(rw.x << 16), __uint_as_float(rw.x & 0xffff0000u), __uint_as_float(rw.y << 16), __uint_as_float(rw.y & 0xffff0000u)};
            float sa = S[0] * kn[0];
            sa = fmaf(S[1], kn[1], sa); sa = fmaf(S[2], kn[2], sa); sa = fmaf(S[3], kn[3], sa);
            sa = dpp_red16(sa);
            float y = 0.f;
#pragma unroll
            for (int i = 0; i < 4; ++i) { S[i] = fmaf(S[i], w[i], fmaf(vv, kp[i], -sa * ka[i])); y = fmaf(S[i], rr[i], y); }
            y = dpp_red16(y);
            if (kq == 0) YS[tt * 32 + vl] = y;
        }
        if (c + 1 < TP / 64) scan_write(lds + ((c + 1) & 1) * SC_BUF, tid, g);
        __syncthreads();
        {
            float* Y = (float*)(ws + NB_Y);
            for (int i = tid; i < 64 * 32; i += NTH) { const int tt = i >> 5, v = i & 31; Y[((size_t)b * TP + c * 64 + tt) * 1024 + hd * 64 + vh * 32 + v] = YS[i]; }
        }
        __syncthreads();
    }
    float* so = a.out + O_WKVP + ((size_t)(b * 16 + hd) * 64 + vh * 32 + vl) * 64 + kq * 4;
    *(float4*)so = make_float4(S[0], S[1], S[2], S[3]);
}
__device__ __forceinline__ void scan_sample(const Args& a, unsigned char* ws, int s, int hd, int lane) {
    const size_t row = (size_t)MP + s;
    const float* s0 = a.in[I_SWKV] + ((size_t)(s * 16 + hd) * 64 + lane) * 64;
    float* sout = a.out + O_WKVS + ((size_t)(s * 16 + hd) * 64 + lane) * 64;
    const int e = hd * 64 + lane;
    const float twl = bf2f(((const bf16_t*)(ws + NB_TWB) + row * 64)[lane]), awl = bf2f(((const bf16_t*)(ws + NB_AWB) + row * 64)[lane]);
    const bf16_t* w2r = (const bf16_t*)(ws + NB_W2T) + (size_t)e * 64; const bf16_t* a2r = (const bf16_t*)(ws + NB_A2T) + (size_t)e * 64;
    float wl = a.in[I_W0][e], al = a.in[I_A0][e];
#define RL(X, K) __builtin_bit_cast(float, __builtin_amdgcn_readlane(__builtin_bit_cast(int, X), K))
#pragma unroll
    for (int j8 = 0; j8 < 8; ++j8) {
        const u32x4 wq = *(const u32x4*)(w2r + j8 * 8), aq = *(const u32x4*)(a2r + j8 * 8);
#pragma unroll
        for (int i = 0; i < 8; ++i) {
            const float wv_ = __uint_as_float((i & 1) ? (wq[i >> 1] & 0xffff0000u) : (wq[i >> 1] << 16)), av_ = __uint_as_float((i & 1) ? (aq[i >> 1] & 0xffff0000u) : (aq[i >> 1] << 16));
            wl = fmaf(RL(twl, j8 * 8 + i), wv_, wl); al = fmaf(RL(awl, j8 * 8 + i), av_, al);
        }
    }
    const float decl = __expf(-0.60653066f * sigm_f(wl));
    const float aa_ = sigm_f(al);
    const float kf = bf2f(((const bf16_t*)(ws + NB_RKVZ) + ((size_t)1 * XSH_ROWS + row) * 1024)[e]);
    const float rl = bf2f(((const bf16_t*)(ws + NB_RKVZ) + ((size_t)0 * XSH_ROWS + row) * 1024)[e]);
    const float vv = bf2f(((const bf16_t*)(ws + NB_RKVZ) + ((size_t)2 * XSH_ROWS + row) * 1024)[e]);
    const float kkr = kf * a.in[I_KK][e];
    const float kpl = kf * (1.f + (aa_ - 1.f) * a.in[I_KA][e]);
    const float knl = kkr / fmaxf(sqrtf(wave_sum(kkr * kkr)), 1e-12f);
    const float kal = knl * aa_;
    const float rkv = wave_sum(rl * kpl * a.in[I_RK][e]);
    float S[64];
#pragma unroll
    for (int q = 0; q < 16; ++q) { const float4 v4 = *(const float4*)(s0 + q * 4); S[4 * q] = v4.x; S[4 * q + 1] = v4.y; S[4 * q + 2] = v4.z; S[4 * q + 3] = v4.w; }
    float sa = 0.f;
#pragma unroll
    for (int k = 0; k < 64; ++k) sa = fmaf(S[k], RL(knl, k), sa);
    float y = 0.f;
#pragma unroll
    for (int k = 0; k < 64; ++k) { S[k] = fmaf(S[k], RL(decl, k), fmaf(vv, RL(kpl, k), -sa * RL(kal, k))); y = fmaf(S[k], RL(rl, k), y); }
#undef RL
#pragma unroll
    for (int q = 0; q < 16; ++q) *(float4*)(sout + q * 4) = make_float4(S[4 * q], S[4 * q + 1], S[4 * q + 2], S[4 * q + 3]);
    {
        const float mean = wave_sum(y) * (1.f / 64.f);
        const float d = y - mean;
        const float rs = rsqrtf(wave_sum(d * d) * (1.f / 64.f) + GN_EPS);
        const float zf = bf2f(((const bf16_t*)(ws + NB_RKVZ) + ((size_t)3 * XSH_ROWS + row) * 1024)[e]);
        const float o = fmaf(rkv, vv, d * rs * a.in[I_GNG][e] + a.in[I_GNB][e]) * silu_f(zf);
        ((bf16_t*)(ws + NB_G4B))[row * 1024 + e] = (bf16_t)(pk_bf16c(o, 0.f) & 0xffffu);
    }
}

constexpr int CS_LD = 72;
constexpr int CS_SLOT = 64 * CS_LD * 2;
constexpr int CS_F32A = 13 * CS_SLOT;
constexpr int CS_F32B = CS_F32A + 16384;
constexpr int CS_GS = CS_F32B + 16384;
constexpr int CS_END = CS_GS + 4096;
constexpr size_t CK_MCT = 0, CK_RY = 8192, CK_SADD = 16384, CK_Y0 = 24576, CK_BYTES = 32768;

__device__ __forceinline__ PG8_LAS bf16_t* cs_slot(PG8_LAS unsigned char* lds, int i) { return (PG8_LAS bf16_t*)(lds + i * CS_SLOT); }
template <bool SWX = false, bool SWY = false>
__device__ __forceinline__ void cs_mm(f32x16& acc, const PG8_LAS bf16_t* X, const PG8_LAS bf16_t* Yt, int mt, int nt, int lane) {
    const int lr = lane & 31, h = lane >> 5;
    const int rx = mt * 32 + lr, ry = nt * 32 + lr;
    const int sx = SWX ? ((rx >> 3) & 7) : 0, sy = SWY ? ((ry >> 3) & 7) : 0;
#pragma unroll
    for (int s = 0; s < 4; ++s) {
        const bf16x8 av = *(const PG8_LAS bf16x8*)(X + rx * CS_LD + (((2 * s + h) ^ sx) << 3));
        const bf16x8 bv = *(const PG8_LAS bf16x8*)(Yt + ry * CS_LD + (((2 * s + h) ^ sy) << 3));
        acc = __builtin_amdgcn_mfma_f32_32x32x16_bf16(av, bv, acc, 0, 0, 0);
    }
}
__device__ __forceinline__ void cs_store_t(const f32x16& acc, PG8_LAS bf16_t* D, int mt, int nt, int lane) {
    typedef unsigned u32x2 __attribute__((ext_vector_type(2)));
    const int lr = lane & 31, h = lane >> 5;
#pragma unroll
    for (int c = 0; c < 4; ++c) { u32x2 w; w.x = pk_bf16c(acc[4 * c], acc[4 * c + 1]); w.y = pk_bf16c(acc[4 * c + 2], acc[4 * c + 3]);
        *(PG8_LAS u32x2*)(D + (nt * 32 + lr) * CS_LD + mt * 32 + 8 * c + 4 * h) = w; }
}
__device__ __forceinline__ void cs_store_n(const f32x16& acc, PG8_LAS bf16_t* D, int mt, int nt, int lane) {
    const int lr = lane & 31, h = lane >> 5;
#pragma unroll
    for (int i = 0; i < 16; ++i) D[(mt * 32 + (i & 3) + 8 * (i >> 2) + 4 * h) * CS_LD + nt * 32 + lr] = (bf16_t)(pk_bf16c(acc[i], 0.f) & 0xffffu);
}
__device__ __forceinline__ void cs_zero(f32x16& a) {
#pragma unroll
    for (int i = 0; i < 16; ++i) a[i] = 0.f;
}
__device__ __forceinline__ float dpp_red8(float v) {
    v += __builtin_bit_cast(float, __builtin_amdgcn_update_dpp(0, __builtin_bit_cast(int, v), 0xB1, 0xF, 0xF, true));
    v += __builtin_bit_cast(float, __builtin_amdgcn_update_dpp(0, __builtin_bit_cast(int, v), 0x4E, 0xF, 0xF, true));
    v += __builtin_bit_cast(float, __builtin_amdgcn_update_dpp(0, __builtin_bit_cast(int, v), 0x141, 0xF, 0xF, true));
    return v;
}

struct PreRegs { u32x4 kv, rv, vv; bf16x8 af[4]; };
__device__ __forceinline__ void scanpre_load(unsigned char* ws, int b, int hd, int c, int tid, PreRegs& r) {
    const int lane = tid & 63, wv = tid >> 6, lr = lane & 31, h = lane >> 5;
    const size_t row0 = (size_t)b * TP + c * 64;
    const int tok = tid >> 3, c8 = tid & 7;
    const size_t off = (row0 + tok) * 1024 + hd * 64 + c8 * 8;
    const bf16_t* RK = (const bf16_t*)(ws + NB_RKVZ);
    r.kv = *(const u32x4*)(RK + (size_t)1 * XSH_ROWS * 1024 + off); r.rv = *(const u32x4*)(RK + off); r.vv = *(const u32x4*)(RK + (size_t)2 * XSH_ROWS * 1024 + off);
    const int which = wv >> 2, mt = (wv >> 1) & 1;
    const bf16_t* A = (const bf16_t*)(ws + (which ? NB_AWB : NB_TWB)) + (row0 + mt * 32 + lr) * 64 + h * 8;
#pragma unroll
    for (int s = 0; s < 4; ++s) r.af[s] = *(const bf16x8*)(A + s * 16);
}
__device__ __forceinline__ void scanpre_chunk(const Args& a, unsigned char* ws, PG8_LAS unsigned char* lds, int b, int hd, int c, const PreRegs& pre, const bf16x8 (&btf)[4]) {
    const int tid = opaque_v(threadIdx.x), lane = tid & 63, wv = __builtin_amdgcn_readfirstlane(tid >> 6);
    const int lr = lane & 31, h = lane >> 5;
    const size_t row0 = (size_t)b * TP + c * 64;
    typedef unsigned u32x2 __attribute__((ext_vector_type(2)));
    PG8_LAS float* LCUM = (PG8_LAS float*)(lds + CS_F32A);
    PG8_LAS float* AV = (PG8_LAS float*)(lds + CS_F32B);
    PG8_LAS float* GS = (PG8_LAS float*)(lds + CS_GS);
    unsigned char* rec = ws + NB_CHK + ((size_t)(b * 16 + hd) * 32 + c) * CK_BYTES;
    {
        const int tok = tid >> 3, c8 = tid & 7;
        *(PG8_LAS u32x4*)(cs_slot(lds, 0) + tok * CS_LD + c8 * 8) = pre.kv;
        *(PG8_LAS u32x4*)(cs_slot(lds, 1) + tok * CS_LD + c8 * 8) = pre.rv;
        *(PG8_LAS u32x4*)(cs_slot(lds, 2) + tok * CS_LD + c8 * 8) = pre.vv;
    }
    {
        const int which = wv >> 2, mt = (wv >> 1) & 1, nt = wv & 1;
        f32x16 acc; cs_zero(acc);
#pragma unroll
        for (int s = 0; s < 4; ++s) acc = __builtin_amdgcn_mfma_f32_32x32x16_bf16(pre.af[s], btf[s], acc, 0, 0, 0);
        PG8_LAS float* D = which ? AV : LCUM;
        const float bias = a.in[which ? I_A0 : I_W0][hd * 64 + nt * 32 + lr];
#pragma unroll
        for (int i = 0; i < 16; ++i) {
            const float x = acc[i] + bias;
            float y;
            if (which) y = sigm_f(x);
            else y = -0.87503504f * sigm_f(x);
            D[(mt * 32 + (i & 3) + 8 * (i >> 2) + 4 * h) * 64 + nt * 32 + lr] = y;
        }
    }
    lds_barrier();
    {
        const int ch = tid & 63, tg = tid >> 6;
        float p[8]; float run = 0.f;
#pragma unroll
        for (int i = 0; i < 8; ++i) { run += LCUM[(tg * 8 + i) * 64 + ch]; p[i] = run; }
        GS[tg * 64 + ch] = run;
        lds_barrier();
        float offs = 0.f;
        for (int g = 0; g < tg; ++g) offs += GS[g * 64 + ch];
#pragma unroll
        for (int i = 0; i < 8; ++i) LCUM[(tg * 8 + i) * 64 + ch] = p[i] + offs;
    }
    lds_barrier();
    {
        const int tok = tid >> 3, c8 = tid & 7;
        const u32x4 kw = *(const PG8_LAS u32x4*)(cs_slot(lds, 0) + tok * CS_LD + c8 * 8), rw = *(const PG8_LAS u32x4*)(cs_slot(lds, 1) + tok * CS_LD + c8 * 8),
                    vw = *(const PG8_LAS u32x4*)(cs_slot(lds, 2) + tok * CS_LD + c8 * 8);
        float kf[8], rf[8], kk[8], kp[8], av[8];
        float n2 = 0.f, rk = 0.f;
#pragma unroll
        for (int i = 0; i < 8; ++i) {
            const int e = hd * 64 + c8 * 8 + i;
            kf[i] = __uint_as_float((i & 1) ? (kw[i >> 1] & 0xffff0000u) : (kw[i >> 1] << 16));
            rf[i] = __uint_as_float((i & 1) ? (rw[i >> 1] & 0xffff0000u) : (rw[i >> 1] << 16));
            av[i] = AV[tok * 64 + c8 * 8 + i];
            kk[i] = kf[i] * a.in[I_KK][e];
            kp[i] = kf[i] * (1.f + (av[i] - 1.f) * a.in[I_KA][e]);
            n2 = fmaf(kk[i], kk[i], n2);
            rk = fmaf(rf[i] * kp[i], a.in[I_RK][e], rk);
        }
        n2 = dpp_red8(n2); rk = dpp_red8(rk);
        const float inv = 1.f / fmaxf(sqrtf(n2), 1e-12f);
        if (c8 == 0) ((float*)(ws + NB_RKS))[(row0 + tok) * 16 + hd] = rk;
        if (tok == 63) {
#pragma unroll
            for (int i = 0; i < 8; ++i) GS[512 + c8 * 8 + i] = __builtin_amdgcn_exp2f(LCUM[63 * 64 + c8 * 8 + i]);
        }
        float qt[8], rt[8], kt[8], bt[8], kh[8], bh[8];
#pragma unroll
        for (int i = 0; i < 8; ++i) {
            const int ch = c8 * 8 + i;
            const float Lt = LCUM[tok * 64 + ch], Lp = tok ? LCUM[(tok - 1) * 64 + ch] : 0.f, Lc = LCUM[63 * 64 + ch];
            const float kn = kk[i] * inv, ka = kn * av[i];
            const float en = __builtin_amdgcn_exp2f(-Lt), ec = __builtin_amdgcn_exp2f(Lc - Lt);
            qt[i] = kn * __builtin_amdgcn_exp2f(Lp); rt[i] = rf[i] * __builtin_amdgcn_exp2f(Lt); kt[i] = kp[i] * en; bt[i] = ka * en; kh[i] = kp[i] * ec; bh[i] = ka * ec;
        }
#define CS_PUT_ROW(SLOT, ARR) { u32x4 w_; w_.x = pk_bf16c(ARR[0], ARR[1]); w_.y = pk_bf16c(ARR[2], ARR[3]); w_.z = pk_bf16c(ARR[4], ARR[5]); w_.w = pk_bf16c(ARR[6], ARR[7]); \
            *(PG8_LAS u32x4*)(cs_slot(lds, SLOT) + tok * CS_LD + c8 * 8) = w_; }
#define CS_PUT_COL(SLOT, ARR) { _Pragma("unroll") for (int i_ = 0; i_ < 8; ++i_) cs_slot(lds, SLOT)[(c8 * 8 + i_) * CS_LD + tsw] = (bf16_t)(pk_bf16c(ARR[i_], 0.f) & 0xffffu); }
        const int tsw = ((((tok >> 3) ^ c8) & 7) << 3) | (tok & 7);
        CS_PUT_ROW(3, qt) CS_PUT_ROW(4, rt) CS_PUT_ROW(5, kt) CS_PUT_ROW(6, bt)
        CS_PUT_COL(7, qt) CS_PUT_COL(8, bh) CS_PUT_COL(9, kh)
#pragma unroll
        for (int i = 0; i < 8; ++i) cs_slot(lds, 10)[(c8 * 8 + i) * CS_LD + tsw] = (bf16_t)((i & 1) ? (vw[i >> 1] >> 16) : (vw[i >> 1] & 0xffffu));
#undef CS_PUT_ROW
#undef CS_PUT_COL
    }
    lds_barrier();
    {
#pragma unroll 1
        for (int j = 0; j < 2; ++j) {
            const int job = wv * 2 + j, prod = job >> 2, mt = (job >> 1) & 1, nt = job & 1;
            const PG8_LAS bf16_t* X = cs_slot(lds, (prod & 1) ? 6 : 5);
            const PG8_LAS bf16_t* Y = cs_slot(lds, (prod & 2) ? 4 : 3);
            f32x16 acc; cs_zero(acc);
            cs_mm(acc, X, Y, mt, nt, lane);
            const int t = nt * 32 + lr, incl = (prod & 2) ? 1 : 0;
#pragma unroll
            for (int i = 0; i < 16; ++i) { const int sidx = mt * 32 + (i & 3) + 8 * (i >> 2) + 4 * h; acc[i] = (sidx < t + incl) ? acc[i] : 0.f; }
            const int dst = (prod == 0) ? 0 : (prod == 1) ? 11 : (prod == 2) ? 1 : 2;
            cs_store_t(acc, cs_slot(lds, dst), mt, nt, lane);
            if (prod == 1) cs_store_n(acc, cs_slot(lds, 12), mt, nt, lane);
        }
    }
    lds_barrier();
    {
        const int mt = (wv >> 1) & 1, nt = wv & 1;
        f32x16 pacc;
        if (wv < 4) {
#pragma unroll
            for (int i = 0; i < 16; ++i) { const int u = mt * 32 + (i & 3) + 8 * (i >> 2) + 4 * h, t = nt * 32 + lr;
                pacc[i] = ((u == t) ? 1.f : 0.f) - bf2f(cs_slot(lds, 12)[u * CS_LD + t]); }
            cs_store_t(pacc, cs_slot(lds, 3), mt, nt, lane);
        }
        lds_barrier();
        const int mcur = 11, mtcur = 12, mnxt = 5, mtnxt = 6;
        PG8_LAS bf16_t* XS0 = (PG8_LAS bf16_t*)(lds + CS_F32A);
        PG8_LAS bf16_t* XS1 = (PG8_LAS bf16_t*)(lds + CS_F32A + CS_SLOT);
        PG8_LAS bf16_t* XS2 = (PG8_LAS bf16_t*)(lds + CS_F32A + 2 * CS_SLOT);
        PG8_LAS bf16_t* Pc = cs_slot(lds, 3); PG8_LAS bf16_t* Pn = XS0;
        PG8_LAS bf16_t* Mc_ = cs_slot(lds, mcur); PG8_LAS bf16_t* MTc = cs_slot(lds, mtcur);
        PG8_LAS bf16_t* Mn = cs_slot(lds, mnxt); PG8_LAS bf16_t* MTn = cs_slot(lds, mtnxt);
#pragma unroll 1
        for (int it = 0; it < 5; ++it) {
            if (wv >= 4) {
                f32x16 acc; cs_zero(acc);
                cs_mm(acc, Mc_, MTc, mt, nt, lane);
                cs_store_n(acc, Mn, mt, nt, lane);
                cs_store_t(acc, MTn, mt, nt, lane);
                float mx = 0.f;
#pragma unroll
                for (int i = 0; i < 16; ++i) mx = fmaxf(mx, fabsf(acc[i]));
#pragma unroll
                for (int o = 32; o > 0; o >>= 1) mx = fmaxf(mx, __shfl_xor(mx, o));
                if (lane == 0) GS[640 + (wv & 3)] = mx;
            }
            lds_barrier();
            const float m2max = fmaxf(fmaxf(GS[640], GS[641]), fmaxf(GS[642], GS[643]));
            if (wv < 4) {
                cs_mm(pacc, MTn, Pc, mt, nt, lane);
                cs_store_t(pacc, Pn, mt, nt, lane);
            }
            lds_barrier();
            { PG8_LAS bf16_t* t0 = Mc_; Mc_ = Mn; Mn = t0; t0 = MTc; MTc = MTn; MTn = t0; t0 = Pc; Pc = Pn; Pn = t0; }
            if (m2max < 3e-4f) break;
        }
        {
            f32x16 acc; cs_zero(acc);
            if (wv < 4) { cs_mm<false, true>(acc, cs_slot(lds, 0), cs_slot(lds, 10), mt, nt, lane); cs_store_t(acc, XS1, mt, nt, lane); }
            else { cs_mm<false, true>(acc, Pc, cs_slot(lds, 7), mt, nt, lane); cs_store_t(acc, XS2, mt, nt, lane); }
        }
        lds_barrier();
        if (wv < 4) { f32x16 acc; cs_zero(acc); cs_mm(acc, Pc, XS1, mt, nt, lane); cs_store_t(acc, cs_slot(lds, 11), mt, nt, lane); }
        lds_barrier();
        if (wv < 4) {
            f32x16 acc; cs_zero(acc);
            cs_mm<false, true>(acc, XS2, cs_slot(lds, 8), mt, nt, lane);
#pragma unroll
            for (int i = 0; i < 16; ++i) { const int k = mt * 32 + (i & 3) + 8 * (i >> 2) + 4 * h, kp_ = nt * 32 + lr; acc[i] = ((k == kp_) ? GS[512 + k] : 0.f) - acc[i]; }
            bf16_t* mct = (bf16_t*)(rec + CK_MCT);
#pragma unroll
            for (int cc = 0; cc < 4; ++cc) { u32x2 w; w.x = pk_bf16c(acc[4 * cc], acc[4 * cc + 1]); w.y = pk_bf16c(acc[4 * cc + 2], acc[4 * cc + 3]);
                *(u32x2*)(mct + ((nt * 4 + 2 * mt + (cc >> 1)) * 64 + lr + 32 * (cc & 1)) * 8 + 4 * h) = w; }
            f32x16 s1, s2; cs_zero(s1); cs_zero(s2);
            cs_mm<true, true>(s1, cs_slot(lds, 9), cs_slot(lds, 10), mt, nt, lane);
            cs_mm<true, false>(s2, cs_slot(lds, 8), cs_slot(lds, 11), mt, nt, lane);
            bf16_t* sd = (bf16_t*)(rec + CK_SADD) + ((size_t)(wv & 3) * 64 + lane) * 16;
#pragma unroll
            for (int q8 = 0; q8 < 2; ++q8) { u32x4 w;
                w.x = pk_bf16c(s1[8 * q8] - s2[8 * q8], s1[8 * q8 + 1] - s2[8 * q8 + 1]); w.y = pk_bf16c(s1[8 * q8 + 2] - s2[8 * q8 + 2], s1[8 * q8 + 3] - s2[8 * q8 + 3]);
                w.z = pk_bf16c(s1[8 * q8 + 4] - s2[8 * q8 + 4], s1[8 * q8 + 5] - s2[8 * q8 + 5]); w.w = pk_bf16c(s1[8 * q8 + 6] - s2[8 * q8 + 6], s1[8 * q8 + 7] - s2[8 * q8 + 7]);
                *(u32x4*)(sd + q8 * 8) = w; }
        } else {
            f32x16 acc; cs_zero(acc);
            cs_mm(acc, XS2, cs_slot(lds, 2), mt, nt, lane);
            bf16_t* ry = (bf16_t*)(rec + CK_RY);
#pragma unroll
            for (int cc = 0; cc < 4; ++cc) {
                const u32x2 rv = *(const PG8_LAS u32x2*)(cs_slot(lds, 4) + (nt * 32 + lr) * CS_LD + mt * 32 + 8 * cc + 4 * h);
                const float r0 = __uint_as_float(rv.x << 16), r1 = __uint_as_float(rv.x & 0xffff0000u), r2 = __uint_as_float(rv.y << 16), r3 = __uint_as_float(rv.y & 0xffff0000u);
                u32x2 w; w.x = pk_bf16c(r0 - acc[4 * cc], r1 - acc[4 * cc + 1]); w.y = pk_bf16c(r2 - acc[4 * cc + 2], r3 - acc[4 * cc + 3]);
                *(u32x2*)(ry + ((nt * 4 + 2 * mt + (cc >> 1)) * 64 + lr + 32 * (cc & 1)) * 8 + 4 * h) = w;
            }
            f32x16 s1, s2; cs_zero(s1); cs_zero(s2);
            cs_mm<false, true>(s1, cs_slot(lds, 1), cs_slot(lds, 10), mt, nt, lane);
            cs_mm(s2, cs_slot(lds, 2), cs_slot(lds, 11), mt, nt, lane);
            bf16_t* yd = (bf16_t*)(rec + CK_Y0) + ((size_t)(wv & 3) * 64 + lane) * 16;
#pragma unroll
            for (int q8 = 0; q8 < 2; ++q8) { u32x4 w;
                w.x = pk_bf16c(s1[8 * q8] - s2[8 * q8], s1[8 * q8 + 1] - s2[8 * q8 + 1]); w.y = pk_bf16c(s1[8 * q8 + 2] - s2[8 * q8 + 2], s1[8 * q8 + 3] - s2[8 * q8 + 3]);
                w.z = pk_bf16c(s1[8 * q8 + 4] - s2[8 * q8 + 4], s1[8 * q8 + 5] - s2[8 * q8 + 5]); w.w = pk_bf16c(s1[8 * q8 + 6] - s2[8 * q8 + 6], s1[8 * q8 + 7] - s2[8 * q8 + 7]);
                *(u32x4*)(yd + q8 * 8) = w; }
        }
    }
    lds_barrier();
}

struct SeqRegs { bf16x8 a[4]; u32x4 c[2]; };
__device__ __forceinline__ void seq_load(const unsigned char* rec, int wv, int mt, int lane, SeqRegs& r) {
    const bf16_t* ap = (const bf16_t*)(rec + CK_MCT) + ((size_t)mt * 4 * 64 + lane) * 8;
    const bf16_t* cp = (const bf16_t*)(rec + CK_SADD) + ((size_t)(wv & 3) * 64 + lane) * 16;
#pragma unroll
    for (int s = 0; s < 4; ++s) r.a[s] = *(const bf16x8*)(ap + s * 64 * 8);
    r.c[0] = *(const u32x4*)cp; r.c[1] = *(const u32x4*)(cp + 8);
}
__device__ __forceinline__ void scanseq_head(const Args& a, unsigned char* ws, PG8_LAS unsigned char* lds, int b, int hd) {
    const int tid = opaque_v(threadIdx.x), lane = tid & 63, wv = __builtin_amdgcn_readfirstlane(tid >> 6);
    const int lr = lane & 31, h = lane >> 5;
    const int mt = (wv >> 1) & 1, nt = wv & 1;
    const bool isS = wv < 4;
    PG8_LAS bf16_t* SB0 = cs_slot(lds, 0); PG8_LAS bf16_t* SB1 = cs_slot(lds, 1);
    f32x16 st; cs_zero(st);
    for (int i = tid; i < 64 * CS_LD; i += NTH) { SB0[i] = 0; }
    const unsigned char* rec0 = ws + NB_CHK + (size_t)(b * 16 + hd) * 32 * CK_BYTES;
    bf16_t* srec0 = (bf16_t*)(ws + NB_SREC) + (size_t)(b * 16 + hd) * 32 * 4096;
    const int cr = (tid & 255) >> 2, cc8 = (tid & 3) * 16;
    lds_barrier();
    if (isS) {
        SeqRegs r[4];
#pragma unroll
        for (int c = 0; c < 4; ++c) seq_load(rec0 + (size_t)c * CK_BYTES, wv, mt, lane, r[c]);
#pragma unroll
        for (int c = 0; c < 32; ++c) {
            const PG8_LAS bf16_t* S = (c & 1) ? SB1 : SB0;
            PG8_LAS bf16_t* Sn = (c & 1) ? SB0 : SB1;
            f32x16 acc;
#pragma unroll
            for (int i = 0; i < 16; ++i) { const unsigned w = r[c & 3].c[i >> 3][(i & 7) >> 1]; acc[i] = __uint_as_float((i & 1) ? (w & 0xffff0000u) : (w << 16)); }
#pragma unroll
            for (int s = 0; s < 4; ++s) {
                const bf16x8 bv = *(const PG8_LAS bf16x8*)(S + (nt * 32 + lr) * CS_LD + s * 16 + h * 8);
                acc = __builtin_amdgcn_mfma_f32_32x32x16_bf16(r[c & 3].a[s], bv, acc, 0, 0, 0);
            }
            st = acc; cs_store_t(st, Sn, mt, nt, lane);
            if (c + 4 < 32) seq_load(rec0 + (size_t)(c + 4) * CK_BYTES, wv, mt, lane, r[c & 3]);
            lds_barrier();
        }
    } else {
#pragma unroll 1
        for (int c = 0; c < 32; ++c) {
            const PG8_LAS bf16_t* S = (c & 1) ? SB1 : SB0;
            const u32x4 v0 = *(const PG8_LAS u32x4*)(S + cr * CS_LD + cc8), v1 = *(const PG8_LAS u32x4*)(S + cr * CS_LD + cc8 + 8);
            bf16_t* d = srec0 + (size_t)c * 4096 + cr * 64 + cc8;
            *(u32x4*)d = v0; *(u32x4*)(d + 8) = v1;
            lds_barrier();
        }
    }
    if (isS) {
        float* so = a.out + O_WKVP + ((size_t)(b * 16 + hd) * 64 + nt * 32 + lr) * 64 + mt * 32 + 4 * h;
#pragma unroll
        for (int cc = 0; cc < 4; ++cc) *(float4*)(so + 8 * cc) = make_float4(st[4 * cc], st[4 * cc + 1], st[4 * cc + 2], st[4 * cc + 3]);
    }
    lds_barrier();
}
struct YgRegs { bf16x8 a[4]; u32x4 c[2]; u32x4 s0, s1; u32x4 vw[2], zw[2]; float rk; };
__device__ __forceinline__ void yg_load(unsigned char* ws, int ci, int tid, YgRegs& r) {
    const int lane = tid & 63, wv = tid >> 6, t4 = tid & 255;
    const int mt = (wv >> 1) & 1;
    const unsigned char* rec = ws + NB_CHK + (size_t)ci * CK_BYTES;
    const bf16_t* ap = (const bf16_t*)(rec + CK_RY) + ((size_t)mt * 4 * 64 + lane) * 8;
    const bf16_t* cp = (const bf16_t*)(rec + CK_Y0) + ((size_t)(wv & 3) * 64 + lane) * 16;
#pragma unroll
    for (int s = 0; s < 4; ++s) r.a[s] = *(const bf16x8*)(ap + s * 64 * 8);
    r.c[0] = *(const u32x4*)cp; r.c[1] = *(const u32x4*)(cp + 8);
    const bf16_t* sp = (const bf16_t*)(ws + NB_SREC) + (size_t)ci * 4096 + (t4 >> 2) * 64 + (t4 & 3) * 16;
    r.s0 = *(const u32x4*)sp; r.s1 = *(const u32x4*)(sp + 8);
    const int bh = ci >> 5, c = ci & 31, b = bh >> 4, hd = bh & 15;
    const size_t prow = (size_t)b * TP + c * 64 + (t4 >> 2);
    const int pv = (t4 & 3) * 16;
    const bf16_t* vp = (const bf16_t*)(ws + NB_RKVZ) + ((size_t)2 * XSH_ROWS + prow) * 1024 + hd * 64 + pv;
    const bf16_t* zp = (const bf16_t*)(ws + NB_RKVZ) + ((size_t)3 * XSH_ROWS + prow) * 1024 + hd * 64 + pv;
    r.vw[0] = *(const u32x4*)vp; r.vw[1] = *(const u32x4*)(vp + 8); r.zw[0] = *(const u32x4*)zp; r.zw[1] = *(const u32x4*)(zp + 8);
    r.rk = ((const float*)(ws + NB_RKS))[prow * 16 + hd];
}
__device__ __forceinline__ void yg_step(const Args& a, unsigned char* ws, PG8_LAS unsigned char* lds, int ci, int tid, const YgRegs& r) {
    const int lane = tid & 63, wv = tid >> 6, t4 = tid & 255, grp = wv >> 2;
    const int lr = lane & 31, h = lane >> 5, mt = (wv >> 1) & 1, nt = wv & 1;
    PG8_LAS bf16_t* SL = cs_slot(lds, grp);
    PG8_LAS float* YT = (PG8_LAS float*)(lds + 2 * CS_SLOT) + grp * (64 * 68);
    *(PG8_LAS u32x4*)(SL + (t4 >> 2) * CS_LD + (t4 & 3) * 16) = r.s0; *(PG8_LAS u32x4*)(SL + (t4 >> 2) * CS_LD + (t4 & 3) * 16 + 8) = r.s1;
    lds_barrier();
    {
        f32x16 acc;
#pragma unroll
        for (int i = 0; i < 16; ++i) { const unsigned w = r.c[i >> 3][(i & 7) >> 1]; acc[i] = __uint_as_float((i & 1) ? (w & 0xffff0000u) : (w << 16)); }
#pragma unroll
        for (int s = 0; s < 4; ++s) {
            const bf16x8 bv = *(const PG8_LAS bf16x8*)(SL + (nt * 32 + lr) * CS_LD + s * 16 + h * 8);
            acc = __builtin_amdgcn_mfma_f32_32x32x16_bf16(r.a[s], bv, acc, 0, 0, 0);
        }
#pragma unroll
        for (int i = 0; i < 16; ++i) YT[(mt * 32 + (i & 3) + 8 * (i >> 2) + 4 * h) * 68 + nt * 32 + lr] = acc[i];
    }
    lds_barrier();
    {
        const int ptok = t4 >> 2, pv = (t4 & 3) * 16;
        const int bh = ci >> 5, c = ci & 31, b = bh >> 4, hd = bh & 15;
        float y[16];
#pragma unroll
        for (int q = 0; q < 4; ++q) { const f32x4 v = *(const PG8_LAS f32x4*)(YT + ptok * 68 + pv + q * 4); y[4 * q] = v[0]; y[4 * q + 1] = v[1]; y[4 * q + 2] = v[2]; y[4 * q + 3] = v[3]; }
        float sm = 0.f;
#pragma unroll
        for (int i = 0; i < 16; ++i) sm += y[i];
        sm += __builtin_bit_cast(float, __builtin_amdgcn_update_dpp(0, __builtin_bit_cast(int, sm), 0xB1, 0xF, 0xF, true));
        sm += __builtin_bit_cast(float, __builtin_amdgcn_update_dpp(0, __builtin_bit_cast(int, sm), 0x4E, 0xF, 0xF, true));
        const float mean = sm * (1.f / 64.f);
        float sq = 0.f;
#pragma unroll
        for (int i = 0; i < 16; ++i) { y[i] -= mean; sq += y[i] * y[i]; }
        sq += __builtin_bit_cast(float, __builtin_amdgcn_update_dpp(0, __builtin_bit_cast(int, sq), 0xB1, 0xF, 0xF, true));
        sq += __builtin_bit_cast(float, __builtin_amdgcn_update_dpp(0, __builtin_bit_cast(int, sq), 0x4E, 0xF, 0xF, true));
        const float rs = rsqrtf(sq * (1.f / 64.f) + GN_EPS);
        const float* gg = a.in[I_GNG] + hd * 64 + pv; const float* gb = a.in[I_GNB] + hd * 64 + pv;
        float o[16];
#pragma unroll
        for (int i = 0; i < 16; ++i) {
            const unsigned vw = r.vw[i >> 3][(i & 7) >> 1], zw = r.zw[i >> 3][(i & 7) >> 1];
            const float vf = __uint_as_float((i & 1) ? (vw & 0xffff0000u) : (vw << 16)), zf = __uint_as_float((i & 1) ? (zw & 0xffff0000u) : (zw << 16));
            o[i] = fmaf(r.rk, vf, y[i] * rs * gg[i] + gb[i]) * silu_f(zf);
        }
        bf16_t* dst = (bf16_t*)(ws + NB_G4B) + ((size_t)b * TP + c * 64 + ptok) * 1024 + hd * 64 + pv;
        u32x4 w0, w1;
        w0.x = pk_bf16c(o[0], o[1]); w0.y = pk_bf16c(o[2], o[3]); w0.z = pk_bf16c(o[4], o[5]); w0.w = pk_bf16c(o[6], o[7]);
        w1.x = pk_bf16c(o[8], o[9]); w1.y = pk_bf16c(o[10], o[11]); w1.z = pk_bf16c(o[12], o[13]); w1.w = pk_bf16c(o[14], o[15]);
        *(u32x4*)dst = w0; *(u32x4*)(dst + 8) = w1;
    }
}
__device__ __forceinline__ void phase_ygate(const Args& a, unsigned char* ws, PG8_LAS unsigned char* lds, int bid, int nb) {
    const int tid = opaque_v(threadIdx.x), grp = tid >> 8;
    YgRegs cur, nxt;
    int pair = bid;
    if (pair < 2048) yg_load(ws, 2 * pair + grp, tid, nxt);
#pragma unroll 1
    while (pair < 2048) {
        cur = nxt;
        const int npair = pair + nb;
        if (npair < 2048) yg_load(ws, 2 * npair + grp, tid, nxt);
        yg_step(a, ws, lds, 2 * pair + grp, tid, cur);
        pair = npair;
    }
    lds_barrier();
}

__device__ __forceinline__ void phase_lnf(const Args& a, unsigned char* ws, int bid, int nb) {
    const int tid = opaque_v(threadIdx.x), lane = tid & 63, wv = tid >> 6;
    const float* PRE = (const float*)ws + WS_PRE;
    const bf16_t* P2 = (const bf16_t*)(ws + NB_Y);
    float x[16], nx[16], y[16]; uint2 ny[4];
    int row = bid * 8 + wv;
    if (row < MT) { ld_row16(PRE + (size_t)row * 1024, lane, nx);
#pragma unroll
        for (int q = 0; q < 4; ++q) ny[q] = *(const uint2*)(P2 + (size_t)row * 1024 + q * 256 + lane * 4); }
#pragma unroll 1
    while (row < MT) {
#pragma unroll
        for (int i = 0; i < 16; ++i) x[i] = nx[i];
#pragma unroll
        for (int q = 0; q < 4; ++q) { y[4 * q] = __uint_as_float(ny[q].x << 16); y[4 * q + 1] = __uint_as_float(ny[q].x & 0xffff0000u); y[4 * q + 2] = __uint_as_float(ny[q].y << 16); y[4 * q + 3] = __uint_as_float(ny[q].y & 0xffff0000u); }
        const int nrow = row + nb * 8;
        if (nrow < MT) { ld_row16(PRE + (size_t)nrow * 1024, lane, nx);
#pragma unroll
            for (int q = 0; q < 4; ++q) ny[q] = *(const uint2*)(P2 + (size_t)nrow * 1024 + q * 256 + lane * 4); }
        ln_calc16(a.in[I_LNG], a.in[I_LNB], lane, x);
#pragma unroll
        for (int i = 0; i < 16; ++i) x[i] = fmaf(ALPHA, x[i], y[i]);
        ln_calc16(a.in[I_LNG] + 1024, a.in[I_LNB] + 1024, lane, x);
#if PROBE_TIME >= 0
        if (row >= MP) {
            const unsigned long long* tsp = (const unsigned long long*)(ws + NB_BAR + 16384);
            const float dt_us = (float)(__hip_atomic_load(tsp + PROBE_TIME + 1, __ATOMIC_RELAXED, __HIP_MEMORY_SCOPE_AGENT) - __hip_atomic_load(tsp + PROBE_TIME, __ATOMIC_RELAXED, __HIP_MEMORY_SCOPE_AGENT)) * 0.01f;
            const float f = 1.f + PROBE_K * dt_us;
#pragma unroll
            for (int i = 0; i < 16; ++i) x[i] *= f;
        }
#endif
        float* o = (row < MP ? a.out + O_Y + (size_t)row * 1024 : a.out + O_YS + (size_t)(row - MP) * 1024) + lane * 4;
#pragma unroll
        for (int q = 0; q < 4; ++q) *(float4*)(o + q * 256) = make_float4(x[4 * q], x[4 * q + 1], x[4 * q + 2], x[4 * q + 3]);
        row = nrow;
    }
}
__device__ __forceinline__ void sample_pool_copy(const Args& a, unsigned char* ws, int bid, int nb) {
    float* KCS = (float*)(ws + NB_KCS);
    const int* pt = (const int*)a.in[I_PT];
    const float* ccmp = a.in[I_CCMP];
#pragma unroll 2
    for (int i = bid * NTH + threadIdx.x; i < BS * 256 * 256; i += nb * NTH) {
        const int c = i & 255, n = (i >> 8) & 255, s = i >> 16;
        const int kv = c >> 7, g = (c >> 6) & 1;
        const float* w = kv ? a.in[I_WVC] : a.in[I_WKC];
        const int pos0 = n * 32;
        const float* src = ccmp + ((size_t)pt[s * NPAGE + (pos0 >> 7)] * PAGE + (pos0 & 127)) * 256 + c;
        float acc = 0.f;
#pragma unroll
        for (int l = 0; l < 32; ++l) acc = fmaf(src[(size_t)l * 256], w[l * 2 + g], acc);
        KCS[i] = acc;
    }
    const float4* cw = (const float4*)a.in[I_CWIN];
    float4* ow = (float4*)(a.out + O_WINS);
#pragma unroll 4
    for (int i = bid * NTH + threadIdx.x; i < BS * 511 * 64; i += nb * NTH) {
        const int s = i / (511 * 64), rem = i - s * (511 * 64);
        ow[(size_t)s * 512 * 64 + rem] = cw[(size_t)s * 512 * 64 + 64 + rem];
    }
}
__device__ __forceinline__ void sample_conv(const Args& a, unsigned char* ws, PG8_LAS unsigned char* lds, int s) {
    const int ch = opaque_v(threadIdx.x);
    const bf16_t* h = (const bf16_t*)(ws + NB_HB) + (size_t)(MP + s) * 2560;
    const float* sc = a.in[I_SCONV] + (size_t)s * 30 * 512 + ch;
    const float u = bf2f(h[ch]) * sigm_f(bf2f(h[512 + ch]));
    float scv[30], wj[31];
    const float* __restrict__ cwp = a.in[I_CONVW] + ch;
#pragma unroll
    for (int j = 0; j < 30; ++j) { scv[j] = sc[(size_t)j * 512]; wj[j] = cwp[j * 512]; }
    wj[30] = cwp[30 * 512];
    float acc = a.in[I_CONVB][ch];
#pragma unroll
    for (int j = 0; j < 30; ++j) acc = fmaf(wj[j], scv[j], acc);
    acc = fmaf(wj[30], u, acc);
    float* __restrict__ oc = a.out + O_CONVS + (size_t)s * 30 * 512 + ch;
#pragma unroll
    for (int i = 0; i < 29; ++i) oc[(size_t)i * 512] = scv[i + 1];
    oc[(size_t)29 * 512] = u;
    PG8_LAS float* red = (PG8_LAS float*)lds;
    const int lane = ch & 63, wv = ch >> 6;
    float sm = wave_sum(acc);
    __syncthreads();
    if (lane == 0) red[wv] = sm;
    __syncthreads();
    float tot = 0.f;
#pragma unroll
    for (int i = 0; i < 8; ++i) tot += red[i];
    const float mean = tot * (1.f / 512.f);
    const float d = acc - mean;
    float sq = wave_sum(d * d);
    __syncthreads();
    if (lane == 0) red[wv] = sq;
    __syncthreads();
    tot = 0.f;
#pragma unroll
    for (int i = 0; i < 8; ++i) tot += red[i];
    const float rs = rsqrtf(tot * (1.f / 512.f) + LN_EPS);
    const float y = silu_f(d * rs * a.in[I_CLNG][ch] + a.in[I_CLNB][ch]) * silu_f(bf2f(h[1024 + ch]));
    ((bf16_t*)(ws + NB_CATB))[(size_t)(MP + s) * 1024 + ch] = (bf16_t)(pk_bf16(y, 0.f) & 0xffffu);
    __syncthreads();
}

constexpr int SP_STRIDE = 66;
__device__ __forceinline__ void sample_attn(const Args& a, unsigned char* ws, PG8_LAS unsigned char* lds, int s, int g, int part) {
    const int tid = opaque_v(threadIdx.x), lane = tid & 63, wv = __builtin_amdgcn_readfirstlane(tid >> 6);
    PG8_LAS float* PC = (PG8_LAS float*)lds;
    PG8_LAS float* IMP = (PG8_LAS float*)(lds + 4096);
    PG8_LAS int* SEL = (PG8_LAS int*)(lds + 4096 + 1024);
    PG8_LAS int* FLG = (PG8_LAS int*)(lds + 4096 + 1024 + 128);
    PG8_LAS float* PS = (PG8_LAS float*)(lds + 8192) + (tid >> 6) * 64;
    const int r = wv & 3, hh = g * 4 + r;
    const float slope = __builtin_amdgcn_exp2f(-(float)(hh + 1));
    const int* pt = (const int*)a.in[I_PT] + s * NPAGE;
    const bf16_t* hrow = (const bf16_t*)(ws + NB_HB) + (size_t)(MP + s) * 2560;
    float q[64];
#pragma unroll
    for (int d8 = 0; d8 < 8; ++d8) { const u32x4 w = *(const u32x4*)(hrow + 1536 + hh * 64 + d8 * 8);
#pragma unroll
        for (int i = 0; i < 4; ++i) { q[d8 * 8 + 2 * i] = __uint_as_float(w[i] << 16); q[d8 * 8 + 2 * i + 1] = __uint_as_float(w[i] & 0xffff0000u); } }
#define SAMP_DOT(KPTR, OUT) { const float4* k4_ = (const float4*)(KPTR); float4 kk_[16]; \
        _Pragma("unroll") for (int i_ = 0; i_ < 16; ++i_) kk_[i_] = k4_[i_]; float s_ = 0.f; \
        _Pragma("unroll") for (int i_ = 0; i_ < 16; ++i_) { s_ = fmaf(q[4 * i_], kk_[i_].x, s_); s_ = fmaf(q[4 * i_ + 1], kk_[i_].y, s_); s_ = fmaf(q[4 * i_ + 2], kk_[i_].z, s_); s_ = fmaf(q[4 * i_ + 3], kk_[i_].w, s_); } OUT = s_; }
    if (wv < 4) {
        const float* kc = (const float*)(ws + NB_KCS) + (size_t)s * 256 * 256 + g * 64;
        float sc[4];
        float mx = -INFINITY;
#pragma unroll
        for (int i = 0; i < 4; ++i) { const int n = lane + 64 * i; float d; SAMP_DOT(kc + (size_t)n * 256, d); sc[i] = d - slope * (float)(PAST - (32 * n + 31)); mx = fmaxf(mx, sc[i]); }
#pragma unroll
        for (int o = 32; o > 0; o >>= 1) mx = fmaxf(mx, __shfl_xor(mx, o));
        float ls = 0.f;
#pragma unroll
        for (int i = 0; i < 4; ++i) { sc[i] = __expf(sc[i] - mx); ls += sc[i]; }
        ls = wave_sum(ls);
        const float inv = 1.f / ls;
#pragma unroll
        for (int i = 0; i < 4; ++i) PC[r * 256 + lane + 64 * i] = sc[i] * inv;
    }
    __syncthreads();
    if (wv < 4 && part == 0) {
        const float* vc = (const float*)(ws + NB_KCS) + (size_t)s * 256 * 256 + 128 + g * 64 + lane;
        float oc0 = 0.f, oc1 = 0.f, oc2 = 0.f, oc3 = 0.f;
#pragma unroll 8
        for (int n = 0; n < 256; n += 4) {
            oc0 = fmaf(PC[r * 256 + n], vc[(size_t)n * 256], oc0); oc1 = fmaf(PC[r * 256 + n + 1], vc[(size_t)(n + 1) * 256], oc1);
            oc2 = fmaf(PC[r * 256 + n + 2], vc[(size_t)(n + 2) * 256], oc2); oc3 = fmaf(PC[r * 256 + n + 3], vc[(size_t)(n + 3) * 256], oc3);
        }
        ((float*)(ws + NB_OCS))[(size_t)(s * 8 + hh) * 64 + lane] = (oc0 + oc1) + (oc2 + oc3);
    }
    if (tid < 129) {
        float v = 0.f;
        if (tid < 128) { for (int rr = 0; rr < 4; ++rr) v += PC[rr * 256 + 2 * tid] + PC[rr * 256 + 2 * tid + 1]; }
        if (tid == 0 || tid >= 127) v = 1e4f;
        IMP[tid] = v;
    }
    __syncthreads();
    if (tid < 129) {
        const float vj = IMP[tid];
        int rank = 0;
        for (int i = 0; i < 129; ++i) { const float vi = IMP[i]; rank += (vi > vj || (vi == vj && i < tid)) ? 1 : 0; }
        FLG[tid] = (rank < 16) ? 1 : 0;
    }
    __syncthreads();
    if (tid < 129 && FLG[tid]) { int slot = 0; for (int i = 0; i < tid; ++i) slot += FLG[i]; SEL[slot] = tid; }
    __syncthreads();
    const float* csel = a.in[I_CSEL];
    const float* newsel = a.out + O_SELS + (size_t)s * 256;
    const float* cwin = a.in[I_CWIN] + (size_t)s * 512 * 256;
    const float* newwin = a.out + O_WINS + (size_t)(s * 512 + 511) * 256;
#pragma unroll 1
    for (int it = 0; it < 3; ++it) {
        const int lb = (wv >> 2) + 2 * it;
        const bool is_sel = lb < 4;
        const int slot = is_sel ? part * 4 + lb : part * 2 + (lb - 4);
        const float* rowp; const float* vb; int vstride_last; float dist; bool valid; int nk;
        if (is_sel) {
            const int blk = SEL[slot];
            const int kpos = blk * 64 + lane;
            valid = kpos <= PAST;
            rowp = (blk < 128) ? csel + ((size_t)pt[blk >> 1] * PAGE + (kpos & 127)) * 256 : newsel;
            vb = (blk < 128) ? csel + ((size_t)pt[blk >> 1] * PAGE + ((blk * 64) & 127)) * 256 + 128 + g * 64 + lane : newsel + 128 + g * 64 + lane;
            nk = (blk < 128) ? 64 : 1; dist = (float)(PAST - kpos); vstride_last = 0;
        } else {
            const int i0 = 1 + slot * 64;
            const int i = i0 + lane;
            valid = true; nk = 64;
            rowp = (i < 512) ? cwin + (size_t)i * 256 : newwin;
            vb = cwin + (size_t)i0 * 256 + 128 + g * 64 + lane;
            dist = (float)(512 - i); vstride_last = (slot == 7) ? 1 : 0;
        }
        float sc = -INFINITY;
        if (valid) { float d; SAMP_DOT(rowp + g * 64, d); sc = d - slope * dist; }
        float mx = sc;
#pragma unroll
        for (int of = 32; of > 0; of >>= 1) mx = fmaxf(mx, __shfl_xor(mx, of));
        const float p = valid ? __expf(sc - mx) : 0.f;
        const float l = wave_sum(p);
        PS[lane] = p; __builtin_amdgcn_wave_barrier();
        float o0 = 0.f, o1 = 0.f, o2 = 0.f, o3 = 0.f;
        if (nk == 64) {
            float vv[64];
#pragma unroll
            for (int k = 0; k < 63; ++k) vv[k] = vb[(size_t)k * 256];
            vv[63] = vstride_last ? newwin[128 + g * 64 + lane] : vb[(size_t)63 * 256];
#pragma unroll
            for (int k = 0; k < 64; k += 4) { o0 = fmaf(PS[k], vv[k], o0); o1 = fmaf(PS[k + 1], vv[k + 1], o1); o2 = fmaf(PS[k + 2], vv[k + 2], o2); o3 = fmaf(PS[k + 3], vv[k + 3], o3); }
        } else o0 = PS[0] * vb[0];
        __builtin_amdgcn_wave_barrier();
        float* pp = (float*)(ws + NB_PARTS) + ((size_t)((s * 8 + hh) * 24 + (is_sel ? slot : 16 + slot))) * SP_STRIDE;
        pp[2 + lane] = (o0 + o1) + (o2 + o3);
        if (lane == 0) { pp[0] = mx; pp[1] = l; }
    }
#undef SAMP_DOT
    __syncthreads();
}
__device__ __forceinline__ void sample_combine(const Args& a, unsigned char* ws, int s, int g) {
    const int tid = opaque_v(threadIdx.x), lane = tid & 63, wv = __builtin_amdgcn_readfirstlane(tid >> 6);
    if (wv >= 4) return;
    const int hh = g * 4 + wv;
    const float* pp = (const float*)(ws + NB_PARTS) + (size_t)(s * 8 + hh) * 24 * SP_STRIDE;
    const float* g3p = (const float*)(ws + NB_G3) + (size_t)(MP + s) * 32 + hh * 3;
    const float gc = sigm_f(g3p[0]), gs = sigm_f(g3p[1]), gw = sigm_f(g3p[2]);
    float res = gc * ((const float*)(ws + NB_OCS))[(size_t)(s * 8 + hh) * 64 + lane];
#pragma unroll
    for (int br = 0; br < 2; ++br) {
        const int n0 = br ? 16 : 0, cnt = br ? 8 : 16;
        float M = -INFINITY;
        for (int i = 0; i < cnt; ++i) M = fmaxf(M, pp[(size_t)(n0 + i) * SP_STRIDE]);
        float L = 0.f, O = 0.f;
        for (int i = 0; i < cnt; ++i) { const float* q = pp + (size_t)(n0 + i) * SP_STRIDE; const float w = __expf(q[0] - M); L = fmaf(q[1], w, L); O = fmaf(q[2 + lane], w, O); }
        res = fmaf(br ? gw : gs, O / L, res);
    }
    const bf16_t* hrow = (const bf16_t*)(ws + NB_HB) + (size_t)(MP + s) * 2560;
    const float y = res * silu_f(bf2f(hrow[2048 + hh * 64 + lane]));
    ((bf16_t*)(ws + NB_CATB))[(size_t)(MP + s) * 1024 + 512 + hh * 64 + lane] = (bf16_t)(pk_bf16(y, 0.f) & 0xffffu);
}

static_assert(CS_END <= LDS_MISC, "chunk-scan LDS map overlaps the barrier words");
enum { PH_PREP = 0, PH_GEMM1, PH_CONV, PH_ATTN, PH_GEMM2, PH_LNS, PH_GEMM3, PH_PREP2, PH_SCAN, PH_POST, PH_GEMM4, PH_LNF, NPHASE };

__global__ void __launch_bounds__(NTH, 2) mega(Args a) {
    extern __shared__ __attribute__((aligned(16))) unsigned char lds_raw[];
    PG8_LAS unsigned char* lds = (PG8_LAS unsigned char*)lds_raw;
    unsigned char* ws = a.ws;
    volatile LAS unsigned* misc = (volatile LAS unsigned*)(lds + LDS_MISC);
    if (threadIdx.x < 4) misc[threadIdx.x] = 0u;
    __syncthreads();
    XcdBarrier bar = xcd_barrier_post((unsigned*)(ws + NB_BAR), misc);
    const int lo = a.ph_lo, hi = a.ph_hi;
#ifndef DUP_SATTN
#define DUP_SATTN 0
#endif
#ifndef DUP_CONV
#define DUP_CONV 0
#endif
#ifndef DUP_GEMM1
#define DUP_GEMM1 0
#endif
#ifndef SKIPMASK
#define SKIPMASK 0
#endif
#define IN(k) (lo <= (k) && (k) < hi && !((SKIPMASK >> (k)) & 1))
#ifndef REPMASK
#define REPMASK 0
#endif
#define REPS(k) _Pragma("unroll 1") for (int rep_ = 0; rep_ < (((REPMASK >> (k)) & 1) ? 2 : 1); ++rep_)
#if PROBE_TIME >= 0
    unsigned long long* const tstamp = (unsigned long long*)(ws + NB_BAR + 16384);
#define STAMP(i) do { if (blockIdx.x == 0 && threadIdx.x == 0) __hip_atomic_store(tstamp + (i), (unsigned long long)__builtin_amdgcn_s_memrealtime(), __ATOMIC_RELAXED, __HIP_MEMORY_SCOPE_AGENT); } while (0)
#else
#define STAMP(i) do { } while (0)
#endif
#define SEAM(k) do { if (IN(k) && IN((k) + 1)) xcd_barrier(bar); STAMP((k) + 1); } while (0)
    STAMP(0);
    if (IN(PH_PREP)) REPS(PH_PREP) {
        const int bid = opaque(blockIdx.x), nb = gridDim.x;
        convert_wt(a.in[I_WIN], 1024, DIN, (bf16_t*)(ws + NB_WT1), N1PAD, MapWin{}, bid, nb);
        convert_wt(a.in[I_WOUTE], 1024, 1024, (bf16_t*)(ws + NB_WT2), 1024, MapId{}, bid, nb);
        for (int n = 0; n < 4; ++n) convert_wt(a.in[I_WRKVZ] + (size_t)n * 1024 * 1024, 1024, 1024, (bf16_t*)(ws + NB_WT3) + (size_t)n * 1024 * 1024, 1024, MapId{}, bid, nb);
        convert_wt(a.in[I_WOUTO], 1024, 1024, (bf16_t*)(ws + NB_WT4), 1024, MapId{}, bid, nb);
        convert_wt(a.in[I_W1], 1024, 64, (bf16_t*)(ws + NB_W1T), 64, MapId{}, bid, nb);
        convert_wt(a.in[I_A1], 1024, 64, (bf16_t*)(ws + NB_A1T), 64, MapId{}, bid, nb);
        convert_wt(a.in[I_W2], 64, 1024, (bf16_t*)(ws + NB_W2T), 1024, MapId{}, bid, nb);
        convert_wt(a.in[I_A2], 64, 1024, (bf16_t*)(ws + NB_A2T), 1024, MapId{}, bid, nb);
        convert_rows(a.in[I_XP], (size_t)MP * 1024 / 8, (bf16_t*)(ws + NB_XB), bid, nb);
        convert_rows(a.in[I_XS], (size_t)BS * 1024 / 8, (bf16_t*)(ws + NB_XSB), bid, nb);
        sample_pool_copy(a, ws, bid, nb);
    }
    SEAM(PH_PREP);
    if (IN(PH_GEMM1)) REPS(PH_GEMM1) {
        const int bid = opaque(blockIdx.x), nb = gridDim.x;
        const Route1 R{(bf16_t*)(ws + NB_HB), (bf16_t*)(ws + NB_KVB), (float*)(ws + NB_G3), a.out};
        {
            pg8::Gemm g{(const bf16_t*)(ws + NB_XB), (const bf16_t*)(ws + NB_WT1), MP, N1PAD, 1024};
            pg8::StaticOrder S; S.init(MP, N1PAD, nb, bid);
            Epi1 E{R};
            pg8::gemm_phase<Epi1, pg8::StaticOrder, false>(lds, g, S, E, nullptr);
#if DUP_GEMM1
            __syncthreads();
            pg8::gemm_phase<Epi1, pg8::StaticOrder, false>(lds, g, S, E, nullptr);
#endif
        }
        {
            for (int task = bid; task < 105; task += nb) {
                sample_gemm32_wg((const bf16_t*)(ws + NB_XSB), (const bf16_t*)(ws + NB_WT1), 1024, task * 32, lds,
                    [&](int r, int n, float v) {
                        const int row = MP + r;
                        if (n < 2560) { const float sc = (n >= 1536 && n < 2048) ? 0.125f : 1.0f; ((bf16_t*)(ws + NB_HB))[(size_t)row * 2560 + n] = (bf16_t)(pk_bf16c(v * sc, 0.f) & 0xffffu); }
                        else if (n < 3328) { const int c = n - 2560, i3 = c >> 8, cc = c & 255; ((bf16_t*)(ws + NB_KVB))[(size_t)row * 768 + c] = (bf16_t)(pk_bf16c(v, 0.f) & 0xffffu);
                            float* dst = (i3 == 0) ? a.out + O_CMPS + (size_t)r * 256 + cc : (i3 == 1) ? a.out + O_SELS + (size_t)r * 256 + cc : a.out + O_WINS + (size_t)(r * 512 + 511) * 256 + cc;
                            *dst = v; }
                        else if (n < 3352) ((float*)(ws + NB_G3))[(size_t)row * 32 + (n - 3328)] = v;
                    });
            }
        }
    }
    SEAM(PH_GEMM1);
    if (IN(PH_CONV)) REPS(PH_CONV) {
        const int bid = opaque(blockIdx.x), nb = gridDim.x;
#pragma unroll 1
        for (int item = bid; item < 512; item += nb) conv_item(a, ws, lds, item);
        pool_prompt(a, ws, bid, nb);
        sample_attn(a, ws, lds, bid >> 3, (bid >> 2) & 1, bid & 3);
#if DUP_SATTN
        __syncthreads();
        sample_attn(a, ws, lds, bid >> 3, (bid >> 2) & 1, bid & 3);
#endif
        if (bid >= 96 && bid < 128) sample_conv(a, ws, lds, bid - 96);
    }
    SEAM(PH_CONV);
    if (IN(PH_ATTN)) REPS(PH_ATTN) {
        const int bid = opaque(blockIdx.x), nb = gridDim.x;
        if (bid < 64) sample_combine(a, ws, bid >> 1, bid & 1);
        for (int pr = bid; pr < 256; pr += nb) {
            const int b = pr >> 5, g = (pr >> 4) & 1, xq = pr & 15;
#pragma unroll 1
            for (int k = 0; k < 2; ++k) attn_item(a, ws, lds, b, g, k ? xq : 31 - xq);
        }
    }
    SEAM(PH_ATTN);
    if (IN(PH_GEMM2)) REPS(PH_GEMM2) {
        const int bid = opaque(blockIdx.x), nb = gridDim.x;
        {
            pg8::Gemm g{(const bf16_t*)(ws + NB_CATB), (const bf16_t*)(ws + NB_WT2), MP, 1024, 1024};
            pg8::StaticOrder S; S.init(MP, 1024, nb, bid);
            EpiPreRes E{(float*)ws + WS_PRE, a.in[I_XP]};
            pg8::gemm_phase<EpiPreRes, pg8::StaticOrder, false>(lds, g, S, E, nullptr);
        }
        {
            const int lane = threadIdx.x & 63, wv = __builtin_amdgcn_readfirstlane(threadIdx.x >> 6);
            float* PREs = (float*)ws + WS_PRE + (size_t)MP * 1024;
            const float* xs = a.in[I_XS];
            for (int task = bid; task < 32; task += nb)
                sample_gemm32_wg((const bf16_t*)(ws + NB_CATB) + (size_t)MP * 1024, (const bf16_t*)(ws + NB_WT2), 1024, task * 32, lds,
                              [&](int r, int n, float v) { PREs[(size_t)r * 1024 + n] = fmaf(ALPHA, xs[(size_t)r * 1024 + n], v); });
        }
    }
    SEAM(PH_GEMM2);
    if (IN(PH_LNS)) REPS(PH_LNS) { const int bid = opaque(blockIdx.x), nb = gridDim.x; phase_lns(a, ws, bid, nb); }
    SEAM(PH_LNS);
    if (IN(PH_GEMM3)) REPS(PH_GEMM3) {
        const int bid = opaque(blockIdx.x), nb = gridDim.x;
        {
            pg8::Gemm g{(const bf16_t*)(ws + NB_XSH), (const bf16_t*)(ws + NB_WT3), MP, 4096, 1024};
            Order3 S; S.init(nb, bid);
            Epi3 E{(bf16_t*)(ws + NB_RKVZ)};
            pg8::gemm_phase<Epi3, Order3, false>(lds, g, S, E, nullptr);
        }
        {
            const int lane = threadIdx.x & 63, wv = __builtin_amdgcn_readfirstlane(threadIdx.x >> 6);
            for (int task = bid; task < 128; task += nb) {
                const int n = task >> 5, n0 = (task & 31) * 32;
                bf16_t* dst = (bf16_t*)(ws + NB_RKVZ) + ((size_t)n * XSH_ROWS + MP) * 1024;
                sample_gemm32_wg((const bf16_t*)(ws + NB_XSH) + ((size_t)n * XSH_ROWS + MP) * 1024, (const bf16_t*)(ws + NB_WT3) + (size_t)n * 1024 * 1024, 1024, n0, lds,
                              [&](int r, int c, float v) { dst[(size_t)r * 1024 + c] = (bf16_t)(pk_bf16c(v, 0.f) & 0xffffu); });
            }
            {
                const int tidl = opaque_v(threadIdx.x);
                LoraRegs lcur, lnxt;
                int task = bid;
                if (task < 1026) lora_load(ws, task, tidl, lnxt);
#pragma unroll 1
                while (task < 1026) {
                    lcur = lnxt;
                    const int ntask = task + nb;
                    if (ntask < 1026) lora_load(ws, ntask, tidl, lnxt);
                    lora_tile(ws, lds, task, tidl, lcur);
                    task = ntask;
                }
            }
        }
    }
    SEAM(PH_GEMM3);
    if (IN(PH_PREP2)) REPS(PH_PREP2) {
        const int bid = opaque(blockIdx.x), nb = gridDim.x;
        for (int pr = bid; pr < 256; pr += nb) {
            const int bh = pr >> 1, b = bh >> 4, hd = bh & 15, c0 = (pr & 1) * 16;
            const int tidp = opaque_v(threadIdx.x), lanep = tidp & 63, wvp = tidp >> 6;
            bf16x8 btf[4];
            { const int which = wvp >> 2, nt = wvp & 1;
              const bf16_t* Bt = (const bf16_t*)(ws + (which ? NB_A2T : NB_W2T)) + (size_t)(hd * 64 + nt * 32 + (lanep & 31)) * 64 + (lanep >> 5) * 8;
#pragma unroll
              for (int s4 = 0; s4 < 4; ++s4) btf[s4] = *(const bf16x8*)(Bt + s4 * 16); }
            PreRegs pcur, pnxt;
            scanpre_load(ws, b, hd, c0, tidp, pnxt);
#pragma unroll 1
            for (int cc = 0; cc < 16; ++cc) {
                pcur = pnxt;
                if (cc + 1 < 16) scanpre_load(ws, b, hd, c0 + cc + 1, tidp, pnxt);
                scanpre_chunk(a, ws, lds, b, hd, c0 + cc, pcur, btf);
            }
        }
    }
    SEAM(PH_PREP2);
    if (IN(PH_SCAN)) REPS(PH_SCAN) {
        const int bid = opaque(blockIdx.x), nb = gridDim.x;
#pragma unroll 1
        for (int item = bid; item < 128; item += nb) scanseq_head(a, ws, lds, item >> 4, item & 15);
        const int lane = opaque_v(threadIdx.x) & 63, wv = __builtin_amdgcn_readfirstlane(threadIdx.x >> 6);
        for (int task = (nb - 1 - bid) * 8 + wv; task < BS * 16; task += nb * 8) scan_sample(a, ws, task >> 4, task & 15, lane);
    }
    SEAM(PH_SCAN);
    if (IN(PH_POST)) REPS(PH_POST) { const int bid = opaque(blockIdx.x), nb = gridDim.x; phase_ygate(a, ws, lds, bid, nb); }
    SEAM(PH_POST);
    if (IN(PH_GEMM4)) REPS(PH_GEMM4) {
        const int bid = opaque(blockIdx.x), nb = gridDim.x;
        {
            pg8::Gemm g{(const bf16_t*)(ws + NB_G4B), (const bf16_t*)(ws + NB_WT4), MP, 1024, 1024};
            pg8::StaticOrder S; S.init(MP, 1024, nb, bid);
            EpiPreB E{(bf16_t*)(ws + NB_Y)};
            pg8::gemm_phase<EpiPreB, pg8::StaticOrder, false>(lds, g, S, E, nullptr);
        }
        {
            bf16_t* PREs = (bf16_t*)(ws + NB_Y) + (size_t)MP * 1024;
            for (int task = bid; task < 32; task += nb)
                sample_gemm32_wg((const bf16_t*)(ws + NB_G4B) + (size_t)MP * 1024, (const bf16_t*)(ws + NB_WT4), 1024, task * 32, lds,
                              [&](int r, int n, float v) { PREs[(size_t)r * 1024 + n] = (bf16_t)(pk_bf16c(v, 0.f) & 0xffffu); });
        }
    }
    SEAM(PH_GEMM4);
    if (IN(PH_LNF)) REPS(PH_LNF) { const int bid = opaque(blockIdx.x), nb = gridDim.x; phase_lnf(a, ws, bid, nb); }
#undef IN
#undef SEAM
}
}

extern "C" void kernel_launch(void* const* d_in, const int* in_sizes, int n_in, void* d_out, int out_size, void* d_ws, size_t ws_size,
                              hipStream_t stream) {
    if (n_in != N_IN || ws_size < nk::NB_END) { fprintf(stderr, "kernel_launch: unexpected n_in %d or ws_size %zu (need %zu)\n", n_in, ws_size, (size_t)nk::NB_END); return; }
    static int grid = 0;
    if (!grid) {
        int dev = 0, cus = 0, per_cu = 0;
        hipGetDevice(&dev);
        hipDeviceGetAttribute(&cus, hipDeviceAttributeMultiprocessorCount, dev);
        hipFuncSetAttribute((const void*)nk::mega, hipFuncAttributeMaxDynamicSharedMemorySize, nk::LDS_BYTES);
        hipOccupancyMaxActiveBlocksPerMultiprocessor(&per_cu, (const void*)nk::mega, nk::NTH, nk::LDS_BYTES);
        if (per_cu < 1) fprintf(stderr, "kernel_launch: occupancy query says %d blocks per CU\n", per_cu);
        grid = cus;
    }
    hipMemsetAsync((unsigned char*)d_ws + nk::NB_BAR, 0, 32768, stream);
    nk::Args a{};
    for (int i = 0; i < N_IN; ++i) a.in[i] = (const float*)d_in[i];
    a.out = (float*)d_out; a.ws = (unsigned char*)d_ws; a.ph_lo = 0; a.ph_hi = nk::NPHASE;
    void* args[] = {&a};
    hipError_t e = hipLaunchCooperativeKernel((const void*)nk::mega, dim3(grid), dim3(nk::NTH), args, nk::LDS_BYTES, stream);
    if (e != hipSuccess) fprintf(stderr, "cooperative launch failed: %s (grid %d)\n", hipGetErrorString(e), grid);
}
```

```cpp
#include <hip/hip_runtime.h>
#include <hip/hip_cooperative_groups.h>
#include <cstdio>
namespace cg = cooperative_groups;
#ifndef PROBE_TIME
#define PROBE_TIME -1
#endif
#ifndef PROBE_K
#define PROBE_K 1e-4f
#endif

constexpr int D = 1024, BP = 8, TP = 2048, MP = BP * TP, BS = 32, MT = MP + BS;
constexpr int DIN = 3352;
constexpr int C_AVAL = 0, C_AGLU = 512, C_ZA = 1024, C_Q = 1536, C_KV = 2048, C_G3 = 2816, C_ZB = 2840;
constexpr int C_CMP = C_KV, C_SEL = C_KV + 256, C_WIN = C_KV + 512;
constexpr int PAST = 8192, NPAGE = 64, PAGE = 128;
constexpr float ALPHA = 1.4142135623730951f;
constexpr float LN_EPS = 1e-5f, GN_EPS = 64e-5f;

constexpr size_t O_Y = 0, O_YS = 16777216, O_CMPP = 16809984, O_CMPS = 21004288, O_SELP = 21012480, O_SELS = 25206784,
                 O_WINP = 25214976, O_WINS = 26263552, O_CONVP = 30457856, O_CONVS = 30580736, O_WKVP = 31072256,
                 O_WKVS = 31596544, O_SHP = 33693696, O_SHS = 33701888;

enum { I_XP = 0, I_XS, I_CCMP, I_CSEL, I_CWIN, I_SCONV, I_SWKV, I_SSHIFT, I_PT, I_WIN, I_CONVW, I_CONVB, I_CLNG, I_CLNB,
       I_WKC, I_WVC, I_WOUTE, I_MU, I_WRKVZ, I_W0, I_W1, I_W2, I_A0, I_A1, I_A2, I_KK, I_KA, I_RK, I_GNG, I_GNB, I_WOUTO,
       I_LNG, I_LNB, N_IN };

constexpr size_t SZ_ROWD = (size_t)MT * D;
constexpr size_t WS_H = 0;
constexpr size_t WS_CAT = WS_H + (size_t)MT * DIN;
constexpr size_t WS_OC = WS_CAT + SZ_ROWD;
constexpr size_t WS_XSH = 0;
constexpr size_t WS_Y = 0;
constexpr size_t WS_G4 = SZ_ROWD;
constexpr size_t WS_R0END = 6 * SZ_ROWD;
constexpr size_t WS_PRE = WS_R0END;
constexpr size_t WS_X1 = WS_PRE + SZ_ROWD;
constexpr size_t WS_R = WS_X1 + SZ_ROWD;
constexpr size_t WS_K = WS_R + SZ_ROWD;
constexpr size_t WS_V = WS_K + SZ_ROWD;
constexpr size_t WS_Z = WS_V + SZ_ROWD;
constexpr size_t WS_DEC = WS_Z + SZ_ROWD;
constexpr size_t WS_KKN = WS_DEC + SZ_ROWD;
constexpr size_t WS_KKA = WS_KKN + SZ_ROWD;
constexpr size_t WS_TW = WS_KKA + SZ_ROWD;
constexpr size_t WS_AW = WS_TW + (size_t)MT * 64;
constexpr size_t WS_RK = WS_AW + (size_t)MT * 64;
constexpr size_t WS_END = WS_RK + (size_t)MT * 16;
constexpr size_t WS_PCP = WS_R;
constexpr size_t WS_PCS = WS_R + (size_t)MP * 8 * 64;
constexpr size_t WS_IMP = WS_K;
constexpr size_t WS_SELIDX = WS_V;
constexpr size_t WS_KCP = WS_Z;
constexpr size_t WS_KCS = WS_Z + (size_t)8 * 64 * 256;
static_assert(WS_OC + (size_t)MT * 512 <= WS_R0END, "layer0 temporaries overflow region 0");

namespace pg8 {
#define PG8_LAS __attribute__((address_space(3)))
typedef unsigned short bf16_t;
typedef short bf16x8 __attribute__((ext_vector_type(8)));
typedef float f32x4 __attribute__((ext_vector_type(4)));
typedef unsigned u32x4 __attribute__((ext_vector_type(4)));
constexpr int BM = 256, BK = 64, HALF = 128, HTB = HALF * BK * 2  , STAGE_BYTES = 8 * HTB, NXCD = 8, WGM = 8;

__host__ __device__ __forceinline__ int lds_byte(int r, int c) { const int st = (r >> 4) * 2 + (c >> 5), rr = r & 15, cc = c & 31, ob = rr * 64 + cc * 2; return st * 1024 + (ob ^ (((ob >> 9) & 1) << 5)); }
__host__ __device__ __forceinline__ void stage_rc(int b, int& R, int& C) { const int st = b / 1024, sb = b % 1024, swz = sb ^ (((sb >> 9) & 1) << 5); R = (st >> 1) * 16 + swz / 64; C = (st & 1) * 32 + (swz % 64) / 2; }
__host__ __device__ __forceinline__ int perm32(int rho) { const int n = rho >> 4, i = rho & 15; return 8 * (i >> 2) + 4 * n + (i & 3); }

struct Unit { int pm, pn; };
struct Gemm { const bf16_t* A; const bf16_t* Bt; int M, N, K; };

struct StaticOrder {
    int nM, nN, nwg, G, c;
    __host__ __device__ void init(int M, int N, int G_, int c_) { nM = M / BM; nN = N / BM; nwg = nM * nN; G = G_; c = c_; }
    __host__ __device__ bool next(int i, Unit& u) const {
        const long L = (long)i * G + c; if (L >= nwg) return false;
        int wgid = (int)L; { const int q = nwg / NXCD, r = nwg % NXCD, xcd = wgid % NXCD, off = wgid / NXCD; wgid = (xcd < r ? xcd * (q + 1) : r * (q + 1) + (xcd - r) * q) + off; }
        const int nig = WGM * nN, gid = wgid / nig, fm = gid * WGM, gsz = (nM - fm) < WGM ? (nM - fm) : WGM;
        u.pm = fm + ((wgid % nig) % gsz); u.pn = (wgid % nig) / gsz; return true;
    }
    __device__ __forceinline__ void a_ready(const Unit&) const {}
    __device__ __forceinline__ void done(const Unit&) const {}
};
struct CountedOrder : StaticOrder {
    const unsigned* ready; unsigned need; unsigned* tmo;
    __device__ __forceinline__ void a_ready(const Unit& u) const {
        if (threadIdx.x < 64) {
            const unsigned long long t0 = __builtin_amdgcn_s_memrealtime(); unsigned polls = 0;
            while ((unsigned)__builtin_amdgcn_readfirstlane(__hip_atomic_load(ready + 64 * u.pm, __ATOMIC_RELAXED, __HIP_MEMORY_SCOPE_AGENT)) < need) {
                if ((++polls & 255u) == 0u && __builtin_amdgcn_readfirstlane(__hip_atomic_load(tmo, __ATOMIC_RELAXED, __HIP_MEMORY_SCOPE_AGENT)) != 0u) break;
                if (__builtin_amdgcn_s_memrealtime() - t0 > 2000000ull) {
                    if (threadIdx.x == 0) { unsigned expect = 0u; __hip_atomic_compare_exchange_strong(tmo + 1, &expect, 0x600u | (unsigned)(u.pm & 0xff), __ATOMIC_RELAXED, __ATOMIC_RELAXED, __HIP_MEMORY_SCOPE_AGENT); __hip_atomic_store(tmo, 1u, __ATOMIC_RELAXED, __HIP_MEMORY_SCOPE_AGENT); }
                    break; }
                __builtin_amdgcn_s_sleep(2); }
            __builtin_amdgcn_fence(__ATOMIC_ACQUIRE, "agent");
            asm volatile("s_waitcnt vmcnt(0)" ::: "memory");
        }
#if !defined(BROKEN_HOOK_NO_BARRIER)
        asm volatile("" ::: "memory"); __builtin_amdgcn_s_barrier(); asm volatile("" ::: "memory");
#endif
    }
};


template <class Epi, class Sched, bool STAMP = false>
__device__ __forceinline__ void gemm_phase(PG8_LAS unsigned char* lds, const Gemm g, const Sched& S, const Epi& E, unsigned long long* stamps) {
    int tid_ = threadIdx.x; asm volatile("" : "+v"(tid_));
    const int tid = tid_, wid = __builtin_amdgcn_readfirstlane(tid >> 6), lane = tid & 63, wr = wid >> 2, wc = wid & 3, fr = lane & 15, fq = lane >> 4;
    const int K = g.K, nt = K / BK;
    int ts_lo = 0, ts_hi = 0, nts = 0; const unsigned long long rt_entry = STAMP ? (unsigned long long)wall_clock64() : 0ull;
#define PG8_STAMP() do { if (STAMP && wid == 0 && nts < 64) { const unsigned long long _c = (unsigned long long)clock64(); \
        ts_lo = (lane == nts) ? (int)(unsigned)_c : ts_lo; ts_hi = (lane == nts) ? (int)(unsigned)(_c >> 32) : ts_hi; ++nts; } } while (0)
    PG8_STAMP();
    unsigned voffA[2], voffB[2];
#pragma unroll
    for (int i = 0; i < 2; ++i) { int R, C; stage_rc(tid * 16 + i * 8192, R, C); const int Rb = Epi::PERM ? ((R & ~31) + perm32(R & 31)) : R;
        voffA[i] = (unsigned)(R * K + C) * 2u; voffB[i] = (unsigned)(Rb * K + C) * 2u; }
    const size_t kstep = (size_t)(BK * 2);
    const size_t hstep = (size_t)HALF * K * 2;
    const size_t tstep = 2 * hstep;
    const unsigned ldsw = (unsigned)wid * 1024u;
    const int aoff = lds_byte(wr * 64 + fr, fq * 8), boff = lds_byte(wc * 32 + fr, fq * 8);
#define PG8_SA(b, h) (((b) * 2 + (h)) * HTB)
#define PG8_SB(b, h) ((4 + (b) * 2 + (h)) * HTB)
#define PG8_STAGE(bufoff, gbase, voff) do { _Pragma("unroll") for (int _i = 0; _i < 2; ++_i) \
        __builtin_amdgcn_global_load_lds((const unsigned*)((const char*)(gbase) + (voff)[_i]), (PG8_LAS unsigned*)(lds + (bufoff) + ldsw + _i * 8192), 16, 0, 0); } while (0)
#define PG8_LDA(dst, b, h) do { _Pragma("unroll") for (int m = 0; m < 4; ++m) _Pragma("unroll") for (int k = 0; k < 2; ++k) dst[m][k] = *(const PG8_LAS bf16x8*)(lds + PG8_SA(b, h) + aoff + m * 2048 + k * 1024); } while (0)
#define PG8_LDB(dst, b, h) do { _Pragma("unroll") for (int n = 0; n < 2; ++n) _Pragma("unroll") for (int k = 0; k < 2; ++k) dst[n][k] = *(const PG8_LAS bf16x8*)(lds + PG8_SB(b, h) + boff + n * 2048 + k * 1024); } while (0)
#define PG8_MMA(ai, bj, At, Bt) do { __builtin_amdgcn_s_setprio(1); _Pragma("unroll") for (int m = 0; m < 4; ++m) _Pragma("unroll") for (int n = 0; n < 2; ++n) _Pragma("unroll") for (int k = 0; k < 2; ++k) \
        acc[ai][bj][m][n] = __builtin_amdgcn_mfma_f32_16x16x32_bf16(Bt[n][k], At[m][k], acc[ai][bj][m][n], 0, 0, 0); __builtin_amdgcn_s_setprio(0); } while (0)
#define PG8_WAIT_V(n) asm volatile("s_waitcnt vmcnt(" #n ")" ::: "memory")
#define PG8_WAIT_L(n) asm volatile("s_waitcnt lgkmcnt(" #n ")" ::: "memory")
#define PG8_BAR __builtin_amdgcn_s_barrier()
#define PG8_SCHED __builtin_amdgcn_sched_barrier(0)
    Unit cur, nxt; int ui = 0;
    if (!S.next(0, cur)) return;
    f32x4 acc[2][2][4][2];
#pragma unroll
    for (int a = 0; a < 2; ++a)
#pragma unroll
        for (int b = 0; b < 2; ++b)
#pragma unroll
            for (int m = 0; m < 4; ++m)
#pragma unroll
                for (int n = 0; n < 2; ++n) acc[a][b][m][n] = (f32x4){0.f, 0.f, 0.f, 0.f};
    bf16x8 At[4][2], B0[2][2], B1[2][2];
    const char* cA = (const char*)g.A + (size_t)cur.pm * tstep; const char* cB = (const char*)g.Bt + (size_t)cur.pn * tstep;
    S.a_ready(cur);
    PG8_STAGE(PG8_SB(0, 0), cB, voffB); PG8_STAGE(PG8_SA(0, 0), cA, voffA); PG8_STAGE(PG8_SB(0, 1), cB + hstep, voffB); PG8_STAGE(PG8_SA(0, 1), cA + hstep, voffA);
    if (wr == 1) PG8_BAR;
    PG8_WAIT_V(4); PG8_BAR;
    PG8_STAGE(PG8_SB(1, 0), cB + kstep, voffB); PG8_STAGE(PG8_SA(1, 0), cA + kstep, voffA); PG8_STAGE(PG8_SB(1, 1), cB + hstep + kstep, voffB);
    PG8_WAIT_V(6); PG8_BAR;
    PG8_STAMP();
    for (;;) {
        const bool has_next = S.next(ui + 1, nxt);
        const char* nA = has_next ? (const char*)g.A + (size_t)nxt.pm * tstep : cA; const char* nB = has_next ? (const char*)g.Bt + (size_t)nxt.pn * tstep : cB;
        for (int t = 0; t < nt; t += 2) {
            const bool last = (t == nt - 2);
            const char* a1 = cA + (size_t)(t + 1) * kstep;
            const char* a2 = last ? nA : cA + (size_t)(t + 2) * kstep; const char* b2 = last ? nB : cB + (size_t)(t + 2) * kstep;
            const char* a3 = a2 + kstep; const char* b3 = b2 + kstep;
            if (last && has_next) S.a_ready(nxt);
            PG8_LDB(B0, 0, 0); PG8_SCHED; PG8_LDA(At, 0, 0); PG8_STAGE(PG8_SA(1, 1), a1 + hstep, voffA);
            PG8_WAIT_L(8); PG8_BAR; PG8_WAIT_L(0); PG8_MMA(0, 0, At, B0); PG8_BAR; PG8_SCHED;
            PG8_LDB(B1, 0, 1); PG8_STAGE(PG8_SB(0, 0), b2, voffB);
            PG8_BAR; PG8_WAIT_L(0); PG8_MMA(0, 1, At, B1); PG8_BAR;
            PG8_LDA(At, 0, 1); PG8_STAGE(PG8_SA(0, 0), a2, voffA);
            PG8_BAR; PG8_WAIT_L(0); PG8_MMA(1, 0, At, B0); PG8_BAR; PG8_SCHED;
            PG8_STAGE(PG8_SB(0, 1), b2 + hstep, voffB);
            PG8_WAIT_V(6); PG8_BAR; PG8_MMA(1, 1, At, B1); PG8_BAR;
            PG8_LDB(B0, 1, 0); PG8_SCHED; PG8_LDA(At, 1, 0); PG8_STAGE(PG8_SA(0, 1), a2 + hstep, voffA);
            PG8_WAIT_L(8); PG8_BAR; PG8_WAIT_L(0); PG8_MMA(0, 0, At, B0); PG8_BAR; PG8_SCHED;
            PG8_LDB(B1, 1, 1); PG8_STAGE(PG8_SB(1, 0), b3, voffB);
            PG8_BAR; PG8_WAIT_L(0); PG8_MMA(0, 1, At, B1); PG8_BAR;
            PG8_LDA(At, 1, 1); PG8_STAGE(PG8_SA(1, 0), a3, voffA);
            PG8_BAR; PG8_WAIT_L(0); PG8_MMA(1, 0, At, B0); PG8_BAR; PG8_SCHED;
            PG8_STAGE(PG8_SB(1, 1), b3 + hstep, voffB);
            PG8_WAIT_V(6); PG8_BAR; PG8_MMA(1, 1, At, B1); PG8_BAR;
        }
        PG8_STAMP();
        if constexpr (!Epi::AFTER_DRAIN) { E(acc, cur, wr, wc, fr, fq); S.done(cur); }
        PG8_STAMP();
        if (!has_next) break;
#pragma unroll
        for (int a = 0; a < 2; ++a)
#pragma unroll
            for (int b = 0; b < 2; ++b)
#pragma unroll
                for (int m = 0; m < 4; ++m)
#pragma unroll
                    for (int n = 0; n < 2; ++n) acc[a][b][m][n] = (f32x4){0.f, 0.f, 0.f, 0.f};
        cur = nxt; cA = nA; cB = nB; ++ui;
    }
    PG8_WAIT_V(0);
    if (wr == 0) PG8_BAR;
    PG8_BAR;
    if constexpr (Epi::AFTER_DRAIN) { E.fused(acc, cur, wr, wc, fr, fq, lds, wid, lane); S.done(cur); }
    PG8_STAMP();
    if (STAMP && wid == 0) { stamps[lane] = lane < nts ? (((unsigned long long)(unsigned)ts_hi << 32) | (unsigned)ts_lo) : 0ull;
        if (lane == 62) stamps[62] = rt_entry; if (lane == 63) stamps[63] = (unsigned long long)wall_clock64(); }
#undef PG8_STAMP
#undef PG8_SA
#undef PG8_SB
#undef PG8_STAGE
#undef PG8_LDA
#undef PG8_LDB
#undef PG8_MMA
#undef PG8_WAIT_V
#undef PG8_WAIT_L
#undef PG8_BAR
#undef PG8_SCHED
}
}

#define XB_TMO      128
#define XB_XCNT(j)  (256  + 64 * (j))
#define XB_XSUB(j)  (1280 + 64 * (j))
#define XB_XGEN(j)  (2304 + 64 * (j))
#define XB_TOP      3328
#define XB_TOPGEN   3392
#define XCD_BAR_WORDS 3456
#define XB_SPIN_CAP (1u << 18)
#define LAS __attribute__((address_space(3)))

__device__ __forceinline__ unsigned xb_ld(unsigned* p)              { return __hip_atomic_load(p, __ATOMIC_RELAXED, __HIP_MEMORY_SCOPE_AGENT); }
__device__ __forceinline__ unsigned xb_add(unsigned* p, unsigned v) { return __hip_atomic_fetch_add(p, v, __ATOMIC_RELAXED, __HIP_MEMORY_SCOPE_AGENT); }
__device__ __forceinline__ unsigned xb_xcc_id() { return (unsigned)__builtin_amdgcn_s_getreg((3 << 11) | 20) & 0xFu; }
#define XB_SPIN(cond, bar) do { unsigned _sp = 0; while (cond) { __builtin_amdgcn_s_sleep(1); \
    if ((++_sp & 255u) == 0u) { if (xb_ld(&(bar)[XB_TMO])) break; if (_sp > XB_SPIN_CAP) { atomicAdd(&(bar)[XB_TMO], 1u); break; } } } } while (0)

struct XcdBarrier {
    unsigned* bar; unsigned x;
    volatile LAS unsigned* st;
};

__device__ __forceinline__ XcdBarrier xcd_barrier_post(unsigned* bar, volatile LAS unsigned* st) {
    XcdBarrier b; b.bar = bar; b.x = xb_xcc_id(); b.st = st;
    if (threadIdx.x == 0) (void)xb_add(&bar[XB_XCNT(b.x)], 1u);
    return b;
}
__device__ __forceinline__ void xcd_barrier_complete(unsigned* bar, unsigned x, unsigned& nloc, unsigned& nx) {
    const unsigned G = gridDim.x * gridDim.y * gridDim.z;
    unsigned sum, cnt, mine, sp = 0u;
    for (;;) {
        sum = 0u; cnt = 0u; mine = 0u;
#pragma unroll
        for (unsigned j = 0; j < 16; ++j) { const unsigned c = xb_ld(&bar[XB_XCNT(j)]); sum += c; cnt += (c > 0u) ? 1u : 0u; mine = (j == x) ? c : mine; }
        if (sum == G) break;
        __builtin_amdgcn_s_sleep(1);
        if ((++sp & 255u) == 0u) { if (xb_ld(&bar[XB_TMO])) break; if (sp > XB_SPIN_CAP) { atomicAdd(&bar[XB_TMO], 1u); break; } }
    }
    nloc = mine > 0u ? mine : 1u; nx = cnt > 0u ? cnt : 1u;
}

__device__ __forceinline__ void xcd_barrier(const XcdBarrier& b) {
    asm volatile("s_waitcnt vmcnt(0)" ::: "memory");
    __syncthreads();
    if (threadIdx.x == 0) {
        unsigned* bar = b.bar;
        __builtin_amdgcn_s_waitcnt(0);
        unsigned nloc = b.st[0], nx = b.st[1];
        if (nloc == 0u) { xcd_barrier_complete(bar, b.x, nloc, nx); b.st[0] = nloc; b.st[1] = nx; }
        const unsigned old = xb_add(&bar[XB_XSUB(b.x)], 1u);
        const unsigned gen = old / nloc;
        if (old + 1u == (gen + 1u) * nloc) {
            __builtin_amdgcn_fence(__ATOMIC_RELEASE, "agent");
            asm volatile("s_waitcnt vmcnt(0)" ::: "memory");
            const unsigned og = xb_add(&bar[XB_TOP], 1u);
            const unsigned tg = og / nx;
            if (og + 1u == (tg + 1u) * nx) xb_add(&bar[XB_TOPGEN], 1u);
            else XB_SPIN(xb_ld(&bar[XB_TOPGEN]) == tg, bar);
            __builtin_amdgcn_fence(__ATOMIC_ACQUIRE, "agent");
            xb_add(&bar[XB_XGEN(b.x)], 1u);
            asm volatile("s_waitcnt vmcnt(0)" ::: "memory");
        } else {
            XB_SPIN(xb_ld(&bar[XB_XGEN(b.x)]) == gen, bar);
            __builtin_amdgcn_fence(__ATOMIC_ACQUIRE, "agent");
            asm volatile("s_waitcnt vmcnt(0)" ::: "memory");
        }
    }
    __syncthreads();
}

namespace nk {
using pg8::bf16_t; using pg8::bf16x8; using pg8::f32x4; using pg8::u32x4; using pg8::Unit;
constexpr int NTH = 512;
constexpr int LDS_STAGE = pg8::STAGE_BYTES;
constexpr int LDS_MISC = 158720;
constexpr int LDS_BYTES = LDS_MISC + 1024;

constexpr size_t NB0 = WS_END * 4;
constexpr size_t NB_BAR = NB0;
constexpr size_t NB_WT1 = NB_BAR + 32768;
constexpr size_t NB_WT2 = NB_WT1 + (size_t)3584 * 1024 * 2;
constexpr size_t NB_XB = NB_WT2 + (size_t)1024 * 1024 * 2;
constexpr size_t NB_XSB = NB_XB + (size_t)MP * 1024 * 2;
constexpr size_t NB_HB = NB_XSB + (size_t)BS * 1024 * 2;
constexpr size_t NB_KVB = NB_HB + (size_t)MT * 2560 * 2;
constexpr size_t NB_G3 = NB_KVB + (size_t)MT * 768 * 2;
constexpr size_t NB_CATB = NB_G3 + (size_t)MT * 32 * 4;
constexpr size_t NB_CBUF = NB_CATB + (size_t)MT * 1024 * 2;
constexpr size_t NB_KCB = NB_CBUF + (size_t)MP * 512 * 4;
constexpr size_t NB_WT3 = NB_KCB + (size_t)BP * 64 * 256 * 2;
constexpr size_t NB_WT4 = NB_WT3 + (size_t)4 * 1024 * 1024 * 2;
constexpr size_t NB_W1T = NB_WT4 + (size_t)1024 * 1024 * 2;
constexpr size_t NB_A1T = NB_W1T + (size_t)64 * 1024 * 2;
constexpr size_t NB_W2T = NB_A1T + (size_t)64 * 1024 * 2;
constexpr size_t NB_A2T = NB_W2T + (size_t)64 * 1024 * 2;
constexpr size_t NB_KCS = NB_A2T + (size_t)64 * 1024 * 2;
constexpr size_t NB_OCS = NB_KCS + (size_t)BS * 256 * 256 * 4;
constexpr size_t NB_PARTS = NB_OCS + (size_t)BS * 8 * 64 * 4;
constexpr size_t NB_END = NB_PARTS + (size_t)BS * 8 * 24 * 66 * 4;
constexpr size_t NB_XSH = 0;
constexpr size_t NB_RKVZ = NB_XSH + (size_t)6 * 16640 * 1024 * 2;
constexpr size_t NB_TWB = NB_RKVZ + (size_t)4 * 16640 * 1024 * 2;
constexpr size_t NB_AWB = NB_TWB + (size_t)MT * 64 * 2;
constexpr size_t NB_RKS = NB_AWB + (size_t)MT * 64 * 2;
static_assert(NB_RKS + (size_t)MT * 16 * 4 <= WS_PRE * 4, "layer-1 region A overflows into PRE");
constexpr size_t NB_DEC = (WS_X1 + SZ_ROWD) * 4;
constexpr size_t NB_KKN = NB_DEC + (size_t)MT * 1024 * 4;
constexpr size_t NB_KKA = NB_KKN + (size_t)MT * 1024 * 2;
constexpr size_t NB_KP = NB_KKA + (size_t)MT * 1024 * 2;
constexpr size_t NB_Y = NB_KP + (size_t)MT * 1024 * 2;
constexpr size_t NB_G4B = NB_Y + (size_t)MT * 1024 * 4;
constexpr size_t NB_CHK = NB_G4B + (size_t)MT * 1024 * 2;
constexpr size_t NB_SREC = NB_CHK + (size_t)4096 * 32768;
static_assert(NB_SREC + (size_t)4096 * 8192 <= NB0, "layer-1 region B overflows");
constexpr int N1PAD = 3584;
__host__ __device__ __forceinline__ int win_src_col(int n) { return n < 2048 ? n : (n < 2560 ? C_ZB + (n - 2048) : (n < 3328 ? C_KV + (n - 2560) : (n < 3352 ? C_G3 + (n - 3328) : -1))); }

__device__ __forceinline__ int opaque(int x) { asm volatile("" : "+s"(x)); return x; }
__device__ __forceinline__ void lds_barrier() { asm volatile("s_waitcnt lgkmcnt(0)" ::: "memory"); __builtin_amdgcn_s_barrier(); asm volatile("" ::: "memory"); }
__device__ __forceinline__ int opaque_v(int x) { asm volatile("" : "+v"(x)); return x; }
struct Args { const float* in[N_IN]; float* out; unsigned char* ws; int ph_lo, ph_hi; };

__device__ __forceinline__ unsigned pk_bf16(float lo, float hi) { unsigned r; asm volatile("v_cvt_pk_bf16_f32 %0, %1, %2" : "=v"(r) : "v"(lo), "v"(hi)); return r; }
typedef __bf16 bf16x2_t __attribute__((ext_vector_type(2)));
__device__ __forceinline__ unsigned pk_bf16c(float lo, float hi) { bf16x2_t v; v[0] = (__bf16)lo; v[1] = (__bf16)hi; return __builtin_bit_cast(unsigned, v); }

template <class MAP>
__device__ __forceinline__ void convert_wt(const float* __restrict__ W, int K, int ldw, bf16_t* __restrict__ Wt, int Npad, MAP map, int bid, int nb) {
    const int kg = K / 8;
    const size_t total = (size_t)Npad * kg;
    for (size_t i = (size_t)bid * NTH + threadIdx.x; i < total; i += (size_t)nb * NTH) {
        const int n = (int)(i % Npad), k0 = (int)(i / Npad) * 8;
        const int sc = map(n);
        u32x4 w = {0u, 0u, 0u, 0u};
        if (sc >= 0) {
            float v[8];
#pragma unroll
            for (int j = 0; j < 8; ++j) v[j] = W[(size_t)(k0 + j) * ldw + sc];
            w.x = pk_bf16(v[0], v[1]); w.y = pk_bf16(v[2], v[3]); w.z = pk_bf16(v[4], v[5]); w.w = pk_bf16(v[6], v[7]);
        }
        *(u32x4*)(Wt + (size_t)n * K + k0) = w;
    }
}
struct MapId { __device__ __forceinline__ int operator()(int n) const { return n; } };
struct MapWin { __device__ __forceinline__ int operator()(int n) const { return win_src_col(n); } };
__device__ __forceinline__ void convert_wfrag(const float* __restrict__ W, bf16_t* __restrict__ Wf, int bid, int nb) {
    for (int i = bid * NTH + threadIdx.x; i < 64 * 128; i += nb * NTH) {
        const int n = i & 63, k0 = (i >> 6) * 8;
        float v[8];
#pragma unroll
        for (int j = 0; j < 8; ++j) v[j] = W[(size_t)(k0 + j) * 64 + n];
        u32x4 w; w.x = pk_bf16(v[0], v[1]); w.y = pk_bf16(v[2], v[3]); w.z = pk_bf16(v[4], v[5]); w.w = pk_bf16(v[6], v[7]);
        *(u32x4*)(Wf + ((size_t)((n >> 5) * 64 + (k0 >> 4)) * 64 + ((k0 >> 3) & 1) * 32 + (n & 31)) * 8) = w;
    }
}
__device__ __forceinline__ void convert_rows(const float* __restrict__ src, size_t n8, bf16_t* __restrict__ dst, int bid, int nb) {
#pragma unroll 4
    for (size_t i = (size_t)bid * NTH + threadIdx.x; i < n8; i += (size_t)nb * NTH) {
        const float4 a = *(const float4*)(src + i * 8), b = *(const float4*)(src + i * 8 + 4);
        u32x4 w; w.x = pk_bf16(a.x, a.y); w.y = pk_bf16(a.z, a.w); w.z = pk_bf16(b.x, b.y); w.w = pk_bf16(b.z, b.w);
        *(u32x4*)(dst + i * 8) = w;
    }
}

struct EpiPre {
    static constexpr bool PERM = false, AFTER_DRAIN = false;
    float* C; int ldc;
    __device__ __forceinline__ void operator()(const f32x4 (&acc)[2][2][4][2], const Unit& u, int wr, int wc, int fr, int fq) const {
        const int row0 = u.pm * 256 + wr * 64 + fr, col0 = u.pn * 256 + wc * 32 + 4 * fq;
#pragma unroll
        for (int ai = 0; ai < 2; ++ai)
#pragma unroll
            for (int m = 0; m < 4; ++m) { float* rowp = C + (size_t)(row0 + ai * 128 + m * 16) * ldc + col0;
#pragma unroll
                for (int bj = 0; bj < 2; ++bj)
#pragma unroll
                    for (int n = 0; n < 2; ++n) *(f32x4*)(rowp + bj * 128 + n * 16) = acc[ai][bj][m][n]; }
    }
};


struct EpiPreB {
    static constexpr bool PERM = true, AFTER_DRAIN = false;
    bf16_t* O;
    __device__ __forceinline__ void operator()(const f32x4 (&acc)[2][2][4][2], const Unit& u, int wr, int wc, int fr, int fq) const {
        const int row0 = u.pm * 256 + wr * 64 + fr, col0 = u.pn * 256 + wc * 32 + 8 * fq;
#pragma unroll
        for (int ai = 0; ai < 2; ++ai)
#pragma unroll
            for (int m = 0; m < 4; ++m) { bf16_t* rowp = O + (size_t)(row0 + ai * 128 + m * 16) * 1024 + col0;
#pragma unroll
                for (int bj = 0; bj < 2; ++bj) { const f32x4 v0 = acc[ai][bj][m][0], v1 = acc[ai][bj][m][1];
                    u32x4 w; w.x = pk_bf16c(v0[0], v0[1]); w.y = pk_bf16c(v0[2], v0[3]); w.z = pk_bf16c(v1[0], v1[1]); w.w = pk_bf16c(v1[2], v1[3]);
                    *(u32x4*)(rowp + bj * 128) = w; } }
    }
};


struct Route1 {
    bf16_t* HB; bf16_t* KVB; float* G3; float* out;
    __device__ __forceinline__ void put8(int row, int n0, const f32x4& v0, const f32x4& v1) const {
        if (n0 < 2560) {
            const float sc = (n0 >= 1536 && n0 < 2048) ? 0.125f : 1.0f;
            u32x4 w; w.x = pk_bf16c(v0[0] * sc, v0[1] * sc); w.y = pk_bf16c(v0[2] * sc, v0[3] * sc); w.z = pk_bf16c(v1[0] * sc, v1[1] * sc); w.w = pk_bf16c(v1[2] * sc, v1[3] * sc);
            *(u32x4*)(HB + (size_t)row * 2560 + n0) = w;
        } else if (n0 < 3328) {
            const int c = n0 - 2560, i3 = c >> 8, cc = c & 255;
            u32x4 w; w.x = pk_bf16c(v0[0], v0[1]); w.y = pk_bf16c(v0[2], v0[3]); w.z = pk_bf16c(v1[0], v1[1]); w.w = pk_bf16c(v1[2], v1[3]);
            *(u32x4*)(KVB + (size_t)row * 768 + c) = w;
            float* dst = nullptr;
            if (row < MP) {
                if (i3 == 0) dst = out + O_CMPP + (size_t)row * 256 + cc;
                else if (i3 == 1) dst = out + O_SELP + (size_t)row * 256 + cc;
                else { const int b = row >> 11, t = row & 2047; if (t >= TP - 512) dst = out + O_WINP + (size_t)(b * 512 + t - (TP - 512)) * 256 + cc; }
            } else {
                const int sidx = row - MP;
                if (i3 == 0) dst = out + O_CMPS + (size_t)sidx * 256 + cc;
                else if (i3 == 1) dst = out + O_SELS + (size_t)sidx * 256 + cc;
                else dst = out + O_WINS + (size_t)(sidx * 512 + 511) * 256 + cc;
            }
            if (dst) { *(f32x4*)dst = v0; *(f32x4*)(dst + 4) = v1; }
        } else if (n0 < 3352) {
            float* dst = G3 + (size_t)row * 32 + (n0 - 3328);
            *(f32x4*)dst = v0; *(f32x4*)(dst + 4) = v1;
        }
    }
};
struct Epi1 {
    static constexpr bool PERM = true, AFTER_DRAIN = false;
    Route1 R;
    __device__ __forceinline__ void operator()(const f32x4 (&acc)[2][2][4][2], const Unit& u, int wr, int wc, int fr, int fq) const {
        const int row0 = u.pm * 256 + wr * 64 + fr, col0 = u.pn * 256 + wc * 32 + 8 * fq;
#pragma unroll
        for (int ai = 0; ai < 2; ++ai)
#pragma unroll
            for (int m = 0; m < 4; ++m)
#pragma unroll
                for (int bj = 0; bj < 2; ++bj) R.put8(row0 + ai * 128 + m * 16, col0 + bj * 128, acc[ai][bj][m][0], acc[ai][bj][m][1]);
    }
};

typedef float f32x16 __attribute__((ext_vector_type(16)));
template <class EMIT>
__device__ __forceinline__ void sample_gemm32(const bf16_t* __restrict__ A, const bf16_t* __restrict__ Bt, int K, int n0, int lane, EMIT emit) {
    const bf16_t* ap = A + (size_t)(lane & 31) * K + 8 * (lane >> 5);
    const bf16_t* bp = Bt + (size_t)(n0 + (lane & 31)) * K + 8 * (lane >> 5);
    f32x16 acc;
#pragma unroll
    for (int i = 0; i < 16; ++i) acc[i] = 0.f;
#pragma unroll 16
    for (int k = 0; k < K; k += 16) {
        const bf16x8 av = *(const bf16x8*)(ap + k), bv = *(const bf16x8*)(bp + k);
        acc = __builtin_amdgcn_mfma_f32_32x32x16_bf16(av, bv, acc, 0, 0, 0);
    }
#pragma unroll
    for (int r = 0; r < 16; ++r) emit((r & 3) + 8 * (r >> 2) + 4 * (lane >> 5), n0 + (lane & 31), acc[r]);
}

template <class EMIT>
__device__ __forceinline__ void sample_gemm32_wg(const bf16_t* __restrict__ A, const bf16_t* __restrict__ Bt, int K, int n0, PG8_LAS unsigned char* lds, EMIT emit) {
    const int tid = opaque_v(threadIdx.x), lane = tid & 63, wv = tid >> 6;
    const int kq = K / 8;
    const bf16_t* ap = A + (size_t)(lane & 31) * K + 8 * (lane >> 5) + wv * kq;
    const bf16_t* bp = Bt + (size_t)(n0 + (lane & 31)) * K + 8 * (lane >> 5) + wv * kq;
    f32x16 acc;
#pragma unroll
    for (int i = 0; i < 16; ++i) acc[i] = 0.f;
#pragma unroll 8
    for (int k = 0; k < kq; k += 16) {
        const bf16x8 av = *(const bf16x8*)(ap + k), bv = *(const bf16x8*)(bp + k);
        acc = __builtin_amdgcn_mfma_f32_32x32x16_bf16(av, bv, acc, 0, 0, 0);
    }
    PG8_LAS float* P = (PG8_LAS float*)lds;
#pragma unroll
    for (int q = 0; q < 4; ++q) *(PG8_LAS f32x4*)(P + (wv * 64 + lane) * 16 + q * 4) = (f32x4){acc[4 * q], acc[4 * q + 1], acc[4 * q + 2], acc[4 * q + 3]};
    __syncthreads();
    if (wv == 0) {
#pragma unroll
        for (int w = 1; w < 8; ++w)
#pragma unroll
            for (int q = 0; q < 4; ++q) { const f32x4 v = *(const PG8_LAS f32x4*)(P + (w * 64 + lane) * 16 + q * 4); acc[4 * q] += v[0]; acc[4 * q + 1] += v[1]; acc[4 * q + 2] += v[2]; acc[4 * q + 3] += v[3]; }
#pragma unroll
        for (int r = 0; r < 16; ++r) emit((r & 3) + 8 * (r >> 2) + 4 * (lane >> 5), n0 + (lane & 31), acc[r]);
    }
    __syncthreads();
}

typedef float f32x16 __attribute__((ext_vector_type(16)));
__device__ __forceinline__ float bf2f(bf16_t v) { return __uint_as_float((unsigned)v << 16); }
__device__ __forceinline__ float sigm_f(float x) { return 1.f / (1.f + __expf(-x)); }
__device__ __forceinline__ float silu_f(float x) { return x / (1.f + __expf(-x)); }

__device__ __forceinline__ float wsum64(float v) {
    v += __builtin_bit_cast(float, __builtin_amdgcn_update_dpp(0, __builtin_bit_cast(int, v), 0xB1, 0xF, 0xF, true));
    v += __builtin_bit_cast(float, __builtin_amdgcn_update_dpp(0, __builtin_bit_cast(int, v), 0x4E, 0xF, 0xF, true));
    v += __builtin_bit_cast(float, __builtin_amdgcn_update_dpp(0, __builtin_bit_cast(int, v), 0x141, 0xF, 0xF, true));
    v += __builtin_bit_cast(float, __builtin_amdgcn_update_dpp(0, __builtin_bit_cast(int, v), 0x140, 0xF, 0xF, true));
    v += __shfl_xor(v, 16); v += __shfl_xor(v, 32);
    return v;
}
constexpr int CV_U = 0;
constexpr int CV_C = 65536;
__device__ __forceinline__ void conv_item(const Args& a, unsigned char* ws, PG8_LAS unsigned char* lds, int item) {
    const int tid = opaque_v(threadIdx.x);
    const int b = item >> 6, t0 = (item & 63) * 32;
    const bf16_t* HB = (const bf16_t*)(ws + NB_HB);
    PG8_LAS float* U = (PG8_LAS float*)(lds + CV_U);
    PG8_LAS float* C = (PG8_LAS float*)(lds + CV_C);
    const int chl = tid & 255, tp = tid >> 8;
    const int lane = tid & 63, wv = tid >> 6;
    u32x4 zv[4];
#pragma unroll
    for (int k = 0; k < 4; ++k) zv[k] = *(const u32x4*)(HB + (size_t)(b * TP + t0 + wv * 4 + k) * 2560 + 1024 + lane * 8);
#pragma unroll 1
    for (int half = 0; half < 2; ++half) {
        const int chb = half * 256;
#pragma unroll
        for (int it = 0; it < 4; ++it) {
            const int vi = tid + it * NTH;
            if (vi < 62 * 32) {
                const int r = vi >> 5, c8 = (vi & 31) * 8, t = t0 - 30 + r;
                float u[8];
                if (t >= 0) {
                    const bf16_t* h = HB + (size_t)(b * TP + t) * 2560 + chb + c8;
                    const u32x4 av = *(const u32x4*)h, gv = *(const u32x4*)(h + 512);
#pragma unroll
                    for (int i = 0; i < 8; ++i) {
                        const float x = __uint_as_float((i & 1) ? (av[i >> 1] & 0xffff0000u) : (av[i >> 1] << 16));
                        const float g = __uint_as_float((i & 1) ? (gv[i >> 1] & 0xffff0000u) : (gv[i >> 1] << 16));
                        u[i] = x * sigm_f(g);
                    }
                } else {
#pragma unroll
                    for (int i = 0; i < 8; ++i) u[i] = 0.f;
                }
                *(PG8_LAS f32x4*)(U + r * 256 + c8) = (f32x4){u[0], u[1], u[2], u[3]};
                *(PG8_LAS f32x4*)(U + r * 256 + c8 + 4) = (f32x4){u[4], u[5], u[6], u[7]};
                if (t >= TP - 30 && r >= 30) {
                    float* o = a.out + O_CONVP + (size_t)(b * 30 + t - (TP - 30)) * 512 + chb + c8;
                    *(float4*)o = make_float4(u[0], u[1], u[2], u[3]); *(float4*)(o + 4) = make_float4(u[4], u[5], u[6], u[7]);
                }
            }
        }
        __syncthreads();
        {
            const int ch = chb + chl;
            float w[31], uw[46], acc[16];
#pragma unroll
            for (int j = 0; j < 31; ++j) w[j] = a.in[I_CONVW][j * 512 + ch];
            const float bias = a.in[I_CONVB][ch];
#pragma unroll
            for (int r = 0; r < 46; ++r) uw[r] = U[(tp * 16 + r) * 256 + chl];
#pragma unroll
            for (int k = 0; k < 16; ++k) {
                float s_ = bias;
#pragma unroll
                for (int j = 0; j < 31; ++j) s_ = fmaf(w[j], uw[k + j], s_);
                acc[k] = s_;
            }
#pragma unroll
            for (int k = 0; k < 16; ++k) C[(tp * 16 + k) * 516 + ch] = acc[k];
        }
        __syncthreads();
    }
    {
        const float4 g0 = *(const float4*)(a.in[I_CLNG] + lane * 8), g1 = *(const float4*)(a.in[I_CLNG] + lane * 8 + 4);
        const float4 b0 = *(const float4*)(a.in[I_CLNB] + lane * 8), b1 = *(const float4*)(a.in[I_CLNB] + lane * 8 + 4);
        const float gg[8] = {g0.x, g0.y, g0.z, g0.w, g1.x, g1.y, g1.z, g1.w}, bb[8] = {b0.x, b0.y, b0.z, b0.w, b1.x, b1.y, b1.z, b1.w};
#pragma unroll
        for (int k = 0; k < 4; ++k) {
            const int tl = wv * 4 + k;
            const size_t row = (size_t)(b * TP + t0 + tl);
            const f32x4 c0 = *(const PG8_LAS f32x4*)(C + tl * 516 + lane * 8), c1 = *(const PG8_LAS f32x4*)(C + tl * 516 + lane * 8 + 4);
            float c[8] = {c0[0], c0[1], c0[2], c0[3], c1[0], c1[1], c1[2], c1[3]};
            float sm = 0.f;
#pragma unroll
            for (int i = 0; i < 8; ++i) sm += c[i];
            const float mean = wsum64(sm) * (1.f / 512.f);
            float sq = 0.f;
#pragma unroll
            for (int i = 0; i < 8; ++i) { c[i] -= mean; sq += c[i] * c[i]; }
            const float rs = rsqrtf(wsum64(sq) * (1.f / 512.f) + LN_EPS);
            float y[8];
#pragma unroll
            for (int i = 0; i < 8; ++i) {
                const float z = __uint_as_float((i & 1) ? (zv[k][i >> 1] & 0xffff0000u) : (zv[k][i >> 1] << 16));
                y[i] = silu_f(c[i] * rs * gg[i] + bb[i]) * silu_f(z);
            }
            u32x4 o; o.x = pk_bf16(y[0], y[1]); o.y = pk_bf16(y[2], y[3]); o.z = pk_bf16(y[4], y[5]); o.w = pk_bf16(y[6], y[7]);
            *(u32x4*)((bf16_t*)(ws + NB_CATB) + row * 1024 + lane * 8) = o;
        }
    }
    __syncthreads();
}

__device__ __forceinline__ void pool_prompt(const Args& a, unsigned char* ws, int bid, int nb) {
    bf16_t* KCB = (bf16_t*)(ws + NB_KCB);
    for (int i = bid * NTH + threadIdx.x; i < BP * 64 * 256; i += nb * NTH) {
        const int c = i & 255, n = (i >> 8) & 63, b = i >> 14;
        const int kv = c >> 7, g = (c >> 6) & 1;
        const float* w = kv ? a.in[I_WVC] : a.in[I_WKC];
        const float* src = a.out + O_CMPP + (size_t)(b * TP + n * 32) * 256 + c;
        float acc = 0.f;
#pragma unroll 8
        for (int l = 0; l < 32; ++l) acc = fmaf(src[(size_t)l * 256], w[l * 2 + g], acc);
        KCB[i] = (bf16_t)(pk_bf16(acc, 0.f) & 0xffffu);
    }
}

constexpr int A_KT = 0;
constexpr int A_VT = 18432;
constexpr int A_IMPH = 35840;
constexpr int A_IMPS = 68608;
constexpr int A_MASK = 76800;
constexpr float LOG2E = 1.4426950408889634f;

struct KvSrc { const bf16_t* k; const bf16_t* v; int rstride; };

__device__ __forceinline__ void kv_issue(const KvSrc& s, int tid, u32x4& kr, u32x4& vr) {
    const int key = tid >> 3, c8 = tid & 7;
    kr = *(const u32x4*)(s.k + (size_t)key * s.rstride + c8 * 8);
    vr = *(const u32x4*)(s.v + (size_t)key * s.rstride + c8 * 8);
}
__device__ __forceinline__ void kv_write(PG8_LAS unsigned char* lds, int buf, int tid, const u32x4& kr, const u32x4& vr) {
    const int key = tid >> 3, c8 = tid & 7;
    *(PG8_LAS u32x4*)(lds + A_KT + buf * 9216 + key * 144 + c8 * 16) = kr;
    PG8_LAS bf16_t* vt = (PG8_LAS bf16_t*)(lds + A_VT + buf * 8704);
#pragma unroll
    for (int i = 0; i < 4; ++i) { vt[(c8 * 8 + 2 * i) * 68 + key] = (bf16_t)(vr[i] & 0xffffu); vt[(c8 * 8 + 2 * i + 1) * 68 + key] = (bf16_t)(vr[i] >> 16); }
}

__device__ __forceinline__ void attn_block(const int MODE, PG8_LAS unsigned char* lds, int buf, const bf16x8 (&qf)[4], int lane, float kslope, float base, int kmax, int kmin,
                                           float& m, float& l, f32x16 (&o)[2], f32x16 (&x)[2]) {
    const int lr = lane & 31, h = lane >> 5;
    const PG8_LAS unsigned char* kt_p = lds + A_KT + buf * 9216 + lr * 144 + h * 16;
#pragma unroll
    for (int kt = 0; kt < 2; ++kt) {
#pragma unroll
        for (int i = 0; i < 16; ++i) x[kt][i] = 0.f;
#pragma unroll
        for (int s = 0; s < 4; ++s) {
            const bf16x8 kf = *(const PG8_LAS bf16x8*)(kt_p + kt * 32 * 144 + s * 32);
            x[kt] = __builtin_amdgcn_mfma_f32_32x32x16_bf16(kf, qf[s], x[kt], 0, 0, 0);
        }
    }
    const float bh = base + kslope * (float)(4 * h);
    float mx = -INFINITY;
#pragma unroll
    for (int kt = 0; kt < 2; ++kt)
#pragma unroll
        for (int i = 0; i < 16; ++i) {
            const int kc = kt * 32 + (i & 3) + 8 * (i >> 2);
            x[kt][i] = fmaf(x[kt][i], LOG2E, fmaf(kslope, (float)kc, bh));
        }
    if (MODE) {
        const int hi = kmax - 4 * h, lo = kmin - 4 * h;
#pragma unroll
        for (int kt = 0; kt < 2; ++kt)
#pragma unroll
            for (int i = 0; i < 16; ++i) {
                const int kc = kt * 32 + (i & 3) + 8 * (i >> 2);
                x[kt][i] = (kc > hi || kc < lo) ? -INFINITY : x[kt][i];
            }
    }
#pragma unroll
    for (int kt = 0; kt < 2; ++kt)
#pragma unroll
        for (int i = 0; i < 16; ++i) mx = fmaxf(mx, x[kt][i]);
    mx = fmaxf(mx, __shfl_xor(mx, 32));
    const float mn = fmaxf(m, mx);
    const float corr = __builtin_amdgcn_exp2f(m - mn);
    const bool grew = __any(mn > m);
    m = mn;
    float ls = 0.f;
#pragma unroll
    for (int kt = 0; kt < 2; ++kt)
#pragma unroll
        for (int i = 0; i < 16; ++i) { const float pv = __builtin_amdgcn_exp2f(x[kt][i] - mn); x[kt][i] = pv; ls += pv; }
    l = fmaf(l, corr, ls);
    if (grew) {
#pragma unroll
        for (int dt = 0; dt < 2; ++dt)
#pragma unroll
            for (int i = 0; i < 16; ++i) o[dt][i] *= corr;
    }
    const PG8_LAS unsigned char* vt_p = lds + A_VT + buf * 8704 + lr * 136 + h * 8;
#pragma unroll
    for (int kt = 0; kt < 2; ++kt)
#pragma unroll
        for (int s = 0; s < 2; ++s) {
            u32x4 pw; pw.x = pk_bf16(x[kt][8 * s + 0], x[kt][8 * s + 1]); pw.y = pk_bf16(x[kt][8 * s + 2], x[kt][8 * s + 3]);
            pw.z = pk_bf16(x[kt][8 * s + 4], x[kt][8 * s + 5]); pw.w = pk_bf16(x[kt][8 * s + 6], x[kt][8 * s + 7]);
            const bf16x8 pf = __builtin_bit_cast(bf16x8, pw);
#pragma unroll
            for (int dt = 0; dt < 2; ++dt) {
                const PG8_LAS unsigned char* vp = vt_p + dt * 32 * 136 + (kt * 32 + s * 16) * 2;
                typedef unsigned u32x2 __attribute__((ext_vector_type(2)));
                const u32x2 v0 = *(const PG8_LAS u32x2*)vp, v1 = *(const PG8_LAS u32x2*)(vp + 16);
                u32x4 vw; vw.x = v0.x; vw.y = v0.y; vw.z = v1.x; vw.w = v1.y;
                o[dt] = __builtin_amdgcn_mfma_f32_32x32x16_bf16(__builtin_bit_cast(bf16x8, vw), pf, o[dt], 0, 0, 0);
            }
        }
}

__device__ __forceinline__ void attn_item(const Args& a, unsigned char* ws, PG8_LAS unsigned char* lds, int b, int g, int qb) {
    const int tid = opaque_v(threadIdx.x), lane = tid & 63, wv = __builtin_amdgcn_readfirstlane(tid >> 6);
    const int lr = lane & 31, h = lane >> 5;
    const int r = wv >> 1, th = wv & 1, hh = g * 4 + r;
    const int t0 = qb * 64, tb = qb;
    const int qloc = th * 32 + lr;
    const int qpos = t0 + qloc;
    const size_t qrow = (size_t)b * TP + qpos;
    const bf16_t* HB = (const bf16_t*)(ws + NB_HB);
    const bf16_t* KVB = (const bf16_t*)(ws + NB_KVB);
    const float slope2 = __builtin_amdgcn_exp2f(-(float)(hh + 1)) * LOG2E;
    bf16x8 qf[4];
#pragma unroll
    for (int s = 0; s < 4; ++s) qf[s] = *(const bf16x8*)(HB + qrow * 2560 + 1536 + hh * 64 + s * 16 + h * 8);
    const float* g3p = (const float*)(ws + NB_G3) + qrow * 32 + hh * 3;
    const float gc = sigm_f(g3p[0]), gs = sigm_f(g3p[1]), gw = sigm_f(g3p[2]);
    f32x16 res[2], o[2], x[2];
#pragma unroll
    for (int dt = 0; dt < 2; ++dt)
#pragma unroll
        for (int i = 0; i < 16; ++i) { res[dt][i] = 0.f; o[dt][i] = 0.f; }
    float m = -1e30f, l = 0.f;
    u32x4 kr, vr;
    PG8_LAS float* IMPH = (PG8_LAS float*)(lds + A_IMPH);
    PG8_LAS float* IMPS = (PG8_LAS float*)(lds + A_IMPS);
    PG8_LAS unsigned* MASK = (PG8_LAS unsigned*)(lds + A_MASK);

    {
        const bf16_t* kc = (const bf16_t*)(ws + NB_KCB) + (size_t)b * 64 * 256 + g * 64;
        KvSrc s{kc, kc + 128, 256};
        kv_issue(s, tid, kr, vr); kv_write(lds, 0, tid, kr, vr);
        if (tid < 64) MASK[tid] = 0u;
        __syncthreads();
        const int nmax = (qpos >= 31) ? ((qpos - 31) >> 5) : -1;
        attn_block(1, lds, 0, qf, lane, slope2 * 32.f, slope2 * (float)(31 - qpos), nmax, 0, m, l, o, x);
        const float lt = l + __shfl_xor(l, 32);
        const float inv = (nmax >= 0) ? 1.f / lt : 0.f;
        const float sc = gc * inv;
#pragma unroll
        for (int dt = 0; dt < 2; ++dt)
#pragma unroll
            for (int i = 0; i < 16; ++i) { res[dt][i] = o[dt][i] * sc; o[dt][i] = 0.f; }
        if (tb >= 16) {
#pragma unroll
            for (int kt = 0; kt < 2; ++kt)
#pragma unroll
                for (int c = 0; c < 4; ++c)
#pragma unroll
                    for (int e = 0; e < 2; ++e)
                        IMPH[(r * 64 + qloc) * 32 + kt * 16 + 4 * c + 2 * h + e] = (nmax >= 0) ? (x[kt][4 * c + 2 * e] + x[kt][4 * c + 2 * e + 1]) * inv : 0.f;
        }
        m = -1e30f; l = 0.f;
        __syncthreads();
    }
    if (tb >= 16) {
        const int tq = opaque_v(tid);
        const int q = tq >> 3, jq = tq & 7;
        float v4[4];
#pragma unroll
        for (int e = 0; e < 4; ++e) {
            const int j = jq * 4 + e;
            float v = IMPH[(0 * 64 + q) * 32 + j] + IMPH[(1 * 64 + q) * 32 + j] + IMPH[(2 * 64 + q) * 32 + j] + IMPH[(3 * 64 + q) * 32 + j];
            if (j == 0 || j == tb || j == tb - 1) v = 1e4f;
            IMPS[q * 32 + j] = v; v4[e] = v;
        }
        __syncthreads();
        unsigned bits = 0u;
#pragma unroll
        for (int e = 0; e < 4; ++e) {
            const int j = jq * 4 + e;
            int rank = 0;
            for (int i = 0; i <= tb; ++i) { const float vi = IMPS[q * 32 + i]; rank += (vi > v4[e] || (vi == v4[e] && i < j)) ? 1 : 0; }
            if (j <= tb && rank < 16) bits |= 1u << j;
        }
        if (bits) atomicOr((unsigned*)&MASK[q], bits);
    } else {
        if (tid < 64) MASK[tid] = (2u << tb) - 1u;
    }
    __syncthreads();
    const unsigned selmask = MASK[qloc];

    {
        const bf16_t* kb = KVB + (size_t)b * TP * 768 + 256 + g * 64;
        { KvSrc s{kb, kb + 128, 768}; kv_issue(s, tid, kr, vr); kv_write(lds, 0, tid, kr, vr); }
        __syncthreads();
        for (int j = 0; j <= tb; ++j) {
            if (j < tb) { KvSrc s{kb + (size_t)(j + 1) * 64 * 768, kb + (size_t)(j + 1) * 64 * 768 + 128, 768}; kv_issue(s, tid, kr, vr); }
            const float base = ((selmask >> j) & 1u) ? slope2 * (float)(j * 64 - qpos) : -INFINITY;
            attn_block(j == tb, lds, j & 1, qf, lane, slope2, base, qloc, 0, m, l, o, x);
            if (j < tb) kv_write(lds, (j + 1) & 1, tid, kr, vr);
            __syncthreads();
        }
        const float lt = l + __shfl_xor(l, 32);
        const float sc = gs / lt;
#pragma unroll
        for (int dt = 0; dt < 2; ++dt)
#pragma unroll
            for (int i = 0; i < 16; ++i) { res[dt][i] = fmaf(o[dt][i], sc, res[dt][i]); o[dt][i] = 0.f; }
        m = -1e30f; l = 0.f;
    }
    {
        const int jlo = (tb >= 8) ? tb - 8 : 0;
        const bf16_t* kb = KVB + (size_t)b * TP * 768 + 512 + g * 64;
        { KvSrc s{kb + (size_t)jlo * 64 * 768, kb + (size_t)jlo * 64 * 768 + 128, 768}; kv_issue(s, tid, kr, vr); kv_write(lds, 0, tid, kr, vr); }
        __syncthreads();
        for (int j = jlo; j <= tb; ++j) {
            const int bi = (j - jlo) & 1;
            if (j < tb) { KvSrc s{kb + (size_t)(j + 1) * 64 * 768, kb + (size_t)(j + 1) * 64 * 768 + 128, 768}; kv_issue(s, tid, kr, vr); }
            const float base = slope2 * (float)(j * 64 - qpos);
            attn_block((j == tb) || (j == tb - 8), lds, bi, qf, lane, slope2, base, (j == tb) ? qloc : 64, (j == tb - 8) ? qpos - 511 - j * 64 : 0, m, l, o, x);
            if (j < tb) kv_write(lds, bi ^ 1, tid, kr, vr);
            __syncthreads();
        }
        const float lt = l + __shfl_xor(l, 32);
        const float sc = gw / lt;
#pragma unroll
        for (int dt = 0; dt < 2; ++dt)
#pragma unroll
            for (int i = 0; i < 16; ++i) res[dt][i] = fmaf(o[dt][i], sc, res[dt][i]);
    }
    {
        const size_t qrow2 = (size_t)b * TP + t0 + th * 32 + (opaque_v(lane) & 31);
        const bf16_t* zb = HB + qrow2 * 2560 + 2048 + hh * 64;
        bf16_t* dst = (bf16_t*)(ws + NB_CATB) + qrow2 * 1024 + 512 + hh * 64;
        typedef unsigned u32x2 __attribute__((ext_vector_type(2)));
#pragma unroll
        for (int dt = 0; dt < 2; ++dt)
#pragma unroll
            for (int c = 0; c < 4; ++c) {
                const int d = dt * 32 + 8 * c + 4 * h;
                const u32x2 zv = *(const u32x2*)(zb + d);
                const float z0 = __uint_as_float(zv.x << 16), z1 = __uint_as_float(zv.x & 0xffff0000u), z2 = __uint_as_float(zv.y << 16), z3 = __uint_as_float(zv.y & 0xffff0000u);
                u32x2 w; w.x = pk_bf16(res[dt][4 * c + 0] * silu_f(z0), res[dt][4 * c + 1] * silu_f(z1)); w.y = pk_bf16(res[dt][4 * c + 2] * silu_f(z2), res[dt][4 * c + 3] * silu_f(z3));
                *(u32x2*)(dst + d) = w;
            }
    }
}

constexpr int XSH_ROWS = 16640;
__device__ __forceinline__ float wave_sum(float v) {
#pragma unroll
    for (int o = 32; o > 0; o >>= 1) v += __shfl_xor(v, o);
    return v;
}
__device__ __forceinline__ void ld_row16(const float* __restrict__ src, int lane, float (&x)[16]) {
#pragma unroll
    for (int q = 0; q < 4; ++q) { const float4 v = *(const float4*)(src + q * 256 + lane * 4); x[4 * q] = v.x; x[4 * q + 1] = v.y; x[4 * q + 2] = v.z; x[4 * q + 3] = v.w; }
}
__device__ __forceinline__ void ln_calc16(const float* __restrict__ g, const float* __restrict__ bta, int lane, float (&x)[16]) {
    float sm = 0.f;
#pragma unroll
    for (int i = 0; i < 16; ++i) sm += x[i];
    const float mean = wave_sum(sm) * (1.f / 1024.f);
    float sq = 0.f;
#pragma unroll
    for (int i = 0; i < 16; ++i) { x[i] -= mean; sq += x[i] * x[i]; }
    const float rs = rsqrtf(wave_sum(sq) * (1.f / 1024.f) + LN_EPS);
#pragma unroll
    for (int q = 0; q < 4; ++q) {
        const float4 gv = *(const float4*)(g + q * 256 + lane * 4), bv = *(const float4*)(bta + q * 256 + lane * 4);
        x[4 * q] = x[4 * q] * rs * gv.x + bv.x; x[4 * q + 1] = x[4 * q + 1] * rs * gv.y + bv.y; x[4 * q + 2] = x[4 * q + 2] * rs * gv.z + bv.z; x[4 * q + 3] = x[4 * q + 3] * rs * gv.w + bv.w;
    }
}
__device__ __forceinline__ void ln_row16(const float* __restrict__ src, const float* __restrict__ g, const float* __restrict__ bta, int lane, float (&x)[16]) {
    ld_row16(src, lane, x); ln_calc16(g, bta, lane, x);
}
constexpr int LR_A = 0;
__device__ __forceinline__ void store_x1_xsh(const Args& a, unsigned char* ws, PG8_LAS unsigned char* lds, size_t xrow, int lrow, int lane, const float (&cur)[16], const float (&prev)[16]) {
    typedef unsigned u32x2 __attribute__((ext_vector_type(2)));
#pragma unroll 1
    for (int n = 0; n < 6; ++n) {
        const float* mu = a.in[I_MU] + n * 1024 + lane * 4;
        u32x2 w[4];
#pragma unroll
        for (int q = 0; q < 4; ++q) { const float4 m4 = *(const float4*)(mu + q * 256);
            w[q].x = pk_bf16(fmaf(prev[4 * q] - cur[4 * q], m4.x, cur[4 * q]), fmaf(prev[4 * q + 1] - cur[4 * q + 1], m4.y, cur[4 * q + 1]));
            w[q].y = pk_bf16(fmaf(prev[4 * q + 2] - cur[4 * q + 2], m4.z, cur[4 * q + 2]), fmaf(prev[4 * q + 3] - cur[4 * q + 3], m4.w, cur[4 * q + 3])); }
        if (n < 4 || lrow < 0) {
            bf16_t* dst = (bf16_t*)(ws + NB_XSH) + ((size_t)n * XSH_ROWS + xrow) * 1024 + lane * 4;
#pragma unroll
            for (int q = 0; q < 4; ++q) *(u32x2*)(dst + q * 256) = w[q];
        } else {
            PG8_LAS bf16_t* dst = (PG8_LAS bf16_t*)(lds + LR_A) + ((n - 4) * 32 + lrow) * 1032 + lane * 4;
#pragma unroll
            for (int q = 0; q < 4; ++q) *(PG8_LAS u32x2*)(dst + q * 256) = w[q];
        }
    }
}
template <class ROWMAP>
__device__ __forceinline__ void lora_pass(unsigned char* ws, PG8_LAS unsigned char* lds, int tid, ROWMAP rowmap) {
    const int lane = tid & 63, wv = tid >> 6, lr = lane & 31, h = lane >> 5;
    const int which = wv >> 2, kq = wv & 3;
    PG8_LAS bf16_t* AT = (PG8_LAS bf16_t*)(lds + LR_A) + which * 32 * 1032;
    PG8_LAS float* P = (PG8_LAS float*)(lds + LR_A);
    __syncthreads();
    const bf16_t* Bt = (const bf16_t*)(ws + (which ? NB_A1T : NB_W1T));
    f32x16 acc0, acc1;
#pragma unroll
    for (int i = 0; i < 16; ++i) { acc0[i] = 0.f; acc1[i] = 0.f; }
#pragma unroll
    for (int s = 0; s < 16; ++s) {
        const int k = kq * 256 + s * 16 + h * 8;
        const bf16x8 av = *(const PG8_LAS bf16x8*)(AT + lr * 1032 + k);
        const bf16x8 b0 = *(const bf16x8*)(Bt + ((size_t)(kq * 16 + s) * 64 + lane) * 8), b1 = *(const bf16x8*)(Bt + ((size_t)(64 + kq * 16 + s) * 64 + lane) * 8);
        acc0 = __builtin_amdgcn_mfma_f32_32x32x16_bf16(av, b0, acc0, 0, 0, 0);
        acc1 = __builtin_amdgcn_mfma_f32_32x32x16_bf16(av, b1, acc1, 0, 0, 0);
    }
    __syncthreads();
#pragma unroll
    for (int q = 0; q < 4; ++q) {
        *(PG8_LAS f32x4*)(P + (wv * 64 + lane) * 32 + q * 4) = (f32x4){acc0[4 * q], acc0[4 * q + 1], acc0[4 * q + 2], acc0[4 * q + 3]};
        *(PG8_LAS f32x4*)(P + (wv * 64 + lane) * 32 + 16 + q * 4) = (f32x4){acc1[4 * q], acc1[4 * q + 1], acc1[4 * q + 2], acc1[4 * q + 3]};
    }
    __syncthreads();
    if (wv < 4) {
        const int wh = wv >> 1, half = wv & 1;
        float sum[16];
#pragma unroll
        for (int i = 0; i < 16; ++i) sum[i] = 0.f;
#pragma unroll
        for (int w = 0; w < 4; ++w)
#pragma unroll
            for (int q = 0; q < 4; ++q) { const f32x4 v = *(const PG8_LAS f32x4*)(P + ((wh * 4 + w) * 64 + lane) * 32 + half * 16 + q * 4); sum[4 * q] += v[0]; sum[4 * q + 1] += v[1]; sum[4 * q + 2] += v[2]; sum[4 * q + 3] += v[3]; }
        bf16_t* dst = (bf16_t*)(ws + (wh ? NB_AWB : NB_TWB)) + half * 32 + lr;
#pragma unroll
        for (int i = 0; i < 16; ++i) { const int rl = (i & 3) + 8 * (i >> 2) + 4 * h; const float v = wh ? sum[i] : tanhf(sum[i]); dst[rowmap(rl) * 64] = (bf16_t)(pk_bf16c(v, 0.f) & 0xffffu); }
    }
    __syncthreads();
}
__device__ __forceinline__ void phase_lns(const Args& a, unsigned char* ws, PG8_LAS unsigned char* lds, int bid, int nb) {
    const int tid = opaque_v(threadIdx.x), lane = tid & 63, wv = tid >> 6;
    const float* PRE = (const float*)ws + WS_PRE;
    const float* g = a.in[I_LNG]; const float* bta = a.in[I_LNB];
    for (int blk = bid; blk < 256; blk += nb) {
        const int r0 = blk * 64 + wv * 8;
        float prev[16], cur[16];
        if ((r0 & (TP - 1)) == 0) {
#pragma unroll
            for (int i = 0; i < 16; ++i) prev[i] = 0.f;
        } else ln_row16(PRE + (size_t)(r0 - 1) * 1024, g, bta, lane, prev);
        float nxt[16];
        ld_row16(PRE + (size_t)r0 * 1024, lane, nxt);
#pragma unroll 1
        for (int k = 0; k < 8; ++k) {
            const int row = r0 + k;
#pragma unroll
            for (int i = 0; i < 16; ++i) cur[i] = nxt[i];
            if (k + 1 < 8) ld_row16(PRE + (size_t)(row + 1) * 1024, lane, nxt);
            ln_calc16(g, bta, lane, cur);
            store_x1_xsh(a, ws, lds, row, wv * 4 + (k & 3), lane, cur, prev);
            if ((row & (TP - 1)) == TP - 1) {
                float* so = a.out + O_SHP + (size_t)(row >> 11) * 1024 + lane * 4;
#pragma unroll
                for (int q = 0; q < 4; ++q) *(float4*)(so + q * 256) = make_float4(cur[4 * q], cur[4 * q + 1], cur[4 * q + 2], cur[4 * q + 3]);
            }
#pragma unroll
            for (int i = 0; i < 16; ++i) prev[i] = cur[i];
            if ((k & 3) == 3) {
                const int rbase = blk * 64 + (k & 4);
                lora_pass(ws, lds, tid, [&](int rl) { return (size_t)(rbase + (rl >> 2) * 8 + (rl & 3)); });
            }
        }
    }
    for (int s = bid * 8 + wv; s < BS; s += nb * 8) {
        float prev[16], cur[16];
        const float* sp = a.in[I_SSHIFT] + (size_t)s * 1024 + lane * 4;
#pragma unroll
        for (int q = 0; q < 4; ++q) { const float4 v = *(const float4*)(sp + q * 256); prev[4 * q] = v.x; prev[4 * q + 1] = v.y; prev[4 * q + 2] = v.z; prev[4 * q + 3] = v.w; }
        ln_row16(PRE + (size_t)(MP + s) * 1024, g, bta, lane, cur);
        store_x1_xsh(a, ws, lds, MP + s, -1, lane, cur, prev);
        float* so = a.out + O_SHS + (size_t)s * 1024 + lane * 4;
#pragma unroll
        for (int q = 0; q < 4; ++q) *(float4*)(so + q * 256) = make_float4(cur[4 * q], cur[4 * q + 1], cur[4 * q + 2], cur[4 * q + 3]);
    }
}

struct Order3 {
    pg8::StaticOrder so;
    __device__ void init(int G, int c) { so.init(MP, 4096, G, c); }
    __device__ bool next(int i, Unit& u) const { Unit v; if (!so.next(i, v)) return false; const int n = v.pn >> 2; u.pm = n * 65 + v.pm; u.pn = v.pn; return true; }
    __device__ __forceinline__ void a_ready(const Unit&) const {}
    __device__ __forceinline__ void done(const Unit&) const {}
};
struct Epi3 {
    static constexpr bool PERM = true, AFTER_DRAIN = false;
    bf16_t* O;
    __device__ __forceinline__ void operator()(const f32x4 (&acc)[2][2][4][2], const Unit& u, int wr, int wc, int fr, int fq) const {
        const int n = u.pn >> 2, pm = u.pm - n * 65, pn = u.pn & 3;
        const int row0 = pm * 256 + wr * 64 + fr, col0 = pn * 256 + wc * 32 + 8 * fq;
        bf16_t* base = O + (size_t)n * XSH_ROWS * 1024;
#pragma unroll
        for (int ai = 0; ai < 2; ++ai)
#pragma unroll
            for (int m = 0; m < 4; ++m) { bf16_t* rowp = base + (size_t)(row0 + ai * 128 + m * 16) * 1024 + col0;
#pragma unroll
                for (int bj = 0; bj < 2; ++bj) { const f32x4 v0 = acc[ai][bj][m][0], v1 = acc[ai][bj][m][1];
                    u32x4 w; w.x = pk_bf16c(v0[0], v0[1]); w.y = pk_bf16c(v0[2], v0[3]); w.z = pk_bf16c(v1[0], v1[1]); w.w = pk_bf16c(v1[2], v1[3]);
                    *(u32x4*)(rowp + bj * 128) = w; } }
    }
};
struct EpiPreRes {
    static constexpr bool PERM = false, AFTER_DRAIN = false;
    float* C; const float* X;
    __device__ __forceinline__ void operator()(const f32x4 (&acc)[2][2][4][2], const Unit& u, int wr, int wc, int fr, int fq) const {
        const int row0 = u.pm * 256 + wr * 64 + fr, col0 = u.pn * 256 + wc * 32 + 4 * fq;
#pragma unroll
        for (int ai = 0; ai < 2; ++ai)
#pragma unroll
            for (int m = 0; m < 4; ++m) { const size_t off = (size_t)(row0 + ai * 128 + m * 16) * 1024 + col0;
#pragma unroll
                for (int bj = 0; bj < 2; ++bj)
#pragma unroll
                    for (int n = 0; n < 2; ++n) { const f32x4 xv = *(const f32x4*)(X + off + bj * 128 + n * 16); *(f32x4*)(C + off + bj * 128 + n * 16) = acc[ai][bj][m][n] + xv * ALPHA; } }
    }
};

constexpr int LR_A0 = 0;
constexpr int LR_P = 67584;
struct LoraRegs { u32x4 v[8]; };
__device__ __forceinline__ void lora_load(unsigned char* ws, int task, int tid, LoraRegs& r) {
    const int rt = task >> 1, which = task & 1;
    const bf16_t* A = (const bf16_t*)(ws + NB_XSH) + ((size_t)(4 + which) * XSH_ROWS + (size_t)rt * 32) * 1024;
#pragma unroll
    for (int i = 0; i < 8; ++i) { const int idx = tid + i * NTH; r.v[i] = *(const u32x4*)(A + (size_t)(idx >> 7) * 1024 + (idx & 127) * 8); }
}
__device__ __forceinline__ void lora_tile(unsigned char* ws, PG8_LAS unsigned char* lds, int task, int tid, const LoraRegs& r) {
    const int rt = task >> 1, which = task & 1;
    const int lane = tid & 63, wv = tid >> 6, lr = lane & 31, h = lane >> 5;
    PG8_LAS bf16_t* AT = (PG8_LAS bf16_t*)(lds + LR_A0);
    PG8_LAS float* P = (PG8_LAS float*)(lds + LR_P);
#pragma unroll
    for (int i = 0; i < 8; ++i) { const int idx = tid + i * NTH; *(PG8_LAS u32x4*)(AT + (idx >> 7) * 1032 + (idx & 127) * 8) = r.v[i]; }
    __syncthreads();
    const bf16_t* Bt = (const bf16_t*)(ws + (which ? NB_A1T : NB_W1T));
    f32x16 acc0, acc1;
#pragma unroll
    for (int i = 0; i < 16; ++i) { acc0[i] = 0.f; acc1[i] = 0.f; }
#pragma unroll
    for (int s = 0; s < 8; ++s) {
        const int k = wv * 128 + s * 16 + h * 8;
        const bf16x8 av = *(const PG8_LAS bf16x8*)(AT + lr * 1032 + k);
        const bf16x8 b0 = *(const bf16x8*)(Bt + ((size_t)(wv * 8 + s) * 64 + lane) * 8), b1 = *(const bf16x8*)(Bt + ((size_t)(64 + wv * 8 + s) * 64 + lane) * 8);
        acc0 = __builtin_amdgcn_mfma_f32_32x32x16_bf16(av, b0, acc0, 0, 0, 0);
        acc1 = __builtin_amdgcn_mfma_f32_32x32x16_bf16(av, b1, acc1, 0, 0, 0);
    }
#pragma unroll
    for (int q = 0; q < 4; ++q) {
        *(PG8_LAS f32x4*)(P + (wv * 64 + lane) * 32 + q * 4) = (f32x4){acc0[4 * q], acc0[4 * q + 1], acc0[4 * q + 2], acc0[4 * q + 3]};
        *(PG8_LAS f32x4*)(P + (wv * 64 + lane) * 32 + 16 + q * 4) = (f32x4){acc1[4 * q], acc1[4 * q + 1], acc1[4 * q + 2], acc1[4 * q + 3]};
    }
    __syncthreads();
    if (wv < 2) {
        float sum[16];
#pragma unroll
        for (int i = 0; i < 16; ++i) sum[i] = 0.f;
#pragma unroll
        for (int w = 0; w < 8; ++w)
#pragma unroll
            for (int q = 0; q < 4; ++q) { const f32x4 v = *(const PG8_LAS f32x4*)(P + (w * 64 + lane) * 32 + wv * 16 + q * 4); sum[4 * q] += v[0]; sum[4 * q + 1] += v[1]; sum[4 * q + 2] += v[2]; sum[4 * q + 3] += v[3]; }
        bf16_t* dst = (bf16_t*)(ws + (which ? NB_AWB : NB_TWB)) + (size_t)rt * 32 * 64 + wv * 32 + lr;
#pragma unroll
        for (int i = 0; i < 16; ++i) { const int row = (i & 3) + 8 * (i >> 2) + 4 * h; const float v = which ? sum[i] : tanhf(sum[i]); dst[(size_t)row * 64] = (bf16_t)(pk_bf16c(v, 0.f) & 0xffffu); }
    }
    __syncthreads();
}

__device__ __forceinline__ float dpp_red16f(float v) {
    v += __builtin_bit_cast(float, __builtin_amdgcn_update_dpp(0, __builtin_bit_cast(int, v), 0xB1, 0xF, 0xF, true));
    v += __builtin_bit_cast(float, __builtin_amdgcn_update_dpp(0, __builtin_bit_cast(int, v), 0x4E, 0xF, 0xF, true));
    v += __builtin_bit_cast(float, __builtin_amdgcn_update_dpp(0, __builtin_bit_cast(int, v), 0x141, 0xF, 0xF, true));
    v += __builtin_bit_cast(float, __builtin_amdgcn_update_dpp(0, __builtin_bit_cast(int, v), 0x140, 0xF, 0xF, true));
    return v;
}
__device__ __forceinline__ void prep2_task(const Args& a, unsigned char* ws, int rt, int hd, int lane) {
    const int lr = lane & 31, h2 = lane >> 5;
    const size_t row0 = (size_t)rt * 32;
    const bf16_t* W2T = (const bf16_t*)(ws + NB_W2T); const bf16_t* A2T = (const bf16_t*)(ws + NB_A2T);
    const bf16_t* TWB = (const bf16_t*)(ws + NB_TWB); const bf16_t* AWB = (const bf16_t*)(ws + NB_AWB);
    f32x16 aw[2], aa[2];
#pragma unroll
    for (int ct = 0; ct < 2; ++ct)
#pragma unroll
        for (int i = 0; i < 16; ++i) { aw[ct][i] = 0.f; aa[ct][i] = 0.f; }
#pragma unroll
    for (int s = 0; s < 4; ++s) {
        const bf16x8 at = *(const bf16x8*)(TWB + (row0 + lr) * 64 + s * 16 + h2 * 8), aa_ = *(const bf16x8*)(AWB + (row0 + lr) * 64 + s * 16 + h2 * 8);
#pragma unroll
        for (int ct = 0; ct < 2; ++ct) {
            const size_t e = (size_t)hd * 64 + ct * 32 + lr;
            const bf16x8 w2 = *(const bf16x8*)(W2T + e * 64 + s * 16 + h2 * 8), a2 = *(const bf16x8*)(A2T + e * 64 + s * 16 + h2 * 8);
            aw[ct] = __builtin_amdgcn_mfma_f32_32x32x16_bf16(at, w2, aw[ct], 0, 0, 0);
            aa[ct] = __builtin_amdgcn_mfma_f32_32x32x16_bf16(aa_, a2, aa[ct], 0, 0, 0);
        }
    }
    const bf16_t* KB = (const bf16_t*)(ws + NB_RKVZ) + (size_t)1 * XSH_ROWS * 1024;
    const bf16_t* RB = (const bf16_t*)(ws + NB_RKVZ);
    float* DEC = (float*)(ws + NB_DEC);
    bf16_t* KKN = (bf16_t*)(ws + NB_KKN); bf16_t* KKA = (bf16_t*)(ws + NB_KKA); bf16_t* KP = (bf16_t*)(ws + NB_KP);
    float w0v[2], a0v[2], kkp[2], kap[2], rkp[2];
#pragma unroll
    for (int ct = 0; ct < 2; ++ct) { const int e = hd * 64 + ct * 32 + lr; w0v[ct] = a.in[I_W0][e]; a0v[ct] = a.in[I_A0][e]; kkp[ct] = a.in[I_KK][e]; kap[ct] = a.in[I_KA][e]; rkp[ct] = a.in[I_RK][e]; }
    float n2[16], rk[16];
#pragma unroll
    for (int i = 0; i < 16; ++i) { n2[i] = 0.f; rk[i] = 0.f; }
#pragma unroll
    for (int ct = 0; ct < 2; ++ct)
#pragma unroll
        for (int i = 0; i < 16; ++i) {
            const size_t off = (row0 + (i & 3) + 8 * (i >> 2) + 4 * h2) * 1024 + hd * 64 + ct * 32 + lr;
            const float kf = bf2f(KB[off]), rf = bf2f(RB[off]);
            const float wl = w0v[ct] + aw[ct][i];
            const float sp = fmaxf(-wl, 0.f) + log1pf(__expf(-fabsf(wl)));
            DEC[off] = __expf(-__expf(-sp - 0.5f));
            const float av_ = sigm_f(a0v[ct] + aa[ct][i]);
            const float kk = kf * kkp[ct];
            const float kp = kf * (1.f + (av_ - 1.f) * kap[ct]);
            KP[off] = (bf16_t)(pk_bf16(kp, 0.f) & 0xffffu);
            aw[ct][i] = kk; aa[ct][i] = av_;
            n2[i] = fmaf(kk, kk, n2[i]);
            rk[i] = fmaf(rf * kp, rkp[ct], rk[i]);
        }
#pragma unroll
    for (int i = 0; i < 16; ++i) {
        float v = dpp_red16f(n2[i]); v += __shfl_xor(v, 16); n2[i] = 1.f / fmaxf(sqrtf(v), 1e-12f);
        float w = dpp_red16f(rk[i]); w += __shfl_xor(w, 16); rk[i] = w;
    }
#pragma unroll
    for (int ct = 0; ct < 2; ++ct)
#pragma unroll
        for (int i = 0; i < 16; ++i) {
            const size_t off = (row0 + (i & 3) + 8 * (i >> 2) + 4 * h2) * 1024 + hd * 64 + ct * 32 + lr;
            const float kn = aw[ct][i] * n2[i];
            KKN[off] = (bf16_t)(pk_bf16(kn, 0.f) & 0xffffu);
            KKA[off] = (bf16_t)(pk_bf16(kn * aa[ct][i], 0.f) & 0xffffu);
        }
    if (lr == 0) {
#pragma unroll
        for (int i = 0; i < 16; ++i) ((float*)(ws + NB_RKS))[(row0 + (i & 3) + 8 * (i >> 2) + 4 * h2) * 16 + hd] = rk[i];
    }
}

constexpr int SC_BUF = 53248;
__device__ __forceinline__ float dpp_red16(float v) {
    v += __builtin_bit_cast(float, __builtin_amdgcn_update_dpp(0, __builtin_bit_cast(int, v), 0xB1, 0xF, 0xF, true));
    v += __builtin_bit_cast(float, __builtin_amdgcn_update_dpp(0, __builtin_bit_cast(int, v), 0x4E, 0xF, 0xF, true));
    v += __builtin_bit_cast(float, __builtin_amdgcn_update_dpp(0, __builtin_bit_cast(int, v), 0x141, 0xF, 0xF, true));
    v += __builtin_bit_cast(float, __builtin_amdgcn_update_dpp(0, __builtin_bit_cast(int, v), 0x140, 0xF, 0xF, true));
    return v;
}
struct ScanRegs { u32x4 d0, d1, kn, ka, kp, r, v; };
__device__ __forceinline__ void scan_issue(unsigned char* ws, int b, int hd, int vh, int chunk, int tid, ScanRegs& g) {
    const int tt = tid >> 3, part = tid & 7;
    const size_t row = (size_t)b * TP + chunk * 64 + tt;
    const size_t off = row * 1024 + hd * 64 + part * 8;
    const float* dp = (const float*)(ws + NB_DEC) + off;
    g.d0 = *(const u32x4*)dp; g.d1 = *(const u32x4*)(dp + 4);
    g.kn = *(const u32x4*)((const bf16_t*)(ws + NB_KKN) + off);
    g.ka = *(const u32x4*)((const bf16_t*)(ws + NB_KKA) + off);
    g.kp = *(const u32x4*)((const bf16_t*)(ws + NB_KP) + off);
    g.r = *(const u32x4*)((const bf16_t*)(ws + NB_RKVZ) + ((size_t)0 * XSH_ROWS + row) * 1024 + hd * 64 + part * 8);
    if (part < 4) g.v = *(const u32x4*)((const bf16_t*)(ws + NB_RKVZ) + ((size_t)2 * XSH_ROWS + row) * 1024 + hd * 64 + vh * 32 + part * 8);
}
__device__ __forceinline__ void scan_write(PG8_LAS unsigned char* buf, int tid, const ScanRegs& g) {
    const int tt = tid >> 3, part = tid & 7;
    *(PG8_LAS u32x4*)(buf + tt * 256 + part * 32) = g.d0; *(PG8_LAS u32x4*)(buf + tt * 256 + part * 32 + 16) = g.d1;
    *(PG8_LAS u32x4*)(buf + 16384 + tt * 128 + part * 16) = g.kn;
    *(PG8_LAS u32x4*)(buf + 24576 + tt * 128 + part * 16) = g.ka;
    *(PG8_LAS u32x4*)(buf + 32768 + tt * 128 + part * 16) = g.kp;
    *(PG8_LAS u32x4*)(buf + 40960 + tt * 128 + part * 16) = g.r;
    if (part < 4) *(PG8_LAS u32x4*)(buf + 49152 + tt * 64 + part * 16) = g.v;
}
__device__ __forceinline__ void scan_prompt(const Args& a, unsigned char* ws, PG8_LAS unsigned char* lds, int item) {
    const int tid = opaque_v(threadIdx.x);
    const int b = item >> 5, hd = (item >> 1) & 15, vh = item & 1;
    const int vl = tid >> 4, kq = tid & 15;
    typedef unsigned u32x2 __attribute__((ext_vector_type(2)));
    float S[4] = {0.f, 0.f, 0.f, 0.f};
    ScanRegs g;
    PG8_LAS float* YS = (PG8_LAS float*)(lds + 2 * SC_BUF);
    scan_issue(ws, b, hd, vh, 0, tid, g); scan_write(lds, tid, g);
    __syncthreads();
    for (int c = 0; c < TP / 64; ++c) {
        PG8_LAS unsigned char* buf = lds + (c & 1) * SC_BUF;
        if (c + 1 < TP / 64) scan_issue(ws, b, hd, vh, c + 1, tid, g);
#pragma unroll 4
        for (int tt = 0; tt < 64; ++tt) {
            const f32x4 w = *(const PG8_LAS f32x4*)(buf + tt * 256 + kq * 16);
            const u32x2 knw = *(const PG8_LAS u32x2*)(buf + 16384 + tt * 128 + kq * 8), kaw = *(const PG8_LAS u32x2*)(buf + 24576 + tt * 128 + kq * 8),
                        kpw = *(const PG8_LAS u32x2*)(buf + 32768 + tt * 128 + kq * 8), rw = *(const PG8_LAS u32x2*)(buf + 40960 + tt * 128 + kq * 8);
            const float vv = bf2f(*(const PG8_LAS bf16_t*)(buf + 49152 + tt * 64 + vl * 2));
            const float kn[4] = {__uint_as_float(knw.x << 16), __uint_as_float(knw.x & 0xffff0000u), __uint_as_float(knw.y << 16), __uint_as_float(knw.y & 0xffff0000u)};
            const float ka[4] = {__uint_as_float(kaw.x << 16), __uint_as_float(kaw.x & 0xffff0000u), __uint_as_float(kaw.y << 16), __uint_as_float(kaw.y & 0xffff0000u)};
            const float kp[4] = {__uint_as_float(kpw.x << 16), __uint_as_float(kpw.x & 0xffff0000u), __uint_as_float(kpw.y << 16), __uint_as_float(kpw.y & 0xffff0000u)};
            const float rr[4] = {__uint_as_float(rw.x << 16), __uint_as_float(rw.x & 0xffff0000u), __uint_as_float(rw.y << 16), __uint_as_float(rw.y & 0xffff0000u)};
            float sa = S[0] * kn[0];
            sa = fmaf(S[1], kn[1], sa); sa = fmaf(S[2], kn[2], sa); sa = fmaf(S[3], kn[3], sa);
            sa = dpp_red16(sa);
            float y = 0.f;
#pragma unroll
            for (int i = 0; i < 4; ++i) { S[i] = fmaf(S[i], w[i], fmaf(vv, kp[i], -sa * ka[i])); y = fmaf(S[i], rr[i], y); }
            y = dpp_red16(y);
            if (kq == 0) YS[tt * 32 + vl] = y;
        }
        if (c + 1 < TP / 64) scan_write(lds + ((c + 1) & 1) * SC_BUF, tid, g);
        __syncthreads();
        {
            float* Y = (float*)(ws + NB_Y);
            for (int i = tid; i < 64 * 32; i += NTH) { const int tt = i >> 5, v = i & 31; Y[((size_t)b * TP + c * 64 + tt) * 1024 + hd * 64 + vh * 32 + v] = YS[i]; }
        }
        __syncthreads();
    }
    float* so = a.out + O_WKVP + ((size_t)(b * 16 + hd) * 64 + vh * 32 + vl) * 64 + kq * 4;
    *(float4*)so = make_float4(S[0], S[1], S[2], S[3]);
}
__device__ __forceinline__ void scan_sample(const Args& a, unsigned char* ws, int s, int hd, int lane) {
    const size_t row = (size_t)MP + s;
    const float* s0 = a.in[I_SWKV] + ((size_t)(s * 16 + hd) * 64 + lane) * 64;
    float* sout = a.out + O_WKVS + ((size_t)(s * 16 + hd) * 64 + lane) * 64;
    const int e = hd * 64 + lane;
    const float twl = bf2f(((const bf16_t*)(ws + NB_TWB) + row * 64)[lane]), awl = bf2f(((const bf16_t*)(ws + NB_AWB) + row * 64)[lane]);
    const bf16_t* w2r = (const bf16_t*)(ws + NB_W2T) + (size_t)e * 64; const bf16_t* a2r = (const bf16_t*)(ws + NB_A2T) + (size_t)e * 64;
    float wl = a.in[I_W0][e], al = a.in[I_A0][e];
#define RL(X, K) __builtin_bit_cast(float, __builtin_amdgcn_readlane(__builtin_bit_cast(int, X), K))
#pragma unroll
    for (int j8 = 0; j8 < 8; ++j8) {
        const u32x4 wq = *(const u32x4*)(w2r + j8 * 8), aq = *(const u32x4*)(a2r + j8 * 8);
#pragma unroll
        for (int i = 0; i < 8; ++i) {
            const float wv_ = __uint_as_float((i & 1) ? (wq[i >> 1] & 0xffff0000u) : (wq[i >> 1] << 16)), av_ = __uint_as_float((i & 1) ? (aq[i >> 1] & 0xffff0000u) : (aq[i >> 1] << 16));
            wl = fmaf(RL(twl, j8 * 8 + i), wv_, wl); al = fmaf(RL(awl, j8 * 8 + i), av_, al);
        }
    }
    const float decl = __expf(-0.60653066f * sigm_f(wl));
    const float aa_ = sigm_f(al);
    const float kf = bf2f(((const bf16_t*)(ws + NB_RKVZ) + ((size_t)1 * XSH_ROWS + row) * 1024)[e]);
    const float rl = bf2f(((const bf16_t*)(ws + NB_RKVZ) + ((size_t)0 * XSH_ROWS + row) * 1024)[e]);
    const float vv = bf2f(((const bf16_t*)(ws + NB_RKVZ) + ((size_t)2 * XSH_ROWS + row) * 1024)[e]);
    const float kkr = kf * a.in[I_KK][e];
    const float kpl = kf * (1.f + (aa_ - 1.f) * a.in[I_KA][e]);
    const float knl = kkr / fmaxf(sqrtf(wave_sum(kkr * kkr)), 1e-12f);
    const float kal = knl * aa_;
    const float rkv = wave_sum(rl * kpl * a.in[I_RK][e]);
    float S[64];
#pragma unroll
    for (int q = 0; q < 16; ++q) { const float4 v4 = *(const float4*)(s0 + q * 4); S[4 * q] = v4.x; S[4 * q + 1] = v4.y; S[4 * q + 2] = v4.z; S[4 * q + 3] = v4.w; }
    float sa = 0.f;
#pragma unroll
    for (int k = 0; k < 64; ++k) sa = fmaf(S[k], RL(knl, k), sa);
    float y = 0.f;
#pragma unroll
    for (int k = 0; k < 64; ++k) { S[k] = fmaf(S[k], RL(decl, k), fmaf(vv, RL(kpl, k), -sa * RL(kal, k))); y = fmaf(S[k], RL(rl, k), y); }
#undef RL
#pragma unroll
    for (int q = 0; q < 16; ++q) *(float4*)(sout + q * 4) = make_float4(S[4 * q], S[4 * q + 1], S[4 * q + 2], S[4 * q + 3]);
    {
        const float mean = wave_sum(y) * (1.f / 64.f);
        const float d = y - mean;
        const float rs = rsqrtf(wave_sum(d * d) * (1.f / 64.f) + GN_EPS);
        const float zf = bf2f(((const bf16_t*)(ws + NB_RKVZ) + ((size_t)3 * XSH_ROWS + row) * 1024)[e]);
        const float o = fmaf(rkv, vv, d * rs * a.in[I_GNG][e] + a.in[I_GNB][e]) * silu_f(zf);
        ((bf16_t*)(ws + NB_G4B))[row * 1024 + e] = (bf16_t)(pk_bf16c(o, 0.f) & 0xffffu);
    }
}

constexpr int CS_LD = 72;
constexpr int CS_SLOT = 64 * CS_LD * 2;
constexpr int CS_F32A = 13 * CS_SLOT;
constexpr int CS_F32B = CS_F32A + 16384;
constexpr int CS_GS = CS_F32B + 16384;
constexpr int CS_END = CS_GS + 4096;
constexpr size_t CK_MCT = 0, CK_RY = 8192, CK_SADD = 16384, CK_Y0 = 24576, CK_BYTES = 32768;

__device__ __forceinline__ PG8_LAS bf16_t* cs_slot(PG8_LAS unsigned char* lds, int i) { return (PG8_LAS bf16_t*)(lds + i * CS_SLOT); }
template <bool SWX = false, bool SWY = false>
__device__ __forceinline__ void cs_mm(f32x16& acc, const PG8_LAS bf16_t* X, const PG8_LAS bf16_t* Yt, int mt, int nt, int lane) {
    const int lr = lane & 31, h = lane >> 5;
    const int rx = mt * 32 + lr, ry = nt * 32 + lr;
    const int sx = SWX ? ((rx >> 3) & 7) : 0, sy = SWY ? ((ry >> 3) & 7) : 0;
#pragma unroll
    for (int s = 0; s < 4; ++s) {
        const bf16x8 av = *(const PG8_LAS bf16x8*)(X + rx * CS_LD + (((2 * s + h) ^ sx) << 3));
        const bf16x8 bv = *(const PG8_LAS bf16x8*)(Yt + ry * CS_LD + (((2 * s + h) ^ sy) << 3));
        acc = __builtin_amdgcn_mfma_f32_32x32x16_bf16(av, bv, acc, 0, 0, 0);
    }
}
__device__ __forceinline__ void cs_store_t(const f32x16& acc, PG8_LAS bf16_t* D, int mt, int nt, int lane) {
    typedef unsigned u32x2 __attribute__((ext_vector_type(2)));
    const int lr = lane & 31, h = lane >> 5;
#pragma unroll
    for (int c = 0; c < 4; ++c) { u32x2 w; w.x = pk_bf16c(acc[4 * c], acc[4 * c + 1]); w.y = pk_bf16c(acc[4 * c + 2], acc[4 * c + 3]);
        *(PG8_LAS u32x2*)(D + (nt * 32 + lr) * CS_LD + mt * 32 + 8 * c + 4 * h) = w; }
}
__device__ __forceinline__ void cs_store_n(const f32x16& acc, PG8_LAS bf16_t* D, int mt, int nt, int lane) {
    const int lr = lane & 31, h = lane >> 5;
#pragma unroll
    for (int i = 0; i < 16; ++i) D[(mt * 32 + (i & 3) + 8 * (i >> 2) + 4 * h) * CS_LD + nt * 32 + lr] = (bf16_t)(pk_bf16c(acc[i], 0.f) & 0xffffu);
}
__device__ __forceinline__ void cs_zero(f32x16& a) {
#pragma unroll
    for (int i = 0; i < 16; ++i) a[i] = 0.f;
}
__device__ __forceinline__ float dpp_red8(float v) {
    v += __builtin_bit_cast(float, __builtin_amdgcn_update_dpp(0, __builtin_bit_cast(int, v), 0xB1, 0xF, 0xF, true));
    v += __builtin_bit_cast(float, __builtin_amdgcn_update_dpp(0, __builtin_bit_cast(int, v), 0x4E, 0xF, 0xF, true));
    v += __builtin_bit_cast(float, __builtin_amdgcn_update_dpp(0, __builtin_bit_cast(int, v), 0x141, 0xF, 0xF, true));
    return v;
}

struct PreRegs { u32x4 kv, rv, vv; bf16x8 af[4]; };
__device__ __forceinline__ void scanpre_load(unsigned char* ws, int b, int hd, int c, int tid, PreRegs& r) {
    const int lane = tid & 63, wv = tid >> 6, lr = lane & 31, h = lane >> 5;
    const size_t row0 = (size_t)b * TP + c * 64;
    const int tok = tid >> 3, c8 = tid & 7;
    const size_t off = (row0 + tok) * 1024 + hd * 64 + c8 * 8;
    const bf16_t* RK = (const bf16_t*)(ws + NB_RKVZ);
    r.kv = *(const u32x4*)(RK + (size_t)1 * XSH_ROWS * 1024 + off); r.rv = *(const u32x4*)(RK + off); r.vv = *(const u32x4*)(RK + (size_t)2 * XSH_ROWS * 1024 + off);
    const int which = wv >> 2, mt = (wv >> 1) & 1;
    const bf16_t* A = (const bf16_t*)(ws + (which ? NB_AWB : NB_TWB)) + (row0 + mt * 32 + lr) * 64 + h * 8;
#pragma unroll
    for (int s = 0; s < 4; ++s) r.af[s] = *(const bf16x8*)(A + s * 16);
}
__device__ __forceinline__ void scanpre_chunk(const Args& a, unsigned char* ws, PG8_LAS unsigned char* lds, int b, int hd, int c, const PreRegs& pre, const bf16x8 (&btf)[4]) {
    const int tid = opaque_v(threadIdx.x), lane = tid & 63, wv = __builtin_amdgcn_readfirstlane(tid >> 6);
    const int lr = lane & 31, h = lane >> 5;
    const size_t row0 = (size_t)b * TP + c * 64;
    typedef unsigned u32x2 __attribute__((ext_vector_type(2)));
    PG8_LAS float* LCUM = (PG8_LAS float*)(lds + CS_F32A);
    PG8_LAS float* AV = (PG8_LAS float*)(lds + CS_F32B);
    PG8_LAS float* GS = (PG8_LAS float*)(lds + CS_GS);
    unsigned char* rec = ws + NB_CHK + ((size_t)(b * 16 + hd) * 32 + c) * CK_BYTES;
    {
        const int tok = tid >> 3, c8 = tid & 7;
        *(PG8_LAS u32x4*)(cs_slot(lds, 0) + tok * CS_LD + c8 * 8) = pre.kv;
        *(PG8_LAS u32x4*)(cs_slot(lds, 1) + tok * CS_LD + c8 * 8) = pre.rv;
        *(PG8_LAS u32x4*)(cs_slot(lds, 2) + tok * CS_LD + c8 * 8) = pre.vv;
    }
    {
        const int which = wv >> 2, mt = (wv >> 1) & 1, nt = wv & 1;
        f32x16 acc; cs_zero(acc);
#pragma unroll
        for (int s = 0; s < 4; ++s) acc = __builtin_amdgcn_mfma_f32_32x32x16_bf16(pre.af[s], btf[s], acc, 0, 0, 0);
        PG8_LAS float* D = which ? AV : LCUM;
        const float bias = a.in[which ? I_A0 : I_W0][hd * 64 + nt * 32 + lr];
#pragma unroll
        for (int i = 0; i < 16; ++i) {
            const float x = acc[i] + bias;
            float y;
            if (which) y = sigm_f(x);
            else y = -0.87503504f * sigm_f(x);
            D[(mt * 32 + (i & 3) + 8 * (i >> 2) + 4 * h) * 64 + nt * 32 + lr] = y;
        }
    }
    lds_barrier();
    {
        const int ch = tid & 63, tg = tid >> 6;
        float p[8]; float run = 0.f;
#pragma unroll
        for (int i = 0; i < 8; ++i) { run += LCUM[(tg * 8 + i) * 64 + ch]; p[i] = run; }
        GS[tg * 64 + ch] = run;
        lds_barrier();
        float offs = 0.f;
        for (int g = 0; g < tg; ++g) offs += GS[g * 64 + ch];
#pragma unroll
        for (int i = 0; i < 8; ++i) LCUM[(tg * 8 + i) * 64 + ch] = p[i] + offs;
    }
    lds_barrier();
    {
        const int tok = tid >> 3, c8 = tid & 7;
        const u32x4 kw = *(const PG8_LAS u32x4*)(cs_slot(lds, 0) + tok * CS_LD + c8 * 8), rw = *(const PG8_LAS u32x4*)(cs_slot(lds, 1) + tok * CS_LD + c8 * 8),
                    vw = *(const PG8_LAS u32x4*)(cs_slot(lds, 2) + tok * CS_LD + c8 * 8);
        float kf[8], rf[8], kk[8], kp[8], av[8];
        float n2 = 0.f, rk = 0.f;
#pragma unroll
        for (int i = 0; i < 8; ++i) {
            const int e = hd * 64 + c8 * 8 + i;
            kf[i] = __uint_as_float((i & 1) ? (kw[i >> 1] & 0xffff0000u) : (kw[i >> 1] << 16));
            rf[i] = __uint_as_float((i & 1) ? (rw[i >> 1] & 0xffff0000u) : (rw[i >> 1] << 16));
            av[i] = AV[tok * 64 + c8 * 8 + i];
            kk[i] = kf[i] * a.in[I_KK][e];
            kp[i] = kf[i] * (1.f + (av[i] - 1.f) * a.in[I_KA][e]);
            n2 = fmaf(kk[i], kk[i], n2);
            rk = fmaf(rf[i] * kp[i], a.in[I_RK][e], rk);
        }
        n2 = dpp_red8(n2); rk = dpp_red8(rk);
        const float inv = 1.f / fmaxf(sqrtf(n2), 1e-12f);
        if (c8 == 0) ((float*)(ws + NB_RKS))[(row0 + tok) * 16 + hd] = rk;
        if (tok == 63) {
#pragma unroll
            for (int i = 0; i < 8; ++i) GS[512 + c8 * 8 + i] = __builtin_amdgcn_exp2f(LCUM[63 * 64 + c8 * 8 + i]);
        }
        float qt[8], rt[8], kt[8], bt[8], kh[8], bh[8];
#pragma unroll
        for (int i = 0; i < 8; ++i) {
            const int ch = c8 * 8 + i;
            const float Lt = LCUM[tok * 64 + ch], Lp = tok ? LCUM[(tok - 1) * 64 + ch] : 0.f, Lc = LCUM[63 * 64 + ch];
            const float kn = kk[i] * inv, ka = kn * av[i];
            const float en = __builtin_amdgcn_exp2f(-Lt), ec = __builtin_amdgcn_exp2f(Lc - Lt);
            qt[i] = kn * __builtin_amdgcn_exp2f(Lp); rt[i] = rf[i] * __builtin_amdgcn_exp2f(Lt); kt[i] = kp[i] * en; bt[i] = ka * en; kh[i] = kp[i] * ec; bh[i] = ka * ec;
        }
#define CS_PUT_ROW(SLOT, ARR) { u32x4 w_; w_.x = pk_bf16c(ARR[0], ARR[1]); w_.y = pk_bf16c(ARR[2], ARR[3]); w_.z = pk_bf16c(ARR[4], ARR[5]); w_.w = pk_bf16c(ARR[6], ARR[7]); \
            *(PG8_LAS u32x4*)(cs_slot(lds, SLOT) + tok * CS_LD + c8 * 8) = w_; }
#define CS_PUT_COL(SLOT, ARR) { _Pragma("unroll") for (int i_ = 0; i_ < 8; ++i_) cs_slot(lds, SLOT)[(c8 * 8 + i_) * CS_LD + tsw] = (bf16_t)(pk_bf16c(ARR[i_], 0.f) & 0xffffu); }
        const int tsw = ((((tok >> 3) ^ c8) & 7) << 3) | (tok & 7);
        CS_PUT_ROW(3, qt) CS_PUT_ROW(4, rt) CS_PUT_ROW(5, kt) CS_PUT_ROW(6, bt)
        CS_PUT_COL(7, qt) CS_PUT_COL(8, bh) CS_PUT_COL(9, kh)
#pragma unroll
        for (int i = 0; i < 8; ++i) cs_slot(lds, 10)[(c8 * 8 + i) * CS_LD + tsw] = (bf16_t)((i & 1) ? (vw[i >> 1] >> 16) : (vw[i >> 1] & 0xffffu));
#undef CS_PUT_ROW
#undef CS_PUT_COL
    }
    lds_barrier();
    {
#pragma unroll 1
        for (int j = 0; j < 2; ++j) {
            const int job = wv * 2 + j, prod = job >> 2, mt = (job >> 1) & 1, nt = job & 1;
            const PG8_LAS bf16_t* X = cs_slot(lds, (prod & 1) ? 6 : 5);
            const PG8_LAS bf16_t* Y = cs_slot(lds, (prod & 2) ? 4 : 3);
            f32x16 acc; cs_zero(acc);
            cs_mm(acc, X, Y, mt, nt, lane);
            const int t = nt * 32 + lr, incl = (prod & 2) ? 1 : 0;
#pragma unroll
            for (int i = 0; i < 16; ++i) { const int sidx = mt * 32 + (i & 3) + 8 * (i >> 2) + 4 * h; acc[i] = (sidx < t + incl) ? acc[i] : 0.f; }
            const int dst = (prod == 0) ? 0 : (prod == 1) ? 11 : (prod == 2) ? 1 : 2;
            cs_store_t(acc, cs_slot(lds, dst), mt, nt, lane);
            if (prod == 1) cs_store_n(acc, cs_slot(lds, 12), mt, nt, lane);
        }
    }
    lds_barrier();
    {
        const int mt = (wv >> 1) & 1, nt = wv & 1;
        f32x16 pacc;
        if (wv < 4) {
#pragma unroll
            for (int i = 0; i < 16; ++i) { const int u = mt * 32 + (i & 3) + 8 * (i >> 2) + 4 * h, t = nt * 32 + lr;
                pacc[i] = ((u == t) ? 1.f : 0.f) - bf2f(cs_slot(lds, 12)[u * CS_LD + t]); }
            cs_store_t(pacc, cs_slot(lds, 3), mt, nt, lane);
        }
        lds_barrier();
        const int mcur = 11, mtcur = 12, mnxt = 5, mtnxt = 6;
        PG8_LAS bf16_t* XS0 = (PG8_LAS bf16_t*)(lds + CS_F32A);
        PG8_LAS bf16_t* XS1 = (PG8_LAS bf16_t*)(lds + CS_F32A + CS_SLOT);
        PG8_LAS bf16_t* XS2 = (PG8_LAS bf16_t*)(lds + CS_F32A + 2 * CS_SLOT);
        PG8_LAS bf16_t* Pc = cs_slot(lds, 3); PG8_LAS bf16_t* Pn = XS0;
        PG8_LAS bf16_t* Mc_ = cs_slot(lds, mcur); PG8_LAS bf16_t* MTc = cs_slot(lds, mtcur);
        PG8_LAS bf16_t* Mn = cs_slot(lds, mnxt); PG8_LAS bf16_t* MTn = cs_slot(lds, mtnxt);
#pragma unroll 1
        for (int it = 0; it < 5; ++it) {
            if (wv >= 4) {
                f32x16 acc; cs_zero(acc);
                cs_mm(acc, Mc_, MTc, mt, nt, lane);
                cs_store_n(acc, Mn, mt, nt, lane);
                cs_store_t(acc, MTn, mt, nt, lane);
                float mx = 0.f;
#pragma unroll
                for (int i = 0; i < 16; ++i) mx = fmaxf(mx, fabsf(acc[i]));
#pragma unroll
                for (int o = 32; o > 0; o >>= 1) mx = fmaxf(mx, __shfl_xor(mx, o));
                if (lane == 0) GS[640 + (wv & 3)] = mx;
            }
            lds_barrier();
            const float m2max = fmaxf(fmaxf(GS[640], GS[641]), fmaxf(GS[642], GS[643]));
            if (wv < 4) {
                cs_mm(pacc, MTn, Pc, mt, nt, lane);
                cs_store_t(pacc, Pn, mt, nt, lane);
            }
            lds_barrier();
            { PG8_LAS bf16_t* t0 = Mc_; Mc_ = Mn; Mn = t0; t0 = MTc; MTc = MTn; MTn = t0; t0 = Pc; Pc = Pn; Pn = t0; }
            if (m2max < 3e-4f) break;
        }
        {
            f32x16 acc; cs_zero(acc);
            if (wv < 4) { cs_mm<false, true>(acc, cs_slot(lds, 0), cs_slot(lds, 10), mt, nt, lane); cs_store_t(acc, XS1, mt, nt, lane); }
            else { cs_mm<false, true>(acc, Pc, cs_slot(lds, 7), mt, nt, lane); cs_store_t(acc, XS2, mt, nt, lane); }
        }
        lds_barrier();
        if (wv < 4) { f32x16 acc; cs_zero(acc); cs_mm(acc, Pc, XS1, mt, nt, lane); cs_store_t(acc, cs_slot(lds, 11), mt, nt, lane); }
        lds_barrier();
        if (wv < 4) {
            f32x16 acc; cs_zero(acc);
            cs_mm<false, true>(acc, XS2, cs_slot(lds, 8), mt, nt, lane);
#pragma unroll
            for (int i = 0; i < 16; ++i) { const int k = mt * 32 + (i & 3) + 8 * (i >> 2) + 4 * h, kp_ = nt * 32 + lr; acc[i] = ((k == kp_) ? GS[512 + k] : 0.f) - acc[i]; }
            bf16_t* mct = (bf16_t*)(rec + CK_MCT);
#pragma unroll
            for (int cc = 0; cc < 4; ++cc) { u32x2 w; w.x = pk_bf16c(acc[4 * cc], acc[4 * cc + 1]); w.y = pk_bf16c(acc[4 * cc + 2], acc[4 * cc + 3]);
                *(u32x2*)(mct + ((nt * 4 + 2 * mt + (cc >> 1)) * 64 + lr + 32 * (cc & 1)) * 8 + 4 * h) = w; }
            f32x16 s1, s2; cs_zero(s1); cs_zero(s2);
            cs_mm<true, true>(s1, cs_slot(lds, 9), cs_slot(lds, 10), mt, nt, lane);
            cs_mm<true, false>(s2, cs_slot(lds, 8), cs_slot(lds, 11), mt, nt, lane);
            bf16_t* sd = (bf16_t*)(rec + CK_SADD) + ((size_t)(wv & 3) * 64 + lane) * 16;
#pragma unroll
            for (int q8 = 0; q8 < 2; ++q8) { u32x4 w;
                w.x = pk_bf16c(s1[8 * q8] - s2[8 * q8], s1[8 * q8 + 1] - s2[8 * q8 + 1]); w.y = pk_bf16c(s1[8 * q8 + 2] - s2[8 * q8 + 2], s1[8 * q8 + 3] - s2[8 * q8 + 3]);
                w.z = pk_bf16c(s1[8 * q8 + 4] - s2[8 * q8 + 4], s1[8 * q8 + 5] - s2[8 * q8 + 5]); w.w = pk_bf16c(s1[8 * q8 + 6] - s2[8 * q8 + 6], s1[8 * q8 + 7] - s2[8 * q8 + 7]);
                *(u32x4*)(sd + q8 * 8) = w; }
        } else {
            f32x16 acc; cs_zero(acc);
            cs_mm(acc, XS2, cs_slot(lds, 2), mt, nt, lane);
            bf16_t* ry = (bf16_t*)(rec + CK_RY);
#pragma unroll
            for (int cc = 0; cc < 4; ++cc) {
                const u32x2 rv = *(const PG8_LAS u32x2*)(cs_slot(lds, 4) + (nt * 32 + lr) * CS_LD + mt * 32 + 8 * cc + 4 * h);
                const float r0 = __uint_as_float(rv.x << 16), r1 = __uint_as_float(rv.x & 0xffff0000u), r2 = __uint_as_float(rv.y << 16), r3 = __uint_as_float(rv.y & 0xffff0000u);
                u32x2 w; w.x = pk_bf16c(r0 - acc[4 * cc], r1 - acc[4 * cc + 1]); w.y = pk_bf16c(r2 - acc[4 * cc + 2], r3 - acc[4 * cc + 3]);
                *(u32x2*)(ry + ((nt * 4 + 2 * mt + (cc >> 1)) * 64 + lr + 32 * (cc & 1)) * 8 + 4 * h) = w;
            }
            f32x16 s1, s2; cs_zero(s1); cs_zero(s2);
            cs_mm<false, true>(s1, cs_slot(lds, 1), cs_slot(lds, 10), mt, nt, lane);
            cs_mm(s2, cs_slot(lds, 2), cs_slot(lds, 11), mt, nt, lane);
            bf16_t* yd = (bf16_t*)(rec + CK_Y0) + ((size_t)(wv & 3) * 64 + lane) * 16;
#pragma unroll
            for (int q8 = 0; q8 < 2; ++q8) { u32x4 w;
                w.x = pk_bf16c(s1[8 * q8] - s2[8 * q8], s1[8 * q8 + 1] - s2[8 * q8 + 1]); w.y = pk_bf16c(s1[8 * q8 + 2] - s2[8 * q8 + 2], s1[8 * q8 + 3] - s2[8 * q8 + 3]);
                w.z = pk_bf16c(s1[8 * q8 + 4] - s2[8 * q8 + 4], s1[8 * q8 + 5] - s2[8 * q8 + 5]); w.w = pk_bf16c(s1[8 * q8 + 6] - s2[8 * q8 + 6], s1[8 * q8 + 7] - s2[8 * q8 + 7]);
                *(u32x4*)(yd + q8 * 8) = w; }
        }
    }
    lds_barrier();
}

struct SeqRegs { bf16x8 a[4]; u32x4 c[2]; };
__device__ __forceinline__ void seq_load(const unsigned char* rec, int wv, int mt, int lane, SeqRegs& r) {
    const bf16_t* ap = (const bf16_t*)(rec + CK_MCT) + ((size_t)mt * 4 * 64 + lane) * 8;
    const bf16_t* cp = (const bf16_t*)(rec + CK_SADD) + ((size_t)(wv & 3) * 64 + lane) * 16;
#pragma unroll
    for (int s = 0; s < 4; ++s) r.a[s] = *(const bf16x8*)(ap + s * 64 * 8);
    r.c[0] = *(const u32x4*)cp; r.c[1] = *(const u32x4*)(cp + 8);
}
__device__ __forceinline__ void scanseq_head(const Args& a, unsigned char* ws, PG8_LAS unsigned char* lds, int b, int hd) {
    const int tid = opaque_v(threadIdx.x), lane = tid & 63, wv = __builtin_amdgcn_readfirstlane(tid >> 6);
    const int lr = lane & 31, h = lane >> 5;
    const int mt = (wv >> 1) & 1, nt = wv & 1;
    const bool isS = wv < 4;
    PG8_LAS bf16_t* SB0 = cs_slot(lds, 0); PG8_LAS bf16_t* SB1 = cs_slot(lds, 1);
    f32x16 st; cs_zero(st);
    for (int i = tid; i < 64 * CS_LD; i += NTH) { SB0[i] = 0; }
    const unsigned char* rec0 = ws + NB_CHK + (size_t)(b * 16 + hd) * 32 * CK_BYTES;
    bf16_t* srec0 = (bf16_t*)(ws + NB_SREC) + (size_t)(b * 16 + hd) * 32 * 4096;
    const int cr = (tid & 255) >> 2, cc8 = (tid & 3) * 16;
    lds_barrier();
    if (isS) {
        SeqRegs r[4];
#pragma unroll
        for (int c = 0; c < 4; ++c) seq_load(rec0 + (size_t)c * CK_BYTES, wv, mt, lane, r[c]);
#pragma unroll
        for (int c = 0; c < 32; ++c) {
            const PG8_LAS bf16_t* S = (c & 1) ? SB1 : SB0;
            PG8_LAS bf16_t* Sn = (c & 1) ? SB0 : SB1;
            f32x16 acc;
#pragma unroll
            for (int i = 0; i < 16; ++i) { const unsigned w = r[c & 3].c[i >> 3][(i & 7) >> 1]; acc[i] = __uint_as_float((i & 1) ? (w & 0xffff0000u) : (w << 16)); }
#pragma unroll
            for (int s = 0; s < 4; ++s) {
                const bf16x8 bv = *(const PG8_LAS bf16x8*)(S + (nt * 32 + lr) * CS_LD + s * 16 + h * 8);
                acc = __builtin_amdgcn_mfma_f32_32x32x16_bf16(r[c & 3].a[s], bv, acc, 0, 0, 0);
            }
            st = acc; cs_store_t(st, Sn, mt, nt, lane);
            if (c + 4 < 32) seq_load(rec0 + (size_t)(c + 4) * CK_BYTES, wv, mt, lane, r[c & 3]);
            lds_barrier();
        }
    } else {
#pragma unroll 1
        for (int c = 0; c < 32; ++c) {
            const PG8_LAS bf16_t* S = (c & 1) ? SB1 : SB0;
            const u32x4 v0 = *(const PG8_LAS u32x4*)(S + cr * CS_LD + cc8), v1 = *(const PG8_LAS u32x4*)(S + cr * CS_LD + cc8 + 8);
            bf16_t* d = srec0 + (size_t)c * 4096 + cr * 64 + cc8;
            *(u32x4*)d = v0; *(u32x4*)(d + 8) = v1;
            lds_barrier();
        }
    }
    if (isS) {
        float* so = a.out + O_WKVP + ((size_t)(b * 16 + hd) * 64 + nt * 32 + lr) * 64 + mt * 32 + 4 * h;
#pragma unroll
        for (int cc = 0; cc < 4; ++cc) *(float4*)(so + 8 * cc) = make_float4(st[4 * cc], st[4 * cc + 1], st[4 * cc + 2], st[4 * cc + 3]);
    }
    lds_barrier();
}
struct YgRegs { bf16x8 a[4]; u32x4 c[2]; u32x4 s0, s1; u32x4 vw[2], zw[2]; float rk; };
__device__ __forceinline__ void yg_load(unsigned char* ws, int ci, int tid, YgRegs& r) {
    const int lane = tid & 63, wv = tid >> 6, t4 = tid & 255;
    const int mt = (wv >> 1) & 1;
    const unsigned char* rec = ws + NB_CHK + (size_t)ci * CK_BYTES;
    const bf16_t* ap = (const bf16_t*)(rec + CK_RY) + ((size_t)mt * 4 * 64 + lane) * 8;
    const bf16_t* cp = (const bf16_t*)(rec + CK_Y0) + ((size_t)(wv & 3) * 64 + lane) * 16;
#pragma unroll
    for (int s = 0; s < 4; ++s) r.a[s] = *(const bf16x8*)(ap + s * 64 * 8);
    r.c[0] = *(const u32x4*)cp; r.c[1] = *(const u32x4*)(cp + 8);
    const bf16_t* sp = (const bf16_t*)(ws + NB_SREC) + (size_t)ci * 4096 + (t4 >> 2) * 64 + (t4 & 3) * 16;
    r.s0 = *(const u32x4*)sp; r.s1 = *(const u32x4*)(sp + 8);
    const int bh = ci >> 5, c = ci & 31, b = bh >> 4, hd = bh & 15;
    const size_t prow = (size_t)b * TP + c * 64 + (t4 >> 2);
    const int pv = (t4 & 3) * 16;
    const bf16_t* vp = (const bf16_t*)(ws + NB_RKVZ) + ((size_t)2 * XSH_ROWS + prow) * 1024 + hd * 64 + pv;
    const bf16_t* zp = (const bf16_t*)(ws + NB_RKVZ) + ((size_t)3 * XSH_ROWS + prow) * 1024 + hd * 64 + pv;
    r.vw[0] = *(const u32x4*)vp; r.vw[1] = *(const u32x4*)(vp + 8); r.zw[0] = *(const u32x4*)zp; r.zw[1] = *(const u32x4*)(zp + 8);
    r.rk = ((const float*)(ws + NB_RKS))[prow * 16 + hd];
}
__device__ __forceinline__ void yg_step(const Args& a, unsigned char* ws, PG8_LAS unsigned char* lds, int ci, int tid, const YgRegs& r) {
    const int lane = tid & 63, wv = tid >> 6, t4 = tid & 255, grp = wv >> 2;
    const int lr = lane & 31, h = lane >> 5, mt = (wv >> 1) & 1, nt = wv & 1;
    PG8_LAS bf16_t* SL = cs_slot(lds, grp);
    PG8_LAS float* YT = (PG8_LAS float*)(lds + 2 * CS_SLOT) + grp * (64 * 68);
    *(PG8_LAS u32x4*)(SL + (t4 >> 2) * CS_LD + (t4 & 3) * 16) = r.s0; *(PG8_LAS u32x4*)(SL + (t4 >> 2) * CS_LD + (t4 & 3) * 16 + 8) = r.s1;
    lds_barrier();
    {
        f32x16 acc;
#pragma unroll
        for (int i = 0; i < 16; ++i) { const unsigned w = r.c[i >> 3][(i & 7) >> 1]; acc[i] = __uint_as_float((i & 1) ? (w & 0xffff0000u) : (w << 16)); }
#pragma unroll
        for (int s = 0; s < 4; ++s) {
            const bf16x8 bv = *(const PG8_LAS bf16x8*)(SL + (nt * 32 + lr) * CS_LD + s * 16 + h * 8);
            acc = __builtin_amdgcn_mfma_f32_32x32x16_bf16(r.a[s], bv, acc, 0, 0, 0);
        }
#pragma unroll
        for (int i = 0; i < 16; ++i) YT[(mt * 32 + (i & 3) + 8 * (i >> 2) + 4 * h) * 68 + nt * 32 + lr] = acc[i];
    }
    lds_barrier();
    {
        const int ptok = t4 >> 2, pv = (t4 & 3) * 16;
        const int bh = ci >> 5, c = ci & 31, b = bh >> 4, hd = bh & 15;
        float y[16];
#pragma unroll
        for (int q = 0; q < 4; ++q) { const f32x4 v = *(const PG8_LAS f32x4*)(YT + ptok * 68 + pv + q * 4); y[4 * q] = v[0]; y[4 * q + 1] = v[1]; y[4 * q + 2] = v[2]; y[4 * q + 3] = v[3]; }
        float sm = 0.f;
#pragma unroll
        for (int i = 0; i < 16; ++i) sm += y[i];
        sm += __builtin_bit_cast(float, __builtin_amdgcn_update_dpp(0, __builtin_bit_cast(int, sm), 0xB1, 0xF, 0xF, true));
        sm += __builtin_bit_cast(float, __builtin_amdgcn_update_dpp(0, __builtin_bit_cast(int, sm), 0x4E, 0xF, 0xF, true));
        const float mean = sm * (1.f / 64.f);
        float sq = 0.f;
#pragma unroll
        for (int i = 0; i < 16; ++i) { y[i] -= mean; sq += y[i] * y[i]; }
        sq += __builtin_bit_cast(float, __builtin_amdgcn_update_dpp(0, __builtin_bit_cast(int, sq), 0xB1, 0xF, 0xF, true));
        sq += __builtin_bit_cast(float, __builtin_amdgcn_update_dpp(0, __builtin_bit_cast(int, sq), 0x4E, 0xF, 0xF, true));
        const float rs = rsqrtf(sq * (1.f / 64.f) + GN_EPS);
        const float* gg = a.in[I_GNG] + hd * 64 + pv; const float* gb = a.in[I_GNB] + hd * 64 + pv;
        float o[16];
#pragma unroll
        for (int i = 0; i < 16; ++i) {
            const unsigned vw = r.vw[i >> 3][(i & 7) >> 1], zw = r.zw[i >> 3][(i & 7) >> 1];
            const float vf = __uint_as_float((i & 1) ? (vw & 0xffff0000u) : (vw << 16)), zf = __uint_as_float((i & 1) ? (zw & 0xffff0000u) : (zw << 16));
            o[i] = fmaf(r.rk, vf, y[i] * rs * gg[i] + gb[i]) * silu_f(zf);
        }
        bf16_t* dst = (bf16_t*)(ws + NB_G4B) + ((size_t)b * TP + c * 64 + ptok) * 1024 + hd * 64 + pv;
        u32x4 w0, w1;
        w0.x = pk_bf16c(o[0], o[1]); w0.y = pk_bf16c(o[2], o[3]); w0.z = pk_bf16c(o[4], o[5]); w0.w = pk_bf16c(o[6], o[7]);
        w1.x = pk_bf16c(o[8], o[9]); w1.y = pk_bf16c(o[10], o[11]); w1.z = pk_bf16c(o[12], o[13]); w1.w = pk_bf16c(o[14], o[15]);
        *(u32x4*)dst = w0; *(u32x4*)(dst + 8) = w1;
    }
}
__device__ __forceinline__ void phase_ygate(const Args& a, unsigned char* ws, PG8_LAS unsigned char* lds, int bid, int nb) {
    const int tid = opaque_v(threadIdx.x), grp = tid >> 8;
    YgRegs cur, nxt;
    int pair = bid;
    if (pair < 2048) yg_load(ws, 2 * pair + grp, tid, nxt);
#pragma unroll 1
    while (pair < 2048) {
        cur = nxt;
        const int npair = pair + nb;
        if (npair < 2048) yg_load(ws, 2 * npair + grp, tid, nxt);
        yg_step(a, ws, lds, 2 * pair + grp, tid, cur);
        pair = npair;
    }
    lds_barrier();
}

__device__ __forceinline__ void phase_lnf(const Args& a, unsigned char* ws, int bid, int nb) {
    const int tid = opaque_v(threadIdx.x), lane = tid & 63, wv = tid >> 6;
    const float* PRE = (const float*)ws + WS_PRE;
    const bf16_t* P2 = (const bf16_t*)(ws + NB_Y);
    float x[16], nx[16], y[16]; uint2 ny[4];
    int row = bid * 8 + wv;
    if (row < MT) { ld_row16(PRE + (size_t)row * 1024, lane, nx);
#pragma unroll
        for (int q = 0; q < 4; ++q) ny[q] = *(const uint2*)(P2 + (size_t)row * 1024 + q * 256 + lane * 4); }
#pragma unroll 1
    while (row < MT) {
#pragma unroll
        for (int i = 0; i < 16; ++i) x[i] = nx[i];
#pragma unroll
        for (int q = 0; q < 4; ++q) { y[4 * q] = __uint_as_float(ny[q].x << 16); y[4 * q + 1] = __uint_as_float(ny[q].x & 0xffff0000u); y[4 * q + 2] = __uint_as_float(ny[q].y << 16); y[4 * q + 3] = __uint_as_float(ny[q].y & 0xffff0000u); }
        const int nrow = row + nb * 8;
        if (nrow < MT) { ld_row16(PRE + (size_t)nrow * 1024, lane, nx);
#pragma unroll
            for (int q = 0; q < 4; ++q) ny[q] = *(const uint2*)(P2 + (size_t)nrow * 1024 + q * 256 + lane * 4); }
        ln_calc16(a.in[I_LNG], a.in[I_LNB], lane, x);
#pragma unroll
        for (int i = 0; i < 16; ++i) x[i] = fmaf(ALPHA, x[i], y[i]);
        ln_calc16(a.in[I_LNG] + 1024, a.in[I_LNB] + 1024, lane, x);
#if PROBE_TIME >= 0
        if (row >= MP) {
            const unsigned long long* tsp = (const unsigned long long*)(ws + NB_BAR + 16384);
            const float dt_us = (float)(__hip_atomic_load(tsp + PROBE_TIME + 1, __ATOMIC_RELAXED, __HIP_MEMORY_SCOPE_AGENT) - __hip_atomic_load(tsp + PROBE_TIME, __ATOMIC_RELAXED, __HIP_MEMORY_SCOPE_AGENT)) * 0.01f;
            const float f = 1.f + PROBE_K * dt_us;
#pragma unroll
            for (int i = 0; i < 16; ++i) x[i] *= f;
        }
#endif
        float* o = (row < MP ? a.out + O_Y + (size_t)row * 1024 : a.out + O_YS + (size_t)(row - MP) * 1024) + lane * 4;
#pragma unroll
        for (int q = 0; q < 4; ++q) *(float4*)(o + q * 256) = make_float4(x[4 * q], x[4 * q + 1], x[4 * q + 2], x[4 * q + 3]);
        row = nrow;
    }
}
__device__ __forceinline__ void sample_pool_copy(const Args& a, unsigned char* ws, int bid, int nb) {
    float* KCS = (float*)(ws + NB_KCS);
    const int* pt = (const int*)a.in[I_PT];
    const float* ccmp = a.in[I_CCMP];
#pragma unroll 2
    for (int i = bid * NTH + threadIdx.x; i < BS * 256 * 256; i += nb * NTH) {
        const int c = i & 255, n = (i >> 8) & 255, s = i >> 16;
        const int kv = c >> 7, g = (c >> 6) & 1;
        const float* w = kv ? a.in[I_WVC] : a.in[I_WKC];
        const int pos0 = n * 32;
        const float* src = ccmp + ((size_t)pt[s * NPAGE + (pos0 >> 7)] * PAGE + (pos0 & 127)) * 256 + c;
        float acc = 0.f;
#pragma unroll
        for (int l = 0; l < 32; ++l) acc = fmaf(src[(size_t)l * 256], w[l * 2 + g], acc);
        KCS[i] = acc;
    }
    const float4* cw = (const float4*)a.in[I_CWIN];
    float4* ow = (float4*)(a.out + O_WINS);
#pragma unroll 4
    for (int i = bid * NTH + threadIdx.x; i < BS * 511 * 64; i += nb * NTH) {
        const int s = i / (511 * 64), rem = i - s * (511 * 64);
        ow[(size_t)s * 512 * 64 + rem] = cw[(size_t)s * 512 * 64 + 64 + rem];
    }
}
__device__ __forceinline__ void sample_conv(const Args& a, unsigned char* ws, PG8_LAS unsigned char* lds, int s) {
    const int ch = opaque_v(threadIdx.x);
    const bf16_t* h = (const bf16_t*)(ws + NB_HB) + (size_t)(MP + s) * 2560;
    const float* sc = a.in[I_SCONV] + (size_t)s * 30 * 512 + ch;
    const float u = bf2f(h[ch]) * sigm_f(bf2f(h[512 + ch]));
    float scv[30], wj[31];
    const float* __restrict__ cwp = a.in[I_CONVW] + ch;
#pragma unroll
    for (int j = 0; j < 30; ++j) { scv[j] = sc[(size_t)j * 512]; wj[j] = cwp[j * 512]; }
    wj[30] = cwp[30 * 512];
    float acc = a.in[I_CONVB][ch];
#pragma unroll
    for (int j = 0; j < 30; ++j) acc = fmaf(wj[j], scv[j], acc);
    acc = fmaf(wj[30], u, acc);
    float* __restrict__ oc = a.out + O_CONVS + (size_t)s * 30 * 512 + ch;
#pragma unroll
    for (int i = 0; i < 29; ++i) oc[(size_t)i * 512] = scv[i + 1];
    oc[(size_t)29 * 512] = u;
    PG8_LAS float* red = (PG8_LAS float*)lds;
    const int lane = ch & 63, wv = ch >> 6;
    float sm = wave_sum(acc);
    __syncthreads();
    if (lane == 0) red[wv] = sm;
    __syncthreads();
    float tot = 0.f;
#pragma unroll
    for (int i = 0; i < 8; ++i) tot += red[i];
    const float mean = tot * (1.f / 512.f);
    const float d = acc - mean;
    float sq = wave_sum(d * d);
    __syncthreads();
    if (lane == 0) red[wv] = sq;
    __syncthreads();
    tot = 0.f;
#pragma unroll
    for (int i = 0; i < 8; ++i) tot += red[i];
    const float rs = rsqrtf(tot * (1.f / 512.f) + LN_EPS);
    const float y = silu_f(d * rs * a.in[I_CLNG][ch] + a.in[I_CLNB][ch]) * silu_f(bf2f(h[1024 + ch]));
    ((bf16_t*)(ws + NB_CATB))[(size_t)(MP + s) * 1024 + ch] = (bf16_t)(pk_bf16(y, 0.f) & 0xffffu);
    __syncthreads();
}

constexpr int SP_STRIDE = 66;
__device__ __forceinline__ void sample_attn(const Args& a, unsigned char* ws, PG8_LAS unsigned char* lds, int s, int g, int part) {
    const int tid = opaque_v(threadIdx.x), lane = tid & 63, wv = __builtin_amdgcn_readfirstlane(tid >> 6);
    PG8_LAS float* PC = (PG8_LAS float*)lds;
    PG8_LAS float* IMP = (PG8_LAS float*)(lds + 4096);
    PG8_LAS int* SEL = (PG8_LAS int*)(lds + 4096 + 1024);
    PG8_LAS int* FLG = (PG8_LAS int*)(lds + 4096 + 1024 + 128);
    PG8_LAS float* PS = (PG8_LAS float*)(lds + 8192) + (tid >> 6) * 64;
    const int r = wv & 3, hh = g * 4 + r;
    const float slope = __builtin_amdgcn_exp2f(-(float)(hh + 1));
    const int* pt = (const int*)a.in[I_PT] + s * NPAGE;
    const bf16_t* hrow = (const bf16_t*)(ws + NB_HB) + (size_t)(MP + s) * 2560;
    float q[64];
#pragma unroll
    for (int d8 = 0; d8 < 8; ++d8) { const u32x4 w = *(const u32x4*)(hrow + 1536 + hh * 64 + d8 * 8);
#pragma unroll
        for (int i = 0; i < 4; ++i) { q[d8 * 8 + 2 * i] = __uint_as_float(w[i] << 16); q[d8 * 8 + 2 * i + 1] = __uint_as_float(w[i] & 0xffff0000u); } }
#define SAMP_DOT(KPTR, OUT) { const float4* k4_ = (const float4*)(KPTR); float4 kk_[16]; \
        _Pragma("unroll") for (int i_ = 0; i_ < 16; ++i_) kk_[i_] = k4_[i_]; float s_ = 0.f; \
        _Pragma("unroll") for (int i_ = 0; i_ < 16; ++i_) { s_ = fmaf(q[4 * i_], kk_[i_].x, s_); s_ = fmaf(q[4 * i_ + 1], kk_[i_].y, s_); s_ = fmaf(q[4 * i_ + 2], kk_[i_].z, s_); s_ = fmaf(q[4 * i_ + 3], kk_[i_].w, s_); } OUT = s_; }
    if (wv < 4) {
        const float* kc = (const float*)(ws + NB_KCS) + (size_t)s * 256 * 256 + g * 64;
        float sc[4];
        float mx = -INFINITY;
#pragma unroll
        for (int i = 0; i < 4; ++i) { const int n = lane + 64 * i; float d; SAMP_DOT(kc + (size_t)n * 256, d); sc[i] = d - slope * (float)(PAST - (32 * n + 31)); mx = fmaxf(mx, sc[i]); }
#pragma unroll
        for (int o = 32; o > 0; o >>= 1) mx = fmaxf(mx, __shfl_xor(mx, o));
        float ls = 0.f;
#pragma unroll
        for (int i = 0; i < 4; ++i) { sc[i] = __expf(sc[i] - mx); ls += sc[i]; }
        ls = wave_sum(ls);
        const float inv = 1.f / ls;
#pragma unroll
        for (int i = 0; i < 4; ++i) PC[r * 256 + lane + 64 * i] = sc[i] * inv;
    }
    __syncthreads();
    if (wv < 4 && part == 0) {
        const float* vc = (const float*)(ws + NB_KCS) + (size_t)s * 256 * 256 + 128 + g * 64 + lane;
        float oc0 = 0.f, oc1 = 0.f, oc2 = 0.f, oc3 = 0.f;
#pragma unroll 8
        for (int n = 0; n < 256; n += 4) {
            oc0 = fmaf(PC[r * 256 + n], vc[(size_t)n * 256], oc0); oc1 = fmaf(PC[r * 256 + n + 1], vc[(size_t)(n + 1) * 256], oc1);
            oc2 = fmaf(PC[r * 256 + n + 2], vc[(size_t)(n + 2) * 256], oc2); oc3 = fmaf(PC[r * 256 + n + 3], vc[(size_t)(n + 3) * 256], oc3);
        }
        ((float*)(ws + NB_OCS))[(size_t)(s * 8 + hh) * 64 + lane] = (oc0 + oc1) + (oc2 + oc3);
    }
    if (tid < 129) {
        float v = 0.f;
        if (tid < 128) { for (int rr = 0; rr < 4; ++rr) v += PC[rr * 256 + 2 * tid] + PC[rr * 256 + 2 * tid + 1]; }
        if (tid == 0 || tid >= 127) v = 1e4f;
        IMP[tid] = v;
    }
    __syncthreads();
    if (tid < 129) {
        const float vj = IMP[tid];
        int rank = 0;
        for (int i = 0; i < 129; ++i) { const float vi = IMP[i]; rank += (vi > vj || (vi == vj && i < tid)) ? 1 : 0; }
        FLG[tid] = (rank < 16) ? 1 : 0;
    }
    __syncthreads();
    if (tid < 129 && FLG[tid]) { int slot = 0; for (int i = 0; i < tid; ++i) slot += FLG[i]; SEL[slot] = tid; }
    __syncthreads();
    const float* csel = a.in[I_CSEL];
    const float* newsel = a.out + O_SELS + (size_t)s * 256;
    const float* cwin = a.in[I_CWIN] + (size_t)s * 512 * 256;
    const float* newwin = a.out + O_WINS + (size_t)(s * 512 + 511) * 256;
#pragma unroll 1
    for (int it = 0; it < 3; ++it) {
        const int lb = (wv >> 2) + 2 * it;
        const bool is_sel = lb < 4;
        const int slot = is_sel ? part * 4 + lb : part * 2 + (lb - 4);
        const float* rowp; const float* vb; int vstride_last; float dist; bool valid; int nk;
        if (is_sel) {
            const int blk = SEL[slot];
            const int kpos = blk * 64 + lane;
            valid = kpos <= PAST;
            rowp = (blk < 128) ? csel + ((size_t)pt[blk >> 1] * PAGE + (kpos & 127)) * 256 : newsel;
            vb = (blk < 128) ? csel + ((size_t)pt[blk >> 1] * PAGE + ((blk * 64) & 127)) * 256 + 128 + g * 64 + lane : newsel + 128 + g * 64 + lane;
            nk = (blk < 128) ? 64 : 1; dist = (float)(PAST - kpos); vstride_last = 0;
        } else {
            const int i0 = 1 + slot * 64;
            const int i = i0 + lane;
            valid = true; nk = 64;
            rowp = (i < 512) ? cwin + (size_t)i * 256 : newwin;
            vb = cwin + (size_t)i0 * 256 + 128 + g * 64 + lane;
            dist = (float)(512 - i); vstride_last = (slot == 7) ? 1 : 0;
        }
        float sc = -INFINITY;
        if (valid) { float d; SAMP_DOT(rowp + g * 64, d); sc = d - slope * dist; }
        float mx = sc;
#pragma unroll
        for (int of = 32; of > 0; of >>= 1) mx = fmaxf(mx, __shfl_xor(mx, of));
        const float p = valid ? __expf(sc - mx) : 0.f;
        const float l = wave_sum(p);
        PS[lane] = p; __builtin_amdgcn_wave_barrier();
        float o0 = 0.f, o1 = 0.f, o2 = 0.f, o3 = 0.f;
        if (nk == 64) {
            float vv[64];
#pragma unroll
            for (int k = 0; k < 63; ++k) vv[k] = vb[(size_t)k * 256];
            vv[63] = vstride_last ? newwin[128 + g * 64 + lane] : vb[(size_t)63 * 256];
#pragma unroll
            for (int k = 0; k < 64; k += 4) { o0 = fmaf(PS[k], vv[k], o0); o1 = fmaf(PS[k + 1], vv[k + 1], o1); o2 = fmaf(PS[k + 2], vv[k + 2], o2); o3 = fmaf(PS[k + 3], vv[k + 3], o3); }
        } else o0 = PS[0] * vb[0];
        __builtin_amdgcn_wave_barrier();
        float* pp = (float*)(ws + NB_PARTS) + ((size_t)((s * 8 + hh) * 24 + (is_sel ? slot : 16 + slot))) * SP_STRIDE;
        pp[2 + lane] = (o0 + o1) + (o2 + o3);
        if (lane == 0) { pp[0] = mx; pp[1] = l; }
    }
#undef SAMP_DOT
    __syncthreads();
}
__device__ __forceinline__ void sample_combine(const Args& a, unsigned char* ws, int s, int g) {
    const int tid = opaque_v(threadIdx.x), lane = tid & 63, wv = __builtin_amdgcn_readfirstlane(tid >> 6);
    if (wv >= 4) return;
    const int hh = g * 4 + wv;
    const float* pp = (const float*)(ws + NB_PARTS) + (size_t)(s * 8 + hh) * 24 * SP_STRIDE;
    const float* g3p = (const float*)(ws + NB_G3) + (size_t)(MP + s) * 32 + hh * 3;
    const float gc = sigm_f(g3p[0]), gs = sigm_f(g3p[1]), gw = sigm_f(g3p[2]);
    float res = gc * ((const float*)(ws + NB_OCS))[(size_t)(s * 8 + hh) * 64 + lane];
#pragma unroll
    for (int br = 0; br < 2; ++br) {
        const int n0 = br ? 16 : 0, cnt = br ? 8 : 16;
        float M = -INFINITY;
        for (int i = 0; i < cnt; ++i) M = fmaxf(M, pp[(size_t)(n0 + i) * SP_STRIDE]);
        float L = 0.f, O = 0.f;
        for (int i = 0; i < cnt; ++i) { const float* q = pp + (size_t)(n0 + i) * SP_STRIDE; const float w = __expf(q[0] - M); L = fmaf(q[1], w, L); O = fmaf(q[2 + lane], w, O); }
        res = fmaf(br ? gw : gs, O / L, res);
    }
    const bf16_t* hrow = (const bf16_t*)(ws + NB_HB) + (size_t)(MP + s) * 2560;
    const float y = res * silu_f(bf2f(hrow[2048 + hh * 64 + lane]));
    ((bf16_t*)(ws + NB_CATB))[(size_t)(MP + s) * 1024 + 512 + hh * 64 + lane] = (bf16_t)(pk_bf16(y, 0.f) & 0xffffu);
}

static_assert(CS_END <= LDS_MISC, "chunk-scan LDS map overlaps the barrier words");
enum { PH_PREP = 0, PH_GEMM1, PH_CONV, PH_ATTN, PH_GEMM2, PH_LNS, PH_GEMM3, PH_PREP2, PH_SCAN, PH_POST, PH_GEMM4, PH_LNF, NPHASE };

__global__ void __launch_bounds__(NTH, 2) mega(Args a) {
    extern __shared__ __attribute__((aligned(16))) unsigned char lds_raw[];
    PG8_LAS unsigned char* lds = (PG8_LAS unsigned char*)lds_raw;
    unsigned char* ws = a.ws;
    volatile LAS unsigned* misc = (volatile LAS unsigned*)(lds + LDS_MISC);
    if (threadIdx.x < 4) misc[threadIdx.x] = 0u;
    __syncthreads();
    XcdBarrier bar = xcd_barrier_post((unsigned*)(ws + NB_BAR), misc);
    const int lo = a.ph_lo, hi = a.ph_hi;
#ifndef DUP_SATTN
#define DUP_SATTN 0
#endif
#ifndef DUP_CONV
#define DUP_CONV 0
#endif
#ifndef DUP_GEMM1
#define DUP_GEMM1 0
#endif
#ifndef SKIPMASK
#define SKIPMASK 0
#endif
#define IN(k) (lo <= (k) && (k) < hi && !((SKIPMASK >> (k)) & 1))
#ifndef REPMASK
#define REPMASK 0
#endif
#define REPS(k) _Pragma("unroll 1") for (int rep_ = 0; rep_ < (((REPMASK >> (k)) & 1) ? 2 : 1); ++rep_)
#if PROBE_TIME >= 0
    unsigned long long* const tstamp = (unsigned long long*)(ws + NB_BAR + 16384);
#define STAMP(i) do { if (blockIdx.x == 0 && threadIdx.x == 0) __hip_atomic_store(tstamp + (i), (unsigned long long)__builtin_amdgcn_s_memrealtime(), __ATOMIC_RELAXED, __HIP_MEMORY_SCOPE_AGENT); } while (0)
#else
#define STAMP(i) do { } while (0)
#endif
#define SEAM(k) do { if (IN(k) && IN((k) + 1)) xcd_barrier(bar); STAMP((k) + 1); } while (0)
    STAMP(0);
    if (IN(PH_PREP)) REPS(PH_PREP) {
        const int bid = opaque(blockIdx.x), nb = gridDim.x;
        convert_wt(a.in[I_WIN], 1024, DIN, (bf16_t*)(ws + NB_WT1), N1PAD, MapWin{}, bid, nb);
        convert_wt(a.in[I_WOUTE], 1024, 1024, (bf16_t*)(ws + NB_WT2), 1024, MapId{}, bid, nb);
        for (int n = 0; n < 4; ++n) convert_wt(a.in[I_WRKVZ] + (size_t)n * 1024 * 1024, 1024, 1024, (bf16_t*)(ws + NB_WT3) + (size_t)n * 1024 * 1024, 1024, MapId{}, bid, nb);
        convert_wt(a.in[I_WOUTO], 1024, 1024, (bf16_t*)(ws + NB_WT4), 1024, MapId{}, bid, nb);
        convert_wfrag(a.in[I_W1], (bf16_t*)(ws + NB_W1T), bid, nb);
        convert_wfrag(a.in[I_A1], (bf16_t*)(ws + NB_A1T), bid, nb);
        convert_wt(a.in[I_W2], 64, 1024, (bf16_t*)(ws + NB_W2T), 1024, MapId{}, bid, nb);
        convert_wt(a.in[I_A2], 64, 1024, (bf16_t*)(ws + NB_A2T), 1024, MapId{}, bid, nb);
        convert_rows(a.in[I_XP], (size_t)MP * 1024 / 8, (bf16_t*)(ws + NB_XB), bid, nb);
        convert_rows(a.in[I_XS], (size_t)BS * 1024 / 8, (bf16_t*)(ws + NB_XSB), bid, nb);
        sample_pool_copy(a, ws, bid, nb);
    }
    SEAM(PH_PREP);
    if (IN(PH_GEMM1)) REPS(PH_GEMM1) {
        const int bid = opaque(blockIdx.x), nb = gridDim.x;
        const Route1 R{(bf16_t*)(ws + NB_HB), (bf16_t*)(ws + NB_KVB), (float*)(ws + NB_G3), a.out};
        {
            pg8::Gemm g{(const bf16_t*)(ws + NB_XB), (const bf16_t*)(ws + NB_WT1), MP, N1PAD, 1024};
            pg8::StaticOrder S; S.init(MP, N1PAD, nb, bid);
            Epi1 E{R};
            pg8::gemm_phase<Epi1, pg8::StaticOrder, false>(lds, g, S, E, nullptr);
#if DUP_GEMM1
            __syncthreads();
            pg8::gemm_phase<Epi1, pg8::StaticOrder, false>(lds, g, S, E, nullptr);
#endif
        }
        {
            for (int task = bid; task < 105; task += nb) {
                sample_gemm32_wg((const bf16_t*)(ws + NB_XSB), (const bf16_t*)(ws + NB_WT1), 1024, task * 32, lds,
                    [&](int r, int n, float v) {
                        const int row = MP + r;
                        if (n < 2560) { const float sc = (n >= 1536 && n < 2048) ? 0.125f : 1.0f; ((bf16_t*)(ws + NB_HB))[(size_t)row * 2560 + n] = (bf16_t)(pk_bf16c(v * sc, 0.f) & 0xffffu); }
                        else if (n < 3328) { const int c = n - 2560, i3 = c >> 8, cc = c & 255; ((bf16_t*)(ws + NB_KVB))[(size_t)row * 768 + c] = (bf16_t)(pk_bf16c(v, 0.f) & 0xffffu);
                            float* dst = (i3 == 0) ? a.out + O_CMPS + (size_t)r * 256 + cc : (i3 == 1) ? a.out + O_SELS + (size_t)r * 256 + cc : a.out + O_WINS + (size_t)(r * 512 + 511) * 256 + cc;
                            *dst = v; }
                        else if (n < 3352) ((float*)(ws + NB_G3))[(size_t)row * 32 + (n - 3328)] = v;
                    });
            }
        }
    }
    SEAM(PH_GEMM1);
    if (IN(PH_CONV)) REPS(PH_CONV) {
        const int bid = opaque(blockIdx.x), nb = gridDim.x;
#pragma unroll 1
        for (int item = bid; item < 512; item += nb) conv_item(a, ws, lds, item);
        pool_prompt(a, ws, bid, nb);
        sample_attn(a, ws, lds, bid >> 3, (bid >> 2) & 1, bid & 3);
#if DUP_SATTN
        __syncthreads();
        sample_attn(a, ws, lds, bid >> 3, (bid >> 2) & 1, bid & 3);
#endif
        if (bid >= 96 && bid < 128) sample_conv(a, ws, lds, bid - 96);
    }
    SEAM(PH_CONV);
    if (IN(PH_ATTN)) REPS(PH_ATTN) {
        const int bid = opaque(blockIdx.x), nb = gridDim.x;
        if (bid < 64) sample_combine(a, ws, bid >> 1, bid & 1);
        for (int pr = bid; pr < 256; pr += nb) {
            const int b = pr >> 5, g = (pr >> 4) & 1, xq = pr & 15;
#pragma unroll 1
            for (int k = 0; k < 2; ++k) attn_item(a, ws, lds, b, g, k ? xq : 31 - xq);
        }
    }
    SEAM(PH_ATTN);
    if (IN(PH_GEMM2)) REPS(PH_GEMM2) {
        const int bid = opaque(blockIdx.x), nb = gridDim.x;
        {
            pg8::Gemm g{(const bf16_t*)(ws + NB_CATB), (const bf16_t*)(ws + NB_WT2), MP, 1024, 1024};
            pg8::StaticOrder S; S.init(MP, 1024, nb, bid);
            EpiPreRes E{(float*)ws + WS_PRE, a.in[I_XP]};
            pg8::gemm_phase<EpiPreRes, pg8::StaticOrder, false>(lds, g, S, E, nullptr);
        }
        {
            const int lane = threadIdx.x & 63, wv = __builtin_amdgcn_readfirstlane(threadIdx.x >> 6);
            float* PREs = (float*)ws + WS_PRE + (size_t)MP * 1024;
            const float* xs = a.in[I_XS];
            for (int task = bid; task < 32; task += nb)
                sample_gemm32_wg((const bf16_t*)(ws + NB_CATB) + (size_t)MP * 1024, (const bf16_t*)(ws + NB_WT2), 1024, task * 32, lds,
                              [&](int r, int n, float v) { PREs[(size_t)r * 1024 + n] = fmaf(ALPHA, xs[(size_t)r * 1024 + n], v); });
        }
    }
    SEAM(PH_GEMM2);
    if (IN(PH_LNS)) REPS(PH_LNS) { const int bid = opaque(blockIdx.x), nb = gridDim.x; phase_lns(a, ws, lds, bid, nb); }
    SEAM(PH_LNS);
    if (IN(PH_GEMM3)) REPS(PH_GEMM3) {
        const int bid = opaque(blockIdx.x), nb = gridDim.x;
        {
            pg8::Gemm g{(const bf16_t*)(ws + NB_XSH), (const bf16_t*)(ws + NB_WT3), MP, 4096, 1024};
            Order3 S; S.init(nb, bid);
            Epi3 E{(bf16_t*)(ws + NB_RKVZ)};
            pg8::gemm_phase<Epi3, Order3, false>(lds, g, S, E, nullptr);
        }
        {
            const int lane = threadIdx.x & 63, wv = __builtin_amdgcn_readfirstlane(threadIdx.x >> 6);
            for (int task = bid; task < 128; task += nb) {
                const int n = task >> 5, n0 = (task & 31) * 32;
                bf16_t* dst = (bf16_t*)(ws + NB_RKVZ) + ((size_t)n * XSH_ROWS + MP) * 1024;
                sample_gemm32_wg((const bf16_t*)(ws + NB_XSH) + ((size_t)n * XSH_ROWS + MP) * 1024, (const bf16_t*)(ws + NB_WT3) + (size_t)n * 1024 * 1024, 1024, n0, lds,
                              [&](int r, int c, float v) { dst[(size_t)r * 1024 + c] = (bf16_t)(pk_bf16c(v, 0.f) & 0xffffu); });
            }
            if (bid >= nb - 2) {
                const int tidl = opaque_v(threadIdx.x), task = 1024 + (nb - 1 - bid);
                LoraRegs lr_; lora_load(ws, task, tidl, lr_); lora_tile(ws, lds, task, tidl, lr_);
            }
        }
    }
    SEAM(PH_GEMM3);
    if (IN(PH_PREP2)) REPS(PH_PREP2) {
        const int bid = opaque(blockIdx.x), nb = gridDim.x;
        for (int pr = bid; pr < 256; pr += nb) {
            const int bh = pr >> 1, b = bh >> 4, hd = bh & 15, c0 = (pr & 1) * 16;
            const int tidp = opaque_v(threadIdx.x), lanep = tidp & 63, wvp = tidp >> 6;
            bf16x8 btf[4];
            { const int which = wvp >> 2, nt = wvp & 1;
              const bf16_t* Bt = (const bf16_t*)(ws + (which ? NB_A2T : NB_W2T)) + (size_t)(hd * 64 + nt * 32 + (lanep & 31)) * 64 + (lanep >> 5) * 8;
#pragma unroll
              for (int s4 = 0; s4 < 4; ++s4) btf[s4] = *(const bf16x8*)(Bt + s4 * 16); }
            PreRegs pcur, pnxt;
            scanpre_load(ws, b, hd, c0, tidp, pnxt);
#pragma unroll 1
            for (int cc = 0; cc < 16; ++cc) {
                pcur = pnxt;
                if (cc + 1 < 16) scanpre_load(ws, b, hd, c0 + cc + 1, tidp, pnxt);
                scanpre_chunk(a, ws, lds, b, hd, c0 + cc, pcur, btf);
            }
        }
    }
    SEAM(PH_PREP2);
    if (IN(PH_SCAN)) REPS(PH_SCAN) {
        const int bid = opaque(blockIdx.x), nb = gridDim.x;
#pragma unroll 1
        for (int item = bid; item < 128; item += nb) scanseq_head(a, ws, lds, item >> 4, item & 15);
        const int lane = opaque_v(threadIdx.x) & 63, wv = __builtin_amdgcn_readfirstlane(threadIdx.x >> 6);
        for (int task = (nb - 1 - bid) * 8 + wv; task < BS * 16; task += nb * 8) scan_sample(a, ws, task >> 4, task & 15, lane);
    }
    SEAM(PH_SCAN);
    if (IN(PH_POST)) REPS(PH_POST) { const int bid = opaque(blockIdx.x), nb = gridDim.x; phase_ygate(a, ws, lds, bid, nb); }
    SEAM(PH_POST);
    if (IN(PH_GEMM4)) REPS(PH_GEMM4) {
        const int bid = opaque(blockIdx.x), nb = gridDim.x;
        {
            pg8::Gemm g{(const bf16_t*)(ws + NB_G4B), (const bf16_t*)(ws + NB_WT4), MP, 1024, 1024};
            pg8::StaticOrder S; S.init(MP, 1024, nb, bid);
            EpiPreB E{(bf16_t*)(ws + NB_Y)};
            pg8::gemm_phase<EpiPreB, pg8::StaticOrder, false>(lds, g, S, E, nullptr);
        }
        {
            bf16_t* PREs = (bf16_t*)(ws + NB_Y) + (size_t)MP * 1024;
            for (int task = bid; task < 32; task += nb)
                sample_gemm32_wg((const bf16_t*)(ws + NB_G4B) + (size_t)MP * 1024, (const bf16_t*)(ws + NB_WT4), 1024, task * 32, lds,
                              [&](int r, int n, float v) { PREs[(size_t)r * 1024 + n] = (bf16_t)(pk_bf16c(v, 0.f) & 0xffffu); });
        }
    }
    SEAM(PH_GEMM4);
    if (IN(PH_LNF)) REPS(PH_LNF) { const int bid = opaque(blockIdx.x), nb = gridDim.x; phase_lnf(a, ws, bid, nb); }
#undef IN
#undef SEAM
}
}

extern "C" void kernel_launch(void* const* d_in, const int* in_sizes, int n_in, void* d_out, int out_size, void* d_ws, size_t ws_size,
                              hipStream_t stream) {
    if (n_in != N_IN || ws_size < nk::NB_END) { fprintf(stderr, "kernel_launch: unexpected n_in %d or ws_size %zu (need %zu)\n", n_in, ws_size, (size_t)nk::NB_END); return; }
    static int grid = 0;
    if (!grid) {
        int dev = 0, cus = 0, per_cu = 0;
        hipGetDevice(&dev);
        hipDeviceGetAttribute(&cus, hipDeviceAttributeMultiprocessorCount, dev);
        hipFuncSetAttribute((const void*)nk::mega, hipFuncAttributeMaxDynamicSharedMemorySize, nk::LDS_BYTES);
        hipOccupancyMaxActiveBlocksPerMultiprocessor(&per_cu, (const void*)nk::mega, nk::NTH, nk::LDS_BYTES);
        if (per_cu < 1) fprintf(stderr, "kernel_launch: occupancy query says %d blocks per CU\n", per_cu);
        grid = cus;
    }
    hipMemsetAsync((unsigned char*)d_ws + nk::NB_BAR, 0, 32768, stream);
    nk::Args a{};
    for (int i = 0; i < N_IN; ++i) a.in[i] = (const float*)d_in[i];
    a.out = (float*)d_out; a.ws = (unsigned char*)d_ws; a.ph_lo = 0; a.ph_hi = nk::NPHASE;
    void* args[] = {&a};
    hipError_t e = hipLaunchCooperativeKernel((const void*)nk::mega, dim3(grid), dim3(nk::NTH), args, nk::LDS_BYTES, stream);
    if (e != hipSuccess) fprintf(stderr, "cooperative launch failed: %s (grid %d)\n", hipGetErrorString(e), grid);
}
```

```cpp
#include <hip/hip_runtime.h>
#include <hip/hip_cooperative_groups.h>
#include <cstdio>
namespace cg = cooperative_groups;
#ifndef PROBE_TIME
#define PROBE_TIME -1
#endif
#ifndef PROBE_K
#define PROBE_K 1e-4f
#endif

constexpr int D = 1024, BP = 8, TP = 2048, MP = BP * TP, BS = 32, MT = MP + BS;
constexpr int DIN = 3352;
constexpr int C_AVAL = 0, C_AGLU = 512, C_ZA = 1024, C_Q = 1536, C_KV = 2048, C_G3 = 2816, C_ZB = 2840;
constexpr int C_CMP = C_KV, C_SEL = C_KV + 256, C_WIN = C_KV + 512;
constexpr int PAST = 8192, NPAGE = 64, PAGE = 128;
constexpr float ALPHA = 1.4142135623730951f;
constexpr float LN_EPS = 1e-5f, GN_EPS = 64e-5f;

constexpr size_t O_Y = 0, O_YS = 16777216, O_CMPP = 16809984, O_CMPS = 21004288, O_SELP = 21012480, O_SELS = 25206784,
                 O_WINP = 25214976, O_WINS = 26263552, O_CONVP = 30457856, O_CONVS = 30580736, O_WKVP = 31072256,
                 O_WKVS = 31596544, O_SHP = 33693696, O_SHS = 33701888;

enum { I_XP = 0, I_XS, I_CCMP, I_CSEL, I_CWIN, I_SCONV, I_SWKV, I_SSHIFT, I_PT, I_WIN, I_CONVW, I_CONVB, I_CLNG, I_CLNB,
       I_WKC, I_WVC, I_WOUTE, I_MU, I_WRKVZ, I_W0, I_W1, I_W2, I_A0, I_A1, I_A2, I_KK, I_KA, I_RK, I_GNG, I_GNB, I_WOUTO,
       I_LNG, I_LNB, N_IN };

constexpr size_t SZ_ROWD = (size_t)MT * D;
constexpr size_t WS_H = 0;
constexpr size_t WS_CAT = WS_H + (size_t)MT * DIN;
constexpr size_t WS_OC = WS_CAT + SZ_ROWD;
constexpr size_t WS_XSH = 0;
constexpr size_t WS_Y = 0;
constexpr size_t WS_G4 = SZ_ROWD;
constexpr size_t WS_R0END = 6 * SZ_ROWD;
constexpr size_t WS_PRE = WS_R0END;
constexpr size_t WS_X1 = WS_PRE + SZ_ROWD;
constexpr size_t WS_R = WS_X1 + SZ_ROWD;
constexpr size_t WS_K = WS_R + SZ_ROWD;
constexpr size_t WS_V = WS_K + SZ_ROWD;
constexpr size_t WS_Z = WS_V + SZ_ROWD;
constexpr size_t WS_DEC = WS_Z + SZ_ROWD;
constexpr size_t WS_KKN = WS_DEC + SZ_ROWD;
constexpr size_t WS_KKA = WS_KKN + SZ_ROWD;
constexpr size_t WS_TW = WS_KKA + SZ_ROWD;
constexpr size_t WS_AW = WS_TW + (size_t)MT * 64;
constexpr size_t WS_RK = WS_AW + (size_t)MT * 64;
constexpr size_t WS_END = WS_RK + (size_t)MT * 16;
constexpr size_t WS_PCP = WS_R;
constexpr size_t WS_PCS = WS_R + (size_t)MP * 8 * 64;
constexpr size_t WS_IMP = WS_K;
constexpr size_t WS_SELIDX = WS_V;
constexpr size_t WS_KCP = WS_Z;
constexpr size_t WS_KCS = WS_Z + (size_t)8 * 64 * 256;
static_assert(WS_OC + (size_t)MT * 512 <= WS_R0END, "layer0 temporaries overflow region 0");

namespace pg8 {
#define PG8_LAS __attribute__((address_space(3)))
typedef unsigned short bf16_t;
typedef short bf16x8 __attribute__((ext_vector_type(8)));
typedef float f32x4 __attribute__((ext_vector_type(4)));
typedef unsigned u32x4 __attribute__((ext_vector_type(4)));
constexpr int BM = 256, BK = 64, HALF = 128, HTB = HALF * BK * 2  , STAGE_BYTES = 8 * HTB, NXCD = 8, WGM = 8;

__host__ __device__ __forceinline__ int lds_byte(int r, int c) { const int st = (r >> 4) * 2 + (c >> 5), rr = r & 15, cc = c & 31, ob = rr * 64 + cc * 2; return st * 1024 + (ob ^ (((ob >> 9) & 1) << 5)); }
__host__ __device__ __forceinline__ void stage_rc(int b, int& R, int& C) { const int st = b / 1024, sb = b % 1024, swz = sb ^ (((sb >> 9) & 1) << 5); R = (st >> 1) * 16 + swz / 64; C = (st & 1) * 32 + (swz % 64) / 2; }
__host__ __device__ __forceinline__ int perm32(int rho) { const int n = rho >> 4, i = rho & 15; return 8 * (i >> 2) + 4 * n + (i & 3); }

struct Unit { int pm, pn; };
struct Gemm { const bf16_t* A; const bf16_t* Bt; int M, N, K; };

struct StaticOrder {
    int nM, nN, nwg, G, c;
    __host__ __device__ void init(int M, int N, int G_, int c_) { nM = M / BM; nN = N / BM; nwg = nM * nN; G = G_; c = c_; }
    __host__ __device__ bool next(int i, Unit& u) const {
        const long L = (long)i * G + c; if (L >= nwg) return false;
        int wgid = (int)L; { const int q = nwg / NXCD, r = nwg % NXCD, xcd = wgid % NXCD, off = wgid / NXCD; wgid = (xcd < r ? xcd * (q + 1) : r * (q + 1) + (xcd - r) * q) + off; }
        const int nig = WGM * nN, gid = wgid / nig, fm = gid * WGM, gsz = (nM - fm) < WGM ? (nM - fm) : WGM;
        u.pm = fm + ((wgid % nig) % gsz); u.pn = (wgid % nig) / gsz; return true;
    }
    __device__ __forceinline__ void a_ready(const Unit&) const {}
    __device__ __forceinline__ void done(const Unit&) const {}
};
struct CountedOrder : StaticOrder {
    const unsigned* ready; unsigned need; unsigned* tmo;
    __device__ __forceinline__ void a_ready(const Unit& u) const {
        if (threadIdx.x < 64) {
            const unsigned long long t0 = __builtin_amdgcn_s_memrealtime(); unsigned polls = 0;
            while ((unsigned)__builtin_amdgcn_readfirstlane(__hip_atomic_load(ready + 64 * u.pm, __ATOMIC_RELAXED, __HIP_MEMORY_SCOPE_AGENT)) < need) {
                if ((++polls & 255u) == 0u && __builtin_amdgcn_readfirstlane(__hip_atomic_load(tmo, __ATOMIC_RELAXED, __HIP_MEMORY_SCOPE_AGENT)) != 0u) break;
                if (__builtin_amdgcn_s_memrealtime() - t0 > 2000000ull) {
                    if (threadIdx.x == 0) { unsigned expect = 0u; __hip_atomic_compare_exchange_strong(tmo + 1, &expect, 0x600u | (unsigned)(u.pm & 0xff), __ATOMIC_RELAXED, __ATOMIC_RELAXED, __HIP_MEMORY_SCOPE_AGENT); __hip_atomic_store(tmo, 1u, __ATOMIC_RELAXED, __HIP_MEMORY_SCOPE_AGENT); }
                    break; }
                __builtin_amdgcn_s_sleep(2); }
            __builtin_amdgcn_fence(__ATOMIC_ACQUIRE, "agent");
            asm volatile("s_waitcnt vmcnt(0)" ::: "memory");
        }
#if !defined(BROKEN_HOOK_NO_BARRIER)
        asm volatile("" ::: "memory"); __builtin_amdgcn_s_barrier(); asm volatile("" ::: "memory");
#endif
    }
};


template <class Epi, class Sched, bool STAMP = false>
__device__ __forceinline__ void gemm_phase(PG8_LAS unsigned char* lds, const Gemm g, const Sched& S, const Epi& E, unsigned long long* stamps) {
    int tid_ = threadIdx.x; asm volatile("" : "+v"(tid_));
    const int tid = tid_, wid = __builtin_amdgcn_readfirstlane(tid >> 6), lane = tid & 63, wr = wid >> 2, wc = wid & 3, fr = lane & 15, fq = lane >> 4;
    const int K = g.K, nt = K / BK;
    int ts_lo = 0, ts_hi = 0, nts = 0; const unsigned long long rt_entry = STAMP ? (unsigned long long)wall_clock64() : 0ull;
#define PG8_STAMP() do { if (STAMP && wid == 0 && nts < 64) { const unsigned long long _c = (unsigned long long)clock64(); \
        ts_lo = (lane == nts) ? (int)(unsigned)_c : ts_lo; ts_hi = (lane == nts) ? (int)(unsigned)(_c >> 32) : ts_hi; ++nts; } } while (0)
    PG8_STAMP();
    unsigned voffA[2], voffB[2];
#pragma unroll
    for (int i = 0; i < 2; ++i) { int R, C; stage_rc(tid * 16 + i * 8192, R, C); const int Rb = Epi::PERM ? ((R & ~31) + perm32(R & 31)) : R;
        voffA[i] = (unsigned)(R * K + C) * 2u; voffB[i] = (unsigned)(Rb * K + C) * 2u; }
    const size_t kstep = (size_t)(BK * 2);
    const size_t hstep = (size_t)HALF * K * 2;
    const size_t tstep = 2 * hstep;
    const unsigned ldsw = (unsigned)wid * 1024u;
    const int aoff = lds_byte(wr * 64 + fr, fq * 8), boff = lds_byte(wc * 32 + fr, fq * 8);
#define PG8_SA(b, h) (((b) * 2 + (h)) * HTB)
#define PG8_SB(b, h) ((4 + (b) * 2 + (h)) * HTB)
#define PG8_STAGE(bufoff, gbase, voff) do { _Pragma("unroll") for (int _i = 0; _i < 2; ++_i) \
        __builtin_amdgcn_global_load_lds((const unsigned*)((const char*)(gbase) + (voff)[_i]), (PG8_LAS unsigned*)(lds + (bufoff) + ldsw + _i * 8192), 16, 0, 0); } while (0)
#define PG8_LDA(dst, b, h) do { _Pragma("unroll") for (int m = 0; m < 4; ++m) _Pragma("unroll") for (int k = 0; k < 2; ++k) dst[m][k] = *(const PG8_LAS bf16x8*)(lds + PG8_SA(b, h) + aoff + m * 2048 + k * 1024); } while (0)
#define PG8_LDB(dst, b, h) do { _Pragma("unroll") for (int n = 0; n < 2; ++n) _Pragma("unroll") for (int k = 0; k < 2; ++k) dst[n][k] = *(const PG8_LAS bf16x8*)(lds + PG8_SB(b, h) + boff + n * 2048 + k * 1024); } while (0)
#define PG8_MMA(ai, bj, At, Bt) do { __builtin_amdgcn_s_setprio(1); _Pragma("unroll") for (int m = 0; m < 4; ++m) _Pragma("unroll") for (int n = 0; n < 2; ++n) _Pragma("unroll") for (int k = 0; k < 2; ++k) \
        acc[ai][bj][m][n] = __builtin_amdgcn_mfma_f32_16x16x32_bf16(Bt[n][k], At[m][k], acc[ai][bj][m][n], 0, 0, 0); __builtin_amdgcn_s_setprio(0); } while (0)
#define PG8_WAIT_V(n) asm volatile("s_waitcnt vmcnt(" #n ")" ::: "memory")
#define PG8_WAIT_L(n) asm volatile("s_waitcnt lgkmcnt(" #n ")" ::: "memory")
#define PG8_BAR __builtin_amdgcn_s_barrier()
#define PG8_SCHED __builtin_amdgcn_sched_barrier(0)
    Unit cur, nxt; int ui = 0;
    if (!S.next(0, cur)) return;
    f32x4 acc[2][2][4][2];
#pragma unroll
    for (int a = 0; a < 2; ++a)
#pragma unroll
        for (int b = 0; b < 2; ++b)
#pragma unroll
            for (int m = 0; m < 4; ++m)
#pragma unroll
                for (int n = 0; n < 2; ++n) acc[a][b][m][n] = (f32x4){0.f, 0.f, 0.f, 0.f};
    bf16x8 At[4][2], B0[2][2], B1[2][2];
    const char* cA = (const char*)g.A + (size_t)cur.pm * tstep; const char* cB = (const char*)g.Bt + (size_t)cur.pn * tstep;
    S.a_ready(cur);
    PG8_STAGE(PG8_SB(0, 0), cB, voffB); PG8_STAGE(PG8_SA(0, 0), cA, voffA); PG8_STAGE(PG8_SB(0, 1), cB + hstep, voffB); PG8_STAGE(PG8_SA(0, 1), cA + hstep, voffA);
    if (wr == 1) PG8_BAR;
    PG8_WAIT_V(4); PG8_BAR;
    PG8_STAGE(PG8_SB(1, 0), cB + kstep, voffB); PG8_STAGE(PG8_SA(1, 0), cA + kstep, voffA); PG8_STAGE(PG8_SB(1, 1), cB + hstep + kstep, voffB);
    PG8_WAIT_V(6); PG8_BAR;
    PG8_STAMP();
    for (;;) {
        const bool has_next = S.next(ui + 1, nxt);
        const char* nA = has_next ? (const char*)g.A + (size_t)nxt.pm * tstep : cA; const char* nB = has_next ? (const char*)g.Bt + (size_t)nxt.pn * tstep : cB;
        for (int t = 0; t < nt; t += 2) {
            const bool last = (t == nt - 2);
            const char* a1 = cA + (size_t)(t + 1) * kstep;
            const char* a2 = last ? nA : cA + (size_t)(t + 2) * kstep; const char* b2 = last ? nB : cB + (size_t)(t + 2) * kstep;
            const char* a3 = a2 + kstep; const char* b3 = b2 + kstep;
            if (last && has_next) S.a_ready(nxt);
            PG8_LDB(B0, 0, 0); PG8_SCHED; PG8_LDA(At, 0, 0); PG8_STAGE(PG8_SA(1, 1), a1 + hstep, voffA);
            PG8_WAIT_L(8); PG8_BAR; PG8_WAIT_L(0); PG8_MMA(0, 0, At, B0); PG8_BAR; PG8_SCHED;
            PG8_LDB(B1, 0, 1); PG8_STAGE(PG8_SB(0, 0), b2, voffB);
            PG8_BAR; PG8_WAIT_L(0); PG8_MMA(0, 1, At, B1); PG8_BAR;
            PG8_LDA(At, 0, 1); PG8_STAGE(PG8_SA(0, 0), a2, voffA);
            PG8_BAR; PG8_WAIT_L(0); PG8_MMA(1, 0, At, B0); PG8_BAR; PG8_SCHED;
            PG8_STAGE(PG8_SB(0, 1), b2 + hstep, voffB);
            PG8_WAIT_V(6); PG8_BAR; PG8_MMA(1, 1, At, B1); PG8_BAR;
            PG8_LDB(B0, 1, 0); PG8_SCHED; PG8_LDA(At, 1, 0); PG8_STAGE(PG8_SA(0, 1), a2 + hstep, voffA);
            PG8_WAIT_L(8); PG8_BAR; PG8_WAIT_L(0); PG8_MMA(0, 0, At, B0); PG8_BAR; PG8_SCHED;
            PG8_LDB(B1, 1, 1); PG8_STAGE(PG8_SB(1, 0), b3, voffB);
            PG8_BAR; PG8_WAIT_L(0); PG8_MMA(0, 1, At, B1); PG8_BAR;
            PG8_LDA(At, 1, 1); PG8_STAGE(PG8_SA(1, 0), a3, voffA);
            PG8_BAR; PG8_WAIT_L(0); PG8_MMA(1, 0, At, B0); PG8_BAR; PG8_SCHED;
            PG8_STAGE(PG8_SB(1, 1), b3 + hstep, voffB);
            PG8_WAIT_V(6); PG8_BAR; PG8_MMA(1, 1, At, B1); PG8_BAR;
        }
        PG8_STAMP();
        if constexpr (!Epi::AFTER_DRAIN) { E(acc, cur, wr, wc, fr, fq); S.done(cur); }
        PG8_STAMP();
        if (!has_next) break;
#pragma unroll
        for (int a = 0; a < 2; ++a)
#pragma unroll
            for (int b = 0; b < 2; ++b)
#pragma unroll
                for (int m = 0; m < 4; ++m)
#pragma unroll
                    for (int n = 0; n < 2; ++n) acc[a][b][m][n] = (f32x4){0.f, 0.f, 0.f, 0.f};
        cur = nxt; cA = nA; cB = nB; ++ui;
    }
    PG8_WAIT_V(0);
    if (wr == 0) PG8_BAR;
    PG8_BAR;
    if constexpr (Epi::AFTER_DRAIN) { E.fused(acc, cur, wr, wc, fr, fq, lds, wid, lane); S.done(cur); }
    PG8_STAMP();
    if (STAMP && wid == 0) { stamps[lane] = lane < nts ? (((unsigned long long)(unsigned)ts_hi << 32) | (unsigned)ts_lo) : 0ull;
        if (lane == 62) stamps[62] = rt_entry; if (lane == 63) stamps[63] = (unsigned long long)wall_clock64(); }
#undef PG8_STAMP
#undef PG8_SA
#undef PG8_SB
#undef PG8_STAGE
#undef PG8_LDA
#undef PG8_LDB
#undef PG8_MMA
#undef PG8_WAIT_V
#undef PG8_WAIT_L
#undef PG8_BAR
#undef PG8_SCHED
}
}

#define XB_TMO      128
#define XB_XCNT(j)  (256  + 64 * (j))
#define XB_XSUB(j)  (1280 + 64 * (j))
#define XB_XGEN(j)  (2304 + 64 * (j))
#define XB_TOP      3328
#define XB_TOPGEN   3392
#define XCD_BAR_WORDS 3456
#define XB_SPIN_CAP (1u << 18)
#define LAS __attribute__((address_space(3)))

__device__ __forceinline__ unsigned xb_ld(unsigned* p)              { return __hip_atomic_load(p, __ATOMIC_RELAXED, __HIP_MEMORY_SCOPE_AGENT); }
__device__ __forceinline__ unsigned xb_add(unsigned* p, unsigned v) { return __hip_atomic_fetch_add(p, v, __ATOMIC_RELAXED, __HIP_MEMORY_SCOPE_AGENT); }
__device__ __forceinline__ unsigned xb_xcc_id() { return (unsigned)__builtin_amdgcn_s_getreg((3 << 11) | 20) & 0xFu; }
#define XB_SPIN(cond, bar) do { unsigned _sp = 0; while (cond) { __builtin_amdgcn_s_sleep(1); \
    if ((++_sp & 255u) == 0u) { if (xb_ld(&(bar)[XB_TMO])) break; if (_sp > XB_SPIN_CAP) { atomicAdd(&(bar)[XB_TMO], 1u); break; } } } } while (0)

struct XcdBarrier {
    unsigned* bar; unsigned x;
    volatile LAS unsigned* st;
};

__device__ __forceinline__ XcdBarrier xcd_barrier_post(unsigned* bar, volatile LAS unsigned* st) {
    XcdBarrier b; b.bar = bar; b.x = xb_xcc_id(); b.st = st;
    if (threadIdx.x == 0) (void)xb_add(&bar[XB_XCNT(b.x)], 1u);
    return b;
}
__device__ __forceinline__ void xcd_barrier_complete(unsigned* bar, unsigned x, unsigned& nloc, unsigned& nx) {
    const unsigned G = gridDim.x * gridDim.y * gridDim.z;
    unsigned sum, cnt, mine, sp = 0u;
    for (;;) {
        sum = 0u; cnt = 0u; mine = 0u;
#pragma unroll
        for (unsigned j = 0; j < 16; ++j) { const unsigned c = xb_ld(&bar[XB_XCNT(j)]); sum += c; cnt += (c > 0u) ? 1u : 0u; mine = (j == x) ? c : mine; }
        if (sum == G) break;
        __builtin_amdgcn_s_sleep(1);
        if ((++sp & 255u) == 0u) { if (xb_ld(&bar[XB_TMO])) break; if (sp > XB_SPIN_CAP) { atomicAdd(&bar[XB_TMO], 1u); break; } }
    }
    nloc = mine > 0u ? mine : 1u; nx = cnt > 0u ? cnt : 1u;
}

__device__ __forceinline__ void xcd_barrier(const XcdBarrier& b) {
    asm volatile("s_waitcnt vmcnt(0)" ::: "memory");
    __syncthreads();
    if (threadIdx.x == 0) {
        unsigned* bar = b.bar;
        __builtin_amdgcn_s_waitcnt(0);
        unsigned nloc = b.st[0], nx = b.st[1];
        if (nloc == 0u) { xcd_barrier_complete(bar, b.x, nloc, nx); b.st[0] = nloc; b.st[1] = nx; }
        const unsigned old = xb_add(&bar[XB_XSUB(b.x)], 1u);
        const unsigned gen = old / nloc;
        if (old + 1u == (gen + 1u) * nloc) {
            __builtin_amdgcn_fence(__ATOMIC_RELEASE, "agent");
            asm volatile("s_waitcnt vmcnt(0)" ::: "memory");
            const unsigned og = xb_add(&bar[XB_TOP], 1u);
            const unsigned tg = og / nx;
            if (og + 1u == (tg + 1u) * nx) xb_add(&bar[XB_TOPGEN], 1u);
            else XB_SPIN(xb_ld(&bar[XB_TOPGEN]) == tg, bar);
            __builtin_amdgcn_fence(__ATOMIC_ACQUIRE, "agent");
            xb_add(&bar[XB_XGEN(b.x)], 1u);
            asm volatile("s_waitcnt vmcnt(0)" ::: "memory");
        } else {
            XB_SPIN(xb_ld(&bar[XB_XGEN(b.x)]) == gen, bar);
            __builtin_amdgcn_fence(__ATOMIC_ACQUIRE, "agent");
            asm volatile("s_waitcnt vmcnt(0)" ::: "memory");
        }
    }
    __syncthreads();
}

namespace nk {
using pg8::bf16_t; using pg8::bf16x8; using pg8::f32x4; using pg8::u32x4; using pg8::Unit;
constexpr int NTH = 512;
constexpr int LDS_STAGE = pg8::STAGE_BYTES;
constexpr int LDS_MISC = 158720;
constexpr int LDS_BYTES = LDS_MISC + 1024;

constexpr size_t NB0 = WS_END * 4;
constexpr size_t NB_BAR = NB0;
constexpr size_t NB_WT1 = NB_BAR + 32768;
constexpr size_t NB_WT2 = NB_WT1 + (size_t)3584 * 1024 * 2;
constexpr size_t NB_XB = NB_WT2 + (size_t)1024 * 1024 * 2;
constexpr size_t NB_XSB = NB_XB + (size_t)MP * 1024 * 2;
constexpr size_t NB_HB = NB_XSB + (size_t)BS * 1024 * 2;
constexpr size_t NB_KVB = NB_HB + (size_t)MT * 2560 * 2;
constexpr size_t NB_G3 = NB_KVB + (size_t)MT * 768 * 2;
constexpr size_t NB_CATB = NB_G3 + (size_t)MT * 32 * 4;
constexpr size_t NB_CBUF = NB_CATB + (size_t)MT * 1024 * 2;
constexpr size_t NB_KCB = NB_CBUF + (size_t)MP * 512 * 4;
constexpr size_t NB_WT3 = NB_KCB + (size_t)BP * 64 * 256 * 2;
constexpr size_t NB_WT4 = NB_WT3 + (size_t)4 * 1024 * 1024 * 2;
constexpr size_t NB_W1T = NB_WT4 + (size_t)1024 * 1024 * 2;
constexpr size_t NB_A1T = NB_W1T + (size_t)64 * 1024 * 2;
constexpr size_t NB_W2T = NB_A1T + (size_t)64 * 1024 * 2;
constexpr size_t NB_A2T = NB_W2T + (size_t)64 * 1024 * 2;
constexpr size_t NB_KCS = NB_A2T + (size_t)64 * 1024 * 2;
constexpr size_t NB_OCS = NB_KCS + (size_t)BS * 256 * 256 * 4;
constexpr size_t NB_PARTS = NB_OCS + (size_t)BS * 8 * 64 * 4;
constexpr size_t NB_END = NB_PARTS + (size_t)BS * 8 * 24 * 66 * 4;
constexpr size_t NB_XSH = 0;
constexpr size_t NB_RKVZ = NB_XSH + (size_t)6 * 16640 * 1024 * 2;
constexpr size_t NB_TWB = NB_RKVZ + (size_t)4 * 16640 * 1024 * 2;
constexpr size_t NB_AWB = NB_TWB + (size_t)MT * 64 * 2;
constexpr size_t NB_RKS = NB_AWB + (size_t)MT * 64 * 2;
static_assert(NB_RKS + (size_t)MT * 16 * 4 <= WS_PRE * 4, "layer-1 region A overflows into PRE");
constexpr size_t NB_DEC = (WS_X1 + SZ_ROWD) * 4;
constexpr size_t NB_KKN = NB_DEC + (size_t)MT * 1024 * 4;
constexpr size_t NB_KKA = NB_KKN + (size_t)MT * 1024 * 2;
constexpr size_t NB_KP = NB_KKA + (size_t)MT * 1024 * 2;
constexpr size_t NB_Y = NB_KP + (size_t)MT * 1024 * 2;
constexpr size_t NB_G4B = NB_Y + (size_t)MT * 1024 * 4;
constexpr size_t NB_CHK = NB_G4B + (size_t)MT * 1024 * 2;
constexpr size_t NB_SREC = NB_CHK + (size_t)4096 * 32768;
static_assert(NB_SREC + (size_t)4096 * 8192 <= NB0, "layer-1 region B overflows");
constexpr int N1PAD = 3584;
__host__ __device__ __forceinline__ int win_src_col(int n) { return n < 2048 ? n : (n < 2560 ? C_ZB + (n - 2048) : (n < 3328 ? C_KV + (n - 2560) : (n < 3352 ? C_G3 + (n - 3328) : -1))); }

__device__ __forceinline__ int opaque(int x) { asm volatile("" : "+s"(x)); return x; }
__device__ __forceinline__ void lds_barrier() { asm volatile("s_waitcnt lgkmcnt(0)" ::: "memory"); __builtin_amdgcn_s_barrier(); asm volatile("" ::: "memory"); }
__device__ __forceinline__ int opaque_v(int x) { asm volatile("" : "+v"(x)); return x; }
struct Args { const float* in[N_IN]; float* out; unsigned char* ws; int ph_lo, ph_hi; };

__device__ __forceinline__ unsigned pk_bf16(float lo, float hi) { unsigned r; asm volatile("v_cvt_pk_bf16_f32 %0, %1, %2" : "=v"(r) : "v"(lo), "v"(hi)); return r; }
typedef __bf16 bf16x2_t __attribute__((ext_vector_type(2)));
__device__ __forceinline__ unsigned pk_bf16c(float lo, float hi) { bf16x2_t v; v[0] = (__bf16)lo; v[1] = (__bf16)hi; return __builtin_bit_cast(unsigned, v); }

template <class MAP>
__device__ __forceinline__ void convert_wt(const float* __restrict__ W, int K, int ldw, bf16_t* __restrict__ Wt, int Npad, MAP map, int bid, int nb) {
    const int kg = K / 8;
    const size_t total = (size_t)Npad * kg;
    for (size_t i = (size_t)bid * NTH + threadIdx.x; i < total; i += (size_t)nb * NTH) {
        const int n = (int)(i % Npad), k0 = (int)(i / Npad) * 8;
        const int sc = map(n);
        u32x4 w = {0u, 0u, 0u, 0u};
        if (sc >= 0) {
            float v[8];
#pragma unroll
            for (int j = 0; j < 8; ++j) v[j] = W[(size_t)(k0 + j) * ldw + sc];
            w.x = pk_bf16(v[0], v[1]); w.y = pk_bf16(v[2], v[3]); w.z = pk_bf16(v[4], v[5]); w.w = pk_bf16(v[6], v[7]);
        }
        *(u32x4*)(Wt + (size_t)n * K + k0) = w;
    }
}
struct MapId { __device__ __forceinline__ int operator()(int n) const { return n; } };
struct MapWin { __device__ __forceinline__ int operator()(int n) const { return win_src_col(n); } };
__device__ __forceinline__ void convert_wfrag(const float* __restrict__ W, bf16_t* __restrict__ Wf, int bid, int nb) {
    for (int i = bid * NTH + threadIdx.x; i < 64 * 128; i += nb * NTH) {
        const int n = i & 63, k0 = (i >> 6) * 8;
        float v[8];
#pragma unroll
        for (int j = 0; j < 8; ++j) v[j] = W[(size_t)(k0 + j) * 64 + n];
        u32x4 w; w.x = pk_bf16(v[0], v[1]); w.y = pk_bf16(v[2], v[3]); w.z = pk_bf16(v[4], v[5]); w.w = pk_bf16(v[6], v[7]);
        *(u32x4*)(Wf + ((size_t)((n >> 5) * 64 + (k0 >> 4)) * 64 + ((k0 >> 3) & 1) * 32 + (n & 31)) * 8) = w;
    }
}
__device__ __forceinline__ void convert_rows(const float* __restrict__ src, size_t n8, bf16_t* __restrict__ dst, int bid, int nb) {
#pragma unroll 4
    for (size_t i = (size_t)bid * NTH + threadIdx.x; i < n8; i += (size_t)nb * NTH) {
        const float4 a = *(const float4*)(src + i * 8), b = *(const float4*)(src + i * 8 + 4);
        u32x4 w; w.x = pk_bf16(a.x, a.y); w.y = pk_bf16(a.z, a.w); w.z = pk_bf16(b.x, b.y); w.w = pk_bf16(b.z, b.w);
        *(u32x4*)(dst + i * 8) = w;
    }
}

struct EpiPre {
    static constexpr bool PERM = false, AFTER_DRAIN = false;
    float* C; int ldc;
    __device__ __forceinline__ void operator()(const f32x4 (&acc)[2][2][4][2], const Unit& u, int wr, int wc, int fr, int fq) const {
        const int row0 = u.pm * 256 + wr * 64 + fr, col0 = u.pn * 256 + wc * 32 + 4 * fq;
#pragma unroll
        for (int ai = 0; ai < 2; ++ai)
#pragma unroll
            for (int m = 0; m < 4; ++m) { float* rowp = C + (size_t)(row0 + ai * 128 + m * 16) * ldc + col0;
#pragma unroll
                for (int bj = 0; bj < 2; ++bj)
#pragma unroll
                    for (int n = 0; n < 2; ++n) *(f32x4*)(rowp + bj * 128 + n * 16) = acc[ai][bj][m][n]; }
    }
};


struct EpiPreB {
    static constexpr bool PERM = true, AFTER_DRAIN = false;
    bf16_t* O;
    __device__ __forceinline__ void operator()(const f32x4 (&acc)[2][2][4][2], const Unit& u, int wr, int wc, int fr, int fq) const {
        const int row0 = u.pm * 256 + wr * 64 + fr, col0 = u.pn * 256 + wc * 32 + 8 * fq;
#pragma unroll
        for (int ai = 0; ai < 2; ++ai)
#pragma unroll
            for (int m = 0; m < 4; ++m) { bf16_t* rowp = O + (size_t)(row0 + ai * 128 + m * 16) * 1024 + col0;
#pragma unroll
                for (int bj = 0; bj < 2; ++bj) { const f32x4 v0 = acc[ai][bj][m][0], v1 = acc[ai][bj][m][1];
                    u32x4 w; w.x = pk_bf16c(v0[0], v0[1]); w.y = pk_bf16c(v0[2], v0[3]); w.z = pk_bf16c(v1[0], v1[1]); w.w = pk_bf16c(v1[2], v1[3]);
                    *(u32x4*)(rowp + bj * 128) = w; } }
    }
};


struct Route1 {
    bf16_t* HB; bf16_t* KVB; float* G3; float* out;
    __device__ __forceinline__ void put8(int row, int n0, const f32x4& v0, const f32x4& v1) const {
        if (n0 < 2560) {
            const float sc = (n0 >= 1536 && n0 < 2048) ? 0.125f : 1.0f;
            u32x4 w; w.x = pk_bf16c(v0[0] * sc, v0[1] * sc); w.y = pk_bf16c(v0[2] * sc, v0[3] * sc); w.z = pk_bf16c(v1[0] * sc, v1[1] * sc); w.w = pk_bf16c(v1[2] * sc, v1[3] * sc);
            *(u32x4*)(HB + (size_t)row * 2560 + n0) = w;
        } else if (n0 < 3328) {
            const int c = n0 - 2560, i3 = c >> 8, cc = c & 255;
            u32x4 w; w.x = pk_bf16c(v0[0], v0[1]); w.y = pk_bf16c(v0[2], v0[3]); w.z = pk_bf16c(v1[0], v1[1]); w.w = pk_bf16c(v1[2], v1[3]);
            *(u32x4*)(KVB + (size_t)row * 768 + c) = w;
            float* dst = nullptr;
            if (row < MP) {
                if (i3 == 0) dst = out + O_CMPP + (size_t)row * 256 + cc;
                else if (i3 == 1) dst = out + O_SELP + (size_t)row * 256 + cc;
                else { const int b = row >> 11, t = row & 2047; if (t >= TP - 512) dst = out + O_WINP + (size_t)(b * 512 + t - (TP - 512)) * 256 + cc; }
            } else {
                const int sidx = row - MP;
                if (i3 == 0) dst = out + O_CMPS + (size_t)sidx * 256 + cc;
                else if (i3 == 1) dst = out + O_SELS + (size_t)sidx * 256 + cc;
                else dst = out + O_WINS + (size_t)(sidx * 512 + 511) * 256 + cc;
            }
            if (dst) { *(f32x4*)dst = v0; *(f32x4*)(dst + 4) = v1; }
        } else if (n0 < 3352) {
            float* dst = G3 + (size_t)row * 32 + (n0 - 3328);
            *(f32x4*)dst = v0; *(f32x4*)(dst + 4) = v1;
        }
    }
};
struct Epi1 {
    static constexpr bool PERM = true, AFTER_DRAIN = false;
    Route1 R;
    __device__ __forceinline__ void operator()(const f32x4 (&acc)[2][2][4][2], const Unit& u, int wr, int wc, int fr, int fq) const {
        const int row0 = u.pm * 256 + wr * 64 + fr, col0 = u.pn * 256 + wc * 32 + 8 * fq;
#pragma unroll
        for (int ai = 0; ai < 2; ++ai)
#pragma unroll
            for (int m = 0; m < 4; ++m)
#pragma unroll
                for (int bj = 0; bj < 2; ++bj) R.put8(row0 + ai * 128 + m * 16, col0 + bj * 128, acc[ai][bj][m][0], acc[ai][bj][m][1]);
    }
};

typedef float f32x16 __attribute__((ext_vector_type(16)));
template <class EMIT>
__device__ __forceinline__ void sample_gemm32(const bf16_t* __restrict__ A, const bf16_t* __restrict__ Bt, int K, int n0, int lane, EMIT emit) {
    const bf16_t* ap = A + (size_t)(lane & 31) * K + 8 * (lane >> 5);
    const bf16_t* bp = Bt + (size_t)(n0 + (lane & 31)) * K + 8 * (lane >> 5);
    f32x16 acc;
#pragma unroll
    for (int i = 0; i < 16; ++i) acc[i] = 0.f;
#pragma unroll 16
    for (int k = 0; k < K; k += 16) {
        const bf16x8 av = *(const bf16x8*)(ap + k), bv = *(const bf16x8*)(bp + k);
        acc = __builtin_amdgcn_mfma_f32_32x32x16_bf16(av, bv, acc, 0, 0, 0);
    }
#pragma unroll
    for (int r = 0; r < 16; ++r) emit((r & 3) + 8 * (r >> 2) + 4 * (lane >> 5), n0 + (lane & 31), acc[r]);
}

template <class EMIT>
__device__ __forceinline__ void sample_gemm32_wg(const bf16_t* __restrict__ A, const bf16_t* __restrict__ Bt, int K, int n0, PG8_LAS unsigned char* lds, EMIT emit) {
    const int tid = opaque_v(threadIdx.x), lane = tid & 63, wv = tid >> 6;
    const int kq = K / 8;
    const bf16_t* ap = A + (size_t)(lane & 31) * K + 8 * (lane >> 5) + wv * kq;
    const bf16_t* bp = Bt + (size_t)(n0 + (lane & 31)) * K + 8 * (lane >> 5) + wv * kq;
    f32x16 acc;
#pragma unroll
    for (int i = 0; i < 16; ++i) acc[i] = 0.f;
#pragma unroll 8
    for (int k = 0; k < kq; k += 16) {
        const bf16x8 av = *(const bf16x8*)(ap + k), bv = *(const bf16x8*)(bp + k);
        acc = __builtin_amdgcn_mfma_f32_32x32x16_bf16(av, bv, acc, 0, 0, 0);
    }
    PG8_LAS float* P = (PG8_LAS float*)lds;
#pragma unroll
    for (int q = 0; q < 4; ++q) *(PG8_LAS f32x4*)(P + (wv * 64 + lane) * 16 + q * 4) = (f32x4){acc[4 * q], acc[4 * q + 1], acc[4 * q + 2], acc[4 * q + 3]};
    __syncthreads();
    if (wv == 0) {
#pragma unroll
        for (int w = 1; w < 8; ++w)
#pragma unroll
            for (int q = 0; q < 4; ++q) { const f32x4 v = *(const PG8_LAS f32x4*)(P + (w * 64 + lane) * 16 + q * 4); acc[4 * q] += v[0]; acc[4 * q + 1] += v[1]; acc[4 * q + 2] += v[2]; acc[4 * q + 3] += v[3]; }
#pragma unroll
        for (int r = 0; r < 16; ++r) emit((r & 3) + 8 * (r >> 2) + 4 * (lane >> 5), n0 + (lane & 31), acc[r]);
    }
    __syncthreads();
}

typedef float f32x16 __attribute__((ext_vector_type(16)));
__device__ __forceinline__ float bf2f(bf16_t v) { return __uint_as_float((unsigned)v << 16); }
__device__ __forceinline__ float sigm_f(float x) { return 1.f / (1.f + __expf(-x)); }
__device__ __forceinline__ float silu_f(float x) { return x / (1.f + __expf(-x)); }

__device__ __forceinline__ float wsum64(float v) {
    v += __builtin_bit_cast(float, __builtin_amdgcn_update_dpp(0, __builtin_bit_cast(int, v), 0xB1, 0xF, 0xF, true));
    v += __builtin_bit_cast(float, __builtin_amdgcn_update_dpp(0, __builtin_bit_cast(int, v), 0x4E, 0xF, 0xF, true));
    v += __builtin_bit_cast(float, __builtin_amdgcn_update_dpp(0, __builtin_bit_cast(int, v), 0x141, 0xF, 0xF, true));
    v += __builtin_bit_cast(float, __builtin_amdgcn_update_dpp(0, __builtin_bit_cast(int, v), 0x140, 0xF, 0xF, true));
    v += __shfl_xor(v, 16); v += __shfl_xor(v, 32);
    return v;
}
constexpr int CV_U = 0;
constexpr int CV_C = 65536;
__device__ __forceinline__ void conv_item(const Args& a, unsigned char* ws, PG8_LAS unsigned char* lds, int item) {
    const int tid = opaque_v(threadIdx.x);
    const int b = item >> 6, t0 = (item & 63) * 32;
    const bf16_t* HB = (const bf16_t*)(ws + NB_HB);
    PG8_LAS float* U = (PG8_LAS float*)(lds + CV_U);
    PG8_LAS float* C = (PG8_LAS float*)(lds + CV_C);
    const int chl = tid & 255, tp = tid >> 8;
    const int lane = tid & 63, wv = tid >> 6;
    u32x4 zv[4];
#pragma unroll
    for (int k = 0; k < 4; ++k) zv[k] = *(const u32x4*)(HB + (size_t)(b * TP + t0 + wv * 4 + k) * 2560 + 1024 + lane * 8);
#pragma unroll 1
    for (int half = 0; half < 2; ++half) {
        const int chb = half * 256;
#pragma unroll
        for (int it = 0; it < 4; ++it) {
            const int vi = tid + it * NTH;
            if (vi < 62 * 32) {
                const int r = vi >> 5, c8 = (vi & 31) * 8, t = t0 - 30 + r;
                float u[8];
                if (t >= 0) {
                    const bf16_t* h = HB + (size_t)(b * TP + t) * 2560 + chb + c8;
                    const u32x4 av = *(const u32x4*)h, gv = *(const u32x4*)(h + 512);
#pragma unroll
                    for (int i = 0; i < 8; ++i) {
                        const float x = __uint_as_float((i & 1) ? (av[i >> 1] & 0xffff0000u) : (av[i >> 1] << 16));
                        const float g = __uint_as_float((i & 1) ? (gv[i >> 1] & 0xffff0000u) : (gv[i >> 1] << 16));
                        u[i] = x * sigm_f(g);
                    }
                } else {
#pragma unroll
                    for (int i = 0; i < 8; ++i) u[i] = 0.f;
                }
                *(PG8_LAS f32x4*)(U + r * 256 + c8) = (f32x4){u[0], u[1], u[2], u[3]};
                *(PG8_LAS f32x4*)(U + r * 256 + c8 + 4) = (f32x4){u[4], u[5], u[6], u[7]};
                if (t >= TP - 30 && r >= 30) {
                    float* o = a.out + O_CONVP + (size_t)(b * 30 + t - (TP - 30)) * 512 + chb + c8;
                    *(float4*)o = make_float4(u[0], u[1], u[2], u[3]); *(float4*)(o + 4) = make_float4(u[4], u[5], u[6], u[7]);
                }
            }
        }
        __syncthreads();
        {
            const int ch = chb + chl;
            float w[31], uw[46], acc[16];
#pragma unroll
            for (int j = 0; j < 31; ++j) w[j] = a.in[I_CONVW][j * 512 + ch];
            const float bias = a.in[I_CONVB][ch];
#pragma unroll
            for (int r = 0; r < 46; ++r) uw[r] = U[(tp * 16 + r) * 256 + chl];
#pragma unroll
            for (int k = 0; k < 16; ++k) {
                float s_ = bias;
#pragma unroll
                for (int j = 0; j < 31; ++j) s_ = fmaf(w[j], uw[k + j], s_);
                acc[k] = s_;
            }
#pragma unroll
            for (int k = 0; k < 16; ++k) C[(tp * 16 + k) * 516 + ch] = acc[k];
        }
        __syncthreads();
    }
    {
        const float4 g0 = *(const float4*)(a.in[I_CLNG] + lane * 8), g1 = *(const float4*)(a.in[I_CLNG] + lane * 8 + 4);
        const float4 b0 = *(const float4*)(a.in[I_CLNB] + lane * 8), b1 = *(const float4*)(a.in[I_CLNB] + lane * 8 + 4);
        const float gg[8] = {g0.x, g0.y, g0.z, g0.w, g1.x, g1.y, g1.z, g1.w}, bb[8] = {b0.x, b0.y, b0.z, b0.w, b1.x, b1.y, b1.z, b1.w};
#pragma unroll
        for (int k = 0; k < 4; ++k) {
            const int tl = wv * 4 + k;
            const size_t row = (size_t)(b * TP + t0 + tl);
            const f32x4 c0 = *(const PG8_LAS f32x4*)(C + tl * 516 + lane * 8), c1 = *(const PG8_LAS f32x4*)(C + tl * 516 + lane * 8 + 4);
            float c[8] = {c0[0], c0[1], c0[2], c0[3], c1[0], c1[1], c1[2], c1[3]};
            float sm = 0.f;
#pragma unroll
            for (int i = 0; i < 8; ++i) sm += c[i];
            const float mean = wsum64(sm) * (1.f / 512.f);
            float sq = 0.f;
#pragma unroll
            for (int i = 0; i < 8; ++i) { c[i] -= mean; sq += c[i] * c[i]; }
            const float rs = rsqrtf(wsum64(sq) * (1.f / 512.f) + LN_EPS);
            float y[8];
#pragma unroll
            for (int i = 0; i < 8; ++i) {
                const float z = __uint_as_float((i & 1) ? (zv[k][i >> 1] & 0xffff0000u) : (zv[k][i >> 1] << 16));
                y[i] = silu_f(c[i] * rs * gg[i] + bb[i]) * silu_f(z);
            }
            u32x4 o; o.x = pk_bf16(y[0], y[1]); o.y = pk_bf16(y[2], y[3]); o.z = pk_bf16(y[4], y[5]); o.w = pk_bf16(y[6], y[7]);
            *(u32x4*)((bf16_t*)(ws + NB_CATB) + row * 1024 + lane * 8) = o;
        }
    }
    __syncthreads();
}

__device__ __forceinline__ void pool_prompt(const Args& a, unsigned char* ws, int bid, int nb) {
    bf16_t* KCB = (bf16_t*)(ws + NB_KCB);
    for (int i = bid * NTH + threadIdx.x; i < BP * 64 * 256; i += nb * NTH) {
        const int c = i & 255, n = (i >> 8) & 63, b = i >> 14;
        const int kv = c >> 7, g = (c >> 6) & 1;
        const float* w = kv ? a.in[I_WVC] : a.in[I_WKC];
        const float* src = a.out + O_CMPP + (size_t)(b * TP + n * 32) * 256 + c;
        float acc = 0.f;
#pragma unroll 8
        for (int l = 0; l < 32; ++l) acc = fmaf(src[(size_t)l * 256], w[l * 2 + g], acc);
        KCB[i] = (bf16_t)(pk_bf16(acc, 0.f) & 0xffffu);
    }
}

constexpr int A_KT = 0;
constexpr int A_VT = 18432;
constexpr int A_IMPH = 35840;
constexpr int A_IMPS = 68608;
constexpr int A_MASK = 76800;
constexpr float LOG2E = 1.4426950408889634f;

struct KvSrc { const bf16_t* k; const bf16_t* v; int rstride; };

__device__ __forceinline__ void kv_issue(const KvSrc& s, int tid, u32x4& kr, u32x4& vr) {
    const int key = tid >> 3, c8 = tid & 7;
    kr = *(const u32x4*)(s.k + (size_t)key * s.rstride + c8 * 8);
    vr = *(const u32x4*)(s.v + (size_t)key * s.rstride + c8 * 8);
}
__device__ __forceinline__ void kv_write(PG8_LAS unsigned char* lds, int buf, int tid, const u32x4& kr, const u32x4& vr) {
    const int key = tid >> 3, c8 = tid & 7;
    *(PG8_LAS u32x4*)(lds + A_KT + buf * 9216 + key * 144 + c8 * 16) = kr;
    PG8_LAS bf16_t* vt = (PG8_LAS bf16_t*)(lds + A_VT + buf * 8704);
#pragma unroll
    for (int i = 0; i < 4; ++i) { vt[(c8 * 8 + 2 * i) * 68 + key] = (bf16_t)(vr[i] & 0xffffu); vt[(c8 * 8 + 2 * i + 1) * 68 + key] = (bf16_t)(vr[i] >> 16); }
}

__device__ __forceinline__ void attn_block(const int MODE, PG8_LAS unsigned char* lds, int buf, const bf16x8 (&qf)[4], int lane, float kslope, float base, int kmax, int kmin,
                                           float& m, float& l, f32x16 (&o)[2], f32x16 (&x)[2]) {
    const int lr = lane & 31, h = lane >> 5;
    const PG8_LAS unsigned char* kt_p = lds + A_KT + buf * 9216 + lr * 144 + h * 16;
#pragma unroll
    for (int kt = 0; kt < 2; ++kt) {
#pragma unroll
        for (int i = 0; i < 16; ++i) x[kt][i] = 0.f;
#pragma unroll
        for (int s = 0; s < 4; ++s) {
            const bf16x8 kf = *(const PG8_LAS bf16x8*)(kt_p + kt * 32 * 144 + s * 32);
            x[kt] = __builtin_amdgcn_mfma_f32_32x32x16_bf16(kf, qf[s], x[kt], 0, 0, 0);
        }
    }
    const float bh = base + kslope * (float)(4 * h);
    float mx = -INFINITY;
#pragma unroll
    for (int kt = 0; kt < 2; ++kt)
#pragma unroll
        for (int i = 0; i < 16; ++i) {
            const int kc = kt * 32 + (i & 3) + 8 * (i >> 2);
            x[kt][i] = fmaf(x[kt][i], LOG2E, fmaf(kslope, (float)kc, bh));
        }
    if (MODE) {
        const int hi = kmax - 4 * h, lo = kmin - 4 * h;
#pragma unroll
        for (int kt = 0; kt < 2; ++kt)
#pragma unroll
            for (int i = 0; i < 16; ++i) {
                const int kc = kt * 32 + (i & 3) + 8 * (i >> 2);
                x[kt][i] = (kc > hi || kc < lo) ? -INFINITY : x[kt][i];
            }
    }
#pragma unroll
    for (int kt = 0; kt < 2; ++kt)
#pragma unroll
        for (int i = 0; i < 16; ++i) mx = fmaxf(mx, x[kt][i]);
    mx = fmaxf(mx, __shfl_xor(mx, 32));
    const float mn = fmaxf(m, mx);
    const float corr = __builtin_amdgcn_exp2f(m - mn);
    const bool grew = __any(mn > m);
    m = mn;
    float ls = 0.f;
#pragma unroll
    for (int kt = 0; kt < 2; ++kt)
#pragma unroll
        for (int i = 0; i < 16; ++i) { const float pv = __builtin_amdgcn_exp2f(x[kt][i] - mn); x[kt][i] = pv; ls += pv; }
    l = fmaf(l, corr, ls);
    if (grew) {
#pragma unroll
        for (int dt = 0; dt < 2; ++dt)
#pragma unroll
            for (int i = 0; i < 16; ++i) o[dt][i] *= corr;
    }
    const PG8_LAS unsigned char* vt_p = lds + A_VT + buf * 8704 + lr * 136 + h * 8;
#pragma unroll
    for (int kt = 0; kt < 2; ++kt)
#pragma unroll
        for (int s = 0; s < 2; ++s) {
            u32x4 pw; pw.x = pk_bf16(x[kt][8 * s + 0], x[kt][8 * s + 1]); pw.y = pk_bf16(x[kt][8 * s + 2], x[kt][8 * s + 3]);
            pw.z = pk_bf16(x[kt][8 * s + 4], x[kt][8 * s + 5]); pw.w = pk_bf16(x[kt][8 * s + 6], x[kt][8 * s + 7]);
            const bf16x8 pf = __builtin_bit_cast(bf16x8, pw);
#pragma unroll
            for (int dt = 0; dt < 2; ++dt) {
                const PG8_LAS unsigned char* vp = vt_p + dt * 32 * 136 + (kt * 32 + s * 16) * 2;
                typedef unsigned u32x2 __attribute__((ext_vector_type(2)));
                const u32x2 v0 = *(const PG8_LAS u32x2*)vp, v1 = *(const PG8_LAS u32x2*)(vp + 16);
                u32x4 vw; vw.x = v0.x; vw.y = v0.y; vw.z = v1.x; vw.w = v1.y;
                o[dt] = __builtin_amdgcn_mfma_f32_32x32x16_bf16(__builtin_bit_cast(bf16x8, vw), pf, o[dt], 0, 0, 0);
            }
        }
}

__device__ __forceinline__ void attn_item(const Args& a, unsigned char* ws, PG8_LAS unsigned char* lds, int b, int g, int qb) {
    const int tid = opaque_v(threadIdx.x), lane = tid & 63, wv = __builtin_amdgcn_readfirstlane(tid >> 6);
    const int lr = lane & 31, h = lane >> 5;
    const int r = wv >> 1, th = wv & 1, hh = g * 4 + r;
    const int t0 = qb * 64, tb = qb;
    const int qloc = th * 32 + lr;
    const int qpos = t0 + qloc;
    const size_t qrow = (size_t)b * TP + qpos;
    const bf16_t* HB = (const bf16_t*)(ws + NB_HB);
    const bf16_t* KVB = (const bf16_t*)(ws + NB_KVB);
    const float slope2 = __builtin_amdgcn_exp2f(-(float)(hh + 1)) * LOG2E;
    bf16x8 qf[4];
#pragma unroll
    for (int s = 0; s < 4; ++s) qf[s] = *(const bf16x8*)(HB + qrow * 2560 + 1536 + hh * 64 + s * 16 + h * 8);
    const float* g3p = (const float*)(ws + NB_G3) + qrow * 32 + hh * 3;
    const float gc = sigm_f(g3p[0]), gs = sigm_f(g3p[1]), gw = sigm_f(g3p[2]);
    f32x16 res[2], o[2], x[2];
#pragma unroll
    for (int dt = 0; dt < 2; ++dt)
#pragma unroll
        for (int i = 0; i < 16; ++i) { res[dt][i] = 0.f; o[dt][i] = 0.f; }
    float m = -1e30f, l = 0.f;
    u32x4 kr, vr;
    PG8_LAS float* IMPH = (PG8_LAS float*)(lds + A_IMPH);
    PG8_LAS float* IMPS = (PG8_LAS float*)(lds + A_IMPS);
    PG8_LAS unsigned* MASK = (PG8_LAS unsigned*)(lds + A_MASK);

    {
        const bf16_t* kc = (const bf16_t*)(ws + NB_KCB) + (size_t)b * 64 * 256 + g * 64;
        KvSrc s{kc, kc + 128, 256};
        kv_issue(s, tid, kr, vr); kv_write(lds, 0, tid, kr, vr);
        if (tid < 64) MASK[tid] = 0u;
        __syncthreads();
        const int nmax = (qpos >= 31) ? ((qpos - 31) >> 5) : -1;
        attn_block(1, lds, 0, qf, lane, slope2 * 32.f, slope2 * (float)(31 - qpos), nmax, 0, m, l, o, x);
        const float lt = l + __shfl_xor(l, 32);
        const float inv = (nmax >= 0) ? 1.f / lt : 0.f;
        const float sc = gc * inv;
#pragma unroll
        for (int dt = 0; dt < 2; ++dt)
#pragma unroll
            for (int i = 0; i < 16; ++i) { res[dt][i] = o[dt][i] * sc; o[dt][i] = 0.f; }
        if (tb >= 16) {
#pragma unroll
            for (int kt = 0; kt < 2; ++kt)
#pragma unroll
                for (int c = 0; c < 4; ++c)
#pragma unroll
                    for (int e = 0; e < 2; ++e)
                        IMPH[(r * 64 + qloc) * 32 + kt * 16 + 4 * c + 2 * h + e] = (nmax >= 0) ? (x[kt][4 * c + 2 * e] + x[kt][4 * c + 2 * e + 1]) * inv : 0.f;
        }
        m = -1e30f; l = 0.f;
        __syncthreads();
    }
    if (tb >= 16) {
        const int tq = opaque_v(tid);
        const int q = tq >> 3, jq = tq & 7;
        float v4[4];
#pragma unroll
        for (int e = 0; e < 4; ++e) {
            const int j = jq * 4 + e;
            float v = IMPH[(0 * 64 + q) * 32 + j] + IMPH[(1 * 64 + q) * 32 + j] + IMPH[(2 * 64 + q) * 32 + j] + IMPH[(3 * 64 + q) * 32 + j];
            if (j == 0 || j == tb || j == tb - 1) v = 1e4f;
            IMPS[q * 32 + j] = v; v4[e] = v;
        }
        __syncthreads();
        unsigned bits = 0u;
#pragma unroll
        for (int e = 0; e < 4; ++e) {
            const int j = jq * 4 + e;
            int rank = 0;
            for (int i = 0; i <= tb; ++i) { const float vi = IMPS[q * 32 + i]; rank += (vi > v4[e] || (vi == v4[e] && i < j)) ? 1 : 0; }
            if (j <= tb && rank < 16) bits |= 1u << j;
        }
        if (bits) atomicOr((unsigned*)&MASK[q], bits);
    } else {
        if (tid < 64) MASK[tid] = (2u << tb) - 1u;
    }
    __syncthreads();
    const unsigned selmask = MASK[qloc];

    {
        const bf16_t* kb = KVB + (size_t)b * TP * 768 + 256 + g * 64;
        { KvSrc s{kb, kb + 128, 768}; kv_issue(s, tid, kr, vr); kv_write(lds, 0, tid, kr, vr); }
        __syncthreads();
        for (int j = 0; j <= tb; ++j) {
            if (j < tb) { KvSrc s{kb + (size_t)(j + 1) * 64 * 768, kb + (size_t)(j + 1) * 64 * 768 + 128, 768}; kv_issue(s, tid, kr, vr); }
            const float base = ((selmask >> j) & 1u) ? slope2 * (float)(j * 64 - qpos) : -INFINITY;
            attn_block(j == tb, lds, j & 1, qf, lane, slope2, base, qloc, 0, m, l, o, x);
            if (j < tb) kv_write(lds, (j + 1) & 1, tid, kr, vr);
            __syncthreads();
        }
        const float lt = l + __shfl_xor(l, 32);
        const float sc = gs / lt;
#pragma unroll
        for (int dt = 0; dt < 2; ++dt)
#pragma unroll
            for (int i = 0; i < 16; ++i) { res[dt][i] = fmaf(o[dt][i], sc, res[dt][i]); o[dt][i] = 0.f; }
        m = -1e30f; l = 0.f;
    }
    {
        const int jlo = (tb >= 8) ? tb - 8 : 0;
        const bf16_t* kb = KVB + (size_t)b * TP * 768 + 512 + g * 64;
        { KvSrc s{kb + (size_t)jlo * 64 * 768, kb + (size_t)jlo * 64 * 768 + 128, 768}; kv_issue(s, tid, kr, vr); kv_write(lds, 0, tid, kr, vr); }
        __syncthreads();
        for (int j = jlo; j <= tb; ++j) {
            const int bi = (j - jlo) & 1;
            if (j < tb) { KvSrc s{kb + (size_t)(j + 1) * 64 * 768, kb + (size_t)(j + 1) * 64 * 768 + 128, 768}; kv_issue(s, tid, kr, vr); }
            const float base = slope2 * (float)(j * 64 - qpos);
            attn_block((j == tb) || (j == tb - 8), lds, bi, qf, lane, slope2, base, (j == tb) ? qloc : 64, (j == tb - 8) ? qpos - 511 - j * 64 : 0, m, l, o, x);
            if (j < tb) kv_write(lds, bi ^ 1, tid, kr, vr);
            __syncthreads();
        }
        const float lt = l + __shfl_xor(l, 32);
        const float sc = gw / lt;
#pragma unroll
        for (int dt = 0; dt < 2; ++dt)
#pragma unroll
            for (int i = 0; i < 16; ++i) res[dt][i] = fmaf(o[dt][i], sc, res[dt][i]);
    }
    {
        const size_t qrow2 = (size_t)b * TP + t0 + th * 32 + (opaque_v(lane) & 31);
        const bf16_t* zb = HB + qrow2 * 2560 + 2048 + hh * 64;
        bf16_t* dst = (bf16_t*)(ws + NB_CATB) + qrow2 * 1024 + 512 + hh * 64;
        typedef unsigned u32x2 __attribute__((ext_vector_type(2)));
#pragma unroll
        for (int dt = 0; dt < 2; ++dt)
#pragma unroll
            for (int c = 0; c < 4; ++c) {
                const int d = dt * 32 + 8 * c + 4 * h;
                const u32x2 zv = *(const u32x2*)(zb + d);
                const float z0 = __uint_as_float(zv.x << 16), z1 = __uint_as_float(zv.x & 0xffff0000u), z2 = __uint_as_float(zv.y << 16), z3 = __uint_as_float(zv.y & 0xffff0000u);
                u32x2 w; w.x = pk_bf16(res[dt][4 * c + 0] * silu_f(z0), res[dt][4 * c + 1] * silu_f(z1)); w.y = pk_bf16(res[dt][4 * c + 2] * silu_f(z2), res[dt][4 * c + 3] * silu_f(z3));
                *(u32x2*)(dst + d) = w;
            }
    }
}

constexpr int XSH_ROWS = 16640;
__device__ __forceinline__ float wave_sum(float v) {
#pragma unroll
    for (int o = 32; o > 0; o >>= 1) v += __shfl_xor(v, o);
    return v;
}
__device__ __forceinline__ void ld_row16(const float* __restrict__ src, int lane, float (&x)[16]) {
#pragma unroll
    for (int q = 0; q < 4; ++q) { const float4 v = *(const float4*)(src + q * 256 + lane * 4); x[4 * q] = v.x; x[4 * q + 1] = v.y; x[4 * q + 2] = v.z; x[4 * q + 3] = v.w; }
}
__device__ __forceinline__ void ln_calc16(const float* __restrict__ g, const float* __restrict__ bta, int lane, float (&x)[16]) {
    float sm = 0.f;
#pragma unroll
    for (int i = 0; i < 16; ++i) sm += x[i];
    const float mean = wave_sum(sm) * (1.f / 1024.f);
    float sq = 0.f;
#pragma unroll
    for (int i = 0; i < 16; ++i) { x[i] -= mean; sq += x[i] * x[i]; }
    const float rs = rsqrtf(wave_sum(sq) * (1.f / 1024.f) + LN_EPS);
#pragma unroll
    for (int q = 0; q < 4; ++q) {
        const float4 gv = *(const float4*)(g + q * 256 + lane * 4), bv = *(const float4*)(bta + q * 256 + lane * 4);
        x[4 * q] = x[4 * q] * rs * gv.x + bv.x; x[4 * q + 1] = x[4 * q + 1] * rs * gv.y + bv.y; x[4 * q + 2] = x[4 * q + 2] * rs * gv.z + bv.z; x[4 * q + 3] = x[4 * q + 3] * rs * gv.w + bv.w;
    }
}
__device__ __forceinline__ void ln_row16(const float* __restrict__ src, const float* __restrict__ g, const float* __restrict__ bta, int lane, float (&x)[16]) {
    ld_row16(src, lane, x); ln_calc16(g, bta, lane, x);
}
constexpr int LR_A = 0;
__device__ __forceinline__ void store_x1_xsh(const Args& a, unsigned char* ws, PG8_LAS unsigned char* lds, size_t xrow, int lrow, int lane, const float (&cur)[16], const float (&prev)[16]) {
    typedef unsigned u32x2 __attribute__((ext_vector_type(2)));
#pragma unroll 1
    for (int n = 0; n < 6; ++n) {
        const float* mu = a.in[I_MU] + n * 1024 + lane * 4;
        u32x2 w[4];
#pragma unroll
        for (int q = 0; q < 4; ++q) { const float4 m4 = *(const float4*)(mu + q * 256);
            w[q].x = pk_bf16(fmaf(prev[4 * q] - cur[4 * q], m4.x, cur[4 * q]), fmaf(prev[4 * q + 1] - cur[4 * q + 1], m4.y, cur[4 * q + 1]));
            w[q].y = pk_bf16(fmaf(prev[4 * q + 2] - cur[4 * q + 2], m4.z, cur[4 * q + 2]), fmaf(prev[4 * q + 3] - cur[4 * q + 3], m4.w, cur[4 * q + 3])); }
        if (n < 4 || lrow < 0) {
            bf16_t* dst = (bf16_t*)(ws + NB_XSH) + ((size_t)n * XSH_ROWS + xrow) * 1024 + lane * 4;
#pragma unroll
            for (int q = 0; q < 4; ++q) *(u32x2*)(dst + q * 256) = w[q];
        } else {
            PG8_LAS bf16_t* dst = (PG8_LAS bf16_t*)(lds + LR_A) + ((n - 4) * 32 + lrow) * 1032 + lane * 4;
#pragma unroll
            for (int q = 0; q < 4; ++q) *(PG8_LAS u32x2*)(dst + q * 256) = w[q];
        }
    }
}
template <class ROWMAP>
__device__ __forceinline__ void lora_pass(unsigned char* ws, PG8_LAS unsigned char* lds, int tid, ROWMAP rowmap) {
    const int lane = tid & 63, wv = tid >> 6, lr = lane & 31, h = lane >> 5;
    const int which = wv >> 2, kq = wv & 3;
    PG8_LAS bf16_t* AT = (PG8_LAS bf16_t*)(lds + LR_A) + which * 32 * 1032;
    PG8_LAS float* P = (PG8_LAS float*)(lds + LR_A);
    __syncthreads();
    const bf16_t* Bt = (const bf16_t*)(ws + (which ? NB_A1T : NB_W1T));
    f32x16 acc0, acc1;
#pragma unroll
    for (int i = 0; i < 16; ++i) { acc0[i] = 0.f; acc1[i] = 0.f; }
#pragma unroll
    for (int s = 0; s < 16; ++s) {
        const int k = kq * 256 + s * 16 + h * 8;
        const bf16x8 av = *(const PG8_LAS bf16x8*)(AT + lr * 1032 + k);
        const bf16x8 b0 = *(const bf16x8*)(Bt + ((size_t)(kq * 16 + s) * 64 + lane) * 8), b1 = *(const bf16x8*)(Bt + ((size_t)(64 + kq * 16 + s) * 64 + lane) * 8);
        acc0 = __builtin_amdgcn_mfma_f32_32x32x16_bf16(av, b0, acc0, 0, 0, 0);
        acc1 = __builtin_amdgcn_mfma_f32_32x32x16_bf16(av, b1, acc1, 0, 0, 0);
    }
    __syncthreads();
#pragma unroll
    for (int q = 0; q < 4; ++q) {
        *(PG8_LAS f32x4*)(P + (wv * 64 + lane) * 32 + q * 4) = (f32x4){acc0[4 * q], acc0[4 * q + 1], acc0[4 * q + 2], acc0[4 * q + 3]};
        *(PG8_LAS f32x4*)(P + (wv * 64 + lane) * 32 + 16 + q * 4) = (f32x4){acc1[4 * q], acc1[4 * q + 1], acc1[4 * q + 2], acc1[4 * q + 3]};
    }
    __syncthreads();
    if (wv < 4) {
        const int wh = wv >> 1, half = wv & 1;
        float sum[16];
#pragma unroll
        for (int i = 0; i < 16; ++i) sum[i] = 0.f;
#pragma unroll
        for (int w = 0; w < 4; ++w)
#pragma unroll
            for (int q = 0; q < 4; ++q) { const f32x4 v = *(const PG8_LAS f32x4*)(P + ((wh * 4 + w) * 64 + lane) * 32 + half * 16 + q * 4); sum[4 * q] += v[0]; sum[4 * q + 1] += v[1]; sum[4 * q + 2] += v[2]; sum[4 * q + 3] += v[3]; }
        bf16_t* dst = (bf16_t*)(ws + (wh ? NB_AWB : NB_TWB)) + half * 32 + lr;
#pragma unroll
        for (int i = 0; i < 16; ++i) { const int rl = (i & 3) + 8 * (i >> 2) + 4 * h; const float v = wh ? sum[i] : tanhf(sum[i]); dst[rowmap(rl) * 64] = (bf16_t)(pk_bf16c(v, 0.f) & 0xffffu); }
    }
    __syncthreads();
}
__device__ __forceinline__ void phase_lns(const Args& a, unsigned char* ws, PG8_LAS unsigned char* lds, int bid, int nb) {
    const int tid = opaque_v(threadIdx.x), lane = tid & 63, wv = tid >> 6;
    const float* PRE = (const float*)ws + WS_PRE;
    const float* g = a.in[I_LNG]; const float* bta = a.in[I_LNB];
    for (int blk = bid; blk < 256; blk += nb) {
        const int r0 = blk * 64 + wv * 8;
        float prev[16], cur[16];
        if ((r0 & (TP - 1)) == 0) {
#pragma unroll
            for (int i = 0; i < 16; ++i) prev[i] = 0.f;
        } else ln_row16(PRE + (size_t)(r0 - 1) * 1024, g, bta, lane, prev);
        float nxt[16];
        ld_row16(PRE + (size_t)r0 * 1024, lane, nxt);
#pragma unroll 1
        for (int k = 0; k < 8; ++k) {
            const int row = r0 + k;
#pragma unroll
            for (int i = 0; i < 16; ++i) cur[i] = nxt[i];
            if (k + 1 < 8) ld_row16(PRE + (size_t)(row + 1) * 1024, lane, nxt);
            ln_calc16(g, bta, lane, cur);
            store_x1_xsh(a, ws, lds, row, wv * 4 + (k & 3), lane, cur, prev);
            if ((row & (TP - 1)) == TP - 1) {
                float* so = a.out + O_SHP + (size_t)(row >> 11) * 1024 + lane * 4;
#pragma unroll
                for (int q = 0; q < 4; ++q) *(float4*)(so + q * 256) = make_float4(cur[4 * q], cur[4 * q + 1], cur[4 * q + 2], cur[4 * q + 3]);
            }
#pragma unroll
            for (int i = 0; i < 16; ++i) prev[i] = cur[i];
            if ((k & 3) == 3) {
                const int rbase = blk * 64 + (k & 4);
                lora_pass(ws, lds, tid, [&](int rl) { return (size_t)(rbase + (rl >> 2) * 8 + (rl & 3)); });
            }
        }
    }
    for (int s = bid * 8 + wv; s < BS; s += nb * 8) {
        float prev[16], cur[16];
        const float* sp = a.in[I_SSHIFT] + (size_t)s * 1024 + lane * 4;
#pragma unroll
        for (int q = 0; q < 4; ++q) { const float4 v = *(const float4*)(sp + q * 256); prev[4 * q] = v.x; prev[4 * q + 1] = v.y; prev[4 * q + 2] = v.z; prev[4 * q + 3] = v.w; }
        ln_row16(PRE + (size_t)(MP + s) * 1024, g, bta, lane, cur);
        store_x1_xsh(a, ws, lds, MP + s, -1, lane, cur, prev);
        float* so = a.out + O_SHS + (size_t)s * 1024 + lane * 4;
#pragma unroll
        for (int q = 0; q < 4; ++q) *(float4*)(so + q * 256) = make_float4(cur[4 * q], cur[4 * q + 1], cur[4 * q + 2], cur[4 * q + 3]);
    }
}

struct Order3 {
    pg8::StaticOrder so;
    __device__ void init(int G, int c) { so.init(MP, 4096, G, c); }
    __device__ bool next(int i, Unit& u) const { Unit v; if (!so.next(i, v)) return false; const int n = v.pn >> 2; u.pm = n * 65 + v.pm; u.pn = v.pn; return true; }
    __device__ __forceinline__ void a_ready(const Unit&) const {}
    __device__ __forceinline__ void done(const Unit&) const {}
};
struct Epi3 {
    static constexpr bool PERM = true, AFTER_DRAIN = false;
    bf16_t* O;
    __device__ __forceinline__ void operator()(const f32x4 (&acc)[2][2][4][2], const Unit& u, int wr, int wc, int fr, int fq) const {
        const int n = u.pn >> 2, pm = u.pm - n * 65, pn = u.pn & 3;
        const int row0 = pm * 256 + wr * 64 + fr, col0 = pn * 256 + wc * 32 + 8 * fq;
        bf16_t* base = O + (size_t)n * XSH_ROWS * 1024;
#pragma unroll
        for (int ai = 0; ai < 2; ++ai)
#pragma unroll
            for (int m = 0; m < 4; ++m) { bf16_t* rowp = base + (size_t)(row0 + ai * 128 + m * 16) * 1024 + col0;
#pragma unroll
                for (int bj = 0; bj < 2; ++bj) { const f32x4 v0 = acc[ai][bj][m][0], v1 = acc[ai][bj][m][1];
                    u32x4 w; w.x = pk_bf16c(v0[0], v0[1]); w.y = pk_bf16c(v0[2], v0[3]); w.z = pk_bf16c(v1[0], v1[1]); w.w = pk_bf16c(v1[2], v1[3]);
                    *(u32x4*)(rowp + bj * 128) = w; } }
    }
};
struct EpiPreRes {
    static constexpr bool PERM = false, AFTER_DRAIN = false;
    float* C; const float* X;
    __device__ __forceinline__ void operator()(const f32x4 (&acc)[2][2][4][2], const Unit& u, int wr, int wc, int fr, int fq) const {
        const int row0 = u.pm * 256 + wr * 64 + fr, col0 = u.pn * 256 + wc * 32 + 4 * fq;
#pragma unroll
        for (int ai = 0; ai < 2; ++ai)
#pragma unroll
            for (int m = 0; m < 4; ++m) { const size_t off = (size_t)(row0 + ai * 128 + m * 16) * 1024 + col0;
#pragma unroll
                for (int bj = 0; bj < 2; ++bj)
#pragma unroll
                    for (int n = 0; n < 2; ++n) { const f32x4 xv = *(const f32x4*)(X + off + bj * 128 + n * 16); *(f32x4*)(C + off + bj * 128 + n * 16) = acc[ai][bj][m][n] + xv * ALPHA; } }
    }
};

constexpr int LR_A0 = 0;
constexpr int LR_P = 67584;
struct LoraRegs { u32x4 v[8]; };
__device__ __forceinline__ void lora_load(unsigned char* ws, int task, int tid, LoraRegs& r) {
    const int rt = task >> 1, which = task & 1;
    const bf16_t* A = (const bf16_t*)(ws + NB_XSH) + ((size_t)(4 + which) * XSH_ROWS + (size_t)rt * 32) * 1024;
#pragma unroll
    for (int i = 0; i < 8; ++i) { const int idx = tid + i * NTH; r.v[i] = *(const u32x4*)(A + (size_t)(idx >> 7) * 1024 + (idx & 127) * 8); }
}
__device__ __forceinline__ void lora_tile(unsigned char* ws, PG8_LAS unsigned char* lds, int task, int tid, const LoraRegs& r) {
    const int rt = task >> 1, which = task & 1;
    const int lane = tid & 63, wv = tid >> 6, lr = lane & 31, h = lane >> 5;
    PG8_LAS bf16_t* AT = (PG8_LAS bf16_t*)(lds + LR_A0);
    PG8_LAS float* P = (PG8_LAS float*)(lds + LR_P);
#pragma unroll
    for (int i = 0; i < 8; ++i) { const int idx = tid + i * NTH; *(PG8_LAS u32x4*)(AT + (idx >> 7) * 1032 + (idx & 127) * 8) = r.v[i]; }
    __syncthreads();
    const bf16_t* Bt = (const bf16_t*)(ws + (which ? NB_A1T : NB_W1T));
    f32x16 acc0, acc1;
#pragma unroll
    for (int i = 0; i < 16; ++i) { acc0[i] = 0.f; acc1[i] = 0.f; }
#pragma unroll
    for (int s = 0; s < 8; ++s) {
        const int k = wv * 128 + s * 16 + h * 8;
        const bf16x8 av = *(const PG8_LAS bf16x8*)(AT + lr * 1032 + k);
        const bf16x8 b0 = *(const bf16x8*)(Bt + ((size_t)(wv * 8 + s) * 64 + lane) * 8), b1 = *(const bf16x8*)(Bt + ((size_t)(64 + wv * 8 + s) * 64 + lane) * 8);
        acc0 = __builtin_amdgcn_mfma_f32_32x32x16_bf16(av, b0, acc0, 0, 0, 0);
        acc1 = __builtin_amdgcn_mfma_f32_32x32x16_bf16(av, b1, acc1, 0, 0, 0);
    }
#pragma unroll
    for (int q = 0; q < 4; ++q) {
        *(PG8_LAS f32x4*)(P + (wv * 64 + lane) * 32 + q * 4) = (f32x4){acc0[4 * q], acc0[4 * q + 1], acc0[4 * q + 2], acc0[4 * q + 3]};
        *(PG8_LAS f32x4*)(P + (wv * 64 + lane) * 32 + 16 + q * 4) = (f32x4){acc1[4 * q], acc1[4 * q + 1], acc1[4 * q + 2], acc1[4 * q + 3]};
    }
    __syncthreads();
    if (wv < 2) {
        float sum[16];
#pragma unroll
        for (int i = 0; i < 16; ++i) sum[i] = 0.f;
#pragma unroll
        for (int w = 0; w < 8; ++w)
#pragma unroll
            for (int q = 0; q < 4; ++q) { const f32x4 v = *(const PG8_LAS f32x4*)(P + (w * 64 + lane) * 32 + wv * 16 + q * 4); sum[4 * q] += v[0]; sum[4 * q + 1] += v[1]; sum[4 * q + 2] += v[2]; sum[4 * q + 3] += v[3]; }
        bf16_t* dst = (bf16_t*)(ws + (which ? NB_AWB : NB_TWB)) + (size_t)rt * 32 * 64 + wv * 32 + lr;
#pragma unroll
        for (int i = 0; i < 16; ++i) { const int row = (i & 3) + 8 * (i >> 2) + 4 * h; const float v = which ? sum[i] : tanhf(sum[i]); dst[(size_t)row * 64] = (bf16_t)(pk_bf16c(v, 0.f) & 0xffffu); }
    }
    __syncthreads();
}

__device__ __forceinline__ float dpp_red16f(float v) {
    v += __builtin_bit_cast(float, __builtin_amdgcn_update_dpp(0, __builtin_bit_cast(int, v), 0xB1, 0xF, 0xF, true));
    v += __builtin_bit_cast(float, __builtin_amdgcn_update_dpp(0, __builtin_bit_cast(int, v), 0x4E, 0xF, 0xF, true));
    v += __builtin_bit_cast(float, __builtin_amdgcn_update_dpp(0, __builtin_bit_cast(int, v), 0x141, 0xF, 0xF, true));
    v += __builtin_bit_cast(float, __builtin_amdgcn_update_dpp(0, __builtin_bit_cast(int, v), 0x140, 0xF, 0xF, true));
    return v;
}
__device__ __forceinline__ void prep2_task(const Args& a, unsigned char* ws, int rt, int hd, int lane) {
    const int lr = lane & 31, h2 = lane >> 5;
    const size_t row0 = (size_t)rt * 32;
    const bf16_t* W2T = (const bf16_t*)(ws + NB_W2T); const bf16_t* A2T = (const bf16_t*)(ws + NB_A2T);
    const bf16_t* TWB = (const bf16_t*)(ws + NB_TWB); const bf16_t* AWB = (const bf16_t*)(ws + NB_AWB);
    f32x16 aw[2], aa[2];
#pragma unroll
    for (int ct = 0; ct < 2; ++ct)
#pragma unroll
        for (int i = 0; i < 16; ++i) { aw[ct][i] = 0.f; aa[ct][i] = 0.f; }
#pragma unroll
    for (int s = 0; s < 4; ++s) {
        const bf16x8 at = *(const bf16x8*)(TWB + (row0 + lr) * 64 + s * 16 + h2 * 8), aa_ = *(const bf16x8*)(AWB + (row0 + lr) * 64 + s * 16 + h2 * 8);
#pragma unroll
        for (int ct = 0; ct < 2; ++ct) {
            const size_t e = (size_t)hd * 64 + ct * 32 + lr;
            const bf16x8 w2 = *(const bf16x8*)(W2T + e * 64 + s * 16 + h2 * 8), a2 = *(const bf16x8*)(A2T + e * 64 + s * 16 + h2 * 8);
            aw[ct] = __builtin_amdgcn_mfma_f32_32x32x16_bf16(at, w2, aw[ct], 0, 0, 0);
            aa[ct] = __builtin_amdgcn_mfma_f32_32x32x16_bf16(aa_, a2, aa[ct], 0, 0, 0);
        }
    }
    const bf16_t* KB = (const bf16_t*)(ws + NB_RKVZ) + (size_t)1 * XSH_ROWS * 1024;
    const bf16_t* RB = (const bf16_t*)(ws + NB_RKVZ);
    float* DEC = (float*)(ws + NB_DEC);
    bf16_t* KKN = (bf16_t*)(ws + NB_KKN); bf16_t* KKA = (bf16_t*)(ws + NB_KKA); bf16_t* KP = (bf16_t*)(ws + NB_KP);
    float w0v[2], a0v[2], kkp[2], kap[2], rkp[2];
#pragma unroll
    for (int ct = 0; ct < 2; ++ct) { const int e = hd * 64 + ct * 32 + lr; w0v[ct] = a.in[I_W0][e]; a0v[ct] = a.in[I_A0][e]; kkp[ct] = a.in[I_KK][e]; kap[ct] = a.in[I_KA][e]; rkp[ct] = a.in[I_RK][e]; }
    float n2[16], rk[16];
#pragma unroll
    for (int i = 0; i < 16; ++i) { n2[i] = 0.f; rk[i] = 0.f; }
#pragma unroll
    for (int ct = 0; ct < 2; ++ct)
#pragma unroll
        for (int i = 0; i < 16; ++i) {
            const size_t off = (row0 + (i & 3) + 8 * (i >> 2) + 4 * h2) * 1024 + hd * 64 + ct * 32 + lr;
            const float kf = bf2f(KB[off]), rf = bf2f(RB[off]);
            const float wl = w0v[ct] + aw[ct][i];
            const float sp = fmaxf(-wl, 0.f) + log1pf(__expf(-fabsf(wl)));
            DEC[off] = __expf(-__expf(-sp - 0.5f));
            const float av_ = sigm_f(a0v[ct] + aa[ct][i]);
            const float kk = kf * kkp[ct];
            const float kp = kf * (1.f + (av_ - 1.f) * kap[ct]);
            KP[off] = (bf16_t)(pk_bf16(kp, 0.f) & 0xffffu);
            aw[ct][i] = kk; aa[ct][i] = av_;
            n2[i] = fmaf(kk, kk, n2[i]);
            rk[i] = fmaf(rf * kp, rkp[ct], rk[i]);
        }
#pragma unroll
    for (int i = 0; i < 16; ++i) {
        float v = dpp_red16f(n2[i]); v += __shfl_xor(v, 16); n2[i] = 1.f / fmaxf(sqrtf(v), 1e-12f);
        float w = dpp_red16f(rk[i]); w += __shfl_xor(w, 16); rk[i] = w;
    }
#pragma unroll
    for (int ct = 0; ct < 2; ++ct)
#pragma unroll
        for (int i = 0; i < 16; ++i) {
            const size_t off = (row0 + (i & 3) + 8 * (i >> 2) + 4 * h2) * 1024 + hd * 64 + ct * 32 + lr;
            const float kn = aw[ct][i] * n2[i];
            KKN[off] = (bf16_t)(pk_bf16(kn, 0.f) & 0xffffu);
            KKA[off] = (bf16_t)(pk_bf16(kn * aa[ct][i], 0.f) & 0xffffu);
        }
    if (lr == 0) {
#pragma unroll
        for (int i = 0; i < 16; ++i) ((float*)(ws + NB_RKS))[(row0 + (i & 3) + 8 * (i >> 2) + 4 * h2) * 16 + hd] = rk[i];
    }
}

constexpr int SC_BUF = 53248;
__device__ __forceinline__ float dpp_red16(float v) {
    v += __builtin_bit_cast(float, __builtin_amdgcn_update_dpp(0, __builtin_bit_cast(int, v), 0xB1, 0xF, 0xF, true));
    v += __builtin_bit_cast(float, __builtin_amdgcn_update_dpp(0, __builtin_bit_cast(int, v), 0x4E, 0xF, 0xF, true));
    v += __builtin_bit_cast(float, __builtin_amdgcn_update_dpp(0, __builtin_bit_cast(int, v), 0x141, 0xF, 0xF, true));
    v += __builtin_bit_cast(float, __builtin_amdgcn_update_dpp(0, __builtin_bit_cast(int, v), 0x140, 0xF, 0xF, true));
    return v;
}
struct ScanRegs { u32x4 d0, d1, kn, ka, kp, r, v; };
__device__ __forceinline__ void scan_issue(unsigned char* ws, int b, int hd, int vh, int chunk, int tid, ScanRegs& g) {
    const int tt = tid >> 3, part = tid & 7;
    const size_t row = (size_t)b * TP + chunk * 64 + tt;
    const size_t off = row * 1024 + hd * 64 + part * 8;
    const float* dp = (const float*)(ws + NB_DEC) + off;
    g.d0 = *(const u32x4*)dp; g.d1 = *(const u32x4*)(dp + 4);
    g.kn = *(const u32x4*)((const bf16_t*)(ws + NB_KKN) + off);
    g.ka = *(const u32x4*)((const bf16_t*)(ws + NB_KKA) + off);
    g.kp = *(const u32x4*)((const bf16_t*)(ws + NB_KP) + off);
    g.r = *(const u32x4*)((const bf16_t*)(ws + NB_RKVZ) + ((size_t)0 * XSH_ROWS + row) * 1024 + hd * 64 + part * 8);
    if (part < 4) g.v = *(const u32x4*)((const bf16_t*)(ws + NB_RKVZ) + ((size_t)2 * XSH_ROWS + row) * 1024 + hd * 64 + vh * 32 + part * 8);
}
__device__ __forceinline__ void scan_write(PG8_LAS unsigned char* buf, int tid, const ScanRegs& g) {
    const int tt = tid >> 3, part = tid & 7;
    *(PG8_LAS u32x4*)(buf + tt * 256 + part * 32) = g.d0; *(PG8_LAS u32x4*)(buf + tt * 256 + part * 32 + 16) = g.d1;
    *(PG8_LAS u32x4*)(buf + 16384 + tt * 128 + part * 16) = g.kn;
    *(PG8_LAS u32x4*)(buf + 24576 + tt * 128 + part * 16) = g.ka;
    *(PG8_LAS u32x4*)(buf + 32768 + tt * 128 + part * 16) = g.kp;
    *(PG8_LAS u32x4*)(buf + 40960 + tt * 128 + part * 16) = g.r;
    if (part < 4) *(PG8_LAS u32x4*)(buf + 49152 + tt * 64 + part * 16) = g.v;
}
__device__ __forceinline__ void scan_prompt(const Args& a, unsigned char* ws, PG8_LAS unsigned char* lds, int item) {
    const int tid = opaque_v(threadIdx.x);
    const int b = item >> 5, hd = (item >> 1) & 15, vh = item & 1;
    const int vl = tid >> 4, kq = tid & 15;
    typedef unsigned u32x2 __attribute__((ext_vector_type(2)));
    float S[4] = {0.f, 0.f, 0.f, 0.f};
    ScanRegs g;
    PG8_LAS float* YS = (PG8_LAS float*)(lds + 2 * SC_BUF);
    scan_issue(ws, b, hd, vh, 0, tid, g); scan_write(lds, tid, g);
    __syncthreads();
    for (int c = 0; c < TP / 64; ++c) {
        PG8_LAS unsigned char* buf = lds + (c & 1) * SC_BUF;
        if (c + 1 < TP / 64) scan_issue(ws, b, hd, vh, c + 1, tid, g);
#pragma unroll 4
        for (int tt = 0; tt < 64; ++tt) {
            const f32x4 w = *(const PG8_LAS f32x4*)(buf + tt * 256 + kq * 16);
            const u32x2 knw = *(const PG8_LAS u32x2*)(buf + 16384 + tt * 128 + kq * 8), kaw = *(const PG8_LAS u32x2*)(buf + 24576 + tt * 128 + kq * 8),
                        kpw = *(const PG8_LAS u32x2*)(buf + 32768 + tt * 128 + kq * 8), rw = *(const PG8_LAS u32x2*)(buf + 40960 + tt * 128 + kq * 8);
            const float vv = bf2f(*(const PG8_LAS bf16_t*)(buf + 49152 + tt * 64 + vl * 2));
            const float kn[4] = {__uint_as_float(knw.x << 16), __uint_as_float(knw.x & 0xffff0000u), __uint_as_float(knw.y << 16), __uint_as_float(knw.y & 0xffff0000u)};
            const float ka[4] = {__uint_as_float(kaw.x << 16), __uint_as_float(kaw.x & 0xffff0000u), __uint_as_float(kaw.y << 16), __uint_as_float(kaw.y & 0xffff0000u)};
            const float kp[4] = {__uint_as_float(kpw.x << 16), __uint_as_float(kpw.x & 0xffff0000u), __uint_as_float(kpw.y << 16), __uint_as_float(kpw.y & 0xffff0000u)};
            const float rr[4] = {__uint_as_float(rw.x << 16), __uint_as_float(rw.x & 0xffff0000u), __uint_as_float(rw.y << 16), __uint_as_float(rw.y & 0xffff0000u)};
            float sa = S[0] * kn[0];
            sa = fmaf(S[1], kn[1], sa); sa = fmaf(S[2], kn[2], sa); sa = fmaf(S[3], kn[3], sa);
            sa = dpp_red16(sa);
            float y = 0.f;
#pragma unroll
            for (int i = 0; i < 4; ++i) { S[i] = fmaf(S[i], w[i], fmaf(vv, kp[i], -sa * ka[i])); y = fmaf(S[i], rr[i], y); }
            y = dpp_red16(y);
            if (kq == 0) YS[tt * 32 + vl] = y;
        }
        if (c + 1 < TP / 64) scan_write(lds + ((c + 1) & 1) * SC_BUF, tid, g);
        __syncthreads();
        {
            float* Y = (float*)(ws + NB_Y);
            for (int i = tid; i < 64 * 32; i += NTH) { const int tt = i >> 5, v = i & 31; Y[((size_t)b * TP + c * 64 + tt) * 1024 + hd * 64 + vh * 32 + v] = YS[i]; }
        }
        __syncthreads();
    }
    float* so = a.out + O_WKVP + ((size_t)(b * 16 + hd) * 64 + vh * 32 + vl) * 64 + kq * 4;
    *(float4*)so = make_float4(S[0], S[1], S[2], S[3]);
}
__device__ __forceinline__ void scan_sample(const Args& a, unsigned char* ws, int s, int hd, int lane) {
    const size_t row = (size_t)MP + s;
    const float* s0 = a.in[I_SWKV] + ((size_t)(s * 16 + hd) * 64 + lane) * 64;
    float* sout = a.out + O_WKVS + ((size_t)(s * 16 + hd) * 64 + lane) * 64;
    const int e = hd * 64 + lane;
    const float twl = bf2f(((const bf16_t*)(ws + NB_TWB) + row * 64)[lane]), awl = bf2f(((const bf16_t*)(ws + NB_AWB) + row * 64)[lane]);
    const bf16_t* w2r = (const bf16_t*)(ws + NB_W2T) + (size_t)e * 64; const bf16_t* a2r = (const bf16_t*)(ws + NB_A2T) + (size_t)e * 64;
    float wl = a.in[I_W0][e], al = a.in[I_A0][e];
#define RL(X, K) __builtin_bit_cast(float, __builtin_amdgcn_readlane(__builtin_bit_cast(int, X), K))
#pragma unroll
    for (int j8 = 0; j8 < 8; ++j8) {
        const u32x4 wq = *(const u32x4*)(w2r + j8 * 8), aq = *(const u32x4*)(a2r + j8 * 8);
#pragma unroll
        for (int i = 0; i < 8; ++i) {
            const float wv_ = __uint_as_float((i & 1) ? (wq[i >> 1] & 0xffff0000u) : (wq[i >> 1] << 16)), av_ = __uint_as_float((i & 1) ? (aq[i >> 1] & 0xffff0000u) : (aq[i >> 1] << 16));
            wl = fmaf(RL(twl, j8 * 8 + i), wv_, wl); al = fmaf(RL(awl, j8 * 8 + i), av_, al);
        }
    }
    const float decl = __expf(-0.60653066f * sigm_f(wl));
    const float aa_ = sigm_f(al);
    const float kf = bf2f(((const bf16_t*)(ws + NB_RKVZ) + ((size_t)1 * XSH_ROWS + row) * 1024)[e]);
    const float rl = bf2f(((const bf16_t*)(ws + NB_RKVZ) + ((size_t)0 * XSH_ROWS + row) * 1024)[e]);
    const float vv = bf2f(((const bf16_t*)(ws + NB_RKVZ) + ((size_t)2 * XSH_ROWS + row) * 1024)[e]);
    const float kkr = kf * a.in[I_KK][e];
    const float kpl = kf * (1.f + (aa_ - 1.f) * a.in[I_KA][e]);
    const float knl = kkr / fmaxf(sqrtf(wave_sum(kkr * kkr)), 1e-12f);
    const float kal = knl * aa_;
    const float rkv = wave_sum(rl * kpl * a.in[I_RK][e]);
    float S[64];
#pragma unroll
    for (int q = 0; q < 16; ++q) { const float4 v4 = *(const float4*)(s0 + q * 4); S[4 * q] = v4.x; S[4 * q + 1] = v4.y; S[4 * q + 2] = v4.z; S[4 * q + 3] = v4.w; }
    float sa = 0.f;
#pragma unroll
    for (int k = 0; k < 64; ++k) sa = fmaf(S[k], RL(knl, k), sa);
    float y = 0.f;
#pragma unroll
    for (int k = 0; k < 64; ++k) { S[k] = fmaf(S[k], RL(decl, k), fmaf(vv, RL(kpl, k), -sa * RL(kal, k))); y = fmaf(S[k], RL(rl, k), y); }
#undef RL
#pragma unroll
    for (int q = 0; q < 16; ++q) *(float4*)(sout + q * 4) = make_float4(S[4 * q], S[4 * q + 1], S[4 * q + 2], S[4 * q + 3]);
    {
        const float mean = wave_sum(y) * (1.f / 64.f);
        const float d = y - mean;
        const float rs = rsqrtf(wave_sum(d * d) * (1.f / 64.f) + GN_EPS);
        const float zf = bf2f(((const bf16_t*)(ws + NB_RKVZ) + ((size_t)3 * XSH_ROWS + row) * 1024)[e]);
        const float o = fmaf(rkv, vv, d * rs * a.in[I_GNG][e] + a.in[I_GNB][e]) * silu_f(zf);
        ((bf16_t*)(ws + NB_G4B))[row * 1024 + e] = (bf16_t)(pk_bf16c(o, 0.f) & 0xffffu);
    }
}

constexpr int CS_LD = 72;
constexpr int CS_SLOT = 64 * CS_LD * 2;
constexpr int CS_F32A = 13 * CS_SLOT;
constexpr int CS_F32B = CS_F32A + 16384;
constexpr int CS_GS = CS_F32B + 16384;
constexpr int CS_END = CS_GS + 4096;
constexpr size_t CK_MCT = 0, CK_RY = 8192, CK_SADD = 16384, CK_Y0 = 24576, CK_BYTES = 32768;

__device__ __forceinline__ PG8_LAS bf16_t* cs_slot(PG8_LAS unsigned char* lds, int i) { return (PG8_LAS bf16_t*)(lds + i * CS_SLOT); }
template <bool SWX = false, bool SWY = false>
__device__ __forceinline__ void cs_mm(f32x16& acc, const PG8_LAS bf16_t* X, const PG8_LAS bf16_t* Yt, int mt, int nt, int lane) {
    const int lr = lane & 31, h = lane >> 5;
    const int rx = mt * 32 + lr, ry = nt * 32 + lr;
    const int sx = SWX ? ((rx >> 3) & 7) : 0, sy = SWY ? ((ry >> 3) & 7) : 0;
#pragma unroll
    for (int s = 0; s < 4; ++s) {
        const bf16x8 av = *(const PG8_LAS bf16x8*)(X + rx * CS_LD + (((2 * s + h) ^ sx) << 3));
        const bf16x8 bv = *(const PG8_LAS bf16x8*)(Yt + ry * CS_LD + (((2 * s + h) ^ sy) << 3));
        acc = __builtin_amdgcn_mfma_f32_32x32x16_bf16(av, bv, acc, 0, 0, 0);
    }
}
__device__ __forceinline__ void cs_store_t(const f32x16& acc, PG8_LAS bf16_t* D, int mt, int nt, int lane) {
    typedef unsigned u32x2 __attribute__((ext_vector_type(2)));
    const int lr = lane & 31, h = lane >> 5;
#pragma unroll
    for (int c = 0; c < 4; ++c) { u32x2 w; w.x = pk_bf16c(acc[4 * c], acc[4 * c + 1]); w.y = pk_bf16c(acc[4 * c + 2], acc[4 * c + 3]);
        *(PG8_LAS u32x2*)(D + (nt * 32 + lr) * CS_LD + mt * 32 + 8 * c + 4 * h) = w; }
}
__device__ __forceinline__ void cs_store_n(const f32x16& acc, PG8_LAS bf16_t* D, int mt, int nt, int lane) {
    const int lr = lane & 31, h = lane >> 5;
#pragma unroll
    for (int i = 0; i < 16; ++i) D[(mt * 32 + (i & 3) + 8 * (i >> 2) + 4 * h) * CS_LD + nt * 32 + lr] = (bf16_t)(pk_bf16c(acc[i], 0.f) & 0xffffu);
}
__device__ __forceinline__ void cs_zero(f32x16& a) {
#pragma unroll
    for (int i = 0; i < 16; ++i) a[i] = 0.f;
}
__device__ __forceinline__ float dpp_red8(float v) {
    v += __builtin_bit_cast(float, __builtin_amdgcn_update_dpp(0, __builtin_bit_cast(int, v), 0xB1, 0xF, 0xF, true));
    v += __builtin_bit_cast(float, __builtin_amdgcn_update_dpp(0, __builtin_bit_cast(int, v), 0x4E, 0xF, 0xF, true));
    v += __builtin_bit_cast(float, __builtin_amdgcn_update_dpp(0, __builtin_bit_cast(int, v), 0x141, 0xF, 0xF, true));
    return v;
}

struct PreRegs { u32x4 kv, rv, vv; bf16x8 af[4]; };
__device__ __forceinline__ void scanpre_load(unsigned char* ws, int b, int hd, int c, int tid, PreRegs& r) {
    const int lane = tid & 63, wv = tid >> 6, lr = lane & 31, h = lane >> 5;
    const size_t row0 = (size_t)b * TP + c * 64;
    const int tok = tid >> 3, c8 = tid & 7;
    const size_t off = (row0 + tok) * 1024 + hd * 64 + c8 * 8;
    const bf16_t* RK = (const bf16_t*)(ws + NB_RKVZ);
    r.kv = *(const u32x4*)(RK + (size_t)1 * XSH_ROWS * 1024 + off); r.rv = *(const u32x4*)(RK + off); r.vv = *(const u32x4*)(RK + (size_t)2 * XSH_ROWS * 1024 + off);
    const int which = wv >> 2, mt = (wv >> 1) & 1;
    const bf16_t* A = (const bf16_t*)(ws + (which ? NB_AWB : NB_TWB)) + (row0 + mt * 32 + lr) * 64 + h * 8;
#pragma unroll
    for (int s = 0; s < 4; ++s) r.af[s] = *(const bf16x8*)(A + s * 16);
}
__device__ __forceinline__ void scanpre_chunk(const Args& a, unsigned char* ws, PG8_LAS unsigned char* lds, int b, int hd, int c, const PreRegs& pre, const bf16x8 (&btf)[4]) {
    const int tid = opaque_v(threadIdx.x), lane = tid & 63, wv = __builtin_amdgcn_readfirstlane(tid >> 6);
    const int lr = lane & 31, h = lane >> 5;
    const size_t row0 = (size_t)b * TP + c * 64;
    typedef unsigned u32x2 __attribute__((ext_vector_type(2)));
    PG8_LAS float* LCUM = (PG8_LAS float*)(lds + CS_F32A);
    PG8_LAS float* AV = (PG8_LAS float*)(lds + CS_F32B);
    PG8_LAS float* GS = (PG8_LAS float*)(lds + CS_GS);
    unsigned char* rec = ws + NB_CHK + ((size_t)(b * 16 + hd) * 32 + c) * CK_BYTES;
    {
        const int tok = tid >> 3, c8 = tid & 7;
        *(PG8_LAS u32x4*)(cs_slot(lds, 0) + tok * CS_LD + c8 * 8) = pre.kv;
        *(PG8_LAS u32x4*)(cs_slot(lds, 1) + tok * CS_LD + c8 * 8) = pre.rv;
        *(PG8_LAS u32x4*)(cs_slot(lds, 2) + tok * CS_LD + c8 * 8) = pre.vv;
    }
    {
        const int which = wv >> 2, mt = (wv >> 1) & 1, nt = wv & 1;
        f32x16 acc; cs_zero(acc);
#pragma unroll
        for (int s = 0; s < 4; ++s) acc = __builtin_amdgcn_mfma_f32_32x32x16_bf16(pre.af[s], btf[s], acc, 0, 0, 0);
        PG8_LAS float* D = which ? AV : LCUM;
        const float bias = a.in[which ? I_A0 : I_W0][hd * 64 + nt * 32 + lr];
#pragma unroll
        for (int i = 0; i < 16; ++i) {
            const float x = acc[i] + bias;
            float y;
            if (which) y = sigm_f(x);
            else y = -0.87503504f * sigm_f(x);
            D[(mt * 32 + (i & 3) + 8 * (i >> 2) + 4 * h) * 64 + nt * 32 + lr] = y;
        }
    }
    lds_barrier();
    {
        const int ch = tid & 63, tg = tid >> 6;
        float p[8]; float run = 0.f;
#pragma unroll
        for (int i = 0; i < 8; ++i) { run += LCUM[(tg * 8 + i) * 64 + ch]; p[i] = run; }
        GS[tg * 64 + ch] = run;
        lds_barrier();
        float offs = 0.f;
        for (int g = 0; g < tg; ++g) offs += GS[g * 64 + ch];
#pragma unroll
        for (int i = 0; i < 8; ++i) LCUM[(tg * 8 + i) * 64 + ch] = p[i] + offs;
    }
    lds_barrier();
    {
        const int tok = tid >> 3, c8 = tid & 7;
        const u32x4 kw = *(const PG8_LAS u32x4*)(cs_slot(lds, 0) + tok * CS_LD + c8 * 8), rw = *(const PG8_LAS u32x4*)(cs_slot(lds, 1) + tok * CS_LD + c8 * 8),
                    vw = *(const PG8_LAS u32x4*)(cs_slot(lds, 2) + tok * CS_LD + c8 * 8);
        float kf[8], rf[8], kk[8], kp[8], av[8];
        float n2 = 0.f, rk = 0.f;
#pragma unroll
        for (int i = 0; i < 8; ++i) {
            const int e = hd * 64 + c8 * 8 + i;
            kf[i] = __uint_as_float((i & 1) ? (kw[i >> 1] & 0xffff0000u) : (kw[i >> 1] << 16));
            rf[i] = __uint_as_float((i & 1) ? (rw[i >> 1] & 0xffff0000u) : (rw[i >> 1] << 16));
            av[i] = AV[tok * 64 + c8 * 8 + i];
            kk[i] = kf[i] * a.in[I_KK][e];
            kp[i] = kf[i] * (1.f + (av[i] - 1.f) * a.in[I_KA][e]);
            n2 = fmaf(kk[i], kk[i], n2);
            rk = fmaf(rf[i] * kp[i], a.in[I_RK][e], rk);
        }
        n2 = dpp_red8(n2); rk = dpp_red8(rk);
        const float inv = 1.f / fmaxf(sqrtf(n2), 1e-12f);
        if (c8 == 0) ((float*)(ws + NB_RKS))[(row0 + tok) * 16 + hd] = rk;
        if (tok == 63) {
#pragma unroll
            for (int i = 0; i < 8; ++i) GS[512 + c8 * 8 + i] = __builtin_amdgcn_exp2f(LCUM[63 * 64 + c8 * 8 + i]);
        }
        float qt[8], rt[8], kt[8], bt[8], kh[8], bh[8];
#pragma unroll
        for (int i = 0; i < 8; ++i) {
            const int ch = c8 * 8 + i;
            const float Lt = LCUM[tok * 64 + ch], Lp = tok ? LCUM[(tok - 1) * 64 + ch] : 0.f, Lc = LCUM[63 * 64 + ch];
            const float kn = kk[i] * inv, ka = kn * av[i];
            const float en = __builtin_amdgcn_exp2f(-Lt), ec = __builtin_amdgcn_exp2f(Lc - Lt);
            qt[i] = kn * __builtin_amdgcn_exp2f(Lp); rt[i] = rf[i] * __builtin_amdgcn_exp2f(Lt); kt[i] = kp[i] * en; bt[i] = ka * en; kh[i] = kp[i] * ec; bh[i] = ka * ec;
        }
#define CS_PUT_ROW(SLOT, ARR) { u32x4 w_; w_.x = pk_bf16c(ARR[0], ARR[1]); w_.y = pk_bf16c(ARR[2], ARR[3]); w_.z = pk_bf16c(ARR[4], ARR[5]); w_.w = pk_bf16c(ARR[6], ARR[7]); \
            *(PG8_LAS u32x4*)(cs_slot(lds, SLOT) + tok * CS_LD + c8 * 8) = w_; }
#define CS_PUT_COL(SLOT, ARR) { _Pragma("unroll") for (int i_ = 0; i_ < 8; ++i_) cs_slot(lds, SLOT)[(c8 * 8 + i_) * CS_LD + tsw] = (bf16_t)(pk_bf16c(ARR[i_], 0.f) & 0xffffu); }
        const int tsw = ((((tok >> 3) ^ c8) & 7) << 3) | (tok & 7);
        CS_PUT_ROW(3, qt) CS_PUT_ROW(4, rt) CS_PUT_ROW(5, kt) CS_PUT_ROW(6, bt)
        CS_PUT_COL(7, qt) CS_PUT_COL(8, bh) CS_PUT_COL(9, kh)
#pragma unroll
        for (int i = 0; i < 8; ++i) cs_slot(lds, 10)[(c8 * 8 + i) * CS_LD + tsw] = (bf16_t)((i & 1) ? (vw[i >> 1] >> 16) : (vw[i >> 1] & 0xffffu));
#undef CS_PUT_ROW
#undef CS_PUT_COL
    }
    lds_barrier();
    {
#pragma unroll 1
        for (int j = 0; j < 2; ++j) {
            const int job = wv * 2 + j, prod = job >> 2, mt = (job >> 1) & 1, nt = job & 1;
            const PG8_LAS bf16_t* X = cs_slot(lds, (prod & 1) ? 6 : 5);
            const PG8_LAS bf16_t* Y = cs_slot(lds, (prod & 2) ? 4 : 3);
            f32x16 acc; cs_zero(acc);
            cs_mm(acc, X, Y, mt, nt, lane);
            const int t = nt * 32 + lr, incl = (prod & 2) ? 1 : 0;
#pragma unroll
            for (int i = 0; i < 16; ++i) { const int sidx = mt * 32 + (i & 3) + 8 * (i >> 2) + 4 * h; acc[i] = (sidx < t + incl) ? acc[i] : 0.f; }
            const int dst = (prod == 0) ? 0 : (prod == 1) ? 11 : (prod == 2) ? 1 : 2;
            cs_store_t(acc, cs_slot(lds, dst), mt, nt, lane);
            if (prod == 1) cs_store_n(acc, cs_slot(lds, 12), mt, nt, lane);
        }
    }
    lds_barrier();
    {
        const int mt = (wv >> 1) & 1, nt = wv & 1;
        f32x16 pacc;
        if (wv < 4) {
#pragma unroll
            for (int i = 0; i < 16; ++i) { const int u = mt * 32 + (i & 3) + 8 * (i >> 2) + 4 * h, t = nt * 32 + lr;
                pacc[i] = ((u == t) ? 1.f : 0.f) - bf2f(cs_slot(lds, 12)[u * CS_LD + t]); }
            cs_store_t(pacc, cs_slot(lds, 3), mt, nt, lane);
        }
        lds_barrier();
        const int mcur = 11, mtcur = 12, mnxt = 5, mtnxt = 6;
        PG8_LAS bf16_t* XS0 = (PG8_LAS bf16_t*)(lds + CS_F32A);
        PG8_LAS bf16_t* XS1 = (PG8_LAS bf16_t*)(lds + CS_F32A + CS_SLOT);
        PG8_LAS bf16_t* XS2 = (PG8_LAS bf16_t*)(lds + CS_F32A + 2 * CS_SLOT);
        PG8_LAS bf16_t* Pc = cs_slot(lds, 3); PG8_LAS bf16_t* Pn = XS0;
        PG8_LAS bf16_t* Mc_ = cs_slot(lds, mcur); PG8_LAS bf16_t* MTc = cs_slot(lds, mtcur);
        PG8_LAS bf16_t* Mn = cs_slot(lds, mnxt); PG8_LAS bf16_t* MTn = cs_slot(lds, mtnxt);
#pragma unroll 1
        for (int it = 0; it < 5; ++it) {
            if (wv >= 4) {
                f32x16 acc; cs_zero(acc);
                cs_mm(acc, Mc_, MTc, mt, nt, lane);
                cs_store_n(acc, Mn, mt, nt, lane);
                cs_store_t(acc, MTn, mt, nt, lane);
                float mx = 0.f;
#pragma unroll
                for (int i = 0; i < 16; ++i) mx = fmaxf(mx, fabsf(acc[i]));
#pragma unroll
                for (int o = 32; o > 0; o >>= 1) mx = fmaxf(mx, __shfl_xor(mx, o));
                if (lane == 0) GS[640 + (wv & 3)] = mx;
            }
            lds_barrier();
            const float m2max = fmaxf(fmaxf(GS[640], GS[641]), fmaxf(GS[642], GS[643]));
            if (wv < 4) {
                cs_mm(pacc, MTn, Pc, mt, nt, lane);
                cs_store_t(pacc, Pn, mt, nt, lane);
            }
            lds_barrier();
            { PG8_LAS bf16_t* t0 = Mc_; Mc_ = Mn; Mn = t0; t0 = MTc; MTc = MTn; MTn = t0; t0 = Pc; Pc = Pn; Pn = t0; }
            if (m2max < 3e-4f) break;
        }
        {
            f32x16 acc; cs_zero(acc);
            if (wv < 4) { cs_mm<false, true>(acc, cs_slot(lds, 0), cs_slot(lds, 10), mt, nt, lane); cs_store_t(acc, XS1, mt, nt, lane); }
            else { cs_mm<false, true>(acc, Pc, cs_slot(lds, 7), mt, nt, lane); cs_store_t(acc, XS2, mt, nt, lane); }
        }
        lds_barrier();
        if (wv < 4) { f32x16 acc; cs_zero(acc); cs_mm(acc, Pc, XS1, mt, nt, lane); cs_store_t(acc, cs_slot(lds, 11), mt, nt, lane); }
        lds_barrier();
        if (wv < 4) {
            f32x16 acc; cs_zero(acc);
            cs_mm<false, true>(acc, XS2, cs_slot(lds, 8), mt, nt, lane);
#pragma unroll
            for (int i = 0; i < 16; ++i) { const int k = mt * 32 + (i & 3) + 8 * (i >> 2) + 4 * h, kp_ = nt * 32 + lr; acc[i] = ((k == kp_) ? GS[512 + k] : 0.f) - acc[i]; }
            bf16_t* mct = (bf16_t*)(rec + CK_MCT);
#pragma unroll
            for (int cc = 0; cc < 4; ++cc) { u32x2 w; w.x = pk_bf16c(acc[4 * cc], acc[4 * cc + 1]); w.y = pk_bf16c(acc[4 * cc + 2], acc[4 * cc + 3]);
                *(u32x2*)(mct + ((nt * 4 + 2 * mt + (cc >> 1)) * 64 + lr + 32 * (cc & 1)) * 8 + 4 * h) = w; }
            f32x16 s1, s2; cs_zero(s1); cs_zero(s2);
            cs_mm<true, true>(s1, cs_slot(lds, 9), cs_slot(lds, 10), mt, nt, lane);
            cs_mm<true, false>(s2, cs_slot(lds, 8), cs_slot(lds, 11), mt, nt, lane);
            bf16_t* sd = (bf16_t*)(rec + CK_SADD) + ((size_t)(wv & 3) * 64 + lane) * 16;
#pragma unroll
            for (int q8 = 0; q8 < 2; ++q8) { u32x4 w;
                w.x = pk_bf16c(s1[8 * q8] - s2[8 * q8], s1[8 * q8 + 1] - s2[8 * q8 + 1]); w.y = pk_bf16c(s1[8 * q8 + 2] - s2[8 * q8 + 2], s1[8 * q8 + 3] - s2[8 * q8 + 3]);
                w.z = pk_bf16c(s1[8 * q8 + 4] - s2[8 * q8 + 4], s1[8 * q8 + 5] - s2[8 * q8 + 5]); w.w = pk_bf16c(s1[8 * q8 + 6] - s2[8 * q8 + 6], s1[8 * q8 + 7] - s2[8 * q8 + 7]);
                *(u32x4*)(sd + q8 * 8) = w; }
        } else {
            f32x16 acc; cs_zero(acc);
            cs_mm(acc, XS2, cs_slot(lds, 2), mt, nt, lane);
            bf16_t* ry = (bf16_t*)(rec + CK_RY);
#pragma unroll
            for (int cc = 0; cc < 4; ++cc) {
                const u32x2 rv = *(const PG8_LAS u32x2*)(cs_slot(lds, 4) + (nt * 32 + lr) * CS_LD + mt * 32 + 8 * cc + 4 * h);
                const float r0 = __uint_as_float(rv.x << 16), r1 = __uint_as_float(rv.x & 0xffff0000u), r2 = __uint_as_float(rv.y << 16), r3 = __uint_as_float(rv.y & 0xffff0000u);
                u32x2 w; w.x = pk_bf16c(r0 - acc[4 * cc], r1 - acc[4 * cc + 1]); w.y = pk_bf16c(r2 - acc[4 * cc + 2], r3 - acc[4 * cc + 3]);
                *(u32x2*)(ry + ((nt * 4 + 2 * mt + (cc >> 1)) * 64 + lr + 32 * (cc & 1)) * 8 + 4 * h) = w;
            }
            f32x16 s1, s2; cs_zero(s1); cs_zero(s2);
            cs_mm<false, true>(s1, cs_slot(lds, 1), cs_slot(lds, 10), mt, nt, lane);
            cs_mm(s2, cs_slot(lds, 2), cs_slot(lds, 11), mt, nt, lane);
            bf16_t* yd = (bf16_t*)(rec + CK_Y0) + ((size_t)(wv & 3) * 64 + lane) * 16;
#pragma unroll
            for (int q8 = 0; q8 < 2; ++q8) { u32x4 w;
                w.x = pk_bf16c(s1[8 * q8] - s2[8 * q8], s1[8 * q8 + 1] - s2[8 * q8 + 1]); w.y = pk_bf16c(s1[8 * q8 + 2] - s2[8 * q8 + 2], s1[8 * q8 + 3] - s2[8 * q8 + 3]);
                w.z = pk_bf16c(s1[8 * q8 + 4] - s2[8 * q8 + 4], s1[8 * q8 + 5] - s2[8 * q8 + 5]); w.w = pk_bf16c(s1[8 * q8 + 6] - s2[8 * q8 + 6], s1[8 * q8 + 7] - s2[8 * q8 + 7]);
                *(u32x4*)(yd + q8 * 8) = w; }
        }
    }
    lds_barrier();
}

struct SeqRegs { bf16x8 a[4]; u32x4 c[2]; };
__device__ __forceinline__ void seq_load(const unsigned char* rec, int wv, int mt, int lane, SeqRegs& r) {
    const bf16_t* ap = (const bf16_t*)(rec + CK_MCT) + ((size_t)mt * 4 * 64 + lane) * 8;
    const bf16_t* cp = (const bf16_t*)(rec + CK_SADD) + ((size_t)(wv & 3) * 64 + lane) * 16;
#pragma unroll
    for (int s = 0; s < 4; ++s) r.a[s] = *(const bf16x8*)(ap + s * 64 * 8);
    r.c[0] = *(const u32x4*)cp; r.c[1] = *(const u32x4*)(cp + 8);
}
__device__ __forceinline__ void scanseq_head(const Args& a, unsigned char* ws, PG8_LAS unsigned char* lds, int b, int hd) {
    const int tid = opaque_v(threadIdx.x), lane = tid & 63, wv = __builtin_amdgcn_readfirstlane(tid >> 6);
    const int lr = lane & 31, h = lane >> 5;
    const int mt = (wv >> 1) & 1, nt = wv & 1;
    const bool isS = wv < 4;
    PG8_LAS bf16_t* SB0 = cs_slot(lds, 0); PG8_LAS bf16_t* SB1 = cs_slot(lds, 1);
    f32x16 st; cs_zero(st);
    for (int i = tid; i < 64 * CS_LD; i += NTH) { SB0[i] = 0; }
    const unsigned char* rec0 = ws + NB_CHK + (size_t)(b * 16 + hd) * 32 * CK_BYTES;
    bf16_t* srec0 = (bf16_t*)(ws + NB_SREC) + (size_t)(b * 16 + hd) * 32 * 4096;
    const int cr = (tid & 255) >> 2, cc8 = (tid & 3) * 16;
    lds_barrier();
    if (isS) {
        SeqRegs r[4];
#pragma unroll
        for (int c = 0; c < 4; ++c) seq_load(rec0 + (size_t)c * CK_BYTES, wv, mt, lane, r[c]);
#pragma unroll
        for (int c = 0; c < 32; ++c) {
            const PG8_LAS bf16_t* S = (c & 1) ? SB1 : SB0;
            PG8_LAS bf16_t* Sn = (c & 1) ? SB0 : SB1;
            f32x16 acc;
#pragma unroll
            for (int i = 0; i < 16; ++i) { const unsigned w = r[c & 3].c[i >> 3][(i & 7) >> 1]; acc[i] = __uint_as_float((i & 1) ? (w & 0xffff0000u) : (w << 16)); }
#pragma unroll
            for (int s = 0; s < 4; ++s) {
                const bf16x8 bv = *(const PG8_LAS bf16x8*)(S + (nt * 32 + lr) * CS_LD + s * 16 + h * 8);
                acc = __builtin_amdgcn_mfma_f32_32x32x16_bf16(r[c & 3].a[s], bv, acc, 0, 0, 0);
            }
            st = acc; cs_store_t(st, Sn, mt, nt, lane);
            if (c + 4 < 32) seq_load(rec0 + (size_t)(c + 4) * CK_BYTES, wv, mt, lane, r[c & 3]);
            lds_barrier();
        }
    } else {
#pragma unroll 1
        for (int c = 0; c < 32; ++c) {
            const PG8_LAS bf16_t* S = (c & 1) ? SB1 : SB0;
            const u32x4 v0 = *(const PG8_LAS u32x4*)(S + cr * CS_LD + cc8), v1 = *(const PG8_LAS u32x4*)(S + cr * CS_LD + cc8 + 8);
            bf16_t* d = srec0 + (size_t)c * 4096 + cr * 64 + cc8;
            *(u32x4*)d = v0; *(u32x4*)(d + 8) = v1;
            lds_barrier();
        }
    }
    if (isS) {
        float* so = a.out + O_WKVP + ((size_t)(b * 16 + hd) * 64 + nt * 32 + lr) * 64 + mt * 32 + 4 * h;
#pragma unroll
        for (int cc = 0; cc < 4; ++cc) *(float4*)(so + 8 * cc) = make_float4(st[4 * cc], st[4 * cc + 1], st[4 * cc + 2], st[4 * cc + 3]);
    }
    lds_barrier();
}
struct YgRegs { bf16x8 a[4]; u32x4 c[2]; u32x4 s0, s1; u32x4 vw[2], zw[2]; float rk; };
__device__ __forceinline__ void yg_load(unsigned char* ws, int ci, int tid, YgRegs& r) {
    const int lane = tid & 63, wv = tid >> 6, t4 = tid & 255;
    const int mt = (wv >> 1) & 1;
    const unsigned char* rec = ws + NB_CHK + (size_t)ci * CK_BYTES;
    const bf16_t* ap = (const bf16_t*)(rec + CK_RY) + ((size_t)mt * 4 * 64 + lane) * 8;
    const bf16_t* cp = (const bf16_t*)(rec + CK_Y0) + ((size_t)(wv & 3) * 64 + lane) * 16;
#pragma unroll
    for (int s = 0; s < 4; ++s) r.a[s] = *(const bf16x8*)(ap + s * 64 * 8);
    r.c[0] = *(const u32x4*)cp; r.c[1] = *(const u32x4*)(cp + 8);
    const bf16_t* sp = (const bf16_t*)(ws + NB_SREC) + (size_t)ci * 4096 + (t4 >> 2) * 64 + (t4 & 3) * 16;
    r.s0 = *(const u32x4*)sp; r.s1 = *(const u32x4*)(sp + 8);
    const int bh = ci >> 5, c = ci & 31, b = bh >> 4, hd = bh & 15;
    const size_t prow = (size_t)b * TP + c * 64 + (t4 >> 2);
    const int pv = (t4 & 3) * 16;
    const bf16_t* vp = (const bf16_t*)(ws + NB_RKVZ) + ((size_t)2 * XSH_ROWS + prow) * 1024 + hd * 64 + pv;
    const bf16_t* zp = (const bf16_t*)(ws + NB_RKVZ) + ((size_t)3 * XSH_ROWS + prow) * 1024 + hd * 64 + pv;
    r.vw[0] = *(const u32x4*)vp; r.vw[1] = *(const u32x4*)(vp + 8); r.zw[0] = *(const u32x4*)zp; r.zw[1] = *(const u32x4*)(zp + 8);
    r.rk = ((const float*)(ws + NB_RKS))[prow * 16 + hd];
}
__device__ __forceinline__ void yg_step(const Args& a, unsigned char* ws, PG8_LAS unsigned char* lds, int ci, int tid, const YgRegs& r) {
    const int lane = tid & 63, wv = tid >> 6, t4 = tid & 255, grp = wv >> 2;
    const int lr = lane & 31, h = lane >> 5, mt = (wv >> 1) & 1, nt = wv & 1;
    PG8_LAS bf16_t* SL = cs_slot(lds, grp);
    PG8_LAS float* YT = (PG8_LAS float*)(lds + 2 * CS_SLOT) + grp * (64 * 68);
    *(PG8_LAS u32x4*)(SL + (t4 >> 2) * CS_LD + (t4 & 3) * 16) = r.s0; *(PG8_LAS u32x4*)(SL + (t4 >> 2) * CS_LD + (t4 & 3) * 16 + 8) = r.s1;
    lds_barrier();
    {
        f32x16 acc;
#pragma unroll
        for (int i = 0; i < 16; ++i) { const unsigned w = r.c[i >> 3][(i & 7) >> 1]; acc[i] = __uint_as_float((i & 1) ? (w & 0xffff0000u) : (w << 16)); }
#pragma unroll
        for (int s = 0; s < 4; ++s) {
            const bf16x8 bv = *(const PG8_LAS bf16x8*)(SL + (nt * 32 + lr) * CS_LD + s * 16 + h * 8);
            acc = __builtin_amdgcn_mfma_f32_32x32x16_bf16(r.a[s], bv, acc, 0, 0, 0);
        }
#pragma unroll
        for (int i = 0; i < 16; ++i) YT[(mt * 32 + (i & 3) + 8 * (i >> 2) + 4 * h) * 68 + nt * 32 + lr] = acc[i];
    }
    lds_barrier();
    {
        const int ptok = t4 >> 2, pv = (t4 & 3) * 16;
        const int bh = ci >> 5, c = ci & 31, b = bh >> 4, hd = bh & 15;
        float y[16];
#pragma unroll
        for (int q = 0; q < 4; ++q) { const f32x4 v = *(const PG8_LAS f32x4*)(YT + ptok * 68 + pv + q * 4); y[4 * q] = v[0]; y[4 * q + 1] = v[1]; y[4 * q + 2] = v[2]; y[4 * q + 3] = v[3]; }
        float sm = 0.f;
#pragma unroll
        for (int i = 0; i < 16; ++i) sm += y[i];
        sm += __builtin_bit_cast(float, __builtin_amdgcn_update_dpp(0, __builtin_bit_cast(int, sm), 0xB1, 0xF, 0xF, true));
        sm += __builtin_bit_cast(float, __builtin_amdgcn_update_dpp(0, __builtin_bit_cast(int, sm), 0x4E, 0xF, 0xF, true));
        const float mean = sm * (1.f / 64.f);
        float sq = 0.f;
#pragma unroll
        for (int i = 0; i < 16; ++i) { y[i] -= mean; sq += y[i] * y[i]; }
        sq += __builtin_bit_cast(float, __builtin_amdgcn_update_dpp(0, __builtin_bit_cast(int, sq), 0xB1, 0xF, 0xF, true));
        sq += __builtin_bit_cast(float, __builtin_amdgcn_update_dpp(0, __builtin_bit_cast(int, sq), 0x4E, 0xF, 0xF, true));
        const float rs = rsqrtf(sq * (1.f / 64.f) + GN_EPS);
        const float* gg = a.in[I_GNG] + hd * 64 + pv; const float* gb = a.in[I_GNB] + hd * 64 + pv;
        float o[16];
#pragma unroll
        for (int i = 0; i < 16; ++i) {
            const unsigned vw = r.vw[i >> 3][(i & 7) >> 1], zw = r.zw[i >> 3][(i & 7) >> 1];
            const float vf = __uint_as_float((i & 1) ? (vw & 0xffff0000u) : (vw << 16)), zf = __uint_as_float((i & 1) ? (zw & 0xffff0000u) : (zw << 16));
            o[i] = fmaf(r.rk, vf, y[i] * rs * gg[i] + gb[i]) * silu_f(zf);
        }
        bf16_t* dst = (bf16_t*)(ws + NB_G4B) + ((size_t)b * TP + c * 64 + ptok) * 1024 + hd * 64 + pv;
        u32x4 w0, w1;
        w0.x = pk_bf16c(o[0], o[1]); w0.y = pk_bf16c(o[2], o[3]); w0.z = pk_bf16c(o[4], o[5]); w0.w = pk_bf16c(o[6], o[7]);
        w1.x = pk_bf16c(o[8], o[9]); w1.y = pk_bf16c(o[10], o[11]); w1.z = pk_bf16c(o[12], o[13]); w1.w = pk_bf16c(o[14], o[15]);
        *(u32x4*)dst = w0; *(u32x4*)(dst + 8) = w1;
    }
}
__device__ __forceinline__ void phase_ygate(const Args& a, unsigned char* ws, PG8_LAS unsigned char* lds, int bid, int nb) {
    const int tid = opaque_v(threadIdx.x), grp = tid >> 8;
    YgRegs cur, nxt;
    int pair = bid;
    if (pair < 2048) yg_load(ws, 2 * pair + grp, tid, nxt);
#pragma unroll 1
    while (pair < 2048) {
        cur = nxt;
        const int npair = pair + nb;
        if (npair < 2048) yg_load(ws, 2 * npair + grp, tid, nxt);
        yg_step(a, ws, lds, 2 * pair + grp, tid, cur);
        pair = npair;
    }
    lds_barrier();
}

__device__ __forceinline__ void phase_lnf(const Args& a, unsigned char* ws, int bid, int nb) {
    const int tid = opaque_v(threadIdx.x), lane = tid & 63, wv = tid >> 6;
    const float* PRE = (const float*)ws + WS_PRE;
    const bf16_t* P2 = (const bf16_t*)(ws + NB_Y);
    float x[16], nx[16], y[16]; uint2 ny[4];
    int row = bid * 8 + wv;
    if (row < MT) { ld_row16(PRE + (size_t)row * 1024, lane, nx);
#pragma unroll
        for (int q = 0; q < 4; ++q) ny[q] = *(const uint2*)(P2 + (size_t)row * 1024 + q * 256 + lane * 4); }
#pragma unroll 1
    while (row < MT) {
#pragma unroll
        for (int i = 0; i < 16; ++i) x[i] = nx[i];
#pragma unroll
        for (int q = 0; q < 4; ++q) { y[4 * q] = __uint_as_float(ny[q].x << 16); y[4 * q + 1] = __uint_as_float(ny[q].x & 0xffff0000u); y[4 * q + 2] = __uint_as_float(ny[q].y << 16); y[4 * q + 3] = __uint_as_float(ny[q].y & 0xffff0000u); }
        const int nrow = row + nb * 8;
        if (nrow < MT) { ld_row16(PRE + (size_t)nrow * 1024, lane, nx);
#pragma unroll
            for (int q = 0; q < 4; ++q) ny[q] = *(const uint2*)(P2 + (size_t)nrow * 1024 + q * 256 + lane * 4); }
        ln_calc16(a.in[I_LNG], a.in[I_LNB], lane, x);
#pragma unroll
        for (int i = 0; i < 16; ++i) x[i] = fmaf(ALPHA, x[i], y[i]);
        ln_calc16(a.in[I_LNG] + 1024, a.in[I_LNB] + 1024, lane, x);
#if PROBE_TIME >= 0
        if (row >= MP) {
            const unsigned long long* tsp = (const unsigned long long*)(ws + NB_BAR + 16384);
            const float dt_us = (float)(__hip_atomic_load(tsp + PROBE_TIME + 1, __ATOMIC_RELAXED, __HIP_MEMORY_SCOPE_AGENT) - __hip_atomic_load(tsp + PROBE_TIME, __ATOMIC_RELAXED, __HIP_MEMORY_SCOPE_AGENT)) * 0.01f;
            const float f = 1.f + PROBE_K * dt_us;
#pragma unroll
            for (int i = 0; i < 16; ++i) x[i] *= f;
        }
#endif
        float* o = (row < MP ? a.out + O_Y + (size_t)row * 1024 : a.out + O_YS + (size_t)(row - MP) * 1024) + lane * 4;
#pragma unroll
        for (int q = 0; q < 4; ++q) *(float4*)(o + q * 256) = make_float4(x[4 * q], x[4 * q + 1], x[4 * q + 2], x[4 * q + 3]);
        row = nrow;
    }
}
constexpr int POOL_ITEMS = BS * 32;
__device__ __forceinline__ void pool_item(const Args& a, unsigned char* ws, int item, int tid) {
    float* KCS = (float*)(ws + NB_KCS);
    const int* pt = (const int*)a.in[I_PT];
    const int s = item >> 5, n = (item & 31) * 8 + (tid >> 6), c = (tid & 63) * 4;
    const int kv = c >> 7, g = (c >> 6) & 1;
    const float* w = (kv ? a.in[I_WVC] : a.in[I_WKC]) + g;
    const int pos0 = n * 32;
    const float* src = a.in[I_CCMP] + ((size_t)pt[s * NPAGE + (pos0 >> 7)] * PAGE + (pos0 & 127)) * 256 + c;
    f32x4 v[32];
#pragma unroll
    for (int l = 0; l < 32; ++l) v[l] = __builtin_nontemporal_load((const f32x4*)(src + (size_t)l * 256));
    float4 acc = make_float4(0.f, 0.f, 0.f, 0.f);
#pragma unroll
    for (int l = 0; l < 32; ++l) { const float wl = w[l * 2]; acc.x = fmaf(v[l][0], wl, acc.x); acc.y = fmaf(v[l][1], wl, acc.y); acc.z = fmaf(v[l][2], wl, acc.z); acc.w = fmaf(v[l][3], wl, acc.w); }
    *(float4*)(KCS + ((size_t)(s * 256 + n) * 256 + c)) = acc;
}
__device__ __forceinline__ void sample_pool_copy(const Args& a, unsigned char* ws, int bid, int nb) {
    const float4* cw = (const float4*)a.in[I_CWIN];
    float4* ow = (float4*)(a.out + O_WINS);
#pragma unroll 4
    for (int i = bid * NTH + threadIdx.x; i < BS * 511 * 64; i += nb * NTH) {
        const int s = i / (511 * 64), rem = i - s * (511 * 64);
        ow[(size_t)s * 512 * 64 + rem] = cw[(size_t)s * 512 * 64 + 64 + rem];
    }
}
__device__ __forceinline__ void sample_conv(const Args& a, unsigned char* ws, PG8_LAS unsigned char* lds, int s) {
    const int ch = opaque_v(threadIdx.x);
    const bf16_t* h = (const bf16_t*)(ws + NB_HB) + (size_t)(MP + s) * 2560;
    const float* sc = a.in[I_SCONV] + (size_t)s * 30 * 512 + ch;
    const float u = bf2f(h[ch]) * sigm_f(bf2f(h[512 + ch]));
    float scv[30], wj[31];
    const float* __restrict__ cwp = a.in[I_CONVW] + ch;
#pragma unroll
    for (int j = 0; j < 30; ++j) { scv[j] = sc[(size_t)j * 512]; wj[j] = cwp[j * 512]; }
    wj[30] = cwp[30 * 512];
    float acc = a.in[I_CONVB][ch];
#pragma unroll
    for (int j = 0; j < 30; ++j) acc = fmaf(wj[j], scv[j], acc);
    acc = fmaf(wj[30], u, acc);
    float* __restrict__ oc = a.out + O_CONVS + (size_t)s * 30 * 512 + ch;
#pragma unroll
    for (int i = 0; i < 29; ++i) oc[(size_t)i * 512] = scv[i + 1];
    oc[(size_t)29 * 512] = u;
    PG8_LAS float* red = (PG8_LAS float*)lds;
    const int lane = ch & 63, wv = ch >> 6;
    float sm = wave_sum(acc);
    __syncthreads();
    if (lane == 0) red[wv] = sm;
    __syncthreads();
    float tot = 0.f;
#pragma unroll
    for (int i = 0; i < 8; ++i) tot += red[i];
    const float mean = tot * (1.f / 512.f);
    const float d = acc - mean;
    float sq = wave_sum(d * d);
    __syncthreads();
    if (lane == 0) red[wv] = sq;
    __syncthreads();
    tot = 0.f;
#pragma unroll
    for (int i = 0; i < 8; ++i) tot += red[i];
    const float rs = rsqrtf(tot * (1.f / 512.f) + LN_EPS);
    const float y = silu_f(d * rs * a.in[I_CLNG][ch] + a.in[I_CLNB][ch]) * silu_f(bf2f(h[1024 + ch]));
    ((bf16_t*)(ws + NB_CATB))[(size_t)(MP + s) * 1024 + ch] = (bf16_t)(pk_bf16(y, 0.f) & 0xffffu);
    __syncthreads();
}

constexpr int SP_STRIDE = 66;
__device__ __forceinline__ void sample_attn(const Args& a, unsigned char* ws, PG8_LAS unsigned char* lds, int s, int g, int part) {
    const int tid = opaque_v(threadIdx.x), lane = tid & 63, wv = __builtin_amdgcn_readfirstlane(tid >> 6);
    PG8_LAS float* PC = (PG8_LAS float*)lds;
    PG8_LAS float* IMP = (PG8_LAS float*)(lds + 4096);
    PG8_LAS int* SEL = (PG8_LAS int*)(lds + 4096 + 1024);
    PG8_LAS int* FLG = (PG8_LAS int*)(lds + 4096 + 1024 + 128);
    PG8_LAS float* PS = (PG8_LAS float*)(lds + 8192) + (tid >> 6) * 64;
    const int r = wv & 3, hh = g * 4 + r;
    const float slope = __builtin_amdgcn_exp2f(-(float)(hh + 1));
    const int* pt = (const int*)a.in[I_PT] + s * NPAGE;
    const bf16_t* hrow = (const bf16_t*)(ws + NB_HB) + (size_t)(MP + s) * 2560;
    float q[64];
#pragma unroll
    for (int d8 = 0; d8 < 8; ++d8) { const u32x4 w = *(const u32x4*)(hrow + 1536 + hh * 64 + d8 * 8);
#pragma unroll
        for (int i = 0; i < 4; ++i) { q[d8 * 8 + 2 * i] = __uint_as_float(w[i] << 16); q[d8 * 8 + 2 * i + 1] = __uint_as_float(w[i] & 0xffff0000u); } }
#define SAMP_DOT(KPTR, OUT) { const float4* k4_ = (const float4*)(KPTR); float4 kk_[16]; \
        _Pragma("unroll") for (int i_ = 0; i_ < 16; ++i_) kk_[i_] = k4_[i_]; float s_ = 0.f; \
        _Pragma("unroll") for (int i_ = 0; i_ < 16; ++i_) { s_ = fmaf(q[4 * i_], kk_[i_].x, s_); s_ = fmaf(q[4 * i_ + 1], kk_[i_].y, s_); s_ = fmaf(q[4 * i_ + 2], kk_[i_].z, s_); s_ = fmaf(q[4 * i_ + 3], kk_[i_].w, s_); } OUT = s_; }
    if (wv < 4) {
        const float* kc = (const float*)(ws + NB_KCS) + (size_t)s * 256 * 256 + g * 64;
        float sc[4];
        float mx = -INFINITY;
#pragma unroll
        for (int i = 0; i < 4; ++i) { const int n = lane + 64 * i; float d; SAMP_DOT(kc + (size_t)n * 256, d); sc[i] = d - slope * (float)(PAST - (32 * n + 31)); mx = fmaxf(mx, sc[i]); }
#pragma unroll
        for (int o = 32; o > 0; o >>= 1) mx = fmaxf(mx, __shfl_xor(mx, o));
        float ls = 0.f;
#pragma unroll
        for (int i = 0; i < 4; ++i) { sc[i] = __expf(sc[i] - mx); ls += sc[i]; }
        ls = wave_sum(ls);
        const float inv = 1.f / ls;
#pragma unroll
        for (int i = 0; i < 4; ++i) PC[r * 256 + lane + 64 * i] = sc[i] * inv;
    }
    __syncthreads();
    if (wv < 4 && part == 0) {
        const float* vc = (const float*)(ws + NB_KCS) + (size_t)s * 256 * 256 + 128 + g * 64 + lane;
        float oc0 = 0.f, oc1 = 0.f, oc2 = 0.f, oc3 = 0.f;
#pragma unroll 8
        for (int n = 0; n < 256; n += 4) {
            oc0 = fmaf(PC[r * 256 + n], vc[(size_t)n * 256], oc0); oc1 = fmaf(PC[r * 256 + n + 1], vc[(size_t)(n + 1) * 256], oc1);
            oc2 = fmaf(PC[r * 256 + n + 2], vc[(size_t)(n + 2) * 256], oc2); oc3 = fmaf(PC[r * 256 + n + 3], vc[(size_t)(n + 3) * 256], oc3);
        }
        ((float*)(ws + NB_OCS))[(size_t)(s * 8 + hh) * 64 + lane] = (oc0 + oc1) + (oc2 + oc3);
    }
    if (tid < 129) {
        float v = 0.f;
        if (tid < 128) { for (int rr = 0; rr < 4; ++rr) v += PC[rr * 256 + 2 * tid] + PC[rr * 256 + 2 * tid + 1]; }
        if (tid == 0 || tid >= 127) v = 1e4f;
        IMP[tid] = v;
    }
    __syncthreads();
    if (tid < 129) {
        const float vj = IMP[tid];
        int rank = 0;
        for (int i = 0; i < 129; ++i) { const float vi = IMP[i]; rank += (vi > vj || (vi == vj && i < tid)) ? 1 : 0; }
        FLG[tid] = (rank < 16) ? 1 : 0;
    }
    __syncthreads();
    if (tid < 129 && FLG[tid]) { int slot = 0; for (int i = 0; i < tid; ++i) slot += FLG[i]; SEL[slot] = tid; }
    __syncthreads();
    const float* csel = a.in[I_CSEL];
    const float* newsel = a.out + O_SELS + (size_t)s * 256;
    const float* cwin = a.in[I_CWIN] + (size_t)s * 512 * 256;
    const float* newwin = a.out + O_WINS + (size_t)(s * 512 + 511) * 256;
#pragma unroll 1
    for (int it = 0; it < 3; ++it) {
        const int lb = (wv >> 2) + 2 * it;
        const bool is_sel = lb < 4;
        const int slot = is_sel ? part * 4 + lb : part * 2 + (lb - 4);
        const float* rowp; const float* vb; int vstride_last; float dist; bool valid; int nk;
        if (is_sel) {
            const int blk = SEL[slot];
            const int kpos = blk * 64 + lane;
            valid = kpos <= PAST;
            rowp = (blk < 128) ? csel + ((size_t)pt[blk >> 1] * PAGE + (kpos & 127)) * 256 : newsel;
            vb = (blk < 128) ? csel + ((size_t)pt[blk >> 1] * PAGE + ((blk * 64) & 127)) * 256 + 128 + g * 64 + lane : newsel + 128 + g * 64 + lane;
            nk = (blk < 128) ? 64 : 1; dist = (float)(PAST - kpos); vstride_last = 0;
        } else {
            const int i0 = 1 + slot * 64;
            const int i = i0 + lane;
            valid = true; nk = 64;
            rowp = (i < 512) ? cwin + (size_t)i * 256 : newwin;
            vb = cwin + (size_t)i0 * 256 + 128 + g * 64 + lane;
            dist = (float)(512 - i); vstride_last = (slot == 7) ? 1 : 0;
        }
        float sc = -INFINITY;
        if (valid) { float d; SAMP_DOT(rowp + g * 64, d); sc = d - slope * dist; }
        float mx = sc;
#pragma unroll
        for (int of = 32; of > 0; of >>= 1) mx = fmaxf(mx, __shfl_xor(mx, of));
        const float p = valid ? __expf(sc - mx) : 0.f;
        const float l = wave_sum(p);
        PS[lane] = p; __builtin_amdgcn_wave_barrier();
        float o0 = 0.f, o1 = 0.f, o2 = 0.f, o3 = 0.f;
        if (nk == 64) {
            float vv[64];
#pragma unroll
            for (int k = 0; k < 63; ++k) vv[k] = vb[(size_t)k * 256];
            vv[63] = vstride_last ? newwin[128 + g * 64 + lane] : vb[(size_t)63 * 256];
#pragma unroll
            for (int k = 0; k < 64; k += 4) { o0 = fmaf(PS[k], vv[k], o0); o1 = fmaf(PS[k + 1], vv[k + 1], o1); o2 = fmaf(PS[k + 2], vv[k + 2], o2); o3 = fmaf(PS[k + 3], vv[k + 3], o3); }
        } else o0 = PS[0] * vb[0];
        __builtin_amdgcn_wave_barrier();
        float* pp = (float*)(ws + NB_PARTS) + ((size_t)((s * 8 + hh) * 24 + (is_sel ? slot : 16 + slot))) * SP_STRIDE;
        pp[2 + lane] = (o0 + o1) + (o2 + o3);
        if (lane == 0) { pp[0] = mx; pp[1] = l; }
    }
#undef SAMP_DOT
    __syncthreads();
}
__device__ __forceinline__ void sample_combine(const Args& a, unsigned char* ws, int s, int g) {
    const int tid = opaque_v(threadIdx.x), lane = tid & 63, wv = __builtin_amdgcn_readfirstlane(tid >> 6);
    if (wv >= 4) return;
    const int hh = g * 4 + wv;
    const float* pp = (const float*)(ws + NB_PARTS) + (size_t)(s * 8 + hh) * 24 * SP_STRIDE;
    const float* g3p = (const float*)(ws + NB_G3) + (size_t)(MP + s) * 32 + hh * 3;
    const float gc = sigm_f(g3p[0]), gs = sigm_f(g3p[1]), gw = sigm_f(g3p[2]);
    float res = gc * ((const float*)(ws + NB_OCS))[(size_t)(s * 8 + hh) * 64 + lane];
#pragma unroll
    for (int br = 0; br < 2; ++br) {
        const int n0 = br ? 16 : 0, cnt = br ? 8 : 16;
        float M = -INFINITY;
        for (int i = 0; i < cnt; ++i) M = fmaxf(M, pp[(size_t)(n0 + i) * SP_STRIDE]);
        float L = 0.f, O = 0.f;
        for (int i = 0; i < cnt; ++i) { const float* q = pp + (size_t)(n0 + i) * SP_STRIDE; const float w = __expf(q[0] - M); L = fmaf(q[1], w, L); O = fmaf(q[2 + lane], w, O); }
        res = fmaf(br ? gw : gs, O / L, res);
    }
    const bf16_t* hrow = (const bf16_t*)(ws + NB_HB) + (size_t)(MP + s) * 2560;
    const float y = res * silu_f(bf2f(hrow[2048 + hh * 64 + lane]));
    ((bf16_t*)(ws + NB_CATB))[(size_t)(MP + s) * 1024 + 512 + hh * 64 + lane] = (bf16_t)(pk_bf16(y, 0.f) & 0xffffu);
}

static_assert(CS_END <= LDS_MISC, "chunk-scan LDS map overlaps the barrier words");
enum { PH_PREP = 0, PH_GEMM1, PH_CONV, PH_ATTN, PH_GEMM2, PH_LNS, PH_GEMM3, PH_PREP2, PH_SCAN, PH_POST, PH_GEMM4, PH_LNF, NPHASE };

__global__ void __launch_bounds__(NTH, 2) mega(Args a) {
    extern __shared__ __attribute__((aligned(16))) unsigned char lds_raw[];
    PG8_LAS unsigned char* lds = (PG8_LAS unsigned char*)lds_raw;
    unsigned char* ws = a.ws;
    volatile LAS unsigned* misc = (volatile LAS unsigned*)(lds + LDS_MISC);
    if (threadIdx.x < 4) misc[threadIdx.x] = 0u;
    __syncthreads();
    XcdBarrier bar = xcd_barrier_post((unsigned*)(ws + NB_BAR), misc);
    const int lo = a.ph_lo, hi = a.ph_hi;
#ifndef DUP_SATTN
#define DUP_SATTN 0
#endif
#ifndef DUP_CONV
#define DUP_CONV 0
#endif
#ifndef DUP_GEMM1
#define DUP_GEMM1 0
#endif
#ifndef SKIPMASK
#define SKIPMASK 0
#endif
#define IN(k) (lo <= (k) && (k) < hi && !((SKIPMASK >> (k)) & 1))
#ifndef REPMASK
#define REPMASK 0
#endif
#define REPS(k) _Pragma("unroll 1") for (int rep_ = 0; rep_ < (((REPMASK >> (k)) & 1) ? 2 : 1); ++rep_)
#if PROBE_TIME >= 0
    unsigned long long* const tstamp = (unsigned long long*)(ws + NB_BAR + 16384);
#define STAMP(i) do { if (blockIdx.x == 0 && threadIdx.x == 0) __hip_atomic_store(tstamp + (i), (unsigned long long)__builtin_amdgcn_s_memrealtime(), __ATOMIC_RELAXED, __HIP_MEMORY_SCOPE_AGENT); } while (0)
#else
#define STAMP(i) do { } while (0)
#endif
#define SEAM(k) do { if (IN(k) && IN((k) + 1)) xcd_barrier(bar); STAMP((k) + 1); } while (0)
    STAMP(0);
    if (IN(PH_PREP)) REPS(PH_PREP) {
        const int bid = opaque(blockIdx.x), nb = gridDim.x;
        convert_wt(a.in[I_WIN], 1024, DIN, (bf16_t*)(ws + NB_WT1), N1PAD, MapWin{}, bid, nb);
        convert_wt(a.in[I_WOUTE], 1024, 1024, (bf16_t*)(ws + NB_WT2), 1024, MapId{}, bid, nb);
        for (int n = 0; n < 4; ++n) convert_wt(a.in[I_WRKVZ] + (size_t)n * 1024 * 1024, 1024, 1024, (bf16_t*)(ws + NB_WT3) + (size_t)n * 1024 * 1024, 1024, MapId{}, bid, nb);
        convert_wt(a.in[I_WOUTO], 1024, 1024, (bf16_t*)(ws + NB_WT4), 1024, MapId{}, bid, nb);
        convert_wfrag(a.in[I_W1], (bf16_t*)(ws + NB_W1T), bid, nb);
        convert_wfrag(a.in[I_A1], (bf16_t*)(ws + NB_A1T), bid, nb);
        convert_wt(a.in[I_W2], 64, 1024, (bf16_t*)(ws + NB_W2T), 1024, MapId{}, bid, nb);
        convert_wt(a.in[I_A2], 64, 1024, (bf16_t*)(ws + NB_A2T), 1024, MapId{}, bid, nb);
        convert_rows(a.in[I_XP], (size_t)MP * 1024 / 8, (bf16_t*)(ws + NB_XB), bid, nb);
        convert_rows(a.in[I_XS], (size_t)BS * 1024 / 8, (bf16_t*)(ws + NB_XSB), bid, nb);
        sample_pool_copy(a, ws, bid, nb);
    }
    SEAM(PH_PREP);
    if (IN(PH_GEMM1)) REPS(PH_GEMM1) {
        const int bid = opaque(blockIdx.x), nb = gridDim.x;
        const Route1 R{(bf16_t*)(ws + NB_HB), (bf16_t*)(ws + NB_KVB), (float*)(ws + NB_G3), a.out};
        {
            pg8::Gemm g{(const bf16_t*)(ws + NB_XB), (const bf16_t*)(ws + NB_WT1), MP, N1PAD, 1024};
            const int G1 = nb >= 256 ? 232 : nb;
            if (bid < G1) {
                pg8::StaticOrder S; S.init(MP, N1PAD, G1, bid);
                Epi1 E{R};
                pg8::gemm_phase<Epi1, pg8::StaticOrder, false>(lds, g, S, E, nullptr);
            }
        }
        {
            unsigned* const qctr = (unsigned*)(ws + NB_BAR + 20480);
            PG8_LAS int* const slot = (PG8_LAS int*)(lds + LDS_MISC + 64);
            const int tidq = opaque_v(threadIdx.x);
#pragma unroll 1
            for (;;) {
                __syncthreads();
                if (tidq == 0) *slot = (int)__hip_atomic_fetch_add(qctr, 1u, __ATOMIC_RELAXED, __HIP_MEMORY_SCOPE_AGENT);
                __syncthreads();
                const int item = __builtin_amdgcn_readfirstlane(*slot);
                if (item >= 105 + POOL_ITEMS) break;
                if (item >= 105) { pool_item(a, ws, item - 105, tidq); continue; }
                const int task = item;
                sample_gemm32_wg((const bf16_t*)(ws + NB_XSB), (const bf16_t*)(ws + NB_WT1), 1024, task * 32, lds,
                    [&](int r, int n, float v) {
                        const int row = MP + r;
                        if (n < 2560) { const float sc = (n >= 1536 && n < 2048) ? 0.125f : 1.0f; ((bf16_t*)(ws + NB_HB))[(size_t)row * 2560 + n] = (bf16_t)(pk_bf16c(v * sc, 0.f) & 0xffffu); }
                        else if (n < 3328) { const int c = n - 2560, i3 = c >> 8, cc = c & 255; ((bf16_t*)(ws + NB_KVB))[(size_t)row * 768 + c] = (bf16_t)(pk_bf16c(v, 0.f) & 0xffffu);
                            float* dst = (i3 == 0) ? a.out + O_CMPS + (size_t)r * 256 + cc : (i3 == 1) ? a.out + O_SELS + (size_t)r * 256 + cc : a.out + O_WINS + (size_t)(r * 512 + 511) * 256 + cc;
                            *dst = v; }
                        else if (n < 3352) ((float*)(ws + NB_G3))[(size_t)row * 32 + (n - 3328)] = v;
                    });
            }
        }
    }
    SEAM(PH_GEMM1);
    if (IN(PH_CONV)) REPS(PH_CONV) {
        const int bid = opaque(blockIdx.x), nb = gridDim.x;
#pragma unroll 1
        for (int item = bid; item < 512; item += nb) conv_item(a, ws, lds, item);
        pool_prompt(a, ws, bid, nb);
        sample_attn(a, ws, lds, bid >> 3, (bid >> 2) & 1, bid & 3);
#if DUP_SATTN
        __syncthreads();
        sample_attn(a, ws, lds, bid >> 3, (bid >> 2) & 1, bid & 3);
#endif
        if (bid >= 96 && bid < 128) sample_conv(a, ws, lds, bid - 96);
    }
    SEAM(PH_CONV);
    if (IN(PH_ATTN)) REPS(PH_ATTN) {
        const int bid = opaque(blockIdx.x), nb = gridDim.x;
        if (bid < 64) sample_combine(a, ws, bid >> 1, bid & 1);
        for (int pr = bid; pr < 256; pr += nb) {
            const int b = pr >> 5, g = (pr >> 4) & 1, xq = pr & 15;
#pragma unroll 1
            for (int k = 0; k < 2; ++k) attn_item(a, ws, lds, b, g, k ? xq : 31 - xq);
        }
    }
    SEAM(PH_ATTN);
    if (IN(PH_GEMM2)) REPS(PH_GEMM2) {
        const int bid = opaque(blockIdx.x), nb = gridDim.x;
        {
            pg8::Gemm g{(const bf16_t*)(ws + NB_CATB), (const bf16_t*)(ws + NB_WT2), MP, 1024, 1024};
            pg8::StaticOrder S; S.init(MP, 1024, nb, bid);
            EpiPreRes E{(float*)ws + WS_PRE, a.in[I_XP]};
            pg8::gemm_phase<EpiPreRes, pg8::StaticOrder, false>(lds, g, S, E, nullptr);
        }
        {
            const int lane = threadIdx.x & 63, wv = __builtin_amdgcn_readfirstlane(threadIdx.x >> 6);
            float* PREs = (float*)ws + WS_PRE + (size_t)MP * 1024;
            const float* xs = a.in[I_XS];
            for (int task = bid; task < 32; task += nb)
                sample_gemm32_wg((const bf16_t*)(ws + NB_CATB) + (size_t)MP * 1024, (const bf16_t*)(ws + NB_WT2), 1024, task * 32, lds,
                              [&](int r, int n, float v) { PREs[(size_t)r * 1024 + n] = fmaf(ALPHA, xs[(size_t)r * 1024 + n], v); });
        }
    }
    SEAM(PH_GEMM2);
    if (IN(PH_LNS)) REPS(PH_LNS) { const int bid = opaque(blockIdx.x), nb = gridDim.x; phase_lns(a, ws, lds, bid, nb); }
    SEAM(PH_LNS);
    if (IN(PH_GEMM3)) REPS(PH_GEMM3) {
        const int bid = opaque(blockIdx.x), nb = gridDim.x;
        {
            pg8::Gemm g{(const bf16_t*)(ws + NB_XSH), (const bf16_t*)(ws + NB_WT3), MP, 4096, 1024};
            Order3 S; S.init(nb, bid);
            Epi3 E{(bf16_t*)(ws + NB_RKVZ)};
            pg8::gemm_phase<Epi3, Order3, false>(lds, g, S, E, nullptr);
        }
        {
            const int lane = threadIdx.x & 63, wv = __builtin_amdgcn_readfirstlane(threadIdx.x >> 6);
            for (int task = bid; task < 128; task += nb) {
                const int n = task >> 5, n0 = (task & 31) * 32;
                bf16_t* dst = (bf16_t*)(ws + NB_RKVZ) + ((size_t)n * XSH_ROWS + MP) * 1024;
                sample_gemm32_wg((const bf16_t*)(ws + NB_XSH) + ((size_t)n * XSH_ROWS + MP) * 1024, (const bf16_t*)(ws + NB_WT3) + (size_t)n * 1024 * 1024, 1024, n0, lds,
                              [&](int r, int c, float v) { dst[(size_t)r * 1024 + c] = (bf16_t)(pk_bf16c(v, 0.f) & 0xffffu); });
            }
            if (bid >= nb - 2) {
                const int tidl = opaque_v(threadIdx.x), task = 1024 + (nb - 1 - bid);
                LoraRegs lr_; lora_load(ws, task, tidl, lr_); lora_tile(ws, lds, task, tidl, lr_);
            }
        }
    }
    SEAM(PH_GEMM3);
    if (IN(PH_PREP2)) REPS(PH_PREP2) {
        const int bid = opaque(blockIdx.x), nb = gridDim.x;
        for (int pr = bid; pr < 256; pr += nb) {
            const int bh = pr >> 1, b = bh >> 4, hd = bh & 15, c0 = (pr & 1) * 16;
            const int tidp = opaque_v(threadIdx.x), lanep = tidp & 63, wvp = tidp >> 6;
            bf16x8 btf[4];
            { const int which = wvp >> 2, nt = wvp & 1;
              const bf16_t* Bt = (const bf16_t*)(ws + (which ? NB_A2T : NB_W2T)) + (size_t)(hd * 64 + nt * 32 + (lanep & 31)) * 64 + (lanep >> 5) * 8;
#pragma unroll
              for (int s4 = 0; s4 < 4; ++s4) btf[s4] = *(const bf16x8*)(Bt + s4 * 16); }
            PreRegs pcur, pnxt;
            scanpre_load(ws, b, hd, c0, tidp, pnxt);
#pragma unroll 1
            for (int cc = 0; cc < 16; ++cc) {
                pcur = pnxt;
                if (cc + 1 < 16) scanpre_load(ws, b, hd, c0 + cc + 1, tidp, pnxt);
                scanpre_chunk(a, ws, lds, b, hd, c0 + cc, pcur, btf);
            }
        }
    }
    SEAM(PH_PREP2);
    if (IN(PH_SCAN)) REPS(PH_SCAN) {
        const int bid = opaque(blockIdx.x), nb = gridDim.x;
#pragma unroll 1
        for (int item = bid; item < 128; item += nb) scanseq_head(a, ws, lds, item >> 4, item & 15);
        const int lane = opaque_v(threadIdx.x) & 63, wv = __builtin_amdgcn_readfirstlane(threadIdx.x >> 6);
        for (int task = (nb - 1 - bid) * 8 + wv; task < BS * 16; task += nb * 8) scan_sample(a, ws, task >> 4, task & 15, lane);
    }
    SEAM(PH_SCAN);
    if (IN(PH_POST)) REPS(PH_POST) { const int bid = opaque(blockIdx.x), nb = gridDim.x; phase_ygate(a, ws, lds, bid, nb); }
    SEAM(PH_POST);
    if (IN(PH_GEMM4)) REPS(PH_GEMM4) {
        const int bid = opaque(blockIdx.x), nb = gridDim.x;
        {
            pg8::Gemm g{(const bf16_t*)(ws + NB_G4B), (const bf16_t*)(ws + NB_WT4), MP, 1024, 1024};
            pg8::StaticOrder S; S.init(MP, 1024, nb, bid);
            EpiPreB E{(bf16_t*)(ws + NB_Y)};
            pg8::gemm_phase<EpiPreB, pg8::StaticOrder, false>(lds, g, S, E, nullptr);
        }
        {
            bf16_t* PREs = (bf16_t*)(ws + NB_Y) + (size_t)MP * 1024;
            for (int task = bid; task < 32; task += nb)
                sample_gemm32_wg((const bf16_t*)(ws + NB_G4B) + (size_t)MP * 1024, (const bf16_t*)(ws + NB_WT4), 1024, task * 32, lds,
                              [&](int r, int n, float v) { PREs[(size_t)r * 1024 + n] = (bf16_t)(pk_bf16c(v, 0.f) & 0xffffu); });
        }
    }
    SEAM(PH_GEMM4);
    if (IN(PH_LNF)) REPS(PH_LNF) { const int bid = opaque(blockIdx.x), nb = gridDim.x; phase_lnf(a, ws, bid, nb); }
#undef IN
#undef SEAM
}
}

extern "C" void kernel_launch(void* const* d_in, const int* in_sizes, int n_in, void* d_out, int out_size, void* d_ws, size_t ws_size,
                              hipStream_t stream) {
    if (n_in != N_IN || ws_size < nk::NB_END) { fprintf(stderr, "kernel_launch: unexpected n_in %d or ws_size %zu (need %zu)\n", n_in, ws_size, (size_t)nk::NB_END); return; }
    static int grid = 0;
    if (!grid) {
        int dev = 0, cus = 0, per_cu = 0;
        hipGetDevice(&dev);
        hipDeviceGetAttribute(&cus, hipDeviceAttributeMultiprocessorCount, dev);
        hipFuncSetAttribute((const void*)nk::mega, hipFuncAttributeMaxDynamicSharedMemorySize, nk::LDS_BYTES);
        hipOccupancyMaxActiveBlocksPerMultiprocessor(&per_cu, (const void*)nk::mega, nk::NTH, nk::LDS_BYTES);
        if (per_cu < 1) fprintf(stderr, "kernel_launch: occupancy query says %d blocks per CU\n", per_cu);
        grid = cus;
    }
    hipMemsetAsync((unsigned char*)d_ws + nk::NB_BAR, 0, 32768, stream);
    nk::Args a{};
    for (int i = 0; i < N_IN; ++i) a.in[i] = (const float*)d_in[i];
    a.out = (float*)d_out; a.ws = (unsigned char*)d_ws; a.ph_lo = 0; a.ph_hi = nk::NPHASE;
    void* args[] = {&a};
    hipError_t e = hipLaunchCooperativeKernel((const void*)nk::mega, dim3(grid), dim3(nk::NTH), args, nk::LDS_BYTES, stream);
    if (e != hipSuccess) fprintf(stderr, "cooperative launch failed: %s (grid %d)\n", hipGetErrorString(e), grid);
}
```

```cpp
#include <hip/hip_runtime.h>
#include <hip/hip_cooperative_groups.h>
#include <cstdio>
namespace cg = cooperative_groups;
#ifndef PROBE_TIME
#define PROBE_TIME -1
#endif
#ifndef PROBE_K
#define PROBE_K 1e-4f
#endif

constexpr int D = 1024, BP = 8, TP = 2048, MP = BP * TP, BS = 32, MT = MP + BS;
constexpr int DIN = 3352;
constexpr int C_AVAL = 0, C_AGLU = 512, C_ZA = 1024, C_Q = 1536, C_KV = 2048, C_G3 = 2816, C_ZB = 2840;
constexpr int C_CMP = C_KV, C_SEL = C_KV + 256, C_WIN = C_KV + 512;
constexpr int PAST = 8192, NPAGE = 64, PAGE = 128;
constexpr float ALPHA = 1.4142135623730951f;
constexpr float LN_EPS = 1e-5f, GN_EPS = 64e-5f;

constexpr size_t O_Y = 0, O_YS = 16777216, O_CMPP = 16809984, O_CMPS = 21004288, O_SELP = 21012480, O_SELS = 25206784,
                 O_WINP = 25214976, O_WINS = 26263552, O_CONVP = 30457856, O_CONVS = 30580736, O_WKVP = 31072256,
                 O_WKVS = 31596544, O_SHP = 33693696, O_SHS = 33701888;

enum { I_XP = 0, I_XS, I_CCMP, I_CSEL, I_CWIN, I_SCONV, I_SWKV, I_SSHIFT, I_PT, I_WIN, I_CONVW, I_CONVB, I_CLNG, I_CLNB,
       I_WKC, I_WVC, I_WOUTE, I_MU, I_WRKVZ, I_W0, I_W1, I_W2, I_A0, I_A1, I_A2, I_KK, I_KA, I_RK, I_GNG, I_GNB, I_WOUTO,
       I_LNG, I_LNB, N_IN };

constexpr size_t SZ_ROWD = (size_t)MT * D;
constexpr size_t WS_H = 0;
constexpr size_t WS_CAT = WS_H + (size_t)MT * DIN;
constexpr size_t WS_OC = WS_CAT + SZ_ROWD;
constexpr size_t WS_XSH = 0;
constexpr size_t WS_Y = 0;
constexpr size_t WS_G4 = SZ_ROWD;
constexpr size_t WS_R0END = 6 * SZ_ROWD;
constexpr size_t WS_PRE = WS_R0END;
constexpr size_t WS_X1 = WS_PRE + SZ_ROWD;
constexpr size_t WS_R = WS_X1 + SZ_ROWD;
constexpr size_t WS_K = WS_R + SZ_ROWD;
constexpr size_t WS_V = WS_K + SZ_ROWD;
constexpr size_t WS_Z = WS_V + SZ_ROWD;
constexpr size_t WS_DEC = WS_Z + SZ_ROWD;
constexpr size_t WS_KKN = WS_DEC + SZ_ROWD;
constexpr size_t WS_KKA = WS_KKN + SZ_ROWD;
constexpr size_t WS_TW = WS_KKA + SZ_ROWD;
constexpr size_t WS_AW = WS_TW + (size_t)MT * 64;
constexpr size_t WS_RK = WS_AW + (size_t)MT * 64;
constexpr size_t WS_END = WS_RK + (size_t)MT * 16;
constexpr size_t WS_PCP = WS_R;
constexpr size_t WS_PCS = WS_R + (size_t)MP * 8 * 64;
constexpr size_t WS_IMP = WS_K;
constexpr size_t WS_SELIDX = WS_V;
constexpr size_t WS_KCP = WS_Z;
constexpr size_t WS_KCS = WS_Z + (size_t)8 * 64 * 256;
static_assert(WS_OC + (size_t)MT * 512 <= WS_R0END, "layer0 temporaries overflow region 0");

namespace pg8 {
#define PG8_LAS __attribute__((address_space(3)))
typedef unsigned short bf16_t;
typedef short bf16x8 __attribute__((ext_vector_type(8)));
typedef float f32x4 __attribute__((ext_vector_type(4)));
typedef unsigned u32x4 __attribute__((ext_vector_type(4)));
constexpr int BM = 256, BK = 64, HALF = 128, HTB = HALF * BK * 2  , STAGE_BYTES = 8 * HTB, NXCD = 8, WGM = 8;

__host__ __device__ __forceinline__ int lds_byte(int r, int c) { const int st = (r >> 4) * 2 + (c >> 5), rr = r & 15, cc = c & 31, ob = rr * 64 + cc * 2; return st * 1024 + (ob ^ (((ob >> 9) & 1) << 5)); }
__host__ __device__ __forceinline__ void stage_rc(int b, int& R, int& C) { const int st = b / 1024, sb = b % 1024, swz = sb ^ (((sb >> 9) & 1) << 5); R = (st >> 1) * 16 + swz / 64; C = (st & 1) * 32 + (swz % 64) / 2; }
__host__ __device__ __forceinline__ int perm32(int rho) { const int n = rho >> 4, i = rho & 15; return 8 * (i >> 2) + 4 * n + (i & 3); }

struct Unit { int pm, pn; };
struct Gemm { const bf16_t* A; const bf16_t* Bt; int M, N, K; };

struct StaticOrder {
    int nM, nN, nwg, G, c;
    __host__ __device__ void init(int M, int N, int G_, int c_) { nM = M / BM; nN = N / BM; nwg = nM * nN; G = G_; c = c_; }
    __host__ __device__ bool next(int i, Unit& u) const {
        const long L = (long)i * G + c; if (L >= nwg) return false;
        int wgid = (int)L; { const int q = nwg / NXCD, r = nwg % NXCD, xcd = wgid % NXCD, off = wgid / NXCD; wgid = (xcd < r ? xcd * (q + 1) : r * (q + 1) + (xcd - r) * q) + off; }
        const int nig = WGM * nN, gid = wgid / nig, fm = gid * WGM, gsz = (nM - fm) < WGM ? (nM - fm) : WGM;
        u.pm = fm + ((wgid % nig) % gsz); u.pn = (wgid % nig) / gsz; return true;
    }
    __device__ __forceinline__ void a_ready(const Unit&) const {}
    __device__ __forceinline__ void done(const Unit&) const {}
};
struct CountedOrder : StaticOrder {
    const unsigned* ready; unsigned need; unsigned* tmo;
    __device__ __forceinline__ void a_ready(const Unit& u) const {
        if (threadIdx.x < 64) {
            const unsigned long long t0 = __builtin_amdgcn_s_memrealtime(); unsigned polls = 0;
            while ((unsigned)__builtin_amdgcn_readfirstlane(__hip_atomic_load(ready + 64 * u.pm, __ATOMIC_RELAXED, __HIP_MEMORY_SCOPE_AGENT)) < need) {
                if ((++polls & 255u) == 0u && __builtin_amdgcn_readfirstlane(__hip_atomic_load(tmo, __ATOMIC_RELAXED, __HIP_MEMORY_SCOPE_AGENT)) != 0u) break;
                if (__builtin_amdgcn_s_memrealtime() - t0 > 2000000ull) {
                    if (threadIdx.x == 0) { unsigned expect = 0u; __hip_atomic_compare_exchange_strong(tmo + 1, &expect, 0x600u | (unsigned)(u.pm & 0xff), __ATOMIC_RELAXED, __ATOMIC_RELAXED, __HIP_MEMORY_SCOPE_AGENT); __hip_atomic_store(tmo, 1u, __ATOMIC_RELAXED, __HIP_MEMORY_SCOPE_AGENT); }
                    break; }
                __builtin_amdgcn_s_sleep(2); }
            __builtin_amdgcn_fence(__ATOMIC_ACQUIRE, "agent");
            asm volatile("s_waitcnt vmcnt(0)" ::: "memory");
        }
#if !defined(BROKEN_HOOK_NO_BARRIER)
        asm volatile("" ::: "memory"); __builtin_amdgcn_s_barrier(); asm volatile("" ::: "memory");
#endif
    }
};


template <class Epi, class Sched, bool STAMP = false>
__device__ __forceinline__ void gemm_phase(PG8_LAS unsigned char* lds, const Gemm g, const Sched& S, const Epi& E, unsigned long long* stamps) {
    int tid_ = threadIdx.x; asm volatile("" : "+v"(tid_));
    const int tid = tid_, wid = __builtin_amdgcn_readfirstlane(tid >> 6), lane = tid & 63, wr = wid >> 2, wc = wid & 3, fr = lane & 15, fq = lane >> 4;
    const int K = g.K, nt = K / BK;
    int ts_lo = 0, ts_hi = 0, nts = 0; const unsigned long long rt_entry = STAMP ? (unsigned long long)wall_clock64() : 0ull;
#define PG8_STAMP() do { if (STAMP && wid == 0 && nts < 64) { const unsigned long long _c = (unsigned long long)clock64(); \
        ts_lo = (lane == nts) ? (int)(unsigned)_c : ts_lo; ts_hi = (lane == nts) ? (int)(unsigned)(_c >> 32) : ts_hi; ++nts; } } while (0)
    PG8_STAMP();
    unsigned voffA[2], voffB[2];
#pragma unroll
    for (int i = 0; i < 2; ++i) { int R, C; stage_rc(tid * 16 + i * 8192, R, C); const int Rb = Epi::PERM ? ((R & ~31) + perm32(R & 31)) : R;
        voffA[i] = (unsigned)(R * K + C) * 2u; voffB[i] = (unsigned)(Rb * K + C) * 2u; }
    const size_t kstep = (size_t)(BK * 2);
    const size_t hstep = (size_t)HALF * K * 2;
    const size_t tstep = 2 * hstep;
    const unsigned ldsw = (unsigned)wid * 1024u;
    const int aoff = lds_byte(wr * 64 + fr, fq * 8), boff = lds_byte(wc * 32 + fr, fq * 8);
#define PG8_SA(b, h) (((b) * 2 + (h)) * HTB)
#define PG8_SB(b, h) ((4 + (b) * 2 + (h)) * HTB)
#define PG8_STAGE(bufoff, gbase, voff) do { _Pragma("unroll") for (int _i = 0; _i < 2; ++_i) \
        __builtin_amdgcn_global_load_lds((const unsigned*)((const char*)(gbase) + (voff)[_i]), (PG8_LAS unsigned*)(lds + (bufoff) + ldsw + _i * 8192), 16, 0, 0); } while (0)
#define PG8_LDA(dst, b, h) do { _Pragma("unroll") for (int m = 0; m < 4; ++m) _Pragma("unroll") for (int k = 0; k < 2; ++k) dst[m][k] = *(const PG8_LAS bf16x8*)(lds + PG8_SA(b, h) + aoff + m * 2048 + k * 1024); } while (0)
#define PG8_LDB(dst, b, h) do { _Pragma("unroll") for (int n = 0; n < 2; ++n) _Pragma("unroll") for (int k = 0; k < 2; ++k) dst[n][k] = *(const PG8_LAS bf16x8*)(lds + PG8_SB(b, h) + boff + n * 2048 + k * 1024); } while (0)
#define PG8_MMA(ai, bj, At, Bt) do { __builtin_amdgcn_s_setprio(1); _Pragma("unroll") for (int m = 0; m < 4; ++m) _Pragma("unroll") for (int n = 0; n < 2; ++n) _Pragma("unroll") for (int k = 0; k < 2; ++k) \
        acc[ai][bj][m][n] = __builtin_amdgcn_mfma_f32_16x16x32_bf16(Bt[n][k], At[m][k], acc[ai][bj][m][n], 0, 0, 0); __builtin_amdgcn_s_setprio(0); } while (0)
#define PG8_WAIT_V(n) asm volatile("s_waitcnt vmcnt(" #n ")" ::: "memory")
#define PG8_WAIT_L(n) asm volatile("s_waitcnt lgkmcnt(" #n ")" ::: "memory")
#define PG8_BAR __builtin_amdgcn_s_barrier()
#define PG8_SCHED __builtin_amdgcn_sched_barrier(0)
    Unit cur, nxt; int ui = 0;
    if (!S.next(0, cur)) return;
    f32x4 acc[2][2][4][2];
#pragma unroll
    for (int a = 0; a < 2; ++a)
#pragma unroll
        for (int b = 0; b < 2; ++b)
#pragma unroll
            for (int m = 0; m < 4; ++m)
#pragma unroll
                for (int n = 0; n < 2; ++n) acc[a][b][m][n] = (f32x4){0.f, 0.f, 0.f, 0.f};
    bf16x8 At[4][2], B0[2][2], B1[2][2];
    const char* cA = (const char*)g.A + (size_t)cur.pm * tstep; const char* cB = (const char*)g.Bt + (size_t)cur.pn * tstep;
    S.a_ready(cur);
    PG8_STAGE(PG8_SB(0, 0), cB, voffB); PG8_STAGE(PG8_SA(0, 0), cA, voffA); PG8_STAGE(PG8_SB(0, 1), cB + hstep, voffB); PG8_STAGE(PG8_SA(0, 1), cA + hstep, voffA);
    if (wr == 1) PG8_BAR;
    PG8_WAIT_V(4); PG8_BAR;
    PG8_STAGE(PG8_SB(1, 0), cB + kstep, voffB); PG8_STAGE(PG8_SA(1, 0), cA + kstep, voffA); PG8_STAGE(PG8_SB(1, 1), cB + hstep + kstep, voffB);
    PG8_WAIT_V(6); PG8_BAR;
    PG8_STAMP();
    for (;;) {
        const bool has_next = S.next(ui + 1, nxt);
        const char* nA = has_next ? (const char*)g.A + (size_t)nxt.pm * tstep : cA; const char* nB = has_next ? (const char*)g.Bt + (size_t)nxt.pn * tstep : cB;
        for (int t = 0; t < nt; t += 2) {
            const bool last = (t == nt - 2);
            const char* a1 = cA + (size_t)(t + 1) * kstep;
            const char* a2 = last ? nA : cA + (size_t)(t + 2) * kstep; const char* b2 = last ? nB : cB + (size_t)(t + 2) * kstep;
            const char* a3 = a2 + kstep; const char* b3 = b2 + kstep;
            if (last && has_next) S.a_ready(nxt);
            PG8_LDB(B0, 0, 0); PG8_SCHED; PG8_LDA(At, 0, 0); PG8_STAGE(PG8_SA(1, 1), a1 + hstep, voffA);
            PG8_WAIT_L(8); PG8_BAR; PG8_WAIT_L(0); PG8_MMA(0, 0, At, B0); PG8_BAR; PG8_SCHED;
            PG8_LDB(B1, 0, 1); PG8_STAGE(PG8_SB(0, 0), b2, voffB);
            PG8_BAR; PG8_WAIT_L(0); PG8_MMA(0, 1, At, B1); PG8_BAR;
            PG8_LDA(At, 0, 1); PG8_STAGE(PG8_SA(0, 0), a2, voffA);
            PG8_BAR; PG8_WAIT_L(0); PG8_MMA(1, 0, At, B0); PG8_BAR; PG8_SCHED;
            PG8_STAGE(PG8_SB(0, 1), b2 + hstep, voffB);
            PG8_WAIT_V(6); PG8_BAR; PG8_MMA(1, 1, At, B1); PG8_BAR;
            PG8_LDB(B0, 1, 0); PG8_SCHED; PG8_LDA(At, 1, 0); PG8_STAGE(PG8_SA(0, 1), a2 + hstep, voffA);
            PG8_WAIT_L(8); PG8_BAR; PG8_WAIT_L(0); PG8_MMA(0, 0, At, B0); PG8_BAR; PG8_SCHED;
            PG8_LDB(B1, 1, 1); PG8_STAGE(PG8_SB(1, 0), b3, voffB);
            PG8_BAR; PG8_WAIT_L(0); PG8_MMA(0, 1, At, B1); PG8_BAR;
            PG8_LDA(At, 1, 1); PG8_STAGE(PG8_SA(1, 0), a3, voffA);
            PG8_BAR; PG8_WAIT_L(0); PG8_MMA(1, 0, At, B0); PG8_BAR; PG8_SCHED;
            PG8_STAGE(PG8_SB(1, 1), b3 + hstep, voffB);
            PG8_WAIT_V(6); PG8_BAR; PG8_MMA(1, 1, At, B1); PG8_BAR;
        }
        PG8_STAMP();
        if constexpr (!Epi::AFTER_DRAIN) { E(acc, cur, wr, wc, fr, fq); S.done(cur); }
        PG8_STAMP();
        if (!has_next) break;
#pragma unroll
        for (int a = 0; a < 2; ++a)
#pragma unroll
            for (int b = 0; b < 2; ++b)
#pragma unroll
                for (int m = 0; m < 4; ++m)
#pragma unroll
                    for (int n = 0; n < 2; ++n) acc[a][b][m][n] = (f32x4){0.f, 0.f, 0.f, 0.f};
        cur = nxt; cA = nA; cB = nB; ++ui;
    }
    PG8_WAIT_V(0);
    if (wr == 0) PG8_BAR;
    PG8_BAR;
    if constexpr (Epi::AFTER_DRAIN) { E.fused(acc, cur, wr, wc, fr, fq, lds, wid, lane); S.done(cur); }
    PG8_STAMP();
    if (STAMP && wid == 0) { stamps[lane] = lane < nts ? (((unsigned long long)(unsigned)ts_hi << 32) | (unsigned)ts_lo) : 0ull;
        if (lane == 62) stamps[62] = rt_entry; if (lane == 63) stamps[63] = (unsigned long long)wall_clock64(); }
#undef PG8_STAMP
#undef PG8_SA
#undef PG8_SB
#undef PG8_STAGE
#undef PG8_LDA
#undef PG8_LDB
#undef PG8_MMA
#undef PG8_WAIT_V
#undef PG8_WAIT_L
#undef PG8_BAR
#undef PG8_SCHED
}
}

#define XB_TMO      128
#define XB_XCNT(j)  (256  + 64 * (j))
#define XB_XSUB(j)  (1280 + 64 * (j))
#define XB_XGEN(j)  (2304 + 64 * (j))
#define XB_TOP      3328
#define XB_TOPGEN   3392
#define XCD_BAR_WORDS 3456
#define XB_SPIN_CAP (1u << 18)
#define LAS __attribute__((address_space(3)))

__device__ __forceinline__ unsigned xb_ld(unsigned* p)              { return __hip_atomic_load(p, __ATOMIC_RELAXED, __HIP_MEMORY_SCOPE_AGENT); }
__device__ __forceinline__ unsigned xb_add(unsigned* p, unsigned v) { return __hip_atomic_fetch_add(p, v, __ATOMIC_RELAXED, __HIP_MEMORY_SCOPE_AGENT); }
__device__ __forceinline__ unsigned xb_xcc_id() { return (unsigned)__builtin_amdgcn_s_getreg((3 << 11) | 20) & 0xFu; }
#define XB_SPIN(cond, bar) do { unsigned _sp = 0; while (cond) { __builtin_amdgcn_s_sleep(1); \
    if ((++_sp & 255u) == 0u) { if (xb_ld(&(bar)[XB_TMO])) break; if (_sp > XB_SPIN_CAP) { atomicAdd(&(bar)[XB_TMO], 1u); break; } } } } while (0)

struct XcdBarrier {
    unsigned* bar; unsigned x;
    volatile LAS unsigned* st;
};

__device__ __forceinline__ XcdBarrier xcd_barrier_post(unsigned* bar, volatile LAS unsigned* st) {
    XcdBarrier b; b.bar = bar; b.x = xb_xcc_id(); b.st = st;
    if (threadIdx.x == 0) (void)xb_add(&bar[XB_XCNT(b.x)], 1u);
    return b;
}
__device__ __forceinline__ void xcd_barrier_complete(unsigned* bar, unsigned x, unsigned& nloc, unsigned& nx) {
    const unsigned G = gridDim.x * gridDim.y * gridDim.z;
    unsigned sum, cnt, mine, sp = 0u;
    for (;;) {
        sum = 0u; cnt = 0u; mine = 0u;
#pragma unroll
        for (unsigned j = 0; j < 16; ++j) { const unsigned c = xb_ld(&bar[XB_XCNT(j)]); sum += c; cnt += (c > 0u) ? 1u : 0u; mine = (j == x) ? c : mine; }
        if (sum == G) break;
        __builtin_amdgcn_s_sleep(1);
        if ((++sp & 255u) == 0u) { if (xb_ld(&bar[XB_TMO])) break; if (sp > XB_SPIN_CAP) { atomicAdd(&bar[XB_TMO], 1u); break; } }
    }
    nloc = mine > 0u ? mine : 1u; nx = cnt > 0u ? cnt : 1u;
}

__device__ __forceinline__ void xcd_barrier(const XcdBarrier& b) {
    asm volatile("s_waitcnt vmcnt(0)" ::: "memory");
    __syncthreads();
    if (threadIdx.x == 0) {
        unsigned* bar = b.bar;
        __builtin_amdgcn_s_waitcnt(0);
        unsigned nloc = b.st[0], nx = b.st[1];
        if (nloc == 0u) { xcd_barrier_complete(bar, b.x, nloc, nx); b.st[0] = nloc; b.st[1] = nx; }
        const unsigned old = xb_add(&bar[XB_XSUB(b.x)], 1u);
        const unsigned gen = old / nloc;
        if (old + 1u == (gen + 1u) * nloc) {
            __builtin_amdgcn_fence(__ATOMIC_RELEASE, "agent");
            asm volatile("s_waitcnt vmcnt(0)" ::: "memory");
            const unsigned og = xb_add(&bar[XB_TOP], 1u);
            const unsigned tg = og / nx;
            if (og + 1u == (tg + 1u) * nx) xb_add(&bar[XB_TOPGEN], 1u);
            else XB_SPIN(xb_ld(&bar[XB_TOPGEN]) == tg, bar);
            __builtin_amdgcn_fence(__ATOMIC_ACQUIRE, "agent");
            xb_add(&bar[XB_XGEN(b.x)], 1u);
            asm volatile("s_waitcnt vmcnt(0)" ::: "memory");
        } else {
            XB_SPIN(xb_ld(&bar[XB_XGEN(b.x)]) == gen, bar);
            __builtin_amdgcn_fence(__ATOMIC_ACQUIRE, "agent");
            asm volatile("s_waitcnt vmcnt(0)" ::: "memory");
        }
    }
    __syncthreads();
}

namespace nk {
using pg8::bf16_t; using pg8::bf16x8; using pg8::f32x4; using pg8::u32x4; using pg8::Unit;
constexpr int NTH = 512;
constexpr int LDS_STAGE = pg8::STAGE_BYTES;
constexpr int LDS_MISC = 158720;
constexpr int LDS_BYTES = LDS_MISC + 1024;

constexpr size_t NB0 = WS_END * 4;
constexpr size_t NB_BAR = NB0;
constexpr size_t NB_WT1 = NB_BAR + 32768;
constexpr size_t NB_WT2 = NB_WT1 + (size_t)3584 * 1024 * 2;
constexpr size_t NB_XB = NB_WT2 + (size_t)1024 * 1024 * 2;
constexpr size_t NB_XSB = NB_XB + (size_t)MP * 1024 * 2;
constexpr size_t NB_HB = NB_XSB + (size_t)BS * 1024 * 2;
constexpr size_t NB_KVB = NB_HB + (size_t)MT * 2560 * 2;
constexpr size_t NB_G3 = NB_KVB + (size_t)MT * 768 * 2;
constexpr size_t NB_CATB = NB_G3 + (size_t)MT * 32 * 4;
constexpr size_t NB_CBUF = NB_CATB + (size_t)MT * 1024 * 2;
constexpr size_t NB_KCB = NB_CBUF + (size_t)MP * 512 * 4;
constexpr size_t NB_WT3 = NB_KCB + (size_t)BP * 64 * 256 * 2;
constexpr size_t NB_WT4 = NB_WT3 + (size_t)4 * 1024 * 1024 * 2;
constexpr size_t NB_W1T = NB_WT4 + (size_t)1024 * 1024 * 2;
constexpr size_t NB_A1T = NB_W1T + (size_t)64 * 1024 * 2;
constexpr size_t NB_W2T = NB_A1T + (size_t)64 * 1024 * 2;
constexpr size_t NB_A2T = NB_W2T + (size_t)64 * 1024 * 2;
constexpr size_t NB_KCS = NB_A2T + (size_t)64 * 1024 * 2;
constexpr size_t NB_OCS = NB_KCS + (size_t)BS * 256 * 256 * 4;
constexpr size_t NB_PARTS = NB_OCS + (size_t)BS * 8 * 64 * 4;
constexpr size_t NB_END = NB_PARTS + (size_t)BS * 8 * 24 * 66 * 4;
constexpr size_t NB_XSH = 0;
constexpr size_t NB_RKVZ = NB_XSH + (size_t)6 * 16640 * 1024 * 2;
constexpr size_t NB_TWB = NB_RKVZ + (size_t)4 * 16640 * 1024 * 2;
constexpr size_t NB_AWB = NB_TWB + (size_t)MT * 64 * 2;
constexpr size_t NB_RKS = NB_AWB + (size_t)MT * 64 * 2;
static_assert(NB_RKS + (size_t)MT * 16 * 4 <= WS_PRE * 4, "layer-1 region A overflows into PRE");
constexpr size_t NB_DEC = (WS_X1 + SZ_ROWD) * 4;
constexpr size_t NB_KKN = NB_DEC + (size_t)MT * 1024 * 4;
constexpr size_t NB_KKA = NB_KKN + (size_t)MT * 1024 * 2;
constexpr size_t NB_KP = NB_KKA + (size_t)MT * 1024 * 2;
constexpr size_t NB_Y = NB_KP + (size_t)MT * 1024 * 2;
constexpr size_t NB_G4B = NB_Y + (size_t)MT * 1024 * 4;
constexpr size_t NB_CHK = NB_G4B + (size_t)MT * 1024 * 2;
constexpr size_t NB_SREC = NB_CHK + (size_t)4096 * 32768;
static_assert(NB_SREC + (size_t)4096 * 8192 <= NB0, "layer-1 region B overflows");
constexpr int N1PAD = 3584;
__host__ __device__ __forceinline__ int win_src_col(int n) { return n < 2048 ? n : (n < 2560 ? C_ZB + (n - 2048) : (n < 3328 ? C_KV + (n - 2560) : (n < 3352 ? C_G3 + (n - 3328) : -1))); }

__device__ __forceinline__ int opaque(int x) { asm volatile("" : "+s"(x)); return x; }
__device__ __forceinline__ void lds_barrier() { asm volatile("s_waitcnt lgkmcnt(0)" ::: "memory"); __builtin_amdgcn_s_barrier(); asm volatile("" ::: "memory"); }
__device__ __forceinline__ int opaque_v(int x) { asm volatile("" : "+v"(x)); return x; }
struct Args { const float* in[N_IN]; float* out; unsigned char* ws; int ph_lo, ph_hi; };

__device__ __forceinline__ unsigned pk_bf16(float lo, float hi) { unsigned r; asm volatile("v_cvt_pk_bf16_f32 %0, %1, %2" : "=v"(r) : "v"(lo), "v"(hi)); return r; }
typedef __bf16 bf16x2_t __attribute__((ext_vector_type(2)));
__device__ __forceinline__ unsigned pk_bf16c(float lo, float hi) { bf16x2_t v; v[0] = (__bf16)lo; v[1] = (__bf16)hi; return __builtin_bit_cast(unsigned, v); }

template <class MAP>
__device__ __forceinline__ void convert_wt(const float* __restrict__ W, int K, int ldw, bf16_t* __restrict__ Wt, int Npad, MAP map, int bid, int nb) {
    const int kg = K / 8;
    const size_t total = (size_t)Npad * kg;
    for (size_t i = (size_t)bid * NTH + threadIdx.x; i < total; i += (size_t)nb * NTH) {
        const int n = (int)(i % Npad), k0 = (int)(i / Npad) * 8;
        const int sc = map(n);
        u32x4 w = {0u, 0u, 0u, 0u};
        if (sc >= 0) {
            float v[8];
#pragma unroll
            for (int j = 0; j < 8; ++j) v[j] = W[(size_t)(k0 + j) * ldw + sc];
            w.x = pk_bf16(v[0], v[1]); w.y = pk_bf16(v[2], v[3]); w.z = pk_bf16(v[4], v[5]); w.w = pk_bf16(v[6], v[7]);
        }
        *(u32x4*)(Wt + (size_t)n * K + k0) = w;
    }
}
struct MapId { __device__ __forceinline__ int operator()(int n) const { return n; } };
struct MapWin { __device__ __forceinline__ int operator()(int n) const { return win_src_col(n); } };
__device__ __forceinline__ void convert_wfrag(const float* __restrict__ W, bf16_t* __restrict__ Wf, int bid, int nb) {
    for (int i = bid * NTH + threadIdx.x; i < 64 * 128; i += nb * NTH) {
        const int n = i & 63, k0 = (i >> 6) * 8;
        float v[8];
#pragma unroll
        for (int j = 0; j < 8; ++j) v[j] = W[(size_t)(k0 + j) * 64 + n];
        u32x4 w; w.x = pk_bf16(v[0], v[1]); w.y = pk_bf16(v[2], v[3]); w.z = pk_bf16(v[4], v[5]); w.w = pk_bf16(v[6], v[7]);
        *(u32x4*)(Wf + ((size_t)((n >> 5) * 64 + (k0 >> 4)) * 64 + ((k0 >> 3) & 1) * 32 + (n & 31)) * 8) = w;
    }
}
__device__ __forceinline__ void convert_rows(const float* __restrict__ src, size_t n8, bf16_t* __restrict__ dst, int bid, int nb) {
#pragma unroll 4
    for (size_t i = (size_t)bid * NTH + threadIdx.x; i < n8; i += (size_t)nb * NTH) {
        const float4 a = *(const float4*)(src + i * 8), b = *(const float4*)(src + i * 8 + 4);
        u32x4 w; w.x = pk_bf16(a.x, a.y); w.y = pk_bf16(a.z, a.w); w.z = pk_bf16(b.x, b.y); w.w = pk_bf16(b.z, b.w);
        *(u32x4*)(dst + i * 8) = w;
    }
}

struct EpiPre {
    static constexpr bool PERM = false, AFTER_DRAIN = false;
    float* C; int ldc;
    __device__ __forceinline__ void operator()(const f32x4 (&acc)[2][2][4][2], const Unit& u, int wr, int wc, int fr, int fq) const {
        const int row0 = u.pm * 256 + wr * 64 + fr, col0 = u.pn * 256 + wc * 32 + 4 * fq;
#pragma unroll
        for (int ai = 0; ai < 2; ++ai)
#pragma unroll
            for (int m = 0; m < 4; ++m) { float* rowp = C + (size_t)(row0 + ai * 128 + m * 16) * ldc + col0;
#pragma unroll
                for (int bj = 0; bj < 2; ++bj)
#pragma unroll
                    for (int n = 0; n < 2; ++n) *(f32x4*)(rowp + bj * 128 + n * 16) = acc[ai][bj][m][n]; }
    }
};


struct EpiPreB {
    static constexpr bool PERM = true, AFTER_DRAIN = false;
    bf16_t* O;
    __device__ __forceinline__ void operator()(const f32x4 (&acc)[2][2][4][2], const Unit& u, int wr, int wc, int fr, int fq) const {
        const int row0 = u.pm * 256 + wr * 64 + fr, col0 = u.pn * 256 + wc * 32 + 8 * fq;
#pragma unroll
        for (int ai = 0; ai < 2; ++ai)
#pragma unroll
            for (int m = 0; m < 4; ++m) { bf16_t* rowp = O + (size_t)(row0 + ai * 128 + m * 16) * 1024 + col0;
#pragma unroll
                for (int bj = 0; bj < 2; ++bj) { const f32x4 v0 = acc[ai][bj][m][0], v1 = acc[ai][bj][m][1];
                    u32x4 w; w.x = pk_bf16c(v0[0], v0[1]); w.y = pk_bf16c(v0[2], v0[3]); w.z = pk_bf16c(v1[0], v1[1]); w.w = pk_bf16c(v1[2], v1[3]);
                    *(u32x4*)(rowp + bj * 128) = w; } }
    }
};


struct Route1 {
    bf16_t* HB; bf16_t* KVB; float* G3; float* out;
    __device__ __forceinline__ void put8(int row, int n0, const f32x4& v0, const f32x4& v1) const {
        if (n0 < 2560) {
            const float sc = (n0 >= 1536 && n0 < 2048) ? 0.125f : 1.0f;
            u32x4 w; w.x = pk_bf16c(v0[0] * sc, v0[1] * sc); w.y = pk_bf16c(v0[2] * sc, v0[3] * sc); w.z = pk_bf16c(v1[0] * sc, v1[1] * sc); w.w = pk_bf16c(v1[2] * sc, v1[3] * sc);
            *(u32x4*)(HB + (size_t)row * 2560 + n0) = w;
        } else if (n0 < 3328) {
            const int c = n0 - 2560, i3 = c >> 8, cc = c & 255;
            u32x4 w; w.x = pk_bf16c(v0[0], v0[1]); w.y = pk_bf16c(v0[2], v0[3]); w.z = pk_bf16c(v1[0], v1[1]); w.w = pk_bf16c(v1[2], v1[3]);
            *(u32x4*)(KVB + (size_t)row * 768 + c) = w;
            float* dst = nullptr;
            if (row < MP) {
                if (i3 == 0) dst = out + O_CMPP + (size_t)row * 256 + cc;
                else if (i3 == 1) dst = out + O_SELP + (size_t)row * 256 + cc;
                else { const int b = row >> 11, t = row & 2047; if (t >= TP - 512) dst = out + O_WINP + (size_t)(b * 512 + t - (TP - 512)) * 256 + cc; }
            } else {
                const int sidx = row - MP;
                if (i3 == 0) dst = out + O_CMPS + (size_t)sidx * 256 + cc;
                else if (i3 == 1) dst = out + O_SELS + (size_t)sidx * 256 + cc;
                else dst = out + O_WINS + (size_t)(sidx * 512 + 511) * 256 + cc;
            }
            if (dst) { *(f32x4*)dst = v0; *(f32x4*)(dst + 4) = v1; }
        } else if (n0 < 3352) {
            float* dst = G3 + (size_t)row * 32 + (n0 - 3328);
            *(f32x4*)dst = v0; *(f32x4*)(dst + 4) = v1;
        }
    }
};
struct Epi1 {
    static constexpr bool PERM = true, AFTER_DRAIN = false;
    Route1 R;
    __device__ __forceinline__ void operator()(const f32x4 (&acc)[2][2][4][2], const Unit& u, int wr, int wc, int fr, int fq) const {
        const int row0 = u.pm * 256 + wr * 64 + fr, col0 = u.pn * 256 + wc * 32 + 8 * fq;
#pragma unroll
        for (int ai = 0; ai < 2; ++ai)
#pragma unroll
            for (int m = 0; m < 4; ++m)
#pragma unroll
                for (int bj = 0; bj < 2; ++bj) R.put8(row0 + ai * 128 + m * 16, col0 + bj * 128, acc[ai][bj][m][0], acc[ai][bj][m][1]);
    }
};

typedef float f32x16 __attribute__((ext_vector_type(16)));
template <class EMIT>
__device__ __forceinline__ void sample_gemm32(const bf16_t* __restrict__ A, const bf16_t* __restrict__ Bt, int K, int n0, int lane, EMIT emit) {
    const bf16_t* ap = A + (size_t)(lane & 31) * K + 8 * (lane >> 5);
    const bf16_t* bp = Bt + (size_t)(n0 + (lane & 31)) * K + 8 * (lane >> 5);
    f32x16 acc;
#pragma unroll
    for (int i = 0; i < 16; ++i) acc[i] = 0.f;
#pragma unroll 16
    for (int k = 0; k < K; k += 16) {
        const bf16x8 av = *(const bf16x8*)(ap + k), bv = *(const bf16x8*)(bp + k);
        acc = __builtin_amdgcn_mfma_f32_32x32x16_bf16(av, bv, acc, 0, 0, 0);
    }
#pragma unroll
    for (int r = 0; r < 16; ++r) emit((r & 3) + 8 * (r >> 2) + 4 * (lane >> 5), n0 + (lane & 31), acc[r]);
}

template <class EMIT>
__device__ __forceinline__ void sample_gemm32_wg(const bf16_t* __restrict__ A, const bf16_t* __restrict__ Bt, int K, int n0, PG8_LAS unsigned char* lds, EMIT emit) {
    const int tid = opaque_v(threadIdx.x), lane = tid & 63, wv = tid >> 6;
    const int kq = K / 8;
    const bf16_t* ap = A + (size_t)(lane & 31) * K + 8 * (lane >> 5) + wv * kq;
    const bf16_t* bp = Bt + (size_t)(n0 + (lane & 31)) * K + 8 * (lane >> 5) + wv * kq;
    f32x16 acc;
#pragma unroll
    for (int i = 0; i < 16; ++i) acc[i] = 0.f;
#pragma unroll 8
    for (int k = 0; k < kq; k += 16) {
        const bf16x8 av = *(const bf16x8*)(ap + k), bv = *(const bf16x8*)(bp + k);
        acc = __builtin_amdgcn_mfma_f32_32x32x16_bf16(av, bv, acc, 0, 0, 0);
    }
    PG8_LAS float* P = (PG8_LAS float*)lds;
#pragma unroll
    for (int q = 0; q < 4; ++q) *(PG8_LAS f32x4*)(P + (wv * 64 + lane) * 16 + q * 4) = (f32x4){acc[4 * q], acc[4 * q + 1], acc[4 * q + 2], acc[4 * q + 3]};
    __syncthreads();
    if (wv == 0) {
#pragma unroll
        for (int w = 1; w < 8; ++w)
#pragma unroll
            for (int q = 0; q < 4; ++q) { const f32x4 v = *(const PG8_LAS f32x4*)(P + (w * 64 + lane) * 16 + q * 4); acc[4 * q] += v[0]; acc[4 * q + 1] += v[1]; acc[4 * q + 2] += v[2]; acc[4 * q + 3] += v[3]; }
#pragma unroll
        for (int r = 0; r < 16; ++r) emit((r & 3) + 8 * (r >> 2) + 4 * (lane >> 5), n0 + (lane & 31), acc[r]);
    }
    __syncthreads();
}

typedef float f32x16 __attribute__((ext_vector_type(16)));
__device__ __forceinline__ float bf2f(bf16_t v) { return __uint_as_float((unsigned)v << 16); }
__device__ __forceinline__ float sigm_f(float x) { return 1.f / (1.f + __expf(-x)); }
__device__ __forceinline__ float silu_f(float x) { return x / (1.f + __expf(-x)); }

__device__ __forceinline__ float wsum64(float v) {
    v += __builtin_bit_cast(float, __builtin_amdgcn_update_dpp(0, __builtin_bit_cast(int, v), 0xB1, 0xF, 0xF, true));
    v += __builtin_bit_cast(float, __builtin_amdgcn_update_dpp(0, __builtin_bit_cast(int, v), 0x4E, 0xF, 0xF, true));
    v += __builtin_bit_cast(float, __builtin_amdgcn_update_dpp(0, __builtin_bit_cast(int, v), 0x141, 0xF, 0xF, true));
    v += __builtin_bit_cast(float, __builtin_amdgcn_update_dpp(0, __builtin_bit_cast(int, v), 0x140, 0xF, 0xF, true));
    v += __shfl_xor(v, 16); v += __shfl_xor(v, 32);
    return v;
}
constexpr int CV_U = 0;
constexpr int CV_C = 65536;
__device__ __forceinline__ void conv_item(const Args& a, unsigned char* ws, PG8_LAS unsigned char* lds, int item) {
    const int tid = opaque_v(threadIdx.x);
    const int b = item >> 6, t0 = (item & 63) * 32;
    const bf16_t* HB = (const bf16_t*)(ws + NB_HB);
    PG8_LAS float* U = (PG8_LAS float*)(lds + CV_U);
    PG8_LAS float* C = (PG8_LAS float*)(lds + CV_C);
    const int chl = tid & 255, tp = tid >> 8;
    const int lane = tid & 63, wv = tid >> 6;
    u32x4 zv[4];
#pragma unroll
    for (int k = 0; k < 4; ++k) zv[k] = *(const u32x4*)(HB + (size_t)(b * TP + t0 + wv * 4 + k) * 2560 + 1024 + lane * 8);
#pragma unroll 1
    for (int half = 0; half < 2; ++half) {
        const int chb = half * 256;
#pragma unroll
        for (int it = 0; it < 4; ++it) {
            const int vi = tid + it * NTH;
            if (vi < 62 * 32) {
                const int r = vi >> 5, c8 = (vi & 31) * 8, t = t0 - 30 + r;
                float u[8];
                if (t >= 0) {
                    const bf16_t* h = HB + (size_t)(b * TP + t) * 2560 + chb + c8;
                    const u32x4 av = *(const u32x4*)h, gv = *(const u32x4*)(h + 512);
#pragma unroll
                    for (int i = 0; i < 8; ++i) {
                        const float x = __uint_as_float((i & 1) ? (av[i >> 1] & 0xffff0000u) : (av[i >> 1] << 16));
                        const float g = __uint_as_float((i & 1) ? (gv[i >> 1] & 0xffff0000u) : (gv[i >> 1] << 16));
                        u[i] = x * sigm_f(g);
                    }
                } else {
#pragma unroll
                    for (int i = 0; i < 8; ++i) u[i] = 0.f;
                }
                *(PG8_LAS f32x4*)(U + r * 256 + c8) = (f32x4){u[0], u[1], u[2], u[3]};
                *(PG8_LAS f32x4*)(U + r * 256 + c8 + 4) = (f32x4){u[4], u[5], u[6], u[7]};
                if (t >= TP - 30 && r >= 30) {
                    float* o = a.out + O_CONVP + (size_t)(b * 30 + t - (TP - 30)) * 512 + chb + c8;
                    *(float4*)o = make_float4(u[0], u[1], u[2], u[3]); *(float4*)(o + 4) = make_float4(u[4], u[5], u[6], u[7]);
                }
            }
        }
        __syncthreads();
        {
            const int ch = chb + chl;
            float w[31], uw[46], acc[16];
#pragma unroll
            for (int j = 0; j < 31; ++j) w[j] = a.in[I_CONVW][j * 512 + ch];
            const float bias = a.in[I_CONVB][ch];
#pragma unroll
            for (int r = 0; r < 46; ++r) uw[r] = U[(tp * 16 + r) * 256 + chl];
#pragma unroll
            for (int k = 0; k < 16; ++k) {
                float s_ = bias;
#pragma unroll
                for (int j = 0; j < 31; ++j) s_ = fmaf(w[j], uw[k + j], s_);
                acc[k] = s_;
            }
#pragma unroll
            for (int k = 0; k < 16; ++k) C[(tp * 16 + k) * 516 + ch] = acc[k];
        }
        __syncthreads();
    }
    {
        const float4 g0 = *(const float4*)(a.in[I_CLNG] + lane * 8), g1 = *(const float4*)(a.in[I_CLNG] + lane * 8 + 4);
        const float4 b0 = *(const float4*)(a.in[I_CLNB] + lane * 8), b1 = *(const float4*)(a.in[I_CLNB] + lane * 8 + 4);
        const float gg[8] = {g0.x, g0.y, g0.z, g0.w, g1.x, g1.y, g1.z, g1.w}, bb[8] = {b0.x, b0.y, b0.z, b0.w, b1.x, b1.y, b1.z, b1.w};
#pragma unroll
        for (int k = 0; k < 4; ++k) {
            const int tl = wv * 4 + k;
            const size_t row = (size_t)(b * TP + t0 + tl);
            const f32x4 c0 = *(const PG8_LAS f32x4*)(C + tl * 516 + lane * 8), c1 = *(const PG8_LAS f32x4*)(C + tl * 516 + lane * 8 + 4);
            float c[8] = {c0[0], c0[1], c0[2], c0[3], c1[0], c1[1], c1[2], c1[3]};
            float sm = 0.f;
#pragma unroll
            for (int i = 0; i < 8; ++i) sm += c[i];
            const float mean = wsum64(sm) * (1.f / 512.f);
            float sq = 0.f;
#pragma unroll
            for (int i = 0; i < 8; ++i) { c[i] -= mean; sq += c[i] * c[i]; }
            const float rs = rsqrtf(wsum64(sq) * (1.f / 512.f) + LN_EPS);
            float y[8];
#pragma unroll
            for (int i = 0; i < 8; ++i) {
                const float z = __uint_as_float((i & 1) ? (zv[k][i >> 1] & 0xffff0000u) : (zv[k][i >> 1] << 16));
                y[i] = silu_f(c[i] * rs * gg[i] + bb[i]) * silu_f(z);
            }
            u32x4 o; o.x = pk_bf16(y[0], y[1]); o.y = pk_bf16(y[2], y[3]); o.z = pk_bf16(y[4], y[5]); o.w = pk_bf16(y[6], y[7]);
            *(u32x4*)((bf16_t*)(ws + NB_CATB) + row * 1024 + lane * 8) = o;
        }
    }
    __syncthreads();
}

__device__ __forceinline__ void pool_prompt(const Args& a, unsigned char* ws, int bid, int nb) {
    bf16_t* KCB = (bf16_t*)(ws + NB_KCB);
    for (int i = bid * NTH + threadIdx.x; i < BP * 64 * 256; i += nb * NTH) {
        const int c = i & 255, n = (i >> 8) & 63, b = i >> 14;
        const int kv = c >> 7, g = (c >> 6) & 1;
        const float* w = kv ? a.in[I_WVC] : a.in[I_WKC];
        const float* src = a.out + O_CMPP + (size_t)(b * TP + n * 32) * 256 + c;
        float acc = 0.f;
#pragma unroll 8
        for (int l = 0; l < 32; ++l) acc = fmaf(src[(size_t)l * 256], w[l * 2 + g], acc);
        KCB[i] = (bf16_t)(pk_bf16(acc, 0.f) & 0xffffu);
    }
}

constexpr int A_KT = 0;
constexpr int A_VT = 18432;
constexpr int A_IMPH = 35840;
constexpr int A_IMPS = 68608;
constexpr int A_MASK = 76800;
constexpr float LOG2E = 1.4426950408889634f;

struct KvSrc { const bf16_t* k; const bf16_t* v; int rstride; };

__device__ __forceinline__ void kv_issue(const KvSrc& s, int tid, u32x4& kr, u32x4& vr) {
    const int key = tid >> 3, c8 = tid & 7;
    kr = *(const u32x4*)(s.k + (size_t)key * s.rstride + c8 * 8);
    vr = *(const u32x4*)(s.v + (size_t)key * s.rstride + c8 * 8);
}
__device__ __forceinline__ void kv_write(PG8_LAS unsigned char* lds, int buf, int tid, const u32x4& kr, const u32x4& vr) {
    const int key = tid >> 3, c8 = tid & 7;
    *(PG8_LAS u32x4*)(lds + A_KT + buf * 9216 + key * 144 + c8 * 16) = kr;
    PG8_LAS bf16_t* vt = (PG8_LAS bf16_t*)(lds + A_VT + buf * 8704);
#pragma unroll
    for (int i = 0; i < 4; ++i) { vt[(c8 * 8 + 2 * i) * 68 + key] = (bf16_t)(vr[i] & 0xffffu); vt[(c8 * 8 + 2 * i + 1) * 68 + key] = (bf16_t)(vr[i] >> 16); }
}

__device__ __forceinline__ void attn_block(const int MODE, PG8_LAS unsigned char* lds, int buf, const bf16x8 (&qf)[4], int lane, float kslope, float base, int kmax, int kmin,
                                           float& m, float& l, f32x16 (&o)[2], f32x16 (&x)[2]) {
    const int lr = lane & 31, h = lane >> 5;
    const PG8_LAS unsigned char* kt_p = lds + A_KT + buf * 9216 + lr * 144 + h * 16;
#pragma unroll
    for (int kt = 0; kt < 2; ++kt) {
#pragma unroll
        for (int i = 0; i < 16; ++i) x[kt][i] = 0.f;
#pragma unroll
        for (int s = 0; s < 4; ++s) {
            const bf16x8 kf = *(const PG8_LAS bf16x8*)(kt_p + kt * 32 * 144 + s * 32);
            x[kt] = __builtin_amdgcn_mfma_f32_32x32x16_bf16(kf, qf[s], x[kt], 0, 0, 0);
        }
    }
    const float bh = base + kslope * (float)(4 * h);
    float mx = -INFINITY;
#pragma unroll
    for (int kt = 0; kt < 2; ++kt)
#pragma unroll
        for (int i = 0; i < 16; ++i) {
            const int kc = kt * 32 + (i & 3) + 8 * (i >> 2);
            x[kt][i] = fmaf(x[kt][i], LOG2E, fmaf(kslope, (float)kc, bh));
        }
    if (MODE) {
        const int hi = kmax - 4 * h, lo = kmin - 4 * h;
#pragma unroll
        for (int kt = 0; kt < 2; ++kt)
#pragma unroll
            for (int i = 0; i < 16; ++i) {
                const int kc = kt * 32 + (i & 3) + 8 * (i >> 2);
                x[kt][i] = (kc > hi || kc < lo) ? -INFINITY : x[kt][i];
            }
    }
#pragma unroll
    for (int kt = 0; kt < 2; ++kt)
#pragma unroll
        for (int i = 0; i < 16; ++i) mx = fmaxf(mx, x[kt][i]);
    mx = fmaxf(mx, __shfl_xor(mx, 32));
    const float mn = fmaxf(m, mx);
    const float corr = __builtin_amdgcn_exp2f(m - mn);
    const bool grew = __any(mn > m);
    m = mn;
    float ls = 0.f;
#pragma unroll
    for (int kt = 0; kt < 2; ++kt)
#pragma unroll
        for (int i = 0; i < 16; ++i) { const float pv = __builtin_amdgcn_exp2f(x[kt][i] - mn); x[kt][i] = pv; ls += pv; }
    l = fmaf(l, corr, ls);
    if (grew) {
#pragma unroll
        for (int dt = 0; dt < 2; ++dt)
#pragma unroll
            for (int i = 0; i < 16; ++i) o[dt][i] *= corr;
    }
    const PG8_LAS unsigned char* vt_p = lds + A_VT + buf * 8704 + lr * 136 + h * 8;
#pragma unroll
    for (int kt = 0; kt < 2; ++kt)
#pragma unroll
        for (int s = 0; s < 2; ++s) {
            u32x4 pw; pw.x = pk_bf16(x[kt][8 * s + 0], x[kt][8 * s + 1]); pw.y = pk_bf16(x[kt][8 * s + 2], x[kt][8 * s + 3]);
            pw.z = pk_bf16(x[kt][8 * s + 4], x[kt][8 * s + 5]); pw.w = pk_bf16(x[kt][8 * s + 6], x[kt][8 * s + 7]);
            const bf16x8 pf = __builtin_bit_cast(bf16x8, pw);
#pragma unroll
            for (int dt = 0; dt < 2; ++dt) {
                const PG8_LAS unsigned char* vp = vt_p + dt * 32 * 136 + (kt * 32 + s * 16) * 2;
                typedef unsigned u32x2 __attribute__((ext_vector_type(2)));
                const u32x2 v0 = *(const PG8_LAS u32x2*)vp, v1 = *(const PG8_LAS u32x2*)(vp + 16);
                u32x4 vw; vw.x = v0.x; vw.y = v0.y; vw.z = v1.x; vw.w = v1.y;
                o[dt] = __builtin_amdgcn_mfma_f32_32x32x16_bf16(__builtin_bit_cast(bf16x8, vw), pf, o[dt], 0, 0, 0);
            }
        }
}

__device__ __forceinline__ void attn_item(const Args& a, unsigned char* ws, PG8_LAS unsigned char* lds, int b, int g, int qb) {
    const int tid = opaque_v(threadIdx.x), lane = tid & 63, wv = __builtin_amdgcn_readfirstlane(tid >> 6);
    const int lr = lane & 31, h = lane >> 5;
    const int r = wv >> 1, th = wv & 1, hh = g * 4 + r;
    const int t0 = qb * 64, tb = qb;
    const int qloc = th * 32 + lr;
    const int qpos = t0 + qloc;
    const size_t qrow = (size_t)b * TP + qpos;
    const bf16_t* HB = (const bf16_t*)(ws + NB_HB);
    const bf16_t* KVB = (const bf16_t*)(ws + NB_KVB);
    const float slope2 = __builtin_amdgcn_exp2f(-(float)(hh + 1)) * LOG2E;
    bf16x8 qf[4];
#pragma unroll
    for (int s = 0; s < 4; ++s) qf[s] = *(const bf16x8*)(HB + qrow * 2560 + 1536 + hh * 64 + s * 16 + h * 8);
    const float* g3p = (const float*)(ws + NB_G3) + qrow * 32 + hh * 3;
    const float gc = sigm_f(g3p[0]), gs = sigm_f(g3p[1]), gw = sigm_f(g3p[2]);
    f32x16 res[2], o[2], x[2];
#pragma unroll
    for (int dt = 0; dt < 2; ++dt)
#pragma unroll
        for (int i = 0; i < 16; ++i) { res[dt][i] = 0.f; o[dt][i] = 0.f; }
    float m = -1e30f, l = 0.f;
    u32x4 kr, vr;
    PG8_LAS float* IMPH = (PG8_LAS float*)(lds + A_IMPH);
    PG8_LAS float* IMPS = (PG8_LAS float*)(lds + A_IMPS);
    PG8_LAS unsigned* MASK = (PG8_LAS unsigned*)(lds + A_MASK);

    {
        const bf16_t* kc = (const bf16_t*)(ws + NB_KCB) + (size_t)b * 64 * 256 + g * 64;
        KvSrc s{kc, kc + 128, 256};
        kv_issue(s, tid, kr, vr); kv_write(lds, 0, tid, kr, vr);
        if (tid < 64) MASK[tid] = 0u;
        __syncthreads();
        const int nmax = (qpos >= 31) ? ((qpos - 31) >> 5) : -1;
        attn_block(1, lds, 0, qf, lane, slope2 * 32.f, slope2 * (float)(31 - qpos), nmax, 0, m, l, o, x);
        const float lt = l + __shfl_xor(l, 32);
        const float inv = (nmax >= 0) ? 1.f / lt : 0.f;
        const float sc = gc * inv;
#pragma unroll
        for (int dt = 0; dt < 2; ++dt)
#pragma unroll
            for (int i = 0; i < 16; ++i) { res[dt][i] = o[dt][i] * sc; o[dt][i] = 0.f; }
        if (tb >= 16) {
#pragma unroll
            for (int kt = 0; kt < 2; ++kt)
#pragma unroll
                for (int c = 0; c < 4; ++c)
#pragma unroll
                    for (int e = 0; e < 2; ++e)
                        IMPH[(r * 64 + qloc) * 32 + kt * 16 + 4 * c + 2 * h + e] = (nmax >= 0) ? (x[kt][4 * c + 2 * e] + x[kt][4 * c + 2 * e + 1]) * inv : 0.f;
        }
        m = -1e30f; l = 0.f;
        __syncthreads();
    }
    if (tb >= 16) {
        const int tq = opaque_v(tid);
        const int q = tq >> 3, jq = tq & 7;
        float v4[4];
#pragma unroll
        for (int e = 0; e < 4; ++e) {
            const int j = jq * 4 + e;
            float v = IMPH[(0 * 64 + q) * 32 + j] + IMPH[(1 * 64 + q) * 32 + j] + IMPH[(2 * 64 + q) * 32 + j] + IMPH[(3 * 64 + q) * 32 + j];
            if (j == 0 || j == tb || j == tb - 1) v = 1e4f;
            IMPS[q * 32 + j] = v; v4[e] = v;
        }
        __syncthreads();
        unsigned bits = 0u;
#pragma unroll
        for (int e = 0; e < 4; ++e) {
            const int j = jq * 4 + e;
            int rank = 0;
            for (int i = 0; i <= tb; ++i) { const float vi = IMPS[q * 32 + i]; rank += (vi > v4[e] || (vi == v4[e] && i < j)) ? 1 : 0; }
            if (j <= tb && rank < 16) bits |= 1u << j;
        }
        if (bits) atomicOr((unsigned*)&MASK[q], bits);
    } else {
        if (tid < 64) MASK[tid] = (2u << tb) - 1u;
    }
    __syncthreads();
    const unsigned selmask = MASK[qloc];

    {
        const bf16_t* kb = KVB + (size_t)b * TP * 768 + 256 + g * 64;
        { KvSrc s{kb, kb + 128, 768}; kv_issue(s, tid, kr, vr); kv_write(lds, 0, tid, kr, vr); }
        __syncthreads();
        for (int j = 0; j <= tb; ++j) {
            if (j < tb) { KvSrc s{kb + (size_t)(j + 1) * 64 * 768, kb + (size_t)(j + 1) * 64 * 768 + 128, 768}; kv_issue(s, tid, kr, vr); }
            const float base = ((selmask >> j) & 1u) ? slope2 * (float)(j * 64 - qpos) : -INFINITY;
            attn_block(j == tb, lds, j & 1, qf, lane, slope2, base, qloc, 0, m, l, o, x);
            if (j < tb) kv_write(lds, (j + 1) & 1, tid, kr, vr);
            __syncthreads();
        }
        const float lt = l + __shfl_xor(l, 32);
        const float sc = gs / lt;
#pragma unroll
        for (int dt = 0; dt < 2; ++dt)
#pragma unroll
            for (int i = 0; i < 16; ++i) { res[dt][i] = fmaf(o[dt][i], sc, res[dt][i]); o[dt][i] = 0.f; }
        m = -1e30f; l = 0.f;
    }
    {
        const int jlo = (tb >= 8) ? tb - 8 : 0;
        const bf16_t* kb = KVB + (size_t)b * TP * 768 + 512 + g * 64;
        { KvSrc s{kb + (size_t)jlo * 64 * 768, kb + (size_t)jlo * 64 * 768 + 128, 768}; kv_issue(s, tid, kr, vr); kv_write(lds, 0, tid, kr, vr); }
        __syncthreads();
        for (int j = jlo; j <= tb; ++j) {
            const int bi = (j - jlo) & 1;
            if (j < tb) { KvSrc s{kb + (size_t)(j + 1) * 64 * 768, kb + (size_t)(j + 1) * 64 * 768 + 128, 768}; kv_issue(s, tid, kr, vr); }
            const float base = slope2 * (float)(j * 64 - qpos);
            attn_block((j == tb) || (j == tb - 8), lds, bi, qf, lane, slope2, base, (j == tb) ? qloc : 64, (j == tb - 8) ? qpos - 511 - j * 64 : 0, m, l, o, x);
            if (j < tb) kv_write(lds, bi ^ 1, tid, kr, vr);
            __syncthreads();
        }
        const float lt = l + __shfl_xor(l, 32);
        const float sc = gw / lt;
#pragma unroll
        for (int dt = 0; dt < 2; ++dt)
#pragma unroll
            for (int i = 0; i < 16; ++i) res[dt][i] = fmaf(o[dt][i], sc, res[dt][i]);
    }
    {
        const size_t qrow2 = (size_t)b * TP + t0 + th * 32 + (opaque_v(lane) & 31);
        const bf16_t* zb = HB + qrow2 * 2560 + 2048 + hh * 64;
        bf16_t* dst = (bf16_t*)(ws + NB_CATB) + qrow2 * 1024 + 512 + hh * 64;
        typedef unsigned u32x2 __attribute__((ext_vector_type(2)));
#pragma unroll
        for (int dt = 0; dt < 2; ++dt)
#pragma unroll
            for (int c = 0; c < 4; ++c) {
                const int d = dt * 32 + 8 * c + 4 * h;
                const u32x2 zv = *(const u32x2*)(zb + d);
                const float z0 = __uint_as_float(zv.x << 16), z1 = __uint_as_float(zv.x & 0xffff0000u), z2 = __uint_as_float(zv.y << 16), z3 = __uint_as_float(zv.y & 0xffff0000u);
                u32x2 w; w.x = pk_bf16(res[dt][4 * c + 0] * silu_f(z0), res[dt][4 * c + 1] * silu_f(z1)); w.y = pk_bf16(res[dt][4 * c + 2] * silu_f(z2), res[dt][4 * c + 3] * silu_f(z3));
                *(u32x2*)(dst + d) = w;
            }
    }
}

constexpr int XSH_ROWS = 16640;
__device__ __forceinline__ float wave_sum(float v) {
#pragma unroll
    for (int o = 32; o > 0; o >>= 1) v += __shfl_xor(v, o);
    return v;
}
__device__ __forceinline__ void ld_row16(const float* __restrict__ src, int lane, float (&x)[16]) {
#pragma unroll
    for (int q = 0; q < 4; ++q) { const float4 v = *(const float4*)(src + q * 256 + lane * 4); x[4 * q] = v.x; x[4 * q + 1] = v.y; x[4 * q + 2] = v.z; x[4 * q + 3] = v.w; }
}
__device__ __forceinline__ void ln_calc16(const float* __restrict__ g, const float* __restrict__ bta, int lane, float (&x)[16]) {
    float sm = 0.f;
#pragma unroll
    for (int i = 0; i < 16; ++i) sm += x[i];
    const float mean = wave_sum(sm) * (1.f / 1024.f);
    float sq = 0.f;
#pragma unroll
    for (int i = 0; i < 16; ++i) { x[i] -= mean; sq += x[i] * x[i]; }
    const float rs = rsqrtf(wave_sum(sq) * (1.f / 1024.f) + LN_EPS);
#pragma unroll
    for (int q = 0; q < 4; ++q) {
        const float4 gv = *(const float4*)(g + q * 256 + lane * 4), bv = *(const float4*)(bta + q * 256 + lane * 4);
        x[4 * q] = x[4 * q] * rs * gv.x + bv.x; x[4 * q + 1] = x[4 * q + 1] * rs * gv.y + bv.y; x[4 * q + 2] = x[4 * q + 2] * rs * gv.z + bv.z; x[4 * q + 3] = x[4 * q + 3] * rs * gv.w + bv.w;
    }
}
__device__ __forceinline__ void ln_calc16r(const float (&g)[16], const float (&bta)[16], float (&x)[16]) {
    float sm = 0.f;
#pragma unroll
    for (int i = 0; i < 16; ++i) sm += x[i];
    const float mean = wave_sum(sm) * (1.f / 1024.f);
    float sq = 0.f;
#pragma unroll
    for (int i = 0; i < 16; ++i) { x[i] -= mean; sq += x[i] * x[i]; }
    const float rs = rsqrtf(wave_sum(sq) * (1.f / 1024.f) + LN_EPS);
#pragma unroll
    for (int i = 0; i < 16; ++i) x[i] = x[i] * rs * g[i] + bta[i];
}
__device__ __forceinline__ void ln_row16(const float* __restrict__ src, const float* __restrict__ g, const float* __restrict__ bta, int lane, float (&x)[16]) {
    ld_row16(src, lane, x); ln_calc16(g, bta, lane, x);
}
constexpr int LR_A = 0;
constexpr int LR_MU = 132096;
__device__ __forceinline__ void store_x1_xsh(const Args& a, unsigned char* ws, PG8_LAS unsigned char* lds, size_t xrow, int lrow, int lane, const float (&cur)[16], const float (&prev)[16]) {
    typedef unsigned u32x2 __attribute__((ext_vector_type(2)));
#pragma unroll 1
    for (int n = 0; n < 6; ++n) {
        const PG8_LAS float* mu = (const PG8_LAS float*)(lds + LR_MU) + n * 1024 + lane * 4;
        u32x2 w[4];
#pragma unroll
        for (int q = 0; q < 4; ++q) { const f32x4 m4 = *(const PG8_LAS f32x4*)(mu + q * 256);
            w[q].x = pk_bf16(fmaf(prev[4 * q] - cur[4 * q], m4[0], cur[4 * q]), fmaf(prev[4 * q + 1] - cur[4 * q + 1], m4[1], cur[4 * q + 1]));
            w[q].y = pk_bf16(fmaf(prev[4 * q + 2] - cur[4 * q + 2], m4[2], cur[4 * q + 2]), fmaf(prev[4 * q + 3] - cur[4 * q + 3], m4[3], cur[4 * q + 3])); }
        if (n < 4 || lrow < 0) {
            bf16_t* dst = (bf16_t*)(ws + NB_XSH) + ((size_t)n * XSH_ROWS + xrow) * 1024 + lane * 4;
#pragma unroll
            for (int q = 0; q < 4; ++q) *(u32x2*)(dst + q * 256) = w[q];
        } else {
            PG8_LAS bf16_t* dst = (PG8_LAS bf16_t*)(lds + LR_A) + ((n - 4) * 32 + lrow) * 1032 + lane * 4;
#pragma unroll
            for (int q = 0; q < 4; ++q) *(PG8_LAS u32x2*)(dst + q * 256) = w[q];
        }
    }
}
template <class ROWMAP>
__device__ __forceinline__ void lora_pass(unsigned char* ws, PG8_LAS unsigned char* lds, int tid, ROWMAP rowmap) {
    const int lane = tid & 63, wv = tid >> 6, lr = lane & 31, h = lane >> 5;
    const int which = wv >> 2, kq = wv & 3;
    PG8_LAS bf16_t* AT = (PG8_LAS bf16_t*)(lds + LR_A) + which * 32 * 1032;
    PG8_LAS float* P = (PG8_LAS float*)(lds + LR_A);
    __syncthreads();
    const bf16_t* Bt = (const bf16_t*)(ws + (which ? NB_A1T : NB_W1T));
    f32x16 acc0, acc1;
#pragma unroll
    for (int i = 0; i < 16; ++i) { acc0[i] = 0.f; acc1[i] = 0.f; }
#pragma unroll
    for (int s = 0; s < 16; ++s) {
        const int k = kq * 256 + s * 16 + h * 8;
        const bf16x8 av = *(const PG8_LAS bf16x8*)(AT + lr * 1032 + k);
        const bf16x8 b0 = *(const bf16x8*)(Bt + ((size_t)(kq * 16 + s) * 64 + lane) * 8), b1 = *(const bf16x8*)(Bt + ((size_t)(64 + kq * 16 + s) * 64 + lane) * 8);
        acc0 = __builtin_amdgcn_mfma_f32_32x32x16_bf16(av, b0, acc0, 0, 0, 0);
        acc1 = __builtin_amdgcn_mfma_f32_32x32x16_bf16(av, b1, acc1, 0, 0, 0);
    }
    __syncthreads();
#pragma unroll
    for (int q = 0; q < 4; ++q) {
        *(PG8_LAS f32x4*)(P + (wv * 64 + lane) * 32 + q * 4) = (f32x4){acc0[4 * q], acc0[4 * q + 1], acc0[4 * q + 2], acc0[4 * q + 3]};
        *(PG8_LAS f32x4*)(P + (wv * 64 + lane) * 32 + 16 + q * 4) = (f32x4){acc1[4 * q], acc1[4 * q + 1], acc1[4 * q + 2], acc1[4 * q + 3]};
    }
    __syncthreads();
    if (wv < 4) {
        const int wh = wv >> 1, half = wv & 1;
        float sum[16];
#pragma unroll
        for (int i = 0; i < 16; ++i) sum[i] = 0.f;
#pragma unroll
        for (int w = 0; w < 4; ++w)
#pragma unroll
            for (int q = 0; q < 4; ++q) { const f32x4 v = *(const PG8_LAS f32x4*)(P + ((wh * 4 + w) * 64 + lane) * 32 + half * 16 + q * 4); sum[4 * q] += v[0]; sum[4 * q + 1] += v[1]; sum[4 * q + 2] += v[2]; sum[4 * q + 3] += v[3]; }
        bf16_t* dst = (bf16_t*)(ws + (wh ? NB_AWB : NB_TWB)) + half * 32 + lr;
#pragma unroll
        for (int i = 0; i < 16; ++i) { const int rl = (i & 3) + 8 * (i >> 2) + 4 * h; const float v = wh ? sum[i] : tanhf(sum[i]); dst[rowmap(rl) * 64] = (bf16_t)(pk_bf16c(v, 0.f) & 0xffffu); }
    }
    __syncthreads();
}
__device__ __forceinline__ void phase_lns(const Args& a, unsigned char* ws, PG8_LAS unsigned char* lds, int bid, int nb) {
    const int tid = opaque_v(threadIdx.x), lane = tid & 63, wv = tid >> 6;
    const float* PRE = (const float*)ws + WS_PRE;
    float g[16], bta[16];
    ld_row16(a.in[I_LNG], lane, g); ld_row16(a.in[I_LNB], lane, bta);
    for (int i = tid; i < 6 * 256; i += NTH) *(PG8_LAS f32x4*)(lds + LR_MU + i * 16) = *(const f32x4*)(a.in[I_MU] + i * 4);
    __syncthreads();
    for (int blk = bid; blk < 256; blk += nb) {
        const int r0 = blk * 64 + wv * 8;
        float prev[16], cur[16];
        if ((r0 & (TP - 1)) == 0) {
#pragma unroll
            for (int i = 0; i < 16; ++i) prev[i] = 0.f;
        } else { ld_row16(PRE + (size_t)(r0 - 1) * 1024, lane, prev); ln_calc16r(g, bta, prev); }
        float nxt[16];
        ld_row16(PRE + (size_t)r0 * 1024, lane, nxt);
#pragma unroll 1
        for (int k = 0; k < 8; ++k) {
            const int row = r0 + k;
#pragma unroll
            for (int i = 0; i < 16; ++i) cur[i] = nxt[i];
            if (k + 1 < 8) ld_row16(PRE + (size_t)(row + 1) * 1024, lane, nxt);
            ln_calc16r(g, bta, cur);
            store_x1_xsh(a, ws, lds, row, wv * 4 + (k & 3), lane, cur, prev);
            if ((row & (TP - 1)) == TP - 1) {
                float* so = a.out + O_SHP + (size_t)(row >> 11) * 1024 + lane * 4;
#pragma unroll
                for (int q = 0; q < 4; ++q) *(float4*)(so + q * 256) = make_float4(cur[4 * q], cur[4 * q + 1], cur[4 * q + 2], cur[4 * q + 3]);
            }
#pragma unroll
            for (int i = 0; i < 16; ++i) prev[i] = cur[i];
            if ((k & 3) == 3) {
                const int rbase = blk * 64 + (k & 4);
                lora_pass(ws, lds, tid, [&](int rl) { return (size_t)(rbase + (rl >> 2) * 8 + (rl & 3)); });
            }
        }
    }
    for (int s = bid * 8 + wv; s < BS; s += nb * 8) {
        float prev[16], cur[16];
        const float* sp = a.in[I_SSHIFT] + (size_t)s * 1024 + lane * 4;
#pragma unroll
        for (int q = 0; q < 4; ++q) { const float4 v = *(const float4*)(sp + q * 256); prev[4 * q] = v.x; prev[4 * q + 1] = v.y; prev[4 * q + 2] = v.z; prev[4 * q + 3] = v.w; }
        ld_row16(PRE + (size_t)(MP + s) * 1024, lane, cur); ln_calc16r(g, bta, cur);
        store_x1_xsh(a, ws, lds, MP + s, -1, lane, cur, prev);
        float* so = a.out + O_SHS + (size_t)s * 1024 + lane * 4;
#pragma unroll
        for (int q = 0; q < 4; ++q) *(float4*)(so + q * 256) = make_float4(cur[4 * q], cur[4 * q + 1], cur[4 * q + 2], cur[4 * q + 3]);
    }
}

struct Order3 {
    pg8::StaticOrder so;
    __device__ void init(int G, int c) { so.init(MP, 4096, G, c); }
    __device__ bool next(int i, Unit& u) const { Unit v; if (!so.next(i, v)) return false; const int n = v.pn >> 2; u.pm = n * 65 + v.pm; u.pn = v.pn; return true; }
    __device__ __forceinline__ void a_ready(const Unit&) const {}
    __device__ __forceinline__ void done(const Unit&) const {}
};
struct Epi3 {
    static constexpr bool PERM = true, AFTER_DRAIN = false;
    bf16_t* O;
    __device__ __forceinline__ void operator()(const f32x4 (&acc)[2][2][4][2], const Unit& u, int wr, int wc, int fr, int fq) const {
        const int n = u.pn >> 2, pm = u.pm - n * 65, pn = u.pn & 3;
        const int row0 = pm * 256 + wr * 64 + fr, col0 = pn * 256 + wc * 32 + 8 * fq;
        bf16_t* base = O + (size_t)n * XSH_ROWS * 1024;
#pragma unroll
        for (int ai = 0; ai < 2; ++ai)
#pragma unroll
            for (int m = 0; m < 4; ++m) { bf16_t* rowp = base + (size_t)(row0 + ai * 128 + m * 16) * 1024 + col0;
#pragma unroll
                for (int bj = 0; bj < 2; ++bj) { const f32x4 v0 = acc[ai][bj][m][0], v1 = acc[ai][bj][m][1];
                    u32x4 w; w.x = pk_bf16c(v0[0], v0[1]); w.y = pk_bf16c(v0[2], v0[3]); w.z = pk_bf16c(v1[0], v1[1]); w.w = pk_bf16c(v1[2], v1[3]);
                    *(u32x4*)(rowp + bj * 128) = w; } }
    }
};
struct EpiPreRes {
    static constexpr bool PERM = false, AFTER_DRAIN = false;
    float* C; const float* X;
    __device__ __forceinline__ void operator()(const f32x4 (&acc)[2][2][4][2], const Unit& u, int wr, int wc, int fr, int fq) const {
        const int row0 = u.pm * 256 + wr * 64 + fr, col0 = u.pn * 256 + wc * 32 + 4 * fq;
#pragma unroll
        for (int ai = 0; ai < 2; ++ai)
#pragma unroll
            for (int m = 0; m < 4; ++m) { const size_t off = (size_t)(row0 + ai * 128 + m * 16) * 1024 + col0;
#pragma unroll
                for (int bj = 0; bj < 2; ++bj)
#pragma unroll
                    for (int n = 0; n < 2; ++n) { const f32x4 xv = *(const f32x4*)(X + off + bj * 128 + n * 16); *(f32x4*)(C + off + bj * 128 + n * 16) = acc[ai][bj][m][n] + xv * ALPHA; } }
    }
};

constexpr int LR_A0 = 0;
constexpr int LR_P = 67584;
struct LoraRegs { u32x4 v[8]; };
__device__ __forceinline__ void lora_load(unsigned char* ws, int task, int tid, LoraRegs& r) {
    const int rt = task >> 1, which = task & 1;
    const bf16_t* A = (const bf16_t*)(ws + NB_XSH) + ((size_t)(4 + which) * XSH_ROWS + (size_t)rt * 32) * 1024;
#pragma unroll
    for (int i = 0; i < 8; ++i) { const int idx = tid + i * NTH; r.v[i] = *(const u32x4*)(A + (size_t)(idx >> 7) * 1024 + (idx & 127) * 8); }
}
__device__ __forceinline__ void lora_tile(unsigned char* ws, PG8_LAS unsigned char* lds, int task, int tid, const LoraRegs& r) {
    const int rt = task >> 1, which = task & 1;
    const int lane = tid & 63, wv = tid >> 6, lr = lane & 31, h = lane >> 5;
    PG8_LAS bf16_t* AT = (PG8_LAS bf16_t*)(lds + LR_A0);
    PG8_LAS float* P = (PG8_LAS float*)(lds + LR_P);
#pragma unroll
    for (int i = 0; i < 8; ++i) { const int idx = tid + i * NTH; *(PG8_LAS u32x4*)(AT + (idx >> 7) * 1032 + (idx & 127) * 8) = r.v[i]; }
    __syncthreads();
    const bf16_t* Bt = (const bf16_t*)(ws + (which ? NB_A1T : NB_W1T));
    f32x16 acc0, acc1;
#pragma unroll
    for (int i = 0; i < 16; ++i) { acc0[i] = 0.f; acc1[i] = 0.f; }
#pragma unroll
    for (int s = 0; s < 8; ++s) {
        const int k = wv * 128 + s * 16 + h * 8;
        const bf16x8 av = *(const PG8_LAS bf16x8*)(AT + lr * 1032 + k);
        const bf16x8 b0 = *(const bf16x8*)(Bt + ((size_t)(wv * 8 + s) * 64 + lane) * 8), b1 = *(const bf16x8*)(Bt + ((size_t)(64 + wv * 8 + s) * 64 + lane) * 8);
        acc0 = __builtin_amdgcn_mfma_f32_32x32x16_bf16(av, b0, acc0, 0, 0, 0);
        acc1 = __builtin_amdgcn_mfma_f32_32x32x16_bf16(av, b1, acc1, 0, 0, 0);
    }
#pragma unroll
    for (int q = 0; q < 4; ++q) {
        *(PG8_LAS f32x4*)(P + (wv * 64 + lane) * 32 + q * 4) = (f32x4){acc0[4 * q], acc0[4 * q + 1], acc0[4 * q + 2], acc0[4 * q + 3]};
        *(PG8_LAS f32x4*)(P + (wv * 64 + lane) * 32 + 16 + q * 4) = (f32x4){acc1[4 * q], acc1[4 * q + 1], acc1[4 * q + 2], acc1[4 * q + 3]};
    }
    __syncthreads();
    if (wv < 2) {
        float sum[16];
#pragma unroll
        for (int i = 0; i < 16; ++i) sum[i] = 0.f;
#pragma unroll
        for (int w = 0; w < 8; ++w)
#pragma unroll
            for (int q = 0; q < 4; ++q) { const f32x4 v = *(const PG8_LAS f32x4*)(P + (w * 64 + lane) * 32 + wv * 16 + q * 4); sum[4 * q] += v[0]; sum[4 * q + 1] += v[1]; sum[4 * q + 2] += v[2]; sum[4 * q + 3] += v[3]; }
        bf16_t* dst = (bf16_t*)(ws + (which ? NB_AWB : NB_TWB)) + (size_t)rt * 32 * 64 + wv * 32 + lr;
#pragma unroll
        for (int i = 0; i < 16; ++i) { const int row = (i & 3) + 8 * (i >> 2) + 4 * h; const float v = which ? sum[i] : tanhf(sum[i]); dst[(size_t)row * 64] = (bf16_t)(pk_bf16c(v, 0.f) & 0xffffu); }
    }
    __syncthreads();
}

__device__ __forceinline__ float dpp_red16f(float v) {
    v += __builtin_bit_cast(float, __builtin_amdgcn_update_dpp(0, __builtin_bit_cast(int, v), 0xB1, 0xF, 0xF, true));
    v += __builtin_bit_cast(float, __builtin_amdgcn_update_dpp(0, __builtin_bit_cast(int, v), 0x4E, 0xF, 0xF, true));
    v += __builtin_bit_cast(float, __builtin_amdgcn_update_dpp(0, __builtin_bit_cast(int, v), 0x141, 0xF, 0xF, true));
    v += __builtin_bit_cast(float, __builtin_amdgcn_update_dpp(0, __builtin_bit_cast(int, v), 0x140, 0xF, 0xF, true));
    return v;
}
__device__ __forceinline__ void prep2_task(const Args& a, unsigned char* ws, int rt, int hd, int lane) {
    const int lr = lane & 31, h2 = lane >> 5;
    const size_t row0 = (size_t)rt * 32;
    const bf16_t* W2T = (const bf16_t*)(ws + NB_W2T); const bf16_t* A2T = (const bf16_t*)(ws + NB_A2T);
    const bf16_t* TWB = (const bf16_t*)(ws + NB_TWB); const bf16_t* AWB = (const bf16_t*)(ws + NB_AWB);
    f32x16 aw[2], aa[2];
#pragma unroll
    for (int ct = 0; ct < 2; ++ct)
#pragma unroll
        for (int i = 0; i < 16; ++i) { aw[ct][i] = 0.f; aa[ct][i] = 0.f; }
#pragma unroll
    for (int s = 0; s < 4; ++s) {
        const bf16x8 at = *(const bf16x8*)(TWB + (row0 + lr) * 64 + s * 16 + h2 * 8), aa_ = *(const bf16x8*)(AWB + (row0 + lr) * 64 + s * 16 + h2 * 8);
#pragma unroll
        for (int ct = 0; ct < 2; ++ct) {
            const size_t e = (size_t)hd * 64 + ct * 32 + lr;
            const bf16x8 w2 = *(const bf16x8*)(W2T + e * 64 + s * 16 + h2 * 8), a2 = *(const bf16x8*)(A2T + e * 64 + s * 16 + h2 * 8);
            aw[ct] = __builtin_amdgcn_mfma_f32_32x32x16_bf16(at, w2, aw[ct], 0, 0, 0);
            aa[ct] = __builtin_amdgcn_mfma_f32_32x32x16_bf16(aa_, a2, aa[ct], 0, 0, 0);
        }
    }
    const bf16_t* KB = (const bf16_t*)(ws + NB_RKVZ) + (size_t)1 * XSH_ROWS * 1024;
    const bf16_t* RB = (const bf16_t*)(ws + NB_RKVZ);
    float* DEC = (float*)(ws + NB_DEC);
    bf16_t* KKN = (bf16_t*)(ws + NB_KKN); bf16_t* KKA = (bf16_t*)(ws + NB_KKA); bf16_t* KP = (bf16_t*)(ws + NB_KP);
    float w0v[2], a0v[2], kkp[2], kap[2], rkp[2];
#pragma unroll
    for (int ct = 0; ct < 2; ++ct) { const int e = hd * 64 + ct * 32 + lr; w0v[ct] = a.in[I_W0][e]; a0v[ct] = a.in[I_A0][e]; kkp[ct] = a.in[I_KK][e]; kap[ct] = a.in[I_KA][e]; rkp[ct] = a.in[I_RK][e]; }
    float n2[16], rk[16];
#pragma unroll
    for (int i = 0; i < 16; ++i) { n2[i] = 0.f; rk[i] = 0.f; }
#pragma unroll
    for (int ct = 0; ct < 2; ++ct)
#pragma unroll
        for (int i = 0; i < 16; ++i) {
            const size_t off = (row0 + (i & 3) + 8 * (i >> 2) + 4 * h2) * 1024 + hd * 64 + ct * 32 + lr;
            const float kf = bf2f(KB[off]), rf = bf2f(RB[off]);
            const float wl = w0v[ct] + aw[ct][i];
            const float sp = fmaxf(-wl, 0.f) + log1pf(__expf(-fabsf(wl)));
            DEC[off] = __expf(-__expf(-sp - 0.5f));
            const float av_ = sigm_f(a0v[ct] + aa[ct][i]);
            const float kk = kf * kkp[ct];
            const float kp = kf * (1.f + (av_ - 1.f) * kap[ct]);
            KP[off] = (bf16_t)(pk_bf16(kp, 0.f) & 0xffffu);
            aw[ct][i] = kk; aa[ct][i] = av_;
            n2[i] = fmaf(kk, kk, n2[i]);
            rk[i] = fmaf(rf * kp, rkp[ct], rk[i]);
        }
#pragma unroll
    for (int i = 0; i < 16; ++i) {
        float v = dpp_red16f(n2[i]); v += __shfl_xor(v, 16); n2[i] = 1.f / fmaxf(sqrtf(v), 1e-12f);
        float w = dpp_red16f(rk[i]); w += __shfl_xor(w, 16); rk[i] = w;
    }
#pragma unroll
    for (int ct = 0; ct < 2; ++ct)
#pragma unroll
        for (int i = 0; i < 16; ++i) {
            const size_t off = (row0 + (i & 3) + 8 * (i >> 2) + 4 * h2) * 1024 + hd * 64 + ct * 32 + lr;
            const float kn = aw[ct][i] * n2[i];
            KKN[off] = (bf16_t)(pk_bf16(kn, 0.f) & 0xffffu);
            KKA[off] = (bf16_t)(pk_bf16(kn * aa[ct][i], 0.f) & 0xffffu);
        }
    if (lr == 0) {
#pragma unroll
        for (int i = 0; i < 16; ++i) ((float*)(ws + NB_RKS))[(row0 + (i & 3) + 8 * (i >> 2) + 4 * h2) * 16 + hd] = rk[i];
    }
}

constexpr int SC_BUF = 53248;
__device__ __forceinline__ float dpp_red16(float v) {
    v += __builtin_bit_cast(float, __builtin_amdgcn_update_dpp(0, __builtin_bit_cast(int, v), 0xB1, 0xF, 0xF, true));
    v += __builtin_bit_cast(float, __builtin_amdgcn_update_dpp(0, __builtin_bit_cast(int, v), 0x4E, 0xF, 0xF, true));
    v += __builtin_bit_cast(float, __builtin_amdgcn_update_dpp(0, __builtin_bit_cast(int, v), 0x141, 0xF, 0xF, true));
    v += __builtin_bit_cast(float, __builtin_amdgcn_update_dpp(0, __builtin_bit_cast(int, v), 0x140, 0xF, 0xF, true));
    return v;
}
struct ScanRegs { u32x4 d0, d1, kn, ka, kp, r, v; };
__device__ __forceinline__ void scan_issue(unsigned char* ws, int b, int hd, int vh, int chunk, int tid, ScanRegs& g) {
    const int tt = tid >> 3, part = tid & 7;
    const size_t row = (size_t)b * TP + chunk * 64 + tt;
    const size_t off = row * 1024 + hd * 64 + part * 8;
    const float* dp = (const float*)(ws + NB_DEC) + off;
    g.d0 = *(const u32x4*)dp; g.d1 = *(const u32x4*)(dp + 4);
    g.kn = *(const u32x4*)((const bf16_t*)(ws + NB_KKN) + off);
    g.ka = *(const u32x4*)((const bf16_t*)(ws + NB_KKA) + off);
    g.kp = *(const u32x4*)((const bf16_t*)(ws + NB_KP) + off);
    g.r = *(const u32x4*)((const bf16_t*)(ws + NB_RKVZ) + ((size_t)0 * XSH_ROWS + row) * 1024 + hd * 64 + part * 8);
    if (part < 4) g.v = *(const u32x4*)((const bf16_t*)(ws + NB_RKVZ) + ((size_t)2 * XSH_ROWS + row) * 1024 + hd * 64 + vh * 32 + part * 8);
}
__device__ __forceinline__ void scan_write(PG8_LAS unsigned char* buf, int tid, const ScanRegs& g) {
    const int tt = tid >> 3, part = tid & 7;
    *(PG8_LAS u32x4*)(buf + tt * 256 + part * 32) = g.d0; *(PG8_LAS u32x4*)(buf + tt * 256 + part * 32 + 16) = g.d1;
    *(PG8_LAS u32x4*)(buf + 16384 + tt * 128 + part * 16) = g.kn;
    *(PG8_LAS u32x4*)(buf + 24576 + tt * 128 + part * 16) = g.ka;
    *(PG8_LAS u32x4*)(buf + 32768 + tt * 128 + part * 16) = g.kp;
    *(PG8_LAS u32x4*)(buf + 40960 + tt * 128 + part * 16) = g.r;
    if (part < 4) *(PG8_LAS u32x4*)(buf + 49152 + tt * 64 + part * 16) = g.v;
}
__device__ __forceinline__ void scan_prompt(const Args& a, unsigned char* ws, PG8_LAS unsigned char* lds, int item) {
    const int tid = opaque_v(threadIdx.x);
    const int b = item >> 5, hd = (item >> 1) & 15, vh = item & 1;
    const int vl = tid >> 4, kq = tid & 15;
    typedef unsigned u32x2 __attribute__((ext_vector_type(2)));
    float S[4] = {0.f, 0.f, 0.f, 0.f};
    ScanRegs g;
    PG8_LAS float* YS = (PG8_LAS float*)(lds + 2 * SC_BUF);
    scan_issue(ws, b, hd, vh, 0, tid, g); scan_write(lds, tid, g);
    __syncthreads();
    for (int c = 0; c < TP / 64; ++c) {
        PG8_LAS unsigned char* buf = lds + (c & 1) * SC_BUF;
        if (c + 1 < TP / 64) scan_issue(ws, b, hd, vh, c + 1, tid, g);
#pragma unroll 4
        for (int tt = 0; tt < 64; ++tt) {
            const f32x4 w = *(const PG8_LAS f32x4*)(buf + tt * 256 + kq * 16);
            const u32x2 knw = *(const PG8_LAS u32x2*)(buf + 16384 + tt * 128 + kq * 8), kaw = *(const PG8_LAS u32x2*)(buf + 24576 + tt * 128 + kq * 8),
                        kpw = *(const PG8_LAS u32x2*)(buf + 32768 + tt * 128 + kq * 8), rw = *(const PG8_LAS u32x2*)(buf + 40960 + tt * 128 + kq * 8);
            const float vv = bf2f(*(const PG8_LAS bf16_t*)(buf + 49152 + tt * 64 + vl * 2));
            const float kn[4] = {__uint_as_float(knw.x << 16), __uint_as_float(knw.x & 0xffff0000u), __uint_as_float(knw.y << 16), __uint_as_float(knw.y & 0xffff0000u)};
            const float ka[4] = {__uint_as_float(kaw.x << 16), __uint_as_float(kaw.x & 0xffff0000u), __uint_as_float(kaw.y << 16), __uint_as_float(kaw.y & 0xffff0000u)};
            const float kp[4] = {__uint_as_float(kpw.x << 16), __uint_as_float(kpw.x & 0xffff0000u), __uint_as_float(kpw.y << 16), __uint_as_float(kpw.y & 0xffff0000u)};
            const float rr[4] = {__uint_as_float(rw.x << 16), __uint_as_float(rw.x & 0xffff0000u), __uint_as_float(rw.y << 16), __uint_as_float(rw.y & 0xffff0000u)};
            float sa = S[0] * kn[0];
            sa = fmaf(S[1], kn[1], sa); sa = fmaf(S[2], kn[2], sa); sa = fmaf(S[3], kn[3], sa);
            sa = dpp_red16(sa);
            float y = 0.f;
#pragma unroll
            for (int i = 0; i < 4; ++i) { S[i] = fmaf(S[i], w[i], fmaf(vv, kp[i], -sa * ka[i])); y = fmaf(S[i], rr[i], y); }
            y = dpp_red16(y);
            if (kq == 0) YS[tt * 32 + vl] = y;
        }
        if (c + 1 < TP / 64) scan_write(lds + ((c + 1) & 1) * SC_BUF, tid, g);
        __syncthreads();
        {
            float* Y = (float*)(ws + NB_Y);
            for (int i = tid; i < 64 * 32; i += NTH) { const int tt = i >> 5, v = i & 31; Y[((size_t)b * TP + c * 64 + tt) * 1024 + hd * 64 + vh * 32 + v] = YS[i]; }
        }
        __syncthreads();
    }
    float* so = a.out + O_WKVP + ((size_t)(b * 16 + hd) * 64 + vh * 32 + vl) * 64 + kq * 4;
    *(float4*)so = make_float4(S[0], S[1], S[2], S[3]);
}
__device__ __forceinline__ void scan_sample(const Args& a, unsigned char* ws, int s, int hd, int lane) {
    const size_t row = (size_t)MP + s;
    const float* s0 = a.in[I_SWKV] + ((size_t)(s * 16 + hd) * 64 + lane) * 64;
    float* sout = a.out + O_WKVS + ((size_t)(s * 16 + hd) * 64 + lane) * 64;
    const int e = hd * 64 + lane;
    const float twl = bf2f(((const bf16_t*)(ws + NB_TWB) + row * 64)[lane]), awl = bf2f(((const bf16_t*)(ws + NB_AWB) + row * 64)[lane]);
    const bf16_t* w2r = (const bf16_t*)(ws + NB_W2T) + (size_t)e * 64; const bf16_t* a2r = (const bf16_t*)(ws + NB_A2T) + (size_t)e * 64;
    float wl = a.in[I_W0][e], al = a.in[I_A0][e];
#define RL(X, K) __builtin_bit_cast(float, __builtin_amdgcn_readlane(__builtin_bit_cast(int, X), K))
#pragma unroll
    for (int j8 = 0; j8 < 8; ++j8) {
        const u32x4 wq = *(const u32x4*)(w2r + j8 * 8), aq = *(const u32x4*)(a2r + j8 * 8);
#pragma unroll
        for (int i = 0; i < 8; ++i) {
            const float wv_ = __uint_as_float((i & 1) ? (wq[i >> 1] & 0xffff0000u) : (wq[i >> 1] << 16)), av_ = __uint_as_float((i & 1) ? (aq[i >> 1] & 0xffff0000u) : (aq[i >> 1] << 16));
            wl = fmaf(RL(twl, j8 * 8 + i), wv_, wl); al = fmaf(RL(awl, j8 * 8 + i), av_, al);
        }
    }
    const float decl = __expf(-0.60653066f * sigm_f(wl));
    const float aa_ = sigm_f(al);
    const float kf = bf2f(((const bf16_t*)(ws + NB_RKVZ) + ((size_t)1 * XSH_ROWS + row) * 1024)[e]);
    const float rl = bf2f(((const bf16_t*)(ws + NB_RKVZ) + ((size_t)0 * XSH_ROWS + row) * 1024)[e]);
    const float vv = bf2f(((const bf16_t*)(ws + NB_RKVZ) + ((size_t)2 * XSH_ROWS + row) * 1024)[e]);
    const float kkr = kf * a.in[I_KK][e];
    const float kpl = kf * (1.f + (aa_ - 1.f) * a.in[I_KA][e]);
    const float knl = kkr / fmaxf(sqrtf(wave_sum(kkr * kkr)), 1e-12f);
    const float kal = knl * aa_;
    const float rkv = wave_sum(rl * kpl * a.in[I_RK][e]);
    float S[64];
#pragma unroll
    for (int q = 0; q < 16; ++q) { const float4 v4 = *(const float4*)(s0 + q * 4); S[4 * q] = v4.x; S[4 * q + 1] = v4.y; S[4 * q + 2] = v4.z; S[4 * q + 3] = v4.w; }
    float sa = 0.f;
#pragma unroll
    for (int k = 0; k < 64; ++k) sa = fmaf(S[k], RL(knl, k), sa);
    float y = 0.f;
#pragma unroll
    for (int k = 0; k < 64; ++k) { S[k] = fmaf(S[k], RL(decl, k), fmaf(vv, RL(kpl, k), -sa * RL(kal, k))); y = fmaf(S[k], RL(rl, k), y); }
#undef RL
#pragma unroll
    for (int q = 0; q < 16; ++q) *(float4*)(sout + q * 4) = make_float4(S[4 * q], S[4 * q + 1], S[4 * q + 2], S[4 * q + 3]);
    {
        const float mean = wave_sum(y) * (1.f / 64.f);
        const float d = y - mean;
        const float rs = rsqrtf(wave_sum(d * d) * (1.f / 64.f) + GN_EPS);
        const float zf = bf2f(((const bf16_t*)(ws + NB_RKVZ) + ((size_t)3 * XSH_ROWS + row) * 1024)[e]);
        const float o = fmaf(rkv, vv, d * rs * a.in[I_GNG][e] + a.in[I_GNB][e]) * silu_f(zf);
        ((bf16_t*)(ws + NB_G4B))[row * 1024 + e] = (bf16_t)(pk_bf16c(o, 0.f) & 0xffffu);
    }
}

constexpr int CS_LD = 72;
constexpr int CS_SLOT = 64 * CS_LD * 2;
constexpr int CS_F32A = 13 * CS_SLOT;
constexpr int CS_F32B = CS_F32A + 16384;
constexpr int CS_GS = CS_F32B + 16384;
constexpr int CS_END = CS_GS + 4096;
constexpr size_t CK_MCT = 0, CK_RY = 8192, CK_SADD = 16384, CK_Y0 = 24576, CK_BYTES = 32768;

__device__ __forceinline__ PG8_LAS bf16_t* cs_slot(PG8_LAS unsigned char* lds, int i) { return (PG8_LAS bf16_t*)(lds + i * CS_SLOT); }
template <bool SWX = false, bool SWY = false>
__device__ __forceinline__ void cs_mm(f32x16& acc, const PG8_LAS bf16_t* X, const PG8_LAS bf16_t* Yt, int mt, int nt, int lane) {
    const int lr = lane & 31, h = lane >> 5;
    const int rx = mt * 32 + lr, ry = nt * 32 + lr;
    const int sx = SWX ? ((rx >> 3) & 7) : 0, sy = SWY ? ((ry >> 3) & 7) : 0;
#pragma unroll
    for (int s = 0; s < 4; ++s) {
        const bf16x8 av = *(const PG8_LAS bf16x8*)(X + rx * CS_LD + (((2 * s + h) ^ sx) << 3));
        const bf16x8 bv = *(const PG8_LAS bf16x8*)(Yt + ry * CS_LD + (((2 * s + h) ^ sy) << 3));
        acc = __builtin_amdgcn_mfma_f32_32x32x16_bf16(av, bv, acc, 0, 0, 0);
    }
}
__device__ __forceinline__ void cs_store_t(const f32x16& acc, PG8_LAS bf16_t* D, int mt, int nt, int lane) {
    typedef unsigned u32x2 __attribute__((ext_vector_type(2)));
    const int lr = lane & 31, h = lane >> 5;
#pragma unroll
    for (int c = 0; c < 4; ++c) { u32x2 w; w.x = pk_bf16c(acc[4 * c], acc[4 * c + 1]); w.y = pk_bf16c(acc[4 * c + 2], acc[4 * c + 3]);
        *(PG8_LAS u32x2*)(D + (nt * 32 + lr) * CS_LD + mt * 32 + 8 * c + 4 * h) = w; }
}
__device__ __forceinline__ void cs_store_n(const f32x16& acc, PG8_LAS bf16_t* D, int mt, int nt, int lane) {
    const int lr = lane & 31, h = lane >> 5;
#pragma unroll
    for (int i = 0; i < 16; ++i) D[(mt * 32 + (i & 3) + 8 * (i >> 2) + 4 * h) * CS_LD + nt * 32 + lr] = (bf16_t)(pk_bf16c(acc[i], 0.f) & 0xffffu);
}
__device__ __forceinline__ void cs_zero(f32x16& a) {
#pragma unroll
    for (int i = 0; i < 16; ++i) a[i] = 0.f;
}
__device__ __forceinline__ float dpp_red8(float v) {
    v += __builtin_bit_cast(float, __builtin_amdgcn_update_dpp(0, __builtin_bit_cast(int, v), 0xB1, 0xF, 0xF, true));
    v += __builtin_bit_cast(float, __builtin_amdgcn_update_dpp(0, __builtin_bit_cast(int, v), 0x4E, 0xF, 0xF, true));
    v += __builtin_bit_cast(float, __builtin_amdgcn_update_dpp(0, __builtin_bit_cast(int, v), 0x141, 0xF, 0xF, true));
    return v;
}

struct PreRegs { u32x4 kv, rv, vv; bf16x8 af[4]; };
__device__ __forceinline__ void scanpre_load(unsigned char* ws, int b, int hd, int c, int tid, PreRegs& r) {
    const int lane = tid & 63, wv = tid >> 6, lr = lane & 31, h = lane >> 5;
    const size_t row0 = (size_t)b * TP + c * 64;
    const int tok = tid >> 3, c8 = tid & 7;
    const size_t off = (row0 + tok) * 1024 + hd * 64 + c8 * 8;
    const bf16_t* RK = (const bf16_t*)(ws + NB_RKVZ);
    r.kv = *(const u32x4*)(RK + (size_t)1 * XSH_ROWS * 1024 + off); r.rv = *(const u32x4*)(RK + off); r.vv = *(const u32x4*)(RK + (size_t)2 * XSH_ROWS * 1024 + off);
    const int which = wv >> 2, mt = (wv >> 1) & 1;
    const bf16_t* A = (const bf16_t*)(ws + (which ? NB_AWB : NB_TWB)) + (row0 + mt * 32 + lr) * 64 + h * 8;
#pragma unroll
    for (int s = 0; s < 4; ++s) r.af[s] = *(const bf16x8*)(A + s * 16);
}
__device__ __forceinline__ void scanpre_chunk(const Args& a, unsigned char* ws, PG8_LAS unsigned char* lds, int b, int hd, int c, const PreRegs& pre, const bf16x8 (&btf)[4]) {
    const int tid = opaque_v(threadIdx.x), lane = tid & 63, wv = __builtin_amdgcn_readfirstlane(tid >> 6);
    const int lr = lane & 31, h = lane >> 5;
    const size_t row0 = (size_t)b * TP + c * 64;
    typedef unsigned u32x2 __attribute__((ext_vector_type(2)));
    PG8_LAS float* LCUM = (PG8_LAS float*)(lds + CS_F32A);
    PG8_LAS float* AV = (PG8_LAS float*)(lds + CS_F32B);
    PG8_LAS float* GS = (PG8_LAS float*)(lds + CS_GS);
    unsigned char* rec = ws + NB_CHK + ((size_t)(b * 16 + hd) * 32 + c) * CK_BYTES;
    {
        const int tok = tid >> 3, c8 = tid & 7;
        *(PG8_LAS u32x4*)(cs_slot(lds, 0) + tok * CS_LD + c8 * 8) = pre.kv;
        *(PG8_LAS u32x4*)(cs_slot(lds, 1) + tok * CS_LD + c8 * 8) = pre.rv;
        *(PG8_LAS u32x4*)(cs_slot(lds, 2) + tok * CS_LD + c8 * 8) = pre.vv;
    }
    {
        const int which = wv >> 2, mt = (wv >> 1) & 1, nt = wv & 1;
        f32x16 acc; cs_zero(acc);
#pragma unroll
        for (int s = 0; s < 4; ++s) acc = __builtin_amdgcn_mfma_f32_32x32x16_bf16(pre.af[s], btf[s], acc, 0, 0, 0);
        PG8_LAS float* D = which ? AV : LCUM;
        const float bias = a.in[which ? I_A0 : I_W0][hd * 64 + nt * 32 + lr];
#pragma unroll
        for (int i = 0; i < 16; ++i) {
            const float x = acc[i] + bias;
            float y;
            if (which) y = sigm_f(x);
            else y = -0.87503504f * sigm_f(x);
            D[(mt * 32 + (i & 3) + 8 * (i >> 2) + 4 * h) * 64 + nt * 32 + lr] = y;
        }
    }
    lds_barrier();
    {
        const int ch = tid & 63, tg = tid >> 6;
        float p[8]; float run = 0.f;
#pragma unroll
        for (int i = 0; i < 8; ++i) { run += LCUM[(tg * 8 + i) * 64 + ch]; p[i] = run; }
        GS[tg * 64 + ch] = run;
        lds_barrier();
        float offs = 0.f;
        for (int g = 0; g < tg; ++g) offs += GS[g * 64 + ch];
#pragma unroll
        for (int i = 0; i < 8; ++i) LCUM[(tg * 8 + i) * 64 + ch] = p[i] + offs;
    }
    lds_barrier();
    {
        const int tok = tid >> 3, c8 = tid & 7;
        const u32x4 kw = *(const PG8_LAS u32x4*)(cs_slot(lds, 0) + tok * CS_LD + c8 * 8), rw = *(const PG8_LAS u32x4*)(cs_slot(lds, 1) + tok * CS_LD + c8 * 8),
                    vw = *(const PG8_LAS u32x4*)(cs_slot(lds, 2) + tok * CS_LD + c8 * 8);
        float kf[8], rf[8], kk[8], kp[8], av[8];
        float n2 = 0.f, rk = 0.f;
#pragma unroll
        for (int i = 0; i < 8; ++i) {
            const int e = hd * 64 + c8 * 8 + i;
            kf[i] = __uint_as_float((i & 1) ? (kw[i >> 1] & 0xffff0000u) : (kw[i >> 1] << 16));
            rf[i] = __uint_as_float((i & 1) ? (rw[i >> 1] & 0xffff0000u) : (rw[i >> 1] << 16));
            av[i] = AV[tok * 64 + c8 * 8 + i];
            kk[i] = kf[i] * a.in[I_KK][e];
            kp[i] = kf[i] * (1.f + (av[i] - 1.f) * a.in[I_KA][e]);
            n2 = fmaf(kk[i], kk[i], n2);
            rk = fmaf(rf[i] * kp[i], a.in[I_RK][e], rk);
        }
        n2 = dpp_red8(n2); rk = dpp_red8(rk);
        const float inv = 1.f / fmaxf(sqrtf(n2), 1e-12f);
        if (c8 == 0) ((float*)(ws + NB_RKS))[(row0 + tok) * 16 + hd] = rk;
        if (tok == 63) {
#pragma unroll
            for (int i = 0; i < 8; ++i) GS[512 + c8 * 8 + i] = __builtin_amdgcn_exp2f(LCUM[63 * 64 + c8 * 8 + i]);
        }
        float qt[8], rt[8], kt[8], bt[8], kh[8], bh[8];
#pragma unroll
        for (int i = 0; i < 8; ++i) {
            const int ch = c8 * 8 + i;
            const float Lt = LCUM[tok * 64 + ch], Lp = tok ? LCUM[(tok - 1) * 64 + ch] : 0.f, Lc = LCUM[63 * 64 + ch];
            const float kn = kk[i] * inv, ka = kn * av[i];
            const float en = __builtin_amdgcn_exp2f(-Lt), ec = __builtin_amdgcn_exp2f(Lc - Lt);
            qt[i] = kn * __builtin_amdgcn_exp2f(Lp); rt[i] = rf[i] * __builtin_amdgcn_exp2f(Lt); kt[i] = kp[i] * en; bt[i] = ka * en; kh[i] = kp[i] * ec; bh[i] = ka * ec;
        }
#define CS_PUT_ROW(SLOT, ARR) { u32x4 w_; w_.x = pk_bf16c(ARR[0], ARR[1]); w_.y = pk_bf16c(ARR[2], ARR[3]); w_.z = pk_bf16c(ARR[4], ARR[5]); w_.w = pk_bf16c(ARR[6], ARR[7]); \
            *(PG8_LAS u32x4*)(cs_slot(lds, SLOT) + tok * CS_LD + c8 * 8) = w_; }
#define CS_PUT_COL(SLOT, ARR) { _Pragma("unroll") for (int i_ = 0; i_ < 8; ++i_) cs_slot(lds, SLOT)[(c8 * 8 + i_) * CS_LD + tsw] = (bf16_t)(pk_bf16c(ARR[i_], 0.f) & 0xffffu); }
        const int tsw = ((((tok >> 3) ^ c8) & 7) << 3) | (tok & 7);
        CS_PUT_ROW(3, qt) CS_PUT_ROW(4, rt) CS_PUT_ROW(5, kt) CS_PUT_ROW(6, bt)
        CS_PUT_COL(7, qt) CS_PUT_COL(8, bh) CS_PUT_COL(9, kh)
#pragma unroll
        for (int i = 0; i < 8; ++i) cs_slot(lds, 10)[(c8 * 8 + i) * CS_LD + tsw] = (bf16_t)((i & 1) ? (vw[i >> 1] >> 16) : (vw[i >> 1] & 0xffffu));
#undef CS_PUT_ROW
#undef CS_PUT_COL
    }
    lds_barrier();
    {
#pragma unroll 1
        for (int j = 0; j < 2; ++j) {
            const int job = wv * 2 + j, prod = job >> 2, mt = (job >> 1) & 1, nt = job & 1;
            const PG8_LAS bf16_t* X = cs_slot(lds, (prod & 1) ? 6 : 5);
            const PG8_LAS bf16_t* Y = cs_slot(lds, (prod & 2) ? 4 : 3);
            f32x16 acc; cs_zero(acc);
            cs_mm(acc, X, Y, mt, nt, lane);
            const int t = nt * 32 + lr, incl = (prod & 2) ? 1 : 0;
#pragma unroll
            for (int i = 0; i < 16; ++i) { const int sidx = mt * 32 + (i & 3) + 8 * (i >> 2) + 4 * h; acc[i] = (sidx < t + incl) ? acc[i] : 0.f; }
            const int dst = (prod == 0) ? 0 : (prod == 1) ? 11 : (prod == 2) ? 1 : 2;
            cs_store_t(acc, cs_slot(lds, dst), mt, nt, lane);
            if (prod == 1) cs_store_n(acc, cs_slot(lds, 12), mt, nt, lane);
        }
    }
    lds_barrier();
    {
        const int mt = (wv >> 1) & 1, nt = wv & 1;
        f32x16 pacc;
        if (wv < 4) {
#pragma unroll
            for (int i = 0; i < 16; ++i) { const int u = mt * 32 + (i & 3) + 8 * (i >> 2) + 4 * h, t = nt * 32 + lr;
                pacc[i] = ((u == t) ? 1.f : 0.f) - bf2f(cs_slot(lds, 12)[u * CS_LD + t]); }
            cs_store_t(pacc, cs_slot(lds, 3), mt, nt, lane);
        }
        lds_barrier();
        const int mcur = 11, mtcur = 12, mnxt = 5, mtnxt = 6;
        PG8_LAS bf16_t* XS0 = (PG8_LAS bf16_t*)(lds + CS_F32A);
        PG8_LAS bf16_t* XS1 = (PG8_LAS bf16_t*)(lds + CS_F32A + CS_SLOT);
        PG8_LAS bf16_t* XS2 = (PG8_LAS bf16_t*)(lds + CS_F32A + 2 * CS_SLOT);
        PG8_LAS bf16_t* Pc = cs_slot(lds, 3); PG8_LAS bf16_t* Pn = XS0;
        PG8_LAS bf16_t* Mc_ = cs_slot(lds, mcur); PG8_LAS bf16_t* MTc = cs_slot(lds, mtcur);
        PG8_LAS bf16_t* Mn = cs_slot(lds, mnxt); PG8_LAS bf16_t* MTn = cs_slot(lds, mtnxt);
#pragma unroll 1
        for (int it = 0; it < 5; ++it) {
            if (wv >= 4) {
                f32x16 acc; cs_zero(acc);
                cs_mm(acc, Mc_, MTc, mt, nt, lane);
                cs_store_n(acc, Mn, mt, nt, lane);
                cs_store_t(acc, MTn, mt, nt, lane);
                float mx = 0.f;
#pragma unroll
                for (int i = 0; i < 16; ++i) mx = fmaxf(mx, fabsf(acc[i]));
#pragma unroll
                for (int o = 32; o > 0; o >>= 1) mx = fmaxf(mx, __shfl_xor(mx, o));
                if (lane == 0) GS[640 + (wv & 3)] = mx;
            }
            lds_barrier();
            const float m2max = fmaxf(fmaxf(GS[640], GS[641]), fmaxf(GS[642], GS[643]));
            if (wv < 4) {
                cs_mm(pacc, MTn, Pc, mt, nt, lane);
                cs_store_t(pacc, Pn, mt, nt, lane);
            }
            lds_barrier();
            { PG8_LAS bf16_t* t0 = Mc_; Mc_ = Mn; Mn = t0; t0 = MTc; MTc = MTn; MTn = t0; t0 = Pc; Pc = Pn; Pn = t0; }
            if (m2max < 3e-4f) break;
        }
        {
            f32x16 acc; cs_zero(acc);
            if (wv < 4) { cs_mm<false, true>(acc, cs_slot(lds, 0), cs_slot(lds, 10), mt, nt, lane); cs_store_t(acc, XS1, mt, nt, lane); }
            else { cs_mm<false, true>(acc, Pc, cs_slot(lds, 7), mt, nt, lane); cs_store_t(acc, XS2, mt, nt, lane); }
        }
        lds_barrier();
        if (wv < 4) { f32x16 acc; cs_zero(acc); cs_mm(acc, Pc, XS1, mt, nt, lane); cs_store_t(acc, cs_slot(lds, 11), mt, nt, lane); }
        lds_barrier();
        if (wv < 4) {
            f32x16 acc; cs_zero(acc);
            cs_mm<false, true>(acc, XS2, cs_slot(lds, 8), mt, nt, lane);
#pragma unroll
            for (int i = 0; i < 16; ++i) { const int k = mt * 32 + (i & 3) + 8 * (i >> 2) + 4 * h, kp_ = nt * 32 + lr; acc[i] = ((k == kp_) ? GS[512 + k] : 0.f) - acc[i]; }
            bf16_t* mct = (bf16_t*)(rec + CK_MCT);
#pragma unroll
            for (int cc = 0; cc < 4; ++cc) { u32x2 w; w.x = pk_bf16c(acc[4 * cc], acc[4 * cc + 1]); w.y = pk_bf16c(acc[4 * cc + 2], acc[4 * cc + 3]);
                *(u32x2*)(mct + ((nt * 4 + 2 * mt + (cc >> 1)) * 64 + lr + 32 * (cc & 1)) * 8 + 4 * h) = w; }
            f32x16 s1, s2; cs_zero(s1); cs_zero(s2);
            cs_mm<true, true>(s1, cs_slot(lds, 9), cs_slot(lds, 10), mt, nt, lane);
            cs_mm<true, false>(s2, cs_slot(lds, 8), cs_slot(lds, 11), mt, nt, lane);
            bf16_t* sd = (bf16_t*)(rec + CK_SADD) + ((size_t)(wv & 3) * 64 + lane) * 16;
#pragma unroll
            for (int q8 = 0; q8 < 2; ++q8) { u32x4 w;
                w.x = pk_bf16c(s1[8 * q8] - s2[8 * q8], s1[8 * q8 + 1] - s2[8 * q8 + 1]); w.y = pk_bf16c(s1[8 * q8 + 2] - s2[8 * q8 + 2], s1[8 * q8 + 3] - s2[8 * q8 + 3]);
                w.z = pk_bf16c(s1[8 * q8 + 4] - s2[8 * q8 + 4], s1[8 * q8 + 5] - s2[8 * q8 + 5]); w.w = pk_bf16c(s1[8 * q8 + 6] - s2[8 * q8 + 6], s1[8 * q8 + 7] - s2[8 * q8 + 7]);
                *(u32x4*)(sd + q8 * 8) = w; }
        } else {
            f32x16 acc; cs_zero(acc);
            cs_mm(acc, XS2, cs_slot(lds, 2), mt, nt, lane);
            bf16_t* ry = (bf16_t*)(rec + CK_RY);
#pragma unroll
            for (int cc = 0; cc < 4; ++cc) {
                const u32x2 rv = *(const PG8_LAS u32x2*)(cs_slot(lds, 4) + (nt * 32 + lr) * CS_LD + mt * 32 + 8 * cc + 4 * h);
                const float r0 = __uint_as_float(rv.x << 16), r1 = __uint_as_float(rv.x & 0xffff0000u), r2 = __uint_as_float(rv.y << 16), r3 = __uint_as_float(rv.y & 0xffff0000u);
                u32x2 w; w.x = pk_bf16c(r0 - acc[4 * cc], r1 - acc[4 * cc + 1]); w.y = pk_bf16c(r2 - acc[4 * cc + 2], r3 - acc[4 * cc + 3]);
                *(u32x2*)(ry + ((nt * 4 + 2 * mt + (cc >> 1)) * 64 + lr + 32 * (cc & 1)) * 8 + 4 * h) = w;
            }
            f32x16 s1, s2; cs_zero(s1); cs_zero(s2);
            cs_mm<false, true>(s1, cs_slot(lds, 1), cs_slot(lds, 10), mt, nt, lane);
            cs_mm(s2, cs_slot(lds, 2), cs_slot(lds, 11), mt, nt, lane);
            bf16_t* yd = (bf16_t*)(rec + CK_Y0) + ((size_t)(wv & 3) * 64 + lane) * 16;
#pragma unroll
            for (int q8 = 0; q8 < 2; ++q8) { u32x4 w;
                w.x = pk_bf16c(s1[8 * q8] - s2[8 * q8], s1[8 * q8 + 1] - s2[8 * q8 + 1]); w.y = pk_bf16c(s1[8 * q8 + 2] - s2[8 * q8 + 2], s1[8 * q8 + 3] - s2[8 * q8 + 3]);
                w.z = pk_bf16c(s1[8 * q8 + 4] - s2[8 * q8 + 4], s1[8 * q8 + 5] - s2[8 * q8 + 5]); w.w = pk_bf16c(s1[8 * q8 + 6] - s2[8 * q8 + 6], s1[8 * q8 + 7] - s2[8 * q8 + 7]);
                *(u32x4*)(yd + q8 * 8) = w; }
        }
    }
    lds_barrier();
}

struct SeqRegs { bf16x8 a[4]; u32x4 c[2]; };
__device__ __forceinline__ void seq_load(const unsigned char* rec, int wv, int mt, int lane, SeqRegs& r) {
    const bf16_t* ap = (const bf16_t*)(rec + CK_MCT) + ((size_t)mt * 4 * 64 + lane) * 8;
    const bf16_t* cp = (const bf16_t*)(rec + CK_SADD) + ((size_t)(wv & 3) * 64 + lane) * 16;
#pragma unroll
    for (int s = 0; s < 4; ++s) r.a[s] = *(const bf16x8*)(ap + s * 64 * 8);
    r.c[0] = *(const u32x4*)cp; r.c[1] = *(const u32x4*)(cp + 8);
}
__device__ __forceinline__ void scanseq_head(const Args& a, unsigned char* ws, PG8_LAS unsigned char* lds, int b, int hd) {
    const int tid = opaque_v(threadIdx.x), lane = tid & 63, wv = __builtin_amdgcn_readfirstlane(tid >> 6);
    const int lr = lane & 31, h = lane >> 5;
    const int mt = (wv >> 1) & 1, nt = wv & 1;
    const bool isS = wv < 4;
    PG8_LAS bf16_t* SB0 = cs_slot(lds, 0); PG8_LAS bf16_t* SB1 = cs_slot(lds, 1);
    f32x16 st; cs_zero(st);
    for (int i = tid; i < 64 * CS_LD; i += NTH) { SB0[i] = 0; }
    const unsigned char* rec0 = ws + NB_CHK + (size_t)(b * 16 + hd) * 32 * CK_BYTES;
    bf16_t* srec0 = (bf16_t*)(ws + NB_SREC) + (size_t)(b * 16 + hd) * 32 * 4096;
    const int cr = (tid & 255) >> 2, cc8 = (tid & 3) * 16;
    lds_barrier();
    if (isS) {
        SeqRegs r[4];
#pragma unroll
        for (int c = 0; c < 4; ++c) seq_load(rec0 + (size_t)c * CK_BYTES, wv, mt, lane, r[c]);
#pragma unroll
        for (int c = 0; c < 32; ++c) {
            const PG8_LAS bf16_t* S = (c & 1) ? SB1 : SB0;
            PG8_LAS bf16_t* Sn = (c & 1) ? SB0 : SB1;
            f32x16 acc;
#pragma unroll
            for (int i = 0; i < 16; ++i) { const unsigned w = r[c & 3].c[i >> 3][(i & 7) >> 1]; acc[i] = __uint_as_float((i & 1) ? (w & 0xffff0000u) : (w << 16)); }
#pragma unroll
            for (int s = 0; s < 4; ++s) {
                const bf16x8 bv = *(const PG8_LAS bf16x8*)(S + (nt * 32 + lr) * CS_LD + s * 16 + h * 8);
                acc = __builtin_amdgcn_mfma_f32_32x32x16_bf16(r[c & 3].a[s], bv, acc, 0, 0, 0);
            }
            st = acc; cs_store_t(st, Sn, mt, nt, lane);
            if (c + 4 < 32) seq_load(rec0 + (size_t)(c + 4) * CK_BYTES, wv, mt, lane, r[c & 3]);
            lds_barrier();
        }
    } else {
#pragma unroll 1
        for (int c = 0; c < 32; ++c) {
            const PG8_LAS bf16_t* S = (c & 1) ? SB1 : SB0;
            const u32x4 v0 = *(const PG8_LAS u32x4*)(S + cr * CS_LD + cc8), v1 = *(const PG8_LAS u32x4*)(S + cr * CS_LD + cc8 + 8);
            bf16_t* d = srec0 + (size_t)c * 4096 + cr * 64 + cc8;
            *(u32x4*)d = v0; *(u32x4*)(d + 8) = v1;
            lds_barrier();
        }
    }
    if (isS) {
        float* so = a.out + O_WKVP + ((size_t)(b * 16 + hd) * 64 + nt * 32 + lr) * 64 + mt * 32 + 4 * h;
#pragma unroll
        for (int cc = 0; cc < 4; ++cc) *(float4*)(so + 8 * cc) = make_float4(st[4 * cc], st[4 * cc + 1], st[4 * cc + 2], st[4 * cc + 3]);
    }
    lds_barrier();
}
struct YgRegs { bf16x8 a[4]; u32x4 c[2]; u32x4 s0, s1; u32x4 vw[2], zw[2]; float rk; };
__device__ __forceinline__ void yg_load(unsigned char* ws, int ci, int tid, YgRegs& r) {
    const int lane = tid & 63, wv = tid >> 6, t4 = tid & 255;
    const int mt = (wv >> 1) & 1;
    const unsigned char* rec = ws + NB_CHK + (size_t)ci * CK_BYTES;
    const bf16_t* ap = (const bf16_t*)(rec + CK_RY) + ((size_t)mt * 4 * 64 + lane) * 8;
    const bf16_t* cp = (const bf16_t*)(rec + CK_Y0) + ((size_t)(wv & 3) * 64 + lane) * 16;
#pragma unroll
    for (int s = 0; s < 4; ++s) r.a[s] = *(const bf16x8*)(ap + s * 64 * 8);
    r.c[0] = *(const u32x4*)cp; r.c[1] = *(const u32x4*)(cp + 8);
    const bf16_t* sp = (const bf16_t*)(ws + NB_SREC) + (size_t)ci * 4096 + (t4 >> 2) * 64 + (t4 & 3) * 16;
    r.s0 = *(const u32x4*)sp; r.s1 = *(const u32x4*)(sp + 8);
    const int bh = ci >> 5, c = ci & 31, b = bh >> 4, hd = bh & 15;
    const size_t prow = (size_t)b * TP + c * 64 + (t4 >> 2);
    const int pv = (t4 & 3) * 16;
    const bf16_t* vp = (const bf16_t*)(ws + NB_RKVZ) + ((size_t)2 * XSH_ROWS + prow) * 1024 + hd * 64 + pv;
    const bf16_t* zp = (const bf16_t*)(ws + NB_RKVZ) + ((size_t)3 * XSH_ROWS + prow) * 1024 + hd * 64 + pv;
    r.vw[0] = *(const u32x4*)vp; r.vw[1] = *(const u32x4*)(vp + 8); r.zw[0] = *(const u32x4*)zp; r.zw[1] = *(const u32x4*)(zp + 8);
    r.rk = ((const float*)(ws + NB_RKS))[prow * 16 + hd];
}
__device__ __forceinline__ void yg_step(const Args& a, unsigned char* ws, PG8_LAS unsigned char* lds, int ci, int tid, const YgRegs& r) {
    const int lane = tid & 63, wv = tid >> 6, t4 = tid & 255, grp = wv >> 2;
    const int lr = lane & 31, h = lane >> 5, mt = (wv >> 1) & 1, nt = wv & 1;
    PG8_LAS bf16_t* SL = cs_slot(lds, grp);
    PG8_LAS float* YT = (PG8_LAS float*)(lds + 2 * CS_SLOT) + grp * (64 * 68);
    *(PG8_LAS u32x4*)(SL + (t4 >> 2) * CS_LD + (t4 & 3) * 16) = r.s0; *(PG8_LAS u32x4*)(SL + (t4 >> 2) * CS_LD + (t4 & 3) * 16 + 8) = r.s1;
    lds_barrier();
    {
        f32x16 acc;
#pragma unroll
        for (int i = 0; i < 16; ++i) { const unsigned w = r.c[i >> 3][(i & 7) >> 1]; acc[i] = __uint_as_float((i & 1) ? (w & 0xffff0000u) : (w << 16)); }
#pragma unroll
        for (int s = 0; s < 4; ++s) {
            const bf16x8 bv = *(const PG8_LAS bf16x8*)(SL + (nt * 32 + lr) * CS_LD + s * 16 + h * 8);
            acc = __builtin_amdgcn_mfma_f32_32x32x16_bf16(r.a[s], bv, acc, 0, 0, 0);
        }
#pragma unroll
        for (int i = 0; i < 16; ++i) YT[(mt * 32 + (i & 3) + 8 * (i >> 2) + 4 * h) * 68 + nt * 32 + lr] = acc[i];
    }
    lds_barrier();
    {
        const int ptok = t4 >> 2, pv = (t4 & 3) * 16;
        const int bh = ci >> 5, c = ci & 31, b = bh >> 4, hd = bh & 15;
        float y[16];
#pragma unroll
        for (int q = 0; q < 4; ++q) { const f32x4 v = *(const PG8_LAS f32x4*)(YT + ptok * 68 + pv + q * 4); y[4 * q] = v[0]; y[4 * q + 1] = v[1]; y[4 * q + 2] = v[2]; y[4 * q + 3] = v[3]; }
        float sm = 0.f;
#pragma unroll
        for (int i = 0; i < 16; ++i) sm += y[i];
        sm += __builtin_bit_cast(float, __builtin_amdgcn_update_dpp(0, __builtin_bit_cast(int, sm), 0xB1, 0xF, 0xF, true));
        sm += __builtin_bit_cast(float, __builtin_amdgcn_update_dpp(0, __builtin_bit_cast(int, sm), 0x4E, 0xF, 0xF, true));
        const float mean = sm * (1.f / 64.f);
        float sq = 0.f;
#pragma unroll
        for (int i = 0; i < 16; ++i) { y[i] -= mean; sq += y[i] * y[i]; }
        sq += __builtin_bit_cast(float, __builtin_amdgcn_update_dpp(0, __builtin_bit_cast(int, sq), 0xB1, 0xF, 0xF, true));
        sq += __builtin_bit_cast(float, __builtin_amdgcn_update_dpp(0, __builtin_bit_cast(int, sq), 0x4E, 0xF, 0xF, true));
        const float rs = rsqrtf(sq * (1.f / 64.f) + GN_EPS);
        const float* gg = a.in[I_GNG] + hd * 64 + pv; const float* gb = a.in[I_GNB] + hd * 64 + pv;
        float o[16];
#pragma unroll
        for (int i = 0; i < 16; ++i) {
            const unsigned vw = r.vw[i >> 3][(i & 7) >> 1], zw = r.zw[i >> 3][(i & 7) >> 1];
            const float vf = __uint_as_float((i & 1) ? (vw & 0xffff0000u) : (vw << 16)), zf = __uint_as_float((i & 1) ? (zw & 0xffff0000u) : (zw << 16));
            o[i] = fmaf(r.rk, vf, y[i] * rs * gg[i] + gb[i]) * silu_f(zf);
        }
        bf16_t* dst = (bf16_t*)(ws + NB_G4B) + ((size_t)b * TP + c * 64 + ptok) * 1024 + hd * 64 + pv;
        u32x4 w0, w1;
        w0.x = pk_bf16c(o[0], o[1]); w0.y = pk_bf16c(o[2], o[3]); w0.z = pk_bf16c(o[4], o[5]); w0.w = pk_bf16c(o[6], o[7]);
        w1.x = pk_bf16c(o[8], o[9]); w1.y = pk_bf16c(o[10], o[11]); w1.z = pk_bf16c(o[12], o[13]); w1.w = pk_bf16c(o[14], o[15]);
        *(u32x4*)dst = w0; *(u32x4*)(dst + 8) = w1;
    }
}
__device__ __forceinline__ void phase_ygate(const Args& a, unsigned char* ws, PG8_LAS unsigned char* lds, int bid, int nb) {
    const int tid = opaque_v(threadIdx.x), grp = tid >> 8;
    YgRegs cur, nxt;
    int pair = bid;
    if (pair < 2048) yg_load(ws, 2 * pair + grp, tid, nxt);
#pragma unroll 1
    while (pair < 2048) {
        cur = nxt;
        const int npair = pair + nb;
        if (npair < 2048) yg_load(ws, 2 * npair + grp, tid, nxt);
        yg_step(a, ws, lds, 2 * pair + grp, tid, cur);
        pair = npair;
    }
    lds_barrier();
}

__device__ __forceinline__ void phase_lnf(const Args& a, unsigned char* ws, int bid, int nb) {
    const int tid = opaque_v(threadIdx.x), lane = tid & 63, wv = tid >> 6;
    const float* PRE = (const float*)ws + WS_PRE;
    const bf16_t* P2 = (const bf16_t*)(ws + NB_Y);
    float x[16], nx[16], y[16]; uint2 ny[4];
    float g0[16], b0[16], g1[16], b1[16];
    ld_row16(a.in[I_LNG], lane, g0); ld_row16(a.in[I_LNB], lane, b0); ld_row16(a.in[I_LNG] + 1024, lane, g1); ld_row16(a.in[I_LNB] + 1024, lane, b1);
    int row = bid * 8 + wv;
    if (row < MT) { ld_row16(PRE + (size_t)row * 1024, lane, nx);
#pragma unroll
        for (int q = 0; q < 4; ++q) ny[q] = *(const uint2*)(P2 + (size_t)row * 1024 + q * 256 + lane * 4); }
#pragma unroll 1
    while (row < MT) {
#pragma unroll
        for (int i = 0; i < 16; ++i) x[i] = nx[i];
#pragma unroll
        for (int q = 0; q < 4; ++q) { y[4 * q] = __uint_as_float(ny[q].x << 16); y[4 * q + 1] = __uint_as_float(ny[q].x & 0xffff0000u); y[4 * q + 2] = __uint_as_float(ny[q].y << 16); y[4 * q + 3] = __uint_as_float(ny[q].y & 0xffff0000u); }
        const int nrow = row + nb * 8;
        if (nrow < MT) { ld_row16(PRE + (size_t)nrow * 1024, lane, nx);
#pragma unroll
            for (int q = 0; q < 4; ++q) ny[q] = *(const uint2*)(P2 + (size_t)nrow * 1024 + q * 256 + lane * 4); }
        ln_calc16r(g0, b0, x);
#pragma unroll
        for (int i = 0; i < 16; ++i) x[i] = fmaf(ALPHA, x[i], y[i]);
        ln_calc16r(g1, b1, x);
#if PROBE_TIME >= 0
        if (row >= MP) {
            const unsigned long long* tsp = (const unsigned long long*)(ws + NB_BAR + 16384);
            const float dt_us = (float)(__hip_atomic_load(tsp + PROBE_TIME + 1, __ATOMIC_RELAXED, __HIP_MEMORY_SCOPE_AGENT) - __hip_atomic_load(tsp + PROBE_TIME, __ATOMIC_RELAXED, __HIP_MEMORY_SCOPE_AGENT)) * 0.01f;
            const float f = 1.f + PROBE_K * dt_us;
#pragma unroll
            for (int i = 0; i < 16; ++i) x[i] *= f;
        }
#endif
        float* o = (row < MP ? a.out + O_Y + (size_t)row * 1024 : a.out + O_YS + (size_t)(row - MP) * 1024) + lane * 4;
#pragma unroll
        for (int q = 0; q < 4; ++q) *(float4*)(o + q * 256) = make_float4(x[4 * q], x[4 * q + 1], x[4 * q + 2], x[4 * q + 3]);
        row = nrow;
    }
}
constexpr int POOL_ITEMS = BS * 32;
__device__ __forceinline__ void pool_item(const Args& a, unsigned char* ws, int item, int tid) {
    float* KCS = (float*)(ws + NB_KCS);
    const int* pt = (const int*)a.in[I_PT];
    const int s = item >> 5, n = (item & 31) * 8 + (tid >> 6), c = (tid & 63) * 4;
    const int kv = c >> 7, g = (c >> 6) & 1;
    const float* w = (kv ? a.in[I_WVC] : a.in[I_WKC]) + g;
    const int pos0 = n * 32;
    const float* src = a.in[I_CCMP] + ((size_t)pt[s * NPAGE + (pos0 >> 7)] * PAGE + (pos0 & 127)) * 256 + c;
    f32x4 v[32];
#pragma unroll
    for (int l = 0; l < 32; ++l) v[l] = __builtin_nontemporal_load((const f32x4*)(src + (size_t)l * 256));
    float4 acc = make_float4(0.f, 0.f, 0.f, 0.f);
#pragma unroll
    for (int l = 0; l < 32; ++l) { const float wl = w[l * 2]; acc.x = fmaf(v[l][0], wl, acc.x); acc.y = fmaf(v[l][1], wl, acc.y); acc.z = fmaf(v[l][2], wl, acc.z); acc.w = fmaf(v[l][3], wl, acc.w); }
    *(float4*)(KCS + ((size_t)(s * 256 + n) * 256 + c)) = acc;
}
__device__ __forceinline__ void sample_pool_copy(const Args& a, unsigned char* ws, int bid, int nb) {
    const float4* cw = (const float4*)a.in[I_CWIN];
    float4* ow = (float4*)(a.out + O_WINS);
#pragma unroll 4
    for (int i = bid * NTH + threadIdx.x; i < BS * 511 * 64; i += nb * NTH) {
        const int s = i / (511 * 64), rem = i - s * (511 * 64);
        ow[(size_t)s * 512 * 64 + rem] = cw[(size_t)s * 512 * 64 + 64 + rem];
    }
}
__device__ __forceinline__ void sample_conv(const Args& a, unsigned char* ws, PG8_LAS unsigned char* lds, int s) {
    const int ch = opaque_v(threadIdx.x);
    const bf16_t* h = (const bf16_t*)(ws + NB_HB) + (size_t)(MP + s) * 2560;
    const float* sc = a.in[I_SCONV] + (size_t)s * 30 * 512 + ch;
    const float u = bf2f(h[ch]) * sigm_f(bf2f(h[512 + ch]));
    float scv[30], wj[31];
    const float* __restrict__ cwp = a.in[I_CONVW] + ch;
#pragma unroll
    for (int j = 0; j < 30; ++j) { scv[j] = sc[(size_t)j * 512]; wj[j] = cwp[j * 512]; }
    wj[30] = cwp[30 * 512];
    float acc = a.in[I_CONVB][ch];
#pragma unroll
    for (int j = 0; j < 30; ++j) acc = fmaf(wj[j], scv[j], acc);
    acc = fmaf(wj[30], u, acc);
    float* __restrict__ oc = a.out + O_CONVS + (size_t)s * 30 * 512 + ch;
#pragma unroll
    for (int i = 0; i < 29; ++i) oc[(size_t)i * 512] = scv[i + 1];
    oc[(size_t)29 * 512] = u;
    PG8_LAS float* red = (PG8_LAS float*)lds;
    const int lane = ch & 63, wv = ch >> 6;
    float sm = wave_sum(acc);
    __syncthreads();
    if (lane == 0) red[wv] = sm;
    __syncthreads();
    float tot = 0.f;
#pragma unroll
    for (int i = 0; i < 8; ++i) tot += red[i];
    const float mean = tot * (1.f / 512.f);
    const float d = acc - mean;
    float sq = wave_sum(d * d);
    __syncthreads();
    if (lane == 0) red[wv] = sq;
    __syncthreads();
    tot = 0.f;
#pragma unroll
    for (int i = 0; i < 8; ++i) tot += red[i];
    const float rs = rsqrtf(tot * (1.f / 512.f) + LN_EPS);
    const float y = silu_f(d * rs * a.in[I_CLNG][ch] + a.in[I_CLNB][ch]) * silu_f(bf2f(h[1024 + ch]));
    ((bf16_t*)(ws + NB_CATB))[(size_t)(MP + s) * 1024 + ch] = (bf16_t)(pk_bf16(y, 0.f) & 0xffffu);
    __syncthreads();
}

constexpr int SP_STRIDE = 66;
__device__ __forceinline__ void sample_attn(const Args& a, unsigned char* ws, PG8_LAS unsigned char* lds, int s, int g, int part) {
    const int tid = opaque_v(threadIdx.x), lane = tid & 63, wv = __builtin_amdgcn_readfirstlane(tid >> 6);
    PG8_LAS float* PC = (PG8_LAS float*)lds;
    PG8_LAS float* IMP = (PG8_LAS float*)(lds + 4096);
    PG8_LAS int* SEL = (PG8_LAS int*)(lds + 4096 + 1024);
    PG8_LAS int* FLG = (PG8_LAS int*)(lds + 4096 + 1024 + 128);
    PG8_LAS float* PS = (PG8_LAS float*)(lds + 8192) + (tid >> 6) * 64;
    const int r = wv & 3, hh = g * 4 + r;
    const float slope = __builtin_amdgcn_exp2f(-(float)(hh + 1));
    const int* pt = (const int*)a.in[I_PT] + s * NPAGE;
    const bf16_t* hrow = (const bf16_t*)(ws + NB_HB) + (size_t)(MP + s) * 2560;
    float q[64];
#pragma unroll
    for (int d8 = 0; d8 < 8; ++d8) { const u32x4 w = *(const u32x4*)(hrow + 1536 + hh * 64 + d8 * 8);
#pragma unroll
        for (int i = 0; i < 4; ++i) { q[d8 * 8 + 2 * i] = __uint_as_float(w[i] << 16); q[d8 * 8 + 2 * i + 1] = __uint_as_float(w[i] & 0xffff0000u); } }
#define SAMP_DOT(KPTR, OUT) { const float4* k4_ = (const float4*)(KPTR); float4 kk_[16]; \
        _Pragma("unroll") for (int i_ = 0; i_ < 16; ++i_) kk_[i_] = k4_[i_]; float s_ = 0.f; \
        _Pragma("unroll") for (int i_ = 0; i_ < 16; ++i_) { s_ = fmaf(q[4 * i_], kk_[i_].x, s_); s_ = fmaf(q[4 * i_ + 1], kk_[i_].y, s_); s_ = fmaf(q[4 * i_ + 2], kk_[i_].z, s_); s_ = fmaf(q[4 * i_ + 3], kk_[i_].w, s_); } OUT = s_; }
    if (wv < 4) {
        const float* kc = (const float*)(ws + NB_KCS) + (size_t)s * 256 * 256 + g * 64;
        float sc[4];
        float mx = -INFINITY;
#pragma unroll
        for (int i = 0; i < 4; ++i) { const int n = lane + 64 * i; float d; SAMP_DOT(kc + (size_t)n * 256, d); sc[i] = d - slope * (float)(PAST - (32 * n + 31)); mx = fmaxf(mx, sc[i]); }
#pragma unroll
        for (int o = 32; o > 0; o >>= 1) mx = fmaxf(mx, __shfl_xor(mx, o));
        float ls = 0.f;
#pragma unroll
        for (int i = 0; i < 4; ++i) { sc[i] = __expf(sc[i] - mx); ls += sc[i]; }
        ls = wave_sum(ls);
        const float inv = 1.f / ls;
#pragma unroll
        for (int i = 0; i < 4; ++i) PC[r * 256 + lane + 64 * i] = sc[i] * inv;
    }
    __syncthreads();
    if (wv < 4 && part == 0) {
        const float* vc = (const float*)(ws + NB_KCS) + (size_t)s * 256 * 256 + 128 + g * 64 + lane;
        float oc0 = 0.f, oc1 = 0.f, oc2 = 0.f, oc3 = 0.f;
#pragma unroll 8
        for (int n = 0; n < 256; n += 4) {
            oc0 = fmaf(PC[r * 256 + n], vc[(size_t)n * 256], oc0); oc1 = fmaf(PC[r * 256 + n + 1], vc[(size_t)(n + 1) * 256], oc1);
            oc2 = fmaf(PC[r * 256 + n + 2], vc[(size_t)(n + 2) * 256], oc2); oc3 = fmaf(PC[r * 256 + n + 3], vc[(size_t)(n + 3) * 256], oc3);
        }
        ((float*)(ws + NB_OCS))[(size_t)(s * 8 + hh) * 64 + lane] = (oc0 + oc1) + (oc2 + oc3);
    }
    if (tid < 129) {
        float v = 0.f;
        if (tid < 128) { for (int rr = 0; rr < 4; ++rr) v += PC[rr * 256 + 2 * tid] + PC[rr * 256 + 2 * tid + 1]; }
        if (tid == 0 || tid >= 127) v = 1e4f;
        IMP[tid] = v;
    }
    __syncthreads();
    if (tid < 129) {
        const float vj = IMP[tid];
        int rank = 0;
        for (int i = 0; i < 129; ++i) { const float vi = IMP[i]; rank += (vi > vj || (vi == vj && i < tid)) ? 1 : 0; }
        FLG[tid] = (rank < 16) ? 1 : 0;
    }
    __syncthreads();
    if (tid < 129 && FLG[tid]) { int slot = 0; for (int i = 0; i < tid; ++i) slot += FLG[i]; SEL[slot] = tid; }
    __syncthreads();
    const float* csel = a.in[I_CSEL];
    const float* newsel = a.out + O_SELS + (size_t)s * 256;
    const float* cwin = a.in[I_CWIN] + (size_t)s * 512 * 256;
    const float* newwin = a.out + O_WINS + (size_t)(s * 512 + 511) * 256;
#pragma unroll 1
    for (int it = 0; it < 3; ++it) {
        const int lb = (wv >> 2) + 2 * it;
        const bool is_sel = lb < 4;
        const int slot = is_sel ? part * 4 + lb : part * 2 + (lb - 4);
        const float* rowp; const float* vb; int vstride_last; float dist; bool valid; int nk;
        if (is_sel) {
            const int blk = SEL[slot];
            const int kpos = blk * 64 + lane;
            valid = kpos <= PAST;
            rowp = (blk < 128) ? csel + ((size_t)pt[blk >> 1] * PAGE + (kpos & 127)) * 256 : newsel;
            vb = (blk < 128) ? csel + ((size_t)pt[blk >> 1] * PAGE + ((blk * 64) & 127)) * 256 + 128 + g * 64 + lane : newsel + 128 + g * 64 + lane;
            nk = (blk < 128) ? 64 : 1; dist = (float)(PAST - kpos); vstride_last = 0;
        } else {
            const int i0 = 1 + slot * 64;
            const int i = i0 + lane;
            valid = true; nk = 64;
            rowp = (i < 512) ? cwin + (size_t)i * 256 : newwin;
            vb = cwin + (size_t)i0 * 256 + 128 + g * 64 + lane;
            dist = (float)(512 - i); vstride_last = (slot == 7) ? 1 : 0;
        }
        float sc = -INFINITY;
        if (valid) { float d; SAMP_DOT(rowp + g * 64, d); sc = d - slope * dist; }
        float mx = sc;
#pragma unroll
        for (int of = 32; of > 0; of >>= 1) mx = fmaxf(mx, __shfl_xor(mx, of));
        const float p = valid ? __expf(sc - mx) : 0.f;
        const float l = wave_sum(p);
        PS[lane] = p; __builtin_amdgcn_wave_barrier();
        float o0 = 0.f, o1 = 0.f, o2 = 0.f, o3 = 0.f;
        if (nk == 64) {
            float vv[64];
#pragma unroll
            for (int k = 0; k < 63; ++k) vv[k] = vb[(size_t)k * 256];
            vv[63] = vstride_last ? newwin[128 + g * 64 + lane] : vb[(size_t)63 * 256];
#pragma unroll
            for (int k = 0; k < 64; k += 4) { o0 = fmaf(PS[k], vv[k], o0); o1 = fmaf(PS[k + 1], vv[k + 1], o1); o2 = fmaf(PS[k + 2], vv[k + 2], o2); o3 = fmaf(PS[k + 3], vv[k + 3], o3); }
        } else o0 = PS[0] * vb[0];
        __builtin_amdgcn_wave_barrier();
        float* pp = (float*)(ws + NB_PARTS) + ((size_t)((s * 8 + hh) * 24 + (is_sel ? slot : 16 + slot))) * SP_STRIDE;
        pp[2 + lane] = (o0 + o1) + (o2 + o3);
        if (lane == 0) { pp[0] = mx; pp[1] = l; }
    }
#undef SAMP_DOT
    __syncthreads();
}
__device__ __forceinline__ void sample_combine(const Args& a, unsigned char* ws, int s, int g) {
    const int tid = opaque_v(threadIdx.x), lane = tid & 63, wv = __builtin_amdgcn_readfirstlane(tid >> 6);
    if (wv >= 4) return;
    const int hh = g * 4 + wv;
    const float* pp = (const float*)(ws + NB_PARTS) + (size_t)(s * 8 + hh) * 24 * SP_STRIDE;
    const float* g3p = (const float*)(ws + NB_G3) + (size_t)(MP + s) * 32 + hh * 3;
    const float gc = sigm_f(g3p[0]), gs = sigm_f(g3p[1]), gw = sigm_f(g3p[2]);
    float res = gc * ((const float*)(ws + NB_OCS))[(size_t)(s * 8 + hh) * 64 + lane];
#pragma unroll
    for (int br = 0; br < 2; ++br) {
        const int n0 = br ? 16 : 0, cnt = br ? 8 : 16;
        float M = -INFINITY;
        for (int i = 0; i < cnt; ++i) M = fmaxf(M, pp[(size_t)(n0 + i) * SP_STRIDE]);
        float L = 0.f, O = 0.f;
        for (int i = 0; i < cnt; ++i) { const float* q = pp + (size_t)(n0 + i) * SP_STRIDE; const float w = __expf(q[0] - M); L = fmaf(q[1], w, L); O = fmaf(q[2 + lane], w, O); }
        res = fmaf(br ? gw : gs, O / L, res);
    }
    const bf16_t* hrow = (const bf16_t*)(ws + NB_HB) + (size_t)(MP + s) * 2560;
    const float y = res * silu_f(bf2f(hrow[2048 + hh * 64 + lane]));
    ((bf16_t*)(ws + NB_CATB))[(size_t)(MP + s) * 1024 + 512 + hh * 64 + lane] = (bf16_t)(pk_bf16(y, 0.f) & 0xffffu);
}

static_assert(CS_END <= LDS_MISC, "chunk-scan LDS map overlaps the barrier words");
enum { PH_PREP = 0, PH_GEMM1, PH_CONV, PH_ATTN, PH_GEMM2, PH_LNS, PH_GEMM3, PH_PREP2, PH_SCAN, PH_POST, PH_GEMM4, PH_LNF, NPHASE };

__global__ void __launch_bounds__(NTH, 2) mega(Args a) {
    extern __shared__ __attribute__((aligned(16))) unsigned char lds_raw[];
    PG8_LAS unsigned char* lds = (PG8_LAS unsigned char*)lds_raw;
    unsigned char* ws = a.ws;
    volatile LAS unsigned* misc = (volatile LAS unsigned*)(lds + LDS_MISC);
    if (threadIdx.x < 4) misc[threadIdx.x] = 0u;
    __syncthreads();
    XcdBarrier bar = xcd_barrier_post((unsigned*)(ws + NB_BAR), misc);
    const int lo = a.ph_lo, hi = a.ph_hi;
#ifndef DUP_SATTN
#define DUP_SATTN 0
#endif
#ifndef DUP_CONV
#define DUP_CONV 0
#endif
#ifndef DUP_GEMM1
#define DUP_GEMM1 0
#endif
#ifndef SKIPMASK
#define SKIPMASK 0
#endif
#define IN(k) (lo <= (k) && (k) < hi && !((SKIPMASK >> (k)) & 1))
#ifndef REPMASK
#define REPMASK 0
#endif
#define REPS(k) _Pragma("unroll 1") for (int rep_ = 0; rep_ < (((REPMASK >> (k)) & 1) ? 2 : 1); ++rep_)
#if PROBE_TIME >= 0
    unsigned long long* const tstamp = (unsigned long long*)(ws + NB_BAR + 16384);
#define STAMP(i) do { if (blockIdx.x == 0 && threadIdx.x == 0) __hip_atomic_store(tstamp + (i), (unsigned long long)__builtin_amdgcn_s_memrealtime(), __ATOMIC_RELAXED, __HIP_MEMORY_SCOPE_AGENT); } while (0)
#else
#define STAMP(i) do { } while (0)
#endif
#define SEAM(k) do { if (IN(k) && IN((k) + 1)) xcd_barrier(bar); STAMP((k) + 1); } while (0)
    STAMP(0);
    if (IN(PH_PREP)) REPS(PH_PREP) {
        const int bid = opaque(blockIdx.x), nb = gridDim.x;
        convert_wt(a.in[I_WIN], 1024, DIN, (bf16_t*)(ws + NB_WT1), N1PAD, MapWin{}, bid, nb);
        convert_wt(a.in[I_WOUTE], 1024, 1024, (bf16_t*)(ws + NB_WT2), 1024, MapId{}, bid, nb);
        for (int n = 0; n < 4; ++n) convert_wt(a.in[I_WRKVZ] + (size_t)n * 1024 * 1024, 1024, 1024, (bf16_t*)(ws + NB_WT3) + (size_t)n * 1024 * 1024, 1024, MapId{}, bid, nb);
        convert_wt(a.in[I_WOUTO], 1024, 1024, (bf16_t*)(ws + NB_WT4), 1024, MapId{}, bid, nb);
        convert_wfrag(a.in[I_W1], (bf16_t*)(ws + NB_W1T), bid, nb);
        convert_wfrag(a.in[I_A1], (bf16_t*)(ws + NB_A1T), bid, nb);
        convert_wt(a.in[I_W2], 64, 1024, (bf16_t*)(ws + NB_W2T), 1024, MapId{}, bid, nb);
        convert_wt(a.in[I_A2], 64, 1024, (bf16_t*)(ws + NB_A2T), 1024, MapId{}, bid, nb);
        convert_rows(a.in[I_XP], (size_t)MP * 1024 / 8, (bf16_t*)(ws + NB_XB), bid, nb);
        convert_rows(a.in[I_XS], (size_t)BS * 1024 / 8, (bf16_t*)(ws + NB_XSB), bid, nb);
        sample_pool_copy(a, ws, bid, nb);
    }
    SEAM(PH_PREP);
    if (IN(PH_GEMM1)) REPS(PH_GEMM1) {
        const int bid = opaque(blockIdx.x), nb = gridDim.x;
        const Route1 R{(bf16_t*)(ws + NB_HB), (bf16_t*)(ws + NB_KVB), (float*)(ws + NB_G3), a.out};
        {
            pg8::Gemm g{(const bf16_t*)(ws + NB_XB), (const bf16_t*)(ws + NB_WT1), MP, N1PAD, 1024};
            const int G1 = nb >= 256 ? 232 : nb;
            if (bid < G1) {
                pg8::StaticOrder S; S.init(MP, N1PAD, G1, bid);
                Epi1 E{R};
                pg8::gemm_phase<Epi1, pg8::StaticOrder, false>(lds, g, S, E, nullptr);
            }
        }
        {
            unsigned* const qctr = (unsigned*)(ws + NB_BAR + 20480);
            PG8_LAS int* const slot = (PG8_LAS int*)(lds + LDS_MISC + 64);
            const int tidq = opaque_v(threadIdx.x);
#pragma unroll 1
            for (;;) {
                __syncthreads();
                if (tidq == 0) *slot = (int)__hip_atomic_fetch_add(qctr, 1u, __ATOMIC_RELAXED, __HIP_MEMORY_SCOPE_AGENT);
                __syncthreads();
                const int item = __builtin_amdgcn_readfirstlane(*slot);
                if (item >= 105 + POOL_ITEMS) break;
                if (item >= 105) { pool_item(a, ws, item - 105, tidq); continue; }
                const int task = item;
                sample_gemm32_wg((const bf16_t*)(ws + NB_XSB), (const bf16_t*)(ws + NB_WT1), 1024, task * 32, lds,
                    [&](int r, int n, float v) {
                        const int row = MP + r;
                        if (n < 2560) { const float sc = (n >= 1536 && n < 2048) ? 0.125f : 1.0f; ((bf16_t*)(ws + NB_HB))[(size_t)row * 2560 + n] = (bf16_t)(pk_bf16c(v * sc, 0.f) & 0xffffu); }
                        else if (n < 3328) { const int c = n - 2560, i3 = c >> 8, cc = c & 255; ((bf16_t*)(ws + NB_KVB))[(size_t)row * 768 + c] = (bf16_t)(pk_bf16c(v, 0.f) & 0xffffu);
                            float* dst = (i3 == 0) ? a.out + O_CMPS + (size_t)r * 256 + cc : (i3 == 1) ? a.out + O_SELS + (size_t)r * 256 + cc : a.out + O_WINS + (size_t)(r * 512 + 511) * 256 + cc;
                            *dst = v; }
                        else if (n < 3352) ((float*)(ws + NB_G3))[(size_t)row * 32 + (n - 3328)] = v;
                    });
            }
        }
    }
    SEAM(PH_GEMM1);
    if (IN(PH_CONV)) REPS(PH_CONV) {
        const int bid = opaque(blockIdx.x), nb = gridDim.x;
#pragma unroll 1
        for (int item = bid; item < 512; item += nb) conv_item(a, ws, lds, item);
        pool_prompt(a, ws, bid, nb);
        sample_attn(a, ws, lds, bid >> 3, (bid >> 2) & 1, bid & 3);
#if DUP_SATTN
        __syncthreads();
        sample_attn(a, ws, lds, bid >> 3, (bid >> 2) & 1, bid & 3);
#endif
        if (bid >= 96 && bid < 128) sample_conv(a, ws, lds, bid - 96);
    }
    SEAM(PH_CONV);
    if (IN(PH_ATTN)) REPS(PH_ATTN) {
        const int bid = opaque(blockIdx.x), nb = gridDim.x;
        if (bid < 64) sample_combine(a, ws, bid >> 1, bid & 1);
        for (int pr = bid; pr < 256; pr += nb) {
            const int b = pr >> 5, g = (pr >> 4) & 1, xq = pr & 15;
#pragma unroll 1
            for (int k = 0; k < 2; ++k) attn_item(a, ws, lds, b, g, k ? xq : 31 - xq);
        }
    }
    SEAM(PH_ATTN);
    if (IN(PH_GEMM2)) REPS(PH_GEMM2) {
        const int bid = opaque(blockIdx.x), nb = gridDim.x;
        {
            pg8::Gemm g{(const bf16_t*)(ws + NB_CATB), (const bf16_t*)(ws + NB_WT2), MP, 1024, 1024};
            pg8::StaticOrder S; S.init(MP, 1024, nb, bid);
            EpiPreRes E{(float*)ws + WS_PRE, a.in[I_XP]};
            pg8::gemm_phase<EpiPreRes, pg8::StaticOrder, false>(lds, g, S, E, nullptr);
        }
        {
            const int lane = threadIdx.x & 63, wv = __builtin_amdgcn_readfirstlane(threadIdx.x >> 6);
            float* PREs = (float*)ws + WS_PRE + (size_t)MP * 1024;
            const float* xs = a.in[I_XS];
            for (int task = bid; task < 32; task += nb)
                sample_gemm32_wg((const bf16_t*)(ws + NB_CATB) + (size_t)MP * 1024, (const bf16_t*)(ws + NB_WT2), 1024, task * 32, lds,
                              [&](int r, int n, float v) { PREs[(size_t)r * 1024 + n] = fmaf(ALPHA, xs[(size_t)r * 1024 + n], v); });
        }
    }
    SEAM(PH_GEMM2);
    if (IN(PH_LNS)) REPS(PH_LNS) { const int bid = opaque(blockIdx.x), nb = gridDim.x; phase_lns(a, ws, lds, bid, nb); }
    SEAM(PH_LNS);
    if (IN(PH_GEMM3)) REPS(PH_GEMM3) {
        const int bid = opaque(blockIdx.x), nb = gridDim.x;
        {
            pg8::Gemm g{(const bf16_t*)(ws + NB_XSH), (const bf16_t*)(ws + NB_WT3), MP, 4096, 1024};
            Order3 S; S.init(nb, bid);
            Epi3 E{(bf16_t*)(ws + NB_RKVZ)};
            pg8::gemm_phase<Epi3, Order3, false>(lds, g, S, E, nullptr);
        }
        {
            const int lane = threadIdx.x & 63, wv = __builtin_amdgcn_readfirstlane(threadIdx.x >> 6);
            for (int task = bid; task < 128; task += nb) {
                const int n = task >> 5, n0 = (task & 31) * 32;
                bf16_t* dst = (bf16_t*)(ws + NB_RKVZ) + ((size_t)n * XSH_ROWS + MP) * 1024;
                sample_gemm32_wg((const bf16_t*)(ws + NB_XSH) + ((size_t)n * XSH_ROWS + MP) * 1024, (const bf16_t*)(ws + NB_WT3) + (size_t)n * 1024 * 1024, 1024, n0, lds,
                              [&](int r, int c, float v) { dst[(size_t)r * 1024 + c] = (bf16_t)(pk_bf16c(v, 0.f) & 0xffffu); });
            }
            if (bid >= nb - 2) {
                const int tidl = opaque_v(threadIdx.x), task = 1024 + (nb - 1 - bid);
                LoraRegs lr_; lora_load(ws, task, tidl, lr_); lora_tile(ws, lds, task, tidl, lr_);
            }
        }
    }
    SEAM(PH_GEMM3);
    if (IN(PH_PREP2)) REPS(PH_PREP2) {
        const int bid = opaque(blockIdx.x), nb = gridDim.x;
        for (int pr = bid; pr < 256; pr += nb) {
            const int bh = pr >> 1, b = bh >> 4, hd = bh & 15, c0 = (pr & 1) * 16;
            const int tidp = opaque_v(threadIdx.x), lanep = tidp & 63, wvp = tidp >> 6;
            bf16x8 btf[4];
            { const int which = wvp >> 2, nt = wvp & 1;
              const bf16_t* Bt = (const bf16_t*)(ws + (which ? NB_A2T : NB_W2T)) + (size_t)(hd * 64 + nt * 32 + (lanep & 31)) * 64 + (lanep >> 5) * 8;
#pragma unroll
              for (int s4 = 0; s4 < 4; ++s4) btf[s4] = *(const bf16x8*)(Bt + s4 * 16); }
            PreRegs pcur, pnxt;
            scanpre_load(ws, b, hd, c0, tidp, pnxt);
#pragma unroll 1
            for (int cc = 0; cc < 16; ++cc) {
                pcur = pnxt;
                if (cc + 1 < 16) scanpre_load(ws, b, hd, c0 + cc + 1, tidp, pnxt);
                scanpre_chunk(a, ws, lds, b, hd, c0 + cc, pcur, btf);
            }
        }
    }
    SEAM(PH_PREP2);
    if (IN(PH_SCAN)) REPS(PH_SCAN) {
        const int bid = opaque(blockIdx.x), nb = gridDim.x;
#pragma unroll 1
        for (int item = bid; item < 128; item += nb) scanseq_head(a, ws, lds, item >> 4, item & 15);
        const int lane = opaque_v(threadIdx.x) & 63, wv = __builtin_amdgcn_readfirstlane(threadIdx.x >> 6);
        for (int task = (nb - 1 - bid) * 8 + wv; task < BS * 16; task += nb * 8) scan_sample(a, ws, task >> 4, task & 15, lane);
    }
    SEAM(PH_SCAN);
    if (IN(PH_POST)) REPS(PH_POST) { const int bid = opaque(blockIdx.x), nb = gridDim.x; phase_ygate(a, ws, lds, bid, nb); }
    SEAM(PH_POST);
    if (IN(PH_GEMM4)) REPS(PH_GEMM4) {
        const int bid = opaque(blockIdx.x), nb = gridDim.x;
        {
            pg8::Gemm g{(const bf16_t*)(ws + NB_G4B), (const bf16_t*)(ws + NB_WT4), MP, 1024, 1024};
            pg8::StaticOrder S; S.init(MP, 1024, nb, bid);
            EpiPreB E{(bf16_t*)(ws + NB_Y)};
            pg8::gemm_phase<EpiPreB, pg8::StaticOrder, false>(lds, g, S, E, nullptr);
        }
        {
            bf16_t* PREs = (bf16_t*)(ws + NB_Y) + (size_t)MP * 1024;
            for (int task = bid; task < 32; task += nb)
                sample_gemm32_wg((const bf16_t*)(ws + NB_G4B) + (size_t)MP * 1024, (const bf16_t*)(ws + NB_WT4), 1024, task * 32, lds,
                              [&](int r, int n, float v) { PREs[(size_t)r * 1024 + n] = (bf16_t)(pk_bf16c(v, 0.f) & 0xffffu); });
        }
    }
    SEAM(PH_GEMM4);
    if (IN(PH_LNF)) REPS(PH_LNF) { const int bid = opaque(blockIdx.x), nb = gridDim.x; phase_lnf(a, ws, bid, nb); }
#undef IN
#undef SEAM
}
}

extern "C" void kernel_launch(void* const* d_in, const int* in_sizes, int n_in, void* d_out, int out_size, void* d_ws, size_t ws_size,
                              hipStream_t stream) {
    if (n_in != N_IN || ws_size < nk::NB_END) { fprintf(stderr, "kernel_launch: unexpected n_in %d or ws_size %zu (need %zu)\n", n_in, ws_size, (size_t)nk::NB_END); return; }
    static int grid = 0;
    if (!grid) {
        int dev = 0, cus = 0, per_cu = 0;
        hipGetDevice(&dev);
        hipDeviceGetAttribute(&cus, hipDeviceAttributeMultiprocessorCount, dev);
        hipFuncSetAttribute((const void*)nk::mega, hipFuncAttributeMaxDynamicSharedMemorySize, nk::LDS_BYTES);
        hipOccupancyMaxActiveBlocksPerMultiprocessor(&per_cu, (const void*)nk::mega, nk::NTH, nk::LDS_BYTES);
        if (per_cu < 1) fprintf(stderr, "kernel_launch: occupancy query says %d blocks per CU\n", per_cu);
        grid = cus;
    }
    hipMemsetAsync((unsigned char*)d_ws + nk::NB_BAR, 0, 32768, stream);
    nk::Args a{};
    for (int i = 0; i < N_IN; ++i) a.in[i] = (const float*)d_in[i];
    a.out = (float*)d_out; a.ws = (unsigned char*)d_ws; a.ph_lo = 0; a.ph_hi = nk::NPHASE;
    void* args[] = {&a};
    hipError_t e = hipLaunchCooperativeKernel((const void*)nk::mega, dim3(grid), dim3(nk::NTH), args, nk::LDS_BYTES, stream);
    if (e != hipSuccess) fprintf(stderr, "cooperative launch failed: %s (grid %d)\n", hipGetErrorString(e), grid);
}
```

```cpp
#include <hip/hip_runtime.h>
#include <hip/hip_cooperative_groups.h>
#include <cstdio>
namespace cg = cooperative_groups;
#ifndef PROBE_TIME
#define PROBE_TIME -1
#endif
#ifndef PROBE_K
#define PROBE_K 1e-4f
#endif

constexpr int D = 1024, BP = 8, TP = 2048, MP = BP * TP, BS = 32, MT = MP + BS;
constexpr int DIN = 3352;
constexpr int C_AVAL = 0, C_AGLU = 512, C_ZA = 1024, C_Q = 1536, C_KV = 2048, C_G3 = 2816, C_ZB = 2840;
constexpr int C_CMP = C_KV, C_SEL = C_KV + 256, C_WIN = C_KV + 512;
constexpr int PAST = 8192, NPAGE = 64, PAGE = 128;
constexpr float ALPHA = 1.4142135623730951f;
constexpr float LN_EPS = 1e-5f, GN_EPS = 64e-5f;

constexpr size_t O_Y = 0, O_YS = 16777216, O_CMPP = 16809984, O_CMPS = 21004288, O_SELP = 21012480, O_SELS = 25206784,
                 O_WINP = 25214976, O_WINS = 26263552, O_CONVP = 30457856, O_CONVS = 30580736, O_WKVP = 31072256,
                 O_WKVS = 31596544, O_SHP = 33693696, O_SHS = 33701888;

enum { I_XP = 0, I_XS, I_CCMP, I_CSEL, I_CWIN, I_SCONV, I_SWKV, I_SSHIFT, I_PT, I_WIN, I_CONVW, I_CONVB, I_CLNG, I_CLNB,
       I_WKC, I_WVC, I_WOUTE, I_MU, I_WRKVZ, I_W0, I_W1, I_W2, I_A0, I_A1, I_A2, I_KK, I_KA, I_RK, I_GNG, I_GNB, I_WOUTO,
       I_LNG, I_LNB, N_IN };

constexpr size_t SZ_ROWD = (size_t)MT * D;
constexpr size_t WS_H = 0;
constexpr size_t WS_CAT = WS_H + (size_t)MT * DIN;
constexpr size_t WS_OC = WS_CAT + SZ_ROWD;
constexpr size_t WS_XSH = 0;
constexpr size_t WS_Y = 0;
constexpr size_t WS_G4 = SZ_ROWD;
constexpr size_t WS_R0END = 6 * SZ_ROWD;
constexpr size_t WS_PRE = WS_R0END;
constexpr size_t WS_X1 = WS_PRE + SZ_ROWD;
constexpr size_t WS_R = WS_X1 + SZ_ROWD;
constexpr size_t WS_K = WS_R + SZ_ROWD;
constexpr size_t WS_V = WS_K + SZ_ROWD;
constexpr size_t WS_Z = WS_V + SZ_ROWD;
constexpr size_t WS_DEC = WS_Z + SZ_ROWD;
constexpr size_t WS_KKN = WS_DEC + SZ_ROWD;
constexpr size_t WS_KKA = WS_KKN + SZ_ROWD;
constexpr size_t WS_TW = WS_KKA + SZ_ROWD;
constexpr size_t WS_AW = WS_TW + (size_t)MT * 64;
constexpr size_t WS_RK = WS_AW + (size_t)MT * 64;
constexpr size_t WS_END = WS_RK + (size_t)MT * 16;
constexpr size_t WS_PCP = WS_R;
constexpr size_t WS_PCS = WS_R + (size_t)MP * 8 * 64;
constexpr size_t WS_IMP = WS_K;
constexpr size_t WS_SELIDX = WS_V;
constexpr size_t WS_KCP = WS_Z;
constexpr size_t WS_KCS = WS_Z + (size_t)8 * 64 * 256;
static_assert(WS_OC + (size_t)MT * 512 <= WS_R0END, "layer0 temporaries overflow region 0");

namespace pg8 {
#define PG8_LAS __attribute__((address_space(3)))
typedef unsigned short bf16_t;
typedef short bf16x8 __attribute__((ext_vector_type(8)));
typedef float f32x4 __attribute__((ext_vector_type(4)));
typedef unsigned u32x4 __attribute__((ext_vector_type(4)));
constexpr int BM = 256, BK = 64, HALF = 128, HTB = HALF * BK * 2  , STAGE_BYTES = 8 * HTB, NXCD = 8, WGM = 8;

__host__ __device__ __forceinline__ int lds_byte(int r, int c) { const int st = (r >> 4) * 2 + (c >> 5), rr = r & 15, cc = c & 31, ob = rr * 64 + cc * 2; return st * 1024 + (ob ^ (((ob >> 9) & 1) << 5)); }
__host__ __device__ __forceinline__ void stage_rc(int b, int& R, int& C) { const int st = b / 1024, sb = b % 1024, swz = sb ^ (((sb >> 9) & 1) << 5); R = (st >> 1) * 16 + swz / 64; C = (st & 1) * 32 + (swz % 64) / 2; }
__host__ __device__ __forceinline__ int perm32(int rho) { const int n = rho >> 4, i = rho & 15; return 8 * (i >> 2) + 4 * n + (i & 3); }

struct Unit { int pm, pn; };
struct Gemm { const bf16_t* A; const bf16_t* Bt; int M, N, K; };

struct StaticOrder {
    int nM, nN, nwg, G, c;
    __host__ __device__ void init(int M, int N, int G_, int c_) { nM = M / BM; nN = N / BM; nwg = nM * nN; G = G_; c = c_; }
    __host__ __device__ bool next(int i, Unit& u) const {
        const long L = (long)i * G + c; if (L >= nwg) return false;
        int wgid = (int)L; { const int q = nwg / NXCD, r = nwg % NXCD, xcd = wgid % NXCD, off = wgid / NXCD; wgid = (xcd < r ? xcd * (q + 1) : r * (q + 1) + (xcd - r) * q) + off; }
        const int nig = WGM * nN, gid = wgid / nig, fm = gid * WGM, gsz = (nM - fm) < WGM ? (nM - fm) : WGM;
        u.pm = fm + ((wgid % nig) % gsz); u.pn = (wgid % nig) / gsz; return true;
    }
    __device__ __forceinline__ void a_ready(const Unit&) const {}
    __device__ __forceinline__ void done(const Unit&) const {}
};
struct CountedOrder : StaticOrder {
    const unsigned* ready; unsigned need; unsigned* tmo;
    __device__ __forceinline__ void a_ready(const Unit& u) const {
        if (threadIdx.x < 64) {
            const unsigned long long t0 = __builtin_amdgcn_s_memrealtime(); unsigned polls = 0;
            while ((unsigned)__builtin_amdgcn_readfirstlane(__hip_atomic_load(ready + 64 * u.pm, __ATOMIC_RELAXED, __HIP_MEMORY_SCOPE_AGENT)) < need) {
                if ((++polls & 255u) == 0u && __builtin_amdgcn_readfirstlane(__hip_atomic_load(tmo, __ATOMIC_RELAXED, __HIP_MEMORY_SCOPE_AGENT)) != 0u) break;
                if (__builtin_amdgcn_s_memrealtime() - t0 > 2000000ull) {
                    if (threadIdx.x == 0) { unsigned expect = 0u; __hip_atomic_compare_exchange_strong(tmo + 1, &expect, 0x600u | (unsigned)(u.pm & 0xff), __ATOMIC_RELAXED, __ATOMIC_RELAXED, __HIP_MEMORY_SCOPE_AGENT); __hip_atomic_store(tmo, 1u, __ATOMIC_RELAXED, __HIP_MEMORY_SCOPE_AGENT); }
                    break; }
                __builtin_amdgcn_s_sleep(2); }
            __builtin_amdgcn_fence(__ATOMIC_ACQUIRE, "agent");
            asm volatile("s_waitcnt vmcnt(0)" ::: "memory");
        }
#if !defined(BROKEN_HOOK_NO_BARRIER)
        asm volatile("" ::: "memory"); __builtin_amdgcn_s_barrier(); asm volatile("" ::: "memory");
#endif
    }
};


template <class Epi, class Sched, bool STAMP = false>
__device__ __forceinline__ void gemm_phase(PG8_LAS unsigned char* lds, const Gemm g, const Sched& S, const Epi& E, unsigned long long* stamps) {
    int tid_ = threadIdx.x; asm volatile("" : "+v"(tid_));
    const int tid = tid_, wid = __builtin_amdgcn_readfirstlane(tid >> 6), lane = tid & 63, wr = wid >> 2, wc = wid & 3, fr = lane & 15, fq = lane >> 4;
    const int K = g.K, nt = K / BK;
    int ts_lo = 0, ts_hi = 0, nts = 0; const unsigned long long rt_entry = STAMP ? (unsigned long long)wall_clock64() : 0ull;
#define PG8_STAMP() do { if (STAMP && wid == 0 && nts < 64) { const unsigned long long _c = (unsigned long long)clock64(); \
        ts_lo = (lane == nts) ? (int)(unsigned)_c : ts_lo; ts_hi = (lane == nts) ? (int)(unsigned)(_c >> 32) : ts_hi; ++nts; } } while (0)
    PG8_STAMP();
    unsigned voffA[2], voffB[2];
#pragma unroll
    for (int i = 0; i < 2; ++i) { int R, C; stage_rc(tid * 16 + i * 8192, R, C); const int Rb = Epi::PERM ? ((R & ~31) + perm32(R & 31)) : R;
        voffA[i] = (unsigned)(R * K + C) * 2u; voffB[i] = (unsigned)(Rb * K + C) * 2u; }
    const size_t kstep = (size_t)(BK * 2);
    const size_t hstep = (size_t)HALF * K * 2;
    const size_t tstep = 2 * hstep;
    const unsigned ldsw = (unsigned)wid * 1024u;
    const int aoff = lds_byte(wr * 64 + fr, fq * 8), boff = lds_byte(wc * 32 + fr, fq * 8);
#define PG8_SA(b, h) (((b) * 2 + (h)) * HTB)
#define PG8_SB(b, h) ((4 + (b) * 2 + (h)) * HTB)
#define PG8_STAGE(bufoff, gbase, voff) do { _Pragma("unroll") for (int _i = 0; _i < 2; ++_i) \
        __builtin_amdgcn_global_load_lds((const unsigned*)((const char*)(gbase) + (voff)[_i]), (PG8_LAS unsigned*)(lds + (bufoff) + ldsw + _i * 8192), 16, 0, 0); } while (0)
#define PG8_LDA(dst, b, h) do { _Pragma("unroll") for (int m = 0; m < 4; ++m) _Pragma("unroll") for (int k = 0; k < 2; ++k) dst[m][k] = *(const PG8_LAS bf16x8*)(lds + PG8_SA(b, h) + aoff + m * 2048 + k * 1024); } while (0)
#define PG8_LDB(dst, b, h) do { _Pragma("unroll") for (int n = 0; n < 2; ++n) _Pragma("unroll") for (int k = 0; k < 2; ++k) dst[n][k] = *(const PG8_LAS bf16x8*)(lds + PG8_SB(b, h) + boff + n * 2048 + k * 1024); } while (0)
#define PG8_MMA(ai, bj, At, Bt) do { __builtin_amdgcn_s_setprio(1); _Pragma("unroll") for (int m = 0; m < 4; ++m) _Pragma("unroll") for (int n = 0; n < 2; ++n) _Pragma("unroll") for (int k = 0; k < 2; ++k) \
        acc[ai][bj][m][n] = __builtin_amdgcn_mfma_f32_16x16x32_bf16(Bt[n][k], At[m][k], acc[ai][bj][m][n], 0, 0, 0); __builtin_amdgcn_s_setprio(0); } while (0)
#define PG8_WAIT_V(n) asm volatile("s_waitcnt vmcnt(" #n ")" ::: "memory")
#define PG8_WAIT_L(n) asm volatile("s_waitcnt lgkmcnt(" #n ")" ::: "memory")
#define PG8_BAR __builtin_amdgcn_s_barrier()
#define PG8_SCHED __builtin_amdgcn_sched_barrier(0)
    Unit cur, nxt; int ui = 0;
    if (!S.next(0, cur)) return;
    f32x4 acc[2][2][4][2];
#pragma unroll
    for (int a = 0; a < 2; ++a)
#pragma unroll
        for (int b = 0; b < 2; ++b)
#pragma unroll
            for (int m = 0; m < 4; ++m)
#pragma unroll
                for (int n = 0; n < 2; ++n) acc[a][b][m][n] = (f32x4){0.f, 0.f, 0.f, 0.f};
    bf16x8 At[4][2], B0[2][2], B1[2][2];
    const char* cA = (const char*)g.A + (size_t)cur.pm * tstep; const char* cB = (const char*)g.Bt + (size_t)cur.pn * tstep;
    S.a_ready(cur);
    PG8_STAGE(PG8_SB(0, 0), cB, voffB); PG8_STAGE(PG8_SA(0, 0), cA, voffA); PG8_STAGE(PG8_SB(0, 1), cB + hstep, voffB); PG8_STAGE(PG8_SA(0, 1), cA + hstep, voffA);
    if (wr == 1) PG8_BAR;
    PG8_WAIT_V(4); PG8_BAR;
    PG8_STAGE(PG8_SB(1, 0), cB + kstep, voffB); PG8_STAGE(PG8_SA(1, 0), cA + kstep, voffA); PG8_STAGE(PG8_SB(1, 1), cB + hstep + kstep, voffB);
    PG8_WAIT_V(6); PG8_BAR;
    PG8_STAMP();
    for (;;) {
        const bool has_next = S.next(ui + 1, nxt);
        const char* nA = has_next ? (const char*)g.A + (size_t)nxt.pm * tstep : cA; const char* nB = has_next ? (const char*)g.Bt + (size_t)nxt.pn * tstep : cB;
        for (int t = 0; t < nt; t += 2) {
            const bool last = (t == nt - 2);
            const char* a1 = cA + (size_t)(t + 1) * kstep;
            const char* a2 = last ? nA : cA + (size_t)(t + 2) * kstep; const char* b2 = last ? nB : cB + (size_t)(t + 2) * kstep;
            const char* a3 = a2 + kstep; const char* b3 = b2 + kstep;
            if (last && has_next) S.a_ready(nxt);
            PG8_LDB(B0, 0, 0); PG8_SCHED; PG8_LDA(At, 0, 0); PG8_STAGE(PG8_SA(1, 1), a1 + hstep, voffA);
            PG8_WAIT_L(8); PG8_BAR; PG8_WAIT_L(0); PG8_MMA(0, 0, At, B0); PG8_BAR; PG8_SCHED;
            PG8_LDB(B1, 0, 1); PG8_STAGE(PG8_SB(0, 0), b2, voffB);
            PG8_BAR; PG8_WAIT_L(0); PG8_MMA(0, 1, At, B1); PG8_BAR;
            PG8_LDA(At, 0, 1); PG8_STAGE(PG8_SA(0, 0), a2, voffA);
            PG8_BAR; PG8_WAIT_L(0); PG8_MMA(1, 0, At, B0); PG8_BAR; PG8_SCHED;
            PG8_STAGE(PG8_SB(0, 1), b2 + hstep, voffB);
            PG8_WAIT_V(6); PG8_BAR; PG8_MMA(1, 1, At, B1); PG8_BAR;
            PG8_LDB(B0, 1, 0); PG8_SCHED; PG8_LDA(At, 1, 0); PG8_STAGE(PG8_SA(0, 1), a2 + hstep, voffA);
            PG8_WAIT_L(8); PG8_BAR; PG8_WAIT_L(0); PG8_MMA(0, 0, At, B0); PG8_BAR; PG8_SCHED;
            PG8_LDB(B1, 1, 1); PG8_STAGE(PG8_SB(1, 0), b3, voffB);
            PG8_BAR; PG8_WAIT_L(0); PG8_MMA(0, 1, At, B1); PG8_BAR;
            PG8_LDA(At, 1, 1); PG8_STAGE(PG8_SA(1, 0), a3, voffA);
            PG8_BAR; PG8_WAIT_L(0); PG8_MMA(1, 0, At, B0); PG8_BAR; PG8_SCHED;
            PG8_STAGE(PG8_SB(1, 1), b3 + hstep, voffB);
            PG8_WAIT_V(6); PG8_BAR; PG8_MMA(1, 1, At, B1); PG8_BAR;
        }
        PG8_STAMP();
        if constexpr (!Epi::AFTER_DRAIN) { E(acc, cur, wr, wc, fr, fq); S.done(cur); }
        PG8_STAMP();
        if (!has_next) break;
#pragma unroll
        for (int a = 0; a < 2; ++a)
#pragma unroll
            for (int b = 0; b < 2; ++b)
#pragma unroll
                for (int m = 0; m < 4; ++m)
#pragma unroll
                    for (int n = 0; n < 2; ++n) acc[a][b][m][n] = (f32x4){0.f, 0.f, 0.f, 0.f};
        cur = nxt; cA = nA; cB = nB; ++ui;
    }
    PG8_WAIT_V(0);
    if (wr == 0) PG8_BAR;
    PG8_BAR;
    if constexpr (Epi::AFTER_DRAIN) { E.fused(acc, cur, wr, wc, fr, fq, lds, wid, lane); S.done(cur); }
    PG8_STAMP();
    if (STAMP && wid == 0) { stamps[lane] = lane < nts ? (((unsigned long long)(unsigned)ts_hi << 32) | (unsigned)ts_lo) : 0ull;
        if (lane == 62) stamps[62] = rt_entry; if (lane == 63) stamps[63] = (unsigned long long)wall_clock64(); }
#undef PG8_STAMP
#undef PG8_SA
#undef PG8_SB
#undef PG8_STAGE
#undef PG8_LDA
#undef PG8_LDB
#undef PG8_MMA
#undef PG8_WAIT_V
#undef PG8_WAIT_L
#undef PG8_BAR
#undef PG8_SCHED
}
}

#define XB_TMO      128
#define XB_XCNT(j)  (256  + 64 * (j))
#define XB_XSUB(j)  (1280 + 64 * (j))
#define XB_XGEN(j)  (2304 + 64 * (j))
#define XB_TOP      3328
#define XB_TOPGEN   3392
#define XCD_BAR_WORDS 3456
#define XB_SPIN_CAP (1u << 18)
#define LAS __attribute__((address_space(3)))

__device__ __forceinline__ unsigned xb_ld(unsigned* p)              { return __hip_atomic_load(p, __ATOMIC_RELAXED, __HIP_MEMORY_SCOPE_AGENT); }
__device__ __forceinline__ unsigned xb_add(unsigned* p, unsigned v) { return __hip_atomic_fetch_add(p, v, __ATOMIC_RELAXED, __HIP_MEMORY_SCOPE_AGENT); }
__device__ __forceinline__ unsigned xb_xcc_id() { return (unsigned)__builtin_amdgcn_s_getreg((3 << 11) | 20) & 0xFu; }
#define XB_SPIN(cond, bar) do { unsigned _sp = 0; while (cond) { __builtin_amdgcn_s_sleep(1); \
    if ((++_sp & 255u) == 0u) { if (xb_ld(&(bar)[XB_TMO])) break; if (_sp > XB_SPIN_CAP) { atomicAdd(&(bar)[XB_TMO], 1u); break; } } } } while (0)

struct XcdBarrier {
    unsigned* bar; unsigned x;
    volatile LAS unsigned* st;
};

__device__ __forceinline__ XcdBarrier xcd_barrier_post(unsigned* bar, volatile LAS unsigned* st) {
    XcdBarrier b; b.bar = bar; b.x = xb_xcc_id(); b.st = st;
    if (threadIdx.x == 0) (void)xb_add(&bar[XB_XCNT(b.x)], 1u);
    return b;
}
__device__ __forceinline__ void xcd_barrier_complete(unsigned* bar, unsigned x, unsigned& nloc, unsigned& nx) {
    const unsigned G = gridDim.x * gridDim.y * gridDim.z;
    unsigned sum, cnt, mine, sp = 0u;
    for (;;) {
        sum = 0u; cnt = 0u; mine = 0u;
#pragma unroll
        for (unsigned j = 0; j < 16; ++j) { const unsigned c = xb_ld(&bar[XB_XCNT(j)]); sum += c; cnt += (c > 0u) ? 1u : 0u; mine = (j == x) ? c : mine; }
        if (sum == G) break;
        __builtin_amdgcn_s_sleep(1);
        if ((++sp & 255u) == 0u) { if (xb_ld(&bar[XB_TMO])) break; if (sp > XB_SPIN_CAP) { atomicAdd(&bar[XB_TMO], 1u); break; } }
    }
    nloc = mine > 0u ? mine : 1u; nx = cnt > 0u ? cnt : 1u;
}

__device__ __forceinline__ void xcd_barrier(const XcdBarrier& b) {
    asm volatile("s_waitcnt vmcnt(0)" ::: "memory");
    __syncthreads();
    if (threadIdx.x == 0) {
        unsigned* bar = b.bar;
        __builtin_amdgcn_s_waitcnt(0);
        unsigned nloc = b.st[0], nx = b.st[1];
        if (nloc == 0u) { xcd_barrier_complete(bar, b.x, nloc, nx); b.st[0] = nloc; b.st[1] = nx; }
        const unsigned old = xb_add(&bar[XB_XSUB(b.x)], 1u);
        const unsigned gen = old / nloc;
        if (old + 1u == (gen + 1u) * nloc) {
            __builtin_amdgcn_fence(__ATOMIC_RELEASE, "agent");
            asm volatile("s_waitcnt vmcnt(0)" ::: "memory");
            const unsigned og = xb_add(&bar[XB_TOP], 1u);
            const unsigned tg = og / nx;
            if (og + 1u == (tg + 1u) * nx) xb_add(&bar[XB_TOPGEN], 1u);
            else XB_SPIN(xb_ld(&bar[XB_TOPGEN]) == tg, bar);
            __builtin_amdgcn_fence(__ATOMIC_ACQUIRE, "agent");
            xb_add(&bar[XB_XGEN(b.x)], 1u);
            asm volatile("s_waitcnt vmcnt(0)" ::: "memory");
        } else {
            XB_SPIN(xb_ld(&bar[XB_XGEN(b.x)]) == gen, bar);
            __builtin_amdgcn_fence(__ATOMIC_ACQUIRE, "agent");
            asm volatile("s_waitcnt vmcnt(0)" ::: "memory");
        }
    }
    __syncthreads();
}

namespace nk {
using pg8::bf16_t; using pg8::bf16x8; using pg8::f32x4; using pg8::u32x4; using pg8::Unit;
constexpr int NTH = 512;
constexpr int LDS_STAGE = pg8::STAGE_BYTES;
constexpr int LDS_MISC = 158720;
constexpr int LDS_BYTES = LDS_MISC + 1024;

constexpr size_t NB0 = WS_END * 4;
constexpr size_t NB_BAR = NB0;
constexpr size_t NB_WT1 = NB_BAR + 32768;
constexpr size_t NB_WT2 = NB_WT1 + (size_t)3584 * 1024 * 2;
constexpr size_t NB_XB = NB_WT2 + (size_t)1024 * 1024 * 2;
constexpr size_t NB_XSB = NB_XB + (size_t)MP * 1024 * 2;
constexpr size_t NB_HB = NB_XSB + (size_t)BS * 1024 * 2;
constexpr size_t NB_KVB = NB_HB + (size_t)MT * 2560 * 2;
constexpr size_t NB_G3 = NB_KVB + (size_t)MT * 768 * 2;
constexpr size_t NB_CATB = NB_G3 + (size_t)MT * 32 * 4;
constexpr size_t NB_CBUF = NB_CATB + (size_t)MT * 1024 * 2;
constexpr size_t NB_KCB = NB_CBUF + (size_t)MP * 512 * 4;
constexpr size_t NB_WT3 = NB_KCB + (size_t)BP * 64 * 256 * 2;
constexpr size_t NB_WT4 = NB_WT3 + (size_t)4 * 1024 * 1024 * 2;
constexpr size_t NB_W1T = NB_WT4 + (size_t)1024 * 1024 * 2;
constexpr size_t NB_A1T = NB_W1T + (size_t)64 * 1024 * 2;
constexpr size_t NB_W2T = NB_A1T + (size_t)64 * 1024 * 2;
constexpr size_t NB_A2T = NB_W2T + (size_t)64 * 1024 * 2;
constexpr size_t NB_KCS = NB_A2T + (size_t)64 * 1024 * 2;
constexpr size_t NB_OCS = NB_KCS + (size_t)BS * 256 * 256 * 4;
constexpr size_t NB_PARTS = NB_OCS + (size_t)4 * BS * 8 * 64 * 4;
constexpr size_t NB_END = NB_PARTS + (size_t)BS * 8 * 24 * 66 * 4;
constexpr size_t NB_XSH = 0;
constexpr size_t NB_RKVZ = NB_XSH + (size_t)6 * 16640 * 1024 * 2;
constexpr size_t NB_TWB = NB_RKVZ + (size_t)4 * 16640 * 1024 * 2;
constexpr size_t NB_AWB = NB_TWB + (size_t)MT * 64 * 2;
constexpr size_t NB_RKS = NB_AWB + (size_t)MT * 64 * 2;
static_assert(NB_RKS + (size_t)MT * 16 * 4 <= WS_PRE * 4, "layer-1 region A overflows into PRE");
constexpr size_t NB_DEC = (WS_X1 + SZ_ROWD) * 4;
constexpr size_t NB_KKN = NB_DEC + (size_t)MT * 1024 * 4;
constexpr size_t NB_KKA = NB_KKN + (size_t)MT * 1024 * 2;
constexpr size_t NB_KP = NB_KKA + (size_t)MT * 1024 * 2;
constexpr size_t NB_Y = NB_KP + (size_t)MT * 1024 * 2;
constexpr size_t NB_G4B = NB_Y + (size_t)MT * 1024 * 4;
constexpr size_t NB_CHK = NB_G4B + (size_t)MT * 1024 * 2;
constexpr size_t NB_SREC = NB_CHK + (size_t)4096 * 32768;
static_assert(NB_SREC + (size_t)4096 * 8192 <= NB0, "layer-1 region B overflows");
constexpr int N1PAD = 3584;
__host__ __device__ __forceinline__ int win_src_col(int n) { return n < 2048 ? n : (n < 2560 ? C_ZB + (n - 2048) : (n < 3328 ? C_KV + (n - 2560) : (n < 3352 ? C_G3 + (n - 3328) : -1))); }

__device__ __forceinline__ int opaque(int x) { asm volatile("" : "+s"(x)); return x; }
__device__ __forceinline__ void lds_barrier() { asm volatile("s_waitcnt lgkmcnt(0)" ::: "memory"); __builtin_amdgcn_s_barrier(); asm volatile("" ::: "memory"); }
__device__ __forceinline__ int opaque_v(int x) { asm volatile("" : "+v"(x)); return x; }
struct Args { const float* in[N_IN]; float* out; unsigned char* ws; int ph_lo, ph_hi; };

__device__ __forceinline__ unsigned pk_bf16(float lo, float hi) { unsigned r; asm volatile("v_cvt_pk_bf16_f32 %0, %1, %2" : "=v"(r) : "v"(lo), "v"(hi)); return r; }
typedef __bf16 bf16x2_t __attribute__((ext_vector_type(2)));
__device__ __forceinline__ unsigned pk_bf16c(float lo, float hi) { bf16x2_t v; v[0] = (__bf16)lo; v[1] = (__bf16)hi; return __builtin_bit_cast(unsigned, v); }

template <class MAP>
__device__ __forceinline__ void convert_wt(const float* __restrict__ W, int K, int ldw, bf16_t* __restrict__ Wt, int Npad, MAP map, int bid, int nb) {
    const int nblk = Npad >> 3;
    const size_t total = (size_t)Npad * (K >> 3);
    for (size_t i = (size_t)bid * NTH + threadIdx.x; i < total; i += (size_t)nb * NTH) {
        const int l6 = (int)(i & 63); const size_t w = i >> 6;
        const int n = (int)(w % nblk) * 8 + (l6 >> 3), k0 = ((int)(w / nblk) * 8 + (l6 & 7)) * 8;
        const int sc = map(n);
        u32x4 wv = {0u, 0u, 0u, 0u};
        if (sc >= 0) {
            float v[8];
#pragma unroll
            for (int j = 0; j < 8; ++j) v[j] = W[(size_t)(k0 + j) * ldw + sc];
            wv.x = pk_bf16(v[0], v[1]); wv.y = pk_bf16(v[2], v[3]); wv.z = pk_bf16(v[4], v[5]); wv.w = pk_bf16(v[6], v[7]);
        }
        *(u32x4*)(Wt + (size_t)n * K + k0) = wv;
    }
}
struct MapId { __device__ __forceinline__ int operator()(int n) const { return n; } };
struct MapWin { __device__ __forceinline__ int operator()(int n) const { return win_src_col(n); } };
__device__ __forceinline__ void convert_wfrag(const float* __restrict__ W, bf16_t* __restrict__ Wf, int bid, int nb) {
    for (int i = bid * NTH + threadIdx.x; i < 64 * 128; i += nb * NTH) {
        const int n = i & 63, k0 = (i >> 6) * 8;
        float v[8];
#pragma unroll
        for (int j = 0; j < 8; ++j) v[j] = W[(size_t)(k0 + j) * 64 + n];
        u32x4 w; w.x = pk_bf16(v[0], v[1]); w.y = pk_bf16(v[2], v[3]); w.z = pk_bf16(v[4], v[5]); w.w = pk_bf16(v[6], v[7]);
        *(u32x4*)(Wf + ((size_t)((n >> 5) * 64 + (k0 >> 4)) * 64 + ((k0 >> 3) & 1) * 32 + (n & 31)) * 8) = w;
    }
}
__device__ __forceinline__ void convert_rows(const float* __restrict__ src, size_t n8, bf16_t* __restrict__ dst, int bid, int nb) {
#pragma unroll 4
    for (size_t i = (size_t)bid * NTH + threadIdx.x; i < n8; i += (size_t)nb * NTH) {
        const float4 a = *(const float4*)(src + i * 8), b = *(const float4*)(src + i * 8 + 4);
        u32x4 w; w.x = pk_bf16(a.x, a.y); w.y = pk_bf16(a.z, a.w); w.z = pk_bf16(b.x, b.y); w.w = pk_bf16(b.z, b.w);
        *(u32x4*)(dst + i * 8) = w;
    }
}

struct EpiPre {
    static constexpr bool PERM = false, AFTER_DRAIN = false;
    float* C; int ldc;
    __device__ __forceinline__ void operator()(const f32x4 (&acc)[2][2][4][2], const Unit& u, int wr, int wc, int fr, int fq) const {
        const int row0 = u.pm * 256 + wr * 64 + fr, col0 = u.pn * 256 + wc * 32 + 4 * fq;
#pragma unroll
        for (int ai = 0; ai < 2; ++ai)
#pragma unroll
            for (int m = 0; m < 4; ++m) { float* rowp = C + (size_t)(row0 + ai * 128 + m * 16) * ldc + col0;
#pragma unroll
                for (int bj = 0; bj < 2; ++bj)
#pragma unroll
                    for (int n = 0; n < 2; ++n) *(f32x4*)(rowp + bj * 128 + n * 16) = acc[ai][bj][m][n]; }
    }
};


struct EpiPreB {
    static constexpr bool PERM = true, AFTER_DRAIN = false;
    bf16_t* O;
    __device__ __forceinline__ void operator()(const f32x4 (&acc)[2][2][4][2], const Unit& u, int wr, int wc, int fr, int fq) const {
        const int row0 = u.pm * 256 + wr * 64 + fr, col0 = u.pn * 256 + wc * 32 + 8 * fq;
#pragma unroll
        for (int ai = 0; ai < 2; ++ai)
#pragma unroll
            for (int m = 0; m < 4; ++m) { bf16_t* rowp = O + (size_t)(row0 + ai * 128 + m * 16) * 1024 + col0;
#pragma unroll
                for (int bj = 0; bj < 2; ++bj) { const f32x4 v0 = acc[ai][bj][m][0], v1 = acc[ai][bj][m][1];
                    u32x4 w; w.x = pk_bf16c(v0[0], v0[1]); w.y = pk_bf16c(v0[2], v0[3]); w.z = pk_bf16c(v1[0], v1[1]); w.w = pk_bf16c(v1[2], v1[3]);
                    *(u32x4*)(rowp + bj * 128) = w; } }
    }
};


struct Route1 {
    bf16_t* HB; bf16_t* KVB; float* G3; float* out;
    __device__ __forceinline__ void put8(int row, int n0, const f32x4& v0, const f32x4& v1) const {
        if (n0 < 2560) {
            const float sc = (n0 >= 1536 && n0 < 2048) ? 0.125f : 1.0f;
            u32x4 w; w.x = pk_bf16c(v0[0] * sc, v0[1] * sc); w.y = pk_bf16c(v0[2] * sc, v0[3] * sc); w.z = pk_bf16c(v1[0] * sc, v1[1] * sc); w.w = pk_bf16c(v1[2] * sc, v1[3] * sc);
            *(u32x4*)(HB + (size_t)row * 2560 + n0) = w;
        } else if (n0 < 3328) {
            const int c = n0 - 2560, i3 = c >> 8, cc = c & 255;
            u32x4 w; w.x = pk_bf16c(v0[0], v0[1]); w.y = pk_bf16c(v0[2], v0[3]); w.z = pk_bf16c(v1[0], v1[1]); w.w = pk_bf16c(v1[2], v1[3]);
            *(u32x4*)(KVB + (size_t)row * 768 + c) = w;
            float* dst = nullptr;
            if (row < MP) {
                if (i3 == 0) dst = out + O_CMPP + (size_t)row * 256 + cc;
                else if (i3 == 1) dst = out + O_SELP + (size_t)row * 256 + cc;
                else { const int b = row >> 11, t = row & 2047; if (t >= TP - 512) dst = out + O_WINP + (size_t)(b * 512 + t - (TP - 512)) * 256 + cc; }
            } else {
                const int sidx = row - MP;
                if (i3 == 0) dst = out + O_CMPS + (size_t)sidx * 256 + cc;
                else if (i3 == 1) dst = out + O_SELS + (size_t)sidx * 256 + cc;
                else dst = out + O_WINS + (size_t)(sidx * 512 + 511) * 256 + cc;
            }
            if (dst) { *(f32x4*)dst = v0; *(f32x4*)(dst + 4) = v1; }
        } else if (n0 < 3352) {
            float* dst = G3 + (size_t)row * 32 + (n0 - 3328);
            *(f32x4*)dst = v0; *(f32x4*)(dst + 4) = v1;
        }
    }
};
struct Epi1 {
    static constexpr bool PERM = true, AFTER_DRAIN = false;
    Route1 R;
    __device__ __forceinline__ void operator()(const f32x4 (&acc)[2][2][4][2], const Unit& u, int wr, int wc, int fr, int fq) const {
        const int row0 = u.pm * 256 + wr * 64 + fr, col0 = u.pn * 256 + wc * 32 + 8 * fq;
#pragma unroll
        for (int ai = 0; ai < 2; ++ai)
#pragma unroll
            for (int m = 0; m < 4; ++m)
#pragma unroll
                for (int bj = 0; bj < 2; ++bj) R.put8(row0 + ai * 128 + m * 16, col0 + bj * 128, acc[ai][bj][m][0], acc[ai][bj][m][1]);
    }
};

typedef float f32x16 __attribute__((ext_vector_type(16)));
template <class EMIT>
__device__ __forceinline__ void sample_gemm32(const bf16_t* __restrict__ A, const bf16_t* __restrict__ Bt, int K, int n0, int lane, EMIT emit) {
    const bf16_t* ap = A + (size_t)(lane & 31) * K + 8 * (lane >> 5);
    const bf16_t* bp = Bt + (size_t)(n0 + (lane & 31)) * K + 8 * (lane >> 5);
    f32x16 acc;
#pragma unroll
    for (int i = 0; i < 16; ++i) acc[i] = 0.f;
#pragma unroll 16
    for (int k = 0; k < K; k += 16) {
        const bf16x8 av = *(const bf16x8*)(ap + k), bv = *(const bf16x8*)(bp + k);
        acc = __builtin_amdgcn_mfma_f32_32x32x16_bf16(av, bv, acc, 0, 0, 0);
    }
#pragma unroll
    for (int r = 0; r < 16; ++r) emit((r & 3) + 8 * (r >> 2) + 4 * (lane >> 5), n0 + (lane & 31), acc[r]);
}

template <class EMIT>
__device__ __forceinline__ void sample_gemm32_wg(const bf16_t* __restrict__ A, const bf16_t* __restrict__ Bt, int K, int n0, PG8_LAS unsigned char* lds, EMIT emit) {
    const int tid = opaque_v(threadIdx.x), lane = tid & 63, wv = tid >> 6;
    const int kq = K / 8;
    const bf16_t* ap = A + (size_t)(lane & 31) * K + 8 * (lane >> 5) + wv * kq;
    const bf16_t* bp = Bt + (size_t)(n0 + (lane & 31)) * K + 8 * (lane >> 5) + wv * kq;
    f32x16 acc;
#pragma unroll
    for (int i = 0; i < 16; ++i) acc[i] = 0.f;
#pragma unroll 8
    for (int k = 0; k < kq; k += 16) {
        const bf16x8 av = *(const bf16x8*)(ap + k), bv = *(const bf16x8*)(bp + k);
        acc = __builtin_amdgcn_mfma_f32_32x32x16_bf16(av, bv, acc, 0, 0, 0);
    }
    PG8_LAS float* P = (PG8_LAS float*)lds;
#pragma unroll
    for (int q = 0; q < 4; ++q) *(PG8_LAS f32x4*)(P + (wv * 64 + lane) * 16 + q * 4) = (f32x4){acc[4 * q], acc[4 * q + 1], acc[4 * q + 2], acc[4 * q + 3]};
    lds_barrier();
    if (wv == 0) {
#pragma unroll
        for (int w = 1; w < 8; ++w)
#pragma unroll
            for (int q = 0; q < 4; ++q) { const f32x4 v = *(const PG8_LAS f32x4*)(P + (w * 64 + lane) * 16 + q * 4); acc[4 * q] += v[0]; acc[4 * q + 1] += v[1]; acc[4 * q + 2] += v[2]; acc[4 * q + 3] += v[3]; }
#pragma unroll
        for (int r = 0; r < 16; ++r) emit((r & 3) + 8 * (r >> 2) + 4 * (lane >> 5), n0 + (lane & 31), acc[r]);
    }
    lds_barrier();
}

typedef float f32x16 __attribute__((ext_vector_type(16)));
__device__ __forceinline__ float bf2f(bf16_t v) { return __uint_as_float((unsigned)v << 16); }
__device__ __forceinline__ float sigm_f(float x) { return 1.f / (1.f + __expf(-x)); }
__device__ __forceinline__ float silu_f(float x) { return x / (1.f + __expf(-x)); }

__device__ __forceinline__ float wsum64(float v) {
    v += __builtin_bit_cast(float, __builtin_amdgcn_update_dpp(0, __builtin_bit_cast(int, v), 0xB1, 0xF, 0xF, true));
    v += __builtin_bit_cast(float, __builtin_amdgcn_update_dpp(0, __builtin_bit_cast(int, v), 0x4E, 0xF, 0xF, true));
    v += __builtin_bit_cast(float, __builtin_amdgcn_update_dpp(0, __builtin_bit_cast(int, v), 0x141, 0xF, 0xF, true));
    v += __builtin_bit_cast(float, __builtin_amdgcn_update_dpp(0, __builtin_bit_cast(int, v), 0x140, 0xF, 0xF, true));
    const int vi = __builtin_bit_cast(int, v);
    const float r0 = __builtin_bit_cast(float, __builtin_amdgcn_readlane(vi, 0)), r1 = __builtin_bit_cast(float, __builtin_amdgcn_readlane(vi, 16));
    const float r2 = __builtin_bit_cast(float, __builtin_amdgcn_readlane(vi, 32)), r3 = __builtin_bit_cast(float, __builtin_amdgcn_readlane(vi, 48));
    return (r0 + r1) + (r2 + r3);
}
constexpr int CV_U = 0;
constexpr int CV_C = 65536;
struct ConvRegs { u32x4 av[4], gv[4]; };
__device__ __forceinline__ void conv_load(const bf16_t* __restrict__ HB, int item, int half, int tid, ConvRegs& r) {
    const int b = item >> 6, t0 = (item & 63) * 32, chb = half * 256;
#pragma unroll
    for (int it = 0; it < 4; ++it) {
        const int vi = tid + it * NTH;
        const int rr = (vi < 62 * 32) ? (vi >> 5) : 61, c8 = (vi & 31) * 8;
        int t = t0 - 30 + rr; t = t < 0 ? 0 : t;
        const bf16_t* h = HB + (size_t)(b * TP + t) * 2560 + chb + c8;
        r.av[it] = *(const u32x4*)h; r.gv[it] = *(const u32x4*)(h + 512);
    }
}
__device__ __forceinline__ void conv_item(const Args& a, unsigned char* ws, PG8_LAS unsigned char* lds, int item, int next_item, ConvRegs& cr) {
    const int tid = opaque_v(threadIdx.x);
    const int b = item >> 6, t0 = (item & 63) * 32;
    const bf16_t* HB = (const bf16_t*)(ws + NB_HB);
    PG8_LAS float* U = (PG8_LAS float*)(lds + CV_U);
    PG8_LAS float* C = (PG8_LAS float*)(lds + CV_C);
    const int chl = tid & 255, tp = tid >> 8;
    const int lane = tid & 63, wv = tid >> 6;
    u32x4 zv[4];
#pragma unroll
    for (int k = 0; k < 4; ++k) zv[k] = *(const u32x4*)(HB + (size_t)(b * TP + t0 + wv * 4 + k) * 2560 + 1024 + lane * 8);
#pragma unroll 1
    for (int half = 0; half < 2; ++half) {
        const int chb = half * 256;
        float w[31];
#pragma unroll
        for (int j = 0; j < 31; ++j) w[j] = a.in[I_CONVW][j * 512 + chb + chl];
        const float bias = a.in[I_CONVB][chb + chl];
#pragma unroll
        for (int it = 0; it < 4; ++it) {
            const int vi = tid + it * NTH;
            if (vi < 62 * 32) {
                const int r = vi >> 5, c8 = (vi & 31) * 8, t = t0 - 30 + r;
                float u[8];
                if (t >= 0) {
                    const u32x4 av = cr.av[it], gv = cr.gv[it];
#pragma unroll
                    for (int i = 0; i < 8; ++i) {
                        const float x = __uint_as_float((i & 1) ? (av[i >> 1] & 0xffff0000u) : (av[i >> 1] << 16));
                        const float g = __uint_as_float((i & 1) ? (gv[i >> 1] & 0xffff0000u) : (gv[i >> 1] << 16));
                        u[i] = x * sigm_f(g);
                    }
                } else {
#pragma unroll
                    for (int i = 0; i < 8; ++i) u[i] = 0.f;
                }
                *(PG8_LAS f32x4*)(U + r * 256 + c8) = (f32x4){u[0], u[1], u[2], u[3]};
                *(PG8_LAS f32x4*)(U + r * 256 + c8 + 4) = (f32x4){u[4], u[5], u[6], u[7]};
                if (t >= TP - 30 && r >= 30) {
                    float* o = a.out + O_CONVP + (size_t)(b * 30 + t - (TP - 30)) * 512 + chb + c8;
                    *(float4*)o = make_float4(u[0], u[1], u[2], u[3]); *(float4*)(o + 4) = make_float4(u[4], u[5], u[6], u[7]);
                }
            }
        }
        lds_barrier();
        conv_load(HB, half ? next_item : item, half ^ 1, tid, cr);
        {
            const int ch = chb + chl;
            float uw[46], acc[16];
#pragma unroll
            for (int r = 0; r < 46; ++r) uw[r] = U[(tp * 16 + r) * 256 + chl];
#pragma unroll
            for (int k = 0; k < 16; ++k) {
                float s_ = bias;
#pragma unroll
                for (int j = 0; j < 31; ++j) s_ = fmaf(w[j], uw[k + j], s_);
                acc[k] = s_;
            }
#pragma unroll
            for (int k = 0; k < 16; ++k) C[(tp * 16 + k) * 516 + ch] = acc[k];
        }
        lds_barrier();
    }
    {
        const float4 g0 = *(const float4*)(a.in[I_CLNG] + lane * 8), g1 = *(const float4*)(a.in[I_CLNG] + lane * 8 + 4);
        const float4 b0 = *(const float4*)(a.in[I_CLNB] + lane * 8), b1 = *(const float4*)(a.in[I_CLNB] + lane * 8 + 4);
        const float gg[8] = {g0.x, g0.y, g0.z, g0.w, g1.x, g1.y, g1.z, g1.w}, bb[8] = {b0.x, b0.y, b0.z, b0.w, b1.x, b1.y, b1.z, b1.w};
#pragma unroll
        for (int k = 0; k < 4; ++k) {
            const int tl = wv * 4 + k;
            const size_t row = (size_t)(b * TP + t0 + tl);
            const f32x4 c0 = *(const PG8_LAS f32x4*)(C + tl * 516 + lane * 8), c1 = *(const PG8_LAS f32x4*)(C + tl * 516 + lane * 8 + 4);
            float c[8] = {c0[0], c0[1], c0[2], c0[3], c1[0], c1[1], c1[2], c1[3]};
            float sm = 0.f;
#pragma unroll
            for (int i = 0; i < 8; ++i) sm += c[i];
            const float mean = wsum64(sm) * (1.f / 512.f);
            float sq = 0.f;
#pragma unroll
            for (int i = 0; i < 8; ++i) { c[i] -= mean; sq += c[i] * c[i]; }
            const float rs = rsqrtf(wsum64(sq) * (1.f / 512.f) + LN_EPS);
            float y[8];
#pragma unroll
            for (int i = 0; i < 8; ++i) {
                const float z = __uint_as_float((i & 1) ? (zv[k][i >> 1] & 0xffff0000u) : (zv[k][i >> 1] << 16));
                y[i] = silu_f(c[i] * rs * gg[i] + bb[i]) * silu_f(z);
            }
            u32x4 o; o.x = pk_bf16(y[0], y[1]); o.y = pk_bf16(y[2], y[3]); o.z = pk_bf16(y[4], y[5]); o.w = pk_bf16(y[6], y[7]);
            *(u32x4*)((bf16_t*)(ws + NB_CATB) + row * 1024 + lane * 8) = o;
        }
    }
    lds_barrier();
}

__device__ __forceinline__ void pool_prompt(const Args& a, unsigned char* ws, int bid, int nb) {
    bf16_t* KCB = (bf16_t*)(ws + NB_KCB);
    for (int i = bid * NTH + threadIdx.x; i < BP * 64 * 256; i += nb * NTH) {
        const int c = i & 255, n = (i >> 8) & 63, b = i >> 14;
        const int kv = c >> 7, g = (c >> 6) & 1;
        const float* w = kv ? a.in[I_WVC] : a.in[I_WKC];
        const float* src = a.out + O_CMPP + (size_t)(b * TP + n * 32) * 256 + c;
        float acc = 0.f;
#pragma unroll 8
        for (int l = 0; l < 32; ++l) acc = fmaf(src[(size_t)l * 256], w[l * 2 + g], acc);
        KCB[i] = (bf16_t)(pk_bf16(acc, 0.f) & 0xffffu);
    }
}

constexpr int A_KT = 0;
constexpr int A_VT = 18432;
constexpr int A_IMPH = 35840;
constexpr int A_IMPS = 68608;
constexpr int A_MASK = 76800;
constexpr float LOG2E = 1.4426950408889634f;

struct KvSrc { const bf16_t* k; const bf16_t* v; int rstride; };

__device__ __forceinline__ void kv_issue(const KvSrc& s, int tid, u32x4& kr, u32x4& vr) {
    const int key = tid >> 3, c8 = tid & 7;
    kr = *(const u32x4*)(s.k + (size_t)key * s.rstride + c8 * 8);
    vr = *(const u32x4*)(s.v + (size_t)key * s.rstride + c8 * 8);
}
__device__ __forceinline__ void kv_write(PG8_LAS unsigned char* lds, int buf, int tid, const u32x4& kr, const u32x4& vr) {
    const int key = tid >> 3, c8 = tid & 7;
    *(PG8_LAS u32x4*)(lds + A_KT + buf * 9216 + key * 144 + c8 * 16) = kr;
    PG8_LAS bf16_t* vt = (PG8_LAS bf16_t*)(lds + A_VT + buf * 8704);
#pragma unroll
    for (int i = 0; i < 4; ++i) { vt[(c8 * 8 + 2 * i) * 68 + key] = (bf16_t)(vr[i] & 0xffffu); vt[(c8 * 8 + 2 * i + 1) * 68 + key] = (bf16_t)(vr[i] >> 16); }
}

__device__ __forceinline__ void attn_block(const int MODE, PG8_LAS unsigned char* lds, int buf, const bf16x8 (&qf)[4], int lane, float kslope, float base, int kmax, int kmin,
                                           float& m, float& l, f32x16 (&o)[2], f32x16 (&x)[2]) {
    const int lr = lane & 31, h = lane >> 5;
    const PG8_LAS unsigned char* kt_p = lds + A_KT + buf * 9216 + lr * 144 + h * 16;
#pragma unroll
    for (int kt = 0; kt < 2; ++kt) {
#pragma unroll
        for (int i = 0; i < 16; ++i) x[kt][i] = 0.f;
#pragma unroll
        for (int s = 0; s < 4; ++s) {
            const bf16x8 kf = *(const PG8_LAS bf16x8*)(kt_p + kt * 32 * 144 + s * 32);
            x[kt] = __builtin_amdgcn_mfma_f32_32x32x16_bf16(kf, qf[s], x[kt], 0, 0, 0);
        }
    }
    const float bh = base + kslope * (float)(4 * h);
    float mx = -INFINITY;
#pragma unroll
    for (int kt = 0; kt < 2; ++kt)
#pragma unroll
        for (int i = 0; i < 16; ++i) {
            const int kc = kt * 32 + (i & 3) + 8 * (i >> 2);
            x[kt][i] = fmaf(x[kt][i], LOG2E, fmaf(kslope, (float)kc, bh));
        }
    if (MODE) {
        const int hi = kmax - 4 * h, lo = kmin - 4 * h;
#pragma unroll
        for (int kt = 0; kt < 2; ++kt)
#pragma unroll
            for (int i = 0; i < 16; ++i) {
                const int kc = kt * 32 + (i & 3) + 8 * (i >> 2);
                x[kt][i] = (kc > hi || kc < lo) ? -INFINITY : x[kt][i];
            }
    }
#pragma unroll
    for (int kt = 0; kt < 2; ++kt)
#pragma unroll
        for (int i = 0; i < 16; ++i) mx = fmaxf(mx, x[kt][i]);
    mx = fmaxf(mx, __shfl_xor(mx, 32));
    const float mn = fmaxf(m, mx);
    const float corr = __builtin_amdgcn_exp2f(m - mn);
    const bool grew = __any(mn > m);
    m = mn;
    float ls = 0.f;
#pragma unroll
    for (int kt = 0; kt < 2; ++kt)
#pragma unroll
        for (int i = 0; i < 16; ++i) { const float pv = __builtin_amdgcn_exp2f(x[kt][i] - mn); x[kt][i] = pv; ls += pv; }
    l = fmaf(l, corr, ls);
    if (grew) {
#pragma unroll
        for (int dt = 0; dt < 2; ++dt)
#pragma unroll
            for (int i = 0; i < 16; ++i) o[dt][i] *= corr;
    }
    const PG8_LAS unsigned char* vt_p = lds + A_VT + buf * 8704 + lr * 136 + h * 8;
#pragma unroll
    for (int kt = 0; kt < 2; ++kt)
#pragma unroll
        for (int s = 0; s < 2; ++s) {
            u32x4 pw; pw.x = pk_bf16(x[kt][8 * s + 0], x[kt][8 * s + 1]); pw.y = pk_bf16(x[kt][8 * s + 2], x[kt][8 * s + 3]);
            pw.z = pk_bf16(x[kt][8 * s + 4], x[kt][8 * s + 5]); pw.w = pk_bf16(x[kt][8 * s + 6], x[kt][8 * s + 7]);
            const bf16x8 pf = __builtin_bit_cast(bf16x8, pw);
#pragma unroll
            for (int dt = 0; dt < 2; ++dt) {
                const PG8_LAS unsigned char* vp = vt_p + dt * 32 * 136 + (kt * 32 + s * 16) * 2;
                typedef unsigned u32x2 __attribute__((ext_vector_type(2)));
                const u32x2 v0 = *(const PG8_LAS u32x2*)vp, v1 = *(const PG8_LAS u32x2*)(vp + 16);
                u32x4 vw; vw.x = v0.x; vw.y = v0.y; vw.z = v1.x; vw.w = v1.y;
                o[dt] = __builtin_amdgcn_mfma_f32_32x32x16_bf16(__builtin_bit_cast(bf16x8, vw), pf, o[dt], 0, 0, 0);
            }
        }
}

__device__ __forceinline__ void attn_item(const Args& a, unsigned char* ws, PG8_LAS unsigned char* lds, int b, int g, int qb) {
    const int tid = opaque_v(threadIdx.x), lane = tid & 63, wv = __builtin_amdgcn_readfirstlane(tid >> 6);
    const int lr = lane & 31, h = lane >> 5;
    const int r = wv >> 1, th = wv & 1, hh = g * 4 + r;
    const int t0 = qb * 64, tb = qb;
    const int qloc = th * 32 + lr;
    const int qpos = t0 + qloc;
    const size_t qrow = (size_t)b * TP + qpos;
    const bf16_t* HB = (const bf16_t*)(ws + NB_HB);
    const bf16_t* KVB = (const bf16_t*)(ws + NB_KVB);
    const float slope2 = __builtin_amdgcn_exp2f(-(float)(hh + 1)) * LOG2E;
    bf16x8 qf[4];
#pragma unroll
    for (int s = 0; s < 4; ++s) qf[s] = *(const bf16x8*)(HB + qrow * 2560 + 1536 + hh * 64 + s * 16 + h * 8);
    const float* g3p = (const float*)(ws + NB_G3) + qrow * 32 + hh * 3;
    const float gc = sigm_f(g3p[0]), gs = sigm_f(g3p[1]), gw = sigm_f(g3p[2]);
    f32x16 res[2], o[2], x[2];
#pragma unroll
    for (int dt = 0; dt < 2; ++dt)
#pragma unroll
        for (int i = 0; i < 16; ++i) { res[dt][i] = 0.f; o[dt][i] = 0.f; }
    float m = -1e30f, l = 0.f;
    u32x4 kr, vr;
    PG8_LAS float* IMPH = (PG8_LAS float*)(lds + A_IMPH);
    PG8_LAS float* IMPS = (PG8_LAS float*)(lds + A_IMPS);
    PG8_LAS unsigned* MASK = (PG8_LAS unsigned*)(lds + A_MASK);

    {
        const bf16_t* kc = (const bf16_t*)(ws + NB_KCB) + (size_t)b * 64 * 256 + g * 64;
        KvSrc s{kc, kc + 128, 256};
        kv_issue(s, tid, kr, vr); kv_write(lds, 0, tid, kr, vr);
        if (tid < 64) MASK[tid] = 0u;
        __syncthreads();
        const int nmax = (qpos >= 31) ? ((qpos - 31) >> 5) : -1;
        attn_block(1, lds, 0, qf, lane, slope2 * 32.f, slope2 * (float)(31 - qpos), nmax, 0, m, l, o, x);
        const float lt = l + __shfl_xor(l, 32);
        const float inv = (nmax >= 0) ? 1.f / lt : 0.f;
        const float sc = gc * inv;
#pragma unroll
        for (int dt = 0; dt < 2; ++dt)
#pragma unroll
            for (int i = 0; i < 16; ++i) { res[dt][i] = o[dt][i] * sc; o[dt][i] = 0.f; }
        if (tb >= 16) {
#pragma unroll
            for (int kt = 0; kt < 2; ++kt)
#pragma unroll
                for (int c = 0; c < 4; ++c)
#pragma unroll
                    for (int e = 0; e < 2; ++e)
                        IMPH[(r * 64 + qloc) * 32 + kt * 16 + 4 * c + 2 * h + e] = (nmax >= 0) ? (x[kt][4 * c + 2 * e] + x[kt][4 * c + 2 * e + 1]) * inv : 0.f;
        }
        m = -1e30f; l = 0.f;
        __syncthreads();
    }
    if (tb >= 16) {
        const int tq = opaque_v(tid);
        const int q = tq >> 3, jq = tq & 7;
        float v4[4];
#pragma unroll
        for (int e = 0; e < 4; ++e) {
            const int j = jq * 4 + e;
            float v = IMPH[(0 * 64 + q) * 32 + j] + IMPH[(1 * 64 + q) * 32 + j] + IMPH[(2 * 64 + q) * 32 + j] + IMPH[(3 * 64 + q) * 32 + j];
            if (j == 0 || j == tb || j == tb - 1) v = 1e4f;
            IMPS[q * 32 + j] = v; v4[e] = v;
        }
        __syncthreads();
        unsigned bits = 0u;
#pragma unroll
        for (int e = 0; e < 4; ++e) {
            const int j = jq * 4 + e;
            int rank = 0;
            for (int i = 0; i <= tb; ++i) { const float vi = IMPS[q * 32 + i]; rank += (vi > v4[e] || (vi == v4[e] && i < j)) ? 1 : 0; }
            if (j <= tb && rank < 16) bits |= 1u << j;
        }
        if (bits) atomicOr((unsigned*)&MASK[q], bits);
    } else {
        if (tid < 64) MASK[tid] = (2u << tb) - 1u;
    }
    __syncthreads();
    const unsigned selmask = MASK[qloc];

    {
        const bf16_t* kb = KVB + (size_t)b * TP * 768 + 256 + g * 64;
        { KvSrc s{kb, kb + 128, 768}; kv_issue(s, tid, kr, vr); kv_write(lds, 0, tid, kr, vr); }
        __syncthreads();
        for (int j = 0; j <= tb; ++j) {
            if (j < tb) { KvSrc s{kb + (size_t)(j + 1) * 64 * 768, kb + (size_t)(j + 1) * 64 * 768 + 128, 768}; kv_issue(s, tid, kr, vr); }
            const float base = ((selmask >> j) & 1u) ? slope2 * (float)(j * 64 - qpos) : -INFINITY;
            if (__any((selmask >> j) & 1u))
                attn_block(j == tb, lds, j & 1, qf, lane, slope2, base, qloc, 0, m, l, o, x);
            if (j < tb) kv_write(lds, (j + 1) & 1, tid, kr, vr);
            __syncthreads();
        }
        const float lt = l + __shfl_xor(l, 32);
        const float sc = gs / lt;
#pragma unroll
        for (int dt = 0; dt < 2; ++dt)
#pragma unroll
            for (int i = 0; i < 16; ++i) { res[dt][i] = fmaf(o[dt][i], sc, res[dt][i]); o[dt][i] = 0.f; }
        m = -1e30f; l = 0.f;
    }
    {
        const int jlo = (tb >= 8) ? tb - 8 : 0;
        const bf16_t* kb = KVB + (size_t)b * TP * 768 + 512 + g * 64;
        { KvSrc s{kb + (size_t)jlo * 64 * 768, kb + (size_t)jlo * 64 * 768 + 128, 768}; kv_issue(s, tid, kr, vr); kv_write(lds, 0, tid, kr, vr); }
        __syncthreads();
        for (int j = jlo; j <= tb; ++j) {
            const int bi = (j - jlo) & 1;
            if (j < tb) { KvSrc s{kb + (size_t)(j + 1) * 64 * 768, kb + (size_t)(j + 1) * 64 * 768 + 128, 768}; kv_issue(s, tid, kr, vr); }
            const float base = slope2 * (float)(j * 64 - qpos);
            attn_block((j == tb) || (j == tb - 8), lds, bi, qf, lane, slope2, base, (j == tb) ? qloc : 64, (j == tb - 8) ? qpos - 511 - j * 64 : 0, m, l, o, x);
            if (j < tb) kv_write(lds, bi ^ 1, tid, kr, vr);
            __syncthreads();
        }
        const float lt = l + __shfl_xor(l, 32);
        const float sc = gw / lt;
#pragma unroll
        for (int dt = 0; dt < 2; ++dt)
#pragma unroll
            for (int i = 0; i < 16; ++i) res[dt][i] = fmaf(o[dt][i], sc, res[dt][i]);
    }
    {
        const size_t qrow2 = (size_t)b * TP + t0 + th * 32 + (opaque_v(lane) & 31);
        const bf16_t* zb = HB + qrow2 * 2560 + 2048 + hh * 64;
        bf16_t* dst = (bf16_t*)(ws + NB_CATB) + qrow2 * 1024 + 512 + hh * 64;
        typedef unsigned u32x2 __attribute__((ext_vector_type(2)));
#pragma unroll
        for (int dt = 0; dt < 2; ++dt)
#pragma unroll
            for (int c = 0; c < 4; ++c) {
                const int d = dt * 32 + 8 * c + 4 * h;
                const u32x2 zv = *(const u32x2*)(zb + d);
                const float z0 = __uint_as_float(zv.x << 16), z1 = __uint_as_float(zv.x & 0xffff0000u), z2 = __uint_as_float(zv.y << 16), z3 = __uint_as_float(zv.y & 0xffff0000u);
                u32x2 w; w.x = pk_bf16(res[dt][4 * c + 0] * silu_f(z0), res[dt][4 * c + 1] * silu_f(z1)); w.y = pk_bf16(res[dt][4 * c + 2] * silu_f(z2), res[dt][4 * c + 3] * silu_f(z3));
                *(u32x2*)(dst + d) = w;
            }
    }
}

constexpr int XSH_ROWS = 16640;
__device__ __forceinline__ float wave_sum(float v) {
    v += __builtin_bit_cast(float, __builtin_amdgcn_update_dpp(0, __builtin_bit_cast(int, v), 0xB1, 0xF, 0xF, true));
    v += __builtin_bit_cast(float, __builtin_amdgcn_update_dpp(0, __builtin_bit_cast(int, v), 0x4E, 0xF, 0xF, true));
    v += __builtin_bit_cast(float, __builtin_amdgcn_update_dpp(0, __builtin_bit_cast(int, v), 0x141, 0xF, 0xF, true));
    v += __builtin_bit_cast(float, __builtin_amdgcn_update_dpp(0, __builtin_bit_cast(int, v), 0x140, 0xF, 0xF, true));
    const int vi = __builtin_bit_cast(int, v);
    const float r0 = __builtin_bit_cast(float, __builtin_amdgcn_readlane(vi, 0)), r1 = __builtin_bit_cast(float, __builtin_amdgcn_readlane(vi, 16));
    const float r2 = __builtin_bit_cast(float, __builtin_amdgcn_readlane(vi, 32)), r3 = __builtin_bit_cast(float, __builtin_amdgcn_readlane(vi, 48));
    return (r0 + r1) + (r2 + r3);
}
__device__ __forceinline__ void ld_row16(const float* __restrict__ src, int lane, float (&x)[16]) {
#pragma unroll
    for (int q = 0; q < 4; ++q) { const float4 v = *(const float4*)(src + q * 256 + lane * 4); x[4 * q] = v.x; x[4 * q + 1] = v.y; x[4 * q + 2] = v.z; x[4 * q + 3] = v.w; }
}
__device__ __forceinline__ void ld_row16b(const bf16_t* __restrict__ src, int lane, float (&x)[16]) {
#pragma unroll
    for (int q = 0; q < 4; ++q) { const uint2 v = *(const uint2*)(src + q * 256 + lane * 4);
        x[4 * q] = __uint_as_float(v.x << 16); x[4 * q + 1] = __uint_as_float(v.x & 0xffff0000u); x[4 * q + 2] = __uint_as_float(v.y << 16); x[4 * q + 3] = __uint_as_float(v.y & 0xffff0000u); }
}
__device__ __forceinline__ void ln_calc16(const float* __restrict__ g, const float* __restrict__ bta, int lane, float (&x)[16]) {
    float sm = 0.f;
#pragma unroll
    for (int i = 0; i < 16; ++i) sm += x[i];
    const float mean = wave_sum(sm) * (1.f / 1024.f);
    float sq = 0.f;
#pragma unroll
    for (int i = 0; i < 16; ++i) { x[i] -= mean; sq += x[i] * x[i]; }
    const float rs = rsqrtf(wave_sum(sq) * (1.f / 1024.f) + LN_EPS);
#pragma unroll
    for (int q = 0; q < 4; ++q) {
        const float4 gv = *(const float4*)(g + q * 256 + lane * 4), bv = *(const float4*)(bta + q * 256 + lane * 4);
        x[4 * q] = x[4 * q] * rs * gv.x + bv.x; x[4 * q + 1] = x[4 * q + 1] * rs * gv.y + bv.y; x[4 * q + 2] = x[4 * q + 2] * rs * gv.z + bv.z; x[4 * q + 3] = x[4 * q + 3] * rs * gv.w + bv.w;
    }
}
__device__ __forceinline__ void ln_calc16r(const float (&g)[16], const float (&bta)[16], float (&x)[16]) {
    float sm = 0.f;
#pragma unroll
    for (int i = 0; i < 16; ++i) sm += x[i];
    const float mean = wave_sum(sm) * (1.f / 1024.f);
    float sq = 0.f;
#pragma unroll
    for (int i = 0; i < 16; ++i) { x[i] -= mean; sq += x[i] * x[i]; }
    const float rs = rsqrtf(wave_sum(sq) * (1.f / 1024.f) + LN_EPS);
#pragma unroll
    for (int i = 0; i < 16; ++i) x[i] = x[i] * rs * g[i] + bta[i];
}
__device__ __forceinline__ void ln_row16(const float* __restrict__ src, const float* __restrict__ g, const float* __restrict__ bta, int lane, float (&x)[16]) {
    ld_row16(src, lane, x); ln_calc16(g, bta, lane, x);
}
constexpr int LR_A = 0;
constexpr int LR_MU = 132096;
__device__ __forceinline__ void store_x1_xsh(const Args& a, unsigned char* ws, PG8_LAS unsigned char* lds, size_t xrow, int lrow, int lane, const float (&cur)[16], const float (&prev)[16]) {
    typedef unsigned u32x2 __attribute__((ext_vector_type(2)));
#pragma unroll
    for (int n = 0; n < 6; ++n) {
        const PG8_LAS float* mu = (const PG8_LAS float*)(lds + LR_MU) + n * 1024 + lane * 4;
        u32x2 w[4];
#pragma unroll
        for (int q = 0; q < 4; ++q) { const f32x4 m4 = *(const PG8_LAS f32x4*)(mu + q * 256);
            w[q].x = pk_bf16(fmaf(prev[4 * q] - cur[4 * q], m4[0], cur[4 * q]), fmaf(prev[4 * q + 1] - cur[4 * q + 1], m4[1], cur[4 * q + 1]));
            w[q].y = pk_bf16(fmaf(prev[4 * q + 2] - cur[4 * q + 2], m4[2], cur[4 * q + 2]), fmaf(prev[4 * q + 3] - cur[4 * q + 3], m4[3], cur[4 * q + 3])); }
        if (n < 4 || lrow < 0) {
            bf16_t* dst = (bf16_t*)(ws + NB_XSH) + ((size_t)n * XSH_ROWS + xrow) * 1024 + lane * 4;
#pragma unroll
            for (int q = 0; q < 4; ++q) *(u32x2*)(dst + q * 256) = w[q];
        } else {
            PG8_LAS bf16_t* dst = (PG8_LAS bf16_t*)(lds + LR_A) + ((n - 4) * 32 + lrow) * 1032 + lane * 4;
#pragma unroll
            for (int q = 0; q < 4; ++q) *(PG8_LAS u32x2*)(dst + q * 256) = w[q];
        }
    }
}
template <class ROWMAP>
__device__ __forceinline__ void lora_pass(unsigned char* ws, PG8_LAS unsigned char* lds, int tid, ROWMAP rowmap) {
    const int lane = tid & 63, wv = tid >> 6, lr = lane & 31, h = lane >> 5;
    const int which = wv >> 2, kq = wv & 3;
    PG8_LAS bf16_t* AT = (PG8_LAS bf16_t*)(lds + LR_A) + which * 32 * 1032;
    PG8_LAS float* P = (PG8_LAS float*)(lds + LR_A);
    lds_barrier();
    const bf16_t* Bt = (const bf16_t*)(ws + (which ? NB_A1T : NB_W1T));
    f32x16 acc0, acc1;
#pragma unroll
    for (int i = 0; i < 16; ++i) { acc0[i] = 0.f; acc1[i] = 0.f; }
#pragma unroll
    for (int s = 0; s < 16; ++s) {
        const int k = kq * 256 + s * 16 + h * 8;
        const bf16x8 av = *(const PG8_LAS bf16x8*)(AT + lr * 1032 + k);
        const bf16x8 b0 = *(const bf16x8*)(Bt + ((size_t)(kq * 16 + s) * 64 + lane) * 8), b1 = *(const bf16x8*)(Bt + ((size_t)(64 + kq * 16 + s) * 64 + lane) * 8);
        acc0 = __builtin_amdgcn_mfma_f32_32x32x16_bf16(av, b0, acc0, 0, 0, 0);
        acc1 = __builtin_amdgcn_mfma_f32_32x32x16_bf16(av, b1, acc1, 0, 0, 0);
    }
    lds_barrier();
#pragma unroll
    for (int q = 0; q < 4; ++q) {
        *(PG8_LAS f32x4*)(P + (wv * 64 + lane) * 32 + q * 4) = (f32x4){acc0[4 * q], acc0[4 * q + 1], acc0[4 * q + 2], acc0[4 * q + 3]};
        *(PG8_LAS f32x4*)(P + (wv * 64 + lane) * 32 + 16 + q * 4) = (f32x4){acc1[4 * q], acc1[4 * q + 1], acc1[4 * q + 2], acc1[4 * q + 3]};
    }
    lds_barrier();
    if (wv < 4) {
        const int wh = wv >> 1, half = wv & 1;
        float sum[16];
#pragma unroll
        for (int i = 0; i < 16; ++i) sum[i] = 0.f;
#pragma unroll
        for (int w = 0; w < 4; ++w)
#pragma unroll
            for (int q = 0; q < 4; ++q) { const f32x4 v = *(const PG8_LAS f32x4*)(P + ((wh * 4 + w) * 64 + lane) * 32 + half * 16 + q * 4); sum[4 * q] += v[0]; sum[4 * q + 1] += v[1]; sum[4 * q + 2] += v[2]; sum[4 * q + 3] += v[3]; }
        bf16_t* dst = (bf16_t*)(ws + (wh ? NB_AWB : NB_TWB)) + half * 32 + lr;
#pragma unroll
        for (int i = 0; i < 16; ++i) { const int rl = (i & 3) + 8 * (i >> 2) + 4 * h; const float v = wh ? sum[i] : tanhf(sum[i]); dst[rowmap(rl) * 64] = (bf16_t)(pk_bf16c(v, 0.f) & 0xffffu); }
    }
    lds_barrier();
}
__device__ __forceinline__ void phase_lns(const Args& a, unsigned char* ws, PG8_LAS unsigned char* lds, int bid, int nb) {
    const int tid = opaque_v(threadIdx.x), lane = tid & 63, wv = tid >> 6;
    const bf16_t* PRE = (const bf16_t*)((const float*)ws + WS_PRE);
    float g[16], bta[16];
    ld_row16(a.in[I_LNG], lane, g); ld_row16(a.in[I_LNB], lane, bta);
    for (int i = tid; i < 6 * 256; i += NTH) *(PG8_LAS f32x4*)(lds + LR_MU + i * 16) = *(const f32x4*)(a.in[I_MU] + i * 4);
    __syncthreads();
    for (int blk = bid; blk < 256; blk += nb) {
        const int r0 = blk * 64 + wv * 8;
        float prev[16], cur[16];
        if ((r0 & (TP - 1)) == 0) {
#pragma unroll
            for (int i = 0; i < 16; ++i) prev[i] = 0.f;
        } else { ld_row16b(PRE + (size_t)(r0 - 1) * 1024, lane, prev); ln_calc16r(g, bta, prev); }
        float nxt[16];
        ld_row16b(PRE + (size_t)r0 * 1024, lane, nxt);
#pragma unroll 1
        for (int k = 0; k < 8; ++k) {
            const int row = r0 + k;
#pragma unroll
            for (int i = 0; i < 16; ++i) cur[i] = nxt[i];
            if (k + 1 < 8) ld_row16b(PRE + (size_t)(row + 1) * 1024, lane, nxt);
            ln_calc16r(g, bta, cur);
            store_x1_xsh(a, ws, lds, row, wv * 4 + (k & 3), lane, cur, prev);
            if ((row & (TP - 1)) == TP - 1) {
                float* so = a.out + O_SHP + (size_t)(row >> 11) * 1024 + lane * 4;
#pragma unroll
                for (int q = 0; q < 4; ++q) *(float4*)(so + q * 256) = make_float4(cur[4 * q], cur[4 * q + 1], cur[4 * q + 2], cur[4 * q + 3]);
            }
#pragma unroll
            for (int i = 0; i < 16; ++i) prev[i] = cur[i];
            if ((k & 3) == 3) {
                const int rbase = blk * 64 + (k & 4);
                lora_pass(ws, lds, tid, [&](int rl) { return (size_t)(rbase + (rl >> 2) * 8 + (rl & 3)); });
            }
        }
    }
    for (int s = bid * 8 + wv; s < BS; s += nb * 8) {
        float prev[16], cur[16];
        const float* sp = a.in[I_SSHIFT] + (size_t)s * 1024 + lane * 4;
#pragma unroll
        for (int q = 0; q < 4; ++q) { const float4 v = *(const float4*)(sp + q * 256); prev[4 * q] = v.x; prev[4 * q + 1] = v.y; prev[4 * q + 2] = v.z; prev[4 * q + 3] = v.w; }
        ld_row16b(PRE + (size_t)(MP + s) * 1024, lane, cur); ln_calc16r(g, bta, cur);
        store_x1_xsh(a, ws, lds, MP + s, -1, lane, cur, prev);
        float* so = a.out + O_SHS + (size_t)s * 1024 + lane * 4;
#pragma unroll
        for (int q = 0; q < 4; ++q) *(float4*)(so + q * 256) = make_float4(cur[4 * q], cur[4 * q + 1], cur[4 * q + 2], cur[4 * q + 3]);
    }
}

struct Order3 {
    pg8::StaticOrder so;
    __device__ void init(int G, int c) { so.init(MP, 4096, G, c); }
    __device__ bool next(int i, Unit& u) const { Unit v; if (!so.next(i, v)) return false; const int n = v.pn >> 2; u.pm = n * 65 + v.pm; u.pn = v.pn; return true; }
    __device__ __forceinline__ void a_ready(const Unit&) const {}
    __device__ __forceinline__ void done(const Unit&) const {}
};
struct Epi3 {
    static constexpr bool PERM = true, AFTER_DRAIN = false;
    bf16_t* O;
    __device__ __forceinline__ void operator()(const f32x4 (&acc)[2][2][4][2], const Unit& u, int wr, int wc, int fr, int fq) const {
        const int n = u.pn >> 2, pm = u.pm - n * 65, pn = u.pn & 3;
        const int row0 = pm * 256 + wr * 64 + fr, col0 = pn * 256 + wc * 32 + 8 * fq;
        bf16_t* base = O + (size_t)n * XSH_ROWS * 1024;
#pragma unroll
        for (int ai = 0; ai < 2; ++ai)
#pragma unroll
            for (int m = 0; m < 4; ++m) { bf16_t* rowp = base + (size_t)(row0 + ai * 128 + m * 16) * 1024 + col0;
#pragma unroll
                for (int bj = 0; bj < 2; ++bj) { const f32x4 v0 = acc[ai][bj][m][0], v1 = acc[ai][bj][m][1];
                    u32x4 w; w.x = pk_bf16c(v0[0], v0[1]); w.y = pk_bf16c(v0[2], v0[3]); w.z = pk_bf16c(v1[0], v1[1]); w.w = pk_bf16c(v1[2], v1[3]);
                    *(u32x4*)(rowp + bj * 128) = w; } }
    }
};
struct EpiPreRes {
    static constexpr bool PERM = true, AFTER_DRAIN = false;
    bf16_t* C; const bf16_t* X;
    __device__ __forceinline__ void operator()(const f32x4 (&acc)[2][2][4][2], const Unit& u, int wr, int wc, int fr, int fq) const {
        const int row0 = u.pm * 256 + wr * 64 + fr, col0 = u.pn * 256 + wc * 32 + 8 * fq;
#pragma unroll
        for (int ai = 0; ai < 2; ++ai)
#pragma unroll
            for (int m = 0; m < 4; ++m) { const size_t off = (size_t)(row0 + ai * 128 + m * 16) * 1024 + col0;
#pragma unroll
                for (int bj = 0; bj < 2; ++bj) { const f32x4 v0 = acc[ai][bj][m][0], v1 = acc[ai][bj][m][1];
                    const u32x4 xw = *(const u32x4*)(X + off + bj * 128);
                    u32x4 w;
                    w.x = pk_bf16c(fmaf(ALPHA, __uint_as_float(xw.x << 16), v0[0]), fmaf(ALPHA, __uint_as_float(xw.x & 0xffff0000u), v0[1]));
                    w.y = pk_bf16c(fmaf(ALPHA, __uint_as_float(xw.y << 16), v0[2]), fmaf(ALPHA, __uint_as_float(xw.y & 0xffff0000u), v0[3]));
                    w.z = pk_bf16c(fmaf(ALPHA, __uint_as_float(xw.z << 16), v1[0]), fmaf(ALPHA, __uint_as_float(xw.z & 0xffff0000u), v1[1]));
                    w.w = pk_bf16c(fmaf(ALPHA, __uint_as_float(xw.w << 16), v1[2]), fmaf(ALPHA, __uint_as_float(xw.w & 0xffff0000u), v1[3]));
                    *(u32x4*)(C + off + bj * 128) = w; } }
    }
};

constexpr int LR_A0 = 0;
constexpr int LR_P = 67584;
struct LoraRegs { u32x4 v[8]; };
__device__ __forceinline__ void lora_load(unsigned char* ws, int task, int tid, LoraRegs& r) {
    const int rt = task >> 1, which = task & 1;
    const bf16_t* A = (const bf16_t*)(ws + NB_XSH) + ((size_t)(4 + which) * XSH_ROWS + (size_t)rt * 32) * 1024;
#pragma unroll
    for (int i = 0; i < 8; ++i) { const int idx = tid + i * NTH; r.v[i] = *(const u32x4*)(A + (size_t)(idx >> 7) * 1024 + (idx & 127) * 8); }
}
__device__ __forceinline__ void lora_tile(unsigned char* ws, PG8_LAS unsigned char* lds, int task, int tid, const LoraRegs& r) {
    const int rt = task >> 1, which = task & 1;
    const int lane = tid & 63, wv = tid >> 6, lr = lane & 31, h = lane >> 5;
    PG8_LAS bf16_t* AT = (PG8_LAS bf16_t*)(lds + LR_A0);
    PG8_LAS float* P = (PG8_LAS float*)(lds + LR_P);
#pragma unroll
    for (int i = 0; i < 8; ++i) { const int idx = tid + i * NTH; *(PG8_LAS u32x4*)(AT + (idx >> 7) * 1032 + (idx & 127) * 8) = r.v[i]; }
    __syncthreads();
    const bf16_t* Bt = (const bf16_t*)(ws + (which ? NB_A1T : NB_W1T));
    f32x16 acc0, acc1;
#pragma unroll
    for (int i = 0; i < 16; ++i) { acc0[i] = 0.f; acc1[i] = 0.f; }
#pragma unroll
    for (int s = 0; s < 8; ++s) {
        const int k = wv * 128 + s * 16 + h * 8;
        const bf16x8 av = *(const PG8_LAS bf16x8*)(AT + lr * 1032 + k);
        const bf16x8 b0 = *(const bf16x8*)(Bt + ((size_t)(wv * 8 + s) * 64 + lane) * 8), b1 = *(const bf16x8*)(Bt + ((size_t)(64 + wv * 8 + s) * 64 + lane) * 8);
        acc0 = __builtin_amdgcn_mfma_f32_32x32x16_bf16(av, b0, acc0, 0, 0, 0);
        acc1 = __builtin_amdgcn_mfma_f32_32x32x16_bf16(av, b1, acc1, 0, 0, 0);
    }
#pragma unroll
    for (int q = 0; q < 4; ++q) {
        *(PG8_LAS f32x4*)(P + (wv * 64 + lane) * 32 + q * 4) = (f32x4){acc0[4 * q], acc0[4 * q + 1], acc0[4 * q + 2], acc0[4 * q + 3]};
        *(PG8_LAS f32x4*)(P + (wv * 64 + lane) * 32 + 16 + q * 4) = (f32x4){acc1[4 * q], acc1[4 * q + 1], acc1[4 * q + 2], acc1[4 * q + 3]};
    }
    __syncthreads();
    if (wv < 2) {
        float sum[16];
#pragma unroll
        for (int i = 0; i < 16; ++i) sum[i] = 0.f;
#pragma unroll
        for (int w = 0; w < 8; ++w)
#pragma unroll
            for (int q = 0; q < 4; ++q) { const f32x4 v = *(const PG8_LAS f32x4*)(P + (w * 64 + lane) * 32 + wv * 16 + q * 4); sum[4 * q] += v[0]; sum[4 * q + 1] += v[1]; sum[4 * q + 2] += v[2]; sum[4 * q + 3] += v[3]; }
        bf16_t* dst = (bf16_t*)(ws + (which ? NB_AWB : NB_TWB)) + (size_t)rt * 32 * 64 + wv * 32 + lr;
#pragma unroll
        for (int i = 0; i < 16; ++i) { const int row = (i & 3) + 8 * (i >> 2) + 4 * h; const float v = which ? sum[i] : tanhf(sum[i]); dst[(size_t)row * 64] = (bf16_t)(pk_bf16c(v, 0.f) & 0xffffu); }
    }
    __syncthreads();
}

__device__ __forceinline__ float dpp_red16f(float v) {
    v += __builtin_bit_cast(float, __builtin_amdgcn_update_dpp(0, __builtin_bit_cast(int, v), 0xB1, 0xF, 0xF, true));
    v += __builtin_bit_cast(float, __builtin_amdgcn_update_dpp(0, __builtin_bit_cast(int, v), 0x4E, 0xF, 0xF, true));
    v += __builtin_bit_cast(float, __builtin_amdgcn_update_dpp(0, __builtin_bit_cast(int, v), 0x141, 0xF, 0xF, true));
    v += __builtin_bit_cast(float, __builtin_amdgcn_update_dpp(0, __builtin_bit_cast(int, v), 0x140, 0xF, 0xF, true));
    return v;
}
__device__ __forceinline__ void prep2_task(const Args& a, unsigned char* ws, int rt, int hd, int lane) {
    const int lr = lane & 31, h2 = lane >> 5;
    const size_t row0 = (size_t)rt * 32;
    const bf16_t* W2T = (const bf16_t*)(ws + NB_W2T); const bf16_t* A2T = (const bf16_t*)(ws + NB_A2T);
    const bf16_t* TWB = (const bf16_t*)(ws + NB_TWB); const bf16_t* AWB = (const bf16_t*)(ws + NB_AWB);
    f32x16 aw[2], aa[2];
#pragma unroll
    for (int ct = 0; ct < 2; ++ct)
#pragma unroll
        for (int i = 0; i < 16; ++i) { aw[ct][i] = 0.f; aa[ct][i] = 0.f; }
#pragma unroll
    for (int s = 0; s < 4; ++s) {
        const bf16x8 at = *(const bf16x8*)(TWB + (row0 + lr) * 64 + s * 16 + h2 * 8), aa_ = *(const bf16x8*)(AWB + (row0 + lr) * 64 + s * 16 + h2 * 8);
#pragma unroll
        for (int ct = 0; ct < 2; ++ct) {
            const size_t e = (size_t)hd * 64 + ct * 32 + lr;
            const bf16x8 w2 = *(const bf16x8*)(W2T + e * 64 + s * 16 + h2 * 8), a2 = *(const bf16x8*)(A2T + e * 64 + s * 16 + h2 * 8);
            aw[ct] = __builtin_amdgcn_mfma_f32_32x32x16_bf16(at, w2, aw[ct], 0, 0, 0);
            aa[ct] = __builtin_amdgcn_mfma_f32_32x32x16_bf16(aa_, a2, aa[ct], 0, 0, 0);
        }
    }
    const bf16_t* KB = (const bf16_t*)(ws + NB_RKVZ) + (size_t)1 * XSH_ROWS * 1024;
    const bf16_t* RB = (const bf16_t*)(ws + NB_RKVZ);
    float* DEC = (float*)(ws + NB_DEC);
    bf16_t* KKN = (bf16_t*)(ws + NB_KKN); bf16_t* KKA = (bf16_t*)(ws + NB_KKA); bf16_t* KP = (bf16_t*)(ws + NB_KP);
    float w0v[2], a0v[2], kkp[2], kap[2], rkp[2];
#pragma unroll
    for (int ct = 0; ct < 2; ++ct) { const int e = hd * 64 + ct * 32 + lr; w0v[ct] = a.in[I_W0][e]; a0v[ct] = a.in[I_A0][e]; kkp[ct] = a.in[I_KK][e]; kap[ct] = a.in[I_KA][e]; rkp[ct] = a.in[I_RK][e]; }
    float n2[16], rk[16];
#pragma unroll
    for (int i = 0; i < 16; ++i) { n2[i] = 0.f; rk[i] = 0.f; }
#pragma unroll
    for (int ct = 0; ct < 2; ++ct)
#pragma unroll
        for (int i = 0; i < 16; ++i) {
            const size_t off = (row0 + (i & 3) + 8 * (i >> 2) + 4 * h2) * 1024 + hd * 64 + ct * 32 + lr;
            const float kf = bf2f(KB[off]), rf = bf2f(RB[off]);
            const float wl = w0v[ct] + aw[ct][i];
            const float sp = fmaxf(-wl, 0.f) + log1pf(__expf(-fabsf(wl)));
            DEC[off] = __expf(-__expf(-sp - 0.5f));
            const float av_ = sigm_f(a0v[ct] + aa[ct][i]);
            const float kk = kf * kkp[ct];
            const float kp = kf * (1.f + (av_ - 1.f) * kap[ct]);
            KP[off] = (bf16_t)(pk_bf16(kp, 0.f) & 0xffffu);
            aw[ct][i] = kk; aa[ct][i] = av_;
            n2[i] = fmaf(kk, kk, n2[i]);
            rk[i] = fmaf(rf * kp, rkp[ct], rk[i]);
        }
#pragma unroll
    for (int i = 0; i < 16; ++i) {
        float v = dpp_red16f(n2[i]); v += __shfl_xor(v, 16); n2[i] = 1.f / fmaxf(sqrtf(v), 1e-12f);
        float w = dpp_red16f(rk[i]); w += __shfl_xor(w, 16); rk[i] = w;
    }
#pragma unroll
    for (int ct = 0; ct < 2; ++ct)
#pragma unroll
        for (int i = 0; i < 16; ++i) {
            const size_t off = (row0 + (i & 3) + 8 * (i >> 2) + 4 * h2) * 1024 + hd * 64 + ct * 32 + lr;
            const float kn = aw[ct][i] * n2[i];
            KKN[off] = (bf16_t)(pk_bf16(kn, 0.f) & 0xffffu);
            KKA[off] = (bf16_t)(pk_bf16(kn * aa[ct][i], 0.f) & 0xffffu);
        }
    if (lr == 0) {
#pragma unroll
        for (int i = 0; i < 16; ++i) ((float*)(ws + NB_RKS))[(row0 + (i & 3) + 8 * (i >> 2) + 4 * h2) * 16 + hd] = rk[i];
    }
}

constexpr int SC_BUF = 53248;
__device__ __forceinline__ float dpp_red16(float v) {
    v += __builtin_bit_cast(float, __builtin_amdgcn_update_dpp(0, __builtin_bit_cast(int, v), 0xB1, 0xF, 0xF, true));
    v += __builtin_bit_cast(float, __builtin_amdgcn_update_dpp(0, __builtin_bit_cast(int, v), 0x4E, 0xF, 0xF, true));
    v += __builtin_bit_cast(float, __builtin_amdgcn_update_dpp(0, __builtin_bit_cast(int, v), 0x141, 0xF, 0xF, true));
    v += __builtin_bit_cast(float, __builtin_amdgcn_update_dpp(0, __builtin_bit_cast(int, v), 0x140, 0xF, 0xF, true));
    return v;
}
struct ScanRegs { u32x4 d0, d1, kn, ka, kp, r, v; };
__device__ __forceinline__ void scan_issue(unsigned char* ws, int b, int hd, int vh, int chunk, int tid, ScanRegs& g) {
    const int tt = tid >> 3, part = tid & 7;
    const size_t row = (size_t)b * TP + chunk * 64 + tt;
    const size_t off = row * 1024 + hd * 64 + part * 8;
    const float* dp = (const float*)(ws + NB_DEC) + off;
    g.d0 = *(const u32x4*)dp; g.d1 = *(const u32x4*)(dp + 4);
    g.kn = *(const u32x4*)((const bf16_t*)(ws + NB_KKN) + off);
    g.ka = *(const u32x4*)((const bf16_t*)(ws + NB_KKA) + off);
    g.kp = *(const u32x4*)((const bf16_t*)(ws + NB_KP) + off);
    g.r = *(const u32x4*)((const bf16_t*)(ws + NB_RKVZ) + ((size_t)0 * XSH_ROWS + row) * 1024 + hd * 64 + part * 8);
    if (part < 4) g.v = *(const u32x4*)((const bf16_t*)(ws + NB_RKVZ) + ((size_t)2 * XSH_ROWS + row) * 1024 + hd * 64 + vh * 32 + part * 8);
}
__device__ __forceinline__ void scan_write(PG8_LAS unsigned char* buf, int tid, const ScanRegs& g) {
    const int tt = tid >> 3, part = tid & 7;
    *(PG8_LAS u32x4*)(buf + tt * 256 + part * 32) = g.d0; *(PG8_LAS u32x4*)(buf + tt * 256 + part * 32 + 16) = g.d1;
    *(PG8_LAS u32x4*)(buf + 16384 + tt * 128 + part * 16) = g.kn;
    *(PG8_LAS u32x4*)(buf + 24576 + tt * 128 + part * 16) = g.ka;
    *(PG8_LAS u32x4*)(buf + 32768 + tt * 128 + part * 16) = g.kp;
    *(PG8_LAS u32x4*)(buf + 40960 + tt * 128 + part * 16) = g.r;
    if (part < 4) *(PG8_LAS u32x4*)(buf + 49152 + tt * 64 + part * 16) = g.v;
}
__device__ __forceinline__ void scan_prompt(const Args& a, unsigned char* ws, PG8_LAS unsigned char* lds, int item) {
    const int tid = opaque_v(threadIdx.x);
    const int b = item >> 5, hd = (item >> 1) & 15, vh = item & 1;
    const int vl = tid >> 4, kq = tid & 15;
    typedef unsigned u32x2 __attribute__((ext_vector_type(2)));
    float S[4] = {0.f, 0.f, 0.f, 0.f};
    ScanRegs g;
    PG8_LAS float* YS = (PG8_LAS float*)(lds + 2 * SC_BUF);
    scan_issue(ws, b, hd, vh, 0, tid, g); scan_write(lds, tid, g);
    __syncthreads();
    for (int c = 0; c < TP / 64; ++c) {
        PG8_LAS unsigned char* buf = lds + (c & 1) * SC_BUF;
        if (c + 1 < TP / 64) scan_issue(ws, b, hd, vh, c + 1, tid, g);
#pragma unroll 4
        for (int tt = 0; tt < 64; ++tt) {
            const f32x4 w = *(const PG8_LAS f32x4*)(buf + tt * 256 + kq * 16);
            const u32x2 knw = *(const PG8_LAS u32x2*)(buf + 16384 + tt * 128 + kq * 8), kaw = *(const PG8_LAS u32x2*)(buf + 24576 + tt * 128 + kq * 8),
                        kpw = *(const PG8_LAS u32x2*)(buf + 32768 + tt * 128 + kq * 8), rw = *(const PG8_LAS u32x2*)(buf + 40960 + tt * 128 + kq * 8);
            const float vv = bf2f(*(const PG8_LAS bf16_t*)(buf + 49152 + tt * 64 + vl * 2));
            const float kn[4] = {__uint_as_float(knw.x << 16), __uint_as_float(knw.x & 0xffff0000u), __uint_as_float(knw.y << 16), __uint_as_float(knw.y & 0xffff0000u)};
            const float ka[4] = {__uint_as_float(kaw.x << 16), __uint_as_float(kaw.x & 0xffff0000u), __uint_as_float(kaw.y << 16), __uint_as_float(kaw.y & 0xffff0000u)};
            const float kp[4] = {__uint_as_float(kpw.x << 16), __uint_as_float(kpw.x & 0xffff0000u), __uint_as_float(kpw.y << 16), __uint_as_float(kpw.y & 0xffff0000u)};
            const float rr[4] = {__uint_as_float(rw.x << 16), __uint_as_float(rw.x & 0xffff0000u), __uint_as_float(rw.y << 16), __uint_as_float(rw.y & 0xffff0000u)};
            float sa = S[0] * kn[0];
            sa = fmaf(S[1], kn[1], sa); sa = fmaf(S[2], kn[2], sa); sa = fmaf(S[3], kn[3], sa);
            sa = dpp_red16(sa);
            float y = 0.f;
#pragma unroll
            for (int i = 0; i < 4; ++i) { S[i] = fmaf(S[i], w[i], fmaf(vv, kp[i], -sa * ka[i])); y = fmaf(S[i], rr[i], y); }
            y = dpp_red16(y);
            if (kq == 0) YS[tt * 32 + vl] = y;
        }
        if (c + 1 < TP / 64) scan_write(lds + ((c + 1) & 1) * SC_BUF, tid, g);
        __syncthreads();
        {
            float* Y = (float*)(ws + NB_Y);
            for (int i = tid; i < 64 * 32; i += NTH) { const int tt = i >> 5, v = i & 31; Y[((size_t)b * TP + c * 64 + tt) * 1024 + hd * 64 + vh * 32 + v] = YS[i]; }
        }
        __syncthreads();
    }
    float* so = a.out + O_WKVP + ((size_t)(b * 16 + hd) * 64 + vh * 32 + vl) * 64 + kq * 4;
    *(float4*)so = make_float4(S[0], S[1], S[2], S[3]);
}
__device__ __forceinline__ void scan_sample(const Args& a, unsigned char* ws, int s, int hd, int lane) {
    const size_t row = (size_t)MP + s;
    const float* s0 = a.in[I_SWKV] + ((size_t)(s * 16 + hd) * 64 + lane) * 64;
    float* sout = a.out + O_WKVS + ((size_t)(s * 16 + hd) * 64 + lane) * 64;
    const int e = hd * 64 + lane;
    const float twl = bf2f(((const bf16_t*)(ws + NB_TWB) + row * 64)[lane]), awl = bf2f(((const bf16_t*)(ws + NB_AWB) + row * 64)[lane]);
    const bf16_t* w2r = (const bf16_t*)(ws + NB_W2T) + (size_t)e * 64; const bf16_t* a2r = (const bf16_t*)(ws + NB_A2T) + (size_t)e * 64;
    float wl = a.in[I_W0][e], al = a.in[I_A0][e];
#define RL(X, K) __builtin_bit_cast(float, __builtin_amdgcn_readlane(__builtin_bit_cast(int, X), K))
#pragma unroll
    for (int j8 = 0; j8 < 8; ++j8) {
        const u32x4 wq = *(const u32x4*)(w2r + j8 * 8), aq = *(const u32x4*)(a2r + j8 * 8);
#pragma unroll
        for (int i = 0; i < 8; ++i) {
            const float wv_ = __uint_as_float((i & 1) ? (wq[i >> 1] & 0xffff0000u) : (wq[i >> 1] << 16)), av_ = __uint_as_float((i & 1) ? (aq[i >> 1] & 0xffff0000u) : (aq[i >> 1] << 16));
            wl = fmaf(RL(twl, j8 * 8 + i), wv_, wl); al = fmaf(RL(awl, j8 * 8 + i), av_, al);
        }
    }
    const float decl = __expf(-0.60653066f * sigm_f(wl));
    const float aa_ = sigm_f(al);
    const float kf = bf2f(((const bf16_t*)(ws + NB_RKVZ) + ((size_t)1 * XSH_ROWS + row) * 1024)[e]);
    const float rl = bf2f(((const bf16_t*)(ws + NB_RKVZ) + ((size_t)0 * XSH_ROWS + row) * 1024)[e]);
    const float vv = bf2f(((const bf16_t*)(ws + NB_RKVZ) + ((size_t)2 * XSH_ROWS + row) * 1024)[e]);
    const float kkr = kf * a.in[I_KK][e];
    const float kpl = kf * (1.f + (aa_ - 1.f) * a.in[I_KA][e]);
    const float knl = kkr / fmaxf(sqrtf(wave_sum(kkr * kkr)), 1e-12f);
    const float kal = knl * aa_;
    const float rkv = wave_sum(rl * kpl * a.in[I_RK][e]);
    float S[64];
#pragma unroll
    for (int q = 0; q < 16; ++q) { const float4 v4 = *(const float4*)(s0 + q * 4); S[4 * q] = v4.x; S[4 * q + 1] = v4.y; S[4 * q + 2] = v4.z; S[4 * q + 3] = v4.w; }
    float sa = 0.f;
#pragma unroll
    for (int k = 0; k < 64; ++k) sa = fmaf(S[k], RL(knl, k), sa);
    float y = 0.f;
#pragma unroll
    for (int k = 0; k < 64; ++k) { S[k] = fmaf(S[k], RL(decl, k), fmaf(vv, RL(kpl, k), -sa * RL(kal, k))); y = fmaf(S[k], RL(rl, k), y); }
#undef RL
#pragma unroll
    for (int q = 0; q < 16; ++q) *(float4*)(sout + q * 4) = make_float4(S[4 * q], S[4 * q + 1], S[4 * q + 2], S[4 * q + 3]);
    {
        const float mean = wave_sum(y) * (1.f / 64.f);
        const float d = y - mean;
        const float rs = rsqrtf(wave_sum(d * d) * (1.f / 64.f) + GN_EPS);
        const float zf = bf2f(((const bf16_t*)(ws + NB_RKVZ) + ((size_t)3 * XSH_ROWS + row) * 1024)[e]);
        const float o = fmaf(rkv, vv, d * rs * a.in[I_GNG][e] + a.in[I_GNB][e]) * silu_f(zf);
        ((bf16_t*)(ws + NB_G4B))[row * 1024 + e] = (bf16_t)(pk_bf16c(o, 0.f) & 0xffffu);
    }
}

constexpr int CS_LD = 72;
constexpr int CS_SLOT = 64 * CS_LD * 2;
constexpr int CS_F32A = 13 * CS_SLOT;
constexpr int CS_F32B = CS_F32A + 16384;
constexpr int CS_GS = CS_F32B + 16384;
constexpr int CS_PRM = CS_GS + 4096;
constexpr int CS_END = CS_PRM + 1280;
constexpr size_t CK_MCT = 0, CK_RY = 8192, CK_SADD = 16384, CK_Y0 = 24576, CK_BYTES = 32768;

__device__ __forceinline__ PG8_LAS bf16_t* cs_slot(PG8_LAS unsigned char* lds, int i) { return (PG8_LAS bf16_t*)(lds + i * CS_SLOT); }
template <bool SWX = false, bool SWY = false>
__device__ __forceinline__ void cs_mm(f32x16& acc, const PG8_LAS bf16_t* X, const PG8_LAS bf16_t* Yt, int mt, int nt, int lane) {
    const int lr = lane & 31, h = lane >> 5;
    const int rx = mt * 32 + lr, ry = nt * 32 + lr;
    const int sx = SWX ? ((rx >> 3) & 7) : 0, sy = SWY ? ((ry >> 3) & 7) : 0;
#pragma unroll
    for (int s = 0; s < 4; ++s) {
        const bf16x8 av = *(const PG8_LAS bf16x8*)(X + rx * CS_LD + (((2 * s + h) ^ sx) << 3));
        const bf16x8 bv = *(const PG8_LAS bf16x8*)(Yt + ry * CS_LD + (((2 * s + h) ^ sy) << 3));
        acc = __builtin_amdgcn_mfma_f32_32x32x16_bf16(av, bv, acc, 0, 0, 0);
    }
}
__device__ __forceinline__ void cs_store_t(const f32x16& acc, PG8_LAS bf16_t* D, int mt, int nt, int lane) {
    typedef unsigned u32x2 __attribute__((ext_vector_type(2)));
    const int lr = lane & 31, h = lane >> 5;
#pragma unroll
    for (int c = 0; c < 4; ++c) { u32x2 w; w.x = pk_bf16c(acc[4 * c], acc[4 * c + 1]); w.y = pk_bf16c(acc[4 * c + 2], acc[4 * c + 3]);
        *(PG8_LAS u32x2*)(D + (nt * 32 + lr) * CS_LD + mt * 32 + 8 * c + 4 * h) = w; }
}
__device__ __forceinline__ void cs_store_n(const f32x16& acc, PG8_LAS bf16_t* D, int mt, int nt, int lane) {
    const int lr = lane & 31, h = lane >> 5;
#pragma unroll
    for (int i = 0; i < 16; ++i) D[(mt * 32 + (i & 3) + 8 * (i >> 2) + 4 * h) * CS_LD + nt * 32 + lr] = (bf16_t)(pk_bf16c(acc[i], 0.f) & 0xffffu);
}
__device__ __forceinline__ void cs_zero(f32x16& a) {
#pragma unroll
    for (int i = 0; i < 16; ++i) a[i] = 0.f;
}
__device__ __forceinline__ float dpp_red8(float v) {
    v += __builtin_bit_cast(float, __builtin_amdgcn_update_dpp(0, __builtin_bit_cast(int, v), 0xB1, 0xF, 0xF, true));
    v += __builtin_bit_cast(float, __builtin_amdgcn_update_dpp(0, __builtin_bit_cast(int, v), 0x4E, 0xF, 0xF, true));
    v += __builtin_bit_cast(float, __builtin_amdgcn_update_dpp(0, __builtin_bit_cast(int, v), 0x141, 0xF, 0xF, true));
    return v;
}

struct PreRegs { u32x4 kv, rv, vv; bf16x8 af[4]; };
__device__ __forceinline__ void scanpre_load(unsigned char* ws, int b, int hd, int c, int tid, PreRegs& r) {
    const int lane = tid & 63, wv = tid >> 6, lr = lane & 31, h = lane >> 5;
    const size_t row0 = (size_t)b * TP + c * 64;
    const int tok = tid >> 3, c8 = tid & 7;
    const size_t off = (row0 + tok) * 1024 + hd * 64 + c8 * 8;
    const bf16_t* RK = (const bf16_t*)(ws + NB_RKVZ);
    r.kv = *(const u32x4*)(RK + (size_t)1 * XSH_ROWS * 1024 + off); r.rv = *(const u32x4*)(RK + off); r.vv = *(const u32x4*)(RK + (size_t)2 * XSH_ROWS * 1024 + off);
    const int which = wv >> 2, mt = (wv >> 1) & 1;
    const bf16_t* A = (const bf16_t*)(ws + (which ? NB_AWB : NB_TWB)) + (row0 + mt * 32 + lr) * 64 + h * 8;
#pragma unroll
    for (int s = 0; s < 4; ++s) r.af[s] = *(const bf16x8*)(A + s * 16);
}
__device__ __forceinline__ void scanpre_chunk(const Args& a, unsigned char* ws, PG8_LAS unsigned char* lds, int b, int hd, int c, const PreRegs& pre, const bf16x8 (&btf)[4]) {
    const int tid = opaque_v(threadIdx.x), lane = tid & 63, wv = __builtin_amdgcn_readfirstlane(tid >> 6);
    const int lr = lane & 31, h = lane >> 5;
    const size_t row0 = (size_t)b * TP + c * 64;
    typedef unsigned u32x2 __attribute__((ext_vector_type(2)));
    PG8_LAS float* LCUM = (PG8_LAS float*)(lds + CS_F32A);
    PG8_LAS float* AV = (PG8_LAS float*)(lds + CS_F32B);
    PG8_LAS float* GS = (PG8_LAS float*)(lds + CS_GS);
    unsigned char* rec = ws + NB_CHK + ((size_t)(b * 16 + hd) * 32 + c) * CK_BYTES;
    {
        const int tok = tid >> 3, c8 = tid & 7;
        *(PG8_LAS u32x4*)(cs_slot(lds, 0) + tok * CS_LD + c8 * 8) = pre.kv;
        *(PG8_LAS u32x4*)(cs_slot(lds, 1) + tok * CS_LD + c8 * 8) = pre.rv;
        *(PG8_LAS u32x4*)(cs_slot(lds, 2) + tok * CS_LD + c8 * 8) = pre.vv;
    }
    {
        const int which = wv >> 2, mt = (wv >> 1) & 1, nt = wv & 1;
        f32x16 acc; cs_zero(acc);
#pragma unroll
        for (int s = 0; s < 4; ++s) acc = __builtin_amdgcn_mfma_f32_32x32x16_bf16(pre.af[s], btf[s], acc, 0, 0, 0);
        PG8_LAS float* D = which ? AV : LCUM;
        const float bias = ((const PG8_LAS float*)(lds + CS_PRM))[(which ? 4 : 3) * 64 + nt * 32 + lr];
#pragma unroll
        for (int i = 0; i < 16; ++i) {
            const float x = acc[i] + bias;
            float y;
            if (which) y = sigm_f(x);
            else y = -0.87503504f * sigm_f(x);
            D[(mt * 32 + (i & 3) + 8 * (i >> 2) + 4 * h) * 64 + nt * 32 + lr] = y;
        }
    }
    lds_barrier();
    {
        const int ch = tid & 63, tg = tid >> 6;
        float p[8]; float run = 0.f;
#pragma unroll
        for (int i = 0; i < 8; ++i) { run += LCUM[(tg * 8 + i) * 64 + ch]; p[i] = run; }
        GS[tg * 64 + ch] = run;
        lds_barrier();
        float offs = 0.f;
#pragma unroll
        for (int g = 0; g < 7; ++g) { const float gv = GS[g * 64 + ch]; offs += (g < tg) ? gv : 0.f; }
#pragma unroll
        for (int i = 0; i < 8; ++i) LCUM[(tg * 8 + i) * 64 + ch] = p[i] + offs;
    }
    lds_barrier();
    {
        const int tok = tid >> 3, c8 = tid & 7;
        const u32x4 kw = *(const PG8_LAS u32x4*)(cs_slot(lds, 0) + tok * CS_LD + c8 * 8), rw = *(const PG8_LAS u32x4*)(cs_slot(lds, 1) + tok * CS_LD + c8 * 8),
                    vw = *(const PG8_LAS u32x4*)(cs_slot(lds, 2) + tok * CS_LD + c8 * 8);
        float kf[8], rf[8], kk[8], kp[8], av[8];
        float n2 = 0.f, rk = 0.f;
        const PG8_LAS float* PRM = (const PG8_LAS float*)(lds + CS_PRM) + c8 * 8;
#pragma unroll
        for (int i = 0; i < 8; ++i) {
            kf[i] = __uint_as_float((i & 1) ? (kw[i >> 1] & 0xffff0000u) : (kw[i >> 1] << 16));
            rf[i] = __uint_as_float((i & 1) ? (rw[i >> 1] & 0xffff0000u) : (rw[i >> 1] << 16));
            av[i] = AV[tok * 64 + c8 * 8 + i];
            kk[i] = kf[i] * PRM[i];
            kp[i] = kf[i] * (1.f + (av[i] - 1.f) * PRM[64 + i]);
            n2 = fmaf(kk[i], kk[i], n2);
            rk = fmaf(rf[i] * kp[i], PRM[128 + i], rk);
        }
        n2 = dpp_red8(n2); rk = dpp_red8(rk);
        const float inv = 1.f / fmaxf(sqrtf(n2), 1e-12f);
        if (c8 == 0) ((float*)(ws + NB_RKS))[(row0 + tok) * 16 + hd] = rk;
        if (tok == 63) {
#pragma unroll
            for (int i = 0; i < 8; ++i) GS[512 + c8 * 8 + i] = __builtin_amdgcn_exp2f(LCUM[63 * 64 + c8 * 8 + i]);
        }
        float qt[8], rt[8], kt[8], bt[8], kh[8], bh[8];
#pragma unroll
        for (int i = 0; i < 8; ++i) {
            const int ch = c8 * 8 + i;
            const float Lt = LCUM[tok * 64 + ch], Lp = tok ? LCUM[(tok - 1) * 64 + ch] : 0.f, Lc = LCUM[63 * 64 + ch];
            const float kn = kk[i] * inv, ka = kn * av[i];
            const float en = __builtin_amdgcn_exp2f(-Lt), ec = __builtin_amdgcn_exp2f(Lc - Lt);
            qt[i] = kn * __builtin_amdgcn_exp2f(Lp); rt[i] = rf[i] * __builtin_amdgcn_exp2f(Lt); kt[i] = kp[i] * en; bt[i] = ka * en; kh[i] = kp[i] * ec; bh[i] = ka * ec;
        }
#define CS_PUT_ROW(SLOT, ARR) { u32x4 w_; w_.x = pk_bf16c(ARR[0], ARR[1]); w_.y = pk_bf16c(ARR[2], ARR[3]); w_.z = pk_bf16c(ARR[4], ARR[5]); w_.w = pk_bf16c(ARR[6], ARR[7]); \
            *(PG8_LAS u32x4*)(cs_slot(lds, SLOT) + tok * CS_LD + c8 * 8) = w_; }
#define CS_PUT_COL(SLOT, ARR) { _Pragma("unroll") for (int i_ = 0; i_ < 8; ++i_) cs_slot(lds, SLOT)[(c8 * 8 + i_) * CS_LD + tsw] = (bf16_t)(pk_bf16c(ARR[i_], 0.f) & 0xffffu); }
        const int tsw = ((((tok >> 3) ^ c8) & 7) << 3) | (tok & 7);
        CS_PUT_ROW(3, qt) CS_PUT_ROW(4, rt) CS_PUT_ROW(5, kt) CS_PUT_ROW(6, bt)
        CS_PUT_COL(7, qt) CS_PUT_COL(8, bh) CS_PUT_COL(9, kh)
#pragma unroll
        for (int i = 0; i < 8; ++i) cs_slot(lds, 10)[(c8 * 8 + i) * CS_LD + tsw] = (bf16_t)((i & 1) ? (vw[i >> 1] >> 16) : (vw[i >> 1] & 0xffffu));
#undef CS_PUT_ROW
#undef CS_PUT_COL
    }
    lds_barrier();
    {
#pragma unroll 1
        for (int j = 0; j < 2; ++j) {
            const int job = wv * 2 + j, prod = job >> 2, mt = (job >> 1) & 1, nt = job & 1;
            const PG8_LAS bf16_t* X = cs_slot(lds, (prod & 1) ? 6 : 5);
            const PG8_LAS bf16_t* Y = cs_slot(lds, (prod & 2) ? 4 : 3);
            f32x16 acc; cs_zero(acc);
            cs_mm(acc, X, Y, mt, nt, lane);
            const int t = nt * 32 + lr, incl = (prod & 2) ? 1 : 0;
#pragma unroll
            for (int i = 0; i < 16; ++i) { const int sidx = mt * 32 + (i & 3) + 8 * (i >> 2) + 4 * h; acc[i] = (sidx < t + incl) ? acc[i] : 0.f; }
            const int dst = (prod == 0) ? 0 : (prod == 1) ? 11 : (prod == 2) ? 1 : 2;
            cs_store_t(acc, cs_slot(lds, dst), mt, nt, lane);
            if (prod == 1) cs_store_n(acc, cs_slot(lds, 12), mt, nt, lane);
        }
    }
    lds_barrier();
    {
        const int mt = (wv >> 1) & 1, nt = wv & 1;
        f32x16 pacc;
        PG8_LAS bf16_t* XS0 = (PG8_LAS bf16_t*)(lds + CS_F32A);
        PG8_LAS bf16_t* XS1 = (PG8_LAS bf16_t*)(lds + CS_F32A + CS_SLOT);
        PG8_LAS bf16_t* XS2 = (PG8_LAS bf16_t*)(lds + CS_F32A + 2 * CS_SLOT);
        PG8_LAS bf16_t* Pc = cs_slot(lds, 3); PG8_LAS bf16_t* Pn = XS0;
        PG8_LAS bf16_t* Mc_ = cs_slot(lds, 5); PG8_LAS bf16_t* MTc = cs_slot(lds, 6);
        PG8_LAS bf16_t* Mn = cs_slot(lds, 11); PG8_LAS bf16_t* MTn = cs_slot(lds, 12);
#define CS_SQUARE(SRC, SRCT, DST, DSTT, GSOFF) { f32x16 acc; cs_zero(acc); cs_mm(acc, SRC, SRCT, mt, nt, lane); cs_store_n(acc, DST, mt, nt, lane); cs_store_t(acc, DSTT, mt, nt, lane); \
            float mx = 0.f; _Pragma("unroll") for (int i = 0; i < 16; ++i) mx = fmaxf(mx, fabsf(acc[i])); \
            _Pragma("unroll") for (int o = 32; o > 0; o >>= 1) mx = fmaxf(mx, __shfl_xor(mx, o)); if (lane == 0) GS[(GSOFF) + (wv & 3)] = mx; }
        if (wv < 4) {
#pragma unroll
            for (int i = 0; i < 16; ++i) { const int u = mt * 32 + (i & 3) + 8 * (i >> 2) + 4 * h, t = nt * 32 + lr;
                pacc[i] = ((u == t) ? 1.f : 0.f) - bf2f(cs_slot(lds, 12)[u * CS_LD + t]); }
            cs_store_t(pacc, cs_slot(lds, 3), mt, nt, lane);
        } else CS_SQUARE(cs_slot(lds, 11), cs_slot(lds, 12), Mc_, MTc, 640)
        lds_barrier();
#pragma unroll 1
        for (int it = 0; it < 5; ++it) {
            const int gso = 640 + 4 * (it & 1);
            const float m2max = fmaxf(fmaxf(GS[gso], GS[gso + 1]), fmaxf(GS[gso + 2], GS[gso + 3]));
            const bool last = (m2max < 3e-4f) || (it == 4);
            if (wv < 4) {
                cs_mm(pacc, MTc, Pc, mt, nt, lane);
                cs_store_t(pacc, Pn, mt, nt, lane);
            } else if (!last) CS_SQUARE(Mc_, MTc, Mn, MTn, 644 - 4 * (it & 1))
            lds_barrier();
            { PG8_LAS bf16_t* t0 = Mc_; Mc_ = Mn; Mn = t0; t0 = MTc; MTc = MTn; MTn = t0; t0 = Pc; Pc = Pn; Pn = t0; }
            if (last) break;
        }
#undef CS_SQUARE
        {
            f32x16 acc; cs_zero(acc);
            if (wv < 4) { cs_mm<false, true>(acc, cs_slot(lds, 0), cs_slot(lds, 10), mt, nt, lane); cs_store_t(acc, XS1, mt, nt, lane); }
            else { cs_mm<false, true>(acc, Pc, cs_slot(lds, 7), mt, nt, lane); cs_store_t(acc, XS2, mt, nt, lane); }
        }
        lds_barrier();
        if (wv < 4) { f32x16 acc; cs_zero(acc); cs_mm(acc, Pc, XS1, mt, nt, lane); cs_store_t(acc, cs_slot(lds, 11), mt, nt, lane); }
        lds_barrier();
        if (wv < 4) {
            f32x16 acc; cs_zero(acc);
            cs_mm<false, true>(acc, XS2, cs_slot(lds, 8), mt, nt, lane);
#pragma unroll
            for (int i = 0; i < 16; ++i) { const int k = mt * 32 + (i & 3) + 8 * (i >> 2) + 4 * h, kp_ = nt * 32 + lr; acc[i] = ((k == kp_) ? GS[512 + k] : 0.f) - acc[i]; }
            bf16_t* mct = (bf16_t*)(rec + CK_MCT);
#pragma unroll
            for (int cc = 0; cc < 4; ++cc) { u32x2 w; w.x = pk_bf16c(acc[4 * cc], acc[4 * cc + 1]); w.y = pk_bf16c(acc[4 * cc + 2], acc[4 * cc + 3]);
                *(u32x2*)(mct + ((nt * 4 + 2 * mt + (cc >> 1)) * 64 + lr + 32 * (cc & 1)) * 8 + 4 * h) = w; }
            f32x16 s1, s2; cs_zero(s1); cs_zero(s2);
            cs_mm<true, true>(s1, cs_slot(lds, 9), cs_slot(lds, 10), mt, nt, lane);
            cs_mm<true, false>(s2, cs_slot(lds, 8), cs_slot(lds, 11), mt, nt, lane);
            bf16_t* sd = (bf16_t*)(rec + CK_SADD) + ((size_t)(wv & 3) * 64 + lane) * 16;
#pragma unroll
            for (int q8 = 0; q8 < 2; ++q8) { u32x4 w;
                w.x = pk_bf16c(s1[8 * q8] - s2[8 * q8], s1[8 * q8 + 1] - s2[8 * q8 + 1]); w.y = pk_bf16c(s1[8 * q8 + 2] - s2[8 * q8 + 2], s1[8 * q8 + 3] - s2[8 * q8 + 3]);
                w.z = pk_bf16c(s1[8 * q8 + 4] - s2[8 * q8 + 4], s1[8 * q8 + 5] - s2[8 * q8 + 5]); w.w = pk_bf16c(s1[8 * q8 + 6] - s2[8 * q8 + 6], s1[8 * q8 + 7] - s2[8 * q8 + 7]);
                *(u32x4*)(sd + q8 * 8) = w; }
        } else {
            f32x16 acc; cs_zero(acc);
            cs_mm(acc, XS2, cs_slot(lds, 2), mt, nt, lane);
            bf16_t* ry = (bf16_t*)(rec + CK_RY);
#pragma unroll
            for (int cc = 0; cc < 4; ++cc) {
                const u32x2 rv = *(const PG8_LAS u32x2*)(cs_slot(lds, 4) + (nt * 32 + lr) * CS_LD + mt * 32 + 8 * cc + 4 * h);
                const float r0 = __uint_as_float(rv.x << 16), r1 = __uint_as_float(rv.x & 0xffff0000u), r2 = __uint_as_float(rv.y << 16), r3 = __uint_as_float(rv.y & 0xffff0000u);
                u32x2 w; w.x = pk_bf16c(r0 - acc[4 * cc], r1 - acc[4 * cc + 1]); w.y = pk_bf16c(r2 - acc[4 * cc + 2], r3 - acc[4 * cc + 3]);
                *(u32x2*)(ry + ((nt * 4 + 2 * mt + (cc >> 1)) * 64 + lr + 32 * (cc & 1)) * 8 + 4 * h) = w;
            }
            f32x16 s1, s2; cs_zero(s1); cs_zero(s2);
            cs_mm<false, true>(s1, cs_slot(lds, 1), cs_slot(lds, 10), mt, nt, lane);
            cs_mm(s2, cs_slot(lds, 2), cs_slot(lds, 11), mt, nt, lane);
            bf16_t* yd = (bf16_t*)(rec + CK_Y0) + ((size_t)(wv & 3) * 64 + lane) * 16;
#pragma unroll
            for (int q8 = 0; q8 < 2; ++q8) { u32x4 w;
                w.x = pk_bf16c(s1[8 * q8] - s2[8 * q8], s1[8 * q8 + 1] - s2[8 * q8 + 1]); w.y = pk_bf16c(s1[8 * q8 + 2] - s2[8 * q8 + 2], s1[8 * q8 + 3] - s2[8 * q8 + 3]);
                w.z = pk_bf16c(s1[8 * q8 + 4] - s2[8 * q8 + 4], s1[8 * q8 + 5] - s2[8 * q8 + 5]); w.w = pk_bf16c(s1[8 * q8 + 6] - s2[8 * q8 + 6], s1[8 * q8 + 7] - s2[8 * q8 + 7]);
                *(u32x4*)(yd + q8 * 8) = w; }
        }
    }
    lds_barrier();
}

struct SeqRegs { bf16x8 a[4]; u32x4 c[2]; };
__device__ __forceinline__ void seq_load(const unsigned char* rec, int wv, int mt, int lane, SeqRegs& r) {
    const bf16_t* ap = (const bf16_t*)(rec + CK_MCT) + ((size_t)mt * 4 * 64 + lane) * 8;
    const bf16_t* cp = (const bf16_t*)(rec + CK_SADD) + ((size_t)(wv & 3) * 64 + lane) * 16;
#pragma unroll
    for (int s = 0; s < 4; ++s) r.a[s] = *(const bf16x8*)(ap + s * 64 * 8);
    r.c[0] = *(const u32x4*)cp; r.c[1] = *(const u32x4*)(cp + 8);
}
__device__ __forceinline__ void scanseq_head(const Args& a, unsigned char* ws, PG8_LAS unsigned char* lds, int b, int hd) {
    const int tid = opaque_v(threadIdx.x), lane = tid & 63, wv = __builtin_amdgcn_readfirstlane(tid >> 6);
    const int lr = lane & 31, h = lane >> 5;
    const int mt = (wv >> 1) & 1, nt = wv & 1;
    const bool isS = wv < 4;
    PG8_LAS bf16_t* SB0 = cs_slot(lds, 0); PG8_LAS bf16_t* SB1 = cs_slot(lds, 1);
    f32x16 st; cs_zero(st);
    for (int i = tid; i < 64 * CS_LD; i += NTH) { SB0[i] = 0; }
    const unsigned char* rec0 = ws + NB_CHK + (size_t)(b * 16 + hd) * 32 * CK_BYTES;
    bf16_t* srec0 = (bf16_t*)(ws + NB_SREC) + (size_t)(b * 16 + hd) * 32 * 4096;
    const int cr = (tid & 255) >> 2, cc8 = (tid & 3) * 16;
    lds_barrier();
    if (isS) {
        SeqRegs r[4];
#pragma unroll
        for (int c = 0; c < 4; ++c) seq_load(rec0 + (size_t)c * CK_BYTES, wv, mt, lane, r[c]);
#pragma unroll
        for (int c = 0; c < 32; ++c) {
            const PG8_LAS bf16_t* S = (c & 1) ? SB1 : SB0;
            PG8_LAS bf16_t* Sn = (c & 1) ? SB0 : SB1;
            f32x16 acc;
#pragma unroll
            for (int i = 0; i < 16; ++i) { const unsigned w = r[c & 3].c[i >> 3][(i & 7) >> 1]; acc[i] = __uint_as_float((i & 1) ? (w & 0xffff0000u) : (w << 16)); }
#pragma unroll
            for (int s = 0; s < 4; ++s) {
                const bf16x8 bv = *(const PG8_LAS bf16x8*)(S + (nt * 32 + lr) * CS_LD + s * 16 + h * 8);
                acc = __builtin_amdgcn_mfma_f32_32x32x16_bf16(r[c & 3].a[s], bv, acc, 0, 0, 0);
            }
            st = acc; cs_store_t(st, Sn, mt, nt, lane);
            if (c + 4 < 32) seq_load(rec0 + (size_t)(c + 4) * CK_BYTES, wv, mt, lane, r[c & 3]);
            lds_barrier();
        }
    } else {
#pragma unroll 1
        for (int c = 0; c < 32; ++c) {
            const PG8_LAS bf16_t* S = (c & 1) ? SB1 : SB0;
            const u32x4 v0 = *(const PG8_LAS u32x4*)(S + cr * CS_LD + cc8), v1 = *(const PG8_LAS u32x4*)(S + cr * CS_LD + cc8 + 8);
            bf16_t* d = srec0 + (size_t)c * 4096 + cr * 64 + cc8;
            *(u32x4*)d = v0; *(u32x4*)(d + 8) = v1;
            lds_barrier();
        }
    }
    if (isS) {
        float* so = a.out + O_WKVP + ((size_t)(b * 16 + hd) * 64 + nt * 32 + lr) * 64 + mt * 32 + 4 * h;
#pragma unroll
        for (int cc = 0; cc < 4; ++cc) *(float4*)(so + 8 * cc) = make_float4(st[4 * cc], st[4 * cc + 1], st[4 * cc + 2], st[4 * cc + 3]);
    }
    lds_barrier();
}
struct YgRegs { bf16x8 a[4]; u32x4 c[2]; u32x4 s0, s1; u32x4 vw[2], zw[2]; float rk; };
__device__ __forceinline__ void yg_load(unsigned char* ws, int ci, int tid, YgRegs& r) {
    const int lane = tid & 63, wv = tid >> 6, t4 = tid & 255;
    const int mt = (wv >> 1) & 1;
    const unsigned char* rec = ws + NB_CHK + (size_t)ci * CK_BYTES;
    const bf16_t* ap = (const bf16_t*)(rec + CK_RY) + ((size_t)mt * 4 * 64 + lane) * 8;
    const bf16_t* cp = (const bf16_t*)(rec + CK_Y0) + ((size_t)(wv & 3) * 64 + lane) * 16;
#pragma unroll
    for (int s = 0; s < 4; ++s) r.a[s] = *(const bf16x8*)(ap + s * 64 * 8);
    r.c[0] = *(const u32x4*)cp; r.c[1] = *(const u32x4*)(cp + 8);
    const bf16_t* sp = (const bf16_t*)(ws + NB_SREC) + (size_t)ci * 4096 + (t4 >> 2) * 64 + (t4 & 3) * 16;
    r.s0 = *(const u32x4*)sp; r.s1 = *(const u32x4*)(sp + 8);
    const int bh = ci >> 5, c = ci & 31, b = bh >> 4, hd = bh & 15;
    const size_t prow = (size_t)b * TP + c * 64 + (t4 >> 2);
    const int pv = (t4 & 3) * 16;
    const bf16_t* vp = (const bf16_t*)(ws + NB_RKVZ) + ((size_t)2 * XSH_ROWS + prow) * 1024 + hd * 64 + pv;
    const bf16_t* zp = (const bf16_t*)(ws + NB_RKVZ) + ((size_t)3 * XSH_ROWS + prow) * 1024 + hd * 64 + pv;
    r.vw[0] = *(const u32x4*)vp; r.vw[1] = *(const u32x4*)(vp + 8); r.zw[0] = *(const u32x4*)zp; r.zw[1] = *(const u32x4*)(zp + 8);
    r.rk = ((const float*)(ws + NB_RKS))[prow * 16 + hd];
}
constexpr int YG_PRM = 65536;
__device__ __forceinline__ void yg_step(const Args& a, unsigned char* ws, PG8_LAS unsigned char* lds, int ci, int tid, const YgRegs& r) {
    const int lane = tid & 63, wv = tid >> 6, t4 = tid & 255, grp = wv >> 2;
    const int lr = lane & 31, h = lane >> 5, mt = (wv >> 1) & 1, nt = wv & 1;
    PG8_LAS bf16_t* SL = cs_slot(lds, grp);
    PG8_LAS float* YT = (PG8_LAS float*)(lds + 2 * CS_SLOT) + grp * (64 * 68);
    *(PG8_LAS u32x4*)(SL + (t4 >> 2) * CS_LD + (t4 & 3) * 16) = r.s0; *(PG8_LAS u32x4*)(SL + (t4 >> 2) * CS_LD + (t4 & 3) * 16 + 8) = r.s1;
    lds_barrier();
    {
        f32x16 acc;
#pragma unroll
        for (int i = 0; i < 16; ++i) { const unsigned w = r.c[i >> 3][(i & 7) >> 1]; acc[i] = __uint_as_float((i & 1) ? (w & 0xffff0000u) : (w << 16)); }
#pragma unroll
        for (int s = 0; s < 4; ++s) {
            const bf16x8 bv = *(const PG8_LAS bf16x8*)(SL + (nt * 32 + lr) * CS_LD + s * 16 + h * 8);
            acc = __builtin_amdgcn_mfma_f32_32x32x16_bf16(r.a[s], bv, acc, 0, 0, 0);
        }
#pragma unroll
        for (int i = 0; i < 16; ++i) YT[(mt * 32 + (i & 3) + 8 * (i >> 2) + 4 * h) * 68 + nt * 32 + lr] = acc[i];
    }
    lds_barrier();
    {
        const int ptok = t4 >> 2, pv = (t4 & 3) * 16;
        const int bh = ci >> 5, c = ci & 31, b = bh >> 4, hd = bh & 15;
        float y[16];
#pragma unroll
        for (int q = 0; q < 4; ++q) { const f32x4 v = *(const PG8_LAS f32x4*)(YT + ptok * 68 + pv + q * 4); y[4 * q] = v[0]; y[4 * q + 1] = v[1]; y[4 * q + 2] = v[2]; y[4 * q + 3] = v[3]; }
        float sm = 0.f;
#pragma unroll
        for (int i = 0; i < 16; ++i) sm += y[i];
        sm += __builtin_bit_cast(float, __builtin_amdgcn_update_dpp(0, __builtin_bit_cast(int, sm), 0xB1, 0xF, 0xF, true));
        sm += __builtin_bit_cast(float, __builtin_amdgcn_update_dpp(0, __builtin_bit_cast(int, sm), 0x4E, 0xF, 0xF, true));
        const float mean = sm * (1.f / 64.f);
        float sq = 0.f;
#pragma unroll
        for (int i = 0; i < 16; ++i) { y[i] -= mean; sq += y[i] * y[i]; }
        sq += __builtin_bit_cast(float, __builtin_amdgcn_update_dpp(0, __builtin_bit_cast(int, sq), 0xB1, 0xF, 0xF, true));
        sq += __builtin_bit_cast(float, __builtin_amdgcn_update_dpp(0, __builtin_bit_cast(int, sq), 0x4E, 0xF, 0xF, true));
        const float rs = rsqrtf(sq * (1.f / 64.f) + GN_EPS);
        const PG8_LAS float* gg = (const PG8_LAS float*)(lds + YG_PRM) + hd * 64 + pv; const PG8_LAS float* gb = gg + 1024;
        float o[16];
#pragma unroll
        for (int i = 0; i < 16; ++i) {
            const unsigned vw = r.vw[i >> 3][(i & 7) >> 1], zw = r.zw[i >> 3][(i & 7) >> 1];
            const float vf = __uint_as_float((i & 1) ? (vw & 0xffff0000u) : (vw << 16)), zf = __uint_as_float((i & 1) ? (zw & 0xffff0000u) : (zw << 16));
            o[i] = fmaf(r.rk, vf, y[i] * rs * gg[i] + gb[i]) * silu_f(zf);
        }
        bf16_t* dst = (bf16_t*)(ws + NB_G4B) + ((size_t)b * TP + c * 64 + ptok) * 1024 + hd * 64 + pv;
        u32x4 w0, w1;
        w0.x = pk_bf16c(o[0], o[1]); w0.y = pk_bf16c(o[2], o[3]); w0.z = pk_bf16c(o[4], o[5]); w0.w = pk_bf16c(o[6], o[7]);
        w1.x = pk_bf16c(o[8], o[9]); w1.y = pk_bf16c(o[10], o[11]); w1.z = pk_bf16c(o[12], o[13]); w1.w = pk_bf16c(o[14], o[15]);
        *(u32x4*)dst = w0; *(u32x4*)(dst + 8) = w1;
    }
}
__device__ __forceinline__ void phase_ygate(const Args& a, unsigned char* ws, PG8_LAS unsigned char* lds, int bid, int nb) {
    const int tid = opaque_v(threadIdx.x), grp = tid >> 8;
    YgRegs cur, nxt;
    int pair = bid;
    if (pair < 2048) yg_load(ws, 2 * pair + grp, tid, nxt);
    *(PG8_LAS f32x4*)(lds + YG_PRM + tid * 16) = *(const f32x4*)((tid < 256 ? a.in[I_GNG] : a.in[I_GNB] - 1024) + tid * 4);
#pragma unroll 1
    while (pair < 2048) {
        cur = nxt;
        const int npair = pair + nb;
        if (npair < 2048) yg_load(ws, 2 * npair + grp, tid, nxt);
        yg_step(a, ws, lds, 2 * pair + grp, tid, cur);
        pair = npair;
    }
    lds_barrier();
}

__device__ __forceinline__ void phase_lnf(const Args& a, unsigned char* ws, int bid, int nb) {
    const int tid = opaque_v(threadIdx.x), lane = tid & 63, wv = tid >> 6;
    const bf16_t* PRE = (const bf16_t*)((const float*)ws + WS_PRE);
    const bf16_t* P2 = (const bf16_t*)(ws + NB_Y);
    float x[16], y[16];
    float g0[16], b0[16], g1[16], b1[16];
    ld_row16(a.in[I_LNG], lane, g0); ld_row16(a.in[I_LNB], lane, b0); ld_row16(a.in[I_LNG] + 1024, lane, g1); ld_row16(a.in[I_LNB] + 1024, lane, b1);
    constexpr int NIT = 9, DEP = 4;
    const int rstride = nb * 8;
#pragma unroll 1
    for (int base = bid * 8 + wv; base < MT; base += rstride * NIT) {
        uint2 raw[DEP + 1][8];
#define LNF_LOAD(I) { int r_ = base + (I) * rstride; r_ = r_ < MT ? r_ : MT - 1; \
            _Pragma("unroll") for (int q = 0; q < 4; ++q) { raw[(I) % (DEP + 1)][q] = *(const uint2*)(PRE + (size_t)r_ * 1024 + q * 256 + lane * 4); raw[(I) % (DEP + 1)][4 + q] = *(const uint2*)(P2 + (size_t)r_ * 1024 + q * 256 + lane * 4); } }
#pragma unroll
        for (int i = 0; i < DEP; ++i) LNF_LOAD(i)
#pragma unroll
        for (int i = 0; i < NIT; ++i) {
            if (i + DEP < NIT) LNF_LOAD(i + DEP)
            const int row = base + i * rstride;
#pragma unroll
            for (int q = 0; q < 4; ++q) { const uint2 pv = raw[i % (DEP + 1)][q], yv = raw[i % (DEP + 1)][4 + q];
                x[4 * q] = __uint_as_float(pv.x << 16); x[4 * q + 1] = __uint_as_float(pv.x & 0xffff0000u); x[4 * q + 2] = __uint_as_float(pv.y << 16); x[4 * q + 3] = __uint_as_float(pv.y & 0xffff0000u);
                y[4 * q] = __uint_as_float(yv.x << 16); y[4 * q + 1] = __uint_as_float(yv.x & 0xffff0000u); y[4 * q + 2] = __uint_as_float(yv.y << 16); y[4 * q + 3] = __uint_as_float(yv.y & 0xffff0000u); }
            ln_calc16r(g0, b0, x);
#pragma unroll
            for (int k = 0; k < 16; ++k) x[k] = fmaf(ALPHA, x[k], y[k]);
            ln_calc16r(g1, b1, x);
#if PROBE_TIME >= 0
        if (row >= MP) {
            const unsigned long long* tsp = (const unsigned long long*)(ws + NB_BAR + 16384);
            const float dt_us = (float)(__hip_atomic_load(tsp + PROBE_TIME + 1, __ATOMIC_RELAXED, __HIP_MEMORY_SCOPE_AGENT) - __hip_atomic_load(tsp + PROBE_TIME, __ATOMIC_RELAXED, __HIP_MEMORY_SCOPE_AGENT)) * 0.01f;
            const float f = 1.f + PROBE_K * dt_us;
#pragma unroll
            for (int i = 0; i < 16; ++i) x[i] *= f;
        }
#endif
            if (row < MT) {
        float* o = (row < MP ? a.out + O_Y + (size_t)row * 1024 : a.out + O_YS + (size_t)(row - MP) * 1024) + lane * 4;
#pragma unroll
        for (int q = 0; q < 4; ++q) *(float4*)(o + q * 256) = make_float4(x[4 * q], x[4 * q + 1], x[4 * q + 2], x[4 * q + 3]);
            }
        }
#undef LNF_LOAD
    }
}
constexpr int POOL_ITEMS = BS * 32;
__device__ __forceinline__ void pool_item(const Args& a, unsigned char* ws, int item, int tid) {
    float* KCS = (float*)(ws + NB_KCS);
    const int* pt = (const int*)a.in[I_PT];
    const int s = item >> 5, n = (item & 31) * 8 + (tid >> 6), c = (tid & 63) * 4;
    const int kv = c >> 7, g = (c >> 6) & 1;
    const float* w = (kv ? a.in[I_WVC] : a.in[I_WKC]) + g;
    const int pos0 = n * 32;
    const float* src = a.in[I_CCMP] + ((size_t)pt[s * NPAGE + (pos0 >> 7)] * PAGE + (pos0 & 127)) * 256 + c;
    f32x4 v[32];
#pragma unroll
    for (int l = 0; l < 32; ++l) v[l] = __builtin_nontemporal_load((const f32x4*)(src + (size_t)l * 256));
    float4 acc = make_float4(0.f, 0.f, 0.f, 0.f);
#pragma unroll
    for (int l = 0; l < 32; ++l) { const float wl = w[l * 2]; acc.x = fmaf(v[l][0], wl, acc.x); acc.y = fmaf(v[l][1], wl, acc.y); acc.z = fmaf(v[l][2], wl, acc.z); acc.w = fmaf(v[l][3], wl, acc.w); }
    *(float4*)(KCS + ((size_t)(s * 256 + n) * 256 + c)) = acc;
}
__device__ __forceinline__ void sample_pool_copy(const Args& a, unsigned char* ws, int bid, int nb) {
    const float4* cw = (const float4*)a.in[I_CWIN];
    float4* ow = (float4*)(a.out + O_WINS);
#pragma unroll 4
    for (int i = bid * NTH + threadIdx.x; i < BS * 511 * 64; i += nb * NTH) {
        const int s = i / (511 * 64), rem = i - s * (511 * 64);
        ow[(size_t)s * 512 * 64 + rem] = cw[(size_t)s * 512 * 64 + 64 + rem];
    }
}
__device__ __forceinline__ void sample_conv(const Args& a, unsigned char* ws, PG8_LAS unsigned char* lds, int s) {
    const int ch = opaque_v(threadIdx.x);
    const bf16_t* h = (const bf16_t*)(ws + NB_HB) + (size_t)(MP + s) * 2560;
    const float* sc = a.in[I_SCONV] + (size_t)s * 30 * 512 + ch;
    const float u = bf2f(h[ch]) * sigm_f(bf2f(h[512 + ch]));
    float scv[30], wj[31];
    const float* __restrict__ cwp = a.in[I_CONVW] + ch;
#pragma unroll
    for (int j = 0; j < 30; ++j) { scv[j] = sc[(size_t)j * 512]; wj[j] = cwp[j * 512]; }
    wj[30] = cwp[30 * 512];
    float acc = a.in[I_CONVB][ch];
#pragma unroll
    for (int j = 0; j < 30; ++j) acc = fmaf(wj[j], scv[j], acc);
    acc = fmaf(wj[30], u, acc);
    float* __restrict__ oc = a.out + O_CONVS + (size_t)s * 30 * 512 + ch;
#pragma unroll
    for (int i = 0; i < 29; ++i) oc[(size_t)i * 512] = scv[i + 1];
    oc[(size_t)29 * 512] = u;
    PG8_LAS float* red = (PG8_LAS float*)lds;
    const int lane = ch & 63, wv = ch >> 6;
    float sm = wave_sum(acc);
    __syncthreads();
    if (lane == 0) red[wv] = sm;
    __syncthreads();
    float tot = 0.f;
#pragma unroll
    for (int i = 0; i < 8; ++i) tot += red[i];
    const float mean = tot * (1.f / 512.f);
    const float d = acc - mean;
    float sq = wave_sum(d * d);
    __syncthreads();
    if (lane == 0) red[wv] = sq;
    __syncthreads();
    tot = 0.f;
#pragma unroll
    for (int i = 0; i < 8; ++i) tot += red[i];
    const float rs = rsqrtf(tot * (1.f / 512.f) + LN_EPS);
    const float y = silu_f(d * rs * a.in[I_CLNG][ch] + a.in[I_CLNB][ch]) * silu_f(bf2f(h[1024 + ch]));
    ((bf16_t*)(ws + NB_CATB))[(size_t)(MP + s) * 1024 + ch] = (bf16_t)(pk_bf16(y, 0.f) & 0xffffu);
    __syncthreads();
}

constexpr int SP_STRIDE = 66;
__device__ __forceinline__ void sample_attn(const Args& a, unsigned char* ws, PG8_LAS unsigned char* lds, int s, int g, int part) {
    const int tid = opaque_v(threadIdx.x), lane = tid & 63, wv = __builtin_amdgcn_readfirstlane(tid >> 6);
    PG8_LAS float* PC = (PG8_LAS float*)lds;
    PG8_LAS float* IMP = (PG8_LAS float*)(lds + 4096);
    PG8_LAS int* SEL = (PG8_LAS int*)(lds + 4096 + 1024);
    PG8_LAS int* FLG = (PG8_LAS int*)(lds + 4096 + 1024 + 128);
    PG8_LAS float* PS = (PG8_LAS float*)(lds + 8192) + (tid >> 6) * 64;
    PG8_LAS float* OCH = (PG8_LAS float*)(lds + 12288);
    const int r = wv & 3, hh = g * 4 + r;
    const float slope = __builtin_amdgcn_exp2f(-(float)(hh + 1));
    const int* pt = (const int*)a.in[I_PT] + s * NPAGE;
    const bf16_t* hrow = (const bf16_t*)(ws + NB_HB) + (size_t)(MP + s) * 2560;
    const int kq4 = lane >> 4, ch4 = lane & 15;
    float q4[4];
    { const uint2 w = *(const uint2*)(hrow + 1536 + hh * 64 + ch4 * 4);
      q4[0] = __uint_as_float(w.x << 16); q4[1] = __uint_as_float(w.x & 0xffff0000u); q4[2] = __uint_as_float(w.y << 16); q4[3] = __uint_as_float(w.y & 0xffff0000u); }
    {
        const int nb0 = (wv >> 2) * 128 + kq4;
        const float* kc = (const float*)(ws + NB_KCS) + (size_t)s * 256 * 256 + g * 64 + ch4 * 4;
        f32x4 kk[32];
#pragma unroll
        for (int j = 0; j < 32; ++j) kk[j] = *(const f32x4*)(kc + (size_t)(nb0 + j * 4) * 256);
#pragma unroll
        for (int j = 0; j < 32; ++j) {
            float d = fmaf(q4[0], kk[j][0], fmaf(q4[1], kk[j][1], fmaf(q4[2], kk[j][2], q4[3] * kk[j][3])));
            d = dpp_red16f(d);
            const int n = nb0 + j * 4;
            if (ch4 == 0) PC[r * 256 + n] = d - slope * (float)(PAST - (32 * n + 31));
        }
    }
    lds_barrier();
    if (wv < 4) {
        float sc[4];
        float mx = -INFINITY;
#pragma unroll
        for (int i = 0; i < 4; ++i) { sc[i] = PC[r * 256 + lane + 64 * i]; mx = fmaxf(mx, sc[i]); }
#pragma unroll
        for (int o = 32; o > 0; o >>= 1) mx = fmaxf(mx, __shfl_xor(mx, o));
        float ls = 0.f;
#pragma unroll
        for (int i = 0; i < 4; ++i) { sc[i] = __expf(sc[i] - mx); ls += sc[i]; }
        ls = wave_sum(ls);
        const float inv = 1.f / ls;
#pragma unroll
        for (int i = 0; i < 4; ++i) PC[r * 256 + lane + 64 * i] = sc[i] * inv;
    }
    lds_barrier();
    float ocp;
    {
        const int n0 = part * 64 + (wv >> 2) * 32;
        const float* vc = (const float*)(ws + NB_KCS) + (size_t)s * 256 * 256 + (size_t)n0 * 256 + 128 + g * 64 + lane;
        float vv[32];
#pragma unroll
        for (int n = 0; n < 32; ++n) vv[n] = vc[(size_t)n * 256];
        float oc0 = 0.f, oc1 = 0.f, oc2 = 0.f, oc3 = 0.f;
#pragma unroll
        for (int n = 0; n < 32; n += 4) {
            oc0 = fmaf(PC[r * 256 + n0 + n], vv[n], oc0); oc1 = fmaf(PC[r * 256 + n0 + n + 1], vv[n + 1], oc1);
            oc2 = fmaf(PC[r * 256 + n0 + n + 2], vv[n + 2], oc2); oc3 = fmaf(PC[r * 256 + n0 + n + 3], vv[n + 3], oc3);
        }
        ocp = (oc0 + oc1) + (oc2 + oc3);
        if (wv >= 4) OCH[r * 64 + lane] = ocp;
    }
    if (tid < 129) {
        float v = 0.f;
        if (tid < 128) { for (int rr = 0; rr < 4; ++rr) v += PC[rr * 256 + 2 * tid] + PC[rr * 256 + 2 * tid + 1]; }
        if (tid == 0 || tid >= 127) v = 1e4f;
        IMP[tid] = v;
    }
    lds_barrier();
    if (wv < 4) ((float*)(ws + NB_OCS))[((size_t)part * BS * 8 + (s * 8 + hh)) * 64 + lane] = ocp + OCH[r * 64 + lane];
    if (tid < 129) {
        const float vj = IMP[tid];
        int rank = 0;
        for (int i = 0; i < 129; ++i) { const float vi = IMP[i]; rank += (vi > vj || (vi == vj && i < tid)) ? 1 : 0; }
        FLG[tid] = (rank < 16) ? 1 : 0;
    }
    lds_barrier();
    if (tid < 129 && FLG[tid]) { int slot = 0; for (int i = 0; i < tid; ++i) slot += FLG[i]; SEL[slot] = tid; }
    lds_barrier();
    const float* csel = a.in[I_CSEL];
    const float* newsel = a.out + O_SELS + (size_t)s * 256;
    const float* cwin = a.in[I_CWIN] + (size_t)s * 512 * 256;
    const float* newwin = a.out + O_WINS + (size_t)(s * 512 + 511) * 256;
    const int blk0 = SEL[part * 4 + (wv >> 2)], blk1 = SEL[part * 4 + (wv >> 2) + 2];
    const int pg0 = (blk0 < 128) ? pt[blk0 >> 1] : 0, pg1 = (blk1 < 128) ? pt[blk1 >> 1] : 0;
#pragma unroll 1
    for (int it = 0; it < 3; ++it) {
        const int lb = (wv >> 2) + 2 * it;
        const bool is_sel = lb < 4;
        const int slot = is_sel ? part * 4 + lb : part * 2 + (lb - 4);
        const float* kbase; int kstride; const float* vb; int vstride_last; float dist; bool valid; int nk;
        if (is_sel) {
            const int blk = it ? blk1 : blk0, pg = it ? pg1 : pg0;
            const int kpos = blk * 64 + lane;
            valid = kpos <= PAST;
            kbase = (blk < 128) ? csel + ((size_t)pg * PAGE + ((blk * 64) & 127)) * 256 : newsel; kstride = (blk < 128) ? 256 : 0;
            vb = (blk < 128) ? csel + ((size_t)pg * PAGE + ((blk * 64) & 127)) * 256 + 128 + g * 64 + lane : newsel + 128 + g * 64 + lane;
            nk = (blk < 128) ? 64 : 1; dist = (float)(PAST - kpos); vstride_last = 0;
        } else {
            const int i0 = 1 + slot * 64;
            const int i = i0 + lane;
            valid = true; nk = 64;
            kbase = cwin + (size_t)i0 * 256; kstride = 256;
            vb = cwin + (size_t)i0 * 256 + 128 + g * 64 + lane;
            dist = (float)(512 - i); vstride_last = (slot == 7) ? 1 : 0;
        }
        float vv[64];
        vv[0] = vb[0];
        if (nk == 64) {
#pragma unroll
            for (int k = 1; k < 63; ++k) vv[k] = vb[(size_t)k * 256];
            vv[63] = vstride_last ? newwin[128 + g * 64 + lane] : vb[(size_t)63 * 256];
        } else {
#pragma unroll
            for (int k = 1; k < 64; ++k) vv[k] = 0.f;
        }
        {
            f32x4 kk[16];
#pragma unroll
            for (int j = 0; j < 16; ++j) { const int k = j * 4 + kq4; const float* row = (vstride_last && k == 63) ? newwin : kbase + (size_t)k * kstride; kk[j] = *(const f32x4*)(row + g * 64 + ch4 * 4); }
#pragma unroll
            for (int j = 0; j < 16; ++j) {
                float d = fmaf(q4[0], kk[j][0], fmaf(q4[1], kk[j][1], fmaf(q4[2], kk[j][2], q4[3] * kk[j][3])));
                d = dpp_red16f(d);
                if (ch4 == 0) PS[j * 4 + kq4] = d;
            }
        }
        __builtin_amdgcn_wave_barrier();
        const float sc = valid ? PS[lane] - slope * dist : -INFINITY;
        __builtin_amdgcn_wave_barrier();
        float mx = sc;
#pragma unroll
        for (int of = 32; of > 0; of >>= 1) mx = fmaxf(mx, __shfl_xor(mx, of));
        const float p = valid ? __expf(sc - mx) : 0.f;
        const float l = wave_sum(p);
        PS[lane] = p; __builtin_amdgcn_wave_barrier();
        float o0 = 0.f, o1 = 0.f, o2 = 0.f, o3 = 0.f;
#pragma unroll
        for (int k = 0; k < 64; k += 4) { o0 = fmaf(PS[k], vv[k], o0); o1 = fmaf(PS[k + 1], vv[k + 1], o1); o2 = fmaf(PS[k + 2], vv[k + 2], o2); o3 = fmaf(PS[k + 3], vv[k + 3], o3); }
        __builtin_amdgcn_wave_barrier();
        float* pp = (float*)(ws + NB_PARTS) + ((size_t)((s * 8 + hh) * 24 + (is_sel ? slot : 16 + slot))) * SP_STRIDE;
        pp[2 + lane] = (o0 + o1) + (o2 + o3);
        if (lane == 0) { pp[0] = mx; pp[1] = l; }
    }
    lds_barrier();
}
__device__ __forceinline__ void sample_combine(const Args& a, unsigned char* ws, int s, int g) {
    const int tid = opaque_v(threadIdx.x), lane = tid & 63, wv = __builtin_amdgcn_readfirstlane(tid >> 6);
    if (wv >= 4) return;
    const int hh = g * 4 + wv;
    const float* pp = (const float*)(ws + NB_PARTS) + (size_t)(s * 8 + hh) * 24 * SP_STRIDE;
    const float* g3p = (const float*)(ws + NB_G3) + (size_t)(MP + s) * 32 + hh * 3;
    const float gc = sigm_f(g3p[0]), gs = sigm_f(g3p[1]), gw = sigm_f(g3p[2]);
    const float* ocs = (const float*)(ws + NB_OCS) + (size_t)(s * 8 + hh) * 64 + lane;
    float res = gc * ((ocs[0] + ocs[(size_t)BS * 8 * 64]) + (ocs[(size_t)2 * BS * 8 * 64] + ocs[(size_t)3 * BS * 8 * 64]));
    float pm[24], pl[24], po[24];
#pragma unroll
    for (int i = 0; i < 24; ++i) { const float* q = pp + (size_t)i * SP_STRIDE; pm[i] = q[0]; pl[i] = q[1]; po[i] = q[2 + lane]; }
#pragma unroll
    for (int br = 0; br < 2; ++br) {
        const int n0 = br ? 16 : 0, cnt = br ? 8 : 16;
        float M = -INFINITY;
#pragma unroll
        for (int i = 0; i < cnt; ++i) M = fmaxf(M, pm[n0 + i]);
        float L = 0.f, O = 0.f;
#pragma unroll
        for (int i = 0; i < cnt; ++i) { const float w = __expf(pm[n0 + i] - M); L = fmaf(pl[n0 + i], w, L); O = fmaf(po[n0 + i], w, O); }
        res = fmaf(br ? gw : gs, O / L, res);
    }
    const bf16_t* hrow = (const bf16_t*)(ws + NB_HB) + (size_t)(MP + s) * 2560;
    const float y = res * silu_f(bf2f(hrow[2048 + hh * 64 + lane]));
    ((bf16_t*)(ws + NB_CATB))[(size_t)(MP + s) * 1024 + 512 + hh * 64 + lane] = (bf16_t)(pk_bf16(y, 0.f) & 0xffffu);
}

static_assert(CS_END <= LDS_MISC, "chunk-scan LDS map overlaps the barrier words");
enum { PH_PREP = 0, PH_GEMM1, PH_CONV, PH_ATTN, PH_GEMM2, PH_LNS, PH_GEMM3, PH_PREP2, PH_SCAN, PH_POST, PH_GEMM4, PH_LNF, NPHASE };

__global__ void __launch_bounds__(NTH, 2) mega(Args a) {
    extern __shared__ __attribute__((aligned(16))) unsigned char lds_raw[];
    PG8_LAS unsigned char* lds = (PG8_LAS unsigned char*)lds_raw;
    unsigned char* ws = a.ws;
    volatile LAS unsigned* misc = (volatile LAS unsigned*)(lds + LDS_MISC);
    if (threadIdx.x < 4) misc[threadIdx.x] = 0u;
    __syncthreads();
    XcdBarrier bar = xcd_barrier_post((unsigned*)(ws + NB_BAR), misc);
    const int lo = a.ph_lo, hi = a.ph_hi;
#ifndef DUP_SATTN
#define DUP_SATTN 0
#endif
#ifndef DUP_CONV
#define DUP_CONV 0
#endif
#ifndef DUP_GEMM1
#define DUP_GEMM1 0
#endif
#ifndef SKIPMASK
#define SKIPMASK 0
#endif
#define IN(k) (lo <= (k) && (k) < hi && !((SKIPMASK >> (k)) & 1))
#ifndef REPMASK
#define REPMASK 0
#endif
#define REPS(k) _Pragma("unroll 1") for (int rep_ = 0; rep_ < (((REPMASK >> (k)) & 1) ? 2 : 1); ++rep_)
#if PROBE_TIME >= 0
    unsigned long long* const tstamp = (unsigned long long*)(ws + NB_BAR + 16384);
#define STAMP(i) do { if (blockIdx.x == 0 && threadIdx.x == 0) __hip_atomic_store(tstamp + (i), (unsigned long long)__builtin_amdgcn_s_memrealtime(), __ATOMIC_RELAXED, __HIP_MEMORY_SCOPE_AGENT); } while (0)
#else
#define STAMP(i) do { } while (0)
#endif
#define SEAM(k) do { if (IN(k) && IN((k) + 1)) xcd_barrier(bar); STAMP((k) + 1); } while (0)
    STAMP(0);
    if (IN(PH_PREP)) REPS(PH_PREP) {
        const int bid = opaque(blockIdx.x), nb = gridDim.x;
        convert_wt(a.in[I_WIN], 1024, DIN, (bf16_t*)(ws + NB_WT1), N1PAD, MapWin{}, bid, nb);
        convert_wt(a.in[I_WOUTE], 1024, 1024, (bf16_t*)(ws + NB_WT2), 1024, MapId{}, bid, nb);
        for (int n = 0; n < 4; ++n) convert_wt(a.in[I_WRKVZ] + (size_t)n * 1024 * 1024, 1024, 1024, (bf16_t*)(ws + NB_WT3) + (size_t)n * 1024 * 1024, 1024, MapId{}, bid, nb);
        convert_wt(a.in[I_WOUTO], 1024, 1024, (bf16_t*)(ws + NB_WT4), 1024, MapId{}, bid, nb);
        convert_wfrag(a.in[I_W1], (bf16_t*)(ws + NB_W1T), bid, nb);
        convert_wfrag(a.in[I_A1], (bf16_t*)(ws + NB_A1T), bid, nb);
        convert_wt(a.in[I_W2], 64, 1024, (bf16_t*)(ws + NB_W2T), 1024, MapId{}, bid, nb);
        convert_wt(a.in[I_A2], 64, 1024, (bf16_t*)(ws + NB_A2T), 1024, MapId{}, bid, nb);
        convert_rows(a.in[I_XP], (size_t)MP * 1024 / 8, (bf16_t*)(ws + NB_XB), bid, nb);
        convert_rows(a.in[I_XS], (size_t)BS * 1024 / 8, (bf16_t*)(ws + NB_XSB), bid, nb);
        sample_pool_copy(a, ws, bid, nb);
    }
    SEAM(PH_PREP);
    if (IN(PH_GEMM1)) REPS(PH_GEMM1) {
        const int bid = opaque(blockIdx.x), nb = gridDim.x;
        const Route1 R{(bf16_t*)(ws + NB_HB), (bf16_t*)(ws + NB_KVB), (float*)(ws + NB_G3), a.out};
        {
            pg8::Gemm g{(const bf16_t*)(ws + NB_XB), (const bf16_t*)(ws + NB_WT1), MP, N1PAD, 1024};
            const int G1 = nb >= 256 ? 232 : nb;
            if (bid < G1) {
                pg8::StaticOrder S; S.init(MP, N1PAD, G1, bid);
                Epi1 E{R};
                pg8::gemm_phase<Epi1, pg8::StaticOrder, false>(lds, g, S, E, nullptr);
            }
        }
        {
            unsigned* const qctr = (unsigned*)(ws + NB_BAR + 20480);
            PG8_LAS int* const slot = (PG8_LAS int*)(lds + LDS_MISC + 64);
            const int tidq = opaque_v(threadIdx.x);
#pragma unroll 1
            for (;;) {
                lds_barrier();
                if (tidq == 0) *slot = (int)__hip_atomic_fetch_add(qctr, 1u, __ATOMIC_RELAXED, __HIP_MEMORY_SCOPE_AGENT);
                lds_barrier();
                const int item = __builtin_amdgcn_readfirstlane(*slot);
                if (item >= 105 + POOL_ITEMS) break;
                if (item >= 105) { pool_item(a, ws, item - 105, tidq); continue; }
                const int task = item;
                sample_gemm32_wg((const bf16_t*)(ws + NB_XSB), (const bf16_t*)(ws + NB_WT1), 1024, task * 32, lds,
                    [&](int r, int n, float v) {
                        const int row = MP + r;
                        if (n < 2560) { const float sc = (n >= 1536 && n < 2048) ? 0.125f : 1.0f; ((bf16_t*)(ws + NB_HB))[(size_t)row * 2560 + n] = (bf16_t)(pk_bf16c(v * sc, 0.f) & 0xffffu); }
                        else if (n < 3328) { const int c = n - 2560, i3 = c >> 8, cc = c & 255; ((bf16_t*)(ws + NB_KVB))[(size_t)row * 768 + c] = (bf16_t)(pk_bf16c(v, 0.f) & 0xffffu);
                            float* dst = (i3 == 0) ? a.out + O_CMPS + (size_t)r * 256 + cc : (i3 == 1) ? a.out + O_SELS + (size_t)r * 256 + cc : a.out + O_WINS + (size_t)(r * 512 + 511) * 256 + cc;
                            *dst = v; }
                        else if (n < 3352) ((float*)(ws + NB_G3))[(size_t)row * 32 + (n - 3328)] = v;
                    });
            }
        }
    }
    SEAM(PH_GEMM1);
    if (IN(PH_CONV)) REPS(PH_CONV) {
        const int bid = opaque(blockIdx.x), nb = gridDim.x;
        {
            ConvRegs cr;
            if (bid < 512) conv_load((const bf16_t*)(ws + NB_HB), bid, 0, opaque_v(threadIdx.x), cr);
#pragma unroll 1
            for (int item = bid; item < 512; item += nb) conv_item(a, ws, lds, item, item + nb < 512 ? item + nb : item, cr);
        }
        pool_prompt(a, ws, bid, nb);
#if DUP_CONV == 2
        __syncthreads();
        pool_prompt(a, ws, bid, nb);
#endif
        sample_attn(a, ws, lds, bid >> 3, (bid >> 2) & 1, bid & 3);
#if DUP_SATTN
        __syncthreads();
        sample_attn(a, ws, lds, bid >> 3, (bid >> 2) & 1, bid & 3);
#endif
        if (bid >= 96 && bid < 128) sample_conv(a, ws, lds, bid - 96);
    }
    SEAM(PH_CONV);
    if (IN(PH_ATTN)) REPS(PH_ATTN) {
        const int bid = opaque(blockIdx.x), nb = gridDim.x;
        if (bid < 64) sample_combine(a, ws, bid >> 1, bid & 1);
        for (int pr = bid; pr < 256; pr += nb) {
            const int b = pr >> 5, g = (pr >> 4) & 1, xq = pr & 15;
#pragma unroll 1
            for (int k = 0; k < 2; ++k) attn_item(a, ws, lds, b, g, k ? xq : 31 - xq);
        }
    }
    SEAM(PH_ATTN);
    if (IN(PH_GEMM2)) REPS(PH_GEMM2) {
        const int bid = opaque(blockIdx.x), nb = gridDim.x;
        {
            pg8::Gemm g{(const bf16_t*)(ws + NB_CATB), (const bf16_t*)(ws + NB_WT2), MP, 1024, 1024};
            pg8::StaticOrder S; S.init(MP, 1024, nb, bid);
            EpiPreRes E{(bf16_t*)((float*)ws + WS_PRE), (const bf16_t*)(ws + NB_XB)};
            pg8::gemm_phase<EpiPreRes, pg8::StaticOrder, false>(lds, g, S, E, nullptr);
        }
        {
            const int lane = threadIdx.x & 63, wv = __builtin_amdgcn_readfirstlane(threadIdx.x >> 6);
            bf16_t* PREs = (bf16_t*)((float*)ws + WS_PRE) + (size_t)MP * 1024;
            const float* xs = a.in[I_XS];
            for (int task = bid; task < 32; task += nb)
                sample_gemm32_wg((const bf16_t*)(ws + NB_CATB) + (size_t)MP * 1024, (const bf16_t*)(ws + NB_WT2), 1024, task * 32, lds,
                              [&](int r, int n, float v) { PREs[(size_t)r * 1024 + n] = (bf16_t)(pk_bf16c(fmaf(ALPHA, xs[(size_t)r * 1024 + n], v), 0.f) & 0xffffu); });
        }
    }
    SEAM(PH_GEMM2);
    if (IN(PH_LNS)) REPS(PH_LNS) { const int bid = opaque(blockIdx.x), nb = gridDim.x; phase_lns(a, ws, lds, bid, nb); }
    SEAM(PH_LNS);
    if (IN(PH_GEMM3)) REPS(PH_GEMM3) {
        const int bid = opaque(blockIdx.x), nb = gridDim.x;
        {
            pg8::Gemm g{(const bf16_t*)(ws + NB_XSH), (const bf16_t*)(ws + NB_WT3), MP, 4096, 1024};
            Order3 S; S.init(nb, bid);
            Epi3 E{(bf16_t*)(ws + NB_RKVZ)};
            pg8::gemm_phase<Epi3, Order3, false>(lds, g, S, E, nullptr);
        }
        {
            const int lane = threadIdx.x & 63, wv = __builtin_amdgcn_readfirstlane(threadIdx.x >> 6);
            for (int task = bid; task < 128; task += nb) {
                const int n = task >> 5, n0 = (task & 31) * 32;
                bf16_t* dst = (bf16_t*)(ws + NB_RKVZ) + ((size_t)n * XSH_ROWS + MP) * 1024;
                sample_gemm32_wg((const bf16_t*)(ws + NB_XSH) + ((size_t)n * XSH_ROWS + MP) * 1024, (const bf16_t*)(ws + NB_WT3) + (size_t)n * 1024 * 1024, 1024, n0, lds,
                              [&](int r, int c, float v) { dst[(size_t)r * 1024 + c] = (bf16_t)(pk_bf16c(v, 0.f) & 0xffffu); });
            }
            if (bid >= nb - 2) {
                const int tidl = opaque_v(threadIdx.x), task = 1024 + (nb - 1 - bid);
                LoraRegs lr_; lora_load(ws, task, tidl, lr_); lora_tile(ws, lds, task, tidl, lr_);
            }
        }
    }
    SEAM(PH_GEMM3);
    if (IN(PH_PREP2)) REPS(PH_PREP2) {
        const int bid = opaque(blockIdx.x), nb = gridDim.x;
        for (int pr = bid; pr < 256; pr += nb) {
            const int bh = pr >> 1, b = bh >> 4, hd = bh & 15, c0 = (pr & 1) * 16;
            const int tidp = opaque_v(threadIdx.x), lanep = tidp & 63, wvp = tidp >> 6;
            bf16x8 btf[4];
            { const int which = wvp >> 2, nt = wvp & 1;
              const bf16_t* Bt = (const bf16_t*)(ws + (which ? NB_A2T : NB_W2T)) + (size_t)(hd * 64 + nt * 32 + (lanep & 31)) * 64 + (lanep >> 5) * 8;
#pragma unroll
              for (int s4 = 0; s4 < 4; ++s4) btf[s4] = *(const bf16x8*)(Bt + s4 * 16); }
            if (tidp < 320) { const int w5 = tidp >> 6; const float* src = a.in[w5 == 0 ? I_KK : w5 == 1 ? I_KA : w5 == 2 ? I_RK : w5 == 3 ? I_W0 : I_A0];
                ((PG8_LAS float*)(lds + CS_PRM))[tidp] = src[hd * 64 + (tidp & 63)]; }
            PreRegs pcur, pnxt;
            scanpre_load(ws, b, hd, c0, tidp, pnxt);
            __syncthreads();
#pragma unroll 1
            for (int cc = 0; cc < 16; ++cc) {
                pcur = pnxt;
                if (cc + 1 < 16) scanpre_load(ws, b, hd, c0 + cc + 1, tidp, pnxt);
                scanpre_chunk(a, ws, lds, b, hd, c0 + cc, pcur, btf);
            }
        }
    }
    SEAM(PH_PREP2);
    if (IN(PH_SCAN)) REPS(PH_SCAN) {
        const int bid = opaque(blockIdx.x), nb = gridDim.x;
#pragma unroll 1
        for (int item = bid; item < 128; item += nb) scanseq_head(a, ws, lds, item >> 4, item & 15);
        const int lane = opaque_v(threadIdx.x) & 63, wv = __builtin_amdgcn_readfirstlane(threadIdx.x >> 6);
        for (int task = (nb - 1 - bid) * 8 + wv; task < BS * 16; task += nb * 8) scan_sample(a, ws, task >> 4, task & 15, lane);
    }
    SEAM(PH_SCAN);
    if (IN(PH_POST)) REPS(PH_POST) { const int bid = opaque(blockIdx.x), nb = gridDim.x; phase_ygate(a, ws, lds, bid, nb); }
    SEAM(PH_POST);
    if (IN(PH_GEMM4)) REPS(PH_GEMM4) {
        const int bid = opaque(blockIdx.x), nb = gridDim.x;
        {
            pg8::Gemm g{(const bf16_t*)(ws + NB_G4B), (const bf16_t*)(ws + NB_WT4), MP, 1024, 1024};
            pg8::StaticOrder S; S.init(MP, 1024, nb, bid);
            EpiPreB E{(bf16_t*)(ws + NB_Y)};
            pg8::gemm_phase<EpiPreB, pg8::StaticOrder, false>(lds, g, S, E, nullptr);
        }
        {
            bf16_t* PREs = (bf16_t*)(ws + NB_Y) + (size_t)MP * 1024;
            for (int task = bid; task < 32; task += nb)
                sample_gemm32_wg((const bf16_t*)(ws + NB_G4B) + (size_t)MP * 1024, (const bf16_t*)(ws + NB_WT4), 1024, task * 32, lds,
                              [&](int r, int n, float v) { PREs[(size_t)r * 1024 + n] = (bf16_t)(pk_bf16c(v, 0.f) & 0xffffu); });
        }
    }
    SEAM(PH_GEMM4);
    if (IN(PH_LNF)) REPS(PH_LNF) { const int bid = opaque(blockIdx.x), nb = gridDim.x; phase_lnf(a, ws, bid, nb); }
#undef IN
#undef SEAM
}
}

extern "C" void kernel_launch(void* const* d_in, const int* in_sizes, int n_in, void* d_out, int out_size, void* d_ws, size_t ws_size,
                              hipStream_t stream) {
    if (n_in != N_IN || ws_size < nk::NB_END) { fprintf(stderr, "kernel_launch: unexpected n_in %d or ws_size %zu (need %zu)\n", n_in, ws_size, (size_t)nk::NB_END); return; }
    static int grid = 0;
    if (!grid) {
        int dev = 0, cus = 0, per_cu = 0;
        hipGetDevice(&dev);
        hipDeviceGetAttribute(&cus, hipDeviceAttributeMultiprocessorCount, dev);
        hipFuncSetAttribute((const void*)nk::mega, hipFuncAttributeMaxDynamicSharedMemorySize, nk::LDS_BYTES);
        hipOccupancyMaxActiveBlocksPerMultiprocessor(&per_cu, (const void*)nk::mega, nk::NTH, nk::LDS_BYTES);
        if (per_cu < 1) fprintf(stderr, "kernel_launch: occupancy query says %d blocks per CU\n", per_cu);
        grid = cus;
    }
    hipMemsetAsync((unsigned char*)d_ws + nk::NB_BAR, 0, 32768, stream);
    nk::Args a{};
    for (int i = 0; i < N_IN; ++i) a.in[i] = (const float*)d_in[i];
    a.out = (float*)d_out; a.ws = (unsigned char*)d_ws; a.ph_lo = 0; a.ph_hi = nk::NPHASE;
    void* args[] = {&a};
    hipError_t e = hipLaunchCooperativeKernel((const void*)nk::mega, dim3(grid), dim3(nk::NTH), args, nk::LDS_BYTES, stream);
    if (e != hipSuccess) fprintf(stderr, "cooperative launch failed: %s (grid %d)\n", hipGetErrorString(e), grid);
}
```
